# Optimizing an MI355X kernel written in HIP

```python
import math
import jax
import jax.numpy as jnp
from jax import lax
import numpy as np

D_MODEL = 1024
BATCH = 16
SEQ = 2048
DEPTH = 1

MEM_LEN = 256
EPS = 1e-6
DA_HEADS = 4
DA_DIM = 64
DA_VDIM = 2 * DA_DIM
GLA_HEADS = 4
GLA_DK = 64
GLA_DV = 128
GLA_RANK = 16
GLA_TAU = 16.0
GLA_CHUNK = 64
MIX_WIDTH = DA_HEADS * DA_VDIM + GLA_HEADS * GLA_DV
ROPE_THETA = 500000.0
ROPE_DIM = DA_DIM // 4
Q_BLOCK = 128
X_HEADS = 4
X_DIM = D_MODEL // X_HEADS
N_EXPERTS = 32
TOP_K = 4
D_FF = D_MODEL
SWIGLU_LIMIT = 7.0
SWIGLU_ALPHA = 1.702
MOE_BLOCK = 128
DA_QK = DA_HEADS * 2 * DA_DIM
DA_V = DA_HEADS * DA_VDIM
G_QK = GLA_HEADS * GLA_DK
G_V = GLA_HEADS * GLA_DV
SPLITS = (DA_QK, DA_QK, DA_V, G_QK, G_QK, G_V, G_V, GLA_RANK)
IN_WIDTH = 2 * DA_QK + DA_V + 2 * G_QK + 2 * G_V + GLA_RANK

kernel_name = 'hymba_style_diffattn_gla_moe_block'


def rms_norm(x, g):
    xf = x.astype(jnp.float32)
    y = xf * lax.rsqrt(jnp.mean(xf * xf, axis=-1, keepdims=True) + EPS)
    return (y * g.astype(jnp.float32)).astype(x.dtype)


def partial_rope(t, positions):
    half = ROPE_DIM // 2
    inv_freq = ROPE_THETA ** (-jnp.arange(0, ROPE_DIM, 2, dtype=jnp.float32) / ROPE_DIM)
    ang = positions.astype(jnp.float32)[..., None] * inv_freq
    cos = jnp.cos(ang)[:, :, None, None, :]
    sin = jnp.sin(ang)[:, :, None, None, :]
    tf = t.astype(jnp.float32)
    x1, x2 = tf[..., :half], tf[..., half:ROPE_DIM]
    rot = jnp.concatenate([x1 * cos - x2 * sin, x2 * cos + x1 * sin, tf[..., ROPE_DIM:]], axis=-1)
    return rot.astype(t.dtype)


def diff_attention(q, k, v, lam, positions):
    S = q.shape[1]
    q = partial_rope(q, positions) * (DA_DIM ** -0.5)
    k = partial_rope(k, positions)
    outs = []
    for i in range(S // Q_BLOCK):
        q0 = i * Q_BLOCK
        kend = q0 + Q_BLOCK
        s = jnp.einsum('bqhcd,bkhcd->bhcqk', q[:, q0:kend], k[:, :kend]).astype(jnp.float32)
        mask = (q0 + jnp.arange(Q_BLOCK))[:, None] >= jnp.arange(kend)[None, :]
        p = jax.nn.softmax(jnp.where(mask, s, -jnp.inf), axis=-1)
        a = p[:, :, 0] - lam * p[:, :, 1]
        outs.append(jnp.einsum('bhqk,bkhe->bqhe', a.astype(v.dtype), v[:, :kend]))
    return jnp.concatenate(outs, axis=1)


def gla_chunked(q, k, v, log_a):
    B, S, H, dk = q.shape
    dv = v.shape[-1]
    C = GLA_CHUNK
    n = S // C

    def to_chunks(t):
        return t.reshape(B, n, C, H, t.shape[-1]).transpose(1, 0, 3, 2, 4)

    qc, kc, vc, gc = (to_chunks(t) for t in (q * (dk ** -0.5), k, v, log_a))
    causal = jnp.tril(jnp.ones((C, C), dtype=bool))[:, :, None]

    def step(state, inp):
        qi, ki, vi, gi = inp
        b = jnp.cumsum(gi, axis=2)
        inter = jnp.einsum('bhtd,bhde->bhte', qi * jnp.exp(b), state)
        diff = b[:, :, :, None, :] - b[:, :, None, :, :]
        decay = jnp.exp(jnp.where(causal, diff, -jnp.inf))
        attn = jnp.einsum('bhtd,bhsd,bhtsd->bhts', qi, ki, decay)
        intra = jnp.einsum('bhts,bhse->bhte', attn, vi)
        b_last = b[:, :, -1:, :]
        new_state = state * jnp.exp(b_last[:, :, 0, :, None]) + jnp.einsum(
            'bhsd,bhse->bhde', ki * jnp.exp(b_last - b), vi)
        return new_state, inter + intra

    state0 = jnp.zeros((B, H, dk, dv), jnp.float32)
    _, out = lax.scan(step, state0, (qc, kc, vc, gc))
    return out.transpose(1, 0, 3, 2, 4).reshape(B, S, H, dv)


def hybrid_mixer(h, positions, w_in, lambda_q1, lambda_k1, lambda_q2, lambda_k2,
                 diff_norm_g, w_alpha2, b_alpha, gla_norm_g, w_out, lambda_init):
    B, S, _ = h.shape
    proj = h @ w_in
    idx = [int(c) for c in np.cumsum(SPLITS)[:-1]]
    dq, dk_, dv_, gq, gk, gv, gr, ga = jnp.split(proj, idx, axis=-1)
    lam = (jnp.exp(jnp.sum(lambda_q1.astype(jnp.float32) * lambda_k1.astype(jnp.float32)))
           - jnp.exp(jnp.sum(lambda_q2.astype(jnp.float32) * lambda_k2.astype(jnp.float32)))
           + lambda_init)
    o_da = diff_attention(dq.reshape(B, S, DA_HEADS, 2, DA_DIM),
                          dk_.reshape(B, S, DA_HEADS, 2, DA_DIM),
                          dv_.reshape(B, S, DA_HEADS, DA_VDIM), lam, positions)
    o_da = (rms_norm(o_da, diff_norm_g) * (1.0 - lambda_init)).reshape(B, S, DA_V)
    log_a = jax.nn.log_sigmoid((ga @ w_alpha2 + b_alpha).astype(jnp.float32)) / GLA_TAU
    o_gla = gla_chunked(gq.reshape(B, S, GLA_HEADS, GLA_DK).astype(jnp.float32),
                        gk.reshape(B, S, GLA_HEADS, GLA_DK).astype(jnp.float32),
                        gv.reshape(B, S, GLA_HEADS, GLA_DV).astype(jnp.float32),
                        log_a.reshape(B, S, GLA_HEADS, GLA_DK))
    o_gla = rms_norm(o_gla, gla_norm_g) * jax.nn.silu(gr.reshape(B, S, GLA_HEADS, GLA_DV).astype(jnp.float32))
    o_gla = o_gla.reshape(B, S, G_V).astype(h.dtype)
    return jnp.concatenate([o_da, o_gla], axis=-1) @ w_out


def memory_cross_attention(h, m, w_cq, w_ck, w_cv, w_co):
    B, S, D = h.shape
    M = m.shape[1]
    q = (h @ w_cq).reshape(B, S, X_HEADS, X_DIM)
    k = (m @ w_ck).reshape(B, M, X_HEADS, X_DIM)
    v = (m @ w_cv).reshape(B, M, X_HEADS, X_DIM)
    s = jnp.einsum('bqhd,bkhd->bhqk', q, k).astype(jnp.float32) * (X_DIM ** -0.5)
    p = jax.nn.softmax(s, axis=-1)
    o = jnp.einsum('bhqk,bkhd->bqhd', p.astype(v.dtype), v).reshape(B, S, D)
    return o @ w_co


def moe_ffn(h, w_router, b_router, w_up, b_up, w_down, b_down):
    B, S, D = h.shape
    N = B * S
    A = N * TOP_K
    t = h.reshape(N, D)
    logits = (t @ w_router + b_router).astype(jnp.float32)
    top_logit, top_e = lax.top_k(logits, TOP_K)
    gate = jax.nn.softmax(top_logit, axis=-1).reshape(A)
    flat_e = top_e.reshape(A)
    order = jnp.argsort(flat_e)
    sorted_e = flat_e[order]
    tok = order // TOP_K
    counts = jnp.bincount(flat_e, length=N_EXPERTS)
    padded = (counts + MOE_BLOCK - 1) // MOE_BLOCK * MOE_BLOCK
    start = jnp.cumsum(counts) - counts
    pad_end = jnp.cumsum(padded)
    pad_start = pad_end - padded
    dest = pad_start[sorted_e] + jnp.arange(A) - start[sorted_e]
    cap = A + N_EXPERTS * MOE_BLOCK
    n_blk = cap // MOE_BLOCK
    x_pad = jnp.zeros((cap, D), t.dtype).at[dest].set(t[tok])
    blk_e = jnp.minimum(jnp.searchsorted(pad_end, jnp.arange(n_blk) * MOE_BLOCK, side='right'),
                        N_EXPERTS - 1)

    def expert_block(args):
        xb, e = args
        u = xb @ w_up[e] + b_up[e]
        glu = jnp.minimum(u[:, :D_FF], SWIGLU_LIMIT)
        lin = jnp.clip(u[:, D_FF:], -SWIGLU_LIMIT, SWIGLU_LIMIT)
        act = glu * jax.nn.sigmoid(SWIGLU_ALPHA * glu) * (lin + 1.0)
        return act @ w_down[e] + b_down[e]

    y_pad = lax.map(expert_block, (x_pad.reshape(n_blk, MOE_BLOCK, D), blk_e))
    y = y_pad.reshape(cap, D)[dest] * gate[order][:, None].astype(t.dtype)
    return jax.ops.segment_sum(y, tok, num_segments=N).reshape(B, S, D)


def setup_inputs(seed: int = 0) -> dict:
    key = jax.random.key(seed)
    ks = jax.random.split(key, 32)
    L = DEPTH
    f32 = jnp.float32

    def nrm(k, shape, scale):
        return jax.random.normal(k, shape, f32) * scale

    def gain(k, shape):
        return 1.0 + 0.02 * jax.random.normal(k, shape, f32)

    return {
        'x': nrm(ks[0], (BATCH, SEQ, D_MODEL), 1.0),
        'mem': nrm(ks[1], (BATCH, MEM_LEN, D_MODEL), 1.0),
        'positions': (jnp.arange(SEQ, dtype=jnp.int32)[None, :]
                      + jax.random.randint(ks[2], (BATCH, 1), 0, 4096, dtype=jnp.int32)),
        'norm_mix_g': gain(ks[3], (L, D_MODEL)),
        'w_in': nrm(ks[4], (L, D_MODEL, IN_WIDTH), D_MODEL ** -0.5),
        'lambda_q1': nrm(ks[5], (L, DA_DIM), 0.1),
        'lambda_k1': nrm(ks[6], (L, DA_DIM), 0.1),
        'lambda_q2': nrm(ks[7], (L, DA_DIM), 0.1),
        'lambda_k2': nrm(ks[8], (L, DA_DIM), 0.1),
        'diff_norm_g': gain(ks[9], (L, DA_VDIM)),
        'w_alpha2': nrm(ks[10], (L, GLA_RANK, G_QK), GLA_RANK ** -0.5),
        'b_alpha': nrm(ks[11], (L, G_QK), 0.1),
        'gla_norm_g': gain(ks[12], (L, GLA_DV)),
        'w_out': nrm(ks[13], (L, MIX_WIDTH, D_MODEL), MIX_WIDTH ** -0.5),
        'norm_cross_g': gain(ks[14], (L, D_MODEL)),
        'norm_mem_g': gain(ks[15], (L, D_MODEL)),
        'w_cq': nrm(ks[16], (L, D_MODEL, D_MODEL), D_MODEL ** -0.5),
        'w_ck': nrm(ks[17], (L, D_MODEL, D_MODEL), D_MODEL ** -0.5),
        'w_cv': nrm(ks[18], (L, D_MODEL, D_MODEL), D_MODEL ** -0.5),
        'w_co': nrm(ks[19], (L, D_MODEL, D_MODEL), D_MODEL ** -0.5),
        'norm_ffn_g': gain(ks[20], (L, D_MODEL)),
        'w_router': nrm(ks[21], (L, D_MODEL, N_EXPERTS), D_MODEL ** -0.5),
        'b_router': nrm(ks[22], (L, N_EXPERTS), 0.01),
        'w_up': nrm(ks[23], (L, N_EXPERTS, D_MODEL, 2 * D_FF), D_MODEL ** -0.5),
        'b_up': nrm(ks[24], (L, N_EXPERTS, 2 * D_FF), 0.01),
        'w_down': nrm(ks[25], (L, N_EXPERTS, D_FF, D_MODEL), D_FF ** -0.5),
        'b_down': nrm(ks[26], (L, N_EXPERTS, D_MODEL), 0.01),
        'norm_final_g': gain(ks[27], (D_MODEL,)),
    }


def reference(x, mem, positions, norm_mix_g, w_in, lambda_q1, lambda_k1, lambda_q2, lambda_k2,
              diff_norm_g, w_alpha2, b_alpha, gla_norm_g, w_out, norm_cross_g, norm_mem_g,
              w_cq, w_ck, w_cv, w_co, norm_ffn_g, w_router, b_router, w_up, b_up, w_down, b_down,
              norm_final_g):
    for l in range(DEPTH):
        lambda_init = 0.8 - 0.6 * math.exp(-0.3 * l)
        x = x + hybrid_mixer(rms_norm(x, norm_mix_g[l]), positions, w_in[l],
                             lambda_q1[l], lambda_k1[l], lambda_q2[l], lambda_k2[l],
                             diff_norm_g[l], w_alpha2[l], b_alpha[l], gla_norm_g[l], w_out[l],
                             lambda_init)
        x = x + memory_cross_attention(rms_norm(x, norm_cross_g[l]), rms_norm(mem, norm_mem_g[l]),
                                       w_cq[l], w_ck[l], w_cv[l], w_co[l])
        x = x + moe_ffn(rms_norm(x, norm_ffn_g[l]), w_router[l], b_router[l],
                        w_up[l], b_up[l], w_down[l], b_down[l])
    return rms_norm(x, norm_final_g)
```

```cpp
#include <hip/hip_runtime.h>
#include <cstdio>
#include <cstdint>
namespace pg8 {
#define PG8_LAS __attribute__((address_space(3)))
typedef unsigned short bf16_t;
typedef short bf16x8 __attribute__((ext_vector_type(8)));
typedef float f32x4 __attribute__((ext_vector_type(4)));
typedef unsigned u32x4 __attribute__((ext_vector_type(4)));
constexpr int BM = 256, BK = 64, HALF = 128, HTB = HALF * BK * 2  , STAGE_BYTES = 8 * HTB, NXCD = 8, WGM = 8;

__host__ __device__ __forceinline__ int lds_byte(int r, int c) { const int st = (r >> 4) * 2 + (c >> 5), rr = r & 15, cc = c & 31, ob = rr * 64 + cc * 2; return st * 1024 + (ob ^ (((ob >> 9) & 1) << 5)); }
__host__ __device__ __forceinline__ void stage_rc(int b, int& R, int& C) { const int st = b / 1024, sb = b % 1024, swz = sb ^ (((sb >> 9) & 1) << 5); R = (st >> 1) * 16 + swz / 64; C = (st & 1) * 32 + (swz % 64) / 2; }
__host__ __device__ __forceinline__ int perm32(int rho) { const int n = rho >> 4, i = rho & 15; return 8 * (i >> 2) + 4 * n + (i & 3); }

struct Unit { int pm, pn; };
struct Gemm { const bf16_t* A; const bf16_t* Bt; int M, N, K; };

struct StaticOrder {
    int nM, nN, nwg, G, c;
    __host__ __device__ void init(int M, int N, int G_, int c_) { nM = M / BM; nN = N / BM; nwg = nM * nN; G = G_; c = c_; }
    __host__ __device__ bool next(int i, Unit& u) const {
        const long L = (long)i * G + c; if (L >= nwg) return false;
        int wgid = (int)L; { const int q = nwg / NXCD, r = nwg % NXCD, xcd = wgid % NXCD, off = wgid / NXCD; wgid = (xcd < r ? xcd * (q + 1) : r * (q + 1) + (xcd - r) * q) + off; }
        const int nig = WGM * nN, gid = wgid / nig, fm = gid * WGM, gsz = (nM - fm) < WGM ? (nM - fm) : WGM;
        u.pm = fm + ((wgid % nig) % gsz); u.pn = (wgid % nig) / gsz; return true;
    }
    __device__ __forceinline__ void a_ready(const Unit&) const {}
    __device__ __forceinline__ void done(const Unit&) const {}
};

typedef unsigned u32x2 __attribute__((ext_vector_type(2)));
typedef float f32x2_t __attribute__((ext_vector_type(2)));
typedef __bf16 bf16x2_t __attribute__((ext_vector_type(2)));
__device__ __forceinline__ unsigned cvtpk(float lo, float hi) { f32x2_t v = {lo, hi}; bf16x2_t b = __builtin_convertvector(v, bf16x2_t); return __builtin_bit_cast(unsigned, b); }
__device__ __forceinline__ void st_bf4(bf16_t* p, f32x4 v) { u32x2 w; w.x = cvtpk(v[0], v[1]); w.y = cvtpk(v[2], v[3]); *(u32x2*)p = w; }
__device__ __forceinline__ float bf2f(bf16_t b) { return __builtin_bit_cast(float, (unsigned)b << 16); }
#define EPI_ROWS _Pragma("unroll") for (int ai = 0; ai < 2; ++ai) _Pragma("unroll") for (int m = 0; m < 4; ++m)
#define EPI_COLS _Pragma("unroll") for (int bj = 0; bj < 2; ++bj) _Pragma("unroll") for (int n = 0; n < 2; ++n)
constexpr float LOG2E = 1.4426950408889634f;
constexpr float QSCALE_DA = 0.125f * LOG2E;
constexpr float QSCALE_X = 0.0625f * LOG2E;

struct EpiPlain {
    static constexpr bool PERM = false, AFTER_DRAIN = false;
    bf16_t* O; int ldc; float scale;
    __device__ __forceinline__ void operator()(const f32x4 (&acc)[2][2][4][2], const Unit& u, int wr, int wc, int fr, int fq) const {
        EPI_ROWS { const int row = u.pm * 256 + ai * 128 + wr * 64 + m * 16 + fr; bf16_t* rp = O + (size_t)row * ldc + u.pn * 256 + wc * 32 + fq * 4;
            EPI_COLS st_bf4(rp + bj * 128 + n * 16, acc[ai][bj][m][n] * scale); }
    }
};
struct EpiProj {
    static constexpr bool PERM = false, AFTER_DRAIN = false;
    bf16_t* P; float* LA; const float* cs; const float* b_alpha;
    __device__ __forceinline__ void operator()(const f32x4 (&acc)[2][2][4][2], const Unit& u, int wr, int wc, int fr, int fq) const {
        const int pn = u.pn;
        if (pn < 4) {
            const float sc = pn < 2 ? QSCALE_DA : 1.0f; const bool ropew = (wc & 1) == 0; const bool hi = (fq >> 1) != 0;
            EPI_ROWS { const int row = u.pm * 256 + ai * 128 + wr * 64 + m * 16 + fr; bf16_t* rp = P + (size_t)row * 3072 + pn * 256 + wc * 32 + fq * 4;
                f32x4 cv = {1.f, 1.f, 1.f, 1.f}, sv = {0.f, 0.f, 0.f, 0.f};
                if (ropew) { cv = *(const f32x4*)(cs + (size_t)row * 16 + 4 * (fq & 1)); sv = *(const f32x4*)(cs + (size_t)row * 16 + 8 + 4 * (fq & 1)); }
                EPI_COLS { f32x4 v = acc[ai][bj][m][n];
                    if (n == 0 && ropew) { f32x4 p; p[0] = __shfl_xor(v[0], 32); p[1] = __shfl_xor(v[1], 32); p[2] = __shfl_xor(v[2], 32); p[3] = __shfl_xor(v[3], 32);
                        v = hi ? (v * cv + p * sv) : (v * cv - p * sv); }
                    st_bf4(rp + bj * 128 + n * 16, v * sc); } }
        } else if (pn < 12) {
            const float sc = pn == 6 ? 0.125f : 1.0f;
            EPI_ROWS { const int row = u.pm * 256 + ai * 128 + wr * 64 + m * 16 + fr; bf16_t* rp = P + (size_t)row * 3072 + pn * 256 + wc * 32 + fq * 4;
                EPI_COLS st_bf4(rp + bj * 128 + n * 16, acc[ai][bj][m][n] * sc); }
        } else {
            EPI_ROWS { const int row = u.pm * 256 + ai * 128 + wr * 64 + m * 16 + fr;
                EPI_COLS { const int col = bj * 128 + wc * 32 + n * 16 + fq * 4; const f32x4 z = acc[ai][bj][m][n] + *(const f32x4*)(b_alpha + col); f32x4 o;
                    _Pragma("unroll") for (int i = 0; i < 4; ++i) o[i] = (fminf(z[i], 0.f) - log1pf(__expf(-fabsf(z[i])))) * 0.0625f;
                    *(f32x4*)(LA + (size_t)row * 256 + col) = o; } }
        }
    }
};
struct EpiRes1 {
    static constexpr bool PERM = false, AFTER_DRAIN = false;
    const float* base; float* out; bf16_t* xb; float* ssp;
    __device__ __forceinline__ void operator()(const f32x4 (&acc)[2][2][4][2], const Unit& u, int wr, int wc, int fr, int fq) const {
        EPI_ROWS { const int row = u.pm * 256 + ai * 128 + wr * 64 + m * 16 + fr; const size_t off = (size_t)row * 1024 + u.pn * 256 + wc * 32 + fq * 4; float ss = 0.f;
            EPI_COLS { const size_t o2 = off + bj * 128 + n * 16; const f32x4 v = *(const f32x4*)(base + o2) + acc[ai][bj][m][n]; *(f32x4*)(out + o2) = v; st_bf4(xb + o2, v);
                ss += (v[0] * v[0] + v[1] * v[1]) + (v[2] * v[2] + v[3] * v[3]); }
            ss += __shfl_xor(ss, 16); ss += __shfl_xor(ss, 32);
            if (fq == 0) ssp[(size_t)row * 16 + u.pn * 4 + wc] = ss; }
    }
};
struct EpiQX {
    static constexpr bool PERM = false, AFTER_DRAIN = false;
    bf16_t* O; const float* ssp;
    __device__ __forceinline__ void operator()(const f32x4 (&acc)[2][2][4][2], const Unit& u, int wr, int wc, int fr, int fq) const {
        EPI_ROWS { const int row = u.pm * 256 + ai * 128 + wr * 64 + m * 16 + fr; const f32x4* sp = (const f32x4*)(ssp + (size_t)row * 16);
            const f32x4 a = sp[0], b = sp[1], c = sp[2], d = sp[3]; const float ss = ((a[0] + a[1]) + (a[2] + a[3])) + ((b[0] + b[1]) + (b[2] + b[3])) + ((c[0] + c[1]) + (c[2] + c[3])) + ((d[0] + d[1]) + (d[2] + d[3]));
            const float rs = rsqrtf(ss * (1.0f / 1024.0f) + 1e-6f) * QSCALE_X; bf16_t* rp = O + (size_t)row * 1024 + u.pn * 256 + wc * 32 + fq * 4;
            EPI_COLS st_bf4(rp + bj * 128 + n * 16, acc[ai][bj][m][n] * rs); }
    }
};
struct EpiRes2 {
    static constexpr bool PERM = false, AFTER_DRAIN = false;
    float* out;
    __device__ __forceinline__ void operator()(const f32x4 (&acc)[2][2][4][2], const Unit& u, int wr, int wc, int fr, int fq) const {
        EPI_ROWS { const int row = u.pm * 256 + ai * 128 + wr * 64 + m * 16 + fr; float* rp = out + (size_t)row * 1024 + u.pn * 256 + wc * 32 + fq * 4;
            EPI_COLS { f32x4* p = (f32x4*)(rp + bj * 128 + n * 16); *p = *p + acc[ai][bj][m][n]; } }
    }
};
struct EpiUp {
    static constexpr bool PERM = false, AFTER_DRAIN = false;
    bf16_t* ACT; const int* rowtok; const float* rs2; const float* b_up;
    __device__ __forceinline__ void operator()(const f32x4 (&acc)[2][2][4][2], const Unit& u, int wr, int wc, int fr, int fq) const {
        const int e = u.pn >> 3, pnl = u.pn & 7; const float* bg = b_up + (size_t)e * 2048 + pnl * 128 + wc * 32 + fq * 4;
        EPI_ROWS { const int row = u.pm * 256 + ai * 128 + wr * 64 + m * 16 + fr; const int tok = rowtok[row]; const float rs = tok >= 0 ? rs2[tok] : 0.f;
            bf16_t* rp = ACT + (size_t)row * 1024 + pnl * 128 + wc * 32 + fq * 4;
            _Pragma("unroll") for (int n = 0; n < 2; ++n) { const f32x4 g = acc[ai][0][m][n] * rs + *(const f32x4*)(bg + n * 16), l = acc[ai][1][m][n] * rs + *(const f32x4*)(bg + 1024 + n * 16); f32x4 o;
                _Pragma("unroll") for (int i = 0; i < 4; ++i) { const float gl = fminf(g[i], 7.0f), li = fminf(fmaxf(l[i], -7.0f), 7.0f); o[i] = gl / (1.0f + __expf(-1.702f * gl)) * (li + 1.0f); }
                st_bf4(rp + n * 16, o); } }
    }
};
struct EpiDown {
    static constexpr bool PERM = false, AFTER_DRAIN = false;
    bf16_t* Y; const float* b_down;
    __device__ __forceinline__ void operator()(const f32x4 (&acc)[2][2][4][2], const Unit& u, int wr, int wc, int fr, int fq) const {
        const int e = u.pn >> 2, pnl = u.pn & 3; const float* bp = b_down + (size_t)e * 1024 + pnl * 256 + wc * 32 + fq * 4;
        EPI_ROWS { const int row = u.pm * 256 + ai * 128 + wr * 64 + m * 16 + fr; bf16_t* rp = Y + (size_t)row * 1024 + pnl * 256 + wc * 32 + fq * 4;
            EPI_COLS st_bf4(rp + bj * 128 + n * 16, acc[ai][bj][m][n] + *(const f32x4*)(bp + bj * 128 + n * 16)); }
    }
};
struct OrderMap {
    StaticOrder so; int cut, gap;
    __device__ void init(int nM, int nN, int G, int c, int cut_, int gap_) { so.nM = nM; so.nN = nN; so.nwg = nM * nN; so.G = G; so.c = c; cut = cut_; gap = gap_; }
    __device__ bool next(int i, Unit& u) const { if (!so.next(i, u)) return false; if (u.pn >= cut) u.pn += gap; return true; }
    __device__ __forceinline__ void a_ready(const Unit&) const {}
    __device__ __forceinline__ void done(const Unit&) const {}
};
struct MoeOrder {
    StaticOrder so; const PG8_LAS unsigned char* tile_e; int nN;
    __device__ void init(int nM, int nN_, int G, int c, const PG8_LAS unsigned char* te) { so.nM = nM; so.nN = nN_; so.nwg = nM * nN_; so.G = G; so.c = c; tile_e = te; nN = nN_; }
    __device__ bool next(int i, Unit& u) const { if (!so.next(i, u)) return false; u.pn += (int)tile_e[u.pm] * nN; return true; }
    __device__ __forceinline__ void a_ready(const Unit&) const {}
    __device__ __forceinline__ void done(const Unit&) const {}
};

template <class Epi, class Sched, bool ALIGN_EPI = false, bool SP2 = false>
__device__ __forceinline__ void gemm_phase(PG8_LAS unsigned char* lds, const Gemm g, const Sched& S, const Epi& E) {
    const int tid = threadIdx.x, wid = __builtin_amdgcn_readfirstlane(tid >> 6), lane = tid & 63, wr = wid >> 2, wc = wid & 3, fr = lane & 15, fq = lane >> 4;
    const int K = g.K, nt = K / BK;
    unsigned voffA[2], voffB[2];
#pragma unroll
    for (int i = 0; i < 2; ++i) { int R, C; stage_rc(tid * 16 + i * 8192, R, C); const int Rb = Epi::PERM ? ((R & ~31) + perm32(R & 31)) : R;
        voffA[i] = (unsigned)(R * K + C) * 2u; voffB[i] = (unsigned)(Rb * K + C) * 2u; }
    const size_t kstep = (size_t)(BK * 2);
    const size_t hstep = (size_t)HALF * K * 2;
    const size_t tstep = 2 * hstep;
    const unsigned ldsw = (unsigned)wid * 1024u;
    const int aoff = lds_byte(wr * 64 + fr, fq * 8), boff = lds_byte(wc * 32 + fr, fq * 8);
#define PG8_SA(b, h) (((b) * 2 + (h)) * HTB)
#define PG8_SB(b, h) ((4 + (b) * 2 + (h)) * HTB)
#define PG8_STAGE(bufoff, gbase, voff) do { _Pragma("unroll") for (int _i = 0; _i < 2; ++_i) \
        __builtin_amdgcn_global_load_lds((const unsigned*)((const char*)(gbase) + (voff)[_i]), (PG8_LAS unsigned*)(lds + (bufoff) + ldsw + _i * 8192), 16, 0, 0); } while (0)
#define PG8_LDA(dst, b, h) do { _Pragma("unroll") for (int m = 0; m < 4; ++m) _Pragma("unroll") for (int k = 0; k < 2; ++k) dst[m][k] = *(const PG8_LAS bf16x8*)(lds + PG8_SA(b, h) + aoff + m * 2048 + k * 1024); } while (0)
#define PG8_LDB(dst, b, h) do { _Pragma("unroll") for (int n = 0; n < 2; ++n) _Pragma("unroll") for (int k = 0; k < 2; ++k) dst[n][k] = *(const PG8_LAS bf16x8*)(lds + PG8_SB(b, h) + boff + n * 2048 + k * 1024); } while (0)
#define PG8_MMA(ai, bj, At, Bt) do { __builtin_amdgcn_s_setprio(1); _Pragma("unroll") for (int m = 0; m < 4; ++m) _Pragma("unroll") for (int n = 0; n < 2; ++n) _Pragma("unroll") for (int k = 0; k < 2; ++k) \
        acc[ai][bj][m][n] = __builtin_amdgcn_mfma_f32_16x16x32_bf16(Bt[n][k], At[m][k], acc[ai][bj][m][n], 0, 0, 0); __builtin_amdgcn_s_setprio(0); } while (0)
#define PG8_WAIT_V(n) asm volatile("s_waitcnt vmcnt(" #n ")" ::: "memory")
#define PG8_WAIT_L(n) asm volatile("s_waitcnt lgkmcnt(" #n ")" ::: "memory")
#define PG8_BAR __builtin_amdgcn_s_barrier()
#define PG8_SCHED __builtin_amdgcn_sched_barrier(0)
    Unit cur, nxt; int ui = 0;
    if (!S.next(0, cur)) return;
    f32x4 acc[2][2][4][2];
#pragma unroll
    for (int a = 0; a < 2; ++a)
#pragma unroll
        for (int b = 0; b < 2; ++b)
#pragma unroll
            for (int m = 0; m < 4; ++m)
#pragma unroll
                for (int n = 0; n < 2; ++n) acc[a][b][m][n] = (f32x4){0.f, 0.f, 0.f, 0.f};
    bf16x8 At[4][2], B0[2][2], B1[2][2];
    const char* cA = (const char*)g.A + (size_t)cur.pm * tstep; const char* cB = (const char*)g.Bt + (size_t)cur.pn * tstep;
    S.a_ready(cur);
    if constexpr (SP2) {
        PG8_STAGE(PG8_SB(0, 0), cB, voffB); PG8_STAGE(PG8_SB(0, 1), cB + hstep, voffB); PG8_STAGE(PG8_SA(0, 0), cA, voffA); PG8_STAGE(PG8_SA(0, 1), cA + hstep, voffA);
        if (wr == 1) PG8_BAR;
        PG8_WAIT_V(2); PG8_BAR;
        PG8_STAGE(PG8_SB(1, 0), cB + kstep, voffB); PG8_STAGE(PG8_SA(1, 0), cA + kstep, voffA); PG8_STAGE(PG8_SB(1, 1), cB + hstep + kstep, voffB);
        PG8_WAIT_V(6); PG8_BAR;
    } else {
        PG8_STAGE(PG8_SB(0, 0), cB, voffB); PG8_STAGE(PG8_SA(0, 0), cA, voffA); PG8_STAGE(PG8_SB(0, 1), cB + hstep, voffB); PG8_STAGE(PG8_SA(0, 1), cA + hstep, voffA);
        if (wr == 1) PG8_BAR;
        PG8_WAIT_V(4); PG8_BAR;
        PG8_STAGE(PG8_SB(1, 0), cB + kstep, voffB); PG8_STAGE(PG8_SA(1, 0), cA + kstep, voffA); PG8_STAGE(PG8_SB(1, 1), cB + hstep + kstep, voffB);
        PG8_WAIT_V(6); PG8_BAR;
    }
    for (;;) {
        const bool has_next = S.next(ui + 1, nxt);
        const char* nA = has_next ? (const char*)g.A + (size_t)nxt.pm * tstep : cA; const char* nB = has_next ? (const char*)g.Bt + (size_t)nxt.pn * tstep : cB;
        for (int t = 0; t < nt; t += 2) {
            const bool last = (t == nt - 2);
            const char* a1 = cA + (size_t)(t + 1) * kstep;
            const char* a2 = last ? nA : cA + (size_t)(t + 2) * kstep; const char* b2 = last ? nB : cB + (size_t)(t + 2) * kstep;
            const char* a3 = a2 + kstep; const char* b3 = b2 + kstep;
            if (last && has_next) S.a_ready(nxt);
            if constexpr (SP2) {
            PG8_LDB(B0, 0, 0); PG8_LDB(B1, 0, 1); PG8_SCHED; PG8_LDA(At, 0, 0); PG8_STAGE(PG8_SA(1, 1), a1 + hstep, voffA);
            PG8_WAIT_V(8); PG8_WAIT_L(0); PG8_BAR; PG8_MMA(0, 0, At, B0); PG8_MMA(0, 1, At, B1); PG8_BAR; PG8_SCHED;
            PG8_LDA(At, 0, 1); PG8_STAGE(PG8_SB(0, 0), b2, voffB); PG8_STAGE(PG8_SB(0, 1), b2 + hstep, voffB); PG8_STAGE(PG8_SA(0, 0), a2, voffA);
            PG8_WAIT_V(8); PG8_WAIT_L(0); PG8_BAR; PG8_MMA(1, 0, At, B0); PG8_MMA(1, 1, At, B1); PG8_BAR; PG8_SCHED;
            PG8_LDB(B0, 1, 0); PG8_LDB(B1, 1, 1); PG8_SCHED; PG8_LDA(At, 1, 0); PG8_STAGE(PG8_SA(0, 1), a2 + hstep, voffA);
            PG8_WAIT_V(8); PG8_WAIT_L(0); PG8_BAR; PG8_MMA(0, 0, At, B0); PG8_MMA(0, 1, At, B1); PG8_BAR; PG8_SCHED;
            PG8_LDA(At, 1, 1); PG8_STAGE(PG8_SB(1, 0), b3, voffB); PG8_STAGE(PG8_SB(1, 1), b3 + hstep, voffB); PG8_STAGE(PG8_SA(1, 0), a3, voffA);
            PG8_WAIT_V(8); PG8_WAIT_L(0); PG8_BAR; PG8_MMA(1, 0, At, B0); PG8_MMA(1, 1, At, B1); PG8_BAR; PG8_SCHED;
            } else {
            PG8_LDB(B0, 0, 0); PG8_SCHED; PG8_LDA(At, 0, 0); PG8_STAGE(PG8_SA(1, 1), a1 + hstep, voffA);
            PG8_WAIT_L(8); PG8_BAR; PG8_WAIT_L(0); PG8_MMA(0, 0, At, B0); PG8_BAR; PG8_SCHED;
            PG8_LDB(B1, 0, 1); PG8_STAGE(PG8_SB(0, 0), b2, voffB);
            PG8_BAR; PG8_WAIT_L(0); PG8_MMA(0, 1, At, B1); PG8_BAR;
            PG8_LDA(At, 0, 1); PG8_STAGE(PG8_SA(0, 0), a2, voffA);
            PG8_BAR; PG8_WAIT_L(0); PG8_MMA(1, 0, At, B0); PG8_BAR; PG8_SCHED;
            PG8_STAGE(PG8_SB(0, 1), b2 + hstep, voffB);
            PG8_WAIT_V(6); PG8_BAR; PG8_MMA(1, 1, At, B1); PG8_BAR;
            PG8_LDB(B0, 1, 0); PG8_SCHED; PG8_LDA(At, 1, 0); PG8_STAGE(PG8_SA(0, 1), a2 + hstep, voffA);
            PG8_WAIT_L(8); PG8_BAR; PG8_WAIT_L(0); PG8_MMA(0, 0, At, B0); PG8_BAR; PG8_SCHED;
            PG8_LDB(B1, 1, 1); PG8_STAGE(PG8_SB(1, 0), b3, voffB);
            PG8_BAR; PG8_WAIT_L(0); PG8_MMA(0, 1, At, B1); PG8_BAR;
            PG8_LDA(At, 1, 1); PG8_STAGE(PG8_SA(1, 0), a3, voffA);
            PG8_BAR; PG8_WAIT_L(0); PG8_MMA(1, 0, At, B0); PG8_BAR; PG8_SCHED;
            PG8_STAGE(PG8_SB(1, 1), b3 + hstep, voffB);
            PG8_WAIT_V(6); PG8_BAR; PG8_MMA(1, 1, At, B1); PG8_BAR;
            }
        }
        if constexpr (ALIGN_EPI) { if (wr == 0) PG8_BAR; }
        if constexpr (!Epi::AFTER_DRAIN) { E(acc, cur, wr, wc, fr, fq); S.done(cur); }
        if (!has_next) break;
#pragma unroll
        for (int a = 0; a < 2; ++a)
#pragma unroll
            for (int b = 0; b < 2; ++b)
#pragma unroll
                for (int m = 0; m < 4; ++m)
#pragma unroll
                    for (int n = 0; n < 2; ++n) acc[a][b][m][n] = (f32x4){0.f, 0.f, 0.f, 0.f};
        cur = nxt; cA = nA; cB = nB; ++ui;
        if constexpr (ALIGN_EPI) { if (wr == 1) PG8_BAR; }
    }
    PG8_WAIT_V(0);
    if constexpr (!ALIGN_EPI) { if (wr == 0) PG8_BAR; }
    PG8_BAR;
    if constexpr (Epi::AFTER_DRAIN) { E.fused(acc, cur, wr, wc, fr, fq, lds, wid, lane); S.done(cur); }
#undef PG8_SA
#undef PG8_SB
#undef PG8_STAGE
#undef PG8_LDA
#undef PG8_LDB
#undef PG8_MMA
#undef PG8_WAIT_V
#undef PG8_WAIT_L
#undef PG8_BAR
#undef PG8_SCHED
}
}
constexpr int NTOK = 32768, DM = 1024, SEQ = 2048, NBATCH = 16, MEMLEN = 256, NMEM = NBATCH * MEMLEN, INW = 3088, NEXP = 32, TOPK = 4;
constexpr int PW = 3072;
constexpr int MAXTILES = 544;
constexpr float EPS = 1e-6f;
constexpr int NWAVES = 8;
constexpr size_t MiB = 1u << 20;
constexpr size_t WS_CTL = 0, CTL_ZERO_BYTES = 64 * 1024;
constexpr size_t WS_WINT = 2 * MiB, WS_WOUT = 10 * MiB, WS_WCQ = 12 * MiB, WS_WCK = 14 * MiB, WS_WCV = 16 * MiB, WS_WCO = 18 * MiB;
constexpr size_t WS_WR = 20 * MiB, WS_CS = 21 * MiB, WS_SSP1 = 24 * MiB, WS_RS2 = 26 * MiB, WS_GATE = 27 * MiB, WS_ASSIGN = 28 * MiB, WS_LIST = 29 * MiB, WS_ROWTOK = 33 * MiB;
constexpr size_t WS_WUP = 34 * MiB, WS_WDN = 162 * MiB, WS_KX = 226 * MiB, WS_VXT = 234 * MiB;
constexpr size_t WS_HN = 242 * MiB, WS_CAT = 242 * MiB, WS_MN = 306 * MiB, WS_P = 314 * MiB, WS_LA = 506 * MiB, WS_VT = 538 * MiB;
constexpr size_t WS_X1B = 314 * MiB, WS_QX = 378 * MiB, WS_OX = 442 * MiB;
constexpr size_t WS_ACT = 570 * MiB, WS_XG = 242 * MiB, WS_Y = 242 * MiB, WS_END = 842 * MiB;
constexpr int CW_CNT = 64;
constexpr int CW_BAR = 4096;
constexpr int RING_OFF = 0, RING_BYTES = 131072;
constexpr int LDSCTL_OFF = RING_BYTES, MISC_OFF = LDSCTL_OFF + 320;
constexpr int TAB_OFF = LDSCTL_OFF + 512;
constexpr int TAB_TSTART = TAB_OFF + 576, TAB_CNT = TAB_TSTART + 144;
constexpr int LDS_BYTES = 147456;

#define GAS __attribute__((address_space(1)))
#define LAS __attribute__((address_space(3)))
typedef unsigned short bf16;
typedef unsigned v4u __attribute__((ext_vector_type(4)));
typedef float f32x4 __attribute__((ext_vector_type(4)));
typedef short bf16x8 __attribute__((ext_vector_type(8)));
typedef GAS unsigned gu32;
typedef GAS unsigned long long gu64;
#define RLX_AGENT __ATOMIC_RELAXED, __HIP_MEMORY_SCOPE_AGENT
#define LDS_WAIT() asm volatile("s_waitcnt lgkmcnt(0)" ::: "memory")
#define VM_WAIT() asm volatile("s_waitcnt vmcnt(0)" ::: "memory")
__device__ __forceinline__ unsigned long long rt() { return __builtin_amdgcn_s_memrealtime(); }
__device__ __forceinline__ unsigned f2bf(float f) { unsigned u = __builtin_bit_cast(unsigned, f); return (u + 0x7fffu + ((u >> 16) & 1u)) >> 16; }
__device__ __forceinline__ unsigned pk2(float lo, float hi) { return f2bf(lo) | (f2bf(hi) << 16); }

#define XB_TMO      128
#define XB_XCNT(j)  (256  + 64 * (j))
#define XB_XSUB(j)  (1280 + 64 * (j))
#define XB_XGEN(j)  (2304 + 64 * (j))
#define XB_TOP      3328
#define XB_TOPGEN   3392
#define XCD_BAR_WORDS 3456
#define XB_SPIN_CAP (1u << 18)

__device__ __forceinline__ unsigned xb_ld(unsigned* p)              { return __hip_atomic_load(p, __ATOMIC_RELAXED, __HIP_MEMORY_SCOPE_AGENT); }
__device__ __forceinline__ unsigned xb_add(unsigned* p, unsigned v) { return __hip_atomic_fetch_add(p, v, __ATOMIC_RELAXED, __HIP_MEMORY_SCOPE_AGENT); }
__device__ __forceinline__ unsigned xb_xcc_id() { return (unsigned)__builtin_amdgcn_s_getreg((3 << 11) | 20) & 0xFu; }
#define XB_SPIN(cond, bar) do { unsigned _sp = 0; while (cond) { __builtin_amdgcn_s_sleep(1); \
    if ((++_sp & 255u) == 0u) { if (xb_ld(&(bar)[XB_TMO])) break; if (_sp > XB_SPIN_CAP) { atomicAdd(&(bar)[XB_TMO], 1u); break; } } } } while (0)

struct XcdBarrier {
    unsigned* bar; unsigned x;
    volatile LAS unsigned* st;
};

__device__ __forceinline__ XcdBarrier xcd_barrier_post(unsigned* bar, volatile LAS unsigned* st) {
    XcdBarrier b; b.bar = bar; b.x = xb_xcc_id(); b.st = st;
    if (threadIdx.x == 0) (void)xb_add(&bar[XB_XCNT(b.x)], 1u);
    return b;
}
__device__ __forceinline__ void xcd_barrier_complete(unsigned* bar, unsigned x, unsigned& nloc, unsigned& nx) {
    const unsigned G = gridDim.x * gridDim.y * gridDim.z;
    unsigned sum, cnt, mine, sp = 0u;
    for (;;) {
        sum = 0u; cnt = 0u; mine = 0u;
#pragma unroll
        for (unsigned j = 0; j < 16; ++j) { const unsigned c = xb_ld(&bar[XB_XCNT(j)]); sum += c; cnt += (c > 0u) ? 1u : 0u; mine = (j == x) ? c : mine; }
        if (sum == G) break;
        __builtin_amdgcn_s_sleep(1);
        if ((++sp & 255u) == 0u) { if (xb_ld(&bar[XB_TMO])) break; if (sp > XB_SPIN_CAP) { atomicAdd(&bar[XB_TMO], 1u); break; } }
    }
    nloc = mine > 0u ? mine : 1u; nx = cnt > 0u ? cnt : 1u;
}

__device__ __forceinline__ void xcd_barrier(const XcdBarrier& b) {
    asm volatile("s_waitcnt vmcnt(0)" ::: "memory");
    __syncthreads();
    if (threadIdx.x == 0) {
        unsigned* bar = b.bar;
        __builtin_amdgcn_s_waitcnt(0);
        unsigned nloc = b.st[0], nx = b.st[1];
        if (nloc == 0u) { xcd_barrier_complete(bar, b.x, nloc, nx); b.st[0] = nloc; b.st[1] = nx; }
        const unsigned old = xb_add(&bar[XB_XSUB(b.x)], 1u);
        const unsigned gen = old / nloc;
        if (old + 1u == (gen + 1u) * nloc) {
            __builtin_amdgcn_fence(__ATOMIC_RELEASE, "agent");
            asm volatile("s_waitcnt vmcnt(0)" ::: "memory");
            const unsigned og = xb_add(&bar[XB_TOP], 1u);
            const unsigned tg = og / nx;
            if (og + 1u == (tg + 1u) * nx) xb_add(&bar[XB_TOPGEN], 1u);
            else XB_SPIN(xb_ld(&bar[XB_TOPGEN]) == tg, bar);
            __builtin_amdgcn_fence(__ATOMIC_ACQUIRE, "agent");
            xb_add(&bar[XB_XGEN(b.x)], 1u);
            asm volatile("s_waitcnt vmcnt(0)" ::: "memory");
        } else {
            XB_SPIN(xb_ld(&bar[XB_XGEN(b.x)]) == gen, bar);
            __builtin_amdgcn_fence(__ATOMIC_ACQUIRE, "agent");
            asm volatile("s_waitcnt vmcnt(0)" ::: "memory");
        }
    }
    __syncthreads();
}
typedef short bf16x4 __attribute__((ext_vector_type(4)));
typedef unsigned v2u __attribute__((ext_vector_type(2)));
struct Frame {
    LAS unsigned char* lds;
    volatile LAS unsigned* MISC;
    gu32* ctl;
    int tid, lane, wave;
    int vcu, G;
    unsigned char* ws;
    float* out;
};
__device__ __forceinline__ float bf2f(bf16 b) { return __builtin_bit_cast(float, (unsigned)b << 16); }
__device__ __forceinline__ float wave_sum(float v) {
#pragma unroll
    for (int o = 1; o < 64; o <<= 1) v += __shfl_xor(v, o);
    return v;
}
__device__ __forceinline__ f32x4 mfma16(bf16x8 a, bf16x8 b, f32x4 c) { return __builtin_amdgcn_mfma_f32_16x16x32_bf16(a, b, c, 0, 0, 0); }

__device__ __forceinline__ void p0_transpose_item(const float* W, int ldw, const float* gain, bf16* WT, int K, int k0, int n0, size_t orow0, LAS float* scr, int lane) {
#pragma unroll 8
    for (int i = 0; i < 32; ++i) { const int kk = 2 * i + (lane >> 5); float v = W[(size_t)(k0 + kk) * ldw + n0 + (lane & 31)]; if (gain) v *= gain[k0 + kk]; scr[kk * 33 + (lane & 31)] = v; }
    LDS_WAIT(); asm volatile("" ::: "memory");
    const int c = lane & 7;
#pragma unroll
    for (int j = 0; j < 4; ++j) { const int n = (lane >> 3) + 8 * j; const LAS float* s = scr + (8 * c) * 33 + n;
        v4u o; o.x = pk2(s[0 * 33], s[1 * 33]); o.y = pk2(s[2 * 33], s[3 * 33]); o.z = pk2(s[4 * 33], s[5 * 33]); o.w = pk2(s[6 * 33], s[7 * 33]);
        *(GAS v4u*)(WT + (orow0 + n) * (size_t)K + k0 + 8 * c) = o; }
    LDS_WAIT(); asm volatile("" ::: "memory");
}
__device__ __forceinline__ void rms_row_to_bf16(const float* xrow, const float* g, bf16* orow, int lane) {
    const f32x4* xr = (const f32x4*)xrow + lane; const f32x4* gr = (const f32x4*)g + lane;
    f32x4 v[4]; float s = 0.f;
#pragma unroll
    for (int j = 0; j < 4; ++j) { v[j] = xr[64 * j]; s += (v[j].x * v[j].x + v[j].y * v[j].y) + (v[j].z * v[j].z + v[j].w * v[j].w); }
    const float rs = rsqrtf(wave_sum(s) * (1.0f / DM) + EPS);
    unsigned long long* o8 = (unsigned long long*)orow + lane;
#pragma unroll
    for (int j = 0; j < 4; ++j) { const f32x4 gg = gr[64 * j]; o8[64 * j] = (unsigned long long)pk2(v[j].x * rs * gg.x, v[j].y * rs * gg.y) | ((unsigned long long)pk2(v[j].z * rs * gg.z, v[j].w * rs * gg.w) << 32); }
}
struct In {
    const float *x, *mem; const int* positions; const float *norm_mix_g, *w_in, *lq1, *lk1, *lq2, *lk2, *diff_norm_g, *w_alpha2, *b_alpha, *gla_norm_g, *w_out, *norm_cross_g, *norm_mem_g,
        *w_cq, *w_ck, *w_cv, *w_co, *norm_ffn_g, *w_router, *b_router, *w_up, *b_up, *w_down, *b_down, *norm_final_g;
};
__device__ __forceinline__ void p0_prologue(Frame& F, const In& I) {
    LAS float* scr = (LAS float*)(F.lds + RING_OFF + F.wave * 16384);
    const int gw = F.vcu * NWAVES + F.wave, NGW = F.G * NWAVES, lane = F.lane;
    unsigned char* ws = F.ws;
    constexpr int I_IN = 16 * 96, I_SQ = 16 * 32, I_UP = 32 * 16 * 64, I_DN = 32 * 16 * 32;
    constexpr int NITEMS = I_IN + 5 * I_SQ + I_UP + I_DN;
    for (int it = gw; it < NITEMS; it += NGW) {
        int r = it;
        if (r < I_IN) { p0_transpose_item(I.w_in, INW, nullptr, (bf16*)(ws + WS_WINT), DM, 64 * (r / 96), 32 * (r % 96), (size_t)32 * (r % 96), scr, lane); continue; } r -= I_IN;
        if (r < 5 * I_SQ) { const int w = r / I_SQ; r -= w * I_SQ;
            const float* W = w == 0 ? I.w_out : w == 1 ? I.w_cq : w == 2 ? I.w_ck : w == 3 ? I.w_cv : I.w_co;
            bf16* WT = (bf16*)(ws + (w == 0 ? WS_WOUT : w == 1 ? WS_WCQ : w == 2 ? WS_WCK : w == 3 ? WS_WCV : WS_WCO));
            p0_transpose_item(W, DM, w == 1 ? I.norm_cross_g : nullptr, WT, DM, 64 * (r / 32), 32 * (r % 32), (size_t)32 * (r % 32), scr, lane); continue; } r -= 5 * I_SQ;
        if (r < I_UP) { const int e = r / (16 * 64); r -= e * (16 * 64); const int n0 = 32 * (r % 64);
            const size_t orow = (size_t)e * 2048 + ((n0 & 1023) >> 7) * 256 + (n0 >> 10) * 128 + (n0 & 127);
            p0_transpose_item(I.w_up + (size_t)e * DM * 2048, 2048, I.norm_ffn_g, (bf16*)(ws + WS_WUP), DM, 64 * (r / 64), n0, orow, scr, lane); continue; } r -= I_UP;
        { const int e = r / (16 * 32); r -= e * (16 * 32);
            p0_transpose_item(I.w_down + (size_t)e * DM * DM, DM, nullptr, (bf16*)(ws + WS_WDN), DM, 64 * (r / 32), 32 * (r % 32), (size_t)e * 1024 + 32 * (r % 32), scr, lane); }
    }
    const int gt = F.vcu * (NWAVES * 64) + F.tid, NGT = F.G * NWAVES * 64;
    for (int idx = gt; idx < 256 * DM; idx += NGT) { const int j = idx >> 10, k = idx & 1023; const float* wr = I.w_in + (size_t)k * INW + 3072; float s = 0.f;
#pragma unroll
        for (int r = 0; r < 16; ++r) s += wr[r] * I.w_alpha2[r * 256 + j];
        ((bf16*)(ws + WS_WINT))[(size_t)(3072 + j) * DM + k] = (bf16)f2bf(s); }
    for (int idx = gt; idx < DM * NEXP; idx += NGT) ((float*)(ws + WS_WR))[idx] = I.w_router[idx] * I.norm_ffn_g[idx >> 5];
    for (int idx = gt; idx < NTOK * 8; idx += NGT) { const int tok = idx >> 3, i = idx & 7;
        const double inv = exp(-(double)i * 0.125 * 13.122363377404328); const double ang = (double)I.positions[tok] * inv;
        const double red = ang - rint(ang * 0.15915494309189535) * 6.283185307179586; const float rf = (float)red;
        float* cs = (float*)(ws + WS_CS) + (size_t)tok * 16; cs[i] = cosf(rf); cs[8 + i] = sinf(rf); }
    for (int m = gw; m < NTOK + NMEM; m += NGW) {
        if (m < NTOK) rms_row_to_bf16(I.x + (size_t)m * DM, I.norm_mix_g, (bf16*)(ws + WS_HN) + (size_t)m * DM, lane);
        else rms_row_to_bf16(I.mem + (size_t)(m - NTOK) * DM, I.norm_mem_g, (bf16*)(ws + WS_MN) + (size_t)(m - NTOK) * DM, lane);
    }
}

__device__ __forceinline__ void diffattn_unit(const bf16* P, const bf16* VT, bf16* CAT, const float* gdiff, float lam, int b, int h, int qblk, int wave, int lane) {
    const int l15 = lane & 15, g = lane >> 4;
    const int q0 = qblk * 128 + wave * 16;
    const size_t tokq = (size_t)b * SEQ + q0 + l15;
    bf16x8 qf[2][2];
#pragma unroll
    for (int c = 0; c < 2; ++c)
#pragma unroll
        for (int ks = 0; ks < 2; ++ks) qf[c][ks] = *(const bf16x8*)(P + tokq * PW + h * 128 + c * 64 + ks * 32 + g * 8);
    f32x4 o[2][8];
#pragma unroll
    for (int c = 0; c < 2; ++c)
#pragma unroll
        for (int k = 0; k < 8; ++k) o[c][k] = (f32x4){0.f, 0.f, 0.f, 0.f};
    float mrun[2] = {-INFINITY, -INFINITY}, lsum[2] = {0.f, 0.f};
    const int nk = q0 + 16;
    const bf16* Kb = P + (size_t)b * SEQ * PW + 512 + h * 128 + g * 8;
    const bf16* Vb = VT + (size_t)(h * 128 + l15) * NTOK + (size_t)b * SEQ + 4 * g;
    for (int key0 = 0; key0 < nk; key0 += 32) {
        f32x4 s[2][2];
#pragma unroll
        for (int c = 0; c < 2; ++c)
#pragma unroll
            for (int s2 = 0; s2 < 2; ++s2) { f32x4 a = (f32x4){0.f, 0.f, 0.f, 0.f};
#pragma unroll
                for (int ks = 0; ks < 2; ++ks) { const bf16x8 kf = *(const bf16x8*)(Kb + (size_t)(key0 + s2 * 16 + l15) * PW + c * 64 + ks * 32); a = mfma16(kf, qf[c][ks], a); }
                s[c][s2] = a; }
        if (key0 + 31 > q0) {
            const int qrow = q0 + l15;
#pragma unroll
            for (int c = 0; c < 2; ++c)
#pragma unroll
                for (int s2 = 0; s2 < 2; ++s2)
#pragma unroll
                    for (int r = 0; r < 4; ++r) if (key0 + s2 * 16 + 4 * g + r > qrow) s[c][s2][r] = -INFINITY;
        }
        bf16x8 pb[2];
#pragma unroll
        for (int c = 0; c < 2; ++c) {
            float mx = fmaxf(fmaxf(fmaxf(s[c][0][0], s[c][0][1]), fmaxf(s[c][0][2], s[c][0][3])), fmaxf(fmaxf(s[c][1][0], s[c][1][1]), fmaxf(s[c][1][2], s[c][1][3])));
            mx = fmaxf(mx, __shfl_xor(mx, 16)); mx = fmaxf(mx, __shfl_xor(mx, 32));
            const float mnew = fmaxf(mrun[c], mx); const float alpha = __builtin_amdgcn_exp2f(mrun[c] - mnew); mrun[c] = mnew;
            float ps = 0.f;
#pragma unroll
            for (int s2 = 0; s2 < 2; ++s2)
#pragma unroll
                for (int r = 0; r < 4; ++r) { const float p = __builtin_amdgcn_exp2f(s[c][s2][r] - mnew); s[c][s2][r] = p; ps += p; }
            lsum[c] = lsum[c] * alpha + ps;
#pragma unroll
            for (int k = 0; k < 8; ++k) o[c][k] = o[c][k] * alpha;
            v4u w; w.x = pg8::cvtpk(s[c][0][0], s[c][0][1]); w.y = pg8::cvtpk(s[c][0][2], s[c][0][3]); w.z = pg8::cvtpk(s[c][1][0], s[c][1][1]); w.w = pg8::cvtpk(s[c][1][2], s[c][1][3]);
            pb[c] = __builtin_bit_cast(bf16x8, w);
        }
#pragma unroll
        for (int k = 0; k < 8; ++k) { const bf16* vp = Vb + (size_t)k * 16 * NTOK + key0;
            const v2u v0 = *(const v2u*)vp, v1 = *(const v2u*)(vp + 16); v4u vv; vv.x = v0.x; vv.y = v0.y; vv.z = v1.x; vv.w = v1.y; const bf16x8 vf = __builtin_bit_cast(bf16x8, vv);
            o[0][k] = mfma16(vf, pb[0], o[0][k]); o[1][k] = mfma16(vf, pb[1], o[1][k]); }
    }
    float l0 = lsum[0], l1 = lsum[1];
    l0 += __shfl_xor(l0, 16); l0 += __shfl_xor(l0, 32); l1 += __shfl_xor(l1, 16); l1 += __shfl_xor(l1, 32);
    const float i0 = 1.0f / l0, i1 = lam / l1; float ss = 0.f;
#pragma unroll
    for (int k = 0; k < 8; ++k)
#pragma unroll
        for (int r = 0; r < 4; ++r) { const float v = o[0][k][r] * i0 - o[1][k][r] * i1; o[0][k][r] = v; ss += v * v; }
    ss += __shfl_xor(ss, 16); ss += __shfl_xor(ss, 32);
    const float rs = rsqrtf(ss * (1.0f / 128.0f) + EPS) * 0.8f;
    bf16* op = CAT + tokq * DM + h * 128 + 4 * g;
#pragma unroll
    for (int k = 0; k < 8; ++k) { const f32x4 gg = *(const f32x4*)(gdiff + k * 16 + 4 * g); f32x4 v = o[0][k] * rs; v = v * gg; pg8::st_bf4(op + k * 16, v); }
}

__device__ __forceinline__ void crossattn_unit(const bf16* QX, const bf16* KX, const bf16* VXT, bf16* OX, int b, int h, int qblk, int wave, int lane) {
    const int l15 = lane & 15, g = lane >> 4;
    const size_t tokq = (size_t)b * SEQ + qblk * 128 + wave * 16 + l15;
    bf16x8 qf[8];
#pragma unroll
    for (int ks = 0; ks < 8; ++ks) qf[ks] = *(const bf16x8*)(QX + tokq * DM + h * 256 + ks * 32 + g * 8);
    f32x4 s[16];
    const bf16* Kb = KX + (size_t)(b * MEMLEN + l15) * DM + h * 256 + g * 8;
#pragma unroll
    for (int t = 0; t < 16; ++t) { f32x4 a = (f32x4){0.f, 0.f, 0.f, 0.f};
#pragma unroll
        for (int ks = 0; ks < 8; ++ks) { const bf16x8 kf = *(const bf16x8*)(Kb + (size_t)t * 16 * DM + ks * 32); a = mfma16(kf, qf[ks], a); }
        s[t] = a; }
    float mx = -INFINITY;
#pragma unroll
    for (int t = 0; t < 16; ++t) mx = fmaxf(mx, fmaxf(fmaxf(s[t][0], s[t][1]), fmaxf(s[t][2], s[t][3])));
    mx = fmaxf(mx, __shfl_xor(mx, 16)); mx = fmaxf(mx, __shfl_xor(mx, 32));
    float ls = 0.f; bf16x8 pb[8];
#pragma unroll
    for (int t = 0; t < 8; ++t) { float p[8];
#pragma unroll
        for (int r = 0; r < 4; ++r) { p[r] = __builtin_amdgcn_exp2f(s[2 * t][r] - mx); p[4 + r] = __builtin_amdgcn_exp2f(s[2 * t + 1][r] - mx); }
#pragma unroll
        for (int r = 0; r < 8; ++r) ls += p[r];
        v4u w; w.x = pg8::cvtpk(p[0], p[1]); w.y = pg8::cvtpk(p[2], p[3]); w.z = pg8::cvtpk(p[4], p[5]); w.w = pg8::cvtpk(p[6], p[7]); pb[t] = __builtin_bit_cast(bf16x8, w); }
    ls += __shfl_xor(ls, 16); ls += __shfl_xor(ls, 32);
    const float inv = 1.0f / ls;
    const bf16* Vb = VXT + (size_t)(h * 256 + l15) * NMEM + b * MEMLEN + 4 * g;
    bf16* op = OX + tokq * DM + h * 256 + 4 * g;
#pragma unroll 4
    for (int k = 0; k < 16; ++k) { f32x4 a = (f32x4){0.f, 0.f, 0.f, 0.f};
#pragma unroll
        for (int t = 0; t < 8; ++t) { const bf16* vp = Vb + (size_t)k * 16 * NMEM + t * 32;
            const v2u v0 = *(const v2u*)vp, v1 = *(const v2u*)(vp + 16); v4u vv; vv.x = v0.x; vv.y = v0.y; vv.z = v1.x; vv.w = v1.y; a = mfma16(__builtin_bit_cast(bf16x8, vv), pb[t], a); }
        pg8::st_bf4(op + k * 16, a * inv); }
}

__device__ __forceinline__ void gla_unit_naive(Frame& F, const bf16* P, const float* LA, bf16* CAT, const float* ggla, int b, int h) {
    LAS float* sq = (LAS float*)(F.lds + RING_OFF); LAS float* sk = sq + 1024; LAS float* sa = sk + 1024; LAS float* red = sa + 1024;
    const int tid = F.tid, j = tid & 127, dg = tid >> 7;
    float S[16];
#pragma unroll
    for (int i = 0; i < 16; ++i) S[i] = 0.f;
    for (int t0 = 0; t0 < SEQ; t0 += 16) {
        for (int idx = tid; idx < 1024; idx += 512) { const int tt = idx >> 6, d = idx & 63; const size_t tok = (size_t)b * SEQ + t0 + tt;
            sq[idx] = bf2f(P[tok * PW + 1536 + h * 64 + d]); sk[idx] = bf2f(P[tok * PW + 1792 + h * 64 + d]); sa[idx] = __expf(LA[tok * 256 + h * 64 + d]); }
        __syncthreads();
        for (int tt = 0; tt < 16; ++tt) { const float v = bf2f(P[((size_t)b * SEQ + t0 + tt) * PW + 2048 + h * 128 + j]); float part = 0.f;
#pragma unroll
            for (int i = 0; i < 16; ++i) { const int d = tt * 64 + dg * 16 + i; S[i] = sa[d] * S[i] + sk[d] * v; part += sq[d] * S[i]; }
            red[(tt * 4 + dg) * 128 + j] = part; }
        __syncthreads();
        { const int tt = tid >> 5, jj = (tid & 31) * 4; const size_t tok = (size_t)b * SEQ + t0 + tt; float ov[4]; float ss = 0.f;
#pragma unroll
            for (int i = 0; i < 4; ++i) { ov[i] = (red[(tt * 4 + 0) * 128 + jj + i] + red[(tt * 4 + 1) * 128 + jj + i]) + (red[(tt * 4 + 2) * 128 + jj + i] + red[(tt * 4 + 3) * 128 + jj + i]); ss += ov[i] * ov[i]; }
            ss += __shfl_xor(ss, 1); ss += __shfl_xor(ss, 2); ss += __shfl_xor(ss, 4); ss += __shfl_xor(ss, 8); ss += __shfl_xor(ss, 16);
            const float rs = rsqrtf(ss * (1.0f / 128.0f) + EPS); f32x4 o;
#pragma unroll
            for (int i = 0; i < 4; ++i) { const float gr = bf2f(P[tok * PW + 2560 + h * 128 + jj + i]); o[i] = ov[i] * rs * ggla[jj + i] * (gr / (1.0f + __expf(-gr))); }
            pg8::st_bf4(CAT + tok * DM + 512 + h * 128 + jj, o); }
    }
    __syncthreads();
}

__device__ __forceinline__ void router_phase(Frame& F, const float* X2, const float* WR, const float* b_router, float* rs2, float* gate, unsigned* assign, unsigned* list, gu32* cnt) {
    LAS float* xs = (LAS float*)(F.lds + RING_OFF);
    LAS float* wsh = xs + 64 * 129;
    LAS float* lg = wsh + 128 * 32;
    const int tid = F.tid, t = tid & 63, eg = tid >> 6;
    for (int blk = F.vcu; blk < NTOK / 64; blk += F.G) {
        const size_t tok0 = (size_t)blk * 64;
        f32x4 acc = (f32x4){0.f, 0.f, 0.f, 0.f}; float ssq = 0.f;
        for (int kc = 0; kc < DM; kc += 128) {
            { const int row = tid >> 3;
#pragma unroll
              for (int i = 0; i < 4; ++i) { const int col = i * 32 + (tid & 7) * 4; const f32x4 v = *(const f32x4*)(X2 + (tok0 + row) * DM + kc + col);
                  LAS float* d = xs + row * 129 + col; d[0] = v.x; d[1] = v.y; d[2] = v.z; d[3] = v.w; }
#pragma unroll
              for (int i = 0; i < 2; ++i) { const int idx = (i * 512 + tid) * 4; *(LAS f32x4*)(wsh + idx) = *(const f32x4*)(WR + (size_t)kc * 32 + idx); } }
            __syncthreads();
            const LAS float* xr = xs + t * 129;
#pragma unroll 8
            for (int k = 0; k < 128; ++k) { const float xv = xr[k]; const f32x4 w = *(const LAS f32x4*)(wsh + k * 32 + eg * 4); acc = acc + w * xv; ssq += xv * xv; }
            __syncthreads();
        }
        const float rs = rsqrtf(ssq * (1.0f / DM) + EPS);
#pragma unroll
        for (int i = 0; i < 4; ++i) lg[t * 33 + eg * 4 + i] = acc[i] * rs + b_router[eg * 4 + i];
        __syncthreads();
        if (tid < 64) {
            float lv[32];
#pragma unroll
            for (int e = 0; e < 32; ++e) lv[e] = lg[t * 33 + e];
            float tv[4]; int te[4];
#pragma unroll
            for (int k = 0; k < 4; ++k) { float best = -INFINITY; int bi = 0;
#pragma unroll
                for (int e = 0; e < 32; ++e) if (lv[e] > best) { best = lv[e]; bi = e; }
                tv[k] = best; te[k] = bi;
#pragma unroll
                for (int e = 0; e < 32; ++e) if (e == bi) lv[e] = -INFINITY; }
            const float e1 = __expf(tv[1] - tv[0]), e2 = __expf(tv[2] - tv[0]), e3 = __expf(tv[3] - tv[0]); const float inv = 1.0f / (1.0f + e1 + e2 + e3);
            const float gv[4] = {inv, e1 * inv, e2 * inv, e3 * inv};
            const size_t tok = tok0 + t; rs2[tok] = rs;
#pragma unroll
            for (int k = 0; k < 4; ++k) { const unsigned pos = __hip_atomic_fetch_add(cnt + te[k], 1u, RLX_AGENT); list[(size_t)te[k] * NTOK + pos] = (unsigned)tok;
                assign[tok * 4 + k] = ((unsigned)te[k] << 16) | pos; gate[tok * 4 + k] = gv[k]; }
        }
        __syncthreads();
    }
}
__device__ __forceinline__ int moe_tables(Frame& F) {
    LAS unsigned char* tile_e = F.lds + TAB_OFF; LAS int* tstart = (LAS int*)(F.lds + TAB_TSTART); LAS int* lc = (LAS int*)(F.lds + TAB_CNT);
    if (F.tid < 32) lc[F.tid] = (int)__hip_atomic_load(F.ctl + CW_CNT + F.tid, RLX_AGENT);
    __syncthreads();
    if (F.tid == 0) { int s = 0; for (int e = 0; e < 32; ++e) { tstart[e] = s; s += (lc[e] + 255) >> 8; } tstart[32] = s; }
    __syncthreads();
    const int T = tstart[32];
    for (int i = F.tid; i < T; i += 512) { int e = 0;
#pragma unroll
        for (int k = 1; k < 32; ++k) e += (tstart[k] <= i) ? 1 : 0;
        tile_e[i] = (unsigned char)e; }
    __syncthreads();
    return T;
}
__device__ __forceinline__ void gather_phase(Frame& F, const float* X2, const unsigned* list, int* rowtok, bf16* XG) {
    const int T = moe_tables(F);
    const LAS unsigned char* tile_e = F.lds + TAB_OFF; const LAS int* tstart = (const LAS int*)(F.lds + TAB_TSTART); const LAS int* lc = (const LAS int*)(F.lds + TAB_CNT);
    const int gw = F.vcu * NWAVES + F.wave, NGW = F.G * NWAVES, lane = F.lane;
    for (int r = gw; r < T * 256; r += NGW) { const int e = tile_e[r >> 8]; const int pos = r - tstart[e] * 256; const int tok = pos < lc[e] ? (int)list[(size_t)e * NTOK + pos] : -1;
        if (lane == 0) rowtok[r] = tok;
        unsigned long long* o8 = (unsigned long long*)(XG + (size_t)r * DM) + lane;
        if (tok >= 0) { const f32x4* xr = (const f32x4*)(X2 + (size_t)tok * DM) + lane;
#pragma unroll
            for (int j = 0; j < 4; ++j) { const f32x4 v = xr[64 * j]; o8[64 * j] = (unsigned long long)pk2(v.x, v.y) | ((unsigned long long)pk2(v.z, v.w) << 32); } }
        else {
#pragma unroll
            for (int j = 0; j < 4; ++j) o8[64 * j] = 0ull; } }
}
__device__ __forceinline__ void final_phase(Frame& F, float* out, const bf16* Y, const float* gate, const unsigned* assign, const float* gfin) {
    (void)moe_tables(F);
    const LAS int* tstart = (const LAS int*)(F.lds + TAB_TSTART);
    const int gw = F.vcu * NWAVES + F.wave, NGW = F.G * NWAVES, lane = F.lane;
    for (int tok = gw; tok < NTOK; tok += NGW) {
        f32x4* xr = (f32x4*)(out + (size_t)tok * DM) + lane; f32x4 v[4];
#pragma unroll
        for (int j = 0; j < 4; ++j) v[j] = xr[64 * j];
#pragma unroll
        for (int k = 0; k < 4; ++k) { const unsigned a = assign[(size_t)tok * 4 + k]; const float gk = gate[(size_t)tok * 4 + k]; const size_t row = (size_t)tstart[a >> 16] * 256 + (a & 0xffffu);
            const v2u* yr = (const v2u*)(Y + row * DM) + lane;
#pragma unroll
            for (int j = 0; j < 4; ++j) { const v2u w = yr[64 * j]; v[j].x += gk * __builtin_bit_cast(float, w.x << 16); v[j].y += gk * __builtin_bit_cast(float, w.x & 0xffff0000u);
                v[j].z += gk * __builtin_bit_cast(float, w.y << 16); v[j].w += gk * __builtin_bit_cast(float, w.y & 0xffff0000u); } }
        float s = 0.f;
#pragma unroll
        for (int j = 0; j < 4; ++j) s += (v[j].x * v[j].x + v[j].y * v[j].y) + (v[j].z * v[j].z + v[j].w * v[j].w);
        const float rs = rsqrtf(wave_sum(s) * (1.0f / DM) + EPS);
#pragma unroll
        for (int j = 0; j < 4; ++j) { const f32x4 gg = ((const f32x4*)gfin)[lane + 64 * j]; xr[64 * j] = v[j] * rs * gg; }
    }
}

constexpr int NPHASE = 12;
struct Args { const void* in[28]; float* out; unsigned char* ws; int ph_lo, ph_hi; };
__global__ void __launch_bounds__(NWAVES * 64, 2) mk_fwd(Args args) {
    extern __shared__ __attribute__((aligned(16))) unsigned char lds[];
    Frame F;
    F.lds = (LAS unsigned char*)lds;
    F.MISC = (volatile LAS unsigned*)(F.lds + MISC_OFF);
    F.tid = threadIdx.x; F.lane = F.tid & 63; F.wave = __builtin_amdgcn_readfirstlane(F.tid >> 6);
    F.G = gridDim.x; { const int bx = blockIdx.x; F.vcu = (F.G % 8 == 0) ? (bx % 8) * (F.G / 8) + bx / 8 : bx; }
    F.ws = args.ws; F.out = args.out; F.ctl = (gu32*)(args.ws + WS_CTL);
    unsigned char* ws = args.ws;
    In I;
    I.x = (const float*)args.in[0]; I.mem = (const float*)args.in[1]; I.positions = (const int*)args.in[2]; I.norm_mix_g = (const float*)args.in[3]; I.w_in = (const float*)args.in[4];
    I.lq1 = (const float*)args.in[5]; I.lk1 = (const float*)args.in[6]; I.lq2 = (const float*)args.in[7]; I.lk2 = (const float*)args.in[8]; I.diff_norm_g = (const float*)args.in[9];
    I.w_alpha2 = (const float*)args.in[10]; I.b_alpha = (const float*)args.in[11]; I.gla_norm_g = (const float*)args.in[12]; I.w_out = (const float*)args.in[13]; I.norm_cross_g = (const float*)args.in[14];
    I.norm_mem_g = (const float*)args.in[15]; I.w_cq = (const float*)args.in[16]; I.w_ck = (const float*)args.in[17]; I.w_cv = (const float*)args.in[18]; I.w_co = (const float*)args.in[19];
    I.norm_ffn_g = (const float*)args.in[20]; I.w_router = (const float*)args.in[21]; I.b_router = (const float*)args.in[22]; I.w_up = (const float*)args.in[23]; I.b_up = (const float*)args.in[24];
    I.w_down = (const float*)args.in[25]; I.b_down = (const float*)args.in[26]; I.norm_final_g = (const float*)args.in[27];
    for (int u = F.tid; u < (LDS_BYTES - LDSCTL_OFF) / 4; u += NWAVES * 64) ((LAS unsigned*)(F.lds + LDSCTL_OFF))[u] = 0u;
    __syncthreads();
    const int lo = args.ph_lo, hi = args.ph_hi;
    const bool single = (hi - lo) > 1;
    XcdBarrier bar; bar.bar = (unsigned*)(F.ctl + CW_BAR); bar.x = 0; bar.st = nullptr;
    if (single) bar = xcd_barrier_post((unsigned*)(F.ctl + CW_BAR), F.MISC + 8);
#define IN(k) (lo <= (k) && (k) < hi)
#define SEAM(k) do { if (IN(k) && IN((k) + 1)) xcd_barrier(bar); } while (0)
    typedef pg8::bf16_t hb;
    const int bx = (int)blockIdx.x;

    if (IN(0)) { p0_prologue(F, I); }
    SEAM(0);
    if (IN(1)) {
        { pg8::Gemm g{(const hb*)(ws + WS_HN), (const hb*)(ws + WS_WINT), NTOK, 3328, DM}; pg8::OrderMap S; S.init(128, 11, F.G, bx, 4, 2);
          pg8::EpiProj E{(hb*)(ws + WS_P), (float*)(ws + WS_LA), (const float*)(ws + WS_CS), I.b_alpha};
          pg8::gemm_phase<pg8::EpiProj, pg8::OrderMap, true, true>(F.lds + RING_OFF, g, S, E); }
        { pg8::Gemm g{(const hb*)(ws + WS_WINT) + (size_t)1024 * DM, (const hb*)(ws + WS_HN), 512, NTOK, DM}; pg8::StaticOrder S; S.init(512, NTOK, F.G, (bx + 128) % F.G);
          pg8::EpiPlain E{(hb*)(ws + WS_VT), NTOK, 1.0f};
          pg8::gemm_phase<pg8::EpiPlain, pg8::StaticOrder, true, true>(F.lds + RING_OFF, g, S, E); }
        { pg8::Gemm g{(const hb*)(ws + WS_MN), (const hb*)(ws + WS_WCK), NMEM, DM, DM}; pg8::StaticOrder S; S.init(NMEM, DM, F.G, bx);
          pg8::EpiPlain E{(hb*)(ws + WS_KX), DM, 1.0f};
          pg8::gemm_phase<pg8::EpiPlain, pg8::StaticOrder, true, true>(F.lds + RING_OFF, g, S, E); }
        { pg8::Gemm g{(const hb*)(ws + WS_WCV), (const hb*)(ws + WS_MN), DM, NMEM, DM}; pg8::StaticOrder S; S.init(DM, NMEM, F.G, (bx + 64) % F.G);
          pg8::EpiPlain E{(hb*)(ws + WS_VXT), NMEM, 1.0f};
          pg8::gemm_phase<pg8::EpiPlain, pg8::StaticOrder, true, true>(F.lds + RING_OFF, g, S, E); }
    }
    SEAM(1);
    if (IN(2)) {
        float lam;
        { const float a = I.lq1[F.lane] * I.lk1[F.lane], c = I.lq2[F.lane] * I.lk2[F.lane]; lam = __expf(wave_sum(a)) - __expf(wave_sum(c)) + 0.2f; }
        for (int i = F.vcu; i < 512; i += F.G) { const int bh = i >> 3, jj = i & 7;
            diffattn_unit((const bf16*)(ws + WS_P), (const bf16*)(ws + WS_VT), (bf16*)(ws + WS_CAT), I.diff_norm_g, lam, bh >> 2, bh & 3, 15 - jj, F.wave, F.lane);
            diffattn_unit((const bf16*)(ws + WS_P), (const bf16*)(ws + WS_VT), (bf16*)(ws + WS_CAT), I.diff_norm_g, lam, bh >> 2, bh & 3, jj, F.wave, F.lane); }
        for (int i = F.vcu; i < 64; i += F.G) gla_unit_naive(F, (const bf16*)(ws + WS_P), (const float*)(ws + WS_LA), (bf16*)(ws + WS_CAT), I.gla_norm_g, i >> 2, i & 3);
    }
    SEAM(2);
    if (IN(3)) {
        pg8::Gemm g{(const hb*)(ws + WS_CAT), (const hb*)(ws + WS_WOUT), NTOK, DM, DM}; pg8::StaticOrder S; S.init(NTOK, DM, F.G, bx);
        pg8::EpiRes1 E{I.x, F.out, (hb*)(ws + WS_X1B), (float*)(ws + WS_SSP1)};
        pg8::gemm_phase<pg8::EpiRes1, pg8::StaticOrder, true, true>(F.lds + RING_OFF, g, S, E);
    }
    SEAM(3);
    if (IN(4)) {
        pg8::Gemm g{(const hb*)(ws + WS_X1B), (const hb*)(ws + WS_WCQ), NTOK, DM, DM}; pg8::StaticOrder S; S.init(NTOK, DM, F.G, bx);
        pg8::EpiQX E{(hb*)(ws + WS_QX), (const float*)(ws + WS_SSP1)};
        pg8::gemm_phase<pg8::EpiQX, pg8::StaticOrder, true, true>(F.lds + RING_OFF, g, S, E);
    }
    SEAM(4);
    if (IN(5)) {
        for (int i = F.vcu; i < NBATCH * 4 * 16; i += F.G) { const int bh = i >> 4, qb = i & 15;
            crossattn_unit((const bf16*)(ws + WS_QX), (const bf16*)(ws + WS_KX), (const bf16*)(ws + WS_VXT), (bf16*)(ws + WS_OX), bh >> 2, bh & 3, qb, F.wave, F.lane); }
    }
    SEAM(5);
    if (IN(6)) {
        pg8::Gemm g{(const hb*)(ws + WS_OX), (const hb*)(ws + WS_WCO), NTOK, DM, DM}; pg8::StaticOrder S; S.init(NTOK, DM, F.G, bx);
        pg8::EpiRes2 E{F.out};
        pg8::gemm_phase<pg8::EpiRes2, pg8::StaticOrder, true, true>(F.lds + RING_OFF, g, S, E);
    }
    SEAM(6);
    if (IN(7)) router_phase(F, F.out, (const float*)(ws + WS_WR), I.b_router, (float*)(ws + WS_RS2), (float*)(ws + WS_GATE), (unsigned*)(ws + WS_ASSIGN), (unsigned*)(ws + WS_LIST), F.ctl + CW_CNT);
    SEAM(7);
    if (IN(8)) gather_phase(F, F.out, (const unsigned*)(ws + WS_LIST), (int*)(ws + WS_ROWTOK), (bf16*)(ws + WS_XG));
    SEAM(8);
    if (IN(9)) {
        const int T = moe_tables(F);
        pg8::Gemm g{(const hb*)(ws + WS_XG), (const hb*)(ws + WS_WUP), T * 256, NEXP * 2048, DM}; pg8::MoeOrder S; S.init(T, 8, F.G, bx, (const PG8_LAS unsigned char*)(F.lds + TAB_OFF));
        pg8::EpiUp E{(hb*)(ws + WS_ACT), (const int*)(ws + WS_ROWTOK), (const float*)(ws + WS_RS2), I.b_up};
        pg8::gemm_phase<pg8::EpiUp, pg8::MoeOrder, true, true>(F.lds + RING_OFF, g, S, E);
    }
    SEAM(9);
    if (IN(10)) {
        const int T = moe_tables(F);
        pg8::Gemm g{(const hb*)(ws + WS_ACT), (const hb*)(ws + WS_WDN), T * 256, NEXP * 1024, DM}; pg8::MoeOrder S; S.init(T, 4, F.G, bx, (const PG8_LAS unsigned char*)(F.lds + TAB_OFF));
        pg8::EpiDown E{(hb*)(ws + WS_Y), I.b_down};
        pg8::gemm_phase<pg8::EpiDown, pg8::MoeOrder, true, true>(F.lds + RING_OFF, g, S, E);
    }
    SEAM(10);
    if (IN(11)) final_phase(F, F.out, (const bf16*)(ws + WS_Y), (const float*)(ws + WS_GATE), (const unsigned*)(ws + WS_ASSIGN), I.norm_final_g);
#undef IN
#undef SEAM
}

#ifndef MK_N_LAUNCHES
#define MK_N_LAUNCHES 1
#endif
extern "C" void kernel_launch(void* const* d_in, const int* in_sizes, int n_in, void* d_out, int out_size, void* d_ws, size_t ws_size, hipStream_t stream) {
    static int grid = 0;
    if (grid == 0) {
        if (n_in != 28 || out_size != NTOK * DM || ws_size < WS_END) { fprintf(stderr, "kernel_launch: unexpected shapes: n_in %d out %d ws %zu (need %zu)\n", n_in, out_size, ws_size, (size_t)WS_END); grid = -1; return; }
        int dev = 0, cus = 0, per_cu = 0;
        if (hipGetDevice(&dev) != hipSuccess || hipDeviceGetAttribute(&cus, hipDeviceAttributeMultiprocessorCount, dev) != hipSuccess) { fprintf(stderr, "kernel_launch: device query failed\n"); grid = -1; return; }
        if (hipFuncSetAttribute((const void*)mk_fwd, hipFuncAttributeMaxDynamicSharedMemorySize, LDS_BYTES) != hipSuccess) { fprintf(stderr, "kernel_launch: hipFuncSetAttribute failed\n"); grid = -1; return; }
        if (hipOccupancyMaxActiveBlocksPerMultiprocessor(&per_cu, (const void*)mk_fwd, NWAVES * 64, LDS_BYTES) != hipSuccess || per_cu < 1) { fprintf(stderr, "kernel_launch: occupancy query reports %d workgroups per CU\n", per_cu); (void)hipGetLastError(); grid = -1; return; }
        grid = cus;
    }
    if (grid < 0) return;
    (void)hipMemsetAsync((char*)d_ws + WS_CTL, 0, CTL_ZERO_BYTES, stream);
    Args a{};
    for (int i = 0; i < 28; ++i) a.in[i] = d_in[i];
    a.out = (float*)d_out; a.ws = (unsigned char*)d_ws;
    if (MK_N_LAUNCHES == 1) { a.ph_lo = 0; a.ph_hi = NPHASE; hipLaunchKernelGGL(mk_fwd, dim3(grid), dim3(NWAVES * 64), LDS_BYTES, stream, a); }
    else for (int p = 0; p < NPHASE; ++p) { a.ph_lo = p; a.ph_hi = p + 1; hipLaunchKernelGGL(mk_fwd, dim3(grid), dim3(NWAVES * 64), LDS_BYTES, stream, a); }
}
```

```cpp
#include <hip/hip_runtime.h>
#include <cstdio>
#include <cstdint>
namespace pg8 {
#define PG8_LAS __attribute__((address_space(3)))
typedef unsigned short bf16_t;
typedef short bf16x8 __attribute__((ext_vector_type(8)));
typedef float f32x4 __attribute__((ext_vector_type(4)));
typedef unsigned u32x4 __attribute__((ext_vector_type(4)));
constexpr int BM = 256, BK = 64, HALF = 128, HTB = HALF * BK * 2  , STAGE_BYTES = 8 * HTB, NXCD = 8, WGM = 8;

__host__ __device__ __forceinline__ int lds_byte(int r, int c) { const int st = (r >> 4) * 2 + (c >> 5), rr = r & 15, cc = c & 31, ob = rr * 64 + cc * 2; return st * 1024 + (ob ^ (((ob >> 9) & 1) << 5)); }
__host__ __device__ __forceinline__ void stage_rc(int b, int& R, int& C) { const int st = b / 1024, sb = b % 1024, swz = sb ^ (((sb >> 9) & 1) << 5); R = (st >> 1) * 16 + swz / 64; C = (st & 1) * 32 + (swz % 64) / 2; }
__host__ __device__ __forceinline__ int perm32(int rho) { const int n = rho >> 4, i = rho & 15; return 8 * (i >> 2) + 4 * n + (i & 3); }

struct Unit { int pm, pn; };
struct Gemm { const bf16_t* A; const bf16_t* Bt; int M, N, K, lda, ldb; };
struct OrderBase {
    __device__ __forceinline__ const char* a_base(const Gemm& g, const Unit& u) const { return (const char*)g.A + (size_t)u.pm * 256 * g.lda * 2; }
    __device__ __forceinline__ const char* b_base(const Gemm& g, const Unit& u) const { return (const char*)g.Bt + (size_t)u.pn * 256 * g.ldb * 2; }
    __device__ __forceinline__ void a_ready(const Unit&) const {}
    __device__ __forceinline__ void done(const Unit&) const {}
};

struct StaticOrder : OrderBase {
    int nM, nN, nwg, G, c;
    __host__ __device__ void init(int M, int N, int G_, int c_) { nM = M / BM; nN = N / BM; nwg = nM * nN; G = G_; c = c_; }
    __host__ __device__ bool next(int i, Unit& u) const {
        const long L = (long)i * G + c; if (L >= nwg) return false;
        int wgid = (int)L; { const int q = nwg / NXCD, r = nwg % NXCD, xcd = wgid % NXCD, off = wgid / NXCD; wgid = (xcd < r ? xcd * (q + 1) : r * (q + 1) + (xcd - r) * q) + off; }
        const int nig = WGM * nN, gid = wgid / nig, fm = gid * WGM, gsz = (nM - fm) < WGM ? (nM - fm) : WGM;
        u.pm = fm + ((wgid % nig) % gsz); u.pn = (wgid % nig) / gsz; return true;
    }
};

typedef unsigned u32x2 __attribute__((ext_vector_type(2)));
typedef float f32x2_t __attribute__((ext_vector_type(2)));
typedef __bf16 bf16x2_t __attribute__((ext_vector_type(2)));
__device__ __forceinline__ unsigned cvtpk(float lo, float hi) { f32x2_t v = {lo, hi}; bf16x2_t b = __builtin_convertvector(v, bf16x2_t); return __builtin_bit_cast(unsigned, b); }
__device__ __forceinline__ void st_bf4(bf16_t* p, f32x4 v) { u32x2 w; w.x = cvtpk(v[0], v[1]); w.y = cvtpk(v[2], v[3]); *(u32x2*)p = w; }
__device__ __forceinline__ float bf2f(bf16_t b) { return __builtin_bit_cast(float, (unsigned)b << 16); }
#define EPI_ROWS _Pragma("unroll") for (int ai = 0; ai < 2; ++ai) _Pragma("unroll") for (int m = 0; m < 4; ++m)
#define EPI_COLS _Pragma("unroll") for (int bj = 0; bj < 2; ++bj) _Pragma("unroll") for (int n = 0; n < 2; ++n)
constexpr float LOG2E = 1.4426950408889634f;
constexpr float QSCALE_DA = 0.125f * LOG2E;
constexpr float QSCALE_X = 0.0625f * LOG2E;

struct EpiPlain {
    static constexpr bool PERM = false, AFTER_DRAIN = false;
    bf16_t* O; int ldc; float scale;
    __device__ __forceinline__ void operator()(const f32x4 (&acc)[2][2][4][2], const Unit& u, int wr, int wc, int fr, int fq) const {
        EPI_ROWS { const int row = u.pm * 256 + ai * 128 + wr * 64 + m * 16 + fr; bf16_t* rp = O + (size_t)row * ldc + u.pn * 256 + wc * 32 + fq * 4;
            EPI_COLS st_bf4(rp + bj * 128 + n * 16, acc[ai][bj][m][n] * scale); }
    }
};
struct EpiProj {
    static constexpr bool PERM = false, AFTER_DRAIN = false;
    bf16_t* P; float* LA; const float* cs; const float* b_alpha;
    template <int ai> __device__ __forceinline__ void decay_rows(const f32x4 (&acc)[2][2][4][2], const Unit& u, int wr, int wc, int fr, int fq) const {
        const int row0 = u.pm * 256 + ai * 128 + wr * 64 + fr;
        EPI_COLS { const int col = bj * 128 + wc * 32 + n * 16 + fq * 4; const f32x4 ba = *(const f32x4*)(b_alpha + col); f32x4 run = {0.f, 0.f, 0.f, 0.f};
            _Pragma("unroll") for (int m = 0; m < 4; ++m) { const f32x4 z = acc[ai][bj][m][n] + ba; f32x4 o;
                _Pragma("unroll") for (int i = 0; i < 4; ++i) { float v = (fminf(z[i], 0.f) - __logf(1.0f + __expf(-fabsf(z[i])))) * 0.0625f;
                    { float t = __shfl_up(v, 1, 16); if (fr >= 1) v += t; t = __shfl_up(v, 2, 16); if (fr >= 2) v += t; t = __shfl_up(v, 4, 16); if (fr >= 4) v += t; t = __shfl_up(v, 8, 16); if (fr >= 8) v += t; }
                    o[i] = v + run[i]; run[i] += __shfl(v, 15, 16); }
                *(f32x4*)(LA + (size_t)(row0 + m * 16) * 256 + col) = o; } }
    }
    __device__ __forceinline__ void operator()(const f32x4 (&acc)[2][2][4][2], const Unit& u, int wr, int wc, int fr, int fq) const {
        const int pn = u.pn;
        if (pn < 4) {
            const float sc = pn < 2 ? QSCALE_DA : 1.0f; const bool ropew = (wc & 1) == 0; const bool hi = (fq >> 1) != 0;
            EPI_ROWS { const int row = u.pm * 256 + ai * 128 + wr * 64 + m * 16 + fr; bf16_t* rp = P + (size_t)row * 3072 + pn * 256 + wc * 32 + fq * 4;
                f32x4 cv = {1.f, 1.f, 1.f, 1.f}, sv = {0.f, 0.f, 0.f, 0.f};
                if (ropew) { cv = *(const f32x4*)(cs + (size_t)row * 16 + 4 * (fq & 1)); sv = *(const f32x4*)(cs + (size_t)row * 16 + 8 + 4 * (fq & 1)); }
                EPI_COLS { f32x4 v = acc[ai][bj][m][n];
                    if (n == 0 && ropew) { f32x4 p; p[0] = __shfl_xor(v[0], 32); p[1] = __shfl_xor(v[1], 32); p[2] = __shfl_xor(v[2], 32); p[3] = __shfl_xor(v[3], 32);
                        v = hi ? (v * cv + p * sv) : (v * cv - p * sv); }
                    st_bf4(rp + bj * 128 + n * 16, v * sc); } }
        } else if (pn < 12) {
            const float sc = pn == 6 ? 0.125f : 1.0f;
            EPI_ROWS { const int row = u.pm * 256 + ai * 128 + wr * 64 + m * 16 + fr; bf16_t* rp = P + (size_t)row * 3072 + pn * 256 + wc * 32 + fq * 4;
                EPI_COLS st_bf4(rp + bj * 128 + n * 16, acc[ai][bj][m][n] * sc); }
        } else {
            decay_rows<0>(acc, u, wr, wc, fr, fq); decay_rows<1>(acc, u, wr, wc, fr, fq);
        }
    }
};
struct EpiRes1 {
    static constexpr bool PERM = false, AFTER_DRAIN = false;
    const float* base; float* out; bf16_t* xb; float* ssp;
    __device__ __forceinline__ void operator()(const f32x4 (&acc)[2][2][4][2], const Unit& u, int wr, int wc, int fr, int fq) const {
        EPI_ROWS { const int row = u.pm * 256 + ai * 128 + wr * 64 + m * 16 + fr; const size_t off = (size_t)row * 1024 + u.pn * 256 + wc * 32 + fq * 4; float ss = 0.f;
            EPI_COLS { const size_t o2 = off + bj * 128 + n * 16; const f32x4 v = *(const f32x4*)(base + o2) + acc[ai][bj][m][n]; *(f32x4*)(out + o2) = v; st_bf4(xb + o2, v);
                ss += (v[0] * v[0] + v[1] * v[1]) + (v[2] * v[2] + v[3] * v[3]); }
            ss += __shfl_xor(ss, 16); ss += __shfl_xor(ss, 32);
            if (fq == 0) ssp[(size_t)row * 16 + u.pn * 4 + wc] = ss; }
    }
};
struct EpiQX {
    static constexpr bool PERM = false, AFTER_DRAIN = false;
    bf16_t* O; const float* ssp;
    __device__ __forceinline__ void operator()(const f32x4 (&acc)[2][2][4][2], const Unit& u, int wr, int wc, int fr, int fq) const {
        EPI_ROWS { const int row = u.pm * 256 + ai * 128 + wr * 64 + m * 16 + fr; const f32x4* sp = (const f32x4*)(ssp + (size_t)row * 16);
            const f32x4 a = sp[0], b = sp[1], c = sp[2], d = sp[3]; const float ss = ((a[0] + a[1]) + (a[2] + a[3])) + ((b[0] + b[1]) + (b[2] + b[3])) + ((c[0] + c[1]) + (c[2] + c[3])) + ((d[0] + d[1]) + (d[2] + d[3]));
            const float rs = rsqrtf(ss * (1.0f / 1024.0f) + 1e-6f) * QSCALE_X; bf16_t* rp = O + (size_t)row * 1024 + u.pn * 256 + wc * 32 + fq * 4;
            EPI_COLS st_bf4(rp + bj * 128 + n * 16, acc[ai][bj][m][n] * rs); }
    }
};
struct EpiRes2 {
    static constexpr bool PERM = false, AFTER_DRAIN = false;
    float* out;
    __device__ __forceinline__ void operator()(const f32x4 (&acc)[2][2][4][2], const Unit& u, int wr, int wc, int fr, int fq) const {
        EPI_ROWS { const int row = u.pm * 256 + ai * 128 + wr * 64 + m * 16 + fr; float* rp = out + (size_t)row * 1024 + u.pn * 256 + wc * 32 + fq * 4;
            EPI_COLS { f32x4* p = (f32x4*)(rp + bj * 128 + n * 16); *p = *p + acc[ai][bj][m][n]; } }
    }
};
struct EpiUp {
    static constexpr bool PERM = false, AFTER_DRAIN = false;
    bf16_t* ACT; const int* rowtok; const float* rs2; const float* b_up;
    __device__ __forceinline__ void operator()(const f32x4 (&acc)[2][2][4][2], const Unit& u, int wr, int wc, int fr, int fq) const {
        const int e = u.pn >> 3, pnl = u.pn & 7; const float* bg = b_up + (size_t)e * 2048 + pnl * 128 + wc * 32 + fq * 4;
        EPI_ROWS { const int row = u.pm * 256 + ai * 128 + wr * 64 + m * 16 + fr; const int tok = rowtok[row]; const float rs = tok >= 0 ? rs2[tok] : 0.f;
            bf16_t* rp = ACT + (size_t)row * 1024 + pnl * 128 + wc * 32 + fq * 4;
            _Pragma("unroll") for (int n = 0; n < 2; ++n) { const f32x4 g = acc[ai][0][m][n] * rs + *(const f32x4*)(bg + n * 16), l = acc[ai][1][m][n] * rs + *(const f32x4*)(bg + 1024 + n * 16); f32x4 o;
                _Pragma("unroll") for (int i = 0; i < 4; ++i) { const float gl = fminf(g[i], 7.0f), li = fminf(fmaxf(l[i], -7.0f), 7.0f); o[i] = gl / (1.0f + __expf(-1.702f * gl)) * (li + 1.0f); }
                st_bf4(rp + n * 16, o); } }
    }
};
struct EpiDown {
    static constexpr bool PERM = false, AFTER_DRAIN = false;
    bf16_t* Y; const float* b_down;
    __device__ __forceinline__ void operator()(const f32x4 (&acc)[2][2][4][2], const Unit& u, int wr, int wc, int fr, int fq) const {
        const int e = u.pn >> 2, pnl = u.pn & 3; const float* bp = b_down + (size_t)e * 1024 + pnl * 256 + wc * 32 + fq * 4;
        EPI_ROWS { const int row = u.pm * 256 + ai * 128 + wr * 64 + m * 16 + fr; bf16_t* rp = Y + (size_t)row * 1024 + pnl * 256 + wc * 32 + fq * 4;
            EPI_COLS st_bf4(rp + bj * 128 + n * 16, acc[ai][bj][m][n] + *(const f32x4*)(bp + bj * 128 + n * 16)); }
    }
};
struct OrderMap : OrderBase {
    StaticOrder so;
    __device__ void init(int nM, int nN, int G, int c) { so.nM = nM; so.nN = nN; so.nwg = nM * nN; so.G = G; so.c = c; }
    __device__ bool next(int i, Unit& u) const { if (!so.next(i, u)) return false; u.pn += (u.pn >= 4 ? 2 : 0) + (u.pn >= 6 ? 2 : 0); return true; }
};
struct OrderVT : OrderBase {
    StaticOrder so;
    __device__ void init(int nN, int G, int c) { so.nM = 4; so.nN = nN; so.nwg = 4 * nN; so.G = G; so.c = c; }
    __device__ bool next(int i, Unit& u) const { if (!so.next(i, u)) return false; u.pm += (u.pm >= 2 ? 6 : 4); return true; }
};
struct MoeOrder : OrderBase {
    StaticOrder so; const PG8_LAS unsigned char* tile_e; int nN;
    __device__ void init(int nM, int nN_, int G, int c, const PG8_LAS unsigned char* te) { so.nM = nM; so.nN = nN_; so.nwg = nM * nN_; so.G = G; so.c = c; tile_e = te; nN = nN_; }
    __device__ bool next(int i, Unit& u) const { if (!so.next(i, u)) return false; u.pn += (int)tile_e[u.pm] * nN; return true; }
};


struct OrderX1 : OrderBase {
    StaticOrder so;
    __device__ void init(int G, int c) { so.nM = 128; so.nN = 4; so.nwg = 512; so.G = G; so.c = c; }
    __device__ bool next(int i, Unit& u) const { return so.next(i, u); }
    __device__ __forceinline__ const char* a_base(const Gemm& g, const Unit& u) const { return (const char*)(g.A + (size_t)u.pm * 256 * 1024 + u.pn * 256); }
    __device__ __forceinline__ const char* b_base(const Gemm& g, const Unit& u) const { return (const char*)(g.Bt + (size_t)(u.pm >> 3) * 256 * 1024 + u.pn * 256); }
};
struct OrderX2 : OrderBase {
    StaticOrder so;
    __device__ void init(int G, int c) { so.nM = 128; so.nN = 4; so.nwg = 512; so.G = G; so.c = c; }
    __device__ bool next(int i, Unit& u) const { return so.next(i, u); }
    __device__ __forceinline__ const char* a_base(const Gemm& g, const Unit& u) const { return (const char*)(g.A + (size_t)u.pm * 256 * 1024 + u.pn * 256); }
    __device__ __forceinline__ const char* b_base(const Gemm& g, const Unit& u) const { return (const char*)(g.Bt + (size_t)u.pn * 256 * 4096 + (u.pm >> 3) * 256); }
};
struct EpiSoftmax {
    static constexpr bool PERM = false, AFTER_DRAIN = false;
    bf16_t* PX; float* lp; PG8_LAS float* xch;
    __device__ __forceinline__ void operator()(const f32x4 (&acc)[2][2][4][2], const Unit& u, int wr, int wc, int fr, int fq) const {
        PG8_LAS char* rb = (PG8_LAS char*)xch + (wr * 64 + fr) * 16; asm volatile("" : "+v"(rb));
        PG8_LAS char* wb = rb + wc * 4; asm volatile("" : "+v"(wb));
        EPI_ROWS { float a = -INFINITY;
            EPI_COLS { const f32x4 v = acc[ai][bj][m][n]; a = fmaxf(a, fmaxf(fmaxf(v[0], v[1]), fmaxf(v[2], v[3]))); }
            a = fmaxf(a, __shfl_xor(a, 16)); a = fmaxf(a, __shfl_xor(a, 32));
            if (fq == 0) *(PG8_LAS float*)(wb + (ai * 128 + m * 16) * 16) = a; }
        asm volatile("s_waitcnt lgkmcnt(0)" ::: "memory"); __builtin_amdgcn_s_barrier(); asm volatile("" ::: "memory");
        const int row0 = u.pm * 256 + wr * 64 + fr; bf16_t* rp0 = PX + (size_t)row0 * 1024 + u.pn * 256 + wc * 32 + fq * 4; float* lp0 = lp + (size_t)row0 * 16 + u.pn * 4 + wc;
        EPI_ROWS { const f32x4 q = *(const PG8_LAS f32x4*)(rb + (ai * 128 + m * 16) * 16); const float mr = fmaxf(fmaxf(q[0], q[1]), fmaxf(q[2], q[3]));
            bf16_t* rp = rp0 + (size_t)(ai * 128 + m * 16) * 1024; float ps = 0.f;
            EPI_COLS { const f32x4 v = acc[ai][bj][m][n]; f32x4 p; _Pragma("unroll") for (int i = 0; i < 4; ++i) { p[i] = __builtin_amdgcn_exp2f(v[i] - mr); ps += p[i]; }
                st_bf4(rp + bj * 128 + n * 16, p); }
            ps += __shfl_xor(ps, 16); ps += __shfl_xor(ps, 32);
            if (fq == 0) lp0[(ai * 128 + m * 16) * 16] = ps; }
        asm volatile("s_waitcnt lgkmcnt(0)" ::: "memory"); __builtin_amdgcn_s_barrier(); asm volatile("" ::: "memory");
    }
};
struct EpiPV {
    static constexpr bool PERM = false, AFTER_DRAIN = false;
    bf16_t* O; const float* lp;
    __device__ __forceinline__ void operator()(const f32x4 (&acc)[2][2][4][2], const Unit& u, int wr, int wc, int fr, int fq) const {
        EPI_ROWS { const int row = u.pm * 256 + ai * 128 + wr * 64 + m * 16 + fr; const f32x4 q = *(const f32x4*)(lp + (size_t)row * 16 + u.pn * 4);
            const float inv = 1.0f / ((q[0] + q[1]) + (q[2] + q[3])); bf16_t* rp = O + (size_t)row * 1024 + u.pn * 256 + wc * 32 + fq * 4;
            EPI_COLS st_bf4(rp + bj * 128 + n * 16, acc[ai][bj][m][n] * inv); }
    }
};
template <class Epi, class Sched, bool ALIGN_EPI = false, bool SP2 = false>
__device__ __forceinline__ void gemm_phase(PG8_LAS unsigned char* lds, const Gemm g, const Sched& S, const Epi& E) {
    const int tid = threadIdx.x, wid = __builtin_amdgcn_readfirstlane(tid >> 6), lane = tid & 63, wr = wid >> 2, wc = wid & 3, fr = lane & 15, fq = lane >> 4;
    const int K = g.K, nt = K / BK;
    unsigned voffA[2], voffB[2];
#pragma unroll
    for (int i = 0; i < 2; ++i) { int R, C; stage_rc(tid * 16 + i * 8192, R, C); const int Rb = Epi::PERM ? ((R & ~31) + perm32(R & 31)) : R;
        voffA[i] = (unsigned)(R * g.lda + C) * 2u; voffB[i] = (unsigned)(Rb * g.ldb + C) * 2u; }
    const size_t kstep = (size_t)(BK * 2);
    const size_t hstepA = (size_t)HALF * g.lda * 2, hstepB = (size_t)HALF * g.ldb * 2;
    const unsigned ldsw = (unsigned)wid * 1024u;
    const int aoff = lds_byte(wr * 64 + fr, fq * 8), boff = lds_byte(wc * 32 + fr, fq * 8);
#define PG8_SA(b, h) (((b) * 2 + (h)) * HTB)
#define PG8_SB(b, h) ((4 + (b) * 2 + (h)) * HTB)
#define PG8_STAGE(bufoff, gbase, voff) do { _Pragma("unroll") for (int _i = 0; _i < 2; ++_i) \
        __builtin_amdgcn_global_load_lds((const unsigned*)((const char*)(gbase) + (voff)[_i]), (PG8_LAS unsigned*)(lds + (bufoff) + ldsw + _i * 8192), 16, 0, 0); } while (0)
#define PG8_LDA(dst, b, h) do { _Pragma("unroll") for (int m = 0; m < 4; ++m) _Pragma("unroll") for (int k = 0; k < 2; ++k) dst[m][k] = *(const PG8_LAS bf16x8*)(lds + PG8_SA(b, h) + aoff + m * 2048 + k * 1024); } while (0)
#define PG8_LDB(dst, b, h) do { _Pragma("unroll") for (int n = 0; n < 2; ++n) _Pragma("unroll") for (int k = 0; k < 2; ++k) dst[n][k] = *(const PG8_LAS bf16x8*)(lds + PG8_SB(b, h) + boff + n * 2048 + k * 1024); } while (0)
#define PG8_MMA(ai, bj, At, Bt) do { __builtin_amdgcn_s_setprio(1); _Pragma("unroll") for (int m = 0; m < 4; ++m) _Pragma("unroll") for (int n = 0; n < 2; ++n) _Pragma("unroll") for (int k = 0; k < 2; ++k) \
        acc[ai][bj][m][n] = __builtin_amdgcn_mfma_f32_16x16x32_bf16(Bt[n][k], At[m][k], acc[ai][bj][m][n], 0, 0, 0); __builtin_amdgcn_s_setprio(0); } while (0)
#define PG8_WAIT_V(n) asm volatile("s_waitcnt vmcnt(" #n ")" ::: "memory")
#define PG8_WAIT_L(n) asm volatile("s_waitcnt lgkmcnt(" #n ")" ::: "memory")
#define PG8_BAR __builtin_amdgcn_s_barrier()
#define PG8_SCHED __builtin_amdgcn_sched_barrier(0)
    Unit cur, nxt; int ui = 0;
    if (!S.next(0, cur)) return;
    f32x4 acc[2][2][4][2];
#pragma unroll
    for (int a = 0; a < 2; ++a)
#pragma unroll
        for (int b = 0; b < 2; ++b)
#pragma unroll
            for (int m = 0; m < 4; ++m)
#pragma unroll
                for (int n = 0; n < 2; ++n) acc[a][b][m][n] = (f32x4){0.f, 0.f, 0.f, 0.f};
    bf16x8 At[4][2], B0[2][2], B1[2][2];
    const char* cA = S.a_base(g, cur); const char* cB = S.b_base(g, cur);
    S.a_ready(cur);
    if constexpr (SP2) {
        PG8_STAGE(PG8_SB(0, 0), cB, voffB); PG8_STAGE(PG8_SB(0, 1), cB + hstepB, voffB); PG8_STAGE(PG8_SA(0, 0), cA, voffA); PG8_STAGE(PG8_SA(0, 1), cA + hstepA, voffA);
        if (wr == 1) PG8_BAR;
        PG8_WAIT_V(2); PG8_BAR;
        PG8_STAGE(PG8_SB(1, 0), cB + kstep, voffB); PG8_STAGE(PG8_SA(1, 0), cA + kstep, voffA); PG8_STAGE(PG8_SB(1, 1), cB + hstepB + kstep, voffB);
        PG8_WAIT_V(6); PG8_BAR;
    } else {
        PG8_STAGE(PG8_SB(0, 0), cB, voffB); PG8_STAGE(PG8_SA(0, 0), cA, voffA); PG8_STAGE(PG8_SB(0, 1), cB + hstepB, voffB); PG8_STAGE(PG8_SA(0, 1), cA + hstepA, voffA);
        if (wr == 1) PG8_BAR;
        PG8_WAIT_V(4); PG8_BAR;
        PG8_STAGE(PG8_SB(1, 0), cB + kstep, voffB); PG8_STAGE(PG8_SA(1, 0), cA + kstep, voffA); PG8_STAGE(PG8_SB(1, 1), cB + hstepB + kstep, voffB);
        PG8_WAIT_V(6); PG8_BAR;
    }
    for (;;) {
        const bool has_next = S.next(ui + 1, nxt);
        const char* nA = has_next ? S.a_base(g, nxt) : cA; const char* nB = has_next ? S.b_base(g, nxt) : cB;
        for (int t = 0; t < nt; t += 2) {
            const bool last = (t == nt - 2);
            const char* a1 = cA + (size_t)(t + 1) * kstep;
            const char* a2 = last ? nA : cA + (size_t)(t + 2) * kstep; const char* b2 = last ? nB : cB + (size_t)(t + 2) * kstep;
            const char* a3 = a2 + kstep; const char* b3 = b2 + kstep;
            if (last && has_next) S.a_ready(nxt);
            if constexpr (SP2) {
            PG8_LDB(B0, 0, 0); PG8_LDB(B1, 0, 1); PG8_SCHED; PG8_LDA(At, 0, 0); PG8_STAGE(PG8_SA(1, 1), a1 + hstepA, voffA);
            PG8_WAIT_V(8); PG8_WAIT_L(0); PG8_BAR; PG8_MMA(0, 0, At, B0); PG8_MMA(0, 1, At, B1); PG8_BAR; PG8_SCHED;
            PG8_LDA(At, 0, 1); PG8_STAGE(PG8_SB(0, 0), b2, voffB); PG8_STAGE(PG8_SB(0, 1), b2 + hstepB, voffB); PG8_STAGE(PG8_SA(0, 0), a2, voffA);
            PG8_WAIT_V(8); PG8_WAIT_L(0); PG8_BAR; PG8_MMA(1, 0, At, B0); PG8_MMA(1, 1, At, B1); PG8_BAR; PG8_SCHED;
            PG8_LDB(B0, 1, 0); PG8_LDB(B1, 1, 1); PG8_SCHED; PG8_LDA(At, 1, 0); PG8_STAGE(PG8_SA(0, 1), a2 + hstepA, voffA);
            PG8_WAIT_V(8); PG8_WAIT_L(0); PG8_BAR; PG8_MMA(0, 0, At, B0); PG8_MMA(0, 1, At, B1); PG8_BAR; PG8_SCHED;
            PG8_LDA(At, 1, 1); PG8_STAGE(PG8_SB(1, 0), b3, voffB); PG8_STAGE(PG8_SB(1, 1), b3 + hstepB, voffB); PG8_STAGE(PG8_SA(1, 0), a3, voffA);
            PG8_WAIT_V(8); PG8_WAIT_L(0); PG8_BAR; PG8_MMA(1, 0, At, B0); PG8_MMA(1, 1, At, B1); PG8_BAR; PG8_SCHED;
            } else {
            PG8_LDB(B0, 0, 0); PG8_SCHED; PG8_LDA(At, 0, 0); PG8_STAGE(PG8_SA(1, 1), a1 + hstepA, voffA);
            PG8_WAIT_L(8); PG8_BAR; PG8_WAIT_L(0); PG8_MMA(0, 0, At, B0); PG8_BAR; PG8_SCHED;
            PG8_LDB(B1, 0, 1); PG8_STAGE(PG8_SB(0, 0), b2, voffB);
            PG8_BAR; PG8_WAIT_L(0); PG8_MMA(0, 1, At, B1); PG8_BAR;
            PG8_LDA(At, 0, 1); PG8_STAGE(PG8_SA(0, 0), a2, voffA);
            PG8_BAR; PG8_WAIT_L(0); PG8_MMA(1, 0, At, B0); PG8_BAR; PG8_SCHED;
            PG8_STAGE(PG8_SB(0, 1), b2 + hstepB, voffB);
            PG8_WAIT_V(6); PG8_BAR; PG8_MMA(1, 1, At, B1); PG8_BAR;
            PG8_LDB(B0, 1, 0); PG8_SCHED; PG8_LDA(At, 1, 0); PG8_STAGE(PG8_SA(0, 1), a2 + hstepA, voffA);
            PG8_WAIT_L(8); PG8_BAR; PG8_WAIT_L(0); PG8_MMA(0, 0, At, B0); PG8_BAR; PG8_SCHED;
            PG8_LDB(B1, 1, 1); PG8_STAGE(PG8_SB(1, 0), b3, voffB);
            PG8_BAR; PG8_WAIT_L(0); PG8_MMA(0, 1, At, B1); PG8_BAR;
            PG8_LDA(At, 1, 1); PG8_STAGE(PG8_SA(1, 0), a3, voffA);
            PG8_BAR; PG8_WAIT_L(0); PG8_MMA(1, 0, At, B0); PG8_BAR; PG8_SCHED;
            PG8_STAGE(PG8_SB(1, 1), b3 + hstepB, voffB);
            PG8_WAIT_V(6); PG8_BAR; PG8_MMA(1, 1, At, B1); PG8_BAR;
            }
        }
        if constexpr (ALIGN_EPI) { if (wr == 0) PG8_BAR; }
        if constexpr (!Epi::AFTER_DRAIN) { E(acc, cur, wr, wc, fr, fq); S.done(cur); }
        if (!has_next) break;
#pragma unroll
        for (int a = 0; a < 2; ++a)
#pragma unroll
            for (int b = 0; b < 2; ++b)
#pragma unroll
                for (int m = 0; m < 4; ++m)
#pragma unroll
                    for (int n = 0; n < 2; ++n) acc[a][b][m][n] = (f32x4){0.f, 0.f, 0.f, 0.f};
        cur = nxt; cA = nA; cB = nB; ++ui;
        if constexpr (ALIGN_EPI) { if (wr == 1) PG8_BAR; }
    }
    PG8_WAIT_V(0);
    if constexpr (!ALIGN_EPI) { if (wr == 0) PG8_BAR; }
    PG8_BAR;
    if constexpr (Epi::AFTER_DRAIN) { E.fused(acc, cur, wr, wc, fr, fq, lds, wid, lane); S.done(cur); }
#undef PG8_SA
#undef PG8_SB
#undef PG8_STAGE
#undef PG8_LDA
#undef PG8_LDB
#undef PG8_MMA
#undef PG8_WAIT_V
#undef PG8_WAIT_L
#undef PG8_BAR
#undef PG8_SCHED
}
}
constexpr int NTOK = 32768, DM = 1024, SEQ = 2048, NBATCH = 16, MEMLEN = 256, NMEM = NBATCH * MEMLEN, INW = 3088, NEXP = 32, TOPK = 4;
constexpr int PW = 3072;
constexpr int MAXTILES = 544;
constexpr float EPS = 1e-6f;
constexpr int NWAVES = 8;
constexpr size_t MiB = 1u << 20;
constexpr size_t WS_CTL = 0, CTL_ZERO_BYTES = 64 * 1024;
constexpr size_t WS_WINT = 2 * MiB, WS_WOUT = 10 * MiB, WS_WCQ = 12 * MiB, WS_WCK = 14 * MiB, WS_WCV = 16 * MiB, WS_WCO = 18 * MiB;
constexpr size_t WS_WR = 20 * MiB, WS_CS = 21 * MiB, WS_SSP1 = 24 * MiB, WS_RS2 = 26 * MiB, WS_GATE = 27 * MiB, WS_ASSIGN = 28 * MiB, WS_LIST = 29 * MiB, WS_ROWTOK = 33 * MiB;
constexpr size_t WS_WUP = 34 * MiB, WS_WDN = 162 * MiB, WS_KX = 226 * MiB, WS_VXT = 234 * MiB;
constexpr size_t WS_HN = 242 * MiB, WS_CAT = 242 * MiB, WS_MN = 306 * MiB, WS_P = 314 * MiB, WS_LA = 506 * MiB, WS_VT = 538 * MiB;
constexpr size_t WS_X1B = 314 * MiB, WS_QX = 378 * MiB, WS_OX = 442 * MiB, WS_PX = 506 * MiB;
constexpr size_t WS_GVT = 602 * MiB;
constexpr size_t WS_ACT = 570 * MiB, WS_XG = 242 * MiB, WS_Y = 242 * MiB, WS_END = 842 * MiB;
constexpr int CW_Q2 = 128;
constexpr int CW_CNT = 1024;
constexpr int CW_PROBE = 192;
constexpr int CW_BAR = 4096;
constexpr int RING_OFF = 0, RING_BYTES = 131072;
constexpr int LDSCTL_OFF = RING_BYTES, MISC_OFF = LDSCTL_OFF + 320;
constexpr int TAB_OFF = LDSCTL_OFF + 512;
constexpr int TAB_TSTART = TAB_OFF + 576, TAB_CNT = TAB_TSTART + 144;
constexpr int XCH_OFF = LDSCTL_OFF + 2048;
constexpr int TS_OFF = TAB_CNT + 128;
constexpr int LDS_BYTES = 147456;

#define GAS __attribute__((address_space(1)))
#define LAS __attribute__((address_space(3)))
typedef unsigned short bf16;
typedef unsigned v4u __attribute__((ext_vector_type(4)));
typedef float f32x4 __attribute__((ext_vector_type(4)));
typedef short bf16x8 __attribute__((ext_vector_type(8)));
typedef GAS unsigned gu32;
typedef GAS unsigned long long gu64;
#define RLX_AGENT __ATOMIC_RELAXED, __HIP_MEMORY_SCOPE_AGENT
#define LDS_WAIT() asm volatile("s_waitcnt lgkmcnt(0)" ::: "memory")
#define VM_WAIT() asm volatile("s_waitcnt vmcnt(0)" ::: "memory")
__device__ __forceinline__ unsigned long long rt() { return __builtin_amdgcn_s_memrealtime(); }
__device__ __forceinline__ unsigned f2bf(float f) { unsigned u = __builtin_bit_cast(unsigned, f); return (u + 0x7fffu + ((u >> 16) & 1u)) >> 16; }
__device__ __forceinline__ unsigned pk2(float lo, float hi) { return f2bf(lo) | (f2bf(hi) << 16); }

#define XB_TMO      128
#define XB_XCNT(j)  (256  + 64 * (j))
#define XB_XSUB(j)  (1280 + 64 * (j))
#define XB_XGEN(j)  (2304 + 64 * (j))
#define XB_TOP      3328
#define XB_TOPGEN   3392
#define XCD_BAR_WORDS 3456
#define XB_SPIN_CAP (1u << 18)

__device__ __forceinline__ unsigned xb_ld(unsigned* p)              { return __hip_atomic_load(p, __ATOMIC_RELAXED, __HIP_MEMORY_SCOPE_AGENT); }
__device__ __forceinline__ unsigned xb_add(unsigned* p, unsigned v) { return __hip_atomic_fetch_add(p, v, __ATOMIC_RELAXED, __HIP_MEMORY_SCOPE_AGENT); }
__device__ __forceinline__ unsigned xb_xcc_id() { return (unsigned)__builtin_amdgcn_s_getreg((3 << 11) | 20) & 0xFu; }
#define XB_SPIN(cond, bar) do { unsigned _sp = 0; while (cond) { __builtin_amdgcn_s_sleep(1); \
    if ((++_sp & 255u) == 0u) { if (xb_ld(&(bar)[XB_TMO])) break; if (_sp > XB_SPIN_CAP) { atomicAdd(&(bar)[XB_TMO], 1u); break; } } } } while (0)

struct XcdBarrier {
    unsigned* bar; unsigned x;
    volatile LAS unsigned* st;
};

__device__ __forceinline__ XcdBarrier xcd_barrier_post(unsigned* bar, volatile LAS unsigned* st) {
    XcdBarrier b; b.bar = bar; b.x = xb_xcc_id(); b.st = st;
    if (threadIdx.x == 0) (void)xb_add(&bar[XB_XCNT(b.x)], 1u);
    return b;
}
__device__ __forceinline__ void xcd_barrier_complete(unsigned* bar, unsigned x, unsigned& nloc, unsigned& nx) {
    const unsigned G = gridDim.x * gridDim.y * gridDim.z;
    unsigned sum, cnt, mine, sp = 0u;
    for (;;) {
        sum = 0u; cnt = 0u; mine = 0u;
#pragma unroll
        for (unsigned j = 0; j < 16; ++j) { const unsigned c = xb_ld(&bar[XB_XCNT(j)]); sum += c; cnt += (c > 0u) ? 1u : 0u; mine = (j == x) ? c : mine; }
        if (sum == G) break;
        __builtin_amdgcn_s_sleep(1);
        if ((++sp & 255u) == 0u) { if (xb_ld(&bar[XB_TMO])) break; if (sp > XB_SPIN_CAP) { atomicAdd(&bar[XB_TMO], 1u); break; } }
    }
    nloc = mine > 0u ? mine : 1u; nx = cnt > 0u ? cnt : 1u;
}

__device__ __forceinline__ void xcd_barrier(const XcdBarrier& b) {
    asm volatile("s_waitcnt vmcnt(0)" ::: "memory");
    __syncthreads();
    if (threadIdx.x == 0) {
        unsigned* bar = b.bar;
        __builtin_amdgcn_s_waitcnt(0);
        unsigned nloc = b.st[0], nx = b.st[1];
        if (nloc == 0u) { xcd_barrier_complete(bar, b.x, nloc, nx); b.st[0] = nloc; b.st[1] = nx; }
        const unsigned old = xb_add(&bar[XB_XSUB(b.x)], 1u);
        const unsigned gen = old / nloc;
        if (old + 1u == (gen + 1u) * nloc) {
            __builtin_amdgcn_fence(__ATOMIC_RELEASE, "agent");
            asm volatile("s_waitcnt vmcnt(0)" ::: "memory");
            const unsigned og = xb_add(&bar[XB_TOP], 1u);
            const unsigned tg = og / nx;
            if (og + 1u == (tg + 1u) * nx) xb_add(&bar[XB_TOPGEN], 1u);
            else XB_SPIN(xb_ld(&bar[XB_TOPGEN]) == tg, bar);
            __builtin_amdgcn_fence(__ATOMIC_ACQUIRE, "agent");
            xb_add(&bar[XB_XGEN(b.x)], 1u);
            asm volatile("s_waitcnt vmcnt(0)" ::: "memory");
        } else {
            XB_SPIN(xb_ld(&bar[XB_XGEN(b.x)]) == gen, bar);
            __builtin_amdgcn_fence(__ATOMIC_ACQUIRE, "agent");
            asm volatile("s_waitcnt vmcnt(0)" ::: "memory");
        }
    }
    __syncthreads();
}
typedef short bf16x4 __attribute__((ext_vector_type(4)));
typedef unsigned v2u __attribute__((ext_vector_type(2)));
struct Frame {
    LAS unsigned char* lds;
    volatile LAS unsigned* MISC;
    gu32* ctl;
    int tid, lane, wave;
    int vcu, G;
    unsigned char* ws;
    float* out;
};
__device__ __forceinline__ int lane_here() { int l = (int)(threadIdx.x & 63u); asm volatile("" : "+v"(l)); return l; }
__device__ __forceinline__ float bf2f(bf16 b) { return __builtin_bit_cast(float, (unsigned)b << 16); }
__device__ __forceinline__ float wave_sum(float v) {
#pragma unroll
    for (int o = 1; o < 64; o <<= 1) v += __shfl_xor(v, o);
    return v;
}
__device__ __forceinline__ f32x4 mfma16(bf16x8 a, bf16x8 b, f32x4 c) { return __builtin_amdgcn_mfma_f32_16x16x32_bf16(a, b, c, 0, 0, 0); }

__device__ __forceinline__ void p0_transpose_item(const float* W, int ldw, const float* gain, bf16* WT, int K, int k0, int n0, size_t orow0, LAS float* scr, int lane) {
#pragma unroll 8
    for (int i = 0; i < 32; ++i) { const int kk = 2 * i + (lane >> 5); float v = W[(size_t)(k0 + kk) * ldw + n0 + (lane & 31)]; if (gain) v *= gain[k0 + kk]; scr[kk * 33 + (lane & 31)] = v; }
    LDS_WAIT(); asm volatile("" ::: "memory");
    const int c = lane & 7;
#pragma unroll
    for (int j = 0; j < 4; ++j) { const int n = (lane >> 3) + 8 * j; const LAS float* s = scr + (8 * c) * 33 + n;
        v4u o; o.x = pk2(s[0 * 33], s[1 * 33]); o.y = pk2(s[2 * 33], s[3 * 33]); o.z = pk2(s[4 * 33], s[5 * 33]); o.w = pk2(s[6 * 33], s[7 * 33]);
        *(GAS v4u*)(WT + (orow0 + n) * (size_t)K + k0 + 8 * c) = o; }
    LDS_WAIT(); asm volatile("" ::: "memory");
}
__device__ __forceinline__ void rms_row_to_bf16(const float* xrow, const float* g, bf16* orow, int lane) {
    const f32x4* xr = (const f32x4*)xrow + lane; const f32x4* gr = (const f32x4*)g + lane;
    f32x4 v[4]; float s = 0.f;
#pragma unroll
    for (int j = 0; j < 4; ++j) { v[j] = xr[64 * j]; s += (v[j].x * v[j].x + v[j].y * v[j].y) + (v[j].z * v[j].z + v[j].w * v[j].w); }
    const float rs = rsqrtf(wave_sum(s) * (1.0f / DM) + EPS);
    unsigned long long* o8 = (unsigned long long*)orow + lane;
#pragma unroll
    for (int j = 0; j < 4; ++j) { const f32x4 gg = gr[64 * j]; o8[64 * j] = (unsigned long long)pk2(v[j].x * rs * gg.x, v[j].y * rs * gg.y) | ((unsigned long long)pk2(v[j].z * rs * gg.z, v[j].w * rs * gg.w) << 32); }
}
struct In {
    const float *x, *mem; const int* positions; const float *norm_mix_g, *w_in, *lq1, *lk1, *lq2, *lk2, *diff_norm_g, *w_alpha2, *b_alpha, *gla_norm_g, *w_out, *norm_cross_g, *norm_mem_g,
        *w_cq, *w_ck, *w_cv, *w_co, *norm_ffn_g, *w_router, *b_router, *w_up, *b_up, *w_down, *b_down, *norm_final_g;
};
__device__ __forceinline__ void p0_prologue(Frame& F, const In& I) {
    LAS float* scr = (LAS float*)(F.lds + RING_OFF + F.wave * 16384);
    const int gw = F.vcu * NWAVES + F.wave, NGW = F.G * NWAVES, lane = lane_here();
    unsigned char* ws = F.ws;
    constexpr int I_IN = 16 * 96, I_SQ = 16 * 32, I_UP = 32 * 16 * 64, I_DN = 32 * 16 * 32;
    constexpr int NITEMS = I_IN + 5 * I_SQ + I_UP + I_DN;
    for (int it = gw; it < NITEMS; it += NGW) {
        int r = it;
        if (r < I_IN) { p0_transpose_item(I.w_in, INW, nullptr, (bf16*)(ws + WS_WINT), DM, 64 * (r / 96), 32 * (r % 96), (size_t)32 * (r % 96), scr, lane); continue; } r -= I_IN;
        if (r < 5 * I_SQ) { const int w = r / I_SQ; r -= w * I_SQ;
            const float* W = w == 0 ? I.w_out : w == 1 ? I.w_cq : w == 2 ? I.w_ck : w == 3 ? I.w_cv : I.w_co;
            bf16* WT = (bf16*)(ws + (w == 0 ? WS_WOUT : w == 1 ? WS_WCQ : w == 2 ? WS_WCK : w == 3 ? WS_WCV : WS_WCO));
            p0_transpose_item(W, DM, w == 1 ? I.norm_cross_g : nullptr, WT, DM, 64 * (r / 32), 32 * (r % 32), (size_t)32 * (r % 32), scr, lane); continue; } r -= 5 * I_SQ;
        if (r < I_UP) { const int e = r / (16 * 64); r -= e * (16 * 64); const int n0 = 32 * (r % 64);
            const size_t orow = (size_t)e * 2048 + ((n0 & 1023) >> 7) * 256 + (n0 >> 10) * 128 + (n0 & 127);
            p0_transpose_item(I.w_up + (size_t)e * DM * 2048, 2048, I.norm_ffn_g, (bf16*)(ws + WS_WUP), DM, 64 * (r / 64), n0, orow, scr, lane); continue; } r -= I_UP;
        { const int e = r / (16 * 32); r -= e * (16 * 32);
            p0_transpose_item(I.w_down + (size_t)e * DM * DM, DM, nullptr, (bf16*)(ws + WS_WDN), DM, 64 * (r / 32), 32 * (r % 32), (size_t)e * 1024 + 32 * (r % 32), scr, lane); }
    }
    const int gt = F.vcu * (NWAVES * 64) + F.tid, NGT = F.G * NWAVES * 64;
    for (int idx = gt; idx < 256 * DM; idx += NGT) { const int j = idx >> 10, k = idx & 1023; const float* wr = I.w_in + (size_t)k * INW + 3072; float s = 0.f;
#pragma unroll
        for (int r = 0; r < 16; ++r) s += wr[r] * I.w_alpha2[r * 256 + j];
        ((bf16*)(ws + WS_WINT))[(size_t)(3072 + j) * DM + k] = (bf16)f2bf(s); }
    for (int idx = gt; idx < DM * NEXP; idx += NGT) ((float*)(ws + WS_WR))[idx] = I.w_router[idx] * I.norm_ffn_g[idx >> 5];
    for (int idx = gt; idx < NTOK * 8; idx += NGT) { const int tok = idx >> 3, i = idx & 7;
        const double inv = exp(-(double)i * 0.125 * 13.122363377404328); const double ang = (double)I.positions[tok] * inv;
        const double red = ang - rint(ang * 0.15915494309189535) * 6.283185307179586; const float rf = (float)red;
        float* cs = (float*)(ws + WS_CS) + (size_t)tok * 16; cs[i] = cosf(rf); cs[8 + i] = sinf(rf); }
    for (int m = gw; m < NTOK + NMEM; m += NGW) {
        if (m < NTOK) rms_row_to_bf16(I.x + (size_t)m * DM, I.norm_mix_g, (bf16*)(ws + WS_HN) + (size_t)m * DM, lane);
        else rms_row_to_bf16(I.mem + (size_t)(m - NTOK) * DM, I.norm_mem_g, (bf16*)(ws + WS_MN) + (size_t)(m - NTOK) * DM, lane);
    }
}

constexpr int DA_KBUF = 8192, DA_VBUF = 10240, DA_VOFF = 2 * DA_KBUF;
__device__ __forceinline__ void diffattn_unit(Frame& F, const bf16* P, const bf16* VT, bf16* CAT, const float* gdiff, float lam, int b, int h, int qblk) {
    const int lane = lane_here(), wave = F.wave, tid = F.tid, l15 = lane & 15, g = lane >> 4;
    LAS unsigned char* lds = F.lds + RING_OFF;
    const int q0 = qblk * 128 + wave * 16;
    const size_t tokq = (size_t)b * SEQ + q0 + l15;
    bf16x8 qf[2][2];
#pragma unroll
    for (int c = 0; c < 2; ++c)
#pragma unroll
        for (int ks = 0; ks < 2; ++ks) qf[c][ks] = *(const bf16x8*)(P + tokq * PW + h * 128 + c * 64 + ks * 32 + g * 8);
    f32x4 o[2][8];
#pragma unroll
    for (int c = 0; c < 2; ++c)
#pragma unroll
        for (int k = 0; k < 8; ++k) o[c][k] = (f32x4){0.f, 0.f, 0.f, 0.f};
    float mrun[2] = {-INFINITY, -INFINITY}, lsum[2] = {0.f, 0.f};
    const int nk = q0 + 16;
    const int nt = 4 * qblk + 4;
    const int skey = tid >> 4, sch = tid & 15, vrow = tid >> 2, vpc = tid & 3;
    const bf16* ksrc = P + ((size_t)b * SEQ + skey) * PW + 512 + h * 128 + sch * 8;
    const bf16* vsrc = VT + (size_t)(h * 128 + vrow) * NTOK + (size_t)b * SEQ + vpc * 8;
    const int kdst = skey * 256 + ((sch ^ (skey & 15)) * 16), vdst = DA_VOFF + vrow * 80 + vpc * 16;
    int koff[2][2];
#pragma unroll
    for (int c = 0; c < 2; ++c)
#pragma unroll
        for (int ks = 0; ks < 2; ++ks) koff[c][ks] = l15 * 256 + (((c * 8 + ks * 4 + g) ^ l15) * 16);
    const int voff = DA_VOFF + l15 * 80 + g * 8;
    v4u sk = *(const v4u*)ksrc, sv = *(const v4u*)vsrc;
    *(LAS v4u*)(lds + kdst) = sk; *(LAS v4u*)(lds + vdst) = sv;
    __syncthreads();
    for (int t = 0; t < nt; ++t) {
        const int key0 = t * 32, buf = t & 1;
        if (t + 1 < nt) { sk = *(const v4u*)(ksrc + (size_t)(key0 + 32) * PW); sv = *(const v4u*)(vsrc + key0 + 32); }
        if (key0 < nk) {
            const LAS unsigned char* kb = lds + buf * DA_KBUF; const LAS unsigned char* vb = lds + buf * DA_VBUF + voff;
            f32x4 s[2][2];
#pragma unroll
            for (int c = 0; c < 2; ++c)
#pragma unroll
                for (int s2 = 0; s2 < 2; ++s2) { f32x4 a = (f32x4){0.f, 0.f, 0.f, 0.f};
#pragma unroll
                    for (int ks = 0; ks < 2; ++ks) { const bf16x8 kf = *(const LAS bf16x8*)(kb + s2 * 4096 + koff[c][ks]); a = mfma16(kf, qf[c][ks], a); }
                    s[c][s2] = a; }
            if (key0 + 31 > q0) {
                const int qrow = q0 + l15;
#pragma unroll
                for (int c = 0; c < 2; ++c)
#pragma unroll
                    for (int s2 = 0; s2 < 2; ++s2)
#pragma unroll
                        for (int r = 0; r < 4; ++r) if (key0 + s2 * 16 + 4 * g + r > qrow) s[c][s2][r] = -INFINITY;
            }
            float mnew[2]; bool grow = false;
#pragma unroll
            for (int c = 0; c < 2; ++c) {
                float mx = fmaxf(fmaxf(fmaxf(s[c][0][0], s[c][0][1]), fmaxf(s[c][0][2], s[c][0][3])), fmaxf(fmaxf(s[c][1][0], s[c][1][1]), fmaxf(s[c][1][2], s[c][1][3])));
                mx = fmaxf(mx, __shfl_xor(mx, 16)); mx = fmaxf(mx, __shfl_xor(mx, 32));
                mnew[c] = fmaxf(mrun[c], mx); grow = grow || (mnew[c] > mrun[c]); }
            if (__any(grow)) {
#pragma unroll
                for (int c = 0; c < 2; ++c) { const float alpha = __builtin_amdgcn_exp2f(mrun[c] - mnew[c]); mrun[c] = mnew[c]; lsum[c] *= alpha;
#pragma unroll
                    for (int k = 0; k < 8; ++k) o[c][k] = o[c][k] * alpha; }
            }
            bf16x8 pb[2];
#pragma unroll
            for (int c = 0; c < 2; ++c) { float ps = 0.f;
#pragma unroll
                for (int s2 = 0; s2 < 2; ++s2)
#pragma unroll
                    for (int r = 0; r < 4; ++r) { const float p = __builtin_amdgcn_exp2f(s[c][s2][r] - mrun[c]); s[c][s2][r] = p; ps += p; }
                lsum[c] += ps;
                v4u w; w.x = pg8::cvtpk(s[c][0][0], s[c][0][1]); w.y = pg8::cvtpk(s[c][0][2], s[c][0][3]); w.z = pg8::cvtpk(s[c][1][0], s[c][1][1]); w.w = pg8::cvtpk(s[c][1][2], s[c][1][3]);
                pb[c] = __builtin_bit_cast(bf16x8, w); }
#pragma unroll
            for (int k = 0; k < 8; ++k) { const v2u v0 = *(const LAS v2u*)(vb + k * 1280), v1 = *(const LAS v2u*)(vb + k * 1280 + 32);
                v4u vv; vv.x = v0.x; vv.y = v0.y; vv.z = v1.x; vv.w = v1.y; const bf16x8 vf = __builtin_bit_cast(bf16x8, vv);
                o[0][k] = mfma16(vf, pb[0], o[0][k]); o[1][k] = mfma16(vf, pb[1], o[1][k]); }
        }
        if (t + 1 < nt) { *(LAS v4u*)(lds + (buf ^ 1) * DA_KBUF + kdst) = sk; *(LAS v4u*)(lds + (buf ^ 1) * DA_VBUF + vdst) = sv; }
        __syncthreads();
    }
    float l0 = lsum[0], l1 = lsum[1];
    l0 += __shfl_xor(l0, 16); l0 += __shfl_xor(l0, 32); l1 += __shfl_xor(l1, 16); l1 += __shfl_xor(l1, 32);
    const float i0 = 1.0f / l0, i1 = lam / l1; float ss = 0.f;
#pragma unroll
    for (int k = 0; k < 8; ++k)
#pragma unroll
        for (int r = 0; r < 4; ++r) { const float v = o[0][k][r] * i0 - o[1][k][r] * i1; o[0][k][r] = v; ss += v * v; }
    ss += __shfl_xor(ss, 16); ss += __shfl_xor(ss, 32);
    const float rs = rsqrtf(ss * (1.0f / 128.0f) + EPS) * 0.8f;
    bf16* op = CAT + tokq * DM + h * 128 + 4 * g;
#pragma unroll
    for (int k = 0; k < 8; ++k) { const f32x4 gg = *(const f32x4*)(gdiff + k * 16 + 4 * g); f32x4 v = o[0][k] * rs; v = v * gg; pg8::st_bf4(op + k * 16, v); }
}

__device__ __forceinline__ bf16x8 pack8(const f32x4& a, const f32x4& b) { v4u w; w.x = pg8::cvtpk(a[0], a[1]); w.y = pg8::cvtpk(a[2], a[3]); w.z = pg8::cvtpk(b[0], b[1]); w.w = pg8::cvtpk(b[2], b[3]); return __builtin_bit_cast(bf16x8, w); }
constexpr int GL_QI = 0, GL_KI = 9216, GL_IMG = 18432, GL_EL = 2 * GL_IMG, GL_OB = GL_EL + 512, GL_OBS = 17408, GL_PS = GL_OB + 2 * GL_OBS, GL_END = GL_PS + 4096;
__device__ __forceinline__ bf16x8 ldfrag(const LAS unsigned char* p) { const v2u a = *(const LAS v2u*)p, b = *(const LAS v2u*)(p + 32); v4u w; w.x = a.x; w.y = a.y; w.z = b.x; w.w = b.y; return __builtin_bit_cast(bf16x8, w); }
__device__ __forceinline__ void gla_unit(Frame& F, const bf16* P, const float* Bc, const bf16* GVT, bf16* CAT, const float* ggla, int b, int h) {
    const int lane = lane_here(), l15 = lane & 15, g = lane >> 4, eb = F.wave, tid = F.tid;
    LAS unsigned char* lds = F.lds + RING_OFF;
    const f32x4 zero4 = {0.f, 0.f, 0.f, 0.f};
    f32x4 S[4] = {zero4, zero4, zero4, zero4};
    bf16x8 If[4];
#pragma unroll
    for (int db = 0; db < 4; ++db) { const int ks = db >> 1;
#pragma unroll
        for (int j = 0; j < 8; ++j) { const int dp = 32 * ks + (j < 4 ? 4 * g + j : 16 + 4 * g + j - 4); If[db][j] = (dp == 16 * db + l15) ? (short)0x3F80 : (short)0; } }
    const int st = tid >> 3, sp = tid & 7, opc = tid & 15;
    const size_t tokb = (size_t)b * SEQ;
    const bf16* qsrc = P + (tokb + st) * PW + 1536 + h * 64 + sp * 8;
    const float* bsrc = Bc + (tokb + st) * 256 + h * 64 + sp * 8;
    const bf16* Vrow = GVT + (size_t)(h * 128 + 16 * eb + l15) * NTOK + tokb + 4 * g;
    const f32x4 gg0 = *(const f32x4*)(ggla + opc * 8), gg1 = *(const f32x4*)(ggla + opc * 8 + 4);
    const int foff = l15 * 144 + 8 * g;
    v4u rq = *(const v4u*)qsrc, rk = *(const v4u*)(qsrc + 256); f32x4 rb0 = *(const f32x4*)bsrc, rb1 = *(const f32x4*)(bsrc + 4);
#define GLA_STAGE(par) do { \
        float ee[8]; _Pragma("unroll") for (int i = 0; i < 4; ++i) { ee[i] = __expf(rb0[i]); ee[4 + i] = __expf(rb1[i]); } \
        const unsigned qa[4] = {rq.x, rq.y, rq.z, rq.w}, ka[4] = {rk.x, rk.y, rk.z, rk.w}; v4u wq, wk; unsigned* wqp = (unsigned*)&wq; unsigned* wkp = (unsigned*)&wk; \
        _Pragma("unroll") for (int i = 0; i < 4; ++i) { const float q0 = __builtin_bit_cast(float, qa[i] << 16), q1 = __builtin_bit_cast(float, qa[i] & 0xffff0000u), k0 = __builtin_bit_cast(float, ka[i] << 16), k1 = __builtin_bit_cast(float, ka[i] & 0xffff0000u); \
            wqp[i] = pg8::cvtpk(q0 * ee[2 * i], q1 * ee[2 * i + 1]); wkp[i] = pg8::cvtpk(k0 * __builtin_amdgcn_rcpf(ee[2 * i]), k1 * __builtin_amdgcn_rcpf(ee[2 * i + 1])); } \
        *(LAS v4u*)(lds + (par) * GL_IMG + GL_QI + st * 144 + sp * 16) = wq; *(LAS v4u*)(lds + (par) * GL_IMG + GL_KI + st * 144 + sp * 16) = wk; \
        if (st == 63) { *(LAS f32x4*)(lds + GL_EL + (par) * 256 + sp * 32) = (f32x4){ee[0], ee[1], ee[2], ee[3]}; *(LAS f32x4*)(lds + GL_EL + (par) * 256 + sp * 32 + 16) = (f32x4){ee[4], ee[5], ee[6], ee[7]}; } } while (0)
    GLA_STAGE(0);
    __syncthreads();
    for (int c = 0; c < SEQ / 64; ++c) {
        const int par = c & 1; const size_t tok0 = tokb + c * 64;
        if (c + 1 < SEQ / 64) { rq = *(const v4u*)(qsrc + (size_t)(c + 1) * 64 * PW); rk = *(const v4u*)(qsrc + (size_t)(c + 1) * 64 * PW + 256);
            rb0 = *(const f32x4*)(bsrc + (size_t)(c + 1) * 64 * 256); rb1 = *(const f32x4*)(bsrc + (size_t)(c + 1) * 64 * 256 + 4); }
        bf16x8 VF[2];
#pragma unroll
        for (int ss = 0; ss < 2; ++ss) { const bf16* vp = Vrow + c * 64 + 32 * ss; const v2u v0 = *(const v2u*)vp, v1 = *(const v2u*)(vp + 16); v4u vv; vv.x = v0.x; vv.y = v0.y; vv.z = v1.x; vv.w = v1.y; VF[ss] = __builtin_bit_cast(bf16x8, vv); }
        v4u rg[2];
#pragma unroll
        for (int i = 0; i < 2; ++i) rg[i] = *(const v4u*)(P + (tok0 + ((tid + 512 * i) >> 4)) * PW + 2560 + h * 128 + opc * 8);
        const LAS unsigned char* qi = lds + par * GL_IMG + GL_QI + foff; const LAS unsigned char* ki = lds + par * GL_IMG + GL_KI + foff;
        bf16x8 qf[4][2], kf[4][2];
#pragma unroll
        for (int blk = 0; blk < 4; ++blk)
#pragma unroll
            for (int ks = 0; ks < 2; ++ks) { qf[blk][ks] = ldfrag(qi + blk * 2304 + ks * 64); kf[blk][ks] = ldfrag(ki + blk * 2304 + ks * 64); }
        const bf16x8 SF0 = pack8(S[0], S[1]), SF1 = pack8(S[2], S[3]);
        f32x4 O[4];
#pragma unroll
        for (int tb = 0; tb < 4; ++tb) { f32x4 o = mfma16(qf[tb][0], SF0, zero4); o = mfma16(qf[tb][1], SF1, o);
#pragma unroll
            for (int ss = 0; ss < 2; ++ss) if (2 * ss <= tb) { f32x4 a2[2];
#pragma unroll
                for (int hh = 0; hh < 2; ++hh) { const int sb = 2 * ss + hh; f32x4 a = zero4;
                    if (sb <= tb) { a = mfma16(kf[sb][0], qf[tb][0], zero4); a = mfma16(kf[sb][1], qf[tb][1], a);
                        if (sb == tb) {
#pragma unroll
                            for (int r = 0; r < 4; ++r) if (4 * g + r > l15) a[r] = 0.f; } }
                    a2[hh] = a; }
                o = mfma16(pack8(a2[0], a2[1]), VF[ss], o); }
            O[tb] = o; }
#pragma unroll
        for (int db = 0; db < 4; ++db) { f32x4 u = S[db];
#pragma unroll
            for (int ss = 0; ss < 2; ++ss) { const f32x4 t0 = mfma16(kf[2 * ss][db >> 1], If[db], zero4), t1 = mfma16(kf[2 * ss + 1][db >> 1], If[db], zero4); u = mfma16(pack8(t0, t1), VF[ss], u); }
            const f32x4 el = *(const LAS f32x4*)(lds + GL_EL + par * 256 + (16 * db + 4 * g) * 4);
            S[db] = u * el; }
        LAS unsigned char* ob = lds + GL_OB + par * GL_OBS; LAS float* ps = (LAS float*)(lds + GL_PS + par * 2048);
#pragma unroll
        for (int tb = 0; tb < 4; ++tb)
#pragma unroll
            for (int r = 0; r < 4; ++r) { const int t = 16 * tb + 4 * g + r; const float ov = O[tb][r]; float q = ov * ov; q += __shfl_xor(q, 1); q += __shfl_xor(q, 2); q += __shfl_xor(q, 4); q += __shfl_xor(q, 8);
                if (l15 == 0) ps[t * 8 + eb] = q;
                *(LAS bf16*)(ob + t * 272 + (16 * eb + l15) * 2) = (bf16)f2bf(ov); }
        if (c + 1 < SEQ / 64) GLA_STAGE(par ^ 1);
        __syncthreads();
#pragma unroll
        for (int i = 0; i < 2; ++i) { const int ot = (tid + 512 * i) >> 4; const f32x4 p0 = *(const LAS f32x4*)(ps + ot * 8), p1 = *(const LAS f32x4*)(ps + ot * 8 + 4);
            const float ss = ((p0[0] + p0[1]) + (p0[2] + p0[3])) + ((p1[0] + p1[1]) + (p1[2] + p1[3])); const float rs = rsqrtf(ss * (1.0f / 128.0f) + EPS);
            const v4u ov = *(const LAS v4u*)(ob + ot * 272 + opc * 16); const unsigned oa[4] = {ov.x, ov.y, ov.z, ov.w}, ga[4] = {rg[i].x, rg[i].y, rg[i].z, rg[i].w};
            const float gn[8] = {gg0[0], gg0[1], gg0[2], gg0[3], gg1[0], gg1[1], gg1[2], gg1[3]}; v4u w; unsigned* wp = (unsigned*)&w;
#pragma unroll
            for (int j = 0; j < 4; ++j) { const float o0 = __builtin_bit_cast(float, oa[j] << 16), o1 = __builtin_bit_cast(float, oa[j] & 0xffff0000u), g0 = __builtin_bit_cast(float, ga[j] << 16), g1 = __builtin_bit_cast(float, ga[j] & 0xffff0000u);
                wp[j] = pg8::cvtpk(o0 * rs * gn[2 * j] * (g0 / (1.0f + __expf(-g0))), o1 * rs * gn[2 * j + 1] * (g1 / (1.0f + __expf(-g1)))); }
            *(v4u*)(CAT + (tok0 + ot) * DM + 512 + h * 128 + opc * 8) = w; }
    }
#undef GLA_STAGE
    __syncthreads();
}

__device__ __forceinline__ void router_phase(Frame& F, const float* X2, const float* WR, const float* b_router, float* rs2, float* gate, unsigned* assign, unsigned* list, gu32* cnt) {
    LAS float* xs = (LAS float*)(F.lds + RING_OFF);
    LAS float* wsh = xs + 64 * 129;
    LAS float* lg = wsh + 128 * 32;
    const int tid = F.tid, t = tid & 63, eg = tid >> 6;
    for (int blk = F.vcu; blk < NTOK / 64; blk += F.G) {
        const size_t tok0 = (size_t)blk * 64;
        f32x4 acc = (f32x4){0.f, 0.f, 0.f, 0.f}; float ssq = 0.f;
        for (int kc = 0; kc < DM; kc += 128) {
            { const int row = tid >> 3;
#pragma unroll
              for (int i = 0; i < 4; ++i) { const int col = i * 32 + (tid & 7) * 4; const f32x4 v = *(const f32x4*)(X2 + (tok0 + row) * DM + kc + col);
                  LAS float* d = xs + row * 129 + col; d[0] = v.x; d[1] = v.y; d[2] = v.z; d[3] = v.w; }
#pragma unroll
              for (int i = 0; i < 2; ++i) { const int idx = (i * 512 + tid) * 4; *(LAS f32x4*)(wsh + idx) = *(const f32x4*)(WR + (size_t)kc * 32 + idx); } }
            __syncthreads();
            const LAS float* xr = xs + t * 129;
#pragma unroll 8
            for (int k = 0; k < 128; ++k) { const float xv = xr[k]; const f32x4 w = *(const LAS f32x4*)(wsh + k * 32 + eg * 4); acc = acc + w * xv; ssq += xv * xv; }
            __syncthreads();
        }
        const float rs = rsqrtf(ssq * (1.0f / DM) + EPS);
#pragma unroll
        for (int i = 0; i < 4; ++i) lg[t * 33 + eg * 4 + i] = acc[i] * rs + b_router[eg * 4 + i];
        __syncthreads();
        if (tid < 64) {
            float lv[32];
#pragma unroll
            for (int e = 0; e < 32; ++e) lv[e] = lg[t * 33 + e];
            float tv[4]; int te[4];
#pragma unroll
            for (int k = 0; k < 4; ++k) { float best = -INFINITY; int bi = 0;
#pragma unroll
                for (int e = 0; e < 32; ++e) if (lv[e] > best) { best = lv[e]; bi = e; }
                tv[k] = best; te[k] = bi;
#pragma unroll
                for (int e = 0; e < 32; ++e) if (e == bi) lv[e] = -INFINITY; }
            const float e1 = __expf(tv[1] - tv[0]), e2 = __expf(tv[2] - tv[0]), e3 = __expf(tv[3] - tv[0]); const float inv = 1.0f / (1.0f + e1 + e2 + e3);
            const float gv[4] = {inv, e1 * inv, e2 * inv, e3 * inv};
            const size_t tok = tok0 + t; rs2[tok] = rs;
            LAS unsigned* hist = (LAS unsigned*)(lg + 64 * 33); LAS unsigned* gbase = hist + 32;
            if (t < 32) hist[t] = 0u;
            __builtin_amdgcn_wave_barrier(); LDS_WAIT();
            unsigned lpos[4];
#pragma unroll
            for (int k = 0; k < 4; ++k) lpos[k] = __hip_atomic_fetch_add(hist + te[k], 1u, __ATOMIC_RELAXED, __HIP_MEMORY_SCOPE_WORKGROUP);
            __builtin_amdgcn_wave_barrier(); LDS_WAIT();
            if (t < 32) { const unsigned n = hist[t]; gbase[t] = n ? __hip_atomic_fetch_add(cnt + 64 * t, n, RLX_AGENT) : 0u; }
            __builtin_amdgcn_wave_barrier(); LDS_WAIT();
#pragma unroll
            for (int k = 0; k < 4; ++k) { const unsigned pos = gbase[te[k]] + lpos[k]; list[(size_t)te[k] * NTOK + pos] = (unsigned)tok;
                assign[tok * 4 + k] = ((unsigned)te[k] << 16) | pos; gate[tok * 4 + k] = gv[k]; }
        }
        __syncthreads();
    }
}
__device__ __forceinline__ int moe_tables(Frame& F) {
    LAS unsigned char* tile_e = F.lds + TAB_OFF; LAS int* tstart = (LAS int*)(F.lds + TAB_TSTART); LAS int* lc = (LAS int*)(F.lds + TAB_CNT);
    if (F.tid < 32) lc[F.tid] = (int)__hip_atomic_load(F.ctl + CW_CNT + 64 * F.tid, RLX_AGENT);
    __syncthreads();
    if (F.tid == 0) { int s = 0; for (int e = 0; e < 32; ++e) { tstart[e] = s; s += (lc[e] + 255) >> 8; } tstart[32] = s; }
    __syncthreads();
    const int T = tstart[32];
    for (int i = F.tid; i < T; i += 512) { int e = 0;
#pragma unroll
        for (int k = 1; k < 32; ++k) e += (tstart[k] <= i) ? 1 : 0;
        tile_e[i] = (unsigned char)e; }
    __syncthreads();
    return T;
}
__device__ __forceinline__ void gather_phase(Frame& F, const float* X2, const unsigned* list, int* rowtok, bf16* XG) {
    const int T = moe_tables(F);
    const LAS unsigned char* tile_e = F.lds + TAB_OFF; const LAS int* tstart = (const LAS int*)(F.lds + TAB_TSTART); const LAS int* lc = (const LAS int*)(F.lds + TAB_CNT);
    const int gw = F.vcu * NWAVES + F.wave, NGW = F.G * NWAVES, lane = lane_here();
    for (int r = gw; r < T * 256; r += NGW) { const int e = tile_e[r >> 8]; const int pos = r - tstart[e] * 256; const int tok = pos < lc[e] ? (int)list[(size_t)e * NTOK + pos] : -1;
        if (lane == 0) rowtok[r] = tok;
        unsigned long long* o8 = (unsigned long long*)(XG + (size_t)r * DM) + lane;
        if (tok >= 0) { const f32x4* xr = (const f32x4*)(X2 + (size_t)tok * DM) + lane;
#pragma unroll
            for (int j = 0; j < 4; ++j) { const f32x4 v = xr[64 * j]; o8[64 * j] = (unsigned long long)pk2(v.x, v.y) | ((unsigned long long)pk2(v.z, v.w) << 32); } }
        else {
#pragma unroll
            for (int j = 0; j < 4; ++j) o8[64 * j] = 0ull; } }
}
__device__ __forceinline__ void final_phase(Frame& F, float* out, const bf16* Y, const float* gate, const unsigned* assign, const float* gfin) {
    (void)moe_tables(F);
    const LAS int* tstart = (const LAS int*)(F.lds + TAB_TSTART);
    const int gw = F.vcu * NWAVES + F.wave, NGW = F.G * NWAVES, lane = lane_here();
    for (int tok = gw; tok < NTOK; tok += NGW) {
        f32x4* xr = (f32x4*)(out + (size_t)tok * DM) + lane; f32x4 v[4];
#pragma unroll
        for (int j = 0; j < 4; ++j) v[j] = xr[64 * j];
#pragma unroll
        for (int k = 0; k < 4; ++k) { const unsigned a = assign[(size_t)tok * 4 + k]; const float gk = gate[(size_t)tok * 4 + k]; const size_t row = (size_t)tstart[a >> 16] * 256 + (a & 0xffffu);
            const v2u* yr = (const v2u*)(Y + row * DM) + lane;
#pragma unroll
            for (int j = 0; j < 4; ++j) { const v2u w = yr[64 * j]; v[j].x += gk * __builtin_bit_cast(float, w.x << 16); v[j].y += gk * __builtin_bit_cast(float, w.x & 0xffff0000u);
                v[j].z += gk * __builtin_bit_cast(float, w.y << 16); v[j].w += gk * __builtin_bit_cast(float, w.y & 0xffff0000u); } }
        float s = 0.f;
#pragma unroll
        for (int j = 0; j < 4; ++j) s += (v[j].x * v[j].x + v[j].y * v[j].y) + (v[j].z * v[j].z + v[j].w * v[j].w);
        const float rs = rsqrtf(wave_sum(s) * (1.0f / DM) + EPS);
#pragma unroll
        for (int j = 0; j < 4; ++j) { const f32x4 gg = ((const f32x4*)gfin)[lane + 64 * j]; xr[64 * j] = v[j] * rs * gg; }
    }
}

constexpr int NPHASE = 13;
struct Args { const void* in[28]; float* out; unsigned char* ws; int ph_lo, ph_hi; };
__global__ void __launch_bounds__(NWAVES * 64, 2) mk_fwd(Args args) {
    extern __shared__ __attribute__((aligned(16))) unsigned char lds[];
    Frame F;
    F.lds = (LAS unsigned char*)lds;
    F.MISC = (volatile LAS unsigned*)(F.lds + MISC_OFF);
    F.tid = threadIdx.x; F.lane = F.tid & 63; F.wave = __builtin_amdgcn_readfirstlane(F.tid >> 6);
    F.G = gridDim.x; { const int bx = blockIdx.x; F.vcu = (F.G % 8 == 0) ? (bx % 8) * (F.G / 8) + bx / 8 : bx; }
    F.ws = args.ws; F.out = args.out; F.ctl = (gu32*)(args.ws + WS_CTL);
    unsigned char* ws = args.ws;
    typedef const void* const volatile __attribute__((address_space(4))) kargp_t;
    kargp_t* const kargs = (kargp_t*)__builtin_amdgcn_kernarg_segment_ptr();
#define INP(k) ((const float*)kargs[k])
    for (int u = F.tid; u < (LDS_BYTES - LDSCTL_OFF) / 4; u += NWAVES * 64) ((LAS unsigned*)(F.lds + LDSCTL_OFF))[u] = 0u;
    __syncthreads();
    const int lo = args.ph_lo, hi = args.ph_hi;
    const bool single = (hi - lo) > 1;
    XcdBarrier bar; bar.bar = (unsigned*)(F.ctl + CW_BAR); bar.x = 0; bar.st = nullptr;
    if (single) bar = xcd_barrier_post((unsigned*)(F.ctl + CW_BAR), F.MISC + 8);
#define IN(k) (lo <= (k) && (k) < hi)
#if defined(PROBE_K0)
    LAS unsigned long long* tsl = (LAS unsigned long long*)(F.lds + TS_OFF);
    if (blockIdx.x == 0 && F.tid == 0) tsl[0] = rt();
#define SEAM(k) do { if (IN(k) && IN((k) + 1)) xcd_barrier(bar); if (blockIdx.x == 0 && F.tid == 0) tsl[(k) + 1] = rt(); } while (0)
#else
#define SEAM(k) do { if (IN(k) && IN((k) + 1)) xcd_barrier(bar); } while (0)
#endif
    typedef pg8::bf16_t hb;
    const int bx = (int)blockIdx.x;

    if (IN(0)) { In I;
        I.x = (const float*)INP(0);
        I.mem = (const float*)INP(1);
        I.positions = (const int*)INP(2);
        I.norm_mix_g = (const float*)INP(3);
        I.w_in = (const float*)INP(4);
        I.lq1 = (const float*)INP(5);
        I.lk1 = (const float*)INP(6);
        I.lq2 = (const float*)INP(7);
        I.lk2 = (const float*)INP(8);
        I.diff_norm_g = (const float*)INP(9);
        I.w_alpha2 = (const float*)INP(10);
        I.b_alpha = (const float*)INP(11);
        I.gla_norm_g = (const float*)INP(12);
        I.w_out = (const float*)INP(13);
        I.norm_cross_g = (const float*)INP(14);
        I.norm_mem_g = (const float*)INP(15);
        I.w_cq = (const float*)INP(16);
        I.w_ck = (const float*)INP(17);
        I.w_cv = (const float*)INP(18);
        I.w_co = (const float*)INP(19);
        I.norm_ffn_g = (const float*)INP(20);
        I.w_router = (const float*)INP(21);
        I.b_router = (const float*)INP(22);
        I.w_up = (const float*)INP(23);
        I.b_up = (const float*)INP(24);
        I.w_down = (const float*)INP(25);
        I.b_down = (const float*)INP(26);
        I.norm_final_g = (const float*)INP(27);
        p0_prologue(F, I); }
    SEAM(0);
    if (IN(1)) {
        { pg8::Gemm g{(const hb*)(ws + WS_HN), (const hb*)(ws + WS_WINT), NTOK, 3328, DM, DM, DM}; pg8::OrderMap S; S.init(128, 9, F.G, bx);
          pg8::EpiProj E{(hb*)(ws + WS_P), (float*)(ws + WS_LA), (const float*)(ws + WS_CS), INP(11)};
          pg8::gemm_phase<pg8::EpiProj, pg8::OrderMap, true, true>(F.lds + RING_OFF, g, S, E); }
        { pg8::Gemm g{(const hb*)(ws + WS_WINT), (const hb*)(ws + WS_HN), 3328, NTOK, DM, DM, DM}; pg8::OrderVT S; S.init(128, F.G, bx);
          pg8::EpiPlain E{(hb*)(ws + WS_VT) - (size_t)1024 * NTOK, NTOK, 1.0f};
          pg8::gemm_phase<pg8::EpiPlain, pg8::OrderVT, true, true>(F.lds + RING_OFF, g, S, E); }
        { pg8::Gemm g{(const hb*)(ws + WS_MN), (const hb*)(ws + WS_WCK), NMEM, DM, DM, DM, DM}; pg8::StaticOrder S; S.init(NMEM, DM, F.G, bx);
          pg8::EpiPlain E{(hb*)(ws + WS_KX), DM, 1.0f};
          pg8::gemm_phase<pg8::EpiPlain, pg8::StaticOrder, true, true>(F.lds + RING_OFF, g, S, E); }
        { pg8::Gemm g{(const hb*)(ws + WS_WCV), (const hb*)(ws + WS_MN), DM, NMEM, DM, DM, DM}; pg8::StaticOrder S; S.init(DM, NMEM, F.G, (bx + 64) % F.G);
          pg8::EpiPlain E{(hb*)(ws + WS_VXT), NMEM, 1.0f};
          pg8::gemm_phase<pg8::EpiPlain, pg8::StaticOrder, true, true>(F.lds + RING_OFF, g, S, E); }
    }
    SEAM(1);
    if (IN(2)) {
        float lam;
        { const int ln = lane_here(); const float a = INP(5)[ln] * INP(6)[ln], c = INP(7)[ln] * INP(8)[ln]; lam = __expf(wave_sum(a)) - __expf(wave_sum(c)) + 0.2f; }
        LAS int* qslot = (LAS int*)(F.lds + TAB_OFF);
#if defined(PROBE_GLA)
        const unsigned long long p2t0 = rt();
#endif
        for (;;) {
            if (F.tid == 0) qslot[0] = (int)__hip_atomic_fetch_add(F.ctl + CW_Q2, 1u, RLX_AGENT);
            __syncthreads();
            const int u = qslot[0];
            __syncthreads();
            if (u >= 64 + 1024) break;
            if (u < 64) { gla_unit(F, (const bf16*)(ws + WS_P), (const float*)(ws + WS_LA), (const bf16*)(ws + WS_GVT), (bf16*)(ws + WS_CAT), INP(12), u >> 2, u & 3);
#if defined(PROBE_GLA)
                if (F.tid == 0) { const unsigned dtv = (unsigned)(rt() - p2t0); __hip_atomic_fetch_max(F.ctl + CW_PROBE, dtv, RLX_AGENT); }
#endif
            }
            else { const int v = u - 64, bh = v & 63, qb = 15 - (v >> 6);
                diffattn_unit(F, (const bf16*)(ws + WS_P), (const bf16*)(ws + WS_VT), (bf16*)(ws + WS_CAT), INP(9), lam, bh >> 2, bh & 3, qb); }
        }
    }
    SEAM(2);
    if (IN(3)) {
        pg8::Gemm g{(const hb*)(ws + WS_CAT), (const hb*)(ws + WS_WOUT), NTOK, DM, DM, DM, DM}; pg8::StaticOrder S; S.init(NTOK, DM, F.G, bx);
        pg8::EpiRes1 E{INP(0), F.out, (hb*)(ws + WS_X1B), (float*)(ws + WS_SSP1)};
        pg8::gemm_phase<pg8::EpiRes1, pg8::StaticOrder, true, true>(F.lds + RING_OFF, g, S, E);
    }
    SEAM(3);
    if (IN(4)) {
        pg8::Gemm g{(const hb*)(ws + WS_X1B), (const hb*)(ws + WS_WCQ), NTOK, DM, DM, DM, DM}; pg8::StaticOrder S; S.init(NTOK, DM, F.G, bx);
        pg8::EpiQX E{(hb*)(ws + WS_QX), (const float*)(ws + WS_SSP1)};
        pg8::gemm_phase<pg8::EpiQX, pg8::StaticOrder, true, true>(F.lds + RING_OFF, g, S, E);
    }
    SEAM(4);
    if (IN(5)) {
        pg8::Gemm g{(const hb*)(ws + WS_QX), (const hb*)(ws + WS_KX), NTOK, 256, 256, DM, DM}; pg8::OrderX1 S; S.init(F.G, bx);
        pg8::EpiSoftmax E{(hb*)(ws + WS_PX), (float*)(ws + WS_SSP1), (PG8_LAS float*)(F.lds + XCH_OFF)};
        pg8::gemm_phase<pg8::EpiSoftmax, pg8::OrderX1, true, true>(F.lds + RING_OFF, g, S, E);
    }
    SEAM(5);
    if (IN(6)) {
        pg8::Gemm g{(const hb*)(ws + WS_PX), (const hb*)(ws + WS_VXT), NTOK, 256, 256, DM, NMEM}; pg8::OrderX2 S; S.init(F.G, bx);
        pg8::EpiPV E{(hb*)(ws + WS_OX), (const float*)(ws + WS_SSP1)};
        pg8::gemm_phase<pg8::EpiPV, pg8::OrderX2, true, true>(F.lds + RING_OFF, g, S, E);
    }
    SEAM(6);
    if (IN(7)) {
        pg8::Gemm g{(const hb*)(ws + WS_OX), (const hb*)(ws + WS_WCO), NTOK, DM, DM, DM, DM}; pg8::StaticOrder S; S.init(NTOK, DM, F.G, bx);
        pg8::EpiRes2 E{F.out};
        pg8::gemm_phase<pg8::EpiRes2, pg8::StaticOrder, true, true>(F.lds + RING_OFF, g, S, E);
    }
    SEAM(7);
    if (IN(8)) router_phase(F, F.out, (const float*)(ws + WS_WR), INP(22), (float*)(ws + WS_RS2), (float*)(ws + WS_GATE), (unsigned*)(ws + WS_ASSIGN), (unsigned*)(ws + WS_LIST), F.ctl + CW_CNT);
    SEAM(8);
    if (IN(9)) gather_phase(F, F.out, (const unsigned*)(ws + WS_LIST), (int*)(ws + WS_ROWTOK), (bf16*)(ws + WS_XG));
    SEAM(9);
    if (IN(10)) {
        const int T = moe_tables(F);
        pg8::Gemm g{(const hb*)(ws + WS_XG), (const hb*)(ws + WS_WUP), T * 256, NEXP * 2048, DM, DM, DM}; pg8::MoeOrder S; S.init(T, 8, F.G, bx, (const PG8_LAS unsigned char*)(F.lds + TAB_OFF));
        pg8::EpiUp E{(hb*)(ws + WS_ACT), (const int*)(ws + WS_ROWTOK), (const float*)(ws + WS_RS2), INP(24)};
        pg8::gemm_phase<pg8::EpiUp, pg8::MoeOrder, true, true>(F.lds + RING_OFF, g, S, E);
    }
    SEAM(10);
    if (IN(11)) {
        const int T = moe_tables(F);
        pg8::Gemm g{(const hb*)(ws + WS_ACT), (const hb*)(ws + WS_WDN), T * 256, NEXP * 1024, DM, DM, DM}; pg8::MoeOrder S; S.init(T, 4, F.G, bx, (const PG8_LAS unsigned char*)(F.lds + TAB_OFF));
        pg8::EpiDown E{(hb*)(ws + WS_Y), INP(26)};
        pg8::gemm_phase<pg8::EpiDown, pg8::MoeOrder, true, true>(F.lds + RING_OFF, g, S, E);
    }
    SEAM(11);
    if (IN(12)) final_phase(F, F.out, (const bf16*)(ws + WS_Y), (const float*)(ws + WS_GATE), (const unsigned*)(ws + WS_ASSIGN), INP(27));
#if defined(PROBE_K0)
    if (blockIdx.x == 0 && F.tid == 0) { tsl[NPHASE] = rt();
        const int ks[2] = {PROBE_K0, PROBE_K1}; unsigned long long code = 0, mul = 1;
        for (int i = 0; i < 2; ++i) { unsigned long long dt = ks[i] < 100 ? tsl[ks[i] + 1] - tsl[ks[i]] : (unsigned long long)__hip_atomic_load(F.ctl + CW_PROBE + ks[i] - 100, RLX_AGENT);
            unsigned long long q = (dt + 800) / 1600; if (q > 63) q = 63; code += q * mul; mul *= 64; }
        const unsigned long long t0 = rt(), wait = code * 6400ull;
        while (rt() - t0 < wait) __builtin_amdgcn_s_sleep(32); }
#endif
#undef IN
#undef SEAM
}

#ifndef MK_N_LAUNCHES
#define MK_N_LAUNCHES 1
#endif
extern "C" void kernel_launch(void* const* d_in, const int* in_sizes, int n_in, void* d_out, int out_size, void* d_ws, size_t ws_size, hipStream_t stream) {
    static int grid = 0;
    if (grid == 0) {
        if (n_in != 28 || out_size != NTOK * DM || ws_size < WS_END) { fprintf(stderr, "kernel_launch: unexpected shapes: n_in %d out %d ws %zu (need %zu)\n", n_in, out_size, ws_size, (size_t)WS_END); grid = -1; return; }
        int dev = 0, cus = 0, per_cu = 0;
        if (hipGetDevice(&dev) != hipSuccess || hipDeviceGetAttribute(&cus, hipDeviceAttributeMultiprocessorCount, dev) != hipSuccess) { fprintf(stderr, "kernel_launch: device query failed\n"); grid = -1; return; }
        if (hipFuncSetAttribute((const void*)mk_fwd, hipFuncAttributeMaxDynamicSharedMemorySize, LDS_BYTES) != hipSuccess) { fprintf(stderr, "kernel_launch: hipFuncSetAttribute failed\n"); grid = -1; return; }
        if (hipOccupancyMaxActiveBlocksPerMultiprocessor(&per_cu, (const void*)mk_fwd, NWAVES * 64, LDS_BYTES) != hipSuccess || per_cu < 1) { fprintf(stderr, "kernel_launch: occupancy query reports %d workgroups per CU\n", per_cu); (void)hipGetLastError(); grid = -1; return; }
        grid = cus;
    }
    if (grid < 0) return;
    (void)hipMemsetAsync((char*)d_ws + WS_CTL, 0, CTL_ZERO_BYTES, stream);
    Args a{};
    for (int i = 0; i < 28; ++i) a.in[i] = d_in[i];
    a.out = (float*)d_out; a.ws = (unsigned char*)d_ws;
    if (MK_N_LAUNCHES == 1) { a.ph_lo = 0; a.ph_hi = NPHASE; hipLaunchKernelGGL(mk_fwd, dim3(grid), dim3(NWAVES * 64), LDS_BYTES, stream, a); }
    else for (int p = 0; p < NPHASE; ++p) { a.ph_lo = p; a.ph_hi = p + 1; hipLaunchKernelGGL(mk_fwd, dim3(grid), dim3(NWAVES * 64), LDS_BYTES, stream, a); }
}
```

```cpp
#include <hip/hip_runtime.h>
#include <cstdio>
#include <cstdint>
namespace pg8 {
#define PG8_LAS __attribute__((address_space(3)))
typedef unsigned short bf16_t;
typedef short bf16x8 __attribute__((ext_vector_type(8)));
typedef float f32x4 __attribute__((ext_vector_type(4)));
typedef unsigned u32x4 __attribute__((ext_vector_type(4)));
constexpr int BM = 256, BK = 64, HALF = 128, HTB = HALF * BK * 2  , STAGE_BYTES = 8 * HTB, NXCD = 8, WGM = 8;

__host__ __device__ __forceinline__ int lds_byte(int r, int c) { const int st = (r >> 4) * 2 + (c >> 5), rr = r & 15, cc = c & 31, ob = rr * 64 + cc * 2; return st * 1024 + (ob ^ (((ob >> 9) & 1) << 5)); }
__host__ __device__ __forceinline__ void stage_rc(int b, int& R, int& C) { const int st = b / 1024, sb = b % 1024, swz = sb ^ (((sb >> 9) & 1) << 5); R = (st >> 1) * 16 + swz / 64; C = (st & 1) * 32 + (swz % 64) / 2; }
__host__ __device__ __forceinline__ int perm32(int rho) { const int n = rho >> 4, i = rho & 15; return 8 * (i >> 2) + 4 * n + (i & 3); }

struct Unit { int pm, pn; };
struct Gemm { const bf16_t* A; const bf16_t* Bt; int M, N, K, lda, ldb; };
struct OrderBase {
    static constexpr bool GATHER = false;
    __device__ __forceinline__ const char* a_base(const Gemm& g, const Unit& u) const { return (const char*)g.A + (size_t)u.pm * 256 * g.lda * 2; }
    __device__ __forceinline__ const char* b_base(const Gemm& g, const Unit& u) const { return (const char*)g.Bt + (size_t)u.pn * 256 * g.ldb * 2; }
    __device__ __forceinline__ void a_ready(const Unit&) const {}
    __device__ __forceinline__ void done(const Unit&) const {}
};

struct StaticOrder : OrderBase {
    int nM, nN, nwg, G, c;
    __host__ __device__ void init(int M, int N, int G_, int c_) { nM = M / BM; nN = N / BM; nwg = nM * nN; G = G_; c = c_; }
    __host__ __device__ bool next(int i, Unit& u) const {
        const long L = (long)i * G + c; if (L >= nwg) return false;
        int wgid = (int)L; { const int q = nwg / NXCD, r = nwg % NXCD, xcd = wgid % NXCD, off = wgid / NXCD; wgid = (xcd < r ? xcd * (q + 1) : r * (q + 1) + (xcd - r) * q) + off; }
        const int nig = WGM * nN, gid = wgid / nig, fm = gid * WGM, gsz = (nM - fm) < WGM ? (nM - fm) : WGM;
        u.pm = fm + ((wgid % nig) % gsz); u.pn = (wgid % nig) / gsz; return true;
    }
};

typedef unsigned u32x2 __attribute__((ext_vector_type(2)));
typedef float f32x2_t __attribute__((ext_vector_type(2)));
typedef __bf16 bf16x2_t __attribute__((ext_vector_type(2)));
__device__ __forceinline__ unsigned cvtpk(float lo, float hi) { f32x2_t v = {lo, hi}; bf16x2_t b = __builtin_convertvector(v, bf16x2_t); return __builtin_bit_cast(unsigned, b); }
__device__ __forceinline__ void st_bf4(bf16_t* p, f32x4 v) { u32x2 w; w.x = cvtpk(v[0], v[1]); w.y = cvtpk(v[2], v[3]); *(u32x2*)p = w; }
__device__ __forceinline__ float bf2f(bf16_t b) { return __builtin_bit_cast(float, (unsigned)b << 16); }
#define EPI_ROWS _Pragma("unroll") for (int ai = 0; ai < 2; ++ai) _Pragma("unroll") for (int m = 0; m < 4; ++m)
#define EPI_COLS _Pragma("unroll") for (int bj = 0; bj < 2; ++bj) _Pragma("unroll") for (int n = 0; n < 2; ++n)
constexpr float LOG2E = 1.4426950408889634f;
constexpr float QSCALE_DA = 0.125f * LOG2E;
constexpr float QSCALE_X = 0.0625f * LOG2E;

struct EpiPlain {
    static constexpr bool PERM = false, AFTER_DRAIN = false;
    bf16_t* O; int ldc; float scale;
    __device__ __forceinline__ void operator()(const f32x4 (&acc)[2][2][4][2], const Unit& u, int wr, int wc, int fr, int fq) const {
        EPI_ROWS { const int row = u.pm * 256 + ai * 128 + wr * 64 + m * 16 + fr; bf16_t* rp = O + (size_t)row * ldc + u.pn * 256 + wc * 32 + fq * 4;
            EPI_COLS st_bf4(rp + bj * 128 + n * 16, acc[ai][bj][m][n] * scale); }
    }
};
struct EpiProj {
    static constexpr bool PERM = false, AFTER_DRAIN = false;
    bf16_t* P; float* LA; const float* cs; const float* b_alpha;
    template <int ai> __device__ __forceinline__ void decay_rows(const f32x4 (&acc)[2][2][4][2], const Unit& u, int wr, int wc, int fr, int fq) const {
        const int row0 = u.pm * 256 + ai * 128 + wr * 64 + fr;
        EPI_COLS { const int col = bj * 128 + wc * 32 + n * 16 + fq * 4; const f32x4 ba = *(const f32x4*)(b_alpha + col); f32x4 run = {0.f, 0.f, 0.f, 0.f};
            _Pragma("unroll") for (int m = 0; m < 4; ++m) { const f32x4 z = acc[ai][bj][m][n] + ba; f32x4 o;
                _Pragma("unroll") for (int i = 0; i < 4; ++i) { float v = (fminf(z[i], 0.f) - __logf(1.0f + __expf(-fabsf(z[i])))) * 0.0625f;
                    { float t = __shfl_up(v, 1, 16); if (fr >= 1) v += t; t = __shfl_up(v, 2, 16); if (fr >= 2) v += t; t = __shfl_up(v, 4, 16); if (fr >= 4) v += t; t = __shfl_up(v, 8, 16); if (fr >= 8) v += t; }
                    o[i] = v + run[i]; run[i] += __shfl(v, 15, 16); }
                *(f32x4*)(LA + (size_t)(row0 + m * 16) * 256 + col) = o; } }
    }
    __device__ __forceinline__ void operator()(const f32x4 (&acc)[2][2][4][2], const Unit& u, int wr, int wc, int fr, int fq) const {
        const int pn = u.pn;
        if (pn < 4) {
            const float sc = pn < 2 ? QSCALE_DA : 1.0f; const bool ropew = (wc & 1) == 0; const bool hi = (fq >> 1) != 0;
            EPI_ROWS { const int row = u.pm * 256 + ai * 128 + wr * 64 + m * 16 + fr; bf16_t* rp = P + (size_t)row * 3072 + pn * 256 + wc * 32 + fq * 4;
                f32x4 cv = {1.f, 1.f, 1.f, 1.f}, sv = {0.f, 0.f, 0.f, 0.f};
                if (ropew) { cv = *(const f32x4*)(cs + (size_t)row * 16 + 4 * (fq & 1)); sv = *(const f32x4*)(cs + (size_t)row * 16 + 8 + 4 * (fq & 1)); }
                EPI_COLS { f32x4 v = acc[ai][bj][m][n];
                    if (n == 0 && ropew) { f32x4 p; p[0] = __shfl_xor(v[0], 32); p[1] = __shfl_xor(v[1], 32); p[2] = __shfl_xor(v[2], 32); p[3] = __shfl_xor(v[3], 32);
                        v = hi ? (v * cv + p * sv) : (v * cv - p * sv); }
                    st_bf4(rp + bj * 128 + n * 16, v * sc); } }
        } else if (pn < 12) {
            const float sc = pn == 6 ? 0.125f : 1.0f;
            EPI_ROWS { const int row = u.pm * 256 + ai * 128 + wr * 64 + m * 16 + fr; bf16_t* rp = P + (size_t)row * 3072 + pn * 256 + wc * 32 + fq * 4;
                EPI_COLS st_bf4(rp + bj * 128 + n * 16, acc[ai][bj][m][n] * sc); }
        } else {
            decay_rows<0>(acc, u, wr, wc, fr, fq); decay_rows<1>(acc, u, wr, wc, fr, fq);
        }
    }
};
struct EpiRes1 {
    static constexpr bool PERM = false, AFTER_DRAIN = false;
    const float* base; float* out; bf16_t* xb; float* ssp;
    __device__ __forceinline__ void operator()(const f32x4 (&acc)[2][2][4][2], const Unit& u, int wr, int wc, int fr, int fq) const {
        EPI_ROWS { const int row = u.pm * 256 + ai * 128 + wr * 64 + m * 16 + fr; const size_t off = (size_t)row * 1024 + u.pn * 256 + wc * 32 + fq * 4; float ss = 0.f;
            EPI_COLS { const size_t o2 = off + bj * 128 + n * 16; const f32x4 v = *(const f32x4*)(base + o2) + acc[ai][bj][m][n]; *(f32x4*)(out + o2) = v; st_bf4(xb + o2, v);
                ss += (v[0] * v[0] + v[1] * v[1]) + (v[2] * v[2] + v[3] * v[3]); }
            ss += __shfl_xor(ss, 16); ss += __shfl_xor(ss, 32);
            if (fq == 0) ssp[(size_t)row * 16 + u.pn * 4 + wc] = ss; }
    }
};
struct EpiQX {
    static constexpr bool PERM = false, AFTER_DRAIN = false;
    bf16_t* O; const float* ssp;
    __device__ __forceinline__ void operator()(const f32x4 (&acc)[2][2][4][2], const Unit& u, int wr, int wc, int fr, int fq) const {
        EPI_ROWS { const int row = u.pm * 256 + ai * 128 + wr * 64 + m * 16 + fr; const f32x4* sp = (const f32x4*)(ssp + (size_t)row * 16);
            const f32x4 a = sp[0], b = sp[1], c = sp[2], d = sp[3]; const float ss = ((a[0] + a[1]) + (a[2] + a[3])) + ((b[0] + b[1]) + (b[2] + b[3])) + ((c[0] + c[1]) + (c[2] + c[3])) + ((d[0] + d[1]) + (d[2] + d[3]));
            const float rs = rsqrtf(ss * (1.0f / 1024.0f) + 1e-6f) * QSCALE_X; bf16_t* rp = O + (size_t)row * 1024 + u.pn * 256 + wc * 32 + fq * 4;
            EPI_COLS st_bf4(rp + bj * 128 + n * 16, acc[ai][bj][m][n] * rs); }
    }
};
struct EpiRes2 {
    static constexpr bool PERM = false, AFTER_DRAIN = false;
    float* out; bf16_t* xb;
    __device__ __forceinline__ void operator()(const f32x4 (&acc)[2][2][4][2], const Unit& u, int wr, int wc, int fr, int fq) const {
        EPI_ROWS { const int row = u.pm * 256 + ai * 128 + wr * 64 + m * 16 + fr; float* rp = out + (size_t)row * 1024 + u.pn * 256 + wc * 32 + fq * 4;
            bf16_t* bp = xb + (size_t)row * 1024 + u.pn * 256 + wc * 32 + fq * 4;
            EPI_COLS { f32x4* p = (f32x4*)(rp + bj * 128 + n * 16); const f32x4 v = *p + acc[ai][bj][m][n]; *p = v; st_bf4(bp + bj * 128 + n * 16, v); } }
    }
};
struct EpiUp {
    static constexpr bool PERM = false, AFTER_DRAIN = false;
    bf16_t* ACT; const float* rsl; const PG8_LAS int* tstart; const PG8_LAS int* cnt; const float* b_up;
    __device__ __forceinline__ void operator()(const f32x4 (&acc)[2][2][4][2], const Unit& u, int wr, int wc, int fr, int fq) const {
        const int e = u.pn >> 3, pnl = u.pn & 7; const float* bg = b_up + (size_t)e * 2048 + pnl * 128 + wc * 32 + fq * 4;
        const int pos0 = (u.pm - tstart[e]) * 256 + wr * 64 + fr, nv = cnt[e]; const float* rp0 = rsl + (size_t)e * 32768 + pos0;
        EPI_ROWS { const int row = u.pm * 256 + ai * 128 + wr * 64 + m * 16 + fr; const float rs = (pos0 + ai * 128 + m * 16) < nv ? rp0[ai * 128 + m * 16] : 0.f;
            bf16_t* rp = ACT + (size_t)row * 1024 + pnl * 128 + wc * 32 + fq * 4;
            _Pragma("unroll") for (int n = 0; n < 2; ++n) { const f32x4 g = acc[ai][0][m][n] * rs + *(const f32x4*)(bg + n * 16), l = acc[ai][1][m][n] * rs + *(const f32x4*)(bg + 1024 + n * 16); f32x4 o;
                _Pragma("unroll") for (int i = 0; i < 4; ++i) { const float gl = fminf(g[i], 7.0f), li = fminf(fmaxf(l[i], -7.0f), 7.0f); o[i] = gl / (1.0f + __expf(-1.702f * gl)) * (li + 1.0f); }
                st_bf4(rp + n * 16, o); } }
    }
};
struct EpiDown {
    static constexpr bool PERM = false, AFTER_DRAIN = false;
    bf16_t* Y; const float* b_down;
    __device__ __forceinline__ void operator()(const f32x4 (&acc)[2][2][4][2], const Unit& u, int wr, int wc, int fr, int fq) const {
        const int e = u.pn >> 2, pnl = u.pn & 3; const float* bp = b_down + (size_t)e * 1024 + pnl * 256 + wc * 32 + fq * 4;
        EPI_ROWS { const int row = u.pm * 256 + ai * 128 + wr * 64 + m * 16 + fr; bf16_t* rp = Y + (size_t)row * 1024 + pnl * 256 + wc * 32 + fq * 4;
            EPI_COLS st_bf4(rp + bj * 128 + n * 16, acc[ai][bj][m][n] + *(const f32x4*)(bp + bj * 128 + n * 16)); }
    }
};
struct OrderMap : OrderBase {
    StaticOrder so;
    __device__ void init(int nM, int nN, int G, int c) { so.nM = nM; so.nN = nN; so.nwg = nM * nN; so.G = G; so.c = c; }
    __device__ bool next(int i, Unit& u) const { if (!so.next(i, u)) return false; u.pn += (u.pn >= 4 ? 2 : 0) + (u.pn >= 6 ? 2 : 0); return true; }
};
struct OrderVT : OrderBase {
    StaticOrder so;
    __device__ void init(int nN, int G, int c) { so.nM = 4; so.nN = nN; so.nwg = 4 * nN; so.G = G; so.c = c; }
    __device__ bool next(int i, Unit& u) const { if (!so.next(i, u)) return false; u.pm += (u.pm >= 2 ? 6 : 4); return true; }
};
struct MoeOrder : OrderBase {
    StaticOrder so; const PG8_LAS unsigned char* tile_e; int nN;
    __device__ void init(int nM, int nN_, int G, int c, const PG8_LAS unsigned char* te) { so.nM = nM; so.nN = nN_; so.nwg = nM * nN_; so.G = G; so.c = c; tile_e = te; nN = nN_; }
    __device__ bool next(int i, Unit& u) const { if (!so.next(i, u)) return false; u.pn += (int)tile_e[u.pm] * nN; return true; }
};


struct MoeOrderG : OrderBase {
    static constexpr bool GATHER = true;
    StaticOrder so; const PG8_LAS unsigned char* tile_e; const PG8_LAS int* tstart; const PG8_LAS int* cnt; const unsigned* list; PG8_LAS unsigned* gslot; int nN;
    __device__ void init(int nM, int nN_, int G, int c, const PG8_LAS unsigned char* te, const PG8_LAS int* ts, const PG8_LAS int* cn, const unsigned* li, PG8_LAS unsigned* gs) {
        so.nM = nM; so.nN = nN_; so.nwg = nM * nN_; so.G = G; so.c = c; tile_e = te; tstart = ts; cnt = cn; list = li; gslot = gs; nN = nN_; }
    __device__ bool next(int i, Unit& u) const { if (!so.next(i, u)) return false; u.pn += (int)tile_e[u.pm] * nN; return true; }
    __device__ __forceinline__ const char* a_base(const Gemm& g, const Unit&) const { return (const char*)g.A; }
    __device__ __forceinline__ const unsigned* rows(const Unit& u) const { const int e = u.pn / nN; return list + (size_t)e * 32768 + (size_t)(u.pm - tstart[e]) * 256; }
    __device__ __forceinline__ int nvalid(const Unit& u) const { const int e = u.pn / nN; return cnt[e] - (u.pm - tstart[e]) * 256; }
};
struct OrderX1 : OrderBase {
    StaticOrder so;
    __device__ void init(int G, int c) { so.nM = 128; so.nN = 4; so.nwg = 512; so.G = G; so.c = c; }
    __device__ bool next(int i, Unit& u) const { return so.next(i, u); }
    __device__ __forceinline__ const char* a_base(const Gemm& g, const Unit& u) const { return (const char*)(g.A + (size_t)u.pm * 256 * 1024 + u.pn * 256); }
    __device__ __forceinline__ const char* b_base(const Gemm& g, const Unit& u) const { return (const char*)(g.Bt + (size_t)(u.pm >> 3) * 256 * 1024 + u.pn * 256); }
};
struct OrderX2 : OrderBase {
    StaticOrder so;
    __device__ void init(int G, int c) { so.nM = 128; so.nN = 4; so.nwg = 512; so.G = G; so.c = c; }
    __device__ bool next(int i, Unit& u) const { return so.next(i, u); }
    __device__ __forceinline__ const char* a_base(const Gemm& g, const Unit& u) const { return (const char*)(g.A + (size_t)u.pm * 256 * 1024 + u.pn * 256); }
    __device__ __forceinline__ const char* b_base(const Gemm& g, const Unit& u) const { return (const char*)(g.Bt + (size_t)u.pn * 256 * 4096 + (u.pm >> 3) * 256); }
};
struct EpiSoftmax {
    static constexpr bool PERM = false, AFTER_DRAIN = false;
    bf16_t* PX; float* lp; PG8_LAS float* xch;
    __device__ __forceinline__ void operator()(const f32x4 (&acc)[2][2][4][2], const Unit& u, int wr, int wc, int fr, int fq) const {
        PG8_LAS char* rb = (PG8_LAS char*)xch + (wr * 64 + fr) * 16; asm volatile("" : "+v"(rb));
        PG8_LAS char* wb = rb + wc * 4; asm volatile("" : "+v"(wb));
        EPI_ROWS { float a = -INFINITY;
            EPI_COLS { const f32x4 v = acc[ai][bj][m][n]; a = fmaxf(a, fmaxf(fmaxf(v[0], v[1]), fmaxf(v[2], v[3]))); }
            a = fmaxf(a, __shfl_xor(a, 16)); a = fmaxf(a, __shfl_xor(a, 32));
            if (fq == 0) *(PG8_LAS float*)(wb + (ai * 128 + m * 16) * 16) = a; }
        asm volatile("s_waitcnt lgkmcnt(0)" ::: "memory"); __builtin_amdgcn_s_barrier(); asm volatile("" ::: "memory");
        const int row0 = u.pm * 256 + wr * 64 + fr; bf16_t* rp0 = PX + (size_t)row0 * 1024 + u.pn * 256 + wc * 32 + fq * 4; float* lp0 = lp + (size_t)row0 * 16 + u.pn * 4 + wc;
        EPI_ROWS { const f32x4 q = *(const PG8_LAS f32x4*)(rb + (ai * 128 + m * 16) * 16); const float mr = fmaxf(fmaxf(q[0], q[1]), fmaxf(q[2], q[3]));
            bf16_t* rp = rp0 + (size_t)(ai * 128 + m * 16) * 1024; float ps = 0.f;
            EPI_COLS { const f32x4 v = acc[ai][bj][m][n]; f32x4 p; _Pragma("unroll") for (int i = 0; i < 4; ++i) { p[i] = __builtin_amdgcn_exp2f(v[i] - mr); ps += p[i]; }
                st_bf4(rp + bj * 128 + n * 16, p); }
            ps += __shfl_xor(ps, 16); ps += __shfl_xor(ps, 32);
            if (fq == 0) lp0[(ai * 128 + m * 16) * 16] = ps; }
        asm volatile("s_waitcnt lgkmcnt(0)" ::: "memory"); __builtin_amdgcn_s_barrier(); asm volatile("" ::: "memory");
    }
};
struct EpiPV {
    static constexpr bool PERM = false, AFTER_DRAIN = false;
    bf16_t* O; const float* lp;
    __device__ __forceinline__ void operator()(const f32x4 (&acc)[2][2][4][2], const Unit& u, int wr, int wc, int fr, int fq) const {
        EPI_ROWS { const int row = u.pm * 256 + ai * 128 + wr * 64 + m * 16 + fr; const f32x4 q = *(const f32x4*)(lp + (size_t)row * 16 + u.pn * 4);
            const float inv = 1.0f / ((q[0] + q[1]) + (q[2] + q[3])); bf16_t* rp = O + (size_t)row * 1024 + u.pn * 256 + wc * 32 + fq * 4;
            EPI_COLS st_bf4(rp + bj * 128 + n * 16, acc[ai][bj][m][n] * inv); }
    }
};
template <class Epi, class Sched, bool ALIGN_EPI = false, bool SP2 = false>
__device__ __forceinline__ void gemm_phase(PG8_LAS unsigned char* lds, const Gemm g, const Sched& S, const Epi& E) {
    const int tid = threadIdx.x, wid = __builtin_amdgcn_readfirstlane(tid >> 6), lane = tid & 63, wr = wid >> 2, wc = wid & 3, fr = lane & 15, fq = lane >> 4;
    const int K = g.K, nt = K / BK;
    unsigned voffA[2], voffB[2]; int gR[2]; unsigned gCol[2];
    unsigned gC[2][2], gN[2][2], gS[2][2];
#pragma unroll
    for (int i = 0; i < 2; ++i) { int R, C; stage_rc(tid * 16 + i * 8192, R, C); const int Rb = Epi::PERM ? ((R & ~31) + perm32(R & 31)) : R;
        voffA[i] = (unsigned)(R * g.lda + C) * 2u; voffB[i] = (unsigned)(Rb * g.ldb + C) * 2u; gR[i] = R; gCol[i] = (unsigned)C * 2u; }
    const size_t kstep = (size_t)(BK * 2);
    const size_t hstepA = (size_t)HALF * g.lda * 2, hstepB = (size_t)HALF * g.ldb * 2;
    const unsigned ldsw = (unsigned)wid * 1024u;
    const int aoff = lds_byte(wr * 64 + fr, fq * 8), boff = lds_byte(wc * 32 + fr, fq * 8);
#define PG8_SA(b, h) (((b) * 2 + (h)) * HTB)
#define PG8_SB(b, h) ((4 + (b) * 2 + (h)) * HTB)
#define PG8_STAGE(bufoff, gbase, voff) do { _Pragma("unroll") for (int _i = 0; _i < 2; ++_i) \
        __builtin_amdgcn_global_load_lds((const unsigned*)((const char*)(gbase) + (voff)[_i]), (PG8_LAS unsigned*)(lds + (bufoff) + ldsw + _i * 8192), 16, 0, 0); } while (0)
#define PG8_STAGE_A(bufoff, ptr, h, nx) do { if constexpr (Sched::GATHER) { PG8_STAGE(bufoff, ptr, ((nx) ? gS[h] : gC[h])); } else { PG8_STAGE(bufoff, (ptr) + ((h) ? hstepA : 0), voffA); } } while (0)
#define PG8_LDA(dst, b, h) do { _Pragma("unroll") for (int m = 0; m < 4; ++m) _Pragma("unroll") for (int k = 0; k < 2; ++k) dst[m][k] = *(const PG8_LAS bf16x8*)(lds + PG8_SA(b, h) + aoff + m * 2048 + k * 1024); } while (0)
#define PG8_LDB(dst, b, h) do { _Pragma("unroll") for (int n = 0; n < 2; ++n) _Pragma("unroll") for (int k = 0; k < 2; ++k) dst[n][k] = *(const PG8_LAS bf16x8*)(lds + PG8_SB(b, h) + boff + n * 2048 + k * 1024); } while (0)
#define PG8_MMA(ai, bj, At, Bt) do { __builtin_amdgcn_s_setprio(1); _Pragma("unroll") for (int m = 0; m < 4; ++m) _Pragma("unroll") for (int n = 0; n < 2; ++n) _Pragma("unroll") for (int k = 0; k < 2; ++k) \
        acc[ai][bj][m][n] = __builtin_amdgcn_mfma_f32_16x16x32_bf16(Bt[n][k], At[m][k], acc[ai][bj][m][n], 0, 0, 0); __builtin_amdgcn_s_setprio(0); } while (0)
#define PG8_WAIT_V(n) asm volatile("s_waitcnt vmcnt(" #n ")" ::: "memory")
#define PG8_WAIT_L(n) asm volatile("s_waitcnt lgkmcnt(" #n ")" ::: "memory")
#define PG8_BAR __builtin_amdgcn_s_barrier()
#define PG8_SCHED __builtin_amdgcn_sched_barrier(0)
    Unit cur, nxt; int ui = 0;
    if (!S.next(0, cur)) return;
    f32x4 acc[2][2][4][2];
#pragma unroll
    for (int a = 0; a < 2; ++a)
#pragma unroll
        for (int b = 0; b < 2; ++b)
#pragma unroll
            for (int m = 0; m < 4; ++m)
#pragma unroll
                for (int n = 0; n < 2; ++n) acc[a][b][m][n] = (f32x4){0.f, 0.f, 0.f, 0.f};
    bf16x8 At[4][2], B0[2][2], B1[2][2];
    const char* cA = S.a_base(g, cur); const char* cB = S.b_base(g, cur);
    if constexpr (Sched::GATHER) { const unsigned* rp = S.rows(cur); const int nv = S.nvalid(cur);
#pragma unroll
        for (int h = 0; h < 2; ++h)
#pragma unroll
            for (int i = 0; i < 2; ++i) { const int r = h * HALF + gR[i]; const unsigned tok = r < nv ? rp[r] : 0u; gC[h][i] = tok * (unsigned)(g.lda * 2) + gCol[i]; gN[h][i] = gC[h][i]; gS[h][i] = gC[h][i]; } }
    S.a_ready(cur);
    if constexpr (SP2) {
        PG8_STAGE(PG8_SB(0, 0), cB, voffB); PG8_STAGE(PG8_SB(0, 1), cB + hstepB, voffB); PG8_STAGE_A(PG8_SA(0, 0), cA, 0, 0); PG8_STAGE_A(PG8_SA(0, 1), cA, 1, 0);
        if (wr == 1) PG8_BAR;
        PG8_WAIT_V(2); PG8_BAR;
        PG8_STAGE(PG8_SB(1, 0), cB + kstep, voffB); PG8_STAGE_A(PG8_SA(1, 0), cA + kstep, 0, 0); PG8_STAGE(PG8_SB(1, 1), cB + hstepB + kstep, voffB);
        PG8_WAIT_V(6); PG8_BAR;
    } else {
        PG8_STAGE(PG8_SB(0, 0), cB, voffB); PG8_STAGE_A(PG8_SA(0, 0), cA, 0, 0); PG8_STAGE(PG8_SB(0, 1), cB + hstepB, voffB); PG8_STAGE_A(PG8_SA(0, 1), cA, 1, 0);
        if (wr == 1) PG8_BAR;
        PG8_WAIT_V(4); PG8_BAR;
        PG8_STAGE(PG8_SB(1, 0), cB + kstep, voffB); PG8_STAGE_A(PG8_SA(1, 0), cA + kstep, 0, 0); PG8_STAGE(PG8_SB(1, 1), cB + hstepB + kstep, voffB);
        PG8_WAIT_V(6); PG8_BAR;
    }
    for (;;) {
        const bool has_next = S.next(ui + 1, nxt);
        const char* nA = has_next ? S.a_base(g, nxt) : cA; const char* nB = has_next ? S.b_base(g, nxt) : cB;
        if constexpr (Sched::GATHER) { if (has_next && wid < 4)
            __builtin_amdgcn_global_load_lds((const unsigned*)(S.rows(nxt) + wid * 64 + lane), (PG8_LAS unsigned*)(S.gslot + ((ui + 1) & 1) * 256 + wid * 64), 4, 0, 0); }
        for (int t = 0; t < nt; t += 2) {
            const bool last = (t == nt - 2);
            const char* a1 = cA + (size_t)(t + 1) * kstep;
            const char* a2 = last ? nA : cA + (size_t)(t + 2) * kstep; const char* b2 = last ? nB : cB + (size_t)(t + 2) * kstep;
            const char* a3 = a2 + kstep; const char* b3 = b2 + kstep;
            if (last && has_next) S.a_ready(nxt);
            if constexpr (Sched::GATHER) {
                if (last && has_next) { const PG8_LAS unsigned* sl = S.gslot + ((ui + 1) & 1) * 256; const int nv = S.nvalid(nxt);
#pragma unroll
                    for (int h = 0; h < 2; ++h)
#pragma unroll
                        for (int i = 0; i < 2; ++i) { const int r = h * HALF + gR[i]; const unsigned v = sl[r]; const unsigned tok = r < nv ? v : 0u; gN[h][i] = tok * (unsigned)(g.lda * 2) + gCol[i]; } }
#pragma unroll
                for (int h = 0; h < 2; ++h)
#pragma unroll
                    for (int i = 0; i < 2; ++i) gS[h][i] = last ? gN[h][i] : gC[h][i]; }
            if constexpr (SP2) {
            PG8_LDB(B0, 0, 0); PG8_LDB(B1, 0, 1); PG8_SCHED; PG8_LDA(At, 0, 0); PG8_STAGE_A(PG8_SA(1, 1), a1, 1, 0);
            PG8_WAIT_V(8); PG8_WAIT_L(0); PG8_BAR; PG8_MMA(0, 0, At, B0); PG8_MMA(0, 1, At, B1); PG8_BAR; PG8_SCHED;
            PG8_LDA(At, 0, 1); PG8_STAGE(PG8_SB(0, 0), b2, voffB); PG8_STAGE(PG8_SB(0, 1), b2 + hstepB, voffB); PG8_STAGE_A(PG8_SA(0, 0), a2, 0, 1);
            PG8_WAIT_V(8); PG8_WAIT_L(0); PG8_BAR; PG8_MMA(1, 0, At, B0); PG8_MMA(1, 1, At, B1); PG8_BAR; PG8_SCHED;
            PG8_LDB(B0, 1, 0); PG8_LDB(B1, 1, 1); PG8_SCHED; PG8_LDA(At, 1, 0); PG8_STAGE_A(PG8_SA(0, 1), a2, 1, 1);
            PG8_WAIT_V(8); PG8_WAIT_L(0); PG8_BAR; PG8_MMA(0, 0, At, B0); PG8_MMA(0, 1, At, B1); PG8_BAR; PG8_SCHED;
            PG8_LDA(At, 1, 1); PG8_STAGE(PG8_SB(1, 0), b3, voffB); PG8_STAGE(PG8_SB(1, 1), b3 + hstepB, voffB); PG8_STAGE_A(PG8_SA(1, 0), a3, 0, 1);
            PG8_WAIT_V(8); PG8_WAIT_L(0); PG8_BAR; PG8_MMA(1, 0, At, B0); PG8_MMA(1, 1, At, B1); PG8_BAR; PG8_SCHED;
            } else {
            PG8_LDB(B0, 0, 0); PG8_SCHED; PG8_LDA(At, 0, 0); PG8_STAGE_A(PG8_SA(1, 1), a1, 1, 0);
            PG8_WAIT_L(8); PG8_BAR; PG8_WAIT_L(0); PG8_MMA(0, 0, At, B0); PG8_BAR; PG8_SCHED;
            PG8_LDB(B1, 0, 1); PG8_STAGE(PG8_SB(0, 0), b2, voffB);
            PG8_BAR; PG8_WAIT_L(0); PG8_MMA(0, 1, At, B1); PG8_BAR;
            PG8_LDA(At, 0, 1); PG8_STAGE_A(PG8_SA(0, 0), a2, 0, 1);
            PG8_BAR; PG8_WAIT_L(0); PG8_MMA(1, 0, At, B0); PG8_BAR; PG8_SCHED;
            PG8_STAGE(PG8_SB(0, 1), b2 + hstepB, voffB);
            PG8_WAIT_V(6); PG8_BAR; PG8_MMA(1, 1, At, B1); PG8_BAR;
            PG8_LDB(B0, 1, 0); PG8_SCHED; PG8_LDA(At, 1, 0); PG8_STAGE_A(PG8_SA(0, 1), a2, 1, 1);
            PG8_WAIT_L(8); PG8_BAR; PG8_WAIT_L(0); PG8_MMA(0, 0, At, B0); PG8_BAR; PG8_SCHED;
            PG8_LDB(B1, 1, 1); PG8_STAGE(PG8_SB(1, 0), b3, voffB);
            PG8_BAR; PG8_WAIT_L(0); PG8_MMA(0, 1, At, B1); PG8_BAR;
            PG8_LDA(At, 1, 1); PG8_STAGE_A(PG8_SA(1, 0), a3, 0, 1);
            PG8_BAR; PG8_WAIT_L(0); PG8_MMA(1, 0, At, B0); PG8_BAR; PG8_SCHED;
            PG8_STAGE(PG8_SB(1, 1), b3 + hstepB, voffB);
            PG8_WAIT_V(6); PG8_BAR; PG8_MMA(1, 1, At, B1); PG8_BAR;
            }
        }
        if constexpr (ALIGN_EPI) { if (wr == 0) PG8_BAR; }
        if constexpr (!Epi::AFTER_DRAIN) { E(acc, cur, wr, wc, fr, fq); S.done(cur); }
        if (!has_next) break;
#pragma unroll
        for (int a = 0; a < 2; ++a)
#pragma unroll
            for (int b = 0; b < 2; ++b)
#pragma unroll
                for (int m = 0; m < 4; ++m)
#pragma unroll
                    for (int n = 0; n < 2; ++n) acc[a][b][m][n] = (f32x4){0.f, 0.f, 0.f, 0.f};
        cur = nxt; cA = nA; cB = nB; ++ui;
        if constexpr (Sched::GATHER) {
#pragma unroll
            for (int h = 0; h < 2; ++h)
#pragma unroll
                for (int i = 0; i < 2; ++i) gC[h][i] = gN[h][i]; }
        if constexpr (ALIGN_EPI) { if (wr == 1) PG8_BAR; }
    }
    PG8_WAIT_V(0);
    if constexpr (!ALIGN_EPI) { if (wr == 0) PG8_BAR; }
    PG8_BAR;
    if constexpr (Epi::AFTER_DRAIN) { E.fused(acc, cur, wr, wc, fr, fq, lds, wid, lane); S.done(cur); }
#undef PG8_SA
#undef PG8_SB
#undef PG8_STAGE
#undef PG8_STAGE_A
#undef PG8_LDA
#undef PG8_LDB
#undef PG8_MMA
#undef PG8_WAIT_V
#undef PG8_WAIT_L
#undef PG8_BAR
#undef PG8_SCHED
}
}
constexpr int NTOK = 32768, DM = 1024, SEQ = 2048, NBATCH = 16, MEMLEN = 256, NMEM = NBATCH * MEMLEN, INW = 3088, NEXP = 32, TOPK = 4;
constexpr int PW = 3072;
constexpr int MAXTILES = 544;
constexpr float EPS = 1e-6f;
constexpr int NWAVES = 8;
constexpr size_t MiB = 1u << 20;
constexpr size_t WS_CTL = 0, CTL_ZERO_BYTES = 64 * 1024;
constexpr size_t WS_WINT = 2 * MiB, WS_WOUT = 10 * MiB, WS_WCQ = 12 * MiB, WS_WCK = 14 * MiB, WS_WCV = 16 * MiB, WS_WCO = 18 * MiB;
constexpr size_t WS_WR = 20 * MiB, WS_CS = 21 * MiB, WS_SSP1 = 24 * MiB, WS_GATE = 27 * MiB, WS_ASSIGN = 28 * MiB, WS_LIST = 29 * MiB;
constexpr size_t WS_RSL = 842 * MiB;
constexpr size_t WS_X2B = 378 * MiB;
constexpr size_t WS_WUP = 34 * MiB, WS_WDN = 162 * MiB, WS_KX = 226 * MiB, WS_VXT = 234 * MiB;
constexpr size_t WS_HN = 242 * MiB, WS_CAT = 242 * MiB, WS_MN = 306 * MiB, WS_P = 314 * MiB, WS_LA = 506 * MiB, WS_VT = 538 * MiB;
constexpr size_t WS_X1B = 314 * MiB, WS_QX = 378 * MiB, WS_OX = 442 * MiB, WS_PX = 506 * MiB;
constexpr size_t WS_GVT = 602 * MiB;
constexpr size_t WS_ACT = 570 * MiB, WS_XG = 242 * MiB, WS_Y = 242 * MiB, WS_END = 846 * MiB;
constexpr int CW_Q2 = 128;
constexpr int CW_CNT = 1024;
constexpr int CW_PROBE = 192;
constexpr int CW_BAR = 4096;
constexpr int RING_OFF = 0, RING_BYTES = 131072;
constexpr int LDSCTL_OFF = RING_BYTES, MISC_OFF = LDSCTL_OFF + 320;
constexpr int TAB_OFF = LDSCTL_OFF + 512;
constexpr int TAB_TSTART = TAB_OFF + 576, TAB_CNT = TAB_TSTART + 144;
constexpr int XCH_OFF = LDSCTL_OFF + 2048;
constexpr int TS_OFF = TAB_CNT + 128;
constexpr int LDS_BYTES = 147456;

#define GAS __attribute__((address_space(1)))
#define LAS __attribute__((address_space(3)))
typedef unsigned short bf16;
typedef unsigned v4u __attribute__((ext_vector_type(4)));
typedef float f32x4 __attribute__((ext_vector_type(4)));
typedef short bf16x8 __attribute__((ext_vector_type(8)));
typedef GAS unsigned gu32;
typedef GAS unsigned long long gu64;
#define RLX_AGENT __ATOMIC_RELAXED, __HIP_MEMORY_SCOPE_AGENT
#define LDS_WAIT() asm volatile("s_waitcnt lgkmcnt(0)" ::: "memory")
#define VM_WAIT() asm volatile("s_waitcnt vmcnt(0)" ::: "memory")
__device__ __forceinline__ unsigned long long rt() { return __builtin_amdgcn_s_memrealtime(); }
__device__ __forceinline__ unsigned f2bf(float f) { unsigned u = __builtin_bit_cast(unsigned, f); return (u + 0x7fffu + ((u >> 16) & 1u)) >> 16; }
__device__ __forceinline__ unsigned pk2(float lo, float hi) { return f2bf(lo) | (f2bf(hi) << 16); }

#define XB_TMO      128
#define XB_XCNT(j)  (256  + 64 * (j))
#define XB_XSUB(j)  (1280 + 64 * (j))
#define XB_XGEN(j)  (2304 + 64 * (j))
#define XB_TOP      3328
#define XB_TOPGEN   3392
#define XCD_BAR_WORDS 3456
#define XB_SPIN_CAP (1u << 18)

__device__ __forceinline__ unsigned xb_ld(unsigned* p)              { return __hip_atomic_load(p, __ATOMIC_RELAXED, __HIP_MEMORY_SCOPE_AGENT); }
__device__ __forceinline__ unsigned xb_add(unsigned* p, unsigned v) { return __hip_atomic_fetch_add(p, v, __ATOMIC_RELAXED, __HIP_MEMORY_SCOPE_AGENT); }
__device__ __forceinline__ unsigned xb_xcc_id() { return (unsigned)__builtin_amdgcn_s_getreg((3 << 11) | 20) & 0xFu; }
#define XB_SPIN(cond, bar) do { unsigned _sp = 0; while (cond) { __builtin_amdgcn_s_sleep(1); \
    if ((++_sp & 255u) == 0u) { if (xb_ld(&(bar)[XB_TMO])) break; if (_sp > XB_SPIN_CAP) { atomicAdd(&(bar)[XB_TMO], 1u); break; } } } } while (0)

struct XcdBarrier {
    unsigned* bar; unsigned x;
    volatile LAS unsigned* st;
};

__device__ __forceinline__ XcdBarrier xcd_barrier_post(unsigned* bar, volatile LAS unsigned* st) {
    XcdBarrier b; b.bar = bar; b.x = xb_xcc_id(); b.st = st;
    if (threadIdx.x == 0) (void)xb_add(&bar[XB_XCNT(b.x)], 1u);
    return b;
}
__device__ __forceinline__ void xcd_barrier_complete(unsigned* bar, unsigned x, unsigned& nloc, unsigned& nx) {
    const unsigned G = gridDim.x * gridDim.y * gridDim.z;
    unsigned sum, cnt, mine, sp = 0u;
    for (;;) {
        sum = 0u; cnt = 0u; mine = 0u;
#pragma unroll
        for (unsigned j = 0; j < 16; ++j) { const unsigned c = xb_ld(&bar[XB_XCNT(j)]); sum += c; cnt += (c > 0u) ? 1u : 0u; mine = (j == x) ? c : mine; }
        if (sum == G) break;
        __builtin_amdgcn_s_sleep(1);
        if ((++sp & 255u) == 0u) { if (xb_ld(&bar[XB_TMO])) break; if (sp > XB_SPIN_CAP) { atomicAdd(&bar[XB_TMO], 1u); break; } }
    }
    nloc = mine > 0u ? mine : 1u; nx = cnt > 0u ? cnt : 1u;
}

__device__ __forceinline__ void xcd_barrier(const XcdBarrier& b) {
    asm volatile("s_waitcnt vmcnt(0)" ::: "memory");
    __syncthreads();
    if (threadIdx.x == 0) {
        unsigned* bar = b.bar;
        __builtin_amdgcn_s_waitcnt(0);
        unsigned nloc = b.st[0], nx = b.st[1];
        if (nloc == 0u) { xcd_barrier_complete(bar, b.x, nloc, nx); b.st[0] = nloc; b.st[1] = nx; }
        const unsigned old = xb_add(&bar[XB_XSUB(b.x)], 1u);
        const unsigned gen = old / nloc;
        if (old + 1u == (gen + 1u) * nloc) {
            __builtin_amdgcn_fence(__ATOMIC_RELEASE, "agent");
            asm volatile("s_waitcnt vmcnt(0)" ::: "memory");
            const unsigned og = xb_add(&bar[XB_TOP], 1u);
            const unsigned tg = og / nx;
            if (og + 1u == (tg + 1u) * nx) xb_add(&bar[XB_TOPGEN], 1u);
            else XB_SPIN(xb_ld(&bar[XB_TOPGEN]) == tg, bar);
            __builtin_amdgcn_fence(__ATOMIC_ACQUIRE, "agent");
            xb_add(&bar[XB_XGEN(b.x)], 1u);
            asm volatile("s_waitcnt vmcnt(0)" ::: "memory");
        } else {
            XB_SPIN(xb_ld(&bar[XB_XGEN(b.x)]) == gen, bar);
            __builtin_amdgcn_fence(__ATOMIC_ACQUIRE, "agent");
            asm volatile("s_waitcnt vmcnt(0)" ::: "memory");
        }
    }
    __syncthreads();
}
typedef short bf16x4 __attribute__((ext_vector_type(4)));
typedef unsigned v2u __attribute__((ext_vector_type(2)));
struct Frame {
    LAS unsigned char* lds;
    volatile LAS unsigned* MISC;
    gu32* ctl;
    int tid, lane, wave;
    int vcu, G;
    unsigned char* ws;
    float* out;
};
__device__ __forceinline__ int lane_here() { int l = (int)(threadIdx.x & 63u); asm volatile("" : "+v"(l)); return l; }
__device__ __forceinline__ float bf2f(bf16 b) { return __builtin_bit_cast(float, (unsigned)b << 16); }
__device__ __forceinline__ float wave_sum(float v) {
#pragma unroll
    for (int o = 1; o < 64; o <<= 1) v += __shfl_xor(v, o);
    return v;
}
__device__ __forceinline__ f32x4 mfma16(bf16x8 a, bf16x8 b, f32x4 c) { return __builtin_amdgcn_mfma_f32_16x16x32_bf16(a, b, c, 0, 0, 0); }

__device__ __forceinline__ void p0_transpose_item(const float* W, int ldw, const float* gain, bf16* WT, int K, int k0, int n0, size_t orow0, int lane) {
    const int n4 = lane & 15, kq = lane >> 4;
    const float* src = W + (size_t)(k0 + 16 * kq) * ldw + n0 + 4 * n4;
    f32x4 v[16];
#pragma unroll
    for (int i = 0; i < 16; ++i) v[i] = *(const f32x4*)(src + (size_t)i * ldw);
    if (gain) { const f32x4* gp = (const f32x4*)(gain + k0 + 16 * kq);
#pragma unroll
        for (int q = 0; q < 4; ++q) { const f32x4 gq = gp[q];
#pragma unroll
            for (int r = 0; r < 4; ++r) v[4 * q + r] = v[4 * q + r] * gq[r]; } }
    bf16* dst = WT + (orow0 + 4 * n4) * (size_t)K + k0 + 16 * kq;
#pragma unroll
    for (int j = 0; j < 4; ++j) { v4u o0, o1;
        o0.x = pg8::cvtpk(v[0][j], v[1][j]); o0.y = pg8::cvtpk(v[2][j], v[3][j]); o0.z = pg8::cvtpk(v[4][j], v[5][j]); o0.w = pg8::cvtpk(v[6][j], v[7][j]);
        o1.x = pg8::cvtpk(v[8][j], v[9][j]); o1.y = pg8::cvtpk(v[10][j], v[11][j]); o1.z = pg8::cvtpk(v[12][j], v[13][j]); o1.w = pg8::cvtpk(v[14][j], v[15][j]);
        *(v4u*)(dst + (size_t)j * K) = o0; *(v4u*)(dst + (size_t)j * K + 8) = o1; }
}
__device__ __forceinline__ void rms_row_to_bf16(const float* xrow, const float* g, bf16* orow, int lane) {
    const f32x4* xr = (const f32x4*)xrow + lane; const f32x4* gr = (const f32x4*)g + lane;
    f32x4 v[4]; float s = 0.f;
#pragma unroll
    for (int j = 0; j < 4; ++j) { v[j] = xr[64 * j]; s += (v[j].x * v[j].x + v[j].y * v[j].y) + (v[j].z * v[j].z + v[j].w * v[j].w); }
    const float rs = rsqrtf(wave_sum(s) * (1.0f / DM) + EPS);
    unsigned long long* o8 = (unsigned long long*)orow + lane;
#pragma unroll
    for (int j = 0; j < 4; ++j) { const f32x4 gg = gr[64 * j]; o8[64 * j] = (unsigned long long)pk2(v[j].x * rs * gg.x, v[j].y * rs * gg.y) | ((unsigned long long)pk2(v[j].z * rs * gg.z, v[j].w * rs * gg.w) << 32); }
}
struct In {
    const float *x, *mem; const int* positions; const float *norm_mix_g, *w_in, *lq1, *lk1, *lq2, *lk2, *diff_norm_g, *w_alpha2, *b_alpha, *gla_norm_g, *w_out, *norm_cross_g, *norm_mem_g,
        *w_cq, *w_ck, *w_cv, *w_co, *norm_ffn_g, *w_router, *b_router, *w_up, *b_up, *w_down, *b_down, *norm_final_g;
};
__device__ __forceinline__ void p0_prologue(Frame& F, const In& I) {
    const int gw = F.vcu * NWAVES + F.wave, NGW = F.G * NWAVES, lane = lane_here();
    unsigned char* ws = F.ws;
    constexpr int I_IN = 16 * 48, I_SQ = 16 * 16, I_UP = 32 * 16 * 32, I_DN = 32 * 16 * 16;
    constexpr int NITEMS = I_IN + 5 * I_SQ + I_UP + I_DN;
    for (int it = gw; it < NITEMS; it += NGW) {
        int r = it;
        if (r < I_UP) { const int e = r / (16 * 32); r -= e * (16 * 32); const int n0 = 64 * (r % 32);
            const size_t orow = (size_t)e * 2048 + ((n0 & 1023) >> 7) * 256 + (n0 >> 10) * 128 + (n0 & 127);
            p0_transpose_item(I.w_up + (size_t)e * DM * 2048, 2048, I.norm_ffn_g, (bf16*)(ws + WS_WUP), DM, 64 * (r / 32), n0, orow, lane); continue; } r -= I_UP;
        if (r < I_DN) { const int e = r / (16 * 16); r -= e * (16 * 16);
            p0_transpose_item(I.w_down + (size_t)e * DM * DM, DM, nullptr, (bf16*)(ws + WS_WDN), DM, 64 * (r / 16), 64 * (r % 16), (size_t)e * 1024 + 64 * (r % 16), lane); continue; } r -= I_DN;
        if (r < I_IN) { p0_transpose_item(I.w_in, INW, nullptr, (bf16*)(ws + WS_WINT), DM, 64 * (r / 48), 64 * (r % 48), (size_t)64 * (r % 48), lane); continue; } r -= I_IN;
        { const int w = r / I_SQ; r -= w * I_SQ;
            const float* W = w == 0 ? I.w_out : w == 1 ? I.w_cq : w == 2 ? I.w_ck : w == 3 ? I.w_cv : I.w_co;
            bf16* WT = (bf16*)(ws + (w == 0 ? WS_WOUT : w == 1 ? WS_WCQ : w == 2 ? WS_WCK : w == 3 ? WS_WCV : WS_WCO));
            p0_transpose_item(W, DM, w == 1 ? I.norm_cross_g : nullptr, WT, DM, 64 * (r / 16), 64 * (r % 16), (size_t)64 * (r % 16), lane); }
    }
    const int gt = F.vcu * (NWAVES * 64) + F.tid, NGT = F.G * NWAVES * 64;
    for (int idx = gt; idx < 256 * DM; idx += NGT) { const int j = idx >> 10, k = idx & 1023; const float* wr = I.w_in + (size_t)k * INW + 3072; float s = 0.f;
#pragma unroll
        for (int r = 0; r < 16; ++r) s += wr[r] * I.w_alpha2[r * 256 + j];
        ((bf16*)(ws + WS_WINT))[(size_t)(3072 + j) * DM + k] = (bf16)f2bf(s); }
    for (int idx = gt; idx < DM * NEXP; idx += NGT) ((float*)(ws + WS_WR))[idx] = I.w_router[idx] * I.norm_ffn_g[idx >> 5];
    for (int idx = gt; idx < NTOK * 8; idx += NGT) { const int tok = idx >> 3, i = idx & 7;
        const double inv = exp(-(double)i * 0.125 * 13.122363377404328); const double ang = (double)I.positions[tok] * inv;
        const double red = ang - rint(ang * 0.15915494309189535) * 6.283185307179586; const float rf = (float)red;
        float* cs = (float*)(ws + WS_CS) + (size_t)tok * 16; cs[i] = cosf(rf); cs[8 + i] = sinf(rf); }
    for (int m = gw; m < NTOK + NMEM; m += NGW) {
        if (m < NTOK) rms_row_to_bf16(I.x + (size_t)m * DM, I.norm_mix_g, (bf16*)(ws + WS_HN) + (size_t)m * DM, lane);
        else rms_row_to_bf16(I.mem + (size_t)(m - NTOK) * DM, I.norm_mem_g, (bf16*)(ws + WS_MN) + (size_t)(m - NTOK) * DM, lane);
    }
}

constexpr int DA_KBUF = 8192, DA_VBUF = 10240, DA_VOFF = 2 * DA_KBUF;
__device__ __forceinline__ void diffattn_unit(Frame& F, const bf16* P, const bf16* VT, bf16* CAT, const float* gdiff, float lam, int b, int h, int qblk) {
    const int lane = lane_here(), wave = F.wave, tid = F.tid, l15 = lane & 15, g = lane >> 4;
    LAS unsigned char* lds = F.lds + RING_OFF;
    const int q0 = qblk * 128 + wave * 16;
    const size_t tokq = (size_t)b * SEQ + q0 + l15;
    bf16x8 qf[2][2];
#pragma unroll
    for (int c = 0; c < 2; ++c)
#pragma unroll
        for (int ks = 0; ks < 2; ++ks) qf[c][ks] = *(const bf16x8*)(P + tokq * PW + h * 128 + c * 64 + ks * 32 + g * 8);
    f32x4 o[2][8];
#pragma unroll
    for (int c = 0; c < 2; ++c)
#pragma unroll
        for (int k = 0; k < 8; ++k) o[c][k] = (f32x4){0.f, 0.f, 0.f, 0.f};
    float mrun[2] = {-INFINITY, -INFINITY}, lsum[2] = {0.f, 0.f};
    const int nk = q0 + 16;
    const int nt = 4 * qblk + 4;
    const int skey = tid >> 4, sch = tid & 15, vrow = tid >> 2, vpc = tid & 3;
    const bf16* ksrc = P + ((size_t)b * SEQ + skey) * PW + 512 + h * 128 + sch * 8;
    const bf16* vsrc = VT + (size_t)(h * 128 + vrow) * NTOK + (size_t)b * SEQ + vpc * 8;
    const int kdst = skey * 256 + ((sch ^ (skey & 15)) * 16), vdst = DA_VOFF + vrow * 80 + vpc * 16;
    int koff[2][2];
#pragma unroll
    for (int c = 0; c < 2; ++c)
#pragma unroll
        for (int ks = 0; ks < 2; ++ks) koff[c][ks] = l15 * 256 + (((c * 8 + ks * 4 + g) ^ l15) * 16);
    const int voff = DA_VOFF + l15 * 80 + g * 8;
    v4u sk = *(const v4u*)ksrc, sv = *(const v4u*)vsrc;
    *(LAS v4u*)(lds + kdst) = sk; *(LAS v4u*)(lds + vdst) = sv;
    __syncthreads();
    for (int t = 0; t < nt; ++t) {
        const int key0 = t * 32, buf = t & 1;
        if (t + 1 < nt) { sk = *(const v4u*)(ksrc + (size_t)(key0 + 32) * PW); sv = *(const v4u*)(vsrc + key0 + 32); }
        if (key0 < nk) {
            const LAS unsigned char* kb = lds + buf * DA_KBUF; const LAS unsigned char* vb = lds + buf * DA_VBUF + voff;
            f32x4 s[2][2];
#pragma unroll
            for (int c = 0; c < 2; ++c)
#pragma unroll
                for (int s2 = 0; s2 < 2; ++s2) { f32x4 a = (f32x4){0.f, 0.f, 0.f, 0.f};
#pragma unroll
                    for (int ks = 0; ks < 2; ++ks) { const bf16x8 kf = *(const LAS bf16x8*)(kb + s2 * 4096 + koff[c][ks]); a = mfma16(kf, qf[c][ks], a); }
                    s[c][s2] = a; }
            if (key0 + 31 > q0) {
                const int qrow = q0 + l15;
#pragma unroll
                for (int c = 0; c < 2; ++c)
#pragma unroll
                    for (int s2 = 0; s2 < 2; ++s2)
#pragma unroll
                        for (int r = 0; r < 4; ++r) if (key0 + s2 * 16 + 4 * g + r > qrow) s[c][s2][r] = -INFINITY;
            }
            float mnew[2]; bool grow = false;
#pragma unroll
            for (int c = 0; c < 2; ++c) {
                float mx = fmaxf(fmaxf(fmaxf(s[c][0][0], s[c][0][1]), fmaxf(s[c][0][2], s[c][0][3])), fmaxf(fmaxf(s[c][1][0], s[c][1][1]), fmaxf(s[c][1][2], s[c][1][3])));
                mx = fmaxf(mx, __shfl_xor(mx, 16)); mx = fmaxf(mx, __shfl_xor(mx, 32));
                mnew[c] = fmaxf(mrun[c], mx); grow = grow || (mnew[c] > mrun[c]); }
            if (__any(grow)) {
#pragma unroll
                for (int c = 0; c < 2; ++c) { const float alpha = __builtin_amdgcn_exp2f(mrun[c] - mnew[c]); mrun[c] = mnew[c]; lsum[c] *= alpha;
#pragma unroll
                    for (int k = 0; k < 8; ++k) o[c][k] = o[c][k] * alpha; }
            }
            bf16x8 pb[2];
#pragma unroll
            for (int c = 0; c < 2; ++c) { float ps = 0.f;
#pragma unroll
                for (int s2 = 0; s2 < 2; ++s2)
#pragma unroll
                    for (int r = 0; r < 4; ++r) { const float p = __builtin_amdgcn_exp2f(s[c][s2][r] - mrun[c]); s[c][s2][r] = p; ps += p; }
                lsum[c] += ps;
                v4u w; w.x = pg8::cvtpk(s[c][0][0], s[c][0][1]); w.y = pg8::cvtpk(s[c][0][2], s[c][0][3]); w.z = pg8::cvtpk(s[c][1][0], s[c][1][1]); w.w = pg8::cvtpk(s[c][1][2], s[c][1][3]);
                pb[c] = __builtin_bit_cast(bf16x8, w); }
#pragma unroll
            for (int k = 0; k < 8; ++k) { const v2u v0 = *(const LAS v2u*)(vb + k * 1280), v1 = *(const LAS v2u*)(vb + k * 1280 + 32);
                v4u vv; vv.x = v0.x; vv.y = v0.y; vv.z = v1.x; vv.w = v1.y; const bf16x8 vf = __builtin_bit_cast(bf16x8, vv);
                o[0][k] = mfma16(vf, pb[0], o[0][k]); o[1][k] = mfma16(vf, pb[1], o[1][k]); }
        }
        if (t + 1 < nt) { *(LAS v4u*)(lds + (buf ^ 1) * DA_KBUF + kdst) = sk; *(LAS v4u*)(lds + (buf ^ 1) * DA_VBUF + vdst) = sv; }
        __syncthreads();
    }
    float l0 = lsum[0], l1 = lsum[1];
    l0 += __shfl_xor(l0, 16); l0 += __shfl_xor(l0, 32); l1 += __shfl_xor(l1, 16); l1 += __shfl_xor(l1, 32);
    const float i0 = 1.0f / l0, i1 = lam / l1; float ss = 0.f;
#pragma unroll
    for (int k = 0; k < 8; ++k)
#pragma unroll
        for (int r = 0; r < 4; ++r) { const float v = o[0][k][r] * i0 - o[1][k][r] * i1; o[0][k][r] = v; ss += v * v; }
    ss += __shfl_xor(ss, 16); ss += __shfl_xor(ss, 32);
    const float rs = rsqrtf(ss * (1.0f / 128.0f) + EPS) * 0.8f;
    bf16* op = CAT + tokq * DM + h * 128 + 4 * g;
#pragma unroll
    for (int k = 0; k < 8; ++k) { const f32x4 gg = *(const f32x4*)(gdiff + k * 16 + 4 * g); f32x4 v = o[0][k] * rs; v = v * gg; pg8::st_bf4(op + k * 16, v); }
}

__device__ __forceinline__ bf16x8 pack8(const f32x4& a, const f32x4& b) { v4u w; w.x = pg8::cvtpk(a[0], a[1]); w.y = pg8::cvtpk(a[2], a[3]); w.z = pg8::cvtpk(b[0], b[1]); w.w = pg8::cvtpk(b[2], b[3]); return __builtin_bit_cast(bf16x8, w); }
constexpr int GL_QI = 0, GL_KI = 9216, GL_IMG = 18432, GL_EL = 2 * GL_IMG, GL_OB = GL_EL + 512, GL_OBS = 17408, GL_PS = GL_OB + 2 * GL_OBS, GL_END = GL_PS + 4096;
__device__ __forceinline__ bf16x8 ldfrag(const LAS unsigned char* p) { const v2u a = *(const LAS v2u*)p, b = *(const LAS v2u*)(p + 32); v4u w; w.x = a.x; w.y = a.y; w.z = b.x; w.w = b.y; return __builtin_bit_cast(bf16x8, w); }
__device__ __forceinline__ void gla_unit(Frame& F, const bf16* P, const float* Bc, const bf16* GVT, bf16* CAT, const float* ggla, int b, int h) {
    const int lane = lane_here(), l15 = lane & 15, g = lane >> 4, eb = F.wave, tid = F.tid;
    LAS unsigned char* lds = F.lds + RING_OFF;
    const f32x4 zero4 = {0.f, 0.f, 0.f, 0.f};
    f32x4 S[4] = {zero4, zero4, zero4, zero4};
    bf16x8 If[4];
#pragma unroll
    for (int db = 0; db < 4; ++db) { const int ks = db >> 1;
#pragma unroll
        for (int j = 0; j < 8; ++j) { const int dp = 32 * ks + (j < 4 ? 4 * g + j : 16 + 4 * g + j - 4); If[db][j] = (dp == 16 * db + l15) ? (short)0x3F80 : (short)0; } }
    const int st = tid >> 3, sp = tid & 7, opc = tid & 15;
    const size_t tokb = (size_t)b * SEQ;
    const bf16* qsrc = P + (tokb + st) * PW + 1536 + h * 64 + sp * 8;
    const float* bsrc = Bc + (tokb + st) * 256 + h * 64 + sp * 8;
    const bf16* Vrow = GVT + (size_t)(h * 128 + 16 * eb + l15) * NTOK + tokb + 4 * g;
    const f32x4 gg0 = *(const f32x4*)(ggla + opc * 8), gg1 = *(const f32x4*)(ggla + opc * 8 + 4);
    const int foff = l15 * 144 + 8 * g;
    v4u rq = *(const v4u*)qsrc, rk = *(const v4u*)(qsrc + 256); f32x4 rb0 = *(const f32x4*)bsrc, rb1 = *(const f32x4*)(bsrc + 4);
#define GLA_STAGE(par) do { \
        float ee[8]; _Pragma("unroll") for (int i = 0; i < 4; ++i) { ee[i] = __expf(rb0[i]); ee[4 + i] = __expf(rb1[i]); } \
        const unsigned qa[4] = {rq.x, rq.y, rq.z, rq.w}, ka[4] = {rk.x, rk.y, rk.z, rk.w}; v4u wq, wk; unsigned* wqp = (unsigned*)&wq; unsigned* wkp = (unsigned*)&wk; \
        _Pragma("unroll") for (int i = 0; i < 4; ++i) { const float q0 = __builtin_bit_cast(float, qa[i] << 16), q1 = __builtin_bit_cast(float, qa[i] & 0xffff0000u), k0 = __builtin_bit_cast(float, ka[i] << 16), k1 = __builtin_bit_cast(float, ka[i] & 0xffff0000u); \
            wqp[i] = pg8::cvtpk(q0 * ee[2 * i], q1 * ee[2 * i + 1]); wkp[i] = pg8::cvtpk(k0 * __builtin_amdgcn_rcpf(ee[2 * i]), k1 * __builtin_amdgcn_rcpf(ee[2 * i + 1])); } \
        *(LAS v4u*)(lds + (par) * GL_IMG + GL_QI + st * 144 + sp * 16) = wq; *(LAS v4u*)(lds + (par) * GL_IMG + GL_KI + st * 144 + sp * 16) = wk; \
        if (st == 63) { *(LAS f32x4*)(lds + GL_EL + (par) * 256 + sp * 32) = (f32x4){ee[0], ee[1], ee[2], ee[3]}; *(LAS f32x4*)(lds + GL_EL + (par) * 256 + sp * 32 + 16) = (f32x4){ee[4], ee[5], ee[6], ee[7]}; } } while (0)
    GLA_STAGE(0);
    __syncthreads();
    for (int c = 0; c < SEQ / 64; ++c) {
        const int par = c & 1; const size_t tok0 = tokb + c * 64;
        if (c + 1 < SEQ / 64) { rq = *(const v4u*)(qsrc + (size_t)(c + 1) * 64 * PW); rk = *(const v4u*)(qsrc + (size_t)(c + 1) * 64 * PW + 256);
            rb0 = *(const f32x4*)(bsrc + (size_t)(c + 1) * 64 * 256); rb1 = *(const f32x4*)(bsrc + (size_t)(c + 1) * 64 * 256 + 4); }
        bf16x8 VF[2];
#pragma unroll
        for (int ss = 0; ss < 2; ++ss) { const bf16* vp = Vrow + c * 64 + 32 * ss; const v2u v0 = *(const v2u*)vp, v1 = *(const v2u*)(vp + 16); v4u vv; vv.x = v0.x; vv.y = v0.y; vv.z = v1.x; vv.w = v1.y; VF[ss] = __builtin_bit_cast(bf16x8, vv); }
        v4u rg[2];
#pragma unroll
        for (int i = 0; i < 2; ++i) rg[i] = *(const v4u*)(P + (tok0 + ((tid + 512 * i) >> 4)) * PW + 2560 + h * 128 + opc * 8);
        const LAS unsigned char* qi = lds + par * GL_IMG + GL_QI + foff; const LAS unsigned char* ki = lds + par * GL_IMG + GL_KI + foff;
        bf16x8 qf[4][2], kf[4][2];
#pragma unroll
        for (int blk = 0; blk < 4; ++blk)
#pragma unroll
            for (int ks = 0; ks < 2; ++ks) { qf[blk][ks] = ldfrag(qi + blk * 2304 + ks * 64); kf[blk][ks] = ldfrag(ki + blk * 2304 + ks * 64); }
        const bf16x8 SF0 = pack8(S[0], S[1]), SF1 = pack8(S[2], S[3]);
        f32x4 O[4];
#pragma unroll
        for (int tb = 0; tb < 4; ++tb) { f32x4 o = mfma16(qf[tb][0], SF0, zero4); o = mfma16(qf[tb][1], SF1, o);
#pragma unroll
            for (int ss = 0; ss < 2; ++ss) if (2 * ss <= tb) { f32x4 a2[2];
#pragma unroll
                for (int hh = 0; hh < 2; ++hh) { const int sb = 2 * ss + hh; f32x4 a = zero4;
                    if (sb <= tb) { a = mfma16(kf[sb][0], qf[tb][0], zero4); a = mfma16(kf[sb][1], qf[tb][1], a);
                        if (sb == tb) {
#pragma unroll
                            for (int r = 0; r < 4; ++r) if (4 * g + r > l15) a[r] = 0.f; } }
                    a2[hh] = a; }
                o = mfma16(pack8(a2[0], a2[1]), VF[ss], o); }
            O[tb] = o; }
#pragma unroll
        for (int db = 0; db < 4; ++db) { f32x4 u = S[db];
#pragma unroll
            for (int ss = 0; ss < 2; ++ss) { const f32x4 t0 = mfma16(kf[2 * ss][db >> 1], If[db], zero4), t1 = mfma16(kf[2 * ss + 1][db >> 1], If[db], zero4); u = mfma16(pack8(t0, t1), VF[ss], u); }
            const f32x4 el = *(const LAS f32x4*)(lds + GL_EL + par * 256 + (16 * db + 4 * g) * 4);
            S[db] = u * el; }
        LAS unsigned char* ob = lds + GL_OB + par * GL_OBS; LAS float* ps = (LAS float*)(lds + GL_PS + par * 2048);
#pragma unroll
        for (int tb = 0; tb < 4; ++tb)
#pragma unroll
            for (int r = 0; r < 4; ++r) { const int t = 16 * tb + 4 * g + r; const float ov = O[tb][r]; float q = ov * ov; q += __shfl_xor(q, 1); q += __shfl_xor(q, 2); q += __shfl_xor(q, 4); q += __shfl_xor(q, 8);
                if (l15 == 0) ps[t * 8 + eb] = q;
                *(LAS bf16*)(ob + t * 272 + (16 * eb + l15) * 2) = (bf16)f2bf(ov); }
        if (c + 1 < SEQ / 64) GLA_STAGE(par ^ 1);
        __syncthreads();
#pragma unroll
        for (int i = 0; i < 2; ++i) { const int ot = (tid + 512 * i) >> 4; const f32x4 p0 = *(const LAS f32x4*)(ps + ot * 8), p1 = *(const LAS f32x4*)(ps + ot * 8 + 4);
            const float ss = ((p0[0] + p0[1]) + (p0[2] + p0[3])) + ((p1[0] + p1[1]) + (p1[2] + p1[3])); const float rs = rsqrtf(ss * (1.0f / 128.0f) + EPS);
            const v4u ov = *(const LAS v4u*)(ob + ot * 272 + opc * 16); const unsigned oa[4] = {ov.x, ov.y, ov.z, ov.w}, ga[4] = {rg[i].x, rg[i].y, rg[i].z, rg[i].w};
            const float gn[8] = {gg0[0], gg0[1], gg0[2], gg0[3], gg1[0], gg1[1], gg1[2], gg1[3]}; v4u w; unsigned* wp = (unsigned*)&w;
#pragma unroll
            for (int j = 0; j < 4; ++j) { const float o0 = __builtin_bit_cast(float, oa[j] << 16), o1 = __builtin_bit_cast(float, oa[j] & 0xffff0000u), g0 = __builtin_bit_cast(float, ga[j] << 16), g1 = __builtin_bit_cast(float, ga[j] & 0xffff0000u);
                wp[j] = pg8::cvtpk(o0 * rs * gn[2 * j] * (g0 / (1.0f + __expf(-g0))), o1 * rs * gn[2 * j + 1] * (g1 / (1.0f + __expf(-g1)))); }
            *(v4u*)(CAT + (tok0 + ot) * DM + 512 + h * 128 + opc * 8) = w; }
    }
#undef GLA_STAGE
    __syncthreads();
}

__device__ __forceinline__ void router_phase(Frame& F, const float* X2, const float* WR, const float* b_router, float* rsl, float* gate, unsigned* assign, unsigned* list, gu32* cnt) {
    LAS float* xs = (LAS float*)(F.lds + RING_OFF);
    LAS float* wsh = xs + 64 * 129;
    LAS float* lg = wsh + 128 * 32;
    const int tid = F.tid, t = tid & 63, eg = tid >> 6;
    for (int blk = F.vcu; blk < NTOK / 64; blk += F.G) {
        const size_t tok0 = (size_t)blk * 64;
        f32x4 acc = (f32x4){0.f, 0.f, 0.f, 0.f}; float ssq = 0.f;
        for (int kc = 0; kc < DM; kc += 128) {
            { const int row = tid >> 3;
#pragma unroll
              for (int i = 0; i < 4; ++i) { const int col = i * 32 + (tid & 7) * 4; const f32x4 v = *(const f32x4*)(X2 + (tok0 + row) * DM + kc + col);
                  LAS float* d = xs + row * 129 + col; d[0] = v.x; d[1] = v.y; d[2] = v.z; d[3] = v.w; }
#pragma unroll
              for (int i = 0; i < 2; ++i) { const int idx = (i * 512 + tid) * 4; *(LAS f32x4*)(wsh + idx) = *(const f32x4*)(WR + (size_t)kc * 32 + idx); } }
            __syncthreads();
            const LAS float* xr = xs + t * 129;
#pragma unroll 8
            for (int k = 0; k < 128; ++k) { const float xv = xr[k]; const f32x4 w = *(const LAS f32x4*)(wsh + k * 32 + eg * 4); acc = acc + w * xv; ssq += xv * xv; }
            __syncthreads();
        }
        const float rs = rsqrtf(ssq * (1.0f / DM) + EPS);
#pragma unroll
        for (int i = 0; i < 4; ++i) lg[t * 33 + eg * 4 + i] = acc[i] * rs + b_router[eg * 4 + i];
        __syncthreads();
        if (tid < 64) {
            float lv[32];
#pragma unroll
            for (int e = 0; e < 32; ++e) lv[e] = lg[t * 33 + e];
            float tv[4]; int te[4];
#pragma unroll
            for (int k = 0; k < 4; ++k) { float best = -INFINITY; int bi = 0;
#pragma unroll
                for (int e = 0; e < 32; ++e) if (lv[e] > best) { best = lv[e]; bi = e; }
                tv[k] = best; te[k] = bi;
#pragma unroll
                for (int e = 0; e < 32; ++e) if (e == bi) lv[e] = -INFINITY; }
            const float e1 = __expf(tv[1] - tv[0]), e2 = __expf(tv[2] - tv[0]), e3 = __expf(tv[3] - tv[0]); const float inv = 1.0f / (1.0f + e1 + e2 + e3);
            const float gv[4] = {inv, e1 * inv, e2 * inv, e3 * inv};
            const size_t tok = tok0 + t;
            LAS unsigned* hist = (LAS unsigned*)(lg + 64 * 33); LAS unsigned* gbase = hist + 32;
            if (t < 32) hist[t] = 0u;
            __builtin_amdgcn_wave_barrier(); LDS_WAIT();
            unsigned lpos[4];
#pragma unroll
            for (int k = 0; k < 4; ++k) lpos[k] = __hip_atomic_fetch_add(hist + te[k], 1u, __ATOMIC_RELAXED, __HIP_MEMORY_SCOPE_WORKGROUP);
            __builtin_amdgcn_wave_barrier(); LDS_WAIT();
            if (t < 32) { const unsigned n = hist[t]; gbase[t] = n ? __hip_atomic_fetch_add(cnt + 64 * t, n, RLX_AGENT) : 0u; }
            __builtin_amdgcn_wave_barrier(); LDS_WAIT();
#pragma unroll
            for (int k = 0; k < 4; ++k) { const unsigned pos = gbase[te[k]] + lpos[k]; list[(size_t)te[k] * NTOK + pos] = (unsigned)tok; rsl[(size_t)te[k] * NTOK + pos] = rs;
                assign[tok * 4 + k] = ((unsigned)te[k] << 16) | pos; gate[tok * 4 + k] = gv[k]; }
        }
        __syncthreads();
    }
}
__device__ __forceinline__ int moe_tables(Frame& F) {
    LAS unsigned char* tile_e = F.lds + TAB_OFF; LAS int* tstart = (LAS int*)(F.lds + TAB_TSTART); LAS int* lc = (LAS int*)(F.lds + TAB_CNT);
    if (F.tid < 32) lc[F.tid] = (int)__hip_atomic_load(F.ctl + CW_CNT + 64 * F.tid, RLX_AGENT);
    __syncthreads();
    if (F.tid == 0) { int s = 0; for (int e = 0; e < 32; ++e) { tstart[e] = s; s += (lc[e] + 255) >> 8; } tstart[32] = s; }
    __syncthreads();
    const int T = tstart[32];
    for (int i = F.tid; i < T; i += 512) { int e = 0;
#pragma unroll
        for (int k = 1; k < 32; ++k) e += (tstart[k] <= i) ? 1 : 0;
        tile_e[i] = (unsigned char)e; }
    __syncthreads();
    return T;
}
__device__ __forceinline__ void final_phase(Frame& F, float* out, const bf16* Y, const float* gate, const unsigned* assign, const float* gfin) {
    (void)moe_tables(F);
    const LAS int* tstart = (const LAS int*)(F.lds + TAB_TSTART);
    const int gw = F.vcu * NWAVES + F.wave, NGW = F.G * NWAVES, lane = lane_here();
    for (int tok = gw; tok < NTOK; tok += NGW) {
        f32x4* xr = (f32x4*)(out + (size_t)tok * DM) + lane; f32x4 v[4];
#pragma unroll
        for (int j = 0; j < 4; ++j) v[j] = xr[64 * j];
#pragma unroll
        for (int k = 0; k < 4; ++k) { const unsigned a = assign[(size_t)tok * 4 + k]; const float gk = gate[(size_t)tok * 4 + k]; const size_t row = (size_t)tstart[a >> 16] * 256 + (a & 0xffffu);
            const v2u* yr = (const v2u*)(Y + row * DM) + lane;
#pragma unroll
            for (int j = 0; j < 4; ++j) { const v2u w = yr[64 * j]; v[j].x += gk * __builtin_bit_cast(float, w.x << 16); v[j].y += gk * __builtin_bit_cast(float, w.x & 0xffff0000u);
                v[j].z += gk * __builtin_bit_cast(float, w.y << 16); v[j].w += gk * __builtin_bit_cast(float, w.y & 0xffff0000u); } }
        float s = 0.f;
#pragma unroll
        for (int j = 0; j < 4; ++j) s += (v[j].x * v[j].x + v[j].y * v[j].y) + (v[j].z * v[j].z + v[j].w * v[j].w);
        const float rs = rsqrtf(wave_sum(s) * (1.0f / DM) + EPS);
#pragma unroll
        for (int j = 0; j < 4; ++j) { const f32x4 gg = ((const f32x4*)gfin)[lane + 64 * j]; xr[64 * j] = v[j] * rs * gg; }
    }
}

constexpr int NPHASE = 12;
struct Args { const void* in[28]; float* out; unsigned char* ws; int ph_lo, ph_hi; };
__global__ void __launch_bounds__(NWAVES * 64, 2) mk_fwd(Args args) {
    extern __shared__ __attribute__((aligned(16))) unsigned char lds[];
    Frame F;
    F.lds = (LAS unsigned char*)lds;
    F.MISC = (volatile LAS unsigned*)(F.lds + MISC_OFF);
    F.tid = threadIdx.x; F.lane = F.tid & 63; F.wave = __builtin_amdgcn_readfirstlane(F.tid >> 6);
    F.G = gridDim.x; { const int bx = blockIdx.x; F.vcu = (F.G % 8 == 0) ? (bx % 8) * (F.G / 8) + bx / 8 : bx; }
    F.ws = args.ws; F.out = args.out; F.ctl = (gu32*)(args.ws + WS_CTL);
    unsigned char* ws = args.ws;
    typedef const void* const volatile __attribute__((address_space(4))) kargp_t;
    kargp_t* const kargs = (kargp_t*)__builtin_amdgcn_kernarg_segment_ptr();
#define INP(k) ((const float*)kargs[k])
    for (int u = F.tid; u < (LDS_BYTES - LDSCTL_OFF) / 4; u += NWAVES * 64) ((LAS unsigned*)(F.lds + LDSCTL_OFF))[u] = 0u;
    __syncthreads();
    const int lo = args.ph_lo, hi = args.ph_hi;
    const bool single = (hi - lo) > 1;
    XcdBarrier bar; bar.bar = (unsigned*)(F.ctl + CW_BAR); bar.x = 0; bar.st = nullptr;
    if (single) bar = xcd_barrier_post((unsigned*)(F.ctl + CW_BAR), F.MISC + 8);
#define IN(k) (lo <= (k) && (k) < hi)
#if defined(PROBE_K0)
    LAS unsigned long long* tsl = (LAS unsigned long long*)(F.lds + TS_OFF);
    if (F.tid == 0) tsl[0] = rt();
#define SEAM(k) do { if (IN(k) && IN((k) + 1)) xcd_barrier(bar); if (F.tid == 0) tsl[(k) + 1] = rt(); } while (0)
#else
#define SEAM(k) do { if (IN(k) && IN((k) + 1)) xcd_barrier(bar); } while (0)
#endif
    typedef pg8::bf16_t hb;
    const int bx = (int)blockIdx.x;

    if (IN(0)) { In I;
        I.x = (const float*)INP(0);
        I.mem = (const float*)INP(1);
        I.positions = (const int*)INP(2);
        I.norm_mix_g = (const float*)INP(3);
        I.w_in = (const float*)INP(4);
        I.lq1 = (const float*)INP(5);
        I.lk1 = (const float*)INP(6);
        I.lq2 = (const float*)INP(7);
        I.lk2 = (const float*)INP(8);
        I.diff_norm_g = (const float*)INP(9);
        I.w_alpha2 = (const float*)INP(10);
        I.b_alpha = (const float*)INP(11);
        I.gla_norm_g = (const float*)INP(12);
        I.w_out = (const float*)INP(13);
        I.norm_cross_g = (const float*)INP(14);
        I.norm_mem_g = (const float*)INP(15);
        I.w_cq = (const float*)INP(16);
        I.w_ck = (const float*)INP(17);
        I.w_cv = (const float*)INP(18);
        I.w_co = (const float*)INP(19);
        I.norm_ffn_g = (const float*)INP(20);
        I.w_router = (const float*)INP(21);
        I.b_router = (const float*)INP(22);
        I.w_up = (const float*)INP(23);
        I.b_up = (const float*)INP(24);
        I.w_down = (const float*)INP(25);
        I.b_down = (const float*)INP(26);
        I.norm_final_g = (const float*)INP(27);
        p0_prologue(F, I); }
    SEAM(0);
    if (IN(1)) {
        { pg8::Gemm g{(const hb*)(ws + WS_HN), (const hb*)(ws + WS_WINT), NTOK, 3328, DM, DM, DM}; pg8::OrderMap S; S.init(128, 9, F.G, bx);
          pg8::EpiProj E{(hb*)(ws + WS_P), (float*)(ws + WS_LA), (const float*)(ws + WS_CS), INP(11)};
          pg8::gemm_phase<pg8::EpiProj, pg8::OrderMap, true, true>(F.lds + RING_OFF, g, S, E); }
        { pg8::Gemm g{(const hb*)(ws + WS_WINT), (const hb*)(ws + WS_HN), 3328, NTOK, DM, DM, DM}; pg8::OrderVT S; S.init(128, F.G, bx);
          pg8::EpiPlain E{(hb*)(ws + WS_VT) - (size_t)1024 * NTOK, NTOK, 1.0f};
          pg8::gemm_phase<pg8::EpiPlain, pg8::OrderVT, true, true>(F.lds + RING_OFF, g, S, E); }
        { pg8::Gemm g{(const hb*)(ws + WS_MN), (const hb*)(ws + WS_WCK), NMEM, DM, DM, DM, DM}; pg8::StaticOrder S; S.init(NMEM, DM, F.G, bx);
          pg8::EpiPlain E{(hb*)(ws + WS_KX), DM, 1.0f};
          pg8::gemm_phase<pg8::EpiPlain, pg8::StaticOrder, true, true>(F.lds + RING_OFF, g, S, E); }
        { pg8::Gemm g{(const hb*)(ws + WS_WCV), (const hb*)(ws + WS_MN), DM, NMEM, DM, DM, DM}; pg8::StaticOrder S; S.init(DM, NMEM, F.G, (bx + 64) % F.G);
          pg8::EpiPlain E{(hb*)(ws + WS_VXT), NMEM, 1.0f};
          pg8::gemm_phase<pg8::EpiPlain, pg8::StaticOrder, true, true>(F.lds + RING_OFF, g, S, E); }
    }
    SEAM(1);
    if (IN(2)) {
        float lam;
        { const int ln = lane_here(); const float a = INP(5)[ln] * INP(6)[ln], c = INP(7)[ln] * INP(8)[ln]; lam = __expf(wave_sum(a)) - __expf(wave_sum(c)) + 0.2f; }
        LAS int* qslot = (LAS int*)(F.lds + TAB_OFF);
#if defined(PROBE_GLA)
        const unsigned long long p2t0 = rt();
#endif
        for (;;) {
            if (F.tid == 0) qslot[0] = (int)__hip_atomic_fetch_add(F.ctl + CW_Q2, 1u, RLX_AGENT);
            __syncthreads();
            const int u = qslot[0];
            __syncthreads();
            if (u >= 64 + 1024) break;
            if (u < 64) { gla_unit(F, (const bf16*)(ws + WS_P), (const float*)(ws + WS_LA), (const bf16*)(ws + WS_GVT), (bf16*)(ws + WS_CAT), INP(12), u >> 2, u & 3);
#if defined(PROBE_GLA)
                if (F.tid == 0) { const unsigned dtv = (unsigned)(rt() - p2t0); __hip_atomic_fetch_max(F.ctl + CW_PROBE, dtv, RLX_AGENT); }
#endif
            }
            else { const int v = u - 64, bh = v & 63, qb = 15 - (v >> 6);
                diffattn_unit(F, (const bf16*)(ws + WS_P), (const bf16*)(ws + WS_VT), (bf16*)(ws + WS_CAT), INP(9), lam, bh >> 2, bh & 3, qb); }
        }
    }
    SEAM(2);
    if (IN(3)) {
        pg8::Gemm g{(const hb*)(ws + WS_CAT), (const hb*)(ws + WS_WOUT), NTOK, DM, DM, DM, DM}; pg8::StaticOrder S; S.init(NTOK, DM, F.G, bx);
        pg8::EpiRes1 E{INP(0), F.out, (hb*)(ws + WS_X1B), (float*)(ws + WS_SSP1)};
        pg8::gemm_phase<pg8::EpiRes1, pg8::StaticOrder, true, true>(F.lds + RING_OFF, g, S, E);
    }
    SEAM(3);
    if (IN(4)) {
        pg8::Gemm g{(const hb*)(ws + WS_X1B), (const hb*)(ws + WS_WCQ), NTOK, DM, DM, DM, DM}; pg8::StaticOrder S; S.init(NTOK, DM, F.G, bx);
        pg8::EpiQX E{(hb*)(ws + WS_QX), (const float*)(ws + WS_SSP1)};
        pg8::gemm_phase<pg8::EpiQX, pg8::StaticOrder, true, true>(F.lds + RING_OFF, g, S, E);
    }
    SEAM(4);
    if (IN(5)) {
        pg8::Gemm g{(const hb*)(ws + WS_QX), (const hb*)(ws + WS_KX), NTOK, 256, 256, DM, DM}; pg8::OrderX1 S; S.init(F.G, bx);
        pg8::EpiSoftmax E{(hb*)(ws + WS_PX), (float*)(ws + WS_SSP1), (PG8_LAS float*)(F.lds + XCH_OFF)};
        pg8::gemm_phase<pg8::EpiSoftmax, pg8::OrderX1, true, true>(F.lds + RING_OFF, g, S, E);
    }
    SEAM(5);
    if (IN(6)) {
        pg8::Gemm g{(const hb*)(ws + WS_PX), (const hb*)(ws + WS_VXT), NTOK, 256, 256, DM, NMEM}; pg8::OrderX2 S; S.init(F.G, bx);
        pg8::EpiPV E{(hb*)(ws + WS_OX), (const float*)(ws + WS_SSP1)};
        pg8::gemm_phase<pg8::EpiPV, pg8::OrderX2, true, true>(F.lds + RING_OFF, g, S, E);
    }
    SEAM(6);
    if (IN(7)) {
        pg8::Gemm g{(const hb*)(ws + WS_OX), (const hb*)(ws + WS_WCO), NTOK, DM, DM, DM, DM}; pg8::StaticOrder S; S.init(NTOK, DM, F.G, bx);
        pg8::EpiRes2 E{F.out, (hb*)(ws + WS_X2B)};
        pg8::gemm_phase<pg8::EpiRes2, pg8::StaticOrder, true, true>(F.lds + RING_OFF, g, S, E);
    }
    SEAM(7);
    if (IN(8)) router_phase(F, F.out, (const float*)(ws + WS_WR), INP(22), (float*)(ws + WS_RSL), (float*)(ws + WS_GATE), (unsigned*)(ws + WS_ASSIGN), (unsigned*)(ws + WS_LIST), F.ctl + CW_CNT);
    SEAM(8);
    if (IN(9)) {
        const int T = moe_tables(F);
        pg8::Gemm g{(const hb*)(ws + WS_X2B), (const hb*)(ws + WS_WUP), T * 256, NEXP * 2048, DM, DM, DM}; pg8::MoeOrderG S;
        S.init(T, 8, F.G, bx, (const PG8_LAS unsigned char*)(F.lds + TAB_OFF), (const PG8_LAS int*)(F.lds + TAB_TSTART), (const PG8_LAS int*)(F.lds + TAB_CNT), (const unsigned*)(ws + WS_LIST), (PG8_LAS unsigned*)(F.lds + XCH_OFF));
        pg8::EpiUp E{(hb*)(ws + WS_ACT), (const float*)(ws + WS_RSL), (const PG8_LAS int*)(F.lds + TAB_TSTART), (const PG8_LAS int*)(F.lds + TAB_CNT), INP(24)};
        pg8::gemm_phase<pg8::EpiUp, pg8::MoeOrderG, true, true>(F.lds + RING_OFF, g, S, E);
    }
    SEAM(9);
    if (IN(10)) {
        const int T = moe_tables(F);
        pg8::Gemm g{(const hb*)(ws + WS_ACT), (const hb*)(ws + WS_WDN), T * 256, NEXP * 1024, DM, DM, DM}; pg8::MoeOrder S; S.init(T, 4, F.G, bx, (const PG8_LAS unsigned char*)(F.lds + TAB_OFF));
        pg8::EpiDown E{(hb*)(ws + WS_Y), INP(26)};
        pg8::gemm_phase<pg8::EpiDown, pg8::MoeOrder, true, true>(F.lds + RING_OFF, g, S, E);
    }
    SEAM(10);
    if (IN(11)) final_phase(F, F.out, (const bf16*)(ws + WS_Y), (const float*)(ws + WS_GATE), (const unsigned*)(ws + WS_ASSIGN), INP(27));
#if defined(PROBE_K0)
    { if (F.tid == 0) { tsl[NPHASE] = rt();
        const int ks[2] = {PROBE_K0, PROBE_K1}; unsigned long long code = 0, mul = 1;
        for (int i = 0; i < 2; ++i) { unsigned long long dt = tsl[ks[i] + 1] - tsl[ks[i]]; unsigned long long q = (dt + 800) / 1600; if (q > 63) q = 63; code += q * mul; mul *= 64; }
        tsl[15] = code * 6400ull; }
      __syncthreads();
      const unsigned long long t0 = rt(), wait = tsl[15]; float x = (float)F.tid, y = 1.0001f;
      while (rt() - t0 < wait) {
#pragma unroll
          for (int i = 0; i < 64; ++i) x = x * y + 0.5f; }
      if (x == 12345.678f) F.out[0] = x; }
#endif
#undef IN
#undef SEAM
}

#ifndef MK_N_LAUNCHES
#define MK_N_LAUNCHES 1
#endif
extern "C" void kernel_launch(void* const* d_in, const int* in_sizes, int n_in, void* d_out, int out_size, void* d_ws, size_t ws_size, hipStream_t stream) {
    static int grid = 0;
    if (grid == 0) {
        if (n_in != 28 || out_size != NTOK * DM || ws_size < WS_END) { fprintf(stderr, "kernel_launch: unexpected shapes: n_in %d out %d ws %zu (need %zu)\n", n_in, out_size, ws_size, (size_t)WS_END); grid = -1; return; }
        int dev = 0, cus = 0, per_cu = 0;
        if (hipGetDevice(&dev) != hipSuccess || hipDeviceGetAttribute(&cus, hipDeviceAttributeMultiprocessorCount, dev) != hipSuccess) { fprintf(stderr, "kernel_launch: device query failed\n"); grid = -1; return; }
        if (hipFuncSetAttribute((const void*)mk_fwd, hipFuncAttributeMaxDynamicSharedMemorySize, LDS_BYTES) != hipSuccess) { fprintf(stderr, "kernel_launch: hipFuncSetAttribute failed\n"); grid = -1; return; }
        if (hipOccupancyMaxActiveBlocksPerMultiprocessor(&per_cu, (const void*)mk_fwd, NWAVES * 64, LDS_BYTES) != hipSuccess || per_cu < 1) { fprintf(stderr, "kernel_launch: occupancy query reports %d workgroups per CU\n", per_cu); (void)hipGetLastError(); grid = -1; return; }
        grid = cus;
    }
    if (grid < 0) return;
    (void)hipMemsetAsync((char*)d_ws + WS_CTL, 0, CTL_ZERO_BYTES, stream);
    Args a{};
    for (int i = 0; i < 28; ++i) a.in[i] = d_in[i];
    a.out = (float*)d_out; a.ws = (unsigned char*)d_ws;
    if (MK_N_LAUNCHES == 1) { a.ph_lo = 0; a.ph_hi = NPHASE; hipLaunchKernelGGL(mk_fwd, dim3(grid), dim3(NWAVES * 64), LDS_BYTES, stream, a); }
    else for (int p = 0; p < NPHASE; ++p) { a.ph_lo = p; a.ph_hi = p + 1; hipLaunchKernelGGL(mk_fwd, dim3(grid), dim3(NWAVES * 64), LDS_BYTES, stream, a); }
}
```

```cpp
#include <hip/hip_runtime.h>
#include <cstdio>
#include <cstdint>
namespace pg8 {
#define PG8_LAS __attribute__((address_space(3)))
typedef unsigned short bf16_t;
typedef short bf16x8 __attribute__((ext_vector_type(8)));
typedef float f32x4 __attribute__((ext_vector_type(4)));
typedef unsigned u32x4 __attribute__((ext_vector_type(4)));
constexpr int BM = 256, BK = 64, HALF = 128, HTB = HALF * BK * 2  , STAGE_BYTES = 8 * HTB, NXCD = 8, WGM = 8;

__host__ __device__ __forceinline__ int lds_byte(int r, int c) { const int st = (r >> 4) * 2 + (c >> 5), rr = r & 15, cc = c & 31, ob = rr * 64 + cc * 2; return st * 1024 + (ob ^ (((ob >> 9) & 1) << 5)); }
__host__ __device__ __forceinline__ void stage_rc(int b, int& R, int& C) { const int st = b / 1024, sb = b % 1024, swz = sb ^ (((sb >> 9) & 1) << 5); R = (st >> 1) * 16 + swz / 64; C = (st & 1) * 32 + (swz % 64) / 2; }
__host__ __device__ __forceinline__ int perm32(int rho) { const int n = rho >> 4, i = rho & 15; return 8 * (i >> 2) + 4 * n + (i & 3); }

struct Unit { int pm, pn; };
struct Gemm { const bf16_t* A; const bf16_t* Bt; int M, N, K, lda, ldb, sa, sb; };
struct OrderBase {
    static constexpr bool GATHER = false;
    __device__ __forceinline__ const char* a_base(const Gemm& g, const Unit& u) const { return (const char*)g.A + (size_t)u.pm * 256 * g.lda * 2; }
    __device__ __forceinline__ const char* b_base(const Gemm& g, const Unit& u) const { return (const char*)g.Bt + (size_t)u.pn * 256 * g.ldb * 2; }
    __device__ __forceinline__ void a_ready(const Unit&) const {}
    __device__ __forceinline__ void done(const Unit&) const {}
};

struct StaticOrder : OrderBase {
    int nM, nN, nwg, G, c;
    __host__ __device__ void init(int M, int N, int G_, int c_) { nM = M / BM; nN = N / BM; nwg = nM * nN; G = G_; c = c_; }
    __host__ __device__ bool next(int i, Unit& u) const {
        const long L = (long)i * G + c; if (L >= nwg) return false;
        int wgid = (int)L; { const int q = nwg / NXCD, r = nwg % NXCD, xcd = wgid % NXCD, off = wgid / NXCD; wgid = (xcd < r ? xcd * (q + 1) : r * (q + 1) + (xcd - r) * q) + off; }
        const int nig = WGM * nN, gid = wgid / nig, fm = gid * WGM, gsz = (nM - fm) < WGM ? (nM - fm) : WGM;
        u.pm = fm + ((wgid % nig) % gsz); u.pn = (wgid % nig) / gsz; return true;
    }
};

typedef unsigned u32x2 __attribute__((ext_vector_type(2)));
typedef float f32x2_t __attribute__((ext_vector_type(2)));
typedef __bf16 bf16x2_t __attribute__((ext_vector_type(2)));
__device__ __forceinline__ unsigned cvtpk(float lo, float hi) { f32x2_t v = {lo, hi}; bf16x2_t b = __builtin_convertvector(v, bf16x2_t); return __builtin_bit_cast(unsigned, b); }
__device__ __forceinline__ void st_bf4(bf16_t* p, f32x4 v) { u32x2 w; w.x = cvtpk(v[0], v[1]); w.y = cvtpk(v[2], v[3]); *(u32x2*)p = w; }
__device__ __forceinline__ unsigned cvt4_fp8(f32x4 v) { unsigned w = __builtin_amdgcn_cvt_pk_fp8_f32(v[0], v[1], 0, false); return __builtin_amdgcn_cvt_pk_fp8_f32(v[2], v[3], w, true); }
__device__ __forceinline__ float bf2f(bf16_t b) { return __builtin_bit_cast(float, (unsigned)b << 16); }
#define EPI_ROWS _Pragma("unroll") for (int ai = 0; ai < 2; ++ai) _Pragma("unroll") for (int m = 0; m < 4; ++m)
#define EPI_COLS _Pragma("unroll") for (int bj = 0; bj < 2; ++bj) _Pragma("unroll") for (int n = 0; n < 2; ++n)
constexpr float LOG2E = 1.4426950408889634f;
constexpr float QSCALE_DA = 0.125f * LOG2E;
constexpr float QSCALE_X = 0.0625f * LOG2E;

struct EpiPlain {
    static constexpr bool PERM = false, AFTER_DRAIN = false;
    bf16_t* O; int ldc; float scale;
    __device__ __forceinline__ void operator()(const f32x4 (&acc)[2][2][4][2], const Unit& u, int wr, int wc, int fr, int fq) const {
        EPI_ROWS { const int row = u.pm * 256 + ai * 128 + wr * 64 + m * 16 + fr; bf16_t* rp = O + (size_t)row * ldc + u.pn * 256 + wc * 32 + fq * 4;
            EPI_COLS st_bf4(rp + bj * 128 + n * 16, acc[ai][bj][m][n] * scale); }
    }
};
struct EpiProj {
    static constexpr bool PERM = false, AFTER_DRAIN = false;
    bf16_t* P; float* LA; const float* cs; const float* b_alpha;
    template <int ai> __device__ __forceinline__ void decay_rows(const f32x4 (&acc)[2][2][4][2], const Unit& u, int wr, int wc, int fr, int fq) const {
        const int row0 = u.pm * 256 + ai * 128 + wr * 64 + fr;
        EPI_COLS { const int col = bj * 128 + wc * 32 + n * 16 + fq * 4; const f32x4 ba = *(const f32x4*)(b_alpha + col); f32x4 run = {0.f, 0.f, 0.f, 0.f};
            _Pragma("unroll") for (int m = 0; m < 4; ++m) { const f32x4 z = acc[ai][bj][m][n] + ba; f32x4 o;
                _Pragma("unroll") for (int i = 0; i < 4; ++i) { float v = (fminf(z[i], 0.f) - __logf(1.0f + __expf(-fabsf(z[i])))) * 0.0625f;
                    { float t = __shfl_up(v, 1, 16); if (fr >= 1) v += t; t = __shfl_up(v, 2, 16); if (fr >= 2) v += t; t = __shfl_up(v, 4, 16); if (fr >= 4) v += t; t = __shfl_up(v, 8, 16); if (fr >= 8) v += t; }
                    o[i] = v + run[i]; run[i] += __shfl(v, 15, 16); }
                *(f32x4*)(LA + (size_t)(row0 + m * 16) * 256 + col) = o; } }
    }
    __device__ __forceinline__ void operator()(const f32x4 (&acc)[2][2][4][2], const Unit& u, int wr, int wc, int fr, int fq) const {
        const int pn = u.pn;
        if (pn < 4) {
            const float sc = pn < 2 ? QSCALE_DA : 1.0f; const bool ropew = (wc & 1) == 0; const bool hi = (fq >> 1) != 0;
            EPI_ROWS { const int row = u.pm * 256 + ai * 128 + wr * 64 + m * 16 + fr; bf16_t* rp = P + (size_t)row * 3072 + pn * 256 + wc * 32 + fq * 4;
                f32x4 cv = {1.f, 1.f, 1.f, 1.f}, sv = {0.f, 0.f, 0.f, 0.f};
                if (ropew) { cv = *(const f32x4*)(cs + (size_t)row * 16 + 4 * (fq & 1)); sv = *(const f32x4*)(cs + (size_t)row * 16 + 8 + 4 * (fq & 1)); }
                EPI_COLS { f32x4 v = acc[ai][bj][m][n];
                    if (n == 0 && ropew) { f32x4 p; p[0] = __shfl_xor(v[0], 32); p[1] = __shfl_xor(v[1], 32); p[2] = __shfl_xor(v[2], 32); p[3] = __shfl_xor(v[3], 32);
                        v = hi ? (v * cv + p * sv) : (v * cv - p * sv); }
                    st_bf4(rp + bj * 128 + n * 16, v * sc); } }
        } else if (pn < 12) {
            const float sc = pn == 6 ? 0.125f : 1.0f;
            EPI_ROWS { const int row = u.pm * 256 + ai * 128 + wr * 64 + m * 16 + fr; bf16_t* rp = P + (size_t)row * 3072 + pn * 256 + wc * 32 + fq * 4;
                EPI_COLS st_bf4(rp + bj * 128 + n * 16, acc[ai][bj][m][n] * sc); }
        } else {
            decay_rows<0>(acc, u, wr, wc, fr, fq); decay_rows<1>(acc, u, wr, wc, fr, fq);
        }
    }
};
struct EpiRes1 {
    static constexpr bool PERM = false, AFTER_DRAIN = false;
    const float* base; float* out; bf16_t* xb; float* ssp;
    __device__ __forceinline__ void operator()(const f32x4 (&acc)[2][2][4][2], const Unit& u, int wr, int wc, int fr, int fq) const {
        EPI_ROWS { const int row = u.pm * 256 + ai * 128 + wr * 64 + m * 16 + fr; const size_t off = (size_t)row * 1024 + u.pn * 256 + wc * 32 + fq * 4; float ss = 0.f;
            EPI_COLS { const size_t o2 = off + bj * 128 + n * 16; const f32x4 v = *(const f32x4*)(base + o2) + acc[ai][bj][m][n]; *(f32x4*)(out + o2) = v; st_bf4(xb + o2, v);
                ss += (v[0] * v[0] + v[1] * v[1]) + (v[2] * v[2] + v[3] * v[3]); }
            ss += __shfl_xor(ss, 16); ss += __shfl_xor(ss, 32);
            if (fq == 0) ssp[(size_t)row * 16 + u.pn * 4 + wc] = ss; }
    }
};
struct EpiQX {
    static constexpr bool PERM = false, AFTER_DRAIN = false;
    bf16_t* O; const float* ssp;
    __device__ __forceinline__ void operator()(const f32x4 (&acc)[2][2][4][2], const Unit& u, int wr, int wc, int fr, int fq) const {
        EPI_ROWS { const int row = u.pm * 256 + ai * 128 + wr * 64 + m * 16 + fr; const f32x4* sp = (const f32x4*)(ssp + (size_t)row * 16);
            const f32x4 a = sp[0], b = sp[1], c = sp[2], d = sp[3]; const float ss = ((a[0] + a[1]) + (a[2] + a[3])) + ((b[0] + b[1]) + (b[2] + b[3])) + ((c[0] + c[1]) + (c[2] + c[3])) + ((d[0] + d[1]) + (d[2] + d[3]));
            const float rs = rsqrtf(ss * (1.0f / 1024.0f) + 1e-6f) * QSCALE_X; bf16_t* rp = O + (size_t)row * 1024 + u.pn * 256 + wc * 32 + fq * 4;
            EPI_COLS st_bf4(rp + bj * 128 + n * 16, acc[ai][bj][m][n] * rs); }
    }
};
struct EpiRes2 {
    static constexpr bool PERM = false, AFTER_DRAIN = false;
    float* out; unsigned char* xb;
    __device__ __forceinline__ void operator()(const f32x4 (&acc)[2][2][4][2], const Unit& u, int wr, int wc, int fr, int fq) const {
        EPI_ROWS { const int row = u.pm * 256 + ai * 128 + wr * 64 + m * 16 + fr; float* rp = out + (size_t)row * 1024 + u.pn * 256 + wc * 32 + fq * 4;
            unsigned char* bp = xb + (size_t)row * 1024 + u.pn * 256 + wc * 32 + fq * 4;
            EPI_COLS { f32x4* p = (f32x4*)(rp + bj * 128 + n * 16); const f32x4 v = *p + acc[ai][bj][m][n]; *p = v; *(unsigned*)(bp + bj * 128 + n * 16) = cvt4_fp8(v); } }
    }
};
struct EpiUp {
    static constexpr bool PERM = false, AFTER_DRAIN = false;
    unsigned char* ACT; const float* rsl; const PG8_LAS int* tstart; const PG8_LAS int* cnt; const float* b_up;
    __device__ __forceinline__ void operator()(const f32x4 (&acc)[2][2][4][2], const Unit& u, int wr, int wc, int fr, int fq) const {
        const int e = u.pn >> 3, pnl = u.pn & 7; const float* bg = b_up + (size_t)e * 2048 + pnl * 128 + wc * 32 + fq * 4;
        const int pos0 = (u.pm - tstart[e]) * 256 + wr * 64 + fr, nv = cnt[e]; const float* rp0 = rsl + (size_t)e * 32768 + pos0;
        EPI_ROWS { const int row = u.pm * 256 + ai * 128 + wr * 64 + m * 16 + fr; const float rs = (pos0 + ai * 128 + m * 16) < nv ? rp0[ai * 128 + m * 16] : 0.f;
            unsigned char* rp = ACT + (size_t)row * 1024 + pnl * 128 + wc * 32 + fq * 4;
            _Pragma("unroll") for (int n = 0; n < 2; ++n) { const f32x4 g = acc[ai][0][m][n] * rs + *(const f32x4*)(bg + n * 16), l = acc[ai][1][m][n] * rs + *(const f32x4*)(bg + 1024 + n * 16); f32x4 o;
                _Pragma("unroll") for (int i = 0; i < 4; ++i) { const float gl = fminf(g[i], 7.0f), li = fminf(fmaxf(l[i], -7.0f), 7.0f); o[i] = gl / (1.0f + __expf(-1.702f * gl)) * (li + 1.0f); }
                *(unsigned*)(rp + n * 16) = cvt4_fp8(o); } }
    }
};
struct EpiDown {
    static constexpr bool PERM = false, AFTER_DRAIN = false;
    bf16_t* Y; const float* b_down;
    __device__ __forceinline__ void operator()(const f32x4 (&acc)[2][2][4][2], const Unit& u, int wr, int wc, int fr, int fq) const {
        const int e = u.pn >> 2, pnl = u.pn & 3; const float* bp = b_down + (size_t)e * 1024 + pnl * 256 + wc * 32 + fq * 4;
        EPI_ROWS { const int row = u.pm * 256 + ai * 128 + wr * 64 + m * 16 + fr; bf16_t* rp = Y + (size_t)row * 1024 + pnl * 256 + wc * 32 + fq * 4;
            EPI_COLS st_bf4(rp + bj * 128 + n * 16, acc[ai][bj][m][n] + *(const f32x4*)(bp + bj * 128 + n * 16)); }
    }
};
struct OrderMap : OrderBase {
    StaticOrder so;
    __device__ void init(int nM, int nN, int G, int c) { so.nM = nM; so.nN = nN; so.nwg = nM * nN; so.G = G; so.c = c; }
    __device__ bool next(int i, Unit& u) const { if (!so.next(i, u)) return false; u.pn += (u.pn >= 4 ? 2 : 0) + (u.pn >= 6 ? 2 : 0); return true; }
};
struct OrderVT : OrderBase {
    StaticOrder so;
    __device__ void init(int nN, int G, int c) { so.nM = 4; so.nN = nN; so.nwg = 4 * nN; so.G = G; so.c = c; }
    __device__ bool next(int i, Unit& u) const { if (!so.next(i, u)) return false; u.pm += (u.pm >= 2 ? 6 : 4); return true; }
};
struct MoeOrder : OrderBase {
    StaticOrder so; const PG8_LAS unsigned char* tile_e; int nN;
    __device__ void init(int nM, int nN_, int G, int c, const PG8_LAS unsigned char* te) { so.nM = nM; so.nN = nN_; so.nwg = nM * nN_; so.G = G; so.c = c; tile_e = te; nN = nN_; }
    __device__ bool next(int i, Unit& u) const { if (!so.next(i, u)) return false; u.pn += (int)tile_e[u.pm] * nN; return true; }
};


struct MoeOrderG : OrderBase {
    static constexpr bool GATHER = true;
    StaticOrder so; const PG8_LAS unsigned char* tile_e; const PG8_LAS int* tstart; const PG8_LAS int* cnt; const unsigned* list; PG8_LAS unsigned* gslot; int nN;
    __device__ void init(int nM, int nN_, int G, int c, const PG8_LAS unsigned char* te, const PG8_LAS int* ts, const PG8_LAS int* cn, const unsigned* li, PG8_LAS unsigned* gs) {
        so.nM = nM; so.nN = nN_; so.nwg = nM * nN_; so.G = G; so.c = c; tile_e = te; tstart = ts; cnt = cn; list = li; gslot = gs; nN = nN_; }
    __device__ bool next(int i, Unit& u) const { if (!so.next(i, u)) return false; u.pn += (int)tile_e[u.pm] * nN; return true; }
    __device__ __forceinline__ const char* a_base(const Gemm& g, const Unit&) const { return (const char*)g.A; }
    __device__ __forceinline__ const unsigned* rows(const Unit& u) const { const int e = u.pn / nN; return list + (size_t)e * 32768 + (size_t)(u.pm - tstart[e]) * 256; }
    __device__ __forceinline__ int nvalid(const Unit& u) const { const int e = u.pn / nN; return cnt[e] - (u.pm - tstart[e]) * 256; }
};
struct OrderX1 : OrderBase {
    StaticOrder so;
    __device__ void init(int G, int c) { so.nM = 128; so.nN = 4; so.nwg = 512; so.G = G; so.c = c; }
    __device__ bool next(int i, Unit& u) const { return so.next(i, u); }
    __device__ __forceinline__ const char* a_base(const Gemm& g, const Unit& u) const { return (const char*)(g.A + (size_t)u.pm * 256 * 1024 + u.pn * 256); }
    __device__ __forceinline__ const char* b_base(const Gemm& g, const Unit& u) const { return (const char*)(g.Bt + (size_t)(u.pm >> 3) * 256 * 1024 + u.pn * 256); }
};
struct OrderX2 : OrderBase {
    StaticOrder so;
    __device__ void init(int G, int c) { so.nM = 128; so.nN = 4; so.nwg = 512; so.G = G; so.c = c; }
    __device__ bool next(int i, Unit& u) const { return so.next(i, u); }
    __device__ __forceinline__ const char* a_base(const Gemm& g, const Unit& u) const { return (const char*)(g.A + (size_t)u.pm * 256 * 1024 + u.pn * 256); }
    __device__ __forceinline__ const char* b_base(const Gemm& g, const Unit& u) const { return (const char*)(g.Bt + (size_t)u.pn * 256 * 4096 + (u.pm >> 3) * 256); }
};
struct EpiSoftmax {
    static constexpr bool PERM = false, AFTER_DRAIN = false;
    bf16_t* PX; float* lp; PG8_LAS float* xch;
    __device__ __forceinline__ void operator()(const f32x4 (&acc)[2][2][4][2], const Unit& u, int wr, int wc, int fr, int fq) const {
        PG8_LAS char* rb = (PG8_LAS char*)xch + (wr * 64 + fr) * 16; asm volatile("" : "+v"(rb));
        PG8_LAS char* wb = rb + wc * 4; asm volatile("" : "+v"(wb));
        EPI_ROWS { float a = -INFINITY;
            EPI_COLS { const f32x4 v = acc[ai][bj][m][n]; a = fmaxf(a, fmaxf(fmaxf(v[0], v[1]), fmaxf(v[2], v[3]))); }
            a = fmaxf(a, __shfl_xor(a, 16)); a = fmaxf(a, __shfl_xor(a, 32));
            if (fq == 0) *(PG8_LAS float*)(wb + (ai * 128 + m * 16) * 16) = a; }
        asm volatile("s_waitcnt lgkmcnt(0)" ::: "memory"); __builtin_amdgcn_s_barrier(); asm volatile("" ::: "memory");
        const int row0 = u.pm * 256 + wr * 64 + fr; bf16_t* rp0 = PX + (size_t)row0 * 1024 + u.pn * 256 + wc * 32 + fq * 4; float* lp0 = lp + (size_t)row0 * 16 + u.pn * 4 + wc;
        EPI_ROWS { const f32x4 q = *(const PG8_LAS f32x4*)(rb + (ai * 128 + m * 16) * 16); const float mr = fmaxf(fmaxf(q[0], q[1]), fmaxf(q[2], q[3]));
            bf16_t* rp = rp0 + (size_t)(ai * 128 + m * 16) * 1024; float ps = 0.f;
            EPI_COLS { const f32x4 v = acc[ai][bj][m][n]; f32x4 p; _Pragma("unroll") for (int i = 0; i < 4; ++i) { p[i] = __builtin_amdgcn_exp2f(v[i] - mr); ps += p[i]; }
                st_bf4(rp + bj * 128 + n * 16, p); }
            ps += __shfl_xor(ps, 16); ps += __shfl_xor(ps, 32);
            if (fq == 0) lp0[(ai * 128 + m * 16) * 16] = ps; }
        asm volatile("s_waitcnt lgkmcnt(0)" ::: "memory"); __builtin_amdgcn_s_barrier(); asm volatile("" ::: "memory");
    }
};
struct EpiPV {
    static constexpr bool PERM = false, AFTER_DRAIN = false;
    bf16_t* O; const float* lp;
    __device__ __forceinline__ void operator()(const f32x4 (&acc)[2][2][4][2], const Unit& u, int wr, int wc, int fr, int fq) const {
        EPI_ROWS { const int row = u.pm * 256 + ai * 128 + wr * 64 + m * 16 + fr; const f32x4 q = *(const f32x4*)(lp + (size_t)row * 16 + u.pn * 4);
            const float inv = 1.0f / ((q[0] + q[1]) + (q[2] + q[3])); bf16_t* rp = O + (size_t)row * 1024 + u.pn * 256 + wc * 32 + fq * 4;
            EPI_COLS st_bf4(rp + bj * 128 + n * 16, acc[ai][bj][m][n] * inv); }
    }
};
typedef int v4i_t __attribute__((ext_vector_type(4))); typedef int v8i_t __attribute__((ext_vector_type(8)));
__device__ __forceinline__ v8i_t cat8(bf16x8 lo, bf16x8 hi) { return __builtin_shufflevector(__builtin_bit_cast(v4i_t, lo), __builtin_bit_cast(v4i_t, hi), 0, 1, 2, 3, 4, 5, 6, 7); }
__device__ __forceinline__ void mfma8(f32x4& acc, v8i_t w, v8i_t a, int sw, int sa) {
    asm volatile("s_nop 1\n\tv_mfma_scale_f32_16x16x128_f8f6f4 %0, %1, %2, %0, %3, %4 op_sel_hi:[0,0,0]" : "+v"(acc) : "v"(w), "v"(a), "v"(sw), "v"(sa)); }
template <class Epi, class Sched, bool ALIGN_EPI = false, bool SP2 = false, bool FP8 = false>
__device__ __forceinline__ void gemm_phase(PG8_LAS unsigned char* lds, const Gemm g, const Sched& S, const Epi& E) {
    const int tid = threadIdx.x, wid = __builtin_amdgcn_readfirstlane(tid >> 6), lane = tid & 63, wr = wid >> 2, wc = wid & 3, fr = lane & 15, fq = lane >> 4;
    const int K = g.K, nt = K / BK;
    unsigned voffA[2], voffB[2];
    unsigned gC[2][2];
#pragma unroll
    for (int i = 0; i < 2; ++i) { int R, C; stage_rc(tid * 16 + i * 8192, R, C); const int Rb = Epi::PERM ? ((R & ~31) + perm32(R & 31)) : R;
        voffA[i] = (unsigned)(R * g.lda + C) * 2u; voffB[i] = (unsigned)(Rb * g.ldb + C) * 2u; }
    const size_t kstep = (size_t)(BK * 2);
    const size_t hstepA = (size_t)HALF * g.lda * 2, hstepB = (size_t)HALF * g.ldb * 2;
    const unsigned ldsw = (unsigned)wid * 1024u;
    const int aoff = lds_byte(wr * 64 + fr, fq * 8), boff = lds_byte(wc * 32 + fr, fq * 8);
#define PG8_SA(b, h) (((b) * 2 + (h)) * HTB)
#define PG8_SB(b, h) ((4 + (b) * 2 + (h)) * HTB)
#define PG8_STAGE(bufoff, gbase, voff) do { _Pragma("unroll") for (int _i = 0; _i < 2; ++_i) \
        __builtin_amdgcn_global_load_lds((const unsigned*)((const char*)(gbase) + (voff)[_i]), (PG8_LAS unsigned*)(lds + (bufoff) + ldsw + _i * 8192), 16, 0, 0); } while (0)
#define PG8_STAGE_A(bufoff, ptr, h, nx) do { if constexpr (Sched::GATHER) { PG8_STAGE(bufoff, ptr, gC[h]); } else { PG8_STAGE(bufoff, (ptr) + ((h) ? hstepA : 0), voffA); } } while (0)
#define PG8_LDA(dst, b, h) do { _Pragma("unroll") for (int m = 0; m < 4; ++m) _Pragma("unroll") for (int k = 0; k < 2; ++k) dst[m][k] = *(const PG8_LAS bf16x8*)(lds + PG8_SA(b, h) + aoff + m * 2048 + k * 1024); } while (0)
#define PG8_LDB(dst, b, h) do { _Pragma("unroll") for (int n = 0; n < 2; ++n) _Pragma("unroll") for (int k = 0; k < 2; ++k) dst[n][k] = *(const PG8_LAS bf16x8*)(lds + PG8_SB(b, h) + boff + n * 2048 + k * 1024); } while (0)
#define PG8_MMA(ai, bj, At, Bt) do { __builtin_amdgcn_s_setprio(1); \
        if constexpr (FP8) { _Pragma("unroll") for (int m = 0; m < 4; ++m) _Pragma("unroll") for (int n = 0; n < 2; ++n) \
            mfma8(acc[ai][bj][m][n], cat8(Bt[n][0], Bt[n][1]), cat8(At[m][0], At[m][1]), g.sb, g.sa); } \
        else { _Pragma("unroll") for (int m = 0; m < 4; ++m) _Pragma("unroll") for (int n = 0; n < 2; ++n) _Pragma("unroll") for (int k = 0; k < 2; ++k) \
            acc[ai][bj][m][n] = __builtin_amdgcn_mfma_f32_16x16x32_bf16(Bt[n][k], At[m][k], acc[ai][bj][m][n], 0, 0, 0); } \
        __builtin_amdgcn_s_setprio(0); } while (0)
#define PG8_WAIT_V(n) asm volatile("s_waitcnt vmcnt(" #n ")" ::: "memory")
#define PG8_WAIT_L(n) asm volatile("s_waitcnt lgkmcnt(" #n ")" ::: "memory")
#define PG8_BAR __builtin_amdgcn_s_barrier()
#define PG8_SCHED __builtin_amdgcn_sched_barrier(0)
    Unit cur, nxt; int ui = 0;
    if (!S.next(0, cur)) return;
    f32x4 acc[2][2][4][2];
#pragma unroll
    for (int a = 0; a < 2; ++a)
#pragma unroll
        for (int b = 0; b < 2; ++b)
#pragma unroll
            for (int m = 0; m < 4; ++m)
#pragma unroll
                for (int n = 0; n < 2; ++n) acc[a][b][m][n] = (f32x4){0.f, 0.f, 0.f, 0.f};
    bf16x8 At[4][2], B0[2][2], B1[2][2];
    const char* cA = S.a_base(g, cur); const char* cB = S.b_base(g, cur);
    if constexpr (Sched::GATHER) { const unsigned* rp = S.rows(cur); const int nv = S.nvalid(cur);
#pragma unroll
        for (int h = 0; h < 2; ++h)
#pragma unroll
            for (int i = 0; i < 2; ++i) { int R, C; stage_rc(tid * 16 + i * 8192, R, C); const int r = h * HALF + R; const unsigned tok = r < nv ? rp[r] : 0u; gC[h][i] = tok * (unsigned)(g.lda * 2) + (unsigned)C * 2u; } }
    S.a_ready(cur);
    if constexpr (SP2) {
        PG8_STAGE(PG8_SB(0, 0), cB, voffB); PG8_STAGE(PG8_SB(0, 1), cB + hstepB, voffB); PG8_STAGE_A(PG8_SA(0, 0), cA, 0, 0); PG8_STAGE_A(PG8_SA(0, 1), cA, 1, 0);
        if (wr == 1) PG8_BAR;
        PG8_WAIT_V(2); PG8_BAR;
        PG8_STAGE(PG8_SB(1, 0), cB + kstep, voffB); PG8_STAGE_A(PG8_SA(1, 0), cA + kstep, 0, 0); PG8_STAGE(PG8_SB(1, 1), cB + hstepB + kstep, voffB);
        PG8_WAIT_V(6); PG8_BAR;
    } else {
        PG8_STAGE(PG8_SB(0, 0), cB, voffB); PG8_STAGE_A(PG8_SA(0, 0), cA, 0, 0); PG8_STAGE(PG8_SB(0, 1), cB + hstepB, voffB); PG8_STAGE_A(PG8_SA(0, 1), cA, 1, 0);
        if (wr == 1) PG8_BAR;
        PG8_WAIT_V(4); PG8_BAR;
        PG8_STAGE(PG8_SB(1, 0), cB + kstep, voffB); PG8_STAGE_A(PG8_SA(1, 0), cA + kstep, 0, 0); PG8_STAGE(PG8_SB(1, 1), cB + hstepB + kstep, voffB);
        PG8_WAIT_V(6); PG8_BAR;
    }
    for (;;) {
        const bool has_next = S.next(ui + 1, nxt);
        const char* nA = has_next ? S.a_base(g, nxt) : cA; const char* nB = has_next ? S.b_base(g, nxt) : cB;
        if constexpr (Sched::GATHER) { if (has_next && wid < 4)
            __builtin_amdgcn_global_load_lds((const unsigned*)(S.rows(nxt) + wid * 64 + lane), (PG8_LAS unsigned*)(S.gslot + ((ui + 1) & 1) * 256 + wid * 64), 4, 0, 0); }
#pragma nounroll
        for (int t = 0; t < nt; t += 2) {
            const bool last = (t == nt - 2);
            const char* a1 = cA + (size_t)(t + 1) * kstep;
            const char* a2 = last ? nA : cA + (size_t)(t + 2) * kstep; const char* b2 = last ? nB : cB + (size_t)(t + 2) * kstep;
            const char* a3 = a2 + kstep; const char* b3 = b2 + kstep;
            if (last && has_next) S.a_ready(nxt);
            if constexpr (SP2) {
            PG8_LDB(B0, 0, 0); PG8_LDB(B1, 0, 1); PG8_SCHED; PG8_LDA(At, 0, 0); PG8_STAGE_A(PG8_SA(1, 1), a1, 1, 0);
            if constexpr (Sched::GATHER) { if (last && has_next) {
                const PG8_LAS unsigned* sl = S.gslot + ((ui + 1) & 1) * 256; const int nv = S.nvalid(nxt);
#pragma unroll
                for (int h = 0; h < 2; ++h)
#pragma unroll
                    for (int i = 0; i < 2; ++i) { int R, C; stage_rc(tid * 16 + i * 8192, R, C); const int r = h * HALF + R; const unsigned v = sl[r]; const unsigned tok = r < nv ? v : 0u; gC[h][i] = tok * (unsigned)(g.lda * 2) + (unsigned)C * 2u; } } }
            PG8_WAIT_V(8); PG8_WAIT_L(0); PG8_BAR; PG8_MMA(0, 0, At, B0); PG8_MMA(0, 1, At, B1); PG8_BAR; PG8_SCHED;
            PG8_LDA(At, 0, 1); PG8_STAGE(PG8_SB(0, 0), b2, voffB); PG8_STAGE(PG8_SB(0, 1), b2 + hstepB, voffB); PG8_STAGE_A(PG8_SA(0, 0), a2, 0, 1);
            PG8_WAIT_V(8); PG8_WAIT_L(0); PG8_BAR; PG8_MMA(1, 0, At, B0); PG8_MMA(1, 1, At, B1); PG8_BAR; PG8_SCHED;
            PG8_LDB(B0, 1, 0); PG8_LDB(B1, 1, 1); PG8_SCHED; PG8_LDA(At, 1, 0); PG8_STAGE_A(PG8_SA(0, 1), a2, 1, 1);
            PG8_WAIT_V(8); PG8_WAIT_L(0); PG8_BAR; PG8_MMA(0, 0, At, B0); PG8_MMA(0, 1, At, B1); PG8_BAR; PG8_SCHED;
            PG8_LDA(At, 1, 1); PG8_STAGE(PG8_SB(1, 0), b3, voffB); PG8_STAGE(PG8_SB(1, 1), b3 + hstepB, voffB); PG8_STAGE_A(PG8_SA(1, 0), a3, 0, 1);
            PG8_WAIT_V(8); PG8_WAIT_L(0); PG8_BAR; PG8_MMA(1, 0, At, B0); PG8_MMA(1, 1, At, B1); PG8_BAR; PG8_SCHED;
            } else {
            PG8_LDB(B0, 0, 0); PG8_SCHED; PG8_LDA(At, 0, 0); PG8_STAGE_A(PG8_SA(1, 1), a1, 1, 0);
            PG8_WAIT_L(8); PG8_BAR; PG8_WAIT_L(0); PG8_MMA(0, 0, At, B0); PG8_BAR; PG8_SCHED;
            PG8_LDB(B1, 0, 1); PG8_STAGE(PG8_SB(0, 0), b2, voffB);
            PG8_BAR; PG8_WAIT_L(0); PG8_MMA(0, 1, At, B1); PG8_BAR;
            PG8_LDA(At, 0, 1); PG8_STAGE_A(PG8_SA(0, 0), a2, 0, 1);
            PG8_BAR; PG8_WAIT_L(0); PG8_MMA(1, 0, At, B0); PG8_BAR; PG8_SCHED;
            PG8_STAGE(PG8_SB(0, 1), b2 + hstepB, voffB);
            PG8_WAIT_V(6); PG8_BAR; PG8_MMA(1, 1, At, B1); PG8_BAR;
            PG8_LDB(B0, 1, 0); PG8_SCHED; PG8_LDA(At, 1, 0); PG8_STAGE_A(PG8_SA(0, 1), a2, 1, 1);
            PG8_WAIT_L(8); PG8_BAR; PG8_WAIT_L(0); PG8_MMA(0, 0, At, B0); PG8_BAR; PG8_SCHED;
            PG8_LDB(B1, 1, 1); PG8_STAGE(PG8_SB(1, 0), b3, voffB);
            PG8_BAR; PG8_WAIT_L(0); PG8_MMA(0, 1, At, B1); PG8_BAR;
            PG8_LDA(At, 1, 1); PG8_STAGE_A(PG8_SA(1, 0), a3, 0, 1);
            PG8_BAR; PG8_WAIT_L(0); PG8_MMA(1, 0, At, B0); PG8_BAR; PG8_SCHED;
            PG8_STAGE(PG8_SB(1, 1), b3 + hstepB, voffB);
            PG8_WAIT_V(6); PG8_BAR; PG8_MMA(1, 1, At, B1); PG8_BAR;
            }
        }
        if constexpr (ALIGN_EPI) { if (wr == 0) PG8_BAR; }
        if constexpr (FP8) asm volatile("s_nop 15\n\ts_nop 15" ::: "memory");
        if constexpr (!Epi::AFTER_DRAIN) { E(acc, cur, wr, wc, fr, fq); S.done(cur); }
        if (!has_next) break;
#pragma unroll
        for (int a = 0; a < 2; ++a)
#pragma unroll
            for (int b = 0; b < 2; ++b)
#pragma unroll
                for (int m = 0; m < 4; ++m)
#pragma unroll
                    for (int n = 0; n < 2; ++n) acc[a][b][m][n] = (f32x4){0.f, 0.f, 0.f, 0.f};
        cur = nxt; cA = nA; cB = nB; ++ui;
        if constexpr (ALIGN_EPI) { if (wr == 1) PG8_BAR; }
    }
    PG8_WAIT_V(0);
    if constexpr (!ALIGN_EPI) { if (wr == 0) PG8_BAR; }
    PG8_BAR;
    if constexpr (Epi::AFTER_DRAIN) { E.fused(acc, cur, wr, wc, fr, fq, lds, wid, lane); S.done(cur); }
#undef PG8_SA
#undef PG8_SB
#undef PG8_STAGE
#undef PG8_STAGE_A
#undef PG8_LDA
#undef PG8_LDB
#undef PG8_MMA
#undef PG8_WAIT_V
#undef PG8_WAIT_L
#undef PG8_BAR
#undef PG8_SCHED
}
}
constexpr int NTOK = 32768, DM = 1024, SEQ = 2048, NBATCH = 16, MEMLEN = 256, NMEM = NBATCH * MEMLEN, INW = 3088, NEXP = 32, TOPK = 4;
constexpr int PW = 3072;
constexpr int MAXTILES = 544;
constexpr float EPS = 1e-6f;
constexpr int NWAVES = 8;
constexpr size_t MiB = 1u << 20;
constexpr size_t WS_CTL = 0, CTL_ZERO_BYTES = 64 * 1024;
constexpr size_t WS_WINT = 2 * MiB, WS_WOUT = 10 * MiB, WS_WCQ = 12 * MiB, WS_WCK = 14 * MiB, WS_WCV = 16 * MiB, WS_WCO = 18 * MiB;
constexpr size_t WS_WR = 20 * MiB, WS_CS = 21 * MiB, WS_SSP1 = 24 * MiB, WS_GATE = 27 * MiB, WS_ASSIGN = 28 * MiB, WS_LIST = 29 * MiB;
constexpr size_t WS_RSL = 842 * MiB;
constexpr size_t WS_X2B = 378 * MiB;
constexpr size_t WS_WUP = 34 * MiB, WS_WDN = 162 * MiB, WS_KX = 226 * MiB, WS_VXT = 234 * MiB;
constexpr size_t WS_HN = 242 * MiB, WS_CAT = 242 * MiB, WS_MN = 306 * MiB, WS_P = 314 * MiB, WS_LA = 506 * MiB, WS_VT = 538 * MiB;
constexpr size_t WS_X1B = 314 * MiB, WS_QX = 378 * MiB, WS_OX = 442 * MiB, WS_PX = 506 * MiB;
constexpr size_t WS_GVT = 602 * MiB;
constexpr size_t WS_ACT = 570 * MiB, WS_XG = 242 * MiB, WS_Y = 242 * MiB, WS_END = 846 * MiB;
constexpr int CW_Q2 = 128;
constexpr int CW_CNT = 1024;
constexpr int CW_PROBE = 192;
constexpr int CW_BAR = 4096;
constexpr int RING_OFF = 0, RING_BYTES = 131072;
constexpr int LDSCTL_OFF = RING_BYTES, MISC_OFF = LDSCTL_OFF + 320;
constexpr int TAB_OFF = LDSCTL_OFF + 512;
constexpr int TAB_TSTART = TAB_OFF + 576, TAB_CNT = TAB_TSTART + 144;
constexpr int XCH_OFF = LDSCTL_OFF + 2048;
constexpr int TS_OFF = TAB_CNT + 128;
constexpr int LDS_BYTES = 147456;

#define GAS __attribute__((address_space(1)))
#define LAS __attribute__((address_space(3)))
typedef unsigned short bf16;
typedef unsigned v4u __attribute__((ext_vector_type(4)));
typedef float f32x4 __attribute__((ext_vector_type(4)));
typedef short bf16x8 __attribute__((ext_vector_type(8)));
typedef GAS unsigned gu32;
typedef GAS unsigned long long gu64;
#define RLX_AGENT __ATOMIC_RELAXED, __HIP_MEMORY_SCOPE_AGENT
#define LDS_WAIT() asm volatile("s_waitcnt lgkmcnt(0)" ::: "memory")
#define VM_WAIT() asm volatile("s_waitcnt vmcnt(0)" ::: "memory")
__device__ __forceinline__ unsigned long long rt() { return __builtin_amdgcn_s_memrealtime(); }
__device__ __forceinline__ unsigned f2bf(float f) { unsigned u = __builtin_bit_cast(unsigned, f); return (u + 0x7fffu + ((u >> 16) & 1u)) >> 16; }
__device__ __forceinline__ unsigned pk2(float lo, float hi) { return f2bf(lo) | (f2bf(hi) << 16); }

#define XB_TMO      128
#define XB_XCNT(j)  (256  + 64 * (j))
#define XB_XSUB(j)  (1280 + 64 * (j))
#define XB_XGEN(j)  (2304 + 64 * (j))
#define XB_TOP      3328
#define XB_TOPGEN   3392
#define XCD_BAR_WORDS 3456
#define XB_SPIN_CAP (1u << 18)

__device__ __forceinline__ unsigned xb_ld(unsigned* p)              { return __hip_atomic_load(p, __ATOMIC_RELAXED, __HIP_MEMORY_SCOPE_AGENT); }
__device__ __forceinline__ unsigned xb_add(unsigned* p, unsigned v) { return __hip_atomic_fetch_add(p, v, __ATOMIC_RELAXED, __HIP_MEMORY_SCOPE_AGENT); }
__device__ __forceinline__ unsigned xb_xcc_id() { return (unsigned)__builtin_amdgcn_s_getreg((3 << 11) | 20) & 0xFu; }
#define XB_SPIN(cond, bar) do { unsigned _sp = 0; while (cond) { __builtin_amdgcn_s_sleep(1); \
    if ((++_sp & 255u) == 0u) { if (xb_ld(&(bar)[XB_TMO])) break; if (_sp > XB_SPIN_CAP) { atomicAdd(&(bar)[XB_TMO], 1u); break; } } } } while (0)

struct XcdBarrier {
    unsigned* bar; unsigned x;
    volatile LAS unsigned* st;
};

__device__ __forceinline__ XcdBarrier xcd_barrier_post(unsigned* bar, volatile LAS unsigned* st) {
    XcdBarrier b; b.bar = bar; b.x = xb_xcc_id(); b.st = st;
    if (threadIdx.x == 0) (void)xb_add(&bar[XB_XCNT(b.x)], 1u);
    return b;
}
__device__ __forceinline__ void xcd_barrier_complete(unsigned* bar, unsigned x, unsigned& nloc, unsigned& nx) {
    const unsigned G = gridDim.x * gridDim.y * gridDim.z;
    unsigned sum, cnt, mine, sp = 0u;
    for (;;) {
        sum = 0u; cnt = 0u; mine = 0u;
#pragma unroll
        for (unsigned j = 0; j < 16; ++j) { const unsigned c = xb_ld(&bar[XB_XCNT(j)]); sum += c; cnt += (c > 0u) ? 1u : 0u; mine = (j == x) ? c : mine; }
        if (sum == G) break;
        __builtin_amdgcn_s_sleep(1);
        if ((++sp & 255u) == 0u) { if (xb_ld(&bar[XB_TMO])) break; if (sp > XB_SPIN_CAP) { atomicAdd(&bar[XB_TMO], 1u); break; } }
    }
    nloc = mine > 0u ? mine : 1u; nx = cnt > 0u ? cnt : 1u;
}

__device__ __forceinline__ void xcd_barrier(const XcdBarrier& b) {
    asm volatile("s_waitcnt vmcnt(0)" ::: "memory");
    __syncthreads();
    if (threadIdx.x == 0) {
        unsigned* bar = b.bar;
        __builtin_amdgcn_s_waitcnt(0);
        unsigned nloc = b.st[0], nx = b.st[1];
        if (nloc == 0u) { xcd_barrier_complete(bar, b.x, nloc, nx); b.st[0] = nloc; b.st[1] = nx; }
        const unsigned old = xb_add(&bar[XB_XSUB(b.x)], 1u);
        const unsigned gen = old / nloc;
        if (old + 1u == (gen + 1u) * nloc) {
            __builtin_amdgcn_fence(__ATOMIC_RELEASE, "agent");
            asm volatile("s_waitcnt vmcnt(0)" ::: "memory");
            const unsigned og = xb_add(&bar[XB_TOP], 1u);
            const unsigned tg = og / nx;
            if (og + 1u == (tg + 1u) * nx) xb_add(&bar[XB_TOPGEN], 1u);
            else XB_SPIN(xb_ld(&bar[XB_TOPGEN]) == tg, bar);
            __builtin_amdgcn_fence(__ATOMIC_ACQUIRE, "agent");
            xb_add(&bar[XB_XGEN(b.x)], 1u);
            asm volatile("s_waitcnt vmcnt(0)" ::: "memory");
        } else {
            XB_SPIN(xb_ld(&bar[XB_XGEN(b.x)]) == gen, bar);
            __builtin_amdgcn_fence(__ATOMIC_ACQUIRE, "agent");
            asm volatile("s_waitcnt vmcnt(0)" ::: "memory");
        }
    }
    __syncthreads();
}
typedef short bf16x4 __attribute__((ext_vector_type(4)));
typedef unsigned v2u __attribute__((ext_vector_type(2)));
struct Frame {
    LAS unsigned char* lds;
    volatile LAS unsigned* MISC;
    gu32* ctl;
    int tid, lane, wave;
    int vcu, G;
    unsigned char* ws;
    float* out;
};
__device__ __forceinline__ int lane_here() { int t = (int)threadIdx.x; asm volatile("" : "+v"(t)); return t & 63; }
__device__ __forceinline__ float bf2f(bf16 b) { return __builtin_bit_cast(float, (unsigned)b << 16); }
__device__ __forceinline__ float wave_sum(float v) {
#pragma unroll
    for (int o = 1; o < 64; o <<= 1) v += __shfl_xor(v, o);
    return v;
}
__device__ __forceinline__ f32x4 mfma16(bf16x8 a, bf16x8 b, f32x4 c) { return __builtin_amdgcn_mfma_f32_16x16x32_bf16(a, b, c, 0, 0, 0); }

__device__ __forceinline__ void p0_transpose_item(const float* W, int ldw, const float* gain, bf16* WT, int K, int k0, int n0, size_t orow0, int lane) {
    const int n4 = lane & 15, kq = lane >> 4;
    const float* src = W + (size_t)(k0 + 16 * kq) * ldw + n0 + 4 * n4;
    f32x4 v[16];
#pragma unroll
    for (int i = 0; i < 16; ++i) v[i] = *(const f32x4*)(src + (size_t)i * ldw);
    if (gain) { const f32x4* gp = (const f32x4*)(gain + k0 + 16 * kq);
#pragma unroll
        for (int q = 0; q < 4; ++q) { const f32x4 gq = gp[q];
#pragma unroll
            for (int r = 0; r < 4; ++r) v[4 * q + r] = v[4 * q + r] * gq[r]; } }
    bf16* dst = WT + (orow0 + 4 * n4) * (size_t)K + k0 + 16 * kq;
#pragma unroll
    for (int j = 0; j < 4; ++j) { v4u o0, o1;
        o0.x = pg8::cvtpk(v[0][j], v[1][j]); o0.y = pg8::cvtpk(v[2][j], v[3][j]); o0.z = pg8::cvtpk(v[4][j], v[5][j]); o0.w = pg8::cvtpk(v[6][j], v[7][j]);
        o1.x = pg8::cvtpk(v[8][j], v[9][j]); o1.y = pg8::cvtpk(v[10][j], v[11][j]); o1.z = pg8::cvtpk(v[12][j], v[13][j]); o1.w = pg8::cvtpk(v[14][j], v[15][j]);
        *(v4u*)(dst + (size_t)j * K) = o0; *(v4u*)(dst + (size_t)j * K + 8) = o1; }
}
__device__ __forceinline__ void p0_transpose_item8(const float* W, int ldw, const float* gain, unsigned char* WT, int K, int k0, int n0, size_t orow0, int lane) {
    const int n4 = lane & 15, kq = lane >> 4;
    const float* src = W + (size_t)(k0 + 16 * kq) * ldw + n0 + 4 * n4;
    f32x4 v[16];
#pragma unroll
    for (int i = 0; i < 16; ++i) v[i] = *(const f32x4*)(src + (size_t)i * ldw);
    { const f32x4* gp = (const f32x4*)(gain + k0 + 16 * kq);
#pragma unroll
        for (int q = 0; q < 4; ++q) { f32x4 gq = {32.f, 32.f, 32.f, 32.f}; if (gain) gq = gp[q] * 32.0f;
#pragma unroll
            for (int r = 0; r < 4; ++r) v[4 * q + r] = v[4 * q + r] * gq[r]; } }
    unsigned char* dst = WT + (orow0 + 4 * n4) * (size_t)K + k0 + 16 * kq;
#pragma unroll
    for (int j = 0; j < 4; ++j) { v4u o;
        o.x = pg8::cvt4_fp8((f32x4){v[0][j], v[1][j], v[2][j], v[3][j]}); o.y = pg8::cvt4_fp8((f32x4){v[4][j], v[5][j], v[6][j], v[7][j]});
        o.z = pg8::cvt4_fp8((f32x4){v[8][j], v[9][j], v[10][j], v[11][j]}); o.w = pg8::cvt4_fp8((f32x4){v[12][j], v[13][j], v[14][j], v[15][j]});
        *(v4u*)(dst + (size_t)j * K) = o; }
}
__device__ __forceinline__ void rms_row_to_bf16(const float* xrow, const float* g, bf16* orow, int lane) {
    const f32x4* xr = (const f32x4*)xrow + lane; const f32x4* gr = (const f32x4*)g + lane;
    f32x4 v[4]; float s = 0.f;
#pragma unroll
    for (int j = 0; j < 4; ++j) { v[j] = xr[64 * j]; s += (v[j].x * v[j].x + v[j].y * v[j].y) + (v[j].z * v[j].z + v[j].w * v[j].w); }
    const float rs = rsqrtf(wave_sum(s) * (1.0f / DM) + EPS);
    unsigned long long* o8 = (unsigned long long*)orow + lane;
#pragma unroll
    for (int j = 0; j < 4; ++j) { const f32x4 gg = gr[64 * j]; o8[64 * j] = (unsigned long long)pk2(v[j].x * rs * gg.x, v[j].y * rs * gg.y) | ((unsigned long long)pk2(v[j].z * rs * gg.z, v[j].w * rs * gg.w) << 32); }
}
struct In {
    const float *x, *mem; const int* positions; const float *norm_mix_g, *w_in, *lq1, *lk1, *lq2, *lk2, *diff_norm_g, *w_alpha2, *b_alpha, *gla_norm_g, *w_out, *norm_cross_g, *norm_mem_g,
        *w_cq, *w_ck, *w_cv, *w_co, *norm_ffn_g, *w_router, *b_router, *w_up, *b_up, *w_down, *b_down, *norm_final_g;
};
__device__ __forceinline__ void p0_prologue(Frame& F, const In& I) {
    const int gw = F.vcu * NWAVES + F.wave, NGW = F.G * NWAVES, lane = lane_here();
    unsigned char* ws = F.ws;
    constexpr int I_IN = 16 * 48, I_SQ = 16 * 16, I_UP = 32 * 16 * 32, I_DN = 32 * 16 * 16;
    constexpr int NITEMS = I_IN + 5 * I_SQ + I_UP + I_DN;
    for (int it = gw; it < NITEMS; it += NGW) {
        int r = it;
        if (r < I_UP) { const int e = r / (16 * 32); r -= e * (16 * 32); const int n0 = 64 * (r % 32);
            const size_t orow = (size_t)e * 2048 + ((n0 & 1023) >> 7) * 256 + (n0 >> 10) * 128 + (n0 & 127);
            p0_transpose_item8(I.w_up + (size_t)e * DM * 2048, 2048, I.norm_ffn_g, ws + WS_WUP, DM, 64 * (r / 32), n0, orow, lane); continue; } r -= I_UP;
        if (r < I_DN) { const int e = r / (16 * 16); r -= e * (16 * 16);
            p0_transpose_item8(I.w_down + (size_t)e * DM * DM, DM, nullptr, ws + WS_WDN, DM, 64 * (r / 16), 64 * (r % 16), (size_t)e * 1024 + 64 * (r % 16), lane); continue; } r -= I_DN;
        if (r < I_IN) { p0_transpose_item(I.w_in, INW, nullptr, (bf16*)(ws + WS_WINT), DM, 64 * (r / 48), 64 * (r % 48), (size_t)64 * (r % 48), lane); continue; } r -= I_IN;
        { const int w = r / I_SQ; r -= w * I_SQ;
            const float* W = w == 0 ? I.w_out : w == 1 ? I.w_cq : w == 2 ? I.w_ck : w == 3 ? I.w_cv : I.w_co;
            bf16* WT = (bf16*)(ws + (w == 0 ? WS_WOUT : w == 1 ? WS_WCQ : w == 2 ? WS_WCK : w == 3 ? WS_WCV : WS_WCO));
            p0_transpose_item(W, DM, w == 1 ? I.norm_cross_g : nullptr, WT, DM, 64 * (r / 16), 64 * (r % 16), (size_t)64 * (r % 16), lane); }
    }
    const int gt = F.vcu * (NWAVES * 64) + F.tid, NGT = F.G * NWAVES * 64;
    for (int idx = gt; idx < 256 * DM; idx += NGT) { const int j = idx >> 10, k = idx & 1023; const float* wr = I.w_in + (size_t)k * INW + 3072; float s = 0.f;
#pragma unroll
        for (int r = 0; r < 16; ++r) s += wr[r] * I.w_alpha2[r * 256 + j];
        ((bf16*)(ws + WS_WINT))[(size_t)(3072 + j) * DM + k] = (bf16)f2bf(s); }
    for (int idx = gt; idx < DM * NEXP; idx += NGT) ((float*)(ws + WS_WR))[idx] = I.w_router[idx] * I.norm_ffn_g[idx >> 5];
    for (int idx = gt; idx < NTOK * 8; idx += NGT) { const int tok = idx >> 3, i = idx & 7;
        const double inv = exp(-(double)i * 0.125 * 13.122363377404328); const double ang = (double)I.positions[tok] * inv;
        const double red = ang - rint(ang * 0.15915494309189535) * 6.283185307179586; const float rf = (float)red;
        float* cs = (float*)(ws + WS_CS) + (size_t)tok * 16; cs[i] = cosf(rf); cs[8 + i] = sinf(rf); }
    for (int m = gw; m < NTOK + NMEM; m += NGW) {
        if (m < NTOK) rms_row_to_bf16(I.x + (size_t)m * DM, I.norm_mix_g, (bf16*)(ws + WS_HN) + (size_t)m * DM, lane);
        else rms_row_to_bf16(I.mem + (size_t)(m - NTOK) * DM, I.norm_mem_g, (bf16*)(ws + WS_MN) + (size_t)(m - NTOK) * DM, lane);
    }
}

constexpr int DA_KBUF = 8192, DA_VBUF = 10240, DA_VOFF = 2 * DA_KBUF;
__device__ __forceinline__ void diffattn_unit(Frame& F, const bf16* P, const bf16* VT, bf16* CAT, const float* gdiff, float lam, int b, int h, int qblk) {
    const int lane = lane_here(), wave = F.wave, tid = F.tid, l15 = lane & 15, g = lane >> 4;
    LAS unsigned char* lds = F.lds + RING_OFF;
    const int q0 = qblk * 128 + wave * 16;
    const size_t tokq = (size_t)b * SEQ + q0 + l15;
    bf16x8 qf[2][2];
#pragma unroll
    for (int c = 0; c < 2; ++c)
#pragma unroll
        for (int ks = 0; ks < 2; ++ks) qf[c][ks] = *(const bf16x8*)(P + tokq * PW + h * 128 + c * 64 + ks * 32 + g * 8);
    f32x4 o[2][8];
#pragma unroll
    for (int c = 0; c < 2; ++c)
#pragma unroll
        for (int k = 0; k < 8; ++k) o[c][k] = (f32x4){0.f, 0.f, 0.f, 0.f};
    float mrun[2] = {-INFINITY, -INFINITY}, lsum[2] = {0.f, 0.f};
    const int nk = q0 + 16;
    const int nt = 4 * qblk + 4;
    const int skey = tid >> 4, sch = tid & 15, vrow = tid >> 2, vpc = tid & 3;
    const bf16* ksrc = P + ((size_t)b * SEQ + skey) * PW + 512 + h * 128 + sch * 8;
    const bf16* vsrc = VT + (size_t)(h * 128 + vrow) * NTOK + (size_t)b * SEQ + vpc * 8;
    const int kdst = skey * 256 + ((sch ^ (skey & 15)) * 16), vdst = DA_VOFF + vrow * 80 + vpc * 16;
    int koff[2][2];
#pragma unroll
    for (int c = 0; c < 2; ++c)
#pragma unroll
        for (int ks = 0; ks < 2; ++ks) koff[c][ks] = l15 * 256 + (((c * 8 + ks * 4 + g) ^ l15) * 16);
    const int voff = DA_VOFF + l15 * 80 + g * 8;
    v4u sk = *(const v4u*)ksrc, sv = *(const v4u*)vsrc;
    *(LAS v4u*)(lds + kdst) = sk; *(LAS v4u*)(lds + vdst) = sv;
    __syncthreads();
    for (int t = 0; t < nt; ++t) {
        const int key0 = t * 32, buf = t & 1;
        if (t + 1 < nt) { sk = *(const v4u*)(ksrc + (size_t)(key0 + 32) * PW); sv = *(const v4u*)(vsrc + key0 + 32); }
        if (key0 < nk) {
            const LAS unsigned char* kb = lds + buf * DA_KBUF; const LAS unsigned char* vb = lds + buf * DA_VBUF + voff;
            f32x4 s[2][2];
#pragma unroll
            for (int c = 0; c < 2; ++c)
#pragma unroll
                for (int s2 = 0; s2 < 2; ++s2) { f32x4 a = (f32x4){0.f, 0.f, 0.f, 0.f};
#pragma unroll
                    for (int ks = 0; ks < 2; ++ks) { const bf16x8 kf = *(const LAS bf16x8*)(kb + s2 * 4096 + koff[c][ks]); a = mfma16(kf, qf[c][ks], a); }
                    s[c][s2] = a; }
            if (key0 + 31 > q0) {
                const int qrow = q0 + l15;
#pragma unroll
                for (int c = 0; c < 2; ++c)
#pragma unroll
                    for (int s2 = 0; s2 < 2; ++s2)
#pragma unroll
                        for (int r = 0; r < 4; ++r) if (key0 + s2 * 16 + 4 * g + r > qrow) s[c][s2][r] = -INFINITY;
            }
            float mnew[2]; bool grow = false;
#pragma unroll
            for (int c = 0; c < 2; ++c) {
                float mx = fmaxf(fmaxf(fmaxf(s[c][0][0], s[c][0][1]), fmaxf(s[c][0][2], s[c][0][3])), fmaxf(fmaxf(s[c][1][0], s[c][1][1]), fmaxf(s[c][1][2], s[c][1][3])));
                mx = fmaxf(mx, __shfl_xor(mx, 16)); mx = fmaxf(mx, __shfl_xor(mx, 32));
                mnew[c] = fmaxf(mrun[c], mx); grow = grow || (mnew[c] > mrun[c]); }
            if (__any(grow)) {
#pragma unroll
                for (int c = 0; c < 2; ++c) { const float alpha = __builtin_amdgcn_exp2f(mrun[c] - mnew[c]); mrun[c] = mnew[c]; lsum[c] *= alpha;
#pragma unroll
                    for (int k = 0; k < 8; ++k) o[c][k] = o[c][k] * alpha; }
            }
            bf16x8 pb[2];
#pragma unroll
            for (int c = 0; c < 2; ++c) { float ps = 0.f;
#pragma unroll
                for (int s2 = 0; s2 < 2; ++s2)
#pragma unroll
                    for (int r = 0; r < 4; ++r) { const float p = __builtin_amdgcn_exp2f(s[c][s2][r] - mrun[c]); s[c][s2][r] = p; ps += p; }
                lsum[c] += ps;
                v4u w; w.x = pg8::cvtpk(s[c][0][0], s[c][0][1]); w.y = pg8::cvtpk(s[c][0][2], s[c][0][3]); w.z = pg8::cvtpk(s[c][1][0], s[c][1][1]); w.w = pg8::cvtpk(s[c][1][2], s[c][1][3]);
                pb[c] = __builtin_bit_cast(bf16x8, w); }
#pragma unroll
            for (int k = 0; k < 8; ++k) { const v2u v0 = *(const LAS v2u*)(vb + k * 1280), v1 = *(const LAS v2u*)(vb + k * 1280 + 32);
                v4u vv; vv.x = v0.x; vv.y = v0.y; vv.z = v1.x; vv.w = v1.y; const bf16x8 vf = __builtin_bit_cast(bf16x8, vv);
                o[0][k] = mfma16(vf, pb[0], o[0][k]); o[1][k] = mfma16(vf, pb[1], o[1][k]); }
        }
        if (t + 1 < nt) { *(LAS v4u*)(lds + (buf ^ 1) * DA_KBUF + kdst) = sk; *(LAS v4u*)(lds + (buf ^ 1) * DA_VBUF + vdst) = sv; }
        __syncthreads();
    }
    float l0 = lsum[0], l1 = lsum[1];
    l0 += __shfl_xor(l0, 16); l0 += __shfl_xor(l0, 32); l1 += __shfl_xor(l1, 16); l1 += __shfl_xor(l1, 32);
    const float i0 = 1.0f / l0, i1 = lam / l1; float ss = 0.f;
#pragma unroll
    for (int k = 0; k < 8; ++k)
#pragma unroll
        for (int r = 0; r < 4; ++r) { const float v = o[0][k][r] * i0 - o[1][k][r] * i1; o[0][k][r] = v; ss += v * v; }
    ss += __shfl_xor(ss, 16); ss += __shfl_xor(ss, 32);
    const float rs = rsqrtf(ss * (1.0f / 128.0f) + EPS) * 0.8f;
    bf16* op = CAT + tokq * DM + h * 128 + 4 * g;
#pragma unroll
    for (int k = 0; k < 8; ++k) { const f32x4 gg = *(const f32x4*)(gdiff + k * 16 + 4 * g); f32x4 v = o[0][k] * rs; v = v * gg; pg8::st_bf4(op + k * 16, v); }
}

__device__ __forceinline__ bf16x8 pack8(const f32x4& a, const f32x4& b) { v4u w; w.x = pg8::cvtpk(a[0], a[1]); w.y = pg8::cvtpk(a[2], a[3]); w.z = pg8::cvtpk(b[0], b[1]); w.w = pg8::cvtpk(b[2], b[3]); return __builtin_bit_cast(bf16x8, w); }
constexpr int GL_QI = 0, GL_KI = 9216, GL_IMG = 18432, GL_EL = 2 * GL_IMG, GL_OB = GL_EL + 512, GL_OBS = 17408, GL_PS = GL_OB + 2 * GL_OBS, GL_END = GL_PS + 4096;
__device__ __forceinline__ bf16x8 ldfrag(const LAS unsigned char* p) { const v2u a = *(const LAS v2u*)p, b = *(const LAS v2u*)(p + 32); v4u w; w.x = a.x; w.y = a.y; w.z = b.x; w.w = b.y; return __builtin_bit_cast(bf16x8, w); }
__device__ __forceinline__ void gla_unit(Frame& F, const bf16* P, const float* Bc, const bf16* GVT, bf16* CAT, const float* ggla, int b, int h) {
    const int lane = lane_here(), l15 = lane & 15, g = lane >> 4, eb = F.wave, tid = F.tid;
    LAS unsigned char* lds = F.lds + RING_OFF;
    const f32x4 zero4 = {0.f, 0.f, 0.f, 0.f};
    f32x4 S[4] = {zero4, zero4, zero4, zero4};
    bf16x8 If[4];
#pragma unroll
    for (int db = 0; db < 4; ++db) { const int ks = db >> 1;
#pragma unroll
        for (int j = 0; j < 8; ++j) { const int dp = 32 * ks + (j < 4 ? 4 * g + j : 16 + 4 * g + j - 4); If[db][j] = (dp == 16 * db + l15) ? (short)0x3F80 : (short)0; } }
    const int st = tid >> 3, sp = tid & 7, opc = tid & 15;
    const size_t tokb = (size_t)b * SEQ;
    const bf16* qsrc = P + (tokb + st) * PW + 1536 + h * 64 + sp * 8;
    const float* bsrc = Bc + (tokb + st) * 256 + h * 64 + sp * 8;
    const bf16* Vrow = GVT + (size_t)(h * 128 + 16 * eb + l15) * NTOK + tokb + 4 * g;
    const f32x4 gg0 = *(const f32x4*)(ggla + opc * 8), gg1 = *(const f32x4*)(ggla + opc * 8 + 4);
    const int foff = l15 * 144 + 8 * g;
    v4u rq = *(const v4u*)qsrc, rk = *(const v4u*)(qsrc + 256); f32x4 rb0 = *(const f32x4*)bsrc, rb1 = *(const f32x4*)(bsrc + 4);
#define GLA_STAGE(par) do { \
        float ee[8]; _Pragma("unroll") for (int i = 0; i < 4; ++i) { ee[i] = __expf(rb0[i]); ee[4 + i] = __expf(rb1[i]); } \
        const unsigned qa[4] = {rq.x, rq.y, rq.z, rq.w}, ka[4] = {rk.x, rk.y, rk.z, rk.w}; v4u wq, wk; unsigned* wqp = (unsigned*)&wq; unsigned* wkp = (unsigned*)&wk; \
        _Pragma("unroll") for (int i = 0; i < 4; ++i) { const float q0 = __builtin_bit_cast(float, qa[i] << 16), q1 = __builtin_bit_cast(float, qa[i] & 0xffff0000u), k0 = __builtin_bit_cast(float, ka[i] << 16), k1 = __builtin_bit_cast(float, ka[i] & 0xffff0000u); \
            wqp[i] = pg8::cvtpk(q0 * ee[2 * i], q1 * ee[2 * i + 1]); wkp[i] = pg8::cvtpk(k0 * __builtin_amdgcn_rcpf(ee[2 * i]), k1 * __builtin_amdgcn_rcpf(ee[2 * i + 1])); } \
        *(LAS v4u*)(lds + (par) * GL_IMG + GL_QI + st * 144 + sp * 16) = wq; *(LAS v4u*)(lds + (par) * GL_IMG + GL_KI + st * 144 + sp * 16) = wk; \
        if (st == 63) { *(LAS f32x4*)(lds + GL_EL + (par) * 256 + sp * 32) = (f32x4){ee[0], ee[1], ee[2], ee[3]}; *(LAS f32x4*)(lds + GL_EL + (par) * 256 + sp * 32 + 16) = (f32x4){ee[4], ee[5], ee[6], ee[7]}; } } while (0)
    GLA_STAGE(0);
    __syncthreads();
    for (int c = 0; c < SEQ / 64; ++c) {
        const int par = c & 1; const size_t tok0 = tokb + c * 64;
        if (c + 1 < SEQ / 64) { rq = *(const v4u*)(qsrc + (size_t)(c + 1) * 64 * PW); rk = *(const v4u*)(qsrc + (size_t)(c + 1) * 64 * PW + 256);
            rb0 = *(const f32x4*)(bsrc + (size_t)(c + 1) * 64 * 256); rb1 = *(const f32x4*)(bsrc + (size_t)(c + 1) * 64 * 256 + 4); }
        bf16x8 VF[2];
#pragma unroll
        for (int ss = 0; ss < 2; ++ss) { const bf16* vp = Vrow + c * 64 + 32 * ss; const v2u v0 = *(const v2u*)vp, v1 = *(const v2u*)(vp + 16); v4u vv; vv.x = v0.x; vv.y = v0.y; vv.z = v1.x; vv.w = v1.y; VF[ss] = __builtin_bit_cast(bf16x8, vv); }
        v4u rg[2];
#pragma unroll
        for (int i = 0; i < 2; ++i) rg[i] = *(const v4u*)(P + (tok0 + ((tid + 512 * i) >> 4)) * PW + 2560 + h * 128 + opc * 8);
        const LAS unsigned char* qi = lds + par * GL_IMG + GL_QI + foff; const LAS unsigned char* ki = lds + par * GL_IMG + GL_KI + foff;
        bf16x8 qf[4][2], kf[4][2];
#pragma unroll
        for (int blk = 0; blk < 4; ++blk)
#pragma unroll
            for (int ks = 0; ks < 2; ++ks) { qf[blk][ks] = ldfrag(qi + blk * 2304 + ks * 64); kf[blk][ks] = ldfrag(ki + blk * 2304 + ks * 64); }
        const bf16x8 SF0 = pack8(S[0], S[1]), SF1 = pack8(S[2], S[3]);
        f32x4 O[4];
#pragma unroll
        for (int tb = 0; tb < 4; ++tb) { f32x4 o = mfma16(qf[tb][0], SF0, zero4); o = mfma16(qf[tb][1], SF1, o);
#pragma unroll
            for (int ss = 0; ss < 2; ++ss) if (2 * ss <= tb) { f32x4 a2[2];
#pragma unroll
                for (int hh = 0; hh < 2; ++hh) { const int sb = 2 * ss + hh; f32x4 a = zero4;
                    if (sb <= tb) { a = mfma16(kf[sb][0], qf[tb][0], zero4); a = mfma16(kf[sb][1], qf[tb][1], a);
                        if (sb == tb) {
#pragma unroll
                            for (int r = 0; r < 4; ++r) if (4 * g + r > l15) a[r] = 0.f; } }
                    a2[hh] = a; }
                o = mfma16(pack8(a2[0], a2[1]), VF[ss], o); }
            O[tb] = o; }
#pragma unroll
        for (int db = 0; db < 4; ++db) { f32x4 u = S[db];
#pragma unroll
            for (int ss = 0; ss < 2; ++ss) { const f32x4 t0 = mfma16(kf[2 * ss][db >> 1], If[db], zero4), t1 = mfma16(kf[2 * ss + 1][db >> 1], If[db], zero4); u = mfma16(pack8(t0, t1), VF[ss], u); }
            const f32x4 el = *(const LAS f32x4*)(lds + GL_EL + par * 256 + (16 * db + 4 * g) * 4);
            S[db] = u * el; }
        LAS unsigned char* ob = lds + GL_OB + par * GL_OBS; LAS float* ps = (LAS float*)(lds + GL_PS + par * 2048);
#pragma unroll
        for (int tb = 0; tb < 4; ++tb)
#pragma unroll
            for (int r = 0; r < 4; ++r) { const int t = 16 * tb + 4 * g + r; const float ov = O[tb][r]; float q = ov * ov; q += __shfl_xor(q, 1); q += __shfl_xor(q, 2); q += __shfl_xor(q, 4); q += __shfl_xor(q, 8);
                if (l15 == 0) ps[t * 8 + eb] = q;
                *(LAS bf16*)(ob + t * 272 + (16 * eb + l15) * 2) = (bf16)f2bf(ov); }
        if (c + 1 < SEQ / 64) GLA_STAGE(par ^ 1);
        __syncthreads();
#pragma unroll
        for (int i = 0; i < 2; ++i) { const int ot = (tid + 512 * i) >> 4; const f32x4 p0 = *(const LAS f32x4*)(ps + ot * 8), p1 = *(const LAS f32x4*)(ps + ot * 8 + 4);
            const float ss = ((p0[0] + p0[1]) + (p0[2] + p0[3])) + ((p1[0] + p1[1]) + (p1[2] + p1[3])); const float rs = rsqrtf(ss * (1.0f / 128.0f) + EPS);
            const v4u ov = *(const LAS v4u*)(ob + ot * 272 + opc * 16); const unsigned oa[4] = {ov.x, ov.y, ov.z, ov.w}, ga[4] = {rg[i].x, rg[i].y, rg[i].z, rg[i].w};
            const float gn[8] = {gg0[0], gg0[1], gg0[2], gg0[3], gg1[0], gg1[1], gg1[2], gg1[3]}; v4u w; unsigned* wp = (unsigned*)&w;
#pragma unroll
            for (int j = 0; j < 4; ++j) { const float o0 = __builtin_bit_cast(float, oa[j] << 16), o1 = __builtin_bit_cast(float, oa[j] & 0xffff0000u), g0 = __builtin_bit_cast(float, ga[j] << 16), g1 = __builtin_bit_cast(float, ga[j] & 0xffff0000u);
                wp[j] = pg8::cvtpk(o0 * rs * gn[2 * j] * (g0 / (1.0f + __expf(-g0))), o1 * rs * gn[2 * j + 1] * (g1 / (1.0f + __expf(-g1)))); }
            *(v4u*)(CAT + (tok0 + ot) * DM + 512 + h * 128 + opc * 8) = w; }
    }
#undef GLA_STAGE
    __syncthreads();
}

__device__ __forceinline__ void router_phase(Frame& F, const float* X2, const float* WR, const float* b_router, float* rsl, float* gate, unsigned* assign, unsigned* list, gu32* cnt) {
    LAS float* xs = (LAS float*)(F.lds + RING_OFF);
    LAS float* wsh = xs + 64 * 129;
    LAS float* lg = wsh + 128 * 32;
    const int tid = F.tid, t = tid & 63, eg = tid >> 6;
    for (int blk = F.vcu; blk < NTOK / 64; blk += F.G) {
        const size_t tok0 = (size_t)blk * 64;
        f32x4 acc = (f32x4){0.f, 0.f, 0.f, 0.f}; float ssq = 0.f;
        for (int kc = 0; kc < DM; kc += 128) {
            { const int row = tid >> 3;
#pragma unroll
              for (int i = 0; i < 4; ++i) { const int col = i * 32 + (tid & 7) * 4; const f32x4 v = *(const f32x4*)(X2 + (tok0 + row) * DM + kc + col);
                  LAS float* d = xs + row * 129 + col; d[0] = v.x; d[1] = v.y; d[2] = v.z; d[3] = v.w; }
#pragma unroll
              for (int i = 0; i < 2; ++i) { const int idx = (i * 512 + tid) * 4; *(LAS f32x4*)(wsh + idx) = *(const f32x4*)(WR + (size_t)kc * 32 + idx); } }
            __syncthreads();
            const LAS float* xr = xs + t * 129;
#pragma unroll 8
            for (int k = 0; k < 128; ++k) { const float xv = xr[k]; const f32x4 w = *(const LAS f32x4*)(wsh + k * 32 + eg * 4); acc = acc + w * xv; ssq += xv * xv; }
            __syncthreads();
        }
        const float rs = rsqrtf(ssq * (1.0f / DM) + EPS);
#pragma unroll
        for (int i = 0; i < 4; ++i) lg[t * 33 + eg * 4 + i] = acc[i] * rs + b_router[eg * 4 + i];
        __syncthreads();
        if (tid < 64) {
            float lv[32];
#pragma unroll
            for (int e = 0; e < 32; ++e) lv[e] = lg[t * 33 + e];
            float tv[4]; int te[4];
#pragma unroll
            for (int k = 0; k < 4; ++k) { float best = -INFINITY; int bi = 0;
#pragma unroll
                for (int e = 0; e < 32; ++e) if (lv[e] > best) { best = lv[e]; bi = e; }
                tv[k] = best; te[k] = bi;
#pragma unroll
                for (int e = 0; e < 32; ++e) if (e == bi) lv[e] = -INFINITY; }
            const float e1 = __expf(tv[1] - tv[0]), e2 = __expf(tv[2] - tv[0]), e3 = __expf(tv[3] - tv[0]); const float inv = 1.0f / (1.0f + e1 + e2 + e3);
            const float gv[4] = {inv, e1 * inv, e2 * inv, e3 * inv};
            const size_t tok = tok0 + t;
            LAS unsigned* hist = (LAS unsigned*)(lg + 64 * 33); LAS unsigned* gbase = hist + 32;
            if (t < 32) hist[t] = 0u;
            __builtin_amdgcn_wave_barrier(); LDS_WAIT();
            unsigned lpos[4];
#pragma unroll
            for (int k = 0; k < 4; ++k) lpos[k] = __hip_atomic_fetch_add(hist + te[k], 1u, __ATOMIC_RELAXED, __HIP_MEMORY_SCOPE_WORKGROUP);
            __builtin_amdgcn_wave_barrier(); LDS_WAIT();
            if (t < 32) { const unsigned n = hist[t]; gbase[t] = n ? __hip_atomic_fetch_add(cnt + 64 * t, n, RLX_AGENT) : 0u; }
            __builtin_amdgcn_wave_barrier(); LDS_WAIT();
#pragma unroll
            for (int k = 0; k < 4; ++k) { const unsigned pos = gbase[te[k]] + lpos[k]; list[(size_t)te[k] * NTOK + pos] = (unsigned)tok; rsl[(size_t)te[k] * NTOK + pos] = rs;
                assign[tok * 4 + k] = ((unsigned)te[k] << 16) | pos; gate[tok * 4 + k] = gv[k]; }
        }
        __syncthreads();
    }
}
__device__ __forceinline__ int moe_tables(Frame& F) {
    LAS unsigned char* tile_e = F.lds + TAB_OFF; LAS int* tstart = (LAS int*)(F.lds + TAB_TSTART); LAS int* lc = (LAS int*)(F.lds + TAB_CNT);
    if (F.tid < 32) lc[F.tid] = (int)__hip_atomic_load(F.ctl + CW_CNT + 64 * F.tid, RLX_AGENT);
    __syncthreads();
    if (F.tid == 0) { int s = 0; for (int e = 0; e < 32; ++e) { tstart[e] = s; s += (lc[e] + 255) >> 8; } tstart[32] = s; }
    __syncthreads();
    const int T = tstart[32];
    for (int i = F.tid; i < T; i += 512) { int e = 0;
#pragma unroll
        for (int k = 1; k < 32; ++k) e += (tstart[k] <= i) ? 1 : 0;
        tile_e[i] = (unsigned char)e; }
    __syncthreads();
    return T;
}
__device__ __forceinline__ void final_phase(Frame& F, float* out, const bf16* Y, const float* gate, const unsigned* assign, const float* gfin) {
    (void)moe_tables(F);
    const LAS int* tstart = (const LAS int*)(F.lds + TAB_TSTART);
    const int gw = F.vcu * NWAVES + F.wave, NGW = F.G * NWAVES, lane = lane_here();
    for (int tok = gw; tok < NTOK; tok += NGW) {
        f32x4* xr = (f32x4*)(out + (size_t)tok * DM) + lane; f32x4 v[4];
#pragma unroll
        for (int j = 0; j < 4; ++j) v[j] = xr[64 * j];
#pragma unroll
        for (int k = 0; k < 4; ++k) { const unsigned a = assign[(size_t)tok * 4 + k]; const float gk = gate[(size_t)tok * 4 + k]; const size_t row = (size_t)tstart[a >> 16] * 256 + (a & 0xffffu);
            const v2u* yr = (const v2u*)(Y + row * DM) + lane;
#pragma unroll
            for (int j = 0; j < 4; ++j) { const v2u w = yr[64 * j]; v[j].x += gk * __builtin_bit_cast(float, w.x << 16); v[j].y += gk * __builtin_bit_cast(float, w.x & 0xffff0000u);
                v[j].z += gk * __builtin_bit_cast(float, w.y << 16); v[j].w += gk * __builtin_bit_cast(float, w.y & 0xffff0000u); } }
        float s = 0.f;
#pragma unroll
        for (int j = 0; j < 4; ++j) s += (v[j].x * v[j].x + v[j].y * v[j].y) + (v[j].z * v[j].z + v[j].w * v[j].w);
        const float rs = rsqrtf(wave_sum(s) * (1.0f / DM) + EPS);
#pragma unroll
        for (int j = 0; j < 4; ++j) { const f32x4 gg = ((const f32x4*)gfin)[lane + 64 * j]; xr[64 * j] = v[j] * rs * gg; }
    }
}

constexpr int NPHASE = 12;
struct Args { const void* in[28]; float* out; unsigned char* ws; int ph_lo, ph_hi; };
__global__ void __launch_bounds__(NWAVES * 64, 2) mk_fwd(Args args) {
    extern __shared__ __attribute__((aligned(16))) unsigned char lds[];
    Frame F;
    F.lds = (LAS unsigned char*)lds;
    F.MISC = (volatile LAS unsigned*)(F.lds + MISC_OFF);
    F.tid = threadIdx.x; F.lane = F.tid & 63; F.wave = __builtin_amdgcn_readfirstlane(F.tid >> 6);
    F.G = gridDim.x; { const int bx = blockIdx.x; F.vcu = (F.G % 8 == 0) ? (bx % 8) * (F.G / 8) + bx / 8 : bx; }
    F.ws = args.ws; F.out = args.out; F.ctl = (gu32*)(args.ws + WS_CTL);
    unsigned char* ws = args.ws;
    typedef const void* const volatile __attribute__((address_space(4))) kargp_t;
    kargp_t* const kargs = (kargp_t*)__builtin_amdgcn_kernarg_segment_ptr();
#define INP(k) ((const float*)kargs[k])
    for (int u = F.tid; u < (LDS_BYTES - LDSCTL_OFF) / 4; u += NWAVES * 64) ((LAS unsigned*)(F.lds + LDSCTL_OFF))[u] = 0u;
    __syncthreads();
    const int lo = args.ph_lo, hi = args.ph_hi;
    const bool single = (hi - lo) > 1;
    XcdBarrier bar; bar.bar = (unsigned*)(F.ctl + CW_BAR); bar.x = 0; bar.st = nullptr;
    if (single) bar = xcd_barrier_post((unsigned*)(F.ctl + CW_BAR), F.MISC + 8);
#define IN(k) (lo <= (k) && (k) < hi)
#if defined(PROBE_K0)
    LAS unsigned long long* tsl = (LAS unsigned long long*)(F.lds + TS_OFF);
    if (F.tid == 0) tsl[0] = rt();
#define SEAM(k) do { if (IN(k) && IN((k) + 1)) xcd_barrier(bar); if (F.tid == 0) tsl[(k) + 1] = rt(); } while (0)
#else
#define SEAM(k) do { if (IN(k) && IN((k) + 1)) xcd_barrier(bar); } while (0)
#endif
    typedef pg8::bf16_t hb;
    const int bx = (int)blockIdx.x;

    if (IN(0)) { In I;
        I.x = (const float*)INP(0);
        I.mem = (const float*)INP(1);
        I.positions = (const int*)INP(2);
        I.norm_mix_g = (const float*)INP(3);
        I.w_in = (const float*)INP(4);
        I.lq1 = (const float*)INP(5);
        I.lk1 = (const float*)INP(6);
        I.lq2 = (const float*)INP(7);
        I.lk2 = (const float*)INP(8);
        I.diff_norm_g = (const float*)INP(9);
        I.w_alpha2 = (const float*)INP(10);
        I.b_alpha = (const float*)INP(11);
        I.gla_norm_g = (const float*)INP(12);
        I.w_out = (const float*)INP(13);
        I.norm_cross_g = (const float*)INP(14);
        I.norm_mem_g = (const float*)INP(15);
        I.w_cq = (const float*)INP(16);
        I.w_ck = (const float*)INP(17);
        I.w_cv = (const float*)INP(18);
        I.w_co = (const float*)INP(19);
        I.norm_ffn_g = (const float*)INP(20);
        I.w_router = (const float*)INP(21);
        I.b_router = (const float*)INP(22);
        I.w_up = (const float*)INP(23);
        I.b_up = (const float*)INP(24);
        I.w_down = (const float*)INP(25);
        I.b_down = (const float*)INP(26);
        I.norm_final_g = (const float*)INP(27);
        p0_prologue(F, I); }
    SEAM(0);
    if (IN(1)) {
        { pg8::Gemm g{(const hb*)(ws + WS_HN), (const hb*)(ws + WS_WINT), NTOK, 3328, DM, DM, DM, 127, 127}; pg8::OrderMap S; S.init(128, 9, F.G, bx);
          pg8::EpiProj E{(hb*)(ws + WS_P), (float*)(ws + WS_LA), (const float*)(ws + WS_CS), INP(11)};
          pg8::gemm_phase<pg8::EpiProj, pg8::OrderMap, true, true>(F.lds + RING_OFF, g, S, E); }
        { pg8::Gemm g{(const hb*)(ws + WS_WINT), (const hb*)(ws + WS_HN), 3328, NTOK, DM, DM, DM, 127, 127}; pg8::OrderVT S; S.init(128, F.G, bx);
          pg8::EpiPlain E{(hb*)(ws + WS_VT) - (size_t)1024 * NTOK, NTOK, 1.0f};
          pg8::gemm_phase<pg8::EpiPlain, pg8::OrderVT, true, true>(F.lds + RING_OFF, g, S, E); }
        { pg8::Gemm g{(const hb*)(ws + WS_MN), (const hb*)(ws + WS_WCK), NMEM, DM, DM, DM, DM, 127, 127}; pg8::StaticOrder S; S.init(NMEM, DM, F.G, bx);
          pg8::EpiPlain E{(hb*)(ws + WS_KX), DM, 1.0f};
          pg8::gemm_phase<pg8::EpiPlain, pg8::StaticOrder, true, true>(F.lds + RING_OFF, g, S, E); }
        { pg8::Gemm g{(const hb*)(ws + WS_WCV), (const hb*)(ws + WS_MN), DM, NMEM, DM, DM, DM, 127, 127}; pg8::StaticOrder S; S.init(DM, NMEM, F.G, (bx + 64) % F.G);
          pg8::EpiPlain E{(hb*)(ws + WS_VXT), NMEM, 1.0f};
          pg8::gemm_phase<pg8::EpiPlain, pg8::StaticOrder, true, true>(F.lds + RING_OFF, g, S, E); }
    }
    SEAM(1);
    if (IN(2)) {
        float lam;
        { const int ln = lane_here(); const float a = INP(5)[ln] * INP(6)[ln], c = INP(7)[ln] * INP(8)[ln]; lam = __expf(wave_sum(a)) - __expf(wave_sum(c)) + 0.2f; }
        LAS int* qslot = (LAS int*)(F.lds + TAB_OFF);
#if defined(PROBE_GLA)
        const unsigned long long p2t0 = rt();
#endif
        for (;;) {
            if (F.tid == 0) qslot[0] = (int)__hip_atomic_fetch_add(F.ctl + CW_Q2, 1u, RLX_AGENT);
            __syncthreads();
            const int u = qslot[0];
            __syncthreads();
            if (u >= 64 + 1024) break;
            if (u < 64) { gla_unit(F, (const bf16*)(ws + WS_P), (const float*)(ws + WS_LA), (const bf16*)(ws + WS_GVT), (bf16*)(ws + WS_CAT), INP(12), u >> 2, u & 3);
#if defined(PROBE_GLA)
                if (F.tid == 0) { const unsigned dtv = (unsigned)(rt() - p2t0); __hip_atomic_fetch_max(F.ctl + CW_PROBE, dtv, RLX_AGENT); }
#endif
            }
            else { const int v = u - 64, bh = v & 63, qb = 15 - (v >> 6);
                diffattn_unit(F, (const bf16*)(ws + WS_P), (const bf16*)(ws + WS_VT), (bf16*)(ws + WS_CAT), INP(9), lam, bh >> 2, bh & 3, qb); }
        }
    }
    SEAM(2);
    if (IN(3)) {
        pg8::Gemm g{(const hb*)(ws + WS_CAT), (const hb*)(ws + WS_WOUT), NTOK, DM, DM, DM, DM, 127, 127}; pg8::StaticOrder S; S.init(NTOK, DM, F.G, bx);
        pg8::EpiRes1 E{INP(0), F.out, (hb*)(ws + WS_X1B), (float*)(ws + WS_SSP1)};
        pg8::gemm_phase<pg8::EpiRes1, pg8::StaticOrder, true, true>(F.lds + RING_OFF, g, S, E);
    }
    SEAM(3);
    if (IN(4)) {
        pg8::Gemm g{(const hb*)(ws + WS_X1B), (const hb*)(ws + WS_WCQ), NTOK, DM, DM, DM, DM, 127, 127}; pg8::StaticOrder S; S.init(NTOK, DM, F.G, bx);
        pg8::EpiQX E{(hb*)(ws + WS_QX), (const float*)(ws + WS_SSP1)};
        pg8::gemm_phase<pg8::EpiQX, pg8::StaticOrder, true, true>(F.lds + RING_OFF, g, S, E);
    }
    SEAM(4);
    if (IN(5)) {
        pg8::Gemm g{(const hb*)(ws + WS_QX), (const hb*)(ws + WS_KX), NTOK, 256, 256, DM, DM, 127, 127}; pg8::OrderX1 S; S.init(F.G, bx);
        pg8::EpiSoftmax E{(hb*)(ws + WS_PX), (float*)(ws + WS_SSP1), (PG8_LAS float*)(F.lds + XCH_OFF)};
        pg8::gemm_phase<pg8::EpiSoftmax, pg8::OrderX1, true, true>(F.lds + RING_OFF, g, S, E);
    }
    SEAM(5);
    if (IN(6)) {
        pg8::Gemm g{(const hb*)(ws + WS_PX), (const hb*)(ws + WS_VXT), NTOK, 256, 256, DM, NMEM, 127, 127}; pg8::OrderX2 S; S.init(F.G, bx);
        pg8::EpiPV E{(hb*)(ws + WS_OX), (const float*)(ws + WS_SSP1)};
        pg8::gemm_phase<pg8::EpiPV, pg8::OrderX2, true, true>(F.lds + RING_OFF, g, S, E);
    }
    SEAM(6);
    if (IN(7)) {
        pg8::Gemm g{(const hb*)(ws + WS_OX), (const hb*)(ws + WS_WCO), NTOK, DM, DM, DM, DM, 127, 127}; pg8::StaticOrder S; S.init(NTOK, DM, F.G, bx);
        pg8::EpiRes2 E{F.out, ws + WS_X2B};
        pg8::gemm_phase<pg8::EpiRes2, pg8::StaticOrder, true, true>(F.lds + RING_OFF, g, S, E);
    }
    SEAM(7);
    if (IN(8)) router_phase(F, F.out, (const float*)(ws + WS_WR), INP(22), (float*)(ws + WS_RSL), (float*)(ws + WS_GATE), (unsigned*)(ws + WS_ASSIGN), (unsigned*)(ws + WS_LIST), F.ctl + CW_CNT);
    SEAM(8);
    if (IN(9)) {
        const int T = moe_tables(F);
        pg8::Gemm g{(const hb*)(ws + WS_X2B), (const hb*)(ws + WS_WUP), T * 256, NEXP * 2048, 512, 512, 512, 127, 122}; pg8::MoeOrderG S;
        S.init(T, 8, F.G, bx, (const PG8_LAS unsigned char*)(F.lds + TAB_OFF), (const PG8_LAS int*)(F.lds + TAB_TSTART), (const PG8_LAS int*)(F.lds + TAB_CNT), (const unsigned*)(ws + WS_LIST), (PG8_LAS unsigned*)(F.lds + XCH_OFF));
        pg8::EpiUp E{ws + WS_ACT, (const float*)(ws + WS_RSL), (const PG8_LAS int*)(F.lds + TAB_TSTART), (const PG8_LAS int*)(F.lds + TAB_CNT), INP(24)};
        pg8::gemm_phase<pg8::EpiUp, pg8::MoeOrderG, true, true, true>(F.lds + RING_OFF, g, S, E);
    }
    SEAM(9);
    if (IN(10)) {
        const int T = moe_tables(F);
        pg8::Gemm g{(const hb*)(ws + WS_ACT), (const hb*)(ws + WS_WDN), T * 256, NEXP * 1024, 512, 512, 512, 127, 122}; pg8::MoeOrder S; S.init(T, 4, F.G, bx, (const PG8_LAS unsigned char*)(F.lds + TAB_OFF));
        pg8::EpiDown E{(hb*)(ws + WS_Y), INP(26)};
        pg8::gemm_phase<pg8::EpiDown, pg8::MoeOrder, true, true, true>(F.lds + RING_OFF, g, S, E);
    }
    SEAM(10);
    if (IN(11)) final_phase(F, F.out, (const bf16*)(ws + WS_Y), (const float*)(ws + WS_GATE), (const unsigned*)(ws + WS_ASSIGN), INP(27));
#if defined(PROBE_K0)
    { if (F.tid == 0) { tsl[NPHASE] = rt();
        const int ks[2] = {PROBE_K0, PROBE_K1}; unsigned long long code = 0, mul = 1;
        for (int i = 0; i < 2; ++i) { unsigned long long dt = tsl[ks[i] + 1] - tsl[ks[i]]; unsigned long long q = (dt + 800) / 1600; if (q > 63) q = 63; code += q * mul; mul *= 64; }
        tsl[15] = code * 6400ull; }
      __syncthreads();
      const unsigned long long t0 = rt(), wait = tsl[15]; float x = (float)F.tid, y = 1.0001f;
      while (rt() - t0 < wait) {
#pragma unroll
          for (int i = 0; i < 64; ++i) x = x * y + 0.5f; }
      if (x == 12345.678f) F.out[0] = x; }
#endif
#undef IN
#undef SEAM
}

#ifndef MK_N_LAUNCHES
#define MK_N_LAUNCHES 1
#endif
extern "C" void kernel_launch(void* const* d_in, const int* in_sizes, int n_in, void* d_out, int out_size, void* d_ws, size_t ws_size, hipStream_t stream) {
    static int grid = 0;
    if (grid == 0) {
        if (n_in != 28 || out_size != NTOK * DM || ws_size < WS_END) { fprintf(stderr, "kernel_launch: unexpected shapes: n_in %d out %d ws %zu (need %zu)\n", n_in, out_size, ws_size, (size_t)WS_END); grid = -1; return; }
        int dev = 0, cus = 0, per_cu = 0;
        if (hipGetDevice(&dev) != hipSuccess || hipDeviceGetAttribute(&cus, hipDeviceAttributeMultiprocessorCount, dev) != hipSuccess) { fprintf(stderr, "kernel_launch: device query failed\n"); grid = -1; return; }
        if (hipFuncSetAttribute((const void*)mk_fwd, hipFuncAttributeMaxDynamicSharedMemorySize, LDS_BYTES) != hipSuccess) { fprintf(stderr, "kernel_launch: hipFuncSetAttribute failed\n"); grid = -1; return; }
        if (hipOccupancyMaxActiveBlocksPerMultiprocessor(&per_cu, (const void*)mk_fwd, NWAVES * 64, LDS_BYTES) != hipSuccess || per_cu < 1) { fprintf(stderr, "kernel_launch: occupancy query reports %d workgroups per CU\n", per_cu); (void)hipGetLastError(); grid = -1; return; }
        grid = cus;
    }
    if (grid < 0) return;
    (void)hipMemsetAsync((char*)d_ws + WS_CTL, 0, CTL_ZERO_BYTES, stream);
    Args a{};
    for (int i = 0; i < 28; ++i) a.in[i] = d_in[i];
    a.out = (float*)d_out; a.ws = (unsigned char*)d_ws;
    if (MK_N_LAUNCHES == 1) { a.ph_lo = 0; a.ph_hi = NPHASE; hipLaunchKernelGGL(mk_fwd, dim3(grid), dim3(NWAVES * 64), LDS_BYTES, stream, a); }
    else for (int p = 0; p < NPHASE; ++p) { a.ph_lo = p; a.ph_hi = p + 1; hipLaunchKernelGGL(mk_fwd, dim3(grid), dim3(NWAVES * 64), LDS_BYTES, stream, a); }
}
```

```cpp
#include <hip/hip_runtime.h>
#include <cstdio>
#include <cstdint>
namespace pg8 {
#define PG8_LAS __attribute__((address_space(3)))
typedef unsigned short bf16_t;
typedef short bf16x8 __attribute__((ext_vector_type(8)));
typedef float f32x4 __attribute__((ext_vector_type(4)));
typedef unsigned u32x4 __attribute__((ext_vector_type(4)));
constexpr int BM = 256, BK = 64, HALF = 128, HTB = HALF * BK * 2  , STAGE_BYTES = 8 * HTB, NXCD = 8, WGM = 8;

__host__ __device__ __forceinline__ int lds_byte(int r, int c) { const int st = (r >> 4) * 2 + (c >> 5), rr = r & 15, cc = c & 31, ob = rr * 64 + cc * 2; return st * 1024 + (ob ^ (((ob >> 9) & 1) << 5)); }
__host__ __device__ __forceinline__ void stage_rc(int b, int& R, int& C) { const int st = b / 1024, sb = b % 1024, swz = sb ^ (((sb >> 9) & 1) << 5); R = (st >> 1) * 16 + swz / 64; C = (st & 1) * 32 + (swz % 64) / 2; }
__host__ __device__ __forceinline__ int perm32(int rho) { const int n = rho >> 4, i = rho & 15; return 8 * (i >> 2) + 4 * n + (i & 3); }

struct Unit { int pm, pn; };
struct Gemm { const bf16_t* A; const bf16_t* Bt; int M, N, K, lda, ldb, sa, sb; };
struct OrderBase {
    static constexpr bool GATHER = false;
    __device__ __forceinline__ const char* a_base(const Gemm& g, const Unit& u) const { return (const char*)g.A + (size_t)u.pm * 256 * g.lda * 2; }
    __device__ __forceinline__ const char* b_base(const Gemm& g, const Unit& u) const { return (const char*)g.Bt + (size_t)u.pn * 256 * g.ldb * 2; }
    __device__ __forceinline__ void a_ready(const Unit&) const {}
    __device__ __forceinline__ void done(const Unit&) const {}
};

struct StaticOrder : OrderBase {
    int nM, nN, nwg, G, c;
    __host__ __device__ void init(int M, int N, int G_, int c_) { nM = M / BM; nN = N / BM; nwg = nM * nN; G = G_; c = c_; }
    __host__ __device__ bool next(int i, Unit& u) const {
        const long L = (long)i * G + c; if (L >= nwg) return false;
        int wgid = (int)L; { const int q = nwg / NXCD, r = nwg % NXCD, xcd = wgid % NXCD, off = wgid / NXCD; wgid = (xcd < r ? xcd * (q + 1) : r * (q + 1) + (xcd - r) * q) + off; }
        const int nig = WGM * nN, gid = wgid / nig, fm = gid * WGM, gsz = (nM - fm) < WGM ? (nM - fm) : WGM;
        u.pm = fm + ((wgid % nig) % gsz); u.pn = (wgid % nig) / gsz; return true;
    }
};

typedef unsigned u32x2 __attribute__((ext_vector_type(2)));
typedef float f32x2_t __attribute__((ext_vector_type(2)));
typedef __bf16 bf16x2_t __attribute__((ext_vector_type(2)));
__device__ __forceinline__ unsigned cvtpk(float lo, float hi) { f32x2_t v = {lo, hi}; bf16x2_t b = __builtin_convertvector(v, bf16x2_t); return __builtin_bit_cast(unsigned, b); }
__device__ __forceinline__ void st_bf4(bf16_t* p, f32x4 v) { u32x2 w; w.x = cvtpk(v[0], v[1]); w.y = cvtpk(v[2], v[3]); *(u32x2*)p = w; }
__device__ __forceinline__ unsigned cvt4_fp8(f32x4 v) { unsigned w = __builtin_amdgcn_cvt_pk_fp8_f32(v[0], v[1], 0, false); return __builtin_amdgcn_cvt_pk_fp8_f32(v[2], v[3], w, true); }
__device__ __forceinline__ float bf2f(bf16_t b) { return __builtin_bit_cast(float, (unsigned)b << 16); }
#define EPI_ROWS _Pragma("unroll") for (int ai = 0; ai < 2; ++ai) _Pragma("unroll") for (int m = 0; m < 4; ++m)
#define EPI_COLS _Pragma("unroll") for (int bj = 0; bj < 2; ++bj) _Pragma("unroll") for (int n = 0; n < 2; ++n)
constexpr float LOG2E = 1.4426950408889634f;
constexpr float QSCALE_DA = 0.125f * LOG2E;
constexpr float QSCALE_X = 0.0625f * LOG2E;

struct EpiPlain {
    static constexpr bool PERM = false, AFTER_DRAIN = false;
    bf16_t* O; int ldc; float scale;
    __device__ __forceinline__ void operator()(const f32x4 (&acc)[2][2][4][2], const Unit& u, int wr, int wc, int fr, int fq) const {
        EPI_ROWS { const int row = u.pm * 256 + ai * 128 + wr * 64 + m * 16 + fr; bf16_t* rp = O + (size_t)row * ldc + u.pn * 256 + wc * 32 + fq * 4;
            EPI_COLS st_bf4(rp + bj * 128 + n * 16, acc[ai][bj][m][n] * scale); }
    }
};
struct EpiProj {
    static constexpr bool PERM = false, AFTER_DRAIN = false;
    bf16_t* P; float* LA; const float* cs; const float* b_alpha;
    template <int ai> __device__ __forceinline__ void decay_rows(const f32x4 (&acc)[2][2][4][2], const Unit& u, int wr, int wc, int fr, int fq) const {
        const int row0 = u.pm * 256 + ai * 128 + wr * 64 + fr;
        EPI_COLS { const int col = bj * 128 + wc * 32 + n * 16 + fq * 4; const f32x4 ba = *(const f32x4*)(b_alpha + col); f32x4 run = {0.f, 0.f, 0.f, 0.f};
            _Pragma("unroll") for (int m = 0; m < 4; ++m) { const f32x4 z = acc[ai][bj][m][n] + ba; f32x4 o;
                _Pragma("unroll") for (int i = 0; i < 4; ++i) { float v = (fminf(z[i], 0.f) - __logf(1.0f + __expf(-fabsf(z[i])))) * 0.0625f;
                    { float t = __shfl_up(v, 1, 16); if (fr >= 1) v += t; t = __shfl_up(v, 2, 16); if (fr >= 2) v += t; t = __shfl_up(v, 4, 16); if (fr >= 4) v += t; t = __shfl_up(v, 8, 16); if (fr >= 8) v += t; }
                    o[i] = v + run[i]; run[i] += __shfl(v, 15, 16); }
                *(f32x4*)(LA + (size_t)(row0 + m * 16) * 256 + col) = o; } }
    }
    __device__ __forceinline__ void operator()(const f32x4 (&acc)[2][2][4][2], const Unit& u, int wr, int wc, int fr, int fq) const {
        const int pn = u.pn;
        if (pn < 4) {
            const float sc = pn < 2 ? QSCALE_DA : 1.0f; const bool ropew = (wc & 1) == 0; const bool hi = (fq >> 1) != 0;
            EPI_ROWS { const int row = u.pm * 256 + ai * 128 + wr * 64 + m * 16 + fr; bf16_t* rp = P + (size_t)row * 3072 + pn * 256 + wc * 32 + fq * 4;
                f32x4 cv = {1.f, 1.f, 1.f, 1.f}, sv = {0.f, 0.f, 0.f, 0.f};
                if (ropew) { cv = *(const f32x4*)(cs + (size_t)row * 16 + 4 * (fq & 1)); sv = *(const f32x4*)(cs + (size_t)row * 16 + 8 + 4 * (fq & 1)); }
                EPI_COLS { f32x4 v = acc[ai][bj][m][n];
                    if (n == 0 && ropew) { f32x4 p; p[0] = __shfl_xor(v[0], 32); p[1] = __shfl_xor(v[1], 32); p[2] = __shfl_xor(v[2], 32); p[3] = __shfl_xor(v[3], 32);
                        v = hi ? (v * cv + p * sv) : (v * cv - p * sv); }
                    st_bf4(rp + bj * 128 + n * 16, v * sc); } }
        } else if (pn < 12) {
            const float sc = pn == 6 ? 0.125f : 1.0f;
            EPI_ROWS { const int row = u.pm * 256 + ai * 128 + wr * 64 + m * 16 + fr; bf16_t* rp = P + (size_t)row * 3072 + pn * 256 + wc * 32 + fq * 4;
                EPI_COLS st_bf4(rp + bj * 128 + n * 16, acc[ai][bj][m][n] * sc); }
        } else {
            decay_rows<0>(acc, u, wr, wc, fr, fq); decay_rows<1>(acc, u, wr, wc, fr, fq);
        }
    }
};
struct EpiP1 {
    static constexpr bool PERM = false, AFTER_DRAIN = false;
    EpiProj proj; EpiPlain vt, kx, vxt;
    __device__ __forceinline__ void operator()(const f32x4 (&acc)[2][2][4][2], const Unit& u, int wr, int wc, int fr, int fq) const {
        const int job = u.pn >> 16; Unit v; v.pm = u.pm; v.pn = u.pn & 0xffff;
        if (job == 0) proj(acc, v, wr, wc, fr, fq); else if (job == 1) vt(acc, v, wr, wc, fr, fq); else if (job == 2) kx(acc, v, wr, wc, fr, fq); else vxt(acc, v, wr, wc, fr, fq);
    }
};
struct EpiRes1 {
    static constexpr bool PERM = false, AFTER_DRAIN = false;
    const float* base; float* out; bf16_t* xb; float* ssp;
    __device__ __forceinline__ void operator()(const f32x4 (&acc)[2][2][4][2], const Unit& u, int wr, int wc, int fr, int fq) const {
        EPI_ROWS { const int row = u.pm * 256 + ai * 128 + wr * 64 + m * 16 + fr; const size_t off = (size_t)row * 1024 + u.pn * 256 + wc * 32 + fq * 4; float ss = 0.f;
            EPI_COLS { const size_t o2 = off + bj * 128 + n * 16; const f32x4 v = *(const f32x4*)(base + o2) + acc[ai][bj][m][n]; *(f32x4*)(out + o2) = v; st_bf4(xb + o2, v);
                ss += (v[0] * v[0] + v[1] * v[1]) + (v[2] * v[2] + v[3] * v[3]); }
            ss += __shfl_xor(ss, 16); ss += __shfl_xor(ss, 32);
            if (fq == 0) ssp[(size_t)row * 16 + u.pn * 4 + wc] = ss; }
    }
};
struct EpiQX {
    static constexpr bool PERM = false, AFTER_DRAIN = false;
    bf16_t* O; const float* ssp;
    __device__ __forceinline__ void operator()(const f32x4 (&acc)[2][2][4][2], const Unit& u, int wr, int wc, int fr, int fq) const {
        EPI_ROWS { const int row = u.pm * 256 + ai * 128 + wr * 64 + m * 16 + fr; const f32x4* sp = (const f32x4*)(ssp + (size_t)row * 16);
            const f32x4 a = sp[0], b = sp[1], c = sp[2], d = sp[3]; const float ss = ((a[0] + a[1]) + (a[2] + a[3])) + ((b[0] + b[1]) + (b[2] + b[3])) + ((c[0] + c[1]) + (c[2] + c[3])) + ((d[0] + d[1]) + (d[2] + d[3]));
            const float rs = rsqrtf(ss * (1.0f / 1024.0f) + 1e-6f) * QSCALE_X; bf16_t* rp = O + (size_t)row * 1024 + u.pn * 256 + wc * 32 + fq * 4;
            EPI_COLS st_bf4(rp + bj * 128 + n * 16, acc[ai][bj][m][n] * rs); }
    }
};
struct EpiRes2 {
    static constexpr bool PERM = false, AFTER_DRAIN = false;
    float* out; unsigned char* xb;
    __device__ __forceinline__ void operator()(const f32x4 (&acc)[2][2][4][2], const Unit& u, int wr, int wc, int fr, int fq) const {
        EPI_ROWS { const int row = u.pm * 256 + ai * 128 + wr * 64 + m * 16 + fr; float* rp = out + (size_t)row * 1024 + u.pn * 256 + wc * 32 + fq * 4;
            unsigned char* bp = xb + (size_t)row * 1024 + u.pn * 256 + wc * 32 + fq * 4;
            EPI_COLS { f32x4* p = (f32x4*)(rp + bj * 128 + n * 16); const f32x4 v = *p + acc[ai][bj][m][n]; *p = v; *(unsigned*)(bp + bj * 128 + n * 16) = cvt4_fp8(v); } }
    }
};
struct EpiUp {
    static constexpr bool PERM = false, AFTER_DRAIN = false;
    unsigned char* ACT; const float* rsl; const PG8_LAS int* tstart; const PG8_LAS int* cnt; const float* b_up;
    __device__ __forceinline__ void operator()(const f32x4 (&acc)[2][2][4][2], const Unit& u, int wr, int wc, int fr, int fq) const {
        const int e = u.pn >> 3, pnl = u.pn & 7; const float* bg = b_up + (size_t)e * 2048 + pnl * 128 + wc * 32 + fq * 4;
        const int pos0 = (u.pm - tstart[e]) * 256 + wr * 64 + fr, nv = cnt[e]; const float* rp0 = rsl + (size_t)e * 32768 + pos0;
        EPI_ROWS { const int row = u.pm * 256 + ai * 128 + wr * 64 + m * 16 + fr; const float rs = (pos0 + ai * 128 + m * 16) < nv ? rp0[ai * 128 + m * 16] : 0.f;
            unsigned char* rp = ACT + (size_t)row * 1024 + pnl * 128 + wc * 32 + fq * 4;
            _Pragma("unroll") for (int n = 0; n < 2; ++n) { const f32x4 g = acc[ai][0][m][n] * rs + *(const f32x4*)(bg + n * 16), l = acc[ai][1][m][n] * rs + *(const f32x4*)(bg + 1024 + n * 16); f32x4 o;
                _Pragma("unroll") for (int i = 0; i < 4; ++i) { const float gl = fminf(g[i], 7.0f), li = fminf(fmaxf(l[i], -7.0f), 7.0f); o[i] = gl / (1.0f + __expf(-1.702f * gl)) * (li + 1.0f); }
                *(unsigned*)(rp + n * 16) = cvt4_fp8(o); } }
    }
};
struct EpiDown {
    static constexpr bool PERM = false, AFTER_DRAIN = false;
    unsigned char* Y; const float* b_down;
    __device__ __forceinline__ void operator()(const f32x4 (&acc)[2][2][4][2], const Unit& u, int wr, int wc, int fr, int fq) const {
        const int e = u.pn >> 2, pnl = u.pn & 3; const float* bp = b_down + (size_t)e * 1024 + pnl * 256 + wc * 32 + fq * 4;
        EPI_ROWS { const int row = u.pm * 256 + ai * 128 + wr * 64 + m * 16 + fr; unsigned char* rp = Y + (size_t)row * 1024 + pnl * 256 + wc * 32 + fq * 4;
            EPI_COLS *(unsigned*)(rp + bj * 128 + n * 16) = cvt4_fp8(acc[ai][bj][m][n] + *(const f32x4*)(bp + bj * 128 + n * 16)); }
    }
};
struct OrderMap : OrderBase {
    StaticOrder so;
    __device__ void init(int nM, int nN, int G, int c) { so.nM = nM; so.nN = nN; so.nwg = nM * nN; so.G = G; so.c = c; }
    __device__ bool next(int i, Unit& u) const { if (!so.next(i, u)) return false; u.pn += (u.pn >= 4 ? 2 : 0) + (u.pn >= 6 ? 2 : 0); return true; }
};
struct OrderVT : OrderBase {
    StaticOrder so;
    __device__ void init(int nN, int G, int c) { so.nM = 4; so.nN = nN; so.nwg = 4 * nN; so.G = G; so.c = c; }
    __device__ bool next(int i, Unit& u) const { if (!so.next(i, u)) return false; u.pm += (u.pm >= 2 ? 6 : 4); return true; }
};
__device__ __forceinline__ void map_unit(int L, int nM, int nN, int& pm, int& pn) {
    const int nwg = nM * nN; int wgid = L; { const int q = nwg / NXCD, r = nwg % NXCD, xcd = wgid % NXCD, off = wgid / NXCD; wgid = (xcd < r ? xcd * (q + 1) : r * (q + 1) + (xcd - r) * q) + off; }
    const int nig = WGM * nN, gid = wgid / nig, fm = gid * WGM, gsz = (nM - fm) < WGM ? (nM - fm) : WGM;
    pm = fm + ((wgid % nig) % gsz); pn = (wgid % nig) / gsz;
}
template <unsigned oHN, unsigned oWINT, unsigned oMN, unsigned oWCK, unsigned oWCV>
struct OrderP1 : OrderBase {
    int G, c; const char* ws;
    __device__ __forceinline__ bool next(int i, Unit& u) const {
        int L = i * G + c; if (L >= 1792) return false;
        if (L < 1152) { map_unit(L, 128, 9, u.pm, u.pn); u.pn += (u.pn >= 4 ? 2 : 0) + (u.pn >= 6 ? 2 : 0); return true; } L -= 1152;
        if (L < 512) { map_unit(L, 4, 128, u.pm, u.pn); u.pm += (u.pm >= 2 ? 6 : 4); u.pn |= 1 << 16; return true; } L -= 512;
        if (L < 64) { map_unit(L, 16, 4, u.pm, u.pn); u.pn |= 2 << 16; return true; } L -= 64;
        map_unit(L, 4, 16, u.pm, u.pn); u.pn |= 3 << 16; return true;
    }
    __device__ __forceinline__ const char* a_base(const Gemm&, const Unit& u) const { const int job = u.pn >> 16; unsigned o = oHN; o = job == 1 ? oWINT : o; o = job == 2 ? oMN : o; o = job == 3 ? oWCV : o; return ws + o + (size_t)u.pm * (256 * 1024 * 2); }
    __device__ __forceinline__ const char* b_base(const Gemm&, const Unit& u) const { const int job = u.pn >> 16; unsigned o = oWINT; o = job == 1 ? oHN : o; o = job == 2 ? oWCK : o; o = job == 3 ? oMN : o; return ws + o + (size_t)(u.pn & 0xffff) * (256 * 1024 * 2); }
};
struct MoeOrder : OrderBase {
    StaticOrder so; const PG8_LAS unsigned char* tile_e; int nN;
    __device__ void init(int nM, int nN_, int G, int c, const PG8_LAS unsigned char* te) { so.nM = nM; so.nN = nN_; so.nwg = nM * nN_; so.G = G; so.c = c; tile_e = te; nN = nN_; }
    __device__ bool next(int i, Unit& u) const { if (!so.next(i, u)) return false; u.pn += (int)tile_e[u.pm] * nN; return true; }
};


struct MoeOrderG : OrderBase {
    static constexpr bool GATHER = true;
    StaticOrder so; const PG8_LAS unsigned char* tile_e; const PG8_LAS int* tstart; const PG8_LAS int* cnt; const unsigned* list; PG8_LAS unsigned* gslot; int nN;
    __device__ void init(int nM, int nN_, int G, int c, const PG8_LAS unsigned char* te, const PG8_LAS int* ts, const PG8_LAS int* cn, const unsigned* li, PG8_LAS unsigned* gs) {
        so.nM = nM; so.nN = nN_; so.nwg = nM * nN_; so.G = G; so.c = c; tile_e = te; tstart = ts; cnt = cn; list = li; gslot = gs; nN = nN_; }
    __device__ bool next(int i, Unit& u) const { if (!so.next(i, u)) return false; u.pn += (int)tile_e[u.pm] * nN; return true; }
    __device__ __forceinline__ const char* a_base(const Gemm& g, const Unit&) const { return (const char*)g.A; }
    __device__ __forceinline__ const unsigned* rows(const Unit& u) const { const int e = u.pn / nN; return list + (size_t)e * 32768 + (size_t)(u.pm - tstart[e]) * 256; }
    __device__ __forceinline__ int nvalid(const Unit& u) const { const int e = u.pn / nN; return cnt[e] - (u.pm - tstart[e]) * 256; }
};
struct OrderX1 : OrderBase {
    StaticOrder so;
    __device__ void init(int G, int c) { so.nM = 128; so.nN = 4; so.nwg = 512; so.G = G; so.c = c; }
    __device__ bool next(int i, Unit& u) const { return so.next(i, u); }
    __device__ __forceinline__ const char* a_base(const Gemm& g, const Unit& u) const { return (const char*)(g.A + (size_t)u.pm * 256 * 1024 + u.pn * 256); }
    __device__ __forceinline__ const char* b_base(const Gemm& g, const Unit& u) const { return (const char*)(g.Bt + (size_t)(u.pm >> 3) * 256 * 1024 + u.pn * 256); }
};
struct OrderX2 : OrderBase {
    StaticOrder so;
    __device__ void init(int G, int c) { so.nM = 128; so.nN = 4; so.nwg = 512; so.G = G; so.c = c; }
    __device__ bool next(int i, Unit& u) const { return so.next(i, u); }
    __device__ __forceinline__ const char* a_base(const Gemm& g, const Unit& u) const { return (const char*)(g.A + (size_t)u.pm * 256 * 1024 + u.pn * 256); }
    __device__ __forceinline__ const char* b_base(const Gemm& g, const Unit& u) const { return (const char*)(g.Bt + (size_t)u.pn * 256 * 4096 + (u.pm >> 3) * 256); }
};
struct EpiSoftmax {
    static constexpr bool PERM = false, AFTER_DRAIN = false;
    bf16_t* PX; float* lp; PG8_LAS float* xch;
    __device__ __forceinline__ void operator()(const f32x4 (&acc)[2][2][4][2], const Unit& u, int wr, int wc, int fr, int fq) const {
        PG8_LAS char* rb = (PG8_LAS char*)xch + (wr * 64 + fr) * 16; asm volatile("" : "+v"(rb));
        PG8_LAS char* wb = rb + wc * 4; asm volatile("" : "+v"(wb));
        EPI_ROWS { float a = -INFINITY;
            EPI_COLS { const f32x4 v = acc[ai][bj][m][n]; a = fmaxf(a, fmaxf(fmaxf(v[0], v[1]), fmaxf(v[2], v[3]))); }
            a = fmaxf(a, __shfl_xor(a, 16)); a = fmaxf(a, __shfl_xor(a, 32));
            if (fq == 0) *(PG8_LAS float*)(wb + (ai * 128 + m * 16) * 16) = a; }
        asm volatile("s_waitcnt lgkmcnt(0)" ::: "memory"); __builtin_amdgcn_s_barrier(); asm volatile("" ::: "memory");
        const int row0 = u.pm * 256 + wr * 64 + fr; bf16_t* rp0 = PX + (size_t)row0 * 1024 + u.pn * 256 + wc * 32 + fq * 4; float* lp0 = lp + (size_t)row0 * 16 + u.pn * 4 + wc;
        EPI_ROWS { const f32x4 q = *(const PG8_LAS f32x4*)(rb + (ai * 128 + m * 16) * 16); const float mr = fmaxf(fmaxf(q[0], q[1]), fmaxf(q[2], q[3]));
            bf16_t* rp = rp0 + (size_t)(ai * 128 + m * 16) * 1024; float ps = 0.f;
            EPI_COLS { const f32x4 v = acc[ai][bj][m][n]; f32x4 p; _Pragma("unroll") for (int i = 0; i < 4; ++i) { p[i] = __builtin_amdgcn_exp2f(v[i] - mr); ps += p[i]; }
                st_bf4(rp + bj * 128 + n * 16, p); }
            ps += __shfl_xor(ps, 16); ps += __shfl_xor(ps, 32);
            if (fq == 0) lp0[(ai * 128 + m * 16) * 16] = ps; }
        asm volatile("s_waitcnt lgkmcnt(0)" ::: "memory"); __builtin_amdgcn_s_barrier(); asm volatile("" ::: "memory");
    }
};
struct EpiPV {
    static constexpr bool PERM = false, AFTER_DRAIN = false;
    bf16_t* O; const float* lp;
    __device__ __forceinline__ void operator()(const f32x4 (&acc)[2][2][4][2], const Unit& u, int wr, int wc, int fr, int fq) const {
        EPI_ROWS { const int row = u.pm * 256 + ai * 128 + wr * 64 + m * 16 + fr; const f32x4 q = *(const f32x4*)(lp + (size_t)row * 16 + u.pn * 4);
            const float inv = 1.0f / ((q[0] + q[1]) + (q[2] + q[3])); bf16_t* rp = O + (size_t)row * 1024 + u.pn * 256 + wc * 32 + fq * 4;
            EPI_COLS st_bf4(rp + bj * 128 + n * 16, acc[ai][bj][m][n] * inv); }
    }
};
typedef int v4i_t __attribute__((ext_vector_type(4))); typedef int v8i_t __attribute__((ext_vector_type(8)));
__device__ __forceinline__ v8i_t cat8(bf16x8 lo, bf16x8 hi) { return __builtin_shufflevector(__builtin_bit_cast(v4i_t, lo), __builtin_bit_cast(v4i_t, hi), 0, 1, 2, 3, 4, 5, 6, 7); }
__device__ __forceinline__ void mfma8(f32x4& acc, v8i_t w, v8i_t a, int sw, int sa) {
    asm volatile("s_nop 1\n\tv_mfma_scale_f32_16x16x128_f8f6f4 %0, %1, %2, %0, %3, %4 op_sel_hi:[0,0,0]" : "+v"(acc) : "v"(w), "v"(a), "v"(sw), "v"(sa)); }
constexpr int PF_D = 4, PF_LDS = 137216;
template <class Epi, class Sched, bool ALIGN_EPI = false, bool SP2 = false, bool FP8 = false, bool PF = false>
__device__ __forceinline__ void gemm_phase(PG8_LAS unsigned char* lds, const Gemm g, const Sched& S, const Epi& E) {
    const int tid = threadIdx.x, wid = __builtin_amdgcn_readfirstlane(tid >> 6), lane = tid & 63, wr = wid >> 2, wc = wid & 3, fr = lane & 15, fq = lane >> 4;
    const int K = g.K, nt = K / BK;
    unsigned voffA[2], voffB[2];
    unsigned gC[2][2];
#pragma unroll
    for (int i = 0; i < 2; ++i) { int R, C; stage_rc(tid * 16 + i * 8192, R, C); const int Rb = Epi::PERM ? ((R & ~31) + perm32(R & 31)) : R;
        voffA[i] = (unsigned)(R * g.lda + C) * 2u; voffB[i] = (unsigned)(Rb * g.ldb + C) * 2u; }
    const bool pfA = !Sched::GATHER && wid < 4;
    const unsigned pfoff = (unsigned)((((wid >> 1) & 1) * HALF + (wid & 1) * 64 + lane) * (pfA ? g.lda : g.ldb)) * 2u;
    const size_t kstep = (size_t)(BK * 2);
    const size_t hstepA = (size_t)HALF * g.lda * 2, hstepB = (size_t)HALF * g.ldb * 2;
    const unsigned ldsw = (unsigned)wid * 1024u;
    const int aoff = lds_byte(wr * 64 + fr, fq * 8), boff = lds_byte(wc * 32 + fr, fq * 8);
#define PG8_SA(b, h) (((b) * 2 + (h)) * HTB)
#define PG8_SB(b, h) ((4 + (b) * 2 + (h)) * HTB)
#define PG8_STAGE(bufoff, gbase, voff) do { _Pragma("unroll") for (int _i = 0; _i < 2; ++_i) \
        __builtin_amdgcn_global_load_lds((const unsigned*)((const char*)(gbase) + (voff)[_i]), (PG8_LAS unsigned*)(lds + (bufoff) + ldsw + _i * 8192), 16, 0, 0); } while (0)
#define PG8_STAGE_A(bufoff, ptr, h, nx) do { if constexpr (Sched::GATHER) { PG8_STAGE(bufoff, ptr, gC[h]); } else { PG8_STAGE(bufoff, (ptr) + ((h) ? hstepA : 0), voffA); } } while (0)
#define PG8_LDA(dst, b, h) do { _Pragma("unroll") for (int m = 0; m < 4; ++m) _Pragma("unroll") for (int k = 0; k < 2; ++k) dst[m][k] = *(const PG8_LAS bf16x8*)(lds + PG8_SA(b, h) + aoff + m * 2048 + k * 1024); } while (0)
#define PG8_LDB(dst, b, h) do { _Pragma("unroll") for (int n = 0; n < 2; ++n) _Pragma("unroll") for (int k = 0; k < 2; ++k) dst[n][k] = *(const PG8_LAS bf16x8*)(lds + PG8_SB(b, h) + boff + n * 2048 + k * 1024); } while (0)
#define PG8_MMA(ai, bj, At, Bt) do { __builtin_amdgcn_s_setprio(1); \
        if constexpr (FP8) { _Pragma("unroll") for (int m = 0; m < 4; ++m) _Pragma("unroll") for (int n = 0; n < 2; ++n) \
            mfma8(acc[ai][bj][m][n], cat8(Bt[n][0], Bt[n][1]), cat8(At[m][0], At[m][1]), g.sb, g.sa); } \
        else { _Pragma("unroll") for (int m = 0; m < 4; ++m) _Pragma("unroll") for (int n = 0; n < 2; ++n) _Pragma("unroll") for (int k = 0; k < 2; ++k) \
            acc[ai][bj][m][n] = __builtin_amdgcn_mfma_f32_16x16x32_bf16(Bt[n][k], At[m][k], acc[ai][bj][m][n], 0, 0, 0); } \
        __builtin_amdgcn_s_setprio(0); } while (0)
#define PG8_WAIT_V(n) asm volatile("s_waitcnt vmcnt(" #n ")" ::: "memory")
#define PG8_WAIT_VP() do { if constexpr (PF) asm volatile("s_waitcnt vmcnt(9)" ::: "memory"); else asm volatile("s_waitcnt vmcnt(8)" ::: "memory"); } while (0)
#define PG8_PREFETCH(tp) do { if constexpr (PF) { const int tp_ = (tp); const char* pb_ = tp_ < nt ? (pfA ? cA : cB) + (size_t)tp_ * kstep : (pfA ? nA : nB) + (size_t)(tp_ - nt) * kstep; \
        __builtin_amdgcn_global_load_lds((const unsigned*)(pb_ + pfoff), (PG8_LAS unsigned*)(lds + PF_LDS + wid * 256), 4, 0, 0); } } while (0)
#define PG8_WAIT_L(n) asm volatile("s_waitcnt lgkmcnt(" #n ")" ::: "memory")
#define PG8_BAR __builtin_amdgcn_s_barrier()
#define PG8_SCHED __builtin_amdgcn_sched_barrier(0)
    Unit cur, nxt; int ui = 0;
    if (!S.next(0, cur)) return;
    f32x4 acc[2][2][4][2];
#pragma unroll
    for (int a = 0; a < 2; ++a)
#pragma unroll
        for (int b = 0; b < 2; ++b)
#pragma unroll
            for (int m = 0; m < 4; ++m)
#pragma unroll
                for (int n = 0; n < 2; ++n) acc[a][b][m][n] = (f32x4){0.f, 0.f, 0.f, 0.f};
    bf16x8 At[4][2], B0[2][2], B1[2][2];
    const char* cA = S.a_base(g, cur); const char* cB = S.b_base(g, cur);
    if constexpr (Sched::GATHER) { const unsigned* rp = S.rows(cur); const int nv = S.nvalid(cur);
#pragma unroll
        for (int h = 0; h < 2; ++h)
#pragma unroll
            for (int i = 0; i < 2; ++i) { int R, C; stage_rc(tid * 16 + i * 8192, R, C); const int r = h * HALF + R; const unsigned tok = r < nv ? rp[r] : 0u; gC[h][i] = tok * (unsigned)(g.lda * 2) + (unsigned)C * 2u; } }
    S.a_ready(cur);
    if constexpr (SP2) {
        PG8_STAGE(PG8_SB(0, 0), cB, voffB); PG8_STAGE(PG8_SB(0, 1), cB + hstepB, voffB); PG8_STAGE_A(PG8_SA(0, 0), cA, 0, 0); PG8_STAGE_A(PG8_SA(0, 1), cA, 1, 0);
        if (wr == 1) PG8_BAR;
        PG8_WAIT_V(2); PG8_BAR;
        PG8_STAGE(PG8_SB(1, 0), cB + kstep, voffB); PG8_STAGE_A(PG8_SA(1, 0), cA + kstep, 0, 0); PG8_STAGE(PG8_SB(1, 1), cB + hstepB + kstep, voffB);
        PG8_WAIT_V(6); PG8_BAR;
    } else {
        PG8_STAGE(PG8_SB(0, 0), cB, voffB); PG8_STAGE_A(PG8_SA(0, 0), cA, 0, 0); PG8_STAGE(PG8_SB(0, 1), cB + hstepB, voffB); PG8_STAGE_A(PG8_SA(0, 1), cA, 1, 0);
        if (wr == 1) PG8_BAR;
        PG8_WAIT_V(4); PG8_BAR;
        PG8_STAGE(PG8_SB(1, 0), cB + kstep, voffB); PG8_STAGE_A(PG8_SA(1, 0), cA + kstep, 0, 0); PG8_STAGE(PG8_SB(1, 1), cB + hstepB + kstep, voffB);
        PG8_WAIT_V(6); PG8_BAR;
    }
    for (;;) {
        const bool has_next = S.next(ui + 1, nxt);
        const char* nA = has_next ? S.a_base(g, nxt) : cA; const char* nB = has_next ? S.b_base(g, nxt) : cB;
        if constexpr (Sched::GATHER) { if (has_next && wid < 4)
            __builtin_amdgcn_global_load_lds((const unsigned*)(S.rows(nxt) + wid * 64 + lane), (PG8_LAS unsigned*)(S.gslot + ((ui + 1) & 1) * 256 + wid * 64), 4, 0, 0); }
#pragma nounroll
        for (int t = 0; t < nt; t += 2) {
            const bool last = (t == nt - 2);
            const char* a1 = cA + (size_t)(t + 1) * kstep;
            const char* a2 = last ? nA : cA + (size_t)(t + 2) * kstep; const char* b2 = last ? nB : cB + (size_t)(t + 2) * kstep;
            const char* a3 = a2 + kstep; const char* b3 = b2 + kstep;
            if (last && has_next) S.a_ready(nxt);
            if constexpr (SP2) {
            PG8_LDB(B0, 0, 0); PG8_LDB(B1, 0, 1); PG8_SCHED; PG8_LDA(At, 0, 0); PG8_STAGE_A(PG8_SA(1, 1), a1, 1, 0);
            if constexpr (Sched::GATHER) { if (last && has_next) {
                const PG8_LAS unsigned* sl = S.gslot + ((ui + 1) & 1) * 256; const int nv = S.nvalid(nxt);
#pragma unroll
                for (int h = 0; h < 2; ++h)
#pragma unroll
                    for (int i = 0; i < 2; ++i) { int R, C; stage_rc(tid * 16 + i * 8192, R, C); const int r = h * HALF + R; const unsigned v = sl[r]; const unsigned tok = r < nv ? v : 0u; gC[h][i] = tok * (unsigned)(g.lda * 2) + (unsigned)C * 2u; } } }
            PG8_WAIT_VP(); PG8_WAIT_L(0); PG8_BAR; PG8_MMA(0, 0, At, B0); PG8_MMA(0, 1, At, B1); PG8_BAR; PG8_SCHED;
            PG8_LDA(At, 0, 1); PG8_STAGE(PG8_SB(0, 0), b2, voffB); PG8_STAGE(PG8_SB(0, 1), b2 + hstepB, voffB); PG8_STAGE_A(PG8_SA(0, 0), a2, 0, 1); PG8_PREFETCH(t + PF_D);
            PG8_WAIT_VP(); PG8_WAIT_L(0); PG8_BAR; PG8_MMA(1, 0, At, B0); PG8_MMA(1, 1, At, B1); PG8_BAR; PG8_SCHED;
            PG8_LDB(B0, 1, 0); PG8_LDB(B1, 1, 1); PG8_SCHED; PG8_LDA(At, 1, 0); PG8_STAGE_A(PG8_SA(0, 1), a2, 1, 1);
            PG8_WAIT_VP(); PG8_WAIT_L(0); PG8_BAR; PG8_MMA(0, 0, At, B0); PG8_MMA(0, 1, At, B1); PG8_BAR; PG8_SCHED;
            PG8_LDA(At, 1, 1); PG8_STAGE(PG8_SB(1, 0), b3, voffB); PG8_STAGE(PG8_SB(1, 1), b3 + hstepB, voffB); PG8_STAGE_A(PG8_SA(1, 0), a3, 0, 1); PG8_PREFETCH(t + 1 + PF_D);
            PG8_WAIT_VP(); PG8_WAIT_L(0); PG8_BAR; PG8_MMA(1, 0, At, B0); PG8_MMA(1, 1, At, B1); PG8_BAR; PG8_SCHED;
            } else {
            PG8_LDB(B0, 0, 0); PG8_SCHED; PG8_LDA(At, 0, 0); PG8_STAGE_A(PG8_SA(1, 1), a1, 1, 0);
            PG8_WAIT_L(8); PG8_BAR; PG8_WAIT_L(0); PG8_MMA(0, 0, At, B0); PG8_BAR; PG8_SCHED;
            PG8_LDB(B1, 0, 1); PG8_STAGE(PG8_SB(0, 0), b2, voffB);
            PG8_BAR; PG8_WAIT_L(0); PG8_MMA(0, 1, At, B1); PG8_BAR;
            PG8_LDA(At, 0, 1); PG8_STAGE_A(PG8_SA(0, 0), a2, 0, 1);
            PG8_BAR; PG8_WAIT_L(0); PG8_MMA(1, 0, At, B0); PG8_BAR; PG8_SCHED;
            PG8_STAGE(PG8_SB(0, 1), b2 + hstepB, voffB);
            PG8_WAIT_V(6); PG8_BAR; PG8_MMA(1, 1, At, B1); PG8_BAR;
            PG8_LDB(B0, 1, 0); PG8_SCHED; PG8_LDA(At, 1, 0); PG8_STAGE_A(PG8_SA(0, 1), a2, 1, 1);
            PG8_WAIT_L(8); PG8_BAR; PG8_WAIT_L(0); PG8_MMA(0, 0, At, B0); PG8_BAR; PG8_SCHED;
            PG8_LDB(B1, 1, 1); PG8_STAGE(PG8_SB(1, 0), b3, voffB);
            PG8_BAR; PG8_WAIT_L(0); PG8_MMA(0, 1, At, B1); PG8_BAR;
            PG8_LDA(At, 1, 1); PG8_STAGE_A(PG8_SA(1, 0), a3, 0, 1);
            PG8_BAR; PG8_WAIT_L(0); PG8_MMA(1, 0, At, B0); PG8_BAR; PG8_SCHED;
            PG8_STAGE(PG8_SB(1, 1), b3 + hstepB, voffB);
            PG8_WAIT_V(6); PG8_BAR; PG8_MMA(1, 1, At, B1); PG8_BAR;
            }
        }
        if constexpr (ALIGN_EPI) { if (wr == 0) PG8_BAR; }
        if constexpr (FP8) asm volatile("s_nop 15\n\ts_nop 15" ::: "memory");
        if constexpr (!Epi::AFTER_DRAIN) { E(acc, cur, wr, wc, fr, fq); S.done(cur); }
        if (!has_next) break;
#pragma unroll
        for (int a = 0; a < 2; ++a)
#pragma unroll
            for (int b = 0; b < 2; ++b)
#pragma unroll
                for (int m = 0; m < 4; ++m)
#pragma unroll
                    for (int n = 0; n < 2; ++n) acc[a][b][m][n] = (f32x4){0.f, 0.f, 0.f, 0.f};
        cur = nxt; cA = nA; cB = nB; ++ui;
        if constexpr (ALIGN_EPI) { if (wr == 1) PG8_BAR; }
    }
    PG8_WAIT_V(0);
    if constexpr (!ALIGN_EPI) { if (wr == 0) PG8_BAR; }
    PG8_BAR;
    if constexpr (Epi::AFTER_DRAIN) { E.fused(acc, cur, wr, wc, fr, fq, lds, wid, lane); S.done(cur); }
#undef PG8_SA
#undef PG8_SB
#undef PG8_STAGE
#undef PG8_STAGE_A
#undef PG8_LDA
#undef PG8_LDB
#undef PG8_MMA
#undef PG8_WAIT_V
#undef PG8_WAIT_VP
#undef PG8_PREFETCH
#undef PG8_WAIT_L
#undef PG8_BAR
#undef PG8_SCHED
}
}
constexpr int NTOK = 32768, DM = 1024, SEQ = 2048, NBATCH = 16, MEMLEN = 256, NMEM = NBATCH * MEMLEN, INW = 3088, NEXP = 32, TOPK = 4;
constexpr int PW = 3072;
constexpr int MAXTILES = 544;
constexpr float EPS = 1e-6f;
constexpr int NWAVES = 8;
constexpr size_t MiB = 1u << 20;
constexpr size_t WS_CTL = 0, CTL_ZERO_BYTES = 64 * 1024;
constexpr size_t WS_WINT = 2 * MiB, WS_WOUT = 10 * MiB, WS_WCQ = 12 * MiB, WS_WCK = 14 * MiB, WS_WCV = 16 * MiB, WS_WCO = 18 * MiB;
constexpr size_t WS_WR = 20 * MiB, WS_CS = 21 * MiB, WS_SSP1 = 24 * MiB, WS_GATE = 27 * MiB, WS_ASSIGN = 28 * MiB, WS_LIST = 29 * MiB;
constexpr size_t WS_RSL = 842 * MiB;
constexpr size_t WS_X2B = 378 * MiB;
constexpr size_t WS_WUP = 34 * MiB, WS_WDN = 162 * MiB, WS_KX = 226 * MiB, WS_VXT = 234 * MiB;
constexpr size_t WS_HN = 242 * MiB, WS_CAT = 242 * MiB, WS_MN = 306 * MiB, WS_P = 314 * MiB, WS_LA = 506 * MiB, WS_VT = 538 * MiB;
constexpr size_t WS_X1B = 314 * MiB, WS_QX = 378 * MiB, WS_OX = 442 * MiB, WS_PX = 506 * MiB;
constexpr size_t WS_GVT = 602 * MiB;
constexpr size_t WS_ACT = 570 * MiB, WS_XG = 242 * MiB, WS_Y = 242 * MiB, WS_END = 846 * MiB;
constexpr int CW_Q2 = 128;
constexpr int CW_CNT = 1024;
constexpr int CW_PROBE = 192;
constexpr int CW_BAR = 4096;
constexpr int RING_OFF = 0, RING_BYTES = 131072;
constexpr int LDSCTL_OFF = RING_BYTES, MISC_OFF = LDSCTL_OFF + 320;
constexpr int TAB_OFF = LDSCTL_OFF + 512;
constexpr int TAB_TSTART = TAB_OFF + 576, TAB_CNT = TAB_TSTART + 144;
constexpr int XCH_OFF = LDSCTL_OFF + 2048;
constexpr int TS_OFF = TAB_CNT + 128;
constexpr int LDS_BYTES = 147456;

#define GAS __attribute__((address_space(1)))
#define LAS __attribute__((address_space(3)))
typedef unsigned short bf16;
typedef unsigned v4u __attribute__((ext_vector_type(4)));
typedef float f32x4 __attribute__((ext_vector_type(4)));
typedef short bf16x8 __attribute__((ext_vector_type(8)));
typedef GAS unsigned gu32;
typedef GAS unsigned long long gu64;
#define RLX_AGENT __ATOMIC_RELAXED, __HIP_MEMORY_SCOPE_AGENT
#define LDS_WAIT() asm volatile("s_waitcnt lgkmcnt(0)" ::: "memory")
#define VM_WAIT() asm volatile("s_waitcnt vmcnt(0)" ::: "memory")
__device__ __forceinline__ unsigned long long rt() { return __builtin_amdgcn_s_memrealtime(); }
__device__ __forceinline__ unsigned f2bf(float f) { unsigned u = __builtin_bit_cast(unsigned, f); return (u + 0x7fffu + ((u >> 16) & 1u)) >> 16; }
__device__ __forceinline__ unsigned pk2(float lo, float hi) { return f2bf(lo) | (f2bf(hi) << 16); }

#define XB_TMO      128
#define XB_XCNT(j)  (256  + 64 * (j))
#define XB_XSUB(j)  (1280 + 64 * (j))
#define XB_XGEN(j)  (2304 + 64 * (j))
#define XB_TOP      3328
#define XB_TOPGEN   3392
#define XCD_BAR_WORDS 3456
#define XB_SPIN_CAP (1u << 18)

__device__ __forceinline__ unsigned xb_ld(unsigned* p)              { return __hip_atomic_load(p, __ATOMIC_RELAXED, __HIP_MEMORY_SCOPE_AGENT); }
__device__ __forceinline__ unsigned xb_add(unsigned* p, unsigned v) { return __hip_atomic_fetch_add(p, v, __ATOMIC_RELAXED, __HIP_MEMORY_SCOPE_AGENT); }
__device__ __forceinline__ unsigned xb_xcc_id() { return (unsigned)__builtin_amdgcn_s_getreg((3 << 11) | 20) & 0xFu; }
#define XB_SPIN(cond, bar) do { unsigned _sp = 0; while (cond) { __builtin_amdgcn_s_sleep(1); \
    if ((++_sp & 255u) == 0u) { if (xb_ld(&(bar)[XB_TMO])) break; if (_sp > XB_SPIN_CAP) { atomicAdd(&(bar)[XB_TMO], 1u); break; } } } } while (0)

struct XcdBarrier {
    unsigned* bar; unsigned x;
    volatile LAS unsigned* st;
};

__device__ __forceinline__ XcdBarrier xcd_barrier_post(unsigned* bar, volatile LAS unsigned* st) {
    XcdBarrier b; b.bar = bar; b.x = xb_xcc_id(); b.st = st;
    if (threadIdx.x == 0) (void)xb_add(&bar[XB_XCNT(b.x)], 1u);
    return b;
}
__device__ __forceinline__ void xcd_barrier_complete(unsigned* bar, unsigned x, unsigned& nloc, unsigned& nx) {
    const unsigned G = gridDim.x * gridDim.y * gridDim.z;
    unsigned sum, cnt, mine, sp = 0u;
    for (;;) {
        sum = 0u; cnt = 0u; mine = 0u;
#pragma unroll
        for (unsigned j = 0; j < 16; ++j) { const unsigned c = xb_ld(&bar[XB_XCNT(j)]); sum += c; cnt += (c > 0u) ? 1u : 0u; mine = (j == x) ? c : mine; }
        if (sum == G) break;
        __builtin_amdgcn_s_sleep(1);
        if ((++sp & 255u) == 0u) { if (xb_ld(&bar[XB_TMO])) break; if (sp > XB_SPIN_CAP) { atomicAdd(&bar[XB_TMO], 1u); break; } }
    }
    nloc = mine > 0u ? mine : 1u; nx = cnt > 0u ? cnt : 1u;
}

__device__ __forceinline__ void xcd_barrier(const XcdBarrier& b) {
    asm volatile("s_waitcnt vmcnt(0)" ::: "memory");
    __syncthreads();
    if (threadIdx.x == 0) {
        unsigned* bar = b.bar;
        __builtin_amdgcn_s_waitcnt(0);
        unsigned nloc = b.st[0], nx = b.st[1];
        if (nloc == 0u) { xcd_barrier_complete(bar, b.x, nloc, nx); b.st[0] = nloc; b.st[1] = nx; }
        const unsigned old = xb_add(&bar[XB_XSUB(b.x)], 1u);
        const unsigned gen = old / nloc;
        if (old + 1u == (gen + 1u) * nloc) {
            __builtin_amdgcn_fence(__ATOMIC_RELEASE, "agent");
            asm volatile("s_waitcnt vmcnt(0)" ::: "memory");
            const unsigned og = xb_add(&bar[XB_TOP], 1u);
            const unsigned tg = og / nx;
            if (og + 1u == (tg + 1u) * nx) xb_add(&bar[XB_TOPGEN], 1u);
            else XB_SPIN(xb_ld(&bar[XB_TOPGEN]) == tg, bar);
            __builtin_amdgcn_fence(__ATOMIC_ACQUIRE, "agent");
            xb_add(&bar[XB_XGEN(b.x)], 1u);
            asm volatile("s_waitcnt vmcnt(0)" ::: "memory");
        } else {
            XB_SPIN(xb_ld(&bar[XB_XGEN(b.x)]) == gen, bar);
            __builtin_amdgcn_fence(__ATOMIC_ACQUIRE, "agent");
            asm volatile("s_waitcnt vmcnt(0)" ::: "memory");
        }
    }
    __syncthreads();
}
typedef short bf16x4 __attribute__((ext_vector_type(4)));
typedef unsigned v2u __attribute__((ext_vector_type(2)));
struct Frame {
    LAS unsigned char* lds;
    volatile LAS unsigned* MISC;
    gu32* ctl;
    int tid, lane, wave;
    int vcu, G;
    unsigned char* ws;
    float* out;
};
__device__ __forceinline__ int lane_here() { int t = (int)threadIdx.x; asm volatile("" : "+v"(t)); return t & 63; }
__device__ __forceinline__ float bf2f(bf16 b) { return __builtin_bit_cast(float, (unsigned)b << 16); }
__device__ __forceinline__ float wave_sum(float v) {
#pragma unroll
    for (int o = 1; o < 64; o <<= 1) v += __shfl_xor(v, o);
    return v;
}
__device__ __forceinline__ float xmax16(float m) { auto rr = __builtin_amdgcn_permlane16_swap(__float_as_uint(m), __float_as_uint(m), false, false); return fmaxf(__uint_as_float(rr[0]), __uint_as_float(rr[1])); }
__device__ __forceinline__ float xmax32(float m) { auto rr = __builtin_amdgcn_permlane32_swap(__float_as_uint(m), __float_as_uint(m), false, false); return fmaxf(__uint_as_float(rr[0]), __uint_as_float(rr[1])); }
__device__ __forceinline__ f32x4 mfma16(bf16x8 a, bf16x8 b, f32x4 c) { return __builtin_amdgcn_mfma_f32_16x16x32_bf16(a, b, c, 0, 0, 0); }

__device__ __forceinline__ void p0_transpose_item(const float* W, int ldw, const float* gain, bf16* WT, int K, int k0, int n0, size_t orow0, int lane) {
    const int n4 = lane & 15, kq = lane >> 4;
    const float* src = W + (size_t)(k0 + 16 * kq) * ldw + n0 + 4 * n4;
    f32x4 v[16];
#pragma unroll
    for (int i = 0; i < 16; ++i) v[i] = *(const f32x4*)(src + (size_t)i * ldw);
    if (gain) { const f32x4* gp = (const f32x4*)(gain + k0 + 16 * kq);
#pragma unroll
        for (int q = 0; q < 4; ++q) { const f32x4 gq = gp[q];
#pragma unroll
            for (int r = 0; r < 4; ++r) v[4 * q + r] = v[4 * q + r] * gq[r]; } }
    bf16* dst = WT + (orow0 + 4 * n4) * (size_t)K + k0 + 16 * kq;
#pragma unroll
    for (int j = 0; j < 4; ++j) { v4u o0, o1;
        o0.x = pg8::cvtpk(v[0][j], v[1][j]); o0.y = pg8::cvtpk(v[2][j], v[3][j]); o0.z = pg8::cvtpk(v[4][j], v[5][j]); o0.w = pg8::cvtpk(v[6][j], v[7][j]);
        o1.x = pg8::cvtpk(v[8][j], v[9][j]); o1.y = pg8::cvtpk(v[10][j], v[11][j]); o1.z = pg8::cvtpk(v[12][j], v[13][j]); o1.w = pg8::cvtpk(v[14][j], v[15][j]);
        *(v4u*)(dst + (size_t)j * K) = o0; *(v4u*)(dst + (size_t)j * K + 8) = o1; }
}
__device__ __forceinline__ void p0_transpose_item8(const float* W, int ldw, const float* gain, unsigned char* WT, int K, int k0, int n0, size_t orow0, int lane) {
    const int n4 = lane & 15, kq = lane >> 4;
    const float* src = W + (size_t)(k0 + 16 * kq) * ldw + n0 + 4 * n4;
    f32x4 v[16];
#pragma unroll
    for (int i = 0; i < 16; ++i) v[i] = *(const f32x4*)(src + (size_t)i * ldw);
    { const f32x4* gp = (const f32x4*)(gain + k0 + 16 * kq);
#pragma unroll
        for (int q = 0; q < 4; ++q) { f32x4 gq = {32.f, 32.f, 32.f, 32.f}; if (gain) gq = gp[q] * 32.0f;
#pragma unroll
            for (int r = 0; r < 4; ++r) v[4 * q + r] = v[4 * q + r] * gq[r]; } }
    unsigned char* dst = WT + (orow0 + 4 * n4) * (size_t)K + k0 + 16 * kq;
#pragma unroll
    for (int j = 0; j < 4; ++j) { v4u o;
        o.x = pg8::cvt4_fp8((f32x4){v[0][j], v[1][j], v[2][j], v[3][j]}); o.y = pg8::cvt4_fp8((f32x4){v[4][j], v[5][j], v[6][j], v[7][j]});
        o.z = pg8::cvt4_fp8((f32x4){v[8][j], v[9][j], v[10][j], v[11][j]}); o.w = pg8::cvt4_fp8((f32x4){v[12][j], v[13][j], v[14][j], v[15][j]});
        *(v4u*)(dst + (size_t)j * K) = o; }
}
__device__ __forceinline__ void rms_row_to_bf16(const float* xrow, const float* g, bf16* orow, int lane) {
    const f32x4* xr = (const f32x4*)xrow + lane; const f32x4* gr = (const f32x4*)g + lane;
    f32x4 v[4]; float s = 0.f;
#pragma unroll
    for (int j = 0; j < 4; ++j) { v[j] = xr[64 * j]; s += (v[j].x * v[j].x + v[j].y * v[j].y) + (v[j].z * v[j].z + v[j].w * v[j].w); }
    const float rs = rsqrtf(wave_sum(s) * (1.0f / DM) + EPS);
    unsigned long long* o8 = (unsigned long long*)orow + lane;
#pragma unroll
    for (int j = 0; j < 4; ++j) { const f32x4 gg = gr[64 * j]; o8[64 * j] = (unsigned long long)pk2(v[j].x * rs * gg.x, v[j].y * rs * gg.y) | ((unsigned long long)pk2(v[j].z * rs * gg.z, v[j].w * rs * gg.w) << 32); }
}
constexpr int MOE_I_UP = 32 * 16 * 32, MOE_I_DN = 32 * 16 * 16, MOE_UNITS = (MOE_I_UP + MOE_I_DN) / 64;
__device__ __forceinline__ void moe_convert_unit(int unit, const float* w_up, const float* w_down, const float* g_ffn, unsigned char* ws, int wave, int lane) {
#pragma unroll 1
    for (int j = 0; j < 8; ++j) { int r = unit * 64 + j * 8 + wave;
        if (r < MOE_I_UP) { const int e = r / (16 * 32); r -= e * (16 * 32); const int n0 = 64 * (r % 32);
            const size_t orow = (size_t)e * 2048 + ((n0 & 1023) >> 7) * 256 + (n0 >> 10) * 128 + (n0 & 127);
            p0_transpose_item8(w_up + (size_t)e * DM * 2048, 2048, g_ffn, ws + WS_WUP, DM, 64 * (r / 32), n0, orow, lane); }
        else { r -= MOE_I_UP; const int e = r / (16 * 16); r -= e * (16 * 16);
            p0_transpose_item8(w_down + (size_t)e * DM * DM, DM, nullptr, ws + WS_WDN, DM, 64 * (r / 16), 64 * (r % 16), (size_t)e * 1024 + 64 * (r % 16), lane); } }
}
struct In {
    const float *x, *mem; const int* positions; const float *norm_mix_g, *w_in, *lq1, *lk1, *lq2, *lk2, *diff_norm_g, *w_alpha2, *b_alpha, *gla_norm_g, *w_out, *norm_cross_g, *norm_mem_g,
        *w_cq, *w_ck, *w_cv, *w_co, *norm_ffn_g, *w_router, *b_router, *w_up, *b_up, *w_down, *b_down, *norm_final_g;
};
__device__ __forceinline__ void p0_prologue(Frame& F, const In& I) {
    const int gw = F.vcu * NWAVES + F.wave, NGW = F.G * NWAVES, lane = lane_here();
    unsigned char* ws = F.ws;
    constexpr int I_IN = 16 * 48, I_SQ = 16 * 16;
    constexpr int NITEMS = I_IN + 5 * I_SQ;
    for (int it = gw; it < NITEMS; it += NGW) {
        int r = it;
        if (r < I_IN) { p0_transpose_item(I.w_in, INW, nullptr, (bf16*)(ws + WS_WINT), DM, 64 * (r / 48), 64 * (r % 48), (size_t)64 * (r % 48), lane); continue; } r -= I_IN;
        { const int w = r / I_SQ; r -= w * I_SQ;
            const float* W = w == 0 ? I.w_out : w == 1 ? I.w_cq : w == 2 ? I.w_ck : w == 3 ? I.w_cv : I.w_co;
            bf16* WT = (bf16*)(ws + (w == 0 ? WS_WOUT : w == 1 ? WS_WCQ : w == 2 ? WS_WCK : w == 3 ? WS_WCV : WS_WCO));
            p0_transpose_item(W, DM, w == 1 ? I.norm_cross_g : nullptr, WT, DM, 64 * (r / 16), 64 * (r % 16), (size_t)64 * (r % 16), lane); }
    }
    const int gt = F.vcu * (NWAVES * 64) + F.tid, NGT = F.G * NWAVES * 64;
    for (int idx = gt; idx < 256 * DM; idx += NGT) { const int j = idx >> 10, k = idx & 1023; const float* wr = I.w_in + (size_t)k * INW + 3072; float s = 0.f;
#pragma unroll
        for (int r = 0; r < 16; ++r) s += wr[r] * I.w_alpha2[r * 256 + j];
        ((bf16*)(ws + WS_WINT))[(size_t)(3072 + j) * DM + k] = (bf16)f2bf(s); }
    for (int idx = gt; idx < DM * NEXP; idx += NGT) ((float*)(ws + WS_WR))[idx] = I.w_router[idx] * I.norm_ffn_g[idx >> 5];
    for (int idx = gt; idx < NTOK * 8; idx += NGT) { const int tok = idx >> 3, i = idx & 7;
        const double inv = exp(-(double)i * 0.125 * 13.122363377404328); const double ang = (double)I.positions[tok] * inv;
        const double red = ang - rint(ang * 0.15915494309189535) * 6.283185307179586; const float rf = (float)red;
        float* cs = (float*)(ws + WS_CS) + (size_t)tok * 16; cs[i] = cosf(rf); cs[8 + i] = sinf(rf); }
    for (int m = gw; m < NTOK + NMEM; m += NGW) {
        if (m < NTOK) rms_row_to_bf16(I.x + (size_t)m * DM, I.norm_mix_g, (bf16*)(ws + WS_HN) + (size_t)m * DM, lane);
        else rms_row_to_bf16(I.mem + (size_t)(m - NTOK) * DM, I.norm_mem_g, (bf16*)(ws + WS_MN) + (size_t)(m - NTOK) * DM, lane);
    }
}

constexpr int DA_KBUF = 16384, DA_VBUF = 16384, DA_VOFF = 2 * DA_KBUF;
__device__ __forceinline__ void diffattn_unit(Frame& F, const bf16* P, const bf16* VT, bf16* CAT, const float* gdiff, float lam, int b, int h, int qblk) {
    const int lane = lane_here(), wave = F.wave, tid = F.tid, l15 = lane & 15, g = lane >> 4;
    LAS unsigned char* lds = F.lds + RING_OFF;
    const int q0 = qblk * 128 + wave * 16;
    const size_t tokq = (size_t)b * SEQ + q0 + l15;
    bf16x8 qf[2][2];
#pragma unroll
    for (int c = 0; c < 2; ++c)
#pragma unroll
        for (int ks = 0; ks < 2; ++ks) qf[c][ks] = *(const bf16x8*)(P + tokq * PW + h * 128 + c * 64 + ks * 32 + g * 8);
    f32x4 o[2][8];
#pragma unroll
    for (int c = 0; c < 2; ++c)
#pragma unroll
        for (int k = 0; k < 8; ++k) o[c][k] = (f32x4){0.f, 0.f, 0.f, 0.f};
    float mrun[2] = {-INFINITY, -INFINITY}, lsum[2] = {0.f, 0.f};
    const int nk = q0 + 16;
    const int nt = 2 * qblk + 2;
    const int skey = tid >> 4, sch = tid & 15, vrow = tid >> 3, vpc = tid & 7;
    const bf16* ksrc = P + ((size_t)b * SEQ + skey) * PW + 512 + h * 128 + sch * 8;
    const bf16* vsrc = VT + (size_t)(h * 128 + vrow) * NTOK + (size_t)b * SEQ + vpc * 8;
    const int kdst = skey * 256 + ((sch ^ (skey & 15)) * 16);
    const int vfr = (vrow >> 1) & 7, vch = (vpc >> 2) * 4 + 2 * (vpc & 1), vhi = ((vpc & 3) >> 1) * 8;
    const int vdst0 = DA_VOFF + vrow * 128 + ((vch ^ vfr) * 16) + vhi, vdst1 = DA_VOFF + vrow * 128 + (((vch + 1) ^ vfr) * 16) + vhi;
    int koff[2][2];
#pragma unroll
    for (int c = 0; c < 2; ++c)
#pragma unroll
        for (int ks = 0; ks < 2; ++ks) koff[c][ks] = l15 * 256 + (((c * 8 + ks * 4 + g) ^ l15) * 16);
    const int voffs[2] = {DA_VOFF + l15 * 128 + ((g ^ (l15 >> 1)) * 16), DA_VOFF + l15 * 128 + (((4 + g) ^ (l15 >> 1)) * 16)};
    v4u sk0, sk1, sv0, sv1;
#define DA_LOAD(tt) do { const bf16* kp_ = ksrc + (size_t)(tt) * 64 * PW; const bf16* vp_ = vsrc + (tt) * 64; \
        sk0 = *(const v4u*)kp_; sk1 = *(const v4u*)(kp_ + (size_t)32 * PW); sv0 = *(const v4u*)vp_; sv1 = *(const v4u*)(vp_ + (size_t)64 * NTOK); } while (0)
#define DA_STORE(bb) do { LAS unsigned char* kd_ = lds + (bb) * DA_KBUF + kdst; LAS unsigned char* vd_ = lds + (bb) * DA_VBUF; \
        *(LAS v4u*)kd_ = sk0; *(LAS v4u*)(kd_ + 8192) = sk1; \
        *(LAS v2u*)(vd_ + vdst0) = (v2u){sv0.x, sv0.y}; *(LAS v2u*)(vd_ + vdst1) = (v2u){sv0.z, sv0.w}; *(LAS v2u*)(vd_ + vdst0 + 8192) = (v2u){sv1.x, sv1.y}; *(LAS v2u*)(vd_ + vdst1 + 8192) = (v2u){sv1.z, sv1.w}; } while (0)
    DA_LOAD(0); DA_STORE(0);
    __syncthreads();
    auto step = [&](const int t, const int buf) __attribute__((always_inline)) {
        if (t * 64 < nk) {
            const LAS unsigned char* kb = lds + buf * DA_KBUF; const LAS unsigned char* vb = lds + buf * DA_VBUF;
            f32x4 s[2][2][2];
#pragma unroll
            for (int sub = 0; sub < 2; ++sub)
#pragma unroll
                for (int c = 0; c < 2; ++c)
#pragma unroll
                    for (int s2 = 0; s2 < 2; ++s2) { f32x4 a = (f32x4){0.f, 0.f, 0.f, 0.f};
#pragma unroll
                        for (int ks = 0; ks < 2; ++ks) { const bf16x8 kf = *(const LAS bf16x8*)(kb + sub * 8192 + s2 * 4096 + koff[c][ks]); a = mfma16(kf, qf[c][ks], a); }
                        s[sub][c][s2] = a; }
            if (t * 64 + 63 > q0) {
                const int qrow = q0 + l15;
#pragma unroll
                for (int sub = 0; sub < 2; ++sub)
#pragma unroll
                    for (int c = 0; c < 2; ++c)
#pragma unroll
                        for (int s2 = 0; s2 < 2; ++s2)
#pragma unroll
                            for (int r = 0; r < 4; ++r) if (t * 64 + sub * 32 + s2 * 16 + 4 * g + r > qrow) s[sub][c][s2][r] = -INFINITY;
            }
            float mnew[2]; bool grow = false;
#pragma unroll
            for (int c = 0; c < 2; ++c) { float mx = -INFINITY;
#pragma unroll
                for (int sub = 0; sub < 2; ++sub)
#pragma unroll
                    for (int s2 = 0; s2 < 2; ++s2) mx = fmaxf(mx, fmaxf(fmaxf(s[sub][c][s2][0], s[sub][c][s2][1]), fmaxf(s[sub][c][s2][2], s[sub][c][s2][3])));
                mx = xmax16(mx); mx = xmax32(mx);
                mnew[c] = mx > mrun[c] + 8.0f ? mx : mrun[c]; grow = grow || (mnew[c] > mrun[c]); }
            if (__any(grow)) {
#pragma unroll
                for (int c = 0; c < 2; ++c) { const float alpha = __builtin_amdgcn_exp2f(mrun[c] - mnew[c]); mrun[c] = mnew[c]; lsum[c] *= alpha;
#pragma unroll
                    for (int k = 0; k < 8; ++k) o[c][k] = o[c][k] * alpha; }
            }
#pragma unroll
            for (int sub = 0; sub < 2; ++sub) {
                bf16x8 pb[2];
#pragma unroll
                for (int c = 0; c < 2; ++c) { float ps = 0.f;
#pragma unroll
                    for (int s2 = 0; s2 < 2; ++s2)
#pragma unroll
                        for (int r = 0; r < 4; ++r) { const float p = __builtin_amdgcn_exp2f(s[sub][c][s2][r] - mrun[c]); s[sub][c][s2][r] = p; ps += p; }
                    lsum[c] += ps;
                    v4u w; w.x = pg8::cvtpk(s[sub][c][0][0], s[sub][c][0][1]); w.y = pg8::cvtpk(s[sub][c][0][2], s[sub][c][0][3]); w.z = pg8::cvtpk(s[sub][c][1][0], s[sub][c][1][1]); w.w = pg8::cvtpk(s[sub][c][1][2], s[sub][c][1][3]);
                    pb[c] = __builtin_bit_cast(bf16x8, w); }
#pragma unroll
                for (int k = 0; k < 8; ++k) { const bf16x8 vf = *(const LAS bf16x8*)(vb + voffs[sub] + k * 2048);
                    o[0][k] = mfma16(vf, pb[0], o[0][k]); o[1][k] = mfma16(vf, pb[1], o[1][k]); }
            }
        }
    };
    for (int t = 0; t < nt; ++t) {
        if (t + 1 < nt) DA_LOAD(t + 1);
        step(t, t & 1);
        if (t + 1 < nt) DA_STORE((t & 1) ^ 1);
        __syncthreads();
    }
#undef DA_LOAD
#undef DA_STORE
    float l0 = lsum[0], l1 = lsum[1];
    l0 += __shfl_xor(l0, 16); l0 += __shfl_xor(l0, 32); l1 += __shfl_xor(l1, 16); l1 += __shfl_xor(l1, 32);
    const float i0 = 1.0f / l0, i1 = lam / l1; float ss = 0.f;
#pragma unroll
    for (int k = 0; k < 8; ++k)
#pragma unroll
        for (int r = 0; r < 4; ++r) { const float v = o[0][k][r] * i0 - o[1][k][r] * i1; o[0][k][r] = v; ss += v * v; }
    ss += __shfl_xor(ss, 16); ss += __shfl_xor(ss, 32);
    const float rs = rsqrtf(ss * (1.0f / 128.0f) + EPS) * 0.8f;
    bf16* op = CAT + tokq * DM + h * 128 + 4 * g;
#pragma unroll
    for (int k = 0; k < 8; ++k) { const f32x4 gg = *(const f32x4*)(gdiff + k * 16 + 4 * g); f32x4 v = o[0][k] * rs; v = v * gg; pg8::st_bf4(op + k * 16, v); }
}

__device__ __forceinline__ bf16x8 pack8(const f32x4& a, const f32x4& b) { v4u w; w.x = pg8::cvtpk(a[0], a[1]); w.y = pg8::cvtpk(a[2], a[3]); w.z = pg8::cvtpk(b[0], b[1]); w.w = pg8::cvtpk(b[2], b[3]); return __builtin_bit_cast(bf16x8, w); }
constexpr int GL_QI = 0, GL_KI = 8192, GL_IMG = 16384, GL_EL = 2 * GL_IMG, GL_OB = GL_EL + 512, GL_OBS = 17408, GL_PS = GL_OB + 2 * GL_OBS, GL_END = GL_PS + 4096;

__device__ __forceinline__ void gla_unit(Frame& F, const bf16* P, const float* Bc, const bf16* GVT, bf16* CAT, const float* ggla, int b, int h) {
    const int lane = lane_here(), l15 = lane & 15, g = lane >> 4, eb = F.wave, tid = F.tid;
    LAS unsigned char* lds = F.lds + RING_OFF;
    const f32x4 zero4 = {0.f, 0.f, 0.f, 0.f};
    f32x4 S[4] = {zero4, zero4, zero4, zero4};
    bf16x8 If[4];
#pragma unroll
    for (int db = 0; db < 4; ++db) { const int ks = db >> 1;
#pragma unroll
        for (int j = 0; j < 8; ++j) { const int dp = 32 * ks + (j < 4 ? 4 * g + j : 16 + 4 * g + j - 4); If[db][j] = (dp == 16 * db + l15) ? (short)0x3F80 : (short)0; } }
    const int st = tid >> 3, sp = tid & 7, opc = tid & 15;
    const size_t tokb = (size_t)b * SEQ;
    const bf16* qsrc = P + (tokb + st) * PW + 1536 + h * 64 + sp * 8;
    const float* bsrc = Bc + (tokb + st) * 256 + h * 64 + sp * 8;
    const bf16* Vrow = GVT + (size_t)(h * 128 + 16 * eb + l15) * NTOK + tokb + 4 * g;
    const f32x4 gg0 = *(const f32x4*)(ggla + opc * 8), gg1 = *(const f32x4*)(ggla + opc * 8 + 4);
    const int foffs[2] = {l15 * 128 + ((g ^ (l15 >> 1)) * 16), l15 * 128 + (((4 + g) ^ (l15 >> 1)) * 16)};
    const int sfr = (st >> 1) & 7, sch0 = (sp >> 2) * 4 + 2 * (sp & 1), shi = ((sp & 3) >> 1) * 8, sd0 = st * 128 + ((sch0 ^ sfr) * 16) + shi, sd1 = st * 128 + (((sch0 + 1) ^ sfr) * 16) + shi;
    v4u rq = *(const v4u*)qsrc, rk = *(const v4u*)(qsrc + 256); f32x4 rb0 = *(const f32x4*)bsrc, rb1 = *(const f32x4*)(bsrc + 4);
#define GLA_STAGE(par) do { \
        float ee[8]; _Pragma("unroll") for (int i = 0; i < 4; ++i) { ee[i] = __expf(rb0[i]); ee[4 + i] = __expf(rb1[i]); } \
        const unsigned qa[4] = {rq.x, rq.y, rq.z, rq.w}, ka[4] = {rk.x, rk.y, rk.z, rk.w}; v4u wq, wk; unsigned* wqp = (unsigned*)&wq; unsigned* wkp = (unsigned*)&wk; \
        _Pragma("unroll") for (int i = 0; i < 4; ++i) { const float q0 = __builtin_bit_cast(float, qa[i] << 16), q1 = __builtin_bit_cast(float, qa[i] & 0xffff0000u), k0 = __builtin_bit_cast(float, ka[i] << 16), k1 = __builtin_bit_cast(float, ka[i] & 0xffff0000u); \
            wqp[i] = pg8::cvtpk(q0 * ee[2 * i], q1 * ee[2 * i + 1]); wkp[i] = pg8::cvtpk(k0 * __builtin_amdgcn_rcpf(ee[2 * i]), k1 * __builtin_amdgcn_rcpf(ee[2 * i + 1])); } \
        { LAS unsigned char* ib_ = lds + (par) * GL_IMG; *(LAS v2u*)(ib_ + GL_QI + sd0) = (v2u){wq.x, wq.y}; *(LAS v2u*)(ib_ + GL_QI + sd1) = (v2u){wq.z, wq.w}; *(LAS v2u*)(ib_ + GL_KI + sd0) = (v2u){wk.x, wk.y}; *(LAS v2u*)(ib_ + GL_KI + sd1) = (v2u){wk.z, wk.w}; } \
        if (st == 63) { *(LAS f32x4*)(lds + GL_EL + (par) * 256 + sp * 32) = (f32x4){ee[0], ee[1], ee[2], ee[3]}; *(LAS f32x4*)(lds + GL_EL + (par) * 256 + sp * 32 + 16) = (f32x4){ee[4], ee[5], ee[6], ee[7]}; } } while (0)
    bf16x8 VFn[2];
#pragma unroll
    for (int ss = 0; ss < 2; ++ss) { const bf16* vp = Vrow + 32 * ss; const v2u v0 = *(const v2u*)vp, v1 = *(const v2u*)(vp + 16); v4u vv; vv.x = v0.x; vv.y = v0.y; vv.z = v1.x; vv.w = v1.y; VFn[ss] = __builtin_bit_cast(bf16x8, vv); }
    GLA_STAGE(0);
    __syncthreads();
    for (int c = 0; c < SEQ / 64; ++c) {
        const int par = c & 1; const size_t tok0 = tokb + c * 64;
        if (c + 1 < SEQ / 64) { rq = *(const v4u*)(qsrc + (size_t)(c + 1) * 64 * PW); rk = *(const v4u*)(qsrc + (size_t)(c + 1) * 64 * PW + 256);
            rb0 = *(const f32x4*)(bsrc + (size_t)(c + 1) * 64 * 256); rb1 = *(const f32x4*)(bsrc + (size_t)(c + 1) * 64 * 256 + 4); }
        bf16x8 VF[2] = {VFn[0], VFn[1]};
        if (c + 1 < SEQ / 64) {
#pragma unroll
            for (int ss = 0; ss < 2; ++ss) { const bf16* vp = Vrow + (c + 1) * 64 + 32 * ss; const v2u v0 = *(const v2u*)vp, v1 = *(const v2u*)(vp + 16); v4u vv; vv.x = v0.x; vv.y = v0.y; vv.z = v1.x; vv.w = v1.y; VFn[ss] = __builtin_bit_cast(bf16x8, vv); } }
        v4u rg[2];
#pragma unroll
        for (int i = 0; i < 2; ++i) rg[i] = *(const v4u*)(P + (tok0 + ((tid + 512 * i) >> 4)) * PW + 2560 + h * 128 + opc * 8);
        const LAS unsigned char* qi = lds + par * GL_IMG + GL_QI; const LAS unsigned char* ki = lds + par * GL_IMG + GL_KI;
        bf16x8 qf[4][2], kf[4][2];
#pragma unroll
        for (int blk = 0; blk < 4; ++blk)
#pragma unroll
            for (int ks = 0; ks < 2; ++ks) { qf[blk][ks] = *(const LAS bf16x8*)(qi + foffs[ks] + blk * 2048); kf[blk][ks] = *(const LAS bf16x8*)(ki + foffs[ks] + blk * 2048); }
        const bf16x8 SF0 = pack8(S[0], S[1]), SF1 = pack8(S[2], S[3]);
        f32x4 O[4];
#pragma unroll
        for (int tb = 0; tb < 4; ++tb) { f32x4 o = mfma16(qf[tb][0], SF0, zero4); o = mfma16(qf[tb][1], SF1, o);
#pragma unroll
            for (int ss = 0; ss < 2; ++ss) if (2 * ss <= tb) { f32x4 a2[2];
#pragma unroll
                for (int hh = 0; hh < 2; ++hh) { const int sb = 2 * ss + hh; f32x4 a = zero4;
                    if (sb <= tb) { a = mfma16(kf[sb][0], qf[tb][0], zero4); a = mfma16(kf[sb][1], qf[tb][1], a);
                        if (sb == tb) {
#pragma unroll
                            for (int r = 0; r < 4; ++r) if (4 * g + r > l15) a[r] = 0.f; } }
                    a2[hh] = a; }
                o = mfma16(pack8(a2[0], a2[1]), VF[ss], o); }
            O[tb] = o; }
#pragma unroll
        for (int db = 0; db < 4; ++db) { f32x4 u = S[db];
#pragma unroll
            for (int ss = 0; ss < 2; ++ss) { const f32x4 t0 = mfma16(kf[2 * ss][db >> 1], If[db], zero4), t1 = mfma16(kf[2 * ss + 1][db >> 1], If[db], zero4); u = mfma16(pack8(t0, t1), VF[ss], u); }
            const f32x4 el = *(const LAS f32x4*)(lds + GL_EL + par * 256 + (16 * db + 4 * g) * 4);
            S[db] = u * el; }
        LAS unsigned char* ob = lds + GL_OB + par * GL_OBS; LAS float* ps = (LAS float*)(lds + GL_PS + par * 2048);
#pragma unroll
        for (int tb = 0; tb < 4; ++tb)
#pragma unroll
            for (int r = 0; r < 4; ++r) { const int t = 16 * tb + 4 * g + r; const float ov = O[tb][r]; float q = ov * ov; q += __shfl_xor(q, 1); q += __shfl_xor(q, 2); q += __shfl_xor(q, 4); q += __shfl_xor(q, 8);
                if (l15 == 0) ps[t * 8 + eb] = q;
                *(LAS bf16*)(ob + t * 272 + (16 * eb + l15) * 2) = (bf16)f2bf(ov); }
        if (c + 1 < SEQ / 64) GLA_STAGE(par ^ 1);
        __syncthreads();
#pragma unroll
        for (int i = 0; i < 2; ++i) { const int ot = (tid + 512 * i) >> 4; const f32x4 p0 = *(const LAS f32x4*)(ps + ot * 8), p1 = *(const LAS f32x4*)(ps + ot * 8 + 4);
            const float ss = ((p0[0] + p0[1]) + (p0[2] + p0[3])) + ((p1[0] + p1[1]) + (p1[2] + p1[3])); const float rs = rsqrtf(ss * (1.0f / 128.0f) + EPS);
            const v4u ov = *(const LAS v4u*)(ob + ot * 272 + opc * 16); const unsigned oa[4] = {ov.x, ov.y, ov.z, ov.w}, ga[4] = {rg[i].x, rg[i].y, rg[i].z, rg[i].w};
            const float gn[8] = {gg0[0], gg0[1], gg0[2], gg0[3], gg1[0], gg1[1], gg1[2], gg1[3]}; v4u w; unsigned* wp = (unsigned*)&w;
#pragma unroll
            for (int j = 0; j < 4; ++j) { const float o0 = __builtin_bit_cast(float, oa[j] << 16), o1 = __builtin_bit_cast(float, oa[j] & 0xffff0000u), g0 = __builtin_bit_cast(float, ga[j] << 16), g1 = __builtin_bit_cast(float, ga[j] & 0xffff0000u);
                wp[j] = pg8::cvtpk(o0 * rs * gn[2 * j] * (g0 / (1.0f + __expf(-g0))), o1 * rs * gn[2 * j + 1] * (g1 / (1.0f + __expf(-g1)))); }
            *(v4u*)(CAT + (tok0 + ot) * DM + 512 + h * 128 + opc * 8) = w; }
    }
#undef GLA_STAGE
    __syncthreads();
}

__device__ __forceinline__ void router_phase(Frame& F, const float* X2, const float* WR, const float* b_router, float* rsl, float* gate, unsigned* assign, unsigned* list, gu32* cnt) {
    LAS float* xs = (LAS float*)(F.lds + RING_OFF);
    LAS float* wsh = xs + 64 * 129;
    LAS float* lg = wsh + 128 * 32;
    const int tid = F.tid, t = tid & 63, eg = tid >> 6;
    for (int blk = F.vcu; blk < NTOK / 64; blk += F.G) {
        const size_t tok0 = (size_t)blk * 64;
        f32x4 acc = (f32x4){0.f, 0.f, 0.f, 0.f}; float ssq = 0.f;
        for (int kc = 0; kc < DM; kc += 128) {
            { const int row = tid >> 3;
#pragma unroll
              for (int i = 0; i < 4; ++i) { const int col = i * 32 + (tid & 7) * 4; const f32x4 v = *(const f32x4*)(X2 + (tok0 + row) * DM + kc + col);
                  LAS float* d = xs + row * 129 + col; d[0] = v.x; d[1] = v.y; d[2] = v.z; d[3] = v.w; }
#pragma unroll
              for (int i = 0; i < 2; ++i) { const int idx = (i * 512 + tid) * 4; *(LAS f32x4*)(wsh + idx) = *(const f32x4*)(WR + (size_t)kc * 32 + idx); } }
            __syncthreads();
            const LAS float* xr = xs + t * 129;
#pragma unroll 8
            for (int k = 0; k < 128; ++k) { const float xv = xr[k]; const f32x4 w = *(const LAS f32x4*)(wsh + k * 32 + eg * 4); acc = acc + w * xv; ssq += xv * xv; }
            __syncthreads();
        }
        const float rs = rsqrtf(ssq * (1.0f / DM) + EPS);
#pragma unroll
        for (int i = 0; i < 4; ++i) lg[t * 33 + eg * 4 + i] = acc[i] * rs + b_router[eg * 4 + i];
        __syncthreads();
        if (tid < 64) {
            float lv[32];
#pragma unroll
            for (int e = 0; e < 32; ++e) lv[e] = lg[t * 33 + e];
            float tv[4]; int te[4];
#pragma unroll
            for (int k = 0; k < 4; ++k) { float best = -INFINITY; int bi = 0;
#pragma unroll
                for (int e = 0; e < 32; ++e) if (lv[e] > best) { best = lv[e]; bi = e; }
                tv[k] = best; te[k] = bi;
#pragma unroll
                for (int e = 0; e < 32; ++e) if (e == bi) lv[e] = -INFINITY; }
            const float e1 = __expf(tv[1] - tv[0]), e2 = __expf(tv[2] - tv[0]), e3 = __expf(tv[3] - tv[0]); const float inv = 1.0f / (1.0f + e1 + e2 + e3);
            const float gv[4] = {inv, e1 * inv, e2 * inv, e3 * inv};
            const size_t tok = tok0 + t;
            LAS unsigned* hist = (LAS unsigned*)(lg + 64 * 33); LAS unsigned* gbase = hist + 32;
            if (t < 32) hist[t] = 0u;
            __builtin_amdgcn_wave_barrier(); LDS_WAIT();
            unsigned lpos[4];
#pragma unroll
            for (int k = 0; k < 4; ++k) lpos[k] = __hip_atomic_fetch_add(hist + te[k], 1u, __ATOMIC_RELAXED, __HIP_MEMORY_SCOPE_WORKGROUP);
            __builtin_amdgcn_wave_barrier(); LDS_WAIT();
            if (t < 32) { const unsigned n = hist[t]; gbase[t] = n ? __hip_atomic_fetch_add(cnt + 64 * t, n, RLX_AGENT) : 0u; }
            __builtin_amdgcn_wave_barrier(); LDS_WAIT();
#pragma unroll
            for (int k = 0; k < 4; ++k) { const unsigned pos = gbase[te[k]] + lpos[k]; list[(size_t)te[k] * NTOK + pos] = (unsigned)tok; rsl[(size_t)te[k] * NTOK + pos] = rs;
                assign[tok * 4 + k] = ((unsigned)te[k] << 16) | pos; gate[tok * 4 + k] = gv[k]; }
        }
        __syncthreads();
    }
}
__device__ __forceinline__ int moe_tables(Frame& F) {
    LAS unsigned char* tile_e = F.lds + TAB_OFF; LAS int* tstart = (LAS int*)(F.lds + TAB_TSTART); LAS int* lc = (LAS int*)(F.lds + TAB_CNT);
    if (F.tid < 32) lc[F.tid] = (int)__hip_atomic_load(F.ctl + CW_CNT + 64 * F.tid, RLX_AGENT);
    __syncthreads();
    if (F.tid == 0) { int s = 0; for (int e = 0; e < 32; ++e) { tstart[e] = s; s += (lc[e] + 255) >> 8; } tstart[32] = s; }
    __syncthreads();
    const int T = tstart[32];
    for (int i = F.tid; i < T; i += 512) { int e = 0;
#pragma unroll
        for (int k = 1; k < 32; ++k) e += (tstart[k] <= i) ? 1 : 0;
        tile_e[i] = (unsigned char)e; }
    __syncthreads();
    return T;
}
__device__ __forceinline__ void final_phase(Frame& F, float* out, const unsigned char* Y, const float* gate, const unsigned* assign, const float* gfin) {
    (void)moe_tables(F);
    const LAS int* tstart = (const LAS int*)(F.lds + TAB_TSTART);
    const int gw = F.vcu * NWAVES + F.wave, NGW = F.G * NWAVES, lane = lane_here();
    for (int tok = gw; tok < NTOK; tok += NGW) {
        f32x4* xr = (f32x4*)(out + (size_t)tok * DM) + lane; f32x4 v[4];
#pragma unroll
        for (int j = 0; j < 4; ++j) v[j] = xr[64 * j];
#pragma unroll
        for (int k = 0; k < 4; ++k) { const unsigned a = assign[(size_t)tok * 4 + k]; const float gk = gate[(size_t)tok * 4 + k]; const size_t row = (size_t)tstart[a >> 16] * 256 + (a & 0xffffu);
            const unsigned* yr = (const unsigned*)(Y + row * DM) + lane;
#pragma unroll
            for (int j = 0; j < 4; ++j) { const unsigned w = yr[64 * j]; const auto lo = __builtin_amdgcn_cvt_pk_f32_fp8((int)w, false), hi = __builtin_amdgcn_cvt_pk_f32_fp8((int)w, true);
                v[j].x += gk * lo[0]; v[j].y += gk * lo[1]; v[j].z += gk * hi[0]; v[j].w += gk * hi[1]; } }
        float s = 0.f;
#pragma unroll
        for (int j = 0; j < 4; ++j) s += (v[j].x * v[j].x + v[j].y * v[j].y) + (v[j].z * v[j].z + v[j].w * v[j].w);
        const float rs = rsqrtf(wave_sum(s) * (1.0f / DM) + EPS);
#pragma unroll
        for (int j = 0; j < 4; ++j) { const f32x4 gg = ((const f32x4*)gfin)[lane + 64 * j]; xr[64 * j] = v[j] * rs * gg; }
    }
}

constexpr int NPHASE = 12;
struct Args { const void* in[28]; float* out; unsigned char* ws; int ph_lo, ph_hi; };
__global__ void __launch_bounds__(NWAVES * 64, 2) mk_fwd(Args args) {
    extern __shared__ __attribute__((aligned(16))) unsigned char lds[];
    Frame F;
    F.lds = (LAS unsigned char*)lds;
    F.MISC = (volatile LAS unsigned*)(F.lds + MISC_OFF);
    F.tid = threadIdx.x; F.lane = F.tid & 63; F.wave = __builtin_amdgcn_readfirstlane(F.tid >> 6);
    F.G = gridDim.x; { const int bx = blockIdx.x; F.vcu = (F.G % 8 == 0) ? (bx % 8) * (F.G / 8) + bx / 8 : bx; }
    F.ws = args.ws; F.out = args.out; F.ctl = (gu32*)(args.ws + WS_CTL);
    unsigned char* ws = args.ws;
    typedef const void* const volatile __attribute__((address_space(4))) kargp_t;
    kargp_t* const kargs = (kargp_t*)__builtin_amdgcn_kernarg_segment_ptr();
#define INP(k) ((const float*)kargs[k])
    for (int u = F.tid; u < (LDS_BYTES - LDSCTL_OFF) / 4; u += NWAVES * 64) ((LAS unsigned*)(F.lds + LDSCTL_OFF))[u] = 0u;
    __syncthreads();
    const int lo = args.ph_lo, hi = args.ph_hi;
    const bool single = (hi - lo) > 1;
    XcdBarrier bar; bar.bar = (unsigned*)(F.ctl + CW_BAR); bar.x = 0; bar.st = nullptr;
    if (single) bar = xcd_barrier_post((unsigned*)(F.ctl + CW_BAR), F.MISC + 8);
#define IN(k) (lo <= (k) && (k) < hi)
#if defined(PROBE_K0)
    LAS unsigned long long* tsl = (LAS unsigned long long*)(F.lds + TS_OFF);
    if (F.tid == 0) tsl[0] = rt();
#define SEAM(k) do { if (IN(k) && IN((k) + 1)) xcd_barrier(bar); if (F.tid == 0) tsl[(k) + 1] = rt(); } while (0)
#define SEAM_LOCAL(k) do { if (F.tid == 0) tsl[(k) + 1] = rt(); } while (0)
#else
#define SEAM(k) do { if (IN(k) && IN((k) + 1)) xcd_barrier(bar); } while (0)
#define SEAM_LOCAL(k) do { } while (0)
#endif
    typedef pg8::bf16_t hb;
    const int bx = (int)blockIdx.x;

    if (IN(0)) { In I;
        I.x = (const float*)INP(0);
        I.mem = (const float*)INP(1);
        I.positions = (const int*)INP(2);
        I.norm_mix_g = (const float*)INP(3);
        I.w_in = (const float*)INP(4);
        I.lq1 = (const float*)INP(5);
        I.lk1 = (const float*)INP(6);
        I.lq2 = (const float*)INP(7);
        I.lk2 = (const float*)INP(8);
        I.diff_norm_g = (const float*)INP(9);
        I.w_alpha2 = (const float*)INP(10);
        I.b_alpha = (const float*)INP(11);
        I.gla_norm_g = (const float*)INP(12);
        I.w_out = (const float*)INP(13);
        I.norm_cross_g = (const float*)INP(14);
        I.norm_mem_g = (const float*)INP(15);
        I.w_cq = (const float*)INP(16);
        I.w_ck = (const float*)INP(17);
        I.w_cv = (const float*)INP(18);
        I.w_co = (const float*)INP(19);
        I.norm_ffn_g = (const float*)INP(20);
        I.w_router = (const float*)INP(21);
        I.b_router = (const float*)INP(22);
        I.w_up = (const float*)INP(23);
        I.b_up = (const float*)INP(24);
        I.w_down = (const float*)INP(25);
        I.b_down = (const float*)INP(26);
        I.norm_final_g = (const float*)INP(27);
        p0_prologue(F, I); }
    SEAM(0);
    if (IN(1)) {
        pg8::Gemm g{(const hb*)(ws + WS_HN), (const hb*)(ws + WS_WINT), NTOK, 3328, DM, DM, DM, 127, 127};
        typedef pg8::OrderP1<(unsigned)WS_HN, (unsigned)WS_WINT, (unsigned)WS_MN, (unsigned)WS_WCK, (unsigned)WS_WCV> OrdP1; OrdP1 S; S.G = F.G; S.c = bx; S.ws = (const char*)ws;
        pg8::EpiP1 E{pg8::EpiProj{(hb*)(ws + WS_P), (float*)(ws + WS_LA), (const float*)(ws + WS_CS), INP(11)}, pg8::EpiPlain{(hb*)(ws + WS_VT) - (size_t)1024 * NTOK, NTOK, 1.0f},
                     pg8::EpiPlain{(hb*)(ws + WS_KX), DM, 1.0f}, pg8::EpiPlain{(hb*)(ws + WS_VXT), NMEM, 1.0f}};
        pg8::gemm_phase<pg8::EpiP1, OrdP1, true, true, false, false>(F.lds + RING_OFF, g, S, E);
    }
    SEAM(1);
    if (IN(2)) {
        float lam;
        { const int ln = lane_here(); const float a = INP(5)[ln] * INP(6)[ln], c = INP(7)[ln] * INP(8)[ln]; lam = __expf(wave_sum(a)) - __expf(wave_sum(c)) + 0.2f; }
        LAS int* qslot = (LAS int*)(F.lds + TAB_OFF);
        for (;;) {
            if (F.tid == 0) qslot[0] = (int)__hip_atomic_fetch_add(F.ctl + CW_Q2, 1u, RLX_AGENT);
            __syncthreads();
            const int u = qslot[0];
            __syncthreads();
            if (u >= 64 + 1024 + MOE_UNITS) break;
            if (u >= 64 + 1024) { moe_convert_unit(u - (64 + 1024), INP(23), INP(25), INP(20), ws, F.wave, lane_here()); continue; }
#if defined(PROBE_SPLIT)
            if (u < 64) continue;
#endif
            if (u < 64) { gla_unit(F, (const bf16*)(ws + WS_P), (const float*)(ws + WS_LA), (const bf16*)(ws + WS_GVT), (bf16*)(ws + WS_CAT), INP(12), u >> 2, u & 3);
            }
            else { const int v = u - 64, bh = v & 63, qb = 15 - (v >> 6);
                diffattn_unit(F, (const bf16*)(ws + WS_P), (const bf16*)(ws + WS_VT), (bf16*)(ws + WS_CAT), INP(9), lam, bh >> 2, bh & 3, qb); }
        }
    }
#if defined(PROBE_SPLIT)
    if (IN(2)) { xcd_barrier(bar); if (F.tid == 0) tsl[13] = rt();
        for (int u = F.vcu; u < 64; u += F.G) gla_unit(F, (const bf16*)(ws + WS_P), (const float*)(ws + WS_LA), (const bf16*)(ws + WS_GVT), (bf16*)(ws + WS_CAT), INP(12), u >> 2, u & 3); }
#endif
    SEAM(2);
    if (IN(3)) {
        pg8::Gemm g{(const hb*)(ws + WS_CAT), (const hb*)(ws + WS_WOUT), NTOK, DM, DM, DM, DM, 127, 127}; pg8::StaticOrder S; S.init(NTOK, DM, F.G, bx);
        pg8::EpiRes1 E{INP(0), F.out, (hb*)(ws + WS_X1B), (float*)(ws + WS_SSP1)};
        pg8::gemm_phase<pg8::EpiRes1, pg8::StaticOrder, true, true, false, false>(F.lds + RING_OFF, g, S, E);
    }
    SEAM(3);
    if (IN(4)) {
        pg8::Gemm g{(const hb*)(ws + WS_X1B), (const hb*)(ws + WS_WCQ), NTOK, DM, DM, DM, DM, 127, 127}; pg8::StaticOrder S; S.init(NTOK, DM, F.G, bx);
        pg8::EpiQX E{(hb*)(ws + WS_QX), (const float*)(ws + WS_SSP1)};
        pg8::gemm_phase<pg8::EpiQX, pg8::StaticOrder, true, true, false, false>(F.lds + RING_OFF, g, S, E);
    }
    SEAM_LOCAL(4);
    if (IN(5)) {
        pg8::Gemm g{(const hb*)(ws + WS_QX), (const hb*)(ws + WS_KX), NTOK, 256, 256, DM, DM, 127, 127}; pg8::OrderX1 S; S.init(F.G, bx);
        pg8::EpiSoftmax E{(hb*)(ws + WS_PX), (float*)(ws + WS_SSP1), (PG8_LAS float*)(F.lds + XCH_OFF)};
        pg8::gemm_phase<pg8::EpiSoftmax, pg8::OrderX1, true, true>(F.lds + RING_OFF, g, S, E);
    }
    SEAM_LOCAL(5);
    if (IN(6)) {
        pg8::Gemm g{(const hb*)(ws + WS_PX), (const hb*)(ws + WS_VXT), NTOK, 256, 256, DM, NMEM, 127, 127}; pg8::OrderX2 S; S.init(F.G, bx);
        pg8::EpiPV E{(hb*)(ws + WS_OX), (const float*)(ws + WS_SSP1)};
        pg8::gemm_phase<pg8::EpiPV, pg8::OrderX2, true, true>(F.lds + RING_OFF, g, S, E);
    }
    SEAM(6);
    if (IN(7)) {
        pg8::Gemm g{(const hb*)(ws + WS_OX), (const hb*)(ws + WS_WCO), NTOK, DM, DM, DM, DM, 127, 127}; pg8::StaticOrder S; S.init(NTOK, DM, F.G, bx);
        pg8::EpiRes2 E{F.out, ws + WS_X2B};
        pg8::gemm_phase<pg8::EpiRes2, pg8::StaticOrder, true, true, false, false>(F.lds + RING_OFF, g, S, E);
    }
    SEAM(7);
    if (IN(8)) router_phase(F, F.out, (const float*)(ws + WS_WR), INP(22), (float*)(ws + WS_RSL), (float*)(ws + WS_GATE), (unsigned*)(ws + WS_ASSIGN), (unsigned*)(ws + WS_LIST), F.ctl + CW_CNT);
    SEAM(8);
    if (IN(9)) {
        const int T = moe_tables(F);
        pg8::Gemm g{(const hb*)(ws + WS_X2B), (const hb*)(ws + WS_WUP), T * 256, NEXP * 2048, 512, 512, 512, 127, 122}; pg8::MoeOrderG S;
        S.init(T, 8, F.G, bx, (const PG8_LAS unsigned char*)(F.lds + TAB_OFF), (const PG8_LAS int*)(F.lds + TAB_TSTART), (const PG8_LAS int*)(F.lds + TAB_CNT), (const unsigned*)(ws + WS_LIST), (PG8_LAS unsigned*)(F.lds + XCH_OFF));
        pg8::EpiUp E{ws + WS_ACT, (const float*)(ws + WS_RSL), (const PG8_LAS int*)(F.lds + TAB_TSTART), (const PG8_LAS int*)(F.lds + TAB_CNT), INP(24)};
        pg8::gemm_phase<pg8::EpiUp, pg8::MoeOrderG, true, true, true, false>(F.lds + RING_OFF, g, S, E);
    }
    SEAM(9);
    if (IN(10)) {
        const int T = moe_tables(F);
        pg8::Gemm g{(const hb*)(ws + WS_ACT), (const hb*)(ws + WS_WDN), T * 256, NEXP * 1024, 512, 512, 512, 127, 122}; pg8::MoeOrder S; S.init(T, 4, F.G, bx, (const PG8_LAS unsigned char*)(F.lds + TAB_OFF));
        pg8::EpiDown E{ws + WS_Y, INP(26)};
        pg8::gemm_phase<pg8::EpiDown, pg8::MoeOrder, true, true, true, false>(F.lds + RING_OFF, g, S, E);
    }
    SEAM(10);
    if (IN(11)) final_phase(F, F.out, (const unsigned char*)(ws + WS_Y), (const float*)(ws + WS_GATE), (const unsigned*)(ws + WS_ASSIGN), INP(27));
#if defined(PROBE_K0)
    { if (F.tid == 0) { tsl[NPHASE] = rt();
        const int ks[2] = {PROBE_K0, PROBE_K1}; unsigned long long code = 0, mul = 1;
        for (int i = 0; i < 2; ++i) { unsigned long long dt = ks[i] == 97 ? tsl[13] - tsl[2] : ks[i] == 98 ? tsl[3] - tsl[13] : tsl[ks[i] + 1] - tsl[ks[i]]; unsigned long long q = (dt + 800) / 1600; if (q > 63) q = 63; code += q * mul; mul *= 64; }
        tsl[15] = code * 6400ull; }
      __syncthreads();
      const unsigned long long t0 = rt(), wait = tsl[15]; float x = (float)F.tid, y = 1.0001f;
      while (rt() - t0 < wait) {
#pragma unroll
          for (int i = 0; i < 64; ++i) x = x * y + 0.5f; }
      if (x == 12345.678f) F.out[0] = x; }
#endif
#undef IN
#undef SEAM
#undef SEAM_LOCAL
}

#ifndef MK_N_LAUNCHES
#define MK_N_LAUNCHES 1
#endif
extern "C" void kernel_launch(void* const* d_in, const int* in_sizes, int n_in, void* d_out, int out_size, void* d_ws, size_t ws_size, hipStream_t stream) {
    static int grid = 0;
    if (grid == 0) {
        if (n_in != 28 || out_size != NTOK * DM || ws_size < WS_END) { fprintf(stderr, "kernel_launch: unexpected shapes: n_in %d out %d ws %zu (need %zu)\n", n_in, out_size, ws_size, (size_t)WS_END); grid = -1; return; }
        int dev = 0, cus = 0, per_cu = 0;
        if (hipGetDevice(&dev) != hipSuccess || hipDeviceGetAttribute(&cus, hipDeviceAttributeMultiprocessorCount, dev) != hipSuccess) { fprintf(stderr, "kernel_launch: device query failed\n"); grid = -1; return; }
        if (hipFuncSetAttribute((const void*)mk_fwd, hipFuncAttributeMaxDynamicSharedMemorySize, LDS_BYTES) != hipSuccess) { fprintf(stderr, "kernel_launch: hipFuncSetAttribute failed\n"); grid = -1; return; }
        if (hipOccupancyMaxActiveBlocksPerMultiprocessor(&per_cu, (const void*)mk_fwd, NWAVES * 64, LDS_BYTES) != hipSuccess || per_cu < 1) { fprintf(stderr, "kernel_launch: occupancy query reports %d workgroups per CU\n", per_cu); (void)hipGetLastError(); grid = -1; return; }
        grid = cus;
    }
    if (grid < 0) return;
    (void)hipMemsetAsync((char*)d_ws + WS_CTL, 0, CTL_ZERO_BYTES, stream);
    Args a{};
    for (int i = 0; i < 28; ++i) a.in[i] = d_in[i];
    a.out = (float*)d_out; a.ws = (unsigned char*)d_ws;
    if (MK_N_LAUNCHES == 1) { a.ph_lo = 0; a.ph_hi = NPHASE; hipLaunchKernelGGL(mk_fwd, dim3(grid), dim3(NWAVES * 64), LDS_BYTES, stream, a); }
    else for (int p = 0; p < NPHASE; ++p) { a.ph_lo = p; a.ph_hi = p + 1; hipLaunchKernelGGL(mk_fwd, dim3(grid), dim3(NWAVES * 64), LDS_BYTES, stream, a); }
}
```

```cpp
#include <hip/hip_runtime.h>
#include <cstdio>
#include <cstdint>
namespace pg8 {
#define PG8_LAS __attribute__((address_space(3)))
typedef unsigned short bf16_t;
typedef short bf16x8 __attribute__((ext_vector_type(8)));
typedef float f32x4 __attribute__((ext_vector_type(4)));
typedef unsigned u32x4 __attribute__((ext_vector_type(4)));
constexpr int BM = 256, BK = 64, HALF = 128, HTB = HALF * BK * 2  , STAGE_BYTES = 8 * HTB, NXCD = 8, WGM = 8;

__host__ __device__ __forceinline__ int lds_byte(int r, int c) { const int st = (r >> 4) * 2 + (c >> 5), rr = r & 15, cc = c & 31, ob = rr * 64 + cc * 2; return st * 1024 + (ob ^ (((ob >> 9) & 1) << 5)); }
__host__ __device__ __forceinline__ void stage_rc(int b, int& R, int& C) { const int st = b / 1024, sb = b % 1024, swz = sb ^ (((sb >> 9) & 1) << 5); R = (st >> 1) * 16 + swz / 64; C = (st & 1) * 32 + (swz % 64) / 2; }
__host__ __device__ __forceinline__ int perm32(int rho) { const int n = rho >> 4, i = rho & 15; return 8 * (i >> 2) + 4 * n + (i & 3); }

struct Unit { int pm, pn; };
struct Gemm { const bf16_t* A; const bf16_t* Bt; int M, N, K, lda, ldb, sa, sb; };
struct OrderBase {
    static constexpr bool GATHER = false;
    __device__ __forceinline__ const char* a_base(const Gemm& g, const Unit& u) const { return (const char*)g.A + (size_t)u.pm * 256 * g.lda * 2; }
    __device__ __forceinline__ const char* b_base(const Gemm& g, const Unit& u) const { return (const char*)g.Bt + (size_t)u.pn * 256 * g.ldb * 2; }
    __device__ __forceinline__ void a_ready(const Unit&) const {}
    __device__ __forceinline__ void done(const Unit&) const {}
};

struct StaticOrder : OrderBase {
    int nM, nN, nwg, G, c;
    __host__ __device__ void init(int M, int N, int G_, int c_) { nM = M / BM; nN = N / BM; nwg = nM * nN; G = G_; c = c_; }
    __host__ __device__ bool next(int i, Unit& u) const {
        const long L = (long)i * G + c; if (L >= nwg) return false;
        int wgid = (int)L; { const int q = nwg / NXCD, r = nwg % NXCD, xcd = wgid % NXCD, off = wgid / NXCD; wgid = (xcd < r ? xcd * (q + 1) : r * (q + 1) + (xcd - r) * q) + off; }
        const int nig = WGM * nN, gid = wgid / nig, fm = gid * WGM, gsz = (nM - fm) < WGM ? (nM - fm) : WGM;
        u.pm = fm + ((wgid % nig) % gsz); u.pn = (wgid % nig) / gsz; return true;
    }
};

typedef unsigned u32x2 __attribute__((ext_vector_type(2)));
typedef float f32x2_t __attribute__((ext_vector_type(2)));
typedef __bf16 bf16x2_t __attribute__((ext_vector_type(2)));
__device__ __forceinline__ unsigned cvtpk(float lo, float hi) { f32x2_t v = {lo, hi}; bf16x2_t b = __builtin_convertvector(v, bf16x2_t); return __builtin_bit_cast(unsigned, b); }
__device__ __forceinline__ void st_bf4(bf16_t* p, f32x4 v) { u32x2 w; w.x = cvtpk(v[0], v[1]); w.y = cvtpk(v[2], v[3]); *(u32x2*)p = w; }
__device__ __forceinline__ unsigned cvt4_fp8(f32x4 v) { unsigned w = __builtin_amdgcn_cvt_pk_fp8_f32(v[0], v[1], 0, false); return __builtin_amdgcn_cvt_pk_fp8_f32(v[2], v[3], w, true); }
__device__ __forceinline__ float bf2f(bf16_t b) { return __builtin_bit_cast(float, (unsigned)b << 16); }
#define EPI_ROWS _Pragma("unroll") for (int ai = 0; ai < 2; ++ai) _Pragma("unroll") for (int m = 0; m < 4; ++m)
#define EPI_COLS _Pragma("unroll") for (int bj = 0; bj < 2; ++bj) _Pragma("unroll") for (int n = 0; n < 2; ++n)
constexpr float LOG2E = 1.4426950408889634f;
constexpr float QSCALE_DA = 0.125f * LOG2E;
constexpr float QSCALE_X = 0.0625f * LOG2E;

struct EpiPlain {
    static constexpr bool PERM = false, AFTER_DRAIN = false;
    bf16_t* O; int ldc; float scale;
    __device__ __forceinline__ void operator()(const f32x4 (&acc)[2][2][4][2], const Unit& u, int wr, int wc, int fr, int fq) const {
        EPI_ROWS { const int row = u.pm * 256 + ai * 128 + wr * 64 + m * 16 + fr; bf16_t* rp = O + (size_t)row * ldc + u.pn * 256 + wc * 32 + fq * 4;
            EPI_COLS st_bf4(rp + bj * 128 + n * 16, acc[ai][bj][m][n] * scale); }
    }
};
struct EpiProj {
    static constexpr bool PERM = false, AFTER_DRAIN = false;
    bf16_t* P; float* LA; const float* cs; const float* b_alpha;
    template <int ai> __device__ __forceinline__ void decay_rows(const f32x4 (&acc)[2][2][4][2], const Unit& u, int wr, int wc, int fr, int fq) const {
        const int row0 = u.pm * 256 + ai * 128 + wr * 64 + fr;
        EPI_COLS { const int col = bj * 128 + wc * 32 + n * 16 + fq * 4; const f32x4 ba = *(const f32x4*)(b_alpha + col); f32x4 run = {0.f, 0.f, 0.f, 0.f};
            _Pragma("unroll") for (int m = 0; m < 4; ++m) { const f32x4 z = acc[ai][bj][m][n] + ba; f32x4 o;
                _Pragma("unroll") for (int i = 0; i < 4; ++i) { float v = (fminf(z[i], 0.f) - __logf(1.0f + __expf(-fabsf(z[i])))) * 0.0625f;
                    { float t = __shfl_up(v, 1, 16); if (fr >= 1) v += t; t = __shfl_up(v, 2, 16); if (fr >= 2) v += t; t = __shfl_up(v, 4, 16); if (fr >= 4) v += t; t = __shfl_up(v, 8, 16); if (fr >= 8) v += t; }
                    o[i] = v + run[i]; run[i] += __shfl(v, 15, 16); }
                *(f32x4*)(LA + (size_t)(row0 + m * 16) * 256 + col) = o; } }
    }
    __device__ __forceinline__ void operator()(const f32x4 (&acc)[2][2][4][2], const Unit& u, int wr, int wc, int fr, int fq) const {
        const int pn = u.pn;
        if (pn < 4) {
            const float sc = pn < 2 ? QSCALE_DA : 1.0f; const bool ropew = (wc & 1) == 0; const bool hi = (fq >> 1) != 0;
            EPI_ROWS { const int row = u.pm * 256 + ai * 128 + wr * 64 + m * 16 + fr; bf16_t* rp = P + (size_t)row * 3072 + pn * 256 + wc * 32 + fq * 4;
                f32x4 cv = {1.f, 1.f, 1.f, 1.f}, sv = {0.f, 0.f, 0.f, 0.f};
                if (ropew) { cv = *(const f32x4*)(cs + (size_t)row * 16 + 4 * (fq & 1)); sv = *(const f32x4*)(cs + (size_t)row * 16 + 8 + 4 * (fq & 1)); }
                EPI_COLS { f32x4 v = acc[ai][bj][m][n];
                    if (n == 0 && ropew) { f32x4 p; p[0] = __shfl_xor(v[0], 32); p[1] = __shfl_xor(v[1], 32); p[2] = __shfl_xor(v[2], 32); p[3] = __shfl_xor(v[3], 32);
                        v = hi ? (v * cv + p * sv) : (v * cv - p * sv); }
                    st_bf4(rp + bj * 128 + n * 16, v * sc); } }
        } else if (pn < 12) {
            const float sc = pn == 6 ? 0.125f : 1.0f;
            EPI_ROWS { const int row = u.pm * 256 + ai * 128 + wr * 64 + m * 16 + fr; bf16_t* rp = P + (size_t)row * 3072 + pn * 256 + wc * 32 + fq * 4;
                EPI_COLS st_bf4(rp + bj * 128 + n * 16, acc[ai][bj][m][n] * sc); }
        } else {
            decay_rows<0>(acc, u, wr, wc, fr, fq); decay_rows<1>(acc, u, wr, wc, fr, fq);
        }
    }
};
struct EpiP1 {
    static constexpr bool PERM = false, AFTER_DRAIN = false;
    EpiProj proj; EpiPlain vt, kx, vxt;
    __device__ __forceinline__ void operator()(const f32x4 (&acc)[2][2][4][2], const Unit& u, int wr, int wc, int fr, int fq) const {
        const int job = u.pn >> 16; Unit v; v.pm = u.pm; v.pn = u.pn & 0xffff;
        if (job == 0) proj(acc, v, wr, wc, fr, fq); else if (job == 1) vt(acc, v, wr, wc, fr, fq); else if (job == 2) kx(acc, v, wr, wc, fr, fq); else vxt(acc, v, wr, wc, fr, fq);
    }
};
struct EpiRes1 {
    static constexpr bool PERM = false, AFTER_DRAIN = false;
    const float* base; bf16_t* xb; float* ssp;
    __device__ __forceinline__ void operator()(const f32x4 (&acc)[2][2][4][2], const Unit& u, int wr, int wc, int fr, int fq) const {
        EPI_ROWS { const int row = u.pm * 256 + ai * 128 + wr * 64 + m * 16 + fr; const size_t off = (size_t)row * 1024 + u.pn * 256 + wc * 32 + fq * 4; float ss = 0.f;
            EPI_COLS { const size_t o2 = off + bj * 128 + n * 16; const f32x4 v = *(const f32x4*)(base + o2) + acc[ai][bj][m][n]; st_bf4(xb + o2, v);
                ss += (v[0] * v[0] + v[1] * v[1]) + (v[2] * v[2] + v[3] * v[3]); }
            ss += __shfl_xor(ss, 16); ss += __shfl_xor(ss, 32);
            if (fq == 0) ssp[(size_t)row * 16 + u.pn * 4 + wc] = ss; }
    }
};
struct EpiQX {
    static constexpr bool PERM = false, AFTER_DRAIN = false;
    bf16_t* O; const float* ssp;
    __device__ __forceinline__ void operator()(const f32x4 (&acc)[2][2][4][2], const Unit& u, int wr, int wc, int fr, int fq) const {
        EPI_ROWS { const int row = u.pm * 256 + ai * 128 + wr * 64 + m * 16 + fr; const f32x4* sp = (const f32x4*)(ssp + (size_t)row * 16);
            const f32x4 a = sp[0], b = sp[1], c = sp[2], d = sp[3]; const float ss = ((a[0] + a[1]) + (a[2] + a[3])) + ((b[0] + b[1]) + (b[2] + b[3])) + ((c[0] + c[1]) + (c[2] + c[3])) + ((d[0] + d[1]) + (d[2] + d[3]));
            const float rs = rsqrtf(ss * (1.0f / 1024.0f) + 1e-6f) * QSCALE_X; bf16_t* rp = O + (size_t)row * 1024 + u.pn * 256 + wc * 32 + fq * 4;
            EPI_COLS st_bf4(rp + bj * 128 + n * 16, acc[ai][bj][m][n] * rs); }
    }
};
struct EpiRes2 {
    static constexpr bool PERM = false, AFTER_DRAIN = false;
    bf16_t* xh; unsigned char* x8;
    __device__ __forceinline__ void operator()(const f32x4 (&acc)[2][2][4][2], const Unit& u, int wr, int wc, int fr, int fq) const {
        EPI_ROWS { const int row = u.pm * 256 + ai * 128 + wr * 64 + m * 16 + fr; const size_t off = (size_t)row * 1024 + u.pn * 256 + wc * 32 + fq * 4;
            EPI_COLS { bf16_t* p = xh + off + bj * 128 + n * 16; const u32x2 w = *(const u32x2*)p;
                f32x4 v = {__builtin_bit_cast(float, w.x << 16), __builtin_bit_cast(float, w.x & 0xffff0000u), __builtin_bit_cast(float, w.y << 16), __builtin_bit_cast(float, w.y & 0xffff0000u)};
                v = v + acc[ai][bj][m][n]; st_bf4(p, v); *(unsigned*)(x8 + off + bj * 128 + n * 16) = cvt4_fp8(v); } }
    }
};
struct EpiUp {
    static constexpr bool PERM = false, AFTER_DRAIN = false;
    unsigned char* ACT; const float* rsl; const PG8_LAS int* tstart; const PG8_LAS int* cnt; const float* b_up;
    __device__ __forceinline__ void operator()(const f32x4 (&acc)[2][2][4][2], const Unit& u, int wr, int wc, int fr, int fq) const {
        const int e = u.pn >> 3, pnl = u.pn & 7; const float* bg = b_up + (size_t)e * 2048 + pnl * 128 + wc * 32 + fq * 4;
        const int pos0 = (u.pm - tstart[e]) * 256 + wr * 64 + fr, nv = cnt[e]; const float* rp0 = rsl + (size_t)e * 32768 + pos0;
        EPI_ROWS { const int row = u.pm * 256 + ai * 128 + wr * 64 + m * 16 + fr; const float rs = (pos0 + ai * 128 + m * 16) < nv ? rp0[ai * 128 + m * 16] : 0.f;
            unsigned char* rp = ACT + (size_t)row * 1024 + pnl * 128 + wc * 32 + fq * 4;
            _Pragma("unroll") for (int n = 0; n < 2; ++n) { const f32x4 g = acc[ai][0][m][n] * rs + *(const f32x4*)(bg + n * 16), l = acc[ai][1][m][n] * rs + *(const f32x4*)(bg + 1024 + n * 16); f32x4 o;
                _Pragma("unroll") for (int i = 0; i < 4; ++i) { const float gl = fminf(g[i], 7.0f), li = fminf(fmaxf(l[i], -7.0f), 7.0f); o[i] = gl / (1.0f + __expf(-1.702f * gl)) * (li + 1.0f); }
                *(unsigned*)(rp + n * 16) = cvt4_fp8(o); } }
    }
};
struct EpiDown {
    static constexpr bool PERM = false, AFTER_DRAIN = false;
    unsigned char* Y; const float* b_down;
    __device__ __forceinline__ void operator()(const f32x4 (&acc)[2][2][4][2], const Unit& u, int wr, int wc, int fr, int fq) const {
        const int e = u.pn >> 2, pnl = u.pn & 3; const float* bp = b_down + (size_t)e * 1024 + pnl * 256 + wc * 32 + fq * 4;
        EPI_ROWS { const int row = u.pm * 256 + ai * 128 + wr * 64 + m * 16 + fr; unsigned char* rp = Y + (size_t)row * 1024 + pnl * 256 + wc * 32 + fq * 4;
            EPI_COLS *(unsigned*)(rp + bj * 128 + n * 16) = cvt4_fp8(acc[ai][bj][m][n] + *(const f32x4*)(bp + bj * 128 + n * 16)); }
    }
};
struct OrderMap : OrderBase {
    StaticOrder so;
    __device__ void init(int nM, int nN, int G, int c) { so.nM = nM; so.nN = nN; so.nwg = nM * nN; so.G = G; so.c = c; }
    __device__ bool next(int i, Unit& u) const { if (!so.next(i, u)) return false; u.pn += (u.pn >= 4 ? 2 : 0) + (u.pn >= 6 ? 2 : 0); return true; }
};
struct OrderVT : OrderBase {
    StaticOrder so;
    __device__ void init(int nN, int G, int c) { so.nM = 4; so.nN = nN; so.nwg = 4 * nN; so.G = G; so.c = c; }
    __device__ bool next(int i, Unit& u) const { if (!so.next(i, u)) return false; u.pm += (u.pm >= 2 ? 6 : 4); return true; }
};
__device__ __forceinline__ void map_unit(int L, int nM, int nN, int& pm, int& pn) {
    const int nwg = nM * nN; int wgid = L; { const int q = nwg / NXCD, r = nwg % NXCD, xcd = wgid % NXCD, off = wgid / NXCD; wgid = (xcd < r ? xcd * (q + 1) : r * (q + 1) + (xcd - r) * q) + off; }
    const int nig = WGM * nN, gid = wgid / nig, fm = gid * WGM, gsz = (nM - fm) < WGM ? (nM - fm) : WGM;
    pm = fm + ((wgid % nig) % gsz); pn = (wgid % nig) / gsz;
}
template <unsigned oHN, unsigned oWINT, unsigned oMN, unsigned oWCK, unsigned oWCV>
struct OrderP1 : OrderBase {
    int G, c; const char* ws;
    __device__ __forceinline__ bool next(int i, Unit& u) const {
        int L = i * G + c; if (L >= 1792) return false;
        if (L < 1152) { map_unit(L, 128, 9, u.pm, u.pn); u.pn += (u.pn >= 4 ? 2 : 0) + (u.pn >= 6 ? 2 : 0); return true; } L -= 1152;
        if (L < 512) { map_unit(L, 4, 128, u.pm, u.pn); u.pm += (u.pm >= 2 ? 6 : 4); u.pn |= 1 << 16; return true; } L -= 512;
        if (L < 64) { map_unit(L, 16, 4, u.pm, u.pn); u.pn |= 2 << 16; return true; } L -= 64;
        map_unit(L, 4, 16, u.pm, u.pn); u.pn |= 3 << 16; return true;
    }
    __device__ __forceinline__ const char* a_base(const Gemm&, const Unit& u) const { const int job = u.pn >> 16; unsigned o = oHN; o = job == 1 ? oWINT : o; o = job == 2 ? oMN : o; o = job == 3 ? oWCV : o; return ws + o + (size_t)u.pm * (256 * 1024 * 2); }
    __device__ __forceinline__ const char* b_base(const Gemm&, const Unit& u) const { const int job = u.pn >> 16; unsigned o = oWINT; o = job == 1 ? oHN : o; o = job == 2 ? oWCK : o; o = job == 3 ? oMN : o; return ws + o + (size_t)(u.pn & 0xffff) * (256 * 1024 * 2); }
};
struct MoeOrder : OrderBase {
    StaticOrder so; const PG8_LAS unsigned char* tile_e; int nN;
    __device__ void init(int nM, int nN_, int G, int c, const PG8_LAS unsigned char* te) { so.nM = nM; so.nN = nN_; so.nwg = nM * nN_; so.G = G; so.c = c; tile_e = te; nN = nN_; }
    __device__ bool next(int i, Unit& u) const { if (!so.next(i, u)) return false; u.pn += (int)tile_e[u.pm] * nN; return true; }
};


struct MoeOrderG : OrderBase {
    static constexpr bool GATHER = true;
    StaticOrder so; const PG8_LAS unsigned char* tile_e; const PG8_LAS int* tstart; const PG8_LAS int* cnt; const unsigned* list; PG8_LAS unsigned* gslot; int nN;
    __device__ void init(int nM, int nN_, int G, int c, const PG8_LAS unsigned char* te, const PG8_LAS int* ts, const PG8_LAS int* cn, const unsigned* li, PG8_LAS unsigned* gs) {
        so.nM = nM; so.nN = nN_; so.nwg = nM * nN_; so.G = G; so.c = c; tile_e = te; tstart = ts; cnt = cn; list = li; gslot = gs; nN = nN_; }
    __device__ bool next(int i, Unit& u) const { if (!so.next(i, u)) return false; u.pn += (int)tile_e[u.pm] * nN; return true; }
    __device__ __forceinline__ const char* a_base(const Gemm& g, const Unit&) const { return (const char*)g.A; }
    __device__ __forceinline__ const unsigned* rows(const Unit& u) const { const int e = u.pn / nN; return list + (size_t)e * 32768 + (size_t)(u.pm - tstart[e]) * 256; }
    __device__ __forceinline__ int nvalid(const Unit& u) const { const int e = u.pn / nN; return cnt[e] - (u.pm - tstart[e]) * 256; }
};
struct OrderX1 : OrderBase {
    StaticOrder so;
    __device__ void init(int G, int c) { so.nM = 128; so.nN = 4; so.nwg = 512; so.G = G; so.c = c; }
    __device__ bool next(int i, Unit& u) const { return so.next(i, u); }
    __device__ __forceinline__ const char* a_base(const Gemm& g, const Unit& u) const { return (const char*)(g.A + (size_t)u.pm * 256 * 1024 + u.pn * 256); }
    __device__ __forceinline__ const char* b_base(const Gemm& g, const Unit& u) const { return (const char*)(g.Bt + (size_t)(u.pm >> 3) * 256 * 1024 + u.pn * 256); }
};
struct OrderX2 : OrderBase {
    StaticOrder so;
    __device__ void init(int G, int c) { so.nM = 128; so.nN = 4; so.nwg = 512; so.G = G; so.c = c; }
    __device__ bool next(int i, Unit& u) const { return so.next(i, u); }
    __device__ __forceinline__ const char* a_base(const Gemm& g, const Unit& u) const { return (const char*)(g.A + (size_t)u.pm * 256 * 1024 + u.pn * 256); }
    __device__ __forceinline__ const char* b_base(const Gemm& g, const Unit& u) const { return (const char*)(g.Bt + (size_t)u.pn * 256 * 4096 + (u.pm >> 3) * 256); }
};
struct EpiSoftmax {
    static constexpr bool PERM = false, AFTER_DRAIN = false;
    bf16_t* PX; float* lp; PG8_LAS float* xch;
    __device__ __forceinline__ void operator()(const f32x4 (&acc)[2][2][4][2], const Unit& u, int wr, int wc, int fr, int fq) const {
        PG8_LAS char* rb = (PG8_LAS char*)xch + (wr * 64 + fr) * 16; asm volatile("" : "+v"(rb));
        PG8_LAS char* wb = rb + wc * 4; asm volatile("" : "+v"(wb));
        EPI_ROWS { float a = -INFINITY;
            EPI_COLS { const f32x4 v = acc[ai][bj][m][n]; a = fmaxf(a, fmaxf(fmaxf(v[0], v[1]), fmaxf(v[2], v[3]))); }
            a = fmaxf(a, __shfl_xor(a, 16)); a = fmaxf(a, __shfl_xor(a, 32));
            if (fq == 0) *(PG8_LAS float*)(wb + (ai * 128 + m * 16) * 16) = a; }
        asm volatile("s_waitcnt lgkmcnt(0)" ::: "memory"); __builtin_amdgcn_s_barrier(); asm volatile("" ::: "memory");
        const int row0 = u.pm * 256 + wr * 64 + fr; bf16_t* rp0 = PX + (size_t)row0 * 1024 + u.pn * 256 + wc * 32 + fq * 4; float* lp0 = lp + (size_t)row0 * 16 + u.pn * 4 + wc;
        EPI_ROWS { const f32x4 q = *(const PG8_LAS f32x4*)(rb + (ai * 128 + m * 16) * 16); const float mr = fmaxf(fmaxf(q[0], q[1]), fmaxf(q[2], q[3]));
            bf16_t* rp = rp0 + (size_t)(ai * 128 + m * 16) * 1024; float ps = 0.f;
            EPI_COLS { const f32x4 v = acc[ai][bj][m][n]; f32x4 p; _Pragma("unroll") for (int i = 0; i < 4; ++i) { p[i] = __builtin_amdgcn_exp2f(v[i] - mr); ps += p[i]; }
                st_bf4(rp + bj * 128 + n * 16, p); }
            ps += __shfl_xor(ps, 16); ps += __shfl_xor(ps, 32);
            if (fq == 0) lp0[(ai * 128 + m * 16) * 16] = ps; }
        asm volatile("s_waitcnt lgkmcnt(0)" ::: "memory"); __builtin_amdgcn_s_barrier(); asm volatile("" ::: "memory");
    }
};
struct EpiPV {
    static constexpr bool PERM = false, AFTER_DRAIN = false;
    bf16_t* O; const float* lp;
    __device__ __forceinline__ void operator()(const f32x4 (&acc)[2][2][4][2], const Unit& u, int wr, int wc, int fr, int fq) const {
        EPI_ROWS { const int row = u.pm * 256 + ai * 128 + wr * 64 + m * 16 + fr; const f32x4 q = *(const f32x4*)(lp + (size_t)row * 16 + u.pn * 4);
            const float inv = 1.0f / ((q[0] + q[1]) + (q[2] + q[3])); bf16_t* rp = O + (size_t)row * 1024 + u.pn * 256 + wc * 32 + fq * 4;
            EPI_COLS st_bf4(rp + bj * 128 + n * 16, acc[ai][bj][m][n] * inv); }
    }
};
typedef int v4i_t __attribute__((ext_vector_type(4))); typedef int v8i_t __attribute__((ext_vector_type(8)));
__device__ __forceinline__ v8i_t cat8(bf16x8 lo, bf16x8 hi) { return __builtin_shufflevector(__builtin_bit_cast(v4i_t, lo), __builtin_bit_cast(v4i_t, hi), 0, 1, 2, 3, 4, 5, 6, 7); }
__device__ __forceinline__ void mfma8(f32x4& acc, v8i_t w, v8i_t a, int sw, int sa) {
    asm volatile("s_nop 1\n\tv_mfma_scale_f32_16x16x128_f8f6f4 %0, %1, %2, %0, %3, %4 op_sel_hi:[0,0,0]" : "+v"(acc) : "v"(w), "v"(a), "v"(sw), "v"(sa)); }
constexpr int PF_D = 4, PF_LDS = 137216;
template <class Epi, class Sched, bool ALIGN_EPI = false, bool SP2 = false, bool FP8 = false, bool PF = false>
__device__ __forceinline__ void gemm_phase(PG8_LAS unsigned char* lds, const Gemm g, const Sched& S, const Epi& E) {
    const int tid = threadIdx.x, wid = __builtin_amdgcn_readfirstlane(tid >> 6), lane = tid & 63, wr = wid >> 2, wc = wid & 3, fr = lane & 15, fq = lane >> 4;
    const int K = g.K, nt = K / BK;
    unsigned voffA[2], voffB[2];
    unsigned gC[2][2];
#pragma unroll
    for (int i = 0; i < 2; ++i) { int R, C; stage_rc(tid * 16 + i * 8192, R, C); const int Rb = Epi::PERM ? ((R & ~31) + perm32(R & 31)) : R;
        voffA[i] = (unsigned)(R * g.lda + C) * 2u; voffB[i] = (unsigned)(Rb * g.ldb + C) * 2u; }
    const bool pfA = !Sched::GATHER && wid < 4;
    const unsigned pfoff = (unsigned)((((wid >> 1) & 1) * HALF + (wid & 1) * 64 + lane) * (pfA ? g.lda : g.ldb)) * 2u;
    const size_t kstep = (size_t)(BK * 2);
    const size_t hstepA = (size_t)HALF * g.lda * 2, hstepB = (size_t)HALF * g.ldb * 2;
    const unsigned ldsw = (unsigned)wid * 1024u;
    const int aoff = lds_byte(wr * 64 + fr, fq * 8), boff = lds_byte(wc * 32 + fr, fq * 8);
#define PG8_SA(b, h) (((b) * 2 + (h)) * HTB)
#define PG8_SB(b, h) ((4 + (b) * 2 + (h)) * HTB)
#define PG8_STAGE(bufoff, gbase, voff) do { _Pragma("unroll") for (int _i = 0; _i < 2; ++_i) \
        __builtin_amdgcn_global_load_lds((const unsigned*)((const char*)(gbase) + (voff)[_i]), (PG8_LAS unsigned*)(lds + (bufoff) + ldsw + _i * 8192), 16, 0, 0); } while (0)
#define PG8_STAGE_A(bufoff, ptr, h, nx) do { if constexpr (Sched::GATHER) { PG8_STAGE(bufoff, ptr, gC[h]); } else { PG8_STAGE(bufoff, (ptr) + ((h) ? hstepA : 0), voffA); } } while (0)
#define PG8_LDA(dst, b, h) do { _Pragma("unroll") for (int m = 0; m < 4; ++m) _Pragma("unroll") for (int k = 0; k < 2; ++k) dst[m][k] = *(const PG8_LAS bf16x8*)(lds + PG8_SA(b, h) + aoff + m * 2048 + k * 1024); } while (0)
#define PG8_LDB(dst, b, h) do { _Pragma("unroll") for (int n = 0; n < 2; ++n) _Pragma("unroll") for (int k = 0; k < 2; ++k) dst[n][k] = *(const PG8_LAS bf16x8*)(lds + PG8_SB(b, h) + boff + n * 2048 + k * 1024); } while (0)
#define PG8_MMA(ai, bj, At, Bt) do { __builtin_amdgcn_s_setprio(1); \
        if constexpr (FP8) { _Pragma("unroll") for (int m = 0; m < 4; ++m) _Pragma("unroll") for (int n = 0; n < 2; ++n) \
            mfma8(acc[ai][bj][m][n], cat8(Bt[n][0], Bt[n][1]), cat8(At[m][0], At[m][1]), g.sb, g.sa); } \
        else { _Pragma("unroll") for (int m = 0; m < 4; ++m) _Pragma("unroll") for (int n = 0; n < 2; ++n) _Pragma("unroll") for (int k = 0; k < 2; ++k) \
            acc[ai][bj][m][n] = __builtin_amdgcn_mfma_f32_16x16x32_bf16(Bt[n][k], At[m][k], acc[ai][bj][m][n], 0, 0, 0); } \
        __builtin_amdgcn_s_setprio(0); } while (0)
#define PG8_WAIT_V(n) asm volatile("s_waitcnt vmcnt(" #n ")" ::: "memory")
#define PG8_WAIT_VP() do { if constexpr (PF) asm volatile("s_waitcnt vmcnt(9)" ::: "memory"); else asm volatile("s_waitcnt vmcnt(8)" ::: "memory"); } while (0)
#define PG8_PREFETCH(tp) do { if constexpr (PF) { const int tp_ = (tp); const char* pb_ = tp_ < nt ? (pfA ? cA : cB) + (size_t)tp_ * kstep : (pfA ? nA : nB) + (size_t)(tp_ - nt) * kstep; \
        __builtin_amdgcn_global_load_lds((const unsigned*)(pb_ + pfoff), (PG8_LAS unsigned*)(lds + PF_LDS + wid * 256), 4, 0, 0); } } while (0)
#define PG8_WAIT_L(n) asm volatile("s_waitcnt lgkmcnt(" #n ")" ::: "memory")
#define PG8_BAR __builtin_amdgcn_s_barrier()
#define PG8_SCHED __builtin_amdgcn_sched_barrier(0)
    Unit cur, nxt; int ui = 0;
    if (!S.next(0, cur)) return;
    f32x4 acc[2][2][4][2];
#pragma unroll
    for (int a = 0; a < 2; ++a)
#pragma unroll
        for (int b = 0; b < 2; ++b)
#pragma unroll
            for (int m = 0; m < 4; ++m)
#pragma unroll
                for (int n = 0; n < 2; ++n) acc[a][b][m][n] = (f32x4){0.f, 0.f, 0.f, 0.f};
    bf16x8 At[4][2], B0[2][2], B1[2][2];
    const char* cA = S.a_base(g, cur); const char* cB = S.b_base(g, cur);
    if constexpr (Sched::GATHER) { const unsigned* rp = S.rows(cur); const int nv = S.nvalid(cur);
#pragma unroll
        for (int h = 0; h < 2; ++h)
#pragma unroll
            for (int i = 0; i < 2; ++i) { int R, C; stage_rc(tid * 16 + i * 8192, R, C); const int r = h * HALF + R; const unsigned tok = r < nv ? rp[r] : 0u; gC[h][i] = tok * (unsigned)(g.lda * 2) + (unsigned)C * 2u; } }
    S.a_ready(cur);
    if constexpr (SP2) {
        PG8_STAGE(PG8_SB(0, 0), cB, voffB); PG8_STAGE(PG8_SB(0, 1), cB + hstepB, voffB); PG8_STAGE_A(PG8_SA(0, 0), cA, 0, 0); PG8_STAGE_A(PG8_SA(0, 1), cA, 1, 0);
        if (wr == 1) PG8_BAR;
        PG8_WAIT_V(2); PG8_BAR;
        PG8_STAGE(PG8_SB(1, 0), cB + kstep, voffB); PG8_STAGE_A(PG8_SA(1, 0), cA + kstep, 0, 0); PG8_STAGE(PG8_SB(1, 1), cB + hstepB + kstep, voffB);
        PG8_WAIT_V(6); PG8_BAR;
    } else {
        PG8_STAGE(PG8_SB(0, 0), cB, voffB); PG8_STAGE_A(PG8_SA(0, 0), cA, 0, 0); PG8_STAGE(PG8_SB(0, 1), cB + hstepB, voffB); PG8_STAGE_A(PG8_SA(0, 1), cA, 1, 0);
        if (wr == 1) PG8_BAR;
        PG8_WAIT_V(4); PG8_BAR;
        PG8_STAGE(PG8_SB(1, 0), cB + kstep, voffB); PG8_STAGE_A(PG8_SA(1, 0), cA + kstep, 0, 0); PG8_STAGE(PG8_SB(1, 1), cB + hstepB + kstep, voffB);
        PG8_WAIT_V(6); PG8_BAR;
    }
    for (;;) {
        const bool has_next = S.next(ui + 1, nxt);
        const char* nA = has_next ? S.a_base(g, nxt) : cA; const char* nB = has_next ? S.b_base(g, nxt) : cB;
        if constexpr (Sched::GATHER) { if (has_next && wid < 4)
            __builtin_amdgcn_global_load_lds((const unsigned*)(S.rows(nxt) + wid * 64 + lane), (PG8_LAS unsigned*)(S.gslot + ((ui + 1) & 1) * 256 + wid * 64), 4, 0, 0); }
#pragma nounroll
        for (int t = 0; t < nt; t += 2) {
            const bool last = (t == nt - 2);
            const char* a1 = cA + (size_t)(t + 1) * kstep;
            const char* a2 = last ? nA : cA + (size_t)(t + 2) * kstep; const char* b2 = last ? nB : cB + (size_t)(t + 2) * kstep;
            const char* a3 = a2 + kstep; const char* b3 = b2 + kstep;
            if (last && has_next) S.a_ready(nxt);
            if constexpr (SP2) {
            PG8_LDB(B0, 0, 0); PG8_LDB(B1, 0, 1); PG8_SCHED; PG8_LDA(At, 0, 0); PG8_STAGE_A(PG8_SA(1, 1), a1, 1, 0);
            if constexpr (Sched::GATHER) { if (last && has_next) {
                const PG8_LAS unsigned* sl = S.gslot + ((ui + 1) & 1) * 256; const int nv = S.nvalid(nxt);
#pragma unroll
                for (int h = 0; h < 2; ++h)
#pragma unroll
                    for (int i = 0; i < 2; ++i) { int R, C; stage_rc(tid * 16 + i * 8192, R, C); const int r = h * HALF + R; const unsigned v = sl[r]; const unsigned tok = r < nv ? v : 0u; gC[h][i] = tok * (unsigned)(g.lda * 2) + (unsigned)C * 2u; } } }
            PG8_WAIT_VP(); PG8_WAIT_L(0); PG8_BAR; PG8_MMA(0, 0, At, B0); PG8_MMA(0, 1, At, B1); PG8_BAR; PG8_SCHED;
            PG8_LDA(At, 0, 1); PG8_STAGE(PG8_SB(0, 0), b2, voffB); PG8_STAGE(PG8_SB(0, 1), b2 + hstepB, voffB); PG8_STAGE_A(PG8_SA(0, 0), a2, 0, 1); PG8_PREFETCH(t + PF_D);
            PG8_WAIT_VP(); PG8_WAIT_L(0); PG8_BAR; PG8_MMA(1, 0, At, B0); PG8_MMA(1, 1, At, B1); PG8_BAR; PG8_SCHED;
            PG8_LDB(B0, 1, 0); PG8_LDB(B1, 1, 1); PG8_SCHED; PG8_LDA(At, 1, 0); PG8_STAGE_A(PG8_SA(0, 1), a2, 1, 1);
            PG8_WAIT_VP(); PG8_WAIT_L(0); PG8_BAR; PG8_MMA(0, 0, At, B0); PG8_MMA(0, 1, At, B1); PG8_BAR; PG8_SCHED;
            PG8_LDA(At, 1, 1); PG8_STAGE(PG8_SB(1, 0), b3, voffB); PG8_STAGE(PG8_SB(1, 1), b3 + hstepB, voffB); PG8_STAGE_A(PG8_SA(1, 0), a3, 0, 1); PG8_PREFETCH(t + 1 + PF_D);
            PG8_WAIT_VP(); PG8_WAIT_L(0); PG8_BAR; PG8_MMA(1, 0, At, B0); PG8_MMA(1, 1, At, B1); PG8_BAR; PG8_SCHED;
            } else {
            PG8_LDB(B0, 0, 0); PG8_SCHED; PG8_LDA(At, 0, 0); PG8_STAGE_A(PG8_SA(1, 1), a1, 1, 0);
            PG8_WAIT_L(8); PG8_BAR; PG8_WAIT_L(0); PG8_MMA(0, 0, At, B0); PG8_BAR; PG8_SCHED;
            PG8_LDB(B1, 0, 1); PG8_STAGE(PG8_SB(0, 0), b2, voffB);
            PG8_BAR; PG8_WAIT_L(0); PG8_MMA(0, 1, At, B1); PG8_BAR;
            PG8_LDA(At, 0, 1); PG8_STAGE_A(PG8_SA(0, 0), a2, 0, 1);
            PG8_BAR; PG8_WAIT_L(0); PG8_MMA(1, 0, At, B0); PG8_BAR; PG8_SCHED;
            PG8_STAGE(PG8_SB(0, 1), b2 + hstepB, voffB);
            PG8_WAIT_V(6); PG8_BAR; PG8_MMA(1, 1, At, B1); PG8_BAR;
            PG8_LDB(B0, 1, 0); PG8_SCHED; PG8_LDA(At, 1, 0); PG8_STAGE_A(PG8_SA(0, 1), a2, 1, 1);
            PG8_WAIT_L(8); PG8_BAR; PG8_WAIT_L(0); PG8_MMA(0, 0, At, B0); PG8_BAR; PG8_SCHED;
            PG8_LDB(B1, 1, 1); PG8_STAGE(PG8_SB(1, 0), b3, voffB);
            PG8_BAR; PG8_WAIT_L(0); PG8_MMA(0, 1, At, B1); PG8_BAR;
            PG8_LDA(At, 1, 1); PG8_STAGE_A(PG8_SA(1, 0), a3, 0, 1);
            PG8_BAR; PG8_WAIT_L(0); PG8_MMA(1, 0, At, B0); PG8_BAR; PG8_SCHED;
            PG8_STAGE(PG8_SB(1, 1), b3 + hstepB, voffB);
            PG8_WAIT_V(6); PG8_BAR; PG8_MMA(1, 1, At, B1); PG8_BAR;
            }
        }
        if constexpr (ALIGN_EPI) { if (wr == 0) PG8_BAR; }
        if constexpr (FP8) asm volatile("s_nop 15\n\ts_nop 15" ::: "memory");
        if constexpr (!Epi::AFTER_DRAIN) { E(acc, cur, wr, wc, fr, fq); S.done(cur); }
        if (!has_next) break;
#pragma unroll
        for (int a = 0; a < 2; ++a)
#pragma unroll
            for (int b = 0; b < 2; ++b)
#pragma unroll
                for (int m = 0; m < 4; ++m)
#pragma unroll
                    for (int n = 0; n < 2; ++n) acc[a][b][m][n] = (f32x4){0.f, 0.f, 0.f, 0.f};
        cur = nxt; cA = nA; cB = nB; ++ui;
        if constexpr (ALIGN_EPI) { if (wr == 1) PG8_BAR; }
    }
    PG8_WAIT_V(0);
    if constexpr (!ALIGN_EPI) { if (wr == 0) PG8_BAR; }
    PG8_BAR;
    if constexpr (Epi::AFTER_DRAIN) { E.fused(acc, cur, wr, wc, fr, fq, lds, wid, lane); S.done(cur); }
#undef PG8_SA
#undef PG8_SB
#undef PG8_STAGE
#undef PG8_STAGE_A
#undef PG8_LDA
#undef PG8_LDB
#undef PG8_MMA
#undef PG8_WAIT_V
#undef PG8_WAIT_VP
#undef PG8_PREFETCH
#undef PG8_WAIT_L
#undef PG8_BAR
#undef PG8_SCHED
}
}
constexpr int NTOK = 32768, DM = 1024, SEQ = 2048, NBATCH = 16, MEMLEN = 256, NMEM = NBATCH * MEMLEN, INW = 3088, NEXP = 32, TOPK = 4;
constexpr int PW = 3072;
constexpr int MAXTILES = 544;
constexpr float EPS = 1e-6f;
constexpr int NWAVES = 8;
constexpr size_t MiB = 1u << 20;
constexpr size_t WS_CTL = 0, CTL_ZERO_BYTES = 64 * 1024;
constexpr size_t WS_WINT = 2 * MiB, WS_WOUT = 10 * MiB, WS_WCQ = 12 * MiB, WS_WCK = 14 * MiB, WS_WCV = 16 * MiB, WS_WCO = 18 * MiB;
constexpr size_t WS_WR = 20 * MiB, WS_CS = 21 * MiB, WS_SSP1 = 24 * MiB, WS_GATE = 27 * MiB, WS_ASSIGN = 28 * MiB, WS_LIST = 29 * MiB;
constexpr size_t WS_RSL = 842 * MiB;
constexpr size_t WS_X2B = 378 * MiB;
constexpr size_t WS_WUP = 34 * MiB, WS_WDN = 162 * MiB, WS_KX = 226 * MiB, WS_VXT = 234 * MiB;
constexpr size_t WS_HN = 242 * MiB, WS_CAT = 242 * MiB, WS_MN = 306 * MiB, WS_P = 314 * MiB, WS_LA = 506 * MiB, WS_VT = 538 * MiB;
constexpr size_t WS_X1B = 314 * MiB, WS_QX = 378 * MiB, WS_OX = 442 * MiB, WS_PX = 506 * MiB;
constexpr size_t WS_GVT = 602 * MiB;
constexpr size_t WS_ACT = 570 * MiB, WS_Y = 706 * MiB, WS_END = 846 * MiB;
constexpr int CW_Q2 = 128;
constexpr int CW_CNT = 1024;
constexpr int CW_PROBE = 192;
constexpr int CW_BAR = 4096;
constexpr int RING_OFF = 0, RING_BYTES = 131072;
constexpr int LDSCTL_OFF = RING_BYTES, MISC_OFF = LDSCTL_OFF + 320;
constexpr int TAB_OFF = LDSCTL_OFF + 512;
constexpr int TAB_TSTART = TAB_OFF + 576, TAB_CNT = TAB_TSTART + 144;
constexpr int XCH_OFF = LDSCTL_OFF + 2048;
constexpr int TS_OFF = TAB_CNT + 128;
constexpr int LDS_BYTES = 147456;

#define GAS __attribute__((address_space(1)))
#define LAS __attribute__((address_space(3)))
typedef unsigned short bf16;
typedef unsigned v4u __attribute__((ext_vector_type(4)));
typedef float f32x4 __attribute__((ext_vector_type(4)));
typedef short bf16x8 __attribute__((ext_vector_type(8)));
typedef GAS unsigned gu32;
typedef GAS unsigned long long gu64;
#define RLX_AGENT __ATOMIC_RELAXED, __HIP_MEMORY_SCOPE_AGENT
#define LDS_WAIT() asm volatile("s_waitcnt lgkmcnt(0)" ::: "memory")
#define VM_WAIT() asm volatile("s_waitcnt vmcnt(0)" ::: "memory")
__device__ __forceinline__ unsigned long long rt() { return __builtin_amdgcn_s_memrealtime(); }
__device__ __forceinline__ unsigned f2bf(float f) { unsigned u = __builtin_bit_cast(unsigned, f); return (u + 0x7fffu + ((u >> 16) & 1u)) >> 16; }
__device__ __forceinline__ unsigned pk2(float lo, float hi) { return f2bf(lo) | (f2bf(hi) << 16); }

#define XB_TMO      128
#define XB_XCNT(j)  (256  + 64 * (j))
#define XB_XSUB(j)  (1280 + 64 * (j))
#define XB_XGEN(j)  (2304 + 64 * (j))
#define XB_TOP      3328
#define XB_TOPGEN   3392
#define XCD_BAR_WORDS 3456
#define XB_SPIN_CAP (1u << 18)

__device__ __forceinline__ unsigned xb_ld(unsigned* p)              { return __hip_atomic_load(p, __ATOMIC_RELAXED, __HIP_MEMORY_SCOPE_AGENT); }
__device__ __forceinline__ unsigned xb_add(unsigned* p, unsigned v) { return __hip_atomic_fetch_add(p, v, __ATOMIC_RELAXED, __HIP_MEMORY_SCOPE_AGENT); }
__device__ __forceinline__ unsigned xb_xcc_id() { return (unsigned)__builtin_amdgcn_s_getreg((3 << 11) | 20) & 0xFu; }
#define XB_SPIN(cond, bar) do { unsigned _sp = 0; while (cond) { __builtin_amdgcn_s_sleep(1); \
    if ((++_sp & 255u) == 0u) { if (xb_ld(&(bar)[XB_TMO])) break; if (_sp > XB_SPIN_CAP) { atomicAdd(&(bar)[XB_TMO], 1u); break; } } } } while (0)

struct XcdBarrier {
    unsigned* bar; unsigned x;
    volatile LAS unsigned* st;
};

__device__ __forceinline__ XcdBarrier xcd_barrier_post(unsigned* bar, volatile LAS unsigned* st) {
    XcdBarrier b; b.bar = bar; b.x = xb_xcc_id(); b.st = st;
    if (threadIdx.x == 0) (void)xb_add(&bar[XB_XCNT(b.x)], 1u);
    return b;
}
__device__ __forceinline__ void xcd_barrier_complete(unsigned* bar, unsigned x, unsigned& nloc, unsigned& nx) {
    const unsigned G = gridDim.x * gridDim.y * gridDim.z;
    unsigned sum, cnt, mine, sp = 0u;
    for (;;) {
        sum = 0u; cnt = 0u; mine = 0u;
#pragma unroll
        for (unsigned j = 0; j < 16; ++j) { const unsigned c = xb_ld(&bar[XB_XCNT(j)]); sum += c; cnt += (c > 0u) ? 1u : 0u; mine = (j == x) ? c : mine; }
        if (sum == G) break;
        __builtin_amdgcn_s_sleep(1);
        if ((++sp & 255u) == 0u) { if (xb_ld(&bar[XB_TMO])) break; if (sp > XB_SPIN_CAP) { atomicAdd(&bar[XB_TMO], 1u); break; } }
    }
    nloc = mine > 0u ? mine : 1u; nx = cnt > 0u ? cnt : 1u;
}

__device__ __forceinline__ void xcd_barrier(const XcdBarrier& b) {
    asm volatile("s_waitcnt vmcnt(0)" ::: "memory");
    __syncthreads();
    if (threadIdx.x == 0) {
        unsigned* bar = b.bar;
        __builtin_amdgcn_s_waitcnt(0);
        unsigned nloc = b.st[0], nx = b.st[1];
        if (nloc == 0u) { xcd_barrier_complete(bar, b.x, nloc, nx); b.st[0] = nloc; b.st[1] = nx; }
        const unsigned old = xb_add(&bar[XB_XSUB(b.x)], 1u);
        const unsigned gen = old / nloc;
        if (old + 1u == (gen + 1u) * nloc) {
            __builtin_amdgcn_fence(__ATOMIC_RELEASE, "agent");
            asm volatile("s_waitcnt vmcnt(0)" ::: "memory");
            const unsigned og = xb_add(&bar[XB_TOP], 1u);
            const unsigned tg = og / nx;
            if (og + 1u == (tg + 1u) * nx) xb_add(&bar[XB_TOPGEN], 1u);
            else XB_SPIN(xb_ld(&bar[XB_TOPGEN]) == tg, bar);
            __builtin_amdgcn_fence(__ATOMIC_ACQUIRE, "agent");
            xb_add(&bar[XB_XGEN(b.x)], 1u);
            asm volatile("s_waitcnt vmcnt(0)" ::: "memory");
        } else {
            XB_SPIN(xb_ld(&bar[XB_XGEN(b.x)]) == gen, bar);
            __builtin_amdgcn_fence(__ATOMIC_ACQUIRE, "agent");
            asm volatile("s_waitcnt vmcnt(0)" ::: "memory");
        }
    }
    __syncthreads();
}
typedef short bf16x4 __attribute__((ext_vector_type(4)));
typedef unsigned v2u __attribute__((ext_vector_type(2)));
struct Frame {
    LAS unsigned char* lds;
    volatile LAS unsigned* MISC;
    gu32* ctl;
    int tid, lane, wave;
    int vcu, G;
    unsigned char* ws;
    float* out;
};
__device__ __forceinline__ int lane_here() { int t = (int)threadIdx.x; asm volatile("" : "+v"(t)); return t & 63; }
__device__ __forceinline__ float bf2f(bf16 b) { return __builtin_bit_cast(float, (unsigned)b << 16); }
__device__ __forceinline__ float wave_sum(float v) {
#pragma unroll
    for (int o = 1; o < 64; o <<= 1) v += __shfl_xor(v, o);
    return v;
}
__device__ __forceinline__ float xmax16(float m) { auto rr = __builtin_amdgcn_permlane16_swap(__float_as_uint(m), __float_as_uint(m), false, false); return fmaxf(__uint_as_float(rr[0]), __uint_as_float(rr[1])); }
__device__ __forceinline__ float xmax32(float m) { auto rr = __builtin_amdgcn_permlane32_swap(__float_as_uint(m), __float_as_uint(m), false, false); return fmaxf(__uint_as_float(rr[0]), __uint_as_float(rr[1])); }
__device__ __forceinline__ f32x4 mfma16(bf16x8 a, bf16x8 b, f32x4 c) { return __builtin_amdgcn_mfma_f32_16x16x32_bf16(a, b, c, 0, 0, 0); }

__device__ __forceinline__ void p0_transpose_item(const float* W, int ldw, const float* gain, bf16* WT, int K, int k0, int n0, size_t orow0, int lane) {
    const int n4 = lane & 15, kq = lane >> 4;
    const float* src = W + (size_t)(k0 + 16 * kq) * ldw + n0 + 4 * n4;
    f32x4 v[16];
#pragma unroll
    for (int i = 0; i < 16; ++i) v[i] = *(const f32x4*)(src + (size_t)i * ldw);
    if (gain) { const f32x4* gp = (const f32x4*)(gain + k0 + 16 * kq);
#pragma unroll
        for (int q = 0; q < 4; ++q) { const f32x4 gq = gp[q];
#pragma unroll
            for (int r = 0; r < 4; ++r) v[4 * q + r] = v[4 * q + r] * gq[r]; } }
    bf16* dst = WT + (orow0 + 4 * n4) * (size_t)K + k0 + 16 * kq;
#pragma unroll
    for (int j = 0; j < 4; ++j) { v4u o0, o1;
        o0.x = pg8::cvtpk(v[0][j], v[1][j]); o0.y = pg8::cvtpk(v[2][j], v[3][j]); o0.z = pg8::cvtpk(v[4][j], v[5][j]); o0.w = pg8::cvtpk(v[6][j], v[7][j]);
        o1.x = pg8::cvtpk(v[8][j], v[9][j]); o1.y = pg8::cvtpk(v[10][j], v[11][j]); o1.z = pg8::cvtpk(v[12][j], v[13][j]); o1.w = pg8::cvtpk(v[14][j], v[15][j]);
        *(v4u*)(dst + (size_t)j * K) = o0; *(v4u*)(dst + (size_t)j * K + 8) = o1; }
}
__device__ __forceinline__ void p0_transpose_item8(const float* W, int ldw, const float* gain, unsigned char* WT, int K, int k0, int n0, size_t orow0, int lane) {
    const int n4 = lane & 15, kq = lane >> 4;
    const float* src = W + (size_t)(k0 + 16 * kq) * ldw + n0 + 4 * n4;
    f32x4 v[16];
#pragma unroll
    for (int i = 0; i < 16; ++i) v[i] = *(const f32x4*)(src + (size_t)i * ldw);
    { const f32x4* gp = (const f32x4*)(gain + k0 + 16 * kq);
#pragma unroll
        for (int q = 0; q < 4; ++q) { f32x4 gq = {32.f, 32.f, 32.f, 32.f}; if (gain) gq = gp[q] * 32.0f;
#pragma unroll
            for (int r = 0; r < 4; ++r) v[4 * q + r] = v[4 * q + r] * gq[r]; } }
    unsigned char* dst = WT + (orow0 + 4 * n4) * (size_t)K + k0 + 16 * kq;
#pragma unroll
    for (int j = 0; j < 4; ++j) { v4u o;
        o.x = pg8::cvt4_fp8((f32x4){v[0][j], v[1][j], v[2][j], v[3][j]}); o.y = pg8::cvt4_fp8((f32x4){v[4][j], v[5][j], v[6][j], v[7][j]});
        o.z = pg8::cvt4_fp8((f32x4){v[8][j], v[9][j], v[10][j], v[11][j]}); o.w = pg8::cvt4_fp8((f32x4){v[12][j], v[13][j], v[14][j], v[15][j]});
        *(v4u*)(dst + (size_t)j * K) = o; }
}
__device__ __forceinline__ void rms_row_to_bf16(const float* xrow, const float* g, bf16* orow, int lane) {
    const f32x4* xr = (const f32x4*)xrow + lane; const f32x4* gr = (const f32x4*)g + lane;
    f32x4 v[4]; float s = 0.f;
#pragma unroll
    for (int j = 0; j < 4; ++j) { v[j] = xr[64 * j]; s += (v[j].x * v[j].x + v[j].y * v[j].y) + (v[j].z * v[j].z + v[j].w * v[j].w); }
    const float rs = rsqrtf(wave_sum(s) * (1.0f / DM) + EPS);
    unsigned long long* o8 = (unsigned long long*)orow + lane;
#pragma unroll
    for (int j = 0; j < 4; ++j) { const f32x4 gg = gr[64 * j]; o8[64 * j] = (unsigned long long)pk2(v[j].x * rs * gg.x, v[j].y * rs * gg.y) | ((unsigned long long)pk2(v[j].z * rs * gg.z, v[j].w * rs * gg.w) << 32); }
}
constexpr int MOE_I_UP = 32 * 16 * 32, MOE_I_DN = 32 * 16 * 16, MOE_UNITS = (MOE_I_UP + MOE_I_DN) / 64;
__device__ __forceinline__ void moe_convert_unit(int unit, const float* w_up, const float* w_down, const float* g_ffn, unsigned char* ws, int wave, int lane) {
#pragma unroll 1
    for (int j = 0; j < 8; ++j) { int r = unit * 64 + j * 8 + wave;
        if (r < MOE_I_UP) { const int e = r / (16 * 32); r -= e * (16 * 32); const int n0 = 64 * (r % 32);
            const size_t orow = (size_t)e * 2048 + ((n0 & 1023) >> 7) * 256 + (n0 >> 10) * 128 + (n0 & 127);
            p0_transpose_item8(w_up + (size_t)e * DM * 2048, 2048, g_ffn, ws + WS_WUP, DM, 64 * (r / 32), n0, orow, lane); }
        else { r -= MOE_I_UP; const int e = r / (16 * 16); r -= e * (16 * 16);
            p0_transpose_item8(w_down + (size_t)e * DM * DM, DM, nullptr, ws + WS_WDN, DM, 64 * (r / 16), 64 * (r % 16), (size_t)e * 1024 + 64 * (r % 16), lane); } }
}
struct In {
    const float *x, *mem; const int* positions; const float *norm_mix_g, *w_in, *lq1, *lk1, *lq2, *lk2, *diff_norm_g, *w_alpha2, *b_alpha, *gla_norm_g, *w_out, *norm_cross_g, *norm_mem_g,
        *w_cq, *w_ck, *w_cv, *w_co, *norm_ffn_g, *w_router, *b_router, *w_up, *b_up, *w_down, *b_down, *norm_final_g;
};
__device__ __forceinline__ void p0_prologue(Frame& F, const In& I) {
    const int gw = F.vcu * NWAVES + F.wave, NGW = F.G * NWAVES, lane = lane_here();
    unsigned char* ws = F.ws;
    constexpr int I_IN = 16 * 48, I_SQ = 16 * 16;
    constexpr int NITEMS = I_IN + 5 * I_SQ;
    for (int it = gw; it < NITEMS; it += NGW) {
        int r = it;
        if (r < I_IN) { p0_transpose_item(I.w_in, INW, nullptr, (bf16*)(ws + WS_WINT), DM, 64 * (r / 48), 64 * (r % 48), (size_t)64 * (r % 48), lane); continue; } r -= I_IN;
        { const int w = r / I_SQ; r -= w * I_SQ;
            const float* W = w == 0 ? I.w_out : w == 1 ? I.w_cq : w == 2 ? I.w_ck : w == 3 ? I.w_cv : I.w_co;
            bf16* WT = (bf16*)(ws + (w == 0 ? WS_WOUT : w == 1 ? WS_WCQ : w == 2 ? WS_WCK : w == 3 ? WS_WCV : WS_WCO));
            p0_transpose_item(W, DM, w == 1 ? I.norm_cross_g : nullptr, WT, DM, 64 * (r / 16), 64 * (r % 16), (size_t)64 * (r % 16), lane); }
    }
    const int gt = F.vcu * (NWAVES * 64) + F.tid, NGT = F.G * NWAVES * 64;
    for (int idx = gt; idx < 256 * DM; idx += NGT) { const int j = idx >> 10, k = idx & 1023; const float* wr = I.w_in + (size_t)k * INW + 3072; float s = 0.f;
#pragma unroll
        for (int r = 0; r < 16; ++r) s += wr[r] * I.w_alpha2[r * 256 + j];
        ((bf16*)(ws + WS_WINT))[(size_t)(3072 + j) * DM + k] = (bf16)f2bf(s); }
    for (int idx = gt; idx < DM * NEXP; idx += NGT) ((float*)(ws + WS_WR))[idx] = I.w_router[idx] * I.norm_ffn_g[idx >> 5];
    for (int idx = gt; idx < NTOK * 8; idx += NGT) { const int tok = idx >> 3, i = idx & 7;
        const double inv = exp(-(double)i * 0.125 * 13.122363377404328); const double ang = (double)I.positions[tok] * inv;
        const double red = ang - rint(ang * 0.15915494309189535) * 6.283185307179586; const float rf = (float)red;
        float* cs = (float*)(ws + WS_CS) + (size_t)tok * 16; cs[i] = cosf(rf); cs[8 + i] = sinf(rf); }
    for (int m = gw; m < NTOK + NMEM; m += NGW) {
        if (m < NTOK) rms_row_to_bf16(I.x + (size_t)m * DM, I.norm_mix_g, (bf16*)(ws + WS_HN) + (size_t)m * DM, lane);
        else rms_row_to_bf16(I.mem + (size_t)(m - NTOK) * DM, I.norm_mem_g, (bf16*)(ws + WS_MN) + (size_t)(m - NTOK) * DM, lane);
    }
}

constexpr int DA_KBUF = 16384, DA_VBUF = 16384, DA_VOFF = 2 * DA_KBUF;
__device__ __forceinline__ void diffattn_unit(Frame& F, const bf16* P, const bf16* VT, bf16* CAT, const float* gdiff, float lam, int b, int h, int qblk) {
    const int lane = lane_here(), wave = F.wave, tid = F.tid, l15 = lane & 15, g = lane >> 4;
    LAS unsigned char* lds = F.lds + RING_OFF;
    const int q0 = qblk * 128 + wave * 16;
    const size_t tokq = (size_t)b * SEQ + q0 + l15;
    bf16x8 qf[2][2];
#pragma unroll
    for (int c = 0; c < 2; ++c)
#pragma unroll
        for (int ks = 0; ks < 2; ++ks) qf[c][ks] = *(const bf16x8*)(P + tokq * PW + h * 128 + c * 64 + ks * 32 + g * 8);
    f32x4 o[2][8];
#pragma unroll
    for (int c = 0; c < 2; ++c)
#pragma unroll
        for (int k = 0; k < 8; ++k) o[c][k] = (f32x4){0.f, 0.f, 0.f, 0.f};
    float mrun[2] = {-INFINITY, -INFINITY}, lsum[2] = {0.f, 0.f};
    const int nk = q0 + 16;
    const int nt = 2 * qblk + 2;
    const int skey = tid >> 4, sch = tid & 15, vrow = tid >> 3, vpc = tid & 7;
    const bf16* ksrc = P + ((size_t)b * SEQ + skey) * PW + 512 + h * 128 + sch * 8;
    const bf16* vsrc = VT + (size_t)(h * 128 + vrow) * NTOK + (size_t)b * SEQ + vpc * 8;
    const int kdst = skey * 256 + ((sch ^ (skey & 15)) * 16);
    const int vfr = (vrow >> 1) & 7, vch = (vpc >> 2) * 4 + 2 * (vpc & 1), vhi = ((vpc & 3) >> 1) * 8;
    const int vdst0 = DA_VOFF + vrow * 128 + ((vch ^ vfr) * 16) + vhi, vdst1 = DA_VOFF + vrow * 128 + (((vch + 1) ^ vfr) * 16) + vhi;
    int koff[2][2];
#pragma unroll
    for (int c = 0; c < 2; ++c)
#pragma unroll
        for (int ks = 0; ks < 2; ++ks) koff[c][ks] = l15 * 256 + (((c * 8 + ks * 4 + g) ^ l15) * 16);
    const int voffs[2] = {DA_VOFF + l15 * 128 + ((g ^ (l15 >> 1)) * 16), DA_VOFF + l15 * 128 + (((4 + g) ^ (l15 >> 1)) * 16)};
    v4u sk0, sk1, sv0, sv1;
#define DA_LOAD(tt) do { const bf16* kp_ = ksrc + (size_t)(tt) * 64 * PW; const bf16* vp_ = vsrc + (tt) * 64; \
        sk0 = *(const v4u*)kp_; sk1 = *(const v4u*)(kp_ + (size_t)32 * PW); sv0 = *(const v4u*)vp_; sv1 = *(const v4u*)(vp_ + (size_t)64 * NTOK); } while (0)
#define DA_STORE(bb) do { LAS unsigned char* kd_ = lds + (bb) * DA_KBUF + kdst; LAS unsigned char* vd_ = lds + (bb) * DA_VBUF; \
        *(LAS v4u*)kd_ = sk0; *(LAS v4u*)(kd_ + 8192) = sk1; \
        *(LAS v2u*)(vd_ + vdst0) = (v2u){sv0.x, sv0.y}; *(LAS v2u*)(vd_ + vdst1) = (v2u){sv0.z, sv0.w}; *(LAS v2u*)(vd_ + vdst0 + 8192) = (v2u){sv1.x, sv1.y}; *(LAS v2u*)(vd_ + vdst1 + 8192) = (v2u){sv1.z, sv1.w}; } while (0)
    DA_LOAD(0); DA_STORE(0);
    __syncthreads();
    auto step = [&](const int t, const int buf) __attribute__((always_inline)) {
        if (t * 64 < nk) {
            const LAS unsigned char* kb = lds + buf * DA_KBUF; const LAS unsigned char* vb = lds + buf * DA_VBUF;
            f32x4 s[2][2][2];
#pragma unroll
            for (int sub = 0; sub < 2; ++sub)
#pragma unroll
                for (int c = 0; c < 2; ++c)
#pragma unroll
                    for (int s2 = 0; s2 < 2; ++s2) { f32x4 a = (f32x4){0.f, 0.f, 0.f, 0.f};
#pragma unroll
                        for (int ks = 0; ks < 2; ++ks) { const bf16x8 kf = *(const LAS bf16x8*)(kb + sub * 8192 + s2 * 4096 + koff[c][ks]); a = mfma16(kf, qf[c][ks], a); }
                        s[sub][c][s2] = a; }
            if (t * 64 + 63 > q0) {
                const int qrow = q0 + l15;
#pragma unroll
                for (int sub = 0; sub < 2; ++sub)
#pragma unroll
                    for (int c = 0; c < 2; ++c)
#pragma unroll
                        for (int s2 = 0; s2 < 2; ++s2)
#pragma unroll
                            for (int r = 0; r < 4; ++r) if (t * 64 + sub * 32 + s2 * 16 + 4 * g + r > qrow) s[sub][c][s2][r] = -INFINITY;
            }
            float mnew[2]; bool grow = false;
#pragma unroll
            for (int c = 0; c < 2; ++c) { float mx = -INFINITY;
#pragma unroll
                for (int sub = 0; sub < 2; ++sub)
#pragma unroll
                    for (int s2 = 0; s2 < 2; ++s2) mx = fmaxf(mx, fmaxf(fmaxf(s[sub][c][s2][0], s[sub][c][s2][1]), fmaxf(s[sub][c][s2][2], s[sub][c][s2][3])));
                mx = xmax16(mx); mx = xmax32(mx);
                mnew[c] = mx > mrun[c] + 8.0f ? mx : mrun[c]; grow = grow || (mnew[c] > mrun[c]); }
            if (__any(grow)) {
#pragma unroll
                for (int c = 0; c < 2; ++c) { const float alpha = __builtin_amdgcn_exp2f(mrun[c] - mnew[c]); mrun[c] = mnew[c]; lsum[c] *= alpha;
#pragma unroll
                    for (int k = 0; k < 8; ++k) o[c][k] = o[c][k] * alpha; }
            }
#pragma unroll
            for (int sub = 0; sub < 2; ++sub) {
                bf16x8 pb[2];
#pragma unroll
                for (int c = 0; c < 2; ++c) { float ps = 0.f;
#pragma unroll
                    for (int s2 = 0; s2 < 2; ++s2)
#pragma unroll
                        for (int r = 0; r < 4; ++r) { const float p = __builtin_amdgcn_exp2f(s[sub][c][s2][r] - mrun[c]); s[sub][c][s2][r] = p; ps += p; }
                    lsum[c] += ps;
                    v4u w; w.x = pg8::cvtpk(s[sub][c][0][0], s[sub][c][0][1]); w.y = pg8::cvtpk(s[sub][c][0][2], s[sub][c][0][3]); w.z = pg8::cvtpk(s[sub][c][1][0], s[sub][c][1][1]); w.w = pg8::cvtpk(s[sub][c][1][2], s[sub][c][1][3]);
                    pb[c] = __builtin_bit_cast(bf16x8, w); }
#pragma unroll
                for (int k = 0; k < 8; ++k) { const bf16x8 vf = *(const LAS bf16x8*)(vb + voffs[sub] + k * 2048);
                    o[0][k] = mfma16(vf, pb[0], o[0][k]); o[1][k] = mfma16(vf, pb[1], o[1][k]); }
            }
        }
    };
    for (int t = 0; t < nt; ++t) {
        if (t + 1 < nt) DA_LOAD(t + 1);
        step(t, t & 1);
        if (t + 1 < nt) DA_STORE((t & 1) ^ 1);
        __syncthreads();
    }
#undef DA_LOAD
#undef DA_STORE
    float l0 = lsum[0], l1 = lsum[1];
    l0 += __shfl_xor(l0, 16); l0 += __shfl_xor(l0, 32); l1 += __shfl_xor(l1, 16); l1 += __shfl_xor(l1, 32);
    const float i0 = 1.0f / l0, i1 = lam / l1; float ss = 0.f;
#pragma unroll
    for (int k = 0; k < 8; ++k)
#pragma unroll
        for (int r = 0; r < 4; ++r) { const float v = o[0][k][r] * i0 - o[1][k][r] * i1; o[0][k][r] = v; ss += v * v; }
    ss += __shfl_xor(ss, 16); ss += __shfl_xor(ss, 32);
    const float rs = rsqrtf(ss * (1.0f / 128.0f) + EPS) * 0.8f;
    bf16* op = CAT + tokq * DM + h * 128 + 4 * g;
#pragma unroll
    for (int k = 0; k < 8; ++k) { const f32x4 gg = *(const f32x4*)(gdiff + k * 16 + 4 * g); f32x4 v = o[0][k] * rs; v = v * gg; pg8::st_bf4(op + k * 16, v); }
}

__device__ __forceinline__ bf16x8 pack8(const f32x4& a, const f32x4& b) { v4u w; w.x = pg8::cvtpk(a[0], a[1]); w.y = pg8::cvtpk(a[2], a[3]); w.z = pg8::cvtpk(b[0], b[1]); w.w = pg8::cvtpk(b[2], b[3]); return __builtin_bit_cast(bf16x8, w); }
constexpr int GL_QI = 0, GL_KI = 8192, GL_IMG = 16384, GL_EL = 2 * GL_IMG, GL_OB = GL_EL + 512, GL_OBS = 17408, GL_PS = GL_OB + 2 * GL_OBS, GL_END = GL_PS + 4096;

__device__ __forceinline__ void gla_unit(Frame& F, const bf16* P, const float* Bc, const bf16* GVT, bf16* CAT, const float* ggla, int b, int h) {
    const int lane = lane_here(), l15 = lane & 15, g = lane >> 4, eb = F.wave, tid = F.tid;
    LAS unsigned char* lds = F.lds + RING_OFF;
    const f32x4 zero4 = {0.f, 0.f, 0.f, 0.f};
    f32x4 S[4] = {zero4, zero4, zero4, zero4};
    bf16x8 If[4];
#pragma unroll
    for (int db = 0; db < 4; ++db) { const int ks = db >> 1;
#pragma unroll
        for (int j = 0; j < 8; ++j) { const int dp = 32 * ks + (j < 4 ? 4 * g + j : 16 + 4 * g + j - 4); If[db][j] = (dp == 16 * db + l15) ? (short)0x3F80 : (short)0; } }
    const int st = tid >> 3, sp = tid & 7, opc = tid & 15;
    const size_t tokb = (size_t)b * SEQ;
    const bf16* qsrc = P + (tokb + st) * PW + 1536 + h * 64 + sp * 8;
    const float* bsrc = Bc + (tokb + st) * 256 + h * 64 + sp * 8;
    const bf16* Vrow = GVT + (size_t)(h * 128 + 16 * eb + l15) * NTOK + tokb + 4 * g;
    const f32x4 gg0 = *(const f32x4*)(ggla + opc * 8), gg1 = *(const f32x4*)(ggla + opc * 8 + 4);
    const int foffs[2] = {l15 * 128 + ((g ^ (l15 >> 1)) * 16), l15 * 128 + (((4 + g) ^ (l15 >> 1)) * 16)};
    const int sfr = (st >> 1) & 7, sch0 = (sp >> 2) * 4 + 2 * (sp & 1), shi = ((sp & 3) >> 1) * 8, sd0 = st * 128 + ((sch0 ^ sfr) * 16) + shi, sd1 = st * 128 + (((sch0 + 1) ^ sfr) * 16) + shi;
    v4u rq = *(const v4u*)qsrc, rk = *(const v4u*)(qsrc + 256); f32x4 rb0 = *(const f32x4*)bsrc, rb1 = *(const f32x4*)(bsrc + 4);
#define GLA_STAGE(par) do { \
        float ee[8]; _Pragma("unroll") for (int i = 0; i < 4; ++i) { ee[i] = __expf(rb0[i]); ee[4 + i] = __expf(rb1[i]); } \
        const unsigned qa[4] = {rq.x, rq.y, rq.z, rq.w}, ka[4] = {rk.x, rk.y, rk.z, rk.w}; v4u wq, wk; unsigned* wqp = (unsigned*)&wq; unsigned* wkp = (unsigned*)&wk; \
        _Pragma("unroll") for (int i = 0; i < 4; ++i) { const float q0 = __builtin_bit_cast(float, qa[i] << 16), q1 = __builtin_bit_cast(float, qa[i] & 0xffff0000u), k0 = __builtin_bit_cast(float, ka[i] << 16), k1 = __builtin_bit_cast(float, ka[i] & 0xffff0000u); \
            wqp[i] = pg8::cvtpk(q0 * ee[2 * i], q1 * ee[2 * i + 1]); wkp[i] = pg8::cvtpk(k0 * __builtin_amdgcn_rcpf(ee[2 * i]), k1 * __builtin_amdgcn_rcpf(ee[2 * i + 1])); } \
        { LAS unsigned char* ib_ = lds + (par) * GL_IMG; *(LAS v2u*)(ib_ + GL_QI + sd0) = (v2u){wq.x, wq.y}; *(LAS v2u*)(ib_ + GL_QI + sd1) = (v2u){wq.z, wq.w}; *(LAS v2u*)(ib_ + GL_KI + sd0) = (v2u){wk.x, wk.y}; *(LAS v2u*)(ib_ + GL_KI + sd1) = (v2u){wk.z, wk.w}; } \
        if (st == 63) { *(LAS f32x4*)(lds + GL_EL + (par) * 256 + sp * 32) = (f32x4){ee[0], ee[1], ee[2], ee[3]}; *(LAS f32x4*)(lds + GL_EL + (par) * 256 + sp * 32 + 16) = (f32x4){ee[4], ee[5], ee[6], ee[7]}; } } while (0)
    bf16x8 VFn[2];
#pragma unroll
    for (int ss = 0; ss < 2; ++ss) { const bf16* vp = Vrow + 32 * ss; const v2u v0 = *(const v2u*)vp, v1 = *(const v2u*)(vp + 16); v4u vv; vv.x = v0.x; vv.y = v0.y; vv.z = v1.x; vv.w = v1.y; VFn[ss] = __builtin_bit_cast(bf16x8, vv); }
    GLA_STAGE(0);
    __syncthreads();
    for (int c = 0; c < SEQ / 64; ++c) {
        const int par = c & 1; const size_t tok0 = tokb + c * 64;
        if (c + 1 < SEQ / 64) { rq = *(const v4u*)(qsrc + (size_t)(c + 1) * 64 * PW); rk = *(const v4u*)(qsrc + (size_t)(c + 1) * 64 * PW + 256);
            rb0 = *(const f32x4*)(bsrc + (size_t)(c + 1) * 64 * 256); rb1 = *(const f32x4*)(bsrc + (size_t)(c + 1) * 64 * 256 + 4); }
        bf16x8 VF[2] = {VFn[0], VFn[1]};
        if (c + 1 < SEQ / 64) {
#pragma unroll
            for (int ss = 0; ss < 2; ++ss) { const bf16* vp = Vrow + (c + 1) * 64 + 32 * ss; const v2u v0 = *(const v2u*)vp, v1 = *(const v2u*)(vp + 16); v4u vv; vv.x = v0.x; vv.y = v0.y; vv.z = v1.x; vv.w = v1.y; VFn[ss] = __builtin_bit_cast(bf16x8, vv); } }
        v4u rg[2];
#pragma unroll
        for (int i = 0; i < 2; ++i) rg[i] = *(const v4u*)(P + (tok0 + ((tid + 512 * i) >> 4)) * PW + 2560 + h * 128 + opc * 8);
        const LAS unsigned char* qi = lds + par * GL_IMG + GL_QI; const LAS unsigned char* ki = lds + par * GL_IMG + GL_KI;
        bf16x8 qf[4][2], kf[4][2];
#pragma unroll
        for (int blk = 0; blk < 4; ++blk)
#pragma unroll
            for (int ks = 0; ks < 2; ++ks) { qf[blk][ks] = *(const LAS bf16x8*)(qi + foffs[ks] + blk * 2048); kf[blk][ks] = *(const LAS bf16x8*)(ki + foffs[ks] + blk * 2048); }
        const bf16x8 SF0 = pack8(S[0], S[1]), SF1 = pack8(S[2], S[3]);
        f32x4 O[4];
#pragma unroll
        for (int tb = 0; tb < 4; ++tb) { f32x4 o = mfma16(qf[tb][0], SF0, zero4); o = mfma16(qf[tb][1], SF1, o);
#pragma unroll
            for (int ss = 0; ss < 2; ++ss) if (2 * ss <= tb) { f32x4 a2[2];
#pragma unroll
                for (int hh = 0; hh < 2; ++hh) { const int sb = 2 * ss + hh; f32x4 a = zero4;
                    if (sb <= tb) { a = mfma16(kf[sb][0], qf[tb][0], zero4); a = mfma16(kf[sb][1], qf[tb][1], a);
                        if (sb == tb) {
#pragma unroll
                            for (int r = 0; r < 4; ++r) if (4 * g + r > l15) a[r] = 0.f; } }
                    a2[hh] = a; }
                o = mfma16(pack8(a2[0], a2[1]), VF[ss], o); }
            O[tb] = o; }
#pragma unroll
        for (int db = 0; db < 4; ++db) { f32x4 u = S[db];
#pragma unroll
            for (int ss = 0; ss < 2; ++ss) { const f32x4 t0 = mfma16(kf[2 * ss][db >> 1], If[db], zero4), t1 = mfma16(kf[2 * ss + 1][db >> 1], If[db], zero4); u = mfma16(pack8(t0, t1), VF[ss], u); }
            const f32x4 el = *(const LAS f32x4*)(lds + GL_EL + par * 256 + (16 * db + 4 * g) * 4);
            S[db] = u * el; }
        LAS unsigned char* ob = lds + GL_OB + par * GL_OBS; LAS float* ps = (LAS float*)(lds + GL_PS + par * 2048);
#pragma unroll
        for (int tb = 0; tb < 4; ++tb)
#pragma unroll
            for (int r = 0; r < 4; ++r) { const int t = 16 * tb + 4 * g + r; const float ov = O[tb][r]; float q = ov * ov; q += __shfl_xor(q, 1); q += __shfl_xor(q, 2); q += __shfl_xor(q, 4); q += __shfl_xor(q, 8);
                if (l15 == 0) ps[t * 8 + eb] = q;
                *(LAS bf16*)(ob + t * 272 + (16 * eb + l15) * 2) = (bf16)f2bf(ov); }
        if (c + 1 < SEQ / 64) GLA_STAGE(par ^ 1);
        __syncthreads();
#pragma unroll
        for (int i = 0; i < 2; ++i) { const int ot = (tid + 512 * i) >> 4; const f32x4 p0 = *(const LAS f32x4*)(ps + ot * 8), p1 = *(const LAS f32x4*)(ps + ot * 8 + 4);
            const float ss = ((p0[0] + p0[1]) + (p0[2] + p0[3])) + ((p1[0] + p1[1]) + (p1[2] + p1[3])); const float rs = rsqrtf(ss * (1.0f / 128.0f) + EPS);
            const v4u ov = *(const LAS v4u*)(ob + ot * 272 + opc * 16); const unsigned oa[4] = {ov.x, ov.y, ov.z, ov.w}, ga[4] = {rg[i].x, rg[i].y, rg[i].z, rg[i].w};
            const float gn[8] = {gg0[0], gg0[1], gg0[2], gg0[3], gg1[0], gg1[1], gg1[2], gg1[3]}; v4u w; unsigned* wp = (unsigned*)&w;
#pragma unroll
            for (int j = 0; j < 4; ++j) { const float o0 = __builtin_bit_cast(float, oa[j] << 16), o1 = __builtin_bit_cast(float, oa[j] & 0xffff0000u), g0 = __builtin_bit_cast(float, ga[j] << 16), g1 = __builtin_bit_cast(float, ga[j] & 0xffff0000u);
                wp[j] = pg8::cvtpk(o0 * rs * gn[2 * j] * (g0 / (1.0f + __expf(-g0))), o1 * rs * gn[2 * j + 1] * (g1 / (1.0f + __expf(-g1)))); }
            *(v4u*)(CAT + (tok0 + ot) * DM + 512 + h * 128 + opc * 8) = w; }
    }
#undef GLA_STAGE
    __syncthreads();
}

__device__ __forceinline__ void router_phase(Frame& F, const bf16* X2, const float* WR, const float* b_router, float* rsl, float* gate, unsigned* assign, unsigned* list, gu32* cnt) {
    LAS float* xs = (LAS float*)(F.lds + RING_OFF);
    LAS float* wsh = xs + 128 * 129;
    LAS float* lg = wsh + 128 * 32;
    LAS unsigned* hist = (LAS unsigned*)(lg + 128 * 33);
    const int tid = F.tid, t = tid & 63, eg = tid >> 6;
    for (int blk = F.vcu; blk < NTOK / 128; blk += F.G) {
        const size_t tok0 = (size_t)blk * 128;
        f32x4 acc0 = (f32x4){0.f, 0.f, 0.f, 0.f}, acc1 = acc0; float ssq0 = 0.f, ssq1 = 0.f;
        v4u rx[4]; f32x4 rw[2];
#define RT_LOAD(kc) do { _Pragma("unroll") for (int i = 0; i < 4; ++i) rx[i] = *(const v4u*)(X2 + (tok0 + (tid >> 4) + 32 * i) * DM + (kc) + (tid & 15) * 8); \
        _Pragma("unroll") for (int i = 0; i < 2; ++i) rw[i] = *(const f32x4*)(WR + (size_t)(kc) * 32 + (i * 512 + tid) * 4); } while (0)
        RT_LOAD(0);
        for (int kc = 0; kc < DM; kc += 128) {
#pragma unroll
            for (int i = 0; i < 4; ++i) { LAS float* dp = xs + ((tid >> 4) + 32 * i) * 129 + (tid & 15) * 8; const unsigned wv[4] = {rx[i].x, rx[i].y, rx[i].z, rx[i].w};
#pragma unroll
                for (int j = 0; j < 4; ++j) { dp[2 * j] = __builtin_bit_cast(float, wv[j] << 16); dp[2 * j + 1] = __builtin_bit_cast(float, wv[j] & 0xffff0000u); } }
#pragma unroll
            for (int i = 0; i < 2; ++i) *(LAS f32x4*)(wsh + (i * 512 + tid) * 4) = rw[i];
            __syncthreads();
            if (kc + 128 < DM) RT_LOAD(kc + 128);
            const LAS float* xr0 = xs + t * 129; const LAS float* xr1 = xs + (t + 64) * 129;
#pragma unroll 8
            for (int k = 0; k < 128; ++k) { const float x0 = xr0[k], x1 = xr1[k]; const f32x4 w = *(const LAS f32x4*)(wsh + k * 32 + eg * 4); acc0 = acc0 + w * x0; acc1 = acc1 + w * x1; ssq0 += x0 * x0; ssq1 += x1 * x1; }
            __syncthreads();
        }
#undef RT_LOAD
        const float rs0 = rsqrtf(ssq0 * (1.0f / DM) + EPS), rs1 = rsqrtf(ssq1 * (1.0f / DM) + EPS);
#pragma unroll
        for (int i = 0; i < 4; ++i) { const float br = b_router[eg * 4 + i]; lg[t * 33 + eg * 4 + i] = acc0[i] * rs0 + br; lg[(t + 64) * 33 + eg * 4 + i] = acc1[i] * rs1 + br; }
        if (eg == 0) { lg[t * 33 + 32] = rs0; lg[(t + 64) * 33 + 32] = rs1; }
        __syncthreads();
        if (tid < 128) {
            const int w2 = tid >> 6;
            float lv[32];
#pragma unroll
            for (int e = 0; e < 32; ++e) lv[e] = lg[tid * 33 + e];
            const float rs = lg[tid * 33 + 32];
            float tv[4]; int te[4];
#pragma unroll
            for (int k = 0; k < 4; ++k) { float best = -INFINITY; int bi = 0;
#pragma unroll
                for (int e = 0; e < 32; ++e) if (lv[e] > best) { best = lv[e]; bi = e; }
                tv[k] = best; te[k] = bi;
#pragma unroll
                for (int e = 0; e < 32; ++e) if (e == bi) lv[e] = -INFINITY; }
            const float e1 = __expf(tv[1] - tv[0]), e2 = __expf(tv[2] - tv[0]), e3 = __expf(tv[3] - tv[0]); const float inv = 1.0f / (1.0f + e1 + e2 + e3);
            const float gv[4] = {inv, e1 * inv, e2 * inv, e3 * inv};
            const size_t tok = tok0 + tid;
            LAS unsigned* hs = hist + w2 * 32; LAS unsigned* gbase = hist + 64 + w2 * 32;
            if (t < 32) hs[t] = 0u;
            __builtin_amdgcn_wave_barrier(); LDS_WAIT();
            unsigned lpos[4];
#pragma unroll
            for (int k = 0; k < 4; ++k) lpos[k] = __hip_atomic_fetch_add(hs + te[k], 1u, __ATOMIC_RELAXED, __HIP_MEMORY_SCOPE_WORKGROUP);
            __builtin_amdgcn_wave_barrier(); LDS_WAIT();
            if (t < 32) { const unsigned n = hs[t]; gbase[t] = n ? __hip_atomic_fetch_add(cnt + 64 * t, n, RLX_AGENT) : 0u; }
            __builtin_amdgcn_wave_barrier(); LDS_WAIT();
#pragma unroll
            for (int k = 0; k < 4; ++k) { const unsigned pos = gbase[te[k]] + lpos[k]; list[(size_t)te[k] * NTOK + pos] = (unsigned)tok; rsl[(size_t)te[k] * NTOK + pos] = rs;
                assign[tok * 4 + k] = ((unsigned)te[k] << 16) | pos; gate[tok * 4 + k] = gv[k]; }
        }
        __syncthreads();
    }
}
__device__ __forceinline__ int moe_tables(Frame& F) {
    LAS unsigned char* tile_e = F.lds + TAB_OFF; LAS int* tstart = (LAS int*)(F.lds + TAB_TSTART); LAS int* lc = (LAS int*)(F.lds + TAB_CNT);
    if (F.tid < 32) lc[F.tid] = (int)__hip_atomic_load(F.ctl + CW_CNT + 64 * F.tid, RLX_AGENT);
    __syncthreads();
    if (F.tid == 0) { int s = 0; for (int e = 0; e < 32; ++e) { tstart[e] = s; s += (lc[e] + 255) >> 8; } tstart[32] = s; }
    __syncthreads();
    const int T = tstart[32];
    for (int i = F.tid; i < T; i += 512) { int e = 0;
#pragma unroll
        for (int k = 1; k < 32; ++k) e += (tstart[k] <= i) ? 1 : 0;
        tile_e[i] = (unsigned char)e; }
    __syncthreads();
    return T;
}
__device__ __forceinline__ void final_phase(Frame& F, const bf16* X2, float* out, const unsigned char* Y, const float* gate, const unsigned* assign, const float* gfin) {
    (void)moe_tables(F);
    const LAS int* tstart = (const LAS int*)(F.lds + TAB_TSTART);
    const int gw = F.vcu * NWAVES + F.wave, NGW = F.G * NWAVES, lane = lane_here();
    for (int tok = gw; tok < NTOK; tok += NGW) {
        f32x4* xr = (f32x4*)(out + (size_t)tok * DM) + lane; f32x4 v[4]; const v2u* xin = (const v2u*)(X2 + (size_t)tok * DM) + lane;
#pragma unroll
        for (int j = 0; j < 4; ++j) { const v2u w = xin[64 * j]; v[j] = (f32x4){__builtin_bit_cast(float, w.x << 16), __builtin_bit_cast(float, w.x & 0xffff0000u), __builtin_bit_cast(float, w.y << 16), __builtin_bit_cast(float, w.y & 0xffff0000u)}; }
#pragma unroll
        for (int k = 0; k < 4; ++k) { const unsigned a = assign[(size_t)tok * 4 + k]; const float gk = gate[(size_t)tok * 4 + k]; const size_t row = (size_t)tstart[a >> 16] * 256 + (a & 0xffffu);
            const unsigned* yr = (const unsigned*)(Y + row * DM) + lane;
#pragma unroll
            for (int j = 0; j < 4; ++j) { const unsigned w = yr[64 * j]; const auto lo = __builtin_amdgcn_cvt_pk_f32_fp8((int)w, false), hi = __builtin_amdgcn_cvt_pk_f32_fp8((int)w, true);
                v[j].x += gk * lo[0]; v[j].y += gk * lo[1]; v[j].z += gk * hi[0]; v[j].w += gk * hi[1]; } }
        float s = 0.f;
#pragma unroll
        for (int j = 0; j < 4; ++j) s += (v[j].x * v[j].x + v[j].y * v[j].y) + (v[j].z * v[j].z + v[j].w * v[j].w);
        const float rs = rsqrtf(wave_sum(s) * (1.0f / DM) + EPS);
#pragma unroll
        for (int j = 0; j < 4; ++j) { const f32x4 gg = ((const f32x4*)gfin)[lane + 64 * j]; xr[64 * j] = v[j] * rs * gg; }
    }
}

constexpr int NPHASE = 12;
struct Args { const void* in[28]; float* out; unsigned char* ws; int ph_lo, ph_hi; };
__global__ void __launch_bounds__(NWAVES * 64, 2) mk_fwd(Args args) {
    extern __shared__ __attribute__((aligned(16))) unsigned char lds[];
    Frame F;
    F.lds = (LAS unsigned char*)lds;
    F.MISC = (volatile LAS unsigned*)(F.lds + MISC_OFF);
    F.tid = threadIdx.x; F.lane = F.tid & 63; F.wave = __builtin_amdgcn_readfirstlane(F.tid >> 6);
    F.G = gridDim.x; { const int bx = blockIdx.x; F.vcu = (F.G % 8 == 0) ? (bx % 8) * (F.G / 8) + bx / 8 : bx; }
    F.ws = args.ws; F.out = args.out; F.ctl = (gu32*)(args.ws + WS_CTL);
    unsigned char* ws = args.ws;
    typedef const void* const volatile __attribute__((address_space(4))) kargp_t;
    kargp_t* const kargs = (kargp_t*)__builtin_amdgcn_kernarg_segment_ptr();
#define INP(k) ((const float*)kargs[k])
    for (int u = F.tid; u < (LDS_BYTES - LDSCTL_OFF) / 4; u += NWAVES * 64) ((LAS unsigned*)(F.lds + LDSCTL_OFF))[u] = 0u;
    __syncthreads();
    const int lo = args.ph_lo, hi = args.ph_hi;
    const bool single = (hi - lo) > 1;
    XcdBarrier bar; bar.bar = (unsigned*)(F.ctl + CW_BAR); bar.x = 0; bar.st = nullptr;
    if (single) bar = xcd_barrier_post((unsigned*)(F.ctl + CW_BAR), F.MISC + 8);
#define IN(k) (lo <= (k) && (k) < hi)
#if defined(PROBE_K0)
    LAS unsigned long long* tsl = (LAS unsigned long long*)(F.lds + TS_OFF);
    if (F.tid == 0) tsl[0] = rt();
#define SEAM(k) do { if (IN(k) && IN((k) + 1)) xcd_barrier(bar); if (F.tid == 0) tsl[(k) + 1] = rt(); } while (0)
#define SEAM_LOCAL(k) do { if (F.tid == 0) tsl[(k) + 1] = rt(); } while (0)
#else
#define SEAM(k) do { if (IN(k) && IN((k) + 1)) xcd_barrier(bar); } while (0)
#define SEAM_LOCAL(k) do { } while (0)
#endif
    typedef pg8::bf16_t hb;
    const int bx = (int)blockIdx.x;

    if (IN(0)) { In I;
        I.x = (const float*)INP(0);
        I.mem = (const float*)INP(1);
        I.positions = (const int*)INP(2);
        I.norm_mix_g = (const float*)INP(3);
        I.w_in = (const float*)INP(4);
        I.lq1 = (const float*)INP(5);
        I.lk1 = (const float*)INP(6);
        I.lq2 = (const float*)INP(7);
        I.lk2 = (const float*)INP(8);
        I.diff_norm_g = (const float*)INP(9);
        I.w_alpha2 = (const float*)INP(10);
        I.b_alpha = (const float*)INP(11);
        I.gla_norm_g = (const float*)INP(12);
        I.w_out = (const float*)INP(13);
        I.norm_cross_g = (const float*)INP(14);
        I.norm_mem_g = (const float*)INP(15);
        I.w_cq = (const float*)INP(16);
        I.w_ck = (const float*)INP(17);
        I.w_cv = (const float*)INP(18);
        I.w_co = (const float*)INP(19);
        I.norm_ffn_g = (const float*)INP(20);
        I.w_router = (const float*)INP(21);
        I.b_router = (const float*)INP(22);
        I.w_up = (const float*)INP(23);
        I.b_up = (const float*)INP(24);
        I.w_down = (const float*)INP(25);
        I.b_down = (const float*)INP(26);
        I.norm_final_g = (const float*)INP(27);
        p0_prologue(F, I); }
    SEAM(0);
    if (IN(1)) {
        pg8::Gemm g{(const hb*)(ws + WS_HN), (const hb*)(ws + WS_WINT), NTOK, 3328, DM, DM, DM, 127, 127};
        typedef pg8::OrderP1<(unsigned)WS_HN, (unsigned)WS_WINT, (unsigned)WS_MN, (unsigned)WS_WCK, (unsigned)WS_WCV> OrdP1; OrdP1 S; S.G = F.G; S.c = bx; S.ws = (const char*)ws;
        pg8::EpiP1 E{pg8::EpiProj{(hb*)(ws + WS_P), (float*)(ws + WS_LA), (const float*)(ws + WS_CS), INP(11)}, pg8::EpiPlain{(hb*)(ws + WS_VT) - (size_t)1024 * NTOK, NTOK, 1.0f},
                     pg8::EpiPlain{(hb*)(ws + WS_KX), DM, 1.0f}, pg8::EpiPlain{(hb*)(ws + WS_VXT), NMEM, 1.0f}};
        pg8::gemm_phase<pg8::EpiP1, OrdP1, true, true, false, false>(F.lds + RING_OFF, g, S, E);
    }
    SEAM(1);
    if (IN(2)) {
        float lam;
        { const int ln = lane_here(); const float a = INP(5)[ln] * INP(6)[ln], c = INP(7)[ln] * INP(8)[ln]; lam = __expf(wave_sum(a)) - __expf(wave_sum(c)) + 0.2f; }
        LAS int* qslot = (LAS int*)(F.lds + TAB_OFF);
        for (;;) {
            if (F.tid == 0) qslot[0] = (int)__hip_atomic_fetch_add(F.ctl + CW_Q2, 1u, RLX_AGENT);
            __syncthreads();
            const int u = qslot[0];
            __syncthreads();
            if (u >= 64 + 1024 + MOE_UNITS) break;
            if (u >= 64 + 1024) { moe_convert_unit(u - (64 + 1024), INP(23), INP(25), INP(20), ws, F.wave, lane_here()); continue; }
#if defined(PROBE_SPLIT)
            if (u < 64) continue;
#endif
            if (u < 64) { gla_unit(F, (const bf16*)(ws + WS_P), (const float*)(ws + WS_LA), (const bf16*)(ws + WS_GVT), (bf16*)(ws + WS_CAT), INP(12), u >> 2, u & 3);
            }
            else { const int v = u - 64, bh = v & 63, qb = 15 - (v >> 6);
                diffattn_unit(F, (const bf16*)(ws + WS_P), (const bf16*)(ws + WS_VT), (bf16*)(ws + WS_CAT), INP(9), lam, bh >> 2, bh & 3, qb); }
        }
    }
#if defined(PROBE_SPLIT)
    if (IN(2)) { xcd_barrier(bar); if (F.tid == 0) tsl[13] = rt();
        for (int u = F.vcu; u < 64; u += F.G) gla_unit(F, (const bf16*)(ws + WS_P), (const float*)(ws + WS_LA), (const bf16*)(ws + WS_GVT), (bf16*)(ws + WS_CAT), INP(12), u >> 2, u & 3); }
#endif
    SEAM(2);
    if (IN(3)) {
        pg8::Gemm g{(const hb*)(ws + WS_CAT), (const hb*)(ws + WS_WOUT), NTOK, DM, DM, DM, DM, 127, 127}; pg8::StaticOrder S; S.init(NTOK, DM, F.G, bx);
        pg8::EpiRes1 E{INP(0), (hb*)(ws + WS_X1B), (float*)(ws + WS_SSP1)};
        pg8::gemm_phase<pg8::EpiRes1, pg8::StaticOrder, true, true, false, false>(F.lds + RING_OFF, g, S, E);
    }
    SEAM(3);
    if (IN(4)) {
        pg8::Gemm g{(const hb*)(ws + WS_X1B), (const hb*)(ws + WS_WCQ), NTOK, DM, DM, DM, DM, 127, 127}; pg8::StaticOrder S; S.init(NTOK, DM, F.G, bx);
        pg8::EpiQX E{(hb*)(ws + WS_QX), (const float*)(ws + WS_SSP1)};
        pg8::gemm_phase<pg8::EpiQX, pg8::StaticOrder, true, true, false, false>(F.lds + RING_OFF, g, S, E);
    }
    SEAM_LOCAL(4);
    if (IN(5)) {
        pg8::Gemm g{(const hb*)(ws + WS_QX), (const hb*)(ws + WS_KX), NTOK, 256, 256, DM, DM, 127, 127}; pg8::OrderX1 S; S.init(F.G, bx);
        pg8::EpiSoftmax E{(hb*)(ws + WS_PX), (float*)(ws + WS_SSP1), (PG8_LAS float*)(F.lds + XCH_OFF)};
        pg8::gemm_phase<pg8::EpiSoftmax, pg8::OrderX1, true, true>(F.lds + RING_OFF, g, S, E);
    }
    SEAM_LOCAL(5);
    if (IN(6)) {
        pg8::Gemm g{(const hb*)(ws + WS_PX), (const hb*)(ws + WS_VXT), NTOK, 256, 256, DM, NMEM, 127, 127}; pg8::OrderX2 S; S.init(F.G, bx);
        pg8::EpiPV E{(hb*)(ws + WS_OX), (const float*)(ws + WS_SSP1)};
        pg8::gemm_phase<pg8::EpiPV, pg8::OrderX2, true, true>(F.lds + RING_OFF, g, S, E);
    }
    SEAM(6);
    if (IN(7)) {
        pg8::Gemm g{(const hb*)(ws + WS_OX), (const hb*)(ws + WS_WCO), NTOK, DM, DM, DM, DM, 127, 127}; pg8::StaticOrder S; S.init(NTOK, DM, F.G, bx);
        pg8::EpiRes2 E{(hb*)(ws + WS_X1B), ws + WS_X2B};
        pg8::gemm_phase<pg8::EpiRes2, pg8::StaticOrder, true, true, false, false>(F.lds + RING_OFF, g, S, E);
    }
    SEAM(7);
    if (IN(8)) router_phase(F, (const bf16*)(ws + WS_X1B), (const float*)(ws + WS_WR), INP(22), (float*)(ws + WS_RSL), (float*)(ws + WS_GATE), (unsigned*)(ws + WS_ASSIGN), (unsigned*)(ws + WS_LIST), F.ctl + CW_CNT);
    SEAM(8);
    if (IN(9)) {
        const int T = moe_tables(F);
        pg8::Gemm g{(const hb*)(ws + WS_X2B), (const hb*)(ws + WS_WUP), T * 256, NEXP * 2048, 512, 512, 512, 127, 122}; pg8::MoeOrderG S;
        S.init(T, 8, F.G, bx, (const PG8_LAS unsigned char*)(F.lds + TAB_OFF), (const PG8_LAS int*)(F.lds + TAB_TSTART), (const PG8_LAS int*)(F.lds + TAB_CNT), (const unsigned*)(ws + WS_LIST), (PG8_LAS unsigned*)(F.lds + XCH_OFF));
        pg8::EpiUp E{ws + WS_ACT, (const float*)(ws + WS_RSL), (const PG8_LAS int*)(F.lds + TAB_TSTART), (const PG8_LAS int*)(F.lds + TAB_CNT), INP(24)};
        pg8::gemm_phase<pg8::EpiUp, pg8::MoeOrderG, true, true, true, false>(F.lds + RING_OFF, g, S, E);
    }
    SEAM(9);
    if (IN(10)) {
        const int T = moe_tables(F);
        pg8::Gemm g{(const hb*)(ws + WS_ACT), (const hb*)(ws + WS_WDN), T * 256, NEXP * 1024, 512, 512, 512, 127, 122}; pg8::MoeOrder S; S.init(T, 4, F.G, bx, (const PG8_LAS unsigned char*)(F.lds + TAB_OFF));
        pg8::EpiDown E{ws + WS_Y, INP(26)};
        pg8::gemm_phase<pg8::EpiDown, pg8::MoeOrder, true, true, true, false>(F.lds + RING_OFF, g, S, E);
    }
    SEAM(10);
    if (IN(11)) final_phase(F, (const bf16*)(ws + WS_X1B), F.out, (const unsigned char*)(ws + WS_Y), (const float*)(ws + WS_GATE), (const unsigned*)(ws + WS_ASSIGN), INP(27));
#if defined(PROBE_K0)
    { if (F.tid == 0) { tsl[NPHASE] = rt();
        const int ks[2] = {PROBE_K0, PROBE_K1}; unsigned long long code = 0, mul = 1;
        for (int i = 0; i < 2; ++i) { unsigned long long dt = ks[i] == 97 ? tsl[13] - tsl[2] : ks[i] == 98 ? tsl[3] - tsl[13] : tsl[ks[i] + 1] - tsl[ks[i]]; unsigned long long q = (dt + 800) / 1600; if (q > 63) q = 63; code += q * mul; mul *= 64; }
        tsl[15] = code * 6400ull; }
      __syncthreads();
      const unsigned long long t0 = rt(), wait = tsl[15]; float x = (float)F.tid, y = 1.0001f;
      while (rt() - t0 < wait) {
#pragma unroll
          for (int i = 0; i < 64; ++i) x = x * y + 0.5f; }
      if (x == 12345.678f) F.out[0] = x; }
#endif
#undef IN
#undef SEAM
#undef SEAM_LOCAL
}

#ifndef MK_N_LAUNCHES
#define MK_N_LAUNCHES 1
#endif
extern "C" void kernel_launch(void* const* d_in, const int* in_sizes, int n_in, void* d_out, int out_size, void* d_ws, size_t ws_size, hipStream_t stream) {
    static int grid = 0;
    if (grid == 0) {
        if (n_in != 28 || out_size != NTOK * DM || ws_size < WS_END) { fprintf(stderr, "kernel_launch: unexpected shapes: n_in %d out %d ws %zu (need %zu)\n", n_in, out_size, ws_size, (size_t)WS_END); grid = -1; return; }
        int dev = 0, cus = 0, per_cu = 0;
        if (hipGetDevice(&dev) != hipSuccess || hipDeviceGetAttribute(&cus, hipDeviceAttributeMultiprocessorCount, dev) != hipSuccess) { fprintf(stderr, "kernel_launch: device query failed\n"); grid = -1; return; }
        if (hipFuncSetAttribute((const void*)mk_fwd, hipFuncAttributeMaxDynamicSharedMemorySize, LDS_BYTES) != hipSuccess) { fprintf(stderr, "kernel_launch: hipFuncSetAttribute failed\n"); grid = -1; return; }
        if (hipOccupancyMaxActiveBlocksPerMultiprocessor(&per_cu, (const void*)mk_fwd, NWAVES * 64, LDS_BYTES) != hipSuccess || per_cu < 1) { fprintf(stderr, "kernel_launch: occupancy query reports %d workgroups per CU\n", per_cu); (void)hipGetLastError(); grid = -1; return; }
        grid = cus;
    }
    if (grid < 0) return;
    (void)hipMemsetAsync((char*)d_ws + WS_CTL, 0, CTL_ZERO_BYTES, stream);
    Args a{};
    for (int i = 0; i < 28; ++i) a.in[i] = d_in[i];
    a.out = (float*)d_out; a.ws = (unsigned char*)d_ws;
    if (MK_N_LAUNCHES == 1) { a.ph_lo = 0; a.ph_hi = NPHASE; hipLaunchKernelGGL(mk_fwd, dim3(grid), dim3(NWAVES * 64), LDS_BYTES, stream, a); }
    else for (int p = 0; p < NPHASE; ++p) { a.ph_lo = p; a.ph_hi = p + 1; hipLaunchKernelGGL(mk_fwd, dim3(grid), dim3(NWAVES * 64), LDS_BYTES, stream, a); }
}
```

```cpp
#include <hip/hip_runtime.h>
#include <cstdio>
#include <cstdint>
namespace pg8 {
#define PG8_LAS __attribute__((address_space(3)))
typedef unsigned short bf16_t;
typedef short bf16x8 __attribute__((ext_vector_type(8)));
typedef float f32x4 __attribute__((ext_vector_type(4)));
typedef unsigned u32x4 __attribute__((ext_vector_type(4)));
constexpr int BM = 256, BK = 64, HALF = 128, HTB = HALF * BK * 2  , STAGE_BYTES = 8 * HTB, NXCD = 8, WGM = 8;

__host__ __device__ __forceinline__ int lds_byte(int r, int c) { const int st = (r >> 4) * 2 + (c >> 5), rr = r & 15, cc = c & 31, ob = rr * 64 + cc * 2; return st * 1024 + (ob ^ (((ob >> 9) & 1) << 5)); }
__host__ __device__ __forceinline__ void stage_rc(int b, int& R, int& C) { const int st = b / 1024, sb = b % 1024, swz = sb ^ (((sb >> 9) & 1) << 5); R = (st >> 1) * 16 + swz / 64; C = (st & 1) * 32 + (swz % 64) / 2; }
__host__ __device__ __forceinline__ int perm32(int rho) { const int n = rho >> 4, i = rho & 15; return 8 * (i >> 2) + 4 * n + (i & 3); }

struct Unit { int pm, pn; };
struct Gemm { const bf16_t* A; const bf16_t* Bt; int M, N, K, lda, ldb, sa, sb; };
struct OrderBase {
    static constexpr bool GATHER = false;
    __device__ __forceinline__ const char* a_base(const Gemm& g, const Unit& u) const { return (const char*)g.A + (size_t)u.pm * 256 * g.lda * 2; }
    __device__ __forceinline__ const char* b_base(const Gemm& g, const Unit& u) const { return (const char*)g.Bt + (size_t)u.pn * 256 * g.ldb * 2; }
    __device__ __forceinline__ void a_ready(const Unit&) const {}
    __device__ __forceinline__ void done(const Unit&) const {}
};

struct StaticOrder : OrderBase {
    int nM, nN, nwg, G, c;
    __host__ __device__ void init(int M, int N, int G_, int c_) { nM = M / BM; nN = N / BM; nwg = nM * nN; G = G_; c = c_; }
    __host__ __device__ bool next(int i, Unit& u) const {
        const long L = (long)i * G + c; if (L >= nwg) return false;
        int wgid = (int)L; { const int q = nwg / NXCD, r = nwg % NXCD, xcd = wgid % NXCD, off = wgid / NXCD; wgid = (xcd < r ? xcd * (q + 1) : r * (q + 1) + (xcd - r) * q) + off; }
        const int nig = WGM * nN, gid = wgid / nig, fm = gid * WGM, gsz = (nM - fm) < WGM ? (nM - fm) : WGM;
        u.pm = fm + ((wgid % nig) % gsz); u.pn = (wgid % nig) / gsz; return true;
    }
};

typedef unsigned u32x2 __attribute__((ext_vector_type(2)));
typedef float f32x2_t __attribute__((ext_vector_type(2)));
typedef __bf16 bf16x2_t __attribute__((ext_vector_type(2)));
__device__ __forceinline__ unsigned cvtpk(float lo, float hi) { f32x2_t v = {lo, hi}; bf16x2_t b = __builtin_convertvector(v, bf16x2_t); return __builtin_bit_cast(unsigned, b); }
__device__ __forceinline__ void st_bf4(bf16_t* p, f32x4 v) { u32x2 w; w.x = cvtpk(v[0], v[1]); w.y = cvtpk(v[2], v[3]); *(u32x2*)p = w; }
__device__ __forceinline__ unsigned cvt4_fp8(f32x4 v) { unsigned w = __builtin_amdgcn_cvt_pk_fp8_f32(v[0], v[1], 0, false); return __builtin_amdgcn_cvt_pk_fp8_f32(v[2], v[3], w, true); }
__device__ __forceinline__ void st_bf8(bf16_t* p, f32x4 a, f32x4 c) { u32x4 w; w.x = cvtpk(a[0], a[1]); w.y = cvtpk(a[2], a[3]); w.z = cvtpk(c[0], c[1]); w.w = cvtpk(c[2], c[3]); *(u32x4*)p = w; }
__device__ __forceinline__ float bf2f(bf16_t b) { return __builtin_bit_cast(float, (unsigned)b << 16); }
#define EPI_ROWS _Pragma("unroll") for (int ai = 0; ai < 2; ++ai) _Pragma("unroll") for (int m = 0; m < 4; ++m)
#define EPI_COLS _Pragma("unroll") for (int bj = 0; bj < 2; ++bj) _Pragma("unroll") for (int n = 0; n < 2; ++n)
constexpr float LOG2E = 1.4426950408889634f;
constexpr float QSCALE_DA = 0.125f * LOG2E;
constexpr float QSCALE_X = 0.0625f * LOG2E;

struct EpiPlain {
    static constexpr bool PERM = true, AFTER_DRAIN = false;
    bf16_t* O; int ldc; float scale;
    __device__ __forceinline__ void operator()(const f32x4 (&acc)[2][2][4][2], const Unit& u, int wr, int wc, int fr, int fq) const {
        EPI_ROWS { const int row = u.pm * 256 + ai * 128 + wr * 64 + m * 16 + fr; bf16_t* rp = O + (size_t)row * ldc + u.pn * 256 + wc * 32 + fq * 8;
            _Pragma("unroll") for (int bj = 0; bj < 2; ++bj) st_bf8(rp + bj * 128, acc[ai][bj][m][0] * scale, acc[ai][bj][m][1] * scale); }
    }
};
struct EpiProj {
    static constexpr bool PERM = true, AFTER_DRAIN = false;
    bf16_t* P; float* LA; const float* cs; const float* b_alpha;
    template <int ai> __device__ __forceinline__ void decay_rows(const f32x4 (&acc)[2][2][4][2], const Unit& u, int wr, int wc, int fr, int fq) const {
        const int row0 = u.pm * 256 + ai * 128 + wr * 64 + fr;
        EPI_COLS { const int col = bj * 128 + wc * 32 + fq * 8 + n * 4; const f32x4 ba = *(const f32x4*)(b_alpha + col); f32x4 run = {0.f, 0.f, 0.f, 0.f};
            _Pragma("unroll") for (int m = 0; m < 4; ++m) { const f32x4 z = acc[ai][bj][m][n] + ba; f32x4 o;
                _Pragma("unroll") for (int i = 0; i < 4; ++i) { float v = (fminf(z[i], 0.f) - __logf(1.0f + __expf(-fabsf(z[i])))) * 0.0625f;
                    { float t = __shfl_up(v, 1, 16); if (fr >= 1) v += t; t = __shfl_up(v, 2, 16); if (fr >= 2) v += t; t = __shfl_up(v, 4, 16); if (fr >= 4) v += t; t = __shfl_up(v, 8, 16); if (fr >= 8) v += t; }
                    o[i] = v + run[i]; run[i] += __shfl(v, 15, 16); }
                *(f32x4*)(LA + (size_t)(row0 + m * 16) * 256 + col) = o; } }
    }
    __device__ __forceinline__ void operator()(const f32x4 (&acc)[2][2][4][2], const Unit& u, int wr, int wc, int fr, int fq) const {
        const int pn = u.pn;
        if (pn < 4) {
            const float sc = pn < 2 ? QSCALE_DA : 1.0f; const bool ropew = (wc & 1) == 0; const bool rl = fq < 2, hi = fq == 1;
            EPI_ROWS { const int row = u.pm * 256 + ai * 128 + wr * 64 + m * 16 + fr; bf16_t* rp = P + (size_t)row * 3072 + pn * 256 + wc * 32 + fq * 8;
                f32x4 cv[2], sv[2];
                if (ropew) { const f32x4* cp = (const f32x4*)(cs + (size_t)row * 16); cv[0] = cp[0]; cv[1] = cp[1]; sv[0] = cp[2]; sv[1] = cp[3]; }
                _Pragma("unroll") for (int bj = 0; bj < 2; ++bj) { f32x4 v[2] = {acc[ai][bj][m][0], acc[ai][bj][m][1]};
                    if (ropew) { _Pragma("unroll") for (int n = 0; n < 2; ++n) { f32x4 p; p[0] = __shfl_xor(v[n][0], 16); p[1] = __shfl_xor(v[n][1], 16); p[2] = __shfl_xor(v[n][2], 16); p[3] = __shfl_xor(v[n][3], 16);
                            const f32x4 r = hi ? (v[n] * cv[n] + p * sv[n]) : (v[n] * cv[n] - p * sv[n]); v[n] = rl ? r : v[n]; } }
                    st_bf8(rp + bj * 128, v[0] * sc, v[1] * sc); } }
        } else if (pn < 12) {
            const float sc = pn == 6 ? 0.125f : 1.0f;
            EPI_ROWS { const int row = u.pm * 256 + ai * 128 + wr * 64 + m * 16 + fr; bf16_t* rp = P + (size_t)row * 3072 + pn * 256 + wc * 32 + fq * 8;
                _Pragma("unroll") for (int bj = 0; bj < 2; ++bj) st_bf8(rp + bj * 128, acc[ai][bj][m][0] * sc, acc[ai][bj][m][1] * sc); }
        } else {
            decay_rows<0>(acc, u, wr, wc, fr, fq); decay_rows<1>(acc, u, wr, wc, fr, fq);
        }
    }
};
struct EpiP1 {
    static constexpr bool PERM = true, AFTER_DRAIN = false;
    EpiProj proj; EpiPlain vt, kx, vxt;
    __device__ __forceinline__ void operator()(const f32x4 (&acc)[2][2][4][2], const Unit& u, int wr, int wc, int fr, int fq) const {
        const int job = u.pn >> 16; Unit v; v.pm = u.pm; v.pn = u.pn & 0xffff;
        if (job == 0) proj(acc, v, wr, wc, fr, fq); else if (job == 1) vt(acc, v, wr, wc, fr, fq); else if (job == 2) kx(acc, v, wr, wc, fr, fq); else vxt(acc, v, wr, wc, fr, fq);
    }
};
struct EpiRes1 {
    static constexpr bool PERM = true, AFTER_DRAIN = false;
    const float* base; bf16_t* xb; float* ssp;
    __device__ __forceinline__ void operator()(const f32x4 (&acc)[2][2][4][2], const Unit& u, int wr, int wc, int fr, int fq) const {
        EPI_ROWS { const int row = u.pm * 256 + ai * 128 + wr * 64 + m * 16 + fr; const size_t off = (size_t)row * 1024 + u.pn * 256 + wc * 32 + fq * 8; float ss = 0.f;
            _Pragma("unroll") for (int bj = 0; bj < 2; ++bj) { const size_t o2 = off + bj * 128; const f32x4 v0 = *(const f32x4*)(base + o2) + acc[ai][bj][m][0], v1 = *(const f32x4*)(base + o2 + 4) + acc[ai][bj][m][1]; st_bf8(xb + o2, v0, v1);
                ss += ((v0[0] * v0[0] + v0[1] * v0[1]) + (v0[2] * v0[2] + v0[3] * v0[3])) + ((v1[0] * v1[0] + v1[1] * v1[1]) + (v1[2] * v1[2] + v1[3] * v1[3])); }
            ss += __shfl_xor(ss, 16); ss += __shfl_xor(ss, 32);
            if (fq == 0) ssp[(size_t)row * 16 + u.pn * 4 + wc] = ss; }
    }
};
struct EpiQX {
    static constexpr bool PERM = true, AFTER_DRAIN = false;
    bf16_t* O; const float* ssp;
    __device__ __forceinline__ void operator()(const f32x4 (&acc)[2][2][4][2], const Unit& u, int wr, int wc, int fr, int fq) const {
        EPI_ROWS { const int row = u.pm * 256 + ai * 128 + wr * 64 + m * 16 + fr; const f32x4* sp = (const f32x4*)(ssp + (size_t)row * 16);
            const f32x4 a = sp[0], b = sp[1], c = sp[2], d = sp[3]; const float ss = ((a[0] + a[1]) + (a[2] + a[3])) + ((b[0] + b[1]) + (b[2] + b[3])) + ((c[0] + c[1]) + (c[2] + c[3])) + ((d[0] + d[1]) + (d[2] + d[3]));
            const float rs = rsqrtf(ss * (1.0f / 1024.0f) + 1e-6f) * QSCALE_X; bf16_t* rp = O + (size_t)row * 1024 + u.pn * 256 + wc * 32 + fq * 8;
            _Pragma("unroll") for (int bj = 0; bj < 2; ++bj) st_bf8(rp + bj * 128, acc[ai][bj][m][0] * rs, acc[ai][bj][m][1] * rs); }
    }
};
struct EpiRes2 {
    static constexpr bool PERM = true, AFTER_DRAIN = false;
    bf16_t* xh; unsigned char* x8;
    __device__ __forceinline__ void operator()(const f32x4 (&acc)[2][2][4][2], const Unit& u, int wr, int wc, int fr, int fq) const {
        EPI_ROWS { const int row = u.pm * 256 + ai * 128 + wr * 64 + m * 16 + fr; const size_t off = (size_t)row * 1024 + u.pn * 256 + wc * 32 + fq * 8;
            _Pragma("unroll") for (int bj = 0; bj < 2; ++bj) { bf16_t* p = xh + off + bj * 128; const u32x4 w = *(const u32x4*)p;
                f32x4 v0 = {__builtin_bit_cast(float, w.x << 16), __builtin_bit_cast(float, w.x & 0xffff0000u), __builtin_bit_cast(float, w.y << 16), __builtin_bit_cast(float, w.y & 0xffff0000u)};
                f32x4 v1 = {__builtin_bit_cast(float, w.z << 16), __builtin_bit_cast(float, w.z & 0xffff0000u), __builtin_bit_cast(float, w.w << 16), __builtin_bit_cast(float, w.w & 0xffff0000u)};
                v0 = v0 + acc[ai][bj][m][0]; v1 = v1 + acc[ai][bj][m][1]; st_bf8(p, v0, v1); u32x2 q; q.x = cvt4_fp8(v0); q.y = cvt4_fp8(v1); *(u32x2*)(x8 + off + bj * 128) = q; } }
    }
};
struct EpiUp {
    static constexpr bool PERM = true, AFTER_DRAIN = false;
    unsigned char* ACT; const float* rsl; const PG8_LAS int* tstart; const PG8_LAS int* cnt; const float* b_up;
    __device__ __forceinline__ void operator()(const f32x4 (&acc)[2][2][4][2], const Unit& u, int wr, int wc, int fr, int fq) const {
        const int e = u.pn >> 3, pnl = u.pn & 7; const float* bg = b_up + (size_t)e * 2048 + pnl * 128 + wc * 32 + fq * 8;
        const int pos0 = (u.pm - tstart[e]) * 256 + wr * 64 + fr, nv = cnt[e]; const float* rp0 = rsl + (size_t)e * 32768 + pos0;
        const f32x4 bg0 = *(const f32x4*)bg, bg1 = *(const f32x4*)(bg + 4), bl0 = *(const f32x4*)(bg + 1024), bl1 = *(const f32x4*)(bg + 1028);
        EPI_ROWS { const int row = u.pm * 256 + ai * 128 + wr * 64 + m * 16 + fr; const float rs = (pos0 + ai * 128 + m * 16) < nv ? rp0[ai * 128 + m * 16] : 0.f;
            unsigned char* rp = ACT + (size_t)row * 1024 + pnl * 128 + wc * 32 + fq * 8; u32x2 w;
            _Pragma("unroll") for (int n = 0; n < 2; ++n) { const f32x4 g = acc[ai][0][m][n] * rs + (n ? bg1 : bg0), l = acc[ai][1][m][n] * rs + (n ? bl1 : bl0); f32x4 o;
                _Pragma("unroll") for (int i = 0; i < 4; ++i) { const float gl = fminf(g[i], 7.0f), li = fminf(fmaxf(l[i], -7.0f), 7.0f); o[i] = gl / (1.0f + __expf(-1.702f * gl)) * (li + 1.0f); }
                if (n) w.y = cvt4_fp8(o); else w.x = cvt4_fp8(o); }
            *(u32x2*)rp = w; }
    }
};
struct EpiDown {
    static constexpr bool PERM = true, AFTER_DRAIN = false;
    unsigned char* Y; const float* b_down;
    __device__ __forceinline__ void operator()(const f32x4 (&acc)[2][2][4][2], const Unit& u, int wr, int wc, int fr, int fq) const {
        const int e = u.pn >> 2, pnl = u.pn & 3; const float* bp = b_down + (size_t)e * 1024 + pnl * 256 + wc * 32 + fq * 8;
        f32x4 bv[2][2];
        _Pragma("unroll") for (int bj = 0; bj < 2; ++bj) _Pragma("unroll") for (int n = 0; n < 2; ++n) bv[bj][n] = *(const f32x4*)(bp + bj * 128 + n * 4);
        EPI_ROWS { const int row = u.pm * 256 + ai * 128 + wr * 64 + m * 16 + fr; unsigned char* rp = Y + (size_t)row * 1024 + pnl * 256 + wc * 32 + fq * 8;
            _Pragma("unroll") for (int bj = 0; bj < 2; ++bj) { u32x2 w; w.x = cvt4_fp8(acc[ai][bj][m][0] + bv[bj][0]); w.y = cvt4_fp8(acc[ai][bj][m][1] + bv[bj][1]); *(u32x2*)(rp + bj * 128) = w; } }
    }
};
struct OrderMap : OrderBase {
    StaticOrder so;
    __device__ void init(int nM, int nN, int G, int c) { so.nM = nM; so.nN = nN; so.nwg = nM * nN; so.G = G; so.c = c; }
    __device__ bool next(int i, Unit& u) const { if (!so.next(i, u)) return false; u.pn += (u.pn >= 4 ? 2 : 0) + (u.pn >= 6 ? 2 : 0); return true; }
};
struct OrderVT : OrderBase {
    StaticOrder so;
    __device__ void init(int nN, int G, int c) { so.nM = 4; so.nN = nN; so.nwg = 4 * nN; so.G = G; so.c = c; }
    __device__ bool next(int i, Unit& u) const { if (!so.next(i, u)) return false; u.pm += (u.pm >= 2 ? 6 : 4); return true; }
};
__device__ __forceinline__ void map_unit(int L, int nM, int nN, int& pm, int& pn) {
    const int nwg = nM * nN; int wgid = L; { const int q = nwg / NXCD, r = nwg % NXCD, xcd = wgid % NXCD, off = wgid / NXCD; wgid = (xcd < r ? xcd * (q + 1) : r * (q + 1) + (xcd - r) * q) + off; }
    const int nig = WGM * nN, gid = wgid / nig, fm = gid * WGM, gsz = (nM - fm) < WGM ? (nM - fm) : WGM;
    pm = fm + ((wgid % nig) % gsz); pn = (wgid % nig) / gsz;
}
template <unsigned oHN, unsigned oWINT, unsigned oMN, unsigned oWCK, unsigned oWCV>
struct OrderP1 : OrderBase {
    int G, c; const char* ws;
    __device__ __forceinline__ bool next(int i, Unit& u) const {
        int L = i * G + c; if (L >= 1792) return false;
        if (L < 1152) { map_unit(L, 128, 9, u.pm, u.pn); u.pn += (u.pn >= 4 ? 2 : 0) + (u.pn >= 6 ? 2 : 0); return true; } L -= 1152;
        if (L < 512) { map_unit(L, 4, 128, u.pm, u.pn); u.pm += (u.pm >= 2 ? 6 : 4); u.pn |= 1 << 16; return true; } L -= 512;
        if (L < 64) { map_unit(L, 16, 4, u.pm, u.pn); u.pn |= 2 << 16; return true; } L -= 64;
        map_unit(L, 4, 16, u.pm, u.pn); u.pn |= 3 << 16; return true;
    }
    __device__ __forceinline__ const char* a_base(const Gemm&, const Unit& u) const { const int job = u.pn >> 16; unsigned o = oHN; o = job == 1 ? oWINT : o; o = job == 2 ? oMN : o; o = job == 3 ? oWCV : o; return ws + o + (size_t)u.pm * (256 * 1024 * 2); }
    __device__ __forceinline__ const char* b_base(const Gemm&, const Unit& u) const { const int job = u.pn >> 16; unsigned o = oWINT; o = job == 1 ? oHN : o; o = job == 2 ? oWCK : o; o = job == 3 ? oMN : o; return ws + o + (size_t)(u.pn & 0xffff) * (256 * 1024 * 2); }
};
struct MoeOrder : OrderBase {
    StaticOrder so; const PG8_LAS unsigned char* tile_e; int nN;
    __device__ void init(int nM, int nN_, int G, int c, const PG8_LAS unsigned char* te) { so.nM = nM; so.nN = nN_; so.nwg = nM * nN_; so.G = G; so.c = c; tile_e = te; nN = nN_; }
    __device__ bool next(int i, Unit& u) const { if (!so.next(i, u)) return false; u.pn += (int)tile_e[u.pm] * nN; return true; }
};


struct MoeOrderG : OrderBase {
    static constexpr bool GATHER = true;
    StaticOrder so; const PG8_LAS unsigned char* tile_e; const PG8_LAS int* tstart; const PG8_LAS int* cnt; const unsigned* list; PG8_LAS unsigned* gslot; int nN;
    __device__ void init(int nM, int nN_, int G, int c, const PG8_LAS unsigned char* te, const PG8_LAS int* ts, const PG8_LAS int* cn, const unsigned* li, PG8_LAS unsigned* gs) {
        so.nM = nM; so.nN = nN_; so.nwg = nM * nN_; so.G = G; so.c = c; tile_e = te; tstart = ts; cnt = cn; list = li; gslot = gs; nN = nN_; }
    __device__ bool next(int i, Unit& u) const { if (!so.next(i, u)) return false; u.pn += (int)tile_e[u.pm] * nN; return true; }
    __device__ __forceinline__ const char* a_base(const Gemm& g, const Unit&) const { return (const char*)g.A; }
    __device__ __forceinline__ const unsigned* rows(const Unit& u) const { const int e = u.pn / nN; return list + (size_t)e * 32768 + (size_t)(u.pm - tstart[e]) * 256; }
    __device__ __forceinline__ int nvalid(const Unit& u) const { const int e = u.pn / nN; return cnt[e] - (u.pm - tstart[e]) * 256; }
};
struct OrderX1 : OrderBase {
    StaticOrder so;
    __device__ void init(int G, int c) { so.nM = 128; so.nN = 4; so.nwg = 512; so.G = G; so.c = c; }
    __device__ bool next(int i, Unit& u) const { return so.next(i, u); }
    __device__ __forceinline__ const char* a_base(const Gemm& g, const Unit& u) const { return (const char*)(g.A + (size_t)u.pm * 256 * 1024 + u.pn * 256); }
    __device__ __forceinline__ const char* b_base(const Gemm& g, const Unit& u) const { return (const char*)(g.Bt + (size_t)(u.pm >> 3) * 256 * 1024 + u.pn * 256); }
};
struct OrderX2 : OrderBase {
    StaticOrder so;
    __device__ void init(int G, int c) { so.nM = 128; so.nN = 4; so.nwg = 512; so.G = G; so.c = c; }
    __device__ bool next(int i, Unit& u) const { return so.next(i, u); }
    __device__ __forceinline__ const char* a_base(const Gemm& g, const Unit& u) const { return (const char*)(g.A + (size_t)u.pm * 256 * 1024 + u.pn * 256); }
    __device__ __forceinline__ const char* b_base(const Gemm& g, const Unit& u) const { return (const char*)(g.Bt + (size_t)u.pn * 256 * 4096 + (u.pm >> 3) * 256); }
};
struct EpiSoftmax {
    static constexpr bool PERM = true, AFTER_DRAIN = false;
    bf16_t* PX; float* lp; PG8_LAS float* xch;
    __device__ __forceinline__ void operator()(const f32x4 (&acc)[2][2][4][2], const Unit& u, int wr, int wc, int fr, int fq) const {
        PG8_LAS char* rb = (PG8_LAS char*)xch + (wr * 64 + fr) * 16; asm volatile("" : "+v"(rb));
        PG8_LAS char* wb = rb + wc * 4; asm volatile("" : "+v"(wb));
        EPI_ROWS { float a = -INFINITY;
            EPI_COLS { const f32x4 v = acc[ai][bj][m][n]; a = fmaxf(a, fmaxf(fmaxf(v[0], v[1]), fmaxf(v[2], v[3]))); }
            a = fmaxf(a, __shfl_xor(a, 16)); a = fmaxf(a, __shfl_xor(a, 32));
            if (fq == 0) *(PG8_LAS float*)(wb + (ai * 128 + m * 16) * 16) = a; }
        asm volatile("s_waitcnt lgkmcnt(0)" ::: "memory"); __builtin_amdgcn_s_barrier(); asm volatile("" ::: "memory");
        const int row0 = u.pm * 256 + wr * 64 + fr; bf16_t* rp0 = PX + (size_t)row0 * 1024 + u.pn * 256 + wc * 32 + fq * 8; float* lp0 = lp + (size_t)row0 * 16 + u.pn * 4 + wc;
        EPI_ROWS { const f32x4 q = *(const PG8_LAS f32x4*)(rb + (ai * 128 + m * 16) * 16); const float mr = fmaxf(fmaxf(q[0], q[1]), fmaxf(q[2], q[3]));
            bf16_t* rp = rp0 + (size_t)(ai * 128 + m * 16) * 1024; float ps = 0.f;
            _Pragma("unroll") for (int bj = 0; bj < 2; ++bj) { f32x4 p[2];
                _Pragma("unroll") for (int n = 0; n < 2; ++n) _Pragma("unroll") for (int i = 0; i < 4; ++i) { p[n][i] = __builtin_amdgcn_exp2f(acc[ai][bj][m][n][i] - mr); ps += p[n][i]; }
                st_bf8(rp + bj * 128, p[0], p[1]); }
            ps += __shfl_xor(ps, 16); ps += __shfl_xor(ps, 32);
            if (fq == 0) lp0[(ai * 128 + m * 16) * 16] = ps; }
        asm volatile("s_waitcnt lgkmcnt(0)" ::: "memory"); __builtin_amdgcn_s_barrier(); asm volatile("" ::: "memory");
    }
};
struct EpiPV {
    static constexpr bool PERM = true, AFTER_DRAIN = false;
    bf16_t* O; const float* lp;
    __device__ __forceinline__ void operator()(const f32x4 (&acc)[2][2][4][2], const Unit& u, int wr, int wc, int fr, int fq) const {
        EPI_ROWS { const int row = u.pm * 256 + ai * 128 + wr * 64 + m * 16 + fr; const f32x4 q = *(const f32x4*)(lp + (size_t)row * 16 + u.pn * 4);
            const float inv = 1.0f / ((q[0] + q[1]) + (q[2] + q[3])); bf16_t* rp = O + (size_t)row * 1024 + u.pn * 256 + wc * 32 + fq * 8;
            _Pragma("unroll") for (int bj = 0; bj < 2; ++bj) st_bf8(rp + bj * 128, acc[ai][bj][m][0] * inv, acc[ai][bj][m][1] * inv); }
    }
};
typedef int v4i_t __attribute__((ext_vector_type(4))); typedef int v8i_t __attribute__((ext_vector_type(8)));
__device__ __forceinline__ v8i_t cat8(bf16x8 lo, bf16x8 hi) { return __builtin_shufflevector(__builtin_bit_cast(v4i_t, lo), __builtin_bit_cast(v4i_t, hi), 0, 1, 2, 3, 4, 5, 6, 7); }
__device__ __forceinline__ void mfma8(f32x4& acc, v8i_t w, v8i_t a, int sw, int sa) {
    asm volatile("s_nop 1\n\tv_mfma_scale_f32_16x16x128_f8f6f4 %0, %1, %2, %0, %3, %4 op_sel_hi:[0,0,0]" : "+v"(acc) : "v"(w), "v"(a), "v"(sw), "v"(sa)); }
constexpr int PF_D = 4, PF_LDS = 137216;
template <class Epi, class Sched, bool ALIGN_EPI = false, bool SP2 = false, bool FP8 = false, bool PF = false>
__device__ __forceinline__ void gemm_phase(PG8_LAS unsigned char* lds, const Gemm g, const Sched& S, const Epi& E) {
    const int tid = threadIdx.x, wid = __builtin_amdgcn_readfirstlane(tid >> 6), lane = tid & 63, wr = wid >> 2, wc = wid & 3, fr = lane & 15, fq = lane >> 4;
    const int K = g.K, nt = K / BK;
    unsigned voffA[2], voffB[2];
    unsigned gC[2][2];
#pragma unroll
    for (int i = 0; i < 2; ++i) { int R, C; stage_rc(tid * 16 + i * 8192, R, C); const int Rb = Epi::PERM ? ((R & ~31) + perm32(R & 31)) : R;
        voffA[i] = (unsigned)(R * g.lda + C) * 2u; voffB[i] = (unsigned)(Rb * g.ldb + C) * 2u; }
    const bool pfA = !Sched::GATHER && wid < 4;
    const unsigned pfoff = (unsigned)((((wid >> 1) & 1) * HALF + (wid & 1) * 64 + lane) * (pfA ? g.lda : g.ldb)) * 2u;
    const size_t kstep = (size_t)(BK * 2);
    const size_t hstepA = (size_t)HALF * g.lda * 2, hstepB = (size_t)HALF * g.ldb * 2;
    const unsigned ldsw = (unsigned)wid * 1024u;
    const int aoff = lds_byte(wr * 64 + fr, fq * 8), boff = lds_byte(wc * 32 + fr, fq * 8);
#define PG8_SA(b, h) (((b) * 2 + (h)) * HTB)
#define PG8_SB(b, h) ((4 + (b) * 2 + (h)) * HTB)
#define PG8_STAGE(bufoff, gbase, voff) do { _Pragma("unroll") for (int _i = 0; _i < 2; ++_i) \
        __builtin_amdgcn_global_load_lds((const unsigned*)((const char*)(gbase) + (voff)[_i]), (PG8_LAS unsigned*)(lds + (bufoff) + ldsw + _i * 8192), 16, 0, 0); } while (0)
#define PG8_STAGE_A(bufoff, ptr, h, nx) do { if constexpr (Sched::GATHER) { PG8_STAGE(bufoff, ptr, gC[h]); } else { PG8_STAGE(bufoff, (ptr) + ((h) ? hstepA : 0), voffA); } } while (0)
#define PG8_LDA(dst, b, h) do { _Pragma("unroll") for (int m = 0; m < 4; ++m) _Pragma("unroll") for (int k = 0; k < 2; ++k) dst[m][k] = *(const PG8_LAS bf16x8*)(lds + PG8_SA(b, h) + aoff + m * 2048 + k * 1024); } while (0)
#define PG8_LDB(dst, b, h) do { _Pragma("unroll") for (int n = 0; n < 2; ++n) _Pragma("unroll") for (int k = 0; k < 2; ++k) dst[n][k] = *(const PG8_LAS bf16x8*)(lds + PG8_SB(b, h) + boff + n * 2048 + k * 1024); } while (0)
#define PG8_MMA(ai, bj, At, Bt) do { __builtin_amdgcn_s_setprio(1); \
        if constexpr (FP8) { _Pragma("unroll") for (int m = 0; m < 4; ++m) _Pragma("unroll") for (int n = 0; n < 2; ++n) \
            mfma8(acc[ai][bj][m][n], cat8(Bt[n][0], Bt[n][1]), cat8(At[m][0], At[m][1]), g.sb, g.sa); } \
        else { _Pragma("unroll") for (int m = 0; m < 4; ++m) _Pragma("unroll") for (int n = 0; n < 2; ++n) _Pragma("unroll") for (int k = 0; k < 2; ++k) \
            acc[ai][bj][m][n] = __builtin_amdgcn_mfma_f32_16x16x32_bf16(Bt[n][k], At[m][k], acc[ai][bj][m][n], 0, 0, 0); } \
        __builtin_amdgcn_s_setprio(0); } while (0)
#define PG8_WAIT_V(n) asm volatile("s_waitcnt vmcnt(" #n ")" ::: "memory")
#define PG8_WAIT_VP() do { if constexpr (PF) asm volatile("s_waitcnt vmcnt(9)" ::: "memory"); else asm volatile("s_waitcnt vmcnt(8)" ::: "memory"); } while (0)
#define PG8_PREFETCH(tp) do { if constexpr (PF) { const int tp_ = (tp); const char* pb_ = tp_ < nt ? (pfA ? cA : cB) + (size_t)tp_ * kstep : (pfA ? nA : nB) + (size_t)(tp_ - nt) * kstep; \
        __builtin_amdgcn_global_load_lds((const unsigned*)(pb_ + pfoff), (PG8_LAS unsigned*)(lds + PF_LDS + wid * 256), 4, 0, 0); } } while (0)
#define PG8_WAIT_L(n) asm volatile("s_waitcnt lgkmcnt(" #n ")" ::: "memory")
#define PG8_BAR __builtin_amdgcn_s_barrier()
#define PG8_SCHED __builtin_amdgcn_sched_barrier(0)
    Unit cur, nxt; int ui = 0;
    if (!S.next(0, cur)) return;
    f32x4 acc[2][2][4][2];
#pragma unroll
    for (int a = 0; a < 2; ++a)
#pragma unroll
        for (int b = 0; b < 2; ++b)
#pragma unroll
            for (int m = 0; m < 4; ++m)
#pragma unroll
                for (int n = 0; n < 2; ++n) acc[a][b][m][n] = (f32x4){0.f, 0.f, 0.f, 0.f};
    bf16x8 At[4][2], B0[2][2], B1[2][2];
    const char* cA = S.a_base(g, cur); const char* cB = S.b_base(g, cur);
    if constexpr (Sched::GATHER) { const unsigned* rp = S.rows(cur); const int nv = S.nvalid(cur);
#pragma unroll
        for (int h = 0; h < 2; ++h)
#pragma unroll
            for (int i = 0; i < 2; ++i) { int R, C; stage_rc(tid * 16 + i * 8192, R, C); const int r = h * HALF + R; const unsigned tok = r < nv ? rp[r] : 0u; gC[h][i] = tok * (unsigned)(g.lda * 2) + (unsigned)C * 2u; } }
    S.a_ready(cur);
    if constexpr (SP2) {
        PG8_STAGE(PG8_SB(0, 0), cB, voffB); PG8_STAGE(PG8_SB(0, 1), cB + hstepB, voffB); PG8_STAGE_A(PG8_SA(0, 0), cA, 0, 0); PG8_STAGE_A(PG8_SA(0, 1), cA, 1, 0);
        if (wr == 1) PG8_BAR;
        PG8_WAIT_V(2); PG8_BAR;
        PG8_STAGE(PG8_SB(1, 0), cB + kstep, voffB); PG8_STAGE_A(PG8_SA(1, 0), cA + kstep, 0, 0); PG8_STAGE(PG8_SB(1, 1), cB + hstepB + kstep, voffB);
        PG8_WAIT_V(6); PG8_BAR;
    } else {
        PG8_STAGE(PG8_SB(0, 0), cB, voffB); PG8_STAGE_A(PG8_SA(0, 0), cA, 0, 0); PG8_STAGE(PG8_SB(0, 1), cB + hstepB, voffB); PG8_STAGE_A(PG8_SA(0, 1), cA, 1, 0);
        if (wr == 1) PG8_BAR;
        PG8_WAIT_V(4); PG8_BAR;
        PG8_STAGE(PG8_SB(1, 0), cB + kstep, voffB); PG8_STAGE_A(PG8_SA(1, 0), cA + kstep, 0, 0); PG8_STAGE(PG8_SB(1, 1), cB + hstepB + kstep, voffB);
        PG8_WAIT_V(6); PG8_BAR;
    }
    for (;;) {
        const bool has_next = S.next(ui + 1, nxt);
        const char* nA = has_next ? S.a_base(g, nxt) : cA; const char* nB = has_next ? S.b_base(g, nxt) : cB;
        if constexpr (Sched::GATHER) { if (has_next && wid < 4)
            __builtin_amdgcn_global_load_lds((const unsigned*)(S.rows(nxt) + wid * 64 + lane), (PG8_LAS unsigned*)(S.gslot + ((ui + 1) & 1) * 256 + wid * 64), 4, 0, 0); }
#pragma nounroll
        for (int t = 0; t < nt; t += 2) {
            const bool last = (t == nt - 2);
            const char* a1 = cA + (size_t)(t + 1) * kstep;
            const char* a2 = last ? nA : cA + (size_t)(t + 2) * kstep; const char* b2 = last ? nB : cB + (size_t)(t + 2) * kstep;
            const char* a3 = a2 + kstep; const char* b3 = b2 + kstep;
            if (last && has_next) S.a_ready(nxt);
            if constexpr (SP2) {
            PG8_LDB(B0, 0, 0); PG8_LDB(B1, 0, 1); PG8_SCHED; PG8_LDA(At, 0, 0); PG8_STAGE_A(PG8_SA(1, 1), a1, 1, 0);
            if constexpr (Sched::GATHER) { if (last && has_next) {
                const PG8_LAS unsigned* sl = S.gslot + ((ui + 1) & 1) * 256; const int nv = S.nvalid(nxt);
#pragma unroll
                for (int h = 0; h < 2; ++h)
#pragma unroll
                    for (int i = 0; i < 2; ++i) { int R, C; stage_rc(tid * 16 + i * 8192, R, C); const int r = h * HALF + R; const unsigned v = sl[r]; const unsigned tok = r < nv ? v : 0u; gC[h][i] = tok * (unsigned)(g.lda * 2) + (unsigned)C * 2u; } } }
            PG8_WAIT_VP(); PG8_WAIT_L(0); PG8_BAR; PG8_MMA(0, 0, At, B0); PG8_MMA(0, 1, At, B1); PG8_BAR; PG8_SCHED;
            PG8_LDA(At, 0, 1); PG8_STAGE(PG8_SB(0, 0), b2, voffB); PG8_STAGE(PG8_SB(0, 1), b2 + hstepB, voffB); PG8_STAGE_A(PG8_SA(0, 0), a2, 0, 1); PG8_PREFETCH(t + PF_D);
            PG8_WAIT_VP(); PG8_WAIT_L(0); PG8_BAR; PG8_MMA(1, 0, At, B0); PG8_MMA(1, 1, At, B1); PG8_BAR; PG8_SCHED;
            PG8_LDB(B0, 1, 0); PG8_LDB(B1, 1, 1); PG8_SCHED; PG8_LDA(At, 1, 0); PG8_STAGE_A(PG8_SA(0, 1), a2, 1, 1);
            PG8_WAIT_VP(); PG8_WAIT_L(0); PG8_BAR; PG8_MMA(0, 0, At, B0); PG8_MMA(0, 1, At, B1); PG8_BAR; PG8_SCHED;
            PG8_LDA(At, 1, 1); PG8_STAGE(PG8_SB(1, 0), b3, voffB); PG8_STAGE(PG8_SB(1, 1), b3 + hstepB, voffB); PG8_STAGE_A(PG8_SA(1, 0), a3, 0, 1); PG8_PREFETCH(t + 1 + PF_D);
            PG8_WAIT_VP(); PG8_WAIT_L(0); PG8_BAR; PG8_MMA(1, 0, At, B0); PG8_MMA(1, 1, At, B1); PG8_BAR; PG8_SCHED;
            } else {
            PG8_LDB(B0, 0, 0); PG8_SCHED; PG8_LDA(At, 0, 0); PG8_STAGE_A(PG8_SA(1, 1), a1, 1, 0);
            PG8_WAIT_L(8); PG8_BAR; PG8_WAIT_L(0); PG8_MMA(0, 0, At, B0); PG8_BAR; PG8_SCHED;
            PG8_LDB(B1, 0, 1); PG8_STAGE(PG8_SB(0, 0), b2, voffB);
            PG8_BAR; PG8_WAIT_L(0); PG8_MMA(0, 1, At, B1); PG8_BAR;
            PG8_LDA(At, 0, 1); PG8_STAGE_A(PG8_SA(0, 0), a2, 0, 1);
            PG8_BAR; PG8_WAIT_L(0); PG8_MMA(1, 0, At, B0); PG8_BAR; PG8_SCHED;
            PG8_STAGE(PG8_SB(0, 1), b2 + hstepB, voffB);
            PG8_WAIT_V(6); PG8_BAR; PG8_MMA(1, 1, At, B1); PG8_BAR;
            PG8_LDB(B0, 1, 0); PG8_SCHED; PG8_LDA(At, 1, 0); PG8_STAGE_A(PG8_SA(0, 1), a2, 1, 1);
            PG8_WAIT_L(8); PG8_BAR; PG8_WAIT_L(0); PG8_MMA(0, 0, At, B0); PG8_BAR; PG8_SCHED;
            PG8_LDB(B1, 1, 1); PG8_STAGE(PG8_SB(1, 0), b3, voffB);
            PG8_BAR; PG8_WAIT_L(0); PG8_MMA(0, 1, At, B1); PG8_BAR;
            PG8_LDA(At, 1, 1); PG8_STAGE_A(PG8_SA(1, 0), a3, 0, 1);
            PG8_BAR; PG8_WAIT_L(0); PG8_MMA(1, 0, At, B0); PG8_BAR; PG8_SCHED;
            PG8_STAGE(PG8_SB(1, 1), b3 + hstepB, voffB);
            PG8_WAIT_V(6); PG8_BAR; PG8_MMA(1, 1, At, B1); PG8_BAR;
            }
        }
        if constexpr (ALIGN_EPI) { if (wr == 0) PG8_BAR; }
        if constexpr (FP8) asm volatile("s_nop 15\n\ts_nop 15" ::: "memory");
        if constexpr (!Epi::AFTER_DRAIN) { E(acc, cur, wr, wc, fr, fq); S.done(cur); }
        if (!has_next) break;
#pragma unroll
        for (int a = 0; a < 2; ++a)
#pragma unroll
            for (int b = 0; b < 2; ++b)
#pragma unroll
                for (int m = 0; m < 4; ++m)
#pragma unroll
                    for (int n = 0; n < 2; ++n) acc[a][b][m][n] = (f32x4){0.f, 0.f, 0.f, 0.f};
        cur = nxt; cA = nA; cB = nB; ++ui;
        if constexpr (ALIGN_EPI) { if (wr == 1) PG8_BAR; }
    }
    PG8_WAIT_V(0);
    if constexpr (!ALIGN_EPI) { if (wr == 0) PG8_BAR; }
    PG8_BAR;
    if constexpr (Epi::AFTER_DRAIN) { E.fused(acc, cur, wr, wc, fr, fq, lds, wid, lane); S.done(cur); }
#undef PG8_SA
#undef PG8_SB
#undef PG8_STAGE
#undef PG8_STAGE_A
#undef PG8_LDA
#undef PG8_LDB
#undef PG8_MMA
#undef PG8_WAIT_V
#undef PG8_WAIT_VP
#undef PG8_PREFETCH
#undef PG8_WAIT_L
#undef PG8_BAR
#undef PG8_SCHED
}
}
constexpr int NTOK = 32768, DM = 1024, SEQ = 2048, NBATCH = 16, MEMLEN = 256, NMEM = NBATCH * MEMLEN, INW = 3088, NEXP = 32, TOPK = 4;
constexpr int PW = 3072;
constexpr int MAXTILES = 544;
constexpr float EPS = 1e-6f;
constexpr int NWAVES = 8;
constexpr size_t MiB = 1u << 20;
constexpr size_t WS_CTL = 0, CTL_ZERO_BYTES = 64 * 1024;
constexpr size_t WS_WINT = 2 * MiB, WS_WOUT = 10 * MiB, WS_WCQ = 12 * MiB, WS_WCK = 14 * MiB, WS_WCV = 16 * MiB, WS_WCO = 18 * MiB;
constexpr size_t WS_WR = 20 * MiB, WS_CS = 21 * MiB, WS_SSP1 = 24 * MiB, WS_GATE = 27 * MiB, WS_ASSIGN = 28 * MiB, WS_LIST = 29 * MiB;
constexpr size_t WS_RSL = 842 * MiB;
constexpr size_t WS_X2B = 378 * MiB;
constexpr size_t WS_WUP = 34 * MiB, WS_WDN = 162 * MiB, WS_KX = 226 * MiB, WS_VXT = 234 * MiB;
constexpr size_t WS_HN = 242 * MiB, WS_CAT = 242 * MiB, WS_MN = 306 * MiB, WS_P = 314 * MiB, WS_LA = 506 * MiB, WS_VT = 538 * MiB;
constexpr size_t WS_X1B = 314 * MiB, WS_QX = 378 * MiB, WS_OX = 442 * MiB, WS_PX = 506 * MiB;
constexpr size_t WS_GVT = 602 * MiB;
constexpr size_t WS_ACT = 570 * MiB, WS_Y = 706 * MiB, WS_END = 846 * MiB;
constexpr int CW_Q2 = 128;
constexpr int CW_CNT = 1024;
constexpr int CW_PROBE = 192;
constexpr int CW_BAR = 4096;
constexpr int RING_OFF = 0, RING_BYTES = 131072;
constexpr int LDSCTL_OFF = RING_BYTES, MISC_OFF = LDSCTL_OFF + 320;
constexpr int TAB_OFF = LDSCTL_OFF + 512;
constexpr int TAB_TSTART = TAB_OFF + 576, TAB_CNT = TAB_TSTART + 144;
constexpr int XCH_OFF = LDSCTL_OFF + 2048;
constexpr int TS_OFF = TAB_CNT + 128;
constexpr int LDS_BYTES = 147456;

#define GAS __attribute__((address_space(1)))
#define LAS __attribute__((address_space(3)))
typedef unsigned short bf16;
typedef unsigned v4u __attribute__((ext_vector_type(4)));
typedef float f32x4 __attribute__((ext_vector_type(4)));
typedef short bf16x8 __attribute__((ext_vector_type(8)));
typedef GAS unsigned gu32;
typedef GAS unsigned long long gu64;
#define RLX_AGENT __ATOMIC_RELAXED, __HIP_MEMORY_SCOPE_AGENT
#define LDS_WAIT() asm volatile("s_waitcnt lgkmcnt(0)" ::: "memory")
#define VM_WAIT() asm volatile("s_waitcnt vmcnt(0)" ::: "memory")
__device__ __forceinline__ unsigned long long rt() { return __builtin_amdgcn_s_memrealtime(); }
__device__ __forceinline__ unsigned f2bf(float f) { unsigned u = __builtin_bit_cast(unsigned, f); return (u + 0x7fffu + ((u >> 16) & 1u)) >> 16; }
__device__ __forceinline__ unsigned pk2(float lo, float hi) { return f2bf(lo) | (f2bf(hi) << 16); }

#define XB_TMO      128
#define XB_XCNT(j)  (256  + 64 * (j))
#define XB_XSUB(j)  (1280 + 64 * (j))
#define XB_XGEN(j)  (2304 + 64 * (j))
#define XB_TOP      3328
#define XB_TOPGEN   3392
#define XCD_BAR_WORDS 3456
#define XB_SPIN_CAP (1u << 18)

__device__ __forceinline__ unsigned xb_ld(unsigned* p)              { return __hip_atomic_load(p, __ATOMIC_RELAXED, __HIP_MEMORY_SCOPE_AGENT); }
__device__ __forceinline__ unsigned xb_add(unsigned* p, unsigned v) { return __hip_atomic_fetch_add(p, v, __ATOMIC_RELAXED, __HIP_MEMORY_SCOPE_AGENT); }
__device__ __forceinline__ unsigned xb_xcc_id() { return (unsigned)__builtin_amdgcn_s_getreg((3 << 11) | 20) & 0xFu; }
#define XB_SPIN(cond, bar) do { unsigned _sp = 0; while (cond) { __builtin_amdgcn_s_sleep(1); \
    if ((++_sp & 255u) == 0u) { if (xb_ld(&(bar)[XB_TMO])) break; if (_sp > XB_SPIN_CAP) { atomicAdd(&(bar)[XB_TMO], 1u); break; } } } } while (0)

struct XcdBarrier {
    unsigned* bar; unsigned x;
    volatile LAS unsigned* st;
};

__device__ __forceinline__ XcdBarrier xcd_barrier_post(unsigned* bar, volatile LAS unsigned* st) {
    XcdBarrier b; b.bar = bar; b.x = xb_xcc_id(); b.st = st;
    if (threadIdx.x == 0) (void)xb_add(&bar[XB_XCNT(b.x)], 1u);
    return b;
}
__device__ __forceinline__ void xcd_barrier_complete(unsigned* bar, unsigned x, unsigned& nloc, unsigned& nx) {
    const unsigned G = gridDim.x * gridDim.y * gridDim.z;
    unsigned sum, cnt, mine, sp = 0u;
    for (;;) {
        sum = 0u; cnt = 0u; mine = 0u;
#pragma unroll
        for (unsigned j = 0; j < 16; ++j) { const unsigned c = xb_ld(&bar[XB_XCNT(j)]); sum += c; cnt += (c > 0u) ? 1u : 0u; mine = (j == x) ? c : mine; }
        if (sum == G) break;
        __builtin_amdgcn_s_sleep(1);
        if ((++sp & 255u) == 0u) { if (xb_ld(&bar[XB_TMO])) break; if (sp > XB_SPIN_CAP) { atomicAdd(&bar[XB_TMO], 1u); break; } }
    }
    nloc = mine > 0u ? mine : 1u; nx = cnt > 0u ? cnt : 1u;
}

__device__ __forceinline__ void xcd_barrier(const XcdBarrier& b) {
    asm volatile("s_waitcnt vmcnt(0)" ::: "memory");
    __syncthreads();
    if (threadIdx.x == 0) {
        unsigned* bar = b.bar;
        __builtin_amdgcn_s_waitcnt(0);
        unsigned nloc = b.st[0], nx = b.st[1];
        if (nloc == 0u) { xcd_barrier_complete(bar, b.x, nloc, nx); b.st[0] = nloc; b.st[1] = nx; }
        const unsigned old = xb_add(&bar[XB_XSUB(b.x)], 1u);
        const unsigned gen = old / nloc;
        if (old + 1u == (gen + 1u) * nloc) {
            __builtin_amdgcn_fence(__ATOMIC_RELEASE, "agent");
            asm volatile("s_waitcnt vmcnt(0)" ::: "memory");
            const unsigned og = xb_add(&bar[XB_TOP], 1u);
            const unsigned tg = og / nx;
            if (og + 1u == (tg + 1u) * nx) xb_add(&bar[XB_TOPGEN], 1u);
            else XB_SPIN(xb_ld(&bar[XB_TOPGEN]) == tg, bar);
            __builtin_amdgcn_fence(__ATOMIC_ACQUIRE, "agent");
            xb_add(&bar[XB_XGEN(b.x)], 1u);
            asm volatile("s_waitcnt vmcnt(0)" ::: "memory");
        } else {
            XB_SPIN(xb_ld(&bar[XB_XGEN(b.x)]) == gen, bar);
            __builtin_amdgcn_fence(__ATOMIC_ACQUIRE, "agent");
            asm volatile("s_waitcnt vmcnt(0)" ::: "memory");
        }
    }
    __syncthreads();
}
typedef short bf16x4 __attribute__((ext_vector_type(4)));
typedef unsigned v2u __attribute__((ext_vector_type(2)));
struct Frame {
    LAS unsigned char* lds;
    volatile LAS unsigned* MISC;
    gu32* ctl;
    int tid, lane, wave;
    int vcu, G;
    unsigned char* ws;
    float* out;
};
__device__ __forceinline__ int lane_here() { int t = (int)threadIdx.x; asm volatile("" : "+v"(t)); return t & 63; }
__device__ __forceinline__ float bf2f(bf16 b) { return __builtin_bit_cast(float, (unsigned)b << 16); }
__device__ __forceinline__ float wave_sum(float v) {
#pragma unroll
    for (int o = 1; o < 64; o <<= 1) v += __shfl_xor(v, o);
    return v;
}
__device__ __forceinline__ float xmax16(float m) { auto rr = __builtin_amdgcn_permlane16_swap(__float_as_uint(m), __float_as_uint(m), false, false); return fmaxf(__uint_as_float(rr[0]), __uint_as_float(rr[1])); }
__device__ __forceinline__ float xmax32(float m) { auto rr = __builtin_amdgcn_permlane32_swap(__float_as_uint(m), __float_as_uint(m), false, false); return fmaxf(__uint_as_float(rr[0]), __uint_as_float(rr[1])); }
__device__ __forceinline__ f32x4 mfma16(bf16x8 a, bf16x8 b, f32x4 c) { return __builtin_amdgcn_mfma_f32_16x16x32_bf16(a, b, c, 0, 0, 0); }

__device__ __forceinline__ void p0_transpose_item(const float* W, int ldw, const float* gain, bf16* WT, int K, int k0, int n0, size_t orow0, int lane) {
    const int n4 = lane & 15, kq = lane >> 4;
    const float* src = W + (size_t)(k0 + 16 * kq) * ldw + n0 + 4 * n4;
    f32x4 v[16];
#pragma unroll
    for (int i = 0; i < 16; ++i) v[i] = *(const f32x4*)(src + (size_t)i * ldw);
    if (gain) { const f32x4* gp = (const f32x4*)(gain + k0 + 16 * kq);
#pragma unroll
        for (int q = 0; q < 4; ++q) { const f32x4 gq = gp[q];
#pragma unroll
            for (int r = 0; r < 4; ++r) v[4 * q + r] = v[4 * q + r] * gq[r]; } }
    bf16* dst = WT + (orow0 + 4 * n4) * (size_t)K + k0 + 16 * kq;
#pragma unroll
    for (int j = 0; j < 4; ++j) { v4u o0, o1;
        o0.x = pg8::cvtpk(v[0][j], v[1][j]); o0.y = pg8::cvtpk(v[2][j], v[3][j]); o0.z = pg8::cvtpk(v[4][j], v[5][j]); o0.w = pg8::cvtpk(v[6][j], v[7][j]);
        o1.x = pg8::cvtpk(v[8][j], v[9][j]); o1.y = pg8::cvtpk(v[10][j], v[11][j]); o1.z = pg8::cvtpk(v[12][j], v[13][j]); o1.w = pg8::cvtpk(v[14][j], v[15][j]);
        *(v4u*)(dst + (size_t)j * K) = o0; *(v4u*)(dst + (size_t)j * K + 8) = o1; }
}
__device__ __forceinline__ void p0_transpose_item8(const float* W, int ldw, const float* gain, unsigned char* WT, int K, int k0, int n0, size_t orow0, int lane) {
    const int n4 = lane & 15, kq = lane >> 4;
    const float* src = W + (size_t)(k0 + 16 * kq) * ldw + n0 + 4 * n4;
    f32x4 v[16];
#pragma unroll
    for (int i = 0; i < 16; ++i) v[i] = *(const f32x4*)(src + (size_t)i * ldw);
    { const f32x4* gp = (const f32x4*)(gain + k0 + 16 * kq);
#pragma unroll
        for (int q = 0; q < 4; ++q) { f32x4 gq = {32.f, 32.f, 32.f, 32.f}; if (gain) gq = gp[q] * 32.0f;
#pragma unroll
            for (int r = 0; r < 4; ++r) v[4 * q + r] = v[4 * q + r] * gq[r]; } }
    unsigned char* dst = WT + (orow0 + 4 * n4) * (size_t)K + k0 + 16 * kq;
#pragma unroll
    for (int j = 0; j < 4; ++j) { v4u o;
        o.x = pg8::cvt4_fp8((f32x4){v[0][j], v[1][j], v[2][j], v[3][j]}); o.y = pg8::cvt4_fp8((f32x4){v[4][j], v[5][j], v[6][j], v[7][j]});
        o.z = pg8::cvt4_fp8((f32x4){v[8][j], v[9][j], v[10][j], v[11][j]}); o.w = pg8::cvt4_fp8((f32x4){v[12][j], v[13][j], v[14][j], v[15][j]});
        *(v4u*)(dst + (size_t)j * K) = o; }
}
__device__ __forceinline__ void rms_row_to_bf16(const float* xrow, const float* g, bf16* orow, int lane) {
    const f32x4* xr = (const f32x4*)xrow + lane; const f32x4* gr = (const f32x4*)g + lane;
    f32x4 v[4]; float s = 0.f;
#pragma unroll
    for (int j = 0; j < 4; ++j) { v[j] = xr[64 * j]; s += (v[j].x * v[j].x + v[j].y * v[j].y) + (v[j].z * v[j].z + v[j].w * v[j].w); }
    const float rs = rsqrtf(wave_sum(s) * (1.0f / DM) + EPS);
    unsigned long long* o8 = (unsigned long long*)orow + lane;
#pragma unroll
    for (int j = 0; j < 4; ++j) { const f32x4 gg = gr[64 * j]; o8[64 * j] = (unsigned long long)pk2(v[j].x * rs * gg.x, v[j].y * rs * gg.y) | ((unsigned long long)pk2(v[j].z * rs * gg.z, v[j].w * rs * gg.w) << 32); }
}
constexpr int MOE_I_UP = 32 * 16 * 32, MOE_I_DN = 32 * 16 * 16, MOE_UNITS = (MOE_I_UP + MOE_I_DN) / 64;
__device__ __forceinline__ void moe_convert_unit(int unit, const float* w_up, const float* w_down, const float* g_ffn, unsigned char* ws, int wave, int lane) {
#pragma unroll 1
    for (int j = 0; j < 8; ++j) { int r = unit * 64 + j * 8 + wave;
        if (r < MOE_I_UP) { const int e = r / (16 * 32); r -= e * (16 * 32); const int n0 = 64 * (r % 32);
            const size_t orow = (size_t)e * 2048 + ((n0 & 1023) >> 7) * 256 + (n0 >> 10) * 128 + (n0 & 127);
            p0_transpose_item8(w_up + (size_t)e * DM * 2048, 2048, g_ffn, ws + WS_WUP, DM, 64 * (r / 32), n0, orow, lane); }
        else { r -= MOE_I_UP; const int e = r / (16 * 16); r -= e * (16 * 16);
            p0_transpose_item8(w_down + (size_t)e * DM * DM, DM, nullptr, ws + WS_WDN, DM, 64 * (r / 16), 64 * (r % 16), (size_t)e * 1024 + 64 * (r % 16), lane); } }
}
struct In {
    const float *x, *mem; const int* positions; const float *norm_mix_g, *w_in, *lq1, *lk1, *lq2, *lk2, *diff_norm_g, *w_alpha2, *b_alpha, *gla_norm_g, *w_out, *norm_cross_g, *norm_mem_g,
        *w_cq, *w_ck, *w_cv, *w_co, *norm_ffn_g, *w_router, *b_router, *w_up, *b_up, *w_down, *b_down, *norm_final_g;
};
__device__ __forceinline__ void p0_prologue(Frame& F, const In& I) {
    const int gw = F.vcu * NWAVES + F.wave, NGW = F.G * NWAVES, lane = lane_here();
    unsigned char* ws = F.ws;
    constexpr int I_IN = 16 * 48, I_SQ = 16 * 16;
    constexpr int NITEMS = I_IN + 5 * I_SQ;
    for (int it = gw; it < NITEMS; it += NGW) {
        int r = it;
        if (r < I_IN) { p0_transpose_item(I.w_in, INW, nullptr, (bf16*)(ws + WS_WINT), DM, 64 * (r / 48), 64 * (r % 48), (size_t)64 * (r % 48), lane); continue; } r -= I_IN;
        { const int w = r / I_SQ; r -= w * I_SQ;
            const float* W = w == 0 ? I.w_out : w == 1 ? I.w_cq : w == 2 ? I.w_ck : w == 3 ? I.w_cv : I.w_co;
            bf16* WT = (bf16*)(ws + (w == 0 ? WS_WOUT : w == 1 ? WS_WCQ : w == 2 ? WS_WCK : w == 3 ? WS_WCV : WS_WCO));
            p0_transpose_item(W, DM, w == 1 ? I.norm_cross_g : nullptr, WT, DM, 64 * (r / 16), 64 * (r % 16), (size_t)64 * (r % 16), lane); }
    }
    const int gt = F.vcu * (NWAVES * 64) + F.tid, NGT = F.G * NWAVES * 64;
    for (int idx = gt; idx < 256 * DM; idx += NGT) { const int j = idx >> 10, k = idx & 1023; const float* wr = I.w_in + (size_t)k * INW + 3072; float s = 0.f;
#pragma unroll
        for (int r = 0; r < 16; ++r) s += wr[r] * I.w_alpha2[r * 256 + j];
        ((bf16*)(ws + WS_WINT))[(size_t)(3072 + j) * DM + k] = (bf16)f2bf(s); }
    for (int idx = gt; idx < DM * NEXP; idx += NGT) ((float*)(ws + WS_WR))[idx] = I.w_router[idx] * I.norm_ffn_g[idx >> 5];
    for (int idx = gt; idx < NTOK * 8; idx += NGT) { const int tok = idx >> 3, i = idx & 7;
        const double inv = exp(-(double)i * 0.125 * 13.122363377404328); const double ang = (double)I.positions[tok] * inv;
        const double red = ang - rint(ang * 0.15915494309189535) * 6.283185307179586; const float rf = (float)red;
        float* cs = (float*)(ws + WS_CS) + (size_t)tok * 16; cs[i] = cosf(rf); cs[8 + i] = sinf(rf); }
    for (int m = gw; m < NTOK + NMEM; m += NGW) {
        if (m < NTOK) rms_row_to_bf16(I.x + (size_t)m * DM, I.norm_mix_g, (bf16*)(ws + WS_HN) + (size_t)m * DM, lane);
        else rms_row_to_bf16(I.mem + (size_t)(m - NTOK) * DM, I.norm_mem_g, (bf16*)(ws + WS_MN) + (size_t)(m - NTOK) * DM, lane);
    }
}

constexpr int DA_KBUF = 16384, DA_VBUF = 16384, DA_VOFF = 2 * DA_KBUF;
__device__ __forceinline__ void diffattn_unit(Frame& F, const bf16* P, const bf16* VT, bf16* CAT, const float* gdiff, float lam, int b, int h, int qblk) {
    const int lane = lane_here(), wave = F.wave, tid = F.tid, l15 = lane & 15, g = lane >> 4;
    LAS unsigned char* lds = F.lds + RING_OFF;
    const int q0 = qblk * 128 + wave * 16;
    const size_t tokq = (size_t)b * SEQ + q0 + l15;
    bf16x8 qf[2][2];
#pragma unroll
    for (int c = 0; c < 2; ++c)
#pragma unroll
        for (int ks = 0; ks < 2; ++ks) qf[c][ks] = *(const bf16x8*)(P + tokq * PW + h * 128 + c * 64 + ks * 32 + g * 8);
    f32x4 o[2][8];
#pragma unroll
    for (int c = 0; c < 2; ++c)
#pragma unroll
        for (int k = 0; k < 8; ++k) o[c][k] = (f32x4){0.f, 0.f, 0.f, 0.f};
    float mrun[2] = {-INFINITY, -INFINITY}, lsum[2] = {0.f, 0.f};
    const int nk = q0 + 16;
    const int nt = 2 * qblk + 2;
    const int skey = tid >> 4, sch = tid & 15, vrow = tid >> 3, vpc = tid & 7;
    const bf16* ksrc = P + ((size_t)b * SEQ + skey) * PW + 512 + h * 128 + sch * 8;
    const bf16* vsrc = VT + (size_t)(h * 128 + vrow) * NTOK + (size_t)b * SEQ + vpc * 8;
    const int kdst = skey * 256 + ((sch ^ (skey & 15)) * 16);
    const int vfr = (vrow >> 1) & 7, vch = (vpc >> 2) * 4 + 2 * (vpc & 1), vhi = ((vpc & 3) >> 1) * 8;
    const int vdst0 = DA_VOFF + vrow * 128 + ((vch ^ vfr) * 16) + vhi, vdst1 = DA_VOFF + vrow * 128 + (((vch + 1) ^ vfr) * 16) + vhi;
    int koff[2][2];
#pragma unroll
    for (int c = 0; c < 2; ++c)
#pragma unroll
        for (int ks = 0; ks < 2; ++ks) koff[c][ks] = l15 * 256 + (((c * 8 + ks * 4 + g) ^ l15) * 16);
    const int voffs[2] = {DA_VOFF + l15 * 128 + ((g ^ (l15 >> 1)) * 16), DA_VOFF + l15 * 128 + (((4 + g) ^ (l15 >> 1)) * 16)};
    v4u sk0, sk1, sv0, sv1;
#define DA_LOAD(tt) do { const bf16* kp_ = ksrc + (size_t)(tt) * 64 * PW; const bf16* vp_ = vsrc + (tt) * 64; \
        sk0 = *(const v4u*)kp_; sk1 = *(const v4u*)(kp_ + (size_t)32 * PW); sv0 = *(const v4u*)vp_; sv1 = *(const v4u*)(vp_ + (size_t)64 * NTOK); } while (0)
#define DA_STORE(bb) do { LAS unsigned char* kd_ = lds + (bb) * DA_KBUF + kdst; LAS unsigned char* vd_ = lds + (bb) * DA_VBUF; \
        *(LAS v4u*)kd_ = sk0; *(LAS v4u*)(kd_ + 8192) = sk1; \
        *(LAS v2u*)(vd_ + vdst0) = (v2u){sv0.x, sv0.y}; *(LAS v2u*)(vd_ + vdst1) = (v2u){sv0.z, sv0.w}; *(LAS v2u*)(vd_ + vdst0 + 8192) = (v2u){sv1.x, sv1.y}; *(LAS v2u*)(vd_ + vdst1 + 8192) = (v2u){sv1.z, sv1.w}; } while (0)
    DA_LOAD(0); DA_STORE(0);
    __syncthreads();
    auto step = [&](const int t, const int buf) __attribute__((always_inline)) {
        if (t * 64 < nk) {
            const LAS unsigned char* kb = lds + buf * DA_KBUF; const LAS unsigned char* vb = lds + buf * DA_VBUF;
            f32x4 s[2][2][2];
#pragma unroll
            for (int sub = 0; sub < 2; ++sub)
#pragma unroll
                for (int c = 0; c < 2; ++c)
#pragma unroll
                    for (int s2 = 0; s2 < 2; ++s2) { f32x4 a = (f32x4){0.f, 0.f, 0.f, 0.f};
#pragma unroll
                        for (int ks = 0; ks < 2; ++ks) { const bf16x8 kf = *(const LAS bf16x8*)(kb + sub * 8192 + s2 * 4096 + koff[c][ks]); a = mfma16(kf, qf[c][ks], a); }
                        s[sub][c][s2] = a; }
            if (t * 64 + 63 > q0) {
                const int qrow = q0 + l15;
#pragma unroll
                for (int sub = 0; sub < 2; ++sub)
#pragma unroll
                    for (int c = 0; c < 2; ++c)
#pragma unroll
                        for (int s2 = 0; s2 < 2; ++s2)
#pragma unroll
                            for (int r = 0; r < 4; ++r) if (t * 64 + sub * 32 + s2 * 16 + 4 * g + r > qrow) s[sub][c][s2][r] = -INFINITY;
            }
            float mnew[2]; bool grow = false;
#pragma unroll
            for (int c = 0; c < 2; ++c) { float mx = -INFINITY;
#pragma unroll
                for (int sub = 0; sub < 2; ++sub)
#pragma unroll
                    for (int s2 = 0; s2 < 2; ++s2) mx = fmaxf(mx, fmaxf(fmaxf(s[sub][c][s2][0], s[sub][c][s2][1]), fmaxf(s[sub][c][s2][2], s[sub][c][s2][3])));
                mx = xmax16(mx); mx = xmax32(mx);
                mnew[c] = mx > mrun[c] + 8.0f ? mx : mrun[c]; grow = grow || (mnew[c] > mrun[c]); }
            if (__any(grow)) {
#pragma unroll
                for (int c = 0; c < 2; ++c) { const float alpha = __builtin_amdgcn_exp2f(mrun[c] - mnew[c]); mrun[c] = mnew[c]; lsum[c] *= alpha;
#pragma unroll
                    for (int k = 0; k < 8; ++k) o[c][k] = o[c][k] * alpha; }
            }
#pragma unroll
            for (int sub = 0; sub < 2; ++sub) {
                bf16x8 pb[2];
#pragma unroll
                for (int c = 0; c < 2; ++c) { float ps = 0.f;
#pragma unroll
                    for (int s2 = 0; s2 < 2; ++s2)
#pragma unroll
                        for (int r = 0; r < 4; ++r) { const float p = __builtin_amdgcn_exp2f(s[sub][c][s2][r] - mrun[c]); s[sub][c][s2][r] = p; ps += p; }
                    lsum[c] += ps;
                    v4u w; w.x = pg8::cvtpk(s[sub][c][0][0], s[sub][c][0][1]); w.y = pg8::cvtpk(s[sub][c][0][2], s[sub][c][0][3]); w.z = pg8::cvtpk(s[sub][c][1][0], s[sub][c][1][1]); w.w = pg8::cvtpk(s[sub][c][1][2], s[sub][c][1][3]);
                    pb[c] = __builtin_bit_cast(bf16x8, w); }
#pragma unroll
                for (int k = 0; k < 8; ++k) { const bf16x8 vf = *(const LAS bf16x8*)(vb + voffs[sub] + k * 2048);
                    o[0][k] = mfma16(vf, pb[0], o[0][k]); o[1][k] = mfma16(vf, pb[1], o[1][k]); }
            }
        }
    };
    for (int t = 0; t < nt; ++t) {
        if (t + 1 < nt) DA_LOAD(t + 1);
        step(t, t & 1);
        if (t + 1 < nt) DA_STORE((t & 1) ^ 1);
        __syncthreads();
    }
#undef DA_LOAD
#undef DA_STORE
    float l0 = lsum[0], l1 = lsum[1];
    l0 += __shfl_xor(l0, 16); l0 += __shfl_xor(l0, 32); l1 += __shfl_xor(l1, 16); l1 += __shfl_xor(l1, 32);
    const float i0 = 1.0f / l0, i1 = lam / l1; float ss = 0.f;
#pragma unroll
    for (int k = 0; k < 8; ++k)
#pragma unroll
        for (int r = 0; r < 4; ++r) { const float v = o[0][k][r] * i0 - o[1][k][r] * i1; o[0][k][r] = v; ss += v * v; }
    ss += __shfl_xor(ss, 16); ss += __shfl_xor(ss, 32);
    const float rs = rsqrtf(ss * (1.0f / 128.0f) + EPS) * 0.8f;
    bf16* op = CAT + tokq * DM + h * 128 + 4 * g;
#pragma unroll
    for (int k = 0; k < 8; ++k) { const f32x4 gg = *(const f32x4*)(gdiff + k * 16 + 4 * g); f32x4 v = o[0][k] * rs; v = v * gg; pg8::st_bf4(op + k * 16, v); }
}

__device__ __forceinline__ bf16x8 pack8(const f32x4& a, const f32x4& b) { v4u w; w.x = pg8::cvtpk(a[0], a[1]); w.y = pg8::cvtpk(a[2], a[3]); w.z = pg8::cvtpk(b[0], b[1]); w.w = pg8::cvtpk(b[2], b[3]); return __builtin_bit_cast(bf16x8, w); }
constexpr int GL_QI = 0, GL_KI = 8192, GL_IMG = 16384, GL_EL = 2 * GL_IMG, GL_OB = GL_EL + 512, GL_OBS = 17408, GL_PS = GL_OB + 2 * GL_OBS, GL_END = GL_PS + 4096;

__device__ __forceinline__ void gla_unit(Frame& F, const bf16* P, const float* Bc, const bf16* GVT, bf16* CAT, const float* ggla, int b, int h) {
    const int lane = lane_here(), l15 = lane & 15, g = lane >> 4, eb = F.wave, tid = F.tid;
    LAS unsigned char* lds = F.lds + RING_OFF;
    const f32x4 zero4 = {0.f, 0.f, 0.f, 0.f};
    f32x4 S[4] = {zero4, zero4, zero4, zero4};
    bf16x8 If[4];
#pragma unroll
    for (int db = 0; db < 4; ++db) { const int ks = db >> 1;
#pragma unroll
        for (int j = 0; j < 8; ++j) { const int dp = 32 * ks + (j < 4 ? 4 * g + j : 16 + 4 * g + j - 4); If[db][j] = (dp == 16 * db + l15) ? (short)0x3F80 : (short)0; } }
    const int st = tid >> 3, sp = tid & 7, opc = tid & 15;
    const size_t tokb = (size_t)b * SEQ;
    const bf16* qsrc = P + (tokb + st) * PW + 1536 + h * 64 + sp * 8;
    const float* bsrc = Bc + (tokb + st) * 256 + h * 64 + sp * 8;
    const bf16* Vrow = GVT + (size_t)(h * 128 + 16 * eb + l15) * NTOK + tokb + 4 * g;
    const f32x4 gg0 = *(const f32x4*)(ggla + opc * 8), gg1 = *(const f32x4*)(ggla + opc * 8 + 4);
    const int foffs[2] = {l15 * 128 + ((g ^ (l15 >> 1)) * 16), l15 * 128 + (((4 + g) ^ (l15 >> 1)) * 16)};
    const int sfr = (st >> 1) & 7, sch0 = (sp >> 2) * 4 + 2 * (sp & 1), shi = ((sp & 3) >> 1) * 8, sd0 = st * 128 + ((sch0 ^ sfr) * 16) + shi, sd1 = st * 128 + (((sch0 + 1) ^ sfr) * 16) + shi;
    v4u rq = *(const v4u*)qsrc, rk = *(const v4u*)(qsrc + 256); f32x4 rb0 = *(const f32x4*)bsrc, rb1 = *(const f32x4*)(bsrc + 4);
#define GLA_STAGE(par) do { \
        float ee[8]; _Pragma("unroll") for (int i = 0; i < 4; ++i) { ee[i] = __expf(rb0[i]); ee[4 + i] = __expf(rb1[i]); } \
        const unsigned qa[4] = {rq.x, rq.y, rq.z, rq.w}, ka[4] = {rk.x, rk.y, rk.z, rk.w}; v4u wq, wk; unsigned* wqp = (unsigned*)&wq; unsigned* wkp = (unsigned*)&wk; \
        _Pragma("unroll") for (int i = 0; i < 4; ++i) { const float q0 = __builtin_bit_cast(float, qa[i] << 16), q1 = __builtin_bit_cast(float, qa[i] & 0xffff0000u), k0 = __builtin_bit_cast(float, ka[i] << 16), k1 = __builtin_bit_cast(float, ka[i] & 0xffff0000u); \
            wqp[i] = pg8::cvtpk(q0 * ee[2 * i], q1 * ee[2 * i + 1]); wkp[i] = pg8::cvtpk(k0 * __builtin_amdgcn_rcpf(ee[2 * i]), k1 * __builtin_amdgcn_rcpf(ee[2 * i + 1])); } \
        { LAS unsigned char* ib_ = lds + (par) * GL_IMG; *(LAS v2u*)(ib_ + GL_QI + sd0) = (v2u){wq.x, wq.y}; *(LAS v2u*)(ib_ + GL_QI + sd1) = (v2u){wq.z, wq.w}; *(LAS v2u*)(ib_ + GL_KI + sd0) = (v2u){wk.x, wk.y}; *(LAS v2u*)(ib_ + GL_KI + sd1) = (v2u){wk.z, wk.w}; } \
        if (st == 63) { *(LAS f32x4*)(lds + GL_EL + (par) * 256 + sp * 32) = (f32x4){ee[0], ee[1], ee[2], ee[3]}; *(LAS f32x4*)(lds + GL_EL + (par) * 256 + sp * 32 + 16) = (f32x4){ee[4], ee[5], ee[6], ee[7]}; } } while (0)
    bf16x8 VFn[2];
#pragma unroll
    for (int ss = 0; ss < 2; ++ss) { const bf16* vp = Vrow + 32 * ss; const v2u v0 = *(const v2u*)vp, v1 = *(const v2u*)(vp + 16); v4u vv; vv.x = v0.x; vv.y = v0.y; vv.z = v1.x; vv.w = v1.y; VFn[ss] = __builtin_bit_cast(bf16x8, vv); }
    GLA_STAGE(0);
    __syncthreads();
    for (int c = 0; c < SEQ / 64; ++c) {
        const int par = c & 1; const size_t tok0 = tokb + c * 64;
        if (c + 1 < SEQ / 64) { rq = *(const v4u*)(qsrc + (size_t)(c + 1) * 64 * PW); rk = *(const v4u*)(qsrc + (size_t)(c + 1) * 64 * PW + 256);
            rb0 = *(const f32x4*)(bsrc + (size_t)(c + 1) * 64 * 256); rb1 = *(const f32x4*)(bsrc + (size_t)(c + 1) * 64 * 256 + 4); }
        bf16x8 VF[2] = {VFn[0], VFn[1]};
        if (c + 1 < SEQ / 64) {
#pragma unroll
            for (int ss = 0; ss < 2; ++ss) { const bf16* vp = Vrow + (c + 1) * 64 + 32 * ss; const v2u v0 = *(const v2u*)vp, v1 = *(const v2u*)(vp + 16); v4u vv; vv.x = v0.x; vv.y = v0.y; vv.z = v1.x; vv.w = v1.y; VFn[ss] = __builtin_bit_cast(bf16x8, vv); } }
        v4u rg[2];
#pragma unroll
        for (int i = 0; i < 2; ++i) rg[i] = *(const v4u*)(P + (tok0 + ((tid + 512 * i) >> 4)) * PW + 2560 + h * 128 + opc * 8);
        const LAS unsigned char* qi = lds + par * GL_IMG + GL_QI; const LAS unsigned char* ki = lds + par * GL_IMG + GL_KI;
        bf16x8 qf[4][2], kf[4][2];
#pragma unroll
        for (int blk = 0; blk < 4; ++blk)
#pragma unroll
            for (int ks = 0; ks < 2; ++ks) { qf[blk][ks] = *(const LAS bf16x8*)(qi + foffs[ks] + blk * 2048); kf[blk][ks] = *(const LAS bf16x8*)(ki + foffs[ks] + blk * 2048); }
        const bf16x8 SF0 = pack8(S[0], S[1]), SF1 = pack8(S[2], S[3]);
        f32x4 O[4];
#pragma unroll
        for (int tb = 0; tb < 4; ++tb) { f32x4 o = mfma16(qf[tb][0], SF0, zero4); o = mfma16(qf[tb][1], SF1, o);
#pragma unroll
            for (int ss = 0; ss < 2; ++ss) if (2 * ss <= tb) { f32x4 a2[2];
#pragma unroll
                for (int hh = 0; hh < 2; ++hh) { const int sb = 2 * ss + hh; f32x4 a = zero4;
                    if (sb <= tb) { a = mfma16(kf[sb][0], qf[tb][0], zero4); a = mfma16(kf[sb][1], qf[tb][1], a);
                        if (sb == tb) {
#pragma unroll
                            for (int r = 0; r < 4; ++r) if (4 * g + r > l15) a[r] = 0.f; } }
                    a2[hh] = a; }
                o = mfma16(pack8(a2[0], a2[1]), VF[ss], o); }
            O[tb] = o; }
#pragma unroll
        for (int db = 0; db < 4; ++db) { f32x4 u = S[db];
#pragma unroll
            for (int ss = 0; ss < 2; ++ss) { const f32x4 t0 = mfma16(kf[2 * ss][db >> 1], If[db], zero4), t1 = mfma16(kf[2 * ss + 1][db >> 1], If[db], zero4); u = mfma16(pack8(t0, t1), VF[ss], u); }
            const f32x4 el = *(const LAS f32x4*)(lds + GL_EL + par * 256 + (16 * db + 4 * g) * 4);
            S[db] = u * el; }
        LAS unsigned char* ob = lds + GL_OB + par * GL_OBS; LAS float* ps = (LAS float*)(lds + GL_PS + par * 2048);
#pragma unroll
        for (int tb = 0; tb < 4; ++tb)
#pragma unroll
            for (int r = 0; r < 4; ++r) { const int t = 16 * tb + 4 * g + r; const float ov = O[tb][r]; float q = ov * ov; q += __shfl_xor(q, 1); q += __shfl_xor(q, 2); q += __shfl_xor(q, 4); q += __shfl_xor(q, 8);
                if (l15 == 0) ps[t * 8 + eb] = q;
                *(LAS bf16*)(ob + t * 272 + (16 * eb + l15) * 2) = (bf16)f2bf(ov); }
        if (c + 1 < SEQ / 64) GLA_STAGE(par ^ 1);
        __syncthreads();
#pragma unroll
        for (int i = 0; i < 2; ++i) { const int ot = (tid + 512 * i) >> 4; const f32x4 p0 = *(const LAS f32x4*)(ps + ot * 8), p1 = *(const LAS f32x4*)(ps + ot * 8 + 4);
            const float ss = ((p0[0] + p0[1]) + (p0[2] + p0[3])) + ((p1[0] + p1[1]) + (p1[2] + p1[3])); const float rs = rsqrtf(ss * (1.0f / 128.0f) + EPS);
            const v4u ov = *(const LAS v4u*)(ob + ot * 272 + opc * 16); const unsigned oa[4] = {ov.x, ov.y, ov.z, ov.w}, ga[4] = {rg[i].x, rg[i].y, rg[i].z, rg[i].w};
            const float gn[8] = {gg0[0], gg0[1], gg0[2], gg0[3], gg1[0], gg1[1], gg1[2], gg1[3]}; v4u w; unsigned* wp = (unsigned*)&w;
#pragma unroll
            for (int j = 0; j < 4; ++j) { const float o0 = __builtin_bit_cast(float, oa[j] << 16), o1 = __builtin_bit_cast(float, oa[j] & 0xffff0000u), g0 = __builtin_bit_cast(float, ga[j] << 16), g1 = __builtin_bit_cast(float, ga[j] & 0xffff0000u);
                wp[j] = pg8::cvtpk(o0 * rs * gn[2 * j] * (g0 / (1.0f + __expf(-g0))), o1 * rs * gn[2 * j + 1] * (g1 / (1.0f + __expf(-g1)))); }
            *(v4u*)(CAT + (tok0 + ot) * DM + 512 + h * 128 + opc * 8) = w; }
    }
#undef GLA_STAGE
    __syncthreads();
}

__device__ __forceinline__ void router_phase(Frame& F, const bf16* X2, const float* WR, const float* b_router, float* rsl, float* gate, unsigned* assign, unsigned* list, gu32* cnt) {
    LAS float* xs = (LAS float*)(F.lds + RING_OFF);
    LAS float* wsh = xs + 128 * 129;
    LAS float* lg = wsh + 128 * 32;
    LAS unsigned* hist = (LAS unsigned*)(lg + 128 * 33);
    const int tid = F.tid, t = tid & 63, eg = tid >> 6;
    for (int blk = F.vcu; blk < NTOK / 128; blk += F.G) {
        const size_t tok0 = (size_t)blk * 128;
        f32x4 acc0 = (f32x4){0.f, 0.f, 0.f, 0.f}, acc1 = acc0; float ssq0 = 0.f, ssq1 = 0.f;
        v4u rx[4]; f32x4 rw[2];
#define RT_LOAD(kc) do { _Pragma("unroll") for (int i = 0; i < 4; ++i) rx[i] = *(const v4u*)(X2 + (tok0 + (tid >> 4) + 32 * i) * DM + (kc) + (tid & 15) * 8); \
        _Pragma("unroll") for (int i = 0; i < 2; ++i) rw[i] = *(const f32x4*)(WR + (size_t)(kc) * 32 + (i * 512 + tid) * 4); } while (0)
        RT_LOAD(0);
        for (int kc = 0; kc < DM; kc += 128) {
#pragma unroll
            for (int i = 0; i < 4; ++i) { LAS float* dp = xs + ((tid >> 4) + 32 * i) * 129 + (tid & 15) * 8; const unsigned wv[4] = {rx[i].x, rx[i].y, rx[i].z, rx[i].w};
#pragma unroll
                for (int j = 0; j < 4; ++j) { dp[2 * j] = __builtin_bit_cast(float, wv[j] << 16); dp[2 * j + 1] = __builtin_bit_cast(float, wv[j] & 0xffff0000u); } }
#pragma unroll
            for (int i = 0; i < 2; ++i) *(LAS f32x4*)(wsh + (i * 512 + tid) * 4) = rw[i];
            __syncthreads();
            if (kc + 128 < DM) RT_LOAD(kc + 128);
            const LAS float* xr0 = xs + t * 129; const LAS float* xr1 = xs + (t + 64) * 129;
#pragma unroll 8
            for (int k = 0; k < 128; ++k) { const float x0 = xr0[k], x1 = xr1[k]; const f32x4 w = *(const LAS f32x4*)(wsh + k * 32 + eg * 4); acc0 = acc0 + w * x0; acc1 = acc1 + w * x1; ssq0 += x0 * x0; ssq1 += x1 * x1; }
            __syncthreads();
        }
#undef RT_LOAD
        const float rs0 = rsqrtf(ssq0 * (1.0f / DM) + EPS), rs1 = rsqrtf(ssq1 * (1.0f / DM) + EPS);
#pragma unroll
        for (int i = 0; i < 4; ++i) { const float br = b_router[eg * 4 + i]; lg[t * 33 + eg * 4 + i] = acc0[i] * rs0 + br; lg[(t + 64) * 33 + eg * 4 + i] = acc1[i] * rs1 + br; }
        if (eg == 0) { lg[t * 33 + 32] = rs0; lg[(t + 64) * 33 + 32] = rs1; }
        __syncthreads();
        if (tid < 128) {
            const int w2 = tid >> 6;
            float lv[32];
#pragma unroll
            for (int e = 0; e < 32; ++e) lv[e] = lg[tid * 33 + e];
            const float rs = lg[tid * 33 + 32];
            float tv[4]; int te[4];
#pragma unroll
            for (int k = 0; k < 4; ++k) { float best = -INFINITY; int bi = 0;
#pragma unroll
                for (int e = 0; e < 32; ++e) if (lv[e] > best) { best = lv[e]; bi = e; }
                tv[k] = best; te[k] = bi;
#pragma unroll
                for (int e = 0; e < 32; ++e) if (e == bi) lv[e] = -INFINITY; }
            const float e1 = __expf(tv[1] - tv[0]), e2 = __expf(tv[2] - tv[0]), e3 = __expf(tv[3] - tv[0]); const float inv = 1.0f / (1.0f + e1 + e2 + e3);
            const float gv[4] = {inv, e1 * inv, e2 * inv, e3 * inv};
            const size_t tok = tok0 + tid;
            LAS unsigned* hs = hist + w2 * 32; LAS unsigned* gbase = hist + 64 + w2 * 32;
            if (t < 32) hs[t] = 0u;
            __builtin_amdgcn_wave_barrier(); LDS_WAIT();
            unsigned lpos[4];
#pragma unroll
            for (int k = 0; k < 4; ++k) lpos[k] = __hip_atomic_fetch_add(hs + te[k], 1u, __ATOMIC_RELAXED, __HIP_MEMORY_SCOPE_WORKGROUP);
            __builtin_amdgcn_wave_barrier(); LDS_WAIT();
            if (t < 32) { const unsigned n = hs[t]; gbase[t] = n ? __hip_atomic_fetch_add(cnt + 64 * t, n, RLX_AGENT) : 0u; }
            __builtin_amdgcn_wave_barrier(); LDS_WAIT();
#pragma unroll
            for (int k = 0; k < 4; ++k) { const unsigned pos = gbase[te[k]] + lpos[k]; list[(size_t)te[k] * NTOK + pos] = (unsigned)tok; rsl[(size_t)te[k] * NTOK + pos] = rs;
                assign[tok * 4 + k] = ((unsigned)te[k] << 16) | pos; gate[tok * 4 + k] = gv[k]; }
        }
        __syncthreads();
    }
}
__device__ __forceinline__ int moe_tables(Frame& F) {
    LAS unsigned char* tile_e = F.lds + TAB_OFF; LAS int* tstart = (LAS int*)(F.lds + TAB_TSTART); LAS int* lc = (LAS int*)(F.lds + TAB_CNT);
    if (F.tid < 32) lc[F.tid] = (int)__hip_atomic_load(F.ctl + CW_CNT + 64 * F.tid, RLX_AGENT);
    __syncthreads();
    if (F.tid == 0) { int s = 0; for (int e = 0; e < 32; ++e) { tstart[e] = s; s += (lc[e] + 255) >> 8; } tstart[32] = s; }
    __syncthreads();
    const int T = tstart[32];
    for (int i = F.tid; i < T; i += 512) { int e = 0;
#pragma unroll
        for (int k = 1; k < 32; ++k) e += (tstart[k] <= i) ? 1 : 0;
        tile_e[i] = (unsigned char)e; }
    __syncthreads();
    return T;
}
__device__ __forceinline__ void final_phase(Frame& F, const bf16* X2, float* out, const unsigned char* Y, const float* gate, const unsigned* assign, const float* gfin) {
    (void)moe_tables(F);
    const LAS int* tstart = (const LAS int*)(F.lds + TAB_TSTART);
    const int gw = F.vcu * NWAVES + F.wave, NGW = F.G * NWAVES, lane = lane_here();
    for (int tok = gw; tok < NTOK; tok += NGW) {
        f32x4* xr = (f32x4*)(out + (size_t)tok * DM) + lane; f32x4 v[4]; const v2u* xin = (const v2u*)(X2 + (size_t)tok * DM) + lane;
#pragma unroll
        for (int j = 0; j < 4; ++j) { const v2u w = xin[64 * j]; v[j] = (f32x4){__builtin_bit_cast(float, w.x << 16), __builtin_bit_cast(float, w.x & 0xffff0000u), __builtin_bit_cast(float, w.y << 16), __builtin_bit_cast(float, w.y & 0xffff0000u)}; }
#pragma unroll
        for (int k = 0; k < 4; ++k) { const unsigned a = assign[(size_t)tok * 4 + k]; const float gk = gate[(size_t)tok * 4 + k]; const size_t row = (size_t)tstart[a >> 16] * 256 + (a & 0xffffu);
            const unsigned* yr = (const unsigned*)(Y + row * DM) + lane;
#pragma unroll
            for (int j = 0; j < 4; ++j) { const unsigned w = yr[64 * j]; const auto lo = __builtin_amdgcn_cvt_pk_f32_fp8((int)w, false), hi = __builtin_amdgcn_cvt_pk_f32_fp8((int)w, true);
                v[j].x += gk * lo[0]; v[j].y += gk * lo[1]; v[j].z += gk * hi[0]; v[j].w += gk * hi[1]; } }
        float s = 0.f;
#pragma unroll
        for (int j = 0; j < 4; ++j) s += (v[j].x * v[j].x + v[j].y * v[j].y) + (v[j].z * v[j].z + v[j].w * v[j].w);
        const float rs = rsqrtf(wave_sum(s) * (1.0f / DM) + EPS);
#pragma unroll
        for (int j = 0; j < 4; ++j) { const f32x4 gg = ((const f32x4*)gfin)[lane + 64 * j]; xr[64 * j] = v[j] * rs * gg; }
    }
}

constexpr int NPHASE = 12;
struct Args { const void* in[28]; float* out; unsigned char* ws; int ph_lo, ph_hi; };
__global__ void __launch_bounds__(NWAVES * 64, 2) mk_fwd(Args args) {
    extern __shared__ __attribute__((aligned(16))) unsigned char lds[];
    Frame F;
    F.lds = (LAS unsigned char*)lds;
    F.MISC = (volatile LAS unsigned*)(F.lds + MISC_OFF);
    F.tid = threadIdx.x; F.lane = F.tid & 63; F.wave = __builtin_amdgcn_readfirstlane(F.tid >> 6);
    F.G = gridDim.x; { const int bx = blockIdx.x; F.vcu = (F.G % 8 == 0) ? (bx % 8) * (F.G / 8) + bx / 8 : bx; }
    F.ws = args.ws; F.out = args.out; F.ctl = (gu32*)(args.ws + WS_CTL);
    unsigned char* ws = args.ws;
    typedef const void* const volatile __attribute__((address_space(4))) kargp_t;
    kargp_t* const kargs = (kargp_t*)__builtin_amdgcn_kernarg_segment_ptr();
#define INP(k) ((const float*)kargs[k])
    for (int u = F.tid; u < (LDS_BYTES - LDSCTL_OFF) / 4; u += NWAVES * 64) ((LAS unsigned*)(F.lds + LDSCTL_OFF))[u] = 0u;
    __syncthreads();
    const int lo = args.ph_lo, hi = args.ph_hi;
    const bool single = (hi - lo) > 1;
    XcdBarrier bar; bar.bar = (unsigned*)(F.ctl + CW_BAR); bar.x = 0; bar.st = nullptr;
    if (single) bar = xcd_barrier_post((unsigned*)(F.ctl + CW_BAR), F.MISC + 8);
#define IN(k) (lo <= (k) && (k) < hi)
#if defined(PROBE_K0)
    LAS unsigned long long* tsl = (LAS unsigned long long*)(F.lds + TS_OFF);
    if (F.tid == 0) tsl[0] = rt();
#define SEAM(k) do { if (IN(k) && IN((k) + 1)) xcd_barrier(bar); if (F.tid == 0) tsl[(k) + 1] = rt(); } while (0)
#define SEAM_LOCAL(k) do { if (F.tid == 0) tsl[(k) + 1] = rt(); } while (0)
#else
#define SEAM(k) do { if (IN(k) && IN((k) + 1)) xcd_barrier(bar); } while (0)
#define SEAM_LOCAL(k) do { } while (0)
#endif
    typedef pg8::bf16_t hb;
    const int bx = (int)blockIdx.x;

    if (IN(0)) { In I;
        I.x = (const float*)INP(0);
        I.mem = (const float*)INP(1);
        I.positions = (const int*)INP(2);
        I.norm_mix_g = (const float*)INP(3);
        I.w_in = (const float*)INP(4);
        I.lq1 = (const float*)INP(5);
        I.lk1 = (const float*)INP(6);
        I.lq2 = (const float*)INP(7);
        I.lk2 = (const float*)INP(8);
        I.diff_norm_g = (const float*)INP(9);
        I.w_alpha2 = (const float*)INP(10);
        I.b_alpha = (const float*)INP(11);
        I.gla_norm_g = (const float*)INP(12);
        I.w_out = (const float*)INP(13);
        I.norm_cross_g = (const float*)INP(14);
        I.norm_mem_g = (const float*)INP(15);
        I.w_cq = (const float*)INP(16);
        I.w_ck = (const float*)INP(17);
        I.w_cv = (const float*)INP(18);
        I.w_co = (const float*)INP(19);
        I.norm_ffn_g = (const float*)INP(20);
        I.w_router = (const float*)INP(21);
        I.b_router = (const float*)INP(22);
        I.w_up = (const float*)INP(23);
        I.b_up = (const float*)INP(24);
        I.w_down = (const float*)INP(25);
        I.b_down = (const float*)INP(26);
        I.norm_final_g = (const float*)INP(27);
        p0_prologue(F, I); }
    SEAM(0);
    if (IN(1)) {
        pg8::Gemm g{(const hb*)(ws + WS_HN), (const hb*)(ws + WS_WINT), NTOK, 3328, DM, DM, DM, 127, 127};
        typedef pg8::OrderP1<(unsigned)WS_HN, (unsigned)WS_WINT, (unsigned)WS_MN, (unsigned)WS_WCK, (unsigned)WS_WCV> OrdP1; OrdP1 S; S.G = F.G; S.c = bx; S.ws = (const char*)ws;
        pg8::EpiP1 E{pg8::EpiProj{(hb*)(ws + WS_P), (float*)(ws + WS_LA), (const float*)(ws + WS_CS), INP(11)}, pg8::EpiPlain{(hb*)(ws + WS_VT) - (size_t)1024 * NTOK, NTOK, 1.0f},
                     pg8::EpiPlain{(hb*)(ws + WS_KX), DM, 1.0f}, pg8::EpiPlain{(hb*)(ws + WS_VXT), NMEM, 1.0f}};
        pg8::gemm_phase<pg8::EpiP1, OrdP1, true, true, false, false>(F.lds + RING_OFF, g, S, E);
    }
    SEAM(1);
    if (IN(2)) {
        float lam;
        { const int ln = lane_here(); const float a = INP(5)[ln] * INP(6)[ln], c = INP(7)[ln] * INP(8)[ln]; lam = __expf(wave_sum(a)) - __expf(wave_sum(c)) + 0.2f; }
        LAS int* qslot = (LAS int*)(F.lds + TAB_OFF);
        for (;;) {
            if (F.tid == 0) qslot[0] = (int)__hip_atomic_fetch_add(F.ctl + CW_Q2, 1u, RLX_AGENT);
            __syncthreads();
            const int u = qslot[0];
            __syncthreads();
            if (u >= 64 + 1024 + MOE_UNITS) break;
            if (u >= 64 + 1024) { moe_convert_unit(u - (64 + 1024), INP(23), INP(25), INP(20), ws, F.wave, lane_here()); continue; }
#if defined(PROBE_SPLIT)
            if (u < 64) continue;
#endif
            if (u < 64) { gla_unit(F, (const bf16*)(ws + WS_P), (const float*)(ws + WS_LA), (const bf16*)(ws + WS_GVT), (bf16*)(ws + WS_CAT), INP(12), u >> 2, u & 3);
            }
            else { const int v = u - 64, bh = v & 63, qb = 15 - (v >> 6);
                diffattn_unit(F, (const bf16*)(ws + WS_P), (const bf16*)(ws + WS_VT), (bf16*)(ws + WS_CAT), INP(9), lam, bh >> 2, bh & 3, qb); }
        }
    }
#if defined(PROBE_SPLIT)
    if (IN(2)) { xcd_barrier(bar); if (F.tid == 0) tsl[13] = rt();
        for (int u = F.vcu; u < 64; u += F.G) gla_unit(F, (const bf16*)(ws + WS_P), (const float*)(ws + WS_LA), (const bf16*)(ws + WS_GVT), (bf16*)(ws + WS_CAT), INP(12), u >> 2, u & 3); }
#endif
    SEAM(2);
    if (IN(3)) {
        pg8::Gemm g{(const hb*)(ws + WS_CAT), (const hb*)(ws + WS_WOUT), NTOK, DM, DM, DM, DM, 127, 127}; pg8::StaticOrder S; S.init(NTOK, DM, F.G, bx);
        pg8::EpiRes1 E{INP(0), (hb*)(ws + WS_X1B), (float*)(ws + WS_SSP1)};
        pg8::gemm_phase<pg8::EpiRes1, pg8::StaticOrder, true, true, false, false>(F.lds + RING_OFF, g, S, E);
    }
    SEAM(3);
    if (IN(4)) {
        pg8::Gemm g{(const hb*)(ws + WS_X1B), (const hb*)(ws + WS_WCQ), NTOK, DM, DM, DM, DM, 127, 127}; pg8::StaticOrder S; S.init(NTOK, DM, F.G, bx);
        pg8::EpiQX E{(hb*)(ws + WS_QX), (const float*)(ws + WS_SSP1)};
        pg8::gemm_phase<pg8::EpiQX, pg8::StaticOrder, true, true, false, false>(F.lds + RING_OFF, g, S, E);
    }
    SEAM_LOCAL(4);
    if (IN(5)) {
        pg8::Gemm g{(const hb*)(ws + WS_QX), (const hb*)(ws + WS_KX), NTOK, 256, 256, DM, DM, 127, 127}; pg8::OrderX1 S; S.init(F.G, bx);
        pg8::EpiSoftmax E{(hb*)(ws + WS_PX), (float*)(ws + WS_SSP1), (PG8_LAS float*)(F.lds + XCH_OFF)};
        pg8::gemm_phase<pg8::EpiSoftmax, pg8::OrderX1, true, true>(F.lds + RING_OFF, g, S, E);
    }
    SEAM_LOCAL(5);
    if (IN(6)) {
        pg8::Gemm g{(const hb*)(ws + WS_PX), (const hb*)(ws + WS_VXT), NTOK, 256, 256, DM, NMEM, 127, 127}; pg8::OrderX2 S; S.init(F.G, bx);
        pg8::EpiPV E{(hb*)(ws + WS_OX), (const float*)(ws + WS_SSP1)};
        pg8::gemm_phase<pg8::EpiPV, pg8::OrderX2, true, true>(F.lds + RING_OFF, g, S, E);
    }
    SEAM(6);
    if (IN(7)) {
        pg8::Gemm g{(const hb*)(ws + WS_OX), (const hb*)(ws + WS_WCO), NTOK, DM, DM, DM, DM, 127, 127}; pg8::StaticOrder S; S.init(NTOK, DM, F.G, bx);
        pg8::EpiRes2 E{(hb*)(ws + WS_X1B), ws + WS_X2B};
        pg8::gemm_phase<pg8::EpiRes2, pg8::StaticOrder, true, true, false, false>(F.lds + RING_OFF, g, S, E);
    }
    SEAM(7);
    if (IN(8)) router_phase(F, (const bf16*)(ws + WS_X1B), (const float*)(ws + WS_WR), INP(22), (float*)(ws + WS_RSL), (float*)(ws + WS_GATE), (unsigned*)(ws + WS_ASSIGN), (unsigned*)(ws + WS_LIST), F.ctl + CW_CNT);
    SEAM(8);
    if (IN(9)) {
        const int T = moe_tables(F);
        pg8::Gemm g{(const hb*)(ws + WS_X2B), (const hb*)(ws + WS_WUP), T * 256, NEXP * 2048, 512, 512, 512, 127, 122}; pg8::MoeOrderG S;
        S.init(T, 8, F.G, bx, (const PG8_LAS unsigned char*)(F.lds + TAB_OFF), (const PG8_LAS int*)(F.lds + TAB_TSTART), (const PG8_LAS int*)(F.lds + TAB_CNT), (const unsigned*)(ws + WS_LIST), (PG8_LAS unsigned*)(F.lds + XCH_OFF));
        pg8::EpiUp E{ws + WS_ACT, (const float*)(ws + WS_RSL), (const PG8_LAS int*)(F.lds + TAB_TSTART), (const PG8_LAS int*)(F.lds + TAB_CNT), INP(24)};
        pg8::gemm_phase<pg8::EpiUp, pg8::MoeOrderG, true, true, true, false>(F.lds + RING_OFF, g, S, E);
    }
    SEAM(9);
    if (IN(10)) {
        const int T = moe_tables(F);
        pg8::Gemm g{(const hb*)(ws + WS_ACT), (const hb*)(ws + WS_WDN), T * 256, NEXP * 1024, 512, 512, 512, 127, 122}; pg8::MoeOrder S; S.init(T, 4, F.G, bx, (const PG8_LAS unsigned char*)(F.lds + TAB_OFF));
        pg8::EpiDown E{ws + WS_Y, INP(26)};
        pg8::gemm_phase<pg8::EpiDown, pg8::MoeOrder, true, true, true, false>(F.lds + RING_OFF, g, S, E);
    }
    SEAM(10);
    if (IN(11)) final_phase(F, (const bf16*)(ws + WS_X1B), F.out, (const unsigned char*)(ws + WS_Y), (const float*)(ws + WS_GATE), (const unsigned*)(ws + WS_ASSIGN), INP(27));
#if defined(PROBE_K0)
    { if (F.tid == 0) { tsl[NPHASE] = rt();
        const int ks[2] = {PROBE_K0, PROBE_K1}; unsigned long long code = 0, mul = 1;
        for (int i = 0; i < 2; ++i) { unsigned long long dt = ks[i] == 97 ? tsl[13] - tsl[2] : ks[i] == 98 ? tsl[3] - tsl[13] : tsl[ks[i] + 1] - tsl[ks[i]]; unsigned long long q = (dt + 800) / 1600; if (q > 63) q = 63; code += q * mul; mul *= 64; }
        tsl[15] = code * 6400ull; }
      __syncthreads();
      const unsigned long long t0 = rt(), wait = tsl[15]; float x = (float)F.tid, y = 1.0001f;
      while (rt() - t0 < wait) {
#pragma unroll
          for (int i = 0; i < 64; ++i) x = x * y + 0.5f; }
      if (x == 12345.678f) F.out[0] = x; }
#endif
#undef IN
#undef SEAM
#undef SEAM_LOCAL
}

#ifndef MK_N_LAUNCHES
#define MK_N_LAUNCHES 1
#endif
extern "C" void kernel_launch(void* const* d_in, const int* in_sizes, int n_in, void* d_out, int out_size, void* d_ws, size_t ws_size, hipStream_t stream) {
    static int grid = 0;
    if (grid == 0) {
        if (n_in != 28 || out_size != NTOK * DM || ws_size < WS_END) { fprintf(stderr, "kernel_launch: unexpected shapes: n_in %d out %d ws %zu (need %zu)\n", n_in, out_size, ws_size, (size_t)WS_END); grid = -1; return; }
        int dev = 0, cus = 0, per_cu = 0;
        if (hipGetDevice(&dev) != hipSuccess || hipDeviceGetAttribute(&cus, hipDeviceAttributeMultiprocessorCount, dev) != hipSuccess) { fprintf(stderr, "kernel_launch: device query failed\n"); grid = -1; return; }
        if (hipFuncSetAttribute((const void*)mk_fwd, hipFuncAttributeMaxDynamicSharedMemorySize, LDS_BYTES) != hipSuccess) { fprintf(stderr, "kernel_launch: hipFuncSetAttribute failed\n"); grid = -1; return; }
        if (hipOccupancyMaxActiveBlocksPerMultiprocessor(&per_cu, (const void*)mk_fwd, NWAVES * 64, LDS_BYTES) != hipSuccess || per_cu < 1) { fprintf(stderr, "kernel_launch: occupancy query reports %d workgroups per CU\n", per_cu); (void)hipGetLastError(); grid = -1; return; }
        grid = cus;
    }
    if (grid < 0) return;
    (void)hipMemsetAsync((char*)d_ws + WS_CTL, 0, CTL_ZERO_BYTES, stream);
    Args a{};
    for (int i = 0; i < 28; ++i) a.in[i] = d_in[i];
    a.out = (float*)d_out; a.ws = (unsigned char*)d_ws;
    if (MK_N_LAUNCHES == 1) { a.ph_lo = 0; a.ph_hi = NPHASE; hipLaunchKernelGGL(mk_fwd, dim3(grid), dim3(NWAVES * 64), LDS_BYTES, stream, a); }
    else for (int p = 0; p < NPHASE; ++p) { a.ph_lo = p; a.ph_hi = p + 1; hipLaunchKernelGGL(mk_fwd, dim3(grid), dim3(NWAVES * 64), LDS_BYTES, stream, a); }
}
```

```cpp
#include <hip/hip_runtime.h>
#include <cstdio>
#include <cstdint>
namespace pg8 {
#define PG8_LAS __attribute__((address_space(3)))
typedef unsigned short bf16_t;
typedef short bf16x8 __attribute__((ext_vector_type(8)));
typedef float f32x4 __attribute__((ext_vector_type(4)));
typedef unsigned u32x4 __attribute__((ext_vector_type(4)));
constexpr int BM = 256, BK = 64, HALF = 128, HTB = HALF * BK * 2  , STAGE_BYTES = 8 * HTB, NXCD = 8, WGM = 8;

__host__ __device__ __forceinline__ int lds_byte(int r, int c) { const int st = (r >> 4) * 2 + (c >> 5), rr = r & 15, cc = c & 31, ob = rr * 64 + cc * 2; return st * 1024 + (ob ^ (((ob >> 9) & 1) << 5)); }
__host__ __device__ __forceinline__ void stage_rc(int b, int& R, int& C) { const int st = b / 1024, sb = b % 1024, swz = sb ^ (((sb >> 9) & 1) << 5); R = (st >> 1) * 16 + swz / 64; C = (st & 1) * 32 + (swz % 64) / 2; }
__host__ __device__ __forceinline__ int perm32(int rho) { const int n = rho >> 4, i = rho & 15; return 8 * (i >> 2) + 4 * n + (i & 3); }

struct Unit { int pm, pn; };
struct Gemm { const bf16_t* A; const bf16_t* Bt; int M, N, K, lda, ldb, sa, sb; };
struct OrderBase {
    static constexpr bool GATHER = false;
    __device__ __forceinline__ const char* a_base(const Gemm& g, const Unit& u) const { return (const char*)g.A + (size_t)u.pm * 256 * g.lda * 2; }
    __device__ __forceinline__ const char* b_base(const Gemm& g, const Unit& u) const { return (const char*)g.Bt + (size_t)u.pn * 256 * g.ldb * 2; }
    __device__ __forceinline__ void a_ready(const Unit&) const {}
    __device__ __forceinline__ void done(const Unit&) const {}
};

struct StaticOrder : OrderBase {
    int nM, nN, nwg, G, c;
    __host__ __device__ void init(int M, int N, int G_, int c_) { nM = M / BM; nN = N / BM; nwg = nM * nN; G = G_; c = c_; }
    __host__ __device__ bool next(int i, Unit& u) const {
        const long L = (long)i * G + c; if (L >= nwg) return false;
        int wgid = (int)L; { const int q = nwg / NXCD, r = nwg % NXCD, xcd = wgid % NXCD, off = wgid / NXCD; wgid = (xcd < r ? xcd * (q + 1) : r * (q + 1) + (xcd - r) * q) + off; }
        const int nig = WGM * nN, gid = wgid / nig, fm = gid * WGM, gsz = (nM - fm) < WGM ? (nM - fm) : WGM;
        u.pm = fm + ((wgid % nig) % gsz); u.pn = (wgid % nig) / gsz; return true;
    }
};

typedef unsigned u32x2 __attribute__((ext_vector_type(2)));
typedef float f32x2_t __attribute__((ext_vector_type(2)));
typedef __bf16 bf16x2_t __attribute__((ext_vector_type(2)));
__device__ __forceinline__ unsigned cvtpk(float lo, float hi) { f32x2_t v = {lo, hi}; bf16x2_t b = __builtin_convertvector(v, bf16x2_t); return __builtin_bit_cast(unsigned, b); }
__device__ __forceinline__ void st_bf4(bf16_t* p, f32x4 v) { u32x2 w; w.x = cvtpk(v[0], v[1]); w.y = cvtpk(v[2], v[3]); *(u32x2*)p = w; }
__device__ __forceinline__ unsigned cvt4_fp8(f32x4 v) { unsigned w = __builtin_amdgcn_cvt_pk_fp8_f32(v[0], v[1], 0, false); return __builtin_amdgcn_cvt_pk_fp8_f32(v[2], v[3], w, true); }
__device__ __forceinline__ void st_bf8(bf16_t* p, f32x4 a, f32x4 c) { u32x4 w; w.x = cvtpk(a[0], a[1]); w.y = cvtpk(a[2], a[3]); w.z = cvtpk(c[0], c[1]); w.w = cvtpk(c[2], c[3]); *(u32x4*)p = w; }
__device__ __forceinline__ float bf2f(bf16_t b) { return __builtin_bit_cast(float, (unsigned)b << 16); }
#define EPI_ROWS _Pragma("unroll") for (int ai = 0; ai < 2; ++ai) _Pragma("unroll") for (int m = 0; m < 4; ++m)
#define EPI_COLS _Pragma("unroll") for (int bj = 0; bj < 2; ++bj) _Pragma("unroll") for (int n = 0; n < 2; ++n)
constexpr float LOG2E = 1.4426950408889634f;
constexpr float QSCALE_DA = 0.125f * LOG2E;
constexpr float QSCALE_X = 0.0625f * LOG2E;

struct EpiPlain {
    static constexpr bool PERM = true, AFTER_DRAIN = false;
    bf16_t* O; int ldc; float scale;
    __device__ __forceinline__ void operator()(const f32x4 (&acc)[2][2][4][2], const Unit& u, int wr, int wc, int fr, int fq) const {
        EPI_ROWS { const int row = u.pm * 256 + ai * 128 + wr * 64 + m * 16 + fr; bf16_t* rp = O + (size_t)row * ldc + u.pn * 256 + wc * 32 + fq * 8;
            _Pragma("unroll") for (int bj = 0; bj < 2; ++bj) st_bf8(rp + bj * 128, acc[ai][bj][m][0] * scale, acc[ai][bj][m][1] * scale); }
    }
};
struct EpiProj {
    static constexpr bool PERM = true, AFTER_DRAIN = false;
    bf16_t* P; float* LA; const float* cs; const float* b_alpha;
    template <int ai> __device__ __forceinline__ void decay_rows(const f32x4 (&acc)[2][2][4][2], const Unit& u, int wr, int wc, int fr, int fq) const {
        const int row0 = u.pm * 256 + ai * 128 + wr * 64 + fr;
        EPI_COLS { const int col = bj * 128 + wc * 32 + fq * 8 + n * 4; const f32x4 ba = *(const f32x4*)(b_alpha + col); f32x4 run = {0.f, 0.f, 0.f, 0.f};
            _Pragma("unroll") for (int m = 0; m < 4; ++m) { const f32x4 z = acc[ai][bj][m][n] + ba; f32x4 o;
                _Pragma("unroll") for (int i = 0; i < 4; ++i) { float v = (fminf(z[i], 0.f) - __logf(1.0f + __expf(-fabsf(z[i])))) * 0.0625f;
                    { float t = __shfl_up(v, 1, 16); if (fr >= 1) v += t; t = __shfl_up(v, 2, 16); if (fr >= 2) v += t; t = __shfl_up(v, 4, 16); if (fr >= 4) v += t; t = __shfl_up(v, 8, 16); if (fr >= 8) v += t; }
                    o[i] = v + run[i]; run[i] += __shfl(v, 15, 16); }
                *(f32x4*)(LA + (size_t)(row0 + m * 16) * 256 + col) = o; } }
    }
    __device__ __forceinline__ void operator()(const f32x4 (&acc)[2][2][4][2], const Unit& u, int wr, int wc, int fr, int fq) const {
        const int pn = u.pn;
        if (pn < 4) {
            const float sc = pn < 2 ? QSCALE_DA : 1.0f; const bool ropew = (wc & 1) == 0; const bool rl = fq < 2, hi = fq == 1;
            EPI_ROWS { const int row = u.pm * 256 + ai * 128 + wr * 64 + m * 16 + fr; bf16_t* rp = P + (size_t)row * 3072 + pn * 256 + wc * 32 + fq * 8;
                f32x4 cv[2], sv[2];
                if (ropew) { const f32x4* cp = (const f32x4*)(cs + (size_t)row * 16); cv[0] = cp[0]; cv[1] = cp[1]; sv[0] = cp[2]; sv[1] = cp[3]; }
                _Pragma("unroll") for (int bj = 0; bj < 2; ++bj) { f32x4 v[2] = {acc[ai][bj][m][0], acc[ai][bj][m][1]};
                    if (ropew) { _Pragma("unroll") for (int n = 0; n < 2; ++n) { f32x4 p; p[0] = __shfl_xor(v[n][0], 16); p[1] = __shfl_xor(v[n][1], 16); p[2] = __shfl_xor(v[n][2], 16); p[3] = __shfl_xor(v[n][3], 16);
                            const f32x4 r = hi ? (v[n] * cv[n] + p * sv[n]) : (v[n] * cv[n] - p * sv[n]); v[n] = rl ? r : v[n]; } }
                    st_bf8(rp + bj * 128, v[0] * sc, v[1] * sc); } }
        } else if (pn < 12) {
            const float sc = pn == 6 ? 0.125f : 1.0f;
            EPI_ROWS { const int row = u.pm * 256 + ai * 128 + wr * 64 + m * 16 + fr; bf16_t* rp = P + (size_t)row * 3072 + pn * 256 + wc * 32 + fq * 8;
                _Pragma("unroll") for (int bj = 0; bj < 2; ++bj) st_bf8(rp + bj * 128, acc[ai][bj][m][0] * sc, acc[ai][bj][m][1] * sc); }
        } else {
            decay_rows<0>(acc, u, wr, wc, fr, fq); decay_rows<1>(acc, u, wr, wc, fr, fq);
        }
    }
};
struct EpiP1 {
    static constexpr bool PERM = true, AFTER_DRAIN = false;
    EpiProj proj; EpiPlain vt, kx, vxt;
    __device__ __forceinline__ void operator()(const f32x4 (&acc)[2][2][4][2], const Unit& u, int wr, int wc, int fr, int fq) const {
        const int job = u.pn >> 16; Unit v; v.pm = u.pm; v.pn = u.pn & 0xffff;
        if (job == 0) proj(acc, v, wr, wc, fr, fq); else if (job == 1) vt(acc, v, wr, wc, fr, fq); else if (job == 2) kx(acc, v, wr, wc, fr, fq); else vxt(acc, v, wr, wc, fr, fq);
    }
};
struct EpiRes1 {
    static constexpr bool PERM = true, AFTER_DRAIN = false;
    const float* base; bf16_t* xb; float* ssp;
    __device__ __forceinline__ void operator()(const f32x4 (&acc)[2][2][4][2], const Unit& u, int wr, int wc, int fr, int fq) const {
        EPI_ROWS { const int row = u.pm * 256 + ai * 128 + wr * 64 + m * 16 + fr; const size_t off = (size_t)row * 1024 + u.pn * 256 + wc * 32 + fq * 8; float ss = 0.f;
            _Pragma("unroll") for (int bj = 0; bj < 2; ++bj) { const size_t o2 = off + bj * 128; const f32x4 v0 = *(const f32x4*)(base + o2) + acc[ai][bj][m][0], v1 = *(const f32x4*)(base + o2 + 4) + acc[ai][bj][m][1]; st_bf8(xb + o2, v0, v1);
                ss += ((v0[0] * v0[0] + v0[1] * v0[1]) + (v0[2] * v0[2] + v0[3] * v0[3])) + ((v1[0] * v1[0] + v1[1] * v1[1]) + (v1[2] * v1[2] + v1[3] * v1[3])); }
            ss += __shfl_xor(ss, 16); ss += __shfl_xor(ss, 32);
            if (fq == 0) ssp[(size_t)row * 16 + u.pn * 4 + wc] = ss; }
    }
};
struct EpiQX {
    static constexpr bool PERM = true, AFTER_DRAIN = false;
    bf16_t* O; const float* ssp;
    __device__ __forceinline__ void operator()(const f32x4 (&acc)[2][2][4][2], const Unit& u, int wr, int wc, int fr, int fq) const {
        EPI_ROWS { const int row = u.pm * 256 + ai * 128 + wr * 64 + m * 16 + fr; const f32x4* sp = (const f32x4*)(ssp + (size_t)row * 16);
            const f32x4 a = sp[0], b = sp[1], c = sp[2], d = sp[3]; const float ss = ((a[0] + a[1]) + (a[2] + a[3])) + ((b[0] + b[1]) + (b[2] + b[3])) + ((c[0] + c[1]) + (c[2] + c[3])) + ((d[0] + d[1]) + (d[2] + d[3]));
            const float rs = rsqrtf(ss * (1.0f / 1024.0f) + 1e-6f) * QSCALE_X; bf16_t* rp = O + (size_t)row * 1024 + u.pn * 256 + wc * 32 + fq * 8;
            _Pragma("unroll") for (int bj = 0; bj < 2; ++bj) st_bf8(rp + bj * 128, acc[ai][bj][m][0] * rs, acc[ai][bj][m][1] * rs); }
    }
};
struct EpiRes2 {
    static constexpr bool PERM = true, AFTER_DRAIN = false;
    bf16_t* xh; unsigned char* x8;
    __device__ __forceinline__ void operator()(const f32x4 (&acc)[2][2][4][2], const Unit& u, int wr, int wc, int fr, int fq) const {
        EPI_ROWS { const int row = u.pm * 256 + ai * 128 + wr * 64 + m * 16 + fr; const size_t off = (size_t)row * 1024 + u.pn * 256 + wc * 32 + fq * 8;
            _Pragma("unroll") for (int bj = 0; bj < 2; ++bj) { bf16_t* p = xh + off + bj * 128; const u32x4 w = *(const u32x4*)p;
                f32x4 v0 = {__builtin_bit_cast(float, w.x << 16), __builtin_bit_cast(float, w.x & 0xffff0000u), __builtin_bit_cast(float, w.y << 16), __builtin_bit_cast(float, w.y & 0xffff0000u)};
                f32x4 v1 = {__builtin_bit_cast(float, w.z << 16), __builtin_bit_cast(float, w.z & 0xffff0000u), __builtin_bit_cast(float, w.w << 16), __builtin_bit_cast(float, w.w & 0xffff0000u)};
                v0 = v0 + acc[ai][bj][m][0]; v1 = v1 + acc[ai][bj][m][1]; st_bf8(p, v0, v1); u32x2 q; q.x = cvt4_fp8(v0); q.y = cvt4_fp8(v1); *(u32x2*)(x8 + off + bj * 128) = q; } }
    }
};
struct EpiUp {
    static constexpr bool PERM = true, AFTER_DRAIN = false;
    unsigned char* ACT; const float* rsl; const PG8_LAS int* tstart; const PG8_LAS int* cnt; const float* b_up;
    __device__ __forceinline__ void operator()(const f32x4 (&acc)[2][2][4][2], const Unit& u, int wr, int wc, int fr, int fq) const {
        const int e = u.pn >> 3, pnl = u.pn & 7; const float* bg = b_up + (size_t)e * 2048 + pnl * 128 + wc * 32 + fq * 8;
        const int pos0 = (u.pm - tstart[e]) * 256 + wr * 64 + fr, nv = cnt[e]; const float* rp0 = rsl + (size_t)e * 32768 + pos0;
        const f32x4 bg0 = *(const f32x4*)bg, bg1 = *(const f32x4*)(bg + 4), bl0 = *(const f32x4*)(bg + 1024), bl1 = *(const f32x4*)(bg + 1028);
        EPI_ROWS { const int row = u.pm * 256 + ai * 128 + wr * 64 + m * 16 + fr; const float rs = (pos0 + ai * 128 + m * 16) < nv ? rp0[ai * 128 + m * 16] : 0.f;
            unsigned char* rp = ACT + (size_t)row * 1024 + pnl * 128 + wc * 32 + fq * 8; u32x2 w;
            _Pragma("unroll") for (int n = 0; n < 2; ++n) { const f32x4 g = acc[ai][0][m][n] * rs + (n ? bg1 : bg0), l = acc[ai][1][m][n] * rs + (n ? bl1 : bl0); f32x4 o;
                _Pragma("unroll") for (int i = 0; i < 4; ++i) { const float gl = fminf(g[i], 7.0f), li = fminf(fmaxf(l[i], -7.0f), 7.0f); o[i] = gl * __builtin_amdgcn_rcpf(1.0f + __builtin_amdgcn_exp2f(-2.4554669595930156f * gl)) * (li + 1.0f); }
                if (n) w.y = cvt4_fp8(o); else w.x = cvt4_fp8(o); }
            *(u32x2*)rp = w; }
    }
};
struct EpiDown {
    static constexpr bool PERM = true, AFTER_DRAIN = false;
    unsigned char* Y; const float* b_down;
    __device__ __forceinline__ void operator()(const f32x4 (&acc)[2][2][4][2], const Unit& u, int wr, int wc, int fr, int fq) const {
        const int e = u.pn >> 2, pnl = u.pn & 3; const float* bp = b_down + (size_t)e * 1024 + pnl * 256 + wc * 32 + fq * 8;
        f32x4 bv[2][2];
        _Pragma("unroll") for (int bj = 0; bj < 2; ++bj) _Pragma("unroll") for (int n = 0; n < 2; ++n) bv[bj][n] = *(const f32x4*)(bp + bj * 128 + n * 4);
        EPI_ROWS { const int row = u.pm * 256 + ai * 128 + wr * 64 + m * 16 + fr; unsigned char* rp = Y + (size_t)row * 1024 + pnl * 256 + wc * 32 + fq * 8;
            _Pragma("unroll") for (int bj = 0; bj < 2; ++bj) { u32x2 w; w.x = cvt4_fp8(acc[ai][bj][m][0] + bv[bj][0]); w.y = cvt4_fp8(acc[ai][bj][m][1] + bv[bj][1]); *(u32x2*)(rp + bj * 128) = w; } }
    }
};
struct OrderMap : OrderBase {
    StaticOrder so;
    __device__ void init(int nM, int nN, int G, int c) { so.nM = nM; so.nN = nN; so.nwg = nM * nN; so.G = G; so.c = c; }
    __device__ bool next(int i, Unit& u) const { if (!so.next(i, u)) return false; u.pn += (u.pn >= 4 ? 2 : 0) + (u.pn >= 6 ? 2 : 0); return true; }
};
struct OrderVT : OrderBase {
    StaticOrder so;
    __device__ void init(int nN, int G, int c) { so.nM = 4; so.nN = nN; so.nwg = 4 * nN; so.G = G; so.c = c; }
    __device__ bool next(int i, Unit& u) const { if (!so.next(i, u)) return false; u.pm += (u.pm >= 2 ? 6 : 4); return true; }
};
__device__ __forceinline__ void map_unit(int L, int nM, int nN, int& pm, int& pn) {
    const int nwg = nM * nN; int wgid = L; { const int q = nwg / NXCD, r = nwg % NXCD, xcd = wgid % NXCD, off = wgid / NXCD; wgid = (xcd < r ? xcd * (q + 1) : r * (q + 1) + (xcd - r) * q) + off; }
    const int nig = WGM * nN, gid = wgid / nig, fm = gid * WGM, gsz = (nM - fm) < WGM ? (nM - fm) : WGM;
    pm = fm + ((wgid % nig) % gsz); pn = (wgid % nig) / gsz;
}
template <unsigned oHN, unsigned oWINT, unsigned oMN, unsigned oWCK, unsigned oWCV>
struct OrderP1 : OrderBase {
    int G, c; const char* ws;
    __device__ __forceinline__ bool next(int i, Unit& u) const {
        int L = i * G + c; if (L >= 1792) return false;
        if (L < 1152) { map_unit(L, 128, 9, u.pm, u.pn); u.pn += (u.pn >= 4 ? 2 : 0) + (u.pn >= 6 ? 2 : 0); return true; } L -= 1152;
        if (L < 512) { map_unit(L, 4, 128, u.pm, u.pn); u.pm += (u.pm >= 2 ? 6 : 4); u.pn |= 1 << 16; return true; } L -= 512;
        if (L < 64) { map_unit(L, 16, 4, u.pm, u.pn); u.pn |= 2 << 16; return true; } L -= 64;
        map_unit(L, 16, 4, u.pm, u.pn); u.pn |= 3 << 16; return true;
    }
    __device__ __forceinline__ const char* a_base(const Gemm&, const Unit& u) const { const int job = u.pn >> 16; unsigned o = oHN; o = job == 1 ? oWINT : o; o = job >= 2 ? oMN : o; return ws + o + (size_t)u.pm * (256 * 1024 * 2); }
    __device__ __forceinline__ const char* b_base(const Gemm&, const Unit& u) const { const int job = u.pn >> 16; unsigned o = oWINT; o = job == 1 ? oHN : o; o = job == 2 ? oWCK : o; o = job == 3 ? oWCV : o; return ws + o + (size_t)(u.pn & 0xffff) * (256 * 1024 * 2); }
};
struct MoeOrder : OrderBase {
    StaticOrder so; const PG8_LAS unsigned char* tile_e; int nN;
    __device__ void init(int nM, int nN_, int G, int c, const PG8_LAS unsigned char* te) { so.nM = nM; so.nN = nN_; so.nwg = nM * nN_; so.G = G; so.c = c; tile_e = te; nN = nN_; }
    __device__ bool next(int i, Unit& u) const { if (!so.next(i, u)) return false; u.pn += (int)tile_e[u.pm] * nN; return true; }
};


struct MoeOrderG : OrderBase {
    static constexpr bool GATHER = true;
    StaticOrder so; const PG8_LAS unsigned char* tile_e; const PG8_LAS int* tstart; const PG8_LAS int* cnt; const unsigned* list; PG8_LAS unsigned* gslot; int nN;
    __device__ void init(int nM, int nN_, int G, int c, const PG8_LAS unsigned char* te, const PG8_LAS int* ts, const PG8_LAS int* cn, const unsigned* li, PG8_LAS unsigned* gs) {
        so.nM = nM; so.nN = nN_; so.nwg = nM * nN_; so.G = G; so.c = c; tile_e = te; tstart = ts; cnt = cn; list = li; gslot = gs; nN = nN_; }
    __device__ bool next(int i, Unit& u) const { if (!so.next(i, u)) return false; u.pn += (int)tile_e[u.pm] * nN; return true; }
    __device__ __forceinline__ const char* a_base(const Gemm& g, const Unit&) const { return (const char*)g.A; }
    __device__ __forceinline__ const unsigned* rows(const Unit& u) const { const int e = u.pn / nN; return list + (size_t)e * 32768 + (size_t)(u.pm - tstart[e]) * 256; }
    __device__ __forceinline__ int nvalid(const Unit& u) const { const int e = u.pn / nN; return cnt[e] - (u.pm - tstart[e]) * 256; }
};
struct OrderX1 : OrderBase {
    StaticOrder so;
    __device__ void init(int G, int c) { so.nM = 128; so.nN = 4; so.nwg = 512; so.G = G; so.c = c; }
    __device__ bool next(int i, Unit& u) const { return so.next(i, u); }
    __device__ __forceinline__ const char* a_base(const Gemm& g, const Unit& u) const { return (const char*)(g.A + (size_t)u.pm * 256 * 1024 + u.pn * 256); }
    __device__ __forceinline__ const char* b_base(const Gemm& g, const Unit& u) const { return (const char*)(g.Bt + (size_t)(u.pm >> 3) * 256 * 1024 + u.pn * 256); }
};
struct OrderX2 : OrderBase {
    StaticOrder so;
    __device__ void init(int G, int c) { so.nM = 128; so.nN = 4; so.nwg = 512; so.G = G; so.c = c; }
    __device__ bool next(int i, Unit& u) const { return so.next(i, u); }
    __device__ __forceinline__ const char* a_base(const Gemm& g, const Unit& u) const { return (const char*)(g.A + (size_t)u.pm * 256 * 1024 + u.pn * 256); }
    __device__ __forceinline__ const char* b_base(const Gemm& g, const Unit& u) const { return (const char*)(g.Bt + (size_t)u.pn * 256 * 4096 + (u.pm >> 3) * 256); }
};
struct EpiSoftmax {
    static constexpr bool PERM = true, AFTER_DRAIN = false;
    bf16_t* PX; float* lp; PG8_LAS float* xch;
    __device__ __forceinline__ void operator()(const f32x4 (&acc)[2][2][4][2], const Unit& u, int wr, int wc, int fr, int fq) const {
        PG8_LAS char* rb = (PG8_LAS char*)xch + (wr * 64 + fr) * 16; asm volatile("" : "+v"(rb));
        PG8_LAS char* wb = rb + wc * 4; asm volatile("" : "+v"(wb));
        EPI_ROWS { float a = -INFINITY;
            EPI_COLS { const f32x4 v = acc[ai][bj][m][n]; a = fmaxf(a, fmaxf(fmaxf(v[0], v[1]), fmaxf(v[2], v[3]))); }
            a = fmaxf(a, __shfl_xor(a, 16)); a = fmaxf(a, __shfl_xor(a, 32));
            if (fq == 0) *(PG8_LAS float*)(wb + (ai * 128 + m * 16) * 16) = a; }
        asm volatile("s_waitcnt lgkmcnt(0)" ::: "memory"); __builtin_amdgcn_s_barrier(); asm volatile("" ::: "memory");
        const int row0 = u.pm * 256 + wr * 64 + fr; bf16_t* rp0 = PX + (size_t)row0 * 1024 + u.pn * 256 + wc * 32 + fq * 8; float* lp0 = lp + (size_t)row0 * 16 + u.pn * 4 + wc;
        EPI_ROWS { const f32x4 q = *(const PG8_LAS f32x4*)(rb + (ai * 128 + m * 16) * 16); const float mr = fmaxf(fmaxf(q[0], q[1]), fmaxf(q[2], q[3]));
            bf16_t* rp = rp0 + (size_t)(ai * 128 + m * 16) * 1024; float ps = 0.f;
            _Pragma("unroll") for (int bj = 0; bj < 2; ++bj) { f32x4 p[2];
                _Pragma("unroll") for (int n = 0; n < 2; ++n) _Pragma("unroll") for (int i = 0; i < 4; ++i) { p[n][i] = __builtin_amdgcn_exp2f(acc[ai][bj][m][n][i] - mr); ps += p[n][i]; }
                st_bf8(rp + bj * 128, p[0], p[1]); }
            ps += __shfl_xor(ps, 16); ps += __shfl_xor(ps, 32);
            if (fq == 0) lp0[(ai * 128 + m * 16) * 16] = ps; }
        asm volatile("s_waitcnt lgkmcnt(0)" ::: "memory"); __builtin_amdgcn_s_barrier(); asm volatile("" ::: "memory");
    }
};
struct EpiPV {
    static constexpr bool PERM = true, AFTER_DRAIN = false;
    bf16_t* O; const float* lp;
    __device__ __forceinline__ void operator()(const f32x4 (&acc)[2][2][4][2], const Unit& u, int wr, int wc, int fr, int fq) const {
        EPI_ROWS { const int row = u.pm * 256 + ai * 128 + wr * 64 + m * 16 + fr; const f32x4 q = *(const f32x4*)(lp + (size_t)row * 16 + u.pn * 4);
            const float inv = 1.0f / ((q[0] + q[1]) + (q[2] + q[3])); bf16_t* rp = O + (size_t)row * 1024 + u.pn * 256 + wc * 32 + fq * 8;
            _Pragma("unroll") for (int bj = 0; bj < 2; ++bj) st_bf8(rp + bj * 128, acc[ai][bj][m][0] * inv, acc[ai][bj][m][1] * inv); }
    }
};

template <unsigned oKX, unsigned oWCQR, unsigned oWCOT, unsigned oVX>
struct OrderGH : OrderBase {
    int G, c; const char* ws;
    __device__ __forceinline__ bool next(int i, Unit& u) const { int L = i * G + c; if (L >= 512) return false;
        if (L < 256) { u.pm = L >> 2; u.pn = L & 3; } else { L -= 256; u.pm = L >> 2; u.pn = (L & 3) | (1 << 16); } return true; }
    __device__ __forceinline__ const char* a_base(const Gemm&, const Unit& u) const { const int job = u.pn >> 16, pn = u.pn & 0xffff;
        return job == 0 ? ws + oKX + ((size_t)(u.pm >> 2) * 256 * 1024 + (u.pm & 3) * 256) * 2 : ws + oWCOT + ((size_t)(u.pm & 3) * 256 * 1024 + pn * 256) * 2; }
    __device__ __forceinline__ const char* b_base(const Gemm&, const Unit& u) const { const int job = u.pn >> 16, pn = u.pn & 0xffff;
        return job == 0 ? ws + oWCQR + ((size_t)pn * 256 * 1024 + (u.pm & 3) * 256) * 2 : ws + oVX + ((size_t)(u.pm >> 2) * 256 * 1024 + pn * 256) * 2; }
};
struct EpiGH {
    static constexpr bool PERM = true, AFTER_DRAIN = false;
    EpiPlain gt, ht;
    __device__ __forceinline__ void operator()(const f32x4 (&acc)[2][2][4][2], const Unit& u, int wr, int wc, int fr, int fq) const {
        Unit v; v.pm = u.pm; v.pn = u.pn & 0xffff; if ((u.pn >> 16) == 0) gt(acc, v, wr, wc, fr, fq); else ht(acc, v, wr, wc, fr, fq); }
};
struct OrderXS : OrderBase {
    StaticOrder so;
    __device__ void init(int G, int c) { so.nM = 128; so.nN = 4; so.nwg = 512; so.G = G; so.c = c; }
    __device__ bool next(int i, Unit& u) const { return so.next(i, u); }
    __device__ __forceinline__ const char* b_base(const Gemm& g, const Unit& u) const { return (const char*)(g.Bt + ((size_t)(u.pm >> 3) * 1024 + u.pn * 256) * 1024); }
};
struct EpiSoftmaxN {
    static constexpr bool PERM = true, AFTER_DRAIN = false;
    bf16_t* PX; const float* ssp; PG8_LAS float* xmax; PG8_LAS float* xsum;
    __device__ __forceinline__ void operator()(f32x4 (&acc)[2][2][4][2], const Unit& u, int wr, int wc, int fr, int fq) const {
        PG8_LAS char* rb = (PG8_LAS char*)xmax + (wr * 64 + fr) * 16; asm volatile("" : "+v"(rb));
        PG8_LAS char* wb = rb + wc * 4; asm volatile("" : "+v"(wb));
        PG8_LAS char* rb2 = (PG8_LAS char*)xsum + (wr * 64 + fr) * 16; asm volatile("" : "+v"(rb2));
        PG8_LAS char* wb2 = rb2 + wc * 4; asm volatile("" : "+v"(wb2));
        const int row0 = u.pm * 256 + wr * 64 + fr;
        EPI_ROWS { const f32x4* sp = (const f32x4*)(ssp + (size_t)(row0 + ai * 128 + m * 16) * 16);
            const f32x4 a4 = sp[0], b4 = sp[1], c4 = sp[2], d4 = sp[3]; const float ss = ((a4[0] + a4[1]) + (a4[2] + a4[3])) + ((b4[0] + b4[1]) + (b4[2] + b4[3])) + ((c4[0] + c4[1]) + (c4[2] + c4[3])) + ((d4[0] + d4[1]) + (d4[2] + d4[3]));
            const float rs = rsqrtf(ss * (1.0f / 1024.0f) + 1e-6f) * QSCALE_X; float a = -INFINITY;
            EPI_COLS { f32x4 v = acc[ai][bj][m][n] * rs; acc[ai][bj][m][n] = v; a = fmaxf(a, fmaxf(fmaxf(v[0], v[1]), fmaxf(v[2], v[3]))); }
            a = fmaxf(a, __shfl_xor(a, 16)); a = fmaxf(a, __shfl_xor(a, 32));
            if (fq == 0) *(PG8_LAS float*)(wb + (ai * 128 + m * 16) * 16) = a; }
        asm volatile("s_waitcnt lgkmcnt(0)" ::: "memory"); __builtin_amdgcn_s_barrier(); asm volatile("" ::: "memory");
        EPI_ROWS { const f32x4 q = *(const PG8_LAS f32x4*)(rb + (ai * 128 + m * 16) * 16); const float mr = fmaxf(fmaxf(q[0], q[1]), fmaxf(q[2], q[3])); float ps = 0.f;
            EPI_COLS { f32x4 p; _Pragma("unroll") for (int i = 0; i < 4; ++i) { p[i] = __builtin_amdgcn_exp2f(acc[ai][bj][m][n][i] - mr); ps += p[i]; } acc[ai][bj][m][n] = p; }
            ps += __shfl_xor(ps, 16); ps += __shfl_xor(ps, 32);
            if (fq == 0) *(PG8_LAS float*)(wb2 + (ai * 128 + m * 16) * 16) = ps; }
        asm volatile("s_waitcnt lgkmcnt(0)" ::: "memory"); __builtin_amdgcn_s_barrier(); asm volatile("" ::: "memory");
        bf16_t* rp0 = PX + (size_t)row0 * 1024 + u.pn * 256 + wc * 32 + fq * 8;
        EPI_ROWS { const f32x4 q = *(const PG8_LAS f32x4*)(rb2 + (ai * 128 + m * 16) * 16); const float inv = __builtin_amdgcn_rcpf((q[0] + q[1]) + (q[2] + q[3]));
            bf16_t* rp = rp0 + (size_t)(ai * 128 + m * 16) * 1024;
            _Pragma("unroll") for (int bj = 0; bj < 2; ++bj) st_bf8(rp + bj * 128, acc[ai][bj][m][0] * inv, acc[ai][bj][m][1] * inv); }
    }
};
struct OrderXO : OrderBase {
    StaticOrder so;
    __device__ void init(int G, int c) { so.nM = 128; so.nN = 4; so.nwg = 512; so.G = G; so.c = c; }
    __device__ bool next(int i, Unit& u) const { return so.next(i, u); }
    __device__ __forceinline__ const char* b_base(const Gemm& g, const Unit& u) const { return (const char*)(g.Bt + ((size_t)(u.pm >> 3) * 1024 + u.pn * 256) * 1024); }
};
typedef int v4i_t __attribute__((ext_vector_type(4))); typedef int v8i_t __attribute__((ext_vector_type(8)));
__device__ __forceinline__ v8i_t cat8(bf16x8 lo, bf16x8 hi) { return __builtin_shufflevector(__builtin_bit_cast(v4i_t, lo), __builtin_bit_cast(v4i_t, hi), 0, 1, 2, 3, 4, 5, 6, 7); }
__device__ __forceinline__ void mfma8(f32x4& acc, v8i_t w, v8i_t a, int sw, int sa) {
    asm volatile("s_nop 1\n\tv_mfma_scale_f32_16x16x128_f8f6f4 %0, %1, %2, %0, %3, %4 op_sel_hi:[0,0,0]" : "+v"(acc) : "v"(w), "v"(a), "v"(sw), "v"(sa)); }
constexpr int PF_D = 4, PF_LDS = 137216;
template <class Epi, class Sched, bool ALIGN_EPI = false, bool SP2 = false, bool FP8 = false, bool PF = false>
__device__ __forceinline__ void gemm_phase(PG8_LAS unsigned char* lds, const Gemm g, const Sched& S, const Epi& E) {
    const int tid = threadIdx.x, wid = __builtin_amdgcn_readfirstlane(tid >> 6), lane = tid & 63, wr = wid >> 2, wc = wid & 3, fr = lane & 15, fq = lane >> 4;
    const int K = g.K, nt = K / BK;
    unsigned voffA[2], voffB[2];
    unsigned gC[2][2];
#pragma unroll
    for (int i = 0; i < 2; ++i) { int R, C; stage_rc(tid * 16 + i * 8192, R, C); const int Rb = Epi::PERM ? ((R & ~31) + perm32(R & 31)) : R;
        voffA[i] = (unsigned)(R * g.lda + C) * 2u; voffB[i] = (unsigned)(Rb * g.ldb + C) * 2u; }
    const bool pfA = !Sched::GATHER && wid < 4;
    const unsigned pfoff = (unsigned)((((wid >> 1) & 1) * HALF + (wid & 1) * 64 + lane) * (pfA ? g.lda : g.ldb)) * 2u;
    const size_t kstep = (size_t)(BK * 2);
    const size_t hstepA = (size_t)HALF * g.lda * 2, hstepB = (size_t)HALF * g.ldb * 2;
    const unsigned ldsw = (unsigned)wid * 1024u;
    const int aoff = lds_byte(wr * 64 + fr, fq * 8), boff = lds_byte(wc * 32 + fr, fq * 8);
#define PG8_SA(b, h) (((b) * 2 + (h)) * HTB)
#define PG8_SB(b, h) ((4 + (b) * 2 + (h)) * HTB)
#define PG8_STAGE(bufoff, gbase, voff) do { _Pragma("unroll") for (int _i = 0; _i < 2; ++_i) \
        __builtin_amdgcn_global_load_lds((const unsigned*)((const char*)(gbase) + (voff)[_i]), (PG8_LAS unsigned*)(lds + (bufoff) + ldsw + _i * 8192), 16, 0, 0); } while (0)
#define PG8_STAGE_A(bufoff, ptr, h, nx) do { if constexpr (Sched::GATHER) { PG8_STAGE(bufoff, ptr, gC[h]); } else { PG8_STAGE(bufoff, (ptr) + ((h) ? hstepA : 0), voffA); } } while (0)
#define PG8_LDA(dst, b, h) do { _Pragma("unroll") for (int m = 0; m < 4; ++m) _Pragma("unroll") for (int k = 0; k < 2; ++k) dst[m][k] = *(const PG8_LAS bf16x8*)(lds + PG8_SA(b, h) + aoff + m * 2048 + k * 1024); } while (0)
#define PG8_LDB(dst, b, h) do { _Pragma("unroll") for (int n = 0; n < 2; ++n) _Pragma("unroll") for (int k = 0; k < 2; ++k) dst[n][k] = *(const PG8_LAS bf16x8*)(lds + PG8_SB(b, h) + boff + n * 2048 + k * 1024); } while (0)
#define PG8_MMA(ai, bj, At, Bt) do { __builtin_amdgcn_s_setprio(1); \
        if constexpr (FP8) { _Pragma("unroll") for (int m = 0; m < 4; ++m) _Pragma("unroll") for (int n = 0; n < 2; ++n) \
            mfma8(acc[ai][bj][m][n], cat8(Bt[n][0], Bt[n][1]), cat8(At[m][0], At[m][1]), g.sb, g.sa); } \
        else { _Pragma("unroll") for (int m = 0; m < 4; ++m) _Pragma("unroll") for (int n = 0; n < 2; ++n) _Pragma("unroll") for (int k = 0; k < 2; ++k) \
            acc[ai][bj][m][n] = __builtin_amdgcn_mfma_f32_16x16x32_bf16(Bt[n][k], At[m][k], acc[ai][bj][m][n], 0, 0, 0); } \
        __builtin_amdgcn_s_setprio(0); } while (0)
#define PG8_WAIT_V(n) asm volatile("s_waitcnt vmcnt(" #n ")" ::: "memory")
#define PG8_WAIT_VP() do { if constexpr (PF) asm volatile("s_waitcnt vmcnt(9)" ::: "memory"); else asm volatile("s_waitcnt vmcnt(8)" ::: "memory"); } while (0)
#define PG8_PREFETCH(tp) do { if constexpr (PF) { const int tp_ = (tp); const char* pb_ = tp_ < nt ? (pfA ? cA : cB) + (size_t)tp_ * kstep : (pfA ? nA : nB) + (size_t)(tp_ - nt) * kstep; \
        __builtin_amdgcn_global_load_lds((const unsigned*)(pb_ + pfoff), (PG8_LAS unsigned*)(lds + PF_LDS + wid * 256), 4, 0, 0); } } while (0)
#define PG8_WAIT_L(n) asm volatile("s_waitcnt lgkmcnt(" #n ")" ::: "memory")
#define PG8_BAR __builtin_amdgcn_s_barrier()
#define PG8_SCHED __builtin_amdgcn_sched_barrier(0)
    Unit cur, nxt; int ui = 0;
    if (!S.next(0, cur)) return;
    f32x4 acc[2][2][4][2];
#pragma unroll
    for (int a = 0; a < 2; ++a)
#pragma unroll
        for (int b = 0; b < 2; ++b)
#pragma unroll
            for (int m = 0; m < 4; ++m)
#pragma unroll
                for (int n = 0; n < 2; ++n) acc[a][b][m][n] = (f32x4){0.f, 0.f, 0.f, 0.f};
    bf16x8 At[4][2], B0[2][2], B1[2][2];
    const char* cA = S.a_base(g, cur); const char* cB = S.b_base(g, cur);
    if constexpr (Sched::GATHER) { const unsigned* rp = S.rows(cur); const int nv = S.nvalid(cur);
#pragma unroll
        for (int h = 0; h < 2; ++h)
#pragma unroll
            for (int i = 0; i < 2; ++i) { int R, C; stage_rc(tid * 16 + i * 8192, R, C); const int r = h * HALF + R; const unsigned tok = r < nv ? rp[r] : 0u; gC[h][i] = tok * (unsigned)(g.lda * 2) + (unsigned)C * 2u; } }
    S.a_ready(cur);
    if constexpr (SP2) {
        PG8_STAGE(PG8_SB(0, 0), cB, voffB); PG8_STAGE(PG8_SB(0, 1), cB + hstepB, voffB); PG8_STAGE_A(PG8_SA(0, 0), cA, 0, 0); PG8_STAGE_A(PG8_SA(0, 1), cA, 1, 0);
        if (wr == 1) PG8_BAR;
        PG8_WAIT_V(2); PG8_BAR;
        PG8_STAGE(PG8_SB(1, 0), cB + kstep, voffB); PG8_STAGE_A(PG8_SA(1, 0), cA + kstep, 0, 0); PG8_STAGE(PG8_SB(1, 1), cB + hstepB + kstep, voffB);
        PG8_WAIT_V(6); PG8_BAR;
    } else {
        PG8_STAGE(PG8_SB(0, 0), cB, voffB); PG8_STAGE_A(PG8_SA(0, 0), cA, 0, 0); PG8_STAGE(PG8_SB(0, 1), cB + hstepB, voffB); PG8_STAGE_A(PG8_SA(0, 1), cA, 1, 0);
        if (wr == 1) PG8_BAR;
        PG8_WAIT_V(4); PG8_BAR;
        PG8_STAGE(PG8_SB(1, 0), cB + kstep, voffB); PG8_STAGE_A(PG8_SA(1, 0), cA + kstep, 0, 0); PG8_STAGE(PG8_SB(1, 1), cB + hstepB + kstep, voffB);
        PG8_WAIT_V(6); PG8_BAR;
    }
    for (;;) {
        const bool has_next = S.next(ui + 1, nxt);
        const char* nA = has_next ? S.a_base(g, nxt) : cA; const char* nB = has_next ? S.b_base(g, nxt) : cB;
        if constexpr (Sched::GATHER) { if (has_next && wid < 4)
            __builtin_amdgcn_global_load_lds((const unsigned*)(S.rows(nxt) + wid * 64 + lane), (PG8_LAS unsigned*)(S.gslot + ((ui + 1) & 1) * 256 + wid * 64), 4, 0, 0); }
#pragma nounroll
        for (int t = 0; t < nt; t += 2) {
            const bool last = (t == nt - 2);
            const char* a1 = cA + (size_t)(t + 1) * kstep;
            const char* a2 = last ? nA : cA + (size_t)(t + 2) * kstep; const char* b2 = last ? nB : cB + (size_t)(t + 2) * kstep;
            const char* a3 = a2 + kstep; const char* b3 = b2 + kstep;
            if (last && has_next) S.a_ready(nxt);
            if constexpr (SP2) {
            PG8_LDB(B0, 0, 0); PG8_LDB(B1, 0, 1); PG8_SCHED; PG8_LDA(At, 0, 0); PG8_STAGE_A(PG8_SA(1, 1), a1, 1, 0);
            if constexpr (Sched::GATHER) { if (last && has_next) {
                const PG8_LAS unsigned* sl = S.gslot + ((ui + 1) & 1) * 256; const int nv = S.nvalid(nxt);
#pragma unroll
                for (int h = 0; h < 2; ++h)
#pragma unroll
                    for (int i = 0; i < 2; ++i) { int R, C; stage_rc(tid * 16 + i * 8192, R, C); const int r = h * HALF + R; const unsigned v = sl[r]; const unsigned tok = r < nv ? v : 0u; gC[h][i] = tok * (unsigned)(g.lda * 2) + (unsigned)C * 2u; } } }
            PG8_WAIT_VP(); PG8_WAIT_L(0); PG8_BAR; PG8_MMA(0, 0, At, B0); PG8_MMA(0, 1, At, B1); PG8_BAR; PG8_SCHED;
            PG8_LDA(At, 0, 1); PG8_STAGE(PG8_SB(0, 0), b2, voffB); PG8_STAGE(PG8_SB(0, 1), b2 + hstepB, voffB); PG8_STAGE_A(PG8_SA(0, 0), a2, 0, 1); PG8_PREFETCH(t + PF_D);
            PG8_WAIT_VP(); PG8_WAIT_L(0); PG8_BAR; PG8_MMA(1, 0, At, B0); PG8_MMA(1, 1, At, B1); PG8_BAR; PG8_SCHED;
            PG8_LDB(B0, 1, 0); PG8_LDB(B1, 1, 1); PG8_SCHED; PG8_LDA(At, 1, 0); PG8_STAGE_A(PG8_SA(0, 1), a2, 1, 1);
            PG8_WAIT_VP(); PG8_WAIT_L(0); PG8_BAR; PG8_MMA(0, 0, At, B0); PG8_MMA(0, 1, At, B1); PG8_BAR; PG8_SCHED;
            PG8_LDA(At, 1, 1); PG8_STAGE(PG8_SB(1, 0), b3, voffB); PG8_STAGE(PG8_SB(1, 1), b3 + hstepB, voffB); PG8_STAGE_A(PG8_SA(1, 0), a3, 0, 1); PG8_PREFETCH(t + 1 + PF_D);
            PG8_WAIT_VP(); PG8_WAIT_L(0); PG8_BAR; PG8_MMA(1, 0, At, B0); PG8_MMA(1, 1, At, B1); PG8_BAR; PG8_SCHED;
            } else {
            PG8_LDB(B0, 0, 0); PG8_SCHED; PG8_LDA(At, 0, 0); PG8_STAGE_A(PG8_SA(1, 1), a1, 1, 0);
            PG8_WAIT_L(8); PG8_BAR; PG8_WAIT_L(0); PG8_MMA(0, 0, At, B0); PG8_BAR; PG8_SCHED;
            PG8_LDB(B1, 0, 1); PG8_STAGE(PG8_SB(0, 0), b2, voffB);
            PG8_BAR; PG8_WAIT_L(0); PG8_MMA(0, 1, At, B1); PG8_BAR;
            PG8_LDA(At, 0, 1); PG8_STAGE_A(PG8_SA(0, 0), a2, 0, 1);
            PG8_BAR; PG8_WAIT_L(0); PG8_MMA(1, 0, At, B0); PG8_BAR; PG8_SCHED;
            PG8_STAGE(PG8_SB(0, 1), b2 + hstepB, voffB);
            PG8_WAIT_V(6); PG8_BAR; PG8_MMA(1, 1, At, B1); PG8_BAR;
            PG8_LDB(B0, 1, 0); PG8_SCHED; PG8_LDA(At, 1, 0); PG8_STAGE_A(PG8_SA(0, 1), a2, 1, 1);
            PG8_WAIT_L(8); PG8_BAR; PG8_WAIT_L(0); PG8_MMA(0, 0, At, B0); PG8_BAR; PG8_SCHED;
            PG8_LDB(B1, 1, 1); PG8_STAGE(PG8_SB(1, 0), b3, voffB);
            PG8_BAR; PG8_WAIT_L(0); PG8_MMA(0, 1, At, B1); PG8_BAR;
            PG8_LDA(At, 1, 1); PG8_STAGE_A(PG8_SA(1, 0), a3, 0, 1);
            PG8_BAR; PG8_WAIT_L(0); PG8_MMA(1, 0, At, B0); PG8_BAR; PG8_SCHED;
            PG8_STAGE(PG8_SB(1, 1), b3 + hstepB, voffB);
            PG8_WAIT_V(6); PG8_BAR; PG8_MMA(1, 1, At, B1); PG8_BAR;
            }
        }
        if constexpr (ALIGN_EPI) { if (wr == 0) PG8_BAR; }
        if constexpr (FP8) asm volatile("s_nop 15\n\ts_nop 15" ::: "memory");
        if constexpr (!Epi::AFTER_DRAIN) { E(acc, cur, wr, wc, fr, fq); S.done(cur); }
        if (!has_next) break;
#pragma unroll
        for (int a = 0; a < 2; ++a)
#pragma unroll
            for (int b = 0; b < 2; ++b)
#pragma unroll
                for (int m = 0; m < 4; ++m)
#pragma unroll
                    for (int n = 0; n < 2; ++n) acc[a][b][m][n] = (f32x4){0.f, 0.f, 0.f, 0.f};
        cur = nxt; cA = nA; cB = nB; ++ui;
        if constexpr (ALIGN_EPI) { if (wr == 1) PG8_BAR; }
    }
    PG8_WAIT_V(0);
    if constexpr (!ALIGN_EPI) { if (wr == 0) PG8_BAR; }
    PG8_BAR;
    if constexpr (Epi::AFTER_DRAIN) { E.fused(acc, cur, wr, wc, fr, fq, lds, wid, lane); S.done(cur); }
#undef PG8_SA
#undef PG8_SB
#undef PG8_STAGE
#undef PG8_STAGE_A
#undef PG8_LDA
#undef PG8_LDB
#undef PG8_MMA
#undef PG8_WAIT_V
#undef PG8_WAIT_VP
#undef PG8_PREFETCH
#undef PG8_WAIT_L
#undef PG8_BAR
#undef PG8_SCHED
}
}
constexpr int NTOK = 32768, DM = 1024, SEQ = 2048, NBATCH = 16, MEMLEN = 256, NMEM = NBATCH * MEMLEN, INW = 3088, NEXP = 32, TOPK = 4;
constexpr int PW = 3072;
constexpr int MAXTILES = 544;
constexpr float EPS = 1e-6f;
constexpr int NWAVES = 8;
constexpr size_t MiB = 1u << 20;
constexpr size_t WS_CTL = 0, CTL_ZERO_BYTES = 64 * 1024;
constexpr size_t WS_WINT = 2 * MiB, WS_WOUT = 10 * MiB, WS_WCQ = 12 * MiB, WS_WCK = 14 * MiB, WS_WCV = 16 * MiB, WS_WCO = 18 * MiB;
constexpr size_t WS_WR = 20 * MiB, WS_CS = 21 * MiB, WS_SSP1 = 24 * MiB, WS_GATE = 27 * MiB, WS_ASSIGN = 28 * MiB, WS_LIST = 29 * MiB;
constexpr size_t WS_RSL = 842 * MiB;
constexpr size_t WS_X2B = 378 * MiB;
constexpr size_t WS_WUP = 34 * MiB, WS_WDN = 162 * MiB, WS_KX = 226 * MiB, WS_VXT = 234 * MiB;
constexpr size_t WS_HN = 242 * MiB, WS_CAT = 242 * MiB, WS_MN = 306 * MiB, WS_P = 314 * MiB, WS_LA = 506 * MiB, WS_VT = 538 * MiB;
constexpr size_t WS_X1B = 314 * MiB, WS_GT = 378 * MiB, WS_HT = 410 * MiB, WS_PX = 506 * MiB;
constexpr size_t WS_GVT = 602 * MiB;
constexpr size_t WS_ACT = 570 * MiB, WS_Y = 706 * MiB, WS_END = 846 * MiB;
constexpr int CW_Q2 = 128;
constexpr int CW_CNT = 1024;
constexpr int CW_PROBE = 192;
constexpr int CW_BAR = 4096;
constexpr int RING_OFF = 0, RING_BYTES = 131072;
constexpr int LDSCTL_OFF = RING_BYTES, MISC_OFF = LDSCTL_OFF + 320;
constexpr int TAB_OFF = LDSCTL_OFF + 512;
constexpr int TAB_TSTART = TAB_OFF + 576, TAB_CNT = TAB_TSTART + 144;
constexpr int XCH2_OFF = LDSCTL_OFF + 6144;
constexpr int XCH_OFF = LDSCTL_OFF + 2048;
constexpr int TS_OFF = TAB_CNT + 128;
constexpr int LDS_BYTES = 147456;

#define GAS __attribute__((address_space(1)))
#define LAS __attribute__((address_space(3)))
typedef unsigned short bf16;
typedef unsigned v4u __attribute__((ext_vector_type(4)));
typedef float f32x4 __attribute__((ext_vector_type(4)));
typedef short bf16x8 __attribute__((ext_vector_type(8)));
typedef GAS unsigned gu32;
typedef GAS unsigned long long gu64;
#define RLX_AGENT __ATOMIC_RELAXED, __HIP_MEMORY_SCOPE_AGENT
#define LDS_WAIT() asm volatile("s_waitcnt lgkmcnt(0)" ::: "memory")
#define VM_WAIT() asm volatile("s_waitcnt vmcnt(0)" ::: "memory")
__device__ __forceinline__ unsigned long long rt() { return __builtin_amdgcn_s_memrealtime(); }
__device__ __forceinline__ unsigned f2bf(float f) { unsigned u = __builtin_bit_cast(unsigned, f); return (u + 0x7fffu + ((u >> 16) & 1u)) >> 16; }
__device__ __forceinline__ unsigned pk2(float lo, float hi) { return f2bf(lo) | (f2bf(hi) << 16); }

#define XB_TMO      128
#define XB_XCNT(j)  (256  + 64 * (j))
#define XB_XSUB(j)  (1280 + 64 * (j))
#define XB_XGEN(j)  (2304 + 64 * (j))
#define XB_TOP      3328
#define XB_TOPGEN   3392
#define XCD_BAR_WORDS 3456
#define XB_SPIN_CAP (1u << 18)

__device__ __forceinline__ unsigned xb_ld(unsigned* p)              { return __hip_atomic_load(p, __ATOMIC_RELAXED, __HIP_MEMORY_SCOPE_AGENT); }
__device__ __forceinline__ unsigned xb_add(unsigned* p, unsigned v) { return __hip_atomic_fetch_add(p, v, __ATOMIC_RELAXED, __HIP_MEMORY_SCOPE_AGENT); }
__device__ __forceinline__ unsigned xb_xcc_id() { return (unsigned)__builtin_amdgcn_s_getreg((3 << 11) | 20) & 0xFu; }
#define XB_SPIN(cond, bar) do { unsigned _sp = 0; while (cond) { __builtin_amdgcn_s_sleep(1); \
    if ((++_sp & 255u) == 0u) { if (xb_ld(&(bar)[XB_TMO])) break; if (_sp > XB_SPIN_CAP) { atomicAdd(&(bar)[XB_TMO], 1u); break; } } } } while (0)

struct XcdBarrier {
    unsigned* bar; unsigned x;
    volatile LAS unsigned* st;
};

__device__ __forceinline__ XcdBarrier xcd_barrier_post(unsigned* bar, volatile LAS unsigned* st) {
    XcdBarrier b; b.bar = bar; b.x = xb_xcc_id(); b.st = st;
    if (threadIdx.x == 0) (void)xb_add(&bar[XB_XCNT(b.x)], 1u);
    return b;
}
__device__ __forceinline__ void xcd_barrier_complete(unsigned* bar, unsigned x, unsigned& nloc, unsigned& nx) {
    const unsigned G = gridDim.x * gridDim.y * gridDim.z;
    unsigned sum, cnt, mine, sp = 0u;
    for (;;) {
        sum = 0u; cnt = 0u; mine = 0u;
#pragma unroll
        for (unsigned j = 0; j < 16; ++j) { const unsigned c = xb_ld(&bar[XB_XCNT(j)]); sum += c; cnt += (c > 0u) ? 1u : 0u; mine = (j == x) ? c : mine; }
        if (sum == G) break;
        __builtin_amdgcn_s_sleep(1);
        if ((++sp & 255u) == 0u) { if (xb_ld(&bar[XB_TMO])) break; if (sp > XB_SPIN_CAP) { atomicAdd(&bar[XB_TMO], 1u); break; } }
    }
    nloc = mine > 0u ? mine : 1u; nx = cnt > 0u ? cnt : 1u;
}

__device__ __forceinline__ void xcd_barrier(const XcdBarrier& b) {
    asm volatile("s_waitcnt vmcnt(0)" ::: "memory");
    __syncthreads();
    if (threadIdx.x == 0) {
        unsigned* bar = b.bar;
        __builtin_amdgcn_s_waitcnt(0);
        unsigned nloc = b.st[0], nx = b.st[1];
        if (nloc == 0u) { xcd_barrier_complete(bar, b.x, nloc, nx); b.st[0] = nloc; b.st[1] = nx; }
        const unsigned old = xb_add(&bar[XB_XSUB(b.x)], 1u);
        const unsigned gen = old / nloc;
        if (old + 1u == (gen + 1u) * nloc) {
            __builtin_amdgcn_fence(__ATOMIC_RELEASE, "agent");
            asm volatile("s_waitcnt vmcnt(0)" ::: "memory");
            const unsigned og = xb_add(&bar[XB_TOP], 1u);
            const unsigned tg = og / nx;
            if (og + 1u == (tg + 1u) * nx) xb_add(&bar[XB_TOPGEN], 1u);
            else XB_SPIN(xb_ld(&bar[XB_TOPGEN]) == tg, bar);
            __builtin_amdgcn_fence(__ATOMIC_ACQUIRE, "agent");
            xb_add(&bar[XB_XGEN(b.x)], 1u);
            asm volatile("s_waitcnt vmcnt(0)" ::: "memory");
        } else {
            XB_SPIN(xb_ld(&bar[XB_XGEN(b.x)]) == gen, bar);
            __builtin_amdgcn_fence(__ATOMIC_ACQUIRE, "agent");
            asm volatile("s_waitcnt vmcnt(0)" ::: "memory");
        }
    }
    __syncthreads();
}
typedef short bf16x4 __attribute__((ext_vector_type(4)));
typedef unsigned v2u __attribute__((ext_vector_type(2)));
struct Frame {
    LAS unsigned char* lds;
    volatile LAS unsigned* MISC;
    gu32* ctl;
    int tid, lane, wave;
    int vcu, G;
    unsigned char* ws;
    float* out;
};
__device__ __forceinline__ int lane_here() { int t = (int)threadIdx.x; asm volatile("" : "+v"(t)); return t & 63; }
__device__ __forceinline__ float bf2f(bf16 b) { return __builtin_bit_cast(float, (unsigned)b << 16); }
__device__ __forceinline__ float wave_sum(float v) {
#pragma unroll
    for (int o = 1; o < 64; o <<= 1) v += __shfl_xor(v, o);
    return v;
}
__device__ __forceinline__ float xmax16(float m) { auto rr = __builtin_amdgcn_permlane16_swap(__float_as_uint(m), __float_as_uint(m), false, false); return fmaxf(__uint_as_float(rr[0]), __uint_as_float(rr[1])); }
__device__ __forceinline__ float xmax32(float m) { auto rr = __builtin_amdgcn_permlane32_swap(__float_as_uint(m), __float_as_uint(m), false, false); return fmaxf(__uint_as_float(rr[0]), __uint_as_float(rr[1])); }
__device__ __forceinline__ f32x4 mfma16(bf16x8 a, bf16x8 b, f32x4 c) { return __builtin_amdgcn_mfma_f32_16x16x32_bf16(a, b, c, 0, 0, 0); }

__device__ __forceinline__ void p0_transpose_item(const float* W, int ldw, const float* gain, bf16* WT, int K, int k0, int n0, size_t orow0, int lane) {
    const int n4 = lane & 15, kq = lane >> 4;
    const float* src = W + (size_t)(k0 + 16 * kq) * ldw + n0 + 4 * n4;
    f32x4 v[16];
#pragma unroll
    for (int i = 0; i < 16; ++i) v[i] = *(const f32x4*)(src + (size_t)i * ldw);
    if (gain) { const f32x4* gp = (const f32x4*)(gain + k0 + 16 * kq);
#pragma unroll
        for (int q = 0; q < 4; ++q) { const f32x4 gq = gp[q];
#pragma unroll
            for (int r = 0; r < 4; ++r) v[4 * q + r] = v[4 * q + r] * gq[r]; } }
    bf16* dst = WT + (orow0 + 4 * n4) * (size_t)K + k0 + 16 * kq;
#pragma unroll
    for (int j = 0; j < 4; ++j) { v4u o0, o1;
        o0.x = pg8::cvtpk(v[0][j], v[1][j]); o0.y = pg8::cvtpk(v[2][j], v[3][j]); o0.z = pg8::cvtpk(v[4][j], v[5][j]); o0.w = pg8::cvtpk(v[6][j], v[7][j]);
        o1.x = pg8::cvtpk(v[8][j], v[9][j]); o1.y = pg8::cvtpk(v[10][j], v[11][j]); o1.z = pg8::cvtpk(v[12][j], v[13][j]); o1.w = pg8::cvtpk(v[14][j], v[15][j]);
        *(v4u*)(dst + (size_t)j * K) = o0; *(v4u*)(dst + (size_t)j * K + 8) = o1; }
}
__device__ __forceinline__ void p0_transpose_item8(const float* W, int ldw, const float* gain, unsigned char* WT, int K, int k0, int n0, size_t orow0, int lane) {
    const int n4 = lane & 15, kq = lane >> 4;
    const float* src = W + (size_t)(k0 + 16 * kq) * ldw + n0 + 4 * n4;
    f32x4 v[16];
#pragma unroll
    for (int i = 0; i < 16; ++i) v[i] = *(const f32x4*)(src + (size_t)i * ldw);
    { const f32x4* gp = (const f32x4*)(gain + k0 + 16 * kq);
#pragma unroll
        for (int q = 0; q < 4; ++q) { f32x4 gq = {32.f, 32.f, 32.f, 32.f}; if (gain) gq = gp[q] * 32.0f;
#pragma unroll
            for (int r = 0; r < 4; ++r) v[4 * q + r] = v[4 * q + r] * gq[r]; } }
    unsigned char* dst = WT + (orow0 + 4 * n4) * (size_t)K + k0 + 16 * kq;
#pragma unroll
    for (int j = 0; j < 4; ++j) { v4u o;
        o.x = pg8::cvt4_fp8((f32x4){v[0][j], v[1][j], v[2][j], v[3][j]}); o.y = pg8::cvt4_fp8((f32x4){v[4][j], v[5][j], v[6][j], v[7][j]});
        o.z = pg8::cvt4_fp8((f32x4){v[8][j], v[9][j], v[10][j], v[11][j]}); o.w = pg8::cvt4_fp8((f32x4){v[12][j], v[13][j], v[14][j], v[15][j]});
        *(v4u*)(dst + (size_t)j * K) = o; }
}
template <int NR> __device__ __forceinline__ void rms_rows_to_bf16(const float* const (&xrow)[NR], const float* g, bf16* const (&orow)[NR], int lane) {
    f32x4 v[NR][4]; float s[NR];
#pragma unroll
    for (int r = 0; r < NR; ++r) { const f32x4* xr = (const f32x4*)xrow[r] + lane;
#pragma unroll
        for (int j = 0; j < 4; ++j) v[r][j] = xr[64 * j]; }
    const f32x4* gr = (const f32x4*)g + lane; f32x4 gg[4];
#pragma unroll
    for (int j = 0; j < 4; ++j) gg[j] = gr[64 * j];
#pragma unroll
    for (int r = 0; r < NR; ++r) { s[r] = 0.f;
#pragma unroll
        for (int j = 0; j < 4; ++j) s[r] += (v[r][j].x * v[r][j].x + v[r][j].y * v[r][j].y) + (v[r][j].z * v[r][j].z + v[r][j].w * v[r][j].w); }
#pragma unroll
    for (int r = 0; r < NR; ++r) { const float rs = rsqrtf(wave_sum(s[r]) * (1.0f / DM) + EPS); unsigned long long* o8 = (unsigned long long*)orow[r] + lane;
#pragma unroll
        for (int j = 0; j < 4; ++j) o8[64 * j] = (unsigned long long)pk2(v[r][j].x * rs * gg[j].x, v[r][j].y * rs * gg[j].y) | ((unsigned long long)pk2(v[r][j].z * rs * gg[j].z, v[r][j].w * rs * gg[j].w) << 32); }
}
constexpr int MOE_I_UP = 32 * 16 * 32, MOE_I_DN = 32 * 16 * 16, MOE_UNITS = (MOE_I_UP + MOE_I_DN) / 64;
__device__ __forceinline__ void moe_convert_unit(int unit, const float* w_up, const float* w_down, const float* g_ffn, unsigned char* ws, int wave, int lane) {
#pragma unroll 1
    for (int j = 0; j < 8; ++j) { int r = unit * 64 + j * 8 + wave;
        if (r < MOE_I_UP) { const int e = r / (16 * 32); r -= e * (16 * 32); const int n0 = 64 * (r % 32);
            const size_t orow = (size_t)e * 2048 + ((n0 & 1023) >> 7) * 256 + (n0 >> 10) * 128 + (n0 & 127);
            p0_transpose_item8(w_up + (size_t)e * DM * 2048, 2048, g_ffn, ws + WS_WUP, DM, 64 * (r / 32), n0, orow, lane); }
        else { r -= MOE_I_UP; const int e = r / (16 * 16); r -= e * (16 * 16);
            p0_transpose_item8(w_down + (size_t)e * DM * DM, DM, nullptr, ws + WS_WDN, DM, 64 * (r / 16), 64 * (r % 16), (size_t)e * 1024 + 64 * (r % 16), lane); } }
}
struct In {
    const float *x, *mem; const int* positions; const float *norm_mix_g, *w_in, *lq1, *lk1, *lq2, *lk2, *diff_norm_g, *w_alpha2, *b_alpha, *gla_norm_g, *w_out, *norm_cross_g, *norm_mem_g,
        *w_cq, *w_ck, *w_cv, *w_co, *norm_ffn_g, *w_router, *b_router, *w_up, *b_up, *w_down, *b_down, *norm_final_g;
};
__device__ __forceinline__ void p0_prologue(Frame& F, const In& I) {
    const int gw = F.vcu * NWAVES + F.wave, NGW = F.G * NWAVES, lane = lane_here();
    unsigned char* ws = F.ws;
    constexpr int I_IN = 16 * 48, I_SQ = 16 * 16;
    constexpr int NITEMS = I_IN + 4 * I_SQ;
    for (int it = gw; it < NITEMS; it += NGW) {
        int r = it;
        if (r < I_IN) { p0_transpose_item(I.w_in, INW, nullptr, (bf16*)(ws + WS_WINT), DM, 64 * (r / 48), 64 * (r % 48), (size_t)64 * (r % 48), lane); continue; } r -= I_IN;
        { const int w = r / I_SQ; r -= w * I_SQ;
            const float* W = w == 0 ? I.w_out : w == 1 ? I.w_ck : w == 2 ? I.w_cv : I.w_co;
            bf16* WT = (bf16*)(ws + (w == 0 ? WS_WOUT : w == 1 ? WS_WCK : w == 2 ? WS_WCV : WS_WCO));
            p0_transpose_item(W, DM, nullptr, WT, DM, 64 * (r / 16), 64 * (r % 16), (size_t)64 * (r % 16), lane); }
    }
    for (int idx = F.vcu * (NWAVES * 64) + F.tid; idx < DM * DM / 4; idx += F.G * NWAVES * 64) { const f32x4 v = ((const f32x4*)I.w_cq)[idx] * I.norm_cross_g[idx >> 8];
        v2u o; o.x = pk2(v.x, v.y); o.y = pk2(v.z, v.w); ((v2u*)(ws + WS_WCQ))[idx] = o; }
    const int gt = F.vcu * (NWAVES * 64) + F.tid, NGT = F.G * NWAVES * 64;
    for (int idx = gt; idx < 256 * DM; idx += NGT) { const int j = idx >> 10, k = idx & 1023; const float* wr = I.w_in + (size_t)k * INW + 3072; float s = 0.f;
#pragma unroll
        for (int r = 0; r < 16; ++r) s += wr[r] * I.w_alpha2[r * 256 + j];
        ((bf16*)(ws + WS_WINT))[(size_t)(3072 + j) * DM + k] = (bf16)f2bf(s); }
    for (int idx = gt; idx < DM * NEXP; idx += NGT) ((float*)(ws + WS_WR))[idx] = I.w_router[idx] * I.norm_ffn_g[idx >> 5];
    for (int idx = gt; idx < NTOK * 8; idx += NGT) { const int tok = idx >> 3, i = idx & 7;
        const double inv = exp(-(double)i * 0.125 * 13.122363377404328); const double ang = (double)I.positions[tok] * inv;
        const double red = ang - rint(ang * 0.15915494309189535) * 6.283185307179586; const float rf = (float)red;
        float* cs = (float*)(ws + WS_CS) + (size_t)tok * 16; cs[i] = cosf(rf); cs[8 + i] = sinf(rf); }
    for (int m = gw * 4; m < NTOK; m += NGW * 4) { const float* xr[4]; bf16* orw[4];
#pragma unroll
        for (int r = 0; r < 4; ++r) { xr[r] = I.x + (size_t)(m + r) * DM; orw[r] = (bf16*)(ws + WS_HN) + (size_t)(m + r) * DM; }
        rms_rows_to_bf16<4>(xr, I.norm_mix_g, orw, lane); }
    for (int m = gw * 4; m < NMEM; m += NGW * 4) { const float* xr[4]; bf16* orw[4];
#pragma unroll
        for (int r = 0; r < 4; ++r) { xr[r] = I.mem + (size_t)(m + r) * DM; orw[r] = (bf16*)(ws + WS_MN) + (size_t)(m + r) * DM; }
        rms_rows_to_bf16<4>(xr, I.norm_mem_g, orw, lane); }
}

constexpr int DA_KBUF = 16384, DA_VBUF = 16384, DA_VOFF = 2 * DA_KBUF;
__device__ __forceinline__ void diffattn_unit(Frame& F, const bf16* P, const bf16* VT, bf16* CAT, const float* gdiff, float lam, int b, int h, int qblk) {
    const int lane = lane_here(), wave = F.wave, tid = F.tid, l15 = lane & 15, g = lane >> 4;
    LAS unsigned char* lds = F.lds + RING_OFF;
    const int q0 = qblk * 128 + wave * 16;
    const size_t tokq = (size_t)b * SEQ + q0 + l15;
    bf16x8 qf[2][2];
#pragma unroll
    for (int c = 0; c < 2; ++c)
#pragma unroll
        for (int ks = 0; ks < 2; ++ks) qf[c][ks] = *(const bf16x8*)(P + tokq * PW + h * 128 + c * 64 + ks * 32 + g * 8);
    f32x4 o[2][8];
#pragma unroll
    for (int c = 0; c < 2; ++c)
#pragma unroll
        for (int k = 0; k < 8; ++k) o[c][k] = (f32x4){0.f, 0.f, 0.f, 0.f};
    float mrun[2] = {0.f, 0.f}, lsum[2] = {0.f, 0.f};
    const int nk = q0 + 16;
    const int nt = 2 * qblk + 2;
    const int skey = tid >> 4, sch = tid & 15, vrow = tid >> 3, vpc = tid & 7;
    const bf16* ksrc = P + ((size_t)b * SEQ + skey) * PW + 512 + h * 128 + sch * 8;
    const bf16* vsrc = VT + (size_t)(h * 128 + vrow) * NTOK + (size_t)b * SEQ + vpc * 8;
    const int kdst = skey * 256 + ((sch ^ (skey & 15)) * 16);
    const int vfr = (vrow >> 1) & 7, vch = (vpc >> 2) * 4 + 2 * (vpc & 1), vhi = ((vpc & 3) >> 1) * 8;
    const int vdst0 = DA_VOFF + vrow * 128 + ((vch ^ vfr) * 16) + vhi, vdst1 = DA_VOFF + vrow * 128 + (((vch + 1) ^ vfr) * 16) + vhi;
    int koff[2][2];
#pragma unroll
    for (int c = 0; c < 2; ++c)
#pragma unroll
        for (int ks = 0; ks < 2; ++ks) koff[c][ks] = l15 * 256 + (((c * 8 + ks * 4 + g) ^ l15) * 16);
    const int voffs[2] = {DA_VOFF + l15 * 128 + ((g ^ (l15 >> 1)) * 16), DA_VOFF + l15 * 128 + (((4 + g) ^ (l15 >> 1)) * 16)};
    v4u sk0, sk1, sv0, sv1;
#define DA_LOAD(tt) do { const bf16* kp_ = ksrc + (size_t)(tt) * 64 * PW; const bf16* vp_ = vsrc + (tt) * 64; \
        sk0 = *(const v4u*)kp_; sk1 = *(const v4u*)(kp_ + (size_t)32 * PW); sv0 = *(const v4u*)vp_; sv1 = *(const v4u*)(vp_ + (size_t)64 * NTOK); } while (0)
#define DA_STORE(bb) do { LAS unsigned char* kd_ = lds + (bb) * DA_KBUF + kdst; LAS unsigned char* vd_ = lds + (bb) * DA_VBUF; \
        *(LAS v4u*)kd_ = sk0; *(LAS v4u*)(kd_ + 8192) = sk1; \
        *(LAS v2u*)(vd_ + vdst0) = (v2u){sv0.x, sv0.y}; *(LAS v2u*)(vd_ + vdst1) = (v2u){sv0.z, sv0.w}; *(LAS v2u*)(vd_ + vdst0 + 8192) = (v2u){sv1.x, sv1.y}; *(LAS v2u*)(vd_ + vdst1 + 8192) = (v2u){sv1.z, sv1.w}; } while (0)
    DA_LOAD(0); DA_STORE(0);
    __syncthreads();
    auto step = [&](const int t, const int buf) __attribute__((always_inline)) {
        if (t * 64 < nk) {
            const LAS unsigned char* kb = lds + buf * DA_KBUF; const LAS unsigned char* vb = lds + buf * DA_VBUF;
            f32x4 s[2][2][2];
#pragma unroll
            for (int sub = 0; sub < 2; ++sub)
#pragma unroll
                for (int c = 0; c < 2; ++c)
#pragma unroll
                    for (int s2 = 0; s2 < 2; ++s2) { f32x4 a = (f32x4){-mrun[c], -mrun[c], -mrun[c], -mrun[c]};
#pragma unroll
                        for (int ks = 0; ks < 2; ++ks) { const bf16x8 kf = *(const LAS bf16x8*)(kb + sub * 8192 + s2 * 4096 + koff[c][ks]); a = mfma16(kf, qf[c][ks], a); }
                        s[sub][c][s2] = a; }
            if (t * 64 + 63 > q0) {
                const int qrow = q0 + l15;
#pragma unroll
                for (int sub = 0; sub < 2; ++sub)
#pragma unroll
                    for (int c = 0; c < 2; ++c)
#pragma unroll
                        for (int s2 = 0; s2 < 2; ++s2)
#pragma unroll
                            for (int r = 0; r < 4; ++r) if (t * 64 + sub * 32 + s2 * 16 + 4 * g + r > qrow) s[sub][c][s2][r] = -INFINITY;
            }
            float dl[2]; bool grow = false;
#pragma unroll
            for (int c = 0; c < 2; ++c) { float mx = -INFINITY;
#pragma unroll
                for (int sub = 0; sub < 2; ++sub)
#pragma unroll
                    for (int s2 = 0; s2 < 2; ++s2) mx = fmaxf(mx, fmaxf(fmaxf(s[sub][c][s2][0], s[sub][c][s2][1]), fmaxf(s[sub][c][s2][2], s[sub][c][s2][3])));
                mx = xmax16(mx); mx = xmax32(mx);
                dl[c] = (t == 0 || mx > 8.0f) ? mx : 0.f; grow = grow || (dl[c] != 0.f); }
            if (__any(grow)) {
#pragma unroll
                for (int c = 0; c < 2; ++c) { const float alpha = __builtin_amdgcn_exp2f(-dl[c]); mrun[c] += dl[c]; lsum[c] *= alpha;
#pragma unroll
                    for (int k = 0; k < 8; ++k) o[c][k] = o[c][k] * alpha;
#pragma unroll
                    for (int sub = 0; sub < 2; ++sub)
#pragma unroll
                        for (int s2 = 0; s2 < 2; ++s2)
#pragma unroll
                            for (int r = 0; r < 4; ++r) s[sub][c][s2][r] -= dl[c]; }
            }
#pragma unroll
            for (int sub = 0; sub < 2; ++sub) {
                bf16x8 pb[2];
#pragma unroll
                for (int c = 0; c < 2; ++c) { float ps = 0.f;
#pragma unroll
                    for (int s2 = 0; s2 < 2; ++s2)
#pragma unroll
                        for (int r = 0; r < 4; ++r) { const float p = __builtin_amdgcn_exp2f(s[sub][c][s2][r]); s[sub][c][s2][r] = p; ps += p; }
                    lsum[c] += ps;
                    v4u w; w.x = pg8::cvtpk(s[sub][c][0][0], s[sub][c][0][1]); w.y = pg8::cvtpk(s[sub][c][0][2], s[sub][c][0][3]); w.z = pg8::cvtpk(s[sub][c][1][0], s[sub][c][1][1]); w.w = pg8::cvtpk(s[sub][c][1][2], s[sub][c][1][3]);
                    pb[c] = __builtin_bit_cast(bf16x8, w); }
#pragma unroll
                for (int k = 0; k < 8; ++k) { const bf16x8 vf = *(const LAS bf16x8*)(vb + voffs[sub] + k * 2048);
                    o[0][k] = mfma16(vf, pb[0], o[0][k]); o[1][k] = mfma16(vf, pb[1], o[1][k]); }
            }
        }
    };
    for (int t = 0; t < nt; ++t) {
        if (t + 1 < nt) DA_LOAD(t + 1);
        step(t, t & 1);
        if (t + 1 < nt) DA_STORE((t & 1) ^ 1);
        __syncthreads();
    }
#undef DA_LOAD
#undef DA_STORE
    float l0 = lsum[0], l1 = lsum[1];
    l0 += __shfl_xor(l0, 16); l0 += __shfl_xor(l0, 32); l1 += __shfl_xor(l1, 16); l1 += __shfl_xor(l1, 32);
    const float i0 = 1.0f / l0, i1 = lam / l1; float ss = 0.f;
#pragma unroll
    for (int k = 0; k < 8; ++k)
#pragma unroll
        for (int r = 0; r < 4; ++r) { const float v = o[0][k][r] * i0 - o[1][k][r] * i1; o[0][k][r] = v; ss += v * v; }
    ss += __shfl_xor(ss, 16); ss += __shfl_xor(ss, 32);
    const float rs = rsqrtf(ss * (1.0f / 128.0f) + EPS) * 0.8f;
    bf16* op = CAT + tokq * DM + h * 128 + 4 * g;
#pragma unroll
    for (int k = 0; k < 8; ++k) { const f32x4 gg = *(const f32x4*)(gdiff + k * 16 + 4 * g); f32x4 v = o[0][k] * rs; v = v * gg; pg8::st_bf4(op + k * 16, v); }
}

__device__ __forceinline__ bf16x8 pack8(const f32x4& a, const f32x4& b) { v4u w; w.x = pg8::cvtpk(a[0], a[1]); w.y = pg8::cvtpk(a[2], a[3]); w.z = pg8::cvtpk(b[0], b[1]); w.w = pg8::cvtpk(b[2], b[3]); return __builtin_bit_cast(bf16x8, w); }
constexpr int GL_QI = 0, GL_KI = 8192, GL_IMG = 16384, GL_EL = 2 * GL_IMG, GL_OB = GL_EL + 512, GL_OBS = 17408, GL_PS = GL_OB + 2 * GL_OBS, GL_END = GL_PS + 4096;

__device__ __forceinline__ void gla_unit(Frame& F, const bf16* P, const float* Bc, const bf16* GVT, bf16* CAT, const float* ggla, int b, int h) {
    const int lane = lane_here(), l15 = lane & 15, g = lane >> 4, eb = F.wave, tid = F.tid;
    LAS unsigned char* lds = F.lds + RING_OFF;
    const f32x4 zero4 = {0.f, 0.f, 0.f, 0.f};
    f32x4 S[4] = {zero4, zero4, zero4, zero4};
    bf16x8 If[4];
#pragma unroll
    for (int db = 0; db < 4; ++db) { const int ks = db >> 1;
#pragma unroll
        for (int j = 0; j < 8; ++j) { const int dp = 32 * ks + (j < 4 ? 4 * g + j : 16 + 4 * g + j - 4); If[db][j] = (dp == 16 * db + l15) ? (short)0x3F80 : (short)0; } }
    const int st = tid >> 3, sp = tid & 7, opc = tid & 15;
    const size_t tokb = (size_t)b * SEQ;
    const bf16* qsrc = P + (tokb + st) * PW + 1536 + h * 64 + sp * 8;
    const float* bsrc = Bc + (tokb + st) * 256 + h * 64 + sp * 8;
    const bf16* Vrow = GVT + (size_t)(h * 128 + 16 * eb + l15) * NTOK + tokb + 4 * g;
    const f32x4 gg0 = *(const f32x4*)(ggla + opc * 8), gg1 = *(const f32x4*)(ggla + opc * 8 + 4);
    const int foffs[2] = {l15 * 128 + ((g ^ (l15 >> 1)) * 16), l15 * 128 + (((4 + g) ^ (l15 >> 1)) * 16)};
    const int sfr = (st >> 1) & 7, sch0 = (sp >> 2) * 4 + 2 * (sp & 1), shi = ((sp & 3) >> 1) * 8, sd0 = st * 128 + ((sch0 ^ sfr) * 16) + shi, sd1 = st * 128 + (((sch0 + 1) ^ sfr) * 16) + shi;
    v4u rq = *(const v4u*)qsrc, rk = *(const v4u*)(qsrc + 256); f32x4 rb0 = *(const f32x4*)bsrc, rb1 = *(const f32x4*)(bsrc + 4);
#define GLA_STAGE(par) do { \
        float ee[8]; _Pragma("unroll") for (int i = 0; i < 4; ++i) { ee[i] = __expf(rb0[i]); ee[4 + i] = __expf(rb1[i]); } \
        const unsigned qa[4] = {rq.x, rq.y, rq.z, rq.w}, ka[4] = {rk.x, rk.y, rk.z, rk.w}; v4u wq, wk; unsigned* wqp = (unsigned*)&wq; unsigned* wkp = (unsigned*)&wk; \
        _Pragma("unroll") for (int i = 0; i < 4; ++i) { const float q0 = __builtin_bit_cast(float, qa[i] << 16), q1 = __builtin_bit_cast(float, qa[i] & 0xffff0000u), k0 = __builtin_bit_cast(float, ka[i] << 16), k1 = __builtin_bit_cast(float, ka[i] & 0xffff0000u); \
            wqp[i] = pg8::cvtpk(q0 * ee[2 * i], q1 * ee[2 * i + 1]); wkp[i] = pg8::cvtpk(k0 * __builtin_amdgcn_rcpf(ee[2 * i]), k1 * __builtin_amdgcn_rcpf(ee[2 * i + 1])); } \
        { LAS unsigned char* ib_ = lds + (par) * GL_IMG; *(LAS v2u*)(ib_ + GL_QI + sd0) = (v2u){wq.x, wq.y}; *(LAS v2u*)(ib_ + GL_QI + sd1) = (v2u){wq.z, wq.w}; *(LAS v2u*)(ib_ + GL_KI + sd0) = (v2u){wk.x, wk.y}; *(LAS v2u*)(ib_ + GL_KI + sd1) = (v2u){wk.z, wk.w}; } \
        if (st == 63) { *(LAS f32x4*)(lds + GL_EL + (par) * 256 + sp * 32) = (f32x4){ee[0], ee[1], ee[2], ee[3]}; *(LAS f32x4*)(lds + GL_EL + (par) * 256 + sp * 32 + 16) = (f32x4){ee[4], ee[5], ee[6], ee[7]}; } } while (0)
    bf16x8 VFn[2];
#pragma unroll
    for (int ss = 0; ss < 2; ++ss) { const bf16* vp = Vrow + 32 * ss; const v2u v0 = *(const v2u*)vp, v1 = *(const v2u*)(vp + 16); v4u vv; vv.x = v0.x; vv.y = v0.y; vv.z = v1.x; vv.w = v1.y; VFn[ss] = __builtin_bit_cast(bf16x8, vv); }
    GLA_STAGE(0);
    __syncthreads();
    for (int c = 0; c < SEQ / 64; ++c) {
        const int par = c & 1; const size_t tok0 = tokb + c * 64;
        if (c + 1 < SEQ / 64) { rq = *(const v4u*)(qsrc + (size_t)(c + 1) * 64 * PW); rk = *(const v4u*)(qsrc + (size_t)(c + 1) * 64 * PW + 256);
            rb0 = *(const f32x4*)(bsrc + (size_t)(c + 1) * 64 * 256); rb1 = *(const f32x4*)(bsrc + (size_t)(c + 1) * 64 * 256 + 4); }
        bf16x8 VF[2] = {VFn[0], VFn[1]};
        if (c + 1 < SEQ / 64) {
#pragma unroll
            for (int ss = 0; ss < 2; ++ss) { const bf16* vp = Vrow + (c + 1) * 64 + 32 * ss; const v2u v0 = *(const v2u*)vp, v1 = *(const v2u*)(vp + 16); v4u vv; vv.x = v0.x; vv.y = v0.y; vv.z = v1.x; vv.w = v1.y; VFn[ss] = __builtin_bit_cast(bf16x8, vv); } }
        v4u rg[2];
#pragma unroll
        for (int i = 0; i < 2; ++i) rg[i] = *(const v4u*)(P + (tok0 + ((tid + 512 * i) >> 4)) * PW + 2560 + h * 128 + opc * 8);
        const LAS unsigned char* qi = lds + par * GL_IMG + GL_QI; const LAS unsigned char* ki = lds + par * GL_IMG + GL_KI;
        bf16x8 qf[4][2], kf[4][2];
#pragma unroll
        for (int blk = 0; blk < 4; ++blk)
#pragma unroll
            for (int ks = 0; ks < 2; ++ks) { qf[blk][ks] = *(const LAS bf16x8*)(qi + foffs[ks] + blk * 2048); kf[blk][ks] = *(const LAS bf16x8*)(ki + foffs[ks] + blk * 2048); }
        const bf16x8 SF0 = pack8(S[0], S[1]), SF1 = pack8(S[2], S[3]);
        f32x4 O[4];
#pragma unroll
        for (int tb = 0; tb < 4; ++tb) { f32x4 o = mfma16(qf[tb][0], SF0, zero4); o = mfma16(qf[tb][1], SF1, o);
#pragma unroll
            for (int ss = 0; ss < 2; ++ss) if (2 * ss <= tb) { f32x4 a2[2];
#pragma unroll
                for (int hh = 0; hh < 2; ++hh) { const int sb = 2 * ss + hh; f32x4 a = zero4;
                    if (sb <= tb) { a = mfma16(kf[sb][0], qf[tb][0], zero4); a = mfma16(kf[sb][1], qf[tb][1], a);
                        if (sb == tb) {
#pragma unroll
                            for (int r = 0; r < 4; ++r) if (4 * g + r > l15) a[r] = 0.f; } }
                    a2[hh] = a; }
                o = mfma16(pack8(a2[0], a2[1]), VF[ss], o); }
            O[tb] = o; }
#pragma unroll
        for (int db = 0; db < 4; ++db) { f32x4 u = S[db];
#pragma unroll
            for (int ss = 0; ss < 2; ++ss) { const f32x4 t0 = mfma16(kf[2 * ss][db >> 1], If[db], zero4), t1 = mfma16(kf[2 * ss + 1][db >> 1], If[db], zero4); u = mfma16(pack8(t0, t1), VF[ss], u); }
            const f32x4 el = *(const LAS f32x4*)(lds + GL_EL + par * 256 + (16 * db + 4 * g) * 4);
            S[db] = u * el; }
        LAS unsigned char* ob = lds + GL_OB + par * GL_OBS; LAS float* ps = (LAS float*)(lds + GL_PS + par * 2048);
#pragma unroll
        for (int tb = 0; tb < 4; ++tb)
#pragma unroll
            for (int r = 0; r < 4; ++r) { const int t = 16 * tb + 4 * g + r; const float ov = O[tb][r]; float q = ov * ov; q += __shfl_xor(q, 1); q += __shfl_xor(q, 2); q += __shfl_xor(q, 4); q += __shfl_xor(q, 8);
                if (l15 == 0) ps[t * 8 + eb] = q;
                *(LAS bf16*)(ob + t * 272 + (16 * eb + l15) * 2) = (bf16)f2bf(ov); }
        if (c + 1 < SEQ / 64) GLA_STAGE(par ^ 1);
        __syncthreads();
#pragma unroll
        for (int i = 0; i < 2; ++i) { const int ot = (tid + 512 * i) >> 4; const f32x4 p0 = *(const LAS f32x4*)(ps + ot * 8), p1 = *(const LAS f32x4*)(ps + ot * 8 + 4);
            const float ss = ((p0[0] + p0[1]) + (p0[2] + p0[3])) + ((p1[0] + p1[1]) + (p1[2] + p1[3])); const float rs = rsqrtf(ss * (1.0f / 128.0f) + EPS);
            const v4u ov = *(const LAS v4u*)(ob + ot * 272 + opc * 16); const unsigned oa[4] = {ov.x, ov.y, ov.z, ov.w}, ga[4] = {rg[i].x, rg[i].y, rg[i].z, rg[i].w};
            const float gn[8] = {gg0[0], gg0[1], gg0[2], gg0[3], gg1[0], gg1[1], gg1[2], gg1[3]}; v4u w; unsigned* wp = (unsigned*)&w;
#pragma unroll
            for (int j = 0; j < 4; ++j) { const float o0 = __builtin_bit_cast(float, oa[j] << 16), o1 = __builtin_bit_cast(float, oa[j] & 0xffff0000u), g0 = __builtin_bit_cast(float, ga[j] << 16), g1 = __builtin_bit_cast(float, ga[j] & 0xffff0000u);
                wp[j] = pg8::cvtpk(o0 * rs * gn[2 * j] * g0 * __builtin_amdgcn_rcpf(1.0f + __builtin_amdgcn_exp2f(-1.4426950408889634f * g0)), o1 * rs * gn[2 * j + 1] * g1 * __builtin_amdgcn_rcpf(1.0f + __builtin_amdgcn_exp2f(-1.4426950408889634f * g1))); }
            *(v4u*)(CAT + (tok0 + ot) * DM + 512 + h * 128 + opc * 8) = w; }
    }
#undef GLA_STAGE
    __syncthreads();
}

__device__ __forceinline__ void router_phase(Frame& F, const bf16* X2, const float* WR, const float* b_router, float* rsl, float* gate, unsigned* assign, unsigned* list, gu32* cnt) {
    LAS float* xs = (LAS float*)(F.lds + RING_OFF);
    LAS float* wsh = xs + 128 * 129;
    LAS float* lg = wsh + 128 * 32;
    LAS unsigned* hist = (LAS unsigned*)(lg + 128 * 33);
    const int tid = F.tid, t = tid & 63, eg = tid >> 6;
    for (int blk = F.vcu; blk < NTOK / 128; blk += F.G) {
        const size_t tok0 = (size_t)blk * 128;
        f32x4 acc0 = (f32x4){0.f, 0.f, 0.f, 0.f}, acc1 = acc0; float ssq0 = 0.f, ssq1 = 0.f;
        v4u rx[4]; f32x4 rw[2];
#define RT_LOAD(kc) do { _Pragma("unroll") for (int i = 0; i < 4; ++i) rx[i] = *(const v4u*)(X2 + (tok0 + (tid >> 4) + 32 * i) * DM + (kc) + (tid & 15) * 8); \
        _Pragma("unroll") for (int i = 0; i < 2; ++i) rw[i] = *(const f32x4*)(WR + (size_t)(kc) * 32 + (i * 512 + tid) * 4); } while (0)
        RT_LOAD(0);
        for (int kc = 0; kc < DM; kc += 128) {
#pragma unroll
            for (int i = 0; i < 4; ++i) { LAS float* dp = xs + ((tid >> 4) + 32 * i) * 129 + (tid & 15) * 8; const unsigned wv[4] = {rx[i].x, rx[i].y, rx[i].z, rx[i].w};
#pragma unroll
                for (int j = 0; j < 4; ++j) { dp[2 * j] = __builtin_bit_cast(float, wv[j] << 16); dp[2 * j + 1] = __builtin_bit_cast(float, wv[j] & 0xffff0000u); } }
#pragma unroll
            for (int i = 0; i < 2; ++i) *(LAS f32x4*)(wsh + (i * 512 + tid) * 4) = rw[i];
            __syncthreads();
            if (kc + 128 < DM) RT_LOAD(kc + 128);
            const LAS float* xr0 = xs + t * 129; const LAS float* xr1 = xs + (t + 64) * 129;
#pragma unroll 8
            for (int k = 0; k < 128; ++k) { const float x0 = xr0[k], x1 = xr1[k]; const f32x4 w = *(const LAS f32x4*)(wsh + k * 32 + eg * 4); acc0 = acc0 + w * x0; acc1 = acc1 + w * x1; ssq0 += x0 * x0; ssq1 += x1 * x1; }
            __syncthreads();
        }
#undef RT_LOAD
        const float rs0 = rsqrtf(ssq0 * (1.0f / DM) + EPS), rs1 = rsqrtf(ssq1 * (1.0f / DM) + EPS);
#pragma unroll
        for (int i = 0; i < 4; ++i) { const float br = b_router[eg * 4 + i]; lg[t * 33 + eg * 4 + i] = acc0[i] * rs0 + br; lg[(t + 64) * 33 + eg * 4 + i] = acc1[i] * rs1 + br; }
        if (eg == 0) { lg[t * 33 + 32] = rs0; lg[(t + 64) * 33 + 32] = rs1; }
        __syncthreads();
        if (tid < 128) {
            const int w2 = tid >> 6;
            float lv[32];
#pragma unroll
            for (int e = 0; e < 32; ++e) lv[e] = lg[tid * 33 + e];
            const float rs = lg[tid * 33 + 32];
            float tv[4]; int te[4];
#pragma unroll
            for (int k = 0; k < 4; ++k) { float best = -INFINITY; int bi = 0;
#pragma unroll
                for (int e = 0; e < 32; ++e) if (lv[e] > best) { best = lv[e]; bi = e; }
                tv[k] = best; te[k] = bi;
#pragma unroll
                for (int e = 0; e < 32; ++e) if (e == bi) lv[e] = -INFINITY; }
            const float e1 = __expf(tv[1] - tv[0]), e2 = __expf(tv[2] - tv[0]), e3 = __expf(tv[3] - tv[0]); const float inv = 1.0f / (1.0f + e1 + e2 + e3);
            const float gv[4] = {inv, e1 * inv, e2 * inv, e3 * inv};
            const size_t tok = tok0 + tid;
            LAS unsigned* hs = hist + w2 * 32; LAS unsigned* gbase = hist + 64 + w2 * 32;
            if (t < 32) hs[t] = 0u;
            __builtin_amdgcn_wave_barrier(); LDS_WAIT();
            unsigned lpos[4];
#pragma unroll
            for (int k = 0; k < 4; ++k) lpos[k] = __hip_atomic_fetch_add(hs + te[k], 1u, __ATOMIC_RELAXED, __HIP_MEMORY_SCOPE_WORKGROUP);
            __builtin_amdgcn_wave_barrier(); LDS_WAIT();
            if (t < 32) { const unsigned n = hs[t]; gbase[t] = n ? __hip_atomic_fetch_add(cnt + 64 * t, n, RLX_AGENT) : 0u; }
            __builtin_amdgcn_wave_barrier(); LDS_WAIT();
#pragma unroll
            for (int k = 0; k < 4; ++k) { const unsigned pos = gbase[te[k]] + lpos[k]; list[(size_t)te[k] * NTOK + pos] = (unsigned)tok; rsl[(size_t)te[k] * NTOK + pos] = rs;
                assign[tok * 4 + k] = ((unsigned)te[k] << 16) | pos; gate[tok * 4 + k] = gv[k]; }
        }
        __syncthreads();
    }
}
__device__ __forceinline__ int moe_tables(Frame& F) {
    LAS unsigned char* tile_e = F.lds + TAB_OFF; LAS int* tstart = (LAS int*)(F.lds + TAB_TSTART); LAS int* lc = (LAS int*)(F.lds + TAB_CNT);
    if (F.tid < 32) lc[F.tid] = (int)__hip_atomic_load(F.ctl + CW_CNT + 64 * F.tid, RLX_AGENT);
    __syncthreads();
    if (F.tid == 0) { int s = 0; for (int e = 0; e < 32; ++e) { tstart[e] = s; s += (lc[e] + 255) >> 8; } tstart[32] = s; }
    __syncthreads();
    const int T = tstart[32];
    for (int i = F.tid; i < T; i += 512) { int e = 0;
#pragma unroll
        for (int k = 1; k < 32; ++k) e += (tstart[k] <= i) ? 1 : 0;
        tile_e[i] = (unsigned char)e; }
    __syncthreads();
    return T;
}
__device__ __forceinline__ void final_phase(Frame& F, const bf16* X2, float* out, const unsigned char* Y, const float* gate, const unsigned* assign, const float* gfin) {
    (void)moe_tables(F);
    const LAS int* tstart = (const LAS int*)(F.lds + TAB_TSTART);
    const int gw = F.vcu * NWAVES + F.wave, NGW = F.G * NWAVES, lane = lane_here();
    for (int tok0 = gw; tok0 < NTOK; tok0 += 2 * NGW) {
        f32x4 v[2][4];
#pragma unroll
        for (int u = 0; u < 2; ++u) { const int tok = (tok0 + u * NGW < NTOK) ? tok0 + u * NGW : tok0; const v2u* xin = (const v2u*)(X2 + (size_t)tok * DM) + lane;
#pragma unroll
            for (int j = 0; j < 4; ++j) { const v2u w = xin[64 * j]; v[u][j] = (f32x4){__builtin_bit_cast(float, w.x << 16), __builtin_bit_cast(float, w.x & 0xffff0000u), __builtin_bit_cast(float, w.y << 16), __builtin_bit_cast(float, w.y & 0xffff0000u)}; } }
        unsigned yw[2][4][4]; float gk[2][4];
#pragma unroll
        for (int u = 0; u < 2; ++u) { const int tok = (tok0 + u * NGW < NTOK) ? tok0 + u * NGW : tok0;
#pragma unroll
            for (int k = 0; k < 4; ++k) { const unsigned a = assign[(size_t)tok * 4 + k]; gk[u][k] = gate[(size_t)tok * 4 + k]; const size_t row = (size_t)tstart[a >> 16] * 256 + (a & 0xffffu);
                const unsigned* yr = (const unsigned*)(Y + row * DM) + lane;
#pragma unroll
                for (int j = 0; j < 4; ++j) yw[u][k][j] = yr[64 * j]; } }
#pragma unroll
        for (int u = 0; u < 2; ++u) { const int tok = (tok0 + u * NGW < NTOK) ? tok0 + u * NGW : tok0;
#pragma unroll
            for (int k = 0; k < 4; ++k)
#pragma unroll
                for (int j = 0; j < 4; ++j) { const unsigned w = yw[u][k][j]; const auto lo = __builtin_amdgcn_cvt_pk_f32_fp8((int)w, false), hi = __builtin_amdgcn_cvt_pk_f32_fp8((int)w, true);
                    v[u][j].x += gk[u][k] * lo[0]; v[u][j].y += gk[u][k] * lo[1]; v[u][j].z += gk[u][k] * hi[0]; v[u][j].w += gk[u][k] * hi[1]; }
            float s = 0.f;
#pragma unroll
            for (int j = 0; j < 4; ++j) s += (v[u][j].x * v[u][j].x + v[u][j].y * v[u][j].y) + (v[u][j].z * v[u][j].z + v[u][j].w * v[u][j].w);
            const float rs = rsqrtf(wave_sum(s) * (1.0f / DM) + EPS); f32x4* xr = (f32x4*)(out + (size_t)tok * DM) + lane;
#pragma unroll
            for (int j = 0; j < 4; ++j) { const f32x4 gg = ((const f32x4*)gfin)[lane + 64 * j]; xr[64 * j] = v[u][j] * rs * gg; } }
    }
}

constexpr int NPHASE = 10;
struct Args { const void* in[28]; float* out; unsigned char* ws; int ph_lo, ph_hi; };
__global__ void __launch_bounds__(NWAVES * 64, 2) mk_fwd(Args args) {
    extern __shared__ __attribute__((aligned(16))) unsigned char lds[];
    Frame F;
    F.lds = (LAS unsigned char*)lds;
    F.MISC = (volatile LAS unsigned*)(F.lds + MISC_OFF);
    F.tid = threadIdx.x; F.lane = F.tid & 63; F.wave = __builtin_amdgcn_readfirstlane(F.tid >> 6);
    F.G = gridDim.x; { const int bx = blockIdx.x; F.vcu = (F.G % 8 == 0) ? (bx % 8) * (F.G / 8) + bx / 8 : bx; }
    F.ws = args.ws; F.out = args.out; F.ctl = (gu32*)(args.ws + WS_CTL);
    unsigned char* ws = args.ws;
    typedef const void* const volatile __attribute__((address_space(4))) kargp_t;
    kargp_t* const kargs = (kargp_t*)__builtin_amdgcn_kernarg_segment_ptr();
#define INP(k) ((const float*)kargs[k])
    for (int u = F.tid; u < (LDS_BYTES - LDSCTL_OFF) / 4; u += NWAVES * 64) ((LAS unsigned*)(F.lds + LDSCTL_OFF))[u] = 0u;
    __syncthreads();
    const int lo = args.ph_lo, hi = args.ph_hi;
    const bool single = (hi - lo) > 1;
    XcdBarrier bar; bar.bar = (unsigned*)(F.ctl + CW_BAR); bar.x = 0; bar.st = nullptr;
    if (single) bar = xcd_barrier_post((unsigned*)(F.ctl + CW_BAR), F.MISC + 8);
#define IN(k) (lo <= (k) && (k) < hi)
#if defined(PROBE_K0)
    LAS unsigned long long* tsl = (LAS unsigned long long*)(F.lds + TS_OFF);
    if (F.tid == 0) tsl[0] = rt();
#define SEAM(k) do { if (IN(k) && IN((k) + 1)) xcd_barrier(bar); if (F.tid == 0) tsl[(k) + 1] = rt(); } while (0)
#define SEAM_LOCAL(k) do { if (F.tid == 0) tsl[(k) + 1] = rt(); } while (0)
#else
#define SEAM(k) do { if (IN(k) && IN((k) + 1)) xcd_barrier(bar); } while (0)
#define SEAM_LOCAL(k) do { } while (0)
#endif
    typedef pg8::bf16_t hb;
    const int bx = (int)blockIdx.x;

    if (IN(0)) { In I;
        I.x = (const float*)INP(0);
        I.mem = (const float*)INP(1);
        I.positions = (const int*)INP(2);
        I.norm_mix_g = (const float*)INP(3);
        I.w_in = (const float*)INP(4);
        I.lq1 = (const float*)INP(5);
        I.lk1 = (const float*)INP(6);
        I.lq2 = (const float*)INP(7);
        I.lk2 = (const float*)INP(8);
        I.diff_norm_g = (const float*)INP(9);
        I.w_alpha2 = (const float*)INP(10);
        I.b_alpha = (const float*)INP(11);
        I.gla_norm_g = (const float*)INP(12);
        I.w_out = (const float*)INP(13);
        I.norm_cross_g = (const float*)INP(14);
        I.norm_mem_g = (const float*)INP(15);
        I.w_cq = (const float*)INP(16);
        I.w_ck = (const float*)INP(17);
        I.w_cv = (const float*)INP(18);
        I.w_co = (const float*)INP(19);
        I.norm_ffn_g = (const float*)INP(20);
        I.w_router = (const float*)INP(21);
        I.b_router = (const float*)INP(22);
        I.w_up = (const float*)INP(23);
        I.b_up = (const float*)INP(24);
        I.w_down = (const float*)INP(25);
        I.b_down = (const float*)INP(26);
        I.norm_final_g = (const float*)INP(27);
        p0_prologue(F, I); }
    SEAM(0);
    if (IN(1)) {
        pg8::Gemm g{(const hb*)(ws + WS_HN), (const hb*)(ws + WS_WINT), NTOK, 3328, DM, DM, DM, 127, 127};
        typedef pg8::OrderP1<(unsigned)WS_HN, (unsigned)WS_WINT, (unsigned)WS_MN, (unsigned)WS_WCK, (unsigned)WS_WCV> OrdP1; OrdP1 S; S.G = F.G; S.c = bx; S.ws = (const char*)ws;
        pg8::EpiP1 E{pg8::EpiProj{(hb*)(ws + WS_P), (float*)(ws + WS_LA), (const float*)(ws + WS_CS), INP(11)}, pg8::EpiPlain{(hb*)(ws + WS_VT) - (size_t)1024 * NTOK, NTOK, 1.0f},
                     pg8::EpiPlain{(hb*)(ws + WS_KX), DM, 1.0f}, pg8::EpiPlain{(hb*)(ws + WS_VXT), DM, 1.0f}};
        pg8::gemm_phase<pg8::EpiP1, OrdP1, true, true, false, false>(F.lds + RING_OFF, g, S, E);
    }
    SEAM(1);
    if (IN(2)) {
        float lam;
        { const int ln = lane_here(); const float a = INP(5)[ln] * INP(6)[ln], c = INP(7)[ln] * INP(8)[ln]; lam = __expf(wave_sum(a)) - __expf(wave_sum(c)) + 0.2f; }
        LAS int* qslot = (LAS int*)(F.lds + TAB_OFF);
        for (;;) {
            if (F.tid == 0) qslot[0] = (int)__hip_atomic_fetch_add(F.ctl + CW_Q2, 1u, RLX_AGENT);
            __syncthreads();
            const int u = qslot[0];
            __syncthreads();
            if (u >= 64 + 1024 + MOE_UNITS) break;
            if (u >= 64 + 1024) { moe_convert_unit(u - (64 + 1024), INP(23), INP(25), INP(20), ws, F.wave, lane_here()); continue; }
#if defined(PROBE_SPLIT)
            if (u < 64) continue;
#endif
            if (u < 64) { gla_unit(F, (const bf16*)(ws + WS_P), (const float*)(ws + WS_LA), (const bf16*)(ws + WS_GVT), (bf16*)(ws + WS_CAT), INP(12), u >> 2, u & 3);
            }
            else { const int v = u - 64, bh = v & 63, qb = 15 - (v >> 6);
                diffattn_unit(F, (const bf16*)(ws + WS_P), (const bf16*)(ws + WS_VT), (bf16*)(ws + WS_CAT), INP(9), lam, bh >> 2, bh & 3, qb); }
        }
    }
#if defined(PROBE_SPLIT)
    if (IN(2)) { xcd_barrier(bar); if (F.tid == 0) tsl[13] = rt();
        for (int u = F.vcu; u < 64; u += F.G) gla_unit(F, (const bf16*)(ws + WS_P), (const float*)(ws + WS_LA), (const bf16*)(ws + WS_GVT), (bf16*)(ws + WS_CAT), INP(12), u >> 2, u & 3); }
#endif
    SEAM(2);
    if (IN(3)) {
        { pg8::Gemm g{(const hb*)(ws + WS_CAT), (const hb*)(ws + WS_WOUT), NTOK, DM, DM, DM, DM, 127, 127}; pg8::StaticOrder S; S.init(NTOK, DM, F.G, bx);
          pg8::EpiRes1 E{INP(0), (hb*)(ws + WS_X1B), (float*)(ws + WS_SSP1)};
          pg8::gemm_phase<pg8::EpiRes1, pg8::StaticOrder, true, true, false, false>(F.lds + RING_OFF, g, S, E); }
        { pg8::Gemm g{(const hb*)(ws + WS_KX), (const hb*)(ws + WS_WCQ), 64 * 256, DM, 256, DM, DM, 127, 127};
          typedef pg8::OrderGH<(unsigned)WS_KX, (unsigned)WS_WCQ, (unsigned)WS_WCO, (unsigned)WS_VXT> OrdGH; OrdGH S; S.G = F.G; S.c = bx; S.ws = (const char*)ws;
          pg8::EpiGH E{pg8::EpiPlain{(hb*)(ws + WS_GT), DM, 1.0f}, pg8::EpiPlain{(hb*)(ws + WS_HT), DM, 1.0f}};
          pg8::gemm_phase<pg8::EpiGH, OrdGH, true, true>(F.lds + RING_OFF, g, S, E); }
    }
    SEAM(3);
    if (IN(4)) {
        pg8::Gemm g{(const hb*)(ws + WS_X1B), (const hb*)(ws + WS_GT), NTOK, 256, DM, DM, DM, 127, 127}; pg8::OrderXS S; S.init(F.G, bx);
        pg8::EpiSoftmaxN E{(hb*)(ws + WS_PX), (const float*)(ws + WS_SSP1), (PG8_LAS float*)(F.lds + XCH_OFF), (PG8_LAS float*)(F.lds + XCH2_OFF)};
        pg8::gemm_phase<pg8::EpiSoftmaxN, pg8::OrderXS, true, true>(F.lds + RING_OFF, g, S, E);
    }
    SEAM(4);
    if (IN(5)) {
        pg8::Gemm g{(const hb*)(ws + WS_PX), (const hb*)(ws + WS_HT), NTOK, DM, DM, DM, DM, 127, 127}; pg8::OrderXO S; S.init(F.G, bx);
        pg8::EpiRes2 E{(hb*)(ws + WS_X1B), ws + WS_X2B};
        pg8::gemm_phase<pg8::EpiRes2, pg8::OrderXO, true, true, false, false>(F.lds + RING_OFF, g, S, E);
    }
    SEAM(5);
    if (IN(6)) router_phase(F, (const bf16*)(ws + WS_X1B), (const float*)(ws + WS_WR), INP(22), (float*)(ws + WS_RSL), (float*)(ws + WS_GATE), (unsigned*)(ws + WS_ASSIGN), (unsigned*)(ws + WS_LIST), F.ctl + CW_CNT);
    SEAM(6);
    if (IN(7)) {
        const int T = moe_tables(F);
        pg8::Gemm g{(const hb*)(ws + WS_X2B), (const hb*)(ws + WS_WUP), T * 256, NEXP * 2048, 512, 512, 512, 127, 122}; pg8::MoeOrderG S;
        S.init(T, 8, F.G, bx, (const PG8_LAS unsigned char*)(F.lds + TAB_OFF), (const PG8_LAS int*)(F.lds + TAB_TSTART), (const PG8_LAS int*)(F.lds + TAB_CNT), (const unsigned*)(ws + WS_LIST), (PG8_LAS unsigned*)(F.lds + XCH_OFF));
        pg8::EpiUp E{ws + WS_ACT, (const float*)(ws + WS_RSL), (const PG8_LAS int*)(F.lds + TAB_TSTART), (const PG8_LAS int*)(F.lds + TAB_CNT), INP(24)};
        pg8::gemm_phase<pg8::EpiUp, pg8::MoeOrderG, true, true, true, false>(F.lds + RING_OFF, g, S, E);
    }
    SEAM(7);
    if (IN(8)) {
        const int T = moe_tables(F);
        pg8::Gemm g{(const hb*)(ws + WS_ACT), (const hb*)(ws + WS_WDN), T * 256, NEXP * 1024, 512, 512, 512, 127, 122}; pg8::MoeOrder S; S.init(T, 4, F.G, bx, (const PG8_LAS unsigned char*)(F.lds + TAB_OFF));
        pg8::EpiDown E{ws + WS_Y, INP(26)};
        pg8::gemm_phase<pg8::EpiDown, pg8::MoeOrder, true, true, true, false>(F.lds + RING_OFF, g, S, E);
    }
    SEAM(8);
    if (IN(9)) final_phase(F, (const bf16*)(ws + WS_X1B), F.out, (const unsigned char*)(ws + WS_Y), (const float*)(ws + WS_GATE), (const unsigned*)(ws + WS_ASSIGN), INP(27));
#if defined(PROBE_K0)
    { if (F.tid == 0) { tsl[NPHASE] = rt();
        const int ks[2] = {PROBE_K0, PROBE_K1}; unsigned long long code = 0, mul = 1;
        for (int i = 0; i < 2; ++i) { unsigned long long dt = ks[i] == 97 ? tsl[13] - tsl[2] : ks[i] == 98 ? tsl[3] - tsl[13] : tsl[ks[i] + 1] - tsl[ks[i]]; unsigned long long q = (dt + 800) / 1600; if (q > 63) q = 63; code += q * mul; mul *= 64; }
        tsl[15] = code * 6400ull; }
      __syncthreads();
      const unsigned long long t0 = rt(), wait = tsl[15]; float x = (float)F.tid, y = 1.0001f;
      while (rt() - t0 < wait) {
#pragma unroll
          for (int i = 0; i < 64; ++i) x = x * y + 0.5f; }
      if (x == 12345.678f) F.out[0] = x; }
#endif
#undef IN
#undef SEAM
#undef SEAM_LOCAL
}

#ifndef MK_N_LAUNCHES
#define MK_N_LAUNCHES 1
#endif
extern "C" void kernel_launch(void* const* d_in, const int* in_sizes, int n_in, void* d_out, int out_size, void* d_ws, size_t ws_size, hipStream_t stream) {
    static int grid = 0;
    if (grid == 0) {
        if (n_in != 28 || out_size != NTOK * DM || ws_size < WS_END) { fprintf(stderr, "kernel_launch: unexpected shapes: n_in %d out %d ws %zu (need %zu)\n", n_in, out_size, ws_size, (size_t)WS_END); grid = -1; return; }
        int dev = 0, cus = 0, per_cu = 0;
        if (hipGetDevice(&dev) != hipSuccess || hipDeviceGetAttribute(&cus, hipDeviceAttributeMultiprocessorCount, dev) != hipSuccess) { fprintf(stderr, "kernel_launch: device query failed\n"); grid = -1; return; }
        if (hipFuncSetAttribute((const void*)mk_fwd, hipFuncAttributeMaxDynamicSharedMemorySize, LDS_BYTES) != hipSuccess) { fprintf(stderr, "kernel_launch: hipFuncSetAttribute failed\n"); grid = -1; return; }
        if (hipOccupancyMaxActiveBlocksPerMultiprocessor(&per_cu, (const void*)mk_fwd, NWAVES * 64, LDS_BYTES) != hipSuccess || per_cu < 1) { fprintf(stderr, "kernel_launch: occupancy query reports %d workgroups per CU\n", per_cu); (void)hipGetLastError(); grid = -1; return; }
        grid = cus;
    }
    if (grid < 0) return;
    (void)hipMemsetAsync((char*)d_ws + WS_CTL, 0, CTL_ZERO_BYTES, stream);
    Args a{};
    for (int i = 0; i < 28; ++i) a.in[i] = d_in[i];
    a.out = (float*)d_out; a.ws = (unsigned char*)d_ws;
    if (MK_N_LAUNCHES == 1) { a.ph_lo = 0; a.ph_hi = NPHASE; hipLaunchKernelGGL(mk_fwd, dim3(grid), dim3(NWAVES * 64), LDS_BYTES, stream, a); }
    else for (int p = 0; p < NPHASE; ++p) { a.ph_lo = p; a.ph_hi = p + 1; hipLaunchKernelGGL(mk_fwd, dim3(grid), dim3(NWAVES * 64), LDS_BYTES, stream, a); }
}
```

```cpp
#include <hip/hip_runtime.h>
#include <cstdio>
#include <cstdint>
namespace pg8 {
#define PG8_LAS __attribute__((address_space(3)))
typedef unsigned short bf16_t;
typedef short bf16x8 __attribute__((ext_vector_type(8)));
typedef float f32x4 __attribute__((ext_vector_type(4)));
typedef unsigned u32x4 __attribute__((ext_vector_type(4)));
constexpr int BM = 256, BK = 64, HALF = 128, HTB = HALF * BK * 2  , STAGE_BYTES = 8 * HTB, NXCD = 8, WGM = 8;

__host__ __device__ __forceinline__ int lds_byte(int r, int c) { const int st = (r >> 4) * 2 + (c >> 5), rr = r & 15, cc = c & 31, ob = rr * 64 + cc * 2; return st * 1024 + (ob ^ (((ob >> 9) & 1) << 5)); }
__host__ __device__ __forceinline__ void stage_rc(int b, int& R, int& C) { const int st = b / 1024, sb = b % 1024, swz = sb ^ (((sb >> 9) & 1) << 5); R = (st >> 1) * 16 + swz / 64; C = (st & 1) * 32 + (swz % 64) / 2; }
__host__ __device__ __forceinline__ int perm32(int rho) { const int n = rho >> 4, i = rho & 15; return 8 * (i >> 2) + 4 * n + (i & 3); }

struct Unit { int pm, pn; };
struct Gemm { const bf16_t* A; const bf16_t* Bt; int M, N, K, lda, ldb, sa, sb; };
struct OrderBase {
    static constexpr bool GATHER = false;
    __device__ __forceinline__ const char* a_base(const Gemm& g, const Unit& u) const { return (const char*)g.A + (size_t)u.pm * 256 * g.lda * 2; }
    __device__ __forceinline__ const char* b_base(const Gemm& g, const Unit& u) const { return (const char*)g.Bt + (size_t)u.pn * 256 * g.ldb * 2; }
    __device__ __forceinline__ void a_ready(const Unit&) const {}
    __device__ __forceinline__ void done(const Unit&) const {}
};

struct StaticOrder : OrderBase {
    int nM, nN, nwg, G, c;
    __host__ __device__ void init(int M, int N, int G_, int c_) { nM = M / BM; nN = N / BM; nwg = nM * nN; G = G_; c = c_; }
    __host__ __device__ bool next(int i, Unit& u) const {
        const long L = (long)i * G + c; if (L >= nwg) return false;
        int wgid = (int)L; { const int q = nwg / NXCD, r = nwg % NXCD, xcd = wgid % NXCD, off = wgid / NXCD; wgid = (xcd < r ? xcd * (q + 1) : r * (q + 1) + (xcd - r) * q) + off; }
        const int nig = WGM * nN, gid = wgid / nig, fm = gid * WGM, gsz = (nM - fm) < WGM ? (nM - fm) : WGM;
        u.pm = fm + ((wgid % nig) % gsz); u.pn = (wgid % nig) / gsz; return true;
    }
};

typedef unsigned u32x2 __attribute__((ext_vector_type(2)));
typedef float f32x2_t __attribute__((ext_vector_type(2)));
typedef __bf16 bf16x2_t __attribute__((ext_vector_type(2)));
__device__ __forceinline__ unsigned cvtpk(float lo, float hi) { f32x2_t v = {lo, hi}; bf16x2_t b = __builtin_convertvector(v, bf16x2_t); return __builtin_bit_cast(unsigned, b); }
__device__ __forceinline__ void st_bf4(bf16_t* p, f32x4 v) { u32x2 w; w.x = cvtpk(v[0], v[1]); w.y = cvtpk(v[2], v[3]); *(u32x2*)p = w; }
__device__ __forceinline__ unsigned cvt4_fp8(f32x4 v) { unsigned w = __builtin_amdgcn_cvt_pk_fp8_f32(v[0], v[1], 0, false); return __builtin_amdgcn_cvt_pk_fp8_f32(v[2], v[3], w, true); }
__device__ __forceinline__ void st_bf8(bf16_t* p, f32x4 a, f32x4 c) { u32x4 w; w.x = cvtpk(a[0], a[1]); w.y = cvtpk(a[2], a[3]); w.z = cvtpk(c[0], c[1]); w.w = cvtpk(c[2], c[3]); *(u32x4*)p = w; }
__device__ __forceinline__ float bf2f(bf16_t b) { return __builtin_bit_cast(float, (unsigned)b << 16); }
#define EPI_ROWS _Pragma("unroll") for (int ai = 0; ai < 2; ++ai) _Pragma("unroll") for (int m = 0; m < 4; ++m)
#define EPI_COLS _Pragma("unroll") for (int bj = 0; bj < 2; ++bj) _Pragma("unroll") for (int n = 0; n < 2; ++n)
constexpr float LOG2E = 1.4426950408889634f;
constexpr float QSCALE_DA = 0.125f * LOG2E;
constexpr float QSCALE_X = 0.0625f * LOG2E;

struct EpiPlain {
    static constexpr bool PERM = true, AFTER_DRAIN = false;
    bf16_t* O; int ldc; float scale;
    __device__ __forceinline__ void operator()(const f32x4 (&acc)[2][2][4][2], const Unit& u, int wr, int wc, int fr, int fq) const {
        EPI_ROWS { const int row = u.pm * 256 + ai * 128 + wr * 64 + m * 16 + fr; bf16_t* rp = O + (size_t)row * ldc + u.pn * 256 + wc * 32 + fq * 8;
            _Pragma("unroll") for (int bj = 0; bj < 2; ++bj) st_bf8(rp + bj * 128, acc[ai][bj][m][0] * scale, acc[ai][bj][m][1] * scale); }
    }
};
struct EpiProj {
    static constexpr bool PERM = true, AFTER_DRAIN = false;
    bf16_t* P; float* LA; const float* cs; const float* b_alpha;
    template <int ai> __device__ __forceinline__ void decay_rows(const f32x4 (&acc)[2][2][4][2], const Unit& u, int wr, int wc, int fr, int fq) const {
        const int row0 = u.pm * 256 + ai * 128 + wr * 64 + fr;
        EPI_COLS { const int col = bj * 128 + wc * 32 + fq * 8 + n * 4; const f32x4 ba = *(const f32x4*)(b_alpha + col); f32x4 run = {0.f, 0.f, 0.f, 0.f};
            _Pragma("unroll") for (int m = 0; m < 4; ++m) { const f32x4 z = acc[ai][bj][m][n] + ba; f32x4 o;
                _Pragma("unroll") for (int i = 0; i < 4; ++i) { float v = (fminf(z[i], 0.f) - __logf(1.0f + __expf(-fabsf(z[i])))) * 0.0625f;
                    { float t = __shfl_up(v, 1, 16); if (fr >= 1) v += t; t = __shfl_up(v, 2, 16); if (fr >= 2) v += t; t = __shfl_up(v, 4, 16); if (fr >= 4) v += t; t = __shfl_up(v, 8, 16); if (fr >= 8) v += t; }
                    o[i] = v + run[i]; run[i] += __shfl(v, 15, 16); }
                *(f32x4*)(LA + (size_t)(row0 + m * 16) * 256 + col) = o; } }
    }
    __device__ __forceinline__ void operator()(const f32x4 (&acc)[2][2][4][2], const Unit& u, int wr, int wc, int fr, int fq) const {
        const int pn = u.pn;
        if (pn < 4) {
            const float sc = pn < 2 ? QSCALE_DA : 1.0f; const bool ropew = (wc & 1) == 0; const bool rl = fq < 2, hi = fq == 1;
            EPI_ROWS { const int row = u.pm * 256 + ai * 128 + wr * 64 + m * 16 + fr; bf16_t* rp = P + (size_t)row * 3072 + pn * 256 + wc * 32 + fq * 8;
                f32x4 cv[2], sv[2];
                if (ropew) { const f32x4* cp = (const f32x4*)(cs + (size_t)row * 16); cv[0] = cp[0]; cv[1] = cp[1]; sv[0] = cp[2]; sv[1] = cp[3]; }
                _Pragma("unroll") for (int bj = 0; bj < 2; ++bj) { f32x4 v[2] = {acc[ai][bj][m][0], acc[ai][bj][m][1]};
                    if (ropew) { _Pragma("unroll") for (int n = 0; n < 2; ++n) { f32x4 p; p[0] = __shfl_xor(v[n][0], 16); p[1] = __shfl_xor(v[n][1], 16); p[2] = __shfl_xor(v[n][2], 16); p[3] = __shfl_xor(v[n][3], 16);
                            const f32x4 r = hi ? (v[n] * cv[n] + p * sv[n]) : (v[n] * cv[n] - p * sv[n]); v[n] = rl ? r : v[n]; } }
                    st_bf8(rp + bj * 128, v[0] * sc, v[1] * sc); } }
        } else if (pn < 12) {
            const float sc = pn == 6 ? 0.125f : 1.0f;
            EPI_ROWS { const int row = u.pm * 256 + ai * 128 + wr * 64 + m * 16 + fr; bf16_t* rp = P + (size_t)row * 3072 + pn * 256 + wc * 32 + fq * 8;
                _Pragma("unroll") for (int bj = 0; bj < 2; ++bj) st_bf8(rp + bj * 128, acc[ai][bj][m][0] * sc, acc[ai][bj][m][1] * sc); }
        } else {
            decay_rows<0>(acc, u, wr, wc, fr, fq); decay_rows<1>(acc, u, wr, wc, fr, fq);
        }
    }
};
struct EpiP1 {
    static constexpr bool PERM = true, AFTER_DRAIN = false;
    EpiProj proj; EpiPlain vt, kx, vxt;
    __device__ __forceinline__ void operator()(const f32x4 (&acc)[2][2][4][2], const Unit& u, int wr, int wc, int fr, int fq) const {
        const int job = u.pn >> 16; Unit v; v.pm = u.pm; v.pn = u.pn & 0xffff;
        if (job == 0) proj(acc, v, wr, wc, fr, fq); else if (job == 1) vt(acc, v, wr, wc, fr, fq); else if (job == 2) kx(acc, v, wr, wc, fr, fq); else vxt(acc, v, wr, wc, fr, fq);
    }
};
struct EpiRes1 {
    static constexpr bool PERM = true, AFTER_DRAIN = false;
    const float* base; bf16_t* xb; float* ssp;
    __device__ __forceinline__ void operator()(const f32x4 (&acc)[2][2][4][2], const Unit& u, int wr, int wc, int fr, int fq) const {
        EPI_ROWS { const int row = u.pm * 256 + ai * 128 + wr * 64 + m * 16 + fr; const size_t off = (size_t)row * 1024 + u.pn * 256 + wc * 32 + fq * 8; float ss = 0.f;
            _Pragma("unroll") for (int bj = 0; bj < 2; ++bj) { const size_t o2 = off + bj * 128; const f32x4 v0 = *(const f32x4*)(base + o2) + acc[ai][bj][m][0], v1 = *(const f32x4*)(base + o2 + 4) + acc[ai][bj][m][1]; st_bf8(xb + o2, v0, v1);
                ss += ((v0[0] * v0[0] + v0[1] * v0[1]) + (v0[2] * v0[2] + v0[3] * v0[3])) + ((v1[0] * v1[0] + v1[1] * v1[1]) + (v1[2] * v1[2] + v1[3] * v1[3])); }
            ss += __shfl_xor(ss, 16); ss += __shfl_xor(ss, 32);
            if (fq == 0) ssp[(size_t)row * 16 + u.pn * 4 + wc] = ss; }
    }
};
struct EpiQX {
    static constexpr bool PERM = true, AFTER_DRAIN = false;
    bf16_t* O; const float* ssp;
    __device__ __forceinline__ void operator()(const f32x4 (&acc)[2][2][4][2], const Unit& u, int wr, int wc, int fr, int fq) const {
        EPI_ROWS { const int row = u.pm * 256 + ai * 128 + wr * 64 + m * 16 + fr; const f32x4* sp = (const f32x4*)(ssp + (size_t)row * 16);
            const f32x4 a = sp[0], b = sp[1], c = sp[2], d = sp[3]; const float ss = ((a[0] + a[1]) + (a[2] + a[3])) + ((b[0] + b[1]) + (b[2] + b[3])) + ((c[0] + c[1]) + (c[2] + c[3])) + ((d[0] + d[1]) + (d[2] + d[3]));
            const float rs = rsqrtf(ss * (1.0f / 1024.0f) + 1e-6f) * QSCALE_X; bf16_t* rp = O + (size_t)row * 1024 + u.pn * 256 + wc * 32 + fq * 8;
            _Pragma("unroll") for (int bj = 0; bj < 2; ++bj) st_bf8(rp + bj * 128, acc[ai][bj][m][0] * rs, acc[ai][bj][m][1] * rs); }
    }
};
struct EpiRes2 {
    static constexpr bool PERM = true, AFTER_DRAIN = false;
    bf16_t* xh; unsigned char* x8;
    __device__ __forceinline__ void operator()(const f32x4 (&acc)[2][2][4][2], const Unit& u, int wr, int wc, int fr, int fq) const {
        EPI_ROWS { const int row = u.pm * 256 + ai * 128 + wr * 64 + m * 16 + fr; const size_t off = (size_t)row * 1024 + u.pn * 256 + wc * 32 + fq * 8;
            _Pragma("unroll") for (int bj = 0; bj < 2; ++bj) { bf16_t* p = xh + off + bj * 128; const u32x4 w = *(const u32x4*)p;
                f32x4 v0 = {__builtin_bit_cast(float, w.x << 16), __builtin_bit_cast(float, w.x & 0xffff0000u), __builtin_bit_cast(float, w.y << 16), __builtin_bit_cast(float, w.y & 0xffff0000u)};
                f32x4 v1 = {__builtin_bit_cast(float, w.z << 16), __builtin_bit_cast(float, w.z & 0xffff0000u), __builtin_bit_cast(float, w.w << 16), __builtin_bit_cast(float, w.w & 0xffff0000u)};
                v0 = v0 + acc[ai][bj][m][0]; v1 = v1 + acc[ai][bj][m][1]; st_bf8(p, v0, v1); u32x2 q; q.x = cvt4_fp8(v0); q.y = cvt4_fp8(v1); *(u32x2*)(x8 + off + bj * 128) = q; } }
    }
};
struct EpiUp {
    static constexpr bool PERM = true, AFTER_DRAIN = false;
    unsigned char* ACT; const float* rsl; const PG8_LAS int* tstart; const PG8_LAS int* cnt; const float* b_up;
    __device__ __forceinline__ void operator()(const f32x4 (&acc)[2][2][4][2], const Unit& u, int wr, int wc, int fr, int fq) const {
        const int e = u.pn >> 3, pnl = u.pn & 7; const float* bg = b_up + (size_t)e * 2048 + pnl * 128 + wc * 32 + fq * 8;
        const int pos0 = (u.pm - tstart[e]) * 256 + wr * 64 + fr, nv = cnt[e]; const float* rp0 = rsl + (size_t)e * 32768 + pos0;
        const f32x4 bg0 = *(const f32x4*)bg, bg1 = *(const f32x4*)(bg + 4), bl0 = *(const f32x4*)(bg + 1024), bl1 = *(const f32x4*)(bg + 1028);
        EPI_ROWS { const int row = u.pm * 256 + ai * 128 + wr * 64 + m * 16 + fr; const float rs = (pos0 + ai * 128 + m * 16) < nv ? rp0[ai * 128 + m * 16] : 0.f;
            unsigned char* rp = ACT + (size_t)row * 1024 + pnl * 128 + wc * 32 + fq * 8; u32x2 w;
            _Pragma("unroll") for (int n = 0; n < 2; ++n) { const f32x4 g = acc[ai][0][m][n] * rs + (n ? bg1 : bg0), l = acc[ai][1][m][n] * rs + (n ? bl1 : bl0); f32x4 o;
                _Pragma("unroll") for (int i = 0; i < 4; ++i) { const float gl = fminf(g[i], 7.0f), li = fminf(fmaxf(l[i], -7.0f), 7.0f); o[i] = gl * __builtin_amdgcn_rcpf(1.0f + __builtin_amdgcn_exp2f(-2.4554669595930156f * gl)) * (li + 1.0f); }
                if (n) w.y = cvt4_fp8(o); else w.x = cvt4_fp8(o); }
            *(u32x2*)rp = w; }
    }
};
struct EpiDown {
    static constexpr bool PERM = true, AFTER_DRAIN = false;
    unsigned char* Y; const float* b_down;
    __device__ __forceinline__ void operator()(const f32x4 (&acc)[2][2][4][2], const Unit& u, int wr, int wc, int fr, int fq) const {
        const int e = u.pn >> 2, pnl = u.pn & 3; const float* bp = b_down + (size_t)e * 1024 + pnl * 256 + wc * 32 + fq * 8;
        f32x4 bv[2][2];
        _Pragma("unroll") for (int bj = 0; bj < 2; ++bj) _Pragma("unroll") for (int n = 0; n < 2; ++n) bv[bj][n] = *(const f32x4*)(bp + bj * 128 + n * 4);
        EPI_ROWS { const int row = u.pm * 256 + ai * 128 + wr * 64 + m * 16 + fr; unsigned char* rp = Y + (size_t)row * 1024 + pnl * 256 + wc * 32 + fq * 8;
            _Pragma("unroll") for (int bj = 0; bj < 2; ++bj) { u32x2 w; w.x = cvt4_fp8(acc[ai][bj][m][0] + bv[bj][0]); w.y = cvt4_fp8(acc[ai][bj][m][1] + bv[bj][1]); *(u32x2*)(rp + bj * 128) = w; } }
    }
};
struct OrderMap : OrderBase {
    StaticOrder so;
    __device__ void init(int nM, int nN, int G, int c) { so.nM = nM; so.nN = nN; so.nwg = nM * nN; so.G = G; so.c = c; }
    __device__ bool next(int i, Unit& u) const { if (!so.next(i, u)) return false; u.pn += (u.pn >= 4 ? 2 : 0) + (u.pn >= 6 ? 2 : 0); return true; }
};
struct OrderVT : OrderBase {
    StaticOrder so;
    __device__ void init(int nN, int G, int c) { so.nM = 4; so.nN = nN; so.nwg = 4 * nN; so.G = G; so.c = c; }
    __device__ bool next(int i, Unit& u) const { if (!so.next(i, u)) return false; u.pm += (u.pm >= 2 ? 6 : 4); return true; }
};
__device__ __forceinline__ void map_unit(int L, int nM, int nN, int& pm, int& pn) {
    const int nwg = nM * nN; int wgid = L; { const int q = nwg / NXCD, r = nwg % NXCD, xcd = wgid % NXCD, off = wgid / NXCD; wgid = (xcd < r ? xcd * (q + 1) : r * (q + 1) + (xcd - r) * q) + off; }
    const int nig = WGM * nN, gid = wgid / nig, fm = gid * WGM, gsz = (nM - fm) < WGM ? (nM - fm) : WGM;
    pm = fm + ((wgid % nig) % gsz); pn = (wgid % nig) / gsz;
}
template <unsigned oHN, unsigned oWINT, unsigned oMN, unsigned oWCK, unsigned oWCV>
struct OrderP1 : OrderBase {
    int G, c; const char* ws;
    __device__ __forceinline__ bool next(int i, Unit& u) const {
        int L = i * G + c; if (L >= 1792) return false;
        if (L < 1152) { map_unit(L, 128, 9, u.pm, u.pn); u.pn += (u.pn >= 4 ? 2 : 0) + (u.pn >= 6 ? 2 : 0); return true; } L -= 1152;
        if (L < 512) { map_unit(L, 4, 128, u.pm, u.pn); u.pm += (u.pm >= 2 ? 6 : 4); u.pn |= 1 << 16; return true; } L -= 512;
        if (L < 64) { map_unit(L, 16, 4, u.pm, u.pn); u.pn |= 2 << 16; return true; } L -= 64;
        map_unit(L, 16, 4, u.pm, u.pn); u.pn |= 3 << 16; return true;
    }
    __device__ __forceinline__ const char* a_base(const Gemm&, const Unit& u) const { const int job = u.pn >> 16; unsigned o = oHN; o = job == 1 ? oWINT : o; o = job >= 2 ? oMN : o; return ws + o + (size_t)u.pm * (256 * 1024 * 2); }
    __device__ __forceinline__ const char* b_base(const Gemm&, const Unit& u) const { const int job = u.pn >> 16; unsigned o = oWINT; o = job == 1 ? oHN : o; o = job == 2 ? oWCK : o; o = job == 3 ? oWCV : o; return ws + o + (size_t)(u.pn & 0xffff) * (256 * 1024 * 2); }
};
struct MoeOrder : OrderBase {
    StaticOrder so; const PG8_LAS unsigned char* tile_e; int nN;
    __device__ void init(int nM, int nN_, int G, int c, const PG8_LAS unsigned char* te) { so.nM = nM; so.nN = nN_; so.nwg = nM * nN_; so.G = G; so.c = c; tile_e = te; nN = nN_; }
    __device__ bool next(int i, Unit& u) const { if (!so.next(i, u)) return false; u.pn += (int)tile_e[u.pm] * nN; return true; }
};


struct MoeOrderG : OrderBase {
    static constexpr bool GATHER = true;
    StaticOrder so; const PG8_LAS unsigned char* tile_e; const PG8_LAS int* tstart; const PG8_LAS int* cnt; const unsigned* list; PG8_LAS unsigned* gslot; int nN;
    __device__ void init(int nM, int nN_, int G, int c, const PG8_LAS unsigned char* te, const PG8_LAS int* ts, const PG8_LAS int* cn, const unsigned* li, PG8_LAS unsigned* gs) {
        so.nM = nM; so.nN = nN_; so.nwg = nM * nN_; so.G = G; so.c = c; tile_e = te; tstart = ts; cnt = cn; list = li; gslot = gs; nN = nN_; }
    __device__ bool next(int i, Unit& u) const { if (!so.next(i, u)) return false; u.pn += (int)tile_e[u.pm] * nN; return true; }
    __device__ __forceinline__ const char* a_base(const Gemm& g, const Unit&) const { return (const char*)g.A; }
    __device__ __forceinline__ const unsigned* rows(const Unit& u) const { const int e = u.pn / nN; return list + (size_t)e * 32768 + (size_t)(u.pm - tstart[e]) * 256; }
    __device__ __forceinline__ int nvalid(const Unit& u) const { const int e = u.pn / nN; return cnt[e] - (u.pm - tstart[e]) * 256; }
};
struct OrderX1 : OrderBase {
    StaticOrder so;
    __device__ void init(int G, int c) { so.nM = 128; so.nN = 4; so.nwg = 512; so.G = G; so.c = c; }
    __device__ bool next(int i, Unit& u) const { return so.next(i, u); }
    __device__ __forceinline__ const char* a_base(const Gemm& g, const Unit& u) const { return (const char*)(g.A + (size_t)u.pm * 256 * 1024 + u.pn * 256); }
    __device__ __forceinline__ const char* b_base(const Gemm& g, const Unit& u) const { return (const char*)(g.Bt + (size_t)(u.pm >> 3) * 256 * 1024 + u.pn * 256); }
};
struct OrderX2 : OrderBase {
    StaticOrder so;
    __device__ void init(int G, int c) { so.nM = 128; so.nN = 4; so.nwg = 512; so.G = G; so.c = c; }
    __device__ bool next(int i, Unit& u) const { return so.next(i, u); }
    __device__ __forceinline__ const char* a_base(const Gemm& g, const Unit& u) const { return (const char*)(g.A + (size_t)u.pm * 256 * 1024 + u.pn * 256); }
    __device__ __forceinline__ const char* b_base(const Gemm& g, const Unit& u) const { return (const char*)(g.Bt + (size_t)u.pn * 256 * 4096 + (u.pm >> 3) * 256); }
};
struct EpiSoftmax {
    static constexpr bool PERM = true, AFTER_DRAIN = false;
    bf16_t* PX; float* lp; PG8_LAS float* xch;
    __device__ __forceinline__ void operator()(const f32x4 (&acc)[2][2][4][2], const Unit& u, int wr, int wc, int fr, int fq) const {
        PG8_LAS char* rb = (PG8_LAS char*)xch + (wr * 64 + fr) * 16; asm volatile("" : "+v"(rb));
        PG8_LAS char* wb = rb + wc * 4; asm volatile("" : "+v"(wb));
        EPI_ROWS { float a = -INFINITY;
            EPI_COLS { const f32x4 v = acc[ai][bj][m][n]; a = fmaxf(a, fmaxf(fmaxf(v[0], v[1]), fmaxf(v[2], v[3]))); }
            a = fmaxf(a, __shfl_xor(a, 16)); a = fmaxf(a, __shfl_xor(a, 32));
            if (fq == 0) *(PG8_LAS float*)(wb + (ai * 128 + m * 16) * 16) = a; }
        asm volatile("s_waitcnt lgkmcnt(0)" ::: "memory"); __builtin_amdgcn_s_barrier(); asm volatile("" ::: "memory");
        const int row0 = u.pm * 256 + wr * 64 + fr; bf16_t* rp0 = PX + (size_t)row0 * 1024 + u.pn * 256 + wc * 32 + fq * 8; float* lp0 = lp + (size_t)row0 * 16 + u.pn * 4 + wc;
        EPI_ROWS { const f32x4 q = *(const PG8_LAS f32x4*)(rb + (ai * 128 + m * 16) * 16); const float mr = fmaxf(fmaxf(q[0], q[1]), fmaxf(q[2], q[3]));
            bf16_t* rp = rp0 + (size_t)(ai * 128 + m * 16) * 1024; float ps = 0.f;
            _Pragma("unroll") for (int bj = 0; bj < 2; ++bj) { f32x4 p[2];
                _Pragma("unroll") for (int n = 0; n < 2; ++n) _Pragma("unroll") for (int i = 0; i < 4; ++i) { p[n][i] = __builtin_amdgcn_exp2f(acc[ai][bj][m][n][i] - mr); ps += p[n][i]; }
                st_bf8(rp + bj * 128, p[0], p[1]); }
            ps += __shfl_xor(ps, 16); ps += __shfl_xor(ps, 32);
            if (fq == 0) lp0[(ai * 128 + m * 16) * 16] = ps; }
        asm volatile("s_waitcnt lgkmcnt(0)" ::: "memory"); __builtin_amdgcn_s_barrier(); asm volatile("" ::: "memory");
    }
};
struct EpiPV {
    static constexpr bool PERM = true, AFTER_DRAIN = false;
    bf16_t* O; const float* lp;
    __device__ __forceinline__ void operator()(const f32x4 (&acc)[2][2][4][2], const Unit& u, int wr, int wc, int fr, int fq) const {
        EPI_ROWS { const int row = u.pm * 256 + ai * 128 + wr * 64 + m * 16 + fr; const f32x4 q = *(const f32x4*)(lp + (size_t)row * 16 + u.pn * 4);
            const float inv = 1.0f / ((q[0] + q[1]) + (q[2] + q[3])); bf16_t* rp = O + (size_t)row * 1024 + u.pn * 256 + wc * 32 + fq * 8;
            _Pragma("unroll") for (int bj = 0; bj < 2; ++bj) st_bf8(rp + bj * 128, acc[ai][bj][m][0] * inv, acc[ai][bj][m][1] * inv); }
    }
};

template <unsigned oKX, unsigned oWCQR, unsigned oWCOT, unsigned oVX>
struct OrderGH : OrderBase {
    int G, c; const char* ws;
    __device__ __forceinline__ bool next(int i, Unit& u) const { int L = i * G + c; if (L >= 512) return false;
        if (L < 256) { u.pm = L >> 2; u.pn = L & 3; } else { L -= 256; u.pm = L >> 2; u.pn = (L & 3) | (1 << 16); } return true; }
    __device__ __forceinline__ const char* a_base(const Gemm&, const Unit& u) const { const int job = u.pn >> 16, pn = u.pn & 0xffff;
        return job == 0 ? ws + oKX + ((size_t)(u.pm >> 2) * 256 * 1024 + (u.pm & 3) * 256) * 2 : ws + oWCOT + ((size_t)(u.pm & 3) * 256 * 1024 + pn * 256) * 2; }
    __device__ __forceinline__ const char* b_base(const Gemm&, const Unit& u) const { const int job = u.pn >> 16, pn = u.pn & 0xffff;
        return job == 0 ? ws + oWCQR + ((size_t)pn * 256 * 1024 + (u.pm & 3) * 256) * 2 : ws + oVX + ((size_t)(u.pm >> 2) * 256 * 1024 + pn * 256) * 2; }
};
struct EpiGH {
    static constexpr bool PERM = true, AFTER_DRAIN = false;
    EpiPlain gt, ht;
    __device__ __forceinline__ void operator()(const f32x4 (&acc)[2][2][4][2], const Unit& u, int wr, int wc, int fr, int fq) const {
        Unit v; v.pm = u.pm; v.pn = u.pn & 0xffff; if ((u.pn >> 16) == 0) gt(acc, v, wr, wc, fr, fq); else ht(acc, v, wr, wc, fr, fq); }
};
struct OrderXS : OrderBase {
    StaticOrder so;
    __device__ void init(int G, int c) { so.nM = 128; so.nN = 4; so.nwg = 512; so.G = G; so.c = c; }
    __device__ bool next(int i, Unit& u) const { return so.next(i, u); }
    __device__ __forceinline__ const char* b_base(const Gemm& g, const Unit& u) const { return (const char*)(g.Bt + ((size_t)(u.pm >> 3) * 1024 + u.pn * 256) * 1024); }
};
struct EpiSoftmaxN {
    static constexpr bool PERM = true, AFTER_DRAIN = false;
    bf16_t* PX; const float* ssp; PG8_LAS float* xmax; PG8_LAS float* xsum;
    __device__ __forceinline__ void operator()(f32x4 (&acc)[2][2][4][2], const Unit& u, int wr, int wc, int fr, int fq) const {
        PG8_LAS char* rb = (PG8_LAS char*)xmax + (wr * 64 + fr) * 16; asm volatile("" : "+v"(rb));
        PG8_LAS char* wb = rb + wc * 4; asm volatile("" : "+v"(wb));
        PG8_LAS char* rb2 = (PG8_LAS char*)xsum + (wr * 64 + fr) * 16; asm volatile("" : "+v"(rb2));
        PG8_LAS char* wb2 = rb2 + wc * 4; asm volatile("" : "+v"(wb2));
        const int row0 = u.pm * 256 + wr * 64 + fr;
        EPI_ROWS { const f32x4* sp = (const f32x4*)(ssp + (size_t)(row0 + ai * 128 + m * 16) * 16);
            const f32x4 a4 = sp[0], b4 = sp[1], c4 = sp[2], d4 = sp[3]; const float ss = ((a4[0] + a4[1]) + (a4[2] + a4[3])) + ((b4[0] + b4[1]) + (b4[2] + b4[3])) + ((c4[0] + c4[1]) + (c4[2] + c4[3])) + ((d4[0] + d4[1]) + (d4[2] + d4[3]));
            const float rs = rsqrtf(ss * (1.0f / 1024.0f) + 1e-6f) * QSCALE_X; float a = -INFINITY;
            EPI_COLS { f32x4 v = acc[ai][bj][m][n] * rs; acc[ai][bj][m][n] = v; a = fmaxf(a, fmaxf(fmaxf(v[0], v[1]), fmaxf(v[2], v[3]))); }
            a = fmaxf(a, __shfl_xor(a, 16)); a = fmaxf(a, __shfl_xor(a, 32));
            if (fq == 0) *(PG8_LAS float*)(wb + (ai * 128 + m * 16) * 16) = a; }
        asm volatile("s_waitcnt lgkmcnt(0)" ::: "memory"); __builtin_amdgcn_s_barrier(); asm volatile("" ::: "memory");
        EPI_ROWS { const f32x4 q = *(const PG8_LAS f32x4*)(rb + (ai * 128 + m * 16) * 16); const float mr = fmaxf(fmaxf(q[0], q[1]), fmaxf(q[2], q[3])); float ps = 0.f;
            EPI_COLS { f32x4 p; _Pragma("unroll") for (int i = 0; i < 4; ++i) { p[i] = __builtin_amdgcn_exp2f(acc[ai][bj][m][n][i] - mr); ps += p[i]; } acc[ai][bj][m][n] = p; }
            ps += __shfl_xor(ps, 16); ps += __shfl_xor(ps, 32);
            if (fq == 0) *(PG8_LAS float*)(wb2 + (ai * 128 + m * 16) * 16) = ps; }
        asm volatile("s_waitcnt lgkmcnt(0)" ::: "memory"); __builtin_amdgcn_s_barrier(); asm volatile("" ::: "memory");
        bf16_t* rp0 = PX + (size_t)row0 * 1024 + u.pn * 256 + wc * 32 + fq * 8;
        EPI_ROWS { const f32x4 q = *(const PG8_LAS f32x4*)(rb2 + (ai * 128 + m * 16) * 16); const float inv = __builtin_amdgcn_rcpf((q[0] + q[1]) + (q[2] + q[3]));
            bf16_t* rp = rp0 + (size_t)(ai * 128 + m * 16) * 1024;
            _Pragma("unroll") for (int bj = 0; bj < 2; ++bj) st_bf8(rp + bj * 128, acc[ai][bj][m][0] * inv, acc[ai][bj][m][1] * inv); }
    }
};
struct OrderXO : OrderBase {
    StaticOrder so;
    __device__ void init(int G, int c) { so.nM = 128; so.nN = 4; so.nwg = 512; so.G = G; so.c = c; }
    __device__ bool next(int i, Unit& u) const { return so.next(i, u); }
    __device__ __forceinline__ const char* b_base(const Gemm& g, const Unit& u) const { return (const char*)(g.Bt + ((size_t)(u.pm >> 3) * 1024 + u.pn * 256) * 1024); }
};
typedef int v4i_t __attribute__((ext_vector_type(4))); typedef int v8i_t __attribute__((ext_vector_type(8)));
__device__ __forceinline__ v8i_t cat8(bf16x8 lo, bf16x8 hi) { return __builtin_shufflevector(__builtin_bit_cast(v4i_t, lo), __builtin_bit_cast(v4i_t, hi), 0, 1, 2, 3, 4, 5, 6, 7); }
__device__ __forceinline__ void mfma8(f32x4& acc, v8i_t w, v8i_t a, int sw, int sa) {
    asm volatile("s_nop 1\n\tv_mfma_scale_f32_16x16x128_f8f6f4 %0, %1, %2, %0, %3, %4 op_sel_hi:[0,0,0]" : "+v"(acc) : "v"(w), "v"(a), "v"(sw), "v"(sa)); }
constexpr int PF_D = 4, PF_LDS = 137216;
template <class Epi, class Sched, bool ALIGN_EPI = false, bool SP2 = false, bool FP8 = false, bool PF = false>
__device__ __forceinline__ void gemm_phase(PG8_LAS unsigned char* lds, const Gemm g, const Sched& S, const Epi& E) {
    const int tid = threadIdx.x, wid = __builtin_amdgcn_readfirstlane(tid >> 6), lane = tid & 63, wr = wid >> 2, wc = wid & 3, fr = lane & 15, fq = lane >> 4;
    const int K = g.K, nt = K / BK;
    unsigned voffA[2], voffB[2];
    unsigned gC[2][2];
#pragma unroll
    for (int i = 0; i < 2; ++i) { int R, C; stage_rc(tid * 16 + i * 8192, R, C); const int Rb = Epi::PERM ? ((R & ~31) + perm32(R & 31)) : R;
        voffA[i] = (unsigned)(R * g.lda + C) * 2u; voffB[i] = (unsigned)(Rb * g.ldb + C) * 2u; }
    const bool pfA = !Sched::GATHER && wid < 4;
    const unsigned pfoff = (unsigned)((((wid >> 1) & 1) * HALF + (wid & 1) * 64 + lane) * (pfA ? g.lda : g.ldb)) * 2u;
    const size_t kstep = (size_t)(BK * 2);
    const size_t hstepA = (size_t)HALF * g.lda * 2, hstepB = (size_t)HALF * g.ldb * 2;
    const unsigned ldsw = (unsigned)wid * 1024u;
    const int aoff = lds_byte(wr * 64 + fr, fq * 8), boff = lds_byte(wc * 32 + fr, fq * 8);
#define PG8_SA(b, h) (((b) * 2 + (h)) * HTB)
#define PG8_SB(b, h) ((4 + (b) * 2 + (h)) * HTB)
#define PG8_STAGE(bufoff, gbase, voff) do { _Pragma("unroll") for (int _i = 0; _i < 2; ++_i) \
        __builtin_amdgcn_global_load_lds((const unsigned*)((const char*)(gbase) + (voff)[_i]), (PG8_LAS unsigned*)(lds + (bufoff) + ldsw + _i * 8192), 16, 0, 0); } while (0)
#define PG8_STAGE_A(bufoff, ptr, h, nx) do { if constexpr (Sched::GATHER) { PG8_STAGE(bufoff, ptr, gC[h]); } else { PG8_STAGE(bufoff, (ptr) + ((h) ? hstepA : 0), voffA); } } while (0)
#define PG8_LDA(dst, b, h) do { _Pragma("unroll") for (int m = 0; m < 4; ++m) _Pragma("unroll") for (int k = 0; k < 2; ++k) dst[m][k] = *(const PG8_LAS bf16x8*)(lds + PG8_SA(b, h) + aoff + m * 2048 + k * 1024); } while (0)
#define PG8_LDB(dst, b, h) do { _Pragma("unroll") for (int n = 0; n < 2; ++n) _Pragma("unroll") for (int k = 0; k < 2; ++k) dst[n][k] = *(const PG8_LAS bf16x8*)(lds + PG8_SB(b, h) + boff + n * 2048 + k * 1024); } while (0)
#define PG8_MMA(ai, bj, At, Bt) do { __builtin_amdgcn_s_setprio(1); \
        if constexpr (FP8) { _Pragma("unroll") for (int m = 0; m < 4; ++m) _Pragma("unroll") for (int n = 0; n < 2; ++n) \
            mfma8(acc[ai][bj][m][n], cat8(Bt[n][0], Bt[n][1]), cat8(At[m][0], At[m][1]), g.sb, g.sa); } \
        else { _Pragma("unroll") for (int m = 0; m < 4; ++m) _Pragma("unroll") for (int n = 0; n < 2; ++n) _Pragma("unroll") for (int k = 0; k < 2; ++k) \
            acc[ai][bj][m][n] = __builtin_amdgcn_mfma_f32_16x16x32_bf16(Bt[n][k], At[m][k], acc[ai][bj][m][n], 0, 0, 0); } \
        __builtin_amdgcn_s_setprio(0); } while (0)
#define PG8_WAIT_V(n) asm volatile("s_waitcnt vmcnt(" #n ")" ::: "memory")
#define PG8_WAIT_VP() do { if constexpr (PF) asm volatile("s_waitcnt vmcnt(9)" ::: "memory"); else asm volatile("s_waitcnt vmcnt(8)" ::: "memory"); } while (0)
#define PG8_PREFETCH(tp) do { if constexpr (PF) { const int tp_ = (tp); const char* pb_ = tp_ < nt ? (pfA ? cA : cB) + (size_t)tp_ * kstep : (pfA ? nA : nB) + (size_t)(tp_ - nt) * kstep; \
        __builtin_amdgcn_global_load_lds((const unsigned*)(pb_ + pfoff), (PG8_LAS unsigned*)(lds + PF_LDS + wid * 256), 4, 0, 0); } } while (0)
#define PG8_WAIT_L(n) asm volatile("s_waitcnt lgkmcnt(" #n ")" ::: "memory")
#define PG8_BAR __builtin_amdgcn_s_barrier()
#define PG8_SCHED __builtin_amdgcn_sched_barrier(0)
    Unit cur, nxt; int ui = 0;
    if (!S.next(0, cur)) return;
    f32x4 acc[2][2][4][2];
#pragma unroll
    for (int a = 0; a < 2; ++a)
#pragma unroll
        for (int b = 0; b < 2; ++b)
#pragma unroll
            for (int m = 0; m < 4; ++m)
#pragma unroll
                for (int n = 0; n < 2; ++n) acc[a][b][m][n] = (f32x4){0.f, 0.f, 0.f, 0.f};
    bf16x8 At[4][2], B0[2][2], B1[2][2];
    const char* cA = S.a_base(g, cur); const char* cB = S.b_base(g, cur);
    if constexpr (Sched::GATHER) { const unsigned* rp = S.rows(cur); const int nv = S.nvalid(cur);
#pragma unroll
        for (int h = 0; h < 2; ++h)
#pragma unroll
            for (int i = 0; i < 2; ++i) { int R, C; stage_rc(tid * 16 + i * 8192, R, C); const int r = h * HALF + R; const unsigned tok = r < nv ? rp[r] : 0u; gC[h][i] = tok * (unsigned)(g.lda * 2) + (unsigned)C * 2u; } }
    S.a_ready(cur);
    if constexpr (SP2) {
        PG8_STAGE(PG8_SB(0, 0), cB, voffB); PG8_STAGE(PG8_SB(0, 1), cB + hstepB, voffB); PG8_STAGE_A(PG8_SA(0, 0), cA, 0, 0); PG8_STAGE_A(PG8_SA(0, 1), cA, 1, 0);
        if (wr == 1) PG8_BAR;
        PG8_WAIT_V(2); PG8_BAR;
        PG8_STAGE(PG8_SB(1, 0), cB + kstep, voffB); PG8_STAGE_A(PG8_SA(1, 0), cA + kstep, 0, 0); PG8_STAGE(PG8_SB(1, 1), cB + hstepB + kstep, voffB);
        PG8_WAIT_V(6); PG8_BAR;
    } else {
        PG8_STAGE(PG8_SB(0, 0), cB, voffB); PG8_STAGE_A(PG8_SA(0, 0), cA, 0, 0); PG8_STAGE(PG8_SB(0, 1), cB + hstepB, voffB); PG8_STAGE_A(PG8_SA(0, 1), cA, 1, 0);
        if (wr == 1) PG8_BAR;
        PG8_WAIT_V(4); PG8_BAR;
        PG8_STAGE(PG8_SB(1, 0), cB + kstep, voffB); PG8_STAGE_A(PG8_SA(1, 0), cA + kstep, 0, 0); PG8_STAGE(PG8_SB(1, 1), cB + hstepB + kstep, voffB);
        PG8_WAIT_V(6); PG8_BAR;
    }
    for (;;) {
        const bool has_next = S.next(ui + 1, nxt);
        const char* nA = has_next ? S.a_base(g, nxt) : cA; const char* nB = has_next ? S.b_base(g, nxt) : cB;
        if constexpr (Sched::GATHER) { if (has_next && wid < 4)
            __builtin_amdgcn_global_load_lds((const unsigned*)(S.rows(nxt) + wid * 64 + lane), (PG8_LAS unsigned*)(S.gslot + ((ui + 1) & 1) * 256 + wid * 64), 4, 0, 0); }
#pragma nounroll
        for (int t = 0; t < nt; t += 2) {
            const bool last = (t == nt - 2);
            const char* a1 = cA + (size_t)(t + 1) * kstep;
            const char* a2 = last ? nA : cA + (size_t)(t + 2) * kstep; const char* b2 = last ? nB : cB + (size_t)(t + 2) * kstep;
            const char* a3 = a2 + kstep; const char* b3 = b2 + kstep;
            if (last && has_next) S.a_ready(nxt);
            if constexpr (SP2) {
            PG8_LDB(B0, 0, 0); PG8_LDB(B1, 0, 1); PG8_SCHED; PG8_LDA(At, 0, 0); PG8_STAGE_A(PG8_SA(1, 1), a1, 1, 0);
            if constexpr (Sched::GATHER) { if (last && has_next) {
                const PG8_LAS unsigned* sl = S.gslot + ((ui + 1) & 1) * 256; const int nv = S.nvalid(nxt);
#pragma unroll
                for (int h = 0; h < 2; ++h)
#pragma unroll
                    for (int i = 0; i < 2; ++i) { int R, C; stage_rc(tid * 16 + i * 8192, R, C); const int r = h * HALF + R; const unsigned v = sl[r]; const unsigned tok = r < nv ? v : 0u; gC[h][i] = tok * (unsigned)(g.lda * 2) + (unsigned)C * 2u; } } }
            PG8_WAIT_VP(); PG8_WAIT_L(0); PG8_BAR; PG8_MMA(0, 0, At, B0); PG8_MMA(0, 1, At, B1); PG8_BAR; PG8_SCHED;
            PG8_LDA(At, 0, 1); PG8_STAGE(PG8_SB(0, 0), b2, voffB); PG8_STAGE(PG8_SB(0, 1), b2 + hstepB, voffB); PG8_STAGE_A(PG8_SA(0, 0), a2, 0, 1); PG8_PREFETCH(t + PF_D);
            PG8_WAIT_VP(); PG8_WAIT_L(0); PG8_BAR; PG8_MMA(1, 0, At, B0); PG8_MMA(1, 1, At, B1); PG8_BAR; PG8_SCHED;
            PG8_LDB(B0, 1, 0); PG8_LDB(B1, 1, 1); PG8_SCHED; PG8_LDA(At, 1, 0); PG8_STAGE_A(PG8_SA(0, 1), a2, 1, 1);
            PG8_WAIT_VP(); PG8_WAIT_L(0); PG8_BAR; PG8_MMA(0, 0, At, B0); PG8_MMA(0, 1, At, B1); PG8_BAR; PG8_SCHED;
            PG8_LDA(At, 1, 1); PG8_STAGE(PG8_SB(1, 0), b3, voffB); PG8_STAGE(PG8_SB(1, 1), b3 + hstepB, voffB); PG8_STAGE_A(PG8_SA(1, 0), a3, 0, 1); PG8_PREFETCH(t + 1 + PF_D);
            PG8_WAIT_VP(); PG8_WAIT_L(0); PG8_BAR; PG8_MMA(1, 0, At, B0); PG8_MMA(1, 1, At, B1); PG8_BAR; PG8_SCHED;
            } else {
            PG8_LDB(B0, 0, 0); PG8_SCHED; PG8_LDA(At, 0, 0); PG8_STAGE_A(PG8_SA(1, 1), a1, 1, 0);
            PG8_WAIT_L(8); PG8_BAR; PG8_WAIT_L(0); PG8_MMA(0, 0, At, B0); PG8_BAR; PG8_SCHED;
            PG8_LDB(B1, 0, 1); PG8_STAGE(PG8_SB(0, 0), b2, voffB);
            PG8_BAR; PG8_WAIT_L(0); PG8_MMA(0, 1, At, B1); PG8_BAR;
            PG8_LDA(At, 0, 1); PG8_STAGE_A(PG8_SA(0, 0), a2, 0, 1);
            PG8_BAR; PG8_WAIT_L(0); PG8_MMA(1, 0, At, B0); PG8_BAR; PG8_SCHED;
            PG8_STAGE(PG8_SB(0, 1), b2 + hstepB, voffB);
            PG8_WAIT_V(6); PG8_BAR; PG8_MMA(1, 1, At, B1); PG8_BAR;
            PG8_LDB(B0, 1, 0); PG8_SCHED; PG8_LDA(At, 1, 0); PG8_STAGE_A(PG8_SA(0, 1), a2, 1, 1);
            PG8_WAIT_L(8); PG8_BAR; PG8_WAIT_L(0); PG8_MMA(0, 0, At, B0); PG8_BAR; PG8_SCHED;
            PG8_LDB(B1, 1, 1); PG8_STAGE(PG8_SB(1, 0), b3, voffB);
            PG8_BAR; PG8_WAIT_L(0); PG8_MMA(0, 1, At, B1); PG8_BAR;
            PG8_LDA(At, 1, 1); PG8_STAGE_A(PG8_SA(1, 0), a3, 0, 1);
            PG8_BAR; PG8_WAIT_L(0); PG8_MMA(1, 0, At, B0); PG8_BAR; PG8_SCHED;
            PG8_STAGE(PG8_SB(1, 1), b3 + hstepB, voffB);
            PG8_WAIT_V(6); PG8_BAR; PG8_MMA(1, 1, At, B1); PG8_BAR;
            }
        }
        if constexpr (ALIGN_EPI) { if (wr == 0) PG8_BAR; }
        if constexpr (FP8) asm volatile("s_nop 15\n\ts_nop 15" ::: "memory");
        if constexpr (!Epi::AFTER_DRAIN) { E(acc, cur, wr, wc, fr, fq); S.done(cur); }
        if (!has_next) break;
#pragma unroll
        for (int a = 0; a < 2; ++a)
#pragma unroll
            for (int b = 0; b < 2; ++b)
#pragma unroll
                for (int m = 0; m < 4; ++m)
#pragma unroll
                    for (int n = 0; n < 2; ++n) acc[a][b][m][n] = (f32x4){0.f, 0.f, 0.f, 0.f};
        cur = nxt; cA = nA; cB = nB; ++ui;
        if constexpr (ALIGN_EPI) { if (wr == 1) PG8_BAR; }
    }
    PG8_WAIT_V(0);
    if constexpr (!ALIGN_EPI) { if (wr == 0) PG8_BAR; }
    PG8_BAR;
    if constexpr (Epi::AFTER_DRAIN) { E.fused(acc, cur, wr, wc, fr, fq, lds, wid, lane); S.done(cur); }
#undef PG8_SA
#undef PG8_SB
#undef PG8_STAGE
#undef PG8_STAGE_A
#undef PG8_LDA
#undef PG8_LDB
#undef PG8_MMA
#undef PG8_WAIT_V
#undef PG8_WAIT_VP
#undef PG8_PREFETCH
#undef PG8_WAIT_L
#undef PG8_BAR
#undef PG8_SCHED
}
}
constexpr int NTOK = 32768, DM = 1024, SEQ = 2048, NBATCH = 16, MEMLEN = 256, NMEM = NBATCH * MEMLEN, INW = 3088, NEXP = 32, TOPK = 4;
constexpr int PW = 3072;
constexpr int MAXTILES = 544;
constexpr float EPS = 1e-6f;
constexpr int NWAVES = 8;
constexpr size_t MiB = 1u << 20;
constexpr size_t WS_CTL = 0, CTL_ZERO_BYTES = 64 * 1024;
constexpr size_t WS_WINT = 2 * MiB, WS_WOUT = 10 * MiB, WS_WCQ = 12 * MiB, WS_WCK = 14 * MiB, WS_WCV = 16 * MiB, WS_WCO = 18 * MiB;
constexpr size_t WS_WR = 20 * MiB, WS_CS = 21 * MiB, WS_SSP1 = 24 * MiB, WS_GATE = 27 * MiB, WS_ASSIGN = 28 * MiB, WS_LIST = 29 * MiB;
constexpr size_t WS_RSL = 842 * MiB;
constexpr size_t WS_X2B = 378 * MiB;
constexpr size_t WS_WUP = 34 * MiB, WS_WDN = 162 * MiB, WS_KX = 226 * MiB, WS_VXT = 234 * MiB;
constexpr size_t WS_HN = 242 * MiB, WS_CAT = 242 * MiB, WS_MN = 306 * MiB, WS_P = 314 * MiB, WS_LA = 506 * MiB, WS_VT = 538 * MiB;
constexpr size_t WS_X1B = 314 * MiB, WS_GT = 378 * MiB, WS_HT = 410 * MiB, WS_PX = 506 * MiB;
constexpr size_t WS_GVT = 602 * MiB;
constexpr size_t WS_ACT = 570 * MiB, WS_Y = 706 * MiB, WS_END = 846 * MiB;
constexpr int CW_Q2 = 128;
constexpr int CW_CNT = 1024;
constexpr int CW_PROBE = 192;
constexpr int CW_BAR = 4096;
constexpr int RING_OFF = 0, RING_BYTES = 131072;
constexpr int LDSCTL_OFF = RING_BYTES, MISC_OFF = LDSCTL_OFF + 320;
constexpr int TAB_OFF = LDSCTL_OFF + 512;
constexpr int TAB_TSTART = TAB_OFF + 576, TAB_CNT = TAB_TSTART + 144;
constexpr int XCH2_OFF = LDSCTL_OFF + 6144;
constexpr int XCH_OFF = LDSCTL_OFF + 2048;
constexpr int TS_OFF = TAB_CNT + 128;
constexpr int LDS_BYTES = 147456;

#define GAS __attribute__((address_space(1)))
#define LAS __attribute__((address_space(3)))
typedef unsigned short bf16;
typedef unsigned v4u __attribute__((ext_vector_type(4)));
typedef float f32x4 __attribute__((ext_vector_type(4)));
typedef short bf16x8 __attribute__((ext_vector_type(8)));
typedef GAS unsigned gu32;
typedef GAS unsigned long long gu64;
#define RLX_AGENT __ATOMIC_RELAXED, __HIP_MEMORY_SCOPE_AGENT
#define LDS_WAIT() asm volatile("s_waitcnt lgkmcnt(0)" ::: "memory")
#define VM_WAIT() asm volatile("s_waitcnt vmcnt(0)" ::: "memory")
__device__ __forceinline__ unsigned long long rt() { return __builtin_amdgcn_s_memrealtime(); }
__device__ __forceinline__ unsigned f2bf(float f) { unsigned u = __builtin_bit_cast(unsigned, f); return (u + 0x7fffu + ((u >> 16) & 1u)) >> 16; }
__device__ __forceinline__ unsigned pk2(float lo, float hi) { return f2bf(lo) | (f2bf(hi) << 16); }

#define XB_TMO      128
#define XB_XCNT(j)  (256  + 64 * (j))
#define XB_XSUB(j)  (1280 + 64 * (j))
#define XB_XGEN(j)  (2304 + 64 * (j))
#define XB_TOP      3328
#define XB_TOPGEN   3392
#define XCD_BAR_WORDS 3456
#define XB_SPIN_CAP (1u << 18)

__device__ __forceinline__ unsigned xb_ld(unsigned* p)              { return __hip_atomic_load(p, __ATOMIC_RELAXED, __HIP_MEMORY_SCOPE_AGENT); }
__device__ __forceinline__ unsigned xb_add(unsigned* p, unsigned v) { return __hip_atomic_fetch_add(p, v, __ATOMIC_RELAXED, __HIP_MEMORY_SCOPE_AGENT); }
__device__ __forceinline__ unsigned xb_xcc_id() { return (unsigned)__builtin_amdgcn_s_getreg((3 << 11) | 20) & 0xFu; }
#define XB_SPIN(cond, bar) do { unsigned _sp = 0; while (cond) { __builtin_amdgcn_s_sleep(1); \
    if ((++_sp & 255u) == 0u) { if (xb_ld(&(bar)[XB_TMO])) break; if (_sp > XB_SPIN_CAP) { atomicAdd(&(bar)[XB_TMO], 1u); break; } } } } while (0)

struct XcdBarrier {
    unsigned* bar; unsigned x;
    volatile LAS unsigned* st;
};

__device__ __forceinline__ XcdBarrier xcd_barrier_post(unsigned* bar, volatile LAS unsigned* st) {
    XcdBarrier b; b.bar = bar; b.x = xb_xcc_id(); b.st = st;
    if (threadIdx.x == 0) (void)xb_add(&bar[XB_XCNT(b.x)], 1u);
    return b;
}
__device__ __forceinline__ void xcd_barrier_complete(unsigned* bar, unsigned x, unsigned& nloc, unsigned& nx) {
    const unsigned G = gridDim.x * gridDim.y * gridDim.z;
    unsigned sum, cnt, mine, sp = 0u;
    for (;;) {
        sum = 0u; cnt = 0u; mine = 0u;
#pragma unroll
        for (unsigned j = 0; j < 16; ++j) { const unsigned c = xb_ld(&bar[XB_XCNT(j)]); sum += c; cnt += (c > 0u) ? 1u : 0u; mine = (j == x) ? c : mine; }
        if (sum == G) break;
        __builtin_amdgcn_s_sleep(1);
        if ((++sp & 255u) == 0u) { if (xb_ld(&bar[XB_TMO])) break; if (sp > XB_SPIN_CAP) { atomicAdd(&bar[XB_TMO], 1u); break; } }
    }
    nloc = mine > 0u ? mine : 1u; nx = cnt > 0u ? cnt : 1u;
}

__device__ __forceinline__ void xcd_barrier(const XcdBarrier& b) {
    asm volatile("s_waitcnt vmcnt(0)" ::: "memory");
    __syncthreads();
    if (threadIdx.x == 0) {
        unsigned* bar = b.bar;
        __builtin_amdgcn_s_waitcnt(0);
        unsigned nloc = b.st[0], nx = b.st[1];
        if (nloc == 0u) { xcd_barrier_complete(bar, b.x, nloc, nx); b.st[0] = nloc; b.st[1] = nx; }
        const unsigned old = xb_add(&bar[XB_XSUB(b.x)], 1u);
        const unsigned gen = old / nloc;
        if (old + 1u == (gen + 1u) * nloc) {
            __builtin_amdgcn_fence(__ATOMIC_RELEASE, "agent");
            asm volatile("s_waitcnt vmcnt(0)" ::: "memory");
            const unsigned og = xb_add(&bar[XB_TOP], 1u);
            const unsigned tg = og / nx;
            if (og + 1u == (tg + 1u) * nx) xb_add(&bar[XB_TOPGEN], 1u);
            else XB_SPIN(xb_ld(&bar[XB_TOPGEN]) == tg, bar);
            __builtin_amdgcn_fence(__ATOMIC_ACQUIRE, "agent");
            xb_add(&bar[XB_XGEN(b.x)], 1u);
            asm volatile("s_waitcnt vmcnt(0)" ::: "memory");
        } else {
            XB_SPIN(xb_ld(&bar[XB_XGEN(b.x)]) == gen, bar);
            __builtin_amdgcn_fence(__ATOMIC_ACQUIRE, "agent");
            asm volatile("s_waitcnt vmcnt(0)" ::: "memory");
        }
    }
    __syncthreads();
}
typedef short bf16x4 __attribute__((ext_vector_type(4)));
typedef unsigned v2u __attribute__((ext_vector_type(2)));
struct Frame {
    LAS unsigned char* lds;
    volatile LAS unsigned* MISC;
    gu32* ctl;
    int tid, lane, wave;
    int vcu, G;
    unsigned char* ws;
    float* out;
};
__device__ __forceinline__ int lane_here() { int t = (int)threadIdx.x; asm volatile("" : "+v"(t)); return t & 63; }
__device__ __forceinline__ float bf2f(bf16 b) { return __builtin_bit_cast(float, (unsigned)b << 16); }
__device__ __forceinline__ float wave_sum(float v) {
#pragma unroll
    for (int o = 1; o < 64; o <<= 1) v += __shfl_xor(v, o);
    return v;
}
__device__ __forceinline__ float xmax16(float m) { auto rr = __builtin_amdgcn_permlane16_swap(__float_as_uint(m), __float_as_uint(m), false, false); return fmaxf(__uint_as_float(rr[0]), __uint_as_float(rr[1])); }
__device__ __forceinline__ float xmax32(float m) { auto rr = __builtin_amdgcn_permlane32_swap(__float_as_uint(m), __float_as_uint(m), false, false); return fmaxf(__uint_as_float(rr[0]), __uint_as_float(rr[1])); }
__device__ __forceinline__ f32x4 mfma16(bf16x8 a, bf16x8 b, f32x4 c) { return __builtin_amdgcn_mfma_f32_16x16x32_bf16(a, b, c, 0, 0, 0); }

__device__ __forceinline__ void p0_transpose_item(const float* W, int ldw, const float* gain, bf16* WT, int K, int k0, int n0, size_t orow0, int lane) {
    const int n4 = lane & 15, kq = lane >> 4;
    const float* src = W + (size_t)(k0 + 16 * kq) * ldw + n0 + 4 * n4;
    f32x4 v[16];
#pragma unroll
    for (int i = 0; i < 16; ++i) v[i] = *(const f32x4*)(src + (size_t)i * ldw);
    if (gain) { const f32x4* gp = (const f32x4*)(gain + k0 + 16 * kq);
#pragma unroll
        for (int q = 0; q < 4; ++q) { const f32x4 gq = gp[q];
#pragma unroll
            for (int r = 0; r < 4; ++r) v[4 * q + r] = v[4 * q + r] * gq[r]; } }
    bf16* dst = WT + (orow0 + 4 * n4) * (size_t)K + k0 + 16 * kq;
#pragma unroll
    for (int j = 0; j < 4; ++j) { v4u o0, o1;
        o0.x = pg8::cvtpk(v[0][j], v[1][j]); o0.y = pg8::cvtpk(v[2][j], v[3][j]); o0.z = pg8::cvtpk(v[4][j], v[5][j]); o0.w = pg8::cvtpk(v[6][j], v[7][j]);
        o1.x = pg8::cvtpk(v[8][j], v[9][j]); o1.y = pg8::cvtpk(v[10][j], v[11][j]); o1.z = pg8::cvtpk(v[12][j], v[13][j]); o1.w = pg8::cvtpk(v[14][j], v[15][j]);
        *(v4u*)(dst + (size_t)j * K) = o0; *(v4u*)(dst + (size_t)j * K + 8) = o1; }
}
__device__ __forceinline__ void p0_transpose_item8(const float* W, int ldw, const float* gain, unsigned char* WT, int K, int k0, int n0, size_t orow0, int lane) {
    const int n4 = lane & 15, kq = lane >> 4;
    const float* src = W + (size_t)(k0 + 16 * kq) * ldw + n0 + 4 * n4;
    f32x4 v[16];
#pragma unroll
    for (int i = 0; i < 16; ++i) v[i] = *(const f32x4*)(src + (size_t)i * ldw);
    { const f32x4* gp = (const f32x4*)(gain + k0 + 16 * kq);
#pragma unroll
        for (int q = 0; q < 4; ++q) { f32x4 gq = {32.f, 32.f, 32.f, 32.f}; if (gain) gq = gp[q] * 32.0f;
#pragma unroll
            for (int r = 0; r < 4; ++r) v[4 * q + r] = v[4 * q + r] * gq[r]; } }
    unsigned char* dst = WT + (orow0 + 4 * n4) * (size_t)K + k0 + 16 * kq;
#pragma unroll
    for (int j = 0; j < 4; ++j) { v4u o;
        o.x = pg8::cvt4_fp8((f32x4){v[0][j], v[1][j], v[2][j], v[3][j]}); o.y = pg8::cvt4_fp8((f32x4){v[4][j], v[5][j], v[6][j], v[7][j]});
        o.z = pg8::cvt4_fp8((f32x4){v[8][j], v[9][j], v[10][j], v[11][j]}); o.w = pg8::cvt4_fp8((f32x4){v[12][j], v[13][j], v[14][j], v[15][j]});
        *(v4u*)(dst + (size_t)j * K) = o; }
}
template <int NR> __device__ __forceinline__ void rms_rows_to_bf16(const float* const (&xrow)[NR], const float* g, bf16* const (&orow)[NR], int lane) {
    f32x4 v[NR][4]; float s[NR];
#pragma unroll
    for (int r = 0; r < NR; ++r) { const f32x4* xr = (const f32x4*)xrow[r] + lane;
#pragma unroll
        for (int j = 0; j < 4; ++j) v[r][j] = xr[64 * j]; }
    const f32x4* gr = (const f32x4*)g + lane; f32x4 gg[4];
#pragma unroll
    for (int j = 0; j < 4; ++j) gg[j] = gr[64 * j];
#pragma unroll
    for (int r = 0; r < NR; ++r) { s[r] = 0.f;
#pragma unroll
        for (int j = 0; j < 4; ++j) s[r] += (v[r][j].x * v[r][j].x + v[r][j].y * v[r][j].y) + (v[r][j].z * v[r][j].z + v[r][j].w * v[r][j].w); }
#pragma unroll
    for (int r = 0; r < NR; ++r) { const float rs = rsqrtf(wave_sum(s[r]) * (1.0f / DM) + EPS); unsigned long long* o8 = (unsigned long long*)orow[r] + lane;
#pragma unroll
        for (int j = 0; j < 4; ++j) o8[64 * j] = (unsigned long long)pk2(v[r][j].x * rs * gg[j].x, v[r][j].y * rs * gg[j].y) | ((unsigned long long)pk2(v[r][j].z * rs * gg[j].z, v[r][j].w * rs * gg[j].w) << 32); }
}
constexpr int MOE_I_UP = 32 * 16 * 32, MOE_I_DN = 32 * 16 * 16, MOE_UNITS = (MOE_I_UP + MOE_I_DN) / 64;
__device__ __forceinline__ void moe_convert_unit(int unit, const float* w_up, const float* w_down, const float* g_ffn, unsigned char* ws, int wave, int lane) {
#pragma unroll 1
    for (int j = 0; j < 8; ++j) { int r = unit * 64 + j * 8 + wave;
        if (r < MOE_I_UP) { const int e = r / (16 * 32); r -= e * (16 * 32); const int n0 = 64 * (r % 32);
            const size_t orow = (size_t)e * 2048 + ((n0 & 1023) >> 7) * 256 + (n0 >> 10) * 128 + (n0 & 127);
            p0_transpose_item8(w_up + (size_t)e * DM * 2048, 2048, g_ffn, ws + WS_WUP, DM, 64 * (r / 32), n0, orow, lane); }
        else { r -= MOE_I_UP; const int e = r / (16 * 16); r -= e * (16 * 16);
            p0_transpose_item8(w_down + (size_t)e * DM * DM, DM, nullptr, ws + WS_WDN, DM, 64 * (r / 16), 64 * (r % 16), (size_t)e * 1024 + 64 * (r % 16), lane); } }
}
struct In {
    const float *x, *mem; const int* positions; const float *norm_mix_g, *w_in, *lq1, *lk1, *lq2, *lk2, *diff_norm_g, *w_alpha2, *b_alpha, *gla_norm_g, *w_out, *norm_cross_g, *norm_mem_g,
        *w_cq, *w_ck, *w_cv, *w_co, *norm_ffn_g, *w_router, *b_router, *w_up, *b_up, *w_down, *b_down, *norm_final_g;
};
__device__ __forceinline__ void p0_prologue(Frame& F, const In& I) {
    const int gw = F.vcu * NWAVES + F.wave, NGW = F.G * NWAVES, lane = lane_here();
    unsigned char* ws = F.ws;
    constexpr int I_IN = 16 * 48, I_SQ = 16 * 16;
    constexpr int NITEMS = I_IN + 4 * I_SQ;
    for (int it = gw; it < NITEMS; it += NGW) {
        int r = it;
        if (r < I_IN) { p0_transpose_item(I.w_in, INW, nullptr, (bf16*)(ws + WS_WINT), DM, 64 * (r / 48), 64 * (r % 48), (size_t)64 * (r % 48), lane); continue; } r -= I_IN;
        { const int w = r / I_SQ; r -= w * I_SQ;
            const float* W = w == 0 ? I.w_out : w == 1 ? I.w_ck : w == 2 ? I.w_cv : I.w_co;
            bf16* WT = (bf16*)(ws + (w == 0 ? WS_WOUT : w == 1 ? WS_WCK : w == 2 ? WS_WCV : WS_WCO));
            p0_transpose_item(W, DM, nullptr, WT, DM, 64 * (r / 16), 64 * (r % 16), (size_t)64 * (r % 16), lane); }
    }
    for (int idx = F.vcu * (NWAVES * 64) + F.tid; idx < DM * DM / 4; idx += F.G * NWAVES * 64) { const f32x4 v = ((const f32x4*)I.w_cq)[idx] * I.norm_cross_g[idx >> 8];
        v2u o; o.x = pk2(v.x, v.y); o.y = pk2(v.z, v.w); ((v2u*)(ws + WS_WCQ))[idx] = o; }
#if defined(PROBE_P0)
    if (F.tid == 0) ((LAS unsigned long long*)(F.lds + TS_OFF))[13] = rt();
#endif
    const int gt = F.vcu * (NWAVES * 64) + F.tid, NGT = F.G * NWAVES * 64;
    for (int idx = gt; idx < 256 * DM; idx += NGT) { const int j = idx >> 10, k = idx & 1023; const float* wr = I.w_in + (size_t)k * INW + 3072; float s = 0.f;
#pragma unroll
        for (int r = 0; r < 16; ++r) s += wr[r] * I.w_alpha2[r * 256 + j];
        ((bf16*)(ws + WS_WINT))[(size_t)(3072 + j) * DM + k] = (bf16)f2bf(s); }
    for (int idx = gt; idx < DM * NEXP; idx += NGT) ((float*)(ws + WS_WR))[idx] = I.w_router[idx] * I.norm_ffn_g[idx >> 5];
    for (int idx = gt; idx < NTOK * 8; idx += NGT) { const int tok = idx >> 3, i = idx & 7;
        const double inv = exp(-(double)i * 0.125 * 13.122363377404328); const double ang = (double)I.positions[tok] * inv;
        const double red = ang - rint(ang * 0.15915494309189535) * 6.283185307179586; const float rf = (float)red;
        float* cs = (float*)(ws + WS_CS) + (size_t)tok * 16; cs[i] = cosf(rf); cs[8 + i] = sinf(rf); }
#if defined(PROBE_P0)
    if (F.tid == 0) ((LAS unsigned long long*)(F.lds + TS_OFF))[14] = rt();
#endif
    for (int m = gw * 4; m < NTOK; m += NGW * 4) { const float* xr[4]; bf16* orw[4];
#pragma unroll
        for (int r = 0; r < 4; ++r) { xr[r] = I.x + (size_t)(m + r) * DM; orw[r] = (bf16*)(ws + WS_HN) + (size_t)(m + r) * DM; }
        rms_rows_to_bf16<4>(xr, I.norm_mix_g, orw, lane); }
    for (int m = gw * 4; m < NMEM; m += NGW * 4) { const float* xr[4]; bf16* orw[4];
#pragma unroll
        for (int r = 0; r < 4; ++r) { xr[r] = I.mem + (size_t)(m + r) * DM; orw[r] = (bf16*)(ws + WS_MN) + (size_t)(m + r) * DM; }
        rms_rows_to_bf16<4>(xr, I.norm_mem_g, orw, lane); }
}

constexpr int DA_KBUF = 16384, DA_VBUF = 16384, DA_VOFF = 2 * DA_KBUF;
__device__ __forceinline__ void diffattn_unit(Frame& F, const bf16* P, const bf16* VT, bf16* CAT, const float* gdiff, float lam, int b, int h, int qblk) {
    const int lane = lane_here(), wave = F.wave, tid = F.tid, l15 = lane & 15, g = lane >> 4;
    LAS unsigned char* lds = F.lds + RING_OFF;
    const int q0 = qblk * 128 + wave * 16;
    const size_t tokq = (size_t)b * SEQ + q0 + l15;
    bf16x8 qf[2][2];
#pragma unroll
    for (int c = 0; c < 2; ++c)
#pragma unroll
        for (int ks = 0; ks < 2; ++ks) qf[c][ks] = *(const bf16x8*)(P + tokq * PW + h * 128 + c * 64 + ks * 32 + g * 8);
    f32x4 o[2][8];
#pragma unroll
    for (int c = 0; c < 2; ++c)
#pragma unroll
        for (int k = 0; k < 8; ++k) o[c][k] = (f32x4){0.f, 0.f, 0.f, 0.f};
    float mrun[2] = {0.f, 0.f}, lsum[2] = {0.f, 0.f};
    const int nk = q0 + 16;
    const int nt = 2 * qblk + 2;
    const int skey = tid >> 4, sch = tid & 15, vrow = tid >> 3, vpc = tid & 7;
    const bf16* ksrc = P + ((size_t)b * SEQ + skey) * PW + 512 + h * 128 + sch * 8;
    const bf16* vsrc = VT + (size_t)(h * 128 + vrow) * NTOK + (size_t)b * SEQ + vpc * 8;
    const int kdst = skey * 256 + ((sch ^ (skey & 15)) * 16);
    const int vfr = (vrow >> 1) & 7, vch = (vpc >> 2) * 4 + 2 * (vpc & 1), vhi = ((vpc & 3) >> 1) * 8;
    const int vdst0 = DA_VOFF + vrow * 128 + ((vch ^ vfr) * 16) + vhi, vdst1 = DA_VOFF + vrow * 128 + (((vch + 1) ^ vfr) * 16) + vhi;
    int koff[2][2];
#pragma unroll
    for (int c = 0; c < 2; ++c)
#pragma unroll
        for (int ks = 0; ks < 2; ++ks) koff[c][ks] = l15 * 256 + (((c * 8 + ks * 4 + g) ^ l15) * 16);
    const int voffs[2] = {DA_VOFF + l15 * 128 + ((g ^ (l15 >> 1)) * 16), DA_VOFF + l15 * 128 + (((4 + g) ^ (l15 >> 1)) * 16)};
    v4u sk0, sk1, sv0, sv1;
#define DA_LOAD(tt) do { const bf16* kp_ = ksrc + (size_t)(tt) * 64 * PW; const bf16* vp_ = vsrc + (tt) * 64; \
        sk0 = *(const v4u*)kp_; sk1 = *(const v4u*)(kp_ + (size_t)32 * PW); sv0 = *(const v4u*)vp_; sv1 = *(const v4u*)(vp_ + (size_t)64 * NTOK); } while (0)
#define DA_STORE(bb) do { LAS unsigned char* kd_ = lds + (bb) * DA_KBUF + kdst; LAS unsigned char* vd_ = lds + (bb) * DA_VBUF; \
        *(LAS v4u*)kd_ = sk0; *(LAS v4u*)(kd_ + 8192) = sk1; \
        *(LAS v2u*)(vd_ + vdst0) = (v2u){sv0.x, sv0.y}; *(LAS v2u*)(vd_ + vdst1) = (v2u){sv0.z, sv0.w}; *(LAS v2u*)(vd_ + vdst0 + 8192) = (v2u){sv1.x, sv1.y}; *(LAS v2u*)(vd_ + vdst1 + 8192) = (v2u){sv1.z, sv1.w}; } while (0)
    DA_LOAD(0); DA_STORE(0);
    __syncthreads();
    auto step = [&](const int t, const int buf) __attribute__((always_inline)) {
        if (t * 64 < nk) {
            const LAS unsigned char* kb = lds + buf * DA_KBUF; const LAS unsigned char* vb = lds + buf * DA_VBUF;
            f32x4 s[2][2][2];
#pragma unroll
            for (int sub = 0; sub < 2; ++sub)
#pragma unroll
                for (int c = 0; c < 2; ++c)
#pragma unroll
                    for (int s2 = 0; s2 < 2; ++s2) { f32x4 a = (f32x4){-mrun[c], -mrun[c], -mrun[c], -mrun[c]};
#pragma unroll
                        for (int ks = 0; ks < 2; ++ks) { const bf16x8 kf = *(const LAS bf16x8*)(kb + sub * 8192 + s2 * 4096 + koff[c][ks]); a = mfma16(kf, qf[c][ks], a); }
                        s[sub][c][s2] = a; }
            if (t * 64 + 63 > q0) {
                const int qrow = q0 + l15;
#pragma unroll
                for (int sub = 0; sub < 2; ++sub)
#pragma unroll
                    for (int c = 0; c < 2; ++c)
#pragma unroll
                        for (int s2 = 0; s2 < 2; ++s2)
#pragma unroll
                            for (int r = 0; r < 4; ++r) if (t * 64 + sub * 32 + s2 * 16 + 4 * g + r > qrow) s[sub][c][s2][r] = -INFINITY;
            }
            float dl[2]; bool grow = false;
#pragma unroll
            for (int c = 0; c < 2; ++c) { float mx = -INFINITY;
#pragma unroll
                for (int sub = 0; sub < 2; ++sub)
#pragma unroll
                    for (int s2 = 0; s2 < 2; ++s2) mx = fmaxf(mx, fmaxf(fmaxf(s[sub][c][s2][0], s[sub][c][s2][1]), fmaxf(s[sub][c][s2][2], s[sub][c][s2][3])));
                mx = xmax16(mx); mx = xmax32(mx);
                dl[c] = (t == 0 || mx > 8.0f) ? mx : 0.f; grow = grow || (dl[c] != 0.f); }
            if (__any(grow)) {
#pragma unroll
                for (int c = 0; c < 2; ++c) { const float alpha = __builtin_amdgcn_exp2f(-dl[c]); mrun[c] += dl[c]; lsum[c] *= alpha;
#pragma unroll
                    for (int k = 0; k < 8; ++k) o[c][k] = o[c][k] * alpha;
#pragma unroll
                    for (int sub = 0; sub < 2; ++sub)
#pragma unroll
                        for (int s2 = 0; s2 < 2; ++s2)
#pragma unroll
                            for (int r = 0; r < 4; ++r) s[sub][c][s2][r] -= dl[c]; }
            }
#pragma unroll
            for (int sub = 0; sub < 2; ++sub) {
                bf16x8 pb[2];
#pragma unroll
                for (int c = 0; c < 2; ++c) { float ps = 0.f;
#pragma unroll
                    for (int s2 = 0; s2 < 2; ++s2)
#pragma unroll
                        for (int r = 0; r < 4; ++r) { const float p = __builtin_amdgcn_exp2f(s[sub][c][s2][r]); s[sub][c][s2][r] = p; ps += p; }
                    lsum[c] += ps;
                    v4u w; w.x = pg8::cvtpk(s[sub][c][0][0], s[sub][c][0][1]); w.y = pg8::cvtpk(s[sub][c][0][2], s[sub][c][0][3]); w.z = pg8::cvtpk(s[sub][c][1][0], s[sub][c][1][1]); w.w = pg8::cvtpk(s[sub][c][1][2], s[sub][c][1][3]);
                    pb[c] = __builtin_bit_cast(bf16x8, w); }
#pragma unroll
                for (int k = 0; k < 8; ++k) { const bf16x8 vf = *(const LAS bf16x8*)(vb + voffs[sub] + k * 2048);
                    o[0][k] = mfma16(vf, pb[0], o[0][k]); o[1][k] = mfma16(vf, pb[1], o[1][k]); }
            }
        }
    };
    for (int t = 0; t < nt; ++t) {
        if (t + 1 < nt) DA_LOAD(t + 1);
        step(t, t & 1);
        if (t + 1 < nt) DA_STORE((t & 1) ^ 1);
        __syncthreads();
    }
#undef DA_LOAD
#undef DA_STORE
    float l0 = lsum[0], l1 = lsum[1];
    l0 += __shfl_xor(l0, 16); l0 += __shfl_xor(l0, 32); l1 += __shfl_xor(l1, 16); l1 += __shfl_xor(l1, 32);
    const float i0 = 1.0f / l0, i1 = lam / l1; float ss = 0.f;
#pragma unroll
    for (int k = 0; k < 8; ++k)
#pragma unroll
        for (int r = 0; r < 4; ++r) { const float v = o[0][k][r] * i0 - o[1][k][r] * i1; o[0][k][r] = v; ss += v * v; }
    ss += __shfl_xor(ss, 16); ss += __shfl_xor(ss, 32);
    const float rs = rsqrtf(ss * (1.0f / 128.0f) + EPS) * 0.8f;
    bf16* op = CAT + tokq * DM + h * 128 + 4 * g;
#pragma unroll
    for (int k = 0; k < 8; ++k) { const f32x4 gg = *(const f32x4*)(gdiff + k * 16 + 4 * g); f32x4 v = o[0][k] * rs; v = v * gg; pg8::st_bf4(op + k * 16, v); }
}

__device__ __forceinline__ bf16x8 pack8(const f32x4& a, const f32x4& b) { v4u w; w.x = pg8::cvtpk(a[0], a[1]); w.y = pg8::cvtpk(a[2], a[3]); w.z = pg8::cvtpk(b[0], b[1]); w.w = pg8::cvtpk(b[2], b[3]); return __builtin_bit_cast(bf16x8, w); }
constexpr int GL_QI = 0, GL_KI = 8192, GL_IMG = 16384, GL_EL = 2 * GL_IMG, GL_OB = GL_EL + 512, GL_OBS = 17408, GL_PS = GL_OB + 2 * GL_OBS, GL_END = GL_PS + 4096;

__device__ __forceinline__ void gla_unit(Frame& F, const bf16* P, const float* Bc, const bf16* GVT, bf16* CAT, const float* ggla, int b, int h) {
    const int lane = lane_here(), l15 = lane & 15, g = lane >> 4, eb = F.wave, tid = F.tid;
    LAS unsigned char* lds = F.lds + RING_OFF;
    const f32x4 zero4 = {0.f, 0.f, 0.f, 0.f};
    f32x4 S[4] = {zero4, zero4, zero4, zero4};
    bf16x8 If[4];
#pragma unroll
    for (int db = 0; db < 4; ++db) { const int ks = db >> 1;
#pragma unroll
        for (int j = 0; j < 8; ++j) { const int dp = 32 * ks + (j < 4 ? 4 * g + j : 16 + 4 * g + j - 4); If[db][j] = (dp == 16 * db + l15) ? (short)0x3F80 : (short)0; } }
    const int st = tid >> 3, sp = tid & 7, opc = tid & 15;
    const size_t tokb = (size_t)b * SEQ;
    const bf16* qsrc = P + (tokb + st) * PW + 1536 + h * 64 + sp * 8;
    const float* bsrc = Bc + (tokb + st) * 256 + h * 64 + sp * 8;
    const bf16* Vrow = GVT + (size_t)(h * 128 + 16 * eb + l15) * NTOK + tokb + 4 * g;
    const f32x4 gg0 = *(const f32x4*)(ggla + opc * 8), gg1 = *(const f32x4*)(ggla + opc * 8 + 4);
    const int foffs[2] = {l15 * 128 + ((g ^ (l15 >> 1)) * 16), l15 * 128 + (((4 + g) ^ (l15 >> 1)) * 16)};
    const int sfr = (st >> 1) & 7, sch0 = (sp >> 2) * 4 + 2 * (sp & 1), shi = ((sp & 3) >> 1) * 8, sd0 = st * 128 + ((sch0 ^ sfr) * 16) + shi, sd1 = st * 128 + (((sch0 + 1) ^ sfr) * 16) + shi;
    v4u rq = *(const v4u*)qsrc, rk = *(const v4u*)(qsrc + 256); f32x4 rb0 = *(const f32x4*)bsrc, rb1 = *(const f32x4*)(bsrc + 4);
#define GLA_STAGE(par) do { \
        float ee[8]; _Pragma("unroll") for (int i = 0; i < 4; ++i) { ee[i] = __expf(rb0[i]); ee[4 + i] = __expf(rb1[i]); } \
        const unsigned qa[4] = {rq.x, rq.y, rq.z, rq.w}, ka[4] = {rk.x, rk.y, rk.z, rk.w}; v4u wq, wk; unsigned* wqp = (unsigned*)&wq; unsigned* wkp = (unsigned*)&wk; \
        _Pragma("unroll") for (int i = 0; i < 4; ++i) { const float q0 = __builtin_bit_cast(float, qa[i] << 16), q1 = __builtin_bit_cast(float, qa[i] & 0xffff0000u), k0 = __builtin_bit_cast(float, ka[i] << 16), k1 = __builtin_bit_cast(float, ka[i] & 0xffff0000u); \
            wqp[i] = pg8::cvtpk(q0 * ee[2 * i], q1 * ee[2 * i + 1]); wkp[i] = pg8::cvtpk(k0 * __builtin_amdgcn_rcpf(ee[2 * i]), k1 * __builtin_amdgcn_rcpf(ee[2 * i + 1])); } \
        { LAS unsigned char* ib_ = lds + (par) * GL_IMG; *(LAS v2u*)(ib_ + GL_QI + sd0) = (v2u){wq.x, wq.y}; *(LAS v2u*)(ib_ + GL_QI + sd1) = (v2u){wq.z, wq.w}; *(LAS v2u*)(ib_ + GL_KI + sd0) = (v2u){wk.x, wk.y}; *(LAS v2u*)(ib_ + GL_KI + sd1) = (v2u){wk.z, wk.w}; } \
        if (st == 63) { *(LAS f32x4*)(lds + GL_EL + (par) * 256 + sp * 32) = (f32x4){ee[0], ee[1], ee[2], ee[3]}; *(LAS f32x4*)(lds + GL_EL + (par) * 256 + sp * 32 + 16) = (f32x4){ee[4], ee[5], ee[6], ee[7]}; } } while (0)
    bf16x8 VFn[2];
#pragma unroll
    for (int ss = 0; ss < 2; ++ss) { const bf16* vp = Vrow + 32 * ss; const v2u v0 = *(const v2u*)vp, v1 = *(const v2u*)(vp + 16); v4u vv; vv.x = v0.x; vv.y = v0.y; vv.z = v1.x; vv.w = v1.y; VFn[ss] = __builtin_bit_cast(bf16x8, vv); }
    GLA_STAGE(0);
    __syncthreads();
    for (int c = 0; c < SEQ / 64; ++c) {
        const int par = c & 1; const size_t tok0 = tokb + c * 64;
        if (c + 1 < SEQ / 64) { rq = *(const v4u*)(qsrc + (size_t)(c + 1) * 64 * PW); rk = *(const v4u*)(qsrc + (size_t)(c + 1) * 64 * PW + 256);
            rb0 = *(const f32x4*)(bsrc + (size_t)(c + 1) * 64 * 256); rb1 = *(const f32x4*)(bsrc + (size_t)(c + 1) * 64 * 256 + 4); }
        bf16x8 VF[2] = {VFn[0], VFn[1]};
        if (c + 1 < SEQ / 64) {
#pragma unroll
            for (int ss = 0; ss < 2; ++ss) { const bf16* vp = Vrow + (c + 1) * 64 + 32 * ss; const v2u v0 = *(const v2u*)vp, v1 = *(const v2u*)(vp + 16); v4u vv; vv.x = v0.x; vv.y = v0.y; vv.z = v1.x; vv.w = v1.y; VFn[ss] = __builtin_bit_cast(bf16x8, vv); } }
        v4u rg[2];
#pragma unroll
        for (int i = 0; i < 2; ++i) rg[i] = *(const v4u*)(P + (tok0 + ((tid + 512 * i) >> 4)) * PW + 2560 + h * 128 + opc * 8);
        const LAS unsigned char* qi = lds + par * GL_IMG + GL_QI; const LAS unsigned char* ki = lds + par * GL_IMG + GL_KI;
        bf16x8 qf[4][2], kf[4][2];
#pragma unroll
        for (int blk = 0; blk < 4; ++blk)
#pragma unroll
            for (int ks = 0; ks < 2; ++ks) { qf[blk][ks] = *(const LAS bf16x8*)(qi + foffs[ks] + blk * 2048); kf[blk][ks] = *(const LAS bf16x8*)(ki + foffs[ks] + blk * 2048); }
        const bf16x8 SF0 = pack8(S[0], S[1]), SF1 = pack8(S[2], S[3]);
        f32x4 O[4];
#pragma unroll
        for (int tb = 0; tb < 4; ++tb) { f32x4 o = mfma16(qf[tb][0], SF0, zero4); o = mfma16(qf[tb][1], SF1, o);
#pragma unroll
            for (int ss = 0; ss < 2; ++ss) if (2 * ss <= tb) { f32x4 a2[2];
#pragma unroll
                for (int hh = 0; hh < 2; ++hh) { const int sb = 2 * ss + hh; f32x4 a = zero4;
                    if (sb <= tb) { a = mfma16(kf[sb][0], qf[tb][0], zero4); a = mfma16(kf[sb][1], qf[tb][1], a);
                        if (sb == tb) {
#pragma unroll
                            for (int r = 0; r < 4; ++r) if (4 * g + r > l15) a[r] = 0.f; } }
                    a2[hh] = a; }
                o = mfma16(pack8(a2[0], a2[1]), VF[ss], o); }
            O[tb] = o; }
#pragma unroll
        for (int db = 0; db < 4; ++db) { f32x4 u = S[db];
#pragma unroll
            for (int ss = 0; ss < 2; ++ss) { const f32x4 t0 = mfma16(kf[2 * ss][db >> 1], If[db], zero4), t1 = mfma16(kf[2 * ss + 1][db >> 1], If[db], zero4); u = mfma16(pack8(t0, t1), VF[ss], u); }
            const f32x4 el = *(const LAS f32x4*)(lds + GL_EL + par * 256 + (16 * db + 4 * g) * 4);
            S[db] = u * el; }
        LAS unsigned char* ob = lds + GL_OB + par * GL_OBS; LAS float* ps = (LAS float*)(lds + GL_PS + par * 2048);
#pragma unroll
        for (int tb = 0; tb < 4; ++tb)
#pragma unroll
            for (int r = 0; r < 4; ++r) { const int t = 16 * tb + 4 * g + r; const float ov = O[tb][r]; float q = ov * ov; q += __shfl_xor(q, 1); q += __shfl_xor(q, 2); q += __shfl_xor(q, 4); q += __shfl_xor(q, 8);
                if (l15 == 0) ps[t * 8 + eb] = q;
                *(LAS bf16*)(ob + t * 272 + (16 * eb + l15) * 2) = (bf16)f2bf(ov); }
        if (c + 1 < SEQ / 64) GLA_STAGE(par ^ 1);
        __syncthreads();
#pragma unroll
        for (int i = 0; i < 2; ++i) { const int ot = (tid + 512 * i) >> 4; const f32x4 p0 = *(const LAS f32x4*)(ps + ot * 8), p1 = *(const LAS f32x4*)(ps + ot * 8 + 4);
            const float ss = ((p0[0] + p0[1]) + (p0[2] + p0[3])) + ((p1[0] + p1[1]) + (p1[2] + p1[3])); const float rs = rsqrtf(ss * (1.0f / 128.0f) + EPS);
            const v4u ov = *(const LAS v4u*)(ob + ot * 272 + opc * 16); const unsigned oa[4] = {ov.x, ov.y, ov.z, ov.w}, ga[4] = {rg[i].x, rg[i].y, rg[i].z, rg[i].w};
            const float gn[8] = {gg0[0], gg0[1], gg0[2], gg0[3], gg1[0], gg1[1], gg1[2], gg1[3]}; v4u w; unsigned* wp = (unsigned*)&w;
#pragma unroll
            for (int j = 0; j < 4; ++j) { const float o0 = __builtin_bit_cast(float, oa[j] << 16), o1 = __builtin_bit_cast(float, oa[j] & 0xffff0000u), g0 = __builtin_bit_cast(float, ga[j] << 16), g1 = __builtin_bit_cast(float, ga[j] & 0xffff0000u);
                wp[j] = pg8::cvtpk(o0 * rs * gn[2 * j] * g0 * __builtin_amdgcn_rcpf(1.0f + __builtin_amdgcn_exp2f(-1.4426950408889634f * g0)), o1 * rs * gn[2 * j + 1] * g1 * __builtin_amdgcn_rcpf(1.0f + __builtin_amdgcn_exp2f(-1.4426950408889634f * g1))); }
            *(v4u*)(CAT + (tok0 + ot) * DM + 512 + h * 128 + opc * 8) = w; }
    }
#undef GLA_STAGE
    __syncthreads();
}

__device__ __forceinline__ void router_phase(Frame& F, const bf16* X2, const float* WR, const float* b_router, float* rsl, float* gate, unsigned* assign, unsigned* list, gu32* cnt) {
    LAS float* xs = (LAS float*)(F.lds + RING_OFF);
    LAS float* wsh = xs + 128 * 129;
    LAS float* lg = wsh + 128 * 32;
    LAS unsigned* hist = (LAS unsigned*)(lg + 128 * 33);
    const int tid = F.tid, t = tid & 63, eg = tid >> 6;
    for (int blk = F.vcu; blk < NTOK / 128; blk += F.G) {
        const size_t tok0 = (size_t)blk * 128;
        f32x4 acc0 = (f32x4){0.f, 0.f, 0.f, 0.f}, acc1 = acc0; float ssq0 = 0.f, ssq1 = 0.f;
        v4u rx[4]; f32x4 rw[2];
#define RT_LOAD(kc) do { _Pragma("unroll") for (int i = 0; i < 4; ++i) rx[i] = *(const v4u*)(X2 + (tok0 + (tid >> 4) + 32 * i) * DM + (kc) + (tid & 15) * 8); \
        _Pragma("unroll") for (int i = 0; i < 2; ++i) rw[i] = *(const f32x4*)(WR + (size_t)(kc) * 32 + (i * 512 + tid) * 4); } while (0)
        RT_LOAD(0);
        for (int kc = 0; kc < DM; kc += 128) {
#pragma unroll
            for (int i = 0; i < 4; ++i) { LAS float* dp = xs + ((tid >> 4) + 32 * i) * 129 + (tid & 15) * 8; const unsigned wv[4] = {rx[i].x, rx[i].y, rx[i].z, rx[i].w};
#pragma unroll
                for (int j = 0; j < 4; ++j) { dp[2 * j] = __builtin_bit_cast(float, wv[j] << 16); dp[2 * j + 1] = __builtin_bit_cast(float, wv[j] & 0xffff0000u); } }
#pragma unroll
            for (int i = 0; i < 2; ++i) *(LAS f32x4*)(wsh + (i * 512 + tid) * 4) = rw[i];
            __syncthreads();
            if (kc + 128 < DM) RT_LOAD(kc + 128);
            const LAS float* xr0 = xs + t * 129; const LAS float* xr1 = xs + (t + 64) * 129;
#pragma unroll 8
            for (int k = 0; k < 128; ++k) { const float x0 = xr0[k], x1 = xr1[k]; const f32x4 w = *(const LAS f32x4*)(wsh + k * 32 + eg * 4); acc0 = acc0 + w * x0; acc1 = acc1 + w * x1; ssq0 += x0 * x0; ssq1 += x1 * x1; }
            __syncthreads();
        }
#undef RT_LOAD
        const float rs0 = rsqrtf(ssq0 * (1.0f / DM) + EPS), rs1 = rsqrtf(ssq1 * (1.0f / DM) + EPS);
#pragma unroll
        for (int i = 0; i < 4; ++i) { const float br = b_router[eg * 4 + i]; lg[t * 33 + eg * 4 + i] = acc0[i] * rs0 + br; lg[(t + 64) * 33 + eg * 4 + i] = acc1[i] * rs1 + br; }
        if (eg == 0) { lg[t * 33 + 32] = rs0; lg[(t + 64) * 33 + 32] = rs1; }
        __syncthreads();
        if (tid < 128) {
            const int w2 = tid >> 6;
            float lv[32];
#pragma unroll
            for (int e = 0; e < 32; ++e) lv[e] = lg[tid * 33 + e];
            const float rs = lg[tid * 33 + 32];
            float tv[4]; int te[4];
#pragma unroll
            for (int k = 0; k < 4; ++k) { float best = -INFINITY; int bi = 0;
#pragma unroll
                for (int e = 0; e < 32; ++e) if (lv[e] > best) { best = lv[e]; bi = e; }
                tv[k] = best; te[k] = bi;
#pragma unroll
                for (int e = 0; e < 32; ++e) if (e == bi) lv[e] = -INFINITY; }
            const float e1 = __expf(tv[1] - tv[0]), e2 = __expf(tv[2] - tv[0]), e3 = __expf(tv[3] - tv[0]); const float inv = 1.0f / (1.0f + e1 + e2 + e3);
            const float gv[4] = {inv, e1 * inv, e2 * inv, e3 * inv};
            const size_t tok = tok0 + tid;
            LAS unsigned* hs = hist + w2 * 32; LAS unsigned* gbase = hist + 64 + w2 * 32;
            if (t < 32) hs[t] = 0u;
            __builtin_amdgcn_wave_barrier(); LDS_WAIT();
            unsigned lpos[4];
#pragma unroll
            for (int k = 0; k < 4; ++k) lpos[k] = __hip_atomic_fetch_add(hs + te[k], 1u, __ATOMIC_RELAXED, __HIP_MEMORY_SCOPE_WORKGROUP);
            __builtin_amdgcn_wave_barrier(); LDS_WAIT();
            if (t < 32) { const unsigned n = hs[t]; gbase[t] = n ? __hip_atomic_fetch_add(cnt + 64 * t, n, RLX_AGENT) : 0u; }
            __builtin_amdgcn_wave_barrier(); LDS_WAIT();
#pragma unroll
            for (int k = 0; k < 4; ++k) { const unsigned pos = gbase[te[k]] + lpos[k]; list[(size_t)te[k] * NTOK + pos] = (unsigned)tok; rsl[(size_t)te[k] * NTOK + pos] = rs;
                assign[tok * 4 + k] = ((unsigned)te[k] << 16) | pos; gate[tok * 4 + k] = gv[k]; }
        }
        __syncthreads();
    }
}
__device__ __forceinline__ int moe_tables(Frame& F) {
    LAS unsigned char* tile_e = F.lds + TAB_OFF; LAS int* tstart = (LAS int*)(F.lds + TAB_TSTART); LAS int* lc = (LAS int*)(F.lds + TAB_CNT);
    if (F.tid < 32) lc[F.tid] = (int)__hip_atomic_load(F.ctl + CW_CNT + 64 * F.tid, RLX_AGENT);
    __syncthreads();
    if (F.tid == 0) { int s = 0; for (int e = 0; e < 32; ++e) { tstart[e] = s; s += (lc[e] + 255) >> 8; } tstart[32] = s; }
    __syncthreads();
    const int T = tstart[32];
    for (int i = F.tid; i < T; i += 512) { int e = 0;
#pragma unroll
        for (int k = 1; k < 32; ++k) e += (tstart[k] <= i) ? 1 : 0;
        tile_e[i] = (unsigned char)e; }
    __syncthreads();
    return T;
}
__device__ __forceinline__ void final_phase(Frame& F, const bf16* X2, float* out, const unsigned char* Y, const float* gate, const unsigned* assign, const float* gfin) {
    (void)moe_tables(F);
    const LAS int* tstart = (const LAS int*)(F.lds + TAB_TSTART);
    const int gw = F.vcu * NWAVES + F.wave, NGW = F.G * NWAVES, lane = lane_here();
    unsigned an[2][4]; float gn[2][4];
#define FIN_ROUTE(t0) do { _Pragma("unroll") for (int u = 0; u < 2; ++u) { const int tok_ = ((t0) + u * NGW < NTOK) ? (t0) + u * NGW : ((t0) < NTOK ? (t0) : gw); \
        const v4u a4 = *(const v4u*)(assign + (size_t)tok_ * 4); const f32x4 g4 = *(const f32x4*)(gate + (size_t)tok_ * 4); \
        an[u][0] = a4.x; an[u][1] = a4.y; an[u][2] = a4.z; an[u][3] = a4.w; gn[u][0] = g4.x; gn[u][1] = g4.y; gn[u][2] = g4.z; gn[u][3] = g4.w; } } while (0)
    FIN_ROUTE(gw);
    for (int tok0 = gw; tok0 < NTOK; tok0 += 2 * NGW) {
        f32x4 v[2][4]; unsigned yw[2][4][4]; float gk[2][4];
#pragma unroll
        for (int u = 0; u < 2; ++u) { const int tok = (tok0 + u * NGW < NTOK) ? tok0 + u * NGW : tok0;
#pragma unroll
            for (int k = 0; k < 4; ++k) { const unsigned a = an[u][k]; gk[u][k] = gn[u][k]; const size_t row = (size_t)tstart[a >> 16] * 256 + (a & 0xffffu);
                const unsigned* yr = (const unsigned*)(Y + row * DM) + lane;
#pragma unroll
                for (int j = 0; j < 4; ++j) yw[u][k][j] = yr[64 * j]; }
            const v2u* xin = (const v2u*)(X2 + (size_t)tok * DM) + lane;
#pragma unroll
            for (int j = 0; j < 4; ++j) { const v2u w = xin[64 * j]; v[u][j] = (f32x4){__builtin_bit_cast(float, w.x << 16), __builtin_bit_cast(float, w.x & 0xffff0000u), __builtin_bit_cast(float, w.y << 16), __builtin_bit_cast(float, w.y & 0xffff0000u)}; } }
        FIN_ROUTE(tok0 + 2 * NGW);
#pragma unroll
        for (int u = 0; u < 2; ++u) { const int tok = (tok0 + u * NGW < NTOK) ? tok0 + u * NGW : tok0;
#pragma unroll
            for (int k = 0; k < 4; ++k)
#pragma unroll
                for (int j = 0; j < 4; ++j) { const unsigned w = yw[u][k][j]; const auto lo = __builtin_amdgcn_cvt_pk_f32_fp8((int)w, false), hi = __builtin_amdgcn_cvt_pk_f32_fp8((int)w, true);
                    v[u][j].x += gk[u][k] * lo[0]; v[u][j].y += gk[u][k] * lo[1]; v[u][j].z += gk[u][k] * hi[0]; v[u][j].w += gk[u][k] * hi[1]; }
            float s = 0.f;
#pragma unroll
            for (int j = 0; j < 4; ++j) s += (v[u][j].x * v[u][j].x + v[u][j].y * v[u][j].y) + (v[u][j].z * v[u][j].z + v[u][j].w * v[u][j].w);
            const float rs = rsqrtf(wave_sum(s) * (1.0f / DM) + EPS); f32x4* xr = (f32x4*)(out + (size_t)tok * DM) + lane;
#pragma unroll
            for (int j = 0; j < 4; ++j) { const f32x4 gg = ((const f32x4*)gfin)[lane + 64 * j]; xr[64 * j] = v[u][j] * rs * gg; } }
    }
#undef FIN_ROUTE
}

constexpr int NPHASE = 10;
struct Args { const void* in[28]; float* out; unsigned char* ws; int ph_lo, ph_hi; };
__global__ void __launch_bounds__(NWAVES * 64, 2) mk_fwd(Args args) {
    extern __shared__ __attribute__((aligned(16))) unsigned char lds[];
    Frame F;
    F.lds = (LAS unsigned char*)lds;
    F.MISC = (volatile LAS unsigned*)(F.lds + MISC_OFF);
    F.tid = threadIdx.x; F.lane = F.tid & 63; F.wave = __builtin_amdgcn_readfirstlane(F.tid >> 6);
    F.G = gridDim.x; { const int bx = blockIdx.x; F.vcu = (F.G % 8 == 0) ? (bx % 8) * (F.G / 8) + bx / 8 : bx; }
    F.ws = args.ws; F.out = args.out; F.ctl = (gu32*)(args.ws + WS_CTL);
    unsigned char* ws = args.ws;
    typedef const void* const volatile __attribute__((address_space(4))) kargp_t;
    kargp_t* const kargs = (kargp_t*)__builtin_amdgcn_kernarg_segment_ptr();
#define INP(k) ((const float*)kargs[k])
    for (int u = F.tid; u < (LDS_BYTES - LDSCTL_OFF) / 4; u += NWAVES * 64) ((LAS unsigned*)(F.lds + LDSCTL_OFF))[u] = 0u;
    __syncthreads();
    const int lo = args.ph_lo, hi = args.ph_hi;
    const bool single = (hi - lo) > 1;
    XcdBarrier bar; bar.bar = (unsigned*)(F.ctl + CW_BAR); bar.x = 0; bar.st = nullptr;
    if (single) bar = xcd_barrier_post((unsigned*)(F.ctl + CW_BAR), F.MISC + 8);
#define IN(k) (lo <= (k) && (k) < hi)
#if defined(PROBE_K0)
    LAS unsigned long long* tsl = (LAS unsigned long long*)(F.lds + TS_OFF);
    if (F.tid == 0) tsl[0] = rt();
#define SEAM(k) do { if (IN(k) && IN((k) + 1)) xcd_barrier(bar); if (F.tid == 0) tsl[(k) + 1] = rt(); } while (0)
#define SEAM_LOCAL(k) do { if (F.tid == 0) tsl[(k) + 1] = rt(); } while (0)
#else
#define SEAM(k) do { if (IN(k) && IN((k) + 1)) xcd_barrier(bar); } while (0)
#define SEAM_LOCAL(k) do { } while (0)
#endif
    typedef pg8::bf16_t hb;
    const int bx = (int)blockIdx.x;

    if (IN(0)) { In I;
        I.x = (const float*)INP(0);
        I.mem = (const float*)INP(1);
        I.positions = (const int*)INP(2);
        I.norm_mix_g = (const float*)INP(3);
        I.w_in = (const float*)INP(4);
        I.lq1 = (const float*)INP(5);
        I.lk1 = (const float*)INP(6);
        I.lq2 = (const float*)INP(7);
        I.lk2 = (const float*)INP(8);
        I.diff_norm_g = (const float*)INP(9);
        I.w_alpha2 = (const float*)INP(10);
        I.b_alpha = (const float*)INP(11);
        I.gla_norm_g = (const float*)INP(12);
        I.w_out = (const float*)INP(13);
        I.norm_cross_g = (const float*)INP(14);
        I.norm_mem_g = (const float*)INP(15);
        I.w_cq = (const float*)INP(16);
        I.w_ck = (const float*)INP(17);
        I.w_cv = (const float*)INP(18);
        I.w_co = (const float*)INP(19);
        I.norm_ffn_g = (const float*)INP(20);
        I.w_router = (const float*)INP(21);
        I.b_router = (const float*)INP(22);
        I.w_up = (const float*)INP(23);
        I.b_up = (const float*)INP(24);
        I.w_down = (const float*)INP(25);
        I.b_down = (const float*)INP(26);
        I.norm_final_g = (const float*)INP(27);
        p0_prologue(F, I); }
    SEAM(0);
    if (IN(1)) {
        pg8::Gemm g{(const hb*)(ws + WS_HN), (const hb*)(ws + WS_WINT), NTOK, 3328, DM, DM, DM, 127, 127};
        typedef pg8::OrderP1<(unsigned)WS_HN, (unsigned)WS_WINT, (unsigned)WS_MN, (unsigned)WS_WCK, (unsigned)WS_WCV> OrdP1; OrdP1 S; S.G = F.G; S.c = bx; S.ws = (const char*)ws;
        pg8::EpiP1 E{pg8::EpiProj{(hb*)(ws + WS_P), (float*)(ws + WS_LA), (const float*)(ws + WS_CS), INP(11)}, pg8::EpiPlain{(hb*)(ws + WS_VT) - (size_t)1024 * NTOK, NTOK, 1.0f},
                     pg8::EpiPlain{(hb*)(ws + WS_KX), DM, 1.0f}, pg8::EpiPlain{(hb*)(ws + WS_VXT), DM, 1.0f}};
        pg8::gemm_phase<pg8::EpiP1, OrdP1, true, true, false, false>(F.lds + RING_OFF, g, S, E);
    }
    SEAM(1);
    if (IN(2)) {
        float lam;
        { const int ln = lane_here(); const float a = INP(5)[ln] * INP(6)[ln], c = INP(7)[ln] * INP(8)[ln]; lam = __expf(wave_sum(a)) - __expf(wave_sum(c)) + 0.2f; }
        LAS int* qslot = (LAS int*)(F.lds + TAB_OFF);
        for (;;) {
            if (F.tid == 0) qslot[0] = (int)__hip_atomic_fetch_add(F.ctl + CW_Q2, 1u, RLX_AGENT);
            __syncthreads();
            const int u = qslot[0];
            __syncthreads();
            if (u >= 64 + 1024 + MOE_UNITS) break;
            int au = -1;
            if (u >= 64) { const int v = u - 64, gi = v / 11, r = v - gi * 11;
                if (r >= 8) { moe_convert_unit(gi * 3 + (r - 8), INP(23), INP(25), INP(20), ws, F.wave, lane_here()); continue; }
                au = gi * 8 + r; }
#if defined(PROBE_SPLIT)
            if (u < 64) continue;
#endif
            if (u < 64) { gla_unit(F, (const bf16*)(ws + WS_P), (const float*)(ws + WS_LA), (const bf16*)(ws + WS_GVT), (bf16*)(ws + WS_CAT), INP(12), u >> 2, u & 3);
            }
            else { const int v = au, bh = v & 63, qb = 15 - (v >> 6);
                diffattn_unit(F, (const bf16*)(ws + WS_P), (const bf16*)(ws + WS_VT), (bf16*)(ws + WS_CAT), INP(9), lam, bh >> 2, bh & 3, qb); }
        }
    }
#if defined(PROBE_SPLIT)
    if (IN(2)) { xcd_barrier(bar); if (F.tid == 0) tsl[13] = rt();
        for (int u = F.vcu; u < 64; u += F.G) gla_unit(F, (const bf16*)(ws + WS_P), (const float*)(ws + WS_LA), (const bf16*)(ws + WS_GVT), (bf16*)(ws + WS_CAT), INP(12), u >> 2, u & 3); }
#endif
    SEAM(2);
    if (IN(3)) {
        { pg8::Gemm g{(const hb*)(ws + WS_CAT), (const hb*)(ws + WS_WOUT), NTOK, DM, DM, DM, DM, 127, 127}; pg8::StaticOrder S; S.init(NTOK, DM, F.G, bx);
          pg8::EpiRes1 E{INP(0), (hb*)(ws + WS_X1B), (float*)(ws + WS_SSP1)};
          pg8::gemm_phase<pg8::EpiRes1, pg8::StaticOrder, true, true, false, false>(F.lds + RING_OFF, g, S, E); }
        { pg8::Gemm g{(const hb*)(ws + WS_KX), (const hb*)(ws + WS_WCQ), 64 * 256, DM, 256, DM, DM, 127, 127};
          typedef pg8::OrderGH<(unsigned)WS_KX, (unsigned)WS_WCQ, (unsigned)WS_WCO, (unsigned)WS_VXT> OrdGH; OrdGH S; S.G = F.G; S.c = bx; S.ws = (const char*)ws;
          pg8::EpiGH E{pg8::EpiPlain{(hb*)(ws + WS_GT), DM, 1.0f}, pg8::EpiPlain{(hb*)(ws + WS_HT), DM, 1.0f}};
          pg8::gemm_phase<pg8::EpiGH, OrdGH, true, true>(F.lds + RING_OFF, g, S, E); }
    }
    SEAM(3);
    if (IN(4)) {
        pg8::Gemm g{(const hb*)(ws + WS_X1B), (const hb*)(ws + WS_GT), NTOK, 256, DM, DM, DM, 127, 127}; pg8::OrderXS S; S.init(F.G, bx);
        pg8::EpiSoftmaxN E{(hb*)(ws + WS_PX), (const float*)(ws + WS_SSP1), (PG8_LAS float*)(F.lds + XCH_OFF), (PG8_LAS float*)(F.lds + XCH2_OFF)};
        pg8::gemm_phase<pg8::EpiSoftmaxN, pg8::OrderXS, true, true>(F.lds + RING_OFF, g, S, E);
    }
    SEAM(4);
    if (IN(5)) {
        pg8::Gemm g{(const hb*)(ws + WS_PX), (const hb*)(ws + WS_HT), NTOK, DM, DM, DM, DM, 127, 127}; pg8::OrderXO S; S.init(F.G, bx);
        pg8::EpiRes2 E{(hb*)(ws + WS_X1B), ws + WS_X2B};
        pg8::gemm_phase<pg8::EpiRes2, pg8::OrderXO, true, true, false, false>(F.lds + RING_OFF, g, S, E);
    }
    SEAM(5);
    if (IN(6)) router_phase(F, (const bf16*)(ws + WS_X1B), (const float*)(ws + WS_WR), INP(22), (float*)(ws + WS_RSL), (float*)(ws + WS_GATE), (unsigned*)(ws + WS_ASSIGN), (unsigned*)(ws + WS_LIST), F.ctl + CW_CNT);
    SEAM(6);
    if (IN(7)) {
        const int T = moe_tables(F);
        pg8::Gemm g{(const hb*)(ws + WS_X2B), (const hb*)(ws + WS_WUP), T * 256, NEXP * 2048, 512, 512, 512, 127, 122}; pg8::MoeOrderG S;
        S.init(T, 8, F.G, bx, (const PG8_LAS unsigned char*)(F.lds + TAB_OFF), (const PG8_LAS int*)(F.lds + TAB_TSTART), (const PG8_LAS int*)(F.lds + TAB_CNT), (const unsigned*)(ws + WS_LIST), (PG8_LAS unsigned*)(F.lds + XCH_OFF));
        pg8::EpiUp E{ws + WS_ACT, (const float*)(ws + WS_RSL), (const PG8_LAS int*)(F.lds + TAB_TSTART), (const PG8_LAS int*)(F.lds + TAB_CNT), INP(24)};
        pg8::gemm_phase<pg8::EpiUp, pg8::MoeOrderG, true, true, true, false>(F.lds + RING_OFF, g, S, E);
    }
    SEAM(7);
    if (IN(8)) {
        const int T = moe_tables(F);
        pg8::Gemm g{(const hb*)(ws + WS_ACT), (const hb*)(ws + WS_WDN), T * 256, NEXP * 1024, 512, 512, 512, 127, 122}; pg8::MoeOrder S; S.init(T, 4, F.G, bx, (const PG8_LAS unsigned char*)(F.lds + TAB_OFF));
        pg8::EpiDown E{ws + WS_Y, INP(26)};
        pg8::gemm_phase<pg8::EpiDown, pg8::MoeOrder, true, true, true, false>(F.lds + RING_OFF, g, S, E);
    }
    SEAM(8);
    if (IN(9)) final_phase(F, (const bf16*)(ws + WS_X1B), F.out, (const unsigned char*)(ws + WS_Y), (const float*)(ws + WS_GATE), (const unsigned*)(ws + WS_ASSIGN), INP(27));
#if defined(PROBE_K0)
    { if (F.tid == 0) { tsl[NPHASE] = rt();
        const int ks[2] = {PROBE_K0, PROBE_K1}; unsigned long long code = 0, mul = 1;
        for (int i = 0; i < 2; ++i) { unsigned long long dt = ks[i] == 97 ? tsl[13] - tsl[2] : ks[i] == 98 ? tsl[3] - tsl[13] : ks[i] == 95 ? tsl[13] - tsl[0] : ks[i] == 96 ? tsl[14] - tsl[13] : tsl[ks[i] + 1] - tsl[ks[i]]; unsigned long long q = (dt + 800) / 1600; if (q > 63) q = 63; code += q * mul; mul *= 64; }
        tsl[15] = code * 6400ull; }
      __syncthreads();
      const unsigned long long t0 = rt(), wait = tsl[15]; float x = (float)F.tid, y = 1.0001f;
      while (rt() - t0 < wait) {
#pragma unroll
          for (int i = 0; i < 64; ++i) x = x * y + 0.5f; }
      if (x == 12345.678f) F.out[0] = x; }
#endif
#undef IN
#undef SEAM
#undef SEAM_LOCAL
}

#ifndef MK_N_LAUNCHES
#define MK_N_LAUNCHES 1
#endif
extern "C" void kernel_launch(void* const* d_in, const int* in_sizes, int n_in, void* d_out, int out_size, void* d_ws, size_t ws_size, hipStream_t stream) {
    static int grid = 0;
    if (grid == 0) {
        if (n_in != 28 || out_size != NTOK * DM || ws_size < WS_END) { fprintf(stderr, "kernel_launch: unexpected shapes: n_in %d out %d ws %zu (need %zu)\n", n_in, out_size, ws_size, (size_t)WS_END); grid = -1; return; }
        int dev = 0, cus = 0, per_cu = 0;
        if (hipGetDevice(&dev) != hipSuccess || hipDeviceGetAttribute(&cus, hipDeviceAttributeMultiprocessorCount, dev) != hipSuccess) { fprintf(stderr, "kernel_launch: device query failed\n"); grid = -1; return; }
        if (hipFuncSetAttribute((const void*)mk_fwd, hipFuncAttributeMaxDynamicSharedMemorySize, LDS_BYTES) != hipSuccess) { fprintf(stderr, "kernel_launch: hipFuncSetAttribute failed\n"); grid = -1; return; }
        if (hipOccupancyMaxActiveBlocksPerMultiprocessor(&per_cu, (const void*)mk_fwd, NWAVES * 64, LDS_BYTES) != hipSuccess || per_cu < 1) { fprintf(stderr, "kernel_launch: occupancy query reports %d workgroups per CU\n", per_cu); (void)hipGetLastError(); grid = -1; return; }
        grid = cus;
    }
    if (grid < 0) return;
    (void)hipMemsetAsync((char*)d_ws + WS_CTL, 0, CTL_ZERO_BYTES, stream);
    Args a{};
    for (int i = 0; i < 28; ++i) a.in[i] = d_in[i];
    a.out = (float*)d_out; a.ws = (unsigned char*)d_ws;
    if (MK_N_LAUNCHES == 1) { a.ph_lo = 0; a.ph_hi = NPHASE; hipLaunchKernelGGL(mk_fwd, dim3(grid), dim3(NWAVES * 64), LDS_BYTES, stream, a); }
    else for (int p = 0; p < NPHASE; ++p) { a.ph_lo = p; a.ph_hi = p + 1; hipLaunchKernelGGL(mk_fwd, dim3(grid), dim3(NWAVES * 64), LDS_BYTES, stream, a); }
}
```

```cpp
#include <hip/hip_runtime.h>
#include <cstdio>
#include <cstdint>
namespace pg8 {
#define PG8_LAS __attribute__((address_space(3)))
typedef unsigned short bf16_t;
typedef short bf16x8 __attribute__((ext_vector_type(8)));
typedef float f32x4 __attribute__((ext_vector_type(4)));
typedef unsigned u32x4 __attribute__((ext_vector_type(4)));
constexpr int BM = 256, BK = 64, HALF = 128, HTB = HALF * BK * 2  , STAGE_BYTES = 8 * HTB, NXCD = 8, WGM = 8;

__host__ __device__ __forceinline__ int lds_byte(int r, int c) { const int st = (r >> 4) * 2 + (c >> 5), rr = r & 15, cc = c & 31, ob = rr * 64 + cc * 2; return st * 1024 + (ob ^ (((ob >> 9) & 1) << 5)); }
__host__ __device__ __forceinline__ void stage_rc(int b, int& R, int& C) { const int st = b / 1024, sb = b % 1024, swz = sb ^ (((sb >> 9) & 1) << 5); R = (st >> 1) * 16 + swz / 64; C = (st & 1) * 32 + (swz % 64) / 2; }
__host__ __device__ __forceinline__ int perm32(int rho) { const int n = rho >> 4, i = rho & 15; return 8 * (i >> 2) + 4 * n + (i & 3); }

struct Unit { int pm, pn; };
struct Gemm { const bf16_t* A; const bf16_t* Bt; int M, N, K, lda, ldb, sa, sb; };
struct OrderBase {
    static constexpr bool GATHER = false;
    __device__ __forceinline__ const char* a_base(const Gemm& g, const Unit& u) const { return (const char*)g.A + (size_t)u.pm * 256 * g.lda * 2; }
    __device__ __forceinline__ const char* b_base(const Gemm& g, const Unit& u) const { return (const char*)g.Bt + (size_t)u.pn * 256 * g.ldb * 2; }
    __device__ __forceinline__ void a_ready(const Unit&) const {}
    __device__ __forceinline__ void done(const Unit&) const {}
};

struct StaticOrder : OrderBase {
    int nM, nN, nwg, G, c;
    __host__ __device__ void init(int M, int N, int G_, int c_) { nM = M / BM; nN = N / BM; nwg = nM * nN; G = G_; c = c_; }
    __host__ __device__ bool next(int i, Unit& u) const {
        const long L = (long)i * G + c; if (L >= nwg) return false;
        int wgid = (int)L; { const int q = nwg / NXCD, r = nwg % NXCD, xcd = wgid % NXCD, off = wgid / NXCD; wgid = (xcd < r ? xcd * (q + 1) : r * (q + 1) + (xcd - r) * q) + off; }
        const int nig = WGM * nN, gid = wgid / nig, fm = gid * WGM, gsz = (nM - fm) < WGM ? (nM - fm) : WGM;
        u.pm = fm + ((wgid % nig) % gsz); u.pn = (wgid % nig) / gsz; return true;
    }
};

typedef unsigned u32x2 __attribute__((ext_vector_type(2)));
typedef float f32x2_t __attribute__((ext_vector_type(2)));
typedef __bf16 bf16x2_t __attribute__((ext_vector_type(2)));
__device__ __forceinline__ unsigned cvtpk(float lo, float hi) { f32x2_t v = {lo, hi}; bf16x2_t b = __builtin_convertvector(v, bf16x2_t); return __builtin_bit_cast(unsigned, b); }
__device__ __forceinline__ void st_bf4(bf16_t* p, f32x4 v) { u32x2 w; w.x = cvtpk(v[0], v[1]); w.y = cvtpk(v[2], v[3]); *(u32x2*)p = w; }
__device__ __forceinline__ unsigned cvt4_fp8(f32x4 v) { unsigned w = __builtin_amdgcn_cvt_pk_fp8_f32(v[0], v[1], 0, false); return __builtin_amdgcn_cvt_pk_fp8_f32(v[2], v[3], w, true); }
__device__ __forceinline__ void st_bf8(bf16_t* p, f32x4 a, f32x4 c) { u32x4 w; w.x = cvtpk(a[0], a[1]); w.y = cvtpk(a[2], a[3]); w.z = cvtpk(c[0], c[1]); w.w = cvtpk(c[2], c[3]); *(u32x4*)p = w; }
__device__ __forceinline__ float bf2f(bf16_t b) { return __builtin_bit_cast(float, (unsigned)b << 16); }
#define EPI_ROWS _Pragma("unroll") for (int ai = 0; ai < 2; ++ai) _Pragma("unroll") for (int m = 0; m < 4; ++m)
#define EPI_COLS _Pragma("unroll") for (int bj = 0; bj < 2; ++bj) _Pragma("unroll") for (int n = 0; n < 2; ++n)
constexpr float LOG2E = 1.4426950408889634f;
constexpr float QSCALE_DA = 0.125f * LOG2E;
constexpr float QSCALE_X = 0.0625f * LOG2E;

struct EpiPlain {
    static constexpr bool PERM = true, AFTER_DRAIN = false;
    bf16_t* O; int ldc; float scale;
    __device__ __forceinline__ void operator()(const f32x4 (&acc)[2][2][4][2], const Unit& u, int wr, int wc, int fr, int fq) const {
        EPI_ROWS { const int row = u.pm * 256 + ai * 128 + wr * 64 + m * 16 + fr; bf16_t* rp = O + (size_t)row * ldc + u.pn * 256 + wc * 32 + fq * 8;
            _Pragma("unroll") for (int bj = 0; bj < 2; ++bj) st_bf8(rp + bj * 128, acc[ai][bj][m][0] * scale, acc[ai][bj][m][1] * scale); }
    }
};
struct EpiProj {
    static constexpr bool PERM = true, AFTER_DRAIN = false;
    bf16_t* P; float* LA; const float* cs; const float* b_alpha;
    template <int ai> __device__ __forceinline__ void decay_rows(const f32x4 (&acc)[2][2][4][2], const Unit& u, int wr, int wc, int fr, int fq) const {
        const int row0 = u.pm * 256 + ai * 128 + wr * 64 + fr;
        EPI_COLS { const int col = bj * 128 + wc * 32 + fq * 8 + n * 4; const f32x4 ba = *(const f32x4*)(b_alpha + col); f32x4 run = {0.f, 0.f, 0.f, 0.f};
            _Pragma("unroll") for (int m = 0; m < 4; ++m) { const f32x4 z = acc[ai][bj][m][n] + ba; f32x4 o;
                _Pragma("unroll") for (int i = 0; i < 4; ++i) { float v = (fminf(z[i], 0.f) - __logf(1.0f + __expf(-fabsf(z[i])))) * 0.0625f;
                    { float t = __shfl_up(v, 1, 16); if (fr >= 1) v += t; t = __shfl_up(v, 2, 16); if (fr >= 2) v += t; t = __shfl_up(v, 4, 16); if (fr >= 4) v += t; t = __shfl_up(v, 8, 16); if (fr >= 8) v += t; }
                    o[i] = v + run[i]; run[i] += __shfl(v, 15, 16); }
                *(f32x4*)(LA + (size_t)(row0 + m * 16) * 256 + col) = o; } }
    }
    __device__ __forceinline__ void operator()(const f32x4 (&acc)[2][2][4][2], const Unit& u, int wr, int wc, int fr, int fq) const {
        const int pn = u.pn;
        if (pn < 4) {
            const float sc = pn < 2 ? QSCALE_DA : 1.0f; const bool ropew = (wc & 1) == 0; const bool rl = fq < 2, hi = fq == 1;
            EPI_ROWS { const int row = u.pm * 256 + ai * 128 + wr * 64 + m * 16 + fr; bf16_t* rp = P + (size_t)row * 3072 + pn * 256 + wc * 32 + fq * 8;
                f32x4 cv[2], sv[2];
                if (ropew) { const f32x4* cp = (const f32x4*)(cs + (size_t)row * 16); cv[0] = cp[0]; cv[1] = cp[1]; sv[0] = cp[2]; sv[1] = cp[3]; }
                _Pragma("unroll") for (int bj = 0; bj < 2; ++bj) { f32x4 v[2] = {acc[ai][bj][m][0], acc[ai][bj][m][1]};
                    if (ropew) { _Pragma("unroll") for (int n = 0; n < 2; ++n) { f32x4 p; p[0] = __shfl_xor(v[n][0], 16); p[1] = __shfl_xor(v[n][1], 16); p[2] = __shfl_xor(v[n][2], 16); p[3] = __shfl_xor(v[n][3], 16);
                            const f32x4 r = hi ? (v[n] * cv[n] + p * sv[n]) : (v[n] * cv[n] - p * sv[n]); v[n] = rl ? r : v[n]; } }
                    st_bf8(rp + bj * 128, v[0] * sc, v[1] * sc); } }
        } else if (pn < 12) {
            const float sc = pn == 6 ? 0.125f : 1.0f;
            EPI_ROWS { const int row = u.pm * 256 + ai * 128 + wr * 64 + m * 16 + fr; bf16_t* rp = P + (size_t)row * 3072 + pn * 256 + wc * 32 + fq * 8;
                _Pragma("unroll") for (int bj = 0; bj < 2; ++bj) st_bf8(rp + bj * 128, acc[ai][bj][m][0] * sc, acc[ai][bj][m][1] * sc); }
        } else {
            decay_rows<0>(acc, u, wr, wc, fr, fq); decay_rows<1>(acc, u, wr, wc, fr, fq);
        }
    }
};
struct EpiP1 {
    static constexpr bool PERM = true, AFTER_DRAIN = false;
    EpiProj proj; EpiPlain vt, kx, vxt;
    __device__ __forceinline__ void operator()(const f32x4 (&acc)[2][2][4][2], const Unit& u, int wr, int wc, int fr, int fq) const {
        const int job = u.pn >> 16; Unit v; v.pm = u.pm; v.pn = u.pn & 0xffff;
        if (job == 0) proj(acc, v, wr, wc, fr, fq); else if (job == 1) vt(acc, v, wr, wc, fr, fq); else if (job == 2) kx(acc, v, wr, wc, fr, fq); else vxt(acc, v, wr, wc, fr, fq);
    }
};
struct EpiRes1 {
    static constexpr bool PERM = true, AFTER_DRAIN = false;
    const float* base; bf16_t* xb; float* ssp;
    __device__ __forceinline__ void operator()(const f32x4 (&acc)[2][2][4][2], const Unit& u, int wr, int wc, int fr, int fq) const {
        EPI_ROWS { const int row = u.pm * 256 + ai * 128 + wr * 64 + m * 16 + fr; const size_t off = (size_t)row * 1024 + u.pn * 256 + wc * 32 + fq * 8; float ss = 0.f;
            _Pragma("unroll") for (int bj = 0; bj < 2; ++bj) { const size_t o2 = off + bj * 128; const f32x4 v0 = *(const f32x4*)(base + o2) + acc[ai][bj][m][0], v1 = *(const f32x4*)(base + o2 + 4) + acc[ai][bj][m][1]; st_bf8(xb + o2, v0, v1);
                ss += ((v0[0] * v0[0] + v0[1] * v0[1]) + (v0[2] * v0[2] + v0[3] * v0[3])) + ((v1[0] * v1[0] + v1[1] * v1[1]) + (v1[2] * v1[2] + v1[3] * v1[3])); }
            ss += __shfl_xor(ss, 16); ss += __shfl_xor(ss, 32);
            if (fq == 0) ssp[(size_t)row * 16 + u.pn * 4 + wc] = ss; }
    }
};
struct EpiQX {
    static constexpr bool PERM = true, AFTER_DRAIN = false;
    bf16_t* O; const float* ssp;
    __device__ __forceinline__ void operator()(const f32x4 (&acc)[2][2][4][2], const Unit& u, int wr, int wc, int fr, int fq) const {
        EPI_ROWS { const int row = u.pm * 256 + ai * 128 + wr * 64 + m * 16 + fr; const f32x4* sp = (const f32x4*)(ssp + (size_t)row * 16);
            const f32x4 a = sp[0], b = sp[1], c = sp[2], d = sp[3]; const float ss = ((a[0] + a[1]) + (a[2] + a[3])) + ((b[0] + b[1]) + (b[2] + b[3])) + ((c[0] + c[1]) + (c[2] + c[3])) + ((d[0] + d[1]) + (d[2] + d[3]));
            const float rs = rsqrtf(ss * (1.0f / 1024.0f) + 1e-6f) * QSCALE_X; bf16_t* rp = O + (size_t)row * 1024 + u.pn * 256 + wc * 32 + fq * 8;
            _Pragma("unroll") for (int bj = 0; bj < 2; ++bj) st_bf8(rp + bj * 128, acc[ai][bj][m][0] * rs, acc[ai][bj][m][1] * rs); }
    }
};
struct EpiRes2 {
    static constexpr bool PERM = true, AFTER_DRAIN = false;
    bf16_t* xh; unsigned char* x8;
    __device__ __forceinline__ void operator()(const f32x4 (&acc)[2][2][4][2], const Unit& u, int wr, int wc, int fr, int fq) const {
        EPI_ROWS { const int row = u.pm * 256 + ai * 128 + wr * 64 + m * 16 + fr; const size_t off = (size_t)row * 1024 + u.pn * 256 + wc * 32 + fq * 8;
            _Pragma("unroll") for (int bj = 0; bj < 2; ++bj) { bf16_t* p = xh + off + bj * 128; const u32x4 w = *(const u32x4*)p;
                f32x4 v0 = {__builtin_bit_cast(float, w.x << 16), __builtin_bit_cast(float, w.x & 0xffff0000u), __builtin_bit_cast(float, w.y << 16), __builtin_bit_cast(float, w.y & 0xffff0000u)};
                f32x4 v1 = {__builtin_bit_cast(float, w.z << 16), __builtin_bit_cast(float, w.z & 0xffff0000u), __builtin_bit_cast(float, w.w << 16), __builtin_bit_cast(float, w.w & 0xffff0000u)};
                v0 = v0 + acc[ai][bj][m][0]; v1 = v1 + acc[ai][bj][m][1]; st_bf8(p, v0, v1); u32x2 q; q.x = cvt4_fp8(v0); q.y = cvt4_fp8(v1); *(u32x2*)(x8 + off + bj * 128) = q; } }
    }
};
struct EpiUp {
    static constexpr bool PERM = true, AFTER_DRAIN = false;
    unsigned char* ACT; const float* rsl; const PG8_LAS int* tstart; const PG8_LAS int* cnt; const float* b_up;
    __device__ __forceinline__ void operator()(const f32x4 (&acc)[2][2][4][2], const Unit& u, int wr, int wc, int fr, int fq) const {
        const int e = u.pn >> 3, pnl = u.pn & 7; const float* bg = b_up + (size_t)e * 2048 + pnl * 128 + wc * 32 + fq * 8;
        const int pos0 = (u.pm - tstart[e]) * 256 + wr * 64 + fr, nv = cnt[e]; const float* rp0 = rsl + (size_t)e * 32768 + pos0;
        const f32x4 bg0 = *(const f32x4*)bg, bg1 = *(const f32x4*)(bg + 4), bl0 = *(const f32x4*)(bg + 1024), bl1 = *(const f32x4*)(bg + 1028);
        EPI_ROWS { const int row = u.pm * 256 + ai * 128 + wr * 64 + m * 16 + fr; const float rs = (pos0 + ai * 128 + m * 16) < nv ? rp0[ai * 128 + m * 16] : 0.f;
            unsigned char* rp = ACT + (size_t)row * 1024 + pnl * 128 + wc * 32 + fq * 8; u32x2 w;
            _Pragma("unroll") for (int n = 0; n < 2; ++n) {
                const f32x4 c7 = {7.0f, 7.0f, 7.0f, 7.0f}, one = {1.0f, 1.0f, 1.0f, 1.0f};
                const f32x4 gl = __builtin_elementwise_min(acc[ai][0][m][n] * rs + (n ? bg1 : bg0), c7), li = __builtin_elementwise_min(__builtin_elementwise_max(acc[ai][1][m][n] * rs + (n ? bl1 : bl0), -c7), c7);
                const f32x4 t = gl * -2.4554669595930156f; f32x4 e; _Pragma("unroll") for (int i = 0; i < 4; ++i) e[i] = __builtin_amdgcn_exp2f(t[i]);
                const f32x4 a = e + one; f32x4 r; _Pragma("unroll") for (int i = 0; i < 4; ++i) r[i] = __builtin_amdgcn_rcpf(a[i]);
                const f32x4 o = (gl * r) * (li + one);
                if (n) w.y = cvt4_fp8(o); else w.x = cvt4_fp8(o); }
            *(u32x2*)rp = w; }
    }
};
struct EpiDown {
    static constexpr bool PERM = true, AFTER_DRAIN = false;
    unsigned char* Y; const float* b_down;
    __device__ __forceinline__ void operator()(const f32x4 (&acc)[2][2][4][2], const Unit& u, int wr, int wc, int fr, int fq) const {
        const int e = u.pn >> 2, pnl = u.pn & 3; const float* bp = b_down + (size_t)e * 1024 + pnl * 256 + wc * 32 + fq * 8;
        f32x4 bv[2][2];
        _Pragma("unroll") for (int bj = 0; bj < 2; ++bj) _Pragma("unroll") for (int n = 0; n < 2; ++n) bv[bj][n] = *(const f32x4*)(bp + bj * 128 + n * 4);
        EPI_ROWS { const int row = u.pm * 256 + ai * 128 + wr * 64 + m * 16 + fr; unsigned char* rp = Y + (size_t)row * 1024 + pnl * 256 + wc * 32 + fq * 8;
            _Pragma("unroll") for (int bj = 0; bj < 2; ++bj) { u32x2 w; w.x = cvt4_fp8(acc[ai][bj][m][0] + bv[bj][0]); w.y = cvt4_fp8(acc[ai][bj][m][1] + bv[bj][1]); *(u32x2*)(rp + bj * 128) = w; } }
    }
};
struct OrderMap : OrderBase {
    StaticOrder so;
    __device__ void init(int nM, int nN, int G, int c) { so.nM = nM; so.nN = nN; so.nwg = nM * nN; so.G = G; so.c = c; }
    __device__ bool next(int i, Unit& u) const { if (!so.next(i, u)) return false; u.pn += (u.pn >= 4 ? 2 : 0) + (u.pn >= 6 ? 2 : 0); return true; }
};
struct OrderVT : OrderBase {
    StaticOrder so;
    __device__ void init(int nN, int G, int c) { so.nM = 4; so.nN = nN; so.nwg = 4 * nN; so.G = G; so.c = c; }
    __device__ bool next(int i, Unit& u) const { if (!so.next(i, u)) return false; u.pm += (u.pm >= 2 ? 6 : 4); return true; }
};
__device__ __forceinline__ void map_unit(int L, int nM, int nN, int& pm, int& pn) {
    const int nwg = nM * nN; int wgid = L; { const int q = nwg / NXCD, r = nwg % NXCD, xcd = wgid % NXCD, off = wgid / NXCD; wgid = (xcd < r ? xcd * (q + 1) : r * (q + 1) + (xcd - r) * q) + off; }
    const int nig = WGM * nN, gid = wgid / nig, fm = gid * WGM, gsz = (nM - fm) < WGM ? (nM - fm) : WGM;
    pm = fm + ((wgid % nig) % gsz); pn = (wgid % nig) / gsz;
}
template <unsigned oHN, unsigned oWINT, unsigned oMN, unsigned oWCK, unsigned oWCV>
struct OrderP1 : OrderBase {
    int G, c; const char* ws;
    __device__ __forceinline__ bool next(int i, Unit& u) const {
        int L = i * G + c; if (L >= 1792) return false;
        if (L < 1152) { map_unit(L, 128, 9, u.pm, u.pn); u.pn += (u.pn >= 4 ? 2 : 0) + (u.pn >= 6 ? 2 : 0); return true; } L -= 1152;
        if (L < 512) { map_unit(L, 4, 128, u.pm, u.pn); u.pm += (u.pm >= 2 ? 6 : 4); u.pn |= 1 << 16; return true; } L -= 512;
        if (L < 64) { map_unit(L, 16, 4, u.pm, u.pn); u.pn |= 2 << 16; return true; } L -= 64;
        map_unit(L, 16, 4, u.pm, u.pn); u.pn |= 3 << 16; return true;
    }
    __device__ __forceinline__ const char* a_base(const Gemm&, const Unit& u) const { const int job = u.pn >> 16; unsigned o = oHN; o = job == 1 ? oWINT : o; o = job >= 2 ? oMN : o; return ws + o + (size_t)u.pm * (256 * 1024 * 2); }
    __device__ __forceinline__ const char* b_base(const Gemm&, const Unit& u) const { const int job = u.pn >> 16; unsigned o = oWINT; o = job == 1 ? oHN : o; o = job == 2 ? oWCK : o; o = job == 3 ? oWCV : o; return ws + o + (size_t)(u.pn & 0xffff) * (256 * 1024 * 2); }
};
struct MoeOrder : OrderBase {
    StaticOrder so; const PG8_LAS unsigned char* tile_e; int nN;
    __device__ void init(int nM, int nN_, int G, int c, const PG8_LAS unsigned char* te) { so.nM = nM; so.nN = nN_; so.nwg = nM * nN_; so.G = G; so.c = c; tile_e = te; nN = nN_; }
    __device__ bool next(int i, Unit& u) const { if (!so.next(i, u)) return false; u.pn += (int)tile_e[u.pm] * nN; return true; }
};


struct MoeOrderG : OrderBase {
    static constexpr bool GATHER = true;
    StaticOrder so; const PG8_LAS unsigned char* tile_e; const PG8_LAS int* tstart; const PG8_LAS int* cnt; const unsigned* list; PG8_LAS unsigned* gslot; int nN;
    __device__ void init(int nM, int nN_, int G, int c, const PG8_LAS unsigned char* te, const PG8_LAS int* ts, const PG8_LAS int* cn, const unsigned* li, PG8_LAS unsigned* gs) {
        so.nM = nM; so.nN = nN_; so.nwg = nM * nN_; so.G = G; so.c = c; tile_e = te; tstart = ts; cnt = cn; list = li; gslot = gs; nN = nN_; }
    __device__ bool next(int i, Unit& u) const { if (!so.next(i, u)) return false; u.pn += (int)tile_e[u.pm] * nN; return true; }
    __device__ __forceinline__ const char* a_base(const Gemm& g, const Unit&) const { return (const char*)g.A; }
    __device__ __forceinline__ const unsigned* rows(const Unit& u) const { const int e = u.pn / nN; return list + (size_t)e * 32768 + (size_t)(u.pm - tstart[e]) * 256; }
    __device__ __forceinline__ int nvalid(const Unit& u) const { const int e = u.pn / nN; return cnt[e] - (u.pm - tstart[e]) * 256; }
};
struct OrderX1 : OrderBase {
    StaticOrder so;
    __device__ void init(int G, int c) { so.nM = 128; so.nN = 4; so.nwg = 512; so.G = G; so.c = c; }
    __device__ bool next(int i, Unit& u) const { return so.next(i, u); }
    __device__ __forceinline__ const char* a_base(const Gemm& g, const Unit& u) const { return (const char*)(g.A + (size_t)u.pm * 256 * 1024 + u.pn * 256); }
    __device__ __forceinline__ const char* b_base(const Gemm& g, const Unit& u) const { return (const char*)(g.Bt + (size_t)(u.pm >> 3) * 256 * 1024 + u.pn * 256); }
};
struct OrderX2 : OrderBase {
    StaticOrder so;
    __device__ void init(int G, int c) { so.nM = 128; so.nN = 4; so.nwg = 512; so.G = G; so.c = c; }
    __device__ bool next(int i, Unit& u) const { return so.next(i, u); }
    __device__ __forceinline__ const char* a_base(const Gemm& g, const Unit& u) const { return (const char*)(g.A + (size_t)u.pm * 256 * 1024 + u.pn * 256); }
    __device__ __forceinline__ const char* b_base(const Gemm& g, const Unit& u) const { return (const char*)(g.Bt + (size_t)u.pn * 256 * 4096 + (u.pm >> 3) * 256); }
};
struct EpiSoftmax {
    static constexpr bool PERM = true, AFTER_DRAIN = false;
    bf16_t* PX; float* lp; PG8_LAS float* xch;
    __device__ __forceinline__ void operator()(const f32x4 (&acc)[2][2][4][2], const Unit& u, int wr, int wc, int fr, int fq) const {
        PG8_LAS char* rb = (PG8_LAS char*)xch + (wr * 64 + fr) * 16; asm volatile("" : "+v"(rb));
        PG8_LAS char* wb = rb + wc * 4; asm volatile("" : "+v"(wb));
        EPI_ROWS { float a = -INFINITY;
            EPI_COLS { const f32x4 v = acc[ai][bj][m][n]; a = fmaxf(a, fmaxf(fmaxf(v[0], v[1]), fmaxf(v[2], v[3]))); }
            a = fmaxf(a, __shfl_xor(a, 16)); a = fmaxf(a, __shfl_xor(a, 32));
            if (fq == 0) *(PG8_LAS float*)(wb + (ai * 128 + m * 16) * 16) = a; }
        asm volatile("s_waitcnt lgkmcnt(0)" ::: "memory"); __builtin_amdgcn_s_barrier(); asm volatile("" ::: "memory");
        const int row0 = u.pm * 256 + wr * 64 + fr; bf16_t* rp0 = PX + (size_t)row0 * 1024 + u.pn * 256 + wc * 32 + fq * 8; float* lp0 = lp + (size_t)row0 * 16 + u.pn * 4 + wc;
        EPI_ROWS { const f32x4 q = *(const PG8_LAS f32x4*)(rb + (ai * 128 + m * 16) * 16); const float mr = fmaxf(fmaxf(q[0], q[1]), fmaxf(q[2], q[3]));
            bf16_t* rp = rp0 + (size_t)(ai * 128 + m * 16) * 1024; float ps = 0.f;
            _Pragma("unroll") for (int bj = 0; bj < 2; ++bj) { f32x4 p[2];
                _Pragma("unroll") for (int n = 0; n < 2; ++n) _Pragma("unroll") for (int i = 0; i < 4; ++i) { p[n][i] = __builtin_amdgcn_exp2f(acc[ai][bj][m][n][i] - mr); ps += p[n][i]; }
                st_bf8(rp + bj * 128, p[0], p[1]); }
            ps += __shfl_xor(ps, 16); ps += __shfl_xor(ps, 32);
            if (fq == 0) lp0[(ai * 128 + m * 16) * 16] = ps; }
        asm volatile("s_waitcnt lgkmcnt(0)" ::: "memory"); __builtin_amdgcn_s_barrier(); asm volatile("" ::: "memory");
    }
};
struct EpiPV {
    static constexpr bool PERM = true, AFTER_DRAIN = false;
    bf16_t* O; const float* lp;
    __device__ __forceinline__ void operator()(const f32x4 (&acc)[2][2][4][2], const Unit& u, int wr, int wc, int fr, int fq) const {
        EPI_ROWS { const int row = u.pm * 256 + ai * 128 + wr * 64 + m * 16 + fr; const f32x4 q = *(const f32x4*)(lp + (size_t)row * 16 + u.pn * 4);
            const float inv = 1.0f / ((q[0] + q[1]) + (q[2] + q[3])); bf16_t* rp = O + (size_t)row * 1024 + u.pn * 256 + wc * 32 + fq * 8;
            _Pragma("unroll") for (int bj = 0; bj < 2; ++bj) st_bf8(rp + bj * 128, acc[ai][bj][m][0] * inv, acc[ai][bj][m][1] * inv); }
    }
};

template <unsigned oKX, unsigned oWCQR, unsigned oWCOT, unsigned oVX>
struct OrderGH : OrderBase {
    int G, c; const char* ws;
    __device__ __forceinline__ bool next(int i, Unit& u) const { int L = i * G + c; if (L >= 512) return false;
        if (L < 256) { u.pm = L >> 2; u.pn = L & 3; } else { L -= 256; u.pm = L >> 2; u.pn = (L & 3) | (1 << 16); } return true; }
    __device__ __forceinline__ const char* a_base(const Gemm&, const Unit& u) const { const int job = u.pn >> 16, pn = u.pn & 0xffff;
        return job == 0 ? ws + oKX + ((size_t)(u.pm >> 2) * 256 * 1024 + (u.pm & 3) * 256) * 2 : ws + oWCOT + ((size_t)(u.pm & 3) * 256 * 1024 + pn * 256) * 2; }
    __device__ __forceinline__ const char* b_base(const Gemm&, const Unit& u) const { const int job = u.pn >> 16, pn = u.pn & 0xffff;
        return job == 0 ? ws + oWCQR + ((size_t)pn * 256 * 1024 + (u.pm & 3) * 256) * 2 : ws + oVX + ((size_t)(u.pm >> 2) * 256 * 1024 + pn * 256) * 2; }
};
struct EpiGH {
    static constexpr bool PERM = true, AFTER_DRAIN = false;
    EpiPlain gt, ht;
    __device__ __forceinline__ void operator()(const f32x4 (&acc)[2][2][4][2], const Unit& u, int wr, int wc, int fr, int fq) const {
        Unit v; v.pm = u.pm; v.pn = u.pn & 0xffff; if ((u.pn >> 16) == 0) gt(acc, v, wr, wc, fr, fq); else ht(acc, v, wr, wc, fr, fq); }
};
struct OrderXS : OrderBase {
    StaticOrder so;
    __device__ void init(int G, int c) { so.nM = 128; so.nN = 4; so.nwg = 512; so.G = G; so.c = c; }
    __device__ bool next(int i, Unit& u) const { return so.next(i, u); }
    __device__ __forceinline__ const char* b_base(const Gemm& g, const Unit& u) const { return (const char*)(g.Bt + ((size_t)(u.pm >> 3) * 1024 + u.pn * 256) * 1024); }
};
struct EpiSoftmaxN {
    static constexpr bool PERM = true, AFTER_DRAIN = false;
    bf16_t* PX; const float* ssp; PG8_LAS float* xmax; PG8_LAS float* xsum;
    __device__ __forceinline__ void operator()(f32x4 (&acc)[2][2][4][2], const Unit& u, int wr, int wc, int fr, int fq) const {
        PG8_LAS char* rb = (PG8_LAS char*)xmax + (wr * 64 + fr) * 16; asm volatile("" : "+v"(rb));
        PG8_LAS char* wb = rb + wc * 4; asm volatile("" : "+v"(wb));
        PG8_LAS char* rb2 = (PG8_LAS char*)xsum + (wr * 64 + fr) * 16; asm volatile("" : "+v"(rb2));
        PG8_LAS char* wb2 = rb2 + wc * 4; asm volatile("" : "+v"(wb2));
        const int row0 = u.pm * 256 + wr * 64 + fr;
        EPI_ROWS { const f32x4* sp = (const f32x4*)(ssp + (size_t)(row0 + ai * 128 + m * 16) * 16);
            const f32x4 a4 = sp[0], b4 = sp[1], c4 = sp[2], d4 = sp[3]; const float ss = ((a4[0] + a4[1]) + (a4[2] + a4[3])) + ((b4[0] + b4[1]) + (b4[2] + b4[3])) + ((c4[0] + c4[1]) + (c4[2] + c4[3])) + ((d4[0] + d4[1]) + (d4[2] + d4[3]));
            const float rs = rsqrtf(ss * (1.0f / 1024.0f) + 1e-6f) * QSCALE_X; float a = -INFINITY;
            EPI_COLS { f32x4 v = acc[ai][bj][m][n] * rs; acc[ai][bj][m][n] = v; a = fmaxf(a, fmaxf(fmaxf(v[0], v[1]), fmaxf(v[2], v[3]))); }
            a = fmaxf(a, __shfl_xor(a, 16)); a = fmaxf(a, __shfl_xor(a, 32));
            if (fq == 0) *(PG8_LAS float*)(wb + (ai * 128 + m * 16) * 16) = a; }
        asm volatile("s_waitcnt lgkmcnt(0)" ::: "memory"); __builtin_amdgcn_s_barrier(); asm volatile("" ::: "memory");
        EPI_ROWS { const f32x4 q = *(const PG8_LAS f32x4*)(rb + (ai * 128 + m * 16) * 16); const float mr = fmaxf(fmaxf(q[0], q[1]), fmaxf(q[2], q[3])); float ps = 0.f;
            EPI_COLS { f32x4 p; _Pragma("unroll") for (int i = 0; i < 4; ++i) { p[i] = __builtin_amdgcn_exp2f(acc[ai][bj][m][n][i] - mr); ps += p[i]; } acc[ai][bj][m][n] = p; }
            ps += __shfl_xor(ps, 16); ps += __shfl_xor(ps, 32);
            if (fq == 0) *(PG8_LAS float*)(wb2 + (ai * 128 + m * 16) * 16) = ps; }
        asm volatile("s_waitcnt lgkmcnt(0)" ::: "memory"); __builtin_amdgcn_s_barrier(); asm volatile("" ::: "memory");
        bf16_t* rp0 = PX + (size_t)row0 * 1024 + u.pn * 256 + wc * 32 + fq * 8;
        EPI_ROWS { const f32x4 q = *(const PG8_LAS f32x4*)(rb2 + (ai * 128 + m * 16) * 16); const float inv = __builtin_amdgcn_rcpf((q[0] + q[1]) + (q[2] + q[3]));
            bf16_t* rp = rp0 + (size_t)(ai * 128 + m * 16) * 1024;
            _Pragma("unroll") for (int bj = 0; bj < 2; ++bj) st_bf8(rp + bj * 128, acc[ai][bj][m][0] * inv, acc[ai][bj][m][1] * inv); }
    }
};
struct OrderXO : OrderBase {
    StaticOrder so;
    __device__ void init(int G, int c) { so.nM = 128; so.nN = 4; so.nwg = 512; so.G = G; so.c = c; }
    __device__ bool next(int i, Unit& u) const { return so.next(i, u); }
    __device__ __forceinline__ const char* b_base(const Gemm& g, const Unit& u) const { return (const char*)(g.Bt + ((size_t)(u.pm >> 3) * 1024 + u.pn * 256) * 1024); }
};
typedef int v4i_t __attribute__((ext_vector_type(4))); typedef int v8i_t __attribute__((ext_vector_type(8)));
__device__ __forceinline__ v8i_t cat8(bf16x8 lo, bf16x8 hi) { return __builtin_shufflevector(__builtin_bit_cast(v4i_t, lo), __builtin_bit_cast(v4i_t, hi), 0, 1, 2, 3, 4, 5, 6, 7); }
__device__ __forceinline__ void mfma8(f32x4& acc, v8i_t w, v8i_t a, int sw, int sa) {
    asm volatile("s_nop 1\n\tv_mfma_scale_f32_16x16x128_f8f6f4 %0, %1, %2, %0, %3, %4 op_sel_hi:[0,0,0]" : "+v"(acc) : "v"(w), "v"(a), "v"(sw), "v"(sa)); }
constexpr int PF_D = 4, PF_LDS = 137216;
template <class Epi, class Sched, bool ALIGN_EPI = false, bool SP2 = false, bool FP8 = false, bool PF = false, int DBG = 0>
__device__ __forceinline__ void gemm_phase(PG8_LAS unsigned char* lds, const Gemm g, const Sched& S, const Epi& E) {
    const int tid = threadIdx.x, wid = __builtin_amdgcn_readfirstlane(tid >> 6), lane = tid & 63, wr = wid >> 2, wc = wid & 3, fr = lane & 15, fq = lane >> 4;
    const int K = g.K, nt = K / BK;
    unsigned voffA[2], voffB[2];
    unsigned gC[2][2];
#pragma unroll
    for (int i = 0; i < 2; ++i) { int R, C; stage_rc(tid * 16 + i * 8192, R, C); const int Rb = Epi::PERM ? ((R & ~31) + perm32(R & 31)) : R;
        voffA[i] = (unsigned)(R * g.lda + C) * 2u; voffB[i] = (unsigned)(Rb * g.ldb + C) * 2u; }
    const bool pfA = !Sched::GATHER && wid < 4;
    const unsigned pfoff = (unsigned)((((wid >> 1) & 1) * HALF + (wid & 1) * 64 + lane) * (pfA ? g.lda : g.ldb)) * 2u;
    const size_t kstep = (size_t)(BK * 2);
    const size_t hstepA = (size_t)HALF * g.lda * 2, hstepB = (size_t)HALF * g.ldb * 2;
    const unsigned ldsw = (unsigned)wid * 1024u;
    const int aoff = lds_byte(wr * 64 + fr, fq * 8), boff = lds_byte(wc * 32 + fr, fq * 8);
#define PG8_SA(b, h) (((b) * 2 + (h)) * HTB)
#define PG8_SB(b, h) ((4 + (b) * 2 + (h)) * HTB)
#define PG8_STAGE(bufoff, gbase, voff) do { if constexpr ((DBG & 2) == 0) _Pragma("unroll") for (int _i = 0; _i < 2; ++_i) \
        __builtin_amdgcn_global_load_lds((const unsigned*)((const char*)(gbase) + (voff)[_i]), (PG8_LAS unsigned*)(lds + (bufoff) + ldsw + _i * 8192), 16, 0, 0); } while (0)
#define PG8_STAGE_A(bufoff, ptr, h, nx) do { if constexpr (Sched::GATHER) { PG8_STAGE(bufoff, ptr, gC[h]); } else { PG8_STAGE(bufoff, (ptr) + ((h) ? hstepA : 0), voffA); } } while (0)
#define PG8_LDA(dst, b, h) do { if constexpr ((DBG & 8) == 0) _Pragma("unroll") for (int m = 0; m < 4; ++m) _Pragma("unroll") for (int k = 0; k < 2; ++k) dst[m][k] = *(const PG8_LAS bf16x8*)(lds + PG8_SA(b, h) + aoff + m * 2048 + k * 1024); } while (0)
#define PG8_LDB(dst, b, h) do { if constexpr ((DBG & 8) == 0) _Pragma("unroll") for (int n = 0; n < 2; ++n) _Pragma("unroll") for (int k = 0; k < 2; ++k) dst[n][k] = *(const PG8_LAS bf16x8*)(lds + PG8_SB(b, h) + boff + n * 2048 + k * 1024); } while (0)
#define PG8_MMA(ai, bj, At, Bt) do { if constexpr ((DBG & 1) == 0) { __builtin_amdgcn_s_setprio(1); \
        if constexpr (FP8) { _Pragma("unroll") for (int m = 0; m < 4; ++m) _Pragma("unroll") for (int n = 0; n < 2; ++n) \
            mfma8(acc[ai][bj][m][n], cat8(Bt[n][0], Bt[n][1]), cat8(At[m][0], At[m][1]), g.sb, g.sa); } \
        else { _Pragma("unroll") for (int m = 0; m < 4; ++m) _Pragma("unroll") for (int n = 0; n < 2; ++n) _Pragma("unroll") for (int k = 0; k < 2; ++k) \
            acc[ai][bj][m][n] = __builtin_amdgcn_mfma_f32_16x16x32_bf16(Bt[n][k], At[m][k], acc[ai][bj][m][n], 0, 0, 0); } \
        __builtin_amdgcn_s_setprio(0); } } while (0)
#define PG8_WAIT_V(n) asm volatile("s_waitcnt vmcnt(" #n ")" ::: "memory")
#define PG8_WAIT_VP() do { if constexpr (PF) asm volatile("s_waitcnt vmcnt(9)" ::: "memory"); else asm volatile("s_waitcnt vmcnt(8)" ::: "memory"); } while (0)
#define PG8_PREFETCH(tp) do { if constexpr (PF) { const int tp_ = (tp); const char* pb_ = tp_ < nt ? (pfA ? cA : cB) + (size_t)tp_ * kstep : (pfA ? nA : nB) + (size_t)(tp_ - nt) * kstep; \
        __builtin_amdgcn_global_load_lds((const unsigned*)(pb_ + pfoff), (PG8_LAS unsigned*)(lds + PF_LDS + wid * 256), 4, 0, 0); } } while (0)
#define PG8_WAIT_L(n) asm volatile("s_waitcnt lgkmcnt(" #n ")" ::: "memory")
#define PG8_BAR __builtin_amdgcn_s_barrier()
#define PG8_SCHED __builtin_amdgcn_sched_barrier(0)
    Unit cur, nxt; int ui = 0;
    if (!S.next(0, cur)) return;
    f32x4 acc[2][2][4][2];
#pragma unroll
    for (int a = 0; a < 2; ++a)
#pragma unroll
        for (int b = 0; b < 2; ++b)
#pragma unroll
            for (int m = 0; m < 4; ++m)
#pragma unroll
                for (int n = 0; n < 2; ++n) acc[a][b][m][n] = (f32x4){0.f, 0.f, 0.f, 0.f};
    bf16x8 At[4][2], B0[2][2], B1[2][2];
    const char* cA = S.a_base(g, cur); const char* cB = S.b_base(g, cur);
    if constexpr (Sched::GATHER) { const unsigned* rp = S.rows(cur); const int nv = S.nvalid(cur);
#pragma unroll
        for (int h = 0; h < 2; ++h)
#pragma unroll
            for (int i = 0; i < 2; ++i) { int R, C; stage_rc(tid * 16 + i * 8192, R, C); const int r = h * HALF + R; const unsigned tok = r < nv ? rp[r] : 0u; gC[h][i] = tok * (unsigned)(g.lda * 2) + (unsigned)C * 2u; } }
    S.a_ready(cur);
    if constexpr (SP2) {
        PG8_STAGE(PG8_SB(0, 0), cB, voffB); PG8_STAGE(PG8_SB(0, 1), cB + hstepB, voffB); PG8_STAGE_A(PG8_SA(0, 0), cA, 0, 0); PG8_STAGE_A(PG8_SA(0, 1), cA, 1, 0);
        if (wr == 1) PG8_BAR;
        PG8_WAIT_V(2); PG8_BAR;
        PG8_STAGE(PG8_SB(1, 0), cB + kstep, voffB); PG8_STAGE_A(PG8_SA(1, 0), cA + kstep, 0, 0); PG8_STAGE(PG8_SB(1, 1), cB + hstepB + kstep, voffB);
        PG8_WAIT_V(6); PG8_BAR;
    } else {
        PG8_STAGE(PG8_SB(0, 0), cB, voffB); PG8_STAGE_A(PG8_SA(0, 0), cA, 0, 0); PG8_STAGE(PG8_SB(0, 1), cB + hstepB, voffB); PG8_STAGE_A(PG8_SA(0, 1), cA, 1, 0);
        if (wr == 1) PG8_BAR;
        PG8_WAIT_V(4); PG8_BAR;
        PG8_STAGE(PG8_SB(1, 0), cB + kstep, voffB); PG8_STAGE_A(PG8_SA(1, 0), cA + kstep, 0, 0); PG8_STAGE(PG8_SB(1, 1), cB + hstepB + kstep, voffB);
        PG8_WAIT_V(6); PG8_BAR;
    }
    for (;;) {
        const bool has_next = S.next(ui + 1, nxt);
        const char* nA = has_next ? S.a_base(g, nxt) : cA; const char* nB = has_next ? S.b_base(g, nxt) : cB;
        if constexpr (Sched::GATHER) { if (has_next && wid < 4)
            __builtin_amdgcn_global_load_lds((const unsigned*)(S.rows(nxt) + wid * 64 + lane), (PG8_LAS unsigned*)(S.gslot + ((ui + 1) & 1) * 256 + wid * 64), 4, 0, 0); }
#pragma nounroll
        for (int t = 0; t < nt; t += 2) {
            const bool last = (t == nt - 2);
            const char* a1 = cA + (size_t)(t + 1) * kstep;
            const char* a2 = last ? nA : cA + (size_t)(t + 2) * kstep; const char* b2 = last ? nB : cB + (size_t)(t + 2) * kstep;
            const char* a3 = a2 + kstep; const char* b3 = b2 + kstep;
            if (last && has_next) S.a_ready(nxt);
            if constexpr (SP2) {
            PG8_LDB(B0, 0, 0); PG8_LDB(B1, 0, 1); PG8_SCHED; PG8_LDA(At, 0, 0); PG8_STAGE_A(PG8_SA(1, 1), a1, 1, 0);
            if constexpr (Sched::GATHER) { if (last && has_next) {
                const PG8_LAS unsigned* sl = S.gslot + ((ui + 1) & 1) * 256; const int nv = S.nvalid(nxt);
#pragma unroll
                for (int h = 0; h < 2; ++h)
#pragma unroll
                    for (int i = 0; i < 2; ++i) { int R, C; stage_rc(tid * 16 + i * 8192, R, C); const int r = h * HALF + R; const unsigned v = sl[r]; const unsigned tok = r < nv ? v : 0u; gC[h][i] = tok * (unsigned)(g.lda * 2) + (unsigned)C * 2u; } } }
            PG8_WAIT_VP(); PG8_WAIT_L(0); PG8_BAR; PG8_MMA(0, 0, At, B0); PG8_MMA(0, 1, At, B1); PG8_BAR; PG8_SCHED;
            PG8_LDA(At, 0, 1); PG8_STAGE(PG8_SB(0, 0), b2, voffB); PG8_STAGE(PG8_SB(0, 1), b2 + hstepB, voffB); PG8_STAGE_A(PG8_SA(0, 0), a2, 0, 1); PG8_PREFETCH(t + PF_D);
            PG8_WAIT_VP(); PG8_WAIT_L(0); PG8_BAR; PG8_MMA(1, 0, At, B0); PG8_MMA(1, 1, At, B1); PG8_BAR; PG8_SCHED;
            PG8_LDB(B0, 1, 0); PG8_LDB(B1, 1, 1); PG8_SCHED; PG8_LDA(At, 1, 0); PG8_STAGE_A(PG8_SA(0, 1), a2, 1, 1);
            PG8_WAIT_VP(); PG8_WAIT_L(0); PG8_BAR; PG8_MMA(0, 0, At, B0); PG8_MMA(0, 1, At, B1); PG8_BAR; PG8_SCHED;
            PG8_LDA(At, 1, 1); PG8_STAGE(PG8_SB(1, 0), b3, voffB); PG8_STAGE(PG8_SB(1, 1), b3 + hstepB, voffB); PG8_STAGE_A(PG8_SA(1, 0), a3, 0, 1); PG8_PREFETCH(t + 1 + PF_D);
            PG8_WAIT_VP(); PG8_WAIT_L(0); PG8_BAR; PG8_MMA(1, 0, At, B0); PG8_MMA(1, 1, At, B1); PG8_BAR; PG8_SCHED;
            } else {
            PG8_LDB(B0, 0, 0); PG8_SCHED; PG8_LDA(At, 0, 0); PG8_STAGE_A(PG8_SA(1, 1), a1, 1, 0);
            PG8_WAIT_L(8); PG8_BAR; PG8_WAIT_L(0); PG8_MMA(0, 0, At, B0); PG8_BAR; PG8_SCHED;
            PG8_LDB(B1, 0, 1); PG8_STAGE(PG8_SB(0, 0), b2, voffB);
            PG8_BAR; PG8_WAIT_L(0); PG8_MMA(0, 1, At, B1); PG8_BAR;
            PG8_LDA(At, 0, 1); PG8_STAGE_A(PG8_SA(0, 0), a2, 0, 1);
            PG8_BAR; PG8_WAIT_L(0); PG8_MMA(1, 0, At, B0); PG8_BAR; PG8_SCHED;
            PG8_STAGE(PG8_SB(0, 1), b2 + hstepB, voffB);
            PG8_WAIT_V(6); PG8_BAR; PG8_MMA(1, 1, At, B1); PG8_BAR;
            PG8_LDB(B0, 1, 0); PG8_SCHED; PG8_LDA(At, 1, 0); PG8_STAGE_A(PG8_SA(0, 1), a2, 1, 1);
            PG8_WAIT_L(8); PG8_BAR; PG8_WAIT_L(0); PG8_MMA(0, 0, At, B0); PG8_BAR; PG8_SCHED;
            PG8_LDB(B1, 1, 1); PG8_STAGE(PG8_SB(1, 0), b3, voffB);
            PG8_BAR; PG8_WAIT_L(0); PG8_MMA(0, 1, At, B1); PG8_BAR;
            PG8_LDA(At, 1, 1); PG8_STAGE_A(PG8_SA(1, 0), a3, 0, 1);
            PG8_BAR; PG8_WAIT_L(0); PG8_MMA(1, 0, At, B0); PG8_BAR; PG8_SCHED;
            PG8_STAGE(PG8_SB(1, 1), b3 + hstepB, voffB);
            PG8_WAIT_V(6); PG8_BAR; PG8_MMA(1, 1, At, B1); PG8_BAR;
            }
        }
        if constexpr (ALIGN_EPI) { if (wr == 0) PG8_BAR; }
        if constexpr (FP8) asm volatile("s_nop 15\n\ts_nop 15" ::: "memory");
        if constexpr (!Epi::AFTER_DRAIN && (DBG & 4) == 0) { E(acc, cur, wr, wc, fr, fq); S.done(cur); }
        if (!has_next) break;
#pragma unroll
        for (int a = 0; a < 2; ++a)
#pragma unroll
            for (int b = 0; b < 2; ++b)
#pragma unroll
                for (int m = 0; m < 4; ++m)
#pragma unroll
                    for (int n = 0; n < 2; ++n) acc[a][b][m][n] = (f32x4){0.f, 0.f, 0.f, 0.f};
        cur = nxt; cA = nA; cB = nB; ++ui;
        if constexpr (ALIGN_EPI) { if (wr == 1) PG8_BAR; }
    }
    PG8_WAIT_V(0);
    if constexpr (!ALIGN_EPI) { if (wr == 0) PG8_BAR; }
    PG8_BAR;
    if constexpr (Epi::AFTER_DRAIN) { E.fused(acc, cur, wr, wc, fr, fq, lds, wid, lane); S.done(cur); }
#undef PG8_SA
#undef PG8_SB
#undef PG8_STAGE
#undef PG8_STAGE_A
#undef PG8_LDA
#undef PG8_LDB
#undef PG8_MMA
#undef PG8_WAIT_V
#undef PG8_WAIT_VP
#undef PG8_PREFETCH
#undef PG8_WAIT_L
#undef PG8_BAR
#undef PG8_SCHED
}
}
constexpr int NTOK = 32768, DM = 1024, SEQ = 2048, NBATCH = 16, MEMLEN = 256, NMEM = NBATCH * MEMLEN, INW = 3088, NEXP = 32, TOPK = 4;
constexpr int PW = 3072;
constexpr int MAXTILES = 544;
constexpr float EPS = 1e-6f;
constexpr int NWAVES = 8;
constexpr size_t MiB = 1u << 20;
constexpr size_t WS_CTL = 0, CTL_ZERO_BYTES = 64 * 1024;
constexpr size_t WS_WINT = 2 * MiB, WS_WOUT = 10 * MiB, WS_WCQ = 12 * MiB, WS_WCK = 14 * MiB, WS_WCV = 16 * MiB, WS_WCO = 18 * MiB;
constexpr size_t WS_WR = 20 * MiB, WS_CS = 21 * MiB, WS_SSP1 = 24 * MiB, WS_GATE = 27 * MiB, WS_ASSIGN = 28 * MiB, WS_LIST = 29 * MiB;
constexpr size_t WS_RSL = 842 * MiB;
constexpr size_t WS_X2B = 378 * MiB;
constexpr size_t WS_WUP = 34 * MiB, WS_WDN = 162 * MiB, WS_KX = 226 * MiB, WS_VXT = 234 * MiB;
constexpr size_t WS_HN = 242 * MiB, WS_CAT = 242 * MiB, WS_MN = 306 * MiB, WS_P = 314 * MiB, WS_LA = 506 * MiB, WS_VT = 538 * MiB;
constexpr size_t WS_X1B = 314 * MiB, WS_GT = 378 * MiB, WS_HT = 410 * MiB, WS_PX = 506 * MiB;
constexpr size_t WS_GVT = 602 * MiB;
constexpr size_t WS_ACT = 570 * MiB, WS_Y = 706 * MiB, WS_END = 846 * MiB;
constexpr int CW_Q2 = 128;
constexpr int CW_CNT = 1024;
constexpr int CW_PROBE = 192;
constexpr int CW_BAR = 4096;
constexpr int RING_OFF = 0, RING_BYTES = 131072;
constexpr int LDSCTL_OFF = RING_BYTES, MISC_OFF = LDSCTL_OFF + 320;
constexpr int TAB_OFF = LDSCTL_OFF + 512;
constexpr int TAB_TSTART = TAB_OFF + 576, TAB_CNT = TAB_TSTART + 144;
constexpr int XCH2_OFF = LDSCTL_OFF + 6144;
constexpr int XCH_OFF = LDSCTL_OFF + 2048;
constexpr int TS_OFF = TAB_CNT + 128;
constexpr int LDS_BYTES = 147456;

#define GAS __attribute__((address_space(1)))
#define LAS __attribute__((address_space(3)))
typedef unsigned short bf16;
typedef unsigned v4u __attribute__((ext_vector_type(4)));
typedef float f32x4 __attribute__((ext_vector_type(4)));
typedef short bf16x8 __attribute__((ext_vector_type(8)));
typedef GAS unsigned gu32;
typedef GAS unsigned long long gu64;
#define RLX_AGENT __ATOMIC_RELAXED, __HIP_MEMORY_SCOPE_AGENT
#define LDS_WAIT() asm volatile("s_waitcnt lgkmcnt(0)" ::: "memory")
#define VM_WAIT() asm volatile("s_waitcnt vmcnt(0)" ::: "memory")
__device__ __forceinline__ unsigned long long rt() { return __builtin_amdgcn_s_memrealtime(); }
__device__ __forceinline__ unsigned f2bf(float f) { unsigned u = __builtin_bit_cast(unsigned, f); return (u + 0x7fffu + ((u >> 16) & 1u)) >> 16; }
__device__ __forceinline__ unsigned pk2(float lo, float hi) { return f2bf(lo) | (f2bf(hi) << 16); }

#define XB_TMO      128
#define XB_XCNT(j)  (256  + 64 * (j))
#define XB_XSUB(j)  (1280 + 64 * (j))
#define XB_XGEN(j)  (2304 + 64 * (j))
#define XB_TOP      3328
#define XB_TOPGEN   3392
#define XCD_BAR_WORDS 3456
#define XB_SPIN_CAP (1u << 18)

__device__ __forceinline__ unsigned xb_ld(unsigned* p)              { return __hip_atomic_load(p, __ATOMIC_RELAXED, __HIP_MEMORY_SCOPE_AGENT); }
__device__ __forceinline__ unsigned xb_add(unsigned* p, unsigned v) { return __hip_atomic_fetch_add(p, v, __ATOMIC_RELAXED, __HIP_MEMORY_SCOPE_AGENT); }
__device__ __forceinline__ unsigned xb_xcc_id() { return (unsigned)__builtin_amdgcn_s_getreg((3 << 11) | 20) & 0xFu; }
#define XB_SPIN(cond, bar) do { unsigned _sp = 0; while (cond) { __builtin_amdgcn_s_sleep(1); \
    if ((++_sp & 255u) == 0u) { if (xb_ld(&(bar)[XB_TMO])) break; if (_sp > XB_SPIN_CAP) { atomicAdd(&(bar)[XB_TMO], 1u); break; } } } } while (0)

struct XcdBarrier {
    unsigned* bar; unsigned x;
    volatile LAS unsigned* st;
};

__device__ __forceinline__ XcdBarrier xcd_barrier_post(unsigned* bar, volatile LAS unsigned* st) {
    XcdBarrier b; b.bar = bar; b.x = xb_xcc_id(); b.st = st;
    if (threadIdx.x == 0) (void)xb_add(&bar[XB_XCNT(b.x)], 1u);
    return b;
}
__device__ __forceinline__ void xcd_barrier_complete(unsigned* bar, unsigned x, unsigned& nloc, unsigned& nx) {
    const unsigned G = gridDim.x * gridDim.y * gridDim.z;
    unsigned sum, cnt, mine, sp = 0u;
    for (;;) {
        sum = 0u; cnt = 0u; mine = 0u;
#pragma unroll
        for (unsigned j = 0; j < 16; ++j) { const unsigned c = xb_ld(&bar[XB_XCNT(j)]); sum += c; cnt += (c > 0u) ? 1u : 0u; mine = (j == x) ? c : mine; }
        if (sum == G) break;
        __builtin_amdgcn_s_sleep(1);
        if ((++sp & 255u) == 0u) { if (xb_ld(&bar[XB_TMO])) break; if (sp > XB_SPIN_CAP) { atomicAdd(&bar[XB_TMO], 1u); break; } }
    }
    nloc = mine > 0u ? mine : 1u; nx = cnt > 0u ? cnt : 1u;
}

__device__ __forceinline__ void xcd_barrier(const XcdBarrier& b) {
    asm volatile("s_waitcnt vmcnt(0)" ::: "memory");
    __syncthreads();
    if (threadIdx.x == 0) {
        unsigned* bar = b.bar;
        __builtin_amdgcn_s_waitcnt(0);
        unsigned nloc = b.st[0], nx = b.st[1];
        if (nloc == 0u) { xcd_barrier_complete(bar, b.x, nloc, nx); b.st[0] = nloc; b.st[1] = nx; }
        const unsigned old = xb_add(&bar[XB_XSUB(b.x)], 1u);
        const unsigned gen = old / nloc;
        if (old + 1u == (gen + 1u) * nloc) {
            __builtin_amdgcn_fence(__ATOMIC_RELEASE, "agent");
            asm volatile("s_waitcnt vmcnt(0)" ::: "memory");
            const unsigned og = xb_add(&bar[XB_TOP], 1u);
            const unsigned tg = og / nx;
            if (og + 1u == (tg + 1u) * nx) xb_add(&bar[XB_TOPGEN], 1u);
            else XB_SPIN(xb_ld(&bar[XB_TOPGEN]) == tg, bar);
            __builtin_amdgcn_fence(__ATOMIC_ACQUIRE, "agent");
            xb_add(&bar[XB_XGEN(b.x)], 1u);
            asm volatile("s_waitcnt vmcnt(0)" ::: "memory");
        } else {
            XB_SPIN(xb_ld(&bar[XB_XGEN(b.x)]) == gen, bar);
            __builtin_amdgcn_fence(__ATOMIC_ACQUIRE, "agent");
            asm volatile("s_waitcnt vmcnt(0)" ::: "memory");
        }
    }
    __syncthreads();
}
typedef short bf16x4 __attribute__((ext_vector_type(4)));
typedef unsigned v2u __attribute__((ext_vector_type(2)));
struct Frame {
    LAS unsigned char* lds;
    volatile LAS unsigned* MISC;
    gu32* ctl;
    int tid, lane, wave;
    int vcu, G;
    unsigned char* ws;
    float* out;
};
__device__ __forceinline__ int lane_here() { int t = (int)threadIdx.x; asm volatile("" : "+v"(t)); return t & 63; }
__device__ __forceinline__ float bf2f(bf16 b) { return __builtin_bit_cast(float, (unsigned)b << 16); }
__device__ __forceinline__ float wave_sum(float v) {
#pragma unroll
    for (int o = 1; o < 64; o <<= 1) v += __shfl_xor(v, o);
    return v;
}
__device__ __forceinline__ float xmax16(float m) { auto rr = __builtin_amdgcn_permlane16_swap(__float_as_uint(m), __float_as_uint(m), false, false); return fmaxf(__uint_as_float(rr[0]), __uint_as_float(rr[1])); }
__device__ __forceinline__ float xmax32(float m) { auto rr = __builtin_amdgcn_permlane32_swap(__float_as_uint(m), __float_as_uint(m), false, false); return fmaxf(__uint_as_float(rr[0]), __uint_as_float(rr[1])); }
__device__ __forceinline__ f32x4 mfma16(bf16x8 a, bf16x8 b, f32x4 c) { return __builtin_amdgcn_mfma_f32_16x16x32_bf16(a, b, c, 0, 0, 0); }

__device__ __forceinline__ void p0_transpose_item(const float* W, int ldw, const float* gain, bf16* WT, int K, int k0, int n0, size_t orow0, int lane) {
    const int n4 = lane & 15, kq = lane >> 4;
    const float* src = W + (size_t)(k0 + 16 * kq) * ldw + n0 + 4 * n4;
    f32x4 v[16];
#pragma unroll
    for (int i = 0; i < 16; ++i) v[i] = *(const f32x4*)(src + (size_t)i * ldw);
    if (gain) { const f32x4* gp = (const f32x4*)(gain + k0 + 16 * kq);
#pragma unroll
        for (int q = 0; q < 4; ++q) { const f32x4 gq = gp[q];
#pragma unroll
            for (int r = 0; r < 4; ++r) v[4 * q + r] = v[4 * q + r] * gq[r]; } }
    bf16* dst = WT + (orow0 + 4 * n4) * (size_t)K + k0 + 16 * kq;
#pragma unroll
    for (int j = 0; j < 4; ++j) { v4u o0, o1;
        o0.x = pg8::cvtpk(v[0][j], v[1][j]); o0.y = pg8::cvtpk(v[2][j], v[3][j]); o0.z = pg8::cvtpk(v[4][j], v[5][j]); o0.w = pg8::cvtpk(v[6][j], v[7][j]);
        o1.x = pg8::cvtpk(v[8][j], v[9][j]); o1.y = pg8::cvtpk(v[10][j], v[11][j]); o1.z = pg8::cvtpk(v[12][j], v[13][j]); o1.w = pg8::cvtpk(v[14][j], v[15][j]);
        *(v4u*)(dst + (size_t)j * K) = o0; *(v4u*)(dst + (size_t)j * K + 8) = o1; }
}
__device__ __forceinline__ void p0_transpose_item8(const float* W, int ldw, const float* gain, unsigned char* WT, int K, int k0, int n0, size_t orow0, int lane) {
    const int n4 = lane & 15, kq = lane >> 4;
    const float* src = W + (size_t)(k0 + 16 * kq) * ldw + n0 + 4 * n4;
    f32x4 v[16];
#pragma unroll
    for (int i = 0; i < 16; ++i) v[i] = *(const f32x4*)(src + (size_t)i * ldw);
    { const f32x4* gp = (const f32x4*)(gain + k0 + 16 * kq);
#pragma unroll
        for (int q = 0; q < 4; ++q) { f32x4 gq = {32.f, 32.f, 32.f, 32.f}; if (gain) gq = gp[q] * 32.0f;
#pragma unroll
            for (int r = 0; r < 4; ++r) v[4 * q + r] = v[4 * q + r] * gq[r]; } }
    unsigned char* dst = WT + (orow0 + 4 * n4) * (size_t)K + k0 + 16 * kq;
#pragma unroll
    for (int j = 0; j < 4; ++j) { v4u o;
        o.x = pg8::cvt4_fp8((f32x4){v[0][j], v[1][j], v[2][j], v[3][j]}); o.y = pg8::cvt4_fp8((f32x4){v[4][j], v[5][j], v[6][j], v[7][j]});
        o.z = pg8::cvt4_fp8((f32x4){v[8][j], v[9][j], v[10][j], v[11][j]}); o.w = pg8::cvt4_fp8((f32x4){v[12][j], v[13][j], v[14][j], v[15][j]});
        *(v4u*)(dst + (size_t)j * K) = o; }
}
template <int NR> __device__ __forceinline__ void rms_rows_to_bf16(const float* const (&xrow)[NR], const float* g, bf16* const (&orow)[NR], int lane) {
    f32x4 v[NR][4]; float s[NR];
#pragma unroll
    for (int r = 0; r < NR; ++r) { const f32x4* xr = (const f32x4*)xrow[r] + lane;
#pragma unroll
        for (int j = 0; j < 4; ++j) v[r][j] = xr[64 * j]; }
    const f32x4* gr = (const f32x4*)g + lane; f32x4 gg[4];
#pragma unroll
    for (int j = 0; j < 4; ++j) gg[j] = gr[64 * j];
#pragma unroll
    for (int r = 0; r < NR; ++r) { s[r] = 0.f;
#pragma unroll
        for (int j = 0; j < 4; ++j) s[r] += (v[r][j].x * v[r][j].x + v[r][j].y * v[r][j].y) + (v[r][j].z * v[r][j].z + v[r][j].w * v[r][j].w); }
#pragma unroll
    for (int r = 0; r < NR; ++r) { const float rs = rsqrtf(wave_sum(s[r]) * (1.0f / DM) + EPS); unsigned long long* o8 = (unsigned long long*)orow[r] + lane;
#pragma unroll
        for (int j = 0; j < 4; ++j) o8[64 * j] = (unsigned long long)pk2(v[r][j].x * rs * gg[j].x, v[r][j].y * rs * gg[j].y) | ((unsigned long long)pk2(v[r][j].z * rs * gg[j].z, v[r][j].w * rs * gg[j].w) << 32); }
}
constexpr int MOE_I_UP = 32 * 16 * 32, MOE_I_DN = 32 * 16 * 16, MOE_UNITS = (MOE_I_UP + MOE_I_DN) / 64;
__device__ __forceinline__ void moe_convert_unit(int unit, const float* w_up, const float* w_down, const float* g_ffn, unsigned char* ws, int wave, int lane) {
#pragma unroll 1
    for (int j = 0; j < 8; ++j) { int r = unit * 64 + j * 8 + wave;
        if (r < MOE_I_UP) { const int e = r / (16 * 32); r -= e * (16 * 32); const int n0 = 64 * (r % 32);
            const size_t orow = (size_t)e * 2048 + ((n0 & 1023) >> 7) * 256 + (n0 >> 10) * 128 + (n0 & 127);
            p0_transpose_item8(w_up + (size_t)e * DM * 2048, 2048, g_ffn, ws + WS_WUP, DM, 64 * (r / 32), n0, orow, lane); }
        else { r -= MOE_I_UP; const int e = r / (16 * 16); r -= e * (16 * 16);
            p0_transpose_item8(w_down + (size_t)e * DM * DM, DM, nullptr, ws + WS_WDN, DM, 64 * (r / 16), 64 * (r % 16), (size_t)e * 1024 + 64 * (r % 16), lane); } }
}
struct In {
    const float *x, *mem; const int* positions; const float *norm_mix_g, *w_in, *lq1, *lk1, *lq2, *lk2, *diff_norm_g, *w_alpha2, *b_alpha, *gla_norm_g, *w_out, *norm_cross_g, *norm_mem_g,
        *w_cq, *w_ck, *w_cv, *w_co, *norm_ffn_g, *w_router, *b_router, *w_up, *b_up, *w_down, *b_down, *norm_final_g;
};
__device__ __forceinline__ void p0_prologue(Frame& F, const In& I) {
    const int gw = F.vcu * NWAVES + F.wave, NGW = F.G * NWAVES, lane = lane_here();
    unsigned char* ws = F.ws;
    constexpr int I_IN = 16 * 48, I_SQ = 16 * 16;
    constexpr int NITEMS = I_IN + 4 * I_SQ;
    for (int it = gw; it < NITEMS; it += NGW) {
        int r = it;
        if (r < I_IN) { p0_transpose_item(I.w_in, INW, nullptr, (bf16*)(ws + WS_WINT), DM, 64 * (r / 48), 64 * (r % 48), (size_t)64 * (r % 48), lane); continue; } r -= I_IN;
        { const int w = r / I_SQ; r -= w * I_SQ;
            const float* W = w == 0 ? I.w_out : w == 1 ? I.w_ck : w == 2 ? I.w_cv : I.w_co;
            bf16* WT = (bf16*)(ws + (w == 0 ? WS_WOUT : w == 1 ? WS_WCK : w == 2 ? WS_WCV : WS_WCO));
            p0_transpose_item(W, DM, nullptr, WT, DM, 64 * (r / 16), 64 * (r % 16), (size_t)64 * (r % 16), lane); }
    }
    for (int idx = F.vcu * (NWAVES * 64) + F.tid; idx < DM * DM / 4; idx += F.G * NWAVES * 64) { const f32x4 v = ((const f32x4*)I.w_cq)[idx] * I.norm_cross_g[idx >> 8];
        v2u o; o.x = pk2(v.x, v.y); o.y = pk2(v.z, v.w); ((v2u*)(ws + WS_WCQ))[idx] = o; }
#if defined(PROBE_P0)
    if (F.tid == 0) ((LAS unsigned long long*)(F.lds + TS_OFF))[13] = rt();
#endif
    const int gt = F.vcu * (NWAVES * 64) + F.tid, NGT = F.G * NWAVES * 64;
    for (int idx = gt; idx < 256 * DM; idx += NGT) { const int j = idx >> 10, k = idx & 1023; const float* wr = I.w_in + (size_t)k * INW + 3072; float s = 0.f;
#pragma unroll
        for (int r = 0; r < 16; ++r) s += wr[r] * I.w_alpha2[r * 256 + j];
        ((bf16*)(ws + WS_WINT))[(size_t)(3072 + j) * DM + k] = (bf16)f2bf(s); }
    for (int idx = gt; idx < DM * NEXP; idx += NGT) ((float*)(ws + WS_WR))[idx] = I.w_router[idx] * I.norm_ffn_g[idx >> 5];
    for (int idx = gt; idx < NTOK * 8; idx += NGT) { const int tok = idx >> 3, i = idx & 7;
        const double inv = exp(-(double)i * 0.125 * 13.122363377404328); const double ang = (double)I.positions[tok] * inv;
        const double red = ang - rint(ang * 0.15915494309189535) * 6.283185307179586; const float rf = (float)red;
        float* cs = (float*)(ws + WS_CS) + (size_t)tok * 16; cs[i] = cosf(rf); cs[8 + i] = sinf(rf); }
#if defined(PROBE_P0)
    if (F.tid == 0) ((LAS unsigned long long*)(F.lds + TS_OFF))[14] = rt();
#endif
    for (int m = gw * 4; m < NTOK; m += NGW * 4) { const float* xr[4]; bf16* orw[4];
#pragma unroll
        for (int r = 0; r < 4; ++r) { xr[r] = I.x + (size_t)(m + r) * DM; orw[r] = (bf16*)(ws + WS_HN) + (size_t)(m + r) * DM; }
        rms_rows_to_bf16<4>(xr, I.norm_mix_g, orw, lane); }
    for (int m = gw * 4; m < NMEM; m += NGW * 4) { const float* xr[4]; bf16* orw[4];
#pragma unroll
        for (int r = 0; r < 4; ++r) { xr[r] = I.mem + (size_t)(m + r) * DM; orw[r] = (bf16*)(ws + WS_MN) + (size_t)(m + r) * DM; }
        rms_rows_to_bf16<4>(xr, I.norm_mem_g, orw, lane); }
}

constexpr int DA_KBUF = 16384, DA_VBUF = 16384, DA_VOFF = 2 * DA_KBUF;
__device__ __forceinline__ void diffattn_unit(Frame& F, const bf16* P, const bf16* VT, bf16* CAT, const float* gdiff, float lam, int b, int h, int qblk) {
    const int lane = lane_here(), wave = F.wave, tid = F.tid, l15 = lane & 15, g = lane >> 4;
    LAS unsigned char* lds = F.lds + RING_OFF;
    const int q0 = qblk * 128 + wave * 16;
    const size_t tokq = (size_t)b * SEQ + q0 + l15;
    bf16x8 qf[2][2];
#pragma unroll
    for (int c = 0; c < 2; ++c)
#pragma unroll
        for (int ks = 0; ks < 2; ++ks) qf[c][ks] = *(const bf16x8*)(P + tokq * PW + h * 128 + c * 64 + ks * 32 + g * 8);
    f32x4 o[2][8];
#pragma unroll
    for (int c = 0; c < 2; ++c)
#pragma unroll
        for (int k = 0; k < 8; ++k) o[c][k] = (f32x4){0.f, 0.f, 0.f, 0.f};
    float mrun[2] = {0.f, 0.f}, lsum[2] = {0.f, 0.f};
    const int nk = q0 + 16;
    const int nt = 2 * qblk + 2;
    const int skey = tid >> 4, sch = tid & 15, vrow = tid >> 3, vpc = tid & 7;
    const bf16* ksrc = P + ((size_t)b * SEQ + skey) * PW + 512 + h * 128 + sch * 8;
    const bf16* vsrc = VT + (size_t)(h * 128 + vrow) * NTOK + (size_t)b * SEQ + vpc * 8;
    const int kdst = skey * 256 + ((sch ^ (skey & 15)) * 16);
    const int vfr = (vrow >> 1) & 7, vch = (vpc >> 2) * 4 + 2 * (vpc & 1), vhi = ((vpc & 3) >> 1) * 8;
    const int vdst0 = DA_VOFF + vrow * 128 + ((vch ^ vfr) * 16) + vhi, vdst1 = DA_VOFF + vrow * 128 + (((vch + 1) ^ vfr) * 16) + vhi;
    int koff[2][2];
#pragma unroll
    for (int c = 0; c < 2; ++c)
#pragma unroll
        for (int ks = 0; ks < 2; ++ks) koff[c][ks] = l15 * 256 + (((c * 8 + ks * 4 + g) ^ l15) * 16);
    const int voffs[2] = {DA_VOFF + l15 * 128 + ((g ^ (l15 >> 1)) * 16), DA_VOFF + l15 * 128 + (((4 + g) ^ (l15 >> 1)) * 16)};
    v4u sk0, sk1, sv0, sv1;
#define DA_LOAD(tt) do { const bf16* kp_ = ksrc + (size_t)(tt) * 64 * PW; const bf16* vp_ = vsrc + (tt) * 64; \
        sk0 = *(const v4u*)kp_; sk1 = *(const v4u*)(kp_ + (size_t)32 * PW); sv0 = *(const v4u*)vp_; sv1 = *(const v4u*)(vp_ + (size_t)64 * NTOK); } while (0)
#define DA_STORE(bb) do { LAS unsigned char* kd_ = lds + (bb) * DA_KBUF + kdst; LAS unsigned char* vd_ = lds + (bb) * DA_VBUF; \
        *(LAS v4u*)kd_ = sk0; *(LAS v4u*)(kd_ + 8192) = sk1; \
        *(LAS v2u*)(vd_ + vdst0) = (v2u){sv0.x, sv0.y}; *(LAS v2u*)(vd_ + vdst1) = (v2u){sv0.z, sv0.w}; *(LAS v2u*)(vd_ + vdst0 + 8192) = (v2u){sv1.x, sv1.y}; *(LAS v2u*)(vd_ + vdst1 + 8192) = (v2u){sv1.z, sv1.w}; } while (0)
    DA_LOAD(0); DA_STORE(0);
    __syncthreads();
    auto step = [&](const int t, const int buf) __attribute__((always_inline)) {
        if (t * 64 < nk) {
            const LAS unsigned char* kb = lds + buf * DA_KBUF; const LAS unsigned char* vb = lds + buf * DA_VBUF;
            f32x4 s[2][2][2];
#pragma unroll
            for (int sub = 0; sub < 2; ++sub)
#pragma unroll
                for (int c = 0; c < 2; ++c)
#pragma unroll
                    for (int s2 = 0; s2 < 2; ++s2) { f32x4 a = (f32x4){-mrun[c], -mrun[c], -mrun[c], -mrun[c]};
#pragma unroll
                        for (int ks = 0; ks < 2; ++ks) { const bf16x8 kf = *(const LAS bf16x8*)(kb + sub * 8192 + s2 * 4096 + koff[c][ks]); a = mfma16(kf, qf[c][ks], a); }
                        s[sub][c][s2] = a; }
            if (t * 64 + 63 > q0) {
                const int qrow = q0 + l15;
#pragma unroll
                for (int sub = 0; sub < 2; ++sub)
#pragma unroll
                    for (int c = 0; c < 2; ++c)
#pragma unroll
                        for (int s2 = 0; s2 < 2; ++s2)
#pragma unroll
                            for (int r = 0; r < 4; ++r) if (t * 64 + sub * 32 + s2 * 16 + 4 * g + r > qrow) s[sub][c][s2][r] = -INFINITY;
            }
            float dl[2]; bool grow = false;
#pragma unroll
            for (int c = 0; c < 2; ++c) { float mx = -INFINITY;
#pragma unroll
                for (int sub = 0; sub < 2; ++sub)
#pragma unroll
                    for (int s2 = 0; s2 < 2; ++s2) mx = fmaxf(mx, fmaxf(fmaxf(s[sub][c][s2][0], s[sub][c][s2][1]), fmaxf(s[sub][c][s2][2], s[sub][c][s2][3])));
                mx = xmax16(mx); mx = xmax32(mx);
                dl[c] = (t == 0 || mx > 8.0f) ? mx : 0.f; grow = grow || (dl[c] != 0.f); }
            if (__any(grow)) {
#pragma unroll
                for (int c = 0; c < 2; ++c) { const float alpha = __builtin_amdgcn_exp2f(-dl[c]); mrun[c] += dl[c]; lsum[c] *= alpha;
#pragma unroll
                    for (int k = 0; k < 8; ++k) o[c][k] = o[c][k] * alpha;
#pragma unroll
                    for (int sub = 0; sub < 2; ++sub)
#pragma unroll
                        for (int s2 = 0; s2 < 2; ++s2)
#pragma unroll
                            for (int r = 0; r < 4; ++r) s[sub][c][s2][r] -= dl[c]; }
            }
#pragma unroll
            for (int sub = 0; sub < 2; ++sub) {
                bf16x8 pb[2];
#pragma unroll
                for (int c = 0; c < 2; ++c) { float ps = 0.f;
#pragma unroll
                    for (int s2 = 0; s2 < 2; ++s2)
#pragma unroll
                        for (int r = 0; r < 4; ++r) { const float p = __builtin_amdgcn_exp2f(s[sub][c][s2][r]); s[sub][c][s2][r] = p; ps += p; }
                    lsum[c] += ps;
                    v4u w; w.x = pg8::cvtpk(s[sub][c][0][0], s[sub][c][0][1]); w.y = pg8::cvtpk(s[sub][c][0][2], s[sub][c][0][3]); w.z = pg8::cvtpk(s[sub][c][1][0], s[sub][c][1][1]); w.w = pg8::cvtpk(s[sub][c][1][2], s[sub][c][1][3]);
                    pb[c] = __builtin_bit_cast(bf16x8, w); }
#pragma unroll
                for (int k = 0; k < 8; ++k) { const bf16x8 vf = *(const LAS bf16x8*)(vb + voffs[sub] + k * 2048);
                    o[0][k] = mfma16(vf, pb[0], o[0][k]); o[1][k] = mfma16(vf, pb[1], o[1][k]); }
            }
        }
    };
    for (int t = 0; t < nt; ++t) {
        if (t + 1 < nt) DA_LOAD(t + 1);
        step(t, t & 1);
        if (t + 1 < nt) DA_STORE((t & 1) ^ 1);
        __syncthreads();
    }
#undef DA_LOAD
#undef DA_STORE
    float l0 = lsum[0], l1 = lsum[1];
    l0 += __shfl_xor(l0, 16); l0 += __shfl_xor(l0, 32); l1 += __shfl_xor(l1, 16); l1 += __shfl_xor(l1, 32);
    const float i0 = 1.0f / l0, i1 = lam / l1; float ss = 0.f;
#pragma unroll
    for (int k = 0; k < 8; ++k)
#pragma unroll
        for (int r = 0; r < 4; ++r) { const float v = o[0][k][r] * i0 - o[1][k][r] * i1; o[0][k][r] = v; ss += v * v; }
    ss += __shfl_xor(ss, 16); ss += __shfl_xor(ss, 32);
    const float rs = rsqrtf(ss * (1.0f / 128.0f) + EPS) * 0.8f;
    bf16* op = CAT + tokq * DM + h * 128 + 4 * g;
#pragma unroll
    for (int k = 0; k < 8; ++k) { const f32x4 gg = *(const f32x4*)(gdiff + k * 16 + 4 * g); f32x4 v = o[0][k] * rs; v = v * gg; pg8::st_bf4(op + k * 16, v); }
}

__device__ __forceinline__ bf16x8 pack8(const f32x4& a, const f32x4& b) { v4u w; w.x = pg8::cvtpk(a[0], a[1]); w.y = pg8::cvtpk(a[2], a[3]); w.z = pg8::cvtpk(b[0], b[1]); w.w = pg8::cvtpk(b[2], b[3]); return __builtin_bit_cast(bf16x8, w); }
constexpr int GL_QI = 0, GL_KI = 8192, GL_IMG = 16384, GL_EL = 2 * GL_IMG, GL_OB = GL_EL + 512, GL_OBS = 17408, GL_PS = GL_OB + 2 * GL_OBS, GL_END = GL_PS + 4096;

__device__ __forceinline__ void gla_unit(Frame& F, const bf16* P, const float* Bc, const bf16* GVT, bf16* CAT, const float* ggla, int b, int h) {
    const int lane = lane_here(), l15 = lane & 15, g = lane >> 4, eb = F.wave, tid = F.tid;
    LAS unsigned char* lds = F.lds + RING_OFF;
    const f32x4 zero4 = {0.f, 0.f, 0.f, 0.f};
    f32x4 S[4] = {zero4, zero4, zero4, zero4};
    bf16x8 If[4];
#pragma unroll
    for (int db = 0; db < 4; ++db) { const int ks = db >> 1;
#pragma unroll
        for (int j = 0; j < 8; ++j) { const int dp = 32 * ks + (j < 4 ? 4 * g + j : 16 + 4 * g + j - 4); If[db][j] = (dp == 16 * db + l15) ? (short)0x3F80 : (short)0; } }
    const int st = tid >> 3, sp = tid & 7, opc = tid & 15;
    const size_t tokb = (size_t)b * SEQ;
    const bf16* qsrc = P + (tokb + st) * PW + 1536 + h * 64 + sp * 8;
    const float* bsrc = Bc + (tokb + st) * 256 + h * 64 + sp * 8;
    const bf16* Vrow = GVT + (size_t)(h * 128 + 16 * eb + l15) * NTOK + tokb + 4 * g;
    const f32x4 gg0 = *(const f32x4*)(ggla + opc * 8), gg1 = *(const f32x4*)(ggla + opc * 8 + 4);
    const int foffs[2] = {l15 * 128 + ((g ^ (l15 >> 1)) * 16), l15 * 128 + (((4 + g) ^ (l15 >> 1)) * 16)};
    const int sfr = (st >> 1) & 7, sch0 = (sp >> 2) * 4 + 2 * (sp & 1), shi = ((sp & 3) >> 1) * 8, sd0 = st * 128 + ((sch0 ^ sfr) * 16) + shi, sd1 = st * 128 + (((sch0 + 1) ^ sfr) * 16) + shi;
    v4u rq = *(const v4u*)qsrc, rk = *(const v4u*)(qsrc + 256); f32x4 rb0 = *(const f32x4*)bsrc, rb1 = *(const f32x4*)(bsrc + 4);
#define GLA_STAGE(par) do { \
        float ee[8]; _Pragma("unroll") for (int i = 0; i < 4; ++i) { ee[i] = __expf(rb0[i]); ee[4 + i] = __expf(rb1[i]); } \
        const unsigned qa[4] = {rq.x, rq.y, rq.z, rq.w}, ka[4] = {rk.x, rk.y, rk.z, rk.w}; v4u wq, wk; unsigned* wqp = (unsigned*)&wq; unsigned* wkp = (unsigned*)&wk; \
        _Pragma("unroll") for (int i = 0; i < 4; ++i) { const float q0 = __builtin_bit_cast(float, qa[i] << 16), q1 = __builtin_bit_cast(float, qa[i] & 0xffff0000u), k0 = __builtin_bit_cast(float, ka[i] << 16), k1 = __builtin_bit_cast(float, ka[i] & 0xffff0000u); \
            wqp[i] = pg8::cvtpk(q0 * ee[2 * i], q1 * ee[2 * i + 1]); wkp[i] = pg8::cvtpk(k0 * __builtin_amdgcn_rcpf(ee[2 * i]), k1 * __builtin_amdgcn_rcpf(ee[2 * i + 1])); } \
        { LAS unsigned char* ib_ = lds + (par) * GL_IMG; *(LAS v2u*)(ib_ + GL_QI + sd0) = (v2u){wq.x, wq.y}; *(LAS v2u*)(ib_ + GL_QI + sd1) = (v2u){wq.z, wq.w}; *(LAS v2u*)(ib_ + GL_KI + sd0) = (v2u){wk.x, wk.y}; *(LAS v2u*)(ib_ + GL_KI + sd1) = (v2u){wk.z, wk.w}; } \
        if (st == 63) { *(LAS f32x4*)(lds + GL_EL + (par) * 256 + sp * 32) = (f32x4){ee[0], ee[1], ee[2], ee[3]}; *(LAS f32x4*)(lds + GL_EL + (par) * 256 + sp * 32 + 16) = (f32x4){ee[4], ee[5], ee[6], ee[7]}; } } while (0)
    bf16x8 VFn[2];
#pragma unroll
    for (int ss = 0; ss < 2; ++ss) { const bf16* vp = Vrow + 32 * ss; const v2u v0 = *(const v2u*)vp, v1 = *(const v2u*)(vp + 16); v4u vv; vv.x = v0.x; vv.y = v0.y; vv.z = v1.x; vv.w = v1.y; VFn[ss] = __builtin_bit_cast(bf16x8, vv); }
    GLA_STAGE(0);
    __syncthreads();
    for (int c = 0; c < SEQ / 64; ++c) {
        const int par = c & 1; const size_t tok0 = tokb + c * 64;
        if (c + 1 < SEQ / 64) { rq = *(const v4u*)(qsrc + (size_t)(c + 1) * 64 * PW); rk = *(const v4u*)(qsrc + (size_t)(c + 1) * 64 * PW + 256);
            rb0 = *(const f32x4*)(bsrc + (size_t)(c + 1) * 64 * 256); rb1 = *(const f32x4*)(bsrc + (size_t)(c + 1) * 64 * 256 + 4); }
        bf16x8 VF[2] = {VFn[0], VFn[1]};
        if (c + 1 < SEQ / 64) {
#pragma unroll
            for (int ss = 0; ss < 2; ++ss) { const bf16* vp = Vrow + (c + 1) * 64 + 32 * ss; const v2u v0 = *(const v2u*)vp, v1 = *(const v2u*)(vp + 16); v4u vv; vv.x = v0.x; vv.y = v0.y; vv.z = v1.x; vv.w = v1.y; VFn[ss] = __builtin_bit_cast(bf16x8, vv); } }
        v4u rg[2];
#pragma unroll
        for (int i = 0; i < 2; ++i) rg[i] = *(const v4u*)(P + (tok0 + ((tid + 512 * i) >> 4)) * PW + 2560 + h * 128 + opc * 8);
        const LAS unsigned char* qi = lds + par * GL_IMG + GL_QI; const LAS unsigned char* ki = lds + par * GL_IMG + GL_KI;
        bf16x8 qf[4][2], kf[4][2];
#pragma unroll
        for (int blk = 0; blk < 4; ++blk)
#pragma unroll
            for (int ks = 0; ks < 2; ++ks) { qf[blk][ks] = *(const LAS bf16x8*)(qi + foffs[ks] + blk * 2048); kf[blk][ks] = *(const LAS bf16x8*)(ki + foffs[ks] + blk * 2048); }
        const bf16x8 SF0 = pack8(S[0], S[1]), SF1 = pack8(S[2], S[3]);
        f32x4 O[4];
#pragma unroll
        for (int tb = 0; tb < 4; ++tb) { f32x4 o = mfma16(qf[tb][0], SF0, zero4); o = mfma16(qf[tb][1], SF1, o);
#pragma unroll
            for (int ss = 0; ss < 2; ++ss) if (2 * ss <= tb) { f32x4 a2[2];
#pragma unroll
                for (int hh = 0; hh < 2; ++hh) { const int sb = 2 * ss + hh; f32x4 a = zero4;
                    if (sb <= tb) { a = mfma16(kf[sb][0], qf[tb][0], zero4); a = mfma16(kf[sb][1], qf[tb][1], a);
                        if (sb == tb) {
#pragma unroll
                            for (int r = 0; r < 4; ++r) if (4 * g + r > l15) a[r] = 0.f; } }
                    a2[hh] = a; }
                o = mfma16(pack8(a2[0], a2[1]), VF[ss], o); }
            O[tb] = o; }
#pragma unroll
        for (int db = 0; db < 4; ++db) { f32x4 u = S[db];
#pragma unroll
            for (int ss = 0; ss < 2; ++ss) { const f32x4 t0 = mfma16(kf[2 * ss][db >> 1], If[db], zero4), t1 = mfma16(kf[2 * ss + 1][db >> 1], If[db], zero4); u = mfma16(pack8(t0, t1), VF[ss], u); }
            const f32x4 el = *(const LAS f32x4*)(lds + GL_EL + par * 256 + (16 * db + 4 * g) * 4);
            S[db] = u * el; }
        LAS unsigned char* ob = lds + GL_OB + par * GL_OBS; LAS float* ps = (LAS float*)(lds + GL_PS + par * 2048);
#pragma unroll
        for (int tb = 0; tb < 4; ++tb)
#pragma unroll
            for (int r = 0; r < 4; ++r) { const int t = 16 * tb + 4 * g + r; const float ov = O[tb][r]; float q = ov * ov; q += __shfl_xor(q, 1); q += __shfl_xor(q, 2); q += __shfl_xor(q, 4); q += __shfl_xor(q, 8);
                if (l15 == 0) ps[t * 8 + eb] = q;
                *(LAS bf16*)(ob + t * 272 + (16 * eb + l15) * 2) = (bf16)f2bf(ov); }
        if (c + 1 < SEQ / 64) GLA_STAGE(par ^ 1);
        __syncthreads();
#pragma unroll
        for (int i = 0; i < 2; ++i) { const int ot = (tid + 512 * i) >> 4; const f32x4 p0 = *(const LAS f32x4*)(ps + ot * 8), p1 = *(const LAS f32x4*)(ps + ot * 8 + 4);
            const float ss = ((p0[0] + p0[1]) + (p0[2] + p0[3])) + ((p1[0] + p1[1]) + (p1[2] + p1[3])); const float rs = rsqrtf(ss * (1.0f / 128.0f) + EPS);
            const v4u ov = *(const LAS v4u*)(ob + ot * 272 + opc * 16); const unsigned oa[4] = {ov.x, ov.y, ov.z, ov.w}, ga[4] = {rg[i].x, rg[i].y, rg[i].z, rg[i].w};
            const float gn[8] = {gg0[0], gg0[1], gg0[2], gg0[3], gg1[0], gg1[1], gg1[2], gg1[3]}; v4u w; unsigned* wp = (unsigned*)&w;
#pragma unroll
            for (int j = 0; j < 4; ++j) { const float o0 = __builtin_bit_cast(float, oa[j] << 16), o1 = __builtin_bit_cast(float, oa[j] & 0xffff0000u), g0 = __builtin_bit_cast(float, ga[j] << 16), g1 = __builtin_bit_cast(float, ga[j] & 0xffff0000u);
                wp[j] = pg8::cvtpk(o0 * rs * gn[2 * j] * g0 * __builtin_amdgcn_rcpf(1.0f + __builtin_amdgcn_exp2f(-1.4426950408889634f * g0)), o1 * rs * gn[2 * j + 1] * g1 * __builtin_amdgcn_rcpf(1.0f + __builtin_amdgcn_exp2f(-1.4426950408889634f * g1))); }
            *(v4u*)(CAT + (tok0 + ot) * DM + 512 + h * 128 + opc * 8) = w; }
    }
#undef GLA_STAGE
    __syncthreads();
}

__device__ __forceinline__ void router_phase(Frame& F, const bf16* X2, const float* WR, const float* b_router, float* rsl, float* gate, unsigned* assign, unsigned* list, gu32* cnt) {
    LAS float* xs = (LAS float*)(F.lds + RING_OFF);
    LAS float* wsh = xs + 128 * 129;
    LAS float* lg = wsh + 128 * 32;
    LAS unsigned* hist = (LAS unsigned*)(lg + 128 * 33);
    const int tid = F.tid, t = tid & 63, eg = tid >> 6;
    for (int blk = F.vcu; blk < NTOK / 128; blk += F.G) {
        const size_t tok0 = (size_t)blk * 128;
        f32x4 acc0 = (f32x4){0.f, 0.f, 0.f, 0.f}, acc1 = acc0; float ssq0 = 0.f, ssq1 = 0.f;
        v4u rx[4]; f32x4 rw[2];
#define RT_LOAD(kc) do { _Pragma("unroll") for (int i = 0; i < 4; ++i) rx[i] = *(const v4u*)(X2 + (tok0 + (tid >> 4) + 32 * i) * DM + (kc) + (tid & 15) * 8); \
        _Pragma("unroll") for (int i = 0; i < 2; ++i) rw[i] = *(const f32x4*)(WR + (size_t)(kc) * 32 + (i * 512 + tid) * 4); } while (0)
        RT_LOAD(0);
        for (int kc = 0; kc < DM; kc += 128) {
#pragma unroll
            for (int i = 0; i < 4; ++i) { LAS float* dp = xs + ((tid >> 4) + 32 * i) * 129 + (tid & 15) * 8; const unsigned wv[4] = {rx[i].x, rx[i].y, rx[i].z, rx[i].w};
#pragma unroll
                for (int j = 0; j < 4; ++j) { dp[2 * j] = __builtin_bit_cast(float, wv[j] << 16); dp[2 * j + 1] = __builtin_bit_cast(float, wv[j] & 0xffff0000u); } }
#pragma unroll
            for (int i = 0; i < 2; ++i) *(LAS f32x4*)(wsh + (i * 512 + tid) * 4) = rw[i];
            __syncthreads();
            if (kc + 128 < DM) RT_LOAD(kc + 128);
            const LAS float* xr0 = xs + t * 129; const LAS float* xr1 = xs + (t + 64) * 129;
#pragma unroll 8
            for (int k = 0; k < 128; ++k) { const float x0 = xr0[k], x1 = xr1[k]; const f32x4 w = *(const LAS f32x4*)(wsh + k * 32 + eg * 4); acc0 = acc0 + w * x0; acc1 = acc1 + w * x1; ssq0 += x0 * x0; ssq1 += x1 * x1; }
            __syncthreads();
        }
#undef RT_LOAD
        const float rs0 = rsqrtf(ssq0 * (1.0f / DM) + EPS), rs1 = rsqrtf(ssq1 * (1.0f / DM) + EPS);
#pragma unroll
        for (int i = 0; i < 4; ++i) { const float br = b_router[eg * 4 + i]; lg[t * 33 + eg * 4 + i] = acc0[i] * rs0 + br; lg[(t + 64) * 33 + eg * 4 + i] = acc1[i] * rs1 + br; }
        if (eg == 0) { lg[t * 33 + 32] = rs0; lg[(t + 64) * 33 + 32] = rs1; }
        __syncthreads();
        if (tid < 128) {
            const int w2 = tid >> 6;
            float lv[32];
#pragma unroll
            for (int e = 0; e < 32; ++e) lv[e] = lg[tid * 33 + e];
            const float rs = lg[tid * 33 + 32];
            float tv[4]; int te[4];
#pragma unroll
            for (int k = 0; k < 4; ++k) { float best = -INFINITY; int bi = 0;
#pragma unroll
                for (int e = 0; e < 32; ++e) if (lv[e] > best) { best = lv[e]; bi = e; }
                tv[k] = best; te[k] = bi;
#pragma unroll
                for (int e = 0; e < 32; ++e) if (e == bi) lv[e] = -INFINITY; }
            const float e1 = __expf(tv[1] - tv[0]), e2 = __expf(tv[2] - tv[0]), e3 = __expf(tv[3] - tv[0]); const float inv = 1.0f / (1.0f + e1 + e2 + e3);
            const float gv[4] = {inv, e1 * inv, e2 * inv, e3 * inv};
            const size_t tok = tok0 + tid;
            LAS unsigned* hs = hist + w2 * 32; LAS unsigned* gbase = hist + 64 + w2 * 32;
            if (t < 32) hs[t] = 0u;
            __builtin_amdgcn_wave_barrier(); LDS_WAIT();
            unsigned lpos[4];
#pragma unroll
            for (int k = 0; k < 4; ++k) lpos[k] = __hip_atomic_fetch_add(hs + te[k], 1u, __ATOMIC_RELAXED, __HIP_MEMORY_SCOPE_WORKGROUP);
            __builtin_amdgcn_wave_barrier(); LDS_WAIT();
            if (t < 32) { const unsigned n = hs[t]; gbase[t] = n ? __hip_atomic_fetch_add(cnt + 64 * t, n, RLX_AGENT) : 0u; }
            __builtin_amdgcn_wave_barrier(); LDS_WAIT();
#pragma unroll
            for (int k = 0; k < 4; ++k) { const unsigned pos = gbase[te[k]] + lpos[k]; list[(size_t)te[k] * NTOK + pos] = (unsigned)tok; rsl[(size_t)te[k] * NTOK + pos] = rs;
                assign[tok * 4 + k] = ((unsigned)te[k] << 16) | pos; gate[tok * 4 + k] = gv[k]; }
        }
        __syncthreads();
    }
}
__device__ __forceinline__ int moe_tables(Frame& F) {
    LAS unsigned char* tile_e = F.lds + TAB_OFF; LAS int* tstart = (LAS int*)(F.lds + TAB_TSTART); LAS int* lc = (LAS int*)(F.lds + TAB_CNT);
    if (F.tid < 32) lc[F.tid] = (int)__hip_atomic_load(F.ctl + CW_CNT + 64 * F.tid, RLX_AGENT);
    __syncthreads();
    if (F.tid == 0) { int s = 0; for (int e = 0; e < 32; ++e) { tstart[e] = s; s += (lc[e] + 255) >> 8; } tstart[32] = s; }
    __syncthreads();
    const int T = tstart[32];
    for (int i = F.tid; i < T; i += 512) { int e = 0;
#pragma unroll
        for (int k = 1; k < 32; ++k) e += (tstart[k] <= i) ? 1 : 0;
        tile_e[i] = (unsigned char)e; }
    __syncthreads();
    return T;
}
__device__ __forceinline__ void final_phase(Frame& F, const bf16* X2, float* out, const unsigned char* Y, const float* gate, const unsigned* assign, const float* gfin) {
    (void)moe_tables(F);
    const LAS int* tstart = (const LAS int*)(F.lds + TAB_TSTART);
    const int gw = F.vcu * NWAVES + F.wave, NGW = F.G * NWAVES, lane = lane_here();
    unsigned an[2][4]; float gn[2][4];
#define FIN_ROUTE(t0) do { _Pragma("unroll") for (int u = 0; u < 2; ++u) { const int tok_ = ((t0) + u * NGW < NTOK) ? (t0) + u * NGW : ((t0) < NTOK ? (t0) : gw); \
        const v4u a4 = *(const v4u*)(assign + (size_t)tok_ * 4); const f32x4 g4 = *(const f32x4*)(gate + (size_t)tok_ * 4); \
        an[u][0] = a4.x; an[u][1] = a4.y; an[u][2] = a4.z; an[u][3] = a4.w; gn[u][0] = g4.x; gn[u][1] = g4.y; gn[u][2] = g4.z; gn[u][3] = g4.w; } } while (0)
    FIN_ROUTE(gw);
    for (int tok0 = gw; tok0 < NTOK; tok0 += 2 * NGW) {
        f32x4 v[2][4]; unsigned yw[2][4][4]; float gk[2][4];
#pragma unroll
        for (int u = 0; u < 2; ++u) { const int tok = (tok0 + u * NGW < NTOK) ? tok0 + u * NGW : tok0;
#pragma unroll
            for (int k = 0; k < 4; ++k) { const unsigned a = an[u][k]; gk[u][k] = gn[u][k]; const size_t row = (size_t)tstart[a >> 16] * 256 + (a & 0xffffu);
                const unsigned* yr = (const unsigned*)(Y + row * DM) + lane;
#pragma unroll
                for (int j = 0; j < 4; ++j) yw[u][k][j] = yr[64 * j]; }
            const v2u* xin = (const v2u*)(X2 + (size_t)tok * DM) + lane;
#pragma unroll
            for (int j = 0; j < 4; ++j) { const v2u w = xin[64 * j]; v[u][j] = (f32x4){__builtin_bit_cast(float, w.x << 16), __builtin_bit_cast(float, w.x & 0xffff0000u), __builtin_bit_cast(float, w.y << 16), __builtin_bit_cast(float, w.y & 0xffff0000u)}; } }
        FIN_ROUTE(tok0 + 2 * NGW);
#pragma unroll
        for (int u = 0; u < 2; ++u) { const int tok = (tok0 + u * NGW < NTOK) ? tok0 + u * NGW : tok0;
#pragma unroll
            for (int k = 0; k < 4; ++k)
#pragma unroll
                for (int j = 0; j < 4; ++j) { const unsigned w = yw[u][k][j]; const auto lo = __builtin_amdgcn_cvt_pk_f32_fp8((int)w, false), hi = __builtin_amdgcn_cvt_pk_f32_fp8((int)w, true);
                    v[u][j].x += gk[u][k] * lo[0]; v[u][j].y += gk[u][k] * lo[1]; v[u][j].z += gk[u][k] * hi[0]; v[u][j].w += gk[u][k] * hi[1]; }
            float s = 0.f;
#pragma unroll
            for (int j = 0; j < 4; ++j) s += (v[u][j].x * v[u][j].x + v[u][j].y * v[u][j].y) + (v[u][j].z * v[u][j].z + v[u][j].w * v[u][j].w);
            const float rs = rsqrtf(wave_sum(s) * (1.0f / DM) + EPS); f32x4* xr = (f32x4*)(out + (size_t)tok * DM) + lane;
#pragma unroll
            for (int j = 0; j < 4; ++j) { const f32x4 gg = ((const f32x4*)gfin)[lane + 64 * j]; xr[64 * j] = v[u][j] * rs * gg; } }
    }
#undef FIN_ROUTE
}

constexpr int NPHASE = 10;
struct Args { const void* in[28]; float* out; unsigned char* ws; int ph_lo, ph_hi; };
__global__ void __launch_bounds__(NWAVES * 64, 2) mk_fwd(Args args) {
    extern __shared__ __attribute__((aligned(16))) unsigned char lds[];
    Frame F;
    F.lds = (LAS unsigned char*)lds;
    F.MISC = (volatile LAS unsigned*)(F.lds + MISC_OFF);
    F.tid = threadIdx.x; F.lane = F.tid & 63; F.wave = __builtin_amdgcn_readfirstlane(F.tid >> 6);
    F.G = gridDim.x; { const int bx = blockIdx.x; F.vcu = (F.G % 8 == 0) ? (bx % 8) * (F.G / 8) + bx / 8 : bx; }
    F.ws = args.ws; F.out = args.out; F.ctl = (gu32*)(args.ws + WS_CTL);
    unsigned char* ws = args.ws;
    typedef const void* const volatile __attribute__((address_space(4))) kargp_t;
    kargp_t* const kargs = (kargp_t*)__builtin_amdgcn_kernarg_segment_ptr();
#define INP(k) ((const float*)kargs[k])
    for (int u = F.tid; u < (LDS_BYTES - LDSCTL_OFF) / 4; u += NWAVES * 64) ((LAS unsigned*)(F.lds + LDSCTL_OFF))[u] = 0u;
    __syncthreads();
    const int lo = args.ph_lo, hi = args.ph_hi;
    const bool single = (hi - lo) > 1;
    XcdBarrier bar; bar.bar = (unsigned*)(F.ctl + CW_BAR); bar.x = 0; bar.st = nullptr;
    if (single) bar = xcd_barrier_post((unsigned*)(F.ctl + CW_BAR), F.MISC + 8);
#define IN(k) (lo <= (k) && (k) < hi)
#if defined(PROBE_K0)
    LAS unsigned long long* tsl = (LAS unsigned long long*)(F.lds + TS_OFF);
    if (F.tid == 0) tsl[0] = rt();
#define SEAM(k) do { if (IN(k) && IN((k) + 1)) xcd_barrier(bar); if (F.tid == 0) tsl[(k) + 1] = rt(); } while (0)
#define SEAM_LOCAL(k) do { if (F.tid == 0) tsl[(k) + 1] = rt(); } while (0)
#else
#define SEAM(k) do { if (IN(k) && IN((k) + 1)) xcd_barrier(bar); } while (0)
#define SEAM_LOCAL(k) do { } while (0)
#endif
    typedef pg8::bf16_t hb;
    const int bx = (int)blockIdx.x;

    if (IN(0)) { In I;
        I.x = (const float*)INP(0);
        I.mem = (const float*)INP(1);
        I.positions = (const int*)INP(2);
        I.norm_mix_g = (const float*)INP(3);
        I.w_in = (const float*)INP(4);
        I.lq1 = (const float*)INP(5);
        I.lk1 = (const float*)INP(6);
        I.lq2 = (const float*)INP(7);
        I.lk2 = (const float*)INP(8);
        I.diff_norm_g = (const float*)INP(9);
        I.w_alpha2 = (const float*)INP(10);
        I.b_alpha = (const float*)INP(11);
        I.gla_norm_g = (const float*)INP(12);
        I.w_out = (const float*)INP(13);
        I.norm_cross_g = (const float*)INP(14);
        I.norm_mem_g = (const float*)INP(15);
        I.w_cq = (const float*)INP(16);
        I.w_ck = (const float*)INP(17);
        I.w_cv = (const float*)INP(18);
        I.w_co = (const float*)INP(19);
        I.norm_ffn_g = (const float*)INP(20);
        I.w_router = (const float*)INP(21);
        I.b_router = (const float*)INP(22);
        I.w_up = (const float*)INP(23);
        I.b_up = (const float*)INP(24);
        I.w_down = (const float*)INP(25);
        I.b_down = (const float*)INP(26);
        I.norm_final_g = (const float*)INP(27);
        p0_prologue(F, I); }
    SEAM(0);
    if (IN(1)) {
        pg8::Gemm g{(const hb*)(ws + WS_HN), (const hb*)(ws + WS_WINT), NTOK, 3328, DM, DM, DM, 127, 127};
        typedef pg8::OrderP1<(unsigned)WS_HN, (unsigned)WS_WINT, (unsigned)WS_MN, (unsigned)WS_WCK, (unsigned)WS_WCV> OrdP1; OrdP1 S; S.G = F.G; S.c = bx; S.ws = (const char*)ws;
        pg8::EpiP1 E{pg8::EpiProj{(hb*)(ws + WS_P), (float*)(ws + WS_LA), (const float*)(ws + WS_CS), INP(11)}, pg8::EpiPlain{(hb*)(ws + WS_VT) - (size_t)1024 * NTOK, NTOK, 1.0f},
                     pg8::EpiPlain{(hb*)(ws + WS_KX), DM, 1.0f}, pg8::EpiPlain{(hb*)(ws + WS_VXT), DM, 1.0f}};
        pg8::gemm_phase<pg8::EpiP1, OrdP1, true, true, false, false>(F.lds + RING_OFF, g, S, E);
    }
    SEAM(1);
    if (IN(2)) {
        float lam;
        { const int ln = lane_here(); const float a = INP(5)[ln] * INP(6)[ln], c = INP(7)[ln] * INP(8)[ln]; lam = __expf(wave_sum(a)) - __expf(wave_sum(c)) + 0.2f; }
        LAS int* qslot = (LAS int*)(F.lds + TAB_OFF);
        for (;;) {
            if (F.tid == 0) qslot[0] = (int)__hip_atomic_fetch_add(F.ctl + CW_Q2, 1u, RLX_AGENT);
            __syncthreads();
            const int u = qslot[0];
            __syncthreads();
            if (u >= 64 + 1024 + MOE_UNITS) break;
            int au = -1;
            if (u >= 64) { const int v = u - 64, gi = v / 11, r = v - gi * 11;
                if (r >= 8) { moe_convert_unit(gi * 3 + (r - 8), INP(23), INP(25), INP(20), ws, F.wave, lane_here()); continue; }
                au = gi * 8 + r; }
#if defined(PROBE_SPLIT)
            if (u < 64) continue;
#endif
            if (u < 64) { gla_unit(F, (const bf16*)(ws + WS_P), (const float*)(ws + WS_LA), (const bf16*)(ws + WS_GVT), (bf16*)(ws + WS_CAT), INP(12), u >> 2, u & 3);
            }
            else { const int v = au, bh = v & 63, qb = 15 - (v >> 6);
                diffattn_unit(F, (const bf16*)(ws + WS_P), (const bf16*)(ws + WS_VT), (bf16*)(ws + WS_CAT), INP(9), lam, bh >> 2, bh & 3, qb); }
        }
    }
#if defined(PROBE_SPLIT)
    if (IN(2)) { xcd_barrier(bar); if (F.tid == 0) tsl[13] = rt();
        for (int u = F.vcu; u < 64; u += F.G) gla_unit(F, (const bf16*)(ws + WS_P), (const float*)(ws + WS_LA), (const bf16*)(ws + WS_GVT), (bf16*)(ws + WS_CAT), INP(12), u >> 2, u & 3); }
#endif
    SEAM(2);
    if (IN(3)) {
        { pg8::Gemm g{(const hb*)(ws + WS_CAT), (const hb*)(ws + WS_WOUT), NTOK, DM, DM, DM, DM, 127, 127}; pg8::StaticOrder S; S.init(NTOK, DM, F.G, bx);
          pg8::EpiRes1 E{INP(0), (hb*)(ws + WS_X1B), (float*)(ws + WS_SSP1)};
          pg8::gemm_phase<pg8::EpiRes1, pg8::StaticOrder, true, true, false, false>(F.lds + RING_OFF, g, S, E); }
        { pg8::Gemm g{(const hb*)(ws + WS_KX), (const hb*)(ws + WS_WCQ), 64 * 256, DM, 256, DM, DM, 127, 127};
          typedef pg8::OrderGH<(unsigned)WS_KX, (unsigned)WS_WCQ, (unsigned)WS_WCO, (unsigned)WS_VXT> OrdGH; OrdGH S; S.G = F.G; S.c = bx; S.ws = (const char*)ws;
          pg8::EpiGH E{pg8::EpiPlain{(hb*)(ws + WS_GT), DM, 1.0f}, pg8::EpiPlain{(hb*)(ws + WS_HT), DM, 1.0f}};
          pg8::gemm_phase<pg8::EpiGH, OrdGH, true, true>(F.lds + RING_OFF, g, S, E); }
    }
    SEAM(3);
    if (IN(4)) {
        pg8::Gemm g{(const hb*)(ws + WS_X1B), (const hb*)(ws + WS_GT), NTOK, 256, DM, DM, DM, 127, 127}; pg8::OrderXS S; S.init(F.G, bx);
        pg8::EpiSoftmaxN E{(hb*)(ws + WS_PX), (const float*)(ws + WS_SSP1), (PG8_LAS float*)(F.lds + XCH_OFF), (PG8_LAS float*)(F.lds + XCH2_OFF)};
        pg8::gemm_phase<pg8::EpiSoftmaxN, pg8::OrderXS, true, true>(F.lds + RING_OFF, g, S, E);
    }
    SEAM(4);
    if (IN(5)) {
        pg8::Gemm g{(const hb*)(ws + WS_PX), (const hb*)(ws + WS_HT), NTOK, DM, DM, DM, DM, 127, 127}; pg8::OrderXO S; S.init(F.G, bx);
        pg8::EpiRes2 E{(hb*)(ws + WS_X1B), ws + WS_X2B};
        pg8::gemm_phase<pg8::EpiRes2, pg8::OrderXO, true, true, false, false>(F.lds + RING_OFF, g, S, E);
    }
    SEAM(5);
    if (IN(6)) router_phase(F, (const bf16*)(ws + WS_X1B), (const float*)(ws + WS_WR), INP(22), (float*)(ws + WS_RSL), (float*)(ws + WS_GATE), (unsigned*)(ws + WS_ASSIGN), (unsigned*)(ws + WS_LIST), F.ctl + CW_CNT);
    SEAM(6);
    if (IN(7)) {
        const int T = moe_tables(F);
        pg8::Gemm g{(const hb*)(ws + WS_X2B), (const hb*)(ws + WS_WUP), T * 256, NEXP * 2048, 512, 512, 512, 127, 122}; pg8::MoeOrderG S;
        S.init(T, 8, F.G, bx, (const PG8_LAS unsigned char*)(F.lds + TAB_OFF), (const PG8_LAS int*)(F.lds + TAB_TSTART), (const PG8_LAS int*)(F.lds + TAB_CNT), (const unsigned*)(ws + WS_LIST), (PG8_LAS unsigned*)(F.lds + XCH_OFF));
        pg8::EpiUp E{ws + WS_ACT, (const float*)(ws + WS_RSL), (const PG8_LAS int*)(F.lds + TAB_TSTART), (const PG8_LAS int*)(F.lds + TAB_CNT), INP(24)};
        pg8::gemm_phase<pg8::EpiUp, pg8::MoeOrderG, true, true, true, false>(F.lds + RING_OFF, g, S, E);
    }
    SEAM(7);
    if (IN(8)) {
        const int T = moe_tables(F);
        pg8::Gemm g{(const hb*)(ws + WS_ACT), (const hb*)(ws + WS_WDN), T * 256, NEXP * 1024, 512, 512, 512, 127, 122}; pg8::MoeOrder S; S.init(T, 4, F.G, bx, (const PG8_LAS unsigned char*)(F.lds + TAB_OFF));
        pg8::EpiDown E{ws + WS_Y, INP(26)};
        pg8::gemm_phase<pg8::EpiDown, pg8::MoeOrder, true, true, true, false>(F.lds + RING_OFF, g, S, E);
    }
    SEAM(8);
    if (IN(9)) final_phase(F, (const bf16*)(ws + WS_X1B), F.out, (const unsigned char*)(ws + WS_Y), (const float*)(ws + WS_GATE), (const unsigned*)(ws + WS_ASSIGN), INP(27));
#if defined(PROBE_GEMM)
    { xcd_barrier(bar); if (F.tid == 0) tsl[13] = rt();
      const int T = moe_tables(F);
      pg8::Gemm g{(const hb*)(ws + WS_X2B), (const hb*)(ws + WS_WUP), T * 256, NEXP * 2048, 512, 512, 512, 127, 122}; pg8::MoeOrderG S;
      S.init(T, 8, F.G, bx, (const PG8_LAS unsigned char*)(F.lds + TAB_OFF), (const PG8_LAS int*)(F.lds + TAB_TSTART), (const PG8_LAS int*)(F.lds + TAB_CNT), (const unsigned*)(ws + WS_LIST), (PG8_LAS unsigned*)(F.lds + XCH_OFF));
      pg8::EpiUp E{ws + WS_ACT, (const float*)(ws + WS_RSL), (const PG8_LAS int*)(F.lds + TAB_TSTART), (const PG8_LAS int*)(F.lds + TAB_CNT), INP(24)};
      pg8::gemm_phase<pg8::EpiUp, pg8::MoeOrderG, true, true, true, false, PROBE_GEMM>(F.lds + RING_OFF, g, S, E);
      xcd_barrier(bar); if (F.tid == 0) tsl[14] = rt(); }
#endif
#if defined(PROBE_K0)
    { if (F.tid == 0) { tsl[NPHASE] = rt();
        const int ks[2] = {PROBE_K0, PROBE_K1}; unsigned long long code = 0, mul = 1;
        for (int i = 0; i < 2; ++i) { unsigned long long dt = ks[i] == 94 ? tsl[14] - tsl[13] : ks[i] == 97 ? tsl[13] - tsl[2] : ks[i] == 98 ? tsl[3] - tsl[13] : ks[i] == 95 ? tsl[13] - tsl[0] : ks[i] == 96 ? tsl[14] - tsl[13] : tsl[ks[i] + 1] - tsl[ks[i]]; unsigned long long q = (dt + 800) / 1600; if (q > 63) q = 63; code += q * mul; mul *= 64; }
        tsl[15] = code * 6400ull; }
      __syncthreads();
      const unsigned long long t0 = rt(), wait = tsl[15]; float x = (float)F.tid, y = 1.0001f;
      while (rt() - t0 < wait) {
#pragma unroll
          for (int i = 0; i < 64; ++i) x = x * y + 0.5f; }
      if (x == 12345.678f) F.out[0] = x; }
#endif
#undef IN
#undef SEAM
#undef SEAM_LOCAL
}

#ifndef MK_N_LAUNCHES
#define MK_N_LAUNCHES 1
#endif
extern "C" void kernel_launch(void* const* d_in, const int* in_sizes, int n_in, void* d_out, int out_size, void* d_ws, size_t ws_size, hipStream_t stream) {
    static int grid = 0;
    if (grid == 0) {
        if (n_in != 28 || out_size != NTOK * DM || ws_size < WS_END) { fprintf(stderr, "kernel_launch: unexpected shapes: n_in %d out %d ws %zu (need %zu)\n", n_in, out_size, ws_size, (size_t)WS_END); grid = -1; return; }
        int dev = 0, cus = 0, per_cu = 0;
        if (hipGetDevice(&dev) != hipSuccess || hipDeviceGetAttribute(&cus, hipDeviceAttributeMultiprocessorCount, dev) != hipSuccess) { fprintf(stderr, "kernel_launch: device query failed\n"); grid = -1; return; }
        if (hipFuncSetAttribute((const void*)mk_fwd, hipFuncAttributeMaxDynamicSharedMemorySize, LDS_BYTES) != hipSuccess) { fprintf(stderr, "kernel_launch: hipFuncSetAttribute failed\n"); grid = -1; return; }
        if (hipOccupancyMaxActiveBlocksPerMultiprocessor(&per_cu, (const void*)mk_fwd, NWAVES * 64, LDS_BYTES) != hipSuccess || per_cu < 1) { fprintf(stderr, "kernel_launch: occupancy query reports %d workgroups per CU\n", per_cu); (void)hipGetLastError(); grid = -1; return; }
        grid = cus;
    }
    if (grid < 0) return;
    (void)hipMemsetAsync((char*)d_ws + WS_CTL, 0, CTL_ZERO_BYTES, stream);
    Args a{};
    for (int i = 0; i < 28; ++i) a.in[i] = d_in[i];
    a.out = (float*)d_out; a.ws = (unsigned char*)d_ws;
    if (MK_N_LAUNCHES == 1) { a.ph_lo = 0; a.ph_hi = NPHASE; hipLaunchKernelGGL(mk_fwd, dim3(grid), dim3(NWAVES * 64), LDS_BYTES, stream, a); }
    else for (int p = 0; p < NPHASE; ++p) { a.ph_lo = p; a.ph_hi = p + 1; hipLaunchKernelGGL(mk_fwd, dim3(grid), dim3(NWAVES * 64), LDS_BYTES, stream, a); }
}
```

```cpp
#include <hip/hip_runtime.h>
#include <cstdio>
#include <cstdint>
namespace pg8 {
#define PG8_LAS __attribute__((address_space(3)))
typedef unsigned short bf16_t;
typedef short bf16x8 __attribute__((ext_vector_type(8)));
typedef float f32x4 __attribute__((ext_vector_type(4)));
typedef unsigned u32x4 __attribute__((ext_vector_type(4)));
constexpr int BM = 256, BK = 64, HALF = 128, HTB = HALF * BK * 2  , STAGE_BYTES = 8 * HTB, NXCD = 8, WGM = 8;

__host__ __device__ __forceinline__ int lds_byte(int r, int c) { const int st = (r >> 4) * 2 + (c >> 5), rr = r & 15, cc = c & 31, ob = rr * 64 + cc * 2; return st * 1024 + (ob ^ (((ob >> 9) & 1) << 5)); }
__host__ __device__ __forceinline__ void stage_rc(int b, int& R, int& C) { const int st = b / 1024, sb = b % 1024, swz = sb ^ (((sb >> 9) & 1) << 5); R = (st >> 1) * 16 + swz / 64; C = (st & 1) * 32 + (swz % 64) / 2; }
__host__ __device__ __forceinline__ int perm32(int rho) { const int n = rho >> 4, i = rho & 15; return 8 * (i >> 2) + 4 * n + (i & 3); }

struct Unit { int pm, pn; };
struct Gemm { const bf16_t* A; const bf16_t* Bt; int M, N, K, lda, ldb, sa, sb; };
struct OrderBase {
    static constexpr bool GATHER = false;
    __device__ __forceinline__ const char* a_base(const Gemm& g, const Unit& u) const { return (const char*)g.A + (size_t)u.pm * 256 * g.lda * 2; }
    __device__ __forceinline__ const char* b_base(const Gemm& g, const Unit& u) const { return (const char*)g.Bt + (size_t)u.pn * 256 * g.ldb * 2; }
    __device__ __forceinline__ void a_ready(const Unit&) const {}
    __device__ __forceinline__ void done(const Unit&) const {}
};

struct StaticOrder : OrderBase {
    int nM, nN, nwg, G, c;
    __host__ __device__ void init(int M, int N, int G_, int c_) { nM = M / BM; nN = N / BM; nwg = nM * nN; G = G_; c = c_; }
    __host__ __device__ bool next(int i, Unit& u) const {
        const long L = (long)i * G + c; if (L >= nwg) return false;
        int wgid = (int)L; { const int q = nwg / NXCD, r = nwg % NXCD, xcd = wgid % NXCD, off = wgid / NXCD; wgid = (xcd < r ? xcd * (q + 1) : r * (q + 1) + (xcd - r) * q) + off; }
        const int nig = WGM * nN, gid = wgid / nig, fm = gid * WGM, gsz = (nM - fm) < WGM ? (nM - fm) : WGM;
        u.pm = fm + ((wgid % nig) % gsz); u.pn = (wgid % nig) / gsz; return true;
    }
};

typedef unsigned u32x2 __attribute__((ext_vector_type(2)));
typedef float f32x2_t __attribute__((ext_vector_type(2)));
typedef __bf16 bf16x2_t __attribute__((ext_vector_type(2)));
__device__ __forceinline__ unsigned cvtpk(float lo, float hi) { f32x2_t v = {lo, hi}; bf16x2_t b = __builtin_convertvector(v, bf16x2_t); return __builtin_bit_cast(unsigned, b); }
__device__ __forceinline__ void st_bf4(bf16_t* p, f32x4 v) { u32x2 w; w.x = cvtpk(v[0], v[1]); w.y = cvtpk(v[2], v[3]); *(u32x2*)p = w; }
__device__ __forceinline__ unsigned cvt4_fp8(f32x4 v) { unsigned w = __builtin_amdgcn_cvt_pk_fp8_f32(v[0], v[1], 0, false); return __builtin_amdgcn_cvt_pk_fp8_f32(v[2], v[3], w, true); }
__device__ __forceinline__ void st_bf8(bf16_t* p, f32x4 a, f32x4 c) { u32x4 w; w.x = cvtpk(a[0], a[1]); w.y = cvtpk(a[2], a[3]); w.z = cvtpk(c[0], c[1]); w.w = cvtpk(c[2], c[3]); *(u32x4*)p = w; }
__device__ __forceinline__ float bf2f(bf16_t b) { return __builtin_bit_cast(float, (unsigned)b << 16); }
#define EPI_ROWS _Pragma("unroll") for (int ai = 0; ai < 2; ++ai) _Pragma("unroll") for (int m = 0; m < 4; ++m)
#define EPI_COLS _Pragma("unroll") for (int bj = 0; bj < 2; ++bj) _Pragma("unroll") for (int n = 0; n < 2; ++n)
constexpr float LOG2E = 1.4426950408889634f;
constexpr float QSCALE_DA = 0.125f * LOG2E;
constexpr float QSCALE_X = 0.0625f * LOG2E;

struct EpiPlain {
    static constexpr bool PERM = true, AFTER_DRAIN = false;
    bf16_t* O; int ldc; float scale;
    __device__ __forceinline__ void operator()(const f32x4 (&acc)[2][2][4][2], const Unit& u, int wr, int wc, int fr, int fq) const {
        EPI_ROWS { const int row = u.pm * 256 + ai * 128 + wr * 64 + m * 16 + fr; bf16_t* rp = O + (size_t)row * ldc + u.pn * 256 + wc * 32 + fq * 8;
            _Pragma("unroll") for (int bj = 0; bj < 2; ++bj) st_bf8(rp + bj * 128, acc[ai][bj][m][0] * scale, acc[ai][bj][m][1] * scale); }
    }
};
struct EpiProj {
    static constexpr bool PERM = true, AFTER_DRAIN = false;
    bf16_t* P; float* LA; const float* cs; const float* b_alpha;
    template <int ai> __device__ __forceinline__ void decay_rows(const f32x4 (&acc)[2][2][4][2], const Unit& u, int wr, int wc, int fr, int fq) const {
        const int row0 = u.pm * 256 + ai * 128 + wr * 64 + fr;
        EPI_COLS { const int col = bj * 128 + wc * 32 + fq * 8 + n * 4; const f32x4 ba = *(const f32x4*)(b_alpha + col); f32x4 run = {0.f, 0.f, 0.f, 0.f};
            _Pragma("unroll") for (int m = 0; m < 4; ++m) { const f32x4 z = acc[ai][bj][m][n] + ba; f32x4 o;
                _Pragma("unroll") for (int i = 0; i < 4; ++i) { float v = (fminf(z[i], 0.f) - __logf(1.0f + __expf(-fabsf(z[i])))) * 0.0625f;
                    { float t = __shfl_up(v, 1, 16); if (fr >= 1) v += t; t = __shfl_up(v, 2, 16); if (fr >= 2) v += t; t = __shfl_up(v, 4, 16); if (fr >= 4) v += t; t = __shfl_up(v, 8, 16); if (fr >= 8) v += t; }
                    o[i] = v + run[i]; run[i] += __shfl(v, 15, 16); }
                *(f32x4*)(LA + (size_t)(row0 + m * 16) * 256 + col) = o; } }
    }
    __device__ __forceinline__ void operator()(const f32x4 (&acc)[2][2][4][2], const Unit& u, int wr, int wc, int fr, int fq) const {
        const int pn = u.pn;
        if (pn < 4) {
            const float sc = pn < 2 ? QSCALE_DA : 1.0f; const bool ropew = (wc & 1) == 0; const bool rl = fq < 2, hi = fq == 1;
            EPI_ROWS { const int row = u.pm * 256 + ai * 128 + wr * 64 + m * 16 + fr; bf16_t* rp = P + (size_t)row * 3072 + pn * 256 + wc * 32 + fq * 8;
                f32x4 cv[2], sv[2];
                if (ropew) { const f32x4* cp = (const f32x4*)(cs + (size_t)row * 16); cv[0] = cp[0]; cv[1] = cp[1]; sv[0] = cp[2]; sv[1] = cp[3]; }
                _Pragma("unroll") for (int bj = 0; bj < 2; ++bj) { f32x4 v[2] = {acc[ai][bj][m][0], acc[ai][bj][m][1]};
                    if (ropew) { _Pragma("unroll") for (int n = 0; n < 2; ++n) { f32x4 p; p[0] = __shfl_xor(v[n][0], 16); p[1] = __shfl_xor(v[n][1], 16); p[2] = __shfl_xor(v[n][2], 16); p[3] = __shfl_xor(v[n][3], 16);
                            const f32x4 r = hi ? (v[n] * cv[n] + p * sv[n]) : (v[n] * cv[n] - p * sv[n]); v[n] = rl ? r : v[n]; } }
                    st_bf8(rp + bj * 128, v[0] * sc, v[1] * sc); } }
        } else if (pn < 12) {
            const float sc = pn == 6 ? 0.125f : 1.0f;
            EPI_ROWS { const int row = u.pm * 256 + ai * 128 + wr * 64 + m * 16 + fr; bf16_t* rp = P + (size_t)row * 3072 + pn * 256 + wc * 32 + fq * 8;
                _Pragma("unroll") for (int bj = 0; bj < 2; ++bj) st_bf8(rp + bj * 128, acc[ai][bj][m][0] * sc, acc[ai][bj][m][1] * sc); }
        } else {
            decay_rows<0>(acc, u, wr, wc, fr, fq); decay_rows<1>(acc, u, wr, wc, fr, fq);
        }
    }
};
struct EpiP1 {
    static constexpr bool PERM = true, AFTER_DRAIN = false;
    EpiProj proj; EpiPlain vt, kx, vxt;
    __device__ __forceinline__ void operator()(const f32x4 (&acc)[2][2][4][2], const Unit& u, int wr, int wc, int fr, int fq) const {
        const int job = u.pn >> 16; Unit v; v.pm = u.pm; v.pn = u.pn & 0xffff;
        if (job == 0) proj(acc, v, wr, wc, fr, fq); else if (job == 1) vt(acc, v, wr, wc, fr, fq); else if (job == 2) kx(acc, v, wr, wc, fr, fq); else vxt(acc, v, wr, wc, fr, fq);
    }
};
struct EpiRes1 {
    static constexpr bool PERM = true, AFTER_DRAIN = false;
    const float* base; bf16_t* xb; float* ssp;
    __device__ __forceinline__ void operator()(const f32x4 (&acc)[2][2][4][2], const Unit& u, int wr, int wc, int fr, int fq) const {
        EPI_ROWS { const int row = u.pm * 256 + ai * 128 + wr * 64 + m * 16 + fr; const size_t off = (size_t)row * 1024 + u.pn * 256 + wc * 32 + fq * 8; float ss = 0.f;
            _Pragma("unroll") for (int bj = 0; bj < 2; ++bj) { const size_t o2 = off + bj * 128; const f32x4 v0 = *(const f32x4*)(base + o2) + acc[ai][bj][m][0], v1 = *(const f32x4*)(base + o2 + 4) + acc[ai][bj][m][1]; st_bf8(xb + o2, v0, v1);
                ss += ((v0[0] * v0[0] + v0[1] * v0[1]) + (v0[2] * v0[2] + v0[3] * v0[3])) + ((v1[0] * v1[0] + v1[1] * v1[1]) + (v1[2] * v1[2] + v1[3] * v1[3])); }
            ss += __shfl_xor(ss, 16); ss += __shfl_xor(ss, 32);
            if (fq == 0) ssp[(size_t)row * 16 + u.pn * 4 + wc] = ss; }
    }
};
struct EpiQX {
    static constexpr bool PERM = true, AFTER_DRAIN = false;
    bf16_t* O; const float* ssp;
    __device__ __forceinline__ void operator()(const f32x4 (&acc)[2][2][4][2], const Unit& u, int wr, int wc, int fr, int fq) const {
        EPI_ROWS { const int row = u.pm * 256 + ai * 128 + wr * 64 + m * 16 + fr; const f32x4* sp = (const f32x4*)(ssp + (size_t)row * 16);
            const f32x4 a = sp[0], b = sp[1], c = sp[2], d = sp[3]; const float ss = ((a[0] + a[1]) + (a[2] + a[3])) + ((b[0] + b[1]) + (b[2] + b[3])) + ((c[0] + c[1]) + (c[2] + c[3])) + ((d[0] + d[1]) + (d[2] + d[3]));
            const float rs = rsqrtf(ss * (1.0f / 1024.0f) + 1e-6f) * QSCALE_X; bf16_t* rp = O + (size_t)row * 1024 + u.pn * 256 + wc * 32 + fq * 8;
            _Pragma("unroll") for (int bj = 0; bj < 2; ++bj) st_bf8(rp + bj * 128, acc[ai][bj][m][0] * rs, acc[ai][bj][m][1] * rs); }
    }
};
struct EpiRes2 {
    static constexpr bool PERM = true, AFTER_DRAIN = false;
    bf16_t* xh; unsigned char* x8;
    __device__ __forceinline__ void operator()(const f32x4 (&acc)[2][2][4][2], const Unit& u, int wr, int wc, int fr, int fq) const {
        EPI_ROWS { const int row = u.pm * 256 + ai * 128 + wr * 64 + m * 16 + fr; const size_t off = (size_t)row * 1024 + u.pn * 256 + wc * 32 + fq * 8;
            _Pragma("unroll") for (int bj = 0; bj < 2; ++bj) { bf16_t* p = xh + off + bj * 128; const u32x4 w = *(const u32x4*)p;
                f32x4 v0 = {__builtin_bit_cast(float, w.x << 16), __builtin_bit_cast(float, w.x & 0xffff0000u), __builtin_bit_cast(float, w.y << 16), __builtin_bit_cast(float, w.y & 0xffff0000u)};
                f32x4 v1 = {__builtin_bit_cast(float, w.z << 16), __builtin_bit_cast(float, w.z & 0xffff0000u), __builtin_bit_cast(float, w.w << 16), __builtin_bit_cast(float, w.w & 0xffff0000u)};
                v0 = v0 + acc[ai][bj][m][0]; v1 = v1 + acc[ai][bj][m][1]; st_bf8(p, v0, v1); u32x2 q; q.x = cvt4_fp8(v0); q.y = cvt4_fp8(v1); *(u32x2*)(x8 + off + bj * 128) = q; } }
    }
};
struct EpiUp {
    static constexpr bool PERM = true, AFTER_DRAIN = false;
    unsigned char* ACT; const float* rsl; const PG8_LAS int* tstart; const PG8_LAS int* cnt; const float* b_up;
    __device__ __forceinline__ void operator()(const f32x4 (&acc)[2][2][4][2], const Unit& u, int wr, int wc, int fr, int fq) const {
        const int e = u.pn >> 3, pnl = u.pn & 7; const float* bg = b_up + (size_t)e * 2048 + pnl * 128 + wc * 32 + fq * 8;
        const int pos0 = (u.pm - tstart[e]) * 256 + wr * 64 + fr, nv = cnt[e]; const float* rp0 = rsl + (size_t)e * 32768 + pos0;
        const f32x4 bg0 = *(const f32x4*)bg, bg1 = *(const f32x4*)(bg + 4), bl0 = *(const f32x4*)(bg + 1024), bl1 = *(const f32x4*)(bg + 1028);
        EPI_ROWS { const int row = u.pm * 256 + ai * 128 + wr * 64 + m * 16 + fr; const float rs = (pos0 + ai * 128 + m * 16) < nv ? rp0[ai * 128 + m * 16] : 0.f;
            unsigned char* rp = ACT + (size_t)row * 1024 + pnl * 128 + wc * 32 + fq * 8; u32x2 w;
            _Pragma("unroll") for (int n = 0; n < 2; ++n) {
                const f32x4 c7 = {7.0f, 7.0f, 7.0f, 7.0f}, one = {1.0f, 1.0f, 1.0f, 1.0f};
                const f32x4 gl = __builtin_elementwise_min(acc[ai][0][m][n] * rs + (n ? bg1 : bg0), c7), li = __builtin_elementwise_min(__builtin_elementwise_max(acc[ai][1][m][n] * rs + (n ? bl1 : bl0), -c7), c7);
                const f32x4 t = gl * -2.4554669595930156f; f32x4 e; _Pragma("unroll") for (int i = 0; i < 4; ++i) e[i] = __builtin_amdgcn_exp2f(t[i]);
                const f32x4 a = e + one; f32x4 r; _Pragma("unroll") for (int i = 0; i < 4; ++i) r[i] = __builtin_amdgcn_rcpf(a[i]);
                const f32x4 o = (gl * r) * (li + one);
                if (n) w.y = cvt4_fp8(o); else w.x = cvt4_fp8(o); }
            *(u32x2*)rp = w; }
    }
};
struct EpiDown {
    static constexpr bool PERM = true, AFTER_DRAIN = false;
    unsigned char* Y; const float* b_down;
    __device__ __forceinline__ void operator()(const f32x4 (&acc)[2][2][4][2], const Unit& u, int wr, int wc, int fr, int fq) const {
        const int e = u.pn >> 2, pnl = u.pn & 3; const float* bp = b_down + (size_t)e * 1024 + pnl * 256 + wc * 32 + fq * 8;
        f32x4 bv[2][2];
        _Pragma("unroll") for (int bj = 0; bj < 2; ++bj) _Pragma("unroll") for (int n = 0; n < 2; ++n) bv[bj][n] = *(const f32x4*)(bp + bj * 128 + n * 4);
        EPI_ROWS { const int row = u.pm * 256 + ai * 128 + wr * 64 + m * 16 + fr; unsigned char* rp = Y + (size_t)row * 1024 + pnl * 256 + wc * 32 + fq * 8;
            _Pragma("unroll") for (int bj = 0; bj < 2; ++bj) { u32x2 w; w.x = cvt4_fp8(acc[ai][bj][m][0] + bv[bj][0]); w.y = cvt4_fp8(acc[ai][bj][m][1] + bv[bj][1]); *(u32x2*)(rp + bj * 128) = w; } }
    }
};
struct OrderMap : OrderBase {
    StaticOrder so;
    __device__ void init(int nM, int nN, int G, int c) { so.nM = nM; so.nN = nN; so.nwg = nM * nN; so.G = G; so.c = c; }
    __device__ bool next(int i, Unit& u) const { if (!so.next(i, u)) return false; u.pn += (u.pn >= 4 ? 2 : 0) + (u.pn >= 6 ? 2 : 0); return true; }
};
struct OrderVT : OrderBase {
    StaticOrder so;
    __device__ void init(int nN, int G, int c) { so.nM = 4; so.nN = nN; so.nwg = 4 * nN; so.G = G; so.c = c; }
    __device__ bool next(int i, Unit& u) const { if (!so.next(i, u)) return false; u.pm += (u.pm >= 2 ? 6 : 4); return true; }
};
__device__ __forceinline__ void map_unit(int L, int nM, int nN, int& pm, int& pn) {
    const int nwg = nM * nN; int wgid = L; { const int q = nwg / NXCD, r = nwg % NXCD, xcd = wgid % NXCD, off = wgid / NXCD; wgid = (xcd < r ? xcd * (q + 1) : r * (q + 1) + (xcd - r) * q) + off; }
    const int nig = WGM * nN, gid = wgid / nig, fm = gid * WGM, gsz = (nM - fm) < WGM ? (nM - fm) : WGM;
    pm = fm + ((wgid % nig) % gsz); pn = (wgid % nig) / gsz;
}
template <unsigned oHN, unsigned oWINT, unsigned oMN, unsigned oWCK, unsigned oWCV>
struct OrderP1 : OrderBase {
    int G, c; const char* ws;
    __device__ __forceinline__ bool next(int i, Unit& u) const {
        int L = i * G + c; if (L >= 1792) return false;
        if (L < 1152) { map_unit(L, 128, 9, u.pm, u.pn); u.pn += (u.pn >= 4 ? 2 : 0) + (u.pn >= 6 ? 2 : 0); return true; } L -= 1152;
        if (L < 512) { map_unit(L, 4, 128, u.pm, u.pn); u.pm += (u.pm >= 2 ? 6 : 4); u.pn |= 1 << 16; return true; } L -= 512;
        if (L < 64) { map_unit(L, 16, 4, u.pm, u.pn); u.pn |= 2 << 16; return true; } L -= 64;
        map_unit(L, 16, 4, u.pm, u.pn); u.pn |= 3 << 16; return true;
    }
    __device__ __forceinline__ const char* a_base(const Gemm&, const Unit& u) const { const int job = u.pn >> 16; unsigned o = oHN; o = job == 1 ? oWINT : o; o = job >= 2 ? oMN : o; return ws + o + (size_t)u.pm * (256 * 1024 * 2); }
    __device__ __forceinline__ const char* b_base(const Gemm&, const Unit& u) const { const int job = u.pn >> 16; unsigned o = oWINT; o = job == 1 ? oHN : o; o = job == 2 ? oWCK : o; o = job == 3 ? oWCV : o; return ws + o + (size_t)(u.pn & 0xffff) * (256 * 1024 * 2); }
};
struct MoeOrder : OrderBase {
    StaticOrder so; const PG8_LAS unsigned char* tile_e; int nN;
    __device__ void init(int nM, int nN_, int G, int c, const PG8_LAS unsigned char* te) { so.nM = nM; so.nN = nN_; so.nwg = nM * nN_; so.G = G; so.c = c; tile_e = te; nN = nN_; }
    __device__ bool next(int i, Unit& u) const { if (!so.next(i, u)) return false; u.pn += (int)tile_e[u.pm] * nN; return true; }
};


struct MoeOrderG : OrderBase {
    static constexpr bool GATHER = true;
    StaticOrder so; const PG8_LAS unsigned char* tile_e; const PG8_LAS int* tstart; const PG8_LAS int* cnt; const unsigned* list; PG8_LAS unsigned* gslot; int nN;
    __device__ void init(int nM, int nN_, int G, int c, const PG8_LAS unsigned char* te, const PG8_LAS int* ts, const PG8_LAS int* cn, const unsigned* li, PG8_LAS unsigned* gs) {
        so.nM = nM; so.nN = nN_; so.nwg = nM * nN_; so.G = G; so.c = c; tile_e = te; tstart = ts; cnt = cn; list = li; gslot = gs; nN = nN_; }
    __device__ bool next(int i, Unit& u) const { if (!so.next(i, u)) return false; u.pn += (int)tile_e[u.pm] * nN; return true; }
    __device__ __forceinline__ const char* a_base(const Gemm& g, const Unit&) const { return (const char*)g.A; }
    __device__ __forceinline__ const unsigned* rows(const Unit& u) const { const int e = u.pn / nN; return list + (size_t)e * 32768 + (size_t)(u.pm - tstart[e]) * 256; }
    __device__ __forceinline__ int nvalid(const Unit& u) const { const int e = u.pn / nN; return cnt[e] - (u.pm - tstart[e]) * 256; }
};
struct OrderX1 : OrderBase {
    StaticOrder so;
    __device__ void init(int G, int c) { so.nM = 128; so.nN = 4; so.nwg = 512; so.G = G; so.c = c; }
    __device__ bool next(int i, Unit& u) const { return so.next(i, u); }
    __device__ __forceinline__ const char* a_base(const Gemm& g, const Unit& u) const { return (const char*)(g.A + (size_t)u.pm * 256 * 1024 + u.pn * 256); }
    __device__ __forceinline__ const char* b_base(const Gemm& g, const Unit& u) const { return (const char*)(g.Bt + (size_t)(u.pm >> 3) * 256 * 1024 + u.pn * 256); }
};
struct OrderX2 : OrderBase {
    StaticOrder so;
    __device__ void init(int G, int c) { so.nM = 128; so.nN = 4; so.nwg = 512; so.G = G; so.c = c; }
    __device__ bool next(int i, Unit& u) const { return so.next(i, u); }
    __device__ __forceinline__ const char* a_base(const Gemm& g, const Unit& u) const { return (const char*)(g.A + (size_t)u.pm * 256 * 1024 + u.pn * 256); }
    __device__ __forceinline__ const char* b_base(const Gemm& g, const Unit& u) const { return (const char*)(g.Bt + (size_t)u.pn * 256 * 4096 + (u.pm >> 3) * 256); }
};
struct EpiSoftmax {
    static constexpr bool PERM = true, AFTER_DRAIN = false;
    bf16_t* PX; float* lp; PG8_LAS float* xch;
    __device__ __forceinline__ void operator()(const f32x4 (&acc)[2][2][4][2], const Unit& u, int wr, int wc, int fr, int fq) const {
        PG8_LAS char* rb = (PG8_LAS char*)xch + (wr * 64 + fr) * 16; asm volatile("" : "+v"(rb));
        PG8_LAS char* wb = rb + wc * 4; asm volatile("" : "+v"(wb));
        EPI_ROWS { float a = -INFINITY;
            EPI_COLS { const f32x4 v = acc[ai][bj][m][n]; a = fmaxf(a, fmaxf(fmaxf(v[0], v[1]), fmaxf(v[2], v[3]))); }
            a = fmaxf(a, __shfl_xor(a, 16)); a = fmaxf(a, __shfl_xor(a, 32));
            if (fq == 0) *(PG8_LAS float*)(wb + (ai * 128 + m * 16) * 16) = a; }
        asm volatile("s_waitcnt lgkmcnt(0)" ::: "memory"); __builtin_amdgcn_s_barrier(); asm volatile("" ::: "memory");
        const int row0 = u.pm * 256 + wr * 64 + fr; bf16_t* rp0 = PX + (size_t)row0 * 1024 + u.pn * 256 + wc * 32 + fq * 8; float* lp0 = lp + (size_t)row0 * 16 + u.pn * 4 + wc;
        EPI_ROWS { const f32x4 q = *(const PG8_LAS f32x4*)(rb + (ai * 128 + m * 16) * 16); const float mr = fmaxf(fmaxf(q[0], q[1]), fmaxf(q[2], q[3]));
            bf16_t* rp = rp0 + (size_t)(ai * 128 + m * 16) * 1024; float ps = 0.f;
            _Pragma("unroll") for (int bj = 0; bj < 2; ++bj) { f32x4 p[2];
                _Pragma("unroll") for (int n = 0; n < 2; ++n) _Pragma("unroll") for (int i = 0; i < 4; ++i) { p[n][i] = __builtin_amdgcn_exp2f(acc[ai][bj][m][n][i] - mr); ps += p[n][i]; }
                st_bf8(rp + bj * 128, p[0], p[1]); }
            ps += __shfl_xor(ps, 16); ps += __shfl_xor(ps, 32);
            if (fq == 0) lp0[(ai * 128 + m * 16) * 16] = ps; }
        asm volatile("s_waitcnt lgkmcnt(0)" ::: "memory"); __builtin_amdgcn_s_barrier(); asm volatile("" ::: "memory");
    }
};
struct EpiPV {
    static constexpr bool PERM = true, AFTER_DRAIN = false;
    bf16_t* O; const float* lp;
    __device__ __forceinline__ void operator()(const f32x4 (&acc)[2][2][4][2], const Unit& u, int wr, int wc, int fr, int fq) const {
        EPI_ROWS { const int row = u.pm * 256 + ai * 128 + wr * 64 + m * 16 + fr; const f32x4 q = *(const f32x4*)(lp + (size_t)row * 16 + u.pn * 4);
            const float inv = 1.0f / ((q[0] + q[1]) + (q[2] + q[3])); bf16_t* rp = O + (size_t)row * 1024 + u.pn * 256 + wc * 32 + fq * 8;
            _Pragma("unroll") for (int bj = 0; bj < 2; ++bj) st_bf8(rp + bj * 128, acc[ai][bj][m][0] * inv, acc[ai][bj][m][1] * inv); }
    }
};

template <unsigned oKX, unsigned oWCQR, unsigned oWCOT, unsigned oVX>
struct OrderGH : OrderBase {
    int G, c; const char* ws;
    __device__ __forceinline__ bool next(int i, Unit& u) const { int L = i * G + c; if (L >= 512) return false;
        if (L < 256) { u.pm = L >> 2; u.pn = L & 3; } else { L -= 256; u.pm = L >> 2; u.pn = (L & 3) | (1 << 16); } return true; }
    __device__ __forceinline__ const char* a_base(const Gemm&, const Unit& u) const { const int job = u.pn >> 16, pn = u.pn & 0xffff;
        return job == 0 ? ws + oKX + ((size_t)(u.pm >> 2) * 256 * 1024 + (u.pm & 3) * 256) * 2 : ws + oWCOT + ((size_t)(u.pm & 3) * 256 * 1024 + pn * 256) * 2; }
    __device__ __forceinline__ const char* b_base(const Gemm&, const Unit& u) const { const int job = u.pn >> 16, pn = u.pn & 0xffff;
        return job == 0 ? ws + oWCQR + ((size_t)pn * 256 * 1024 + (u.pm & 3) * 256) * 2 : ws + oVX + ((size_t)(u.pm >> 2) * 256 * 1024 + pn * 256) * 2; }
};
struct EpiGH {
    static constexpr bool PERM = true, AFTER_DRAIN = false;
    EpiPlain gt, ht;
    __device__ __forceinline__ void operator()(const f32x4 (&acc)[2][2][4][2], const Unit& u, int wr, int wc, int fr, int fq) const {
        Unit v; v.pm = u.pm; v.pn = u.pn & 0xffff; if ((u.pn >> 16) == 0) gt(acc, v, wr, wc, fr, fq); else ht(acc, v, wr, wc, fr, fq); }
};
struct OrderXS : OrderBase {
    StaticOrder so;
    __device__ void init(int G, int c) { so.nM = 128; so.nN = 4; so.nwg = 512; so.G = G; so.c = c; }
    __device__ bool next(int i, Unit& u) const { return so.next(i, u); }
    __device__ __forceinline__ const char* b_base(const Gemm& g, const Unit& u) const { return (const char*)(g.Bt + ((size_t)(u.pm >> 3) * 1024 + u.pn * 256) * 1024); }
};
struct EpiSoftmaxN {
    static constexpr bool PERM = true, AFTER_DRAIN = false;
    bf16_t* PX; const float* ssp; PG8_LAS float* xmax; PG8_LAS float* xsum;
    __device__ __forceinline__ void operator()(f32x4 (&acc)[2][2][4][2], const Unit& u, int wr, int wc, int fr, int fq) const {
        PG8_LAS char* rb = (PG8_LAS char*)xmax + (wr * 64 + fr) * 16; asm volatile("" : "+v"(rb));
        PG8_LAS char* wb = rb + wc * 4; asm volatile("" : "+v"(wb));
        PG8_LAS char* rb2 = (PG8_LAS char*)xsum + (wr * 64 + fr) * 16; asm volatile("" : "+v"(rb2));
        PG8_LAS char* wb2 = rb2 + wc * 4; asm volatile("" : "+v"(wb2));
        const int row0 = u.pm * 256 + wr * 64 + fr;
        EPI_ROWS { const f32x4* sp = (const f32x4*)(ssp + (size_t)(row0 + ai * 128 + m * 16) * 16);
            const f32x4 a4 = sp[0], b4 = sp[1], c4 = sp[2], d4 = sp[3]; const float ss = ((a4[0] + a4[1]) + (a4[2] + a4[3])) + ((b4[0] + b4[1]) + (b4[2] + b4[3])) + ((c4[0] + c4[1]) + (c4[2] + c4[3])) + ((d4[0] + d4[1]) + (d4[2] + d4[3]));
            const float rs = rsqrtf(ss * (1.0f / 1024.0f) + 1e-6f) * QSCALE_X; float a = -INFINITY;
            EPI_COLS { f32x4 v = acc[ai][bj][m][n] * rs; acc[ai][bj][m][n] = v; a = fmaxf(a, fmaxf(fmaxf(v[0], v[1]), fmaxf(v[2], v[3]))); }
            a = fmaxf(a, __shfl_xor(a, 16)); a = fmaxf(a, __shfl_xor(a, 32));
            if (fq == 0) *(PG8_LAS float*)(wb + (ai * 128 + m * 16) * 16) = a; }
        asm volatile("s_waitcnt lgkmcnt(0)" ::: "memory"); __builtin_amdgcn_s_barrier(); asm volatile("" ::: "memory");
        EPI_ROWS { const f32x4 q = *(const PG8_LAS f32x4*)(rb + (ai * 128 + m * 16) * 16); const float mr = fmaxf(fmaxf(q[0], q[1]), fmaxf(q[2], q[3])); float ps = 0.f;
            EPI_COLS { f32x4 p; _Pragma("unroll") for (int i = 0; i < 4; ++i) { p[i] = __builtin_amdgcn_exp2f(acc[ai][bj][m][n][i] - mr); ps += p[i]; } acc[ai][bj][m][n] = p; }
            ps += __shfl_xor(ps, 16); ps += __shfl_xor(ps, 32);
            if (fq == 0) *(PG8_LAS float*)(wb2 + (ai * 128 + m * 16) * 16) = ps; }
        asm volatile("s_waitcnt lgkmcnt(0)" ::: "memory"); __builtin_amdgcn_s_barrier(); asm volatile("" ::: "memory");
        bf16_t* rp0 = PX + (size_t)row0 * 1024 + u.pn * 256 + wc * 32 + fq * 8;
        EPI_ROWS { const f32x4 q = *(const PG8_LAS f32x4*)(rb2 + (ai * 128 + m * 16) * 16); const float inv = __builtin_amdgcn_rcpf((q[0] + q[1]) + (q[2] + q[3]));
            bf16_t* rp = rp0 + (size_t)(ai * 128 + m * 16) * 1024;
            _Pragma("unroll") for (int bj = 0; bj < 2; ++bj) st_bf8(rp + bj * 128, acc[ai][bj][m][0] * inv, acc[ai][bj][m][1] * inv); }
    }
};
struct OrderXO : OrderBase {
    StaticOrder so;
    __device__ void init(int G, int c) { so.nM = 128; so.nN = 4; so.nwg = 512; so.G = G; so.c = c; }
    __device__ bool next(int i, Unit& u) const { return so.next(i, u); }
    __device__ __forceinline__ const char* b_base(const Gemm& g, const Unit& u) const { return (const char*)(g.Bt + ((size_t)(u.pm >> 3) * 1024 + u.pn * 256) * 1024); }
};
typedef int v4i_t __attribute__((ext_vector_type(4))); typedef int v8i_t __attribute__((ext_vector_type(8)));
__device__ __forceinline__ v8i_t cat8(bf16x8 lo, bf16x8 hi) { return __builtin_shufflevector(__builtin_bit_cast(v4i_t, lo), __builtin_bit_cast(v4i_t, hi), 0, 1, 2, 3, 4, 5, 6, 7); }
__device__ __forceinline__ void mfma8(f32x4& acc, v8i_t w, v8i_t a, int sw, int sa) {
    asm volatile("s_nop 1\n\tv_mfma_scale_f32_16x16x128_f8f6f4 %0, %1, %2, %0, %3, %4 op_sel_hi:[0,0,0]" : "+v"(acc) : "v"(w), "v"(a), "v"(sw), "v"(sa)); }
constexpr int PF_D = 4, PF_LDS = 137216;
template <class Epi, class Sched, bool ALIGN_EPI = false, bool SP2 = false, bool FP8 = false, bool PF = false, int DBG = 0>
__device__ __forceinline__ void gemm_phase(PG8_LAS unsigned char* lds, const Gemm g, const Sched& S, const Epi& E) {
    const int tid = threadIdx.x, wid = __builtin_amdgcn_readfirstlane(tid >> 6), lane = tid & 63, wr = wid >> 2, wc = wid & 3, fr = lane & 15, fq = lane >> 4;
    const int K = g.K, nt = K / BK;
    unsigned voffA[2], voffB[2];
    unsigned gC[2][2];
#pragma unroll
    for (int i = 0; i < 2; ++i) { int R, C; stage_rc(tid * 16 + i * 8192, R, C); const int Rb = Epi::PERM ? ((R & ~31) + perm32(R & 31)) : R;
        voffA[i] = (unsigned)(R * g.lda + C) * 2u; voffB[i] = (unsigned)(Rb * g.ldb + C) * 2u; }
    const bool pfA = !Sched::GATHER && wid < 4;
    const unsigned pfoff = (unsigned)((((wid >> 1) & 1) * HALF + (wid & 1) * 64 + lane) * (pfA ? g.lda : g.ldb)) * 2u;
    const size_t kstep = (size_t)(BK * 2);
    const size_t hstepA = (size_t)HALF * g.lda * 2, hstepB = (size_t)HALF * g.ldb * 2;
    const unsigned ldsw = (unsigned)wid * 1024u;
    const int aoff = lds_byte(wr * 64 + fr, fq * 8), boff = lds_byte(wc * 32 + fr, fq * 8);
#define PG8_SA(b, h) (((b) * 2 + (h)) * HTB)
#define PG8_SB(b, h) ((4 + (b) * 2 + (h)) * HTB)
#define PG8_STAGE(bufoff, gbase, voff) do { if constexpr ((DBG & 2) == 0) _Pragma("unroll") for (int _i = 0; _i < 2; ++_i) \
        __builtin_amdgcn_global_load_lds((const unsigned*)((const char*)(gbase) + (voff)[_i]), (PG8_LAS unsigned*)(lds + (bufoff) + ldsw + _i * 8192), 16, 0, 0); } while (0)
#define PG8_STAGE_A(bufoff, ptr, h, nx) do { if constexpr (Sched::GATHER) { PG8_STAGE(bufoff, ptr, gC[h]); } else { PG8_STAGE(bufoff, (ptr) + ((h) ? hstepA : 0), voffA); } } while (0)
#define PG8_LDA(dst, b, h) do { if constexpr ((DBG & 8) == 0) _Pragma("unroll") for (int m = 0; m < 4; ++m) _Pragma("unroll") for (int k = 0; k < 2; ++k) dst[m][k] = *(const PG8_LAS bf16x8*)(lds + PG8_SA(b, h) + aoff + m * 2048 + k * 1024); } while (0)
#define PG8_LDB(dst, b, h) do { if constexpr ((DBG & 8) == 0) _Pragma("unroll") for (int n = 0; n < 2; ++n) _Pragma("unroll") for (int k = 0; k < 2; ++k) dst[n][k] = *(const PG8_LAS bf16x8*)(lds + PG8_SB(b, h) + boff + n * 2048 + k * 1024); } while (0)
#define PG8_MMA(ai, bj, At, Bt) do { if constexpr ((DBG & 1) == 0) { __builtin_amdgcn_s_setprio(1); \
        if constexpr (FP8) { _Pragma("unroll") for (int m = 0; m < 4; ++m) _Pragma("unroll") for (int n = 0; n < 2; ++n) \
            mfma8(acc[ai][bj][m][n], cat8(Bt[n][0], Bt[n][1]), cat8(At[m][0], At[m][1]), g.sb, g.sa); } \
        else { _Pragma("unroll") for (int m = 0; m < 4; ++m) _Pragma("unroll") for (int n = 0; n < 2; ++n) _Pragma("unroll") for (int k = 0; k < 2; ++k) \
            acc[ai][bj][m][n] = __builtin_amdgcn_mfma_f32_16x16x32_bf16(Bt[n][k], At[m][k], acc[ai][bj][m][n], 0, 0, 0); } \
        __builtin_amdgcn_s_setprio(0); } } while (0)
#define PG8_WAIT_V(n) asm volatile("s_waitcnt vmcnt(" #n ")" ::: "memory")
#define PG8_WAIT_VP() do { if constexpr (PF) asm volatile("s_waitcnt vmcnt(9)" ::: "memory"); else asm volatile("s_waitcnt vmcnt(8)" ::: "memory"); } while (0)
#define PG8_PREFETCH(tp) do { if constexpr (PF) { const int tp_ = (tp); const char* pb_ = tp_ < nt ? (pfA ? cA : cB) + (size_t)tp_ * kstep : (pfA ? nA : nB) + (size_t)(tp_ - nt) * kstep; \
        __builtin_amdgcn_global_load_lds((const unsigned*)(pb_ + pfoff), (PG8_LAS unsigned*)(lds + PF_LDS + wid * 256), 4, 0, 0); } } while (0)
#define PG8_WAIT_L(n) asm volatile("s_waitcnt lgkmcnt(" #n ")" ::: "memory")
#define PG8_BAR __builtin_amdgcn_s_barrier()
#define PG8_SCHED __builtin_amdgcn_sched_barrier(0)
    Unit cur, nxt; int ui = 0;
    if (!S.next(0, cur)) return;
    f32x4 acc[2][2][4][2];
#pragma unroll
    for (int a = 0; a < 2; ++a)
#pragma unroll
        for (int b = 0; b < 2; ++b)
#pragma unroll
            for (int m = 0; m < 4; ++m)
#pragma unroll
                for (int n = 0; n < 2; ++n) acc[a][b][m][n] = (f32x4){0.f, 0.f, 0.f, 0.f};
    bf16x8 At[4][2], B0[2][2], B1[2][2];
    const char* cA = S.a_base(g, cur); const char* cB = S.b_base(g, cur);
    if constexpr (Sched::GATHER) { const unsigned* rp = S.rows(cur); const int nv = S.nvalid(cur);
#pragma unroll
        for (int h = 0; h < 2; ++h)
#pragma unroll
            for (int i = 0; i < 2; ++i) { int R, C; stage_rc(tid * 16 + i * 8192, R, C); const int r = h * HALF + R; const unsigned tok = r < nv ? rp[r] : 0u; gC[h][i] = tok * (unsigned)(g.lda * 2) + (unsigned)C * 2u; } }
    S.a_ready(cur);
    if constexpr (SP2) {
        PG8_STAGE(PG8_SB(0, 0), cB, voffB); PG8_STAGE(PG8_SB(0, 1), cB + hstepB, voffB); PG8_STAGE_A(PG8_SA(0, 0), cA, 0, 0); PG8_STAGE_A(PG8_SA(0, 1), cA, 1, 0);
        if (wr == 1) PG8_BAR;
        PG8_WAIT_V(2); PG8_BAR;
        PG8_STAGE(PG8_SB(1, 0), cB + kstep, voffB); PG8_STAGE_A(PG8_SA(1, 0), cA + kstep, 0, 0); PG8_STAGE(PG8_SB(1, 1), cB + hstepB + kstep, voffB);
        PG8_WAIT_V(6); PG8_BAR;
    } else {
        PG8_STAGE(PG8_SB(0, 0), cB, voffB); PG8_STAGE_A(PG8_SA(0, 0), cA, 0, 0); PG8_STAGE(PG8_SB(0, 1), cB + hstepB, voffB); PG8_STAGE_A(PG8_SA(0, 1), cA, 1, 0);
        if (wr == 1) PG8_BAR;
        PG8_WAIT_V(4); PG8_BAR;
        PG8_STAGE(PG8_SB(1, 0), cB + kstep, voffB); PG8_STAGE_A(PG8_SA(1, 0), cA + kstep, 0, 0); PG8_STAGE(PG8_SB(1, 1), cB + hstepB + kstep, voffB);
        PG8_WAIT_V(6); PG8_BAR;
    }
    for (;;) {
        const bool has_next = S.next(ui + 1, nxt);
        const char* nA = has_next ? S.a_base(g, nxt) : cA; const char* nB = has_next ? S.b_base(g, nxt) : cB;
        if constexpr (Sched::GATHER) { if (has_next && wid < 4)
            __builtin_amdgcn_global_load_lds((const unsigned*)(S.rows(nxt) + wid * 64 + lane), (PG8_LAS unsigned*)(S.gslot + ((ui + 1) & 1) * 256 + wid * 64), 4, 0, 0); }
#pragma nounroll
        for (int t = 0; t < nt; t += 2) {
            const bool last = (t == nt - 2);
            const char* a1 = cA + (size_t)(t + 1) * kstep;
            const char* a2 = last ? nA : cA + (size_t)(t + 2) * kstep; const char* b2 = last ? nB : cB + (size_t)(t + 2) * kstep;
            const char* a3 = a2 + kstep; const char* b3 = b2 + kstep;
            if (last && has_next) S.a_ready(nxt);
            if constexpr (SP2) {
            PG8_LDB(B0, 0, 0); PG8_LDB(B1, 0, 1); PG8_SCHED; PG8_LDA(At, 0, 0); PG8_STAGE_A(PG8_SA(1, 1), a1, 1, 0);
            if constexpr (Sched::GATHER) { if (last && has_next) {
                const PG8_LAS unsigned* sl = S.gslot + ((ui + 1) & 1) * 256; const int nv = S.nvalid(nxt);
#pragma unroll
                for (int h = 0; h < 2; ++h)
#pragma unroll
                    for (int i = 0; i < 2; ++i) { int R, C; stage_rc(tid * 16 + i * 8192, R, C); const int r = h * HALF + R; const unsigned v = sl[r]; const unsigned tok = r < nv ? v : 0u; gC[h][i] = tok * (unsigned)(g.lda * 2) + (unsigned)C * 2u; } } }
            PG8_WAIT_VP(); PG8_WAIT_L(0); PG8_BAR; PG8_MMA(0, 0, At, B0); PG8_MMA(0, 1, At, B1); PG8_BAR; PG8_SCHED;
            PG8_LDA(At, 0, 1); PG8_STAGE(PG8_SB(0, 0), b2, voffB); PG8_STAGE(PG8_SB(0, 1), b2 + hstepB, voffB); PG8_STAGE_A(PG8_SA(0, 0), a2, 0, 1); PG8_PREFETCH(t + PF_D);
            PG8_WAIT_VP(); PG8_WAIT_L(0); PG8_BAR; PG8_MMA(1, 0, At, B0); PG8_MMA(1, 1, At, B1); PG8_BAR; PG8_SCHED;
            PG8_LDB(B0, 1, 0); PG8_LDB(B1, 1, 1); PG8_SCHED; PG8_LDA(At, 1, 0); PG8_STAGE_A(PG8_SA(0, 1), a2, 1, 1);
            PG8_WAIT_VP(); PG8_WAIT_L(0); PG8_BAR; PG8_MMA(0, 0, At, B0); PG8_MMA(0, 1, At, B1); PG8_BAR; PG8_SCHED;
            PG8_LDA(At, 1, 1); PG8_STAGE(PG8_SB(1, 0), b3, voffB); PG8_STAGE(PG8_SB(1, 1), b3 + hstepB, voffB); PG8_STAGE_A(PG8_SA(1, 0), a3, 0, 1); PG8_PREFETCH(t + 1 + PF_D);
            PG8_WAIT_VP(); PG8_WAIT_L(0); PG8_BAR; PG8_MMA(1, 0, At, B0); PG8_MMA(1, 1, At, B1); PG8_BAR; PG8_SCHED;
            } else {
            PG8_LDB(B0, 0, 0); PG8_SCHED; PG8_LDA(At, 0, 0); PG8_STAGE_A(PG8_SA(1, 1), a1, 1, 0);
            PG8_WAIT_L(8); PG8_BAR; PG8_WAIT_L(0); PG8_MMA(0, 0, At, B0); PG8_BAR; PG8_SCHED;
            PG8_LDB(B1, 0, 1); PG8_STAGE(PG8_SB(0, 0), b2, voffB);
            PG8_BAR; PG8_WAIT_L(0); PG8_MMA(0, 1, At, B1); PG8_BAR;
            PG8_LDA(At, 0, 1); PG8_STAGE_A(PG8_SA(0, 0), a2, 0, 1);
            PG8_BAR; PG8_WAIT_L(0); PG8_MMA(1, 0, At, B0); PG8_BAR; PG8_SCHED;
            PG8_STAGE(PG8_SB(0, 1), b2 + hstepB, voffB);
            PG8_WAIT_V(6); PG8_BAR; PG8_MMA(1, 1, At, B1); PG8_BAR;
            PG8_LDB(B0, 1, 0); PG8_SCHED; PG8_LDA(At, 1, 0); PG8_STAGE_A(PG8_SA(0, 1), a2, 1, 1);
            PG8_WAIT_L(8); PG8_BAR; PG8_WAIT_L(0); PG8_MMA(0, 0, At, B0); PG8_BAR; PG8_SCHED;
            PG8_LDB(B1, 1, 1); PG8_STAGE(PG8_SB(1, 0), b3, voffB);
            PG8_BAR; PG8_WAIT_L(0); PG8_MMA(0, 1, At, B1); PG8_BAR;
            PG8_LDA(At, 1, 1); PG8_STAGE_A(PG8_SA(1, 0), a3, 0, 1);
            PG8_BAR; PG8_WAIT_L(0); PG8_MMA(1, 0, At, B0); PG8_BAR; PG8_SCHED;
            PG8_STAGE(PG8_SB(1, 1), b3 + hstepB, voffB);
            PG8_WAIT_V(6); PG8_BAR; PG8_MMA(1, 1, At, B1); PG8_BAR;
            }
        }
        if constexpr (ALIGN_EPI) { if (wr == 0) PG8_BAR; }
        if constexpr (FP8) asm volatile("s_nop 15\n\ts_nop 15" ::: "memory");
        if constexpr (!Epi::AFTER_DRAIN && (DBG & 4) == 0) { E(acc, cur, wr, wc, fr, fq); S.done(cur); }
        if (!has_next) break;
#pragma unroll
        for (int a = 0; a < 2; ++a)
#pragma unroll
            for (int b = 0; b < 2; ++b)
#pragma unroll
                for (int m = 0; m < 4; ++m)
#pragma unroll
                    for (int n = 0; n < 2; ++n) acc[a][b][m][n] = (f32x4){0.f, 0.f, 0.f, 0.f};
        cur = nxt; cA = nA; cB = nB; ++ui;
        if constexpr (ALIGN_EPI) { if (wr == 1) PG8_BAR; }
    }
    PG8_WAIT_V(0);
    if constexpr (!ALIGN_EPI) { if (wr == 0) PG8_BAR; }
    PG8_BAR;
    if constexpr (Epi::AFTER_DRAIN) { E.fused(acc, cur, wr, wc, fr, fq, lds, wid, lane); S.done(cur); }
#undef PG8_SA
#undef PG8_SB
#undef PG8_STAGE
#undef PG8_STAGE_A
#undef PG8_LDA
#undef PG8_LDB
#undef PG8_MMA
#undef PG8_WAIT_V
#undef PG8_WAIT_VP
#undef PG8_PREFETCH
#undef PG8_WAIT_L
#undef PG8_BAR
#undef PG8_SCHED
}
}
constexpr int NTOK = 32768, DM = 1024, SEQ = 2048, NBATCH = 16, MEMLEN = 256, NMEM = NBATCH * MEMLEN, INW = 3088, NEXP = 32, TOPK = 4;
constexpr int PW = 3072;
constexpr int MAXTILES = 544;
constexpr float EPS = 1e-6f;
constexpr int NWAVES = 8;
constexpr size_t MiB = 1u << 20;
constexpr size_t WS_CTL = 0, CTL_ZERO_BYTES = 64 * 1024;
constexpr size_t WS_WINT = 2 * MiB, WS_WOUT = 10 * MiB, WS_WCQ = 12 * MiB, WS_WCK = 14 * MiB, WS_WCV = 16 * MiB, WS_WCO = 18 * MiB;
constexpr size_t WS_WR = 20 * MiB, WS_CS = 21 * MiB, WS_SSP1 = 24 * MiB, WS_GATE = 27 * MiB, WS_ASSIGN = 28 * MiB, WS_LIST = 29 * MiB;
constexpr size_t WS_RSL = 842 * MiB;
constexpr size_t WS_X2B = 378 * MiB;
constexpr size_t WS_WUP = 34 * MiB, WS_WDN = 162 * MiB, WS_KX = 226 * MiB, WS_VXT = 234 * MiB;
constexpr size_t WS_HN = 242 * MiB, WS_CAT = 242 * MiB, WS_MN = 306 * MiB, WS_P = 314 * MiB, WS_LA = 506 * MiB, WS_VT = 538 * MiB;
constexpr size_t WS_X1B = 314 * MiB, WS_GT = 378 * MiB, WS_HT = 410 * MiB, WS_PX = 506 * MiB;
constexpr size_t WS_GVT = 602 * MiB;
constexpr size_t WS_ACT = 570 * MiB, WS_Y = 706 * MiB, WS_END = 846 * MiB;
constexpr int CW_Q2 = 128;
constexpr int CW_CNT = 1024;
constexpr int CW_PROBE = 192;
constexpr int CW_BAR = 4096;
constexpr int RING_OFF = 0, RING_BYTES = 131072;
constexpr int LDSCTL_OFF = RING_BYTES, MISC_OFF = LDSCTL_OFF + 320;
constexpr int TAB_OFF = LDSCTL_OFF + 512;
constexpr int TAB_TSTART = TAB_OFF + 576, TAB_CNT = TAB_TSTART + 144;
constexpr int XCH2_OFF = LDSCTL_OFF + 6144;
constexpr int XCH_OFF = LDSCTL_OFF + 2048;
constexpr int TS_OFF = TAB_CNT + 128;
constexpr int LDS_BYTES = 147456;

#define GAS __attribute__((address_space(1)))
#define LAS __attribute__((address_space(3)))
typedef unsigned short bf16;
typedef unsigned v4u __attribute__((ext_vector_type(4)));
typedef float f32x4 __attribute__((ext_vector_type(4)));
typedef short bf16x8 __attribute__((ext_vector_type(8)));
typedef GAS unsigned gu32;
typedef GAS unsigned long long gu64;
#define RLX_AGENT __ATOMIC_RELAXED, __HIP_MEMORY_SCOPE_AGENT
#define LDS_WAIT() asm volatile("s_waitcnt lgkmcnt(0)" ::: "memory")
#define VM_WAIT() asm volatile("s_waitcnt vmcnt(0)" ::: "memory")
__device__ __forceinline__ unsigned long long rt() { return __builtin_amdgcn_s_memrealtime(); }
__device__ __forceinline__ unsigned f2bf(float f) { unsigned u = __builtin_bit_cast(unsigned, f); return (u + 0x7fffu + ((u >> 16) & 1u)) >> 16; }
__device__ __forceinline__ unsigned pk2(float lo, float hi) { return f2bf(lo) | (f2bf(hi) << 16); }

#define XB_TMO      128
#define XB_XCNT(j)  (256  + 64 * (j))
#define XB_XSUB(j)  (1280 + 64 * (j))
#define XB_XGEN(j)  (2304 + 64 * (j))
#define XB_TOP      3328
#define XB_TOPGEN   3392
#define XCD_BAR_WORDS 3456
#define XB_SPIN_CAP (1u << 18)

__device__ __forceinline__ unsigned xb_ld(unsigned* p)              { return __hip_atomic_load(p, __ATOMIC_RELAXED, __HIP_MEMORY_SCOPE_AGENT); }
__device__ __forceinline__ unsigned xb_add(unsigned* p, unsigned v) { return __hip_atomic_fetch_add(p, v, __ATOMIC_RELAXED, __HIP_MEMORY_SCOPE_AGENT); }
__device__ __forceinline__ unsigned xb_xcc_id() { return (unsigned)__builtin_amdgcn_s_getreg((3 << 11) | 20) & 0xFu; }
#define XB_SPIN(cond, bar) do { unsigned _sp = 0; while (cond) { __builtin_amdgcn_s_sleep(1); \
    if ((++_sp & 255u) == 0u) { if (xb_ld(&(bar)[XB_TMO])) break; if (_sp > XB_SPIN_CAP) { atomicAdd(&(bar)[XB_TMO], 1u); break; } } } } while (0)

struct XcdBarrier {
    unsigned* bar; unsigned x;
    volatile LAS unsigned* st;
};

__device__ __forceinline__ XcdBarrier xcd_barrier_post(unsigned* bar, volatile LAS unsigned* st) {
    XcdBarrier b; b.bar = bar; b.x = xb_xcc_id(); b.st = st;
    if (threadIdx.x == 0) (void)xb_add(&bar[XB_XCNT(b.x)], 1u);
    return b;
}
__device__ __forceinline__ void xcd_barrier_complete(unsigned* bar, unsigned x, unsigned& nloc, unsigned& nx) {
    const unsigned G = gridDim.x * gridDim.y * gridDim.z;
    unsigned sum, cnt, mine, sp = 0u;
    for (;;) {
        sum = 0u; cnt = 0u; mine = 0u;
#pragma unroll
        for (unsigned j = 0; j < 16; ++j) { const unsigned c = xb_ld(&bar[XB_XCNT(j)]); sum += c; cnt += (c > 0u) ? 1u : 0u; mine = (j == x) ? c : mine; }
        if (sum == G) break;
        __builtin_amdgcn_s_sleep(1);
        if ((++sp & 255u) == 0u) { if (xb_ld(&bar[XB_TMO])) break; if (sp > XB_SPIN_CAP) { atomicAdd(&bar[XB_TMO], 1u); break; } }
    }
    nloc = mine > 0u ? mine : 1u; nx = cnt > 0u ? cnt : 1u;
}

__device__ __forceinline__ void xcd_barrier(const XcdBarrier& b) {
    asm volatile("s_waitcnt vmcnt(0)" ::: "memory");
    __syncthreads();
    if (threadIdx.x == 0) {
        unsigned* bar = b.bar;
        __builtin_amdgcn_s_waitcnt(0);
        unsigned nloc = b.st[0], nx = b.st[1];
        if (nloc == 0u) { xcd_barrier_complete(bar, b.x, nloc, nx); b.st[0] = nloc; b.st[1] = nx; }
        const unsigned old = xb_add(&bar[XB_XSUB(b.x)], 1u);
        const unsigned gen = old / nloc;
        if (old + 1u == (gen + 1u) * nloc) {
            __builtin_amdgcn_fence(__ATOMIC_RELEASE, "agent");
            asm volatile("s_waitcnt vmcnt(0)" ::: "memory");
            const unsigned og = xb_add(&bar[XB_TOP], 1u);
            const unsigned tg = og / nx;
            if (og + 1u == (tg + 1u) * nx) xb_add(&bar[XB_TOPGEN], 1u);
            else XB_SPIN(xb_ld(&bar[XB_TOPGEN]) == tg, bar);
            __builtin_amdgcn_fence(__ATOMIC_ACQUIRE, "agent");
            xb_add(&bar[XB_XGEN(b.x)], 1u);
            asm volatile("s_waitcnt vmcnt(0)" ::: "memory");
        } else {
            XB_SPIN(xb_ld(&bar[XB_XGEN(b.x)]) == gen, bar);
            __builtin_amdgcn_fence(__ATOMIC_ACQUIRE, "agent");
            asm volatile("s_waitcnt vmcnt(0)" ::: "memory");
        }
    }
    __syncthreads();
}
typedef short bf16x4 __attribute__((ext_vector_type(4)));
typedef unsigned v2u __attribute__((ext_vector_type(2)));
struct Frame {
    LAS unsigned char* lds;
    volatile LAS unsigned* MISC;
    gu32* ctl;
    int tid, lane, wave;
    int vcu, G;
    unsigned char* ws;
    float* out;
};
__device__ __forceinline__ int lane_here() { int t = (int)threadIdx.x; asm volatile("" : "+v"(t)); return t & 63; }
__device__ __forceinline__ float bf2f(bf16 b) { return __builtin_bit_cast(float, (unsigned)b << 16); }
__device__ __forceinline__ float wave_sum(float v) {
#pragma unroll
    for (int o = 1; o < 64; o <<= 1) v += __shfl_xor(v, o);
    return v;
}
__device__ __forceinline__ float xmax16(float m) { auto rr = __builtin_amdgcn_permlane16_swap(__float_as_uint(m), __float_as_uint(m), false, false); return fmaxf(__uint_as_float(rr[0]), __uint_as_float(rr[1])); }
__device__ __forceinline__ float xmax32(float m) { auto rr = __builtin_amdgcn_permlane32_swap(__float_as_uint(m), __float_as_uint(m), false, false); return fmaxf(__uint_as_float(rr[0]), __uint_as_float(rr[1])); }
__device__ __forceinline__ f32x4 mfma16(bf16x8 a, bf16x8 b, f32x4 c) { return __builtin_amdgcn_mfma_f32_16x16x32_bf16(a, b, c, 0, 0, 0); }

__device__ __forceinline__ void p0_transpose_item(const float* W, int ldw, const float* gain, bf16* WT, int K, int k0, int n0, size_t orow0, int lane) {
    const int n4 = lane & 15, kq = lane >> 4;
    const float* src = W + (size_t)(k0 + 16 * kq) * ldw + n0 + 4 * n4;
    f32x4 v[16];
#pragma unroll
    for (int i = 0; i < 16; ++i) v[i] = *(const f32x4*)(src + (size_t)i * ldw);
    if (gain) { const f32x4* gp = (const f32x4*)(gain + k0 + 16 * kq);
#pragma unroll
        for (int q = 0; q < 4; ++q) { const f32x4 gq = gp[q];
#pragma unroll
            for (int r = 0; r < 4; ++r) v[4 * q + r] = v[4 * q + r] * gq[r]; } }
    bf16* dst = WT + (orow0 + 4 * n4) * (size_t)K + k0 + 16 * kq;
#pragma unroll
    for (int j = 0; j < 4; ++j) { v4u o0, o1;
        o0.x = pg8::cvtpk(v[0][j], v[1][j]); o0.y = pg8::cvtpk(v[2][j], v[3][j]); o0.z = pg8::cvtpk(v[4][j], v[5][j]); o0.w = pg8::cvtpk(v[6][j], v[7][j]);
        o1.x = pg8::cvtpk(v[8][j], v[9][j]); o1.y = pg8::cvtpk(v[10][j], v[11][j]); o1.z = pg8::cvtpk(v[12][j], v[13][j]); o1.w = pg8::cvtpk(v[14][j], v[15][j]);
        *(v4u*)(dst + (size_t)j * K) = o0; *(v4u*)(dst + (size_t)j * K + 8) = o1; }
}
__device__ __forceinline__ void p0_transpose_item8(const float* W, int ldw, const float* gain, unsigned char* WT, int K, int k0, int n0, size_t orow0, int lane) {
    const int n4 = lane & 15, kq = lane >> 4;
    const float* src = W + (size_t)(k0 + 16 * kq) * ldw + n0 + 4 * n4;
    f32x4 v[16];
#pragma unroll
    for (int i = 0; i < 16; ++i) v[i] = *(const f32x4*)(src + (size_t)i * ldw);
    { const f32x4* gp = (const f32x4*)(gain + k0 + 16 * kq);
#pragma unroll
        for (int q = 0; q < 4; ++q) { f32x4 gq = {32.f, 32.f, 32.f, 32.f}; if (gain) gq = gp[q] * 32.0f;
#pragma unroll
            for (int r = 0; r < 4; ++r) v[4 * q + r] = v[4 * q + r] * gq[r]; } }
    unsigned char* dst = WT + (orow0 + 4 * n4) * (size_t)K + k0 + 16 * kq;
#pragma unroll
    for (int j = 0; j < 4; ++j) { v4u o;
        o.x = pg8::cvt4_fp8((f32x4){v[0][j], v[1][j], v[2][j], v[3][j]}); o.y = pg8::cvt4_fp8((f32x4){v[4][j], v[5][j], v[6][j], v[7][j]});
        o.z = pg8::cvt4_fp8((f32x4){v[8][j], v[9][j], v[10][j], v[11][j]}); o.w = pg8::cvt4_fp8((f32x4){v[12][j], v[13][j], v[14][j], v[15][j]});
        *(v4u*)(dst + (size_t)j * K) = o; }
}
template <int NR> __device__ __forceinline__ void rms_rows_to_bf16(const float* const (&xrow)[NR], const float* g, bf16* const (&orow)[NR], int lane) {
    f32x4 v[NR][4]; float s[NR];
#pragma unroll
    for (int r = 0; r < NR; ++r) { const f32x4* xr = (const f32x4*)xrow[r] + lane;
#pragma unroll
        for (int j = 0; j < 4; ++j) v[r][j] = xr[64 * j]; }
    const f32x4* gr = (const f32x4*)g + lane; f32x4 gg[4];
#pragma unroll
    for (int j = 0; j < 4; ++j) gg[j] = gr[64 * j];
#pragma unroll
    for (int r = 0; r < NR; ++r) { s[r] = 0.f;
#pragma unroll
        for (int j = 0; j < 4; ++j) s[r] += (v[r][j].x * v[r][j].x + v[r][j].y * v[r][j].y) + (v[r][j].z * v[r][j].z + v[r][j].w * v[r][j].w); }
#pragma unroll
    for (int r = 0; r < NR; ++r) { const float rs = rsqrtf(wave_sum(s[r]) * (1.0f / DM) + EPS); unsigned long long* o8 = (unsigned long long*)orow[r] + lane;
#pragma unroll
        for (int j = 0; j < 4; ++j) o8[64 * j] = (unsigned long long)pk2(v[r][j].x * rs * gg[j].x, v[r][j].y * rs * gg[j].y) | ((unsigned long long)pk2(v[r][j].z * rs * gg[j].z, v[r][j].w * rs * gg[j].w) << 32); }
}
constexpr int MOE_I_UP = 32 * 16 * 32, MOE_I_DN = 32 * 16 * 16, MOE_UNITS = (MOE_I_UP + MOE_I_DN) / 64;
__device__ __forceinline__ void moe_convert_unit(int unit, const float* w_up, const float* w_down, const float* g_ffn, unsigned char* ws, int wave, int lane) {
#pragma unroll 1
    for (int j = 0; j < 8; ++j) { int r = unit * 64 + j * 8 + wave;
        if (r < MOE_I_UP) { const int e = r / (16 * 32); r -= e * (16 * 32); const int n0 = 64 * (r % 32);
            const size_t orow = (size_t)e * 2048 + ((n0 & 1023) >> 7) * 256 + (n0 >> 10) * 128 + (n0 & 127);
            p0_transpose_item8(w_up + (size_t)e * DM * 2048, 2048, g_ffn, ws + WS_WUP, DM, 64 * (r / 32), n0, orow, lane); }
        else { r -= MOE_I_UP; const int e = r / (16 * 16); r -= e * (16 * 16);
            p0_transpose_item8(w_down + (size_t)e * DM * DM, DM, nullptr, ws + WS_WDN, DM, 64 * (r / 16), 64 * (r % 16), (size_t)e * 1024 + 64 * (r % 16), lane); } }
}
struct In {
    const float *x, *mem; const int* positions; const float *norm_mix_g, *w_in, *lq1, *lk1, *lq2, *lk2, *diff_norm_g, *w_alpha2, *b_alpha, *gla_norm_g, *w_out, *norm_cross_g, *norm_mem_g,
        *w_cq, *w_ck, *w_cv, *w_co, *norm_ffn_g, *w_router, *b_router, *w_up, *b_up, *w_down, *b_down, *norm_final_g;
};
__device__ __forceinline__ void p0_prologue(Frame& F, const In& I) {
    const int gw = F.vcu * NWAVES + F.wave, NGW = F.G * NWAVES, lane = lane_here();
    unsigned char* ws = F.ws;
    constexpr int I_IN = 16 * 48, I_SQ = 16 * 16;
    constexpr int NITEMS = I_IN + 4 * I_SQ;
    for (int it = gw; it < NITEMS; it += NGW) {
        int r = it;
        if (r < I_IN) { p0_transpose_item(I.w_in, INW, nullptr, (bf16*)(ws + WS_WINT), DM, 64 * (r / 48), 64 * (r % 48), (size_t)64 * (r % 48), lane); continue; } r -= I_IN;
        { const int w = r / I_SQ; r -= w * I_SQ;
            const float* W = w == 0 ? I.w_out : w == 1 ? I.w_ck : w == 2 ? I.w_cv : I.w_co;
            bf16* WT = (bf16*)(ws + (w == 0 ? WS_WOUT : w == 1 ? WS_WCK : w == 2 ? WS_WCV : WS_WCO));
            p0_transpose_item(W, DM, nullptr, WT, DM, 64 * (r / 16), 64 * (r % 16), (size_t)64 * (r % 16), lane); }
    }
    for (int idx = F.vcu * (NWAVES * 64) + F.tid; idx < DM * DM / 4; idx += F.G * NWAVES * 64) { const f32x4 v = ((const f32x4*)I.w_cq)[idx] * I.norm_cross_g[idx >> 8];
        v2u o; o.x = pk2(v.x, v.y); o.y = pk2(v.z, v.w); ((v2u*)(ws + WS_WCQ))[idx] = o; }
#if defined(PROBE_P0)
    if (F.tid == 0) ((LAS unsigned long long*)(F.lds + TS_OFF))[13] = rt();
#endif
    const int gt = F.vcu * (NWAVES * 64) + F.tid, NGT = F.G * NWAVES * 64;
    for (int idx = gt; idx < 256 * DM; idx += NGT) { const int j = idx >> 10, k = idx & 1023; const float* wr = I.w_in + (size_t)k * INW + 3072; float s = 0.f;
#pragma unroll
        for (int r = 0; r < 16; ++r) s += wr[r] * I.w_alpha2[r * 256 + j];
        ((bf16*)(ws + WS_WINT))[(size_t)(3072 + j) * DM + k] = (bf16)f2bf(s); }
    for (int idx = gt; idx < DM * NEXP; idx += NGT) { const int e = idx >> 10, k = idx & 1023; ((float*)(ws + WS_WR))[idx] = I.w_router[k * NEXP + e] * I.norm_ffn_g[k]; }
    for (int idx = gt; idx < NTOK * 8; idx += NGT) { const int tok = idx >> 3, i = idx & 7;
        const double inv = exp(-(double)i * 0.125 * 13.122363377404328); const double ang = (double)I.positions[tok] * inv;
        const double red = ang - rint(ang * 0.15915494309189535) * 6.283185307179586; const float rf = (float)red;
        float* cs = (float*)(ws + WS_CS) + (size_t)tok * 16; cs[i] = cosf(rf); cs[8 + i] = sinf(rf); }
#if defined(PROBE_P0)
    if (F.tid == 0) ((LAS unsigned long long*)(F.lds + TS_OFF))[14] = rt();
#endif
    for (int m = gw * 4; m < NTOK; m += NGW * 4) { const float* xr[4]; bf16* orw[4];
#pragma unroll
        for (int r = 0; r < 4; ++r) { xr[r] = I.x + (size_t)(m + r) * DM; orw[r] = (bf16*)(ws + WS_HN) + (size_t)(m + r) * DM; }
        rms_rows_to_bf16<4>(xr, I.norm_mix_g, orw, lane); }
    for (int m = gw * 4; m < NMEM; m += NGW * 4) { const float* xr[4]; bf16* orw[4];
#pragma unroll
        for (int r = 0; r < 4; ++r) { xr[r] = I.mem + (size_t)(m + r) * DM; orw[r] = (bf16*)(ws + WS_MN) + (size_t)(m + r) * DM; }
        rms_rows_to_bf16<4>(xr, I.norm_mem_g, orw, lane); }
}

constexpr int DA_KBUF = 16384, DA_VBUF = 16384, DA_VOFF = 2 * DA_KBUF;
template <int DBG = 0> __device__ __forceinline__ void diffattn_unit(Frame& F, const bf16* P, const bf16* VT, bf16* CAT, const float* gdiff, float lam, int b, int h, int qblk) {
    const int lane = lane_here(), wave = F.wave, tid = F.tid, l15 = lane & 15, g = lane >> 4;
    LAS unsigned char* lds = F.lds + RING_OFF;
    const int q0 = qblk * 128 + wave * 16;
    const size_t tokq = (size_t)b * SEQ + q0 + l15;
    bf16x8 qf[2][2];
#pragma unroll
    for (int c = 0; c < 2; ++c)
#pragma unroll
        for (int ks = 0; ks < 2; ++ks) qf[c][ks] = *(const bf16x8*)(P + tokq * PW + h * 128 + c * 64 + ks * 32 + g * 8);
    f32x4 o[2][8];
#pragma unroll
    for (int c = 0; c < 2; ++c)
#pragma unroll
        for (int k = 0; k < 8; ++k) o[c][k] = (f32x4){0.f, 0.f, 0.f, 0.f};
    float mrun[2] = {0.f, 0.f}, lsum[2] = {0.f, 0.f};
    const int nk = q0 + 16;
    const int nt = 2 * qblk + 2;
    const int skey = tid >> 4, sch = tid & 15, vrow = tid >> 3, vpc = tid & 7;
    const bf16* ksrc = P + ((size_t)b * SEQ + skey) * PW + 512 + h * 128 + sch * 8;
    const bf16* vsrc = VT + (size_t)(h * 128 + vrow) * NTOK + (size_t)b * SEQ + vpc * 8;
    const int kdst = skey * 256 + ((sch ^ (skey & 15)) * 16);
    const int vfr = (vrow >> 1) & 7, vch = (vpc >> 2) * 4 + 2 * (vpc & 1), vhi = ((vpc & 3) >> 1) * 8;
    const int vdst0 = DA_VOFF + vrow * 128 + ((vch ^ vfr) * 16) + vhi, vdst1 = DA_VOFF + vrow * 128 + (((vch + 1) ^ vfr) * 16) + vhi;
    int koff[2][2];
#pragma unroll
    for (int c = 0; c < 2; ++c)
#pragma unroll
        for (int ks = 0; ks < 2; ++ks) koff[c][ks] = l15 * 256 + (((c * 8 + ks * 4 + g) ^ l15) * 16);
    const int voffs[2] = {DA_VOFF + l15 * 128 + ((g ^ (l15 >> 1)) * 16), DA_VOFF + l15 * 128 + (((4 + g) ^ (l15 >> 1)) * 16)};
    v4u sk0, sk1, sv0, sv1;
#define DA_LOAD(tt) do { const bf16* kp_ = ksrc + (size_t)(tt) * 64 * PW; const bf16* vp_ = vsrc + (tt) * 64; \
        sk0 = *(const v4u*)kp_; sk1 = *(const v4u*)(kp_ + (size_t)32 * PW); sv0 = *(const v4u*)vp_; sv1 = *(const v4u*)(vp_ + (size_t)64 * NTOK); } while (0)
#define DA_STORE(bb) do { LAS unsigned char* kd_ = lds + (bb) * DA_KBUF + kdst; LAS unsigned char* vd_ = lds + (bb) * DA_VBUF; \
        *(LAS v4u*)kd_ = sk0; *(LAS v4u*)(kd_ + 8192) = sk1; \
        *(LAS v2u*)(vd_ + vdst0) = (v2u){sv0.x, sv0.y}; *(LAS v2u*)(vd_ + vdst1) = (v2u){sv0.z, sv0.w}; *(LAS v2u*)(vd_ + vdst0 + 8192) = (v2u){sv1.x, sv1.y}; *(LAS v2u*)(vd_ + vdst1 + 8192) = (v2u){sv1.z, sv1.w}; } while (0)
    DA_LOAD(0); DA_STORE(0);
    __syncthreads();
    auto step = [&](const int t, const int buf) __attribute__((always_inline)) {
        if (t * 64 < nk) {
            const LAS unsigned char* kb = lds + buf * DA_KBUF; const LAS unsigned char* vb = lds + buf * DA_VBUF;
            f32x4 s[2][2][2];
#pragma unroll
            for (int sub = 0; sub < 2; ++sub)
#pragma unroll
                for (int c = 0; c < 2; ++c)
#pragma unroll
                    for (int s2 = 0; s2 < 2; ++s2) { f32x4 a = (f32x4){-mrun[c], -mrun[c], -mrun[c], -mrun[c]};
#pragma unroll
                        for (int ks = 0; ks < 2; ++ks) { const bf16x8 kf = (DBG & 2) ? qf[c][ks ^ 1] : *(const LAS bf16x8*)(kb + sub * 8192 + s2 * 4096 + koff[c][ks]); if constexpr ((DBG & 1) == 0) a = mfma16(kf, qf[c][ks], a); else a[ks] += __builtin_bit_cast(float, (int)kf[0] << 16); }
                        s[sub][c][s2] = a; }
            if (t * 64 + 63 > q0) {
                const int qrow = q0 + l15;
#pragma unroll
                for (int sub = 0; sub < 2; ++sub)
#pragma unroll
                    for (int c = 0; c < 2; ++c)
#pragma unroll
                        for (int s2 = 0; s2 < 2; ++s2)
#pragma unroll
                            for (int r = 0; r < 4; ++r) if (t * 64 + sub * 32 + s2 * 16 + 4 * g + r > qrow) s[sub][c][s2][r] = -INFINITY;
            }
            float dl[2]; bool grow = false;
#pragma unroll
            for (int c = 0; c < 2; ++c) { float mx = -INFINITY;
#pragma unroll
                for (int sub = 0; sub < 2; ++sub)
#pragma unroll
                    for (int s2 = 0; s2 < 2; ++s2) mx = fmaxf(mx, fmaxf(fmaxf(s[sub][c][s2][0], s[sub][c][s2][1]), fmaxf(s[sub][c][s2][2], s[sub][c][s2][3])));
                mx = xmax16(mx); mx = xmax32(mx);
                dl[c] = (t == 0 || mx > 8.0f) ? mx : 0.f; grow = grow || (dl[c] != 0.f); }
            if (__any(grow)) {
#pragma unroll
                for (int c = 0; c < 2; ++c) { const float alpha = __builtin_amdgcn_exp2f(-dl[c]); mrun[c] += dl[c]; lsum[c] *= alpha;
#pragma unroll
                    for (int k = 0; k < 8; ++k) o[c][k] = o[c][k] * alpha;
#pragma unroll
                    for (int sub = 0; sub < 2; ++sub)
#pragma unroll
                        for (int s2 = 0; s2 < 2; ++s2)
#pragma unroll
                            for (int r = 0; r < 4; ++r) s[sub][c][s2][r] -= dl[c]; }
            }
#pragma unroll
            for (int sub = 0; sub < 2; ++sub) {
                bf16x8 pb[2];
#pragma unroll
                for (int c = 0; c < 2; ++c) { float ps = 0.f;
#pragma unroll
                    for (int s2 = 0; s2 < 2; ++s2)
#pragma unroll
                        for (int r = 0; r < 4; ++r) { const float p = (DBG & 4) ? s[sub][c][s2][r] * 0.001f : __builtin_amdgcn_exp2f(s[sub][c][s2][r]); s[sub][c][s2][r] = p; ps += p; }
                    lsum[c] += ps;
                    v4u w; w.x = pg8::cvtpk(s[sub][c][0][0], s[sub][c][0][1]); w.y = pg8::cvtpk(s[sub][c][0][2], s[sub][c][0][3]); w.z = pg8::cvtpk(s[sub][c][1][0], s[sub][c][1][1]); w.w = pg8::cvtpk(s[sub][c][1][2], s[sub][c][1][3]);
                    pb[c] = __builtin_bit_cast(bf16x8, w); }
#pragma unroll
                for (int k = 0; k < 8; ++k) { const bf16x8 vf = (DBG & 2) ? qf[k & 1][(k >> 1) & 1] : *(const LAS bf16x8*)(vb + voffs[sub] + k * 2048);
                    if constexpr ((DBG & 1) == 0) { o[0][k] = mfma16(vf, pb[0], o[0][k]); o[1][k] = mfma16(vf, pb[1], o[1][k]); }
                    else { o[0][k][0] += __builtin_bit_cast(float, (int)vf[0] << 16) + __builtin_bit_cast(float, (int)pb[0][k] << 16); o[1][k][0] += __builtin_bit_cast(float, (int)pb[1][k] << 16); } }
            }
        }
    };
    for (int t = 0; t < nt; ++t) {
        if ((DBG & 8) == 0 && t + 1 < nt) DA_LOAD(t + 1);
        step(t, t & 1);
        if ((DBG & 8) == 0 && t + 1 < nt) DA_STORE((t & 1) ^ 1);
        __syncthreads();
    }
#undef DA_LOAD
#undef DA_STORE
    float l0 = lsum[0], l1 = lsum[1];
    l0 += __shfl_xor(l0, 16); l0 += __shfl_xor(l0, 32); l1 += __shfl_xor(l1, 16); l1 += __shfl_xor(l1, 32);
    const float i0 = 1.0f / l0, i1 = lam / l1; float ss = 0.f;
#pragma unroll
    for (int k = 0; k < 8; ++k)
#pragma unroll
        for (int r = 0; r < 4; ++r) { const float v = o[0][k][r] * i0 - o[1][k][r] * i1; o[0][k][r] = v; ss += v * v; }
    ss += __shfl_xor(ss, 16); ss += __shfl_xor(ss, 32);
    const float rs = rsqrtf(ss * (1.0f / 128.0f) + EPS) * 0.8f;
    bf16* op = CAT + tokq * DM + h * 128 + 4 * g;
#pragma unroll
    for (int k = 0; k < 8; ++k) { const f32x4 gg = *(const f32x4*)(gdiff + k * 16 + 4 * g); f32x4 v = o[0][k] * rs; v = v * gg; pg8::st_bf4(op + k * 16, v); }
}

__device__ __forceinline__ bf16x8 pack8(const f32x4& a, const f32x4& b) { v4u w; w.x = pg8::cvtpk(a[0], a[1]); w.y = pg8::cvtpk(a[2], a[3]); w.z = pg8::cvtpk(b[0], b[1]); w.w = pg8::cvtpk(b[2], b[3]); return __builtin_bit_cast(bf16x8, w); }
constexpr int GL_QI = 0, GL_KI = 8192, GL_IMG = 16384, GL_EL = 2 * GL_IMG, GL_OB = GL_EL + 512, GL_OBS = 17408, GL_PS = GL_OB + 2 * GL_OBS, GL_END = GL_PS + 4096;

__device__ __forceinline__ void gla_unit(Frame& F, const bf16* P, const float* Bc, const bf16* GVT, bf16* CAT, const float* ggla, int b, int h) {
    const int lane = lane_here(), l15 = lane & 15, g = lane >> 4, eb = F.wave, tid = F.tid;
    LAS unsigned char* lds = F.lds + RING_OFF;
    const f32x4 zero4 = {0.f, 0.f, 0.f, 0.f};
    f32x4 S[4] = {zero4, zero4, zero4, zero4};
    bf16x8 If[4];
#pragma unroll
    for (int db = 0; db < 4; ++db) { const int ks = db >> 1;
#pragma unroll
        for (int j = 0; j < 8; ++j) { const int dp = 32 * ks + (j < 4 ? 4 * g + j : 16 + 4 * g + j - 4); If[db][j] = (dp == 16 * db + l15) ? (short)0x3F80 : (short)0; } }
    const int st = tid >> 3, sp = tid & 7, opc = tid & 15;
    const size_t tokb = (size_t)b * SEQ;
    const bf16* qsrc = P + (tokb + st) * PW + 1536 + h * 64 + sp * 8;
    const float* bsrc = Bc + (tokb + st) * 256 + h * 64 + sp * 8;
    const bf16* Vrow = GVT + (size_t)(h * 128 + 16 * eb + l15) * NTOK + tokb + 4 * g;
    const f32x4 gg0 = *(const f32x4*)(ggla + opc * 8), gg1 = *(const f32x4*)(ggla + opc * 8 + 4);
    const int foffs[2] = {l15 * 128 + ((g ^ (l15 >> 1)) * 16), l15 * 128 + (((4 + g) ^ (l15 >> 1)) * 16)};
    const int sfr = (st >> 1) & 7, sch0 = (sp >> 2) * 4 + 2 * (sp & 1), shi = ((sp & 3) >> 1) * 8, sd0 = st * 128 + ((sch0 ^ sfr) * 16) + shi, sd1 = st * 128 + (((sch0 + 1) ^ sfr) * 16) + shi;
    v4u rq = *(const v4u*)qsrc, rk = *(const v4u*)(qsrc + 256); f32x4 rb0 = *(const f32x4*)bsrc, rb1 = *(const f32x4*)(bsrc + 4);
#define GLA_STAGE(par) do { \
        float ee[8]; _Pragma("unroll") for (int i = 0; i < 4; ++i) { ee[i] = __expf(rb0[i]); ee[4 + i] = __expf(rb1[i]); } \
        const unsigned qa[4] = {rq.x, rq.y, rq.z, rq.w}, ka[4] = {rk.x, rk.y, rk.z, rk.w}; v4u wq, wk; unsigned* wqp = (unsigned*)&wq; unsigned* wkp = (unsigned*)&wk; \
        _Pragma("unroll") for (int i = 0; i < 4; ++i) { const float q0 = __builtin_bit_cast(float, qa[i] << 16), q1 = __builtin_bit_cast(float, qa[i] & 0xffff0000u), k0 = __builtin_bit_cast(float, ka[i] << 16), k1 = __builtin_bit_cast(float, ka[i] & 0xffff0000u); \
            wqp[i] = pg8::cvtpk(q0 * ee[2 * i], q1 * ee[2 * i + 1]); wkp[i] = pg8::cvtpk(k0 * __builtin_amdgcn_rcpf(ee[2 * i]), k1 * __builtin_amdgcn_rcpf(ee[2 * i + 1])); } \
        { LAS unsigned char* ib_ = lds + (par) * GL_IMG; *(LAS v2u*)(ib_ + GL_QI + sd0) = (v2u){wq.x, wq.y}; *(LAS v2u*)(ib_ + GL_QI + sd1) = (v2u){wq.z, wq.w}; *(LAS v2u*)(ib_ + GL_KI + sd0) = (v2u){wk.x, wk.y}; *(LAS v2u*)(ib_ + GL_KI + sd1) = (v2u){wk.z, wk.w}; } \
        if (st == 63) { *(LAS f32x4*)(lds + GL_EL + (par) * 256 + sp * 32) = (f32x4){ee[0], ee[1], ee[2], ee[3]}; *(LAS f32x4*)(lds + GL_EL + (par) * 256 + sp * 32 + 16) = (f32x4){ee[4], ee[5], ee[6], ee[7]}; } } while (0)
    bf16x8 VFn[2];
#pragma unroll
    for (int ss = 0; ss < 2; ++ss) { const bf16* vp = Vrow + 32 * ss; const v2u v0 = *(const v2u*)vp, v1 = *(const v2u*)(vp + 16); v4u vv; vv.x = v0.x; vv.y = v0.y; vv.z = v1.x; vv.w = v1.y; VFn[ss] = __builtin_bit_cast(bf16x8, vv); }
    GLA_STAGE(0);
    __syncthreads();
    for (int c = 0; c < SEQ / 64; ++c) {
        const int par = c & 1; const size_t tok0 = tokb + c * 64;
        if (c + 1 < SEQ / 64) { rq = *(const v4u*)(qsrc + (size_t)(c + 1) * 64 * PW); rk = *(const v4u*)(qsrc + (size_t)(c + 1) * 64 * PW + 256);
            rb0 = *(const f32x4*)(bsrc + (size_t)(c + 1) * 64 * 256); rb1 = *(const f32x4*)(bsrc + (size_t)(c + 1) * 64 * 256 + 4); }
        bf16x8 VF[2] = {VFn[0], VFn[1]};
        if (c + 1 < SEQ / 64) {
#pragma unroll
            for (int ss = 0; ss < 2; ++ss) { const bf16* vp = Vrow + (c + 1) * 64 + 32 * ss; const v2u v0 = *(const v2u*)vp, v1 = *(const v2u*)(vp + 16); v4u vv; vv.x = v0.x; vv.y = v0.y; vv.z = v1.x; vv.w = v1.y; VFn[ss] = __builtin_bit_cast(bf16x8, vv); } }
        v4u rg[2];
#pragma unroll
        for (int i = 0; i < 2; ++i) rg[i] = *(const v4u*)(P + (tok0 + ((tid + 512 * i) >> 4)) * PW + 2560 + h * 128 + opc * 8);
        const LAS unsigned char* qi = lds + par * GL_IMG + GL_QI; const LAS unsigned char* ki = lds + par * GL_IMG + GL_KI;
        bf16x8 qf[4][2], kf[4][2];
#pragma unroll
        for (int blk = 0; blk < 4; ++blk)
#pragma unroll
            for (int ks = 0; ks < 2; ++ks) { qf[blk][ks] = *(const LAS bf16x8*)(qi + foffs[ks] + blk * 2048); kf[blk][ks] = *(const LAS bf16x8*)(ki + foffs[ks] + blk * 2048); }
        const bf16x8 SF0 = pack8(S[0], S[1]), SF1 = pack8(S[2], S[3]);
        f32x4 O[4];
#pragma unroll
        for (int tb = 0; tb < 4; ++tb) { f32x4 o = mfma16(qf[tb][0], SF0, zero4); o = mfma16(qf[tb][1], SF1, o);
#pragma unroll
            for (int ss = 0; ss < 2; ++ss) if (2 * ss <= tb) { f32x4 a2[2];
#pragma unroll
                for (int hh = 0; hh < 2; ++hh) { const int sb = 2 * ss + hh; f32x4 a = zero4;
                    if (sb <= tb) { a = mfma16(kf[sb][0], qf[tb][0], zero4); a = mfma16(kf[sb][1], qf[tb][1], a);
                        if (sb == tb) {
#pragma unroll
                            for (int r = 0; r < 4; ++r) if (4 * g + r > l15) a[r] = 0.f; } }
                    a2[hh] = a; }
                o = mfma16(pack8(a2[0], a2[1]), VF[ss], o); }
            O[tb] = o; }
#pragma unroll
        for (int db = 0; db < 4; ++db) { f32x4 u = S[db];
#pragma unroll
            for (int ss = 0; ss < 2; ++ss) { const f32x4 t0 = mfma16(kf[2 * ss][db >> 1], If[db], zero4), t1 = mfma16(kf[2 * ss + 1][db >> 1], If[db], zero4); u = mfma16(pack8(t0, t1), VF[ss], u); }
            const f32x4 el = *(const LAS f32x4*)(lds + GL_EL + par * 256 + (16 * db + 4 * g) * 4);
            S[db] = u * el; }
        LAS unsigned char* ob = lds + GL_OB + par * GL_OBS; LAS float* ps = (LAS float*)(lds + GL_PS + par * 2048);
#pragma unroll
        for (int tb = 0; tb < 4; ++tb)
#pragma unroll
            for (int r = 0; r < 4; ++r) { const int t = 16 * tb + 4 * g + r; const float ov = O[tb][r]; float q = ov * ov; q += __shfl_xor(q, 1); q += __shfl_xor(q, 2); q += __shfl_xor(q, 4); q += __shfl_xor(q, 8);
                if (l15 == 0) ps[t * 8 + eb] = q;
                *(LAS bf16*)(ob + t * 272 + (16 * eb + l15) * 2) = (bf16)f2bf(ov); }
        if (c + 1 < SEQ / 64) GLA_STAGE(par ^ 1);
        __syncthreads();
#pragma unroll
        for (int i = 0; i < 2; ++i) { const int ot = (tid + 512 * i) >> 4; const f32x4 p0 = *(const LAS f32x4*)(ps + ot * 8), p1 = *(const LAS f32x4*)(ps + ot * 8 + 4);
            const float ss = ((p0[0] + p0[1]) + (p0[2] + p0[3])) + ((p1[0] + p1[1]) + (p1[2] + p1[3])); const float rs = rsqrtf(ss * (1.0f / 128.0f) + EPS);
            const v4u ov = *(const LAS v4u*)(ob + ot * 272 + opc * 16); const unsigned oa[4] = {ov.x, ov.y, ov.z, ov.w}, ga[4] = {rg[i].x, rg[i].y, rg[i].z, rg[i].w};
            const float gn[8] = {gg0[0], gg0[1], gg0[2], gg0[3], gg1[0], gg1[1], gg1[2], gg1[3]}; v4u w; unsigned* wp = (unsigned*)&w;
#pragma unroll
            for (int j = 0; j < 4; ++j) { const float o0 = __builtin_bit_cast(float, oa[j] << 16), o1 = __builtin_bit_cast(float, oa[j] & 0xffff0000u), g0 = __builtin_bit_cast(float, ga[j] << 16), g1 = __builtin_bit_cast(float, ga[j] & 0xffff0000u);
                wp[j] = pg8::cvtpk(o0 * rs * gn[2 * j] * g0 * __builtin_amdgcn_rcpf(1.0f + __builtin_amdgcn_exp2f(-1.4426950408889634f * g0)), o1 * rs * gn[2 * j + 1] * g1 * __builtin_amdgcn_rcpf(1.0f + __builtin_amdgcn_exp2f(-1.4426950408889634f * g1))); }
            *(v4u*)(CAT + (tok0 + ot) * DM + 512 + h * 128 + opc * 8) = w; }
    }
#undef GLA_STAGE
    __syncthreads();
}

__device__ __forceinline__ void router_phase(Frame& F, const bf16* X2, const float* WRt, const float* b_router, float* rsl, float* gate, unsigned* assign, unsigned* list, gu32* cnt) {
    typedef float f32x4v __attribute__((ext_vector_type(4)));
    LAS float* lg = (LAS float*)(F.lds + RING_OFF);
    LAS unsigned* hist = (LAS unsigned*)(lg + 128 * 33);
    const int tid = F.tid, lane = lane_here(), r16 = lane & 15, kq = lane >> 4, wv = F.wave, t = tid & 63;
    for (int blk = F.vcu; blk < NTOK / 128; blk += F.G) {
        const size_t tok0 = (size_t)blk * 128;
        const bf16* xp = X2 + (tok0 + wv * 16 + r16) * DM + 8 * kq; const float* w0 = WRt + (size_t)r16 * DM + 8 * kq; const float* w1 = w0 + (size_t)16 * DM;
        f32x4v acc0 = {0.f, 0.f, 0.f, 0.f}, acc1 = acc0; float ssq = 0.f;
#pragma unroll 4
        for (int m = 0; m < 32; ++m) { const v4u xw = *(const v4u*)(xp + 32 * m); const f32x4 a0 = *(const f32x4*)(w0 + 32 * m), a1 = *(const f32x4*)(w0 + 32 * m + 4), b0 = *(const f32x4*)(w1 + 32 * m), b1 = *(const f32x4*)(w1 + 32 * m + 4);
            const unsigned xa[4] = {xw.x, xw.y, xw.z, xw.w}; float xv[8];
#pragma unroll
            for (int j = 0; j < 4; ++j) { xv[2 * j] = __builtin_bit_cast(float, xa[j] << 16); xv[2 * j + 1] = __builtin_bit_cast(float, xa[j] & 0xffff0000u); }
            const float wa[8] = {a0[0], a0[1], a0[2], a0[3], a1[0], a1[1], a1[2], a1[3]}, wb[8] = {b0[0], b0[1], b0[2], b0[3], b1[0], b1[1], b1[2], b1[3]};
#pragma unroll
            for (int i = 0; i < 8; ++i) { acc0 = __builtin_amdgcn_mfma_f32_16x16x4f32(xv[i], wa[i], acc0, 0, 0, 0); acc1 = __builtin_amdgcn_mfma_f32_16x16x4f32(xv[i], wb[i], acc1, 0, 0, 0); ssq += xv[i] * xv[i]; } }
        ssq += __shfl_xor(ssq, 16); ssq += __shfl_xor(ssq, 32);
        float rsv[4];
#pragma unroll
        for (int j = 0; j < 4; ++j) { const float sq = __shfl(ssq, 4 * kq + j); rsv[j] = rsqrtf(sq * (1.0f / DM) + EPS); }
        const float br0 = b_router[r16], br1 = b_router[16 + r16];
#pragma unroll
        for (int j = 0; j < 4; ++j) { const int tl = wv * 16 + 4 * kq + j; lg[tl * 33 + r16] = acc0[j] * rsv[j] + br0; lg[tl * 33 + 16 + r16] = acc1[j] * rsv[j] + br1; if (r16 == 0) lg[tl * 33 + 32] = rsv[j]; }
        __syncthreads();
        if (tid < 128) {
            const int w2 = tid >> 6;
            float lv[32];
#pragma unroll
            for (int e = 0; e < 32; ++e) lv[e] = lg[tid * 33 + e];
            const float rs = lg[tid * 33 + 32];
            float tv[4]; int te[4];
#pragma unroll
            for (int k = 0; k < 4; ++k) { float best = -INFINITY; int bi = 0;
#pragma unroll
                for (int e = 0; e < 32; ++e) if (lv[e] > best) { best = lv[e]; bi = e; }
                tv[k] = best; te[k] = bi;
#pragma unroll
                for (int e = 0; e < 32; ++e) if (e == bi) lv[e] = -INFINITY; }
            const float e1 = __expf(tv[1] - tv[0]), e2 = __expf(tv[2] - tv[0]), e3 = __expf(tv[3] - tv[0]); const float inv = 1.0f / (1.0f + e1 + e2 + e3);
            const float gv[4] = {inv, e1 * inv, e2 * inv, e3 * inv};
            const size_t tok = tok0 + tid;
            LAS unsigned* hs = hist + w2 * 32; LAS unsigned* gbase = hist + 64 + w2 * 32;
            if (t < 32) hs[t] = 0u;
            __builtin_amdgcn_wave_barrier(); LDS_WAIT();
            unsigned lpos[4];
#pragma unroll
            for (int k = 0; k < 4; ++k) lpos[k] = __hip_atomic_fetch_add(hs + te[k], 1u, __ATOMIC_RELAXED, __HIP_MEMORY_SCOPE_WORKGROUP);
            __builtin_amdgcn_wave_barrier(); LDS_WAIT();
            if (t < 32) { const unsigned n = hs[t]; gbase[t] = n ? __hip_atomic_fetch_add(cnt + 64 * t, n, RLX_AGENT) : 0u; }
            __builtin_amdgcn_wave_barrier(); LDS_WAIT();
#pragma unroll
            for (int k = 0; k < 4; ++k) { const unsigned pos = gbase[te[k]] + lpos[k]; list[(size_t)te[k] * NTOK + pos] = (unsigned)tok; rsl[(size_t)te[k] * NTOK + pos] = rs;
                assign[tok * 4 + k] = ((unsigned)te[k] << 16) | pos; gate[tok * 4 + k] = gv[k]; }
        }
        __syncthreads();
    }
}
__device__ __forceinline__ int moe_tables(Frame& F) {
    LAS unsigned char* tile_e = F.lds + TAB_OFF; LAS int* tstart = (LAS int*)(F.lds + TAB_TSTART); LAS int* lc = (LAS int*)(F.lds + TAB_CNT);
    if (F.tid < 32) lc[F.tid] = (int)__hip_atomic_load(F.ctl + CW_CNT + 64 * F.tid, RLX_AGENT);
    __syncthreads();
    if (F.tid == 0) { int s = 0; for (int e = 0; e < 32; ++e) { tstart[e] = s; s += (lc[e] + 255) >> 8; } tstart[32] = s; }
    __syncthreads();
    const int T = tstart[32];
    for (int i = F.tid; i < T; i += 512) { int e = 0;
#pragma unroll
        for (int k = 1; k < 32; ++k) e += (tstart[k] <= i) ? 1 : 0;
        tile_e[i] = (unsigned char)e; }
    __syncthreads();
    return T;
}
__device__ __forceinline__ void final_phase(Frame& F, const bf16* X2, float* out, const unsigned char* Y, const float* gate, const unsigned* assign, const float* gfin) {
    (void)moe_tables(F);
    const LAS int* tstart = (const LAS int*)(F.lds + TAB_TSTART);
    const int gw = F.vcu * NWAVES + F.wave, NGW = F.G * NWAVES, lane = lane_here();
    unsigned an[2][4]; float gn[2][4];
#define FIN_ROUTE(t0) do { _Pragma("unroll") for (int u = 0; u < 2; ++u) { const int tok_ = ((t0) + u * NGW < NTOK) ? (t0) + u * NGW : ((t0) < NTOK ? (t0) : gw); \
        const v4u a4 = *(const v4u*)(assign + (size_t)tok_ * 4); const f32x4 g4 = *(const f32x4*)(gate + (size_t)tok_ * 4); \
        an[u][0] = a4.x; an[u][1] = a4.y; an[u][2] = a4.z; an[u][3] = a4.w; gn[u][0] = g4.x; gn[u][1] = g4.y; gn[u][2] = g4.z; gn[u][3] = g4.w; } } while (0)
    FIN_ROUTE(gw);
    for (int tok0 = gw; tok0 < NTOK; tok0 += 2 * NGW) {
        f32x4 v[2][4]; unsigned yw[2][4][4]; float gk[2][4];
#pragma unroll
        for (int u = 0; u < 2; ++u) { const int tok = (tok0 + u * NGW < NTOK) ? tok0 + u * NGW : tok0;
#pragma unroll
            for (int k = 0; k < 4; ++k) { const unsigned a = an[u][k]; gk[u][k] = gn[u][k]; const size_t row = (size_t)tstart[a >> 16] * 256 + (a & 0xffffu);
                const unsigned* yr = (const unsigned*)(Y + row * DM) + lane;
#pragma unroll
                for (int j = 0; j < 4; ++j) yw[u][k][j] = yr[64 * j]; }
            const v2u* xin = (const v2u*)(X2 + (size_t)tok * DM) + lane;
#pragma unroll
            for (int j = 0; j < 4; ++j) { const v2u w = xin[64 * j]; v[u][j] = (f32x4){__builtin_bit_cast(float, w.x << 16), __builtin_bit_cast(float, w.x & 0xffff0000u), __builtin_bit_cast(float, w.y << 16), __builtin_bit_cast(float, w.y & 0xffff0000u)}; } }
        FIN_ROUTE(tok0 + 2 * NGW);
#pragma unroll
        for (int u = 0; u < 2; ++u) { const int tok = (tok0 + u * NGW < NTOK) ? tok0 + u * NGW : tok0;
#pragma unroll
            for (int k = 0; k < 4; ++k)
#pragma unroll
                for (int j = 0; j < 4; ++j) { const unsigned w = yw[u][k][j]; const auto lo = __builtin_amdgcn_cvt_pk_f32_fp8((int)w, false), hi = __builtin_amdgcn_cvt_pk_f32_fp8((int)w, true);
                    v[u][j].x += gk[u][k] * lo[0]; v[u][j].y += gk[u][k] * lo[1]; v[u][j].z += gk[u][k] * hi[0]; v[u][j].w += gk[u][k] * hi[1]; }
            float s = 0.f;
#pragma unroll
            for (int j = 0; j < 4; ++j) s += (v[u][j].x * v[u][j].x + v[u][j].y * v[u][j].y) + (v[u][j].z * v[u][j].z + v[u][j].w * v[u][j].w);
            const float rs = rsqrtf(wave_sum(s) * (1.0f / DM) + EPS); f32x4* xr = (f32x4*)(out + (size_t)tok * DM) + lane;
#pragma unroll
            for (int j = 0; j < 4; ++j) { const f32x4 gg = ((const f32x4*)gfin)[lane + 64 * j]; xr[64 * j] = v[u][j] * rs * gg; } }
    }
#undef FIN_ROUTE
}

constexpr int NPHASE = 10;
struct Args { const void* in[28]; float* out; unsigned char* ws; int ph_lo, ph_hi; };
__global__ void __launch_bounds__(NWAVES * 64, 2) mk_fwd(Args args) {
    extern __shared__ __attribute__((aligned(16))) unsigned char lds[];
    Frame F;
    F.lds = (LAS unsigned char*)lds;
    F.MISC = (volatile LAS unsigned*)(F.lds + MISC_OFF);
    F.tid = threadIdx.x; F.lane = F.tid & 63; F.wave = __builtin_amdgcn_readfirstlane(F.tid >> 6);
    F.G = gridDim.x; { const int bx = blockIdx.x; F.vcu = (F.G % 8 == 0) ? (bx % 8) * (F.G / 8) + bx / 8 : bx; }
    F.ws = args.ws; F.out = args.out; F.ctl = (gu32*)(args.ws + WS_CTL);
    unsigned char* ws = args.ws;
    typedef const void* const volatile __attribute__((address_space(4))) kargp_t;
    kargp_t* const kargs = (kargp_t*)__builtin_amdgcn_kernarg_segment_ptr();
#define INP(k) ((const float*)kargs[k])
    for (int u = F.tid; u < (LDS_BYTES - LDSCTL_OFF) / 4; u += NWAVES * 64) ((LAS unsigned*)(F.lds + LDSCTL_OFF))[u] = 0u;
    __syncthreads();
    const int lo = args.ph_lo, hi = args.ph_hi;
    const bool single = (hi - lo) > 1;
    XcdBarrier bar; bar.bar = (unsigned*)(F.ctl + CW_BAR); bar.x = 0; bar.st = nullptr;
    if (single) bar = xcd_barrier_post((unsigned*)(F.ctl + CW_BAR), F.MISC + 8);
#define IN(k) (lo <= (k) && (k) < hi)
#if defined(PROBE_K0)
    LAS unsigned long long* tsl = (LAS unsigned long long*)(F.lds + TS_OFF);
    if (F.tid == 0) tsl[0] = rt();
#define SEAM(k) do { if (IN(k) && IN((k) + 1)) xcd_barrier(bar); if (F.tid == 0) tsl[(k) + 1] = rt(); } while (0)
#define SEAM_LOCAL(k) do { if (F.tid == 0) tsl[(k) + 1] = rt(); } while (0)
#else
#define SEAM(k) do { if (IN(k) && IN((k) + 1)) xcd_barrier(bar); } while (0)
#define SEAM_LOCAL(k) do { } while (0)
#endif
    typedef pg8::bf16_t hb;
    const int bx = (int)blockIdx.x;

    if (IN(0)) { In I;
        I.x = (const float*)INP(0);
        I.mem = (const float*)INP(1);
        I.positions = (const int*)INP(2);
        I.norm_mix_g = (const float*)INP(3);
        I.w_in = (const float*)INP(4);
        I.lq1 = (const float*)INP(5);
        I.lk1 = (const float*)INP(6);
        I.lq2 = (const float*)INP(7);
        I.lk2 = (const float*)INP(8);
        I.diff_norm_g = (const float*)INP(9);
        I.w_alpha2 = (const float*)INP(10);
        I.b_alpha = (const float*)INP(11);
        I.gla_norm_g = (const float*)INP(12);
        I.w_out = (const float*)INP(13);
        I.norm_cross_g = (const float*)INP(14);
        I.norm_mem_g = (const float*)INP(15);
        I.w_cq = (const float*)INP(16);
        I.w_ck = (const float*)INP(17);
        I.w_cv = (const float*)INP(18);
        I.w_co = (const float*)INP(19);
        I.norm_ffn_g = (const float*)INP(20);
        I.w_router = (const float*)INP(21);
        I.b_router = (const float*)INP(22);
        I.w_up = (const float*)INP(23);
        I.b_up = (const float*)INP(24);
        I.w_down = (const float*)INP(25);
        I.b_down = (const float*)INP(26);
        I.norm_final_g = (const float*)INP(27);
        p0_prologue(F, I); }
    SEAM(0);
    if (IN(1)) {
        pg8::Gemm g{(const hb*)(ws + WS_HN), (const hb*)(ws + WS_WINT), NTOK, 3328, DM, DM, DM, 127, 127};
        typedef pg8::OrderP1<(unsigned)WS_HN, (unsigned)WS_WINT, (unsigned)WS_MN, (unsigned)WS_WCK, (unsigned)WS_WCV> OrdP1; OrdP1 S; S.G = F.G; S.c = bx; S.ws = (const char*)ws;
        pg8::EpiP1 E{pg8::EpiProj{(hb*)(ws + WS_P), (float*)(ws + WS_LA), (const float*)(ws + WS_CS), INP(11)}, pg8::EpiPlain{(hb*)(ws + WS_VT) - (size_t)1024 * NTOK, NTOK, 1.0f},
                     pg8::EpiPlain{(hb*)(ws + WS_KX), DM, 1.0f}, pg8::EpiPlain{(hb*)(ws + WS_VXT), DM, 1.0f}};
        pg8::gemm_phase<pg8::EpiP1, OrdP1, true, true, false, false>(F.lds + RING_OFF, g, S, E);
    }
    SEAM(1);
    if (IN(2)) {
        float lam;
        { const int ln = lane_here(); const float a = INP(5)[ln] * INP(6)[ln], c = INP(7)[ln] * INP(8)[ln]; lam = __expf(wave_sum(a)) - __expf(wave_sum(c)) + 0.2f; }
        LAS int* qslot = (LAS int*)(F.lds + TAB_OFF);
        for (;;) {
            if (F.tid == 0) qslot[0] = (int)__hip_atomic_fetch_add(F.ctl + CW_Q2, 1u, RLX_AGENT);
            __syncthreads();
            const int u = qslot[0];
            __syncthreads();
            if (u >= 64 + 1024 + MOE_UNITS) break;
            int au = -1;
            if (u >= 64) { const int v = u - 64, gi = v / 11, r = v - gi * 11;
                if (r >= 8) { moe_convert_unit(gi * 3 + (r - 8), INP(23), INP(25), INP(20), ws, F.wave, lane_here()); continue; }
                au = gi * 8 + r; }
#if defined(PROBE_SPLIT)
            if (u < 64) continue;
#endif
            if (u < 64) { gla_unit(F, (const bf16*)(ws + WS_P), (const float*)(ws + WS_LA), (const bf16*)(ws + WS_GVT), (bf16*)(ws + WS_CAT), INP(12), u >> 2, u & 3);
            }
            else { const int v = au, bh = v & 63, qb = 15 - (v >> 6);
                diffattn_unit(F, (const bf16*)(ws + WS_P), (const bf16*)(ws + WS_VT), (bf16*)(ws + WS_CAT), INP(9), lam, bh >> 2, bh & 3, qb); }
        }
    }
#if defined(PROBE_SPLIT)
    if (IN(2)) { xcd_barrier(bar); if (F.tid == 0) tsl[13] = rt();
        for (int u = F.vcu; u < 64; u += F.G) gla_unit(F, (const bf16*)(ws + WS_P), (const float*)(ws + WS_LA), (const bf16*)(ws + WS_GVT), (bf16*)(ws + WS_CAT), INP(12), u >> 2, u & 3); }
#endif
    SEAM(2);
    if (IN(3)) {
        { pg8::Gemm g{(const hb*)(ws + WS_CAT), (const hb*)(ws + WS_WOUT), NTOK, DM, DM, DM, DM, 127, 127}; pg8::StaticOrder S; S.init(NTOK, DM, F.G, bx);
          pg8::EpiRes1 E{INP(0), (hb*)(ws + WS_X1B), (float*)(ws + WS_SSP1)};
          pg8::gemm_phase<pg8::EpiRes1, pg8::StaticOrder, true, true, false, false>(F.lds + RING_OFF, g, S, E); }
        { pg8::Gemm g{(const hb*)(ws + WS_KX), (const hb*)(ws + WS_WCQ), 64 * 256, DM, 256, DM, DM, 127, 127};
          typedef pg8::OrderGH<(unsigned)WS_KX, (unsigned)WS_WCQ, (unsigned)WS_WCO, (unsigned)WS_VXT> OrdGH; OrdGH S; S.G = F.G; S.c = bx; S.ws = (const char*)ws;
          pg8::EpiGH E{pg8::EpiPlain{(hb*)(ws + WS_GT), DM, 1.0f}, pg8::EpiPlain{(hb*)(ws + WS_HT), DM, 1.0f}};
          pg8::gemm_phase<pg8::EpiGH, OrdGH, true, true>(F.lds + RING_OFF, g, S, E); }
    }
    SEAM(3);
    if (IN(4)) {
        pg8::Gemm g{(const hb*)(ws + WS_X1B), (const hb*)(ws + WS_GT), NTOK, 256, DM, DM, DM, 127, 127}; pg8::OrderXS S; S.init(F.G, bx);
        pg8::EpiSoftmaxN E{(hb*)(ws + WS_PX), (const float*)(ws + WS_SSP1), (PG8_LAS float*)(F.lds + XCH_OFF), (PG8_LAS float*)(F.lds + XCH2_OFF)};
        pg8::gemm_phase<pg8::EpiSoftmaxN, pg8::OrderXS, true, true>(F.lds + RING_OFF, g, S, E);
    }
    SEAM(4);
    if (IN(5)) {
        pg8::Gemm g{(const hb*)(ws + WS_PX), (const hb*)(ws + WS_HT), NTOK, DM, DM, DM, DM, 127, 127}; pg8::OrderXO S; S.init(F.G, bx);
        pg8::EpiRes2 E{(hb*)(ws + WS_X1B), ws + WS_X2B};
        pg8::gemm_phase<pg8::EpiRes2, pg8::OrderXO, true, true, false, false>(F.lds + RING_OFF, g, S, E);
    }
    SEAM(5);
    if (IN(6)) router_phase(F, (const bf16*)(ws + WS_X1B), (const float*)(ws + WS_WR), INP(22), (float*)(ws + WS_RSL), (float*)(ws + WS_GATE), (unsigned*)(ws + WS_ASSIGN), (unsigned*)(ws + WS_LIST), F.ctl + CW_CNT);
    SEAM(6);
    if (IN(7)) {
        const int T = moe_tables(F);
        pg8::Gemm g{(const hb*)(ws + WS_X2B), (const hb*)(ws + WS_WUP), T * 256, NEXP * 2048, 512, 512, 512, 127, 122}; pg8::MoeOrderG S;
        S.init(T, 8, F.G, bx, (const PG8_LAS unsigned char*)(F.lds + TAB_OFF), (const PG8_LAS int*)(F.lds + TAB_TSTART), (const PG8_LAS int*)(F.lds + TAB_CNT), (const unsigned*)(ws + WS_LIST), (PG8_LAS unsigned*)(F.lds + XCH_OFF));
        pg8::EpiUp E{ws + WS_ACT, (const float*)(ws + WS_RSL), (const PG8_LAS int*)(F.lds + TAB_TSTART), (const PG8_LAS int*)(F.lds + TAB_CNT), INP(24)};
        pg8::gemm_phase<pg8::EpiUp, pg8::MoeOrderG, true, true, true, false>(F.lds + RING_OFF, g, S, E);
    }
    SEAM(7);
    if (IN(8)) {
        const int T = moe_tables(F);
        pg8::Gemm g{(const hb*)(ws + WS_ACT), (const hb*)(ws + WS_WDN), T * 256, NEXP * 1024, 512, 512, 512, 127, 122}; pg8::MoeOrder S; S.init(T, 4, F.G, bx, (const PG8_LAS unsigned char*)(F.lds + TAB_OFF));
        pg8::EpiDown E{ws + WS_Y, INP(26)};
        pg8::gemm_phase<pg8::EpiDown, pg8::MoeOrder, true, true, true, false>(F.lds + RING_OFF, g, S, E);
    }
    SEAM(8);
    if (IN(9)) final_phase(F, (const bf16*)(ws + WS_X1B), F.out, (const unsigned char*)(ws + WS_Y), (const float*)(ws + WS_GATE), (const unsigned*)(ws + WS_ASSIGN), INP(27));
#if defined(PROBE_ATT)
    { xcd_barrier(bar); if (F.tid == 0) tsl[13] = rt();
#pragma unroll 1
      for (int i2 = 2 * F.vcu; i2 < 1024; i2 += 2 * F.G)
#pragma unroll 1
          for (int rep = 0; rep < 2; ++rep) { const int i = i2 >> 1, bh = i >> 3, jj = i & 7;
              diffattn_unit<PROBE_ATT>(F, (const bf16*)(ws + WS_P), (const bf16*)(ws + WS_VT), (bf16*)(ws + WS_ACT), INP(9), 0.5f, bh >> 2, bh & 3, rep ? jj : 15 - jj); }
      xcd_barrier(bar); if (F.tid == 0) tsl[14] = rt(); }
#endif
#if defined(PROBE_GEMM)
    { xcd_barrier(bar); if (F.tid == 0) tsl[13] = rt();
      const int T = moe_tables(F);
      pg8::Gemm g{(const hb*)(ws + WS_X2B), (const hb*)(ws + WS_WUP), T * 256, NEXP * 2048, 512, 512, 512, 127, 122}; pg8::MoeOrderG S;
      S.init(T, 8, F.G, bx, (const PG8_LAS unsigned char*)(F.lds + TAB_OFF), (const PG8_LAS int*)(F.lds + TAB_TSTART), (const PG8_LAS int*)(F.lds + TAB_CNT), (const unsigned*)(ws + WS_LIST), (PG8_LAS unsigned*)(F.lds + XCH_OFF));
      pg8::EpiUp E{ws + WS_ACT, (const float*)(ws + WS_RSL), (const PG8_LAS int*)(F.lds + TAB_TSTART), (const PG8_LAS int*)(F.lds + TAB_CNT), INP(24)};
      pg8::gemm_phase<pg8::EpiUp, pg8::MoeOrderG, true, true, true, false, PROBE_GEMM>(F.lds + RING_OFF, g, S, E);
      xcd_barrier(bar); if (F.tid == 0) tsl[14] = rt(); }
#endif
#if defined(PROBE_K0)
    { if (F.tid == 0) { tsl[NPHASE] = rt();
        const int ks[2] = {PROBE_K0, PROBE_K1}; unsigned long long code = 0, mul = 1;
        for (int i = 0; i < 2; ++i) { unsigned long long dt = ks[i] == 94 ? tsl[14] - tsl[13] : ks[i] == 97 ? tsl[13] - tsl[2] : ks[i] == 98 ? tsl[3] - tsl[13] : ks[i] == 95 ? tsl[13] - tsl[0] : ks[i] == 96 ? tsl[14] - tsl[13] : tsl[ks[i] + 1] - tsl[ks[i]]; unsigned long long q = (dt + 800) / 1600; if (q > 63) q = 63; code += q * mul; mul *= 64; }
        tsl[15] = code * 6400ull; }
      __syncthreads();
      const unsigned long long t0 = rt(), wait = tsl[15]; float x = (float)F.tid, y = 1.0001f;
      while (rt() - t0 < wait) {
#pragma unroll
          for (int i = 0; i < 64; ++i) x = x * y + 0.5f; }
      if (x == 12345.678f) F.out[0] = x; }
#endif
#undef IN
#undef SEAM
#undef SEAM_LOCAL
}

#ifndef MK_N_LAUNCHES
#define MK_N_LAUNCHES 1
#endif
extern "C" void kernel_launch(void* const* d_in, const int* in_sizes, int n_in, void* d_out, int out_size, void* d_ws, size_t ws_size, hipStream_t stream) {
    static int grid = 0;
    if (grid == 0) {
        if (n_in != 28 || out_size != NTOK * DM || ws_size < WS_END) { fprintf(stderr, "kernel_launch: unexpected shapes: n_in %d out %d ws %zu (need %zu)\n", n_in, out_size, ws_size, (size_t)WS_END); grid = -1; return; }
        int dev = 0, cus = 0, per_cu = 0;
        if (hipGetDevice(&dev) != hipSuccess || hipDeviceGetAttribute(&cus, hipDeviceAttributeMultiprocessorCount, dev) != hipSuccess) { fprintf(stderr, "kernel_launch: device query failed\n"); grid = -1; return; }
        if (hipFuncSetAttribute((const void*)mk_fwd, hipFuncAttributeMaxDynamicSharedMemorySize, LDS_BYTES) != hipSuccess) { fprintf(stderr, "kernel_launch: hipFuncSetAttribute failed\n"); grid = -1; return; }
        if (hipOccupancyMaxActiveBlocksPerMultiprocessor(&per_cu, (const void*)mk_fwd, NWAVES * 64, LDS_BYTES) != hipSuccess || per_cu < 1) { fprintf(stderr, "kernel_launch: occupancy query reports %d workgroups per CU\n", per_cu); (void)hipGetLastError(); grid = -1; return; }
        grid = cus;
    }
    if (grid < 0) return;
    (void)hipMemsetAsync((char*)d_ws + WS_CTL, 0, CTL_ZERO_BYTES, stream);
    Args a{};
    for (int i = 0; i < 28; ++i) a.in[i] = d_in[i];
    a.out = (float*)d_out; a.ws = (unsigned char*)d_ws;
    if (MK_N_LAUNCHES == 1) { a.ph_lo = 0; a.ph_hi = NPHASE; hipLaunchKernelGGL(mk_fwd, dim3(grid), dim3(NWAVES * 64), LDS_BYTES, stream, a); }
    else for (int p = 0; p < NPHASE; ++p) { a.ph_lo = p; a.ph_hi = p + 1; hipLaunchKernelGGL(mk_fwd, dim3(grid), dim3(NWAVES * 64), LDS_BYTES, stream, a); }
}
```

```cpp
#include <hip/hip_runtime.h>
#include <cstdio>
#include <cstdint>
namespace pg8 {
#define PG8_LAS __attribute__((address_space(3)))
typedef unsigned short bf16_t;
typedef short bf16x8 __attribute__((ext_vector_type(8)));
typedef float f32x4 __attribute__((ext_vector_type(4)));
typedef unsigned u32x4 __attribute__((ext_vector_type(4)));
constexpr int BM = 256, BK = 64, HALF = 128, HTB = HALF * BK * 2  , STAGE_BYTES = 8 * HTB, NXCD = 8, WGM = 8;

__host__ __device__ __forceinline__ int lds_byte(int r, int c) { const int st = (r >> 4) * 2 + (c >> 5), rr = r & 15, cc = c & 31, ob = rr * 64 + cc * 2; return st * 1024 + (ob ^ (((ob >> 9) & 1) << 5)); }
__host__ __device__ __forceinline__ void stage_rc(int b, int& R, int& C) { const int st = b / 1024, sb = b % 1024, swz = sb ^ (((sb >> 9) & 1) << 5); R = (st >> 1) * 16 + swz / 64; C = (st & 1) * 32 + (swz % 64) / 2; }
__host__ __device__ __forceinline__ int perm32(int rho) { const int n = rho >> 4, i = rho & 15; return 8 * (i >> 2) + 4 * n + (i & 3); }

struct Unit { int pm, pn; };
struct Gemm { const bf16_t* A; const bf16_t* Bt; int M, N, K, lda, ldb, sa, sb; };
struct OrderBase {
    static constexpr bool GATHER = false;
    __device__ __forceinline__ const char* a_base(const Gemm& g, const Unit& u) const { return (const char*)g.A + (size_t)u.pm * 256 * g.lda * 2; }
    __device__ __forceinline__ const char* b_base(const Gemm& g, const Unit& u) const { return (const char*)g.Bt + (size_t)u.pn * 256 * g.ldb * 2; }
    __device__ __forceinline__ void a_ready(const Unit&) const {}
    __device__ __forceinline__ void done(const Unit&) const {}
};

struct StaticOrder : OrderBase {
    int nM, nN, nwg, G, c;
    __host__ __device__ void init(int M, int N, int G_, int c_) { nM = M / BM; nN = N / BM; nwg = nM * nN; G = G_; c = c_; }
    __host__ __device__ bool next(int i, Unit& u) const {
        const long L = (long)i * G + c; if (L >= nwg) return false;
        int wgid = (int)L; { const int q = nwg / NXCD, r = nwg % NXCD, xcd = wgid % NXCD, off = wgid / NXCD; wgid = (xcd < r ? xcd * (q + 1) : r * (q + 1) + (xcd - r) * q) + off; }
        const int nig = WGM * nN, gid = wgid / nig, fm = gid * WGM, gsz = (nM - fm) < WGM ? (nM - fm) : WGM;
        u.pm = fm + ((wgid % nig) % gsz); u.pn = (wgid % nig) / gsz; return true;
    }
};

typedef unsigned u32x2 __attribute__((ext_vector_type(2)));
typedef float f32x2_t __attribute__((ext_vector_type(2)));
typedef __bf16 bf16x2_t __attribute__((ext_vector_type(2)));
__device__ __forceinline__ unsigned cvtpk(float lo, float hi) { f32x2_t v = {lo, hi}; bf16x2_t b = __builtin_convertvector(v, bf16x2_t); return __builtin_bit_cast(unsigned, b); }
__device__ __forceinline__ void st_bf4(bf16_t* p, f32x4 v) { u32x2 w; w.x = cvtpk(v[0], v[1]); w.y = cvtpk(v[2], v[3]); *(u32x2*)p = w; }
__device__ __forceinline__ unsigned cvt4_fp8(f32x4 v) { unsigned w = __builtin_amdgcn_cvt_pk_fp8_f32(v[0], v[1], 0, false); return __builtin_amdgcn_cvt_pk_fp8_f32(v[2], v[3], w, true); }
__device__ __forceinline__ void st_bf8(bf16_t* p, f32x4 a, f32x4 c) { u32x4 w; w.x = cvtpk(a[0], a[1]); w.y = cvtpk(a[2], a[3]); w.z = cvtpk(c[0], c[1]); w.w = cvtpk(c[2], c[3]); *(u32x4*)p = w; }
__device__ __forceinline__ float bf2f(bf16_t b) { return __builtin_bit_cast(float, (unsigned)b << 16); }
#define EPI_ROWS _Pragma("unroll") for (int ai = 0; ai < 2; ++ai) _Pragma("unroll") for (int m = 0; m < 4; ++m)
#define EPI_COLS _Pragma("unroll") for (int bj = 0; bj < 2; ++bj) _Pragma("unroll") for (int n = 0; n < 2; ++n)
constexpr float LOG2E = 1.4426950408889634f;
constexpr float QSCALE_DA = 0.125f * LOG2E;
constexpr float QSCALE_X = 0.0625f * LOG2E;

struct EpiPlain {
    static constexpr bool PERM = true, AFTER_DRAIN = false;
    bf16_t* O; int ldc; float scale;
    __device__ __forceinline__ void operator()(const f32x4 (&acc)[2][2][4][2], const Unit& u, int wr, int wc, int fr, int fq) const {
        EPI_ROWS { const int row = u.pm * 256 + ai * 128 + wr * 64 + m * 16 + fr; bf16_t* rp = O + (size_t)row * ldc + u.pn * 256 + wc * 32 + fq * 8;
            _Pragma("unroll") for (int bj = 0; bj < 2; ++bj) st_bf8(rp + bj * 128, acc[ai][bj][m][0] * scale, acc[ai][bj][m][1] * scale); }
    }
};
struct EpiProj {
    static constexpr bool PERM = true, AFTER_DRAIN = false;
    bf16_t* P; float* LA; const float* cs; const float* b_alpha;
    template <int ai> __device__ __forceinline__ void decay_rows(const f32x4 (&acc)[2][2][4][2], const Unit& u, int wr, int wc, int fr, int fq) const {
        const int row0 = u.pm * 256 + ai * 128 + wr * 64 + fr;
        EPI_COLS { const int col = bj * 128 + wc * 32 + fq * 8 + n * 4; const f32x4 ba = *(const f32x4*)(b_alpha + col); f32x4 run = {0.f, 0.f, 0.f, 0.f};
            _Pragma("unroll") for (int m = 0; m < 4; ++m) { const f32x4 z = acc[ai][bj][m][n] + ba; f32x4 o;
                _Pragma("unroll") for (int i = 0; i < 4; ++i) { float v = (fminf(z[i], 0.f) - __logf(1.0f + __expf(-fabsf(z[i])))) * 0.0625f;
                    { float t = __shfl_up(v, 1, 16); if (fr >= 1) v += t; t = __shfl_up(v, 2, 16); if (fr >= 2) v += t; t = __shfl_up(v, 4, 16); if (fr >= 4) v += t; t = __shfl_up(v, 8, 16); if (fr >= 8) v += t; }
                    o[i] = v + run[i]; run[i] += __shfl(v, 15, 16); }
                *(f32x4*)(LA + (size_t)(row0 + m * 16) * 256 + col) = o; } }
    }
    __device__ __forceinline__ void operator()(const f32x4 (&acc)[2][2][4][2], const Unit& u, int wr, int wc, int fr, int fq) const {
        const int pn = u.pn;
        if (pn < 4) {
            const float sc = pn < 2 ? QSCALE_DA : 1.0f; const bool ropew = (wc & 1) == 0; const bool rl = fq < 2, hi = fq == 1;
            EPI_ROWS { const int row = u.pm * 256 + ai * 128 + wr * 64 + m * 16 + fr; bf16_t* rp = P + (size_t)row * 3072 + pn * 256 + wc * 32 + fq * 8;
                f32x4 cv[2], sv[2];
                if (ropew) { const f32x4* cp = (const f32x4*)(cs + (size_t)row * 16); cv[0] = cp[0]; cv[1] = cp[1]; sv[0] = cp[2]; sv[1] = cp[3]; }
                _Pragma("unroll") for (int bj = 0; bj < 2; ++bj) { f32x4 v[2] = {acc[ai][bj][m][0], acc[ai][bj][m][1]};
                    if (ropew) { _Pragma("unroll") for (int n = 0; n < 2; ++n) { f32x4 p; p[0] = __shfl_xor(v[n][0], 16); p[1] = __shfl_xor(v[n][1], 16); p[2] = __shfl_xor(v[n][2], 16); p[3] = __shfl_xor(v[n][3], 16);
                            const f32x4 r = hi ? (v[n] * cv[n] + p * sv[n]) : (v[n] * cv[n] - p * sv[n]); v[n] = rl ? r : v[n]; } }
                    st_bf8(rp + bj * 128, v[0] * sc, v[1] * sc); } }
        } else if (pn < 12) {
            const float sc = pn == 6 ? 0.125f : 1.0f;
            EPI_ROWS { const int row = u.pm * 256 + ai * 128 + wr * 64 + m * 16 + fr; bf16_t* rp = P + (size_t)row * 3072 + pn * 256 + wc * 32 + fq * 8;
                _Pragma("unroll") for (int bj = 0; bj < 2; ++bj) st_bf8(rp + bj * 128, acc[ai][bj][m][0] * sc, acc[ai][bj][m][1] * sc); }
        } else {
            decay_rows<0>(acc, u, wr, wc, fr, fq); decay_rows<1>(acc, u, wr, wc, fr, fq);
        }
    }
};
struct EpiP1 {
    static constexpr bool PERM = true, AFTER_DRAIN = false;
    EpiProj proj; EpiPlain vt, kx, vxt;
    __device__ __forceinline__ void operator()(const f32x4 (&acc)[2][2][4][2], const Unit& u, int wr, int wc, int fr, int fq) const {
        const int job = u.pn >> 16; Unit v; v.pm = u.pm; v.pn = u.pn & 0xffff;
        if (job == 0) proj(acc, v, wr, wc, fr, fq); else if (job == 1) vt(acc, v, wr, wc, fr, fq); else if (job == 2) kx(acc, v, wr, wc, fr, fq); else vxt(acc, v, wr, wc, fr, fq);
    }
};
struct EpiRes1 {
    static constexpr bool PERM = true, AFTER_DRAIN = false;
    const float* base; bf16_t* xb; float* ssp;
    __device__ __forceinline__ void operator()(const f32x4 (&acc)[2][2][4][2], const Unit& u, int wr, int wc, int fr, int fq) const {
        EPI_ROWS { const int row = u.pm * 256 + ai * 128 + wr * 64 + m * 16 + fr; const size_t off = (size_t)row * 1024 + u.pn * 256 + wc * 32 + fq * 8; float ss = 0.f;
            _Pragma("unroll") for (int bj = 0; bj < 2; ++bj) { const size_t o2 = off + bj * 128; const f32x4 v0 = *(const f32x4*)(base + o2) + acc[ai][bj][m][0], v1 = *(const f32x4*)(base + o2 + 4) + acc[ai][bj][m][1]; st_bf8(xb + o2, v0, v1);
                ss += ((v0[0] * v0[0] + v0[1] * v0[1]) + (v0[2] * v0[2] + v0[3] * v0[3])) + ((v1[0] * v1[0] + v1[1] * v1[1]) + (v1[2] * v1[2] + v1[3] * v1[3])); }
            ss += __shfl_xor(ss, 16); ss += __shfl_xor(ss, 32);
            if (fq == 0) ssp[(size_t)row * 16 + u.pn * 4 + wc] = ss; }
    }
};
struct EpiQX {
    static constexpr bool PERM = true, AFTER_DRAIN = false;
    bf16_t* O; const float* ssp;
    __device__ __forceinline__ void operator()(const f32x4 (&acc)[2][2][4][2], const Unit& u, int wr, int wc, int fr, int fq) const {
        EPI_ROWS { const int row = u.pm * 256 + ai * 128 + wr * 64 + m * 16 + fr; const f32x4* sp = (const f32x4*)(ssp + (size_t)row * 16);
            const f32x4 a = sp[0], b = sp[1], c = sp[2], d = sp[3]; const float ss = ((a[0] + a[1]) + (a[2] + a[3])) + ((b[0] + b[1]) + (b[2] + b[3])) + ((c[0] + c[1]) + (c[2] + c[3])) + ((d[0] + d[1]) + (d[2] + d[3]));
            const float rs = rsqrtf(ss * (1.0f / 1024.0f) + 1e-6f) * QSCALE_X; bf16_t* rp = O + (size_t)row * 1024 + u.pn * 256 + wc * 32 + fq * 8;
            _Pragma("unroll") for (int bj = 0; bj < 2; ++bj) st_bf8(rp + bj * 128, acc[ai][bj][m][0] * rs, acc[ai][bj][m][1] * rs); }
    }
};
struct EpiRes2 {
    static constexpr bool PERM = true, AFTER_DRAIN = false;
    bf16_t* xh; unsigned char* x8;
    __device__ __forceinline__ void operator()(const f32x4 (&acc)[2][2][4][2], const Unit& u, int wr, int wc, int fr, int fq) const {
        EPI_ROWS { const int row = u.pm * 256 + ai * 128 + wr * 64 + m * 16 + fr; const size_t off = (size_t)row * 1024 + u.pn * 256 + wc * 32 + fq * 8;
            _Pragma("unroll") for (int bj = 0; bj < 2; ++bj) { bf16_t* p = xh + off + bj * 128; const u32x4 w = *(const u32x4*)p;
                f32x4 v0 = {__builtin_bit_cast(float, w.x << 16), __builtin_bit_cast(float, w.x & 0xffff0000u), __builtin_bit_cast(float, w.y << 16), __builtin_bit_cast(float, w.y & 0xffff0000u)};
                f32x4 v1 = {__builtin_bit_cast(float, w.z << 16), __builtin_bit_cast(float, w.z & 0xffff0000u), __builtin_bit_cast(float, w.w << 16), __builtin_bit_cast(float, w.w & 0xffff0000u)};
                v0 = v0 + acc[ai][bj][m][0]; v1 = v1 + acc[ai][bj][m][1]; st_bf8(p, v0, v1); u32x2 q; q.x = cvt4_fp8(v0); q.y = cvt4_fp8(v1); *(u32x2*)(x8 + off + bj * 128) = q; } }
    }
};
struct EpiUp {
    static constexpr bool PERM = true, AFTER_DRAIN = false;
    unsigned char* ACT; const float* rsl; const PG8_LAS int* tstart; const PG8_LAS int* cnt; const float* b_up;
    __device__ __forceinline__ void operator()(const f32x4 (&acc)[2][2][4][2], const Unit& u, int wr, int wc, int fr, int fq) const {
        const int e = u.pn >> 3, pnl = u.pn & 7; const float* bg = b_up + (size_t)e * 2048 + pnl * 128 + wc * 32 + fq * 8;
        const int pos0 = (u.pm - tstart[e]) * 256 + wr * 64 + fr, nv = cnt[e]; const float* rp0 = rsl + (size_t)e * 32768 + pos0;
        const f32x4 bg0 = *(const f32x4*)bg, bg1 = *(const f32x4*)(bg + 4), bl0 = *(const f32x4*)(bg + 1024), bl1 = *(const f32x4*)(bg + 1028);
        EPI_ROWS { const int row = u.pm * 256 + ai * 128 + wr * 64 + m * 16 + fr; const float rs = (pos0 + ai * 128 + m * 16) < nv ? rp0[ai * 128 + m * 16] : 0.f;
            unsigned char* rp = ACT + (size_t)row * 1024 + pnl * 128 + wc * 32 + fq * 8; u32x2 w;
            _Pragma("unroll") for (int n = 0; n < 2; ++n) {
                const f32x4 c7 = {7.0f, 7.0f, 7.0f, 7.0f}, one = {1.0f, 1.0f, 1.0f, 1.0f};
                const f32x4 gl = __builtin_elementwise_min(acc[ai][0][m][n] * rs + (n ? bg1 : bg0), c7), li = __builtin_elementwise_min(__builtin_elementwise_max(acc[ai][1][m][n] * rs + (n ? bl1 : bl0), -c7), c7);
                const f32x4 t = gl * -2.4554669595930156f; f32x4 e; _Pragma("unroll") for (int i = 0; i < 4; ++i) e[i] = __builtin_amdgcn_exp2f(t[i]);
                const f32x4 a = e + one; f32x4 r; _Pragma("unroll") for (int i = 0; i < 4; ++i) r[i] = __builtin_amdgcn_rcpf(a[i]);
                const f32x4 o = (gl * r) * (li + one);
                if (n) w.y = cvt4_fp8(o); else w.x = cvt4_fp8(o); }
            *(u32x2*)rp = w; }
    }
};
struct EpiDown {
    static constexpr bool PERM = true, AFTER_DRAIN = false;
    unsigned char* Y; const float* b_down;
    __device__ __forceinline__ void operator()(const f32x4 (&acc)[2][2][4][2], const Unit& u, int wr, int wc, int fr, int fq) const {
        const int e = u.pn >> 2, pnl = u.pn & 3; const float* bp = b_down + (size_t)e * 1024 + pnl * 256 + wc * 32 + fq * 8;
        f32x4 bv[2][2];
        _Pragma("unroll") for (int bj = 0; bj < 2; ++bj) _Pragma("unroll") for (int n = 0; n < 2; ++n) bv[bj][n] = *(const f32x4*)(bp + bj * 128 + n * 4);
        EPI_ROWS { const int row = u.pm * 256 + ai * 128 + wr * 64 + m * 16 + fr; unsigned char* rp = Y + (size_t)row * 1024 + pnl * 256 + wc * 32 + fq * 8;
            _Pragma("unroll") for (int bj = 0; bj < 2; ++bj) { u32x2 w; w.x = cvt4_fp8(acc[ai][bj][m][0] + bv[bj][0]); w.y = cvt4_fp8(acc[ai][bj][m][1] + bv[bj][1]); *(u32x2*)(rp + bj * 128) = w; } }
    }
};
struct OrderMap : OrderBase {
    StaticOrder so;
    __device__ void init(int nM, int nN, int G, int c) { so.nM = nM; so.nN = nN; so.nwg = nM * nN; so.G = G; so.c = c; }
    __device__ bool next(int i, Unit& u) const { if (!so.next(i, u)) return false; u.pn += (u.pn >= 4 ? 2 : 0) + (u.pn >= 6 ? 2 : 0); return true; }
};
struct OrderVT : OrderBase {
    StaticOrder so;
    __device__ void init(int nN, int G, int c) { so.nM = 4; so.nN = nN; so.nwg = 4 * nN; so.G = G; so.c = c; }
    __device__ bool next(int i, Unit& u) const { if (!so.next(i, u)) return false; u.pm += (u.pm >= 2 ? 6 : 4); return true; }
};
__device__ __forceinline__ void map_unit(int L, int nM, int nN, int& pm, int& pn) {
    const int nwg = nM * nN; int wgid = L; { const int q = nwg / NXCD, r = nwg % NXCD, xcd = wgid % NXCD, off = wgid / NXCD; wgid = (xcd < r ? xcd * (q + 1) : r * (q + 1) + (xcd - r) * q) + off; }
    const int nig = WGM * nN, gid = wgid / nig, fm = gid * WGM, gsz = (nM - fm) < WGM ? (nM - fm) : WGM;
    pm = fm + ((wgid % nig) % gsz); pn = (wgid % nig) / gsz;
}
template <unsigned oHN, unsigned oWINT, unsigned oMN, unsigned oWCK, unsigned oWCV>
struct OrderP1 : OrderBase {
    int G, c; const char* ws;
    __device__ __forceinline__ bool next(int i, Unit& u) const {
        int L = i * G + c; if (L >= 1792) return false;
        if (L < 1152) { map_unit(L, 128, 9, u.pm, u.pn); u.pn += (u.pn >= 4 ? 2 : 0) + (u.pn >= 6 ? 2 : 0); return true; } L -= 1152;
        if (L < 512) { map_unit(L, 4, 128, u.pm, u.pn); u.pm += (u.pm >= 2 ? 6 : 4); u.pn |= 1 << 16; return true; } L -= 512;
        if (L < 64) { map_unit(L, 16, 4, u.pm, u.pn); u.pn |= 2 << 16; return true; } L -= 64;
        map_unit(L, 16, 4, u.pm, u.pn); u.pn |= 3 << 16; return true;
    }
    __device__ __forceinline__ const char* a_base(const Gemm&, const Unit& u) const { const int job = u.pn >> 16; unsigned o = oHN; o = job == 1 ? oWINT : o; o = job >= 2 ? oMN : o; return ws + o + (size_t)u.pm * (256 * 1024 * 2); }
    __device__ __forceinline__ const char* b_base(const Gemm&, const Unit& u) const { const int job = u.pn >> 16; unsigned o = oWINT; o = job == 1 ? oHN : o; o = job == 2 ? oWCK : o; o = job == 3 ? oWCV : o; return ws + o + (size_t)(u.pn & 0xffff) * (256 * 1024 * 2); }
};
struct MoeOrder : OrderBase {
    StaticOrder so; const PG8_LAS unsigned char* tile_e; int nN;
    __device__ void init(int nM, int nN_, int G, int c, const PG8_LAS unsigned char* te) { so.nM = nM; so.nN = nN_; so.nwg = nM * nN_; so.G = G; so.c = c; tile_e = te; nN = nN_; }
    __device__ bool next(int i, Unit& u) const { if (!so.next(i, u)) return false; u.pn += (int)tile_e[u.pm] * nN; return true; }
};


struct MoeOrderG : OrderBase {
    static constexpr bool GATHER = true;
    StaticOrder so; const PG8_LAS unsigned char* tile_e; const PG8_LAS int* tstart; const PG8_LAS int* cnt; const unsigned* list; PG8_LAS unsigned* gslot; int nN;
    __device__ void init(int nM, int nN_, int G, int c, const PG8_LAS unsigned char* te, const PG8_LAS int* ts, const PG8_LAS int* cn, const unsigned* li, PG8_LAS unsigned* gs) {
        so.nM = nM; so.nN = nN_; so.nwg = nM * nN_; so.G = G; so.c = c; tile_e = te; tstart = ts; cnt = cn; list = li; gslot = gs; nN = nN_; }
    __device__ bool next(int i, Unit& u) const { if (!so.next(i, u)) return false; u.pn += (int)tile_e[u.pm] * nN; return true; }
    __device__ __forceinline__ const char* a_base(const Gemm& g, const Unit&) const { return (const char*)g.A; }
    __device__ __forceinline__ const unsigned* rows(const Unit& u) const { const int e = u.pn / nN; return list + (size_t)e * 32768 + (size_t)(u.pm - tstart[e]) * 256; }
    __device__ __forceinline__ int nvalid(const Unit& u) const { const int e = u.pn / nN; return cnt[e] - (u.pm - tstart[e]) * 256; }
};
struct OrderX1 : OrderBase {
    StaticOrder so;
    __device__ void init(int G, int c) { so.nM = 128; so.nN = 4; so.nwg = 512; so.G = G; so.c = c; }
    __device__ bool next(int i, Unit& u) const { return so.next(i, u); }
    __device__ __forceinline__ const char* a_base(const Gemm& g, const Unit& u) const { return (const char*)(g.A + (size_t)u.pm * 256 * 1024 + u.pn * 256); }
    __device__ __forceinline__ const char* b_base(const Gemm& g, const Unit& u) const { return (const char*)(g.Bt + (size_t)(u.pm >> 3) * 256 * 1024 + u.pn * 256); }
};
struct OrderX2 : OrderBase {
    StaticOrder so;
    __device__ void init(int G, int c) { so.nM = 128; so.nN = 4; so.nwg = 512; so.G = G; so.c = c; }
    __device__ bool next(int i, Unit& u) const { return so.next(i, u); }
    __device__ __forceinline__ const char* a_base(const Gemm& g, const Unit& u) const { return (const char*)(g.A + (size_t)u.pm * 256 * 1024 + u.pn * 256); }
    __device__ __forceinline__ const char* b_base(const Gemm& g, const Unit& u) const { return (const char*)(g.Bt + (size_t)u.pn * 256 * 4096 + (u.pm >> 3) * 256); }
};
struct EpiSoftmax {
    static constexpr bool PERM = true, AFTER_DRAIN = false;
    bf16_t* PX; float* lp; PG8_LAS float* xch;
    __device__ __forceinline__ void operator()(const f32x4 (&acc)[2][2][4][2], const Unit& u, int wr, int wc, int fr, int fq) const {
        PG8_LAS char* rb = (PG8_LAS char*)xch + (wr * 64 + fr) * 16; asm volatile("" : "+v"(rb));
        PG8_LAS char* wb = rb + wc * 4; asm volatile("" : "+v"(wb));
        EPI_ROWS { float a = -INFINITY;
            EPI_COLS { const f32x4 v = acc[ai][bj][m][n]; a = fmaxf(a, fmaxf(fmaxf(v[0], v[1]), fmaxf(v[2], v[3]))); }
            a = fmaxf(a, __shfl_xor(a, 16)); a = fmaxf(a, __shfl_xor(a, 32));
            if (fq == 0) *(PG8_LAS float*)(wb + (ai * 128 + m * 16) * 16) = a; }
        asm volatile("s_waitcnt lgkmcnt(0)" ::: "memory"); __builtin_amdgcn_s_barrier(); asm volatile("" ::: "memory");
        const int row0 = u.pm * 256 + wr * 64 + fr; bf16_t* rp0 = PX + (size_t)row0 * 1024 + u.pn * 256 + wc * 32 + fq * 8; float* lp0 = lp + (size_t)row0 * 16 + u.pn * 4 + wc;
        EPI_ROWS { const f32x4 q = *(const PG8_LAS f32x4*)(rb + (ai * 128 + m * 16) * 16); const float mr = fmaxf(fmaxf(q[0], q[1]), fmaxf(q[2], q[3]));
            bf16_t* rp = rp0 + (size_t)(ai * 128 + m * 16) * 1024; float ps = 0.f;
            _Pragma("unroll") for (int bj = 0; bj < 2; ++bj) { f32x4 p[2];
                _Pragma("unroll") for (int n = 0; n < 2; ++n) _Pragma("unroll") for (int i = 0; i < 4; ++i) { p[n][i] = __builtin_amdgcn_exp2f(acc[ai][bj][m][n][i] - mr); ps += p[n][i]; }
                st_bf8(rp + bj * 128, p[0], p[1]); }
            ps += __shfl_xor(ps, 16); ps += __shfl_xor(ps, 32);
            if (fq == 0) lp0[(ai * 128 + m * 16) * 16] = ps; }
        asm volatile("s_waitcnt lgkmcnt(0)" ::: "memory"); __builtin_amdgcn_s_barrier(); asm volatile("" ::: "memory");
    }
};
struct EpiPV {
    static constexpr bool PERM = true, AFTER_DRAIN = false;
    bf16_t* O; const float* lp;
    __device__ __forceinline__ void operator()(const f32x4 (&acc)[2][2][4][2], const Unit& u, int wr, int wc, int fr, int fq) const {
        EPI_ROWS { const int row = u.pm * 256 + ai * 128 + wr * 64 + m * 16 + fr; const f32x4 q = *(const f32x4*)(lp + (size_t)row * 16 + u.pn * 4);
            const float inv = 1.0f / ((q[0] + q[1]) + (q[2] + q[3])); bf16_t* rp = O + (size_t)row * 1024 + u.pn * 256 + wc * 32 + fq * 8;
            _Pragma("unroll") for (int bj = 0; bj < 2; ++bj) st_bf8(rp + bj * 128, acc[ai][bj][m][0] * inv, acc[ai][bj][m][1] * inv); }
    }
};

template <unsigned oKX, unsigned oWCQR, unsigned oWCOT, unsigned oVX>
struct OrderGH : OrderBase {
    int G, c; const char* ws;
    __device__ __forceinline__ bool next(int i, Unit& u) const { int L = i * G + c; if (L >= 512) return false;
        if (L < 256) { u.pm = L >> 2; u.pn = L & 3; } else { L -= 256; u.pm = L >> 2; u.pn = (L & 3) | (1 << 16); } return true; }
    __device__ __forceinline__ const char* a_base(const Gemm&, const Unit& u) const { const int job = u.pn >> 16, pn = u.pn & 0xffff;
        return job == 0 ? ws + oKX + ((size_t)(u.pm >> 2) * 256 * 1024 + (u.pm & 3) * 256) * 2 : ws + oWCOT + ((size_t)(u.pm & 3) * 256 * 1024 + pn * 256) * 2; }
    __device__ __forceinline__ const char* b_base(const Gemm&, const Unit& u) const { const int job = u.pn >> 16, pn = u.pn & 0xffff;
        return job == 0 ? ws + oWCQR + ((size_t)pn * 256 * 1024 + (u.pm & 3) * 256) * 2 : ws + oVX + ((size_t)(u.pm >> 2) * 256 * 1024 + pn * 256) * 2; }
};
struct EpiGH {
    static constexpr bool PERM = true, AFTER_DRAIN = false;
    EpiPlain gt, ht;
    __device__ __forceinline__ void operator()(const f32x4 (&acc)[2][2][4][2], const Unit& u, int wr, int wc, int fr, int fq) const {
        Unit v; v.pm = u.pm; v.pn = u.pn & 0xffff; if ((u.pn >> 16) == 0) gt(acc, v, wr, wc, fr, fq); else ht(acc, v, wr, wc, fr, fq); }
};
struct OrderXS : OrderBase {
    StaticOrder so;
    __device__ void init(int G, int c) { so.nM = 128; so.nN = 4; so.nwg = 512; so.G = G; so.c = c; }
    __device__ bool next(int i, Unit& u) const { return so.next(i, u); }
    __device__ __forceinline__ const char* b_base(const Gemm& g, const Unit& u) const { return (const char*)(g.Bt + ((size_t)(u.pm >> 3) * 1024 + u.pn * 256) * 1024); }
};
struct EpiSoftmaxN {
    static constexpr bool PERM = true, AFTER_DRAIN = false;
    bf16_t* PX; const float* ssp; PG8_LAS float* xmax; PG8_LAS float* xsum;
    __device__ __forceinline__ void operator()(f32x4 (&acc)[2][2][4][2], const Unit& u, int wr, int wc, int fr, int fq) const {
        PG8_LAS char* rb = (PG8_LAS char*)xmax + (wr * 64 + fr) * 16; asm volatile("" : "+v"(rb));
        PG8_LAS char* wb = rb + wc * 4; asm volatile("" : "+v"(wb));
        PG8_LAS char* rb2 = (PG8_LAS char*)xsum + (wr * 64 + fr) * 16; asm volatile("" : "+v"(rb2));
        PG8_LAS char* wb2 = rb2 + wc * 4; asm volatile("" : "+v"(wb2));
        const int row0 = u.pm * 256 + wr * 64 + fr;
        EPI_ROWS { const f32x4* sp = (const f32x4*)(ssp + (size_t)(row0 + ai * 128 + m * 16) * 16);
            const f32x4 a4 = sp[0], b4 = sp[1], c4 = sp[2], d4 = sp[3]; const float ss = ((a4[0] + a4[1]) + (a4[2] + a4[3])) + ((b4[0] + b4[1]) + (b4[2] + b4[3])) + ((c4[0] + c4[1]) + (c4[2] + c4[3])) + ((d4[0] + d4[1]) + (d4[2] + d4[3]));
            const float rs = rsqrtf(ss * (1.0f / 1024.0f) + 1e-6f) * QSCALE_X; float a = -INFINITY;
            EPI_COLS { f32x4 v = acc[ai][bj][m][n] * rs; acc[ai][bj][m][n] = v; a = fmaxf(a, fmaxf(fmaxf(v[0], v[1]), fmaxf(v[2], v[3]))); }
            a = fmaxf(a, __shfl_xor(a, 16)); a = fmaxf(a, __shfl_xor(a, 32));
            if (fq == 0) *(PG8_LAS float*)(wb + (ai * 128 + m * 16) * 16) = a; }
        asm volatile("s_waitcnt lgkmcnt(0)" ::: "memory"); __builtin_amdgcn_s_barrier(); asm volatile("" ::: "memory");
        EPI_ROWS { const f32x4 q = *(const PG8_LAS f32x4*)(rb + (ai * 128 + m * 16) * 16); const float mr = fmaxf(fmaxf(q[0], q[1]), fmaxf(q[2], q[3])); float ps = 0.f;
            EPI_COLS { f32x4 p; _Pragma("unroll") for (int i = 0; i < 4; ++i) { p[i] = __builtin_amdgcn_exp2f(acc[ai][bj][m][n][i] - mr); ps += p[i]; } acc[ai][bj][m][n] = p; }
            ps += __shfl_xor(ps, 16); ps += __shfl_xor(ps, 32);
            if (fq == 0) *(PG8_LAS float*)(wb2 + (ai * 128 + m * 16) * 16) = ps; }
        asm volatile("s_waitcnt lgkmcnt(0)" ::: "memory"); __builtin_amdgcn_s_barrier(); asm volatile("" ::: "memory");
        bf16_t* rp0 = PX + (size_t)row0 * 1024 + u.pn * 256 + wc * 32 + fq * 8;
        EPI_ROWS { const f32x4 q = *(const PG8_LAS f32x4*)(rb2 + (ai * 128 + m * 16) * 16); const float inv = __builtin_amdgcn_rcpf((q[0] + q[1]) + (q[2] + q[3]));
            bf16_t* rp = rp0 + (size_t)(ai * 128 + m * 16) * 1024;
            _Pragma("unroll") for (int bj = 0; bj < 2; ++bj) st_bf8(rp + bj * 128, acc[ai][bj][m][0] * inv, acc[ai][bj][m][1] * inv); }
    }
};
struct OrderXO : OrderBase {
    StaticOrder so;
    __device__ void init(int G, int c) { so.nM = 128; so.nN = 4; so.nwg = 512; so.G = G; so.c = c; }
    __device__ bool next(int i, Unit& u) const { return so.next(i, u); }
    __device__ __forceinline__ const char* b_base(const Gemm& g, const Unit& u) const { return (const char*)(g.Bt + ((size_t)(u.pm >> 3) * 1024 + u.pn * 256) * 1024); }
};
typedef int v4i_t __attribute__((ext_vector_type(4))); typedef int v8i_t __attribute__((ext_vector_type(8)));
__device__ __forceinline__ v8i_t cat8(bf16x8 lo, bf16x8 hi) { return __builtin_shufflevector(__builtin_bit_cast(v4i_t, lo), __builtin_bit_cast(v4i_t, hi), 0, 1, 2, 3, 4, 5, 6, 7); }
__device__ __forceinline__ void mfma8(f32x4& acc, v8i_t w, v8i_t a, int sw, int sa) {
    asm volatile("s_nop 1\n\tv_mfma_scale_f32_16x16x128_f8f6f4 %0, %1, %2, %0, %3, %4 op_sel_hi:[0,0,0]" : "+v"(acc) : "v"(w), "v"(a), "v"(sw), "v"(sa)); }
constexpr int PF_D = 4, PF_LDS = 137216;
template <class Epi, class Sched, bool ALIGN_EPI = false, bool SP2 = false, bool FP8 = false, bool PF = false, int DBG = 0>
__device__ __forceinline__ void gemm_phase(PG8_LAS unsigned char* lds, const Gemm g, const Sched& S, const Epi& E) {
    const int tid = threadIdx.x, wid = __builtin_amdgcn_readfirstlane(tid >> 6), lane = tid & 63, wr = wid >> 2, wc = wid & 3, fr = lane & 15, fq = lane >> 4;
    const int K = g.K, nt = K / BK;
    unsigned voffA[2], voffB[2];
    unsigned gC[2][2];
#pragma unroll
    for (int i = 0; i < 2; ++i) { int R, C; stage_rc(tid * 16 + i * 8192, R, C); const int Rb = Epi::PERM ? ((R & ~31) + perm32(R & 31)) : R;
        voffA[i] = (unsigned)(R * g.lda + C) * 2u; voffB[i] = (unsigned)(Rb * g.ldb + C) * 2u; }
    const bool pfA = !Sched::GATHER && wid < 4;
    const unsigned pfoff = (unsigned)((((wid >> 1) & 1) * HALF + (wid & 1) * 64 + lane) * (pfA ? g.lda : g.ldb)) * 2u;
    const size_t kstep = (size_t)(BK * 2);
    const size_t hstepA = (size_t)HALF * g.lda * 2, hstepB = (size_t)HALF * g.ldb * 2;
    const unsigned ldsw = (unsigned)wid * 1024u;
    const int aoff = lds_byte(wr * 64 + fr, fq * 8), boff = lds_byte(wc * 32 + fr, fq * 8);
#define PG8_SA(b, h) (((b) * 2 + (h)) * HTB)
#define PG8_SB(b, h) ((4 + (b) * 2 + (h)) * HTB)
#define PG8_STAGE(bufoff, gbase, voff) do { if constexpr ((DBG & 2) == 0) _Pragma("unroll") for (int _i = 0; _i < 2; ++_i) \
        __builtin_amdgcn_global_load_lds((const unsigned*)((const char*)(gbase) + (voff)[_i]), (PG8_LAS unsigned*)(lds + (bufoff) + ldsw + _i * 8192), 16, 0, 0); } while (0)
#define PG8_STAGE_A(bufoff, ptr, h, nx) do { if constexpr (Sched::GATHER) { PG8_STAGE(bufoff, ptr, gC[h]); } else { PG8_STAGE(bufoff, (ptr) + ((h) ? hstepA : 0), voffA); } } while (0)
#define PG8_LDA(dst, b, h) do { if constexpr ((DBG & 8) == 0) _Pragma("unroll") for (int m = 0; m < 4; ++m) _Pragma("unroll") for (int k = 0; k < 2; ++k) dst[m][k] = *(const PG8_LAS bf16x8*)(lds + PG8_SA(b, h) + aoff + m * 2048 + k * 1024); } while (0)
#define PG8_LDB(dst, b, h) do { if constexpr ((DBG & 8) == 0) _Pragma("unroll") for (int n = 0; n < 2; ++n) _Pragma("unroll") for (int k = 0; k < 2; ++k) dst[n][k] = *(const PG8_LAS bf16x8*)(lds + PG8_SB(b, h) + boff + n * 2048 + k * 1024); } while (0)
#define PG8_MMA(ai, bj, At, Bt) do { if constexpr ((DBG & 1) == 0) { __builtin_amdgcn_s_setprio(1); \
        if constexpr (FP8) { _Pragma("unroll") for (int m = 0; m < 4; ++m) _Pragma("unroll") for (int n = 0; n < 2; ++n) \
            mfma8(acc[ai][bj][m][n], cat8(Bt[n][0], Bt[n][1]), cat8(At[m][0], At[m][1]), g.sb, g.sa); } \
        else { _Pragma("unroll") for (int m = 0; m < 4; ++m) _Pragma("unroll") for (int n = 0; n < 2; ++n) _Pragma("unroll") for (int k = 0; k < 2; ++k) \
            acc[ai][bj][m][n] = __builtin_amdgcn_mfma_f32_16x16x32_bf16(Bt[n][k], At[m][k], acc[ai][bj][m][n], 0, 0, 0); } \
        __builtin_amdgcn_s_setprio(0); } } while (0)
#define PG8_WAIT_V(n) asm volatile("s_waitcnt vmcnt(" #n ")" ::: "memory")
#define PG8_WAIT_VP() do { if constexpr (PF) asm volatile("s_waitcnt vmcnt(9)" ::: "memory"); else asm volatile("s_waitcnt vmcnt(8)" ::: "memory"); } while (0)
#define PG8_PREFETCH(tp) do { if constexpr (PF) { const int tp_ = (tp); const char* pb_ = tp_ < nt ? (pfA ? cA : cB) + (size_t)tp_ * kstep : (pfA ? nA : nB) + (size_t)(tp_ - nt) * kstep; \
        __builtin_amdgcn_global_load_lds((const unsigned*)(pb_ + pfoff), (PG8_LAS unsigned*)(lds + PF_LDS + wid * 256), 4, 0, 0); } } while (0)
#define PG8_WAIT_L(n) asm volatile("s_waitcnt lgkmcnt(" #n ")" ::: "memory")
#define PG8_BAR __builtin_amdgcn_s_barrier()
#define PG8_SCHED __builtin_amdgcn_sched_barrier(0)
    Unit cur, nxt; int ui = 0;
    if (!S.next(0, cur)) return;
    f32x4 acc[2][2][4][2];
#pragma unroll
    for (int a = 0; a < 2; ++a)
#pragma unroll
        for (int b = 0; b < 2; ++b)
#pragma unroll
            for (int m = 0; m < 4; ++m)
#pragma unroll
                for (int n = 0; n < 2; ++n) acc[a][b][m][n] = (f32x4){0.f, 0.f, 0.f, 0.f};
    bf16x8 At[4][2], B0[2][2], B1[2][2];
    const char* cA = S.a_base(g, cur); const char* cB = S.b_base(g, cur);
    if constexpr (Sched::GATHER) { const unsigned* rp = S.rows(cur); const int nv = S.nvalid(cur);
#pragma unroll
        for (int h = 0; h < 2; ++h)
#pragma unroll
            for (int i = 0; i < 2; ++i) { int R, C; stage_rc(tid * 16 + i * 8192, R, C); const int r = h * HALF + R; const unsigned tok = r < nv ? rp[r] : 0u; gC[h][i] = tok * (unsigned)(g.lda * 2) + (unsigned)C * 2u; } }
    S.a_ready(cur);
    if constexpr (SP2) {
        PG8_STAGE(PG8_SB(0, 0), cB, voffB); PG8_STAGE(PG8_SB(0, 1), cB + hstepB, voffB); PG8_STAGE_A(PG8_SA(0, 0), cA, 0, 0); PG8_STAGE_A(PG8_SA(0, 1), cA, 1, 0);
        if (wr == 1) PG8_BAR;
        PG8_WAIT_V(2); PG8_BAR;
        PG8_STAGE(PG8_SB(1, 0), cB + kstep, voffB); PG8_STAGE_A(PG8_SA(1, 0), cA + kstep, 0, 0); PG8_STAGE(PG8_SB(1, 1), cB + hstepB + kstep, voffB);
        PG8_WAIT_V(6); PG8_BAR;
    } else {
        PG8_STAGE(PG8_SB(0, 0), cB, voffB); PG8_STAGE_A(PG8_SA(0, 0), cA, 0, 0); PG8_STAGE(PG8_SB(0, 1), cB + hstepB, voffB); PG8_STAGE_A(PG8_SA(0, 1), cA, 1, 0);
        if (wr == 1) PG8_BAR;
        PG8_WAIT_V(4); PG8_BAR;
        PG8_STAGE(PG8_SB(1, 0), cB + kstep, voffB); PG8_STAGE_A(PG8_SA(1, 0), cA + kstep, 0, 0); PG8_STAGE(PG8_SB(1, 1), cB + hstepB + kstep, voffB);
        PG8_WAIT_V(6); PG8_BAR;
    }
    for (;;) {
        const bool has_next = S.next(ui + 1, nxt);
        const char* nA = has_next ? S.a_base(g, nxt) : cA; const char* nB = has_next ? S.b_base(g, nxt) : cB;
        if constexpr (Sched::GATHER) { if (has_next && wid < 4)
            __builtin_amdgcn_global_load_lds((const unsigned*)(S.rows(nxt) + wid * 64 + lane), (PG8_LAS unsigned*)(S.gslot + ((ui + 1) & 1) * 256 + wid * 64), 4, 0, 0); }
#pragma nounroll
        for (int t = 0; t < nt; t += 2) {
            const bool last = (t == nt - 2);
            const char* a1 = cA + (size_t)(t + 1) * kstep;
            const char* a2 = last ? nA : cA + (size_t)(t + 2) * kstep; const char* b2 = last ? nB : cB + (size_t)(t + 2) * kstep;
            const char* a3 = a2 + kstep; const char* b3 = b2 + kstep;
            if (last && has_next) S.a_ready(nxt);
            if constexpr (SP2) {
            PG8_LDB(B0, 0, 0); PG8_LDB(B1, 0, 1); PG8_SCHED; PG8_LDA(At, 0, 0); PG8_STAGE_A(PG8_SA(1, 1), a1, 1, 0);
            if constexpr (Sched::GATHER) { if (last && has_next) {
                const PG8_LAS unsigned* sl = S.gslot + ((ui + 1) & 1) * 256; const int nv = S.nvalid(nxt);
#pragma unroll
                for (int h = 0; h < 2; ++h)
#pragma unroll
                    for (int i = 0; i < 2; ++i) { int R, C; stage_rc(tid * 16 + i * 8192, R, C); const int r = h * HALF + R; const unsigned v = sl[r]; const unsigned tok = r < nv ? v : 0u; gC[h][i] = tok * (unsigned)(g.lda * 2) + (unsigned)C * 2u; } } }
            PG8_WAIT_VP(); PG8_WAIT_L(0); PG8_BAR; PG8_MMA(0, 0, At, B0); PG8_MMA(0, 1, At, B1); PG8_BAR; PG8_SCHED;
            PG8_LDA(At, 0, 1); PG8_STAGE(PG8_SB(0, 0), b2, voffB); PG8_STAGE(PG8_SB(0, 1), b2 + hstepB, voffB); PG8_STAGE_A(PG8_SA(0, 0), a2, 0, 1); PG8_PREFETCH(t + PF_D);
            PG8_WAIT_VP(); PG8_WAIT_L(0); PG8_BAR; PG8_MMA(1, 0, At, B0); PG8_MMA(1, 1, At, B1); PG8_BAR; PG8_SCHED;
            PG8_LDB(B0, 1, 0); PG8_LDB(B1, 1, 1); PG8_SCHED; PG8_LDA(At, 1, 0); PG8_STAGE_A(PG8_SA(0, 1), a2, 1, 1);
            PG8_WAIT_VP(); PG8_WAIT_L(0); PG8_BAR; PG8_MMA(0, 0, At, B0); PG8_MMA(0, 1, At, B1); PG8_BAR; PG8_SCHED;
            PG8_LDA(At, 1, 1); PG8_STAGE(PG8_SB(1, 0), b3, voffB); PG8_STAGE(PG8_SB(1, 1), b3 + hstepB, voffB); PG8_STAGE_A(PG8_SA(1, 0), a3, 0, 1); PG8_PREFETCH(t + 1 + PF_D);
            PG8_WAIT_VP(); PG8_WAIT_L(0); PG8_BAR; PG8_MMA(1, 0, At, B0); PG8_MMA(1, 1, At, B1); PG8_BAR; PG8_SCHED;
            } else {
            PG8_LDB(B0, 0, 0); PG8_SCHED; PG8_LDA(At, 0, 0); PG8_STAGE_A(PG8_SA(1, 1), a1, 1, 0);
            PG8_WAIT_L(8); PG8_BAR; PG8_WAIT_L(0); PG8_MMA(0, 0, At, B0); PG8_BAR; PG8_SCHED;
            PG8_LDB(B1, 0, 1); PG8_STAGE(PG8_SB(0, 0), b2, voffB);
            PG8_BAR; PG8_WAIT_L(0); PG8_MMA(0, 1, At, B1); PG8_BAR;
            PG8_LDA(At, 0, 1); PG8_STAGE_A(PG8_SA(0, 0), a2, 0, 1);
            PG8_BAR; PG8_WAIT_L(0); PG8_MMA(1, 0, At, B0); PG8_BAR; PG8_SCHED;
            PG8_STAGE(PG8_SB(0, 1), b2 + hstepB, voffB);
            PG8_WAIT_V(6); PG8_BAR; PG8_MMA(1, 1, At, B1); PG8_BAR;
            PG8_LDB(B0, 1, 0); PG8_SCHED; PG8_LDA(At, 1, 0); PG8_STAGE_A(PG8_SA(0, 1), a2, 1, 1);
            PG8_WAIT_L(8); PG8_BAR; PG8_WAIT_L(0); PG8_MMA(0, 0, At, B0); PG8_BAR; PG8_SCHED;
            PG8_LDB(B1, 1, 1); PG8_STAGE(PG8_SB(1, 0), b3, voffB);
            PG8_BAR; PG8_WAIT_L(0); PG8_MMA(0, 1, At, B1); PG8_BAR;
            PG8_LDA(At, 1, 1); PG8_STAGE_A(PG8_SA(1, 0), a3, 0, 1);
            PG8_BAR; PG8_WAIT_L(0); PG8_MMA(1, 0, At, B0); PG8_BAR; PG8_SCHED;
            PG8_STAGE(PG8_SB(1, 1), b3 + hstepB, voffB);
            PG8_WAIT_V(6); PG8_BAR; PG8_MMA(1, 1, At, B1); PG8_BAR;
            }
        }
        if constexpr (ALIGN_EPI) { if (wr == 0) PG8_BAR; }
        if constexpr (FP8) asm volatile("s_nop 15\n\ts_nop 15" ::: "memory");
        if constexpr (!Epi::AFTER_DRAIN && (DBG & 4) == 0) { E(acc, cur, wr, wc, fr, fq); S.done(cur); }
        if (!has_next) break;
#pragma unroll
        for (int a = 0; a < 2; ++a)
#pragma unroll
            for (int b = 0; b < 2; ++b)
#pragma unroll
                for (int m = 0; m < 4; ++m)
#pragma unroll
                    for (int n = 0; n < 2; ++n) acc[a][b][m][n] = (f32x4){0.f, 0.f, 0.f, 0.f};
        cur = nxt; cA = nA; cB = nB; ++ui;
        if constexpr (ALIGN_EPI) { if (wr == 1) PG8_BAR; }
    }
    PG8_WAIT_V(0);
    if constexpr (!ALIGN_EPI) { if (wr == 0) PG8_BAR; }
    PG8_BAR;
    if constexpr (Epi::AFTER_DRAIN) { E.fused(acc, cur, wr, wc, fr, fq, lds, wid, lane); S.done(cur); }
#undef PG8_SA
#undef PG8_SB
#undef PG8_STAGE
#undef PG8_STAGE_A
#undef PG8_LDA
#undef PG8_LDB
#undef PG8_MMA
#undef PG8_WAIT_V
#undef PG8_WAIT_VP
#undef PG8_PREFETCH
#undef PG8_WAIT_L
#undef PG8_BAR
#undef PG8_SCHED
}
}
constexpr int NTOK = 32768, DM = 1024, SEQ = 2048, NBATCH = 16, MEMLEN = 256, NMEM = NBATCH * MEMLEN, INW = 3088, NEXP = 32, TOPK = 4;
constexpr int PW = 3072;
constexpr int MAXTILES = 544;
constexpr float EPS = 1e-6f;
constexpr int NWAVES = 8;
constexpr size_t MiB = 1u << 20;
constexpr size_t WS_CTL = 0, CTL_ZERO_BYTES = 64 * 1024;
constexpr size_t WS_WINT = 2 * MiB, WS_WOUT = 10 * MiB, WS_WCQ = 12 * MiB, WS_WCK = 14 * MiB, WS_WCV = 16 * MiB, WS_WCO = 18 * MiB;
constexpr size_t WS_WR = 20 * MiB, WS_CS = 21 * MiB, WS_SSP1 = 24 * MiB, WS_GATE = 27 * MiB, WS_ASSIGN = 28 * MiB, WS_LIST = 29 * MiB;
constexpr size_t WS_RSL = 842 * MiB;
constexpr size_t WS_X2B = 378 * MiB;
constexpr size_t WS_WUP = 34 * MiB, WS_WDN = 162 * MiB, WS_KX = 226 * MiB, WS_VXT = 234 * MiB;
constexpr size_t WS_HN = 242 * MiB, WS_CAT = 242 * MiB, WS_MN = 306 * MiB, WS_P = 314 * MiB, WS_LA = 506 * MiB, WS_VT = 538 * MiB;
constexpr size_t WS_X1B = 314 * MiB, WS_GT = 378 * MiB, WS_HT = 410 * MiB, WS_PX = 506 * MiB;
constexpr size_t WS_GVT = 602 * MiB;
constexpr size_t WS_ACT = 570 * MiB, WS_Y = 706 * MiB, WS_END = 846 * MiB;
constexpr int CW_Q2 = 128;
constexpr int CW_CNT = 1024;
constexpr int CW_PROBE = 192;
constexpr int CW_BAR = 4096;
constexpr int RING_OFF = 0, RING_BYTES = 131072;
constexpr int LDSCTL_OFF = RING_BYTES, MISC_OFF = LDSCTL_OFF + 320;
constexpr int TAB_OFF = LDSCTL_OFF + 512;
constexpr int TAB_TSTART = TAB_OFF + 576, TAB_CNT = TAB_TSTART + 144;
constexpr int XCH2_OFF = LDSCTL_OFF + 6144;
constexpr int XCH_OFF = LDSCTL_OFF + 2048;
constexpr int TS_OFF = TAB_CNT + 128;
constexpr int LDS_BYTES = 147456;

#define GAS __attribute__((address_space(1)))
#define LAS __attribute__((address_space(3)))
typedef unsigned short bf16;
typedef unsigned v4u __attribute__((ext_vector_type(4)));
typedef float f32x4 __attribute__((ext_vector_type(4)));
typedef short bf16x8 __attribute__((ext_vector_type(8)));
typedef GAS unsigned gu32;
typedef GAS unsigned long long gu64;
#define RLX_AGENT __ATOMIC_RELAXED, __HIP_MEMORY_SCOPE_AGENT
#define LDS_WAIT() asm volatile("s_waitcnt lgkmcnt(0)" ::: "memory")
#define VM_WAIT() asm volatile("s_waitcnt vmcnt(0)" ::: "memory")
__device__ __forceinline__ unsigned long long rt() { return __builtin_amdgcn_s_memrealtime(); }
__device__ __forceinline__ unsigned f2bf(float f) { unsigned u = __builtin_bit_cast(unsigned, f); return (u + 0x7fffu + ((u >> 16) & 1u)) >> 16; }
__device__ __forceinline__ unsigned pk2(float lo, float hi) { return f2bf(lo) | (f2bf(hi) << 16); }

#define XB_TMO      128
#define XB_XCNT(j)  (256  + 64 * (j))
#define XB_XSUB(j)  (1280 + 64 * (j))
#define XB_XGEN(j)  (2304 + 64 * (j))
#define XB_TOP      3328
#define XB_TOPGEN   3392
#define XCD_BAR_WORDS 3456
#define XB_SPIN_CAP (1u << 18)

__device__ __forceinline__ unsigned xb_ld(unsigned* p)              { return __hip_atomic_load(p, __ATOMIC_RELAXED, __HIP_MEMORY_SCOPE_AGENT); }
__device__ __forceinline__ unsigned xb_add(unsigned* p, unsigned v) { return __hip_atomic_fetch_add(p, v, __ATOMIC_RELAXED, __HIP_MEMORY_SCOPE_AGENT); }
__device__ __forceinline__ unsigned xb_xcc_id() { return (unsigned)__builtin_amdgcn_s_getreg((3 << 11) | 20) & 0xFu; }
#define XB_SPIN(cond, bar) do { unsigned _sp = 0; while (cond) { __builtin_amdgcn_s_sleep(1); \
    if ((++_sp & 255u) == 0u) { if (xb_ld(&(bar)[XB_TMO])) break; if (_sp > XB_SPIN_CAP) { atomicAdd(&(bar)[XB_TMO], 1u); break; } } } } while (0)

struct XcdBarrier {
    unsigned* bar; unsigned x;
    volatile LAS unsigned* st;
};

__device__ __forceinline__ XcdBarrier xcd_barrier_post(unsigned* bar, volatile LAS unsigned* st) {
    XcdBarrier b; b.bar = bar; b.x = xb_xcc_id(); b.st = st;
    if (threadIdx.x == 0) (void)xb_add(&bar[XB_XCNT(b.x)], 1u);
    return b;
}
__device__ __forceinline__ void xcd_barrier_complete(unsigned* bar, unsigned x, unsigned& nloc, unsigned& nx) {
    const unsigned G = gridDim.x * gridDim.y * gridDim.z;
    unsigned sum, cnt, mine, sp = 0u;
    for (;;) {
        sum = 0u; cnt = 0u; mine = 0u;
#pragma unroll
        for (unsigned j = 0; j < 16; ++j) { const unsigned c = xb_ld(&bar[XB_XCNT(j)]); sum += c; cnt += (c > 0u) ? 1u : 0u; mine = (j == x) ? c : mine; }
        if (sum == G) break;
        __builtin_amdgcn_s_sleep(1);
        if ((++sp & 255u) == 0u) { if (xb_ld(&bar[XB_TMO])) break; if (sp > XB_SPIN_CAP) { atomicAdd(&bar[XB_TMO], 1u); break; } }
    }
    nloc = mine > 0u ? mine : 1u; nx = cnt > 0u ? cnt : 1u;
}

__device__ __forceinline__ void xcd_barrier(const XcdBarrier& b) {
    asm volatile("s_waitcnt vmcnt(0)" ::: "memory");
    __syncthreads();
    if (threadIdx.x == 0) {
        unsigned* bar = b.bar;
        __builtin_amdgcn_s_waitcnt(0);
        unsigned nloc = b.st[0], nx = b.st[1];
        if (nloc == 0u) { xcd_barrier_complete(bar, b.x, nloc, nx); b.st[0] = nloc; b.st[1] = nx; }
        const unsigned old = xb_add(&bar[XB_XSUB(b.x)], 1u);
        const unsigned gen = old / nloc;
        if (old + 1u == (gen + 1u) * nloc) {
            __builtin_amdgcn_fence(__ATOMIC_RELEASE, "agent");
            asm volatile("s_waitcnt vmcnt(0)" ::: "memory");
            const unsigned og = xb_add(&bar[XB_TOP], 1u);
            const unsigned tg = og / nx;
            if (og + 1u == (tg + 1u) * nx) xb_add(&bar[XB_TOPGEN], 1u);
            else XB_SPIN(xb_ld(&bar[XB_TOPGEN]) == tg, bar);
            __builtin_amdgcn_fence(__ATOMIC_ACQUIRE, "agent");
            xb_add(&bar[XB_XGEN(b.x)], 1u);
            asm volatile("s_waitcnt vmcnt(0)" ::: "memory");
        } else {
            XB_SPIN(xb_ld(&bar[XB_XGEN(b.x)]) == gen, bar);
            __builtin_amdgcn_fence(__ATOMIC_ACQUIRE, "agent");
            asm volatile("s_waitcnt vmcnt(0)" ::: "memory");
        }
    }
    __syncthreads();
}
typedef short bf16x4 __attribute__((ext_vector_type(4)));
typedef unsigned v2u __attribute__((ext_vector_type(2)));
struct Frame {
    LAS unsigned char* lds;
    volatile LAS unsigned* MISC;
    gu32* ctl;
    int tid, lane, wave;
    int vcu, G;
    unsigned char* ws;
    float* out;
};
__device__ __forceinline__ int lane_here() { int t = (int)threadIdx.x; asm volatile("" : "+v"(t)); return t & 63; }
__device__ __forceinline__ float bf2f(bf16 b) { return __builtin_bit_cast(float, (unsigned)b << 16); }
__device__ __forceinline__ float wave_sum(float v) {
#pragma unroll
    for (int o = 1; o < 64; o <<= 1) v += __shfl_xor(v, o);
    return v;
}
__device__ __forceinline__ float xmax16(float m) { auto rr = __builtin_amdgcn_permlane16_swap(__float_as_uint(m), __float_as_uint(m), false, false); return fmaxf(__uint_as_float(rr[0]), __uint_as_float(rr[1])); }
__device__ __forceinline__ float xmax32(float m) { auto rr = __builtin_amdgcn_permlane32_swap(__float_as_uint(m), __float_as_uint(m), false, false); return fmaxf(__uint_as_float(rr[0]), __uint_as_float(rr[1])); }
__device__ __forceinline__ f32x4 mfma16(bf16x8 a, bf16x8 b, f32x4 c) { return __builtin_amdgcn_mfma_f32_16x16x32_bf16(a, b, c, 0, 0, 0); }

__device__ __forceinline__ void p0_transpose_item(const float* W, int ldw, const float* gain, bf16* WT, int K, int k0, int n0, size_t orow0, int lane) {
    const int n4 = lane & 15, kq = lane >> 4;
    const float* src = W + (size_t)(k0 + 16 * kq) * ldw + n0 + 4 * n4;
    f32x4 v[16];
#pragma unroll
    for (int i = 0; i < 16; ++i) v[i] = __builtin_nontemporal_load((const f32x4*)(src + (size_t)i * ldw));
    if (gain) { const f32x4* gp = (const f32x4*)(gain + k0 + 16 * kq);
#pragma unroll
        for (int q = 0; q < 4; ++q) { const f32x4 gq = gp[q];
#pragma unroll
            for (int r = 0; r < 4; ++r) v[4 * q + r] = v[4 * q + r] * gq[r]; } }
    bf16* dst = WT + (orow0 + 4 * n4) * (size_t)K + k0 + 16 * kq;
#pragma unroll
    for (int j = 0; j < 4; ++j) { v4u o0, o1;
        o0.x = pg8::cvtpk(v[0][j], v[1][j]); o0.y = pg8::cvtpk(v[2][j], v[3][j]); o0.z = pg8::cvtpk(v[4][j], v[5][j]); o0.w = pg8::cvtpk(v[6][j], v[7][j]);
        o1.x = pg8::cvtpk(v[8][j], v[9][j]); o1.y = pg8::cvtpk(v[10][j], v[11][j]); o1.z = pg8::cvtpk(v[12][j], v[13][j]); o1.w = pg8::cvtpk(v[14][j], v[15][j]);
        *(v4u*)(dst + (size_t)j * K) = o0; *(v4u*)(dst + (size_t)j * K + 8) = o1; }
}
__device__ __forceinline__ void p0_transpose_item8(const float* W, int ldw, const float* gain, unsigned char* WT, int K, int k0, int n0, size_t orow0, int lane) {
    const int n4 = lane & 15, kq = lane >> 4;
    const float* src = W + (size_t)(k0 + 16 * kq) * ldw + n0 + 4 * n4;
    f32x4 v[16];
#pragma unroll
    for (int i = 0; i < 16; ++i) v[i] = __builtin_nontemporal_load((const f32x4*)(src + (size_t)i * ldw));
    { const f32x4* gp = (const f32x4*)(gain + k0 + 16 * kq);
#pragma unroll
        for (int q = 0; q < 4; ++q) { f32x4 gq = {32.f, 32.f, 32.f, 32.f}; if (gain) gq = gp[q] * 32.0f;
#pragma unroll
            for (int r = 0; r < 4; ++r) v[4 * q + r] = v[4 * q + r] * gq[r]; } }
    unsigned char* dst = WT + (orow0 + 4 * n4) * (size_t)K + k0 + 16 * kq;
#pragma unroll
    for (int j = 0; j < 4; ++j) { v4u o;
        o.x = pg8::cvt4_fp8((f32x4){v[0][j], v[1][j], v[2][j], v[3][j]}); o.y = pg8::cvt4_fp8((f32x4){v[4][j], v[5][j], v[6][j], v[7][j]});
        o.z = pg8::cvt4_fp8((f32x4){v[8][j], v[9][j], v[10][j], v[11][j]}); o.w = pg8::cvt4_fp8((f32x4){v[12][j], v[13][j], v[14][j], v[15][j]});
        *(v4u*)(dst + (size_t)j * K) = o; }
}
template <int NR> __device__ __forceinline__ void rms_rows_to_bf16(const float* const (&xrow)[NR], const float* g, bf16* const (&orow)[NR], int lane) {
    f32x4 v[NR][4]; float s[NR];
#pragma unroll
    for (int r = 0; r < NR; ++r) { const f32x4* xr = (const f32x4*)xrow[r] + lane;
#pragma unroll
        for (int j = 0; j < 4; ++j) v[r][j] = __builtin_nontemporal_load(xr + 64 * j); }
    const f32x4* gr = (const f32x4*)g + lane; f32x4 gg[4];
#pragma unroll
    for (int j = 0; j < 4; ++j) gg[j] = gr[64 * j];
#pragma unroll
    for (int r = 0; r < NR; ++r) { s[r] = 0.f;
#pragma unroll
        for (int j = 0; j < 4; ++j) s[r] += (v[r][j].x * v[r][j].x + v[r][j].y * v[r][j].y) + (v[r][j].z * v[r][j].z + v[r][j].w * v[r][j].w); }
#pragma unroll
    for (int r = 0; r < NR; ++r) { const float rs = rsqrtf(wave_sum(s[r]) * (1.0f / DM) + EPS); unsigned long long* o8 = (unsigned long long*)orow[r] + lane;
#pragma unroll
        for (int j = 0; j < 4; ++j) o8[64 * j] = (unsigned long long)pk2(v[r][j].x * rs * gg[j].x, v[r][j].y * rs * gg[j].y) | ((unsigned long long)pk2(v[r][j].z * rs * gg[j].z, v[r][j].w * rs * gg[j].w) << 32); }
}
constexpr int MOE_I_UP = 32 * 16 * 32, MOE_I_DN = 32 * 16 * 16, MOE_UNITS = (MOE_I_UP + MOE_I_DN) / 64;
__device__ __forceinline__ void moe_convert_unit(int unit, const float* w_up, const float* w_down, const float* g_ffn, unsigned char* ws, int wave, int lane) {
#pragma unroll 1
    for (int j = 0; j < 8; ++j) { int r = unit * 64 + j * 8 + wave;
        if (r < MOE_I_UP) { const int e = r / (16 * 32); r -= e * (16 * 32); const int n0 = 64 * (r % 32);
            const size_t orow = (size_t)e * 2048 + ((n0 & 1023) >> 7) * 256 + (n0 >> 10) * 128 + (n0 & 127);
            p0_transpose_item8(w_up + (size_t)e * DM * 2048, 2048, g_ffn, ws + WS_WUP, DM, 64 * (r / 32), n0, orow, lane); }
        else { r -= MOE_I_UP; const int e = r / (16 * 16); r -= e * (16 * 16);
            p0_transpose_item8(w_down + (size_t)e * DM * DM, DM, nullptr, ws + WS_WDN, DM, 64 * (r / 16), 64 * (r % 16), (size_t)e * 1024 + 64 * (r % 16), lane); } }
}
struct In {
    const float *x, *mem; const int* positions; const float *norm_mix_g, *w_in, *lq1, *lk1, *lq2, *lk2, *diff_norm_g, *w_alpha2, *b_alpha, *gla_norm_g, *w_out, *norm_cross_g, *norm_mem_g,
        *w_cq, *w_ck, *w_cv, *w_co, *norm_ffn_g, *w_router, *b_router, *w_up, *b_up, *w_down, *b_down, *norm_final_g;
};
__device__ __forceinline__ void p0_prologue(Frame& F, const In& I) {
    const int gw = F.vcu * NWAVES + F.wave, NGW = F.G * NWAVES, lane = lane_here();
    unsigned char* ws = F.ws;
    constexpr int I_IN = 16 * 48, I_SQ = 16 * 16;
    constexpr int NITEMS = I_IN + 4 * I_SQ;
    for (int it = gw; it < NITEMS; it += NGW) {
        int r = it;
        if (r < I_IN) { p0_transpose_item(I.w_in, INW, nullptr, (bf16*)(ws + WS_WINT), DM, 64 * (r / 48), 64 * (r % 48), (size_t)64 * (r % 48), lane); continue; } r -= I_IN;
        { const int w = r / I_SQ; r -= w * I_SQ;
            const float* W = w == 0 ? I.w_out : w == 1 ? I.w_ck : w == 2 ? I.w_cv : I.w_co;
            bf16* WT = (bf16*)(ws + (w == 0 ? WS_WOUT : w == 1 ? WS_WCK : w == 2 ? WS_WCV : WS_WCO));
            p0_transpose_item(W, DM, nullptr, WT, DM, 64 * (r / 16), 64 * (r % 16), (size_t)64 * (r % 16), lane); }
    }
    for (int idx = F.vcu * (NWAVES * 64) + F.tid; idx < DM * DM / 4; idx += F.G * NWAVES * 64) { const f32x4 v = ((const f32x4*)I.w_cq)[idx] * I.norm_cross_g[idx >> 8];
        v2u o; o.x = pk2(v.x, v.y); o.y = pk2(v.z, v.w); ((v2u*)(ws + WS_WCQ))[idx] = o; }
#if defined(PROBE_P0)
    if (F.tid == 0) ((LAS unsigned long long*)(F.lds + TS_OFF))[13] = rt();
#endif
    const int gt = F.vcu * (NWAVES * 64) + F.tid, NGT = F.G * NWAVES * 64;
    for (int idx = gt; idx < 256 * DM; idx += NGT) { const int j = idx >> 10, k = idx & 1023; const float* wr = I.w_in + (size_t)k * INW + 3072; float s = 0.f;
#pragma unroll
        for (int r = 0; r < 16; ++r) s += wr[r] * I.w_alpha2[r * 256 + j];
        ((bf16*)(ws + WS_WINT))[(size_t)(3072 + j) * DM + k] = (bf16)f2bf(s); }
    for (int idx = gt; idx < DM * NEXP; idx += NGT) { const int e = idx >> 10, k = idx & 1023; ((float*)(ws + WS_WR))[idx] = I.w_router[k * NEXP + e] * I.norm_ffn_g[k]; }
    for (int idx = gt; idx < NTOK * 8; idx += NGT) { const int tok = idx >> 3, i = idx & 7;
        const double inv = exp(-(double)i * 0.125 * 13.122363377404328); const double ang = (double)I.positions[tok] * inv;
        const double red = ang - rint(ang * 0.15915494309189535) * 6.283185307179586; const float rf = (float)red;
        float* cs = (float*)(ws + WS_CS) + (size_t)tok * 16; cs[i] = cosf(rf); cs[8 + i] = sinf(rf); }
#if defined(PROBE_P0)
    if (F.tid == 0) ((LAS unsigned long long*)(F.lds + TS_OFF))[14] = rt();
#endif
    for (int m = gw * 4; m < NTOK; m += NGW * 4) { const float* xr[4]; bf16* orw[4];
#pragma unroll
        for (int r = 0; r < 4; ++r) { xr[r] = I.x + (size_t)(m + r) * DM; orw[r] = (bf16*)(ws + WS_HN) + (size_t)(m + r) * DM; }
        rms_rows_to_bf16<4>(xr, I.norm_mix_g, orw, lane); }
    for (int m = gw * 4; m < NMEM; m += NGW * 4) { const float* xr[4]; bf16* orw[4];
#pragma unroll
        for (int r = 0; r < 4; ++r) { xr[r] = I.mem + (size_t)(m + r) * DM; orw[r] = (bf16*)(ws + WS_MN) + (size_t)(m + r) * DM; }
        rms_rows_to_bf16<4>(xr, I.norm_mem_g, orw, lane); }
}

constexpr int DA_KBUF = 16384, DA_VBUF = 16384, DA_VOFF = 2 * DA_KBUF;
template <int DBG = 0> __device__ __forceinline__ void diffattn_unit(Frame& F, const bf16* P, const bf16* VT, bf16* CAT, const float* gdiff, float lam, int b, int h, int qblk) {
    const int lane = lane_here(), wave = F.wave, tid = F.tid, l15 = lane & 15, g = lane >> 4;
    LAS unsigned char* lds = F.lds + RING_OFF;
    const int q0 = qblk * 128 + wave * 16;
    const size_t tokq = (size_t)b * SEQ + q0 + l15;
    bf16x8 qf[2][2];
#pragma unroll
    for (int c = 0; c < 2; ++c)
#pragma unroll
        for (int ks = 0; ks < 2; ++ks) qf[c][ks] = *(const bf16x8*)(P + tokq * PW + h * 128 + c * 64 + ks * 32 + g * 8);
    f32x4 o[2][8];
#pragma unroll
    for (int c = 0; c < 2; ++c)
#pragma unroll
        for (int k = 0; k < 8; ++k) o[c][k] = (f32x4){0.f, 0.f, 0.f, 0.f};
    float mrun[2] = {0.f, 0.f}, lsum[2] = {0.f, 0.f};
    const int nk = q0 + 16;
    const int nt = 2 * qblk + 2;
    const int skey = tid >> 4, sch = tid & 15, vrow = tid >> 3, vpc = tid & 7;
    const bf16* ksrc = P + ((size_t)b * SEQ + skey) * PW + 512 + h * 128 + sch * 8;
    const bf16* vsrc = VT + (size_t)(h * 128 + vrow) * NTOK + (size_t)b * SEQ + vpc * 8;
    const int kdst = skey * 256 + ((sch ^ (skey & 15)) * 16);
    const int vfr = (vrow >> 1) & 7, vch = (vpc >> 2) * 4 + 2 * (vpc & 1), vhi = ((vpc & 3) >> 1) * 8;
    const int vdst0 = DA_VOFF + vrow * 128 + ((vch ^ vfr) * 16) + vhi, vdst1 = DA_VOFF + vrow * 128 + (((vch + 1) ^ vfr) * 16) + vhi;
    int koff[2][2];
#pragma unroll
    for (int c = 0; c < 2; ++c)
#pragma unroll
        for (int ks = 0; ks < 2; ++ks) koff[c][ks] = l15 * 256 + (((c * 8 + ks * 4 + g) ^ l15) * 16);
    const int voffs[2] = {DA_VOFF + l15 * 128 + ((g ^ (l15 >> 1)) * 16), DA_VOFF + l15 * 128 + (((4 + g) ^ (l15 >> 1)) * 16)};
    v4u sk0, sk1, sv0, sv1;
#define DA_LOAD(tt) do { const bf16* kp_ = ksrc + (size_t)(tt) * 64 * PW; const bf16* vp_ = vsrc + (tt) * 64; \
        sk0 = *(const v4u*)kp_; sk1 = *(const v4u*)(kp_ + (size_t)32 * PW); sv0 = *(const v4u*)vp_; sv1 = *(const v4u*)(vp_ + (size_t)64 * NTOK); } while (0)
#define DA_STORE(bb) do { LAS unsigned char* kd_ = lds + (bb) * DA_KBUF + kdst; LAS unsigned char* vd_ = lds + (bb) * DA_VBUF; \
        *(LAS v4u*)kd_ = sk0; *(LAS v4u*)(kd_ + 8192) = sk1; \
        *(LAS v2u*)(vd_ + vdst0) = (v2u){sv0.x, sv0.y}; *(LAS v2u*)(vd_ + vdst1) = (v2u){sv0.z, sv0.w}; *(LAS v2u*)(vd_ + vdst0 + 8192) = (v2u){sv1.x, sv1.y}; *(LAS v2u*)(vd_ + vdst1 + 8192) = (v2u){sv1.z, sv1.w}; } while (0)
    DA_LOAD(0); DA_STORE(0);
    __syncthreads();
    auto step = [&](const int t, const int buf) __attribute__((always_inline)) {
        if (t * 64 < nk) {
            const LAS unsigned char* kb = lds + buf * DA_KBUF; const LAS unsigned char* vb = lds + buf * DA_VBUF;
            f32x4 s[2][2][2];
#pragma unroll
            for (int sub = 0; sub < 2; ++sub)
#pragma unroll
                for (int c = 0; c < 2; ++c)
#pragma unroll
                    for (int s2 = 0; s2 < 2; ++s2) { f32x4 a = (f32x4){-mrun[c], -mrun[c], -mrun[c], -mrun[c]};
#pragma unroll
                        for (int ks = 0; ks < 2; ++ks) { const bf16x8 kf = (DBG & 2) ? qf[c][ks ^ 1] : *(const LAS bf16x8*)(kb + sub * 8192 + s2 * 4096 + koff[c][ks]); if constexpr ((DBG & 1) == 0) a = mfma16(kf, qf[c][ks], a); else a[ks] += __builtin_bit_cast(float, (int)kf[0] << 16); }
                        s[sub][c][s2] = a; }
            if (t * 64 + 63 > q0) {
                const int qrow = q0 + l15;
#pragma unroll
                for (int sub = 0; sub < 2; ++sub)
#pragma unroll
                    for (int c = 0; c < 2; ++c)
#pragma unroll
                        for (int s2 = 0; s2 < 2; ++s2)
#pragma unroll
                            for (int r = 0; r < 4; ++r) if (t * 64 + sub * 32 + s2 * 16 + 4 * g + r > qrow) s[sub][c][s2][r] = -INFINITY;
            }
            float dl[2]; bool grow = false;
#pragma unroll
            for (int c = 0; c < 2; ++c) { float mx = -INFINITY;
#pragma unroll
                for (int sub = 0; sub < 2; ++sub)
#pragma unroll
                    for (int s2 = 0; s2 < 2; ++s2) mx = fmaxf(mx, fmaxf(fmaxf(s[sub][c][s2][0], s[sub][c][s2][1]), fmaxf(s[sub][c][s2][2], s[sub][c][s2][3])));
                mx = xmax16(mx); mx = xmax32(mx);
                dl[c] = (t == 0 || mx > 8.0f) ? mx : 0.f; grow = grow || (dl[c] != 0.f); }
            if (__any(grow)) {
#pragma unroll
                for (int c = 0; c < 2; ++c) { const float alpha = __builtin_amdgcn_exp2f(-dl[c]); mrun[c] += dl[c]; lsum[c] *= alpha;
#pragma unroll
                    for (int k = 0; k < 8; ++k) o[c][k] = o[c][k] * alpha;
#pragma unroll
                    for (int sub = 0; sub < 2; ++sub)
#pragma unroll
                        for (int s2 = 0; s2 < 2; ++s2)
#pragma unroll
                            for (int r = 0; r < 4; ++r) s[sub][c][s2][r] -= dl[c]; }
            }
#pragma unroll
            for (int sub = 0; sub < 2; ++sub) {
                bf16x8 pb[2];
#pragma unroll
                for (int c = 0; c < 2; ++c) { float ps = 0.f;
#pragma unroll
                    for (int s2 = 0; s2 < 2; ++s2)
#pragma unroll
                        for (int r = 0; r < 4; ++r) { const float p = (DBG & 4) ? s[sub][c][s2][r] * 0.001f : __builtin_amdgcn_exp2f(s[sub][c][s2][r]); s[sub][c][s2][r] = p; ps += p; }
                    lsum[c] += ps;
                    v4u w; w.x = pg8::cvtpk(s[sub][c][0][0], s[sub][c][0][1]); w.y = pg8::cvtpk(s[sub][c][0][2], s[sub][c][0][3]); w.z = pg8::cvtpk(s[sub][c][1][0], s[sub][c][1][1]); w.w = pg8::cvtpk(s[sub][c][1][2], s[sub][c][1][3]);
                    pb[c] = __builtin_bit_cast(bf16x8, w); }
#pragma unroll
                for (int k = 0; k < 8; ++k) { const bf16x8 vf = (DBG & 2) ? qf[k & 1][(k >> 1) & 1] : *(const LAS bf16x8*)(vb + voffs[sub] + k * 2048);
                    if constexpr ((DBG & 1) == 0) { o[0][k] = mfma16(vf, pb[0], o[0][k]); o[1][k] = mfma16(vf, pb[1], o[1][k]); }
                    else { o[0][k][0] += __builtin_bit_cast(float, (int)vf[0] << 16) + __builtin_bit_cast(float, (int)pb[0][k] << 16); o[1][k][0] += __builtin_bit_cast(float, (int)pb[1][k] << 16); } }
            }
        }
    };
    for (int t = 0; t < nt; ++t) {
        if ((DBG & 8) == 0 && t + 1 < nt) DA_LOAD(t + 1);
        step(t, t & 1);
        if ((DBG & 8) == 0 && t + 1 < nt) DA_STORE((t & 1) ^ 1);
        __syncthreads();
    }
#undef DA_LOAD
#undef DA_STORE
    float l0 = lsum[0], l1 = lsum[1];
    l0 += __shfl_xor(l0, 16); l0 += __shfl_xor(l0, 32); l1 += __shfl_xor(l1, 16); l1 += __shfl_xor(l1, 32);
    const float i0 = 1.0f / l0, i1 = lam / l1; float ss = 0.f;
#pragma unroll
    for (int k = 0; k < 8; ++k)
#pragma unroll
        for (int r = 0; r < 4; ++r) { const float v = o[0][k][r] * i0 - o[1][k][r] * i1; o[0][k][r] = v; ss += v * v; }
    ss += __shfl_xor(ss, 16); ss += __shfl_xor(ss, 32);
    const float rs = rsqrtf(ss * (1.0f / 128.0f) + EPS) * 0.8f;
    bf16* op = CAT + tokq * DM + h * 128 + 4 * g;
#pragma unroll
    for (int k = 0; k < 8; ++k) { const f32x4 gg = *(const f32x4*)(gdiff + k * 16 + 4 * g); f32x4 v = o[0][k] * rs; v = v * gg; pg8::st_bf4(op + k * 16, v); }
}

__device__ __forceinline__ bf16x8 pack8(const f32x4& a, const f32x4& b) { v4u w; w.x = pg8::cvtpk(a[0], a[1]); w.y = pg8::cvtpk(a[2], a[3]); w.z = pg8::cvtpk(b[0], b[1]); w.w = pg8::cvtpk(b[2], b[3]); return __builtin_bit_cast(bf16x8, w); }
constexpr int GL_QI = 0, GL_KI = 8192, GL_IMG = 16384, GL_EL = 2 * GL_IMG, GL_OB = GL_EL + 512, GL_OBS = 17408, GL_PS = GL_OB + 2 * GL_OBS, GL_END = GL_PS + 4096;

__device__ __forceinline__ void gla_unit(Frame& F, const bf16* P, const float* Bc, const bf16* GVT, bf16* CAT, const float* ggla, int b, int h) {
    const int lane = lane_here(), l15 = lane & 15, g = lane >> 4, eb = F.wave, tid = F.tid;
    LAS unsigned char* lds = F.lds + RING_OFF;
    const f32x4 zero4 = {0.f, 0.f, 0.f, 0.f};
    f32x4 S[4] = {zero4, zero4, zero4, zero4};
    bf16x8 If[4];
#pragma unroll
    for (int db = 0; db < 4; ++db) { const int ks = db >> 1;
#pragma unroll
        for (int j = 0; j < 8; ++j) { const int dp = 32 * ks + (j < 4 ? 4 * g + j : 16 + 4 * g + j - 4); If[db][j] = (dp == 16 * db + l15) ? (short)0x3F80 : (short)0; } }
    const int st = tid >> 3, sp = tid & 7, opc = tid & 15;
    const size_t tokb = (size_t)b * SEQ;
    const bf16* qsrc = P + (tokb + st) * PW + 1536 + h * 64 + sp * 8;
    const float* bsrc = Bc + (tokb + st) * 256 + h * 64 + sp * 8;
    const bf16* Vrow = GVT + (size_t)(h * 128 + 16 * eb + l15) * NTOK + tokb + 4 * g;
    const f32x4 gg0 = *(const f32x4*)(ggla + opc * 8), gg1 = *(const f32x4*)(ggla + opc * 8 + 4);
    const int foffs[2] = {l15 * 128 + ((g ^ (l15 >> 1)) * 16), l15 * 128 + (((4 + g) ^ (l15 >> 1)) * 16)};
    const int sfr = (st >> 1) & 7, sch0 = (sp >> 2) * 4 + 2 * (sp & 1), shi = ((sp & 3) >> 1) * 8, sd0 = st * 128 + ((sch0 ^ sfr) * 16) + shi, sd1 = st * 128 + (((sch0 + 1) ^ sfr) * 16) + shi;
    v4u rq = *(const v4u*)qsrc, rk = *(const v4u*)(qsrc + 256); f32x4 rb0 = *(const f32x4*)bsrc, rb1 = *(const f32x4*)(bsrc + 4);
#define GLA_STAGE(par) do { \
        float ee[8]; _Pragma("unroll") for (int i = 0; i < 4; ++i) { ee[i] = __expf(rb0[i]); ee[4 + i] = __expf(rb1[i]); } \
        const unsigned qa[4] = {rq.x, rq.y, rq.z, rq.w}, ka[4] = {rk.x, rk.y, rk.z, rk.w}; v4u wq, wk; unsigned* wqp = (unsigned*)&wq; unsigned* wkp = (unsigned*)&wk; \
        _Pragma("unroll") for (int i = 0; i < 4; ++i) { const float q0 = __builtin_bit_cast(float, qa[i] << 16), q1 = __builtin_bit_cast(float, qa[i] & 0xffff0000u), k0 = __builtin_bit_cast(float, ka[i] << 16), k1 = __builtin_bit_cast(float, ka[i] & 0xffff0000u); \
            wqp[i] = pg8::cvtpk(q0 * ee[2 * i], q1 * ee[2 * i + 1]); wkp[i] = pg8::cvtpk(k0 * __builtin_amdgcn_rcpf(ee[2 * i]), k1 * __builtin_amdgcn_rcpf(ee[2 * i + 1])); } \
        { LAS unsigned char* ib_ = lds + (par) * GL_IMG; *(LAS v2u*)(ib_ + GL_QI + sd0) = (v2u){wq.x, wq.y}; *(LAS v2u*)(ib_ + GL_QI + sd1) = (v2u){wq.z, wq.w}; *(LAS v2u*)(ib_ + GL_KI + sd0) = (v2u){wk.x, wk.y}; *(LAS v2u*)(ib_ + GL_KI + sd1) = (v2u){wk.z, wk.w}; } \
        if (st == 63) { *(LAS f32x4*)(lds + GL_EL + (par) * 256 + sp * 32) = (f32x4){ee[0], ee[1], ee[2], ee[3]}; *(LAS f32x4*)(lds + GL_EL + (par) * 256 + sp * 32 + 16) = (f32x4){ee[4], ee[5], ee[6], ee[7]}; } } while (0)
    bf16x8 VFn[2];
#pragma unroll
    for (int ss = 0; ss < 2; ++ss) { const bf16* vp = Vrow + 32 * ss; const v2u v0 = *(const v2u*)vp, v1 = *(const v2u*)(vp + 16); v4u vv; vv.x = v0.x; vv.y = v0.y; vv.z = v1.x; vv.w = v1.y; VFn[ss] = __builtin_bit_cast(bf16x8, vv); }
    GLA_STAGE(0);
    __syncthreads();
    for (int c = 0; c < SEQ / 64; ++c) {
        const int par = c & 1; const size_t tok0 = tokb + c * 64;
        if (c + 1 < SEQ / 64) { rq = *(const v4u*)(qsrc + (size_t)(c + 1) * 64 * PW); rk = *(const v4u*)(qsrc + (size_t)(c + 1) * 64 * PW + 256);
            rb0 = *(const f32x4*)(bsrc + (size_t)(c + 1) * 64 * 256); rb1 = *(const f32x4*)(bsrc + (size_t)(c + 1) * 64 * 256 + 4); }
        bf16x8 VF[2] = {VFn[0], VFn[1]};
        if (c + 1 < SEQ / 64) {
#pragma unroll
            for (int ss = 0; ss < 2; ++ss) { const bf16* vp = Vrow + (c + 1) * 64 + 32 * ss; const v2u v0 = *(const v2u*)vp, v1 = *(const v2u*)(vp + 16); v4u vv; vv.x = v0.x; vv.y = v0.y; vv.z = v1.x; vv.w = v1.y; VFn[ss] = __builtin_bit_cast(bf16x8, vv); } }
        v4u rg[2];
#pragma unroll
        for (int i = 0; i < 2; ++i) rg[i] = *(const v4u*)(P + (tok0 + ((tid + 512 * i) >> 4)) * PW + 2560 + h * 128 + opc * 8);
        const LAS unsigned char* qi = lds + par * GL_IMG + GL_QI; const LAS unsigned char* ki = lds + par * GL_IMG + GL_KI;
        bf16x8 qf[4][2], kf[4][2];
#pragma unroll
        for (int blk = 0; blk < 4; ++blk)
#pragma unroll
            for (int ks = 0; ks < 2; ++ks) { qf[blk][ks] = *(const LAS bf16x8*)(qi + foffs[ks] + blk * 2048); kf[blk][ks] = *(const LAS bf16x8*)(ki + foffs[ks] + blk * 2048); }
        const bf16x8 SF0 = pack8(S[0], S[1]), SF1 = pack8(S[2], S[3]);
        f32x4 O[4];
#pragma unroll
        for (int tb = 0; tb < 4; ++tb) { f32x4 o = mfma16(qf[tb][0], SF0, zero4); o = mfma16(qf[tb][1], SF1, o);
#pragma unroll
            for (int ss = 0; ss < 2; ++ss) if (2 * ss <= tb) { f32x4 a2[2];
#pragma unroll
                for (int hh = 0; hh < 2; ++hh) { const int sb = 2 * ss + hh; f32x4 a = zero4;
                    if (sb <= tb) { a = mfma16(kf[sb][0], qf[tb][0], zero4); a = mfma16(kf[sb][1], qf[tb][1], a);
                        if (sb == tb) {
#pragma unroll
                            for (int r = 0; r < 4; ++r) if (4 * g + r > l15) a[r] = 0.f; } }
                    a2[hh] = a; }
                o = mfma16(pack8(a2[0], a2[1]), VF[ss], o); }
            O[tb] = o; }
#pragma unroll
        for (int db = 0; db < 4; ++db) { f32x4 u = S[db];
#pragma unroll
            for (int ss = 0; ss < 2; ++ss) { const f32x4 t0 = mfma16(kf[2 * ss][db >> 1], If[db], zero4), t1 = mfma16(kf[2 * ss + 1][db >> 1], If[db], zero4); u = mfma16(pack8(t0, t1), VF[ss], u); }
            const f32x4 el = *(const LAS f32x4*)(lds + GL_EL + par * 256 + (16 * db + 4 * g) * 4);
            S[db] = u * el; }
        LAS unsigned char* ob = lds + GL_OB + par * GL_OBS; LAS float* ps = (LAS float*)(lds + GL_PS + par * 2048);
#pragma unroll
        for (int tb = 0; tb < 4; ++tb)
#pragma unroll
            for (int r = 0; r < 4; ++r) { const int t = 16 * tb + 4 * g + r; const float ov = O[tb][r]; float q = ov * ov; q += __shfl_xor(q, 1); q += __shfl_xor(q, 2); q += __shfl_xor(q, 4); q += __shfl_xor(q, 8);
                if (l15 == 0) ps[t * 8 + eb] = q;
                *(LAS bf16*)(ob + t * 272 + (16 * eb + l15) * 2) = (bf16)f2bf(ov); }
        if (c + 1 < SEQ / 64) GLA_STAGE(par ^ 1);
        __syncthreads();
#pragma unroll
        for (int i = 0; i < 2; ++i) { const int ot = (tid + 512 * i) >> 4; const f32x4 p0 = *(const LAS f32x4*)(ps + ot * 8), p1 = *(const LAS f32x4*)(ps + ot * 8 + 4);
            const float ss = ((p0[0] + p0[1]) + (p0[2] + p0[3])) + ((p1[0] + p1[1]) + (p1[2] + p1[3])); const float rs = rsqrtf(ss * (1.0f / 128.0f) + EPS);
            const v4u ov = *(const LAS v4u*)(ob + ot * 272 + opc * 16); const unsigned oa[4] = {ov.x, ov.y, ov.z, ov.w}, ga[4] = {rg[i].x, rg[i].y, rg[i].z, rg[i].w};
            const float gn[8] = {gg0[0], gg0[1], gg0[2], gg0[3], gg1[0], gg1[1], gg1[2], gg1[3]}; v4u w; unsigned* wp = (unsigned*)&w;
#pragma unroll
            for (int j = 0; j < 4; ++j) { const float o0 = __builtin_bit_cast(float, oa[j] << 16), o1 = __builtin_bit_cast(float, oa[j] & 0xffff0000u), g0 = __builtin_bit_cast(float, ga[j] << 16), g1 = __builtin_bit_cast(float, ga[j] & 0xffff0000u);
                wp[j] = pg8::cvtpk(o0 * rs * gn[2 * j] * g0 * __builtin_amdgcn_rcpf(1.0f + __builtin_amdgcn_exp2f(-1.4426950408889634f * g0)), o1 * rs * gn[2 * j + 1] * g1 * __builtin_amdgcn_rcpf(1.0f + __builtin_amdgcn_exp2f(-1.4426950408889634f * g1))); }
            *(v4u*)(CAT + (tok0 + ot) * DM + 512 + h * 128 + opc * 8) = w; }
    }
#undef GLA_STAGE
    __syncthreads();
}

__device__ __forceinline__ void router_phase(Frame& F, const bf16* X2, const float* WRt, const float* b_router, float* rsl, float* gate, unsigned* assign, unsigned* list, gu32* cnt) {
    typedef float f32x4v __attribute__((ext_vector_type(4)));
    LAS float* lg = (LAS float*)(F.lds + RING_OFF);
    LAS unsigned* hist = (LAS unsigned*)(lg + 128 * 33);
    const int tid = F.tid, lane = lane_here(), r16 = lane & 15, kq = lane >> 4, wv = F.wave, t = tid & 63;
    for (int blk = F.vcu; blk < NTOK / 128; blk += F.G) {
        const size_t tok0 = (size_t)blk * 128;
        const bf16* xp = X2 + (tok0 + wv * 16 + r16) * DM + 8 * kq; const float* w0 = WRt + (size_t)r16 * DM + 8 * kq; const float* w1 = w0 + (size_t)16 * DM;
        f32x4v acc0 = {0.f, 0.f, 0.f, 0.f}, acc1 = acc0; float ssq = 0.f;
#pragma unroll 4
        for (int m = 0; m < 32; ++m) { const v4u xw = *(const v4u*)(xp + 32 * m); const f32x4 a0 = *(const f32x4*)(w0 + 32 * m), a1 = *(const f32x4*)(w0 + 32 * m + 4), b0 = *(const f32x4*)(w1 + 32 * m), b1 = *(const f32x4*)(w1 + 32 * m + 4);
            const unsigned xa[4] = {xw.x, xw.y, xw.z, xw.w}; float xv[8];
#pragma unroll
            for (int j = 0; j < 4; ++j) { xv[2 * j] = __builtin_bit_cast(float, xa[j] << 16); xv[2 * j + 1] = __builtin_bit_cast(float, xa[j] & 0xffff0000u); }
            const float wa[8] = {a0[0], a0[1], a0[2], a0[3], a1[0], a1[1], a1[2], a1[3]}, wb[8] = {b0[0], b0[1], b0[2], b0[3], b1[0], b1[1], b1[2], b1[3]};
#pragma unroll
            for (int i = 0; i < 8; ++i) { acc0 = __builtin_amdgcn_mfma_f32_16x16x4f32(xv[i], wa[i], acc0, 0, 0, 0); acc1 = __builtin_amdgcn_mfma_f32_16x16x4f32(xv[i], wb[i], acc1, 0, 0, 0); ssq += xv[i] * xv[i]; } }
        ssq += __shfl_xor(ssq, 16); ssq += __shfl_xor(ssq, 32);
        float rsv[4];
#pragma unroll
        for (int j = 0; j < 4; ++j) { const float sq = __shfl(ssq, 4 * kq + j); rsv[j] = rsqrtf(sq * (1.0f / DM) + EPS); }
        const float br0 = b_router[r16], br1 = b_router[16 + r16];
#pragma unroll
        for (int j = 0; j < 4; ++j) { const int tl = wv * 16 + 4 * kq + j; lg[tl * 33 + r16] = acc0[j] * rsv[j] + br0; lg[tl * 33 + 16 + r16] = acc1[j] * rsv[j] + br1; if (r16 == 0) lg[tl * 33 + 32] = rsv[j]; }
        __syncthreads();
        if (tid < 128) {
            const int w2 = tid >> 6;
            float lv[32];
#pragma unroll
            for (int e = 0; e < 32; ++e) lv[e] = lg[tid * 33 + e];
            const float rs = lg[tid * 33 + 32];
            float tv[4]; int te[4];
#pragma unroll
            for (int k = 0; k < 4; ++k) { float best = -INFINITY; int bi = 0;
#pragma unroll
                for (int e = 0; e < 32; ++e) if (lv[e] > best) { best = lv[e]; bi = e; }
                tv[k] = best; te[k] = bi;
#pragma unroll
                for (int e = 0; e < 32; ++e) if (e == bi) lv[e] = -INFINITY; }
            const float e1 = __expf(tv[1] - tv[0]), e2 = __expf(tv[2] - tv[0]), e3 = __expf(tv[3] - tv[0]); const float inv = 1.0f / (1.0f + e1 + e2 + e3);
            const float gv[4] = {inv, e1 * inv, e2 * inv, e3 * inv};
            const size_t tok = tok0 + tid;
            LAS unsigned* hs = hist + w2 * 32; LAS unsigned* gbase = hist + 64 + w2 * 32;
            if (t < 32) hs[t] = 0u;
            __builtin_amdgcn_wave_barrier(); LDS_WAIT();
            unsigned lpos[4];
#pragma unroll
            for (int k = 0; k < 4; ++k) lpos[k] = __hip_atomic_fetch_add(hs + te[k], 1u, __ATOMIC_RELAXED, __HIP_MEMORY_SCOPE_WORKGROUP);
            __builtin_amdgcn_wave_barrier(); LDS_WAIT();
            if (t < 32) { const unsigned n = hs[t]; gbase[t] = n ? __hip_atomic_fetch_add(cnt + 64 * t, n, RLX_AGENT) : 0u; }
            __builtin_amdgcn_wave_barrier(); LDS_WAIT();
#pragma unroll
            for (int k = 0; k < 4; ++k) { const unsigned pos = gbase[te[k]] + lpos[k]; list[(size_t)te[k] * NTOK + pos] = (unsigned)tok; rsl[(size_t)te[k] * NTOK + pos] = rs;
                assign[tok * 4 + k] = ((unsigned)te[k] << 16) | pos; gate[tok * 4 + k] = gv[k]; }
        }
        __syncthreads();
    }
}
__device__ __forceinline__ int moe_tables(Frame& F) {
    LAS unsigned char* tile_e = F.lds + TAB_OFF; LAS int* tstart = (LAS int*)(F.lds + TAB_TSTART); LAS int* lc = (LAS int*)(F.lds + TAB_CNT);
    if (F.tid < 32) lc[F.tid] = (int)__hip_atomic_load(F.ctl + CW_CNT + 64 * F.tid, RLX_AGENT);
    __syncthreads();
    if (F.tid == 0) { int s = 0; for (int e = 0; e < 32; ++e) { tstart[e] = s; s += (lc[e] + 255) >> 8; } tstart[32] = s; }
    __syncthreads();
    const int T = tstart[32];
    for (int i = F.tid; i < T; i += 512) { int e = 0;
#pragma unroll
        for (int k = 1; k < 32; ++k) e += (tstart[k] <= i) ? 1 : 0;
        tile_e[i] = (unsigned char)e; }
    __syncthreads();
    return T;
}
__device__ __forceinline__ void final_phase(Frame& F, const bf16* X2, float* out, const unsigned char* Y, const float* gate, const unsigned* assign, const float* gfin) {
    (void)moe_tables(F);
    const LAS int* tstart = (const LAS int*)(F.lds + TAB_TSTART);
    const int gw = F.vcu * NWAVES + F.wave, NGW = F.G * NWAVES, lane = lane_here();
    unsigned an[2][4]; float gn[2][4];
#define FIN_ROUTE(t0) do { _Pragma("unroll") for (int u = 0; u < 2; ++u) { const int tok_ = ((t0) + u * NGW < NTOK) ? (t0) + u * NGW : ((t0) < NTOK ? (t0) : gw); \
        const v4u a4 = *(const v4u*)(assign + (size_t)tok_ * 4); const f32x4 g4 = *(const f32x4*)(gate + (size_t)tok_ * 4); \
        an[u][0] = a4.x; an[u][1] = a4.y; an[u][2] = a4.z; an[u][3] = a4.w; gn[u][0] = g4.x; gn[u][1] = g4.y; gn[u][2] = g4.z; gn[u][3] = g4.w; } } while (0)
    FIN_ROUTE(gw);
    for (int tok0 = gw; tok0 < NTOK; tok0 += 2 * NGW) {
        f32x4 v[2][4]; unsigned yw[2][4][4]; float gk[2][4];
#pragma unroll
        for (int u = 0; u < 2; ++u) { const int tok = (tok0 + u * NGW < NTOK) ? tok0 + u * NGW : tok0;
#pragma unroll
            for (int k = 0; k < 4; ++k) { const unsigned a = an[u][k]; gk[u][k] = gn[u][k]; const size_t row = (size_t)tstart[a >> 16] * 256 + (a & 0xffffu);
                const unsigned* yr = (const unsigned*)(Y + row * DM) + lane;
#pragma unroll
                for (int j = 0; j < 4; ++j) yw[u][k][j] = yr[64 * j]; }
            const v2u* xin = (const v2u*)(X2 + (size_t)tok * DM) + lane;
#pragma unroll
            for (int j = 0; j < 4; ++j) { const v2u w = xin[64 * j]; v[u][j] = (f32x4){__builtin_bit_cast(float, w.x << 16), __builtin_bit_cast(float, w.x & 0xffff0000u), __builtin_bit_cast(float, w.y << 16), __builtin_bit_cast(float, w.y & 0xffff0000u)}; } }
        FIN_ROUTE(tok0 + 2 * NGW);
#pragma unroll
        for (int u = 0; u < 2; ++u) { const int tok = (tok0 + u * NGW < NTOK) ? tok0 + u * NGW : tok0;
#pragma unroll
            for (int k = 0; k < 4; ++k)
#pragma unroll
                for (int j = 0; j < 4; ++j) { const unsigned w = yw[u][k][j]; const auto lo = __builtin_amdgcn_cvt_pk_f32_fp8((int)w, false), hi = __builtin_amdgcn_cvt_pk_f32_fp8((int)w, true);
                    v[u][j].x += gk[u][k] * lo[0]; v[u][j].y += gk[u][k] * lo[1]; v[u][j].z += gk[u][k] * hi[0]; v[u][j].w += gk[u][k] * hi[1]; }
            float s = 0.f;
#pragma unroll
            for (int j = 0; j < 4; ++j) s += (v[u][j].x * v[u][j].x + v[u][j].y * v[u][j].y) + (v[u][j].z * v[u][j].z + v[u][j].w * v[u][j].w);
            const float rs = rsqrtf(wave_sum(s) * (1.0f / DM) + EPS); f32x4* xr = (f32x4*)(out + (size_t)tok * DM) + lane;
#pragma unroll
            for (int j = 0; j < 4; ++j) { const f32x4 gg = ((const f32x4*)gfin)[lane + 64 * j]; xr[64 * j] = v[u][j] * rs * gg; } }
    }
#undef FIN_ROUTE
}

constexpr int NPHASE = 10;
struct Args { const void* in[28]; float* out; unsigned char* ws; int ph_lo, ph_hi; };
__global__ void __launch_bounds__(NWAVES * 64, 2) mk_fwd(Args args) {
    extern __shared__ __attribute__((aligned(16))) unsigned char lds[];
    Frame F;
    F.lds = (LAS unsigned char*)lds;
    F.MISC = (volatile LAS unsigned*)(F.lds + MISC_OFF);
    F.tid = threadIdx.x; F.lane = F.tid & 63; F.wave = __builtin_amdgcn_readfirstlane(F.tid >> 6);
    F.G = gridDim.x; { const int bx = blockIdx.x; F.vcu = (F.G % 8 == 0) ? (bx % 8) * (F.G / 8) + bx / 8 : bx; }
    F.ws = args.ws; F.out = args.out; F.ctl = (gu32*)(args.ws + WS_CTL);
    unsigned char* ws = args.ws;
    typedef const void* const volatile __attribute__((address_space(4))) kargp_t;
    kargp_t* const kargs = (kargp_t*)__builtin_amdgcn_kernarg_segment_ptr();
#define INP(k) ((const float*)kargs[k])
    for (int u = F.tid; u < (LDS_BYTES - LDSCTL_OFF) / 4; u += NWAVES * 64) ((LAS unsigned*)(F.lds + LDSCTL_OFF))[u] = 0u;
    __syncthreads();
    const int lo = args.ph_lo, hi = args.ph_hi;
    const bool single = (hi - lo) > 1;
    XcdBarrier bar; bar.bar = (unsigned*)(F.ctl + CW_BAR); bar.x = 0; bar.st = nullptr;
    if (single) bar = xcd_barrier_post((unsigned*)(F.ctl + CW_BAR), F.MISC + 8);
#define IN(k) (lo <= (k) && (k) < hi)
#if defined(PROBE_K0)
    LAS unsigned long long* tsl = (LAS unsigned long long*)(F.lds + TS_OFF);
    if (F.tid == 0) tsl[0] = rt();
#define SEAM(k) do { if (IN(k) && IN((k) + 1)) xcd_barrier(bar); if (F.tid == 0) tsl[(k) + 1] = rt(); } while (0)
#define SEAM_LOCAL(k) do { if (F.tid == 0) tsl[(k) + 1] = rt(); } while (0)
#else
#define SEAM(k) do { if (IN(k) && IN((k) + 1)) xcd_barrier(bar); } while (0)
#define SEAM_LOCAL(k) do { } while (0)
#endif
    typedef pg8::bf16_t hb;
    const int bx = (int)blockIdx.x;

    if (IN(0)) { In I;
        I.x = (const float*)INP(0);
        I.mem = (const float*)INP(1);
        I.positions = (const int*)INP(2);
        I.norm_mix_g = (const float*)INP(3);
        I.w_in = (const float*)INP(4);
        I.lq1 = (const float*)INP(5);
        I.lk1 = (const float*)INP(6);
        I.lq2 = (const float*)INP(7);
        I.lk2 = (const float*)INP(8);
        I.diff_norm_g = (const float*)INP(9);
        I.w_alpha2 = (const float*)INP(10);
        I.b_alpha = (const float*)INP(11);
        I.gla_norm_g = (const float*)INP(12);
        I.w_out = (const float*)INP(13);
        I.norm_cross_g = (const float*)INP(14);
        I.norm_mem_g = (const float*)INP(15);
        I.w_cq = (const float*)INP(16);
        I.w_ck = (const float*)INP(17);
        I.w_cv = (const float*)INP(18);
        I.w_co = (const float*)INP(19);
        I.norm_ffn_g = (const float*)INP(20);
        I.w_router = (const float*)INP(21);
        I.b_router = (const float*)INP(22);
        I.w_up = (const float*)INP(23);
        I.b_up = (const float*)INP(24);
        I.w_down = (const float*)INP(25);
        I.b_down = (const float*)INP(26);
        I.norm_final_g = (const float*)INP(27);
        p0_prologue(F, I); }
    SEAM(0);
    if (IN(1)) {
        pg8::Gemm g{(const hb*)(ws + WS_HN), (const hb*)(ws + WS_WINT), NTOK, 3328, DM, DM, DM, 127, 127};
        typedef pg8::OrderP1<(unsigned)WS_HN, (unsigned)WS_WINT, (unsigned)WS_MN, (unsigned)WS_WCK, (unsigned)WS_WCV> OrdP1; OrdP1 S; S.G = F.G; S.c = bx; S.ws = (const char*)ws;
        pg8::EpiP1 E{pg8::EpiProj{(hb*)(ws + WS_P), (float*)(ws + WS_LA), (const float*)(ws + WS_CS), INP(11)}, pg8::EpiPlain{(hb*)(ws + WS_VT) - (size_t)1024 * NTOK, NTOK, 1.0f},
                     pg8::EpiPlain{(hb*)(ws + WS_KX), DM, 1.0f}, pg8::EpiPlain{(hb*)(ws + WS_VXT), DM, 1.0f}};
        pg8::gemm_phase<pg8::EpiP1, OrdP1, true, true, false, false>(F.lds + RING_OFF, g, S, E);
    }
    SEAM(1);
    if (IN(2)) {
        float lam;
        { const int ln = lane_here(); const float a = INP(5)[ln] * INP(6)[ln], c = INP(7)[ln] * INP(8)[ln]; lam = __expf(wave_sum(a)) - __expf(wave_sum(c)) + 0.2f; }
        LAS int* qslot = (LAS int*)(F.lds + TAB_OFF);
        for (;;) {
            if (F.tid == 0) qslot[0] = (int)__hip_atomic_fetch_add(F.ctl + CW_Q2, 1u, RLX_AGENT);
            __syncthreads();
            const int u = qslot[0];
            __syncthreads();
            if (u >= 64 + 1024 + MOE_UNITS) break;
            int au = -1;
            if (u >= 64) { const int v = u - 64, gi = v / 11, r = v - gi * 11;
                if (r >= 8) { moe_convert_unit(gi * 3 + (r - 8), INP(23), INP(25), INP(20), ws, F.wave, lane_here()); continue; }
                au = gi * 8 + r; }
#if defined(PROBE_SPLIT)
            if (u < 64) continue;
#endif
            if (u < 64) { gla_unit(F, (const bf16*)(ws + WS_P), (const float*)(ws + WS_LA), (const bf16*)(ws + WS_GVT), (bf16*)(ws + WS_CAT), INP(12), u >> 2, u & 3);
            }
            else { const int v = au, bh = v & 63, qb = 15 - (v >> 6);
                diffattn_unit(F, (const bf16*)(ws + WS_P), (const bf16*)(ws + WS_VT), (bf16*)(ws + WS_CAT), INP(9), lam, bh >> 2, bh & 3, qb); }
        }
    }
#if defined(PROBE_SPLIT)
    if (IN(2)) { xcd_barrier(bar); if (F.tid == 0) tsl[13] = rt();
        for (int u = F.vcu; u < 64; u += F.G) gla_unit(F, (const bf16*)(ws + WS_P), (const float*)(ws + WS_LA), (const bf16*)(ws + WS_GVT), (bf16*)(ws + WS_CAT), INP(12), u >> 2, u & 3); }
#endif
    SEAM(2);
    if (IN(3)) {
        { pg8::Gemm g{(const hb*)(ws + WS_CAT), (const hb*)(ws + WS_WOUT), NTOK, DM, DM, DM, DM, 127, 127}; pg8::StaticOrder S; S.init(NTOK, DM, F.G, bx);
          pg8::EpiRes1 E{INP(0), (hb*)(ws + WS_X1B), (float*)(ws + WS_SSP1)};
          pg8::gemm_phase<pg8::EpiRes1, pg8::StaticOrder, true, true, false, false>(F.lds + RING_OFF, g, S, E); }
        { pg8::Gemm g{(const hb*)(ws + WS_KX), (const hb*)(ws + WS_WCQ), 64 * 256, DM, 256, DM, DM, 127, 127};
          typedef pg8::OrderGH<(unsigned)WS_KX, (unsigned)WS_WCQ, (unsigned)WS_WCO, (unsigned)WS_VXT> OrdGH; OrdGH S; S.G = F.G; S.c = bx; S.ws = (const char*)ws;
          pg8::EpiGH E{pg8::EpiPlain{(hb*)(ws + WS_GT), DM, 1.0f}, pg8::EpiPlain{(hb*)(ws + WS_HT), DM, 1.0f}};
          pg8::gemm_phase<pg8::EpiGH, OrdGH, true, true>(F.lds + RING_OFF, g, S, E); }
    }
    SEAM(3);
    if (IN(4)) {
        pg8::Gemm g{(const hb*)(ws + WS_X1B), (const hb*)(ws + WS_GT), NTOK, 256, DM, DM, DM, 127, 127}; pg8::OrderXS S; S.init(F.G, bx);
        pg8::EpiSoftmaxN E{(hb*)(ws + WS_PX), (const float*)(ws + WS_SSP1), (PG8_LAS float*)(F.lds + XCH_OFF), (PG8_LAS float*)(F.lds + XCH2_OFF)};
        pg8::gemm_phase<pg8::EpiSoftmaxN, pg8::OrderXS, true, true>(F.lds + RING_OFF, g, S, E);
    }
    SEAM(4);
    if (IN(5)) {
        pg8::Gemm g{(const hb*)(ws + WS_PX), (const hb*)(ws + WS_HT), NTOK, DM, DM, DM, DM, 127, 127}; pg8::OrderXO S; S.init(F.G, bx);
        pg8::EpiRes2 E{(hb*)(ws + WS_X1B), ws + WS_X2B};
        pg8::gemm_phase<pg8::EpiRes2, pg8::OrderXO, true, true, false, false>(F.lds + RING_OFF, g, S, E);
    }
    SEAM(5);
    if (IN(6)) router_phase(F, (const bf16*)(ws + WS_X1B), (const float*)(ws + WS_WR), INP(22), (float*)(ws + WS_RSL), (float*)(ws + WS_GATE), (unsigned*)(ws + WS_ASSIGN), (unsigned*)(ws + WS_LIST), F.ctl + CW_CNT);
    SEAM(6);
    if (IN(7)) {
        const int T = moe_tables(F);
        pg8::Gemm g{(const hb*)(ws + WS_X2B), (const hb*)(ws + WS_WUP), T * 256, NEXP * 2048, 512, 512, 512, 127, 122}; pg8::MoeOrderG S;
        S.init(T, 8, F.G, bx, (const PG8_LAS unsigned char*)(F.lds + TAB_OFF), (const PG8_LAS int*)(F.lds + TAB_TSTART), (const PG8_LAS int*)(F.lds + TAB_CNT), (const unsigned*)(ws + WS_LIST), (PG8_LAS unsigned*)(F.lds + XCH_OFF));
        pg8::EpiUp E{ws + WS_ACT, (const float*)(ws + WS_RSL), (const PG8_LAS int*)(F.lds + TAB_TSTART), (const PG8_LAS int*)(F.lds + TAB_CNT), INP(24)};
        pg8::gemm_phase<pg8::EpiUp, pg8::MoeOrderG, true, true, true, false>(F.lds + RING_OFF, g, S, E);
    }
    SEAM(7);
    if (IN(8)) {
        const int T = moe_tables(F);
        pg8::Gemm g{(const hb*)(ws + WS_ACT), (const hb*)(ws + WS_WDN), T * 256, NEXP * 1024, 512, 512, 512, 127, 122}; pg8::MoeOrder S; S.init(T, 4, F.G, bx, (const PG8_LAS unsigned char*)(F.lds + TAB_OFF));
        pg8::EpiDown E{ws + WS_Y, INP(26)};
        pg8::gemm_phase<pg8::EpiDown, pg8::MoeOrder, true, true, true, false>(F.lds + RING_OFF, g, S, E);
    }
    SEAM(8);
    if (IN(9)) final_phase(F, (const bf16*)(ws + WS_X1B), F.out, (const unsigned char*)(ws + WS_Y), (const float*)(ws + WS_GATE), (const unsigned*)(ws + WS_ASSIGN), INP(27));
#if defined(PROBE_ATT)
    { xcd_barrier(bar); if (F.tid == 0) tsl[13] = rt();
#pragma unroll 1
      for (int i2 = 2 * F.vcu; i2 < 1024; i2 += 2 * F.G)
#pragma unroll 1
          for (int rep = 0; rep < 2; ++rep) { const int i = i2 >> 1, bh = i >> 3, jj = i & 7;
              diffattn_unit<PROBE_ATT>(F, (const bf16*)(ws + WS_P), (const bf16*)(ws + WS_VT), (bf16*)(ws + WS_ACT), INP(9), 0.5f, bh >> 2, bh & 3, rep ? jj : 15 - jj); }
      xcd_barrier(bar); if (F.tid == 0) tsl[14] = rt(); }
#endif
#if defined(PROBE_GEMM)
    { xcd_barrier(bar); if (F.tid == 0) tsl[13] = rt();
      const int T = moe_tables(F);
      pg8::Gemm g{(const hb*)(ws + WS_X2B), (const hb*)(ws + WS_WUP), T * 256, NEXP * 2048, 512, 512, 512, 127, 122}; pg8::MoeOrderG S;
      S.init(T, 8, F.G, bx, (const PG8_LAS unsigned char*)(F.lds + TAB_OFF), (const PG8_LAS int*)(F.lds + TAB_TSTART), (const PG8_LAS int*)(F.lds + TAB_CNT), (const unsigned*)(ws + WS_LIST), (PG8_LAS unsigned*)(F.lds + XCH_OFF));
      pg8::EpiUp E{ws + WS_ACT, (const float*)(ws + WS_RSL), (const PG8_LAS int*)(F.lds + TAB_TSTART), (const PG8_LAS int*)(F.lds + TAB_CNT), INP(24)};
      pg8::gemm_phase<pg8::EpiUp, pg8::MoeOrderG, true, true, true, false, PROBE_GEMM>(F.lds + RING_OFF, g, S, E);
      xcd_barrier(bar); if (F.tid == 0) tsl[14] = rt(); }
#endif
#if defined(PROBE_K0)
#ifndef PROBE_UNIT
#define PROBE_UNIT 1600
#endif
    { if (F.tid == 0) { tsl[NPHASE] = rt();
        const int ks[2] = {PROBE_K0, PROBE_K1}; unsigned long long code = 0, mul = 1;
        for (int i = 0; i < 2; ++i) { unsigned long long dt = ks[i] == 94 ? tsl[14] - tsl[13] : ks[i] == 97 ? tsl[13] - tsl[2] : ks[i] == 98 ? tsl[3] - tsl[13] : ks[i] == 95 ? tsl[13] - tsl[0] : ks[i] == 96 ? tsl[14] - tsl[13] : tsl[ks[i] + 1] - tsl[ks[i]]; unsigned long long q = (dt + PROBE_UNIT / 2) / PROBE_UNIT; if (q > 63) q = 63; code += q * mul; mul *= 64; }
        tsl[15] = code * 6400ull; }
      __syncthreads();
      const unsigned long long t0 = rt(), wait = tsl[15]; float x = (float)F.tid, y = 1.0001f;
      while (rt() - t0 < wait) {
#pragma unroll
          for (int i = 0; i < 64; ++i) x = x * y + 0.5f; }
      if (x == 12345.678f) F.out[0] = x; }
#endif
#undef IN
#undef SEAM
#undef SEAM_LOCAL
}

#ifndef MK_N_LAUNCHES
#define MK_N_LAUNCHES 1
#endif
extern "C" void kernel_launch(void* const* d_in, const int* in_sizes, int n_in, void* d_out, int out_size, void* d_ws, size_t ws_size, hipStream_t stream) {
    static int grid = 0;
    if (grid == 0) {
        if (n_in != 28 || out_size != NTOK * DM || ws_size < WS_END) { fprintf(stderr, "kernel_launch: unexpected shapes: n_in %d out %d ws %zu (need %zu)\n", n_in, out_size, ws_size, (size_t)WS_END); grid = -1; return; }
        int dev = 0, cus = 0, per_cu = 0;
        if (hipGetDevice(&dev) != hipSuccess || hipDeviceGetAttribute(&cus, hipDeviceAttributeMultiprocessorCount, dev) != hipSuccess) { fprintf(stderr, "kernel_launch: device query failed\n"); grid = -1; return; }
        if (hipFuncSetAttribute((const void*)mk_fwd, hipFuncAttributeMaxDynamicSharedMemorySize, LDS_BYTES) != hipSuccess) { fprintf(stderr, "kernel_launch: hipFuncSetAttribute failed\n"); grid = -1; return; }
        if (hipOccupancyMaxActiveBlocksPerMultiprocessor(&per_cu, (const void*)mk_fwd, NWAVES * 64, LDS_BYTES) != hipSuccess || per_cu < 1) { fprintf(stderr, "kernel_launch: occupancy query reports %d workgroups per CU\n", per_cu); (void)hipGetLastError(); grid = -1; return; }
        grid = cus;
    }
    if (grid < 0) return;
    (void)hipMemsetAsync((char*)d_ws + WS_CTL, 0, CTL_ZERO_BYTES, stream);
    Args a{};
    for (int i = 0; i < 28; ++i) a.in[i] = d_in[i];
    a.out = (float*)d_out; a.ws = (unsigned char*)d_ws;
    if (MK_N_LAUNCHES == 1) { a.ph_lo = 0; a.ph_hi = NPHASE; hipLaunchKernelGGL(mk_fwd, dim3(grid), dim3(NWAVES * 64), LDS_BYTES, stream, a); }
    else for (int p = 0; p < NPHASE; ++p) { a.ph_lo = p; a.ph_hi = p + 1; hipLaunchKernelGGL(mk_fwd, dim3(grid), dim3(NWAVES * 64), LDS_BYTES, stream, a); }
}
```

```cpp
#include <hip/hip_runtime.h>
#include <cstdio>
#include <cstdint>
namespace pg8 {
#define PG8_LAS __attribute__((address_space(3)))
typedef unsigned short bf16_t;
typedef short bf16x8 __attribute__((ext_vector_type(8)));
typedef float f32x4 __attribute__((ext_vector_type(4)));
typedef unsigned u32x4 __attribute__((ext_vector_type(4)));
constexpr int BM = 256, BK = 64, HALF = 128, HTB = HALF * BK * 2  , STAGE_BYTES = 8 * HTB, NXCD = 8, WGM = 8;

__host__ __device__ __forceinline__ int lds_byte(int r, int c) { const int st = (r >> 4) * 2 + (c >> 5), rr = r & 15, cc = c & 31, ob = rr * 64 + cc * 2; return st * 1024 + (ob ^ (((ob >> 9) & 1) << 5)); }
__host__ __device__ __forceinline__ void stage_rc(int b, int& R, int& C) { const int st = b / 1024, sb = b % 1024, swz = sb ^ (((sb >> 9) & 1) << 5); R = (st >> 1) * 16 + swz / 64; C = (st & 1) * 32 + (swz % 64) / 2; }
__host__ __device__ __forceinline__ int perm32(int rho) { const int n = rho >> 4, i = rho & 15; return 8 * (i >> 2) + 4 * n + (i & 3); }

struct Unit { int pm, pn; };
struct Gemm { const bf16_t* A; const bf16_t* Bt; int M, N, K, lda, ldb, sa, sb; };
struct OrderBase {
    static constexpr bool GATHER = false;
    __device__ __forceinline__ const char* a_base(const Gemm& g, const Unit& u) const { return (const char*)g.A + (size_t)u.pm * 256 * g.lda * 2; }
    __device__ __forceinline__ const char* b_base(const Gemm& g, const Unit& u) const { return (const char*)g.Bt + (size_t)u.pn * 256 * g.ldb * 2; }
    __device__ __forceinline__ void a_ready(const Unit&) const {}
    __device__ __forceinline__ void done(const Unit&) const {}
};

struct StaticOrder : OrderBase {
    int nM, nN, nwg, G, c;
    __host__ __device__ void init(int M, int N, int G_, int c_) { nM = M / BM; nN = N / BM; nwg = nM * nN; G = G_; c = c_; }
    __host__ __device__ bool next(int i, Unit& u) const {
        const long L = (long)i * G + c; if (L >= nwg) return false;
        int wgid = (int)L; { const int q = nwg / NXCD, r = nwg % NXCD, xcd = wgid % NXCD, off = wgid / NXCD; wgid = (xcd < r ? xcd * (q + 1) : r * (q + 1) + (xcd - r) * q) + off; }
        const int nig = WGM * nN, gid = wgid / nig, fm = gid * WGM, gsz = (nM - fm) < WGM ? (nM - fm) : WGM;
        u.pm = fm + ((wgid % nig) % gsz); u.pn = (wgid % nig) / gsz; return true;
    }
};

typedef unsigned u32x2 __attribute__((ext_vector_type(2)));
typedef float f32x2_t __attribute__((ext_vector_type(2)));
typedef __bf16 bf16x2_t __attribute__((ext_vector_type(2)));
__device__ __forceinline__ unsigned cvtpk(float lo, float hi) { f32x2_t v = {lo, hi}; bf16x2_t b = __builtin_convertvector(v, bf16x2_t); return __builtin_bit_cast(unsigned, b); }
__device__ __forceinline__ void st_bf4(bf16_t* p, f32x4 v) { u32x2 w; w.x = cvtpk(v[0], v[1]); w.y = cvtpk(v[2], v[3]); *(u32x2*)p = w; }
__device__ __forceinline__ unsigned cvt4_fp8(f32x4 v) { unsigned w = __builtin_amdgcn_cvt_pk_fp8_f32(v[0], v[1], 0, false); return __builtin_amdgcn_cvt_pk_fp8_f32(v[2], v[3], w, true); }
__device__ __forceinline__ void st_bf8(bf16_t* p, f32x4 a, f32x4 c) { u32x4 w; w.x = cvtpk(a[0], a[1]); w.y = cvtpk(a[2], a[3]); w.z = cvtpk(c[0], c[1]); w.w = cvtpk(c[2], c[3]); *(u32x4*)p = w; }
__device__ __forceinline__ float bf2f(bf16_t b) { return __builtin_bit_cast(float, (unsigned)b << 16); }
#define EPI_ROWS _Pragma("unroll") for (int ai = 0; ai < 2; ++ai) _Pragma("unroll") for (int m = 0; m < 4; ++m)
#define EPI_COLS _Pragma("unroll") for (int bj = 0; bj < 2; ++bj) _Pragma("unroll") for (int n = 0; n < 2; ++n)
constexpr float LOG2E = 1.4426950408889634f;
constexpr float QSCALE_DA = 0.125f * LOG2E;
constexpr float QSCALE_X = 0.0625f * LOG2E;

struct EpiPlain {
    static constexpr bool PERM = true, AFTER_DRAIN = false;
    bf16_t* O; int ldc; float scale;
    __device__ __forceinline__ void operator()(const f32x4 (&acc)[2][2][4][2], const Unit& u, int wr, int wc, int fr, int fq) const {
        EPI_ROWS { const int row = u.pm * 256 + ai * 128 + wr * 64 + m * 16 + fr; bf16_t* rp = O + (size_t)row * ldc + u.pn * 256 + wc * 32 + fq * 8;
            _Pragma("unroll") for (int bj = 0; bj < 2; ++bj) st_bf8(rp + bj * 128, acc[ai][bj][m][0] * scale, acc[ai][bj][m][1] * scale); }
    }
};
struct EpiProj {
    static constexpr bool PERM = true, AFTER_DRAIN = false;
    bf16_t* P; float* LA; const float* cs; const float* b_alpha;
    template <int ai> __device__ __forceinline__ void decay_rows(const f32x4 (&acc)[2][2][4][2], const Unit& u, int wr, int wc, int fr, int fq) const {
        const int row0 = u.pm * 256 + ai * 128 + wr * 64 + fr;
        EPI_COLS { const int col = bj * 128 + wc * 32 + fq * 8 + n * 4; const f32x4 ba = *(const f32x4*)(b_alpha + col); f32x4 run = {0.f, 0.f, 0.f, 0.f};
            _Pragma("unroll") for (int m = 0; m < 4; ++m) { const f32x4 z = acc[ai][bj][m][n] + ba; f32x4 o;
                _Pragma("unroll") for (int i = 0; i < 4; ++i) { float v = (fminf(z[i], 0.f) - __logf(1.0f + __expf(-fabsf(z[i])))) * 0.0625f;
                    { float t = __shfl_up(v, 1, 16); if (fr >= 1) v += t; t = __shfl_up(v, 2, 16); if (fr >= 2) v += t; t = __shfl_up(v, 4, 16); if (fr >= 4) v += t; t = __shfl_up(v, 8, 16); if (fr >= 8) v += t; }
                    o[i] = v + run[i]; run[i] += __shfl(v, 15, 16); }
                *(f32x4*)(LA + (size_t)(row0 + m * 16) * 256 + col) = o; } }
    }
    __device__ __forceinline__ void operator()(const f32x4 (&acc)[2][2][4][2], const Unit& u, int wr, int wc, int fr, int fq) const {
        const int pn = u.pn;
        if (pn < 4) {
            const float sc = pn < 2 ? QSCALE_DA : 1.0f; const bool ropew = (wc & 1) == 0; const bool rl = fq < 2, hi = fq == 1;
            EPI_ROWS { const int row = u.pm * 256 + ai * 128 + wr * 64 + m * 16 + fr; bf16_t* rp = P + (size_t)row * 3072 + pn * 256 + wc * 32 + fq * 8;
                f32x4 cv[2], sv[2];
                if (ropew) { const f32x4* cp = (const f32x4*)(cs + (size_t)row * 16); cv[0] = cp[0]; cv[1] = cp[1]; sv[0] = cp[2]; sv[1] = cp[3]; }
                _Pragma("unroll") for (int bj = 0; bj < 2; ++bj) { f32x4 v[2] = {acc[ai][bj][m][0], acc[ai][bj][m][1]};
                    if (ropew) { _Pragma("unroll") for (int n = 0; n < 2; ++n) { f32x4 p; p[0] = __shfl_xor(v[n][0], 16); p[1] = __shfl_xor(v[n][1], 16); p[2] = __shfl_xor(v[n][2], 16); p[3] = __shfl_xor(v[n][3], 16);
                            const f32x4 r = hi ? (v[n] * cv[n] + p * sv[n]) : (v[n] * cv[n] - p * sv[n]); v[n] = rl ? r : v[n]; } }
                    st_bf8(rp + bj * 128, v[0] * sc, v[1] * sc); } }
        } else if (pn < 12) {
            const float sc = pn == 6 ? 0.125f : 1.0f;
            EPI_ROWS { const int row = u.pm * 256 + ai * 128 + wr * 64 + m * 16 + fr; bf16_t* rp = P + (size_t)row * 3072 + pn * 256 + wc * 32 + fq * 8;
                _Pragma("unroll") for (int bj = 0; bj < 2; ++bj) st_bf8(rp + bj * 128, acc[ai][bj][m][0] * sc, acc[ai][bj][m][1] * sc); }
        } else {
            decay_rows<0>(acc, u, wr, wc, fr, fq); decay_rows<1>(acc, u, wr, wc, fr, fq);
        }
    }
};
struct EpiP1 {
    static constexpr bool PERM = true, AFTER_DRAIN = false;
    EpiProj proj; EpiPlain vt, kx, vxt;
    __device__ __forceinline__ void operator()(const f32x4 (&acc)[2][2][4][2], const Unit& u, int wr, int wc, int fr, int fq) const {
        const int job = u.pn >> 16; Unit v; v.pm = u.pm; v.pn = u.pn & 0xffff;
        if (job == 0) proj(acc, v, wr, wc, fr, fq); else if (job == 1) vt(acc, v, wr, wc, fr, fq); else if (job == 2) kx(acc, v, wr, wc, fr, fq); else vxt(acc, v, wr, wc, fr, fq);
    }
};
struct EpiRes1 {
    static constexpr bool PERM = true, AFTER_DRAIN = false;
    const float* base; bf16_t* xb; float* ssp;
    __device__ __forceinline__ void operator()(const f32x4 (&acc)[2][2][4][2], const Unit& u, int wr, int wc, int fr, int fq) const {
        constexpr int ND = 3;
        const size_t off0 = (size_t)(u.pm * 256 + wr * 64 + fr) * 1024 + u.pn * 256 + wc * 32 + fq * 8;
        f32x4 xq[ND][4];
#define RES1_LD(i, sl) do { const float* bp_ = base + off0 + (size_t)((((i) >> 2) * 128 + ((i) & 3) * 16)) * 1024; xq[sl][0] = *(const f32x4*)bp_; xq[sl][1] = *(const f32x4*)(bp_ + 4); xq[sl][2] = *(const f32x4*)(bp_ + 128); xq[sl][3] = *(const f32x4*)(bp_ + 132); } while (0)
        _Pragma("unroll") for (int i = 0; i < ND; ++i) RES1_LD(i, i);
        _Pragma("unroll") for (int i = 0; i < 8; ++i) { const int ai = i >> 2, m = i & 3; const int row = u.pm * 256 + ai * 128 + wr * 64 + m * 16 + fr; const size_t off = off0 + (size_t)(ai * 128 + m * 16) * 1024;
            f32x4 v[4]; _Pragma("unroll") for (int q = 0; q < 4; ++q) v[q] = xq[i % ND][q] + acc[ai][q >> 1][m][q & 1];
            if (i + ND < 8) RES1_LD(i + ND, i % ND);
            st_bf8(xb + off, v[0], v[1]); st_bf8(xb + off + 128, v[2], v[3]); float ss = 0.f;
            _Pragma("unroll") for (int q = 0; q < 4; ++q) ss += (v[q][0] * v[q][0] + v[q][1] * v[q][1]) + (v[q][2] * v[q][2] + v[q][3] * v[q][3]);
            ss += __shfl_xor(ss, 16); ss += __shfl_xor(ss, 32);
            if (fq == 0) ssp[(size_t)row * 16 + u.pn * 4 + wc] = ss; }
#undef RES1_LD
    }
};
struct EpiQX {
    static constexpr bool PERM = true, AFTER_DRAIN = false;
    bf16_t* O; const float* ssp;
    __device__ __forceinline__ void operator()(const f32x4 (&acc)[2][2][4][2], const Unit& u, int wr, int wc, int fr, int fq) const {
        EPI_ROWS { const int row = u.pm * 256 + ai * 128 + wr * 64 + m * 16 + fr; const f32x4* sp = (const f32x4*)(ssp + (size_t)row * 16);
            const f32x4 a = sp[0], b = sp[1], c = sp[2], d = sp[3]; const float ss = ((a[0] + a[1]) + (a[2] + a[3])) + ((b[0] + b[1]) + (b[2] + b[3])) + ((c[0] + c[1]) + (c[2] + c[3])) + ((d[0] + d[1]) + (d[2] + d[3]));
            const float rs = rsqrtf(ss * (1.0f / 1024.0f) + 1e-6f) * QSCALE_X; bf16_t* rp = O + (size_t)row * 1024 + u.pn * 256 + wc * 32 + fq * 8;
            _Pragma("unroll") for (int bj = 0; bj < 2; ++bj) st_bf8(rp + bj * 128, acc[ai][bj][m][0] * rs, acc[ai][bj][m][1] * rs); }
    }
};
struct EpiRes2 {
    static constexpr bool PERM = true, AFTER_DRAIN = false;
    bf16_t* xh; unsigned char* x8;
    __device__ __forceinline__ void operator()(const f32x4 (&acc)[2][2][4][2], const Unit& u, int wr, int wc, int fr, int fq) const {
        constexpr int ND = 4;
        const size_t off0 = (size_t)(u.pm * 256 + wr * 64 + fr) * 1024 + u.pn * 256 + wc * 32 + fq * 8;
        u32x4 xq[ND][2];
#define RES2_LD(i, sl) do { const bf16_t* bp_ = xh + off0 + (size_t)((((i) >> 2) * 128 + ((i) & 3) * 16)) * 1024; xq[sl][0] = *(const u32x4*)bp_; xq[sl][1] = *(const u32x4*)(bp_ + 128); } while (0)
        _Pragma("unroll") for (int i = 0; i < ND; ++i) RES2_LD(i, i);
        _Pragma("unroll") for (int i = 0; i < 8; ++i) { const int ai = i >> 2, m = i & 3; const size_t off = off0 + (size_t)(ai * 128 + m * 16) * 1024;
            f32x4 v[2][2];
            _Pragma("unroll") for (int bj = 0; bj < 2; ++bj) { const u32x4 w = xq[i % ND][bj];
                const f32x4 v0 = {__builtin_bit_cast(float, w.x << 16), __builtin_bit_cast(float, w.x & 0xffff0000u), __builtin_bit_cast(float, w.y << 16), __builtin_bit_cast(float, w.y & 0xffff0000u)};
                const f32x4 v1 = {__builtin_bit_cast(float, w.z << 16), __builtin_bit_cast(float, w.z & 0xffff0000u), __builtin_bit_cast(float, w.w << 16), __builtin_bit_cast(float, w.w & 0xffff0000u)};
                v[bj][0] = v0 + acc[ai][bj][m][0]; v[bj][1] = v1 + acc[ai][bj][m][1]; }
            if (i + ND < 8) RES2_LD(i + ND, i % ND);
            _Pragma("unroll") for (int bj = 0; bj < 2; ++bj) { st_bf8(xh + off + bj * 128, v[bj][0], v[bj][1]); u32x2 q; q.x = cvt4_fp8(v[bj][0]); q.y = cvt4_fp8(v[bj][1]); *(u32x2*)(x8 + off + bj * 128) = q; } }
#undef RES2_LD
    }
};
struct EpiUp {
    static constexpr bool PERM = true, AFTER_DRAIN = false;
    unsigned char* ACT; const float* rsl; const PG8_LAS int* tstart; const PG8_LAS int* cnt; const float* b_up;
    __device__ __forceinline__ void operator()(const f32x4 (&acc)[2][2][4][2], const Unit& u, int wr, int wc, int fr, int fq) const {
        const int e = u.pn >> 3, pnl = u.pn & 7; const float* bg = b_up + (size_t)e * 2048 + pnl * 128 + wc * 32 + fq * 8;
        const int pos0 = (u.pm - tstart[e]) * 256 + wr * 64 + fr, nv = cnt[e]; const float* rp0 = rsl + (size_t)e * 32768 + pos0;
        const f32x4 bg0 = *(const f32x4*)bg, bg1 = *(const f32x4*)(bg + 4), bl0 = *(const f32x4*)(bg + 1024), bl1 = *(const f32x4*)(bg + 1028);
        float rsv[2][4];
        EPI_ROWS rsv[ai][m] = (pos0 + ai * 128 + m * 16) < nv ? rp0[ai * 128 + m * 16] : 0.f;
        EPI_ROWS { const int row = u.pm * 256 + ai * 128 + wr * 64 + m * 16 + fr; const float rs = rsv[ai][m];
            unsigned char* rp = ACT + (size_t)row * 1024 + pnl * 128 + wc * 32 + fq * 8; u32x2 w;
            _Pragma("unroll") for (int n = 0; n < 2; ++n) {
                const f32x4 c7 = {7.0f, 7.0f, 7.0f, 7.0f}, one = {1.0f, 1.0f, 1.0f, 1.0f};
                const f32x4 gl = __builtin_elementwise_min(acc[ai][0][m][n] * rs + (n ? bg1 : bg0), c7), li = __builtin_elementwise_min(__builtin_elementwise_max(acc[ai][1][m][n] * rs + (n ? bl1 : bl0), -c7), c7);
                const f32x4 t = gl * -2.4554669595930156f; f32x4 e; _Pragma("unroll") for (int i = 0; i < 4; ++i) e[i] = __builtin_amdgcn_exp2f(t[i]);
                const f32x4 a = e + one; f32x4 r; _Pragma("unroll") for (int i = 0; i < 4; ++i) r[i] = __builtin_amdgcn_rcpf(a[i]);
                const f32x4 o = (gl * r) * (li + one);
                if (n) w.y = cvt4_fp8(o); else w.x = cvt4_fp8(o); }
            *(u32x2*)rp = w; }
    }
};
struct EpiDown {
    static constexpr bool PERM = true, AFTER_DRAIN = false;
    unsigned char* Y; const float* b_down;
    __device__ __forceinline__ void operator()(const f32x4 (&acc)[2][2][4][2], const Unit& u, int wr, int wc, int fr, int fq) const {
        const int e = u.pn >> 2, pnl = u.pn & 3; const float* bp = b_down + (size_t)e * 1024 + pnl * 256 + wc * 32 + fq * 8;
        f32x4 bv[2][2];
        _Pragma("unroll") for (int bj = 0; bj < 2; ++bj) _Pragma("unroll") for (int n = 0; n < 2; ++n) bv[bj][n] = *(const f32x4*)(bp + bj * 128 + n * 4);
        EPI_ROWS { const int row = u.pm * 256 + ai * 128 + wr * 64 + m * 16 + fr; unsigned char* rp = Y + (size_t)row * 1024 + pnl * 256 + wc * 32 + fq * 8;
            _Pragma("unroll") for (int bj = 0; bj < 2; ++bj) { u32x2 w; w.x = cvt4_fp8(acc[ai][bj][m][0] + bv[bj][0]); w.y = cvt4_fp8(acc[ai][bj][m][1] + bv[bj][1]); *(u32x2*)(rp + bj * 128) = w; } }
    }
};
struct OrderMap : OrderBase {
    StaticOrder so;
    __device__ void init(int nM, int nN, int G, int c) { so.nM = nM; so.nN = nN; so.nwg = nM * nN; so.G = G; so.c = c; }
    __device__ bool next(int i, Unit& u) const { if (!so.next(i, u)) return false; u.pn += (u.pn >= 4 ? 2 : 0) + (u.pn >= 6 ? 2 : 0); return true; }
};
struct OrderVT : OrderBase {
    StaticOrder so;
    __device__ void init(int nN, int G, int c) { so.nM = 4; so.nN = nN; so.nwg = 4 * nN; so.G = G; so.c = c; }
    __device__ bool next(int i, Unit& u) const { if (!so.next(i, u)) return false; u.pm += (u.pm >= 2 ? 6 : 4); return true; }
};
__device__ __forceinline__ void map_unit(int L, int nM, int nN, int& pm, int& pn) {
    const int nwg = nM * nN; int wgid = L; { const int q = nwg / NXCD, r = nwg % NXCD, xcd = wgid % NXCD, off = wgid / NXCD; wgid = (xcd < r ? xcd * (q + 1) : r * (q + 1) + (xcd - r) * q) + off; }
    const int nig = WGM * nN, gid = wgid / nig, fm = gid * WGM, gsz = (nM - fm) < WGM ? (nM - fm) : WGM;
    pm = fm + ((wgid % nig) % gsz); pn = (wgid % nig) / gsz;
}
template <unsigned oHN, unsigned oWINT, unsigned oMN, unsigned oWCK, unsigned oWCV>
struct OrderP1 : OrderBase {
    int G, c; const char* ws;
    __device__ __forceinline__ bool next(int i, Unit& u) const {
        int L = i * G + c; if (L >= 1792) return false;
        if (L < 1152) { map_unit(L, 128, 9, u.pm, u.pn); u.pn += (u.pn >= 4 ? 2 : 0) + (u.pn >= 6 ? 2 : 0); return true; } L -= 1152;
        if (L < 512) { map_unit(L, 4, 128, u.pm, u.pn); u.pm += (u.pm >= 2 ? 6 : 4); u.pn |= 1 << 16; return true; } L -= 512;
        if (L < 64) { map_unit(L, 16, 4, u.pm, u.pn); u.pn |= 2 << 16; return true; } L -= 64;
        map_unit(L, 16, 4, u.pm, u.pn); u.pn |= 3 << 16; return true;
    }
    __device__ __forceinline__ const char* a_base(const Gemm&, const Unit& u) const { const int job = u.pn >> 16; unsigned o = oHN; o = job == 1 ? oWINT : o; o = job >= 2 ? oMN : o; return ws + o + (size_t)u.pm * (256 * 1024 * 2); }
    __device__ __forceinline__ const char* b_base(const Gemm&, const Unit& u) const { const int job = u.pn >> 16; unsigned o = oWINT; o = job == 1 ? oHN : o; o = job == 2 ? oWCK : o; o = job == 3 ? oWCV : o; return ws + o + (size_t)(u.pn & 0xffff) * (256 * 1024 * 2); }
};
struct MoeOrder : OrderBase {
    StaticOrder so; const PG8_LAS unsigned char* tile_e; int nN;
    __device__ void init(int nM, int nN_, int G, int c, const PG8_LAS unsigned char* te) { so.nM = nM; so.nN = nN_; so.nwg = nM * nN_; so.G = G; so.c = c; tile_e = te; nN = nN_; }
    __device__ bool next(int i, Unit& u) const { if (!so.next(i, u)) return false; u.pn += (int)tile_e[u.pm] * nN; return true; }
};


struct MoeOrderG : OrderBase {
    static constexpr bool GATHER = true;
    StaticOrder so; const PG8_LAS unsigned char* tile_e; const PG8_LAS int* tstart; const PG8_LAS int* cnt; const unsigned* list; PG8_LAS unsigned* gslot; int nN;
    __device__ void init(int nM, int nN_, int G, int c, const PG8_LAS unsigned char* te, const PG8_LAS int* ts, const PG8_LAS int* cn, const unsigned* li, PG8_LAS unsigned* gs) {
        so.nM = nM; so.nN = nN_; so.nwg = nM * nN_; so.G = G; so.c = c; tile_e = te; tstart = ts; cnt = cn; list = li; gslot = gs; nN = nN_; }
    __device__ bool next(int i, Unit& u) const { if (!so.next(i, u)) return false; u.pn += (int)tile_e[u.pm] * nN; return true; }
    __device__ __forceinline__ const char* a_base(const Gemm& g, const Unit&) const { return (const char*)g.A; }
    __device__ __forceinline__ const unsigned* rows(const Unit& u) const { const int e = u.pn / nN; return list + (size_t)e * 32768 + (size_t)(u.pm - tstart[e]) * 256; }
    __device__ __forceinline__ int nvalid(const Unit& u) const { const int e = u.pn / nN; return cnt[e] - (u.pm - tstart[e]) * 256; }
};
struct OrderX1 : OrderBase {
    StaticOrder so;
    __device__ void init(int G, int c) { so.nM = 128; so.nN = 4; so.nwg = 512; so.G = G; so.c = c; }
    __device__ bool next(int i, Unit& u) const { return so.next(i, u); }
    __device__ __forceinline__ const char* a_base(const Gemm& g, const Unit& u) const { return (const char*)(g.A + (size_t)u.pm * 256 * 1024 + u.pn * 256); }
    __device__ __forceinline__ const char* b_base(const Gemm& g, const Unit& u) const { return (const char*)(g.Bt + (size_t)(u.pm >> 3) * 256 * 1024 + u.pn * 256); }
};
struct OrderX2 : OrderBase {
    StaticOrder so;
    __device__ void init(int G, int c) { so.nM = 128; so.nN = 4; so.nwg = 512; so.G = G; so.c = c; }
    __device__ bool next(int i, Unit& u) const { return so.next(i, u); }
    __device__ __forceinline__ const char* a_base(const Gemm& g, const Unit& u) const { return (const char*)(g.A + (size_t)u.pm * 256 * 1024 + u.pn * 256); }
    __device__ __forceinline__ const char* b_base(const Gemm& g, const Unit& u) const { return (const char*)(g.Bt + (size_t)u.pn * 256 * 4096 + (u.pm >> 3) * 256); }
};
struct EpiSoftmax {
    static constexpr bool PERM = true, AFTER_DRAIN = false;
    bf16_t* PX; float* lp; PG8_LAS float* xch;
    __device__ __forceinline__ void operator()(const f32x4 (&acc)[2][2][4][2], const Unit& u, int wr, int wc, int fr, int fq) const {
        PG8_LAS char* rb = (PG8_LAS char*)xch + (wr * 64 + fr) * 16; asm volatile("" : "+v"(rb));
        PG8_LAS char* wb = rb + wc * 4; asm volatile("" : "+v"(wb));
        EPI_ROWS { float a = -INFINITY;
            EPI_COLS { const f32x4 v = acc[ai][bj][m][n]; a = fmaxf(a, fmaxf(fmaxf(v[0], v[1]), fmaxf(v[2], v[3]))); }
            a = fmaxf(a, __shfl_xor(a, 16)); a = fmaxf(a, __shfl_xor(a, 32));
            if (fq == 0) *(PG8_LAS float*)(wb + (ai * 128 + m * 16) * 16) = a; }
        asm volatile("s_waitcnt lgkmcnt(0)" ::: "memory"); __builtin_amdgcn_s_barrier(); asm volatile("" ::: "memory");
        const int row0 = u.pm * 256 + wr * 64 + fr; bf16_t* rp0 = PX + (size_t)row0 * 1024 + u.pn * 256 + wc * 32 + fq * 8; float* lp0 = lp + (size_t)row0 * 16 + u.pn * 4 + wc;
        EPI_ROWS { const f32x4 q = *(const PG8_LAS f32x4*)(rb + (ai * 128 + m * 16) * 16); const float mr = fmaxf(fmaxf(q[0], q[1]), fmaxf(q[2], q[3]));
            bf16_t* rp = rp0 + (size_t)(ai * 128 + m * 16) * 1024; float ps = 0.f;
            _Pragma("unroll") for (int bj = 0; bj < 2; ++bj) { f32x4 p[2];
                _Pragma("unroll") for (int n = 0; n < 2; ++n) _Pragma("unroll") for (int i = 0; i < 4; ++i) { p[n][i] = __builtin_amdgcn_exp2f(acc[ai][bj][m][n][i] - mr); ps += p[n][i]; }
                st_bf8(rp + bj * 128, p[0], p[1]); }
            ps += __shfl_xor(ps, 16); ps += __shfl_xor(ps, 32);
            if (fq == 0) lp0[(ai * 128 + m * 16) * 16] = ps; }
        asm volatile("s_waitcnt lgkmcnt(0)" ::: "memory"); __builtin_amdgcn_s_barrier(); asm volatile("" ::: "memory");
    }
};
struct EpiPV {
    static constexpr bool PERM = true, AFTER_DRAIN = false;
    bf16_t* O; const float* lp;
    __device__ __forceinline__ void operator()(const f32x4 (&acc)[2][2][4][2], const Unit& u, int wr, int wc, int fr, int fq) const {
        EPI_ROWS { const int row = u.pm * 256 + ai * 128 + wr * 64 + m * 16 + fr; const f32x4 q = *(const f32x4*)(lp + (size_t)row * 16 + u.pn * 4);
            const float inv = 1.0f / ((q[0] + q[1]) + (q[2] + q[3])); bf16_t* rp = O + (size_t)row * 1024 + u.pn * 256 + wc * 32 + fq * 8;
            _Pragma("unroll") for (int bj = 0; bj < 2; ++bj) st_bf8(rp + bj * 128, acc[ai][bj][m][0] * inv, acc[ai][bj][m][1] * inv); }
    }
};

template <unsigned oKX, unsigned oWCQR, unsigned oWCOT, unsigned oVX>
struct OrderGH : OrderBase {
    int G, c; const char* ws;
    __device__ __forceinline__ bool next(int i, Unit& u) const { int L = i * G + c; if (L >= 512) return false;
        if (L < 256) { u.pm = L >> 2; u.pn = L & 3; } else { L -= 256; u.pm = L >> 2; u.pn = (L & 3) | (1 << 16); } return true; }
    __device__ __forceinline__ const char* a_base(const Gemm&, const Unit& u) const { const int job = u.pn >> 16, pn = u.pn & 0xffff;
        return job == 0 ? ws + oKX + ((size_t)(u.pm >> 2) * 256 * 1024 + (u.pm & 3) * 256) * 2 : ws + oWCOT + ((size_t)(u.pm & 3) * 256 * 1024 + pn * 256) * 2; }
    __device__ __forceinline__ const char* b_base(const Gemm&, const Unit& u) const { const int job = u.pn >> 16, pn = u.pn & 0xffff;
        return job == 0 ? ws + oWCQR + ((size_t)pn * 256 * 1024 + (u.pm & 3) * 256) * 2 : ws + oVX + ((size_t)(u.pm >> 2) * 256 * 1024 + pn * 256) * 2; }
};
struct EpiGH {
    static constexpr bool PERM = true, AFTER_DRAIN = false;
    EpiPlain gt, ht;
    __device__ __forceinline__ void operator()(const f32x4 (&acc)[2][2][4][2], const Unit& u, int wr, int wc, int fr, int fq) const {
        Unit v; v.pm = u.pm; v.pn = u.pn & 0xffff; if ((u.pn >> 16) == 0) gt(acc, v, wr, wc, fr, fq); else ht(acc, v, wr, wc, fr, fq); }
};
struct OrderXS : OrderBase {
    StaticOrder so;
    __device__ void init(int G, int c) { so.nM = 128; so.nN = 4; so.nwg = 512; so.G = G; so.c = c; }
    __device__ bool next(int i, Unit& u) const { return so.next(i, u); }
    __device__ __forceinline__ const char* b_base(const Gemm& g, const Unit& u) const { return (const char*)(g.Bt + ((size_t)(u.pm >> 3) * 1024 + u.pn * 256) * 1024); }
};
struct EpiSoftmaxN {
    static constexpr bool PERM = true, AFTER_DRAIN = false;
    bf16_t* PX; const float* ssp; PG8_LAS float* xmax; PG8_LAS float* xsum;
    __device__ __forceinline__ void operator()(f32x4 (&acc)[2][2][4][2], const Unit& u, int wr, int wc, int fr, int fq) const {
        PG8_LAS char* rb = (PG8_LAS char*)xmax + (wr * 64 + fr) * 16; asm volatile("" : "+v"(rb));
        PG8_LAS char* wb = rb + wc * 4; asm volatile("" : "+v"(wb));
        PG8_LAS char* rb2 = (PG8_LAS char*)xsum + (wr * 64 + fr) * 16; asm volatile("" : "+v"(rb2));
        PG8_LAS char* wb2 = rb2 + wc * 4; asm volatile("" : "+v"(wb2));
        const int row0 = u.pm * 256 + wr * 64 + fr;
        f32x4 sq[2][4];
        EPI_ROWS sq[ai][m] = ((const f32x4*)(ssp + (size_t)(row0 + ai * 128 + m * 16) * 16))[fq];
        EPI_ROWS { float ss = (sq[ai][m][0] + sq[ai][m][1]) + (sq[ai][m][2] + sq[ai][m][3]); ss += __shfl_xor(ss, 16); ss += __shfl_xor(ss, 32);
            const float rs = rsqrtf(ss * (1.0f / 1024.0f) + 1e-6f) * QSCALE_X; float a = -INFINITY;
            EPI_COLS { f32x4 v = acc[ai][bj][m][n] * rs; acc[ai][bj][m][n] = v; a = fmaxf(a, fmaxf(fmaxf(v[0], v[1]), fmaxf(v[2], v[3]))); }
            a = fmaxf(a, __shfl_xor(a, 16)); a = fmaxf(a, __shfl_xor(a, 32));
            if (fq == 0) *(PG8_LAS float*)(wb + (ai * 128 + m * 16) * 16) = a; }
        asm volatile("s_waitcnt lgkmcnt(0)" ::: "memory"); __builtin_amdgcn_s_barrier(); asm volatile("" ::: "memory");
        EPI_ROWS { const f32x4 q = *(const PG8_LAS f32x4*)(rb + (ai * 128 + m * 16) * 16); const float mr = fmaxf(fmaxf(q[0], q[1]), fmaxf(q[2], q[3])); float ps = 0.f;
            EPI_COLS { f32x4 p; _Pragma("unroll") for (int i = 0; i < 4; ++i) { p[i] = __builtin_amdgcn_exp2f(acc[ai][bj][m][n][i] - mr); ps += p[i]; } acc[ai][bj][m][n] = p; }
            ps += __shfl_xor(ps, 16); ps += __shfl_xor(ps, 32);
            if (fq == 0) *(PG8_LAS float*)(wb2 + (ai * 128 + m * 16) * 16) = ps; }
        asm volatile("s_waitcnt lgkmcnt(0)" ::: "memory"); __builtin_amdgcn_s_barrier(); asm volatile("" ::: "memory");
        bf16_t* rp0 = PX + (size_t)row0 * 1024 + u.pn * 256 + wc * 32 + fq * 8;
        EPI_ROWS { const f32x4 q = *(const PG8_LAS f32x4*)(rb2 + (ai * 128 + m * 16) * 16); const float inv = __builtin_amdgcn_rcpf((q[0] + q[1]) + (q[2] + q[3]));
            bf16_t* rp = rp0 + (size_t)(ai * 128 + m * 16) * 1024;
            _Pragma("unroll") for (int bj = 0; bj < 2; ++bj) st_bf8(rp + bj * 128, acc[ai][bj][m][0] * inv, acc[ai][bj][m][1] * inv); }
    }
};
struct OrderXO : OrderBase {
    StaticOrder so;
    __device__ void init(int G, int c) { so.nM = 128; so.nN = 4; so.nwg = 512; so.G = G; so.c = c; }
    __device__ bool next(int i, Unit& u) const { return so.next(i, u); }
    __device__ __forceinline__ const char* b_base(const Gemm& g, const Unit& u) const { return (const char*)(g.Bt + ((size_t)(u.pm >> 3) * 1024 + u.pn * 256) * 1024); }
};
typedef int v4i_t __attribute__((ext_vector_type(4))); typedef int v8i_t __attribute__((ext_vector_type(8)));
__device__ __forceinline__ v8i_t cat8(bf16x8 lo, bf16x8 hi) { return __builtin_shufflevector(__builtin_bit_cast(v4i_t, lo), __builtin_bit_cast(v4i_t, hi), 0, 1, 2, 3, 4, 5, 6, 7); }
__device__ __forceinline__ void mfma8(f32x4& acc, v8i_t w, v8i_t a, int sw, int sa) {
    asm volatile("s_nop 1\n\tv_mfma_scale_f32_16x16x128_f8f6f4 %0, %1, %2, %0, %3, %4 op_sel_hi:[0,0,0]" : "+v"(acc) : "v"(w), "v"(a), "v"(sw), "v"(sa)); }
constexpr int PF_D = 4, PF_LDS = 137216;
template <class Epi, class Sched, bool ALIGN_EPI = false, bool SP2 = false, bool FP8 = false, bool PF = false, int DBG = 0>
__device__ __forceinline__ void gemm_phase(PG8_LAS unsigned char* lds, const Gemm g, const Sched& S, const Epi& E) {
    const int tid = threadIdx.x, wid = __builtin_amdgcn_readfirstlane(tid >> 6), lane = tid & 63, wr = wid >> 2, wc = wid & 3, fr = lane & 15, fq = lane >> 4;
    const int K = g.K, nt = K / BK;
    unsigned voffA[2], voffB[2];
    unsigned gC[2][2];
#pragma unroll
    for (int i = 0; i < 2; ++i) { int R, C; stage_rc(tid * 16 + i * 8192, R, C); const int Rb = Epi::PERM ? ((R & ~31) + perm32(R & 31)) : R;
        voffA[i] = (unsigned)(R * g.lda + C) * 2u; voffB[i] = (unsigned)(Rb * g.ldb + C) * 2u; }
    const bool pfA = !Sched::GATHER && wid < 4;
    const unsigned pfoff = (unsigned)((((wid >> 1) & 1) * HALF + (wid & 1) * 64 + lane) * (pfA ? g.lda : g.ldb)) * 2u;
    const size_t kstep = (size_t)(BK * 2);
    const size_t hstepA = (size_t)HALF * g.lda * 2, hstepB = (size_t)HALF * g.ldb * 2;
    const unsigned ldsw = (unsigned)wid * 1024u;
    const int aoff = lds_byte(wr * 64 + fr, fq * 8), boff = lds_byte(wc * 32 + fr, fq * 8);
#define PG8_SA(b, h) (((b) * 2 + (h)) * HTB)
#define PG8_SB(b, h) ((4 + (b) * 2 + (h)) * HTB)
#define PG8_STAGE(bufoff, gbase, voff) do { if constexpr ((DBG & 2) == 0) _Pragma("unroll") for (int _i = 0; _i < 2; ++_i) \
        __builtin_amdgcn_global_load_lds((const unsigned*)((const char*)(gbase) + (voff)[_i]), (PG8_LAS unsigned*)(lds + (bufoff) + ldsw + _i * 8192), 16, 0, 0); } while (0)
#define PG8_STAGE_A(bufoff, ptr, h, nx) do { if constexpr (Sched::GATHER) { PG8_STAGE(bufoff, ptr, gC[h]); } else { PG8_STAGE(bufoff, (ptr) + ((h) ? hstepA : 0), voffA); } } while (0)
#define PG8_LDA(dst, b, h) do { if constexpr ((DBG & 8) == 0) _Pragma("unroll") for (int m = 0; m < 4; ++m) _Pragma("unroll") for (int k = 0; k < 2; ++k) dst[m][k] = *(const PG8_LAS bf16x8*)(lds + PG8_SA(b, h) + aoff + m * 2048 + k * 1024); } while (0)
#define PG8_LDB(dst, b, h) do { if constexpr ((DBG & 8) == 0) _Pragma("unroll") for (int n = 0; n < 2; ++n) _Pragma("unroll") for (int k = 0; k < 2; ++k) dst[n][k] = *(const PG8_LAS bf16x8*)(lds + PG8_SB(b, h) + boff + n * 2048 + k * 1024); } while (0)
#define PG8_MMA(ai, bj, At, Bt) do { if constexpr ((DBG & 1) == 0) { __builtin_amdgcn_s_setprio(1); \
        if constexpr (FP8) { _Pragma("unroll") for (int m = 0; m < 4; ++m) _Pragma("unroll") for (int n = 0; n < 2; ++n) \
            mfma8(acc[ai][bj][m][n], cat8(Bt[n][0], Bt[n][1]), cat8(At[m][0], At[m][1]), g.sb, g.sa); } \
        else { _Pragma("unroll") for (int m = 0; m < 4; ++m) _Pragma("unroll") for (int n = 0; n < 2; ++n) _Pragma("unroll") for (int k = 0; k < 2; ++k) \
            acc[ai][bj][m][n] = __builtin_amdgcn_mfma_f32_16x16x32_bf16(Bt[n][k], At[m][k], acc[ai][bj][m][n], 0, 0, 0); } \
        __builtin_amdgcn_s_setprio(0); } } while (0)
#define PG8_WAIT_V(n) asm volatile("s_waitcnt vmcnt(" #n ")" ::: "memory")
#define PG8_WAIT_VP() do { if constexpr (PF) asm volatile("s_waitcnt vmcnt(9)" ::: "memory"); else asm volatile("s_waitcnt vmcnt(8)" ::: "memory"); } while (0)
#define PG8_PREFETCH(tp) do { if constexpr (PF) { const int tp_ = (tp); const char* pb_ = tp_ < nt ? (pfA ? cA : cB) + (size_t)tp_ * kstep : (pfA ? nA : nB) + (size_t)(tp_ - nt) * kstep; \
        __builtin_amdgcn_global_load_lds((const unsigned*)(pb_ + pfoff), (PG8_LAS unsigned*)(lds + PF_LDS + wid * 256), 4, 0, 0); } } while (0)
#define PG8_WAIT_L(n) asm volatile("s_waitcnt lgkmcnt(" #n ")" ::: "memory")
#define PG8_BAR __builtin_amdgcn_s_barrier()
#define PG8_SCHED __builtin_amdgcn_sched_barrier(0)
    Unit cur, nxt; int ui = 0;
    if (!S.next(0, cur)) return;
    f32x4 acc[2][2][4][2];
#pragma unroll
    for (int a = 0; a < 2; ++a)
#pragma unroll
        for (int b = 0; b < 2; ++b)
#pragma unroll
            for (int m = 0; m < 4; ++m)
#pragma unroll
                for (int n = 0; n < 2; ++n) acc[a][b][m][n] = (f32x4){0.f, 0.f, 0.f, 0.f};
    bf16x8 At[4][2], B0[2][2], B1[2][2];
    const char* cA = S.a_base(g, cur); const char* cB = S.b_base(g, cur);
    if constexpr (Sched::GATHER) { const unsigned* rp = S.rows(cur); const int nv = S.nvalid(cur);
#pragma unroll
        for (int h = 0; h < 2; ++h)
#pragma unroll
            for (int i = 0; i < 2; ++i) { int R, C; stage_rc(tid * 16 + i * 8192, R, C); const int r = h * HALF + R; const unsigned tok = r < nv ? rp[r] : 0u; gC[h][i] = tok * (unsigned)(g.lda * 2) + (unsigned)C * 2u; } }
    S.a_ready(cur);
    if constexpr (SP2) {
        PG8_STAGE(PG8_SB(0, 0), cB, voffB); PG8_STAGE(PG8_SB(0, 1), cB + hstepB, voffB); PG8_STAGE_A(PG8_SA(0, 0), cA, 0, 0); PG8_STAGE_A(PG8_SA(0, 1), cA, 1, 0);
        if (wr == 1) PG8_BAR;
        PG8_WAIT_V(2); PG8_BAR;
        PG8_STAGE(PG8_SB(1, 0), cB + kstep, voffB); PG8_STAGE_A(PG8_SA(1, 0), cA + kstep, 0, 0); PG8_STAGE(PG8_SB(1, 1), cB + hstepB + kstep, voffB);
        PG8_WAIT_V(6); PG8_BAR;
    } else {
        PG8_STAGE(PG8_SB(0, 0), cB, voffB); PG8_STAGE_A(PG8_SA(0, 0), cA, 0, 0); PG8_STAGE(PG8_SB(0, 1), cB + hstepB, voffB); PG8_STAGE_A(PG8_SA(0, 1), cA, 1, 0);
        if (wr == 1) PG8_BAR;
        PG8_WAIT_V(4); PG8_BAR;
        PG8_STAGE(PG8_SB(1, 0), cB + kstep, voffB); PG8_STAGE_A(PG8_SA(1, 0), cA + kstep, 0, 0); PG8_STAGE(PG8_SB(1, 1), cB + hstepB + kstep, voffB);
        PG8_WAIT_V(6); PG8_BAR;
    }
    for (;;) {
        const bool has_next = S.next(ui + 1, nxt);
        const char* nA = has_next ? S.a_base(g, nxt) : cA; const char* nB = has_next ? S.b_base(g, nxt) : cB;
        if constexpr (Sched::GATHER) { if (has_next && wid < 4)
            __builtin_amdgcn_global_load_lds((const unsigned*)(S.rows(nxt) + wid * 64 + lane), (PG8_LAS unsigned*)(S.gslot + ((ui + 1) & 1) * 256 + wid * 64), 4, 0, 0); }
#pragma nounroll
        for (int t = 0; t < nt; t += 2) {
            const bool last = (t == nt - 2);
            const char* a1 = cA + (size_t)(t + 1) * kstep;
            const char* a2 = last ? nA : cA + (size_t)(t + 2) * kstep; const char* b2 = last ? nB : cB + (size_t)(t + 2) * kstep;
            const char* a3 = a2 + kstep; const char* b3 = b2 + kstep;
            if (last && has_next) S.a_ready(nxt);
            if constexpr (SP2) {
            PG8_LDB(B0, 0, 0); PG8_LDB(B1, 0, 1); PG8_SCHED; PG8_LDA(At, 0, 0); PG8_STAGE_A(PG8_SA(1, 1), a1, 1, 0);
            if constexpr (Sched::GATHER) { if (last && has_next) {
                const PG8_LAS unsigned* sl = S.gslot + ((ui + 1) & 1) * 256; const int nv = S.nvalid(nxt);
#pragma unroll
                for (int h = 0; h < 2; ++h)
#pragma unroll
                    for (int i = 0; i < 2; ++i) { int R, C; stage_rc(tid * 16 + i * 8192, R, C); const int r = h * HALF + R; const unsigned v = sl[r]; const unsigned tok = r < nv ? v : 0u; gC[h][i] = tok * (unsigned)(g.lda * 2) + (unsigned)C * 2u; } } }
            PG8_WAIT_VP(); PG8_WAIT_L(0); PG8_BAR; PG8_MMA(0, 0, At, B0); PG8_MMA(0, 1, At, B1); PG8_BAR; PG8_SCHED;
            PG8_LDA(At, 0, 1); PG8_STAGE(PG8_SB(0, 0), b2, voffB); PG8_STAGE(PG8_SB(0, 1), b2 + hstepB, voffB); PG8_STAGE_A(PG8_SA(0, 0), a2, 0, 1); PG8_PREFETCH(t + PF_D);
            PG8_WAIT_VP(); PG8_WAIT_L(0); PG8_BAR; PG8_MMA(1, 0, At, B0); PG8_MMA(1, 1, At, B1); PG8_BAR; PG8_SCHED;
            PG8_LDB(B0, 1, 0); PG8_LDB(B1, 1, 1); PG8_SCHED; PG8_LDA(At, 1, 0); PG8_STAGE_A(PG8_SA(0, 1), a2, 1, 1);
            PG8_WAIT_VP(); PG8_WAIT_L(0); PG8_BAR; PG8_MMA(0, 0, At, B0); PG8_MMA(0, 1, At, B1); PG8_BAR; PG8_SCHED;
            PG8_LDA(At, 1, 1); PG8_STAGE(PG8_SB(1, 0), b3, voffB); PG8_STAGE(PG8_SB(1, 1), b3 + hstepB, voffB); PG8_STAGE_A(PG8_SA(1, 0), a3, 0, 1); PG8_PREFETCH(t + 1 + PF_D);
            PG8_WAIT_VP(); PG8_WAIT_L(0); PG8_BAR; PG8_MMA(1, 0, At, B0); PG8_MMA(1, 1, At, B1); PG8_BAR; PG8_SCHED;
            } else {
            PG8_LDB(B0, 0, 0); PG8_SCHED; PG8_LDA(At, 0, 0); PG8_STAGE_A(PG8_SA(1, 1), a1, 1, 0);
            PG8_WAIT_L(8); PG8_BAR; PG8_WAIT_L(0); PG8_MMA(0, 0, At, B0); PG8_BAR; PG8_SCHED;
            PG8_LDB(B1, 0, 1); PG8_STAGE(PG8_SB(0, 0), b2, voffB);
            PG8_BAR; PG8_WAIT_L(0); PG8_MMA(0, 1, At, B1); PG8_BAR;
            PG8_LDA(At, 0, 1); PG8_STAGE_A(PG8_SA(0, 0), a2, 0, 1);
            PG8_BAR; PG8_WAIT_L(0); PG8_MMA(1, 0, At, B0); PG8_BAR; PG8_SCHED;
            PG8_STAGE(PG8_SB(0, 1), b2 + hstepB, voffB);
            PG8_WAIT_V(6); PG8_BAR; PG8_MMA(1, 1, At, B1); PG8_BAR;
            PG8_LDB(B0, 1, 0); PG8_SCHED; PG8_LDA(At, 1, 0); PG8_STAGE_A(PG8_SA(0, 1), a2, 1, 1);
            PG8_WAIT_L(8); PG8_BAR; PG8_WAIT_L(0); PG8_MMA(0, 0, At, B0); PG8_BAR; PG8_SCHED;
            PG8_LDB(B1, 1, 1); PG8_STAGE(PG8_SB(1, 0), b3, voffB);
            PG8_BAR; PG8_WAIT_L(0); PG8_MMA(0, 1, At, B1); PG8_BAR;
            PG8_LDA(At, 1, 1); PG8_STAGE_A(PG8_SA(1, 0), a3, 0, 1);
            PG8_BAR; PG8_WAIT_L(0); PG8_MMA(1, 0, At, B0); PG8_BAR; PG8_SCHED;
            PG8_STAGE(PG8_SB(1, 1), b3 + hstepB, voffB);
            PG8_WAIT_V(6); PG8_BAR; PG8_MMA(1, 1, At, B1); PG8_BAR;
            }
        }
        if constexpr (ALIGN_EPI) { if (wr == 0) PG8_BAR; }
        if constexpr (FP8) asm volatile("s_nop 15\n\ts_nop 15" ::: "memory");
        if constexpr (!Epi::AFTER_DRAIN && (DBG & 4) == 0) { E(acc, cur, wr, wc, fr, fq); S.done(cur); }
        if (!has_next) break;
#pragma unroll
        for (int a = 0; a < 2; ++a)
#pragma unroll
            for (int b = 0; b < 2; ++b)
#pragma unroll
                for (int m = 0; m < 4; ++m)
#pragma unroll
                    for (int n = 0; n < 2; ++n) acc[a][b][m][n] = (f32x4){0.f, 0.f, 0.f, 0.f};
        cur = nxt; cA = nA; cB = nB; ++ui;
        if constexpr (ALIGN_EPI) { if (wr == 1) PG8_BAR; }
    }
    PG8_WAIT_V(0);
    if constexpr (!ALIGN_EPI) { if (wr == 0) PG8_BAR; }
    PG8_BAR;
    if constexpr (Epi::AFTER_DRAIN) { E.fused(acc, cur, wr, wc, fr, fq, lds, wid, lane); S.done(cur); }
#undef PG8_SA
#undef PG8_SB
#undef PG8_STAGE
#undef PG8_STAGE_A
#undef PG8_LDA
#undef PG8_LDB
#undef PG8_MMA
#undef PG8_WAIT_V
#undef PG8_WAIT_VP
#undef PG8_PREFETCH
#undef PG8_WAIT_L
#undef PG8_BAR
#undef PG8_SCHED
}
}
constexpr int NTOK = 32768, DM = 1024, SEQ = 2048, NBATCH = 16, MEMLEN = 256, NMEM = NBATCH * MEMLEN, INW = 3088, NEXP = 32, TOPK = 4;
constexpr int PW = 3072;
constexpr int MAXTILES = 544;
constexpr float EPS = 1e-6f;
constexpr int NWAVES = 8;
constexpr size_t MiB = 1u << 20;
constexpr size_t WS_CTL = 0, CTL_ZERO_BYTES = 64 * 1024;
constexpr size_t WS_WINT = 2 * MiB, WS_WOUT = 10 * MiB, WS_WCQ = 12 * MiB, WS_WCK = 14 * MiB, WS_WCV = 16 * MiB, WS_WCO = 18 * MiB;
constexpr size_t WS_WR = 20 * MiB, WS_CS = 21 * MiB, WS_SSP1 = 24 * MiB, WS_GATE = 27 * MiB, WS_ASSIGN = 28 * MiB, WS_LIST = 29 * MiB;
constexpr size_t WS_RSL = 842 * MiB;
constexpr size_t WS_X2B = 378 * MiB;
constexpr size_t WS_WUP = 34 * MiB, WS_WDN = 162 * MiB, WS_KX = 226 * MiB, WS_VXT = 234 * MiB;
constexpr size_t WS_HN = 242 * MiB, WS_CAT = 242 * MiB, WS_MN = 306 * MiB, WS_P = 314 * MiB, WS_LA = 506 * MiB, WS_VT = 538 * MiB;
constexpr size_t WS_X1B = 314 * MiB, WS_GT = 378 * MiB, WS_HT = 410 * MiB, WS_PX = 506 * MiB;
constexpr size_t WS_GVT = 602 * MiB;
constexpr size_t WS_ACT = 570 * MiB, WS_Y = 706 * MiB, WS_END = 846 * MiB;
constexpr int CW_Q2 = 128;
constexpr int CW_CNT = 1024;
constexpr int CW_PROBE = 192;
constexpr int CW_BAR = 4096;
constexpr int RING_OFF = 0, RING_BYTES = 131072;
constexpr int LDSCTL_OFF = RING_BYTES, MISC_OFF = LDSCTL_OFF + 320;
constexpr int TAB_OFF = LDSCTL_OFF + 512;
constexpr int TAB_TSTART = TAB_OFF + 576, TAB_CNT = TAB_TSTART + 144;
constexpr int XCH2_OFF = LDSCTL_OFF + 6144;
constexpr int XCH_OFF = LDSCTL_OFF + 2048;
constexpr int TS_OFF = TAB_CNT + 128;
constexpr int LDS_BYTES = 147456;

#define GAS __attribute__((address_space(1)))
#define LAS __attribute__((address_space(3)))
typedef unsigned short bf16;
typedef unsigned v4u __attribute__((ext_vector_type(4)));
typedef float f32x4 __attribute__((ext_vector_type(4)));
typedef short bf16x8 __attribute__((ext_vector_type(8)));
typedef GAS unsigned gu32;
typedef GAS unsigned long long gu64;
#define RLX_AGENT __ATOMIC_RELAXED, __HIP_MEMORY_SCOPE_AGENT
#define LDS_WAIT() asm volatile("s_waitcnt lgkmcnt(0)" ::: "memory")
#define VM_WAIT() asm volatile("s_waitcnt vmcnt(0)" ::: "memory")
__device__ __forceinline__ unsigned long long rt() { return __builtin_amdgcn_s_memrealtime(); }
__device__ __forceinline__ unsigned f2bf(float f) { unsigned u = __builtin_bit_cast(unsigned, f); return (u + 0x7fffu + ((u >> 16) & 1u)) >> 16; }
__device__ __forceinline__ unsigned pk2(float lo, float hi) { return f2bf(lo) | (f2bf(hi) << 16); }

#define XB_TMO      128
#define XB_XCNT(j)  (256  + 64 * (j))
#define XB_XSUB(j)  (1280 + 64 * (j))
#define XB_XGEN(j)  (2304 + 64 * (j))
#define XB_TOP      3328
#define XB_TOPGEN   3392
#define XCD_BAR_WORDS 3456
#define XB_SPIN_CAP (1u << 18)

__device__ __forceinline__ unsigned xb_ld(unsigned* p)              { return __hip_atomic_load(p, __ATOMIC_RELAXED, __HIP_MEMORY_SCOPE_AGENT); }
__device__ __forceinline__ unsigned xb_add(unsigned* p, unsigned v) { return __hip_atomic_fetch_add(p, v, __ATOMIC_RELAXED, __HIP_MEMORY_SCOPE_AGENT); }
__device__ __forceinline__ unsigned xb_xcc_id() { return (unsigned)__builtin_amdgcn_s_getreg((3 << 11) | 20) & 0xFu; }
#define XB_SPIN(cond, bar) do { unsigned _sp = 0; while (cond) { __builtin_amdgcn_s_sleep(1); \
    if ((++_sp & 255u) == 0u) { if (xb_ld(&(bar)[XB_TMO])) break; if (_sp > XB_SPIN_CAP) { atomicAdd(&(bar)[XB_TMO], 1u); break; } } } } while (0)

struct XcdBarrier {
    unsigned* bar; unsigned x;
    volatile LAS unsigned* st;
};

__device__ __forceinline__ XcdBarrier xcd_barrier_post(unsigned* bar, volatile LAS unsigned* st) {
    XcdBarrier b; b.bar = bar; b.x = xb_xcc_id(); b.st = st;
    if (threadIdx.x == 0) (void)xb_add(&bar[XB_XCNT(b.x)], 1u);
    return b;
}
__device__ __forceinline__ void xcd_barrier_complete(unsigned* bar, unsigned x, unsigned& nloc, unsigned& nx) {
    const unsigned G = gridDim.x * gridDim.y * gridDim.z;
    unsigned sum, cnt, mine, sp = 0u;
    for (;;) {
        sum = 0u; cnt = 0u; mine = 0u;
#pragma unroll
        for (unsigned j = 0; j < 16; ++j) { const unsigned c = xb_ld(&bar[XB_XCNT(j)]); sum += c; cnt += (c > 0u) ? 1u : 0u; mine = (j == x) ? c : mine; }
        if (sum == G) break;
        __builtin_amdgcn_s_sleep(1);
        if ((++sp & 255u) == 0u) { if (xb_ld(&bar[XB_TMO])) break; if (sp > XB_SPIN_CAP) { atomicAdd(&bar[XB_TMO], 1u); break; } }
    }
    nloc = mine > 0u ? mine : 1u; nx = cnt > 0u ? cnt : 1u;
}

__device__ __forceinline__ void xcd_barrier(const XcdBarrier& b) {
    asm volatile("s_waitcnt vmcnt(0)" ::: "memory");
    __syncthreads();
    if (threadIdx.x == 0) {
        unsigned* bar = b.bar;
        __builtin_amdgcn_s_waitcnt(0);
        unsigned nloc = b.st[0], nx = b.st[1];
        if (nloc == 0u) { xcd_barrier_complete(bar, b.x, nloc, nx); b.st[0] = nloc; b.st[1] = nx; }
        const unsigned old = xb_add(&bar[XB_XSUB(b.x)], 1u);
        const unsigned gen = old / nloc;
        if (old + 1u == (gen + 1u) * nloc) {
            __builtin_amdgcn_fence(__ATOMIC_RELEASE, "agent");
            asm volatile("s_waitcnt vmcnt(0)" ::: "memory");
            const unsigned og = xb_add(&bar[XB_TOP], 1u);
            const unsigned tg = og / nx;
            if (og + 1u == (tg + 1u) * nx) xb_add(&bar[XB_TOPGEN], 1u);
            else XB_SPIN(xb_ld(&bar[XB_TOPGEN]) == tg, bar);
            __builtin_amdgcn_fence(__ATOMIC_ACQUIRE, "agent");
            xb_add(&bar[XB_XGEN(b.x)], 1u);
            asm volatile("s_waitcnt vmcnt(0)" ::: "memory");
        } else {
            XB_SPIN(xb_ld(&bar[XB_XGEN(b.x)]) == gen, bar);
            __builtin_amdgcn_fence(__ATOMIC_ACQUIRE, "agent");
            asm volatile("s_waitcnt vmcnt(0)" ::: "memory");
        }
    }
    __syncthreads();
}
typedef short bf16x4 __attribute__((ext_vector_type(4)));
typedef unsigned v2u __attribute__((ext_vector_type(2)));
struct Frame {
    LAS unsigned char* lds;
    volatile LAS unsigned* MISC;
    gu32* ctl;
    int tid, lane, wave;
    int vcu, G;
    unsigned char* ws;
    float* out;
};
__device__ __forceinline__ int lane_here() { int t = (int)threadIdx.x; asm volatile("" : "+v"(t)); return t & 63; }
__device__ __forceinline__ float bf2f(bf16 b) { return __builtin_bit_cast(float, (unsigned)b << 16); }
__device__ __forceinline__ float wave_sum(float v) {
#pragma unroll
    for (int o = 1; o < 64; o <<= 1) v += __shfl_xor(v, o);
    return v;
}
__device__ __forceinline__ float xmax16(float m) { auto rr = __builtin_amdgcn_permlane16_swap(__float_as_uint(m), __float_as_uint(m), false, false); return fmaxf(__uint_as_float(rr[0]), __uint_as_float(rr[1])); }
__device__ __forceinline__ float xmax32(float m) { auto rr = __builtin_amdgcn_permlane32_swap(__float_as_uint(m), __float_as_uint(m), false, false); return fmaxf(__uint_as_float(rr[0]), __uint_as_float(rr[1])); }
__device__ __forceinline__ f32x4 mfma16(bf16x8 a, bf16x8 b, f32x4 c) { return __builtin_amdgcn_mfma_f32_16x16x32_bf16(a, b, c, 0, 0, 0); }

__device__ __forceinline__ void p0_transpose_item(const float* W, int ldw, const float* gain, bf16* WT, int K, int k0, int n0, size_t orow0, int lane) {
    const int n4 = lane & 15, kq = lane >> 4;
    const float* src = W + (size_t)(k0 + 16 * kq) * ldw + n0 + 4 * n4;
    f32x4 v[16];
#pragma unroll
    for (int i = 0; i < 16; ++i) v[i] = __builtin_nontemporal_load((const f32x4*)(src + (size_t)i * ldw));
    if (gain) { const f32x4* gp = (const f32x4*)(gain + k0 + 16 * kq);
#pragma unroll
        for (int q = 0; q < 4; ++q) { const f32x4 gq = gp[q];
#pragma unroll
            for (int r = 0; r < 4; ++r) v[4 * q + r] = v[4 * q + r] * gq[r]; } }
    bf16* dst = WT + (orow0 + 4 * n4) * (size_t)K + k0 + 16 * kq;
#pragma unroll
    for (int j = 0; j < 4; ++j) { v4u o0, o1;
        o0.x = pg8::cvtpk(v[0][j], v[1][j]); o0.y = pg8::cvtpk(v[2][j], v[3][j]); o0.z = pg8::cvtpk(v[4][j], v[5][j]); o0.w = pg8::cvtpk(v[6][j], v[7][j]);
        o1.x = pg8::cvtpk(v[8][j], v[9][j]); o1.y = pg8::cvtpk(v[10][j], v[11][j]); o1.z = pg8::cvtpk(v[12][j], v[13][j]); o1.w = pg8::cvtpk(v[14][j], v[15][j]);
        *(v4u*)(dst + (size_t)j * K) = o0; *(v4u*)(dst + (size_t)j * K + 8) = o1; }
}
__device__ __forceinline__ void p0_transpose_item8(const float* W, int ldw, const float* gain, unsigned char* WT, int K, int k0, int n0, size_t orow0, int lane) {
    const int n4 = lane & 15, kq = lane >> 4;
    const float* src = W + (size_t)(k0 + 16 * kq) * ldw + n0 + 4 * n4;
    f32x4 v[16];
#pragma unroll
    for (int i = 0; i < 16; ++i) v[i] = __builtin_nontemporal_load((const f32x4*)(src + (size_t)i * ldw));
    { const f32x4* gp = (const f32x4*)(gain + k0 + 16 * kq);
#pragma unroll
        for (int q = 0; q < 4; ++q) { f32x4 gq = {32.f, 32.f, 32.f, 32.f}; if (gain) gq = gp[q] * 32.0f;
#pragma unroll
            for (int r = 0; r < 4; ++r) v[4 * q + r] = v[4 * q + r] * gq[r]; } }
    unsigned char* dst = WT + (orow0 + 4 * n4) * (size_t)K + k0 + 16 * kq;
#pragma unroll
    for (int j = 0; j < 4; ++j) { v4u o;
        o.x = pg8::cvt4_fp8((f32x4){v[0][j], v[1][j], v[2][j], v[3][j]}); o.y = pg8::cvt4_fp8((f32x4){v[4][j], v[5][j], v[6][j], v[7][j]});
        o.z = pg8::cvt4_fp8((f32x4){v[8][j], v[9][j], v[10][j], v[11][j]}); o.w = pg8::cvt4_fp8((f32x4){v[12][j], v[13][j], v[14][j], v[15][j]});
        *(v4u*)(dst + (size_t)j * K) = o; }
}
template <int NR> __device__ __forceinline__ void rms_rows_to_bf16(const float* const (&xrow)[NR], const float* g, bf16* const (&orow)[NR], int lane) {
    f32x4 v[NR][4]; float s[NR];
#pragma unroll
    for (int r = 0; r < NR; ++r) { const f32x4* xr = (const f32x4*)xrow[r] + lane;
#pragma unroll
        for (int j = 0; j < 4; ++j) v[r][j] = __builtin_nontemporal_load(xr + 64 * j); }
    const f32x4* gr = (const f32x4*)g + lane; f32x4 gg[4];
#pragma unroll
    for (int j = 0; j < 4; ++j) gg[j] = gr[64 * j];
#pragma unroll
    for (int r = 0; r < NR; ++r) { s[r] = 0.f;
#pragma unroll
        for (int j = 0; j < 4; ++j) s[r] += (v[r][j].x * v[r][j].x + v[r][j].y * v[r][j].y) + (v[r][j].z * v[r][j].z + v[r][j].w * v[r][j].w); }
#pragma unroll
    for (int r = 0; r < NR; ++r) { const float rs = rsqrtf(wave_sum(s[r]) * (1.0f / DM) + EPS); unsigned long long* o8 = (unsigned long long*)orow[r] + lane;
#pragma unroll
        for (int j = 0; j < 4; ++j) o8[64 * j] = (unsigned long long)pk2(v[r][j].x * rs * gg[j].x, v[r][j].y * rs * gg[j].y) | ((unsigned long long)pk2(v[r][j].z * rs * gg[j].z, v[r][j].w * rs * gg[j].w) << 32); }
}
constexpr int MOE_I_UP = 32 * 16 * 32, MOE_I_DN = 32 * 16 * 16, MOE_UNITS = (MOE_I_UP + MOE_I_DN) / 64;
__device__ __forceinline__ void moe_convert_unit(int unit, const float* w_up, const float* w_down, const float* g_ffn, unsigned char* ws, int wave, int lane) {
#pragma unroll 1
    for (int j = 0; j < 8; ++j) { int r = unit * 64 + j * 8 + wave;
        if (r < MOE_I_UP) { const int e = r / (16 * 32); r -= e * (16 * 32); const int n0 = 64 * (r % 32);
            const size_t orow = (size_t)e * 2048 + ((n0 & 1023) >> 7) * 256 + (n0 >> 10) * 128 + (n0 & 127);
            p0_transpose_item8(w_up + (size_t)e * DM * 2048, 2048, g_ffn, ws + WS_WUP, DM, 64 * (r / 32), n0, orow, lane); }
        else { r -= MOE_I_UP; const int e = r / (16 * 16); r -= e * (16 * 16);
            p0_transpose_item8(w_down + (size_t)e * DM * DM, DM, nullptr, ws + WS_WDN, DM, 64 * (r / 16), 64 * (r % 16), (size_t)e * 1024 + 64 * (r % 16), lane); } }
}
struct In {
    const float *x, *mem; const int* positions; const float *norm_mix_g, *w_in, *lq1, *lk1, *lq2, *lk2, *diff_norm_g, *w_alpha2, *b_alpha, *gla_norm_g, *w_out, *norm_cross_g, *norm_mem_g,
        *w_cq, *w_ck, *w_cv, *w_co, *norm_ffn_g, *w_router, *b_router, *w_up, *b_up, *w_down, *b_down, *norm_final_g;
};
__device__ __forceinline__ void p0_prologue(Frame& F, const In& I) {
    const int gw = F.vcu * NWAVES + F.wave, NGW = F.G * NWAVES, lane = lane_here();
    unsigned char* ws = F.ws;
    constexpr int I_IN = 16 * 48, I_SQ = 16 * 16;
    constexpr int NITEMS = I_IN + 4 * I_SQ;
    for (int it = gw; it < NITEMS; it += NGW) {
        int r = it;
        if (r < I_IN) { p0_transpose_item(I.w_in, INW, nullptr, (bf16*)(ws + WS_WINT), DM, 64 * (r / 48), 64 * (r % 48), (size_t)64 * (r % 48), lane); continue; } r -= I_IN;
        { const int w = r / I_SQ; r -= w * I_SQ;
            const float* W = w == 0 ? I.w_out : w == 1 ? I.w_ck : w == 2 ? I.w_cv : I.w_co;
            bf16* WT = (bf16*)(ws + (w == 0 ? WS_WOUT : w == 1 ? WS_WCK : w == 2 ? WS_WCV : WS_WCO));
            p0_transpose_item(W, DM, nullptr, WT, DM, 64 * (r / 16), 64 * (r % 16), (size_t)64 * (r % 16), lane); }
    }
    for (int idx = F.vcu * (NWAVES * 64) + F.tid; idx < DM * DM / 4; idx += F.G * NWAVES * 64) { const f32x4 v = ((const f32x4*)I.w_cq)[idx] * I.norm_cross_g[idx >> 8];
        v2u o; o.x = pk2(v.x, v.y); o.y = pk2(v.z, v.w); ((v2u*)(ws + WS_WCQ))[idx] = o; }
#if defined(PROBE_P0)
    if (F.tid == 0) ((LAS unsigned long long*)(F.lds + TS_OFF))[13] = rt();
#endif
    const int gt = F.vcu * (NWAVES * 64) + F.tid, NGT = F.G * NWAVES * 64;
    for (int idx = gt; idx < 256 * DM; idx += NGT) { const int j = idx >> 10, k = idx & 1023; const float* wr = I.w_in + (size_t)k * INW + 3072; float s = 0.f;
#pragma unroll
        for (int r = 0; r < 16; ++r) s += wr[r] * I.w_alpha2[r * 256 + j];
        ((bf16*)(ws + WS_WINT))[(size_t)(3072 + j) * DM + k] = (bf16)f2bf(s); }
    for (int idx = gt; idx < DM * NEXP; idx += NGT) { const int e = idx >> 10, k = idx & 1023; ((float*)(ws + WS_WR))[idx] = I.w_router[k * NEXP + e] * I.norm_ffn_g[k]; }
    for (int idx = gt; idx < NTOK * 8; idx += NGT) { const int tok = idx >> 3, i = idx & 7;
        const double inv = exp(-(double)i * 0.125 * 13.122363377404328); const double ang = (double)I.positions[tok] * inv;
        const double red = ang - rint(ang * 0.15915494309189535) * 6.283185307179586; const float rf = (float)red;
        float* cs = (float*)(ws + WS_CS) + (size_t)tok * 16; cs[i] = cosf(rf); cs[8 + i] = sinf(rf); }
#if defined(PROBE_P0)
    if (F.tid == 0) ((LAS unsigned long long*)(F.lds + TS_OFF))[14] = rt();
#endif
    for (int m = gw * 4; m < NTOK; m += NGW * 4) { const float* xr[4]; bf16* orw[4];
#pragma unroll
        for (int r = 0; r < 4; ++r) { xr[r] = I.x + (size_t)(m + r) * DM; orw[r] = (bf16*)(ws + WS_HN) + (size_t)(m + r) * DM; }
        rms_rows_to_bf16<4>(xr, I.norm_mix_g, orw, lane); }
    for (int m = gw * 4; m < NMEM; m += NGW * 4) { const float* xr[4]; bf16* orw[4];
#pragma unroll
        for (int r = 0; r < 4; ++r) { xr[r] = I.mem + (size_t)(m + r) * DM; orw[r] = (bf16*)(ws + WS_MN) + (size_t)(m + r) * DM; }
        rms_rows_to_bf16<4>(xr, I.norm_mem_g, orw, lane); }
}

constexpr int DA_KBUF = 16384, DA_VBUF = 16384, DA_VOFF = 2 * DA_KBUF;
template <int DBG = 0> __device__ __forceinline__ void diffattn_unit(Frame& F, const bf16* P, const bf16* VT, bf16* CAT, const float* gdiff, float lam, int b, int h, int qblk) {
    const int lane = lane_here(), wave = F.wave, tid = F.tid, l15 = lane & 15, g = lane >> 4;
    LAS unsigned char* lds = F.lds + RING_OFF;
    const int q0 = qblk * 128 + wave * 16;
    const size_t tokq = (size_t)b * SEQ + q0 + l15;
    bf16x8 qf[2][2];
#pragma unroll
    for (int c = 0; c < 2; ++c)
#pragma unroll
        for (int ks = 0; ks < 2; ++ks) qf[c][ks] = *(const bf16x8*)(P + tokq * PW + h * 128 + c * 64 + ks * 32 + g * 8);
    f32x4 o[2][8];
#pragma unroll
    for (int c = 0; c < 2; ++c)
#pragma unroll
        for (int k = 0; k < 8; ++k) o[c][k] = (f32x4){0.f, 0.f, 0.f, 0.f};
    float mrun[2] = {0.f, 0.f}, lsum[2] = {0.f, 0.f};
    const int nk = q0 + 16;
    const int nt = 2 * qblk + 2;
    const int skey = tid >> 4, sch = tid & 15, vrow = tid >> 3, vpc = tid & 7;
    const bf16* ksrc = P + ((size_t)b * SEQ + skey) * PW + 512 + h * 128 + sch * 8;
    const bf16* vsrc = VT + (size_t)(h * 128 + vrow) * NTOK + (size_t)b * SEQ + vpc * 8;
    const int kdst = skey * 256 + ((sch ^ (skey & 15)) * 16);
    const int vfr = (vrow >> 1) & 7, vch = (vpc >> 2) * 4 + 2 * (vpc & 1), vhi = ((vpc & 3) >> 1) * 8;
    const int vdst0 = DA_VOFF + vrow * 128 + ((vch ^ vfr) * 16) + vhi, vdst1 = DA_VOFF + vrow * 128 + (((vch + 1) ^ vfr) * 16) + vhi;
    int koff[2][2];
#pragma unroll
    for (int c = 0; c < 2; ++c)
#pragma unroll
        for (int ks = 0; ks < 2; ++ks) koff[c][ks] = l15 * 256 + (((c * 8 + ks * 4 + g) ^ l15) * 16);
    const int voffs[2] = {DA_VOFF + l15 * 128 + ((g ^ (l15 >> 1)) * 16), DA_VOFF + l15 * 128 + (((4 + g) ^ (l15 >> 1)) * 16)};
    v4u sk0, sk1, sv0, sv1;
#define DA_LOAD(tt) do { const bf16* kp_ = ksrc + (size_t)(tt) * 64 * PW; const bf16* vp_ = vsrc + (tt) * 64; \
        sk0 = *(const v4u*)kp_; sk1 = *(const v4u*)(kp_ + (size_t)32 * PW); sv0 = *(const v4u*)vp_; sv1 = *(const v4u*)(vp_ + (size_t)64 * NTOK); } while (0)
#define DA_STORE(bb) do { LAS unsigned char* kd_ = lds + (bb) * DA_KBUF + kdst; LAS unsigned char* vd_ = lds + (bb) * DA_VBUF; \
        *(LAS v4u*)kd_ = sk0; *(LAS v4u*)(kd_ + 8192) = sk1; \
        *(LAS v2u*)(vd_ + vdst0) = (v2u){sv0.x, sv0.y}; *(LAS v2u*)(vd_ + vdst1) = (v2u){sv0.z, sv0.w}; *(LAS v2u*)(vd_ + vdst0 + 8192) = (v2u){sv1.x, sv1.y}; *(LAS v2u*)(vd_ + vdst1 + 8192) = (v2u){sv1.z, sv1.w}; } while (0)
    DA_LOAD(0); DA_STORE(0);
    __syncthreads();
    auto step = [&](const int t, const int buf) __attribute__((always_inline)) {
        if (t * 64 < nk) {
            const LAS unsigned char* kb = lds + buf * DA_KBUF; const LAS unsigned char* vb = lds + buf * DA_VBUF;
            f32x4 s[2][2][2];
#pragma unroll
            for (int sub = 0; sub < 2; ++sub)
#pragma unroll
                for (int c = 0; c < 2; ++c)
#pragma unroll
                    for (int s2 = 0; s2 < 2; ++s2) { f32x4 a = (f32x4){-mrun[c], -mrun[c], -mrun[c], -mrun[c]};
#pragma unroll
                        for (int ks = 0; ks < 2; ++ks) { const bf16x8 kf = (DBG & 2) ? qf[c][ks ^ 1] : *(const LAS bf16x8*)(kb + sub * 8192 + s2 * 4096 + koff[c][ks]); if constexpr ((DBG & 1) == 0) a = mfma16(kf, qf[c][ks], a); else a[ks] += __builtin_bit_cast(float, (int)kf[0] << 16); }
                        s[sub][c][s2] = a; }
            if (t * 64 + 63 > q0) {
                const int qrow = q0 + l15;
#pragma unroll
                for (int sub = 0; sub < 2; ++sub)
#pragma unroll
                    for (int c = 0; c < 2; ++c)
#pragma unroll
                        for (int s2 = 0; s2 < 2; ++s2)
#pragma unroll
                            for (int r = 0; r < 4; ++r) if (t * 64 + sub * 32 + s2 * 16 + 4 * g + r > qrow) s[sub][c][s2][r] = -INFINITY;
            }
            float dl[2]; bool grow = false;
#pragma unroll
            for (int c = 0; c < 2; ++c) { float mx = -INFINITY;
#pragma unroll
                for (int sub = 0; sub < 2; ++sub)
#pragma unroll
                    for (int s2 = 0; s2 < 2; ++s2) mx = fmaxf(mx, fmaxf(fmaxf(s[sub][c][s2][0], s[sub][c][s2][1]), fmaxf(s[sub][c][s2][2], s[sub][c][s2][3])));
                mx = xmax16(mx); mx = xmax32(mx);
                dl[c] = (t == 0 || mx > 8.0f) ? mx : 0.f; grow = grow || (dl[c] != 0.f); }
            if (__any(grow)) {
#pragma unroll
                for (int c = 0; c < 2; ++c) { const float alpha = __builtin_amdgcn_exp2f(-dl[c]); mrun[c] += dl[c]; lsum[c] *= alpha;
#pragma unroll
                    for (int k = 0; k < 8; ++k) o[c][k] = o[c][k] * alpha;
#pragma unroll
                    for (int sub = 0; sub < 2; ++sub)
#pragma unroll
                        for (int s2 = 0; s2 < 2; ++s2)
#pragma unroll
                            for (int r = 0; r < 4; ++r) s[sub][c][s2][r] -= dl[c]; }
            }
#pragma unroll
            for (int sub = 0; sub < 2; ++sub) {
                bf16x8 pb[2];
#pragma unroll
                for (int c = 0; c < 2; ++c) { float ps = 0.f;
#pragma unroll
                    for (int s2 = 0; s2 < 2; ++s2)
#pragma unroll
                        for (int r = 0; r < 4; ++r) { const float p = (DBG & 4) ? s[sub][c][s2][r] * 0.001f : __builtin_amdgcn_exp2f(s[sub][c][s2][r]); s[sub][c][s2][r] = p; ps += p; }
                    lsum[c] += ps;
                    v4u w; w.x = pg8::cvtpk(s[sub][c][0][0], s[sub][c][0][1]); w.y = pg8::cvtpk(s[sub][c][0][2], s[sub][c][0][3]); w.z = pg8::cvtpk(s[sub][c][1][0], s[sub][c][1][1]); w.w = pg8::cvtpk(s[sub][c][1][2], s[sub][c][1][3]);
                    pb[c] = __builtin_bit_cast(bf16x8, w); }
#pragma unroll
                for (int k = 0; k < 8; ++k) { const bf16x8 vf = (DBG & 2) ? qf[k & 1][(k >> 1) & 1] : *(const LAS bf16x8*)(vb + voffs[sub] + k * 2048);
                    if constexpr ((DBG & 1) == 0) { o[0][k] = mfma16(vf, pb[0], o[0][k]); o[1][k] = mfma16(vf, pb[1], o[1][k]); }
                    else { o[0][k][0] += __builtin_bit_cast(float, (int)vf[0] << 16) + __builtin_bit_cast(float, (int)pb[0][k] << 16); o[1][k][0] += __builtin_bit_cast(float, (int)pb[1][k] << 16); } }
            }
        }
    };
    for (int t = 0; t < nt; ++t) {
        if ((DBG & 8) == 0 && t + 1 < nt) DA_LOAD(t + 1);
        step(t, t & 1);
        if ((DBG & 8) == 0 && t + 1 < nt) DA_STORE((t & 1) ^ 1);
        __syncthreads();
    }
#undef DA_LOAD
#undef DA_STORE
    float l0 = lsum[0], l1 = lsum[1];
    l0 += __shfl_xor(l0, 16); l0 += __shfl_xor(l0, 32); l1 += __shfl_xor(l1, 16); l1 += __shfl_xor(l1, 32);
    const float i0 = 1.0f / l0, i1 = lam / l1; float ss = 0.f;
#pragma unroll
    for (int k = 0; k < 8; ++k)
#pragma unroll
        for (int r = 0; r < 4; ++r) { const float v = o[0][k][r] * i0 - o[1][k][r] * i1; o[0][k][r] = v; ss += v * v; }
    ss += __shfl_xor(ss, 16); ss += __shfl_xor(ss, 32);
    const float rs = rsqrtf(ss * (1.0f / 128.0f) + EPS) * 0.8f;
    bf16* op = CAT + tokq * DM + h * 128 + 4 * g;
#pragma unroll
    for (int k = 0; k < 8; ++k) { const f32x4 gg = *(const f32x4*)(gdiff + k * 16 + 4 * g); f32x4 v = o[0][k] * rs; v = v * gg; pg8::st_bf4(op + k * 16, v); }
}

__device__ __forceinline__ bf16x8 pack8(const f32x4& a, const f32x4& b) { v4u w; w.x = pg8::cvtpk(a[0], a[1]); w.y = pg8::cvtpk(a[2], a[3]); w.z = pg8::cvtpk(b[0], b[1]); w.w = pg8::cvtpk(b[2], b[3]); return __builtin_bit_cast(bf16x8, w); }
constexpr int GL_QI = 0, GL_KI = 8192, GL_IMG = 16384, GL_EL = 2 * GL_IMG, GL_OB = GL_EL + 512, GL_OBS = 17408, GL_PS = GL_OB + 2 * GL_OBS, GL_END = GL_PS + 4096;

__device__ __forceinline__ void gla_unit(Frame& F, const bf16* P, const float* Bc, const bf16* GVT, bf16* CAT, const float* ggla, int b, int h) {
    const int lane = lane_here(), l15 = lane & 15, g = lane >> 4, eb = F.wave, tid = F.tid;
    LAS unsigned char* lds = F.lds + RING_OFF;
    const f32x4 zero4 = {0.f, 0.f, 0.f, 0.f};
    f32x4 S[4] = {zero4, zero4, zero4, zero4};
    bf16x8 If[4];
#pragma unroll
    for (int db = 0; db < 4; ++db) { const int ks = db >> 1;
#pragma unroll
        for (int j = 0; j < 8; ++j) { const int dp = 32 * ks + (j < 4 ? 4 * g + j : 16 + 4 * g + j - 4); If[db][j] = (dp == 16 * db + l15) ? (short)0x3F80 : (short)0; } }
    const int st = tid >> 3, sp = tid & 7, opc = tid & 15;
    const size_t tokb = (size_t)b * SEQ;
    const bf16* qsrc = P + (tokb + st) * PW + 1536 + h * 64 + sp * 8;
    const float* bsrc = Bc + (tokb + st) * 256 + h * 64 + sp * 8;
    const bf16* Vrow = GVT + (size_t)(h * 128 + 16 * eb + l15) * NTOK + tokb + 4 * g;
    const f32x4 gg0 = *(const f32x4*)(ggla + opc * 8), gg1 = *(const f32x4*)(ggla + opc * 8 + 4);
    const int foffs[2] = {l15 * 128 + ((g ^ (l15 >> 1)) * 16), l15 * 128 + (((4 + g) ^ (l15 >> 1)) * 16)};
    const int sfr = (st >> 1) & 7, sch0 = (sp >> 2) * 4 + 2 * (sp & 1), shi = ((sp & 3) >> 1) * 8, sd0 = st * 128 + ((sch0 ^ sfr) * 16) + shi, sd1 = st * 128 + (((sch0 + 1) ^ sfr) * 16) + shi;
    v4u rq = *(const v4u*)qsrc, rk = *(const v4u*)(qsrc + 256); f32x4 rb0 = *(const f32x4*)bsrc, rb1 = *(const f32x4*)(bsrc + 4);
#define GLA_STAGE(par) do { \
        float ee[8]; _Pragma("unroll") for (int i = 0; i < 4; ++i) { ee[i] = __expf(rb0[i]); ee[4 + i] = __expf(rb1[i]); } \
        const unsigned qa[4] = {rq.x, rq.y, rq.z, rq.w}, ka[4] = {rk.x, rk.y, rk.z, rk.w}; v4u wq, wk; unsigned* wqp = (unsigned*)&wq; unsigned* wkp = (unsigned*)&wk; \
        _Pragma("unroll") for (int i = 0; i < 4; ++i) { const float q0 = __builtin_bit_cast(float, qa[i] << 16), q1 = __builtin_bit_cast(float, qa[i] & 0xffff0000u), k0 = __builtin_bit_cast(float, ka[i] << 16), k1 = __builtin_bit_cast(float, ka[i] & 0xffff0000u); \
            wqp[i] = pg8::cvtpk(q0 * ee[2 * i], q1 * ee[2 * i + 1]); wkp[i] = pg8::cvtpk(k0 * __builtin_amdgcn_rcpf(ee[2 * i]), k1 * __builtin_amdgcn_rcpf(ee[2 * i + 1])); } \
        { LAS unsigned char* ib_ = lds + (par) * GL_IMG; *(LAS v2u*)(ib_ + GL_QI + sd0) = (v2u){wq.x, wq.y}; *(LAS v2u*)(ib_ + GL_QI + sd1) = (v2u){wq.z, wq.w}; *(LAS v2u*)(ib_ + GL_KI + sd0) = (v2u){wk.x, wk.y}; *(LAS v2u*)(ib_ + GL_KI + sd1) = (v2u){wk.z, wk.w}; } \
        if (st == 63) { *(LAS f32x4*)(lds + GL_EL + (par) * 256 + sp * 32) = (f32x4){ee[0], ee[1], ee[2], ee[3]}; *(LAS f32x4*)(lds + GL_EL + (par) * 256 + sp * 32 + 16) = (f32x4){ee[4], ee[5], ee[6], ee[7]}; } } while (0)
    bf16x8 VFn[2];
#pragma unroll
    for (int ss = 0; ss < 2; ++ss) { const bf16* vp = Vrow + 32 * ss; const v2u v0 = *(const v2u*)vp, v1 = *(const v2u*)(vp + 16); v4u vv; vv.x = v0.x; vv.y = v0.y; vv.z = v1.x; vv.w = v1.y; VFn[ss] = __builtin_bit_cast(bf16x8, vv); }
    GLA_STAGE(0);
    __syncthreads();
    for (int c = 0; c < SEQ / 64; ++c) {
        const int par = c & 1; const size_t tok0 = tokb + c * 64;
        if (c + 1 < SEQ / 64) { rq = *(const v4u*)(qsrc + (size_t)(c + 1) * 64 * PW); rk = *(const v4u*)(qsrc + (size_t)(c + 1) * 64 * PW + 256);
            rb0 = *(const f32x4*)(bsrc + (size_t)(c + 1) * 64 * 256); rb1 = *(const f32x4*)(bsrc + (size_t)(c + 1) * 64 * 256 + 4); }
        bf16x8 VF[2] = {VFn[0], VFn[1]};
        if (c + 1 < SEQ / 64) {
#pragma unroll
            for (int ss = 0; ss < 2; ++ss) { const bf16* vp = Vrow + (c + 1) * 64 + 32 * ss; const v2u v0 = *(const v2u*)vp, v1 = *(const v2u*)(vp + 16); v4u vv; vv.x = v0.x; vv.y = v0.y; vv.z = v1.x; vv.w = v1.y; VFn[ss] = __builtin_bit_cast(bf16x8, vv); } }
        v4u rg[2];
#pragma unroll
        for (int i = 0; i < 2; ++i) rg[i] = *(const v4u*)(P + (tok0 + ((tid + 512 * i) >> 4)) * PW + 2560 + h * 128 + opc * 8);
        const LAS unsigned char* qi = lds + par * GL_IMG + GL_QI; const LAS unsigned char* ki = lds + par * GL_IMG + GL_KI;
        bf16x8 qf[4][2], kf[4][2];
#pragma unroll
        for (int blk = 0; blk < 4; ++blk)
#pragma unroll
            for (int ks = 0; ks < 2; ++ks) { qf[blk][ks] = *(const LAS bf16x8*)(qi + foffs[ks] + blk * 2048); kf[blk][ks] = *(const LAS bf16x8*)(ki + foffs[ks] + blk * 2048); }
        const bf16x8 SF0 = pack8(S[0], S[1]), SF1 = pack8(S[2], S[3]);
        f32x4 O[4];
#pragma unroll
        for (int tb = 0; tb < 4; ++tb) { f32x4 o = mfma16(qf[tb][0], SF0, zero4); o = mfma16(qf[tb][1], SF1, o);
#pragma unroll
            for (int ss = 0; ss < 2; ++ss) if (2 * ss <= tb) { f32x4 a2[2];
#pragma unroll
                for (int hh = 0; hh < 2; ++hh) { const int sb = 2 * ss + hh; f32x4 a = zero4;
                    if (sb <= tb) { a = mfma16(kf[sb][0], qf[tb][0], zero4); a = mfma16(kf[sb][1], qf[tb][1], a);
                        if (sb == tb) {
#pragma unroll
                            for (int r = 0; r < 4; ++r) if (4 * g + r > l15) a[r] = 0.f; } }
                    a2[hh] = a; }
                o = mfma16(pack8(a2[0], a2[1]), VF[ss], o); }
            O[tb] = o; }
#pragma unroll
        for (int db = 0; db < 4; ++db) { f32x4 u = S[db];
#pragma unroll
            for (int ss = 0; ss < 2; ++ss) { const f32x4 t0 = mfma16(kf[2 * ss][db >> 1], If[db], zero4), t1 = mfma16(kf[2 * ss + 1][db >> 1], If[db], zero4); u = mfma16(pack8(t0, t1), VF[ss], u); }
            const f32x4 el = *(const LAS f32x4*)(lds + GL_EL + par * 256 + (16 * db + 4 * g) * 4);
            S[db] = u * el; }
        LAS unsigned char* ob = lds + GL_OB + par * GL_OBS; LAS float* ps = (LAS float*)(lds + GL_PS + par * 2048);
#pragma unroll
        for (int tb = 0; tb < 4; ++tb)
#pragma unroll
            for (int r = 0; r < 4; ++r) { const int t = 16 * tb + 4 * g + r; const float ov = O[tb][r]; float q = ov * ov; q += __shfl_xor(q, 1); q += __shfl_xor(q, 2); q += __shfl_xor(q, 4); q += __shfl_xor(q, 8);
                if (l15 == 0) ps[t * 8 + eb] = q;
                *(LAS bf16*)(ob + t * 272 + (16 * eb + l15) * 2) = (bf16)f2bf(ov); }
        if (c + 1 < SEQ / 64) GLA_STAGE(par ^ 1);
        __syncthreads();
#pragma unroll
        for (int i = 0; i < 2; ++i) { const int ot = (tid + 512 * i) >> 4; const f32x4 p0 = *(const LAS f32x4*)(ps + ot * 8), p1 = *(const LAS f32x4*)(ps + ot * 8 + 4);
            const float ss = ((p0[0] + p0[1]) + (p0[2] + p0[3])) + ((p1[0] + p1[1]) + (p1[2] + p1[3])); const float rs = rsqrtf(ss * (1.0f / 128.0f) + EPS);
            const v4u ov = *(const LAS v4u*)(ob + ot * 272 + opc * 16); const unsigned oa[4] = {ov.x, ov.y, ov.z, ov.w}, ga[4] = {rg[i].x, rg[i].y, rg[i].z, rg[i].w};
            const float gn[8] = {gg0[0], gg0[1], gg0[2], gg0[3], gg1[0], gg1[1], gg1[2], gg1[3]}; v4u w; unsigned* wp = (unsigned*)&w;
#pragma unroll
            for (int j = 0; j < 4; ++j) { const float o0 = __builtin_bit_cast(float, oa[j] << 16), o1 = __builtin_bit_cast(float, oa[j] & 0xffff0000u), g0 = __builtin_bit_cast(float, ga[j] << 16), g1 = __builtin_bit_cast(float, ga[j] & 0xffff0000u);
                wp[j] = pg8::cvtpk(o0 * rs * gn[2 * j] * g0 * __builtin_amdgcn_rcpf(1.0f + __builtin_amdgcn_exp2f(-1.4426950408889634f * g0)), o1 * rs * gn[2 * j + 1] * g1 * __builtin_amdgcn_rcpf(1.0f + __builtin_amdgcn_exp2f(-1.4426950408889634f * g1))); }
            *(v4u*)(CAT + (tok0 + ot) * DM + 512 + h * 128 + opc * 8) = w; }
    }
#undef GLA_STAGE
    __syncthreads();
}

__device__ __forceinline__ void router_phase(Frame& F, const bf16* X2, const float* WRt, const float* b_router, float* rsl, float* gate, unsigned* assign, unsigned* list, gu32* cnt) {
    typedef float f32x4v __attribute__((ext_vector_type(4)));
    LAS float* lg = (LAS float*)(F.lds + RING_OFF);
    LAS unsigned* hist = (LAS unsigned*)(lg + 128 * 33);
    const int tid = F.tid, lane = lane_here(), r16 = lane & 15, kq = lane >> 4, wv = F.wave, t = tid & 63;
    for (int blk = F.vcu; blk < NTOK / 128; blk += F.G) {
        const size_t tok0 = (size_t)blk * 128;
        const bf16* xp = X2 + (tok0 + wv * 16 + r16) * DM + 8 * kq; const float* w0 = WRt + (size_t)r16 * DM + 8 * kq; const float* w1 = w0 + (size_t)16 * DM;
        f32x4v acc0 = {0.f, 0.f, 0.f, 0.f}, acc1 = acc0; float ssq = 0.f;
#pragma unroll 4
        for (int m = 0; m < 32; ++m) { const v4u xw = *(const v4u*)(xp + 32 * m); const f32x4 a0 = *(const f32x4*)(w0 + 32 * m), a1 = *(const f32x4*)(w0 + 32 * m + 4), b0 = *(const f32x4*)(w1 + 32 * m), b1 = *(const f32x4*)(w1 + 32 * m + 4);
            const unsigned xa[4] = {xw.x, xw.y, xw.z, xw.w}; float xv[8];
#pragma unroll
            for (int j = 0; j < 4; ++j) { xv[2 * j] = __builtin_bit_cast(float, xa[j] << 16); xv[2 * j + 1] = __builtin_bit_cast(float, xa[j] & 0xffff0000u); }
            const float wa[8] = {a0[0], a0[1], a0[2], a0[3], a1[0], a1[1], a1[2], a1[3]}, wb[8] = {b0[0], b0[1], b0[2], b0[3], b1[0], b1[1], b1[2], b1[3]};
#pragma unroll
            for (int i = 0; i < 8; ++i) { acc0 = __builtin_amdgcn_mfma_f32_16x16x4f32(xv[i], wa[i], acc0, 0, 0, 0); acc1 = __builtin_amdgcn_mfma_f32_16x16x4f32(xv[i], wb[i], acc1, 0, 0, 0); ssq += xv[i] * xv[i]; } }
        ssq += __shfl_xor(ssq, 16); ssq += __shfl_xor(ssq, 32);
        float rsv[4];
#pragma unroll
        for (int j = 0; j < 4; ++j) { const float sq = __shfl(ssq, 4 * kq + j); rsv[j] = rsqrtf(sq * (1.0f / DM) + EPS); }
        const float br0 = b_router[r16], br1 = b_router[16 + r16];
#pragma unroll
        for (int j = 0; j < 4; ++j) { const int tl = wv * 16 + 4 * kq + j; lg[tl * 33 + r16] = acc0[j] * rsv[j] + br0; lg[tl * 33 + 16 + r16] = acc1[j] * rsv[j] + br1; if (r16 == 0) lg[tl * 33 + 32] = rsv[j]; }
        __syncthreads();
        if (tid < 128) {
            const int w2 = tid >> 6;
            float lv[32];
#pragma unroll
            for (int e = 0; e < 32; ++e) lv[e] = lg[tid * 33 + e];
            const float rs = lg[tid * 33 + 32];
            float tv[4]; int te[4];
#pragma unroll
            for (int k = 0; k < 4; ++k) { float best = -INFINITY; int bi = 0;
#pragma unroll
                for (int e = 0; e < 32; ++e) if (lv[e] > best) { best = lv[e]; bi = e; }
                tv[k] = best; te[k] = bi;
#pragma unroll
                for (int e = 0; e < 32; ++e) if (e == bi) lv[e] = -INFINITY; }
            const float e1 = __expf(tv[1] - tv[0]), e2 = __expf(tv[2] - tv[0]), e3 = __expf(tv[3] - tv[0]); const float inv = 1.0f / (1.0f + e1 + e2 + e3);
            const float gv[4] = {inv, e1 * inv, e2 * inv, e3 * inv};
            const size_t tok = tok0 + tid;
            LAS unsigned* hs = hist + w2 * 32; LAS unsigned* gbase = hist + 64 + w2 * 32;
            if (t < 32) hs[t] = 0u;
            __builtin_amdgcn_wave_barrier(); LDS_WAIT();
            unsigned lpos[4];
#pragma unroll
            for (int k = 0; k < 4; ++k) lpos[k] = __hip_atomic_fetch_add(hs + te[k], 1u, __ATOMIC_RELAXED, __HIP_MEMORY_SCOPE_WORKGROUP);
            __builtin_amdgcn_wave_barrier(); LDS_WAIT();
            if (t < 32) { const unsigned n = hs[t]; gbase[t] = n ? __hip_atomic_fetch_add(cnt + 64 * t, n, RLX_AGENT) : 0u; }
            __builtin_amdgcn_wave_barrier(); LDS_WAIT();
#pragma unroll
            for (int k = 0; k < 4; ++k) { const unsigned pos = gbase[te[k]] + lpos[k]; list[(size_t)te[k] * NTOK + pos] = (unsigned)tok; rsl[(size_t)te[k] * NTOK + pos] = rs;
                assign[tok * 4 + k] = ((unsigned)te[k] << 16) | pos; gate[tok * 4 + k] = gv[k]; }
        }
        __syncthreads();
    }
}
__device__ __forceinline__ int moe_tables(Frame& F) {
    LAS unsigned char* tile_e = F.lds + TAB_OFF; LAS int* tstart = (LAS int*)(F.lds + TAB_TSTART); LAS int* lc = (LAS int*)(F.lds + TAB_CNT);
    if (F.tid < 32) lc[F.tid] = (int)__hip_atomic_load(F.ctl + CW_CNT + 64 * F.tid, RLX_AGENT);
    __syncthreads();
    if (F.tid == 0) { int s = 0; for (int e = 0; e < 32; ++e) { tstart[e] = s; s += (lc[e] + 255) >> 8; } tstart[32] = s; }
    __syncthreads();
    const int T = tstart[32];
    for (int i = F.tid; i < T; i += 512) { int e = 0;
#pragma unroll
        for (int k = 1; k < 32; ++k) e += (tstart[k] <= i) ? 1 : 0;
        tile_e[i] = (unsigned char)e; }
    __syncthreads();
    return T;
}
__device__ __forceinline__ void final_phase(Frame& F, const bf16* X2, float* out, const unsigned char* Y, const float* gate, const unsigned* assign, const float* gfin) {
    (void)moe_tables(F);
    const LAS int* tstart = (const LAS int*)(F.lds + TAB_TSTART);
    const int gw = F.vcu * NWAVES + F.wave, NGW = F.G * NWAVES, lane = lane_here();
    unsigned an[2][4]; float gn[2][4];
#define FIN_ROUTE(t0) do { _Pragma("unroll") for (int u = 0; u < 2; ++u) { const int tok_ = ((t0) + u * NGW < NTOK) ? (t0) + u * NGW : ((t0) < NTOK ? (t0) : gw); \
        const v4u a4 = *(const v4u*)(assign + (size_t)tok_ * 4); const f32x4 g4 = *(const f32x4*)(gate + (size_t)tok_ * 4); \
        an[u][0] = a4.x; an[u][1] = a4.y; an[u][2] = a4.z; an[u][3] = a4.w; gn[u][0] = g4.x; gn[u][1] = g4.y; gn[u][2] = g4.z; gn[u][3] = g4.w; } } while (0)
    FIN_ROUTE(gw);
    for (int tok0 = gw; tok0 < NTOK; tok0 += 2 * NGW) {
        f32x4 v[2][4]; unsigned yw[2][4][4]; float gk[2][4];
#pragma unroll
        for (int u = 0; u < 2; ++u) { const int tok = (tok0 + u * NGW < NTOK) ? tok0 + u * NGW : tok0;
#pragma unroll
            for (int k = 0; k < 4; ++k) { const unsigned a = an[u][k]; gk[u][k] = gn[u][k]; const size_t row = (size_t)tstart[a >> 16] * 256 + (a & 0xffffu);
                const unsigned* yr = (const unsigned*)(Y + row * DM) + lane;
#pragma unroll
                for (int j = 0; j < 4; ++j) yw[u][k][j] = yr[64 * j]; }
            const v2u* xin = (const v2u*)(X2 + (size_t)tok * DM) + lane;
#pragma unroll
            for (int j = 0; j < 4; ++j) { const v2u w = xin[64 * j]; v[u][j] = (f32x4){__builtin_bit_cast(float, w.x << 16), __builtin_bit_cast(float, w.x & 0xffff0000u), __builtin_bit_cast(float, w.y << 16), __builtin_bit_cast(float, w.y & 0xffff0000u)}; } }
        FIN_ROUTE(tok0 + 2 * NGW);
#pragma unroll
        for (int u = 0; u < 2; ++u) { const int tok = (tok0 + u * NGW < NTOK) ? tok0 + u * NGW : tok0;
#pragma unroll
            for (int k = 0; k < 4; ++k)
#pragma unroll
                for (int j = 0; j < 4; ++j) { const unsigned w = yw[u][k][j]; const auto lo = __builtin_amdgcn_cvt_pk_f32_fp8((int)w, false), hi = __builtin_amdgcn_cvt_pk_f32_fp8((int)w, true);
                    v[u][j].x += gk[u][k] * lo[0]; v[u][j].y += gk[u][k] * lo[1]; v[u][j].z += gk[u][k] * hi[0]; v[u][j].w += gk[u][k] * hi[1]; }
            float s = 0.f;
#pragma unroll
            for (int j = 0; j < 4; ++j) s += (v[u][j].x * v[u][j].x + v[u][j].y * v[u][j].y) + (v[u][j].z * v[u][j].z + v[u][j].w * v[u][j].w);
            const float rs = rsqrtf(wave_sum(s) * (1.0f / DM) + EPS); f32x4* xr = (f32x4*)(out + (size_t)tok * DM) + lane;
#pragma unroll
            for (int j = 0; j < 4; ++j) { const f32x4 gg = ((const f32x4*)gfin)[lane + 64 * j]; xr[64 * j] = v[u][j] * rs * gg; } }
    }
#undef FIN_ROUTE
}

constexpr int NPHASE = 10;
struct Args { const void* in[28]; float* out; unsigned char* ws; int ph_lo, ph_hi; };
__global__ void __launch_bounds__(NWAVES * 64, 2) mk_fwd(Args args) {
    extern __shared__ __attribute__((aligned(16))) unsigned char lds[];
    Frame F;
    F.lds = (LAS unsigned char*)lds;
    F.MISC = (volatile LAS unsigned*)(F.lds + MISC_OFF);
    F.tid = threadIdx.x; F.lane = F.tid & 63; F.wave = __builtin_amdgcn_readfirstlane(F.tid >> 6);
    F.G = gridDim.x; { const int bx = blockIdx.x; F.vcu = (F.G % 8 == 0) ? (bx % 8) * (F.G / 8) + bx / 8 : bx; }
    F.ws = args.ws; F.out = args.out; F.ctl = (gu32*)(args.ws + WS_CTL);
    unsigned char* ws = args.ws;
    typedef const void* const volatile __attribute__((address_space(4))) kargp_t;
    kargp_t* const kargs = (kargp_t*)__builtin_amdgcn_kernarg_segment_ptr();
#define INP(k) ((const float*)kargs[k])
    for (int u = F.tid; u < (LDS_BYTES - LDSCTL_OFF) / 4; u += NWAVES * 64) ((LAS unsigned*)(F.lds + LDSCTL_OFF))[u] = 0u;
    __syncthreads();
    const int lo = args.ph_lo, hi = args.ph_hi;
    const bool single = (hi - lo) > 1;
    XcdBarrier bar; bar.bar = (unsigned*)(F.ctl + CW_BAR); bar.x = 0; bar.st = nullptr;
    if (single) bar = xcd_barrier_post((unsigned*)(F.ctl + CW_BAR), F.MISC + 8);
#define IN(k) (lo <= (k) && (k) < hi)
#if defined(PROBE_K0)
    LAS unsigned long long* tsl = (LAS unsigned long long*)(F.lds + TS_OFF);
    if (F.tid == 0) tsl[0] = rt();
#define SEAM(k) do { if (IN(k) && IN((k) + 1)) xcd_barrier(bar); if (F.tid == 0) tsl[(k) + 1] = rt(); } while (0)
#define SEAM_LOCAL(k) do { if (F.tid == 0) tsl[(k) + 1] = rt(); } while (0)
#else
#define SEAM(k) do { if (IN(k) && IN((k) + 1)) xcd_barrier(bar); } while (0)
#define SEAM_LOCAL(k) do { } while (0)
#endif
    typedef pg8::bf16_t hb;
    const int bx = (int)blockIdx.x;

    if (IN(0)) { In I;
        I.x = (const float*)INP(0);
        I.mem = (const float*)INP(1);
        I.positions = (const int*)INP(2);
        I.norm_mix_g = (const float*)INP(3);
        I.w_in = (const float*)INP(4);
        I.lq1 = (const float*)INP(5);
        I.lk1 = (const float*)INP(6);
        I.lq2 = (const float*)INP(7);
        I.lk2 = (const float*)INP(8);
        I.diff_norm_g = (const float*)INP(9);
        I.w_alpha2 = (const float*)INP(10);
        I.b_alpha = (const float*)INP(11);
        I.gla_norm_g = (const float*)INP(12);
        I.w_out = (const float*)INP(13);
        I.norm_cross_g = (const float*)INP(14);
        I.norm_mem_g = (const float*)INP(15);
        I.w_cq = (const float*)INP(16);
        I.w_ck = (const float*)INP(17);
        I.w_cv = (const float*)INP(18);
        I.w_co = (const float*)INP(19);
        I.norm_ffn_g = (const float*)INP(20);
        I.w_router = (const float*)INP(21);
        I.b_router = (const float*)INP(22);
        I.w_up = (const float*)INP(23);
        I.b_up = (const float*)INP(24);
        I.w_down = (const float*)INP(25);
        I.b_down = (const float*)INP(26);
        I.norm_final_g = (const float*)INP(27);
        p0_prologue(F, I); }
    SEAM(0);
    if (IN(1)) {
        pg8::Gemm g{(const hb*)(ws + WS_HN), (const hb*)(ws + WS_WINT), NTOK, 3328, DM, DM, DM, 127, 127};
        typedef pg8::OrderP1<(unsigned)WS_HN, (unsigned)WS_WINT, (unsigned)WS_MN, (unsigned)WS_WCK, (unsigned)WS_WCV> OrdP1; OrdP1 S; S.G = F.G; S.c = bx; S.ws = (const char*)ws;
        pg8::EpiP1 E{pg8::EpiProj{(hb*)(ws + WS_P), (float*)(ws + WS_LA), (const float*)(ws + WS_CS), INP(11)}, pg8::EpiPlain{(hb*)(ws + WS_VT) - (size_t)1024 * NTOK, NTOK, 1.0f},
                     pg8::EpiPlain{(hb*)(ws + WS_KX), DM, 1.0f}, pg8::EpiPlain{(hb*)(ws + WS_VXT), DM, 1.0f}};
        pg8::gemm_phase<pg8::EpiP1, OrdP1, true, true, false, false>(F.lds + RING_OFF, g, S, E);
    }
    SEAM(1);
    if (IN(2)) {
        float lam;
        { const int ln = lane_here(); const float a = INP(5)[ln] * INP(6)[ln], c = INP(7)[ln] * INP(8)[ln]; lam = __expf(wave_sum(a)) - __expf(wave_sum(c)) + 0.2f; }
        LAS int* qslot = (LAS int*)(F.lds + TAB_OFF);
        for (;;) {
            if (F.tid == 0) qslot[0] = (int)__hip_atomic_fetch_add(F.ctl + CW_Q2, 1u, RLX_AGENT);
            __syncthreads();
            const int u = qslot[0];
            __syncthreads();
            if (u >= 64 + 1024 + MOE_UNITS) break;
            int au = -1;
            if (u >= 64) { const int v = u - 64, gi = v / 11, r = v - gi * 11;
                if (r >= 8) { moe_convert_unit(gi * 3 + (r - 8), INP(23), INP(25), INP(20), ws, F.wave, lane_here()); continue; }
                au = gi * 8 + r; }
#if defined(PROBE_SPLIT)
            if (u < 64) continue;
#endif
            if (u < 64) { gla_unit(F, (const bf16*)(ws + WS_P), (const float*)(ws + WS_LA), (const bf16*)(ws + WS_GVT), (bf16*)(ws + WS_CAT), INP(12), u >> 2, u & 3);
            }
            else { const int v = au, bh = v & 63, qb = 15 - (v >> 6);
                diffattn_unit(F, (const bf16*)(ws + WS_P), (const bf16*)(ws + WS_VT), (bf16*)(ws + WS_CAT), INP(9), lam, bh >> 2, bh & 3, qb); }
        }
    }
#if defined(PROBE_SPLIT)
    if (IN(2)) { xcd_barrier(bar); if (F.tid == 0) tsl[13] = rt();
        for (int u = F.vcu; u < 64; u += F.G) gla_unit(F, (const bf16*)(ws + WS_P), (const float*)(ws + WS_LA), (const bf16*)(ws + WS_GVT), (bf16*)(ws + WS_CAT), INP(12), u >> 2, u & 3); }
#endif
    SEAM(2);
    if (IN(3)) {
        { pg8::Gemm g{(const hb*)(ws + WS_CAT), (const hb*)(ws + WS_WOUT), NTOK, DM, DM, DM, DM, 127, 127}; pg8::StaticOrder S; S.init(NTOK, DM, F.G, bx);
          pg8::EpiRes1 E{INP(0), (hb*)(ws + WS_X1B), (float*)(ws + WS_SSP1)};
          pg8::gemm_phase<pg8::EpiRes1, pg8::StaticOrder, true, true, false, false>(F.lds + RING_OFF, g, S, E); }
        { pg8::Gemm g{(const hb*)(ws + WS_KX), (const hb*)(ws + WS_WCQ), 64 * 256, DM, 256, DM, DM, 127, 127};
          typedef pg8::OrderGH<(unsigned)WS_KX, (unsigned)WS_WCQ, (unsigned)WS_WCO, (unsigned)WS_VXT> OrdGH; OrdGH S; S.G = F.G; S.c = bx; S.ws = (const char*)ws;
          pg8::EpiGH E{pg8::EpiPlain{(hb*)(ws + WS_GT), DM, 1.0f}, pg8::EpiPlain{(hb*)(ws + WS_HT), DM, 1.0f}};
          pg8::gemm_phase<pg8::EpiGH, OrdGH, true, true>(F.lds + RING_OFF, g, S, E); }
    }
    SEAM(3);
    if (IN(4)) {
        pg8::Gemm g{(const hb*)(ws + WS_X1B), (const hb*)(ws + WS_GT), NTOK, 256, DM, DM, DM, 127, 127}; pg8::OrderXS S; S.init(F.G, bx);
        pg8::EpiSoftmaxN E{(hb*)(ws + WS_PX), (const float*)(ws + WS_SSP1), (PG8_LAS float*)(F.lds + XCH_OFF), (PG8_LAS float*)(F.lds + XCH2_OFF)};
        pg8::gemm_phase<pg8::EpiSoftmaxN, pg8::OrderXS, true, true>(F.lds + RING_OFF, g, S, E);
    }
    SEAM(4);
    if (IN(5)) {
        pg8::Gemm g{(const hb*)(ws + WS_PX), (const hb*)(ws + WS_HT), NTOK, DM, DM, DM, DM, 127, 127}; pg8::OrderXO S; S.init(F.G, bx);
        pg8::EpiRes2 E{(hb*)(ws + WS_X1B), ws + WS_X2B};
        pg8::gemm_phase<pg8::EpiRes2, pg8::OrderXO, true, true, false, false>(F.lds + RING_OFF, g, S, E);
    }
    SEAM(5);
    if (IN(6)) router_phase(F, (const bf16*)(ws + WS_X1B), (const float*)(ws + WS_WR), INP(22), (float*)(ws + WS_RSL), (float*)(ws + WS_GATE), (unsigned*)(ws + WS_ASSIGN), (unsigned*)(ws + WS_LIST), F.ctl + CW_CNT);
    SEAM(6);
    if (IN(7)) {
        const int T = moe_tables(F);
        pg8::Gemm g{(const hb*)(ws + WS_X2B), (const hb*)(ws + WS_WUP), T * 256, NEXP * 2048, 512, 512, 512, 127, 122}; pg8::MoeOrderG S;
        S.init(T, 8, F.G, bx, (const PG8_LAS unsigned char*)(F.lds + TAB_OFF), (const PG8_LAS int*)(F.lds + TAB_TSTART), (const PG8_LAS int*)(F.lds + TAB_CNT), (const unsigned*)(ws + WS_LIST), (PG8_LAS unsigned*)(F.lds + XCH_OFF));
        pg8::EpiUp E{ws + WS_ACT, (const float*)(ws + WS_RSL), (const PG8_LAS int*)(F.lds + TAB_TSTART), (const PG8_LAS int*)(F.lds + TAB_CNT), INP(24)};
        pg8::gemm_phase<pg8::EpiUp, pg8::MoeOrderG, true, true, true, false>(F.lds + RING_OFF, g, S, E);
    }
    SEAM(7);
    if (IN(8)) {
        const int T = moe_tables(F);
        pg8::Gemm g{(const hb*)(ws + WS_ACT), (const hb*)(ws + WS_WDN), T * 256, NEXP * 1024, 512, 512, 512, 127, 122}; pg8::MoeOrder S; S.init(T, 4, F.G, bx, (const PG8_LAS unsigned char*)(F.lds + TAB_OFF));
        pg8::EpiDown E{ws + WS_Y, INP(26)};
        pg8::gemm_phase<pg8::EpiDown, pg8::MoeOrder, true, true, true, false>(F.lds + RING_OFF, g, S, E);
    }
    SEAM(8);
    if (IN(9)) final_phase(F, (const bf16*)(ws + WS_X1B), F.out, (const unsigned char*)(ws + WS_Y), (const float*)(ws + WS_GATE), (const unsigned*)(ws + WS_ASSIGN), INP(27));
#if defined(PROBE_ATT)
    { xcd_barrier(bar); if (F.tid == 0) tsl[13] = rt();
#pragma unroll 1
      for (int i2 = 2 * F.vcu; i2 < 1024; i2 += 2 * F.G)
#pragma unroll 1
          for (int rep = 0; rep < 2; ++rep) { const int i = i2 >> 1, bh = i >> 3, jj = i & 7;
              diffattn_unit<PROBE_ATT>(F, (const bf16*)(ws + WS_P), (const bf16*)(ws + WS_VT), (bf16*)(ws + WS_ACT), INP(9), 0.5f, bh >> 2, bh & 3, rep ? jj : 15 - jj); }
      xcd_barrier(bar); if (F.tid == 0) tsl[14] = rt(); }
#endif
#if defined(PROBE_GEMM)
    { xcd_barrier(bar); if (F.tid == 0) tsl[13] = rt();
      const int T = moe_tables(F);
      pg8::Gemm g{(const hb*)(ws + WS_X2B), (const hb*)(ws + WS_WUP), T * 256, NEXP * 2048, 512, 512, 512, 127, 122}; pg8::MoeOrderG S;
      S.init(T, 8, F.G, bx, (const PG8_LAS unsigned char*)(F.lds + TAB_OFF), (const PG8_LAS int*)(F.lds + TAB_TSTART), (const PG8_LAS int*)(F.lds + TAB_CNT), (const unsigned*)(ws + WS_LIST), (PG8_LAS unsigned*)(F.lds + XCH_OFF));
      pg8::EpiUp E{ws + WS_ACT, (const float*)(ws + WS_RSL), (const PG8_LAS int*)(F.lds + TAB_TSTART), (const PG8_LAS int*)(F.lds + TAB_CNT), INP(24)};
      pg8::gemm_phase<pg8::EpiUp, pg8::MoeOrderG, true, true, true, false, PROBE_GEMM>(F.lds + RING_OFF, g, S, E);
      xcd_barrier(bar); if (F.tid == 0) tsl[14] = rt(); }
#endif
#if defined(PROBE_K0)
#ifndef PROBE_UNIT
#define PROBE_UNIT 1600
#endif
    { if (F.tid == 0) { tsl[NPHASE] = rt();
        const int ks[2] = {PROBE_K0, PROBE_K1}; unsigned long long code = 0, mul = 1;
        for (int i = 0; i < 2; ++i) { unsigned long long dt = ks[i] == 94 ? tsl[14] - tsl[13] : ks[i] == 97 ? tsl[13] - tsl[2] : ks[i] == 98 ? tsl[3] - tsl[13] : ks[i] == 95 ? tsl[13] - tsl[0] : ks[i] == 96 ? tsl[14] - tsl[13] : tsl[ks[i] + 1] - tsl[ks[i]]; unsigned long long q = (dt + PROBE_UNIT / 2) / PROBE_UNIT; if (q > 63) q = 63; code += q * mul; mul *= 64; }
        tsl[15] = code * 6400ull; }
      __syncthreads();
      const unsigned long long t0 = rt(), wait = tsl[15]; float x = (float)F.tid, y = 1.0001f;
      while (rt() - t0 < wait) {
#pragma unroll
          for (int i = 0; i < 64; ++i) x = x * y + 0.5f; }
      if (x == 12345.678f) F.out[0] = x; }
#endif
#undef IN
#undef SEAM
#undef SEAM_LOCAL
}

#ifndef MK_N_LAUNCHES
#define MK_N_LAUNCHES 1
#endif
extern "C" void kernel_launch(void* const* d_in, const int* in_sizes, int n_in, void* d_out, int out_size, void* d_ws, size_t ws_size, hipStream_t stream) {
    static int grid = 0;
    if (grid == 0) {
        if (n_in != 28 || out_size != NTOK * DM || ws_size < WS_END) { fprintf(stderr, "kernel_launch: unexpected shapes: n_in %d out %d ws %zu (need %zu)\n", n_in, out_size, ws_size, (size_t)WS_END); grid = -1; return; }
        int dev = 0, cus = 0, per_cu = 0;
        if (hipGetDevice(&dev) != hipSuccess || hipDeviceGetAttribute(&cus, hipDeviceAttributeMultiprocessorCount, dev) != hipSuccess) { fprintf(stderr, "kernel_launch: device query failed\n"); grid = -1; return; }
        if (hipFuncSetAttribute((const void*)mk_fwd, hipFuncAttributeMaxDynamicSharedMemorySize, LDS_BYTES) != hipSuccess) { fprintf(stderr, "kernel_launch: hipFuncSetAttribute failed\n"); grid = -1; return; }
        if (hipOccupancyMaxActiveBlocksPerMultiprocessor(&per_cu, (const void*)mk_fwd, NWAVES * 64, LDS_BYTES) != hipSuccess || per_cu < 1) { fprintf(stderr, "kernel_launch: occupancy query reports %d workgroups per CU\n", per_cu); (void)hipGetLastError(); grid = -1; return; }
        grid = cus;
    }
    if (grid < 0) return;
    (void)hipMemsetAsync((char*)d_ws + WS_CTL, 0, CTL_ZERO_BYTES, stream);
    Args a{};
    for (int i = 0; i < 28; ++i) a.in[i] = d_in[i];
    a.out = (float*)d_out; a.ws = (unsigned char*)d_ws;
    if (MK_N_LAUNCHES == 1) { a.ph_lo = 0; a.ph_hi = NPHASE; hipLaunchKernelGGL(mk_fwd, dim3(grid), dim3(NWAVES * 64), LDS_BYTES, stream, a); }
    else for (int p = 0; p < NPHASE; ++p) { a.ph_lo = p; a.ph_hi = p + 1; hipLaunchKernelGGL(mk_fwd, dim3(grid), dim3(NWAVES * 64), LDS_BYTES, stream, a); }
}
```

```cpp
#include <hip/hip_runtime.h>
#include <cstdio>
#include <cstdint>
namespace pg8 {
#define PG8_LAS __attribute__((address_space(3)))
typedef unsigned short bf16_t;
typedef short bf16x8 __attribute__((ext_vector_type(8)));
typedef float f32x4 __attribute__((ext_vector_type(4)));
typedef unsigned u32x4 __attribute__((ext_vector_type(4)));
constexpr int BM = 256, BK = 64, HALF = 128, HTB = HALF * BK * 2  , STAGE_BYTES = 8 * HTB, NXCD = 8, WGM = 8;

__host__ __device__ __forceinline__ int lds_byte(int r, int c) { const int st = (r >> 4) * 2 + (c >> 5), rr = r & 15, cc = c & 31, ob = rr * 64 + cc * 2; return st * 1024 + (ob ^ (((ob >> 9) & 1) << 5)); }
__host__ __device__ __forceinline__ void stage_rc(int b, int& R, int& C) { const int st = b / 1024, sb = b % 1024, swz = sb ^ (((sb >> 9) & 1) << 5); R = (st >> 1) * 16 + swz / 64; C = (st & 1) * 32 + (swz % 64) / 2; }
__host__ __device__ __forceinline__ int perm32(int rho) { const int n = rho >> 4, i = rho & 15; return 8 * (i >> 2) + 4 * n + (i & 3); }

struct Unit { int pm, pn; };
struct Gemm { const bf16_t* A; const bf16_t* Bt; int M, N, K, lda, ldb, sa, sb; };
struct OrderBase {
    static constexpr bool GATHER = false;
    __device__ __forceinline__ const char* a_base(const Gemm& g, const Unit& u) const { return (const char*)g.A + (size_t)u.pm * 256 * g.lda * 2; }
    __device__ __forceinline__ const char* b_base(const Gemm& g, const Unit& u) const { return (const char*)g.Bt + (size_t)u.pn * 256 * g.ldb * 2; }
    __device__ __forceinline__ void a_ready(const Unit&) const {}
    __device__ __forceinline__ void done(const Unit&) const {}
};

struct StaticOrder : OrderBase {
    int nM, nN, nwg, G, c;
    __host__ __device__ void init(int M, int N, int G_, int c_) { nM = M / BM; nN = N / BM; nwg = nM * nN; G = G_; c = c_; }
    __host__ __device__ bool next(int i, Unit& u) const {
        const long L = (long)i * G + c; if (L >= nwg) return false;
        int wgid = (int)L; { const int q = nwg / NXCD, r = nwg % NXCD, xcd = wgid % NXCD, off = wgid / NXCD; wgid = (xcd < r ? xcd * (q + 1) : r * (q + 1) + (xcd - r) * q) + off; }
        const int nig = WGM * nN, gid = wgid / nig, fm = gid * WGM, gsz = (nM - fm) < WGM ? (nM - fm) : WGM;
        u.pm = fm + ((wgid % nig) % gsz); u.pn = (wgid % nig) / gsz; return true;
    }
};

typedef unsigned u32x2 __attribute__((ext_vector_type(2)));
typedef float f32x2_t __attribute__((ext_vector_type(2)));
typedef __bf16 bf16x2_t __attribute__((ext_vector_type(2)));
__device__ __forceinline__ unsigned cvtpk(float lo, float hi) { f32x2_t v = {lo, hi}; bf16x2_t b = __builtin_convertvector(v, bf16x2_t); return __builtin_bit_cast(unsigned, b); }
__device__ __forceinline__ void st_bf4(bf16_t* p, f32x4 v) { u32x2 w; w.x = cvtpk(v[0], v[1]); w.y = cvtpk(v[2], v[3]); *(u32x2*)p = w; }
__device__ __forceinline__ unsigned cvt4_fp8(f32x4 v) { unsigned w = __builtin_amdgcn_cvt_pk_fp8_f32(v[0], v[1], 0, false); return __builtin_amdgcn_cvt_pk_fp8_f32(v[2], v[3], w, true); }
__device__ __forceinline__ void st_bf8(bf16_t* p, f32x4 a, f32x4 c) { u32x4 w; w.x = cvtpk(a[0], a[1]); w.y = cvtpk(a[2], a[3]); w.z = cvtpk(c[0], c[1]); w.w = cvtpk(c[2], c[3]); *(u32x4*)p = w; }
__device__ __forceinline__ float bf2f(bf16_t b) { return __builtin_bit_cast(float, (unsigned)b << 16); }
#define EPI_ROWS _Pragma("unroll") for (int ai = 0; ai < 2; ++ai) _Pragma("unroll") for (int m = 0; m < 4; ++m)
#define EPI_COLS _Pragma("unroll") for (int bj = 0; bj < 2; ++bj) _Pragma("unroll") for (int n = 0; n < 2; ++n)
constexpr float LOG2E = 1.4426950408889634f;
constexpr float QSCALE_DA = 0.125f * LOG2E;
constexpr float QSCALE_X = 0.0625f * LOG2E;

struct EpiPlain {
    static constexpr bool PERM = true, AFTER_DRAIN = false;
    bf16_t* O; int ldc; float scale;
    __device__ __forceinline__ void operator()(const f32x4 (&acc)[2][2][4][2], const Unit& u, int wr, int wc, int fr, int fq) const {
        EPI_ROWS { const int row = u.pm * 256 + ai * 128 + wr * 64 + m * 16 + fr; bf16_t* rp = O + (size_t)row * ldc + u.pn * 256 + wc * 32 + fq * 8;
            _Pragma("unroll") for (int bj = 0; bj < 2; ++bj) st_bf8(rp + bj * 128, acc[ai][bj][m][0] * scale, acc[ai][bj][m][1] * scale); }
    }
};
struct EpiProj {
    static constexpr bool PERM = true, AFTER_DRAIN = false;
    bf16_t* P; float* LA; const float* cs; const float* b_alpha;
    template <int ai> __device__ __forceinline__ void decay_rows(const f32x4 (&acc)[2][2][4][2], const f32x4 (&bav)[2][2], const Unit& u, int wr, int wc, int fr, int fq) const {
        const int row0 = u.pm * 256 + ai * 128 + wr * 64 + fr;
        EPI_COLS { const int col = bj * 128 + wc * 32 + fq * 8 + n * 4; const f32x4 ba = bav[bj][n]; f32x4 run = {0.f, 0.f, 0.f, 0.f};
            _Pragma("unroll") for (int m = 0; m < 4; ++m) { const f32x4 z = acc[ai][bj][m][n] + ba; f32x4 o;
                _Pragma("unroll") for (int i = 0; i < 4; ++i) { float v = (fminf(z[i], 0.f) - __logf(1.0f + __expf(-fabsf(z[i])))) * 0.0625f;
                    { float t = __shfl_up(v, 1, 16); if (fr >= 1) v += t; t = __shfl_up(v, 2, 16); if (fr >= 2) v += t; t = __shfl_up(v, 4, 16); if (fr >= 4) v += t; t = __shfl_up(v, 8, 16); if (fr >= 8) v += t; }
                    o[i] = v + run[i]; run[i] += __shfl(v, 15, 16); }
                *(f32x4*)(LA + (size_t)(row0 + m * 16) * 256 + col) = o; } }
    }
    __device__ __forceinline__ void operator()(const f32x4 (&acc)[2][2][4][2], const Unit& u, int wr, int wc, int fr, int fq) const {
        const int pn = u.pn;
        if (pn < 4) {
            const float sc = pn < 2 ? QSCALE_DA : 1.0f; const bool ropew = (wc & 1) == 0; const bool rl = fq < 2, hi = fq == 1;
            if (ropew) {
                f32x4 cq[2][4];
#define ROPE_LD(i, sl) do { const f32x4* cp_ = (const f32x4*)(cs + (size_t)(u.pm * 256 + ((i) >> 2) * 128 + wr * 64 + ((i) & 3) * 16 + fr) * 16); cq[sl][0] = cp_[0]; cq[sl][1] = cp_[1]; cq[sl][2] = cp_[2]; cq[sl][3] = cp_[3]; } while (0)
                ROPE_LD(0, 0); ROPE_LD(1, 1);
                _Pragma("unroll") for (int ri = 0; ri < 8; ++ri) { const int ai = ri >> 2, m = ri & 3; const int row = u.pm * 256 + ai * 128 + wr * 64 + m * 16 + fr; bf16_t* rp = P + (size_t)row * 3072 + pn * 256 + wc * 32 + fq * 8;
                    const f32x4 cv[2] = {cq[ri & 1][0], cq[ri & 1][1]}, sv[2] = {cq[ri & 1][2], cq[ri & 1][3]};
                    if (ri + 2 < 8) ROPE_LD(ri + 2, ri & 1);
                    _Pragma("unroll") for (int bj = 0; bj < 2; ++bj) { f32x4 v[2] = {acc[ai][bj][m][0], acc[ai][bj][m][1]};
                        _Pragma("unroll") for (int n = 0; n < 2; ++n) { f32x4 p; p[0] = __shfl_xor(v[n][0], 16); p[1] = __shfl_xor(v[n][1], 16); p[2] = __shfl_xor(v[n][2], 16); p[3] = __shfl_xor(v[n][3], 16);
                            const f32x4 r = hi ? (v[n] * cv[n] + p * sv[n]) : (v[n] * cv[n] - p * sv[n]); v[n] = rl ? r : v[n]; }
                        st_bf8(rp + bj * 128, v[0] * sc, v[1] * sc); } }
#undef ROPE_LD
            } else {
                EPI_ROWS { const int row = u.pm * 256 + ai * 128 + wr * 64 + m * 16 + fr; bf16_t* rp = P + (size_t)row * 3072 + pn * 256 + wc * 32 + fq * 8;
                    _Pragma("unroll") for (int bj = 0; bj < 2; ++bj) st_bf8(rp + bj * 128, acc[ai][bj][m][0] * sc, acc[ai][bj][m][1] * sc); }
            }
        } else if (pn < 12) {
            const float sc = pn == 6 ? 0.125f : 1.0f;
            EPI_ROWS { const int row = u.pm * 256 + ai * 128 + wr * 64 + m * 16 + fr; bf16_t* rp = P + (size_t)row * 3072 + pn * 256 + wc * 32 + fq * 8;
                _Pragma("unroll") for (int bj = 0; bj < 2; ++bj) st_bf8(rp + bj * 128, acc[ai][bj][m][0] * sc, acc[ai][bj][m][1] * sc); }
        } else {
            f32x4 bav[2][2]; EPI_COLS bav[bj][n] = *(const f32x4*)(b_alpha + bj * 128 + wc * 32 + fq * 8 + n * 4);
            decay_rows<0>(acc, bav, u, wr, wc, fr, fq); decay_rows<1>(acc, bav, u, wr, wc, fr, fq);
        }
    }
};
struct EpiP1 {
    static constexpr bool PERM = true, AFTER_DRAIN = false;
    EpiProj proj; EpiPlain vt, kx, vxt;
    __device__ __forceinline__ void operator()(const f32x4 (&acc)[2][2][4][2], const Unit& u, int wr, int wc, int fr, int fq) const {
        const int job = u.pn >> 16; Unit v; v.pm = u.pm; v.pn = u.pn & 0xffff;
        if (job == 0) proj(acc, v, wr, wc, fr, fq); else if (job == 1) vt(acc, v, wr, wc, fr, fq); else if (job == 2) kx(acc, v, wr, wc, fr, fq); else vxt(acc, v, wr, wc, fr, fq);
    }
};
struct EpiRes1 {
    static constexpr bool PERM = true, AFTER_DRAIN = false;
    const float* base; bf16_t* xb; float* ssp;
    __device__ __forceinline__ void operator()(const f32x4 (&acc)[2][2][4][2], const Unit& u, int wr, int wc, int fr, int fq) const {
        constexpr int ND = 3;
        const size_t off0 = (size_t)(u.pm * 256 + wr * 64 + fr) * 1024 + u.pn * 256 + wc * 32 + fq * 8;
        f32x4 xq[ND][4];
#define RES1_LD(i, sl) do { const float* bp_ = base + off0 + (size_t)((((i) >> 2) * 128 + ((i) & 3) * 16)) * 1024; xq[sl][0] = *(const f32x4*)bp_; xq[sl][1] = *(const f32x4*)(bp_ + 4); xq[sl][2] = *(const f32x4*)(bp_ + 128); xq[sl][3] = *(const f32x4*)(bp_ + 132); } while (0)
        _Pragma("unroll") for (int i = 0; i < ND; ++i) RES1_LD(i, i);
        _Pragma("unroll") for (int i = 0; i < 8; ++i) { const int ai = i >> 2, m = i & 3; const int row = u.pm * 256 + ai * 128 + wr * 64 + m * 16 + fr; const size_t off = off0 + (size_t)(ai * 128 + m * 16) * 1024;
            f32x4 v[4]; _Pragma("unroll") for (int q = 0; q < 4; ++q) v[q] = xq[i % ND][q] + acc[ai][q >> 1][m][q & 1];
            if (i + ND < 8) RES1_LD(i + ND, i % ND);
            st_bf8(xb + off, v[0], v[1]); st_bf8(xb + off + 128, v[2], v[3]); float ss = 0.f;
            _Pragma("unroll") for (int q = 0; q < 4; ++q) ss += (v[q][0] * v[q][0] + v[q][1] * v[q][1]) + (v[q][2] * v[q][2] + v[q][3] * v[q][3]);
            ss += __shfl_xor(ss, 16); ss += __shfl_xor(ss, 32);
            if (fq == 0) ssp[(size_t)row * 16 + u.pn * 4 + wc] = ss; }
#undef RES1_LD
    }
};
struct EpiQX {
    static constexpr bool PERM = true, AFTER_DRAIN = false;
    bf16_t* O; const float* ssp;
    __device__ __forceinline__ void operator()(const f32x4 (&acc)[2][2][4][2], const Unit& u, int wr, int wc, int fr, int fq) const {
        EPI_ROWS { const int row = u.pm * 256 + ai * 128 + wr * 64 + m * 16 + fr; const f32x4* sp = (const f32x4*)(ssp + (size_t)row * 16);
            const f32x4 a = sp[0], b = sp[1], c = sp[2], d = sp[3]; const float ss = ((a[0] + a[1]) + (a[2] + a[3])) + ((b[0] + b[1]) + (b[2] + b[3])) + ((c[0] + c[1]) + (c[2] + c[3])) + ((d[0] + d[1]) + (d[2] + d[3]));
            const float rs = rsqrtf(ss * (1.0f / 1024.0f) + 1e-6f) * QSCALE_X; bf16_t* rp = O + (size_t)row * 1024 + u.pn * 256 + wc * 32 + fq * 8;
            _Pragma("unroll") for (int bj = 0; bj < 2; ++bj) st_bf8(rp + bj * 128, acc[ai][bj][m][0] * rs, acc[ai][bj][m][1] * rs); }
    }
};
struct EpiRes2 {
    static constexpr bool PERM = true, AFTER_DRAIN = false;
    bf16_t* xh; unsigned char* x8;
    __device__ __forceinline__ void operator()(const f32x4 (&acc)[2][2][4][2], const Unit& u, int wr, int wc, int fr, int fq) const {
        constexpr int ND = 4;
        const size_t off0 = (size_t)(u.pm * 256 + wr * 64 + fr) * 1024 + u.pn * 256 + wc * 32 + fq * 8;
        u32x4 xq[ND][2];
#define RES2_LD(i, sl) do { const bf16_t* bp_ = xh + off0 + (size_t)((((i) >> 2) * 128 + ((i) & 3) * 16)) * 1024; xq[sl][0] = *(const u32x4*)bp_; xq[sl][1] = *(const u32x4*)(bp_ + 128); } while (0)
        _Pragma("unroll") for (int i = 0; i < ND; ++i) RES2_LD(i, i);
        _Pragma("unroll") for (int i = 0; i < 8; ++i) { const int ai = i >> 2, m = i & 3; const size_t off = off0 + (size_t)(ai * 128 + m * 16) * 1024;
            f32x4 v[2][2];
            _Pragma("unroll") for (int bj = 0; bj < 2; ++bj) { const u32x4 w = xq[i % ND][bj];
                const f32x4 v0 = {__builtin_bit_cast(float, w.x << 16), __builtin_bit_cast(float, w.x & 0xffff0000u), __builtin_bit_cast(float, w.y << 16), __builtin_bit_cast(float, w.y & 0xffff0000u)};
                const f32x4 v1 = {__builtin_bit_cast(float, w.z << 16), __builtin_bit_cast(float, w.z & 0xffff0000u), __builtin_bit_cast(float, w.w << 16), __builtin_bit_cast(float, w.w & 0xffff0000u)};
                v[bj][0] = v0 + acc[ai][bj][m][0]; v[bj][1] = v1 + acc[ai][bj][m][1]; }
            if (i + ND < 8) RES2_LD(i + ND, i % ND);
            _Pragma("unroll") for (int bj = 0; bj < 2; ++bj) { st_bf8(xh + off + bj * 128, v[bj][0], v[bj][1]); u32x2 q; q.x = cvt4_fp8(v[bj][0]); q.y = cvt4_fp8(v[bj][1]); *(u32x2*)(x8 + off + bj * 128) = q; } }
#undef RES2_LD
    }
};
struct EpiUp {
    static constexpr bool PERM = true, AFTER_DRAIN = false;
    unsigned char* ACT; const float* rsl; const PG8_LAS int* tstart; const PG8_LAS int* cnt; const float* b_up;
    __device__ __forceinline__ void operator()(const f32x4 (&acc)[2][2][4][2], const Unit& u, int wr, int wc, int fr, int fq) const {
        const int e = u.pn >> 3, pnl = u.pn & 7; const float* bg = b_up + (size_t)e * 2048 + pnl * 128 + wc * 32 + fq * 8;
        const int pos0 = (u.pm - tstart[e]) * 256 + wr * 64 + fr, nv = cnt[e]; const float* rp0 = rsl + (size_t)e * 32768 + pos0;
        const f32x4 bg0 = *(const f32x4*)bg, bg1 = *(const f32x4*)(bg + 4), bl0 = *(const f32x4*)(bg + 1024), bl1 = *(const f32x4*)(bg + 1028);
        float rsv[2][4];
        EPI_ROWS rsv[ai][m] = (pos0 + ai * 128 + m * 16) < nv ? rp0[ai * 128 + m * 16] : 0.f;
        EPI_ROWS { const int row = u.pm * 256 + ai * 128 + wr * 64 + m * 16 + fr; const float rs = rsv[ai][m];
            unsigned char* rp = ACT + (size_t)row * 1024 + pnl * 128 + wc * 32 + fq * 8; u32x2 w;
            _Pragma("unroll") for (int n = 0; n < 2; ++n) {
                const f32x4 c7 = {7.0f, 7.0f, 7.0f, 7.0f}, one = {1.0f, 1.0f, 1.0f, 1.0f};
                const f32x4 gl = __builtin_elementwise_min(acc[ai][0][m][n] * rs + (n ? bg1 : bg0), c7), li = __builtin_elementwise_min(__builtin_elementwise_max(acc[ai][1][m][n] * rs + (n ? bl1 : bl0), -c7), c7);
                const f32x4 t = gl * -2.4554669595930156f; f32x4 e; _Pragma("unroll") for (int i = 0; i < 4; ++i) e[i] = __builtin_amdgcn_exp2f(t[i]);
                const f32x4 a = e + one; f32x4 r; _Pragma("unroll") for (int i = 0; i < 4; ++i) r[i] = __builtin_amdgcn_rcpf(a[i]);
                const f32x4 o = (gl * r) * (li + one);
                if (n) w.y = cvt4_fp8(o); else w.x = cvt4_fp8(o); }
            *(u32x2*)rp = w; }
    }
};
struct EpiDown {
    static constexpr bool PERM = true, AFTER_DRAIN = false;
    unsigned char* Y; const float* b_down;
    __device__ __forceinline__ void operator()(const f32x4 (&acc)[2][2][4][2], const Unit& u, int wr, int wc, int fr, int fq) const {
        const int e = u.pn >> 2, pnl = u.pn & 3; const float* bp = b_down + (size_t)e * 1024 + pnl * 256 + wc * 32 + fq * 8;
        f32x4 bv[2][2];
        _Pragma("unroll") for (int bj = 0; bj < 2; ++bj) _Pragma("unroll") for (int n = 0; n < 2; ++n) bv[bj][n] = *(const f32x4*)(bp + bj * 128 + n * 4);
        EPI_ROWS { const int row = u.pm * 256 + ai * 128 + wr * 64 + m * 16 + fr; unsigned char* rp = Y + (size_t)row * 1024 + pnl * 256 + wc * 32 + fq * 8;
            _Pragma("unroll") for (int bj = 0; bj < 2; ++bj) { u32x2 w; w.x = cvt4_fp8(acc[ai][bj][m][0] + bv[bj][0]); w.y = cvt4_fp8(acc[ai][bj][m][1] + bv[bj][1]); *(u32x2*)(rp + bj * 128) = w; } }
    }
};
struct OrderMap : OrderBase {
    StaticOrder so;
    __device__ void init(int nM, int nN, int G, int c) { so.nM = nM; so.nN = nN; so.nwg = nM * nN; so.G = G; so.c = c; }
    __device__ bool next(int i, Unit& u) const { if (!so.next(i, u)) return false; u.pn += (u.pn >= 4 ? 2 : 0) + (u.pn >= 6 ? 2 : 0); return true; }
};
struct OrderVT : OrderBase {
    StaticOrder so;
    __device__ void init(int nN, int G, int c) { so.nM = 4; so.nN = nN; so.nwg = 4 * nN; so.G = G; so.c = c; }
    __device__ bool next(int i, Unit& u) const { if (!so.next(i, u)) return false; u.pm += (u.pm >= 2 ? 6 : 4); return true; }
};
__device__ __forceinline__ void map_unit(int L, int nM, int nN, int& pm, int& pn) {
    const int nwg = nM * nN; int wgid = L; { const int q = nwg / NXCD, r = nwg % NXCD, xcd = wgid % NXCD, off = wgid / NXCD; wgid = (xcd < r ? xcd * (q + 1) : r * (q + 1) + (xcd - r) * q) + off; }
    const int nig = WGM * nN, gid = wgid / nig, fm = gid * WGM, gsz = (nM - fm) < WGM ? (nM - fm) : WGM;
    pm = fm + ((wgid % nig) % gsz); pn = (wgid % nig) / gsz;
}
template <unsigned oHN, unsigned oWINT, unsigned oMN, unsigned oWCK, unsigned oWCV>
struct OrderP1 : OrderBase {
    int G, c; const char* ws;
    __device__ __forceinline__ bool next(int i, Unit& u) const {
        int L = i * G + c; if (L >= 1792) return false;
        if (L < 1152) { map_unit(L, 128, 9, u.pm, u.pn); u.pn += (u.pn >= 4 ? 2 : 0) + (u.pn >= 6 ? 2 : 0); return true; } L -= 1152;
        if (L < 512) { map_unit(L, 4, 128, u.pm, u.pn); u.pm += (u.pm >= 2 ? 6 : 4); u.pn |= 1 << 16; return true; } L -= 512;
        if (L < 64) { map_unit(L, 16, 4, u.pm, u.pn); u.pn |= 2 << 16; return true; } L -= 64;
        map_unit(L, 16, 4, u.pm, u.pn); u.pn |= 3 << 16; return true;
    }
    __device__ __forceinline__ const char* a_base(const Gemm&, const Unit& u) const { const int job = u.pn >> 16; unsigned o = oHN; o = job == 1 ? oWINT : o; o = job >= 2 ? oMN : o; return ws + o + (size_t)u.pm * (256 * 1024 * 2); }
    __device__ __forceinline__ const char* b_base(const Gemm&, const Unit& u) const { const int job = u.pn >> 16; unsigned o = oWINT; o = job == 1 ? oHN : o; o = job == 2 ? oWCK : o; o = job == 3 ? oWCV : o; return ws + o + (size_t)(u.pn & 0xffff) * (256 * 1024 * 2); }
};
struct MoeOrder : OrderBase {
    StaticOrder so; const PG8_LAS unsigned char* tile_e; int nN;
    __device__ void init(int nM, int nN_, int G, int c, const PG8_LAS unsigned char* te) { so.nM = nM; so.nN = nN_; so.nwg = nM * nN_; so.G = G; so.c = c; tile_e = te; nN = nN_; }
    __device__ bool next(int i, Unit& u) const { if (!so.next(i, u)) return false; u.pn += (int)tile_e[u.pm] * nN; return true; }
};


struct MoeOrderG : OrderBase {
    static constexpr bool GATHER = true;
    StaticOrder so; const PG8_LAS unsigned char* tile_e; const PG8_LAS int* tstart; const PG8_LAS int* cnt; const unsigned* list; PG8_LAS unsigned* gslot; int nN;
    __device__ void init(int nM, int nN_, int G, int c, const PG8_LAS unsigned char* te, const PG8_LAS int* ts, const PG8_LAS int* cn, const unsigned* li, PG8_LAS unsigned* gs) {
        so.nM = nM; so.nN = nN_; so.nwg = nM * nN_; so.G = G; so.c = c; tile_e = te; tstart = ts; cnt = cn; list = li; gslot = gs; nN = nN_; }
    __device__ bool next(int i, Unit& u) const { if (!so.next(i, u)) return false; u.pn += (int)tile_e[u.pm] * nN; return true; }
    __device__ __forceinline__ const char* a_base(const Gemm& g, const Unit&) const { return (const char*)g.A; }
    __device__ __forceinline__ const unsigned* rows(const Unit& u) const { const int e = u.pn / nN; return list + (size_t)e * 32768 + (size_t)(u.pm - tstart[e]) * 256; }
    __device__ __forceinline__ int nvalid(const Unit& u) const { const int e = u.pn / nN; return cnt[e] - (u.pm - tstart[e]) * 256; }
};
struct OrderX1 : OrderBase {
    StaticOrder so;
    __device__ void init(int G, int c) { so.nM = 128; so.nN = 4; so.nwg = 512; so.G = G; so.c = c; }
    __device__ bool next(int i, Unit& u) const { return so.next(i, u); }
    __device__ __forceinline__ const char* a_base(const Gemm& g, const Unit& u) const { return (const char*)(g.A + (size_t)u.pm * 256 * 1024 + u.pn * 256); }
    __device__ __forceinline__ const char* b_base(const Gemm& g, const Unit& u) const { return (const char*)(g.Bt + (size_t)(u.pm >> 3) * 256 * 1024 + u.pn * 256); }
};
struct OrderX2 : OrderBase {
    StaticOrder so;
    __device__ void init(int G, int c) { so.nM = 128; so.nN = 4; so.nwg = 512; so.G = G; so.c = c; }
    __device__ bool next(int i, Unit& u) const { return so.next(i, u); }
    __device__ __forceinline__ const char* a_base(const Gemm& g, const Unit& u) const { return (const char*)(g.A + (size_t)u.pm * 256 * 1024 + u.pn * 256); }
    __device__ __forceinline__ const char* b_base(const Gemm& g, const Unit& u) const { return (const char*)(g.Bt + (size_t)u.pn * 256 * 4096 + (u.pm >> 3) * 256); }
};
struct EpiSoftmax {
    static constexpr bool PERM = true, AFTER_DRAIN = false;
    bf16_t* PX; float* lp; PG8_LAS float* xch;
    __device__ __forceinline__ void operator()(const f32x4 (&acc)[2][2][4][2], const Unit& u, int wr, int wc, int fr, int fq) const {
        PG8_LAS char* rb = (PG8_LAS char*)xch + (wr * 64 + fr) * 16; asm volatile("" : "+v"(rb));
        PG8_LAS char* wb = rb + wc * 4; asm volatile("" : "+v"(wb));
        EPI_ROWS { float a = -INFINITY;
            EPI_COLS { const f32x4 v = acc[ai][bj][m][n]; a = fmaxf(a, fmaxf(fmaxf(v[0], v[1]), fmaxf(v[2], v[3]))); }
            a = fmaxf(a, __shfl_xor(a, 16)); a = fmaxf(a, __shfl_xor(a, 32));
            if (fq == 0) *(PG8_LAS float*)(wb + (ai * 128 + m * 16) * 16) = a; }
        asm volatile("s_waitcnt lgkmcnt(0)" ::: "memory"); __builtin_amdgcn_s_barrier(); asm volatile("" ::: "memory");
        const int row0 = u.pm * 256 + wr * 64 + fr; bf16_t* rp0 = PX + (size_t)row0 * 1024 + u.pn * 256 + wc * 32 + fq * 8; float* lp0 = lp + (size_t)row0 * 16 + u.pn * 4 + wc;
        EPI_ROWS { const f32x4 q = *(const PG8_LAS f32x4*)(rb + (ai * 128 + m * 16) * 16); const float mr = fmaxf(fmaxf(q[0], q[1]), fmaxf(q[2], q[3]));
            bf16_t* rp = rp0 + (size_t)(ai * 128 + m * 16) * 1024; float ps = 0.f;
            _Pragma("unroll") for (int bj = 0; bj < 2; ++bj) { f32x4 p[2];
                _Pragma("unroll") for (int n = 0; n < 2; ++n) _Pragma("unroll") for (int i = 0; i < 4; ++i) { p[n][i] = __builtin_amdgcn_exp2f(acc[ai][bj][m][n][i] - mr); ps += p[n][i]; }
                st_bf8(rp + bj * 128, p[0], p[1]); }
            ps += __shfl_xor(ps, 16); ps += __shfl_xor(ps, 32);
            if (fq == 0) lp0[(ai * 128 + m * 16) * 16] = ps; }
        asm volatile("s_waitcnt lgkmcnt(0)" ::: "memory"); __builtin_amdgcn_s_barrier(); asm volatile("" ::: "memory");
    }
};
struct EpiPV {
    static constexpr bool PERM = true, AFTER_DRAIN = false;
    bf16_t* O; const float* lp;
    __device__ __forceinline__ void operator()(const f32x4 (&acc)[2][2][4][2], const Unit& u, int wr, int wc, int fr, int fq) const {
        EPI_ROWS { const int row = u.pm * 256 + ai * 128 + wr * 64 + m * 16 + fr; const f32x4 q = *(const f32x4*)(lp + (size_t)row * 16 + u.pn * 4);
            const float inv = 1.0f / ((q[0] + q[1]) + (q[2] + q[3])); bf16_t* rp = O + (size_t)row * 1024 + u.pn * 256 + wc * 32 + fq * 8;
            _Pragma("unroll") for (int bj = 0; bj < 2; ++bj) st_bf8(rp + bj * 128, acc[ai][bj][m][0] * inv, acc[ai][bj][m][1] * inv); }
    }
};

template <unsigned oKX, unsigned oWCQR, unsigned oWCOT, unsigned oVX>
struct OrderGH : OrderBase {
    int G, c; const char* ws;
    __device__ __forceinline__ bool next(int i, Unit& u) const { int L = i * G + c; if (L >= 512) return false;
        if (L < 256) { u.pm = L >> 2; u.pn = L & 3; } else { L -= 256; u.pm = L >> 2; u.pn = (L & 3) | (1 << 16); } return true; }
    __device__ __forceinline__ const char* a_base(const Gemm&, const Unit& u) const { const int job = u.pn >> 16, pn = u.pn & 0xffff;
        return job == 0 ? ws + oKX + ((size_t)(u.pm >> 2) * 256 * 1024 + (u.pm & 3) * 256) * 2 : ws + oWCOT + ((size_t)(u.pm & 3) * 256 * 1024 + pn * 256) * 2; }
    __device__ __forceinline__ const char* b_base(const Gemm&, const Unit& u) const { const int job = u.pn >> 16, pn = u.pn & 0xffff;
        return job == 0 ? ws + oWCQR + ((size_t)pn * 256 * 1024 + (u.pm & 3) * 256) * 2 : ws + oVX + ((size_t)(u.pm >> 2) * 256 * 1024 + pn * 256) * 2; }
};
struct EpiGH {
    static constexpr bool PERM = true, AFTER_DRAIN = false;
    EpiPlain gt, ht;
    __device__ __forceinline__ void operator()(const f32x4 (&acc)[2][2][4][2], const Unit& u, int wr, int wc, int fr, int fq) const {
        Unit v; v.pm = u.pm; v.pn = u.pn & 0xffff; if ((u.pn >> 16) == 0) gt(acc, v, wr, wc, fr, fq); else ht(acc, v, wr, wc, fr, fq); }
};
struct OrderXS : OrderBase {
    StaticOrder so;
    __device__ void init(int G, int c) { so.nM = 128; so.nN = 4; so.nwg = 512; so.G = G; so.c = c; }
    __device__ bool next(int i, Unit& u) const { return so.next(i, u); }
    __device__ __forceinline__ const char* b_base(const Gemm& g, const Unit& u) const { return (const char*)(g.Bt + ((size_t)(u.pm >> 3) * 1024 + u.pn * 256) * 1024); }
};
struct EpiSoftmaxN {
    static constexpr bool PERM = true, AFTER_DRAIN = false;
    bf16_t* PX; const float* ssp; PG8_LAS float* xmax; PG8_LAS float* xsum;
    __device__ __forceinline__ void operator()(f32x4 (&acc)[2][2][4][2], const Unit& u, int wr, int wc, int fr, int fq) const {
        PG8_LAS char* rb = (PG8_LAS char*)xmax + (wr * 64 + fr) * 16; asm volatile("" : "+v"(rb));
        PG8_LAS char* wb = rb + wc * 4; asm volatile("" : "+v"(wb));
        PG8_LAS char* rb2 = (PG8_LAS char*)xsum + (wr * 64 + fr) * 16; asm volatile("" : "+v"(rb2));
        PG8_LAS char* wb2 = rb2 + wc * 4; asm volatile("" : "+v"(wb2));
        const int row0 = u.pm * 256 + wr * 64 + fr;
        f32x4 sq[2][4];
        EPI_ROWS sq[ai][m] = ((const f32x4*)(ssp + (size_t)(row0 + ai * 128 + m * 16) * 16))[fq];
        EPI_ROWS { float ss = (sq[ai][m][0] + sq[ai][m][1]) + (sq[ai][m][2] + sq[ai][m][3]); ss += __shfl_xor(ss, 16); ss += __shfl_xor(ss, 32);
            const float rs = rsqrtf(ss * (1.0f / 1024.0f) + 1e-6f) * QSCALE_X; float a = -INFINITY;
            EPI_COLS { f32x4 v = acc[ai][bj][m][n] * rs; acc[ai][bj][m][n] = v; a = fmaxf(a, fmaxf(fmaxf(v[0], v[1]), fmaxf(v[2], v[3]))); }
            a = fmaxf(a, __shfl_xor(a, 16)); a = fmaxf(a, __shfl_xor(a, 32));
            if (fq == 0) *(PG8_LAS float*)(wb + (ai * 128 + m * 16) * 16) = a; }
        asm volatile("s_waitcnt lgkmcnt(0)" ::: "memory"); __builtin_amdgcn_s_barrier(); asm volatile("" ::: "memory");
        EPI_ROWS { const f32x4 q = *(const PG8_LAS f32x4*)(rb + (ai * 128 + m * 16) * 16); const float mr = fmaxf(fmaxf(q[0], q[1]), fmaxf(q[2], q[3])); float ps = 0.f;
            EPI_COLS { f32x4 p; _Pragma("unroll") for (int i = 0; i < 4; ++i) { p[i] = __builtin_amdgcn_exp2f(acc[ai][bj][m][n][i] - mr); ps += p[i]; } acc[ai][bj][m][n] = p; }
            ps += __shfl_xor(ps, 16); ps += __shfl_xor(ps, 32);
            if (fq == 0) *(PG8_LAS float*)(wb2 + (ai * 128 + m * 16) * 16) = ps; }
        asm volatile("s_waitcnt lgkmcnt(0)" ::: "memory"); __builtin_amdgcn_s_barrier(); asm volatile("" ::: "memory");
        bf16_t* rp0 = PX + (size_t)row0 * 1024 + u.pn * 256 + wc * 32 + fq * 8;
        EPI_ROWS { const f32x4 q = *(const PG8_LAS f32x4*)(rb2 + (ai * 128 + m * 16) * 16); const float inv = __builtin_amdgcn_rcpf((q[0] + q[1]) + (q[2] + q[3]));
            bf16_t* rp = rp0 + (size_t)(ai * 128 + m * 16) * 1024;
            _Pragma("unroll") for (int bj = 0; bj < 2; ++bj) st_bf8(rp + bj * 128, acc[ai][bj][m][0] * inv, acc[ai][bj][m][1] * inv); }
    }
};
struct OrderXO : OrderBase {
    StaticOrder so;
    __device__ void init(int G, int c) { so.nM = 128; so.nN = 4; so.nwg = 512; so.G = G; so.c = c; }
    __device__ bool next(int i, Unit& u) const { return so.next(i, u); }
    __device__ __forceinline__ const char* b_base(const Gemm& g, const Unit& u) const { return (const char*)(g.Bt + ((size_t)(u.pm >> 3) * 1024 + u.pn * 256) * 1024); }
};
typedef int v4i_t __attribute__((ext_vector_type(4))); typedef int v8i_t __attribute__((ext_vector_type(8)));
__device__ __forceinline__ v8i_t cat8(bf16x8 lo, bf16x8 hi) { return __builtin_shufflevector(__builtin_bit_cast(v4i_t, lo), __builtin_bit_cast(v4i_t, hi), 0, 1, 2, 3, 4, 5, 6, 7); }
__device__ __forceinline__ void mfma8(f32x4& acc, v8i_t w, v8i_t a, int sw, int sa) {
    asm volatile("s_nop 1\n\tv_mfma_scale_f32_16x16x128_f8f6f4 %0, %1, %2, %0, %3, %4 op_sel_hi:[0,0,0]" : "+v"(acc) : "v"(w), "v"(a), "v"(sw), "v"(sa)); }
constexpr int PF_D = 4, PF_LDS = 137216;
template <class Epi, class Sched, bool ALIGN_EPI = false, bool SP2 = false, bool FP8 = false, bool PF = false, int DBG = 0>
__device__ __forceinline__ void gemm_phase(PG8_LAS unsigned char* lds, const Gemm g, const Sched& S, const Epi& E) {
    const int tid = threadIdx.x, wid = __builtin_amdgcn_readfirstlane(tid >> 6), lane = tid & 63, wr = wid >> 2, wc = wid & 3, fr = lane & 15, fq = lane >> 4;
    const int K = g.K, nt = K / BK;
    unsigned voffA[2], voffB[2];
    unsigned gC[2][2];
#pragma unroll
    for (int i = 0; i < 2; ++i) { int R, C; stage_rc(tid * 16 + i * 8192, R, C); const int Rb = Epi::PERM ? ((R & ~31) + perm32(R & 31)) : R;
        voffA[i] = (unsigned)(R * g.lda + C) * 2u; voffB[i] = (unsigned)(Rb * g.ldb + C) * 2u; }
    const bool pfA = !Sched::GATHER && wid < 4;
    const unsigned pfoff = (unsigned)((((wid >> 1) & 1) * HALF + (wid & 1) * 64 + lane) * (pfA ? g.lda : g.ldb)) * 2u;
    const size_t kstep = (size_t)(BK * 2);
    const size_t hstepA = (size_t)HALF * g.lda * 2, hstepB = (size_t)HALF * g.ldb * 2;
    const unsigned ldsw = (unsigned)wid * 1024u;
    const int aoff = lds_byte(wr * 64 + fr, fq * 8), boff = lds_byte(wc * 32 + fr, fq * 8);
#define PG8_SA(b, h) (((b) * 2 + (h)) * HTB)
#define PG8_SB(b, h) ((4 + (b) * 2 + (h)) * HTB)
#define PG8_STAGE(bufoff, gbase, voff) do { if constexpr ((DBG & 2) == 0) _Pragma("unroll") for (int _i = 0; _i < 2; ++_i) \
        __builtin_amdgcn_global_load_lds((const unsigned*)((const char*)(gbase) + (voff)[_i]), (PG8_LAS unsigned*)(lds + (bufoff) + ldsw + _i * 8192), 16, 0, 0); } while (0)
#define PG8_STAGE_A(bufoff, ptr, h, nx) do { if constexpr (Sched::GATHER) { PG8_STAGE(bufoff, ptr, gC[h]); } else { PG8_STAGE(bufoff, (ptr) + ((h) ? hstepA : 0), voffA); } } while (0)
#define PG8_LDA(dst, b, h) do { if constexpr ((DBG & 8) == 0) _Pragma("unroll") for (int m = 0; m < 4; ++m) _Pragma("unroll") for (int k = 0; k < 2; ++k) dst[m][k] = *(const PG8_LAS bf16x8*)(lds + PG8_SA(b, h) + aoff + m * 2048 + k * 1024); } while (0)
#define PG8_LDB(dst, b, h) do { if constexpr ((DBG & 8) == 0) _Pragma("unroll") for (int n = 0; n < 2; ++n) _Pragma("unroll") for (int k = 0; k < 2; ++k) dst[n][k] = *(const PG8_LAS bf16x8*)(lds + PG8_SB(b, h) + boff + n * 2048 + k * 1024); } while (0)
#define PG8_MMA(ai, bj, At, Bt) do { if constexpr ((DBG & 1) == 0) { __builtin_amdgcn_s_setprio(1); \
        if constexpr (FP8) { _Pragma("unroll") for (int m = 0; m < 4; ++m) _Pragma("unroll") for (int n = 0; n < 2; ++n) \
            mfma8(acc[ai][bj][m][n], cat8(Bt[n][0], Bt[n][1]), cat8(At[m][0], At[m][1]), g.sb, g.sa); } \
        else { _Pragma("unroll") for (int m = 0; m < 4; ++m) _Pragma("unroll") for (int n = 0; n < 2; ++n) _Pragma("unroll") for (int k = 0; k < 2; ++k) \
            acc[ai][bj][m][n] = __builtin_amdgcn_mfma_f32_16x16x32_bf16(Bt[n][k], At[m][k], acc[ai][bj][m][n], 0, 0, 0); } \
        __builtin_amdgcn_s_setprio(0); } } while (0)
#define PG8_WAIT_V(n) asm volatile("s_waitcnt vmcnt(" #n ")" ::: "memory")
#define PG8_WAIT_VP() do { if constexpr (PF) asm volatile("s_waitcnt vmcnt(9)" ::: "memory"); else asm volatile("s_waitcnt vmcnt(8)" ::: "memory"); } while (0)
#define PG8_PREFETCH(tp) do { if constexpr (PF) { const int tp_ = (tp); const char* pb_ = tp_ < nt ? (pfA ? cA : cB) + (size_t)tp_ * kstep : (pfA ? nA : nB) + (size_t)(tp_ - nt) * kstep; \
        __builtin_amdgcn_global_load_lds((const unsigned*)(pb_ + pfoff), (PG8_LAS unsigned*)(lds + PF_LDS + wid * 256), 4, 0, 0); } } while (0)
#define PG8_WAIT_L(n) asm volatile("s_waitcnt lgkmcnt(" #n ")" ::: "memory")
#define PG8_BAR __builtin_amdgcn_s_barrier()
#define PG8_SCHED __builtin_amdgcn_sched_barrier(0)
    Unit cur, nxt; int ui = 0;
    if (!S.next(0, cur)) return;
    f32x4 acc[2][2][4][2];
#pragma unroll
    for (int a = 0; a < 2; ++a)
#pragma unroll
        for (int b = 0; b < 2; ++b)
#pragma unroll
            for (int m = 0; m < 4; ++m)
#pragma unroll
                for (int n = 0; n < 2; ++n) acc[a][b][m][n] = (f32x4){0.f, 0.f, 0.f, 0.f};
    bf16x8 At[4][2], B0[2][2], B1[2][2];
    const char* cA = S.a_base(g, cur); const char* cB = S.b_base(g, cur);
    if constexpr (Sched::GATHER) { const unsigned* rp = S.rows(cur); const int nv = S.nvalid(cur);
#pragma unroll
        for (int h = 0; h < 2; ++h)
#pragma unroll
            for (int i = 0; i < 2; ++i) { int R, C; stage_rc(tid * 16 + i * 8192, R, C); const int r = h * HALF + R; const unsigned tok = r < nv ? rp[r] : 0u; gC[h][i] = tok * (unsigned)(g.lda * 2) + (unsigned)C * 2u; } }
    S.a_ready(cur);
    if constexpr (SP2) {
        PG8_STAGE(PG8_SB(0, 0), cB, voffB); PG8_STAGE(PG8_SB(0, 1), cB + hstepB, voffB); PG8_STAGE_A(PG8_SA(0, 0), cA, 0, 0); PG8_STAGE_A(PG8_SA(0, 1), cA, 1, 0);
        if (wr == 1) PG8_BAR;
        PG8_WAIT_V(2); PG8_BAR;
        PG8_STAGE(PG8_SB(1, 0), cB + kstep, voffB); PG8_STAGE_A(PG8_SA(1, 0), cA + kstep, 0, 0); PG8_STAGE(PG8_SB(1, 1), cB + hstepB + kstep, voffB);
        PG8_WAIT_V(6); PG8_BAR;
    } else {
        PG8_STAGE(PG8_SB(0, 0), cB, voffB); PG8_STAGE_A(PG8_SA(0, 0), cA, 0, 0); PG8_STAGE(PG8_SB(0, 1), cB + hstepB, voffB); PG8_STAGE_A(PG8_SA(0, 1), cA, 1, 0);
        if (wr == 1) PG8_BAR;
        PG8_WAIT_V(4); PG8_BAR;
        PG8_STAGE(PG8_SB(1, 0), cB + kstep, voffB); PG8_STAGE_A(PG8_SA(1, 0), cA + kstep, 0, 0); PG8_STAGE(PG8_SB(1, 1), cB + hstepB + kstep, voffB);
        PG8_WAIT_V(6); PG8_BAR;
    }
    for (;;) {
        const bool has_next = S.next(ui + 1, nxt);
        const char* nA = has_next ? S.a_base(g, nxt) : cA; const char* nB = has_next ? S.b_base(g, nxt) : cB;
        if constexpr (Sched::GATHER) { if (has_next && wid < 4)
            __builtin_amdgcn_global_load_lds((const unsigned*)(S.rows(nxt) + wid * 64 + lane), (PG8_LAS unsigned*)(S.gslot + ((ui + 1) & 1) * 256 + wid * 64), 4, 0, 0); }
#pragma nounroll
        for (int t = 0; t < nt; t += 2) {
            const bool last = (t == nt - 2);
            const char* a1 = cA + (size_t)(t + 1) * kstep;
            const char* a2 = last ? nA : cA + (size_t)(t + 2) * kstep; const char* b2 = last ? nB : cB + (size_t)(t + 2) * kstep;
            const char* a3 = a2 + kstep; const char* b3 = b2 + kstep;
            if (last && has_next) S.a_ready(nxt);
            if constexpr (SP2) {
            PG8_LDB(B0, 0, 0); PG8_LDB(B1, 0, 1); PG8_SCHED; PG8_LDA(At, 0, 0); PG8_STAGE_A(PG8_SA(1, 1), a1, 1, 0);
            if constexpr (Sched::GATHER) { if (last && has_next) {
                const PG8_LAS unsigned* sl = S.gslot + ((ui + 1) & 1) * 256; const int nv = S.nvalid(nxt);
#pragma unroll
                for (int h = 0; h < 2; ++h)
#pragma unroll
                    for (int i = 0; i < 2; ++i) { int R, C; stage_rc(tid * 16 + i * 8192, R, C); const int r = h * HALF + R; const unsigned v = sl[r]; const unsigned tok = r < nv ? v : 0u; gC[h][i] = tok * (unsigned)(g.lda * 2) + (unsigned)C * 2u; } } }
            PG8_WAIT_VP(); PG8_WAIT_L(0); PG8_BAR; PG8_MMA(0, 0, At, B0); PG8_MMA(0, 1, At, B1); PG8_BAR; PG8_SCHED;
            PG8_LDA(At, 0, 1); PG8_STAGE(PG8_SB(0, 0), b2, voffB); PG8_STAGE(PG8_SB(0, 1), b2 + hstepB, voffB); PG8_STAGE_A(PG8_SA(0, 0), a2, 0, 1); PG8_PREFETCH(t + PF_D);
            PG8_WAIT_VP(); PG8_WAIT_L(0); PG8_BAR; PG8_MMA(1, 0, At, B0); PG8_MMA(1, 1, At, B1); PG8_BAR; PG8_SCHED;
            PG8_LDB(B0, 1, 0); PG8_LDB(B1, 1, 1); PG8_SCHED; PG8_LDA(At, 1, 0); PG8_STAGE_A(PG8_SA(0, 1), a2, 1, 1);
            PG8_WAIT_VP(); PG8_WAIT_L(0); PG8_BAR; PG8_MMA(0, 0, At, B0); PG8_MMA(0, 1, At, B1); PG8_BAR; PG8_SCHED;
            PG8_LDA(At, 1, 1); PG8_STAGE(PG8_SB(1, 0), b3, voffB); PG8_STAGE(PG8_SB(1, 1), b3 + hstepB, voffB); PG8_STAGE_A(PG8_SA(1, 0), a3, 0, 1); PG8_PREFETCH(t + 1 + PF_D);
            PG8_WAIT_VP(); PG8_WAIT_L(0); PG8_BAR; PG8_MMA(1, 0, At, B0); PG8_MMA(1, 1, At, B1); PG8_BAR; PG8_SCHED;
            } else {
            PG8_LDB(B0, 0, 0); PG8_SCHED; PG8_LDA(At, 0, 0); PG8_STAGE_A(PG8_SA(1, 1), a1, 1, 0);
            PG8_WAIT_L(8); PG8_BAR; PG8_WAIT_L(0); PG8_MMA(0, 0, At, B0); PG8_BAR; PG8_SCHED;
            PG8_LDB(B1, 0, 1); PG8_STAGE(PG8_SB(0, 0), b2, voffB);
            PG8_BAR; PG8_WAIT_L(0); PG8_MMA(0, 1, At, B1); PG8_BAR;
            PG8_LDA(At, 0, 1); PG8_STAGE_A(PG8_SA(0, 0), a2, 0, 1);
            PG8_BAR; PG8_WAIT_L(0); PG8_MMA(1, 0, At, B0); PG8_BAR; PG8_SCHED;
            PG8_STAGE(PG8_SB(0, 1), b2 + hstepB, voffB);
            PG8_WAIT_V(6); PG8_BAR; PG8_MMA(1, 1, At, B1); PG8_BAR;
            PG8_LDB(B0, 1, 0); PG8_SCHED; PG8_LDA(At, 1, 0); PG8_STAGE_A(PG8_SA(0, 1), a2, 1, 1);
            PG8_WAIT_L(8); PG8_BAR; PG8_WAIT_L(0); PG8_MMA(0, 0, At, B0); PG8_BAR; PG8_SCHED;
            PG8_LDB(B1, 1, 1); PG8_STAGE(PG8_SB(1, 0), b3, voffB);
            PG8_BAR; PG8_WAIT_L(0); PG8_MMA(0, 1, At, B1); PG8_BAR;
            PG8_LDA(At, 1, 1); PG8_STAGE_A(PG8_SA(1, 0), a3, 0, 1);
            PG8_BAR; PG8_WAIT_L(0); PG8_MMA(1, 0, At, B0); PG8_BAR; PG8_SCHED;
            PG8_STAGE(PG8_SB(1, 1), b3 + hstepB, voffB);
            PG8_WAIT_V(6); PG8_BAR; PG8_MMA(1, 1, At, B1); PG8_BAR;
            }
        }
        if constexpr (ALIGN_EPI) { if (wr == 0) PG8_BAR; }
        if constexpr (FP8) asm volatile("s_nop 15\n\ts_nop 15" ::: "memory");
        if constexpr (!Epi::AFTER_DRAIN && (DBG & 4) == 0) { E(acc, cur, wr, wc, fr, fq); S.done(cur); }
        if (!has_next) break;
#pragma unroll
        for (int a = 0; a < 2; ++a)
#pragma unroll
            for (int b = 0; b < 2; ++b)
#pragma unroll
                for (int m = 0; m < 4; ++m)
#pragma unroll
                    for (int n = 0; n < 2; ++n) acc[a][b][m][n] = (f32x4){0.f, 0.f, 0.f, 0.f};
        cur = nxt; cA = nA; cB = nB; ++ui;
        if constexpr (ALIGN_EPI) { if (wr == 1) PG8_BAR; }
    }
    PG8_WAIT_V(0);
    if constexpr (!ALIGN_EPI) { if (wr == 0) PG8_BAR; }
    PG8_BAR;
    if constexpr (Epi::AFTER_DRAIN) { E.fused(acc, cur, wr, wc, fr, fq, lds, wid, lane); S.done(cur); }
#undef PG8_SA
#undef PG8_SB
#undef PG8_STAGE
#undef PG8_STAGE_A
#undef PG8_LDA
#undef PG8_LDB
#undef PG8_MMA
#undef PG8_WAIT_V
#undef PG8_WAIT_VP
#undef PG8_PREFETCH
#undef PG8_WAIT_L
#undef PG8_BAR
#undef PG8_SCHED
}
}
constexpr int NTOK = 32768, DM = 1024, SEQ = 2048, NBATCH = 16, MEMLEN = 256, NMEM = NBATCH * MEMLEN, INW = 3088, NEXP = 32, TOPK = 4;
constexpr int PW = 3072;
constexpr int MAXTILES = 544;
constexpr float EPS = 1e-6f;
constexpr int NWAVES = 8;
constexpr size_t MiB = 1u << 20;
constexpr size_t WS_CTL = 0, CTL_ZERO_BYTES = 64 * 1024;
constexpr size_t WS_WINT = 2 * MiB, WS_WOUT = 10 * MiB, WS_WCQ = 12 * MiB, WS_WCK = 14 * MiB, WS_WCV = 16 * MiB, WS_WCO = 18 * MiB;
constexpr size_t WS_WR = 20 * MiB, WS_CS = 21 * MiB, WS_SSP1 = 24 * MiB, WS_GATE = 27 * MiB, WS_ASSIGN = 28 * MiB, WS_LIST = 29 * MiB;
constexpr size_t WS_RSL = 842 * MiB;
constexpr size_t WS_X2B = 378 * MiB;
constexpr size_t WS_WUP = 34 * MiB, WS_WDN = 162 * MiB, WS_KX = 226 * MiB, WS_VXT = 234 * MiB;
constexpr size_t WS_HN = 242 * MiB, WS_CAT = 242 * MiB, WS_MN = 306 * MiB, WS_P = 314 * MiB, WS_LA = 506 * MiB, WS_VT = 538 * MiB;
constexpr size_t WS_X1B = 314 * MiB, WS_GT = 378 * MiB, WS_HT = 410 * MiB, WS_PX = 506 * MiB;
constexpr size_t WS_GVT = 602 * MiB;
constexpr size_t WS_ACT = 570 * MiB, WS_Y = 706 * MiB, WS_END = 846 * MiB;
constexpr int CW_Q2 = 128;
constexpr int CW_CNT = 1024;
constexpr int CW_PROBE = 192;
constexpr int CW_BAR = 4096;
constexpr int RING_OFF = 0, RING_BYTES = 131072;
constexpr int LDSCTL_OFF = RING_BYTES, MISC_OFF = LDSCTL_OFF + 320;
constexpr int TAB_OFF = LDSCTL_OFF + 512;
constexpr int TAB_TSTART = TAB_OFF + 576, TAB_CNT = TAB_TSTART + 144;
constexpr int XCH2_OFF = LDSCTL_OFF + 6144;
constexpr int XCH_OFF = LDSCTL_OFF + 2048;
constexpr int TS_OFF = TAB_CNT + 128;
constexpr int LDS_BYTES = 147456;

#define GAS __attribute__((address_space(1)))
#define LAS __attribute__((address_space(3)))
typedef unsigned short bf16;
typedef unsigned v4u __attribute__((ext_vector_type(4)));
typedef float f32x4 __attribute__((ext_vector_type(4)));
typedef short bf16x8 __attribute__((ext_vector_type(8)));
typedef GAS unsigned gu32;
typedef GAS unsigned long long gu64;
#define RLX_AGENT __ATOMIC_RELAXED, __HIP_MEMORY_SCOPE_AGENT
#define LDS_WAIT() asm volatile("s_waitcnt lgkmcnt(0)" ::: "memory")
#define VM_WAIT() asm volatile("s_waitcnt vmcnt(0)" ::: "memory")
__device__ __forceinline__ unsigned long long rt() { return __builtin_amdgcn_s_memrealtime(); }
__device__ __forceinline__ unsigned f2bf(float f) { unsigned u = __builtin_bit_cast(unsigned, f); return (u + 0x7fffu + ((u >> 16) & 1u)) >> 16; }
__device__ __forceinline__ unsigned pk2(float lo, float hi) { return f2bf(lo) | (f2bf(hi) << 16); }

#define XB_TMO      128
#define XB_XCNT(j)  (256  + 64 * (j))
#define XB_XSUB(j)  (1280 + 64 * (j))
#define XB_XGEN(j)  (2304 + 64 * (j))
#define XB_TOP      3328
#define XB_TOPGEN   3392
#define XCD_BAR_WORDS 3456
#define XB_SPIN_CAP (1u << 18)

__device__ __forceinline__ unsigned xb_ld(unsigned* p)              { return __hip_atomic_load(p, __ATOMIC_RELAXED, __HIP_MEMORY_SCOPE_AGENT); }
__device__ __forceinline__ unsigned xb_add(unsigned* p, unsigned v) { return __hip_atomic_fetch_add(p, v, __ATOMIC_RELAXED, __HIP_MEMORY_SCOPE_AGENT); }
__device__ __forceinline__ unsigned xb_xcc_id() { return (unsigned)__builtin_amdgcn_s_getreg((3 << 11) | 20) & 0xFu; }
#define XB_SPIN(cond, bar) do { unsigned _sp = 0; while (cond) { __builtin_amdgcn_s_sleep(1); \
    if ((++_sp & 255u) == 0u) { if (xb_ld(&(bar)[XB_TMO])) break; if (_sp > XB_SPIN_CAP) { atomicAdd(&(bar)[XB_TMO], 1u); break; } } } } while (0)

struct XcdBarrier {
    unsigned* bar; unsigned x;
    volatile LAS unsigned* st;
};

__device__ __forceinline__ XcdBarrier xcd_barrier_post(unsigned* bar, volatile LAS unsigned* st) {
    XcdBarrier b; b.bar = bar; b.x = xb_xcc_id(); b.st = st;
    if (threadIdx.x == 0) (void)xb_add(&bar[XB_XCNT(b.x)], 1u);
    return b;
}
__device__ __forceinline__ void xcd_barrier_complete(unsigned* bar, unsigned x, unsigned& nloc, unsigned& nx) {
    const unsigned G = gridDim.x * gridDim.y * gridDim.z;
    unsigned sum, cnt, mine, sp = 0u;
    for (;;) {
        sum = 0u; cnt = 0u; mine = 0u;
#pragma unroll
        for (unsigned j = 0; j < 16; ++j) { const unsigned c = xb_ld(&bar[XB_XCNT(j)]); sum += c; cnt += (c > 0u) ? 1u : 0u; mine = (j == x) ? c : mine; }
        if (sum == G) break;
        __builtin_amdgcn_s_sleep(1);
        if ((++sp & 255u) == 0u) { if (xb_ld(&bar[XB_TMO])) break; if (sp > XB_SPIN_CAP) { atomicAdd(&bar[XB_TMO], 1u); break; } }
    }
    nloc = mine > 0u ? mine : 1u; nx = cnt > 0u ? cnt : 1u;
}

__device__ __forceinline__ void xcd_barrier(const XcdBarrier& b) {
    asm volatile("s_waitcnt vmcnt(0)" ::: "memory");
    __syncthreads();
    if (threadIdx.x == 0) {
        unsigned* bar = b.bar;
        __builtin_amdgcn_s_waitcnt(0);
        unsigned nloc = b.st[0], nx = b.st[1];
        if (nloc == 0u) { xcd_barrier_complete(bar, b.x, nloc, nx); b.st[0] = nloc; b.st[1] = nx; }
        const unsigned old = xb_add(&bar[XB_XSUB(b.x)], 1u);
        const unsigned gen = old / nloc;
        if (old + 1u == (gen + 1u) * nloc) {
            __builtin_amdgcn_fence(__ATOMIC_RELEASE, "agent");
            asm volatile("s_waitcnt vmcnt(0)" ::: "memory");
            const unsigned og = xb_add(&bar[XB_TOP], 1u);
            const unsigned tg = og / nx;
            if (og + 1u == (tg + 1u) * nx) xb_add(&bar[XB_TOPGEN], 1u);
            else XB_SPIN(xb_ld(&bar[XB_TOPGEN]) == tg, bar);
            __builtin_amdgcn_fence(__ATOMIC_ACQUIRE, "agent");
            xb_add(&bar[XB_XGEN(b.x)], 1u);
            asm volatile("s_waitcnt vmcnt(0)" ::: "memory");
        } else {
            XB_SPIN(xb_ld(&bar[XB_XGEN(b.x)]) == gen, bar);
            __builtin_amdgcn_fence(__ATOMIC_ACQUIRE, "agent");
            asm volatile("s_waitcnt vmcnt(0)" ::: "memory");
        }
    }
    __syncthreads();
}
typedef short bf16x4 __attribute__((ext_vector_type(4)));
typedef unsigned v2u __attribute__((ext_vector_type(2)));
struct Frame {
    LAS unsigned char* lds;
    volatile LAS unsigned* MISC;
    gu32* ctl;
    int tid, lane, wave;
    int vcu, G;
    unsigned char* ws;
    float* out;
};
__device__ __forceinline__ int lane_here() { int t = (int)threadIdx.x; asm volatile("" : "+v"(t)); return t & 63; }
__device__ __forceinline__ float bf2f(bf16 b) { return __builtin_bit_cast(float, (unsigned)b << 16); }
__device__ __forceinline__ float wave_sum(float v) {
#pragma unroll
    for (int o = 1; o < 64; o <<= 1) v += __shfl_xor(v, o);
    return v;
}
__device__ __forceinline__ float xmax16(float m) { auto rr = __builtin_amdgcn_permlane16_swap(__float_as_uint(m), __float_as_uint(m), false, false); return fmaxf(__uint_as_float(rr[0]), __uint_as_float(rr[1])); }
__device__ __forceinline__ float xmax32(float m) { auto rr = __builtin_amdgcn_permlane32_swap(__float_as_uint(m), __float_as_uint(m), false, false); return fmaxf(__uint_as_float(rr[0]), __uint_as_float(rr[1])); }
__device__ __forceinline__ f32x4 mfma16(bf16x8 a, bf16x8 b, f32x4 c) { return __builtin_amdgcn_mfma_f32_16x16x32_bf16(a, b, c, 0, 0, 0); }

__device__ __forceinline__ void p0_transpose_item(const float* W, int ldw, const float* gain, bf16* WT, int K, int k0, int n0, size_t orow0, int lane) {
    const int n4 = lane & 15, kq = lane >> 4;
    const float* src = W + (size_t)(k0 + 16 * kq) * ldw + n0 + 4 * n4;
    f32x4 v[16];
#pragma unroll
    for (int i = 0; i < 16; ++i) v[i] = __builtin_nontemporal_load((const f32x4*)(src + (size_t)i * ldw));
    if (gain) { const f32x4* gp = (const f32x4*)(gain + k0 + 16 * kq);
#pragma unroll
        for (int q = 0; q < 4; ++q) { const f32x4 gq = gp[q];
#pragma unroll
            for (int r = 0; r < 4; ++r) v[4 * q + r] = v[4 * q + r] * gq[r]; } }
    bf16* dst = WT + (orow0 + 4 * n4) * (size_t)K + k0 + 16 * kq;
#pragma unroll
    for (int j = 0; j < 4; ++j) { v4u o0, o1;
        o0.x = pg8::cvtpk(v[0][j], v[1][j]); o0.y = pg8::cvtpk(v[2][j], v[3][j]); o0.z = pg8::cvtpk(v[4][j], v[5][j]); o0.w = pg8::cvtpk(v[6][j], v[7][j]);
        o1.x = pg8::cvtpk(v[8][j], v[9][j]); o1.y = pg8::cvtpk(v[10][j], v[11][j]); o1.z = pg8::cvtpk(v[12][j], v[13][j]); o1.w = pg8::cvtpk(v[14][j], v[15][j]);
        *(v4u*)(dst + (size_t)j * K) = o0; *(v4u*)(dst + (size_t)j * K + 8) = o1; }
}
__device__ __forceinline__ void p0_transpose_item8(const float* W, int ldw, const float* gain, unsigned char* WT, int K, int k0, int n0, size_t orow0, int lane) {
    const int n4 = lane & 15, kq = lane >> 4;
    const float* src = W + (size_t)(k0 + 16 * kq) * ldw + n0 + 4 * n4;
    f32x4 v[16];
#pragma unroll
    for (int i = 0; i < 16; ++i) v[i] = __builtin_nontemporal_load((const f32x4*)(src + (size_t)i * ldw));
    { const f32x4* gp = (const f32x4*)(gain + k0 + 16 * kq);
#pragma unroll
        for (int q = 0; q < 4; ++q) { f32x4 gq = {32.f, 32.f, 32.f, 32.f}; if (gain) gq = gp[q] * 32.0f;
#pragma unroll
            for (int r = 0; r < 4; ++r) v[4 * q + r] = v[4 * q + r] * gq[r]; } }
    unsigned char* dst = WT + (orow0 + 4 * n4) * (size_t)K + k0 + 16 * kq;
#pragma unroll
    for (int j = 0; j < 4; ++j) { v4u o;
        o.x = pg8::cvt4_fp8((f32x4){v[0][j], v[1][j], v[2][j], v[3][j]}); o.y = pg8::cvt4_fp8((f32x4){v[4][j], v[5][j], v[6][j], v[7][j]});
        o.z = pg8::cvt4_fp8((f32x4){v[8][j], v[9][j], v[10][j], v[11][j]}); o.w = pg8::cvt4_fp8((f32x4){v[12][j], v[13][j], v[14][j], v[15][j]});
        *(v4u*)(dst + (size_t)j * K) = o; }
}
template <int NR> __device__ __forceinline__ void rms_rows_to_bf16(const float* const (&xrow)[NR], const float* g, bf16* const (&orow)[NR], int lane) {
    f32x4 v[NR][4]; float s[NR];
#pragma unroll
    for (int r = 0; r < NR; ++r) { const f32x4* xr = (const f32x4*)xrow[r] + lane;
#pragma unroll
        for (int j = 0; j < 4; ++j) v[r][j] = __builtin_nontemporal_load(xr + 64 * j); }
    const f32x4* gr = (const f32x4*)g + lane; f32x4 gg[4];
#pragma unroll
    for (int j = 0; j < 4; ++j) gg[j] = gr[64 * j];
#pragma unroll
    for (int r = 0; r < NR; ++r) { s[r] = 0.f;
#pragma unroll
        for (int j = 0; j < 4; ++j) s[r] += (v[r][j].x * v[r][j].x + v[r][j].y * v[r][j].y) + (v[r][j].z * v[r][j].z + v[r][j].w * v[r][j].w); }
#pragma unroll
    for (int r = 0; r < NR; ++r) { const float rs = rsqrtf(wave_sum(s[r]) * (1.0f / DM) + EPS); unsigned long long* o8 = (unsigned long long*)orow[r] + lane;
#pragma unroll
        for (int j = 0; j < 4; ++j) o8[64 * j] = (unsigned long long)pk2(v[r][j].x * rs * gg[j].x, v[r][j].y * rs * gg[j].y) | ((unsigned long long)pk2(v[r][j].z * rs * gg[j].z, v[r][j].w * rs * gg[j].w) << 32); }
}
constexpr int MOE_I_UP = 32 * 16 * 32, MOE_I_DN = 32 * 16 * 16, MOE_UNITS = (MOE_I_UP + MOE_I_DN) / 64;
__device__ __forceinline__ void moe_convert_unit(int unit, const float* w_up, const float* w_down, const float* g_ffn, unsigned char* ws, int wave, int lane) {
#pragma unroll 1
    for (int j = 0; j < 8; ++j) { int r = unit * 64 + j * 8 + wave;
        if (r < MOE_I_UP) { const int e = r / (16 * 32); r -= e * (16 * 32); const int n0 = 64 * (r % 32);
            const size_t orow = (size_t)e * 2048 + ((n0 & 1023) >> 7) * 256 + (n0 >> 10) * 128 + (n0 & 127);
            p0_transpose_item8(w_up + (size_t)e * DM * 2048, 2048, g_ffn, ws + WS_WUP, DM, 64 * (r / 32), n0, orow, lane); }
        else { r -= MOE_I_UP; const int e = r / (16 * 16); r -= e * (16 * 16);
            p0_transpose_item8(w_down + (size_t)e * DM * DM, DM, nullptr, ws + WS_WDN, DM, 64 * (r / 16), 64 * (r % 16), (size_t)e * 1024 + 64 * (r % 16), lane); } }
}
struct In {
    const float *x, *mem; const int* positions; const float *norm_mix_g, *w_in, *lq1, *lk1, *lq2, *lk2, *diff_norm_g, *w_alpha2, *b_alpha, *gla_norm_g, *w_out, *norm_cross_g, *norm_mem_g,
        *w_cq, *w_ck, *w_cv, *w_co, *norm_ffn_g, *w_router, *b_router, *w_up, *b_up, *w_down, *b_down, *norm_final_g;
};
__device__ __forceinline__ void p0_prologue(Frame& F, const In& I) {
    const int gw = F.vcu * NWAVES + F.wave, NGW = F.G * NWAVES, lane = lane_here();
    unsigned char* ws = F.ws;
    constexpr int I_IN = 16 * 48, I_SQ = 16 * 16;
    constexpr int NITEMS = I_IN + 4 * I_SQ;
    for (int it = gw; it < NITEMS; it += NGW) {
        int r = it;
        if (r < I_IN) { p0_transpose_item(I.w_in, INW, nullptr, (bf16*)(ws + WS_WINT), DM, 64 * (r / 48), 64 * (r % 48), (size_t)64 * (r % 48), lane); continue; } r -= I_IN;
        { const int w = r / I_SQ; r -= w * I_SQ;
            const float* W = w == 0 ? I.w_out : w == 1 ? I.w_ck : w == 2 ? I.w_cv : I.w_co;
            bf16* WT = (bf16*)(ws + (w == 0 ? WS_WOUT : w == 1 ? WS_WCK : w == 2 ? WS_WCV : WS_WCO));
            p0_transpose_item(W, DM, nullptr, WT, DM, 64 * (r / 16), 64 * (r % 16), (size_t)64 * (r % 16), lane); }
    }
    for (int idx = F.vcu * (NWAVES * 64) + F.tid; idx < DM * DM / 4; idx += F.G * NWAVES * 64) { const f32x4 v = ((const f32x4*)I.w_cq)[idx] * I.norm_cross_g[idx >> 8];
        v2u o; o.x = pk2(v.x, v.y); o.y = pk2(v.z, v.w); ((v2u*)(ws + WS_WCQ))[idx] = o; }
#if defined(PROBE_P0)
    if (F.tid == 0) ((LAS unsigned long long*)(F.lds + TS_OFF))[13] = rt();
#endif
    const int gt = F.vcu * (NWAVES * 64) + F.tid, NGT = F.G * NWAVES * 64;
    for (int idx = gt; idx < 256 * DM; idx += NGT) { const int j = idx >> 10, k = idx & 1023; const float* wr = I.w_in + (size_t)k * INW + 3072; float s = 0.f;
#pragma unroll
        for (int r = 0; r < 16; ++r) s += wr[r] * I.w_alpha2[r * 256 + j];
        ((bf16*)(ws + WS_WINT))[(size_t)(3072 + j) * DM + k] = (bf16)f2bf(s); }
    for (int idx = gt; idx < DM * NEXP; idx += NGT) { const int e = idx >> 10, k = idx & 1023; ((float*)(ws + WS_WR))[idx] = I.w_router[k * NEXP + e] * I.norm_ffn_g[k]; }
    for (int idx = gt; idx < NTOK * 8; idx += NGT) { const int tok = idx >> 3, i = idx & 7;
        const double inv = exp(-(double)i * 0.125 * 13.122363377404328); const double ang = (double)I.positions[tok] * inv;
        const double red = ang - rint(ang * 0.15915494309189535) * 6.283185307179586; const float rf = (float)red;
        float* cs = (float*)(ws + WS_CS) + (size_t)tok * 16; cs[i] = cosf(rf); cs[8 + i] = sinf(rf); }
#if defined(PROBE_P0)
    if (F.tid == 0) ((LAS unsigned long long*)(F.lds + TS_OFF))[14] = rt();
#endif
    for (int m = gw * 4; m < NTOK; m += NGW * 4) { const float* xr[4]; bf16* orw[4];
#pragma unroll
        for (int r = 0; r < 4; ++r) { xr[r] = I.x + (size_t)(m + r) * DM; orw[r] = (bf16*)(ws + WS_HN) + (size_t)(m + r) * DM; }
        rms_rows_to_bf16<4>(xr, I.norm_mix_g, orw, lane); }
    for (int m = gw * 4; m < NMEM; m += NGW * 4) { const float* xr[4]; bf16* orw[4];
#pragma unroll
        for (int r = 0; r < 4; ++r) { xr[r] = I.mem + (size_t)(m + r) * DM; orw[r] = (bf16*)(ws + WS_MN) + (size_t)(m + r) * DM; }
        rms_rows_to_bf16<4>(xr, I.norm_mem_g, orw, lane); }
}

constexpr int DA_KBUF = 16384, DA_VBUF = 16384, DA_VOFF = 2 * DA_KBUF;
template <int DBG = 0> __device__ __forceinline__ void diffattn_unit(Frame& F, const bf16* P, const bf16* VT, bf16* CAT, const float* gdiff, float lam, int b, int h, int qblk) {
    const int lane = lane_here(), wave = F.wave, tid = F.tid, l15 = lane & 15, g = lane >> 4;
    LAS unsigned char* lds = F.lds + RING_OFF;
    const int q0 = qblk * 128 + wave * 16;
    const size_t tokq = (size_t)b * SEQ + q0 + l15;
    bf16x8 qf[2][2];
#pragma unroll
    for (int c = 0; c < 2; ++c)
#pragma unroll
        for (int ks = 0; ks < 2; ++ks) qf[c][ks] = *(const bf16x8*)(P + tokq * PW + h * 128 + c * 64 + ks * 32 + g * 8);
    f32x4 o[2][8];
#pragma unroll
    for (int c = 0; c < 2; ++c)
#pragma unroll
        for (int k = 0; k < 8; ++k) o[c][k] = (f32x4){0.f, 0.f, 0.f, 0.f};
    float mrun[2] = {0.f, 0.f}, lsum[2] = {0.f, 0.f};
    const int nk = q0 + 16;
    const int nt = 2 * qblk + 2;
    const int skey = tid >> 4, sch = tid & 15, vrow = tid >> 3, vpc = tid & 7;
    const bf16* ksrc = P + ((size_t)b * SEQ + skey) * PW + 512 + h * 128 + sch * 8;
    const bf16* vsrc = VT + (size_t)(h * 128 + vrow) * NTOK + (size_t)b * SEQ + vpc * 8;
    const int kdst = skey * 256 + ((sch ^ (skey & 15)) * 16);
    const int vfr = (vrow >> 1) & 7, vch = (vpc >> 2) * 4 + 2 * (vpc & 1), vhi = ((vpc & 3) >> 1) * 8;
    const int vdst0 = DA_VOFF + vrow * 128 + ((vch ^ vfr) * 16) + vhi, vdst1 = DA_VOFF + vrow * 128 + (((vch + 1) ^ vfr) * 16) + vhi;
    int koff[2][2];
#pragma unroll
    for (int c = 0; c < 2; ++c)
#pragma unroll
        for (int ks = 0; ks < 2; ++ks) koff[c][ks] = l15 * 256 + (((c * 8 + ks * 4 + g) ^ l15) * 16);
    const int voffs[2] = {DA_VOFF + l15 * 128 + ((g ^ (l15 >> 1)) * 16), DA_VOFF + l15 * 128 + (((4 + g) ^ (l15 >> 1)) * 16)};
    v4u sk0, sk1, sv0, sv1;
#define DA_LOAD(tt) do { const bf16* kp_ = ksrc + (size_t)(tt) * 64 * PW; const bf16* vp_ = vsrc + (tt) * 64; \
        sk0 = *(const v4u*)kp_; sk1 = *(const v4u*)(kp_ + (size_t)32 * PW); sv0 = *(const v4u*)vp_; sv1 = *(const v4u*)(vp_ + (size_t)64 * NTOK); } while (0)
#define DA_STORE(bb) do { LAS unsigned char* kd_ = lds + (bb) * DA_KBUF + kdst; LAS unsigned char* vd_ = lds + (bb) * DA_VBUF; \
        *(LAS v4u*)kd_ = sk0; *(LAS v4u*)(kd_ + 8192) = sk1; \
        *(LAS v2u*)(vd_ + vdst0) = (v2u){sv0.x, sv0.y}; *(LAS v2u*)(vd_ + vdst1) = (v2u){sv0.z, sv0.w}; *(LAS v2u*)(vd_ + vdst0 + 8192) = (v2u){sv1.x, sv1.y}; *(LAS v2u*)(vd_ + vdst1 + 8192) = (v2u){sv1.z, sv1.w}; } while (0)
    DA_LOAD(0); DA_STORE(0);
    __syncthreads();
    auto step = [&](const int t, const int buf) __attribute__((always_inline)) {
        if (t * 64 < nk) {
            const LAS unsigned char* kb = lds + buf * DA_KBUF; const LAS unsigned char* vb = lds + buf * DA_VBUF;
            f32x4 s[2][2][2];
#pragma unroll
            for (int sub = 0; sub < 2; ++sub)
#pragma unroll
                for (int c = 0; c < 2; ++c)
#pragma unroll
                    for (int s2 = 0; s2 < 2; ++s2) { f32x4 a = (f32x4){-mrun[c], -mrun[c], -mrun[c], -mrun[c]};
#pragma unroll
                        for (int ks = 0; ks < 2; ++ks) { const bf16x8 kf = (DBG & 2) ? qf[c][ks ^ 1] : *(const LAS bf16x8*)(kb + sub * 8192 + s2 * 4096 + koff[c][ks]); if constexpr ((DBG & 1) == 0) a = mfma16(kf, qf[c][ks], a); else a[ks] += __builtin_bit_cast(float, (int)kf[0] << 16); }
                        s[sub][c][s2] = a; }
            if (t * 64 + 63 > q0) {
                const int qrow = q0 + l15;
#pragma unroll
                for (int sub = 0; sub < 2; ++sub)
#pragma unroll
                    for (int c = 0; c < 2; ++c)
#pragma unroll
                        for (int s2 = 0; s2 < 2; ++s2)
#pragma unroll
                            for (int r = 0; r < 4; ++r) if (t * 64 + sub * 32 + s2 * 16 + 4 * g + r > qrow) s[sub][c][s2][r] = -INFINITY;
            }
            float dl[2]; bool grow = false;
#pragma unroll
            for (int c = 0; c < 2; ++c) { float mx = -INFINITY;
#pragma unroll
                for (int sub = 0; sub < 2; ++sub)
#pragma unroll
                    for (int s2 = 0; s2 < 2; ++s2) mx = fmaxf(mx, fmaxf(fmaxf(s[sub][c][s2][0], s[sub][c][s2][1]), fmaxf(s[sub][c][s2][2], s[sub][c][s2][3])));
                mx = xmax16(mx); mx = xmax32(mx);
                dl[c] = (t == 0 || mx > 8.0f) ? mx : 0.f; grow = grow || (dl[c] != 0.f); }
            if (__any(grow)) {
#pragma unroll
                for (int c = 0; c < 2; ++c) { const float alpha = __builtin_amdgcn_exp2f(-dl[c]); mrun[c] += dl[c]; lsum[c] *= alpha;
#pragma unroll
                    for (int k = 0; k < 8; ++k) o[c][k] = o[c][k] * alpha;
#pragma unroll
                    for (int sub = 0; sub < 2; ++sub)
#pragma unroll
                        for (int s2 = 0; s2 < 2; ++s2)
#pragma unroll
                            for (int r = 0; r < 4; ++r) s[sub][c][s2][r] -= dl[c]; }
            }
#pragma unroll
            for (int sub = 0; sub < 2; ++sub) {
                bf16x8 pb[2];
#pragma unroll
                for (int c = 0; c < 2; ++c) { float ps = 0.f;
#pragma unroll
                    for (int s2 = 0; s2 < 2; ++s2)
#pragma unroll
                        for (int r = 0; r < 4; ++r) { const float p = (DBG & 4) ? s[sub][c][s2][r] * 0.001f : __builtin_amdgcn_exp2f(s[sub][c][s2][r]); s[sub][c][s2][r] = p; ps += p; }
                    lsum[c] += ps;
                    v4u w; w.x = pg8::cvtpk(s[sub][c][0][0], s[sub][c][0][1]); w.y = pg8::cvtpk(s[sub][c][0][2], s[sub][c][0][3]); w.z = pg8::cvtpk(s[sub][c][1][0], s[sub][c][1][1]); w.w = pg8::cvtpk(s[sub][c][1][2], s[sub][c][1][3]);
                    pb[c] = __builtin_bit_cast(bf16x8, w); }
#pragma unroll
                for (int k = 0; k < 8; ++k) { const bf16x8 vf = (DBG & 2) ? qf[k & 1][(k >> 1) & 1] : *(const LAS bf16x8*)(vb + voffs[sub] + k * 2048);
                    if constexpr ((DBG & 1) == 0) { o[0][k] = mfma16(vf, pb[0], o[0][k]); o[1][k] = mfma16(vf, pb[1], o[1][k]); }
                    else { o[0][k][0] += __builtin_bit_cast(float, (int)vf[0] << 16) + __builtin_bit_cast(float, (int)pb[0][k] << 16); o[1][k][0] += __builtin_bit_cast(float, (int)pb[1][k] << 16); } }
            }
        }
    };
    for (int t = 0; t < nt; ++t) {
        if ((DBG & 8) == 0 && t + 1 < nt) DA_LOAD(t + 1);
        step(t, t & 1);
        if ((DBG & 8) == 0 && t + 1 < nt) DA_STORE((t & 1) ^ 1);
        __syncthreads();
    }
#undef DA_LOAD
#undef DA_STORE
    float l0 = lsum[0], l1 = lsum[1];
    l0 += __shfl_xor(l0, 16); l0 += __shfl_xor(l0, 32); l1 += __shfl_xor(l1, 16); l1 += __shfl_xor(l1, 32);
    const float i0 = 1.0f / l0, i1 = lam / l1; float ss = 0.f;
#pragma unroll
    for (int k = 0; k < 8; ++k)
#pragma unroll
        for (int r = 0; r < 4; ++r) { const float v = o[0][k][r] * i0 - o[1][k][r] * i1; o[0][k][r] = v; ss += v * v; }
    ss += __shfl_xor(ss, 16); ss += __shfl_xor(ss, 32);
    const float rs = rsqrtf(ss * (1.0f / 128.0f) + EPS) * 0.8f;
    bf16* op = CAT + tokq * DM + h * 128 + 4 * g;
    f32x4 gg[8];
#pragma unroll
    for (int k = 0; k < 8; ++k) gg[k] = *(const f32x4*)(gdiff + k * 16 + 4 * g);
#pragma unroll
    for (int k = 0; k < 8; ++k) { f32x4 v = o[0][k] * rs; v = v * gg[k]; pg8::st_bf4(op + k * 16, v); }
}

__device__ __forceinline__ bf16x8 pack8(const f32x4& a, const f32x4& b) { v4u w; w.x = pg8::cvtpk(a[0], a[1]); w.y = pg8::cvtpk(a[2], a[3]); w.z = pg8::cvtpk(b[0], b[1]); w.w = pg8::cvtpk(b[2], b[3]); return __builtin_bit_cast(bf16x8, w); }
constexpr int GL_QI = 0, GL_KI = 8192, GL_IMG = 16384, GL_EL = 2 * GL_IMG, GL_OB = GL_EL + 512, GL_OBS = 17408, GL_PS = GL_OB + 2 * GL_OBS, GL_END = GL_PS + 4096;

__device__ __forceinline__ void gla_unit(Frame& F, const bf16* P, const float* Bc, const bf16* GVT, bf16* CAT, const float* ggla, int b, int h) {
    const int lane = lane_here(), l15 = lane & 15, g = lane >> 4, eb = F.wave, tid = F.tid;
    LAS unsigned char* lds = F.lds + RING_OFF;
    const f32x4 zero4 = {0.f, 0.f, 0.f, 0.f};
    f32x4 S[4] = {zero4, zero4, zero4, zero4};
    bf16x8 If[4];
#pragma unroll
    for (int db = 0; db < 4; ++db) { const int ks = db >> 1;
#pragma unroll
        for (int j = 0; j < 8; ++j) { const int dp = 32 * ks + (j < 4 ? 4 * g + j : 16 + 4 * g + j - 4); If[db][j] = (dp == 16 * db + l15) ? (short)0x3F80 : (short)0; } }
    const int st = tid >> 3, sp = tid & 7, opc = tid & 15;
    const size_t tokb = (size_t)b * SEQ;
    const bf16* qsrc = P + (tokb + st) * PW + 1536 + h * 64 + sp * 8;
    const float* bsrc = Bc + (tokb + st) * 256 + h * 64 + sp * 8;
    const bf16* Vrow = GVT + (size_t)(h * 128 + 16 * eb + l15) * NTOK + tokb + 4 * g;
    const f32x4 gg0 = *(const f32x4*)(ggla + opc * 8), gg1 = *(const f32x4*)(ggla + opc * 8 + 4);
    const int foffs[2] = {l15 * 128 + ((g ^ (l15 >> 1)) * 16), l15 * 128 + (((4 + g) ^ (l15 >> 1)) * 16)};
    const int sfr = (st >> 1) & 7, sch0 = (sp >> 2) * 4 + 2 * (sp & 1), shi = ((sp & 3) >> 1) * 8, sd0 = st * 128 + ((sch0 ^ sfr) * 16) + shi, sd1 = st * 128 + (((sch0 + 1) ^ sfr) * 16) + shi;
    v4u rq = *(const v4u*)qsrc, rk = *(const v4u*)(qsrc + 256); f32x4 rb0 = *(const f32x4*)bsrc, rb1 = *(const f32x4*)(bsrc + 4);
#define GLA_STAGE(par) do { \
        float ee[8]; _Pragma("unroll") for (int i = 0; i < 4; ++i) { ee[i] = __expf(rb0[i]); ee[4 + i] = __expf(rb1[i]); } \
        const unsigned qa[4] = {rq.x, rq.y, rq.z, rq.w}, ka[4] = {rk.x, rk.y, rk.z, rk.w}; v4u wq, wk; unsigned* wqp = (unsigned*)&wq; unsigned* wkp = (unsigned*)&wk; \
        _Pragma("unroll") for (int i = 0; i < 4; ++i) { const float q0 = __builtin_bit_cast(float, qa[i] << 16), q1 = __builtin_bit_cast(float, qa[i] & 0xffff0000u), k0 = __builtin_bit_cast(float, ka[i] << 16), k1 = __builtin_bit_cast(float, ka[i] & 0xffff0000u); \
            wqp[i] = pg8::cvtpk(q0 * ee[2 * i], q1 * ee[2 * i + 1]); wkp[i] = pg8::cvtpk(k0 * __builtin_amdgcn_rcpf(ee[2 * i]), k1 * __builtin_amdgcn_rcpf(ee[2 * i + 1])); } \
        { LAS unsigned char* ib_ = lds + (par) * GL_IMG; *(LAS v2u*)(ib_ + GL_QI + sd0) = (v2u){wq.x, wq.y}; *(LAS v2u*)(ib_ + GL_QI + sd1) = (v2u){wq.z, wq.w}; *(LAS v2u*)(ib_ + GL_KI + sd0) = (v2u){wk.x, wk.y}; *(LAS v2u*)(ib_ + GL_KI + sd1) = (v2u){wk.z, wk.w}; } \
        if (st == 63) { *(LAS f32x4*)(lds + GL_EL + (par) * 256 + sp * 32) = (f32x4){ee[0], ee[1], ee[2], ee[3]}; *(LAS f32x4*)(lds + GL_EL + (par) * 256 + sp * 32 + 16) = (f32x4){ee[4], ee[5], ee[6], ee[7]}; } } while (0)
    bf16x8 VFn[2];
#pragma unroll
    for (int ss = 0; ss < 2; ++ss) { const bf16* vp = Vrow + 32 * ss; const v2u v0 = *(const v2u*)vp, v1 = *(const v2u*)(vp + 16); v4u vv; vv.x = v0.x; vv.y = v0.y; vv.z = v1.x; vv.w = v1.y; VFn[ss] = __builtin_bit_cast(bf16x8, vv); }
    GLA_STAGE(0);
    __syncthreads();
    for (int c = 0; c < SEQ / 64; ++c) {
        const int par = c & 1; const size_t tok0 = tokb + c * 64;
        if (c + 1 < SEQ / 64) { rq = *(const v4u*)(qsrc + (size_t)(c + 1) * 64 * PW); rk = *(const v4u*)(qsrc + (size_t)(c + 1) * 64 * PW + 256);
            rb0 = *(const f32x4*)(bsrc + (size_t)(c + 1) * 64 * 256); rb1 = *(const f32x4*)(bsrc + (size_t)(c + 1) * 64 * 256 + 4); }
        bf16x8 VF[2] = {VFn[0], VFn[1]};
        if (c + 1 < SEQ / 64) {
#pragma unroll
            for (int ss = 0; ss < 2; ++ss) { const bf16* vp = Vrow + (c + 1) * 64 + 32 * ss; const v2u v0 = *(const v2u*)vp, v1 = *(const v2u*)(vp + 16); v4u vv; vv.x = v0.x; vv.y = v0.y; vv.z = v1.x; vv.w = v1.y; VFn[ss] = __builtin_bit_cast(bf16x8, vv); } }
        v4u rg[2];
#pragma unroll
        for (int i = 0; i < 2; ++i) rg[i] = *(const v4u*)(P + (tok0 + ((tid + 512 * i) >> 4)) * PW + 2560 + h * 128 + opc * 8);
        const LAS unsigned char* qi = lds + par * GL_IMG + GL_QI; const LAS unsigned char* ki = lds + par * GL_IMG + GL_KI;
        bf16x8 qf[4][2], kf[4][2];
#pragma unroll
        for (int blk = 0; blk < 4; ++blk)
#pragma unroll
            for (int ks = 0; ks < 2; ++ks) { qf[blk][ks] = *(const LAS bf16x8*)(qi + foffs[ks] + blk * 2048); kf[blk][ks] = *(const LAS bf16x8*)(ki + foffs[ks] + blk * 2048); }
        const bf16x8 SF0 = pack8(S[0], S[1]), SF1 = pack8(S[2], S[3]);
        f32x4 O[4];
#pragma unroll
        for (int tb = 0; tb < 4; ++tb) { f32x4 o = mfma16(qf[tb][0], SF0, zero4); o = mfma16(qf[tb][1], SF1, o);
#pragma unroll
            for (int ss = 0; ss < 2; ++ss) if (2 * ss <= tb) { f32x4 a2[2];
#pragma unroll
                for (int hh = 0; hh < 2; ++hh) { const int sb = 2 * ss + hh; f32x4 a = zero4;
                    if (sb <= tb) { a = mfma16(kf[sb][0], qf[tb][0], zero4); a = mfma16(kf[sb][1], qf[tb][1], a);
                        if (sb == tb) {
#pragma unroll
                            for (int r = 0; r < 4; ++r) if (4 * g + r > l15) a[r] = 0.f; } }
                    a2[hh] = a; }
                o = mfma16(pack8(a2[0], a2[1]), VF[ss], o); }
            O[tb] = o; }
#pragma unroll
        for (int db = 0; db < 4; ++db) { f32x4 u = S[db];
#pragma unroll
            for (int ss = 0; ss < 2; ++ss) { const f32x4 t0 = mfma16(kf[2 * ss][db >> 1], If[db], zero4), t1 = mfma16(kf[2 * ss + 1][db >> 1], If[db], zero4); u = mfma16(pack8(t0, t1), VF[ss], u); }
            const f32x4 el = *(const LAS f32x4*)(lds + GL_EL + par * 256 + (16 * db + 4 * g) * 4);
            S[db] = u * el; }
        LAS unsigned char* ob = lds + GL_OB + par * GL_OBS; LAS float* ps = (LAS float*)(lds + GL_PS + par * 2048);
#pragma unroll
        for (int tb = 0; tb < 4; ++tb)
#pragma unroll
            for (int r = 0; r < 4; ++r) { const int t = 16 * tb + 4 * g + r; const float ov = O[tb][r]; float q = ov * ov; q += __shfl_xor(q, 1); q += __shfl_xor(q, 2); q += __shfl_xor(q, 4); q += __shfl_xor(q, 8);
                if (l15 == 0) ps[t * 8 + eb] = q;
                *(LAS bf16*)(ob + t * 272 + (16 * eb + l15) * 2) = (bf16)f2bf(ov); }
        if (c + 1 < SEQ / 64) GLA_STAGE(par ^ 1);
        __syncthreads();
#pragma unroll
        for (int i = 0; i < 2; ++i) { const int ot = (tid + 512 * i) >> 4; const f32x4 p0 = *(const LAS f32x4*)(ps + ot * 8), p1 = *(const LAS f32x4*)(ps + ot * 8 + 4);
            const float ss = ((p0[0] + p0[1]) + (p0[2] + p0[3])) + ((p1[0] + p1[1]) + (p1[2] + p1[3])); const float rs = rsqrtf(ss * (1.0f / 128.0f) + EPS);
            const v4u ov = *(const LAS v4u*)(ob + ot * 272 + opc * 16); const unsigned oa[4] = {ov.x, ov.y, ov.z, ov.w}, ga[4] = {rg[i].x, rg[i].y, rg[i].z, rg[i].w};
            const float gn[8] = {gg0[0], gg0[1], gg0[2], gg0[3], gg1[0], gg1[1], gg1[2], gg1[3]}; v4u w; unsigned* wp = (unsigned*)&w;
#pragma unroll
            for (int j = 0; j < 4; ++j) { const float o0 = __builtin_bit_cast(float, oa[j] << 16), o1 = __builtin_bit_cast(float, oa[j] & 0xffff0000u), g0 = __builtin_bit_cast(float, ga[j] << 16), g1 = __builtin_bit_cast(float, ga[j] & 0xffff0000u);
                wp[j] = pg8::cvtpk(o0 * rs * gn[2 * j] * g0 * __builtin_amdgcn_rcpf(1.0f + __builtin_amdgcn_exp2f(-1.4426950408889634f * g0)), o1 * rs * gn[2 * j + 1] * g1 * __builtin_amdgcn_rcpf(1.0f + __builtin_amdgcn_exp2f(-1.4426950408889634f * g1))); }
            *(v4u*)(CAT + (tok0 + ot) * DM + 512 + h * 128 + opc * 8) = w; }
    }
#undef GLA_STAGE
    __syncthreads();
}

__device__ __forceinline__ void router_phase(Frame& F, const bf16* X2, const float* WRt, const float* b_router, float* rsl, float* gate, unsigned* assign, unsigned* list, gu32* cnt) {
    typedef float f32x4v __attribute__((ext_vector_type(4)));
    LAS float* lg = (LAS float*)(F.lds + RING_OFF);
    LAS unsigned* hist = (LAS unsigned*)(lg + 128 * 33);
    const int tid = F.tid, lane = lane_here(), r16 = lane & 15, kq = lane >> 4, wv = F.wave, t = tid & 63;
    for (int blk = F.vcu; blk < NTOK / 128; blk += F.G) {
        const size_t tok0 = (size_t)blk * 128;
        const bf16* xp = X2 + (tok0 + wv * 16 + r16) * DM + 8 * kq; const float* w0 = WRt + (size_t)r16 * DM + 8 * kq; const float* w1 = w0 + (size_t)16 * DM;
        f32x4v acc0 = {0.f, 0.f, 0.f, 0.f}, acc1 = acc0; float ssq = 0.f;
#pragma unroll 4
        for (int m = 0; m < 32; ++m) { const v4u xw = *(const v4u*)(xp + 32 * m); const f32x4 a0 = *(const f32x4*)(w0 + 32 * m), a1 = *(const f32x4*)(w0 + 32 * m + 4), b0 = *(const f32x4*)(w1 + 32 * m), b1 = *(const f32x4*)(w1 + 32 * m + 4);
            const unsigned xa[4] = {xw.x, xw.y, xw.z, xw.w}; float xv[8];
#pragma unroll
            for (int j = 0; j < 4; ++j) { xv[2 * j] = __builtin_bit_cast(float, xa[j] << 16); xv[2 * j + 1] = __builtin_bit_cast(float, xa[j] & 0xffff0000u); }
            const float wa[8] = {a0[0], a0[1], a0[2], a0[3], a1[0], a1[1], a1[2], a1[3]}, wb[8] = {b0[0], b0[1], b0[2], b0[3], b1[0], b1[1], b1[2], b1[3]};
#pragma unroll
            for (int i = 0; i < 8; ++i) { acc0 = __builtin_amdgcn_mfma_f32_16x16x4f32(xv[i], wa[i], acc0, 0, 0, 0); acc1 = __builtin_amdgcn_mfma_f32_16x16x4f32(xv[i], wb[i], acc1, 0, 0, 0); ssq += xv[i] * xv[i]; } }
        ssq += __shfl_xor(ssq, 16); ssq += __shfl_xor(ssq, 32);
        float rsv[4];
#pragma unroll
        for (int j = 0; j < 4; ++j) { const float sq = __shfl(ssq, 4 * kq + j); rsv[j] = rsqrtf(sq * (1.0f / DM) + EPS); }
        const float br0 = b_router[r16], br1 = b_router[16 + r16];
#pragma unroll
        for (int j = 0; j < 4; ++j) { const int tl = wv * 16 + 4 * kq + j; lg[tl * 33 + r16] = acc0[j] * rsv[j] + br0; lg[tl * 33 + 16 + r16] = acc1[j] * rsv[j] + br1; if (r16 == 0) lg[tl * 33 + 32] = rsv[j]; }
        __syncthreads();
        if (tid < 128) {
            const int w2 = tid >> 6;
            float lv[32];
#pragma unroll
            for (int e = 0; e < 32; ++e) lv[e] = lg[tid * 33 + e];
            const float rs = lg[tid * 33 + 32];
            float tv[4]; int te[4];
#pragma unroll
            for (int k = 0; k < 4; ++k) { float best = -INFINITY; int bi = 0;
#pragma unroll
                for (int e = 0; e < 32; ++e) if (lv[e] > best) { best = lv[e]; bi = e; }
                tv[k] = best; te[k] = bi;
#pragma unroll
                for (int e = 0; e < 32; ++e) if (e == bi) lv[e] = -INFINITY; }
            const float e1 = __expf(tv[1] - tv[0]), e2 = __expf(tv[2] - tv[0]), e3 = __expf(tv[3] - tv[0]); const float inv = 1.0f / (1.0f + e1 + e2 + e3);
            const float gv[4] = {inv, e1 * inv, e2 * inv, e3 * inv};
            const size_t tok = tok0 + tid;
            LAS unsigned* hs = hist + w2 * 32; LAS unsigned* gbase = hist + 64 + w2 * 32;
            if (t < 32) hs[t] = 0u;
            __builtin_amdgcn_wave_barrier(); LDS_WAIT();
            unsigned lpos[4];
#pragma unroll
            for (int k = 0; k < 4; ++k) lpos[k] = __hip_atomic_fetch_add(hs + te[k], 1u, __ATOMIC_RELAXED, __HIP_MEMORY_SCOPE_WORKGROUP);
            __builtin_amdgcn_wave_barrier(); LDS_WAIT();
            if (t < 32) { const unsigned n = hs[t]; gbase[t] = n ? __hip_atomic_fetch_add(cnt + 64 * t, n, RLX_AGENT) : 0u; }
            __builtin_amdgcn_wave_barrier(); LDS_WAIT();
#pragma unroll
            for (int k = 0; k < 4; ++k) { const unsigned pos = gbase[te[k]] + lpos[k]; list[(size_t)te[k] * NTOK + pos] = (unsigned)tok; rsl[(size_t)te[k] * NTOK + pos] = rs;
                assign[tok * 4 + k] = ((unsigned)te[k] << 16) | pos; gate[tok * 4 + k] = gv[k]; }
        }
        __syncthreads();
    }
}
__device__ __forceinline__ int moe_tables(Frame& F) {
    LAS unsigned char* tile_e = F.lds + TAB_OFF; LAS int* tstart = (LAS int*)(F.lds + TAB_TSTART); LAS int* lc = (LAS int*)(F.lds + TAB_CNT);
    if (F.tid < 32) lc[F.tid] = (int)__hip_atomic_load(F.ctl + CW_CNT + 64 * F.tid, RLX_AGENT);
    __syncthreads();
    if (F.tid == 0) { int s = 0; for (int e = 0; e < 32; ++e) { tstart[e] = s; s += (lc[e] + 255) >> 8; } tstart[32] = s; }
    __syncthreads();
    const int T = tstart[32];
    for (int i = F.tid; i < T; i += 512) { int e = 0;
#pragma unroll
        for (int k = 1; k < 32; ++k) e += (tstart[k] <= i) ? 1 : 0;
        tile_e[i] = (unsigned char)e; }
    __syncthreads();
    return T;
}
__device__ __forceinline__ void final_phase(Frame& F, const bf16* X2, float* out, const unsigned char* Y, const float* gate, const unsigned* assign, const float* gfin) {
    (void)moe_tables(F);
    const LAS int* tstart = (const LAS int*)(F.lds + TAB_TSTART);
    const int gw = F.vcu * NWAVES + F.wave, NGW = F.G * NWAVES, lane = lane_here();
    unsigned an[2][4]; float gn[2][4];
#define FIN_ROUTE(t0) do { _Pragma("unroll") for (int u = 0; u < 2; ++u) { const int tok_ = ((t0) + u * NGW < NTOK) ? (t0) + u * NGW : ((t0) < NTOK ? (t0) : gw); \
        const v4u a4 = *(const v4u*)(assign + (size_t)tok_ * 4); const f32x4 g4 = *(const f32x4*)(gate + (size_t)tok_ * 4); \
        an[u][0] = a4.x; an[u][1] = a4.y; an[u][2] = a4.z; an[u][3] = a4.w; gn[u][0] = g4.x; gn[u][1] = g4.y; gn[u][2] = g4.z; gn[u][3] = g4.w; } } while (0)
    FIN_ROUTE(gw);
    f32x4 gfv[4];
#pragma unroll
    for (int j = 0; j < 4; ++j) gfv[j] = ((const f32x4*)gfin)[lane + 64 * j];
    for (int tok0 = gw; tok0 < NTOK; tok0 += 2 * NGW) {
        f32x4 v[2][4]; unsigned yw[2][4][4]; float gk[2][4];
#pragma unroll
        for (int u = 0; u < 2; ++u) { const int tok = (tok0 + u * NGW < NTOK) ? tok0 + u * NGW : tok0;
#pragma unroll
            for (int k = 0; k < 4; ++k) { const unsigned a = an[u][k]; gk[u][k] = gn[u][k]; const size_t row = (size_t)tstart[a >> 16] * 256 + (a & 0xffffu);
                const unsigned* yr = (const unsigned*)(Y + row * DM) + lane;
#pragma unroll
                for (int j = 0; j < 4; ++j) yw[u][k][j] = yr[64 * j]; }
            const v2u* xin = (const v2u*)(X2 + (size_t)tok * DM) + lane;
#pragma unroll
            for (int j = 0; j < 4; ++j) { const v2u w = xin[64 * j]; v[u][j] = (f32x4){__builtin_bit_cast(float, w.x << 16), __builtin_bit_cast(float, w.x & 0xffff0000u), __builtin_bit_cast(float, w.y << 16), __builtin_bit_cast(float, w.y & 0xffff0000u)}; } }
        FIN_ROUTE(tok0 + 2 * NGW);
#pragma unroll
        for (int u = 0; u < 2; ++u) { const int tok = (tok0 + u * NGW < NTOK) ? tok0 + u * NGW : tok0;
#pragma unroll
            for (int k = 0; k < 4; ++k)
#pragma unroll
                for (int j = 0; j < 4; ++j) { const unsigned w = yw[u][k][j]; const auto lo = __builtin_amdgcn_cvt_pk_f32_fp8((int)w, false), hi = __builtin_amdgcn_cvt_pk_f32_fp8((int)w, true);
                    v[u][j].x += gk[u][k] * lo[0]; v[u][j].y += gk[u][k] * lo[1]; v[u][j].z += gk[u][k] * hi[0]; v[u][j].w += gk[u][k] * hi[1]; }
            float s = 0.f;
#pragma unroll
            for (int j = 0; j < 4; ++j) s += (v[u][j].x * v[u][j].x + v[u][j].y * v[u][j].y) + (v[u][j].z * v[u][j].z + v[u][j].w * v[u][j].w);
            const float rs = rsqrtf(wave_sum(s) * (1.0f / DM) + EPS); f32x4* xr = (f32x4*)(out + (size_t)tok * DM) + lane;
#pragma unroll
            for (int j = 0; j < 4; ++j) xr[64 * j] = v[u][j] * rs * gfv[j]; }
    }
#undef FIN_ROUTE
}

constexpr int NPHASE = 10;
struct Args { const void* in[28]; float* out; unsigned char* ws; int ph_lo, ph_hi; };
__global__ void __launch_bounds__(NWAVES * 64, 2) mk_fwd(Args args) {
    extern __shared__ __attribute__((aligned(16))) unsigned char lds[];
    Frame F;
    F.lds = (LAS unsigned char*)lds;
    F.MISC = (volatile LAS unsigned*)(F.lds + MISC_OFF);
    F.tid = threadIdx.x; F.lane = F.tid & 63; F.wave = __builtin_amdgcn_readfirstlane(F.tid >> 6);
    F.G = gridDim.x; { const int bx = blockIdx.x; F.vcu = (F.G % 8 == 0) ? (bx % 8) * (F.G / 8) + bx / 8 : bx; }
    F.ws = args.ws; F.out = args.out; F.ctl = (gu32*)(args.ws + WS_CTL);
    unsigned char* ws = args.ws;
    typedef const void* const volatile __attribute__((address_space(4))) kargp_t;
    kargp_t* const kargs = (kargp_t*)__builtin_amdgcn_kernarg_segment_ptr();
#define INP(k) ((const float*)kargs[k])
    for (int u = F.tid; u < (LDS_BYTES - LDSCTL_OFF) / 4; u += NWAVES * 64) ((LAS unsigned*)(F.lds + LDSCTL_OFF))[u] = 0u;
    __syncthreads();
    const int lo = args.ph_lo, hi = args.ph_hi;
    const bool single = (hi - lo) > 1;
    XcdBarrier bar; bar.bar = (unsigned*)(F.ctl + CW_BAR); bar.x = 0; bar.st = nullptr;
    if (single) bar = xcd_barrier_post((unsigned*)(F.ctl + CW_BAR), F.MISC + 8);
#define IN(k) (lo <= (k) && (k) < hi)
#if defined(PROBE_K0)
    LAS unsigned long long* tsl = (LAS unsigned long long*)(F.lds + TS_OFF);
    if (F.tid == 0) tsl[0] = rt();
#define SEAM(k) do { if (IN(k) && IN((k) + 1)) xcd_barrier(bar); if (F.tid == 0) tsl[(k) + 1] = rt(); } while (0)
#define SEAM_LOCAL(k) do { if (F.tid == 0) tsl[(k) + 1] = rt(); } while (0)
#else
#define SEAM(k) do { if (IN(k) && IN((k) + 1)) xcd_barrier(bar); } while (0)
#define SEAM_LOCAL(k) do { } while (0)
#endif
    typedef pg8::bf16_t hb;
    const int bx = (int)blockIdx.x;

    if (IN(0)) { In I;
        I.x = (const float*)INP(0);
        I.mem = (const float*)INP(1);
        I.positions = (const int*)INP(2);
        I.norm_mix_g = (const float*)INP(3);
        I.w_in = (const float*)INP(4);
        I.lq1 = (const float*)INP(5);
        I.lk1 = (const float*)INP(6);
        I.lq2 = (const float*)INP(7);
        I.lk2 = (const float*)INP(8);
        I.diff_norm_g = (const float*)INP(9);
        I.w_alpha2 = (const float*)INP(10);
        I.b_alpha = (const float*)INP(11);
        I.gla_norm_g = (const float*)INP(12);
        I.w_out = (const float*)INP(13);
        I.norm_cross_g = (const float*)INP(14);
        I.norm_mem_g = (const float*)INP(15);
        I.w_cq = (const float*)INP(16);
        I.w_ck = (const float*)INP(17);
        I.w_cv = (const float*)INP(18);
        I.w_co = (const float*)INP(19);
        I.norm_ffn_g = (const float*)INP(20);
        I.w_router = (const float*)INP(21);
        I.b_router = (const float*)INP(22);
        I.w_up = (const float*)INP(23);
        I.b_up = (const float*)INP(24);
        I.w_down = (const float*)INP(25);
        I.b_down = (const float*)INP(26);
        I.norm_final_g = (const float*)INP(27);
        p0_prologue(F, I); }
    SEAM(0);
    if (IN(1)) {
        pg8::Gemm g{(const hb*)(ws + WS_HN), (const hb*)(ws + WS_WINT), NTOK, 3328, DM, DM, DM, 127, 127};
        typedef pg8::OrderP1<(unsigned)WS_HN, (unsigned)WS_WINT, (unsigned)WS_MN, (unsigned)WS_WCK, (unsigned)WS_WCV> OrdP1; OrdP1 S; S.G = F.G; S.c = bx; S.ws = (const char*)ws;
        pg8::EpiP1 E{pg8::EpiProj{(hb*)(ws + WS_P), (float*)(ws + WS_LA), (const float*)(ws + WS_CS), INP(11)}, pg8::EpiPlain{(hb*)(ws + WS_VT) - (size_t)1024 * NTOK, NTOK, 1.0f},
                     pg8::EpiPlain{(hb*)(ws + WS_KX), DM, 1.0f}, pg8::EpiPlain{(hb*)(ws + WS_VXT), DM, 1.0f}};
        pg8::gemm_phase<pg8::EpiP1, OrdP1, true, true, false, false>(F.lds + RING_OFF, g, S, E);
    }
    SEAM(1);
    if (IN(2)) {
        float lam;
        { const int ln = lane_here(); const float a = INP(5)[ln] * INP(6)[ln], c = INP(7)[ln] * INP(8)[ln]; lam = __expf(wave_sum(a)) - __expf(wave_sum(c)) + 0.2f; }
        LAS int* qslot = (LAS int*)(F.lds + TAB_OFF);
        for (;;) {
            if (F.tid == 0) qslot[0] = (int)__hip_atomic_fetch_add(F.ctl + CW_Q2, 1u, RLX_AGENT);
            __syncthreads();
            const int u = qslot[0];
            __syncthreads();
            if (u >= 64 + 1024 + MOE_UNITS) break;
            int au = -1;
            if (u >= 64) { const int v = u - 64, gi = v / 11, r = v - gi * 11;
                if (r >= 8) { moe_convert_unit(gi * 3 + (r - 8), INP(23), INP(25), INP(20), ws, F.wave, lane_here()); continue; }
                au = gi * 8 + r; }
#if defined(PROBE_SPLIT)
            if (u < 64) continue;
#endif
            if (u < 64) { gla_unit(F, (const bf16*)(ws + WS_P), (const float*)(ws + WS_LA), (const bf16*)(ws + WS_GVT), (bf16*)(ws + WS_CAT), INP(12), u >> 2, u & 3);
            }
            else { const int v = au, bh = v & 63, qb = 15 - (v >> 6);
                diffattn_unit(F, (const bf16*)(ws + WS_P), (const bf16*)(ws + WS_VT), (bf16*)(ws + WS_CAT), INP(9), lam, bh >> 2, bh & 3, qb); }
        }
    }
#if defined(PROBE_SPLIT)
    if (IN(2)) { xcd_barrier(bar); if (F.tid == 0) tsl[13] = rt();
        for (int u = F.vcu; u < 64; u += F.G) gla_unit(F, (const bf16*)(ws + WS_P), (const float*)(ws + WS_LA), (const bf16*)(ws + WS_GVT), (bf16*)(ws + WS_CAT), INP(12), u >> 2, u & 3); }
#endif
    SEAM(2);
    if (IN(3)) {
        { pg8::Gemm g{(const hb*)(ws + WS_CAT), (const hb*)(ws + WS_WOUT), NTOK, DM, DM, DM, DM, 127, 127}; pg8::StaticOrder S; S.init(NTOK, DM, F.G, bx);
          pg8::EpiRes1 E{INP(0), (hb*)(ws + WS_X1B), (float*)(ws + WS_SSP1)};
          pg8::gemm_phase<pg8::EpiRes1, pg8::StaticOrder, true, true, false, false>(F.lds + RING_OFF, g, S, E); }
        { pg8::Gemm g{(const hb*)(ws + WS_KX), (const hb*)(ws + WS_WCQ), 64 * 256, DM, 256, DM, DM, 127, 127};
          typedef pg8::OrderGH<(unsigned)WS_KX, (unsigned)WS_WCQ, (unsigned)WS_WCO, (unsigned)WS_VXT> OrdGH; OrdGH S; S.G = F.G; S.c = bx; S.ws = (const char*)ws;
          pg8::EpiGH E{pg8::EpiPlain{(hb*)(ws + WS_GT), DM, 1.0f}, pg8::EpiPlain{(hb*)(ws + WS_HT), DM, 1.0f}};
          pg8::gemm_phase<pg8::EpiGH, OrdGH, true, true>(F.lds + RING_OFF, g, S, E); }
    }
    SEAM(3);
    if (IN(4)) {
        pg8::Gemm g{(const hb*)(ws + WS_X1B), (const hb*)(ws + WS_GT), NTOK, 256, DM, DM, DM, 127, 127}; pg8::OrderXS S; S.init(F.G, bx);
        pg8::EpiSoftmaxN E{(hb*)(ws + WS_PX), (const float*)(ws + WS_SSP1), (PG8_LAS float*)(F.lds + XCH_OFF), (PG8_LAS float*)(F.lds + XCH2_OFF)};
        pg8::gemm_phase<pg8::EpiSoftmaxN, pg8::OrderXS, true, true>(F.lds + RING_OFF, g, S, E);
    }
    SEAM(4);
    if (IN(5)) {
        pg8::Gemm g{(const hb*)(ws + WS_PX), (const hb*)(ws + WS_HT), NTOK, DM, DM, DM, DM, 127, 127}; pg8::OrderXO S; S.init(F.G, bx);
        pg8::EpiRes2 E{(hb*)(ws + WS_X1B), ws + WS_X2B};
        pg8::gemm_phase<pg8::EpiRes2, pg8::OrderXO, true, true, false, false>(F.lds + RING_OFF, g, S, E);
    }
    SEAM(5);
    if (IN(6)) router_phase(F, (const bf16*)(ws + WS_X1B), (const float*)(ws + WS_WR), INP(22), (float*)(ws + WS_RSL), (float*)(ws + WS_GATE), (unsigned*)(ws + WS_ASSIGN), (unsigned*)(ws + WS_LIST), F.ctl + CW_CNT);
    SEAM(6);
    if (IN(7)) {
        const int T = moe_tables(F);
        pg8::Gemm g{(const hb*)(ws + WS_X2B), (const hb*)(ws + WS_WUP), T * 256, NEXP * 2048, 512, 512, 512, 127, 122}; pg8::MoeOrderG S;
        S.init(T, 8, F.G, bx, (const PG8_LAS unsigned char*)(F.lds + TAB_OFF), (const PG8_LAS int*)(F.lds + TAB_TSTART), (const PG8_LAS int*)(F.lds + TAB_CNT), (const unsigned*)(ws + WS_LIST), (PG8_LAS unsigned*)(F.lds + XCH_OFF));
        pg8::EpiUp E{ws + WS_ACT, (const float*)(ws + WS_RSL), (const PG8_LAS int*)(F.lds + TAB_TSTART), (const PG8_LAS int*)(F.lds + TAB_CNT), INP(24)};
        pg8::gemm_phase<pg8::EpiUp, pg8::MoeOrderG, true, true, true, false>(F.lds + RING_OFF, g, S, E);
    }
    SEAM(7);
    if (IN(8)) {
        const int T = moe_tables(F);
        pg8::Gemm g{(const hb*)(ws + WS_ACT), (const hb*)(ws + WS_WDN), T * 256, NEXP * 1024, 512, 512, 512, 127, 122}; pg8::MoeOrder S; S.init(T, 4, F.G, bx, (const PG8_LAS unsigned char*)(F.lds + TAB_OFF));
        pg8::EpiDown E{ws + WS_Y, INP(26)};
        pg8::gemm_phase<pg8::EpiDown, pg8::MoeOrder, true, true, true, false>(F.lds + RING_OFF, g, S, E);
    }
    SEAM(8);
    if (IN(9)) final_phase(F, (const bf16*)(ws + WS_X1B), F.out, (const unsigned char*)(ws + WS_Y), (const float*)(ws + WS_GATE), (const unsigned*)(ws + WS_ASSIGN), INP(27));
#if defined(PROBE_ATT)
    { xcd_barrier(bar); if (F.tid == 0) tsl[13] = rt();
#pragma unroll 1
      for (int i2 = 2 * F.vcu; i2 < 1024; i2 += 2 * F.G)
#pragma unroll 1
          for (int rep = 0; rep < 2; ++rep) { const int i = i2 >> 1, bh = i >> 3, jj = i & 7;
              diffattn_unit<PROBE_ATT>(F, (const bf16*)(ws + WS_P), (const bf16*)(ws + WS_VT), (bf16*)(ws + WS_ACT), INP(9), 0.5f, bh >> 2, bh & 3, rep ? jj : 15 - jj); }
      xcd_barrier(bar); if (F.tid == 0) tsl[14] = rt(); }
#endif
#if defined(PROBE_GEMM)
    { xcd_barrier(bar); if (F.tid == 0) tsl[13] = rt();
      const int T = moe_tables(F);
      pg8::Gemm g{(const hb*)(ws + WS_X2B), (const hb*)(ws + WS_WUP), T * 256, NEXP * 2048, 512, 512, 512, 127, 122}; pg8::MoeOrderG S;
      S.init(T, 8, F.G, bx, (const PG8_LAS unsigned char*)(F.lds + TAB_OFF), (const PG8_LAS int*)(F.lds + TAB_TSTART), (const PG8_LAS int*)(F.lds + TAB_CNT), (const unsigned*)(ws + WS_LIST), (PG8_LAS unsigned*)(F.lds + XCH_OFF));
      pg8::EpiUp E{ws + WS_ACT, (const float*)(ws + WS_RSL), (const PG8_LAS int*)(F.lds + TAB_TSTART), (const PG8_LAS int*)(F.lds + TAB_CNT), INP(24)};
      pg8::gemm_phase<pg8::EpiUp, pg8::MoeOrderG, true, true, true, false, PROBE_GEMM>(F.lds + RING_OFF, g, S, E);
      xcd_barrier(bar); if (F.tid == 0) tsl[14] = rt(); }
#endif
#if defined(PROBE_K0)
#ifndef PROBE_UNIT
#define PROBE_UNIT 1600
#endif
    { if (F.tid == 0) { tsl[NPHASE] = rt();
        const int ks[2] = {PROBE_K0, PROBE_K1}; unsigned long long code = 0, mul = 1;
        for (int i = 0; i < 2; ++i) { unsigned long long dt = ks[i] == 94 ? tsl[14] - tsl[13] : ks[i] == 97 ? tsl[13] - tsl[2] : ks[i] == 98 ? tsl[3] - tsl[13] : ks[i] == 95 ? tsl[13] - tsl[0] : ks[i] == 96 ? tsl[14] - tsl[13] : tsl[ks[i] + 1] - tsl[ks[i]]; unsigned long long q = (dt + PROBE_UNIT / 2) / PROBE_UNIT; if (q > 63) q = 63; code += q * mul; mul *= 64; }
        tsl[15] = code * 6400ull; }
      __syncthreads();
      const unsigned long long t0 = rt(), wait = tsl[15]; float x = (float)F.tid, y = 1.0001f;
      while (rt() - t0 < wait) {
#pragma unroll
          for (int i = 0; i < 64; ++i) x = x * y + 0.5f; }
      if (x == 12345.678f) F.out[0] = x; }
#endif
#undef IN
#undef SEAM
#undef SEAM_LOCAL
}

#ifndef MK_N_LAUNCHES
#define MK_N_LAUNCHES 1
#endif
extern "C" void kernel_launch(void* const* d_in, const int* in_sizes, int n_in, void* d_out, int out_size, void* d_ws, size_t ws_size, hipStream_t stream) {
    static int grid = 0;
    if (grid == 0) {
        if (n_in != 28 || out_size != NTOK * DM || ws_size < WS_END) { fprintf(stderr, "kernel_launch: unexpected shapes: n_in %d out %d ws %zu (need %zu)\n", n_in, out_size, ws_size, (size_t)WS_END); grid = -1; return; }
        int dev = 0, cus = 0, per_cu = 0;
        if (hipGetDevice(&dev) != hipSuccess || hipDeviceGetAttribute(&cus, hipDeviceAttributeMultiprocessorCount, dev) != hipSuccess) { fprintf(stderr, "kernel_launch: device query failed\n"); grid = -1; return; }
        if (hipFuncSetAttribute((const void*)mk_fwd, hipFuncAttributeMaxDynamicSharedMemorySize, LDS_BYTES) != hipSuccess) { fprintf(stderr, "kernel_launch: hipFuncSetAttribute failed\n"); grid = -1; return; }
        if (hipOccupancyMaxActiveBlocksPerMultiprocessor(&per_cu, (const void*)mk_fwd, NWAVES * 64, LDS_BYTES) != hipSuccess || per_cu < 1) { fprintf(stderr, "kernel_launch: occupancy query reports %d workgroups per CU\n", per_cu); (void)hipGetLastError(); grid = -1; return; }
        grid = cus;
    }
    if (grid < 0) return;
    (void)hipMemsetAsync((char*)d_ws + WS_CTL, 0, CTL_ZERO_BYTES, stream);
    Args a{};
    for (int i = 0; i < 28; ++i) a.in[i] = d_in[i];
    a.out = (float*)d_out; a.ws = (unsigned char*)d_ws;
    if (MK_N_LAUNCHES == 1) { a.ph_lo = 0; a.ph_hi = NPHASE; hipLaunchKernelGGL(mk_fwd, dim3(grid), dim3(NWAVES * 64), LDS_BYTES, stream, a); }
    else for (int p = 0; p < NPHASE; ++p) { a.ph_lo = p; a.ph_hi = p + 1; hipLaunchKernelGGL(mk_fwd, dim3(grid), dim3(NWAVES * 64), LDS_BYTES, stream, a); }
}
```

```cpp
#include <hip/hip_runtime.h>
#include <cstdio>
#include <cstdint>
namespace pg8 {
#define PG8_LAS __attribute__((address_space(3)))
typedef unsigned short bf16_t;
typedef short bf16x8 __attribute__((ext_vector_type(8)));
typedef float f32x4 __attribute__((ext_vector_type(4)));
typedef unsigned u32x4 __attribute__((ext_vector_type(4)));
constexpr int BM = 256, BK = 64, HALF = 128, HTB = HALF * BK * 2  , STAGE_BYTES = 8 * HTB, NXCD = 8, WGM = 8;

__host__ __device__ __forceinline__ int lds_byte(int r, int c) { const int st = (r >> 4) * 2 + (c >> 5), rr = r & 15, cc = c & 31, ob = rr * 64 + cc * 2; return st * 1024 + (ob ^ (((ob >> 9) & 1) << 5)); }
__host__ __device__ __forceinline__ void stage_rc(int b, int& R, int& C) { const int st = b / 1024, sb = b % 1024, swz = sb ^ (((sb >> 9) & 1) << 5); R = (st >> 1) * 16 + swz / 64; C = (st & 1) * 32 + (swz % 64) / 2; }
__host__ __device__ __forceinline__ int perm32(int rho) { const int n = rho >> 4, i = rho & 15; return 8 * (i >> 2) + 4 * n + (i & 3); }

struct Unit { int pm, pn; };
struct Gemm { const bf16_t* A; const bf16_t* Bt; int M, N, K, lda, ldb, sa, sb; };
template <class T, class = void> struct epi_ldsops { static constexpr bool value = false; };
template <class T> struct epi_ldsops<T, decltype((void)T::LDSOPS)> { static constexpr bool value = T::LDSOPS; };
struct OrderBase {
    static constexpr bool GATHER = false;
    __device__ __forceinline__ const char* a_base(const Gemm& g, const Unit& u) const { return (const char*)g.A + (size_t)u.pm * 256 * g.lda * 2; }
    __device__ __forceinline__ const char* b_base(const Gemm& g, const Unit& u) const { return (const char*)g.Bt + (size_t)u.pn * 256 * g.ldb * 2; }
    __device__ __forceinline__ void a_ready(const Unit&) const {}
    __device__ __forceinline__ void done(const Unit&) const {}
};

struct StaticOrder : OrderBase {
    int nM, nN, nwg, G, c;
    __host__ __device__ void init(int M, int N, int G_, int c_) { nM = M / BM; nN = N / BM; nwg = nM * nN; G = G_; c = c_; }
    __host__ __device__ bool next(int i, Unit& u) const {
        const long L = (long)i * G + c; if (L >= nwg) return false;
        int wgid = (int)L; { const int q = nwg / NXCD, r = nwg % NXCD, xcd = wgid % NXCD, off = wgid / NXCD; wgid = (xcd < r ? xcd * (q + 1) : r * (q + 1) + (xcd - r) * q) + off; }
        const int nig = WGM * nN, gid = wgid / nig, fm = gid * WGM, gsz = (nM - fm) < WGM ? (nM - fm) : WGM;
        u.pm = fm + ((wgid % nig) % gsz); u.pn = (wgid % nig) / gsz; return true;
    }
};

typedef unsigned u32x2 __attribute__((ext_vector_type(2)));
typedef float f32x2_t __attribute__((ext_vector_type(2)));
typedef __bf16 bf16x2_t __attribute__((ext_vector_type(2)));
__device__ __forceinline__ unsigned cvtpk(float lo, float hi) { f32x2_t v = {lo, hi}; bf16x2_t b = __builtin_convertvector(v, bf16x2_t); return __builtin_bit_cast(unsigned, b); }
__device__ __forceinline__ void st_bf4(bf16_t* p, f32x4 v) { u32x2 w; w.x = cvtpk(v[0], v[1]); w.y = cvtpk(v[2], v[3]); *(u32x2*)p = w; }
__device__ __forceinline__ unsigned cvt4_fp8(f32x4 v) { unsigned w = __builtin_amdgcn_cvt_pk_fp8_f32(v[0], v[1], 0, false); return __builtin_amdgcn_cvt_pk_fp8_f32(v[2], v[3], w, true); }
__device__ __forceinline__ void st_bf8(bf16_t* p, f32x4 a, f32x4 c) { u32x4 w; w.x = cvtpk(a[0], a[1]); w.y = cvtpk(a[2], a[3]); w.z = cvtpk(c[0], c[1]); w.w = cvtpk(c[2], c[3]); *(u32x4*)p = w; }
__device__ __forceinline__ float bf2f(bf16_t b) { return __builtin_bit_cast(float, (unsigned)b << 16); }
#define EPI_ROWS _Pragma("unroll") for (int ai = 0; ai < 2; ++ai) _Pragma("unroll") for (int m = 0; m < 4; ++m)
#define EPI_COLS _Pragma("unroll") for (int bj = 0; bj < 2; ++bj) _Pragma("unroll") for (int n = 0; n < 2; ++n)
constexpr float LOG2E = 1.4426950408889634f;
constexpr float QSCALE_DA = 0.125f * LOG2E;
constexpr float QSCALE_X = 0.0625f * LOG2E;

struct EpiPlain {
    static constexpr bool PERM = true, AFTER_DRAIN = false;
    bf16_t* O; int ldc; float scale;
    __device__ __forceinline__ void operator()(const f32x4 (&acc)[2][2][4][2], const Unit& u, int wr, int wc, int fr, int fq) const {
        EPI_ROWS { const int row = u.pm * 256 + ai * 128 + wr * 64 + m * 16 + fr; bf16_t* rp = O + (size_t)row * ldc + u.pn * 256 + wc * 32 + fq * 8;
            _Pragma("unroll") for (int bj = 0; bj < 2; ++bj) st_bf8(rp + bj * 128, acc[ai][bj][m][0] * scale, acc[ai][bj][m][1] * scale); }
    }
};
struct EpiProj {
    static constexpr bool PERM = true, AFTER_DRAIN = false;
    bf16_t* P; float* LA; const float* cs; const float* b_alpha;
    template <int ai> __device__ __forceinline__ void decay_rows(const f32x4 (&acc)[2][2][4][2], const f32x4 (&bav)[2][2], const Unit& u, int wr, int wc, int fr, int fq) const {
        const int row0 = u.pm * 256 + ai * 128 + wr * 64 + fr;
        EPI_COLS { const int col = bj * 128 + wc * 32 + fq * 8 + n * 4; const f32x4 ba = bav[bj][n]; f32x4 run = {0.f, 0.f, 0.f, 0.f};
            _Pragma("unroll") for (int m = 0; m < 4; ++m) { const f32x4 z = acc[ai][bj][m][n] + ba; f32x4 o;
                _Pragma("unroll") for (int i = 0; i < 4; ++i) { float v = (fminf(z[i], 0.f) - __logf(1.0f + __expf(-fabsf(z[i])))) * 0.0625f;
                    { float t = __shfl_up(v, 1, 16); if (fr >= 1) v += t; t = __shfl_up(v, 2, 16); if (fr >= 2) v += t; t = __shfl_up(v, 4, 16); if (fr >= 4) v += t; t = __shfl_up(v, 8, 16); if (fr >= 8) v += t; }
                    o[i] = v + run[i]; run[i] += __shfl(v, 15, 16); }
                *(f32x4*)(LA + (size_t)(row0 + m * 16) * 256 + col) = o; } }
    }
    __device__ __forceinline__ void operator()(const f32x4 (&acc)[2][2][4][2], const Unit& u, int wr, int wc, int fr, int fq) const {
        const int pn = u.pn;
        if (pn < 4) {
            const float sc = pn < 2 ? QSCALE_DA : 1.0f; const bool ropew = (wc & 1) == 0; const bool rl = fq < 2, hi = fq == 1;
            if (ropew) {
                f32x4 cq[2][4];
#define ROPE_LD(i, sl) do { const f32x4* cp_ = (const f32x4*)(cs + (size_t)(u.pm * 256 + ((i) >> 2) * 128 + wr * 64 + ((i) & 3) * 16 + fr) * 16); cq[sl][0] = cp_[0]; cq[sl][1] = cp_[1]; cq[sl][2] = cp_[2]; cq[sl][3] = cp_[3]; } while (0)
                ROPE_LD(0, 0); ROPE_LD(1, 1);
                _Pragma("unroll") for (int ri = 0; ri < 8; ++ri) { const int ai = ri >> 2, m = ri & 3; const int row = u.pm * 256 + ai * 128 + wr * 64 + m * 16 + fr; bf16_t* rp = P + (size_t)row * 3072 + pn * 256 + wc * 32 + fq * 8;
                    const f32x4 cv[2] = {cq[ri & 1][0], cq[ri & 1][1]}, sv[2] = {cq[ri & 1][2], cq[ri & 1][3]};
                    if (ri + 2 < 8) ROPE_LD(ri + 2, ri & 1);
                    _Pragma("unroll") for (int bj = 0; bj < 2; ++bj) { f32x4 v[2] = {acc[ai][bj][m][0], acc[ai][bj][m][1]};
                        _Pragma("unroll") for (int n = 0; n < 2; ++n) { f32x4 p; p[0] = __shfl_xor(v[n][0], 16); p[1] = __shfl_xor(v[n][1], 16); p[2] = __shfl_xor(v[n][2], 16); p[3] = __shfl_xor(v[n][3], 16);
                            const f32x4 r = hi ? (v[n] * cv[n] + p * sv[n]) : (v[n] * cv[n] - p * sv[n]); v[n] = rl ? r : v[n]; }
                        st_bf8(rp + bj * 128, v[0] * sc, v[1] * sc); } }
#undef ROPE_LD
            } else {
                EPI_ROWS { const int row = u.pm * 256 + ai * 128 + wr * 64 + m * 16 + fr; bf16_t* rp = P + (size_t)row * 3072 + pn * 256 + wc * 32 + fq * 8;
                    _Pragma("unroll") for (int bj = 0; bj < 2; ++bj) st_bf8(rp + bj * 128, acc[ai][bj][m][0] * sc, acc[ai][bj][m][1] * sc); }
            }
        } else if (pn < 12) {
            const float sc = pn == 6 ? 0.125f : 1.0f;
            EPI_ROWS { const int row = u.pm * 256 + ai * 128 + wr * 64 + m * 16 + fr; bf16_t* rp = P + (size_t)row * 3072 + pn * 256 + wc * 32 + fq * 8;
                _Pragma("unroll") for (int bj = 0; bj < 2; ++bj) st_bf8(rp + bj * 128, acc[ai][bj][m][0] * sc, acc[ai][bj][m][1] * sc); }
        } else {
            f32x4 bav[2][2]; EPI_COLS bav[bj][n] = *(const f32x4*)(b_alpha + bj * 128 + wc * 32 + fq * 8 + n * 4);
            decay_rows<0>(acc, bav, u, wr, wc, fr, fq); decay_rows<1>(acc, bav, u, wr, wc, fr, fq);
        }
    }
};
struct EpiP1 {
    static constexpr bool PERM = true, AFTER_DRAIN = false;
    EpiProj proj; EpiPlain vt, kx, vxt;
    __device__ __forceinline__ void operator()(const f32x4 (&acc)[2][2][4][2], const Unit& u, int wr, int wc, int fr, int fq) const {
        const int job = u.pn >> 16; Unit v; v.pm = u.pm; v.pn = u.pn & 0xffff;
        if (job == 0) proj(acc, v, wr, wc, fr, fq); else if (job == 1) vt(acc, v, wr, wc, fr, fq); else if (job == 2) kx(acc, v, wr, wc, fr, fq); else vxt(acc, v, wr, wc, fr, fq);
    }
};
struct EpiRes1 {
    static constexpr bool PERM = true, AFTER_DRAIN = false;
    const float* base; bf16_t* xb; float* ssp;
    __device__ __forceinline__ void operator()(const f32x4 (&acc)[2][2][4][2], const Unit& u, int wr, int wc, int fr, int fq) const {
        constexpr int ND = 3;
        const size_t off0 = (size_t)(u.pm * 256 + wr * 64 + fr) * 1024 + u.pn * 256 + wc * 32 + fq * 8;
        f32x4 xq[ND][4];
#define RES1_LD(i, sl) do { const float* bp_ = base + off0 + (size_t)((((i) >> 2) * 128 + ((i) & 3) * 16)) * 1024; xq[sl][0] = *(const f32x4*)bp_; xq[sl][1] = *(const f32x4*)(bp_ + 4); xq[sl][2] = *(const f32x4*)(bp_ + 128); xq[sl][3] = *(const f32x4*)(bp_ + 132); } while (0)
        _Pragma("unroll") for (int i = 0; i < ND; ++i) RES1_LD(i, i);
        _Pragma("unroll") for (int i = 0; i < 8; ++i) { const int ai = i >> 2, m = i & 3; const int row = u.pm * 256 + ai * 128 + wr * 64 + m * 16 + fr; const size_t off = off0 + (size_t)(ai * 128 + m * 16) * 1024;
            f32x4 v[4]; _Pragma("unroll") for (int q = 0; q < 4; ++q) v[q] = xq[i % ND][q] + acc[ai][q >> 1][m][q & 1];
            if (i + ND < 8) RES1_LD(i + ND, i % ND);
            st_bf8(xb + off, v[0], v[1]); st_bf8(xb + off + 128, v[2], v[3]); float ss = 0.f;
            _Pragma("unroll") for (int q = 0; q < 4; ++q) ss += (v[q][0] * v[q][0] + v[q][1] * v[q][1]) + (v[q][2] * v[q][2] + v[q][3] * v[q][3]);
            ss += __shfl_xor(ss, 16); ss += __shfl_xor(ss, 32);
            if (fq == 0) ssp[(size_t)row * 16 + u.pn * 4 + wc] = ss; }
#undef RES1_LD
    }
};
struct EpiQX {
    static constexpr bool PERM = true, AFTER_DRAIN = false;
    bf16_t* O; const float* ssp;
    __device__ __forceinline__ void operator()(const f32x4 (&acc)[2][2][4][2], const Unit& u, int wr, int wc, int fr, int fq) const {
        EPI_ROWS { const int row = u.pm * 256 + ai * 128 + wr * 64 + m * 16 + fr; const f32x4* sp = (const f32x4*)(ssp + (size_t)row * 16);
            const f32x4 a = sp[0], b = sp[1], c = sp[2], d = sp[3]; const float ss = ((a[0] + a[1]) + (a[2] + a[3])) + ((b[0] + b[1]) + (b[2] + b[3])) + ((c[0] + c[1]) + (c[2] + c[3])) + ((d[0] + d[1]) + (d[2] + d[3]));
            const float rs = rsqrtf(ss * (1.0f / 1024.0f) + 1e-6f) * QSCALE_X; bf16_t* rp = O + (size_t)row * 1024 + u.pn * 256 + wc * 32 + fq * 8;
            _Pragma("unroll") for (int bj = 0; bj < 2; ++bj) st_bf8(rp + bj * 128, acc[ai][bj][m][0] * rs, acc[ai][bj][m][1] * rs); }
    }
};
struct EpiRes2 {
    static constexpr bool PERM = true, AFTER_DRAIN = false;
    bf16_t* xh; unsigned char* x8;
    __device__ __forceinline__ void operator()(const f32x4 (&acc)[2][2][4][2], const Unit& u, int wr, int wc, int fr, int fq) const {
        constexpr int ND = 4;
        const size_t off0 = (size_t)(u.pm * 256 + wr * 64 + fr) * 1024 + u.pn * 256 + wc * 32 + fq * 8;
        u32x4 xq[ND][2];
#define RES2_LD(i, sl) do { const bf16_t* bp_ = xh + off0 + (size_t)((((i) >> 2) * 128 + ((i) & 3) * 16)) * 1024; xq[sl][0] = *(const u32x4*)bp_; xq[sl][1] = *(const u32x4*)(bp_ + 128); } while (0)
        _Pragma("unroll") for (int i = 0; i < ND; ++i) RES2_LD(i, i);
        _Pragma("unroll") for (int i = 0; i < 8; ++i) { const int ai = i >> 2, m = i & 3; const size_t off = off0 + (size_t)(ai * 128 + m * 16) * 1024;
            f32x4 v[2][2];
            _Pragma("unroll") for (int bj = 0; bj < 2; ++bj) { const u32x4 w = xq[i % ND][bj];
                const f32x4 v0 = {__builtin_bit_cast(float, w.x << 16), __builtin_bit_cast(float, w.x & 0xffff0000u), __builtin_bit_cast(float, w.y << 16), __builtin_bit_cast(float, w.y & 0xffff0000u)};
                const f32x4 v1 = {__builtin_bit_cast(float, w.z << 16), __builtin_bit_cast(float, w.z & 0xffff0000u), __builtin_bit_cast(float, w.w << 16), __builtin_bit_cast(float, w.w & 0xffff0000u)};
                v[bj][0] = v0 + acc[ai][bj][m][0]; v[bj][1] = v1 + acc[ai][bj][m][1]; }
            if (i + ND < 8) RES2_LD(i + ND, i % ND);
            _Pragma("unroll") for (int bj = 0; bj < 2; ++bj) { st_bf8(xh + off + bj * 128, v[bj][0], v[bj][1]); u32x2 q; q.x = cvt4_fp8(v[bj][0]); q.y = cvt4_fp8(v[bj][1]); *(u32x2*)(x8 + off + bj * 128) = q; } }
#undef RES2_LD
    }
};
struct EpiUp {
    static constexpr bool PERM = true, AFTER_DRAIN = false, LDSOPS = true;
    unsigned char* ACT; const float* rsl; const PG8_LAS int* tstart; const PG8_LAS int* cnt; const float* b_up; PG8_LAS unsigned char* eop;
    __device__ __forceinline__ void prefetch(const Unit& u, int slot, int wid, int lane) const {
        const int e = u.pn >> 3, pnl = u.pn & 7;
        if (wid == 4) __builtin_amdgcn_global_load_lds((const unsigned*)(rsl + (size_t)e * 32768 + (size_t)(u.pm - tstart[e]) * 256 + lane * 4), (PG8_LAS unsigned*)(eop + slot * 2048), 16, 0, 0);
        else if (wid == 5) __builtin_amdgcn_global_load_lds((const unsigned*)(b_up + (size_t)e * 2048 + pnl * 128 + (lane >> 5) * 1024 + (lane & 31) * 4), (PG8_LAS unsigned*)(eop + slot * 2048 + 1024), 16, 0, 0);
    }
    __device__ __forceinline__ void operator()(const f32x4 (&acc)[2][2][4][2], const Unit& u, int wr, int wc, int fr, int fq, int slot) const {
        const int e = u.pn >> 3, pnl = u.pn & 7;
        const int pos0 = (u.pm - tstart[e]) * 256 + wr * 64 + fr, nv = cnt[e];
        const PG8_LAS float* ls = (const PG8_LAS float*)(eop + slot * 2048) + wr * 64 + fr; const PG8_LAS float* lb = (const PG8_LAS float*)(eop + slot * 2048 + 1024) + wc * 32 + fq * 8;
        const f32x4 bg0 = *(const PG8_LAS f32x4*)lb, bg1 = *(const PG8_LAS f32x4*)(lb + 4), bl0 = *(const PG8_LAS f32x4*)(lb + 128), bl1 = *(const PG8_LAS f32x4*)(lb + 132);
        float rsv[2][4];
        EPI_ROWS rsv[ai][m] = (pos0 + ai * 128 + m * 16) < nv ? ls[ai * 128 + m * 16] : 0.f;
        EPI_ROWS { const int row = u.pm * 256 + ai * 128 + wr * 64 + m * 16 + fr; const float rs = rsv[ai][m];
            unsigned char* rp = ACT + (size_t)row * 1024 + pnl * 128 + wc * 32 + fq * 8; u32x2 w;
            _Pragma("unroll") for (int n = 0; n < 2; ++n) {
                const f32x4 c7 = {7.0f, 7.0f, 7.0f, 7.0f}, one = {1.0f, 1.0f, 1.0f, 1.0f};
                const f32x4 gl = __builtin_elementwise_min(acc[ai][0][m][n] * rs + (n ? bg1 : bg0), c7), li = __builtin_elementwise_min(__builtin_elementwise_max(acc[ai][1][m][n] * rs + (n ? bl1 : bl0), -c7), c7);
                const f32x4 t = gl * -2.4554669595930156f; f32x4 e; _Pragma("unroll") for (int i = 0; i < 4; ++i) e[i] = __builtin_amdgcn_exp2f(t[i]);
                const f32x4 a = e + one; f32x4 r; _Pragma("unroll") for (int i = 0; i < 4; ++i) r[i] = __builtin_amdgcn_rcpf(a[i]);
                const f32x4 o = (gl * r) * (li + one);
                if (n) w.y = cvt4_fp8(o); else w.x = cvt4_fp8(o); }
            *(u32x2*)rp = w; }
    }
};
struct EpiDown {
    static constexpr bool PERM = true, AFTER_DRAIN = false, LDSOPS = true;
    unsigned char* Y; const float* b_down; PG8_LAS unsigned char* eop;
    __device__ __forceinline__ void prefetch(const Unit& u, int slot, int wid, int lane) const {
        const int e = u.pn >> 2, pnl = u.pn & 3;
        if (wid == 4) __builtin_amdgcn_global_load_lds((const unsigned*)(b_down + (size_t)e * 1024 + pnl * 256 + lane * 4), (PG8_LAS unsigned*)(eop + slot * 2048), 16, 0, 0);
    }
    __device__ __forceinline__ void operator()(const f32x4 (&acc)[2][2][4][2], const Unit& u, int wr, int wc, int fr, int fq, int slot) const {
        const int pnl = u.pn & 3; const PG8_LAS float* lb = (const PG8_LAS float*)(eop + slot * 2048) + wc * 32 + fq * 8;
        f32x4 bv[2][2];
        _Pragma("unroll") for (int bj = 0; bj < 2; ++bj) _Pragma("unroll") for (int n = 0; n < 2; ++n) bv[bj][n] = *(const PG8_LAS f32x4*)(lb + bj * 128 + n * 4);
        EPI_ROWS { const int row = u.pm * 256 + ai * 128 + wr * 64 + m * 16 + fr; unsigned char* rp = Y + (size_t)row * 1024 + pnl * 256 + wc * 32 + fq * 8;
            _Pragma("unroll") for (int bj = 0; bj < 2; ++bj) { u32x2 w; w.x = cvt4_fp8(acc[ai][bj][m][0] + bv[bj][0]); w.y = cvt4_fp8(acc[ai][bj][m][1] + bv[bj][1]); *(u32x2*)(rp + bj * 128) = w; } }
    }
};
struct OrderMap : OrderBase {
    StaticOrder so;
    __device__ void init(int nM, int nN, int G, int c) { so.nM = nM; so.nN = nN; so.nwg = nM * nN; so.G = G; so.c = c; }
    __device__ bool next(int i, Unit& u) const { if (!so.next(i, u)) return false; u.pn += (u.pn >= 4 ? 2 : 0) + (u.pn >= 6 ? 2 : 0); return true; }
};
struct OrderVT : OrderBase {
    StaticOrder so;
    __device__ void init(int nN, int G, int c) { so.nM = 4; so.nN = nN; so.nwg = 4 * nN; so.G = G; so.c = c; }
    __device__ bool next(int i, Unit& u) const { if (!so.next(i, u)) return false; u.pm += (u.pm >= 2 ? 6 : 4); return true; }
};
__device__ __forceinline__ void map_unit(int L, int nM, int nN, int& pm, int& pn) {
    const int nwg = nM * nN; int wgid = L; { const int q = nwg / NXCD, r = nwg % NXCD, xcd = wgid % NXCD, off = wgid / NXCD; wgid = (xcd < r ? xcd * (q + 1) : r * (q + 1) + (xcd - r) * q) + off; }
    const int nig = WGM * nN, gid = wgid / nig, fm = gid * WGM, gsz = (nM - fm) < WGM ? (nM - fm) : WGM;
    pm = fm + ((wgid % nig) % gsz); pn = (wgid % nig) / gsz;
}
template <unsigned oHN, unsigned oWINT, unsigned oMN, unsigned oWCK, unsigned oWCV>
struct OrderP1 : OrderBase {
    int G, c; const char* ws;
    __device__ __forceinline__ bool next(int i, Unit& u) const {
        int L = i * G + c; if (L >= 1792) return false;
        if (L < 1152) { map_unit(L, 128, 9, u.pm, u.pn); u.pn += (u.pn >= 4 ? 2 : 0) + (u.pn >= 6 ? 2 : 0); return true; } L -= 1152;
        if (L < 512) { map_unit(L, 4, 128, u.pm, u.pn); u.pm += (u.pm >= 2 ? 6 : 4); u.pn |= 1 << 16; return true; } L -= 512;
        if (L < 64) { map_unit(L, 16, 4, u.pm, u.pn); u.pn |= 2 << 16; return true; } L -= 64;
        map_unit(L, 16, 4, u.pm, u.pn); u.pn |= 3 << 16; return true;
    }
    __device__ __forceinline__ const char* a_base(const Gemm&, const Unit& u) const { const int job = u.pn >> 16; unsigned o = oHN; o = job == 1 ? oWINT : o; o = job >= 2 ? oMN : o; return ws + o + (size_t)u.pm * (256 * 1024 * 2); }
    __device__ __forceinline__ const char* b_base(const Gemm&, const Unit& u) const { const int job = u.pn >> 16; unsigned o = oWINT; o = job == 1 ? oHN : o; o = job == 2 ? oWCK : o; o = job == 3 ? oWCV : o; return ws + o + (size_t)(u.pn & 0xffff) * (256 * 1024 * 2); }
};
struct MoeOrder : OrderBase {
    StaticOrder so; const PG8_LAS unsigned char* tile_e; int nN;
    __device__ void init(int nM, int nN_, int G, int c, const PG8_LAS unsigned char* te) { so.nM = nM; so.nN = nN_; so.nwg = nM * nN_; so.G = G; so.c = c; tile_e = te; nN = nN_; }
    __device__ bool next(int i, Unit& u) const { if (!so.next(i, u)) return false; u.pn += (int)tile_e[u.pm] * nN; return true; }
};


struct MoeOrderG : OrderBase {
    static constexpr bool GATHER = true;
    StaticOrder so; const PG8_LAS unsigned char* tile_e; const PG8_LAS int* tstart; const PG8_LAS int* cnt; const unsigned* list; PG8_LAS unsigned* gslot; int nN;
    __device__ void init(int nM, int nN_, int G, int c, const PG8_LAS unsigned char* te, const PG8_LAS int* ts, const PG8_LAS int* cn, const unsigned* li, PG8_LAS unsigned* gs) {
        so.nM = nM; so.nN = nN_; so.nwg = nM * nN_; so.G = G; so.c = c; tile_e = te; tstart = ts; cnt = cn; list = li; gslot = gs; nN = nN_; }
    __device__ bool next(int i, Unit& u) const { if (!so.next(i, u)) return false; u.pn += (int)tile_e[u.pm] * nN; return true; }
    __device__ __forceinline__ const char* a_base(const Gemm& g, const Unit&) const { return (const char*)g.A; }
    __device__ __forceinline__ const unsigned* rows(const Unit& u) const { const int e = u.pn / nN; return list + (size_t)e * 32768 + (size_t)(u.pm - tstart[e]) * 256; }
    __device__ __forceinline__ int nvalid(const Unit& u) const { const int e = u.pn / nN; return cnt[e] - (u.pm - tstart[e]) * 256; }
};
struct OrderX1 : OrderBase {
    StaticOrder so;
    __device__ void init(int G, int c) { so.nM = 128; so.nN = 4; so.nwg = 512; so.G = G; so.c = c; }
    __device__ bool next(int i, Unit& u) const { return so.next(i, u); }
    __device__ __forceinline__ const char* a_base(const Gemm& g, const Unit& u) const { return (const char*)(g.A + (size_t)u.pm * 256 * 1024 + u.pn * 256); }
    __device__ __forceinline__ const char* b_base(const Gemm& g, const Unit& u) const { return (const char*)(g.Bt + (size_t)(u.pm >> 3) * 256 * 1024 + u.pn * 256); }
};
struct OrderX2 : OrderBase {
    StaticOrder so;
    __device__ void init(int G, int c) { so.nM = 128; so.nN = 4; so.nwg = 512; so.G = G; so.c = c; }
    __device__ bool next(int i, Unit& u) const { return so.next(i, u); }
    __device__ __forceinline__ const char* a_base(const Gemm& g, const Unit& u) const { return (const char*)(g.A + (size_t)u.pm * 256 * 1024 + u.pn * 256); }
    __device__ __forceinline__ const char* b_base(const Gemm& g, const Unit& u) const { return (const char*)(g.Bt + (size_t)u.pn * 256 * 4096 + (u.pm >> 3) * 256); }
};
struct EpiSoftmax {
    static constexpr bool PERM = true, AFTER_DRAIN = false;
    bf16_t* PX; float* lp; PG8_LAS float* xch;
    __device__ __forceinline__ void operator()(const f32x4 (&acc)[2][2][4][2], const Unit& u, int wr, int wc, int fr, int fq) const {
        PG8_LAS char* rb = (PG8_LAS char*)xch + (wr * 64 + fr) * 16; asm volatile("" : "+v"(rb));
        PG8_LAS char* wb = rb + wc * 4; asm volatile("" : "+v"(wb));
        EPI_ROWS { float a = -INFINITY;
            EPI_COLS { const f32x4 v = acc[ai][bj][m][n]; a = fmaxf(a, fmaxf(fmaxf(v[0], v[1]), fmaxf(v[2], v[3]))); }
            a = fmaxf(a, __shfl_xor(a, 16)); a = fmaxf(a, __shfl_xor(a, 32));
            if (fq == 0) *(PG8_LAS float*)(wb + (ai * 128 + m * 16) * 16) = a; }
        asm volatile("s_waitcnt lgkmcnt(0)" ::: "memory"); __builtin_amdgcn_s_barrier(); asm volatile("" ::: "memory");
        const int row0 = u.pm * 256 + wr * 64 + fr; bf16_t* rp0 = PX + (size_t)row0 * 1024 + u.pn * 256 + wc * 32 + fq * 8; float* lp0 = lp + (size_t)row0 * 16 + u.pn * 4 + wc;
        EPI_ROWS { const f32x4 q = *(const PG8_LAS f32x4*)(rb + (ai * 128 + m * 16) * 16); const float mr = fmaxf(fmaxf(q[0], q[1]), fmaxf(q[2], q[3]));
            bf16_t* rp = rp0 + (size_t)(ai * 128 + m * 16) * 1024; float ps = 0.f;
            _Pragma("unroll") for (int bj = 0; bj < 2; ++bj) { f32x4 p[2];
                _Pragma("unroll") for (int n = 0; n < 2; ++n) _Pragma("unroll") for (int i = 0; i < 4; ++i) { p[n][i] = __builtin_amdgcn_exp2f(acc[ai][bj][m][n][i] - mr); ps += p[n][i]; }
                st_bf8(rp + bj * 128, p[0], p[1]); }
            ps += __shfl_xor(ps, 16); ps += __shfl_xor(ps, 32);
            if (fq == 0) lp0[(ai * 128 + m * 16) * 16] = ps; }
        asm volatile("s_waitcnt lgkmcnt(0)" ::: "memory"); __builtin_amdgcn_s_barrier(); asm volatile("" ::: "memory");
    }
};
struct EpiPV {
    static constexpr bool PERM = true, AFTER_DRAIN = false;
    bf16_t* O; const float* lp;
    __device__ __forceinline__ void operator()(const f32x4 (&acc)[2][2][4][2], const Unit& u, int wr, int wc, int fr, int fq) const {
        EPI_ROWS { const int row = u.pm * 256 + ai * 128 + wr * 64 + m * 16 + fr; const f32x4 q = *(const f32x4*)(lp + (size_t)row * 16 + u.pn * 4);
            const float inv = 1.0f / ((q[0] + q[1]) + (q[2] + q[3])); bf16_t* rp = O + (size_t)row * 1024 + u.pn * 256 + wc * 32 + fq * 8;
            _Pragma("unroll") for (int bj = 0; bj < 2; ++bj) st_bf8(rp + bj * 128, acc[ai][bj][m][0] * inv, acc[ai][bj][m][1] * inv); }
    }
};

template <unsigned oKX, unsigned oWCQR, unsigned oWCOT, unsigned oVX>
struct OrderGH : OrderBase {
    int G, c; const char* ws;
    __device__ __forceinline__ bool next(int i, Unit& u) const { int L = i * G + c; if (L >= 512) return false;
        if (L < 256) { u.pm = L >> 2; u.pn = L & 3; } else { L -= 256; u.pm = L >> 2; u.pn = (L & 3) | (1 << 16); } return true; }
    __device__ __forceinline__ const char* a_base(const Gemm&, const Unit& u) const { const int job = u.pn >> 16, pn = u.pn & 0xffff;
        return job == 0 ? ws + oKX + ((size_t)(u.pm >> 2) * 256 * 1024 + (u.pm & 3) * 256) * 2 : ws + oWCOT + ((size_t)(u.pm & 3) * 256 * 1024 + pn * 256) * 2; }
    __device__ __forceinline__ const char* b_base(const Gemm&, const Unit& u) const { const int job = u.pn >> 16, pn = u.pn & 0xffff;
        return job == 0 ? ws + oWCQR + ((size_t)pn * 256 * 1024 + (u.pm & 3) * 256) * 2 : ws + oVX + ((size_t)(u.pm >> 2) * 256 * 1024 + pn * 256) * 2; }
};
struct EpiGH {
    static constexpr bool PERM = true, AFTER_DRAIN = false;
    EpiPlain gt, ht;
    __device__ __forceinline__ void operator()(const f32x4 (&acc)[2][2][4][2], const Unit& u, int wr, int wc, int fr, int fq) const {
        Unit v; v.pm = u.pm; v.pn = u.pn & 0xffff; if ((u.pn >> 16) == 0) gt(acc, v, wr, wc, fr, fq); else ht(acc, v, wr, wc, fr, fq); }
};
struct OrderXS : OrderBase {
    StaticOrder so;
    __device__ void init(int G, int c) { so.nM = 128; so.nN = 4; so.nwg = 512; so.G = G; so.c = c; }
    __device__ bool next(int i, Unit& u) const { return so.next(i, u); }
    __device__ __forceinline__ const char* b_base(const Gemm& g, const Unit& u) const { return (const char*)(g.Bt + ((size_t)(u.pm >> 3) * 1024 + u.pn * 256) * 1024); }
};
struct EpiSoftmaxN {
    static constexpr bool PERM = true, AFTER_DRAIN = false;
    bf16_t* PX; const float* ssp; PG8_LAS float* xmax; PG8_LAS float* xsum;
    __device__ __forceinline__ void operator()(f32x4 (&acc)[2][2][4][2], const Unit& u, int wr, int wc, int fr, int fq) const {
        PG8_LAS char* rb = (PG8_LAS char*)xmax + (wr * 64 + fr) * 16; asm volatile("" : "+v"(rb));
        PG8_LAS char* wb = rb + wc * 4; asm volatile("" : "+v"(wb));
        PG8_LAS char* rb2 = (PG8_LAS char*)xsum + (wr * 64 + fr) * 16; asm volatile("" : "+v"(rb2));
        PG8_LAS char* wb2 = rb2 + wc * 4; asm volatile("" : "+v"(wb2));
        const int row0 = u.pm * 256 + wr * 64 + fr;
        f32x4 sq[2][4];
        EPI_ROWS sq[ai][m] = ((const f32x4*)(ssp + (size_t)(row0 + ai * 128 + m * 16) * 16))[fq];
        EPI_ROWS { float ss = (sq[ai][m][0] + sq[ai][m][1]) + (sq[ai][m][2] + sq[ai][m][3]); ss += __shfl_xor(ss, 16); ss += __shfl_xor(ss, 32);
            const float rs = rsqrtf(ss * (1.0f / 1024.0f) + 1e-6f) * QSCALE_X; float a = -INFINITY;
            EPI_COLS { f32x4 v = acc[ai][bj][m][n] * rs; acc[ai][bj][m][n] = v; a = fmaxf(a, fmaxf(fmaxf(v[0], v[1]), fmaxf(v[2], v[3]))); }
            a = fmaxf(a, __shfl_xor(a, 16)); a = fmaxf(a, __shfl_xor(a, 32));
            if (fq == 0) *(PG8_LAS float*)(wb + (ai * 128 + m * 16) * 16) = a; }
        asm volatile("s_waitcnt lgkmcnt(0)" ::: "memory"); __builtin_amdgcn_s_barrier(); asm volatile("" ::: "memory");
        EPI_ROWS { const f32x4 q = *(const PG8_LAS f32x4*)(rb + (ai * 128 + m * 16) * 16); const float mr = fmaxf(fmaxf(q[0], q[1]), fmaxf(q[2], q[3])); float ps = 0.f;
            EPI_COLS { f32x4 p; _Pragma("unroll") for (int i = 0; i < 4; ++i) { p[i] = __builtin_amdgcn_exp2f(acc[ai][bj][m][n][i] - mr); ps += p[i]; } acc[ai][bj][m][n] = p; }
            ps += __shfl_xor(ps, 16); ps += __shfl_xor(ps, 32);
            if (fq == 0) *(PG8_LAS float*)(wb2 + (ai * 128 + m * 16) * 16) = ps; }
        asm volatile("s_waitcnt lgkmcnt(0)" ::: "memory"); __builtin_amdgcn_s_barrier(); asm volatile("" ::: "memory");
        bf16_t* rp0 = PX + (size_t)row0 * 1024 + u.pn * 256 + wc * 32 + fq * 8;
        EPI_ROWS { const f32x4 q = *(const PG8_LAS f32x4*)(rb2 + (ai * 128 + m * 16) * 16); const float inv = __builtin_amdgcn_rcpf((q[0] + q[1]) + (q[2] + q[3]));
            bf16_t* rp = rp0 + (size_t)(ai * 128 + m * 16) * 1024;
            _Pragma("unroll") for (int bj = 0; bj < 2; ++bj) st_bf8(rp + bj * 128, acc[ai][bj][m][0] * inv, acc[ai][bj][m][1] * inv); }
    }
};
struct OrderXO : OrderBase {
    StaticOrder so;
    __device__ void init(int G, int c) { so.nM = 128; so.nN = 4; so.nwg = 512; so.G = G; so.c = c; }
    __device__ bool next(int i, Unit& u) const { return so.next(i, u); }
    __device__ __forceinline__ const char* b_base(const Gemm& g, const Unit& u) const { return (const char*)(g.Bt + ((size_t)(u.pm >> 3) * 1024 + u.pn * 256) * 1024); }
};
typedef int v4i_t __attribute__((ext_vector_type(4))); typedef int v8i_t __attribute__((ext_vector_type(8)));
__device__ __forceinline__ v8i_t cat8(bf16x8 lo, bf16x8 hi) { return __builtin_shufflevector(__builtin_bit_cast(v4i_t, lo), __builtin_bit_cast(v4i_t, hi), 0, 1, 2, 3, 4, 5, 6, 7); }
__device__ __forceinline__ void mfma8(f32x4& acc, v8i_t w, v8i_t a, int sw, int sa) {
    asm volatile("s_nop 1\n\tv_mfma_scale_f32_16x16x128_f8f6f4 %0, %1, %2, %0, %3, %4 op_sel_hi:[0,0,0]" : "+v"(acc) : "v"(w), "v"(a), "v"(sw), "v"(sa)); }
constexpr int PF_D = 4, PF_LDS = 137216;
template <class Epi, class Sched, bool ALIGN_EPI = false, bool SP2 = false, bool FP8 = false, bool PF = false, int DBG = 0>
__device__ __forceinline__ void gemm_phase(PG8_LAS unsigned char* lds, const Gemm g, const Sched& S, const Epi& E) {
    const int tid = threadIdx.x, wid = __builtin_amdgcn_readfirstlane(tid >> 6), lane = tid & 63, wr = wid >> 2, wc = wid & 3, fr = lane & 15, fq = lane >> 4;
    const int K = g.K, nt = K / BK;
    unsigned voffA[2], voffB[2];
    unsigned gC[2][2];
#pragma unroll
    for (int i = 0; i < 2; ++i) { int R, C; stage_rc(tid * 16 + i * 8192, R, C); const int Rb = Epi::PERM ? ((R & ~31) + perm32(R & 31)) : R;
        voffA[i] = (unsigned)(R * g.lda + C) * 2u; voffB[i] = (unsigned)(Rb * g.ldb + C) * 2u; }
    const bool pfA = !Sched::GATHER && wid < 4;
    const unsigned pfoff = (unsigned)((((wid >> 1) & 1) * HALF + (wid & 1) * 64 + lane) * (pfA ? g.lda : g.ldb)) * 2u;
    const size_t kstep = (size_t)(BK * 2);
    const size_t hstepA = (size_t)HALF * g.lda * 2, hstepB = (size_t)HALF * g.ldb * 2;
    const unsigned ldsw = (unsigned)wid * 1024u;
    const int aoff = lds_byte(wr * 64 + fr, fq * 8), boff = lds_byte(wc * 32 + fr, fq * 8);
#define PG8_SA(b, h) (((b) * 2 + (h)) * HTB)
#define PG8_SB(b, h) ((4 + (b) * 2 + (h)) * HTB)
#define PG8_STAGE(bufoff, gbase, voff) do { if constexpr ((DBG & 2) == 0) _Pragma("unroll") for (int _i = 0; _i < 2; ++_i) \
        __builtin_amdgcn_global_load_lds((const unsigned*)((const char*)(gbase) + (voff)[_i]), (PG8_LAS unsigned*)(lds + (bufoff) + ldsw + _i * 8192), 16, 0, 0); } while (0)
#define PG8_STAGE_A(bufoff, ptr, h, nx) do { if constexpr (Sched::GATHER) { PG8_STAGE(bufoff, ptr, gC[h]); } else { PG8_STAGE(bufoff, (ptr) + ((h) ? hstepA : 0), voffA); } } while (0)
#define PG8_LDA(dst, b, h) do { if constexpr ((DBG & 8) == 0) _Pragma("unroll") for (int m = 0; m < 4; ++m) _Pragma("unroll") for (int k = 0; k < 2; ++k) dst[m][k] = *(const PG8_LAS bf16x8*)(lds + PG8_SA(b, h) + aoff + m * 2048 + k * 1024); } while (0)
#define PG8_LDB(dst, b, h) do { if constexpr ((DBG & 8) == 0) _Pragma("unroll") for (int n = 0; n < 2; ++n) _Pragma("unroll") for (int k = 0; k < 2; ++k) dst[n][k] = *(const PG8_LAS bf16x8*)(lds + PG8_SB(b, h) + boff + n * 2048 + k * 1024); } while (0)
#define PG8_MMA(ai, bj, At, Bt) do { if constexpr ((DBG & 1) == 0) { __builtin_amdgcn_s_setprio(1); \
        if constexpr (FP8) { _Pragma("unroll") for (int m = 0; m < 4; ++m) _Pragma("unroll") for (int n = 0; n < 2; ++n) \
            mfma8(acc[ai][bj][m][n], cat8(Bt[n][0], Bt[n][1]), cat8(At[m][0], At[m][1]), g.sb, g.sa); } \
        else { _Pragma("unroll") for (int m = 0; m < 4; ++m) _Pragma("unroll") for (int n = 0; n < 2; ++n) _Pragma("unroll") for (int k = 0; k < 2; ++k) \
            acc[ai][bj][m][n] = __builtin_amdgcn_mfma_f32_16x16x32_bf16(Bt[n][k], At[m][k], acc[ai][bj][m][n], 0, 0, 0); } \
        __builtin_amdgcn_s_setprio(0); } } while (0)
#define PG8_WAIT_V(n) asm volatile("s_waitcnt vmcnt(" #n ")" ::: "memory")
#define PG8_WAIT_VP() do { if constexpr (PF) asm volatile("s_waitcnt vmcnt(9)" ::: "memory"); else asm volatile("s_waitcnt vmcnt(8)" ::: "memory"); } while (0)
#define PG8_PREFETCH(tp) do { if constexpr (PF) { const int tp_ = (tp); const char* pb_ = tp_ < nt ? (pfA ? cA : cB) + (size_t)tp_ * kstep : (pfA ? nA : nB) + (size_t)(tp_ - nt) * kstep; \
        __builtin_amdgcn_global_load_lds((const unsigned*)(pb_ + pfoff), (PG8_LAS unsigned*)(lds + PF_LDS + wid * 256), 4, 0, 0); } } while (0)
#define PG8_WAIT_L(n) asm volatile("s_waitcnt lgkmcnt(" #n ")" ::: "memory")
#define PG8_BAR __builtin_amdgcn_s_barrier()
#define PG8_SCHED __builtin_amdgcn_sched_barrier(0)
    Unit cur, nxt; int ui = 0;
    if (!S.next(0, cur)) return;
    f32x4 acc[2][2][4][2];
#pragma unroll
    for (int a = 0; a < 2; ++a)
#pragma unroll
        for (int b = 0; b < 2; ++b)
#pragma unroll
            for (int m = 0; m < 4; ++m)
#pragma unroll
                for (int n = 0; n < 2; ++n) acc[a][b][m][n] = (f32x4){0.f, 0.f, 0.f, 0.f};
    bf16x8 At[4][2], B0[2][2], B1[2][2];
    const char* cA = S.a_base(g, cur); const char* cB = S.b_base(g, cur);
    if constexpr (Sched::GATHER) { const unsigned* rp = S.rows(cur); const int nv = S.nvalid(cur);
#pragma unroll
        for (int h = 0; h < 2; ++h)
#pragma unroll
            for (int i = 0; i < 2; ++i) { int R, C; stage_rc(tid * 16 + i * 8192, R, C); const int r = h * HALF + R; const unsigned tok = r < nv ? rp[r] : 0u; gC[h][i] = tok * (unsigned)(g.lda * 2) + (unsigned)C * 2u; } }
    constexpr bool LO = epi_ldsops<Epi>::value; int us = 0;
    if constexpr (LO) E.prefetch(cur, 0, wid, lane);
    S.a_ready(cur);
    if constexpr (SP2) {
        PG8_STAGE(PG8_SB(0, 0), cB, voffB); PG8_STAGE(PG8_SB(0, 1), cB + hstepB, voffB); PG8_STAGE_A(PG8_SA(0, 0), cA, 0, 0); PG8_STAGE_A(PG8_SA(0, 1), cA, 1, 0);
        if (wr == 1) PG8_BAR;
        PG8_WAIT_V(2); PG8_BAR;
        PG8_STAGE(PG8_SB(1, 0), cB + kstep, voffB); PG8_STAGE_A(PG8_SA(1, 0), cA + kstep, 0, 0); PG8_STAGE(PG8_SB(1, 1), cB + hstepB + kstep, voffB);
        PG8_WAIT_V(6); PG8_BAR;
    } else {
        PG8_STAGE(PG8_SB(0, 0), cB, voffB); PG8_STAGE_A(PG8_SA(0, 0), cA, 0, 0); PG8_STAGE(PG8_SB(0, 1), cB + hstepB, voffB); PG8_STAGE_A(PG8_SA(0, 1), cA, 1, 0);
        if (wr == 1) PG8_BAR;
        PG8_WAIT_V(4); PG8_BAR;
        PG8_STAGE(PG8_SB(1, 0), cB + kstep, voffB); PG8_STAGE_A(PG8_SA(1, 0), cA + kstep, 0, 0); PG8_STAGE(PG8_SB(1, 1), cB + hstepB + kstep, voffB);
        PG8_WAIT_V(6); PG8_BAR;
    }
    for (;;) {
        const bool has_next = S.next(ui + 1, nxt);
        const char* nA = has_next ? S.a_base(g, nxt) : cA; const char* nB = has_next ? S.b_base(g, nxt) : cB;
        if constexpr (LO) { if (has_next) E.prefetch(nxt, us == 2 ? 0 : us + 1, wid, lane); }
        if constexpr (Sched::GATHER) { if (has_next && wid < 4)
            __builtin_amdgcn_global_load_lds((const unsigned*)(S.rows(nxt) + wid * 64 + lane), (PG8_LAS unsigned*)(S.gslot + ((ui + 1) & 1) * 256 + wid * 64), 4, 0, 0); }
#pragma nounroll
        for (int t = 0; t < nt; t += 2) {
            const bool last = (t == nt - 2);
            const char* a1 = cA + (size_t)(t + 1) * kstep;
            const char* a2 = last ? nA : cA + (size_t)(t + 2) * kstep; const char* b2 = last ? nB : cB + (size_t)(t + 2) * kstep;
            const char* a3 = a2 + kstep; const char* b3 = b2 + kstep;
            if (last && has_next) S.a_ready(nxt);
            if constexpr (SP2) {
            PG8_LDB(B0, 0, 0); PG8_LDB(B1, 0, 1); PG8_SCHED; PG8_LDA(At, 0, 0); PG8_STAGE_A(PG8_SA(1, 1), a1, 1, 0);
            if constexpr (Sched::GATHER) { if (last && has_next) {
                const PG8_LAS unsigned* sl = S.gslot + ((ui + 1) & 1) * 256; const int nv = S.nvalid(nxt);
#pragma unroll
                for (int h = 0; h < 2; ++h)
#pragma unroll
                    for (int i = 0; i < 2; ++i) { int R, C; stage_rc(tid * 16 + i * 8192, R, C); const int r = h * HALF + R; const unsigned v = sl[r]; const unsigned tok = r < nv ? v : 0u; gC[h][i] = tok * (unsigned)(g.lda * 2) + (unsigned)C * 2u; } } }
            PG8_WAIT_VP(); PG8_WAIT_L(0); PG8_BAR; PG8_MMA(0, 0, At, B0); PG8_MMA(0, 1, At, B1); PG8_BAR; PG8_SCHED;
            PG8_LDA(At, 0, 1); PG8_STAGE(PG8_SB(0, 0), b2, voffB); PG8_STAGE(PG8_SB(0, 1), b2 + hstepB, voffB); PG8_STAGE_A(PG8_SA(0, 0), a2, 0, 1); PG8_PREFETCH(t + PF_D);
            PG8_WAIT_VP(); PG8_WAIT_L(0); PG8_BAR; PG8_MMA(1, 0, At, B0); PG8_MMA(1, 1, At, B1); PG8_BAR; PG8_SCHED;
            PG8_LDB(B0, 1, 0); PG8_LDB(B1, 1, 1); PG8_SCHED; PG8_LDA(At, 1, 0); PG8_STAGE_A(PG8_SA(0, 1), a2, 1, 1);
            PG8_WAIT_VP(); PG8_WAIT_L(0); PG8_BAR; PG8_MMA(0, 0, At, B0); PG8_MMA(0, 1, At, B1); PG8_BAR; PG8_SCHED;
            PG8_LDA(At, 1, 1); PG8_STAGE(PG8_SB(1, 0), b3, voffB); PG8_STAGE(PG8_SB(1, 1), b3 + hstepB, voffB); PG8_STAGE_A(PG8_SA(1, 0), a3, 0, 1); PG8_PREFETCH(t + 1 + PF_D);
            PG8_WAIT_VP(); PG8_WAIT_L(0); PG8_BAR; PG8_MMA(1, 0, At, B0); PG8_MMA(1, 1, At, B1); PG8_BAR; PG8_SCHED;
            } else {
            PG8_LDB(B0, 0, 0); PG8_SCHED; PG8_LDA(At, 0, 0); PG8_STAGE_A(PG8_SA(1, 1), a1, 1, 0);
            PG8_WAIT_L(8); PG8_BAR; PG8_WAIT_L(0); PG8_MMA(0, 0, At, B0); PG8_BAR; PG8_SCHED;
            PG8_LDB(B1, 0, 1); PG8_STAGE(PG8_SB(0, 0), b2, voffB);
            PG8_BAR; PG8_WAIT_L(0); PG8_MMA(0, 1, At, B1); PG8_BAR;
            PG8_LDA(At, 0, 1); PG8_STAGE_A(PG8_SA(0, 0), a2, 0, 1);
            PG8_BAR; PG8_WAIT_L(0); PG8_MMA(1, 0, At, B0); PG8_BAR; PG8_SCHED;
            PG8_STAGE(PG8_SB(0, 1), b2 + hstepB, voffB);
            PG8_WAIT_V(6); PG8_BAR; PG8_MMA(1, 1, At, B1); PG8_BAR;
            PG8_LDB(B0, 1, 0); PG8_SCHED; PG8_LDA(At, 1, 0); PG8_STAGE_A(PG8_SA(0, 1), a2, 1, 1);
            PG8_WAIT_L(8); PG8_BAR; PG8_WAIT_L(0); PG8_MMA(0, 0, At, B0); PG8_BAR; PG8_SCHED;
            PG8_LDB(B1, 1, 1); PG8_STAGE(PG8_SB(1, 0), b3, voffB);
            PG8_BAR; PG8_WAIT_L(0); PG8_MMA(0, 1, At, B1); PG8_BAR;
            PG8_LDA(At, 1, 1); PG8_STAGE_A(PG8_SA(1, 0), a3, 0, 1);
            PG8_BAR; PG8_WAIT_L(0); PG8_MMA(1, 0, At, B0); PG8_BAR; PG8_SCHED;
            PG8_STAGE(PG8_SB(1, 1), b3 + hstepB, voffB);
            PG8_WAIT_V(6); PG8_BAR; PG8_MMA(1, 1, At, B1); PG8_BAR;
            }
        }
        if constexpr (ALIGN_EPI) { if (wr == 0) PG8_BAR; }
        if constexpr (FP8) asm volatile("s_nop 15\n\ts_nop 15" ::: "memory");
        if constexpr (!Epi::AFTER_DRAIN && (DBG & 4) == 0) { if constexpr (LO) E(acc, cur, wr, wc, fr, fq, us); else E(acc, cur, wr, wc, fr, fq); S.done(cur); }
        if (!has_next) break;
#pragma unroll
        for (int a = 0; a < 2; ++a)
#pragma unroll
            for (int b = 0; b < 2; ++b)
#pragma unroll
                for (int m = 0; m < 4; ++m)
#pragma unroll
                    for (int n = 0; n < 2; ++n) acc[a][b][m][n] = (f32x4){0.f, 0.f, 0.f, 0.f};
        cur = nxt; cA = nA; cB = nB; ++ui; us = us == 2 ? 0 : us + 1;
        if constexpr (ALIGN_EPI) { if (wr == 1) PG8_BAR; }
    }
    PG8_WAIT_V(0);
    if constexpr (!ALIGN_EPI) { if (wr == 0) PG8_BAR; }
    PG8_BAR;
    if constexpr (Epi::AFTER_DRAIN) { E.fused(acc, cur, wr, wc, fr, fq, lds, wid, lane); S.done(cur); }
#undef PG8_SA
#undef PG8_SB
#undef PG8_STAGE
#undef PG8_STAGE_A
#undef PG8_LDA
#undef PG8_LDB
#undef PG8_MMA
#undef PG8_WAIT_V
#undef PG8_WAIT_VP
#undef PG8_PREFETCH
#undef PG8_WAIT_L
#undef PG8_BAR
#undef PG8_SCHED
}
}
constexpr int NTOK = 32768, DM = 1024, SEQ = 2048, NBATCH = 16, MEMLEN = 256, NMEM = NBATCH * MEMLEN, INW = 3088, NEXP = 32, TOPK = 4;
constexpr int PW = 3072;
constexpr int MAXTILES = 544;
constexpr float EPS = 1e-6f;
constexpr int NWAVES = 8;
constexpr size_t MiB = 1u << 20;
constexpr size_t WS_CTL = 0, CTL_ZERO_BYTES = 64 * 1024;
constexpr size_t WS_WINT = 2 * MiB, WS_WOUT = 10 * MiB, WS_WCQ = 12 * MiB, WS_WCK = 14 * MiB, WS_WCV = 16 * MiB, WS_WCO = 18 * MiB;
constexpr size_t WS_WR = 20 * MiB, WS_CS = 21 * MiB, WS_SSP1 = 24 * MiB, WS_GATE = 27 * MiB, WS_ASSIGN = 28 * MiB, WS_LIST = 29 * MiB;
constexpr size_t WS_RSL = 842 * MiB;
constexpr size_t WS_X2B = 378 * MiB;
constexpr size_t WS_WUP = 34 * MiB, WS_WDN = 162 * MiB, WS_KX = 226 * MiB, WS_VXT = 234 * MiB;
constexpr size_t WS_HN = 242 * MiB, WS_CAT = 242 * MiB, WS_MN = 306 * MiB, WS_P = 314 * MiB, WS_LA = 506 * MiB, WS_VT = 538 * MiB;
constexpr size_t WS_X1B = 314 * MiB, WS_GT = 378 * MiB, WS_HT = 410 * MiB, WS_PX = 506 * MiB;
constexpr size_t WS_GVT = 602 * MiB;
constexpr size_t WS_ACT = 570 * MiB, WS_Y = 706 * MiB, WS_END = 846 * MiB;
constexpr int CW_Q2 = 128;
constexpr int CW_CNT = 1024;
constexpr int CW_PROBE = 192;
constexpr int CW_BAR = 4096;
constexpr int RING_OFF = 0, RING_BYTES = 131072;
constexpr int LDSCTL_OFF = RING_BYTES, MISC_OFF = LDSCTL_OFF + 320;
constexpr int TAB_OFF = LDSCTL_OFF + 512;
constexpr int TAB_TSTART = TAB_OFF + 576, TAB_CNT = TAB_TSTART + 144;
constexpr int XCH2_OFF = LDSCTL_OFF + 6144;
constexpr int XCH_OFF = LDSCTL_OFF + 2048;
constexpr int TS_OFF = TAB_CNT + 128;
constexpr int EOP_OFF = LDSCTL_OFF + 10240;
constexpr int LDS_BYTES = 147456;

#define GAS __attribute__((address_space(1)))
#define LAS __attribute__((address_space(3)))
typedef unsigned short bf16;
typedef unsigned v4u __attribute__((ext_vector_type(4)));
typedef float f32x4 __attribute__((ext_vector_type(4)));
typedef short bf16x8 __attribute__((ext_vector_type(8)));
typedef GAS unsigned gu32;
typedef GAS unsigned long long gu64;
#define RLX_AGENT __ATOMIC_RELAXED, __HIP_MEMORY_SCOPE_AGENT
#define LDS_WAIT() asm volatile("s_waitcnt lgkmcnt(0)" ::: "memory")
#define VM_WAIT() asm volatile("s_waitcnt vmcnt(0)" ::: "memory")
__device__ __forceinline__ unsigned long long rt() { return __builtin_amdgcn_s_memrealtime(); }
__device__ __forceinline__ unsigned f2bf(float f) { unsigned u = __builtin_bit_cast(unsigned, f); return (u + 0x7fffu + ((u >> 16) & 1u)) >> 16; }
__device__ __forceinline__ unsigned pk2(float lo, float hi) { return f2bf(lo) | (f2bf(hi) << 16); }

#define XB_TMO      128
#define XB_XCNT(j)  (256  + 64 * (j))
#define XB_XSUB(j)  (1280 + 64 * (j))
#define XB_XGEN(j)  (2304 + 64 * (j))
#define XB_TOP      3328
#define XB_TOPGEN   3392
#define XCD_BAR_WORDS 3456
#define XB_SPIN_CAP (1u << 18)

__device__ __forceinline__ unsigned xb_ld(unsigned* p)              { return __hip_atomic_load(p, __ATOMIC_RELAXED, __HIP_MEMORY_SCOPE_AGENT); }
__device__ __forceinline__ unsigned xb_add(unsigned* p, unsigned v) { return __hip_atomic_fetch_add(p, v, __ATOMIC_RELAXED, __HIP_MEMORY_SCOPE_AGENT); }
__device__ __forceinline__ unsigned xb_xcc_id() { return (unsigned)__builtin_amdgcn_s_getreg((3 << 11) | 20) & 0xFu; }
#define XB_SPIN(cond, bar) do { unsigned _sp = 0; while (cond) { __builtin_amdgcn_s_sleep(1); \
    if ((++_sp & 255u) == 0u) { if (xb_ld(&(bar)[XB_TMO])) break; if (_sp > XB_SPIN_CAP) { atomicAdd(&(bar)[XB_TMO], 1u); break; } } } } while (0)

struct XcdBarrier {
    unsigned* bar; unsigned x;
    volatile LAS unsigned* st;
};

__device__ __forceinline__ XcdBarrier xcd_barrier_post(unsigned* bar, volatile LAS unsigned* st) {
    XcdBarrier b; b.bar = bar; b.x = xb_xcc_id(); b.st = st;
    if (threadIdx.x == 0) (void)xb_add(&bar[XB_XCNT(b.x)], 1u);
    return b;
}
__device__ __forceinline__ void xcd_barrier_complete(unsigned* bar, unsigned x, unsigned& nloc, unsigned& nx) {
    const unsigned G = gridDim.x * gridDim.y * gridDim.z;
    unsigned sum, cnt, mine, sp = 0u;
    for (;;) {
        sum = 0u; cnt = 0u; mine = 0u;
#pragma unroll
        for (unsigned j = 0; j < 16; ++j) { const unsigned c = xb_ld(&bar[XB_XCNT(j)]); sum += c; cnt += (c > 0u) ? 1u : 0u; mine = (j == x) ? c : mine; }
        if (sum == G) break;
        __builtin_amdgcn_s_sleep(1);
        if ((++sp & 255u) == 0u) { if (xb_ld(&bar[XB_TMO])) break; if (sp > XB_SPIN_CAP) { atomicAdd(&bar[XB_TMO], 1u); break; } }
    }
    nloc = mine > 0u ? mine : 1u; nx = cnt > 0u ? cnt : 1u;
}

__device__ __forceinline__ void xcd_barrier(const XcdBarrier& b) {
    asm volatile("s_waitcnt vmcnt(0)" ::: "memory");
    __syncthreads();
    if (threadIdx.x == 0) {
        unsigned* bar = b.bar;
        __builtin_amdgcn_s_waitcnt(0);
        unsigned nloc = b.st[0], nx = b.st[1];
        if (nloc == 0u) { xcd_barrier_complete(bar, b.x, nloc, nx); b.st[0] = nloc; b.st[1] = nx; }
        const unsigned old = xb_add(&bar[XB_XSUB(b.x)], 1u);
        const unsigned gen = old / nloc;
        if (old + 1u == (gen + 1u) * nloc) {
            __builtin_amdgcn_fence(__ATOMIC_RELEASE, "agent");
            asm volatile("s_waitcnt vmcnt(0)" ::: "memory");
            const unsigned og = xb_add(&bar[XB_TOP], 1u);
            const unsigned tg = og / nx;
            if (og + 1u == (tg + 1u) * nx) xb_add(&bar[XB_TOPGEN], 1u);
            else XB_SPIN(xb_ld(&bar[XB_TOPGEN]) == tg, bar);
            __builtin_amdgcn_fence(__ATOMIC_ACQUIRE, "agent");
            xb_add(&bar[XB_XGEN(b.x)], 1u);
            asm volatile("s_waitcnt vmcnt(0)" ::: "memory");
        } else {
            XB_SPIN(xb_ld(&bar[XB_XGEN(b.x)]) == gen, bar);
            __builtin_amdgcn_fence(__ATOMIC_ACQUIRE, "agent");
            asm volatile("s_waitcnt vmcnt(0)" ::: "memory");
        }
    }
    __syncthreads();
}
typedef short bf16x4 __attribute__((ext_vector_type(4)));
typedef unsigned v2u __attribute__((ext_vector_type(2)));
struct Frame {
    LAS unsigned char* lds;
    volatile LAS unsigned* MISC;
    gu32* ctl;
    int tid, lane, wave;
    int vcu, G;
    unsigned char* ws;
    float* out;
};
__device__ __forceinline__ int lane_here() { int t = (int)threadIdx.x; asm volatile("" : "+v"(t)); return t & 63; }
__device__ __forceinline__ float bf2f(bf16 b) { return __builtin_bit_cast(float, (unsigned)b << 16); }
__device__ __forceinline__ float wave_sum(float v) {
#pragma unroll
    for (int o = 1; o < 64; o <<= 1) v += __shfl_xor(v, o);
    return v;
}
__device__ __forceinline__ float xmax16(float m) { auto rr = __builtin_amdgcn_permlane16_swap(__float_as_uint(m), __float_as_uint(m), false, false); return fmaxf(__uint_as_float(rr[0]), __uint_as_float(rr[1])); }
__device__ __forceinline__ float xmax32(float m) { auto rr = __builtin_amdgcn_permlane32_swap(__float_as_uint(m), __float_as_uint(m), false, false); return fmaxf(__uint_as_float(rr[0]), __uint_as_float(rr[1])); }
__device__ __forceinline__ f32x4 mfma16(bf16x8 a, bf16x8 b, f32x4 c) { return __builtin_amdgcn_mfma_f32_16x16x32_bf16(a, b, c, 0, 0, 0); }

__device__ __forceinline__ void p0_transpose_item(const float* W, int ldw, const float* gain, bf16* WT, int K, int k0, int n0, size_t orow0, int lane) {
    const int n4 = lane & 15, kq = lane >> 4;
    const float* src = W + (size_t)(k0 + 16 * kq) * ldw + n0 + 4 * n4;
    f32x4 v[16];
#pragma unroll
    for (int i = 0; i < 16; ++i) v[i] = __builtin_nontemporal_load((const f32x4*)(src + (size_t)i * ldw));
    if (gain) { const f32x4* gp = (const f32x4*)(gain + k0 + 16 * kq);
#pragma unroll
        for (int q = 0; q < 4; ++q) { const f32x4 gq = gp[q];
#pragma unroll
            for (int r = 0; r < 4; ++r) v[4 * q + r] = v[4 * q + r] * gq[r]; } }
    bf16* dst = WT + (orow0 + 4 * n4) * (size_t)K + k0 + 16 * kq;
#pragma unroll
    for (int j = 0; j < 4; ++j) { v4u o0, o1;
        o0.x = pg8::cvtpk(v[0][j], v[1][j]); o0.y = pg8::cvtpk(v[2][j], v[3][j]); o0.z = pg8::cvtpk(v[4][j], v[5][j]); o0.w = pg8::cvtpk(v[6][j], v[7][j]);
        o1.x = pg8::cvtpk(v[8][j], v[9][j]); o1.y = pg8::cvtpk(v[10][j], v[11][j]); o1.z = pg8::cvtpk(v[12][j], v[13][j]); o1.w = pg8::cvtpk(v[14][j], v[15][j]);
        *(v4u*)(dst + (size_t)j * K) = o0; *(v4u*)(dst + (size_t)j * K + 8) = o1; }
}
__device__ __forceinline__ void p0_transpose_item8(const float* W, int ldw, const float* gain, unsigned char* WT, int K, int k0, int n0, size_t orow0, int lane) {
    const int n4 = lane & 15, kq = lane >> 4;
    const float* src = W + (size_t)(k0 + 16 * kq) * ldw + n0 + 4 * n4;
    f32x4 v[16];
#pragma unroll
    for (int i = 0; i < 16; ++i) v[i] = __builtin_nontemporal_load((const f32x4*)(src + (size_t)i * ldw));
    { const f32x4* gp = (const f32x4*)(gain + k0 + 16 * kq);
#pragma unroll
        for (int q = 0; q < 4; ++q) { f32x4 gq = {32.f, 32.f, 32.f, 32.f}; if (gain) gq = gp[q] * 32.0f;
#pragma unroll
            for (int r = 0; r < 4; ++r) v[4 * q + r] = v[4 * q + r] * gq[r]; } }
    unsigned char* dst = WT + (orow0 + 4 * n4) * (size_t)K + k0 + 16 * kq;
#pragma unroll
    for (int j = 0; j < 4; ++j) { v4u o;
        o.x = pg8::cvt4_fp8((f32x4){v[0][j], v[1][j], v[2][j], v[3][j]}); o.y = pg8::cvt4_fp8((f32x4){v[4][j], v[5][j], v[6][j], v[7][j]});
        o.z = pg8::cvt4_fp8((f32x4){v[8][j], v[9][j], v[10][j], v[11][j]}); o.w = pg8::cvt4_fp8((f32x4){v[12][j], v[13][j], v[14][j], v[15][j]});
        *(v4u*)(dst + (size_t)j * K) = o; }
}
template <int NR> __device__ __forceinline__ void rms_rows_to_bf16(const float* const (&xrow)[NR], const float* g, bf16* const (&orow)[NR], int lane) {
    f32x4 v[NR][4]; float s[NR];
#pragma unroll
    for (int r = 0; r < NR; ++r) { const f32x4* xr = (const f32x4*)xrow[r] + lane;
#pragma unroll
        for (int j = 0; j < 4; ++j) v[r][j] = __builtin_nontemporal_load(xr + 64 * j); }
    const f32x4* gr = (const f32x4*)g + lane; f32x4 gg[4];
#pragma unroll
    for (int j = 0; j < 4; ++j) gg[j] = gr[64 * j];
#pragma unroll
    for (int r = 0; r < NR; ++r) { s[r] = 0.f;
#pragma unroll
        for (int j = 0; j < 4; ++j) s[r] += (v[r][j].x * v[r][j].x + v[r][j].y * v[r][j].y) + (v[r][j].z * v[r][j].z + v[r][j].w * v[r][j].w); }
#pragma unroll
    for (int r = 0; r < NR; ++r) { const float rs = rsqrtf(wave_sum(s[r]) * (1.0f / DM) + EPS); unsigned long long* o8 = (unsigned long long*)orow[r] + lane;
#pragma unroll
        for (int j = 0; j < 4; ++j) o8[64 * j] = (unsigned long long)pk2(v[r][j].x * rs * gg[j].x, v[r][j].y * rs * gg[j].y) | ((unsigned long long)pk2(v[r][j].z * rs * gg[j].z, v[r][j].w * rs * gg[j].w) << 32); }
}
constexpr int MOE_I_UP = 32 * 16 * 32, MOE_I_DN = 32 * 16 * 16, MOE_UNITS = (MOE_I_UP + MOE_I_DN) / 64;
__device__ __forceinline__ void moe_convert_unit(int unit, const float* w_up, const float* w_down, const float* g_ffn, unsigned char* ws, int wave, int lane) {
#pragma unroll 1
    for (int j = 0; j < 8; ++j) { int r = unit * 64 + j * 8 + wave;
        if (r < MOE_I_UP) { const int e = r / (16 * 32); r -= e * (16 * 32); const int n0 = 64 * (r % 32);
            const size_t orow = (size_t)e * 2048 + ((n0 & 1023) >> 7) * 256 + (n0 >> 10) * 128 + (n0 & 127);
            p0_transpose_item8(w_up + (size_t)e * DM * 2048, 2048, g_ffn, ws + WS_WUP, DM, 64 * (r / 32), n0, orow, lane); }
        else { r -= MOE_I_UP; const int e = r / (16 * 16); r -= e * (16 * 16);
            p0_transpose_item8(w_down + (size_t)e * DM * DM, DM, nullptr, ws + WS_WDN, DM, 64 * (r / 16), 64 * (r % 16), (size_t)e * 1024 + 64 * (r % 16), lane); } }
}
struct In {
    const float *x, *mem; const int* positions; const float *norm_mix_g, *w_in, *lq1, *lk1, *lq2, *lk2, *diff_norm_g, *w_alpha2, *b_alpha, *gla_norm_g, *w_out, *norm_cross_g, *norm_mem_g,
        *w_cq, *w_ck, *w_cv, *w_co, *norm_ffn_g, *w_router, *b_router, *w_up, *b_up, *w_down, *b_down, *norm_final_g;
};
__device__ __forceinline__ void p0_prologue(Frame& F, const In& I) {
    const int gw = F.vcu * NWAVES + F.wave, NGW = F.G * NWAVES, lane = lane_here();
    unsigned char* ws = F.ws;
    constexpr int I_IN = 16 * 48, I_SQ = 16 * 16;
    constexpr int NITEMS = I_IN + 4 * I_SQ;
    for (int it = gw; it < NITEMS; it += NGW) {
        int r = it;
        if (r < I_IN) { p0_transpose_item(I.w_in, INW, nullptr, (bf16*)(ws + WS_WINT), DM, 64 * (r / 48), 64 * (r % 48), (size_t)64 * (r % 48), lane); continue; } r -= I_IN;
        { const int w = r / I_SQ; r -= w * I_SQ;
            const float* W = w == 0 ? I.w_out : w == 1 ? I.w_ck : w == 2 ? I.w_cv : I.w_co;
            bf16* WT = (bf16*)(ws + (w == 0 ? WS_WOUT : w == 1 ? WS_WCK : w == 2 ? WS_WCV : WS_WCO));
            p0_transpose_item(W, DM, nullptr, WT, DM, 64 * (r / 16), 64 * (r % 16), (size_t)64 * (r % 16), lane); }
    }
    for (int idx = F.vcu * (NWAVES * 64) + F.tid; idx < DM * DM / 4; idx += F.G * NWAVES * 64) { const f32x4 v = ((const f32x4*)I.w_cq)[idx] * I.norm_cross_g[idx >> 8];
        v2u o; o.x = pk2(v.x, v.y); o.y = pk2(v.z, v.w); ((v2u*)(ws + WS_WCQ))[idx] = o; }
#if defined(PROBE_P0)
    if (F.tid == 0) ((LAS unsigned long long*)(F.lds + TS_OFF))[13] = rt();
#endif
    const int gt = F.vcu * (NWAVES * 64) + F.tid, NGT = F.G * NWAVES * 64;
    for (int idx = gt; idx < 256 * DM; idx += NGT) { const int j = idx >> 10, k = idx & 1023; const float* wr = I.w_in + (size_t)k * INW + 3072; float s = 0.f;
#pragma unroll
        for (int r = 0; r < 16; ++r) s += wr[r] * I.w_alpha2[r * 256 + j];
        ((bf16*)(ws + WS_WINT))[(size_t)(3072 + j) * DM + k] = (bf16)f2bf(s); }
    for (int idx = gt; idx < DM * NEXP; idx += NGT) { const int e = idx >> 10, k = idx & 1023; const float w = I.w_router[k * NEXP + e] * I.norm_ffn_g[k];
        const unsigned h1 = f2bf(w); const float r1 = w - __builtin_bit_cast(float, h1 << 16); const unsigned h2 = f2bf(r1); const float r2 = r1 - __builtin_bit_cast(float, h2 << 16); const unsigned h3 = f2bf(r2);
        bf16* W3 = (bf16*)(ws + WS_WR); W3[idx] = (bf16)h1; W3[DM * NEXP + idx] = (bf16)h2; W3[2 * DM * NEXP + idx] = (bf16)h3; }
    for (int idx = gt; idx < NTOK * 8; idx += NGT) { const int tok = idx >> 3, i = idx & 7;
        const double inv = exp(-(double)i * 0.125 * 13.122363377404328); const double ang = (double)I.positions[tok] * inv;
        const double red = ang - rint(ang * 0.15915494309189535) * 6.283185307179586; const float rf = (float)red;
        float* cs = (float*)(ws + WS_CS) + (size_t)tok * 16; cs[i] = cosf(rf); cs[8 + i] = sinf(rf); }
#if defined(PROBE_P0)
    if (F.tid == 0) ((LAS unsigned long long*)(F.lds + TS_OFF))[14] = rt();
#endif
    for (int m = gw * 4; m < NTOK; m += NGW * 4) { const float* xr[4]; bf16* orw[4];
#pragma unroll
        for (int r = 0; r < 4; ++r) { xr[r] = I.x + (size_t)(m + r) * DM; orw[r] = (bf16*)(ws + WS_HN) + (size_t)(m + r) * DM; }
        rms_rows_to_bf16<4>(xr, I.norm_mix_g, orw, lane); }
    for (int m = gw * 4; m < NMEM; m += NGW * 4) { const float* xr[4]; bf16* orw[4];
#pragma unroll
        for (int r = 0; r < 4; ++r) { xr[r] = I.mem + (size_t)(m + r) * DM; orw[r] = (bf16*)(ws + WS_MN) + (size_t)(m + r) * DM; }
        rms_rows_to_bf16<4>(xr, I.norm_mem_g, orw, lane); }
}

constexpr int DA_KBUF = 16384, DA_VBUF = 16384, DA_VOFF = 2 * DA_KBUF;
template <int DBG = 0> __device__ __forceinline__ void diffattn_unit(Frame& F, const bf16* P, const bf16* VT, bf16* CAT, const float* gdiff, float lam, int b, int h, int qblk) {
    const int lane = lane_here(), wave = F.wave, tid = F.tid, l15 = lane & 15, g = lane >> 4;
    LAS unsigned char* lds = F.lds + RING_OFF;
    const int q0 = qblk * 128 + wave * 16;
    const size_t tokq = (size_t)b * SEQ + q0 + l15;
    bf16x8 qf[2][2];
#pragma unroll
    for (int c = 0; c < 2; ++c)
#pragma unroll
        for (int ks = 0; ks < 2; ++ks) qf[c][ks] = *(const bf16x8*)(P + tokq * PW + h * 128 + c * 64 + ks * 32 + g * 8);
    f32x4 o[2][8];
#pragma unroll
    for (int c = 0; c < 2; ++c)
#pragma unroll
        for (int k = 0; k < 8; ++k) o[c][k] = (f32x4){0.f, 0.f, 0.f, 0.f};
    float mrun[2] = {0.f, 0.f}, lsum[2] = {0.f, 0.f};
    const int nk = q0 + 16;
    const int nt = 2 * qblk + 2;
    const int skey = tid >> 4, sch = tid & 15, vrow = tid >> 3, vpc = tid & 7;
    const bf16* ksrc = P + ((size_t)b * SEQ + skey) * PW + 512 + h * 128 + sch * 8;
    const bf16* vsrc = VT + (size_t)(h * 128 + vrow) * NTOK + (size_t)b * SEQ + vpc * 8;
    const int kdst = skey * 256 + ((sch ^ (skey & 15)) * 16);
    const int vfr = (vrow >> 1) & 7, vch = (vpc >> 2) * 4 + 2 * (vpc & 1), vhi = ((vpc & 3) >> 1) * 8;
    const int vdst0 = DA_VOFF + vrow * 128 + ((vch ^ vfr) * 16) + vhi, vdst1 = DA_VOFF + vrow * 128 + (((vch + 1) ^ vfr) * 16) + vhi;
    int koff[2][2];
#pragma unroll
    for (int c = 0; c < 2; ++c)
#pragma unroll
        for (int ks = 0; ks < 2; ++ks) koff[c][ks] = l15 * 256 + (((c * 8 + ks * 4 + g) ^ l15) * 16);
    const int voffs[2] = {DA_VOFF + l15 * 128 + ((g ^ (l15 >> 1)) * 16), DA_VOFF + l15 * 128 + (((4 + g) ^ (l15 >> 1)) * 16)};
    v4u sk0, sk1, sv0, sv1;
#define DA_LOAD(tt) do { const bf16* kp_ = ksrc + (size_t)(tt) * 64 * PW; const bf16* vp_ = vsrc + (tt) * 64; \
        sk0 = *(const v4u*)kp_; sk1 = *(const v4u*)(kp_ + (size_t)32 * PW); sv0 = *(const v4u*)vp_; sv1 = *(const v4u*)(vp_ + (size_t)64 * NTOK); } while (0)
#define DA_STORE(bb) do { LAS unsigned char* kd_ = lds + (bb) * DA_KBUF + kdst; LAS unsigned char* vd_ = lds + (bb) * DA_VBUF; \
        *(LAS v4u*)kd_ = sk0; *(LAS v4u*)(kd_ + 8192) = sk1; \
        *(LAS v2u*)(vd_ + vdst0) = (v2u){sv0.x, sv0.y}; *(LAS v2u*)(vd_ + vdst1) = (v2u){sv0.z, sv0.w}; *(LAS v2u*)(vd_ + vdst0 + 8192) = (v2u){sv1.x, sv1.y}; *(LAS v2u*)(vd_ + vdst1 + 8192) = (v2u){sv1.z, sv1.w}; } while (0)
    DA_LOAD(0); DA_STORE(0);
    __syncthreads();
    auto step = [&](const int t, const int buf) __attribute__((always_inline)) {
        if (t * 64 < nk) {
            const LAS unsigned char* kb = lds + buf * DA_KBUF; const LAS unsigned char* vb = lds + buf * DA_VBUF;
            f32x4 s[2][2][2];
#pragma unroll
            for (int sub = 0; sub < 2; ++sub)
#pragma unroll
                for (int c = 0; c < 2; ++c)
#pragma unroll
                    for (int s2 = 0; s2 < 2; ++s2) { f32x4 a = (f32x4){-mrun[c], -mrun[c], -mrun[c], -mrun[c]};
#pragma unroll
                        for (int ks = 0; ks < 2; ++ks) { const bf16x8 kf = (DBG & 2) ? qf[c][ks ^ 1] : *(const LAS bf16x8*)(kb + sub * 8192 + s2 * 4096 + koff[c][ks]); if constexpr ((DBG & 1) == 0) a = mfma16(kf, qf[c][ks], a); else a[ks] += __builtin_bit_cast(float, (int)kf[0] << 16); }
                        s[sub][c][s2] = a; }
            if (t * 64 + 63 > q0) {
                const int qrow = q0 + l15;
#pragma unroll
                for (int sub = 0; sub < 2; ++sub)
#pragma unroll
                    for (int c = 0; c < 2; ++c)
#pragma unroll
                        for (int s2 = 0; s2 < 2; ++s2)
#pragma unroll
                            for (int r = 0; r < 4; ++r) if (t * 64 + sub * 32 + s2 * 16 + 4 * g + r > qrow) s[sub][c][s2][r] = -INFINITY;
            }
            float dl[2]; bool grow = false;
#pragma unroll
            for (int c = 0; c < 2; ++c) { float mx = -INFINITY;
#pragma unroll
                for (int sub = 0; sub < 2; ++sub)
#pragma unroll
                    for (int s2 = 0; s2 < 2; ++s2) mx = fmaxf(mx, fmaxf(fmaxf(s[sub][c][s2][0], s[sub][c][s2][1]), fmaxf(s[sub][c][s2][2], s[sub][c][s2][3])));
                mx = xmax16(mx); mx = xmax32(mx);
                dl[c] = (t == 0 || mx > 8.0f) ? mx : 0.f; grow = grow || (dl[c] != 0.f); }
            if (__any(grow)) {
#pragma unroll
                for (int c = 0; c < 2; ++c) { const float alpha = __builtin_amdgcn_exp2f(-dl[c]); mrun[c] += dl[c]; lsum[c] *= alpha;
#pragma unroll
                    for (int k = 0; k < 8; ++k) o[c][k] = o[c][k] * alpha;
#pragma unroll
                    for (int sub = 0; sub < 2; ++sub)
#pragma unroll
                        for (int s2 = 0; s2 < 2; ++s2)
#pragma unroll
                            for (int r = 0; r < 4; ++r) s[sub][c][s2][r] -= dl[c]; }
            }
#pragma unroll
            for (int sub = 0; sub < 2; ++sub) {
                bf16x8 pb[2];
#pragma unroll
                for (int c = 0; c < 2; ++c) { float ps = 0.f;
#pragma unroll
                    for (int s2 = 0; s2 < 2; ++s2)
#pragma unroll
                        for (int r = 0; r < 4; ++r) { const float p = (DBG & 4) ? s[sub][c][s2][r] * 0.001f : __builtin_amdgcn_exp2f(s[sub][c][s2][r]); s[sub][c][s2][r] = p; ps += p; }
                    lsum[c] += ps;
                    v4u w; w.x = pg8::cvtpk(s[sub][c][0][0], s[sub][c][0][1]); w.y = pg8::cvtpk(s[sub][c][0][2], s[sub][c][0][3]); w.z = pg8::cvtpk(s[sub][c][1][0], s[sub][c][1][1]); w.w = pg8::cvtpk(s[sub][c][1][2], s[sub][c][1][3]);
                    pb[c] = __builtin_bit_cast(bf16x8, w); }
#pragma unroll
                for (int k = 0; k < 8; ++k) { const bf16x8 vf = (DBG & 2) ? qf[k & 1][(k >> 1) & 1] : *(const LAS bf16x8*)(vb + voffs[sub] + k * 2048);
                    if constexpr ((DBG & 1) == 0) { o[0][k] = mfma16(vf, pb[0], o[0][k]); o[1][k] = mfma16(vf, pb[1], o[1][k]); }
                    else { o[0][k][0] += __builtin_bit_cast(float, (int)vf[0] << 16) + __builtin_bit_cast(float, (int)pb[0][k] << 16); o[1][k][0] += __builtin_bit_cast(float, (int)pb[1][k] << 16); } }
            }
        }
    };
    for (int t = 0; t < nt; ++t) {
        if ((DBG & 8) == 0 && t + 1 < nt) DA_LOAD(t + 1);
        step(t, t & 1);
        if ((DBG & 8) == 0 && t + 1 < nt) DA_STORE((t & 1) ^ 1);
        __syncthreads();
    }
#undef DA_LOAD
#undef DA_STORE
    float l0 = lsum[0], l1 = lsum[1];
    l0 += __shfl_xor(l0, 16); l0 += __shfl_xor(l0, 32); l1 += __shfl_xor(l1, 16); l1 += __shfl_xor(l1, 32);
    const float i0 = 1.0f / l0, i1 = lam / l1; float ss = 0.f;
#pragma unroll
    for (int k = 0; k < 8; ++k)
#pragma unroll
        for (int r = 0; r < 4; ++r) { const float v = o[0][k][r] * i0 - o[1][k][r] * i1; o[0][k][r] = v; ss += v * v; }
    ss += __shfl_xor(ss, 16); ss += __shfl_xor(ss, 32);
    const float rs = rsqrtf(ss * (1.0f / 128.0f) + EPS) * 0.8f;
    bf16* op = CAT + tokq * DM + h * 128 + 4 * g;
    f32x4 gg[8];
#pragma unroll
    for (int k = 0; k < 8; ++k) gg[k] = *(const f32x4*)(gdiff + k * 16 + 4 * g);
#pragma unroll
    for (int k = 0; k < 8; ++k) { f32x4 v = o[0][k] * rs; v = v * gg[k]; pg8::st_bf4(op + k * 16, v); }
}

__device__ __forceinline__ bf16x8 pack8(const f32x4& a, const f32x4& b) { v4u w; w.x = pg8::cvtpk(a[0], a[1]); w.y = pg8::cvtpk(a[2], a[3]); w.z = pg8::cvtpk(b[0], b[1]); w.w = pg8::cvtpk(b[2], b[3]); return __builtin_bit_cast(bf16x8, w); }
constexpr int GL_QI = 0, GL_KI = 8192, GL_IMG = 16384, GL_EL = 2 * GL_IMG, GL_OB = GL_EL + 512, GL_OBS = 17408, GL_PS = GL_OB + 2 * GL_OBS, GL_END = GL_PS + 4096;

__device__ __forceinline__ void gla_unit(Frame& F, const bf16* P, const float* Bc, const bf16* GVT, bf16* CAT, const float* ggla, int b, int h) {
    const int lane = lane_here(), l15 = lane & 15, g = lane >> 4, eb = F.wave, tid = F.tid;
    LAS unsigned char* lds = F.lds + RING_OFF;
    const f32x4 zero4 = {0.f, 0.f, 0.f, 0.f};
    f32x4 S[4] = {zero4, zero4, zero4, zero4};
    bf16x8 If[4];
#pragma unroll
    for (int db = 0; db < 4; ++db) { const int ks = db >> 1;
#pragma unroll
        for (int j = 0; j < 8; ++j) { const int dp = 32 * ks + (j < 4 ? 4 * g + j : 16 + 4 * g + j - 4); If[db][j] = (dp == 16 * db + l15) ? (short)0x3F80 : (short)0; } }
    const int st = tid >> 3, sp = tid & 7, opc = tid & 15;
    const size_t tokb = (size_t)b * SEQ;
    const bf16* qsrc = P + (tokb + st) * PW + 1536 + h * 64 + sp * 8;
    const float* bsrc = Bc + (tokb + st) * 256 + h * 64 + sp * 8;
    const bf16* Vrow = GVT + (size_t)(h * 128 + 16 * eb + l15) * NTOK + tokb + 4 * g;
    const f32x4 gg0 = *(const f32x4*)(ggla + opc * 8), gg1 = *(const f32x4*)(ggla + opc * 8 + 4);
    const int foffs[2] = {l15 * 128 + ((g ^ (l15 >> 1)) * 16), l15 * 128 + (((4 + g) ^ (l15 >> 1)) * 16)};
    const int sfr = (st >> 1) & 7, sch0 = (sp >> 2) * 4 + 2 * (sp & 1), shi = ((sp & 3) >> 1) * 8, sd0 = st * 128 + ((sch0 ^ sfr) * 16) + shi, sd1 = st * 128 + (((sch0 + 1) ^ sfr) * 16) + shi;
    v4u rq = *(const v4u*)qsrc, rk = *(const v4u*)(qsrc + 256); f32x4 rb0 = *(const f32x4*)bsrc, rb1 = *(const f32x4*)(bsrc + 4);
#define GLA_STAGE(par) do { \
        float ee[8]; _Pragma("unroll") for (int i = 0; i < 4; ++i) { ee[i] = __expf(rb0[i]); ee[4 + i] = __expf(rb1[i]); } \
        const unsigned qa[4] = {rq.x, rq.y, rq.z, rq.w}, ka[4] = {rk.x, rk.y, rk.z, rk.w}; v4u wq, wk; unsigned* wqp = (unsigned*)&wq; unsigned* wkp = (unsigned*)&wk; \
        _Pragma("unroll") for (int i = 0; i < 4; ++i) { const float q0 = __builtin_bit_cast(float, qa[i] << 16), q1 = __builtin_bit_cast(float, qa[i] & 0xffff0000u), k0 = __builtin_bit_cast(float, ka[i] << 16), k1 = __builtin_bit_cast(float, ka[i] & 0xffff0000u); \
            wqp[i] = pg8::cvtpk(q0 * ee[2 * i], q1 * ee[2 * i + 1]); wkp[i] = pg8::cvtpk(k0 * __builtin_amdgcn_rcpf(ee[2 * i]), k1 * __builtin_amdgcn_rcpf(ee[2 * i + 1])); } \
        { LAS unsigned char* ib_ = lds + (par) * GL_IMG; *(LAS v2u*)(ib_ + GL_QI + sd0) = (v2u){wq.x, wq.y}; *(LAS v2u*)(ib_ + GL_QI + sd1) = (v2u){wq.z, wq.w}; *(LAS v2u*)(ib_ + GL_KI + sd0) = (v2u){wk.x, wk.y}; *(LAS v2u*)(ib_ + GL_KI + sd1) = (v2u){wk.z, wk.w}; } \
        if (st == 63) { *(LAS f32x4*)(lds + GL_EL + (par) * 256 + sp * 32) = (f32x4){ee[0], ee[1], ee[2], ee[3]}; *(LAS f32x4*)(lds + GL_EL + (par) * 256 + sp * 32 + 16) = (f32x4){ee[4], ee[5], ee[6], ee[7]}; } } while (0)
    bf16x8 VFn[2];
#pragma unroll
    for (int ss = 0; ss < 2; ++ss) { const bf16* vp = Vrow + 32 * ss; const v2u v0 = *(const v2u*)vp, v1 = *(const v2u*)(vp + 16); v4u vv; vv.x = v0.x; vv.y = v0.y; vv.z = v1.x; vv.w = v1.y; VFn[ss] = __builtin_bit_cast(bf16x8, vv); }
    GLA_STAGE(0);
    __syncthreads();
    for (int c = 0; c < SEQ / 64; ++c) {
        const int par = c & 1; const size_t tok0 = tokb + c * 64;
        if (c + 1 < SEQ / 64) { rq = *(const v4u*)(qsrc + (size_t)(c + 1) * 64 * PW); rk = *(const v4u*)(qsrc + (size_t)(c + 1) * 64 * PW + 256);
            rb0 = *(const f32x4*)(bsrc + (size_t)(c + 1) * 64 * 256); rb1 = *(const f32x4*)(bsrc + (size_t)(c + 1) * 64 * 256 + 4); }
        bf16x8 VF[2] = {VFn[0], VFn[1]};
        if (c + 1 < SEQ / 64) {
#pragma unroll
            for (int ss = 0; ss < 2; ++ss) { const bf16* vp = Vrow + (c + 1) * 64 + 32 * ss; const v2u v0 = *(const v2u*)vp, v1 = *(const v2u*)(vp + 16); v4u vv; vv.x = v0.x; vv.y = v0.y; vv.z = v1.x; vv.w = v1.y; VFn[ss] = __builtin_bit_cast(bf16x8, vv); } }
        v4u rg[2];
#pragma unroll
        for (int i = 0; i < 2; ++i) rg[i] = *(const v4u*)(P + (tok0 + ((tid + 512 * i) >> 4)) * PW + 2560 + h * 128 + opc * 8);
        const LAS unsigned char* qi = lds + par * GL_IMG + GL_QI; const LAS unsigned char* ki = lds + par * GL_IMG + GL_KI;
        bf16x8 qf[4][2], kf[4][2];
#pragma unroll
        for (int blk = 0; blk < 4; ++blk)
#pragma unroll
            for (int ks = 0; ks < 2; ++ks) { qf[blk][ks] = *(const LAS bf16x8*)(qi + foffs[ks] + blk * 2048); kf[blk][ks] = *(const LAS bf16x8*)(ki + foffs[ks] + blk * 2048); }
        const bf16x8 SF0 = pack8(S[0], S[1]), SF1 = pack8(S[2], S[3]);
        f32x4 O[4];
#pragma unroll
        for (int tb = 0; tb < 4; ++tb) { f32x4 o = mfma16(qf[tb][0], SF0, zero4); o = mfma16(qf[tb][1], SF1, o);
#pragma unroll
            for (int ss = 0; ss < 2; ++ss) if (2 * ss <= tb) { f32x4 a2[2];
#pragma unroll
                for (int hh = 0; hh < 2; ++hh) { const int sb = 2 * ss + hh; f32x4 a = zero4;
                    if (sb <= tb) { a = mfma16(kf[sb][0], qf[tb][0], zero4); a = mfma16(kf[sb][1], qf[tb][1], a);
                        if (sb == tb) {
#pragma unroll
                            for (int r = 0; r < 4; ++r) if (4 * g + r > l15) a[r] = 0.f; } }
                    a2[hh] = a; }
                o = mfma16(pack8(a2[0], a2[1]), VF[ss], o); }
            O[tb] = o; }
#pragma unroll
        for (int db = 0; db < 4; ++db) { f32x4 u = S[db];
#pragma unroll
            for (int ss = 0; ss < 2; ++ss) { const f32x4 t0 = mfma16(kf[2 * ss][db >> 1], If[db], zero4), t1 = mfma16(kf[2 * ss + 1][db >> 1], If[db], zero4); u = mfma16(pack8(t0, t1), VF[ss], u); }
            const f32x4 el = *(const LAS f32x4*)(lds + GL_EL + par * 256 + (16 * db + 4 * g) * 4);
            S[db] = u * el; }
        LAS unsigned char* ob = lds + GL_OB + par * GL_OBS; LAS float* ps = (LAS float*)(lds + GL_PS + par * 2048);
#pragma unroll
        for (int tb = 0; tb < 4; ++tb)
#pragma unroll
            for (int r = 0; r < 4; ++r) { const int t = 16 * tb + 4 * g + r; const float ov = O[tb][r]; float q = ov * ov; q += __shfl_xor(q, 1); q += __shfl_xor(q, 2); q += __shfl_xor(q, 4); q += __shfl_xor(q, 8);
                if (l15 == 0) ps[t * 8 + eb] = q;
                *(LAS bf16*)(ob + t * 272 + (16 * eb + l15) * 2) = (bf16)f2bf(ov); }
        if (c + 1 < SEQ / 64) GLA_STAGE(par ^ 1);
        __syncthreads();
#pragma unroll
        for (int i = 0; i < 2; ++i) { const int ot = (tid + 512 * i) >> 4; const f32x4 p0 = *(const LAS f32x4*)(ps + ot * 8), p1 = *(const LAS f32x4*)(ps + ot * 8 + 4);
            const float ss = ((p0[0] + p0[1]) + (p0[2] + p0[3])) + ((p1[0] + p1[1]) + (p1[2] + p1[3])); const float rs = rsqrtf(ss * (1.0f / 128.0f) + EPS);
            const v4u ov = *(const LAS v4u*)(ob + ot * 272 + opc * 16); const unsigned oa[4] = {ov.x, ov.y, ov.z, ov.w}, ga[4] = {rg[i].x, rg[i].y, rg[i].z, rg[i].w};
            const float gn[8] = {gg0[0], gg0[1], gg0[2], gg0[3], gg1[0], gg1[1], gg1[2], gg1[3]}; v4u w; unsigned* wp = (unsigned*)&w;
#pragma unroll
            for (int j = 0; j < 4; ++j) { const float o0 = __builtin_bit_cast(float, oa[j] << 16), o1 = __builtin_bit_cast(float, oa[j] & 0xffff0000u), g0 = __builtin_bit_cast(float, ga[j] << 16), g1 = __builtin_bit_cast(float, ga[j] & 0xffff0000u);
                wp[j] = pg8::cvtpk(o0 * rs * gn[2 * j] * g0 * __builtin_amdgcn_rcpf(1.0f + __builtin_amdgcn_exp2f(-1.4426950408889634f * g0)), o1 * rs * gn[2 * j + 1] * g1 * __builtin_amdgcn_rcpf(1.0f + __builtin_amdgcn_exp2f(-1.4426950408889634f * g1))); }
            *(v4u*)(CAT + (tok0 + ot) * DM + 512 + h * 128 + opc * 8) = w; }
    }
#undef GLA_STAGE
    __syncthreads();
}

__device__ __forceinline__ void router_phase(Frame& F, const bf16* X2, const bf16* W3, const float* b_router, float* rsl, float* gate, unsigned* assign, unsigned* list, gu32* cnt) {
    LAS float* part = (LAS float*)(F.lds + RING_OFF);
    LAS float* lg = part;
    LAS float* pss = (LAS float*)(F.lds + XCH_OFF);
    LAS unsigned* hist = (LAS unsigned*)(F.lds + XCH2_OFF);
    const int tid = F.tid, lane = lane_here(), r16 = lane & 15, kq = lane >> 4, wv = F.wave, t = tid & 63;
    bf16x8 wf[3][2][4];
#pragma unroll
    for (int sp = 0; sp < 3; ++sp)
#pragma unroll
        for (int eb = 0; eb < 2; ++eb)
#pragma unroll
            for (int ks = 0; ks < 4; ++ks) wf[sp][eb][ks] = *(const bf16x8*)(W3 + (size_t)sp * DM * NEXP + (size_t)(16 * eb + r16) * DM + 128 * wv + 32 * ks + 8 * kq);
    for (int blk = F.vcu; blk < NTOK / 128; blk += F.G) {
        const size_t tok0 = (size_t)blk * 128;
        const bf16* xp = X2 + (tok0 + r16) * DM + 128 * wv + 8 * kq;
        bf16x8 xq[3][4];
#define RT_LD(rb, sl) do { _Pragma("unroll") for (int ks = 0; ks < 4; ++ks) xq[sl][ks] = *(const bf16x8*)(xp + (size_t)(rb) * 16 * DM + 32 * ks); } while (0)
        RT_LD(0, 0); RT_LD(1, 1);
#pragma unroll
        for (int rb = 0; rb < 8; ++rb) {
            if (rb + 2 < 8) RT_LD(rb + 2, (rb + 2) % 3);
            f32x4 acc0 = {0.f, 0.f, 0.f, 0.f}, acc1 = acc0; float ssq = 0.f;
#pragma unroll
            for (int ks = 0; ks < 4; ++ks) { const bf16x8 xf = xq[rb % 3][ks];
#pragma unroll
                for (int sp = 0; sp < 3; ++sp) { acc0 = mfma16(xf, wf[sp][0][ks], acc0); acc1 = mfma16(xf, wf[sp][1][ks], acc1); }
#pragma unroll
                for (int i = 0; i < 8; ++i) { const float xv = __builtin_bit_cast(float, (unsigned)(unsigned short)xf[i] << 16); ssq += xv * xv; } }
            ssq += __shfl_xor(ssq, 16); ssq += __shfl_xor(ssq, 32);
            if (kq == 0) pss[wv * 128 + 16 * rb + r16] = ssq;
#pragma unroll
            for (int j = 0; j < 4; ++j) { const int tl = 16 * rb + 4 * kq + j; part[(wv * 128 + tl) * 32 + r16] = acc0[j]; part[(wv * 128 + tl) * 32 + 16 + r16] = acc1[j]; }
        }
#undef RT_LD
        __syncthreads();
        { const int tk = tid >> 2, q = tid & 3; f32x4 s0 = {0.f, 0.f, 0.f, 0.f}, s1 = s0; float sq = 0.f;
#pragma unroll
          for (int w = 0; w < 8; ++w) { s0 = s0 + *(const LAS f32x4*)(part + (w * 128 + tk) * 32 + 8 * q); s1 = s1 + *(const LAS f32x4*)(part + (w * 128 + tk) * 32 + 8 * q + 4); sq += pss[w * 128 + tk]; }
          const float rs = rsqrtf(sq * (1.0f / DM) + EPS); const f32x4 b0 = *(const f32x4*)(b_router + 8 * q), b1 = *(const f32x4*)(b_router + 8 * q + 4);
          s0 = s0 * rs + b0; s1 = s1 * rs + b1;
          __syncthreads();
#pragma unroll
          for (int i = 0; i < 4; ++i) { lg[tk * 33 + 8 * q + i] = s0[i]; lg[tk * 33 + 8 * q + 4 + i] = s1[i]; }
          if (q == 0) lg[tk * 33 + 32] = rs; }
        __syncthreads();
        if (tid < 128) {
            const int w2 = tid >> 6;
            float lv[32];
#pragma unroll
            for (int e = 0; e < 32; ++e) lv[e] = lg[tid * 33 + e];
            const float rs = lg[tid * 33 + 32];
            float tv[4]; int te[4];
#pragma unroll
            for (int k = 0; k < 4; ++k) { float best = -INFINITY; int bi = 0;
#pragma unroll
                for (int e = 0; e < 32; ++e) if (lv[e] > best) { best = lv[e]; bi = e; }
                tv[k] = best; te[k] = bi;
#pragma unroll
                for (int e = 0; e < 32; ++e) if (e == bi) lv[e] = -INFINITY; }
            const float e1 = __expf(tv[1] - tv[0]), e2 = __expf(tv[2] - tv[0]), e3 = __expf(tv[3] - tv[0]); const float inv = 1.0f / (1.0f + e1 + e2 + e3);
            const float gv[4] = {inv, e1 * inv, e2 * inv, e3 * inv};
            const size_t tok = tok0 + tid;
            LAS unsigned* hs = hist + w2 * 32; LAS unsigned* gbase = hist + 64 + w2 * 32;
            if (t < 32) hs[t] = 0u;
            __builtin_amdgcn_wave_barrier(); LDS_WAIT();
            unsigned lpos[4];
#pragma unroll
            for (int k = 0; k < 4; ++k) lpos[k] = __hip_atomic_fetch_add(hs + te[k], 1u, __ATOMIC_RELAXED, __HIP_MEMORY_SCOPE_WORKGROUP);
            __builtin_amdgcn_wave_barrier(); LDS_WAIT();
            if (t < 32) { const unsigned n = hs[t]; gbase[t] = n ? __hip_atomic_fetch_add(cnt + 64 * t, n, RLX_AGENT) : 0u; }
            __builtin_amdgcn_wave_barrier(); LDS_WAIT();
#pragma unroll
            for (int k = 0; k < 4; ++k) { const unsigned pos = gbase[te[k]] + lpos[k]; list[(size_t)te[k] * NTOK + pos] = (unsigned)tok; rsl[(size_t)te[k] * NTOK + pos] = rs;
                assign[tok * 4 + k] = ((unsigned)te[k] << 16) | pos; gate[tok * 4 + k] = gv[k]; }
        }
        __syncthreads();
    }
}
__device__ __forceinline__ int moe_tables(Frame& F) {
    LAS unsigned char* tile_e = F.lds + TAB_OFF; LAS int* tstart = (LAS int*)(F.lds + TAB_TSTART); LAS int* lc = (LAS int*)(F.lds + TAB_CNT);
    if (F.tid < 32) lc[F.tid] = (int)__hip_atomic_load(F.ctl + CW_CNT + 64 * F.tid, RLX_AGENT);
    __syncthreads();
    if (F.tid == 0) { int s = 0; for (int e = 0; e < 32; ++e) { tstart[e] = s; s += (lc[e] + 255) >> 8; } tstart[32] = s; }
    __syncthreads();
    const int T = tstart[32];
    for (int i = F.tid; i < T; i += 512) { int e = 0;
#pragma unroll
        for (int k = 1; k < 32; ++k) e += (tstart[k] <= i) ? 1 : 0;
        tile_e[i] = (unsigned char)e; }
    __syncthreads();
    return T;
}
__device__ __forceinline__ void final_phase(Frame& F, const bf16* X2, float* out, const unsigned char* Y, const float* gate, const unsigned* assign, const float* gfin) {
    (void)moe_tables(F);
    const LAS int* tstart = (const LAS int*)(F.lds + TAB_TSTART);
    const int gw = F.vcu * NWAVES + F.wave, NGW = F.G * NWAVES, lane = lane_here();
    unsigned an[2][4]; float gn[2][4];
#define FIN_ROUTE(t0) do { _Pragma("unroll") for (int u = 0; u < 2; ++u) { const int tok_ = ((t0) + u * NGW < NTOK) ? (t0) + u * NGW : ((t0) < NTOK ? (t0) : gw); \
        const v4u a4 = *(const v4u*)(assign + (size_t)tok_ * 4); const f32x4 g4 = *(const f32x4*)(gate + (size_t)tok_ * 4); \
        an[u][0] = a4.x; an[u][1] = a4.y; an[u][2] = a4.z; an[u][3] = a4.w; gn[u][0] = g4.x; gn[u][1] = g4.y; gn[u][2] = g4.z; gn[u][3] = g4.w; } } while (0)
    FIN_ROUTE(gw);
    f32x4 gfv[4];
#pragma unroll
    for (int j = 0; j < 4; ++j) gfv[j] = ((const f32x4*)gfin)[lane + 64 * j];
    for (int tok0 = gw; tok0 < NTOK; tok0 += 2 * NGW) {
        f32x4 v[2][4]; unsigned yw[2][4][4]; float gk[2][4];
#pragma unroll
        for (int u = 0; u < 2; ++u) { const int tok = (tok0 + u * NGW < NTOK) ? tok0 + u * NGW : tok0;
#pragma unroll
            for (int k = 0; k < 4; ++k) { const unsigned a = an[u][k]; gk[u][k] = gn[u][k]; const size_t row = (size_t)tstart[a >> 16] * 256 + (a & 0xffffu);
                const unsigned* yr = (const unsigned*)(Y + row * DM) + lane;
#pragma unroll
                for (int j = 0; j < 4; ++j) yw[u][k][j] = yr[64 * j]; }
            const v2u* xin = (const v2u*)(X2 + (size_t)tok * DM) + lane;
#pragma unroll
            for (int j = 0; j < 4; ++j) { const v2u w = xin[64 * j]; v[u][j] = (f32x4){__builtin_bit_cast(float, w.x << 16), __builtin_bit_cast(float, w.x & 0xffff0000u), __builtin_bit_cast(float, w.y << 16), __builtin_bit_cast(float, w.y & 0xffff0000u)}; } }
        FIN_ROUTE(tok0 + 2 * NGW);
#pragma unroll
        for (int u = 0; u < 2; ++u) { const int tok = (tok0 + u * NGW < NTOK) ? tok0 + u * NGW : tok0;
#pragma unroll
            for (int k = 0; k < 4; ++k)
#pragma unroll
                for (int j = 0; j < 4; ++j) { const unsigned w = yw[u][k][j]; const auto lo = __builtin_amdgcn_cvt_pk_f32_fp8((int)w, false), hi = __builtin_amdgcn_cvt_pk_f32_fp8((int)w, true);
                    v[u][j].x += gk[u][k] * lo[0]; v[u][j].y += gk[u][k] * lo[1]; v[u][j].z += gk[u][k] * hi[0]; v[u][j].w += gk[u][k] * hi[1]; }
            float s = 0.f;
#pragma unroll
            for (int j = 0; j < 4; ++j) s += (v[u][j].x * v[u][j].x + v[u][j].y * v[u][j].y) + (v[u][j].z * v[u][j].z + v[u][j].w * v[u][j].w);
            const float rs = rsqrtf(wave_sum(s) * (1.0f / DM) + EPS); f32x4* xr = (f32x4*)(out + (size_t)tok * DM) + lane;
#pragma unroll
            for (int j = 0; j < 4; ++j) xr[64 * j] = v[u][j] * rs * gfv[j]; }
    }
#undef FIN_ROUTE
}

constexpr int NPHASE = 10;
struct Args { const void* in[28]; float* out; unsigned char* ws; int ph_lo, ph_hi; };
__global__ void __launch_bounds__(NWAVES * 64, 2) mk_fwd(Args args) {
    extern __shared__ __attribute__((aligned(16))) unsigned char lds[];
    Frame F;
    F.lds = (LAS unsigned char*)lds;
    F.MISC = (volatile LAS unsigned*)(F.lds + MISC_OFF);
    F.tid = threadIdx.x; F.lane = F.tid & 63; F.wave = __builtin_amdgcn_readfirstlane(F.tid >> 6);
    F.G = gridDim.x; { const int bx = blockIdx.x; F.vcu = (F.G % 8 == 0) ? (bx % 8) * (F.G / 8) + bx / 8 : bx; }
    F.ws = args.ws; F.out = args.out; F.ctl = (gu32*)(args.ws + WS_CTL);
    unsigned char* ws = args.ws;
    typedef const void* const volatile __attribute__((address_space(4))) kargp_t;
    kargp_t* const kargs = (kargp_t*)__builtin_amdgcn_kernarg_segment_ptr();
#define INP(k) ((const float*)kargs[k])
    for (int u = F.tid; u < (LDS_BYTES - LDSCTL_OFF) / 4; u += NWAVES * 64) ((LAS unsigned*)(F.lds + LDSCTL_OFF))[u] = 0u;
    __syncthreads();
    const int lo = args.ph_lo, hi = args.ph_hi;
    const bool single = (hi - lo) > 1;
    XcdBarrier bar; bar.bar = (unsigned*)(F.ctl + CW_BAR); bar.x = 0; bar.st = nullptr;
    if (single) bar = xcd_barrier_post((unsigned*)(F.ctl + CW_BAR), F.MISC + 8);
#define IN(k) (lo <= (k) && (k) < hi)
#if defined(PROBE_K0)
    LAS unsigned long long* tsl = (LAS unsigned long long*)(F.lds + TS_OFF);
    if (F.tid == 0) tsl[0] = rt();
#define SEAM(k) do { if (IN(k) && IN((k) + 1)) xcd_barrier(bar); if (F.tid == 0) tsl[(k) + 1] = rt(); } while (0)
#define SEAM_LOCAL(k) do { if (F.tid == 0) tsl[(k) + 1] = rt(); } while (0)
#else
#define SEAM(k) do { if (IN(k) && IN((k) + 1)) xcd_barrier(bar); } while (0)
#define SEAM_LOCAL(k) do { } while (0)
#endif
    typedef pg8::bf16_t hb;
    const int bx = (int)blockIdx.x;

    if (IN(0)) { In I;
        I.x = (const float*)INP(0);
        I.mem = (const float*)INP(1);
        I.positions = (const int*)INP(2);
        I.norm_mix_g = (const float*)INP(3);
        I.w_in = (const float*)INP(4);
        I.lq1 = (const float*)INP(5);
        I.lk1 = (const float*)INP(6);
        I.lq2 = (const float*)INP(7);
        I.lk2 = (const float*)INP(8);
        I.diff_norm_g = (const float*)INP(9);
        I.w_alpha2 = (const float*)INP(10);
        I.b_alpha = (const float*)INP(11);
        I.gla_norm_g = (const float*)INP(12);
        I.w_out = (const float*)INP(13);
        I.norm_cross_g = (const float*)INP(14);
        I.norm_mem_g = (const float*)INP(15);
        I.w_cq = (const float*)INP(16);
        I.w_ck = (const float*)INP(17);
        I.w_cv = (const float*)INP(18);
        I.w_co = (const float*)INP(19);
        I.norm_ffn_g = (const float*)INP(20);
        I.w_router = (const float*)INP(21);
        I.b_router = (const float*)INP(22);
        I.w_up = (const float*)INP(23);
        I.b_up = (const float*)INP(24);
        I.w_down = (const float*)INP(25);
        I.b_down = (const float*)INP(26);
        I.norm_final_g = (const float*)INP(27);
        p0_prologue(F, I); }
    SEAM(0);
    if (IN(1)) {
        pg8::Gemm g{(const hb*)(ws + WS_HN), (const hb*)(ws + WS_WINT), NTOK, 3328, DM, DM, DM, 127, 127};
        typedef pg8::OrderP1<(unsigned)WS_HN, (unsigned)WS_WINT, (unsigned)WS_MN, (unsigned)WS_WCK, (unsigned)WS_WCV> OrdP1; OrdP1 S; S.G = F.G; S.c = bx; S.ws = (const char*)ws;
        pg8::EpiP1 E{pg8::EpiProj{(hb*)(ws + WS_P), (float*)(ws + WS_LA), (const float*)(ws + WS_CS), INP(11)}, pg8::EpiPlain{(hb*)(ws + WS_VT) - (size_t)1024 * NTOK, NTOK, 1.0f},
                     pg8::EpiPlain{(hb*)(ws + WS_KX), DM, 1.0f}, pg8::EpiPlain{(hb*)(ws + WS_VXT), DM, 1.0f}};
        pg8::gemm_phase<pg8::EpiP1, OrdP1, true, true, false, false>(F.lds + RING_OFF, g, S, E);
    }
    SEAM(1);
    if (IN(2)) {
        float lam;
        { const int ln = lane_here(); const float a = INP(5)[ln] * INP(6)[ln], c = INP(7)[ln] * INP(8)[ln]; lam = __expf(wave_sum(a)) - __expf(wave_sum(c)) + 0.2f; }
        LAS int* qslot = (LAS int*)(F.lds + TAB_OFF);
        for (;;) {
            if (F.tid == 0) qslot[0] = (int)__hip_atomic_fetch_add(F.ctl + CW_Q2, 1u, RLX_AGENT);
            __syncthreads();
            const int u = qslot[0];
            __syncthreads();
            if (u >= 64 + 1024 + MOE_UNITS) break;
            int au = -1;
            if (u >= 64) { const int v = u - 64, gi = v / 11, r = v - gi * 11;
                if (r >= 8) { moe_convert_unit(gi * 3 + (r - 8), INP(23), INP(25), INP(20), ws, F.wave, lane_here()); continue; }
                au = gi * 8 + r; }
#if defined(PROBE_SPLIT)
            if (u < 64) continue;
#endif
            if (u < 64) { gla_unit(F, (const bf16*)(ws + WS_P), (const float*)(ws + WS_LA), (const bf16*)(ws + WS_GVT), (bf16*)(ws + WS_CAT), INP(12), u >> 2, u & 3);
            }
            else { const int v = au, bh = v & 63, qb = 15 - (v >> 6);
                diffattn_unit(F, (const bf16*)(ws + WS_P), (const bf16*)(ws + WS_VT), (bf16*)(ws + WS_CAT), INP(9), lam, bh >> 2, bh & 3, qb); }
        }
    }
#if defined(PROBE_SPLIT)
    if (IN(2)) { xcd_barrier(bar); if (F.tid == 0) tsl[13] = rt();
        for (int u = F.vcu; u < 64; u += F.G) gla_unit(F, (const bf16*)(ws + WS_P), (const float*)(ws + WS_LA), (const bf16*)(ws + WS_GVT), (bf16*)(ws + WS_CAT), INP(12), u >> 2, u & 3); }
#endif
    SEAM(2);
    if (IN(3)) {
        { pg8::Gemm g{(const hb*)(ws + WS_CAT), (const hb*)(ws + WS_WOUT), NTOK, DM, DM, DM, DM, 127, 127}; pg8::StaticOrder S; S.init(NTOK, DM, F.G, bx);
          pg8::EpiRes1 E{INP(0), (hb*)(ws + WS_X1B), (float*)(ws + WS_SSP1)};
          pg8::gemm_phase<pg8::EpiRes1, pg8::StaticOrder, true, true, false, false>(F.lds + RING_OFF, g, S, E); }
        { pg8::Gemm g{(const hb*)(ws + WS_KX), (const hb*)(ws + WS_WCQ), 64 * 256, DM, 256, DM, DM, 127, 127};
          typedef pg8::OrderGH<(unsigned)WS_KX, (unsigned)WS_WCQ, (unsigned)WS_WCO, (unsigned)WS_VXT> OrdGH; OrdGH S; S.G = F.G; S.c = bx; S.ws = (const char*)ws;
          pg8::EpiGH E{pg8::EpiPlain{(hb*)(ws + WS_GT), DM, 1.0f}, pg8::EpiPlain{(hb*)(ws + WS_HT), DM, 1.0f}};
          pg8::gemm_phase<pg8::EpiGH, OrdGH, true, true>(F.lds + RING_OFF, g, S, E); }
    }
    SEAM(3);
    if (IN(4)) {
        pg8::Gemm g{(const hb*)(ws + WS_X1B), (const hb*)(ws + WS_GT), NTOK, 256, DM, DM, DM, 127, 127}; pg8::OrderXS S; S.init(F.G, bx);
        pg8::EpiSoftmaxN E{(hb*)(ws + WS_PX), (const float*)(ws + WS_SSP1), (PG8_LAS float*)(F.lds + XCH_OFF), (PG8_LAS float*)(F.lds + XCH2_OFF)};
        pg8::gemm_phase<pg8::EpiSoftmaxN, pg8::OrderXS, true, true>(F.lds + RING_OFF, g, S, E);
    }
    SEAM(4);
    if (IN(5)) {
        pg8::Gemm g{(const hb*)(ws + WS_PX), (const hb*)(ws + WS_HT), NTOK, DM, DM, DM, DM, 127, 127}; pg8::OrderXO S; S.init(F.G, bx);
        pg8::EpiRes2 E{(hb*)(ws + WS_X1B), ws + WS_X2B};
        pg8::gemm_phase<pg8::EpiRes2, pg8::OrderXO, true, true, false, false>(F.lds + RING_OFF, g, S, E);
    }
    SEAM(5);
    if (IN(6)) router_phase(F, (const bf16*)(ws + WS_X1B), (const bf16*)(ws + WS_WR), INP(22), (float*)(ws + WS_RSL), (float*)(ws + WS_GATE), (unsigned*)(ws + WS_ASSIGN), (unsigned*)(ws + WS_LIST), F.ctl + CW_CNT);
    SEAM(6);
    if (IN(7)) {
        const int T = moe_tables(F);
        pg8::Gemm g{(const hb*)(ws + WS_X2B), (const hb*)(ws + WS_WUP), T * 256, NEXP * 2048, 512, 512, 512, 127, 122}; pg8::MoeOrderG S;
        S.init(T, 8, F.G, bx, (const PG8_LAS unsigned char*)(F.lds + TAB_OFF), (const PG8_LAS int*)(F.lds + TAB_TSTART), (const PG8_LAS int*)(F.lds + TAB_CNT), (const unsigned*)(ws + WS_LIST), (PG8_LAS unsigned*)(F.lds + XCH_OFF));
        pg8::EpiUp E{ws + WS_ACT, (const float*)(ws + WS_RSL), (const PG8_LAS int*)(F.lds + TAB_TSTART), (const PG8_LAS int*)(F.lds + TAB_CNT), INP(24), (PG8_LAS unsigned char*)(F.lds + EOP_OFF)};
        pg8::gemm_phase<pg8::EpiUp, pg8::MoeOrderG, true, true, true, false>(F.lds + RING_OFF, g, S, E);
    }
    SEAM(7);
    if (IN(8)) {
        const int T = moe_tables(F);
        pg8::Gemm g{(const hb*)(ws + WS_ACT), (const hb*)(ws + WS_WDN), T * 256, NEXP * 1024, 512, 512, 512, 127, 122}; pg8::MoeOrder S; S.init(T, 4, F.G, bx, (const PG8_LAS unsigned char*)(F.lds + TAB_OFF));
        pg8::EpiDown E{ws + WS_Y, INP(26), (PG8_LAS unsigned char*)(F.lds + EOP_OFF)};
        pg8::gemm_phase<pg8::EpiDown, pg8::MoeOrder, true, true, true, false>(F.lds + RING_OFF, g, S, E);
    }
    SEAM(8);
    if (IN(9)) final_phase(F, (const bf16*)(ws + WS_X1B), F.out, (const unsigned char*)(ws + WS_Y), (const float*)(ws + WS_GATE), (const unsigned*)(ws + WS_ASSIGN), INP(27));
#if defined(PROBE_ATT)
    { xcd_barrier(bar); if (F.tid == 0) tsl[13] = rt();
#pragma unroll 1
      for (int i2 = 2 * F.vcu; i2 < 1024; i2 += 2 * F.G)
#pragma unroll 1
          for (int rep = 0; rep < 2; ++rep) { const int i = i2 >> 1, bh = i >> 3, jj = i & 7;
              diffattn_unit<PROBE_ATT>(F, (const bf16*)(ws + WS_P), (const bf16*)(ws + WS_VT), (bf16*)(ws + WS_ACT), INP(9), 0.5f, bh >> 2, bh & 3, rep ? jj : 15 - jj); }
      xcd_barrier(bar); if (F.tid == 0) tsl[14] = rt(); }
#endif
#if defined(PROBE_GEMM)
    { xcd_barrier(bar); if (F.tid == 0) tsl[13] = rt();
      const int T = moe_tables(F);
      pg8::Gemm g{(const hb*)(ws + WS_X2B), (const hb*)(ws + WS_WUP), T * 256, NEXP * 2048, 512, 512, 512, 127, 122}; pg8::MoeOrderG S;
      S.init(T, 8, F.G, bx, (const PG8_LAS unsigned char*)(F.lds + TAB_OFF), (const PG8_LAS int*)(F.lds + TAB_TSTART), (const PG8_LAS int*)(F.lds + TAB_CNT), (const unsigned*)(ws + WS_LIST), (PG8_LAS unsigned*)(F.lds + XCH_OFF));
      pg8::EpiUp E{ws + WS_ACT, (const float*)(ws + WS_RSL), (const PG8_LAS int*)(F.lds + TAB_TSTART), (const PG8_LAS int*)(F.lds + TAB_CNT), INP(24), (PG8_LAS unsigned char*)(F.lds + EOP_OFF)};
      pg8::gemm_phase<pg8::EpiUp, pg8::MoeOrderG, true, true, true, false, PROBE_GEMM>(F.lds + RING_OFF, g, S, E);
      xcd_barrier(bar); if (F.tid == 0) tsl[14] = rt(); }
#endif
#if defined(PROBE_K0)
#ifndef PROBE_UNIT
#define PROBE_UNIT 1600
#endif
    { if (F.tid == 0) { tsl[NPHASE] = rt();
        const int ks[2] = {PROBE_K0, PROBE_K1}; unsigned long long code = 0, mul = 1;
        for (int i = 0; i < 2; ++i) { unsigned long long dt = ks[i] == 94 ? tsl[14] - tsl[13] : ks[i] == 97 ? tsl[13] - tsl[2] : ks[i] == 98 ? tsl[3] - tsl[13] : ks[i] == 95 ? tsl[13] - tsl[0] : ks[i] == 96 ? tsl[14] - tsl[13] : tsl[ks[i] + 1] - tsl[ks[i]]; unsigned long long q = (dt + PROBE_UNIT / 2) / PROBE_UNIT; if (q > 63) q = 63; code += q * mul; mul *= 64; }
        tsl[15] = code * 6400ull; }
      __syncthreads();
      const unsigned long long t0 = rt(), wait = tsl[15]; float x = (float)F.tid, y = 1.0001f;
      while (rt() - t0 < wait) {
#pragma unroll
          for (int i = 0; i < 64; ++i) x = x * y + 0.5f; }
      if (x == 12345.678f) F.out[0] = x; }
#endif
#undef IN
#undef SEAM
#undef SEAM_LOCAL
}

#ifndef MK_N_LAUNCHES
#define MK_N_LAUNCHES 1
#endif
extern "C" void kernel_launch(void* const* d_in, const int* in_sizes, int n_in, void* d_out, int out_size, void* d_ws, size_t ws_size, hipStream_t stream) {
    static int grid = 0;
    if (grid == 0) {
        if (n_in != 28 || out_size != NTOK * DM || ws_size < WS_END) { fprintf(stderr, "kernel_launch: unexpected shapes: n_in %d out %d ws %zu (need %zu)\n", n_in, out_size, ws_size, (size_t)WS_END); grid = -1; return; }
        int dev = 0, cus = 0, per_cu = 0;
        if (hipGetDevice(&dev) != hipSuccess || hipDeviceGetAttribute(&cus, hipDeviceAttributeMultiprocessorCount, dev) != hipSuccess) { fprintf(stderr, "kernel_launch: device query failed\n"); grid = -1; return; }
        if (hipFuncSetAttribute((const void*)mk_fwd, hipFuncAttributeMaxDynamicSharedMemorySize, LDS_BYTES) != hipSuccess) { fprintf(stderr, "kernel_launch: hipFuncSetAttribute failed\n"); grid = -1; return; }
        if (hipOccupancyMaxActiveBlocksPerMultiprocessor(&per_cu, (const void*)mk_fwd, NWAVES * 64, LDS_BYTES) != hipSuccess || per_cu < 1) { fprintf(stderr, "kernel_launch: occupancy query reports %d workgroups per CU\n", per_cu); (void)hipGetLastError(); grid = -1; return; }
        grid = cus;
    }
    if (grid < 0) return;
    (void)hipMemsetAsync((char*)d_ws + WS_CTL, 0, CTL_ZERO_BYTES, stream);
    Args a{};
    for (int i = 0; i < 28; ++i) a.in[i] = d_in[i];
    a.out = (float*)d_out; a.ws = (unsigned char*)d_ws;
    if (MK_N_LAUNCHES == 1) { a.ph_lo = 0; a.ph_hi = NPHASE; hipLaunchKernelGGL(mk_fwd, dim3(grid), dim3(NWAVES * 64), LDS_BYTES, stream, a); }
    else for (int p = 0; p < NPHASE; ++p) { a.ph_lo = p; a.ph_hi = p + 1; hipLaunchKernelGGL(mk_fwd, dim3(grid), dim3(NWAVES * 64), LDS_BYTES, stream, a); }
}
```

```cpp
#include <hip/hip_runtime.h>
#include <cstdio>
#include <cstdint>
namespace pg8 {
#define PG8_LAS __attribute__((address_space(3)))
typedef unsigned short bf16_t;
typedef short bf16x8 __attribute__((ext_vector_type(8)));
typedef float f32x4 __attribute__((ext_vector_type(4)));
typedef unsigned u32x4 __attribute__((ext_vector_type(4)));
constexpr int BM = 256, BK = 64, HALF = 128, HTB = HALF * BK * 2  , STAGE_BYTES = 8 * HTB, NXCD = 8, WGM = 8;

__host__ __device__ __forceinline__ int lds_byte(int r, int c) { const int st = (r >> 4) * 2 + (c >> 5), rr = r & 15, cc = c & 31, ob = rr * 64 + cc * 2; return st * 1024 + (ob ^ (((ob >> 9) & 1) << 5)); }
__host__ __device__ __forceinline__ void stage_rc(int b, int& R, int& C) { const int st = b / 1024, sb = b % 1024, swz = sb ^ (((sb >> 9) & 1) << 5); R = (st >> 1) * 16 + swz / 64; C = (st & 1) * 32 + (swz % 64) / 2; }
__host__ __device__ __forceinline__ int perm32(int rho) { const int n = rho >> 4, i = rho & 15; return 8 * (i >> 2) + 4 * n + (i & 3); }

struct Unit { int pm, pn; };
struct Gemm { const bf16_t* A; const bf16_t* Bt; int M, N, K, lda, ldb, sa, sb; };
template <class T, class = void> struct epi_ldsops { static constexpr bool value = false; };
template <class T> struct epi_ldsops<T, decltype((void)T::LDSOPS)> { static constexpr bool value = T::LDSOPS; };
struct OrderBase {
    static constexpr bool GATHER = false;
    __device__ __forceinline__ const char* a_base(const Gemm& g, const Unit& u) const { return (const char*)g.A + (size_t)u.pm * 256 * g.lda * 2; }
    __device__ __forceinline__ const char* b_base(const Gemm& g, const Unit& u) const { return (const char*)g.Bt + (size_t)u.pn * 256 * g.ldb * 2; }
    __device__ __forceinline__ void a_ready(const Unit&) const {}
    __device__ __forceinline__ void done(const Unit&) const {}
};

struct StaticOrder : OrderBase {
    int nM, nN, nwg, G, c;
    __host__ __device__ void init(int M, int N, int G_, int c_) { nM = M / BM; nN = N / BM; nwg = nM * nN; G = G_; c = c_; }
    __host__ __device__ bool next(int i, Unit& u) const {
        const long L = (long)i * G + c; if (L >= nwg) return false;
        int wgid = (int)L; { const int q = nwg / NXCD, r = nwg % NXCD, xcd = wgid % NXCD, off = wgid / NXCD; wgid = (xcd < r ? xcd * (q + 1) : r * (q + 1) + (xcd - r) * q) + off; }
        const int nig = WGM * nN, gid = wgid / nig, fm = gid * WGM, gsz = (nM - fm) < WGM ? (nM - fm) : WGM;
        u.pm = fm + ((wgid % nig) % gsz); u.pn = (wgid % nig) / gsz; return true;
    }
};

typedef unsigned u32x2 __attribute__((ext_vector_type(2)));
typedef float f32x2_t __attribute__((ext_vector_type(2)));
typedef __bf16 bf16x2_t __attribute__((ext_vector_type(2)));
__device__ __forceinline__ unsigned cvtpk(float lo, float hi) { f32x2_t v = {lo, hi}; bf16x2_t b = __builtin_convertvector(v, bf16x2_t); return __builtin_bit_cast(unsigned, b); }
__device__ __forceinline__ void st_bf4(bf16_t* p, f32x4 v) { u32x2 w; w.x = cvtpk(v[0], v[1]); w.y = cvtpk(v[2], v[3]); *(u32x2*)p = w; }
__device__ __forceinline__ unsigned cvt4_fp8(f32x4 v) { unsigned w = __builtin_amdgcn_cvt_pk_fp8_f32(v[0], v[1], 0, false); return __builtin_amdgcn_cvt_pk_fp8_f32(v[2], v[3], w, true); }
__device__ __forceinline__ void st_bf8(bf16_t* p, f32x4 a, f32x4 c) { u32x4 w; w.x = cvtpk(a[0], a[1]); w.y = cvtpk(a[2], a[3]); w.z = cvtpk(c[0], c[1]); w.w = cvtpk(c[2], c[3]); *(u32x4*)p = w; }
__device__ __forceinline__ float bf2f(bf16_t b) { return __builtin_bit_cast(float, (unsigned)b << 16); }
#define EPI_ROWS _Pragma("unroll") for (int ai = 0; ai < 2; ++ai) _Pragma("unroll") for (int m = 0; m < 4; ++m)
#define EPI_COLS _Pragma("unroll") for (int bj = 0; bj < 2; ++bj) _Pragma("unroll") for (int n = 0; n < 2; ++n)
constexpr float LOG2E = 1.4426950408889634f;
constexpr float QSCALE_DA = 0.125f * LOG2E;
constexpr float QSCALE_X = 0.0625f * LOG2E;

struct EpiPlain {
    static constexpr bool PERM = true, AFTER_DRAIN = false;
    bf16_t* O; int ldc; float scale;
    __device__ __forceinline__ void operator()(const f32x4 (&acc)[2][2][4][2], const Unit& u, int wr, int wc, int fr, int fq) const {
        EPI_ROWS { const int row = u.pm * 256 + ai * 128 + wr * 64 + m * 16 + fr; bf16_t* rp = O + (size_t)row * ldc + u.pn * 256 + wc * 32 + fq * 8;
            _Pragma("unroll") for (int bj = 0; bj < 2; ++bj) st_bf8(rp + bj * 128, acc[ai][bj][m][0] * scale, acc[ai][bj][m][1] * scale); }
    }
};
struct EpiProj {
    static constexpr bool PERM = true, AFTER_DRAIN = false;
    bf16_t* P; float* LA; const float* cs; const float* b_alpha;
    template <int ai> __device__ __forceinline__ void decay_rows(const f32x4 (&acc)[2][2][4][2], const f32x4 (&bav)[2][2], const Unit& u, int wr, int wc, int fr, int fq) const {
        const int row0 = u.pm * 256 + ai * 128 + wr * 64 + fr;
        EPI_COLS { const int col = bj * 128 + wc * 32 + fq * 8 + n * 4; const f32x4 ba = bav[bj][n]; f32x4 run = {0.f, 0.f, 0.f, 0.f};
            _Pragma("unroll") for (int m = 0; m < 4; ++m) { const f32x4 z = acc[ai][bj][m][n] + ba; f32x4 o;
                _Pragma("unroll") for (int i = 0; i < 4; ++i) { float v = (fminf(z[i], 0.f) - __logf(1.0f + __expf(-fabsf(z[i])))) * 0.0625f;
                    { float t = __shfl_up(v, 1, 16); if (fr >= 1) v += t; t = __shfl_up(v, 2, 16); if (fr >= 2) v += t; t = __shfl_up(v, 4, 16); if (fr >= 4) v += t; t = __shfl_up(v, 8, 16); if (fr >= 8) v += t; }
                    o[i] = v + run[i]; run[i] += __shfl(v, 15, 16); }
                *(f32x4*)(LA + (size_t)(row0 + m * 16) * 256 + col) = o; } }
    }
    __device__ __forceinline__ void operator()(const f32x4 (&acc)[2][2][4][2], const Unit& u, int wr, int wc, int fr, int fq) const {
        const int pn = u.pn;
        if (pn < 4) {
            const float sc = pn < 2 ? QSCALE_DA : 1.0f; const bool ropew = (wc & 1) == 0; const bool rl = fq < 2, hi = fq == 1;
            if (ropew) {
                f32x4 cq[2][4];
#define ROPE_LD(i, sl) do { const f32x4* cp_ = (const f32x4*)(cs + (size_t)(u.pm * 256 + ((i) >> 2) * 128 + wr * 64 + ((i) & 3) * 16 + fr) * 16); cq[sl][0] = cp_[0]; cq[sl][1] = cp_[1]; cq[sl][2] = cp_[2]; cq[sl][3] = cp_[3]; } while (0)
                ROPE_LD(0, 0); ROPE_LD(1, 1);
                _Pragma("unroll") for (int ri = 0; ri < 8; ++ri) { const int ai = ri >> 2, m = ri & 3; const int row = u.pm * 256 + ai * 128 + wr * 64 + m * 16 + fr; bf16_t* rp = P + (size_t)row * 3072 + pn * 256 + wc * 32 + fq * 8;
                    const f32x4 cv[2] = {cq[ri & 1][0], cq[ri & 1][1]}, sv[2] = {cq[ri & 1][2], cq[ri & 1][3]};
                    if (ri + 2 < 8) ROPE_LD(ri + 2, ri & 1);
                    _Pragma("unroll") for (int bj = 0; bj < 2; ++bj) { f32x4 v[2] = {acc[ai][bj][m][0], acc[ai][bj][m][1]};
                        _Pragma("unroll") for (int n = 0; n < 2; ++n) { f32x4 p; p[0] = __shfl_xor(v[n][0], 16); p[1] = __shfl_xor(v[n][1], 16); p[2] = __shfl_xor(v[n][2], 16); p[3] = __shfl_xor(v[n][3], 16);
                            const f32x4 r = hi ? (v[n] * cv[n] + p * sv[n]) : (v[n] * cv[n] - p * sv[n]); v[n] = rl ? r : v[n]; }
                        st_bf8(rp + bj * 128, v[0] * sc, v[1] * sc); } }
#undef ROPE_LD
            } else {
                EPI_ROWS { const int row = u.pm * 256 + ai * 128 + wr * 64 + m * 16 + fr; bf16_t* rp = P + (size_t)row * 3072 + pn * 256 + wc * 32 + fq * 8;
                    _Pragma("unroll") for (int bj = 0; bj < 2; ++bj) st_bf8(rp + bj * 128, acc[ai][bj][m][0] * sc, acc[ai][bj][m][1] * sc); }
            }
        } else if (pn < 12) {
            const float sc = pn == 6 ? 0.125f : 1.0f;
            EPI_ROWS { const int row = u.pm * 256 + ai * 128 + wr * 64 + m * 16 + fr; bf16_t* rp = P + (size_t)row * 3072 + pn * 256 + wc * 32 + fq * 8;
                _Pragma("unroll") for (int bj = 0; bj < 2; ++bj) st_bf8(rp + bj * 128, acc[ai][bj][m][0] * sc, acc[ai][bj][m][1] * sc); }
        } else {
            f32x4 bav[2][2]; EPI_COLS bav[bj][n] = *(const f32x4*)(b_alpha + bj * 128 + wc * 32 + fq * 8 + n * 4);
            decay_rows<0>(acc, bav, u, wr, wc, fr, fq); decay_rows<1>(acc, bav, u, wr, wc, fr, fq);
        }
    }
};
struct EpiP1 {
    static constexpr bool PERM = true, AFTER_DRAIN = false;
    EpiProj proj; EpiPlain vt, kx, vxt;
    __device__ __forceinline__ void operator()(const f32x4 (&acc)[2][2][4][2], const Unit& u, int wr, int wc, int fr, int fq) const {
        const int job = u.pn >> 16; Unit v; v.pm = u.pm; v.pn = u.pn & 0xffff;
        if (job == 0) proj(acc, v, wr, wc, fr, fq); else if (job == 1) vt(acc, v, wr, wc, fr, fq); else if (job == 2) kx(acc, v, wr, wc, fr, fq); else vxt(acc, v, wr, wc, fr, fq);
    }
};
struct EpiRes1 {
    static constexpr bool PERM = true, AFTER_DRAIN = false;
    const float* base; bf16_t* xb; float* ssp;
    __device__ __forceinline__ void operator()(const f32x4 (&acc)[2][2][4][2], const Unit& u, int wr, int wc, int fr, int fq) const {
        constexpr int ND = 3;
        const size_t off0 = (size_t)(u.pm * 256 + wr * 64 + fr) * 1024 + u.pn * 256 + wc * 32 + fq * 8;
        f32x4 xq[ND][4];
#define RES1_LD(i, sl) do { const float* bp_ = base + off0 + (size_t)((((i) >> 2) * 128 + ((i) & 3) * 16)) * 1024; xq[sl][0] = *(const f32x4*)bp_; xq[sl][1] = *(const f32x4*)(bp_ + 4); xq[sl][2] = *(const f32x4*)(bp_ + 128); xq[sl][3] = *(const f32x4*)(bp_ + 132); } while (0)
        _Pragma("unroll") for (int i = 0; i < ND; ++i) RES1_LD(i, i);
        _Pragma("unroll") for (int i = 0; i < 8; ++i) { const int ai = i >> 2, m = i & 3; const int row = u.pm * 256 + ai * 128 + wr * 64 + m * 16 + fr; const size_t off = off0 + (size_t)(ai * 128 + m * 16) * 1024;
            f32x4 v[4]; _Pragma("unroll") for (int q = 0; q < 4; ++q) v[q] = xq[i % ND][q] + acc[ai][q >> 1][m][q & 1];
            if (i + ND < 8) RES1_LD(i + ND, i % ND);
            st_bf8(xb + off, v[0], v[1]); st_bf8(xb + off + 128, v[2], v[3]); float ss = 0.f;
            _Pragma("unroll") for (int q = 0; q < 4; ++q) ss += (v[q][0] * v[q][0] + v[q][1] * v[q][1]) + (v[q][2] * v[q][2] + v[q][3] * v[q][3]);
            ss += __shfl_xor(ss, 16); ss += __shfl_xor(ss, 32);
            if (fq == 0) ssp[(size_t)row * 16 + u.pn * 4 + wc] = ss; }
#undef RES1_LD
    }
};
struct EpiQX {
    static constexpr bool PERM = true, AFTER_DRAIN = false;
    bf16_t* O; const float* ssp;
    __device__ __forceinline__ void operator()(const f32x4 (&acc)[2][2][4][2], const Unit& u, int wr, int wc, int fr, int fq) const {
        EPI_ROWS { const int row = u.pm * 256 + ai * 128 + wr * 64 + m * 16 + fr; const f32x4* sp = (const f32x4*)(ssp + (size_t)row * 16);
            const f32x4 a = sp[0], b = sp[1], c = sp[2], d = sp[3]; const float ss = ((a[0] + a[1]) + (a[2] + a[3])) + ((b[0] + b[1]) + (b[2] + b[3])) + ((c[0] + c[1]) + (c[2] + c[3])) + ((d[0] + d[1]) + (d[2] + d[3]));
            const float rs = rsqrtf(ss * (1.0f / 1024.0f) + 1e-6f) * QSCALE_X; bf16_t* rp = O + (size_t)row * 1024 + u.pn * 256 + wc * 32 + fq * 8;
            _Pragma("unroll") for (int bj = 0; bj < 2; ++bj) st_bf8(rp + bj * 128, acc[ai][bj][m][0] * rs, acc[ai][bj][m][1] * rs); }
    }
};
struct EpiRes2 {
    static constexpr bool PERM = true, AFTER_DRAIN = false;
    bf16_t* xh; unsigned char* x8;
    __device__ __forceinline__ void operator()(const f32x4 (&acc)[2][2][4][2], const Unit& u, int wr, int wc, int fr, int fq) const {
        constexpr int ND = 4;
        const size_t off0 = (size_t)(u.pm * 256 + wr * 64 + fr) * 1024 + u.pn * 256 + wc * 32 + fq * 8;
        u32x4 xq[ND][2];
#define RES2_LD(i, sl) do { const bf16_t* bp_ = xh + off0 + (size_t)((((i) >> 2) * 128 + ((i) & 3) * 16)) * 1024; xq[sl][0] = *(const u32x4*)bp_; xq[sl][1] = *(const u32x4*)(bp_ + 128); } while (0)
        _Pragma("unroll") for (int i = 0; i < ND; ++i) RES2_LD(i, i);
        _Pragma("unroll") for (int i = 0; i < 8; ++i) { const int ai = i >> 2, m = i & 3; const size_t off = off0 + (size_t)(ai * 128 + m * 16) * 1024;
            f32x4 v[2][2];
            _Pragma("unroll") for (int bj = 0; bj < 2; ++bj) { const u32x4 w = xq[i % ND][bj];
                const f32x4 v0 = {__builtin_bit_cast(float, w.x << 16), __builtin_bit_cast(float, w.x & 0xffff0000u), __builtin_bit_cast(float, w.y << 16), __builtin_bit_cast(float, w.y & 0xffff0000u)};
                const f32x4 v1 = {__builtin_bit_cast(float, w.z << 16), __builtin_bit_cast(float, w.z & 0xffff0000u), __builtin_bit_cast(float, w.w << 16), __builtin_bit_cast(float, w.w & 0xffff0000u)};
                v[bj][0] = v0 + acc[ai][bj][m][0]; v[bj][1] = v1 + acc[ai][bj][m][1]; }
            if (i + ND < 8) RES2_LD(i + ND, i % ND);
            _Pragma("unroll") for (int bj = 0; bj < 2; ++bj) { st_bf8(xh + off + bj * 128, v[bj][0], v[bj][1]); u32x2 q; q.x = cvt4_fp8(v[bj][0]); q.y = cvt4_fp8(v[bj][1]); *(u32x2*)(x8 + off + bj * 128) = q; } }
#undef RES2_LD
    }
};
struct EpiUp {
    static constexpr bool PERM = true, AFTER_DRAIN = false, LDSOPS = true;
    unsigned char* ACT; const float* rsl; const PG8_LAS int* tstart; const PG8_LAS int* cnt; const float* b_up; PG8_LAS unsigned char* eop;
    __device__ __forceinline__ void prefetch(const Unit& u, int slot, int wid, int lane) const {
        const int e = u.pn >> 3, pnl = u.pn & 7;
        if (wid == 4) __builtin_amdgcn_global_load_lds((const unsigned*)(rsl + (size_t)e * 32768 + (size_t)(u.pm - tstart[e]) * 256 + lane * 4), (PG8_LAS unsigned*)(eop + slot * 2048), 16, 0, 0);
        else if (wid == 5) __builtin_amdgcn_global_load_lds((const unsigned*)(b_up + (size_t)e * 2048 + pnl * 128 + (lane >> 5) * 1024 + (lane & 31) * 4), (PG8_LAS unsigned*)(eop + slot * 2048 + 1024), 16, 0, 0);
    }
    __device__ __forceinline__ void operator()(const f32x4 (&acc)[2][2][4][2], const Unit& u, int wr, int wc, int fr, int fq, int slot) const {
        const int e = u.pn >> 3, pnl = u.pn & 7;
        const int pos0 = (u.pm - tstart[e]) * 256 + wr * 64 + fr, nv = cnt[e];
        const PG8_LAS float* ls = (const PG8_LAS float*)(eop + slot * 2048) + wr * 64 + fr; const PG8_LAS float* lb = (const PG8_LAS float*)(eop + slot * 2048 + 1024) + wc * 32 + fq * 8;
        const f32x4 bg0 = *(const PG8_LAS f32x4*)lb, bg1 = *(const PG8_LAS f32x4*)(lb + 4), bl0 = *(const PG8_LAS f32x4*)(lb + 128), bl1 = *(const PG8_LAS f32x4*)(lb + 132);
        float rsv[2][4];
        EPI_ROWS rsv[ai][m] = (pos0 + ai * 128 + m * 16) < nv ? ls[ai * 128 + m * 16] : 0.f;
        EPI_ROWS { const int row = u.pm * 256 + ai * 128 + wr * 64 + m * 16 + fr; const float rs = rsv[ai][m];
            unsigned char* rp = ACT + (size_t)row * 1024 + pnl * 128 + wc * 32 + fq * 8; u32x2 w;
            _Pragma("unroll") for (int n = 0; n < 2; ++n) {
                const f32x4 c7 = {7.0f, 7.0f, 7.0f, 7.0f}, one = {1.0f, 1.0f, 1.0f, 1.0f};
                const f32x4 gl = __builtin_elementwise_min(acc[ai][0][m][n] * rs + (n ? bg1 : bg0), c7), li = __builtin_elementwise_min(__builtin_elementwise_max(acc[ai][1][m][n] * rs + (n ? bl1 : bl0), -c7), c7);
                const f32x4 t = gl * -2.4554669595930156f; f32x4 e; _Pragma("unroll") for (int i = 0; i < 4; ++i) e[i] = __builtin_amdgcn_exp2f(t[i]);
                const f32x4 a = e + one; f32x4 r; _Pragma("unroll") for (int i = 0; i < 4; ++i) r[i] = __builtin_amdgcn_rcpf(a[i]);
                const f32x4 o = (gl * r) * (li + one);
                if (n) w.y = cvt4_fp8(o); else w.x = cvt4_fp8(o); }
            *(u32x2*)rp = w; }
    }
};
struct EpiDown {
    static constexpr bool PERM = true, AFTER_DRAIN = false, LDSOPS = true;
    unsigned char* Y; const float* b_down; PG8_LAS unsigned char* eop;
    __device__ __forceinline__ void prefetch(const Unit& u, int slot, int wid, int lane) const {
        const int e = u.pn >> 2, pnl = u.pn & 3;
        if (wid == 4) __builtin_amdgcn_global_load_lds((const unsigned*)(b_down + (size_t)e * 1024 + pnl * 256 + lane * 4), (PG8_LAS unsigned*)(eop + slot * 2048), 16, 0, 0);
    }
    __device__ __forceinline__ void operator()(const f32x4 (&acc)[2][2][4][2], const Unit& u, int wr, int wc, int fr, int fq, int slot) const {
        const int pnl = u.pn & 3; const PG8_LAS float* lb = (const PG8_LAS float*)(eop + slot * 2048) + wc * 32 + fq * 8;
        f32x4 bv[2][2];
        _Pragma("unroll") for (int bj = 0; bj < 2; ++bj) _Pragma("unroll") for (int n = 0; n < 2; ++n) bv[bj][n] = *(const PG8_LAS f32x4*)(lb + bj * 128 + n * 4);
        EPI_ROWS { const int row = u.pm * 256 + ai * 128 + wr * 64 + m * 16 + fr; unsigned char* rp = Y + (size_t)row * 1024 + pnl * 256 + wc * 32 + fq * 8;
            _Pragma("unroll") for (int bj = 0; bj < 2; ++bj) { u32x2 w; w.x = cvt4_fp8(acc[ai][bj][m][0] + bv[bj][0]); w.y = cvt4_fp8(acc[ai][bj][m][1] + bv[bj][1]); *(u32x2*)(rp + bj * 128) = w; } }
    }
};
struct OrderMap : OrderBase {
    StaticOrder so;
    __device__ void init(int nM, int nN, int G, int c) { so.nM = nM; so.nN = nN; so.nwg = nM * nN; so.G = G; so.c = c; }
    __device__ bool next(int i, Unit& u) const { if (!so.next(i, u)) return false; u.pn += (u.pn >= 4 ? 2 : 0) + (u.pn >= 6 ? 2 : 0); return true; }
};
struct OrderVT : OrderBase {
    StaticOrder so;
    __device__ void init(int nN, int G, int c) { so.nM = 4; so.nN = nN; so.nwg = 4 * nN; so.G = G; so.c = c; }
    __device__ bool next(int i, Unit& u) const { if (!so.next(i, u)) return false; u.pm += (u.pm >= 2 ? 6 : 4); return true; }
};
__device__ __forceinline__ void map_unit(int L, int nM, int nN, int& pm, int& pn) {
    const int nwg = nM * nN; int wgid = L; { const int q = nwg / NXCD, r = nwg % NXCD, xcd = wgid % NXCD, off = wgid / NXCD; wgid = (xcd < r ? xcd * (q + 1) : r * (q + 1) + (xcd - r) * q) + off; }
    const int nig = WGM * nN, gid = wgid / nig, fm = gid * WGM, gsz = (nM - fm) < WGM ? (nM - fm) : WGM;
    pm = fm + ((wgid % nig) % gsz); pn = (wgid % nig) / gsz;
}
template <unsigned oHN, unsigned oWINT, unsigned oMN, unsigned oWCK, unsigned oWCV>
struct OrderP1 : OrderBase {
    int G, c; const char* ws;
    __device__ __forceinline__ bool next(int i, Unit& u) const {
        int L = i * G + c; if (L >= 1792) return false;
        if (L < 1152) { map_unit(L, 128, 9, u.pm, u.pn); u.pn += (u.pn >= 4 ? 2 : 0) + (u.pn >= 6 ? 2 : 0); return true; } L -= 1152;
        if (L < 512) { map_unit(L, 4, 128, u.pm, u.pn); u.pm += (u.pm >= 2 ? 6 : 4); u.pn |= 1 << 16; return true; } L -= 512;
        if (L < 64) { map_unit(L, 16, 4, u.pm, u.pn); u.pn |= 2 << 16; return true; } L -= 64;
        map_unit(L, 16, 4, u.pm, u.pn); u.pn |= 3 << 16; return true;
    }
    __device__ __forceinline__ const char* a_base(const Gemm&, const Unit& u) const { const int job = u.pn >> 16; unsigned o = oHN; o = job == 1 ? oWINT : o; o = job >= 2 ? oMN : o; return ws + o + (size_t)u.pm * (256 * 1024 * 2); }
    __device__ __forceinline__ const char* b_base(const Gemm&, const Unit& u) const { const int job = u.pn >> 16; unsigned o = oWINT; o = job == 1 ? oHN : o; o = job == 2 ? oWCK : o; o = job == 3 ? oWCV : o; return ws + o + (size_t)(u.pn & 0xffff) * (256 * 1024 * 2); }
};
struct MoeOrder : OrderBase {
    StaticOrder so; const PG8_LAS unsigned char* tile_e; int nN;
    __device__ void init(int nM, int nN_, int G, int c, const PG8_LAS unsigned char* te) { so.nM = nM; so.nN = nN_; so.nwg = nM * nN_; so.G = G; so.c = c; tile_e = te; nN = nN_; }
    __device__ bool next(int i, Unit& u) const { if (!so.next(i, u)) return false; u.pn += (int)tile_e[u.pm] * nN; return true; }
};


struct MoeOrderG : OrderBase {
    static constexpr bool GATHER = true;
    StaticOrder so; const PG8_LAS unsigned char* tile_e; const PG8_LAS int* tstart; const PG8_LAS int* cnt; const unsigned* list; PG8_LAS unsigned* gslot; int nN;
    __device__ void init(int nM, int nN_, int G, int c, const PG8_LAS unsigned char* te, const PG8_LAS int* ts, const PG8_LAS int* cn, const unsigned* li, PG8_LAS unsigned* gs) {
        so.nM = nM; so.nN = nN_; so.nwg = nM * nN_; so.G = G; so.c = c; tile_e = te; tstart = ts; cnt = cn; list = li; gslot = gs; nN = nN_; }
    __device__ bool next(int i, Unit& u) const { if (!so.next(i, u)) return false; u.pn += (int)tile_e[u.pm] * nN; return true; }
    __device__ __forceinline__ const char* a_base(const Gemm& g, const Unit&) const { return (const char*)g.A; }
    __device__ __forceinline__ const unsigned* rows(const Unit& u) const { const int e = u.pn / nN; return list + (size_t)e * 32768 + (size_t)(u.pm - tstart[e]) * 256; }
    __device__ __forceinline__ int nvalid(const Unit& u) const { const int e = u.pn / nN; return cnt[e] - (u.pm - tstart[e]) * 256; }
};
struct OrderX1 : OrderBase {
    StaticOrder so;
    __device__ void init(int G, int c) { so.nM = 128; so.nN = 4; so.nwg = 512; so.G = G; so.c = c; }
    __device__ bool next(int i, Unit& u) const { return so.next(i, u); }
    __device__ __forceinline__ const char* a_base(const Gemm& g, const Unit& u) const { return (const char*)(g.A + (size_t)u.pm * 256 * 1024 + u.pn * 256); }
    __device__ __forceinline__ const char* b_base(const Gemm& g, const Unit& u) const { return (const char*)(g.Bt + (size_t)(u.pm >> 3) * 256 * 1024 + u.pn * 256); }
};
struct OrderX2 : OrderBase {
    StaticOrder so;
    __device__ void init(int G, int c) { so.nM = 128; so.nN = 4; so.nwg = 512; so.G = G; so.c = c; }
    __device__ bool next(int i, Unit& u) const { return so.next(i, u); }
    __device__ __forceinline__ const char* a_base(const Gemm& g, const Unit& u) const { return (const char*)(g.A + (size_t)u.pm * 256 * 1024 + u.pn * 256); }
    __device__ __forceinline__ const char* b_base(const Gemm& g, const Unit& u) const { return (const char*)(g.Bt + (size_t)u.pn * 256 * 4096 + (u.pm >> 3) * 256); }
};
struct EpiSoftmax {
    static constexpr bool PERM = true, AFTER_DRAIN = false;
    bf16_t* PX; float* lp; PG8_LAS float* xch;
    __device__ __forceinline__ void operator()(const f32x4 (&acc)[2][2][4][2], const Unit& u, int wr, int wc, int fr, int fq) const {
        PG8_LAS char* rb = (PG8_LAS char*)xch + (wr * 64 + fr) * 16; asm volatile("" : "+v"(rb));
        PG8_LAS char* wb = rb + wc * 4; asm volatile("" : "+v"(wb));
        EPI_ROWS { float a = -INFINITY;
            EPI_COLS { const f32x4 v = acc[ai][bj][m][n]; a = fmaxf(a, fmaxf(fmaxf(v[0], v[1]), fmaxf(v[2], v[3]))); }
            a = fmaxf(a, __shfl_xor(a, 16)); a = fmaxf(a, __shfl_xor(a, 32));
            if (fq == 0) *(PG8_LAS float*)(wb + (ai * 128 + m * 16) * 16) = a; }
        asm volatile("s_waitcnt lgkmcnt(0)" ::: "memory"); __builtin_amdgcn_s_barrier(); asm volatile("" ::: "memory");
        const int row0 = u.pm * 256 + wr * 64 + fr; bf16_t* rp0 = PX + (size_t)row0 * 1024 + u.pn * 256 + wc * 32 + fq * 8; float* lp0 = lp + (size_t)row0 * 16 + u.pn * 4 + wc;
        EPI_ROWS { const f32x4 q = *(const PG8_LAS f32x4*)(rb + (ai * 128 + m * 16) * 16); const float mr = fmaxf(fmaxf(q[0], q[1]), fmaxf(q[2], q[3]));
            bf16_t* rp = rp0 + (size_t)(ai * 128 + m * 16) * 1024; float ps = 0.f;
            _Pragma("unroll") for (int bj = 0; bj < 2; ++bj) { f32x4 p[2];
                _Pragma("unroll") for (int n = 0; n < 2; ++n) _Pragma("unroll") for (int i = 0; i < 4; ++i) { p[n][i] = __builtin_amdgcn_exp2f(acc[ai][bj][m][n][i] - mr); ps += p[n][i]; }
                st_bf8(rp + bj * 128, p[0], p[1]); }
            ps += __shfl_xor(ps, 16); ps += __shfl_xor(ps, 32);
            if (fq == 0) lp0[(ai * 128 + m * 16) * 16] = ps; }
        asm volatile("s_waitcnt lgkmcnt(0)" ::: "memory"); __builtin_amdgcn_s_barrier(); asm volatile("" ::: "memory");
    }
};
struct EpiPV {
    static constexpr bool PERM = true, AFTER_DRAIN = false;
    bf16_t* O; const float* lp;
    __device__ __forceinline__ void operator()(const f32x4 (&acc)[2][2][4][2], const Unit& u, int wr, int wc, int fr, int fq) const {
        EPI_ROWS { const int row = u.pm * 256 + ai * 128 + wr * 64 + m * 16 + fr; const f32x4 q = *(const f32x4*)(lp + (size_t)row * 16 + u.pn * 4);
            const float inv = 1.0f / ((q[0] + q[1]) + (q[2] + q[3])); bf16_t* rp = O + (size_t)row * 1024 + u.pn * 256 + wc * 32 + fq * 8;
            _Pragma("unroll") for (int bj = 0; bj < 2; ++bj) st_bf8(rp + bj * 128, acc[ai][bj][m][0] * inv, acc[ai][bj][m][1] * inv); }
    }
};

template <unsigned oKX, unsigned oWCQR, unsigned oWCOT, unsigned oVX>
struct OrderGH : OrderBase {
    int G, c; const char* ws;
    __device__ __forceinline__ bool next(int i, Unit& u) const { int L = i * G + c; if (L >= 512) return false;
        if (L < 256) { u.pm = L >> 2; u.pn = L & 3; } else { L -= 256; u.pm = L >> 2; u.pn = (L & 3) | (1 << 16); } return true; }
    __device__ __forceinline__ const char* a_base(const Gemm&, const Unit& u) const { const int job = u.pn >> 16, pn = u.pn & 0xffff;
        return job == 0 ? ws + oKX + ((size_t)(u.pm >> 2) * 256 * 1024 + (u.pm & 3) * 256) * 2 : ws + oWCOT + ((size_t)(u.pm & 3) * 256 * 1024 + pn * 256) * 2; }
    __device__ __forceinline__ const char* b_base(const Gemm&, const Unit& u) const { const int job = u.pn >> 16, pn = u.pn & 0xffff;
        return job == 0 ? ws + oWCQR + ((size_t)pn * 256 * 1024 + (u.pm & 3) * 256) * 2 : ws + oVX + ((size_t)(u.pm >> 2) * 256 * 1024 + pn * 256) * 2; }
};
struct EpiGH {
    static constexpr bool PERM = true, AFTER_DRAIN = false;
    EpiPlain gt, ht;
    __device__ __forceinline__ void operator()(const f32x4 (&acc)[2][2][4][2], const Unit& u, int wr, int wc, int fr, int fq) const {
        Unit v; v.pm = u.pm; v.pn = u.pn & 0xffff; if ((u.pn >> 16) == 0) gt(acc, v, wr, wc, fr, fq); else ht(acc, v, wr, wc, fr, fq); }
};
struct OrderXS : OrderBase {
    StaticOrder so;
    __device__ void init(int G, int c) { so.nM = 128; so.nN = 4; so.nwg = 512; so.G = G; so.c = c; }
    __device__ bool next(int i, Unit& u) const { return so.next(i, u); }
    __device__ __forceinline__ const char* b_base(const Gemm& g, const Unit& u) const { return (const char*)(g.Bt + ((size_t)(u.pm >> 3) * 1024 + u.pn * 256) * 1024); }
};
struct EpiSoftmaxN {
    static constexpr bool PERM = true, AFTER_DRAIN = false;
    bf16_t* PX; const float* ssp; PG8_LAS float* xmax; PG8_LAS float* xsum;
    __device__ __forceinline__ void operator()(f32x4 (&acc)[2][2][4][2], const Unit& u, int wr, int wc, int fr, int fq) const {
        PG8_LAS char* rb = (PG8_LAS char*)xmax + (wr * 64 + fr) * 16; asm volatile("" : "+v"(rb));
        PG8_LAS char* wb = rb + wc * 4; asm volatile("" : "+v"(wb));
        PG8_LAS char* rb2 = (PG8_LAS char*)xsum + (wr * 64 + fr) * 16; asm volatile("" : "+v"(rb2));
        PG8_LAS char* wb2 = rb2 + wc * 4; asm volatile("" : "+v"(wb2));
        const int row0 = u.pm * 256 + wr * 64 + fr;
        f32x4 sq[2][4];
        EPI_ROWS sq[ai][m] = ((const f32x4*)(ssp + (size_t)(row0 + ai * 128 + m * 16) * 16))[fq];
        EPI_ROWS { float ss = (sq[ai][m][0] + sq[ai][m][1]) + (sq[ai][m][2] + sq[ai][m][3]); ss += __shfl_xor(ss, 16); ss += __shfl_xor(ss, 32);
            const float rs = rsqrtf(ss * (1.0f / 1024.0f) + 1e-6f) * QSCALE_X; float a = -INFINITY;
            EPI_COLS { f32x4 v = acc[ai][bj][m][n] * rs; acc[ai][bj][m][n] = v; a = fmaxf(a, fmaxf(fmaxf(v[0], v[1]), fmaxf(v[2], v[3]))); }
            a = fmaxf(a, __shfl_xor(a, 16)); a = fmaxf(a, __shfl_xor(a, 32));
            if (fq == 0) *(PG8_LAS float*)(wb + (ai * 128 + m * 16) * 16) = a; }
        asm volatile("s_waitcnt lgkmcnt(0)" ::: "memory"); __builtin_amdgcn_s_barrier(); asm volatile("" ::: "memory");
        EPI_ROWS { const f32x4 q = *(const PG8_LAS f32x4*)(rb + (ai * 128 + m * 16) * 16); const float mr = fmaxf(fmaxf(q[0], q[1]), fmaxf(q[2], q[3])); float ps = 0.f;
            EPI_COLS { f32x4 p; _Pragma("unroll") for (int i = 0; i < 4; ++i) { p[i] = __builtin_amdgcn_exp2f(acc[ai][bj][m][n][i] - mr); ps += p[i]; } acc[ai][bj][m][n] = p; }
            ps += __shfl_xor(ps, 16); ps += __shfl_xor(ps, 32);
            if (fq == 0) *(PG8_LAS float*)(wb2 + (ai * 128 + m * 16) * 16) = ps; }
        asm volatile("s_waitcnt lgkmcnt(0)" ::: "memory"); __builtin_amdgcn_s_barrier(); asm volatile("" ::: "memory");
        bf16_t* rp0 = PX + (size_t)row0 * 1024 + u.pn * 256 + wc * 32 + fq * 8;
        EPI_ROWS { const f32x4 q = *(const PG8_LAS f32x4*)(rb2 + (ai * 128 + m * 16) * 16); const float inv = __builtin_amdgcn_rcpf((q[0] + q[1]) + (q[2] + q[3]));
            bf16_t* rp = rp0 + (size_t)(ai * 128 + m * 16) * 1024;
            _Pragma("unroll") for (int bj = 0; bj < 2; ++bj) st_bf8(rp + bj * 128, acc[ai][bj][m][0] * inv, acc[ai][bj][m][1] * inv); }
    }
};
struct OrderXO : OrderBase {
    StaticOrder so;
    __device__ void init(int G, int c) { so.nM = 128; so.nN = 4; so.nwg = 512; so.G = G; so.c = c; }
    __device__ bool next(int i, Unit& u) const { return so.next(i, u); }
    __device__ __forceinline__ const char* b_base(const Gemm& g, const Unit& u) const { return (const char*)(g.Bt + ((size_t)(u.pm >> 3) * 1024 + u.pn * 256) * 1024); }
};
typedef int v4i_t __attribute__((ext_vector_type(4))); typedef int v8i_t __attribute__((ext_vector_type(8)));
__device__ __forceinline__ v8i_t cat8(bf16x8 lo, bf16x8 hi) { return __builtin_shufflevector(__builtin_bit_cast(v4i_t, lo), __builtin_bit_cast(v4i_t, hi), 0, 1, 2, 3, 4, 5, 6, 7); }
__device__ __forceinline__ void mfma8(f32x4& acc, v8i_t w, v8i_t a, int sw, int sa) {
    asm volatile("s_nop 1\n\tv_mfma_scale_f32_16x16x128_f8f6f4 %0, %1, %2, %0, %3, %4 op_sel_hi:[0,0,0]" : "+v"(acc) : "v"(w), "v"(a), "v"(sw), "v"(sa)); }
constexpr int PF_D = 4, PF_LDS = 137216;
template <class Epi, class Sched, bool ALIGN_EPI = false, bool SP2 = false, bool FP8 = false, bool PF = false, int DBG = 0>
__device__ __forceinline__ void gemm_phase(PG8_LAS unsigned char* lds, const Gemm g, const Sched& S, const Epi& E) {
    const int tid = threadIdx.x, wid = __builtin_amdgcn_readfirstlane(tid >> 6), lane = tid & 63, wr = wid >> 2, wc = wid & 3, fr = lane & 15, fq = lane >> 4;
    const int K = g.K, nt = K / BK;
    unsigned voffA[2], voffB[2];
    unsigned gC[2][2];
#pragma unroll
    for (int i = 0; i < 2; ++i) { int R, C; stage_rc(tid * 16 + i * 8192, R, C); const int Rb = Epi::PERM ? ((R & ~31) + perm32(R & 31)) : R;
        voffA[i] = (unsigned)(R * g.lda + C) * 2u; voffB[i] = (unsigned)(Rb * g.ldb + C) * 2u; }
    const bool pfA = !Sched::GATHER && wid < 4;
    const unsigned pfoff = (unsigned)((((wid >> 1) & 1) * HALF + (wid & 1) * 64 + lane) * (pfA ? g.lda : g.ldb)) * 2u;
    const size_t kstep = (size_t)(BK * 2);
    const size_t hstepA = (size_t)HALF * g.lda * 2, hstepB = (size_t)HALF * g.ldb * 2;
    const unsigned ldsw = (unsigned)wid * 1024u;
    const int aoff = lds_byte(wr * 64 + fr, fq * 8), boff = lds_byte(wc * 32 + fr, fq * 8);
#define PG8_SA(b, h) (((b) * 2 + (h)) * HTB)
#define PG8_SB(b, h) ((4 + (b) * 2 + (h)) * HTB)
#define PG8_STAGE(bufoff, gbase, voff) do { if constexpr ((DBG & 2) == 0) _Pragma("unroll") for (int _i = 0; _i < 2; ++_i) \
        __builtin_amdgcn_global_load_lds((const unsigned*)((const char*)(gbase) + (voff)[_i]), (PG8_LAS unsigned*)(lds + (bufoff) + ldsw + _i * 8192), 16, 0, 0); } while (0)
#define PG8_STAGE_A(bufoff, ptr, h, nx) do { if constexpr (Sched::GATHER) { PG8_STAGE(bufoff, ptr, gC[h]); } else { PG8_STAGE(bufoff, (ptr) + ((h) ? hstepA : 0), voffA); } } while (0)
#define PG8_LDA(dst, b, h) do { if constexpr ((DBG & 8) == 0) _Pragma("unroll") for (int m = 0; m < 4; ++m) _Pragma("unroll") for (int k = 0; k < 2; ++k) dst[m][k] = *(const PG8_LAS bf16x8*)(lds + PG8_SA(b, h) + aoff + m * 2048 + k * 1024); } while (0)
#define PG8_LDB(dst, b, h) do { if constexpr ((DBG & 8) == 0) _Pragma("unroll") for (int n = 0; n < 2; ++n) _Pragma("unroll") for (int k = 0; k < 2; ++k) dst[n][k] = *(const PG8_LAS bf16x8*)(lds + PG8_SB(b, h) + boff + n * 2048 + k * 1024); } while (0)
#define PG8_MMA(ai, bj, At, Bt) do { if constexpr ((DBG & 1) == 0) { __builtin_amdgcn_s_setprio(1); \
        if constexpr (FP8) { _Pragma("unroll") for (int m = 0; m < 4; ++m) _Pragma("unroll") for (int n = 0; n < 2; ++n) \
            mfma8(acc[ai][bj][m][n], cat8(Bt[n][0], Bt[n][1]), cat8(At[m][0], At[m][1]), g.sb, g.sa); } \
        else { _Pragma("unroll") for (int m = 0; m < 4; ++m) _Pragma("unroll") for (int n = 0; n < 2; ++n) _Pragma("unroll") for (int k = 0; k < 2; ++k) \
            acc[ai][bj][m][n] = __builtin_amdgcn_mfma_f32_16x16x32_bf16(Bt[n][k], At[m][k], acc[ai][bj][m][n], 0, 0, 0); } \
        __builtin_amdgcn_s_setprio(0); } } while (0)
#define PG8_WAIT_V(n) asm volatile("s_waitcnt vmcnt(" #n ")" ::: "memory")
#define PG8_WAIT_VP() do { if constexpr (PF) asm volatile("s_waitcnt vmcnt(9)" ::: "memory"); else asm volatile("s_waitcnt vmcnt(8)" ::: "memory"); } while (0)
#define PG8_PREFETCH(tp) do { if constexpr (PF) { const int tp_ = (tp); const char* pb_ = tp_ < nt ? (pfA ? cA : cB) + (size_t)tp_ * kstep : (pfA ? nA : nB) + (size_t)(tp_ - nt) * kstep; \
        __builtin_amdgcn_global_load_lds((const unsigned*)(pb_ + pfoff), (PG8_LAS unsigned*)(lds + PF_LDS + wid * 256), 4, 0, 0); } } while (0)
#define PG8_WAIT_L(n) asm volatile("s_waitcnt lgkmcnt(" #n ")" ::: "memory")
#define PG8_BAR __builtin_amdgcn_s_barrier()
#define PG8_SCHED __builtin_amdgcn_sched_barrier(0)
    Unit cur, nxt; int ui = 0;
    if (!S.next(0, cur)) return;
    f32x4 acc[2][2][4][2];
#pragma unroll
    for (int a = 0; a < 2; ++a)
#pragma unroll
        for (int b = 0; b < 2; ++b)
#pragma unroll
            for (int m = 0; m < 4; ++m)
#pragma unroll
                for (int n = 0; n < 2; ++n) acc[a][b][m][n] = (f32x4){0.f, 0.f, 0.f, 0.f};
    bf16x8 At[4][2], B0[2][2], B1[2][2];
    const char* cA = S.a_base(g, cur); const char* cB = S.b_base(g, cur);
    if constexpr (Sched::GATHER) { const unsigned* rp = S.rows(cur); const int nv = S.nvalid(cur);
#pragma unroll
        for (int h = 0; h < 2; ++h)
#pragma unroll
            for (int i = 0; i < 2; ++i) { int R, C; stage_rc(tid * 16 + i * 8192, R, C); const int r = h * HALF + R; const unsigned tok = r < nv ? rp[r] : 0u; gC[h][i] = tok * (unsigned)(g.lda * 2) + (unsigned)C * 2u; } }
    constexpr bool LO = epi_ldsops<Epi>::value; int us = 0;
    if constexpr (LO) E.prefetch(cur, 0, wid, lane);
    S.a_ready(cur);
    if constexpr (SP2) {
        PG8_STAGE(PG8_SB(0, 0), cB, voffB); PG8_STAGE(PG8_SB(0, 1), cB + hstepB, voffB); PG8_STAGE_A(PG8_SA(0, 0), cA, 0, 0); PG8_STAGE_A(PG8_SA(0, 1), cA, 1, 0);
        if (wr == 1) PG8_BAR;
        PG8_WAIT_V(2); PG8_BAR;
        PG8_STAGE(PG8_SB(1, 0), cB + kstep, voffB); PG8_STAGE_A(PG8_SA(1, 0), cA + kstep, 0, 0); PG8_STAGE(PG8_SB(1, 1), cB + hstepB + kstep, voffB);
        PG8_WAIT_V(6); PG8_BAR;
    } else {
        PG8_STAGE(PG8_SB(0, 0), cB, voffB); PG8_STAGE_A(PG8_SA(0, 0), cA, 0, 0); PG8_STAGE(PG8_SB(0, 1), cB + hstepB, voffB); PG8_STAGE_A(PG8_SA(0, 1), cA, 1, 0);
        if (wr == 1) PG8_BAR;
        PG8_WAIT_V(4); PG8_BAR;
        PG8_STAGE(PG8_SB(1, 0), cB + kstep, voffB); PG8_STAGE_A(PG8_SA(1, 0), cA + kstep, 0, 0); PG8_STAGE(PG8_SB(1, 1), cB + hstepB + kstep, voffB);
        PG8_WAIT_V(6); PG8_BAR;
    }
    for (;;) {
        const bool has_next = S.next(ui + 1, nxt);
        const char* nA = has_next ? S.a_base(g, nxt) : cA; const char* nB = has_next ? S.b_base(g, nxt) : cB;
        if constexpr (LO) { if (has_next) E.prefetch(nxt, us == 2 ? 0 : us + 1, wid, lane); }
        if constexpr (Sched::GATHER) { if (has_next && wid < 4)
            __builtin_amdgcn_global_load_lds((const unsigned*)(S.rows(nxt) + wid * 64 + lane), (PG8_LAS unsigned*)(S.gslot + ((ui + 1) & 1) * 256 + wid * 64), 4, 0, 0); }
#pragma nounroll
        for (int t = 0; t < nt; t += 2) {
            const bool last = (t == nt - 2);
            const char* a1 = cA + (size_t)(t + 1) * kstep;
            const char* a2 = last ? nA : cA + (size_t)(t + 2) * kstep; const char* b2 = last ? nB : cB + (size_t)(t + 2) * kstep;
            const char* a3 = a2 + kstep; const char* b3 = b2 + kstep;
            if (last && has_next) S.a_ready(nxt);
            if constexpr (SP2) {
            PG8_LDB(B0, 0, 0); PG8_LDB(B1, 0, 1); PG8_SCHED; PG8_LDA(At, 0, 0); PG8_STAGE_A(PG8_SA(1, 1), a1, 1, 0);
            if constexpr (Sched::GATHER) { if (last && has_next) {
                const PG8_LAS unsigned* sl = S.gslot + ((ui + 1) & 1) * 256; const int nv = S.nvalid(nxt);
#pragma unroll
                for (int h = 0; h < 2; ++h)
#pragma unroll
                    for (int i = 0; i < 2; ++i) { int R, C; stage_rc(tid * 16 + i * 8192, R, C); const int r = h * HALF + R; const unsigned v = sl[r]; const unsigned tok = r < nv ? v : 0u; gC[h][i] = tok * (unsigned)(g.lda * 2) + (unsigned)C * 2u; } } }
            PG8_WAIT_VP(); PG8_WAIT_L(0); PG8_BAR; PG8_MMA(0, 0, At, B0); PG8_MMA(0, 1, At, B1); PG8_BAR; PG8_SCHED;
            PG8_LDA(At, 0, 1); PG8_STAGE(PG8_SB(0, 0), b2, voffB); PG8_STAGE(PG8_SB(0, 1), b2 + hstepB, voffB); PG8_STAGE_A(PG8_SA(0, 0), a2, 0, 1); PG8_PREFETCH(t + PF_D);
            PG8_WAIT_VP(); PG8_WAIT_L(0); PG8_BAR; PG8_MMA(1, 0, At, B0); PG8_MMA(1, 1, At, B1); PG8_BAR; PG8_SCHED;
            PG8_LDB(B0, 1, 0); PG8_LDB(B1, 1, 1); PG8_SCHED; PG8_LDA(At, 1, 0); PG8_STAGE_A(PG8_SA(0, 1), a2, 1, 1);
            PG8_WAIT_VP(); PG8_WAIT_L(0); PG8_BAR; PG8_MMA(0, 0, At, B0); PG8_MMA(0, 1, At, B1); PG8_BAR; PG8_SCHED;
            PG8_LDA(At, 1, 1); PG8_STAGE(PG8_SB(1, 0), b3, voffB); PG8_STAGE(PG8_SB(1, 1), b3 + hstepB, voffB); PG8_STAGE_A(PG8_SA(1, 0), a3, 0, 1); PG8_PREFETCH(t + 1 + PF_D);
            PG8_WAIT_VP(); PG8_WAIT_L(0); PG8_BAR; PG8_MMA(1, 0, At, B0); PG8_MMA(1, 1, At, B1); PG8_BAR; PG8_SCHED;
            } else {
            PG8_LDB(B0, 0, 0); PG8_SCHED; PG8_LDA(At, 0, 0); PG8_STAGE_A(PG8_SA(1, 1), a1, 1, 0);
            PG8_WAIT_L(8); PG8_BAR; PG8_WAIT_L(0); PG8_MMA(0, 0, At, B0); PG8_BAR; PG8_SCHED;
            PG8_LDB(B1, 0, 1); PG8_STAGE(PG8_SB(0, 0), b2, voffB);
            PG8_BAR; PG8_WAIT_L(0); PG8_MMA(0, 1, At, B1); PG8_BAR;
            PG8_LDA(At, 0, 1); PG8_STAGE_A(PG8_SA(0, 0), a2, 0, 1);
            PG8_BAR; PG8_WAIT_L(0); PG8_MMA(1, 0, At, B0); PG8_BAR; PG8_SCHED;
            PG8_STAGE(PG8_SB(0, 1), b2 + hstepB, voffB);
            PG8_WAIT_V(6); PG8_BAR; PG8_MMA(1, 1, At, B1); PG8_BAR;
            PG8_LDB(B0, 1, 0); PG8_SCHED; PG8_LDA(At, 1, 0); PG8_STAGE_A(PG8_SA(0, 1), a2, 1, 1);
            PG8_WAIT_L(8); PG8_BAR; PG8_WAIT_L(0); PG8_MMA(0, 0, At, B0); PG8_BAR; PG8_SCHED;
            PG8_LDB(B1, 1, 1); PG8_STAGE(PG8_SB(1, 0), b3, voffB);
            PG8_BAR; PG8_WAIT_L(0); PG8_MMA(0, 1, At, B1); PG8_BAR;
            PG8_LDA(At, 1, 1); PG8_STAGE_A(PG8_SA(1, 0), a3, 0, 1);
            PG8_BAR; PG8_WAIT_L(0); PG8_MMA(1, 0, At, B0); PG8_BAR; PG8_SCHED;
            PG8_STAGE(PG8_SB(1, 1), b3 + hstepB, voffB);
            PG8_WAIT_V(6); PG8_BAR; PG8_MMA(1, 1, At, B1); PG8_BAR;
            }
        }
        if constexpr (ALIGN_EPI) { if (wr == 0) PG8_BAR; }
        if constexpr (FP8) asm volatile("s_nop 15\n\ts_nop 15" ::: "memory");
        if constexpr (!Epi::AFTER_DRAIN && (DBG & 4) == 0) { if constexpr (LO) E(acc, cur, wr, wc, fr, fq, us); else E(acc, cur, wr, wc, fr, fq); S.done(cur); }
        if (!has_next) break;
#pragma unroll
        for (int a = 0; a < 2; ++a)
#pragma unroll
            for (int b = 0; b < 2; ++b)
#pragma unroll
                for (int m = 0; m < 4; ++m)
#pragma unroll
                    for (int n = 0; n < 2; ++n) acc[a][b][m][n] = (f32x4){0.f, 0.f, 0.f, 0.f};
        cur = nxt; cA = nA; cB = nB; ++ui; us = us == 2 ? 0 : us + 1;
        if constexpr (ALIGN_EPI) { if (wr == 1) PG8_BAR; }
    }
    PG8_WAIT_V(0);
    if constexpr (!ALIGN_EPI) { if (wr == 0) PG8_BAR; }
    PG8_BAR;
    if constexpr (Epi::AFTER_DRAIN) { E.fused(acc, cur, wr, wc, fr, fq, lds, wid, lane); S.done(cur); }
#undef PG8_SA
#undef PG8_SB
#undef PG8_STAGE
#undef PG8_STAGE_A
#undef PG8_LDA
#undef PG8_LDB
#undef PG8_MMA
#undef PG8_WAIT_V
#undef PG8_WAIT_VP
#undef PG8_PREFETCH
#undef PG8_WAIT_L
#undef PG8_BAR
#undef PG8_SCHED
}
}
constexpr int NTOK = 32768, DM = 1024, SEQ = 2048, NBATCH = 16, MEMLEN = 256, NMEM = NBATCH * MEMLEN, INW = 3088, NEXP = 32, TOPK = 4;
constexpr int PW = 3072;
constexpr int MAXTILES = 544;
constexpr float EPS = 1e-6f;
constexpr int NWAVES = 8;
constexpr size_t MiB = 1u << 20;
constexpr size_t WS_CTL = 0, CTL_ZERO_BYTES = 64 * 1024;
constexpr size_t WS_WINT = 2 * MiB, WS_WOUT = 10 * MiB, WS_WCQ = 12 * MiB, WS_WCK = 14 * MiB, WS_WCV = 16 * MiB, WS_WCO = 18 * MiB;
constexpr size_t WS_WR = 20 * MiB, WS_CS = 21 * MiB, WS_SSP1 = 24 * MiB, WS_GATE = 27 * MiB, WS_ASSIGN = 28 * MiB, WS_LIST = 29 * MiB;
constexpr size_t WS_RSL = 842 * MiB;
constexpr size_t WS_X2B = 378 * MiB;
constexpr size_t WS_WUP = 34 * MiB, WS_WDN = 162 * MiB, WS_KX = 226 * MiB, WS_VXT = 234 * MiB;
constexpr size_t WS_HN = 242 * MiB, WS_CAT = 242 * MiB, WS_MN = 306 * MiB, WS_P = 314 * MiB, WS_LA = 506 * MiB, WS_VT = 538 * MiB;
constexpr size_t WS_X1B = 314 * MiB, WS_GT = 378 * MiB, WS_HT = 410 * MiB, WS_PX = 506 * MiB;
constexpr size_t WS_GVT = 602 * MiB;
constexpr size_t WS_ACT = 570 * MiB, WS_Y = 706 * MiB, WS_END = 846 * MiB;
constexpr int CW_Q2 = 128;
constexpr int CW_CNT = 1024;
constexpr int CW_PROBE = 192;
constexpr int CW_BAR = 4096;
constexpr int RING_OFF = 0, RING_BYTES = 131072;
constexpr int LDSCTL_OFF = RING_BYTES, MISC_OFF = LDSCTL_OFF + 320;
constexpr int TAB_OFF = LDSCTL_OFF + 512;
constexpr int TAB_TSTART = TAB_OFF + 576, TAB_CNT = TAB_TSTART + 144;
constexpr int XCH2_OFF = LDSCTL_OFF + 6144;
constexpr int XCH_OFF = LDSCTL_OFF + 2048;
constexpr int TS_OFF = TAB_CNT + 128;
constexpr int EOP_OFF = LDSCTL_OFF + 10240;
constexpr int LDS_BYTES = 147456;

#define GAS __attribute__((address_space(1)))
#define LAS __attribute__((address_space(3)))
typedef unsigned short bf16;
typedef unsigned v4u __attribute__((ext_vector_type(4)));
typedef float f32x4 __attribute__((ext_vector_type(4)));
typedef short bf16x8 __attribute__((ext_vector_type(8)));
typedef GAS unsigned gu32;
typedef GAS unsigned long long gu64;
#define RLX_AGENT __ATOMIC_RELAXED, __HIP_MEMORY_SCOPE_AGENT
#define LDS_WAIT() asm volatile("s_waitcnt lgkmcnt(0)" ::: "memory")
#define VM_WAIT() asm volatile("s_waitcnt vmcnt(0)" ::: "memory")
__device__ __forceinline__ unsigned long long rt() { return __builtin_amdgcn_s_memrealtime(); }
__device__ __forceinline__ unsigned f2bf(float f) { unsigned u = __builtin_bit_cast(unsigned, f); return (u + 0x7fffu + ((u >> 16) & 1u)) >> 16; }
__device__ __forceinline__ unsigned pk2(float lo, float hi) { return f2bf(lo) | (f2bf(hi) << 16); }

#define XB_TMO      128
#define XB_XCNT(j)  (256  + 64 * (j))
#define XB_XSUB(j)  (1280 + 64 * (j))
#define XB_XGEN(j)  (2304 + 64 * (j))
#define XB_TOP      3328
#define XB_TOPGEN   3392
#define XCD_BAR_WORDS 3456
#define XB_SPIN_CAP (1u << 18)

__device__ __forceinline__ unsigned xb_ld(unsigned* p)              { return __hip_atomic_load(p, __ATOMIC_RELAXED, __HIP_MEMORY_SCOPE_AGENT); }
__device__ __forceinline__ unsigned xb_add(unsigned* p, unsigned v) { return __hip_atomic_fetch_add(p, v, __ATOMIC_RELAXED, __HIP_MEMORY_SCOPE_AGENT); }
__device__ __forceinline__ unsigned xb_xcc_id() { return (unsigned)__builtin_amdgcn_s_getreg((3 << 11) | 20) & 0xFu; }
#define XB_SPIN(cond, bar) do { unsigned _sp = 0; while (cond) { __builtin_amdgcn_s_sleep(1); \
    if ((++_sp & 255u) == 0u) { if (xb_ld(&(bar)[XB_TMO])) break; if (_sp > XB_SPIN_CAP) { atomicAdd(&(bar)[XB_TMO], 1u); break; } } } } while (0)

struct XcdBarrier {
    unsigned* bar; unsigned x;
    volatile LAS unsigned* st;
};

__device__ __forceinline__ XcdBarrier xcd_barrier_post(unsigned* bar, volatile LAS unsigned* st) {
    XcdBarrier b; b.bar = bar; b.x = xb_xcc_id(); b.st = st;
    if (threadIdx.x == 0) (void)xb_add(&bar[XB_XCNT(b.x)], 1u);
    return b;
}
__device__ __forceinline__ void xcd_barrier_complete(unsigned* bar, unsigned x, unsigned& nloc, unsigned& nx) {
    const unsigned G = gridDim.x * gridDim.y * gridDim.z;
    unsigned sum, cnt, mine, sp = 0u;
    for (;;) {
        sum = 0u; cnt = 0u; mine = 0u;
#pragma unroll
        for (unsigned j = 0; j < 16; ++j) { const unsigned c = xb_ld(&bar[XB_XCNT(j)]); sum += c; cnt += (c > 0u) ? 1u : 0u; mine = (j == x) ? c : mine; }
        if (sum == G) break;
        __builtin_amdgcn_s_sleep(1);
        if ((++sp & 255u) == 0u) { if (xb_ld(&bar[XB_TMO])) break; if (sp > XB_SPIN_CAP) { atomicAdd(&bar[XB_TMO], 1u); break; } }
    }
    nloc = mine > 0u ? mine : 1u; nx = cnt > 0u ? cnt : 1u;
}

__device__ __forceinline__ void xcd_barrier(const XcdBarrier& b) {
    asm volatile("s_waitcnt vmcnt(0)" ::: "memory");
    __syncthreads();
    if (threadIdx.x == 0) {
        unsigned* bar = b.bar;
        __builtin_amdgcn_s_waitcnt(0);
        unsigned nloc = b.st[0], nx = b.st[1];
        if (nloc == 0u) { xcd_barrier_complete(bar, b.x, nloc, nx); b.st[0] = nloc; b.st[1] = nx; }
        const unsigned old = xb_add(&bar[XB_XSUB(b.x)], 1u);
        const unsigned gen = old / nloc;
        if (old + 1u == (gen + 1u) * nloc) {
            __builtin_amdgcn_fence(__ATOMIC_RELEASE, "agent");
            asm volatile("s_waitcnt vmcnt(0)" ::: "memory");
            const unsigned og = xb_add(&bar[XB_TOP], 1u);
            const unsigned tg = og / nx;
            if (og + 1u == (tg + 1u) * nx) xb_add(&bar[XB_TOPGEN], 1u);
            else XB_SPIN(xb_ld(&bar[XB_TOPGEN]) == tg, bar);
            __builtin_amdgcn_fence(__ATOMIC_ACQUIRE, "agent");
            xb_add(&bar[XB_XGEN(b.x)], 1u);
            asm volatile("s_waitcnt vmcnt(0)" ::: "memory");
        } else {
            XB_SPIN(xb_ld(&bar[XB_XGEN(b.x)]) == gen, bar);
            __builtin_amdgcn_fence(__ATOMIC_ACQUIRE, "agent");
            asm volatile("s_waitcnt vmcnt(0)" ::: "memory");
        }
    }
    __syncthreads();
}
typedef short bf16x4 __attribute__((ext_vector_type(4)));
typedef unsigned v2u __attribute__((ext_vector_type(2)));
struct Frame {
    LAS unsigned char* lds;
    volatile LAS unsigned* MISC;
    gu32* ctl;
    int tid, lane, wave;
    int vcu, G;
    unsigned char* ws;
    float* out;
};
__device__ __forceinline__ int lane_here() { int t = (int)threadIdx.x; asm volatile("" : "+v"(t)); return t & 63; }
__device__ __forceinline__ float bf2f(bf16 b) { return __builtin_bit_cast(float, (unsigned)b << 16); }
__device__ __forceinline__ float wave_sum(float v) {
#pragma unroll
    for (int o = 1; o < 64; o <<= 1) v += __shfl_xor(v, o);
    return v;
}
__device__ __forceinline__ float xmax16(float m) { auto rr = __builtin_amdgcn_permlane16_swap(__float_as_uint(m), __float_as_uint(m), false, false); return fmaxf(__uint_as_float(rr[0]), __uint_as_float(rr[1])); }
__device__ __forceinline__ float xmax32(float m) { auto rr = __builtin_amdgcn_permlane32_swap(__float_as_uint(m), __float_as_uint(m), false, false); return fmaxf(__uint_as_float(rr[0]), __uint_as_float(rr[1])); }
__device__ __forceinline__ f32x4 mfma16(bf16x8 a, bf16x8 b, f32x4 c) { return __builtin_amdgcn_mfma_f32_16x16x32_bf16(a, b, c, 0, 0, 0); }

__device__ __forceinline__ void p0_transpose_item(const float* W, int ldw, const float* gain, bf16* WT, int K, int k0, int n0, size_t orow0, int lane) {
    const int n4 = lane & 15, kq = lane >> 4;
    const float* src = W + (size_t)(k0 + 16 * kq) * ldw + n0 + 4 * n4;
    f32x4 v[16];
#pragma unroll
    for (int i = 0; i < 16; ++i) v[i] = __builtin_nontemporal_load((const f32x4*)(src + (size_t)i * ldw));
    if (gain) { const f32x4* gp = (const f32x4*)(gain + k0 + 16 * kq);
#pragma unroll
        for (int q = 0; q < 4; ++q) { const f32x4 gq = gp[q];
#pragma unroll
            for (int r = 0; r < 4; ++r) v[4 * q + r] = v[4 * q + r] * gq[r]; } }
    bf16* dst = WT + (orow0 + 4 * n4) * (size_t)K + k0 + 16 * kq;
#pragma unroll
    for (int j = 0; j < 4; ++j) { v4u o0, o1;
        o0.x = pg8::cvtpk(v[0][j], v[1][j]); o0.y = pg8::cvtpk(v[2][j], v[3][j]); o0.z = pg8::cvtpk(v[4][j], v[5][j]); o0.w = pg8::cvtpk(v[6][j], v[7][j]);
        o1.x = pg8::cvtpk(v[8][j], v[9][j]); o1.y = pg8::cvtpk(v[10][j], v[11][j]); o1.z = pg8::cvtpk(v[12][j], v[13][j]); o1.w = pg8::cvtpk(v[14][j], v[15][j]);
        *(v4u*)(dst + (size_t)j * K) = o0; *(v4u*)(dst + (size_t)j * K + 8) = o1; }
}
__device__ __forceinline__ void p0_transpose_item8(const float* W, int ldw, const float* gain, unsigned char* WT, int K, int k0, int n0, size_t orow0, int lane) {
    const int n4 = lane & 15, kq = lane >> 4;
    const float* src = W + (size_t)(k0 + 16 * kq) * ldw + n0 + 4 * n4;
    f32x4 v[16];
#pragma unroll
    for (int i = 0; i < 16; ++i) v[i] = __builtin_nontemporal_load((const f32x4*)(src + (size_t)i * ldw));
    { const f32x4* gp = (const f32x4*)(gain + k0 + 16 * kq);
#pragma unroll
        for (int q = 0; q < 4; ++q) { f32x4 gq = {32.f, 32.f, 32.f, 32.f}; if (gain) gq = gp[q] * 32.0f;
#pragma unroll
            for (int r = 0; r < 4; ++r) v[4 * q + r] = v[4 * q + r] * gq[r]; } }
    unsigned char* dst = WT + (orow0 + 4 * n4) * (size_t)K + k0 + 16 * kq;
#pragma unroll
    for (int j = 0; j < 4; ++j) { v4u o;
        o.x = pg8::cvt4_fp8((f32x4){v[0][j], v[1][j], v[2][j], v[3][j]}); o.y = pg8::cvt4_fp8((f32x4){v[4][j], v[5][j], v[6][j], v[7][j]});
        o.z = pg8::cvt4_fp8((f32x4){v[8][j], v[9][j], v[10][j], v[11][j]}); o.w = pg8::cvt4_fp8((f32x4){v[12][j], v[13][j], v[14][j], v[15][j]});
        *(v4u*)(dst + (size_t)j * K) = o; }
}
template <int NR> __device__ __forceinline__ void rms_rows_to_bf16(const float* const (&xrow)[NR], const float* g, bf16* const (&orow)[NR], int lane) {
    f32x4 v[NR][4]; float s[NR];
#pragma unroll
    for (int r = 0; r < NR; ++r) { const f32x4* xr = (const f32x4*)xrow[r] + lane;
#pragma unroll
        for (int j = 0; j < 4; ++j) v[r][j] = __builtin_nontemporal_load(xr + 64 * j); }
    const f32x4* gr = (const f32x4*)g + lane; f32x4 gg[4];
#pragma unroll
    for (int j = 0; j < 4; ++j) gg[j] = gr[64 * j];
#pragma unroll
    for (int r = 0; r < NR; ++r) { s[r] = 0.f;
#pragma unroll
        for (int j = 0; j < 4; ++j) s[r] += (v[r][j].x * v[r][j].x + v[r][j].y * v[r][j].y) + (v[r][j].z * v[r][j].z + v[r][j].w * v[r][j].w); }
#pragma unroll
    for (int r = 0; r < NR; ++r) { const float rs = rsqrtf(wave_sum(s[r]) * (1.0f / DM) + EPS); unsigned long long* o8 = (unsigned long long*)orow[r] + lane;
#pragma unroll
        for (int j = 0; j < 4; ++j) o8[64 * j] = (unsigned long long)pk2(v[r][j].x * rs * gg[j].x, v[r][j].y * rs * gg[j].y) | ((unsigned long long)pk2(v[r][j].z * rs * gg[j].z, v[r][j].w * rs * gg[j].w) << 32); }
}
constexpr int MOE_I_UP = 32 * 16 * 32, MOE_I_DN = 32 * 16 * 16, MOE_UNITS = (MOE_I_UP + MOE_I_DN) / 64;
__device__ __forceinline__ void moe_convert_unit(int unit, const float* w_up, const float* w_down, const float* g_ffn, unsigned char* ws, int wave, int lane) {
#pragma unroll 1
    for (int j = 0; j < 8; ++j) { int r = unit * 64 + j * 8 + wave;
        if (r < MOE_I_UP) { const int e = r / (16 * 32); r -= e * (16 * 32); const int n0 = 64 * (r % 32);
            const size_t orow = (size_t)e * 2048 + ((n0 & 1023) >> 7) * 256 + (n0 >> 10) * 128 + (n0 & 127);
            p0_transpose_item8(w_up + (size_t)e * DM * 2048, 2048, g_ffn, ws + WS_WUP, DM, 64 * (r / 32), n0, orow, lane); }
        else { r -= MOE_I_UP; const int e = r / (16 * 16); r -= e * (16 * 16);
            p0_transpose_item8(w_down + (size_t)e * DM * DM, DM, nullptr, ws + WS_WDN, DM, 64 * (r / 16), 64 * (r % 16), (size_t)e * 1024 + 64 * (r % 16), lane); } }
}
struct In {
    const float *x, *mem; const int* positions; const float *norm_mix_g, *w_in, *lq1, *lk1, *lq2, *lk2, *diff_norm_g, *w_alpha2, *b_alpha, *gla_norm_g, *w_out, *norm_cross_g, *norm_mem_g,
        *w_cq, *w_ck, *w_cv, *w_co, *norm_ffn_g, *w_router, *b_router, *w_up, *b_up, *w_down, *b_down, *norm_final_g;
};
__device__ __forceinline__ void p0_prologue(Frame& F, const In& I) {
    const int gw = F.vcu * NWAVES + F.wave, NGW = F.G * NWAVES, lane = lane_here();
    unsigned char* ws = F.ws;
    constexpr int I_IN = 16 * 48, I_SQ = 16 * 16;
    constexpr int NITEMS = I_IN + 4 * I_SQ;
    for (int it = gw; it < NITEMS; it += NGW) {
        int r = it;
        if (r < I_IN) { p0_transpose_item(I.w_in, INW, nullptr, (bf16*)(ws + WS_WINT), DM, 64 * (r / 48), 64 * (r % 48), (size_t)64 * (r % 48), lane); continue; } r -= I_IN;
        { const int w = r / I_SQ; r -= w * I_SQ;
            const float* W = w == 0 ? I.w_out : w == 1 ? I.w_ck : w == 2 ? I.w_cv : I.w_co;
            bf16* WT = (bf16*)(ws + (w == 0 ? WS_WOUT : w == 1 ? WS_WCK : w == 2 ? WS_WCV : WS_WCO));
            p0_transpose_item(W, DM, nullptr, WT, DM, 64 * (r / 16), 64 * (r % 16), (size_t)64 * (r % 16), lane); }
    }
    for (int idx = F.vcu * (NWAVES * 64) + F.tid; idx < DM * DM / 4; idx += F.G * NWAVES * 64) { const f32x4 v = ((const f32x4*)I.w_cq)[idx] * I.norm_cross_g[idx >> 8];
        v2u o; o.x = pk2(v.x, v.y); o.y = pk2(v.z, v.w); ((v2u*)(ws + WS_WCQ))[idx] = o; }
#if defined(PROBE_P0)
    if (F.tid == 0) ((LAS unsigned long long*)(F.lds + TS_OFF))[13] = rt();
#endif
    const int gt = F.vcu * (NWAVES * 64) + F.tid, NGT = F.G * NWAVES * 64;
    for (int idx = gt; idx < 256 * DM; idx += NGT) { const int j = idx >> 10, k = idx & 1023; const float* wr = I.w_in + (size_t)k * INW + 3072; float s = 0.f;
#pragma unroll
        for (int r = 0; r < 16; ++r) s += wr[r] * I.w_alpha2[r * 256 + j];
        ((bf16*)(ws + WS_WINT))[(size_t)(3072 + j) * DM + k] = (bf16)f2bf(s); }
    for (int idx = gt; idx < DM * NEXP; idx += NGT) { const int e = idx >> 10, k = idx & 1023; const float w = I.w_router[k * NEXP + e] * I.norm_ffn_g[k];
        const unsigned h1 = f2bf(w); const float r1 = w - __builtin_bit_cast(float, h1 << 16); const unsigned h2 = f2bf(r1); const float r2 = r1 - __builtin_bit_cast(float, h2 << 16); const unsigned h3 = f2bf(r2);
        bf16* W3 = (bf16*)(ws + WS_WR); W3[idx] = (bf16)h1; W3[DM * NEXP + idx] = (bf16)h2; W3[2 * DM * NEXP + idx] = (bf16)h3; }
    for (int idx = gt; idx < NTOK * 8; idx += NGT) { const int tok = idx >> 3, i = idx & 7;
        const double inv = exp(-(double)i * 0.125 * 13.122363377404328); const double ang = (double)I.positions[tok] * inv;
        const double red = ang - rint(ang * 0.15915494309189535) * 6.283185307179586; const float rf = (float)red;
        float* cs = (float*)(ws + WS_CS) + (size_t)tok * 16; cs[i] = cosf(rf); cs[8 + i] = sinf(rf); }
#if defined(PROBE_P0)
    if (F.tid == 0) ((LAS unsigned long long*)(F.lds + TS_OFF))[14] = rt();
#endif
    for (int m = gw * 4; m < NTOK; m += NGW * 4) { const float* xr[4]; bf16* orw[4];
#pragma unroll
        for (int r = 0; r < 4; ++r) { xr[r] = I.x + (size_t)(m + r) * DM; orw[r] = (bf16*)(ws + WS_HN) + (size_t)(m + r) * DM; }
        rms_rows_to_bf16<4>(xr, I.norm_mix_g, orw, lane); }
    for (int m = gw * 4; m < NMEM; m += NGW * 4) { const float* xr[4]; bf16* orw[4];
#pragma unroll
        for (int r = 0; r < 4; ++r) { xr[r] = I.mem + (size_t)(m + r) * DM; orw[r] = (bf16*)(ws + WS_MN) + (size_t)(m + r) * DM; }
        rms_rows_to_bf16<4>(xr, I.norm_mem_g, orw, lane); }
}

constexpr int DA_KBUF = 16384, DA_VBUF = 16384, DA_VOFF = 2 * DA_KBUF;
template <int DBG = 0> __device__ __forceinline__ void diffattn_unit(Frame& F, const bf16* P, const bf16* VT, bf16* CAT, const float* gdiff, float lam, int b, int h, int qblk) {
    const int lane = lane_here(), wave = F.wave, tid = F.tid, l15 = lane & 15, g = lane >> 4;
    LAS unsigned char* lds = F.lds + RING_OFF;
    const int q0 = qblk * 128 + wave * 16;
    const size_t tokq = (size_t)b * SEQ + q0 + l15;
    bf16x8 qf[2][2];
#pragma unroll
    for (int c = 0; c < 2; ++c)
#pragma unroll
        for (int ks = 0; ks < 2; ++ks) qf[c][ks] = *(const bf16x8*)(P + tokq * PW + h * 128 + c * 64 + ks * 32 + g * 8);
    f32x4 o[2][8];
#pragma unroll
    for (int c = 0; c < 2; ++c)
#pragma unroll
        for (int k = 0; k < 8; ++k) o[c][k] = (f32x4){0.f, 0.f, 0.f, 0.f};
    float mrun[2] = {0.f, 0.f}, lsum[2] = {0.f, 0.f};
    const int nk = q0 + 16;
    const int nt = 2 * qblk + 2;
    const int skey = tid >> 4, sch = tid & 15, vrow = tid >> 3, vpc = tid & 7;
    const bf16* ksrc = P + ((size_t)b * SEQ + skey) * PW + 512 + h * 128 + sch * 8;
    const bf16* vsrc = VT + (size_t)(h * 128 + vrow) * NTOK + (size_t)b * SEQ + vpc * 8;
    const int kdst = skey * 256 + ((sch ^ (skey & 15)) * 16);
    const int vfr = (vrow >> 1) & 7, vch = (vpc >> 2) * 4 + 2 * (vpc & 1), vhi = ((vpc & 3) >> 1) * 8;
    const int vdst0 = DA_VOFF + vrow * 128 + ((vch ^ vfr) * 16) + vhi, vdst1 = DA_VOFF + vrow * 128 + (((vch + 1) ^ vfr) * 16) + vhi;
    int koff[2][2];
#pragma unroll
    for (int c = 0; c < 2; ++c)
#pragma unroll
        for (int ks = 0; ks < 2; ++ks) koff[c][ks] = l15 * 256 + (((c * 8 + ks * 4 + g) ^ l15) * 16);
    const int voffs[2] = {DA_VOFF + l15 * 128 + ((g ^ (l15 >> 1)) * 16), DA_VOFF + l15 * 128 + (((4 + g) ^ (l15 >> 1)) * 16)};
    v4u sk0, sk1, sv0, sv1;
#define DA_LOAD(tt) do { const bf16* kp_ = ksrc + (size_t)(tt) * 64 * PW; const bf16* vp_ = vsrc + (tt) * 64; \
        sk0 = *(const v4u*)kp_; sk1 = *(const v4u*)(kp_ + (size_t)32 * PW); sv0 = *(const v4u*)vp_; sv1 = *(const v4u*)(vp_ + (size_t)64 * NTOK); } while (0)
#define DA_STORE(bb) do { LAS unsigned char* kd_ = lds + (bb) * DA_KBUF + kdst; LAS unsigned char* vd_ = lds + (bb) * DA_VBUF; \
        *(LAS v4u*)kd_ = sk0; *(LAS v4u*)(kd_ + 8192) = sk1; \
        *(LAS v2u*)(vd_ + vdst0) = (v2u){sv0.x, sv0.y}; *(LAS v2u*)(vd_ + vdst1) = (v2u){sv0.z, sv0.w}; *(LAS v2u*)(vd_ + vdst0 + 8192) = (v2u){sv1.x, sv1.y}; *(LAS v2u*)(vd_ + vdst1 + 8192) = (v2u){sv1.z, sv1.w}; } while (0)
    DA_LOAD(0); DA_STORE(0);
    __syncthreads();
    auto step = [&](const int t, const int buf) __attribute__((always_inline)) {
        if (t * 64 < nk) {
            const LAS unsigned char* kb = lds + buf * DA_KBUF; const LAS unsigned char* vb = lds + buf * DA_VBUF;
            f32x4 s[2][2][2];
#pragma unroll
            for (int sub = 0; sub < 2; ++sub)
#pragma unroll
                for (int c = 0; c < 2; ++c)
#pragma unroll
                    for (int s2 = 0; s2 < 2; ++s2) { f32x4 a = (f32x4){-mrun[c], -mrun[c], -mrun[c], -mrun[c]};
#pragma unroll
                        for (int ks = 0; ks < 2; ++ks) { const bf16x8 kf = (DBG & 2) ? qf[c][ks ^ 1] : *(const LAS bf16x8*)(kb + sub * 8192 + s2 * 4096 + koff[c][ks]); if constexpr ((DBG & 1) == 0) a = mfma16(kf, qf[c][ks], a); else a[ks] += __builtin_bit_cast(float, (int)kf[0] << 16); }
                        s[sub][c][s2] = a; }
            if (t * 64 + 63 > q0) {
                const int qrow = q0 + l15;
#pragma unroll
                for (int sub = 0; sub < 2; ++sub)
#pragma unroll
                    for (int c = 0; c < 2; ++c)
#pragma unroll
                        for (int s2 = 0; s2 < 2; ++s2)
#pragma unroll
                            for (int r = 0; r < 4; ++r) if (t * 64 + sub * 32 + s2 * 16 + 4 * g + r > qrow) s[sub][c][s2][r] = -INFINITY;
            }
#pragma unroll
            for (int sub = 0; sub < 2; ++sub) {
                bf16x8 pb[2]; f32x4 pz[2][2]; float ps[2];
#pragma unroll
                for (int c = 0; c < 2; ++c) { ps[c] = 0.f;
#pragma unroll
                    for (int s2 = 0; s2 < 2; ++s2)
#pragma unroll
                        for (int r = 0; r < 4; ++r) { const float p = __builtin_amdgcn_exp2f(s[sub][c][s2][r]); pz[c][s2][r] = p; ps[c] += p; } }
                const bool bad = !(ps[0] <= 256.0f) || !(ps[1] <= 256.0f) || (t == 0 && sub == 0);
                if (__any(bad)) {
#pragma unroll
                    for (int c = 0; c < 2; ++c) { float mx = -INFINITY;
#pragma unroll
                        for (int sb = 0; sb < 2; ++sb) if (sb >= sub)
#pragma unroll
                            for (int s2 = 0; s2 < 2; ++s2) mx = fmaxf(mx, fmaxf(fmaxf(s[sb][c][s2][0], s[sb][c][s2][1]), fmaxf(s[sb][c][s2][2], s[sb][c][s2][3])));
                        mx = xmax16(mx); mx = xmax32(mx);
                        const float dl = (t == 0 && sub == 0) ? mx : fmaxf(mx, 0.f);
                        const float alpha = __builtin_amdgcn_exp2f(-dl); mrun[c] += dl; lsum[c] *= alpha;
#pragma unroll
                        for (int k = 0; k < 8; ++k) o[c][k] = o[c][k] * alpha;
#pragma unroll
                        for (int sb = 0; sb < 2; ++sb) if (sb >= sub)
#pragma unroll
                            for (int s2 = 0; s2 < 2; ++s2)
#pragma unroll
                                for (int r = 0; r < 4; ++r) s[sb][c][s2][r] -= dl;
                        ps[c] = 0.f;
#pragma unroll
                        for (int s2 = 0; s2 < 2; ++s2)
#pragma unroll
                            for (int r = 0; r < 4; ++r) { const float p = __builtin_amdgcn_exp2f(s[sub][c][s2][r]); pz[c][s2][r] = p; ps[c] += p; } }
                }
#pragma unroll
                for (int c = 0; c < 2; ++c) { lsum[c] += ps[c];
                    v4u w; w.x = pg8::cvtpk(pz[c][0][0], pz[c][0][1]); w.y = pg8::cvtpk(pz[c][0][2], pz[c][0][3]); w.z = pg8::cvtpk(pz[c][1][0], pz[c][1][1]); w.w = pg8::cvtpk(pz[c][1][2], pz[c][1][3]);
                    pb[c] = __builtin_bit_cast(bf16x8, w); }
#pragma unroll
                for (int k = 0; k < 8; ++k) { const bf16x8 vf = (DBG & 2) ? qf[k & 1][(k >> 1) & 1] : *(const LAS bf16x8*)(vb + voffs[sub] + k * 2048);
                    if constexpr ((DBG & 1) == 0) { o[0][k] = mfma16(vf, pb[0], o[0][k]); o[1][k] = mfma16(vf, pb[1], o[1][k]); }
                    else { o[0][k][0] += __builtin_bit_cast(float, (int)vf[0] << 16) + __builtin_bit_cast(float, (int)pb[0][k] << 16); o[1][k][0] += __builtin_bit_cast(float, (int)pb[1][k] << 16); } }
            }
        }
    };
    for (int t = 0; t < nt; ++t) {
        if ((DBG & 8) == 0 && t + 1 < nt) DA_LOAD(t + 1);
        step(t, t & 1);
        if ((DBG & 8) == 0 && t + 1 < nt) DA_STORE((t & 1) ^ 1);
        __syncthreads();
    }
#undef DA_LOAD
#undef DA_STORE
    float l0 = lsum[0], l1 = lsum[1];
    l0 += __shfl_xor(l0, 16); l0 += __shfl_xor(l0, 32); l1 += __shfl_xor(l1, 16); l1 += __shfl_xor(l1, 32);
    const float i0 = 1.0f / l0, i1 = lam / l1; float ss = 0.f;
#pragma unroll
    for (int k = 0; k < 8; ++k)
#pragma unroll
        for (int r = 0; r < 4; ++r) { const float v = o[0][k][r] * i0 - o[1][k][r] * i1; o[0][k][r] = v; ss += v * v; }
    ss += __shfl_xor(ss, 16); ss += __shfl_xor(ss, 32);
    const float rs = rsqrtf(ss * (1.0f / 128.0f) + EPS) * 0.8f;
    bf16* op = CAT + tokq * DM + h * 128 + 4 * g;
    f32x4 gg[8];
#pragma unroll
    for (int k = 0; k < 8; ++k) gg[k] = *(const f32x4*)(gdiff + k * 16 + 4 * g);
#pragma unroll
    for (int k = 0; k < 8; ++k) { f32x4 v = o[0][k] * rs; v = v * gg[k]; pg8::st_bf4(op + k * 16, v); }
}

__device__ __forceinline__ bf16x8 pack8(const f32x4& a, const f32x4& b) { v4u w; w.x = pg8::cvtpk(a[0], a[1]); w.y = pg8::cvtpk(a[2], a[3]); w.z = pg8::cvtpk(b[0], b[1]); w.w = pg8::cvtpk(b[2], b[3]); return __builtin_bit_cast(bf16x8, w); }
constexpr int GL_QI = 0, GL_KI = 8192, GL_IMG = 16384, GL_EL = 2 * GL_IMG, GL_OB = GL_EL + 512, GL_OBS = 17408, GL_PS = GL_OB + 2 * GL_OBS, GL_END = GL_PS + 4096;

__device__ __forceinline__ void gla_unit(Frame& F, const bf16* P, const float* Bc, const bf16* GVT, bf16* CAT, const float* ggla, int b, int h) {
    const int lane = lane_here(), l15 = lane & 15, g = lane >> 4, eb = F.wave, tid = F.tid;
    LAS unsigned char* lds = F.lds + RING_OFF;
    const f32x4 zero4 = {0.f, 0.f, 0.f, 0.f};
    f32x4 S[4] = {zero4, zero4, zero4, zero4};
    bf16x8 If[4];
#pragma unroll
    for (int db = 0; db < 4; ++db) { const int ks = db >> 1;
#pragma unroll
        for (int j = 0; j < 8; ++j) { const int dp = 32 * ks + (j < 4 ? 4 * g + j : 16 + 4 * g + j - 4); If[db][j] = (dp == 16 * db + l15) ? (short)0x3F80 : (short)0; } }
    const int st = tid >> 3, sp = tid & 7, opc = tid & 15;
    const size_t tokb = (size_t)b * SEQ;
    const bf16* qsrc = P + (tokb + st) * PW + 1536 + h * 64 + sp * 8;
    const float* bsrc = Bc + (tokb + st) * 256 + h * 64 + sp * 8;
    const bf16* Vrow = GVT + (size_t)(h * 128 + 16 * eb + l15) * NTOK + tokb + 4 * g;
    const f32x4 gg0 = *(const f32x4*)(ggla + opc * 8), gg1 = *(const f32x4*)(ggla + opc * 8 + 4);
    const int foffs[2] = {l15 * 128 + ((g ^ (l15 >> 1)) * 16), l15 * 128 + (((4 + g) ^ (l15 >> 1)) * 16)};
    const int sfr = (st >> 1) & 7, sch0 = (sp >> 2) * 4 + 2 * (sp & 1), shi = ((sp & 3) >> 1) * 8, sd0 = st * 128 + ((sch0 ^ sfr) * 16) + shi, sd1 = st * 128 + (((sch0 + 1) ^ sfr) * 16) + shi;
    v4u rq = *(const v4u*)qsrc, rk = *(const v4u*)(qsrc + 256); f32x4 rb0 = *(const f32x4*)bsrc, rb1 = *(const f32x4*)(bsrc + 4);
#define GLA_STAGE(par) do { \
        float ee[8]; _Pragma("unroll") for (int i = 0; i < 4; ++i) { ee[i] = __expf(rb0[i]); ee[4 + i] = __expf(rb1[i]); } \
        const unsigned qa[4] = {rq.x, rq.y, rq.z, rq.w}, ka[4] = {rk.x, rk.y, rk.z, rk.w}; v4u wq, wk; unsigned* wqp = (unsigned*)&wq; unsigned* wkp = (unsigned*)&wk; \
        _Pragma("unroll") for (int i = 0; i < 4; ++i) { const float q0 = __builtin_bit_cast(float, qa[i] << 16), q1 = __builtin_bit_cast(float, qa[i] & 0xffff0000u), k0 = __builtin_bit_cast(float, ka[i] << 16), k1 = __builtin_bit_cast(float, ka[i] & 0xffff0000u); \
            wqp[i] = pg8::cvtpk(q0 * ee[2 * i], q1 * ee[2 * i + 1]); wkp[i] = pg8::cvtpk(k0 * __builtin_amdgcn_rcpf(ee[2 * i]), k1 * __builtin_amdgcn_rcpf(ee[2 * i + 1])); } \
        { LAS unsigned char* ib_ = lds + (par) * GL_IMG; *(LAS v2u*)(ib_ + GL_QI + sd0) = (v2u){wq.x, wq.y}; *(LAS v2u*)(ib_ + GL_QI + sd1) = (v2u){wq.z, wq.w}; *(LAS v2u*)(ib_ + GL_KI + sd0) = (v2u){wk.x, wk.y}; *(LAS v2u*)(ib_ + GL_KI + sd1) = (v2u){wk.z, wk.w}; } \
        if (st == 63) { *(LAS f32x4*)(lds + GL_EL + (par) * 256 + sp * 32) = (f32x4){ee[0], ee[1], ee[2], ee[3]}; *(LAS f32x4*)(lds + GL_EL + (par) * 256 + sp * 32 + 16) = (f32x4){ee[4], ee[5], ee[6], ee[7]}; } } while (0)
    bf16x8 VFn[2];
#pragma unroll
    for (int ss = 0; ss < 2; ++ss) { const bf16* vp = Vrow + 32 * ss; const v2u v0 = *(const v2u*)vp, v1 = *(const v2u*)(vp + 16); v4u vv; vv.x = v0.x; vv.y = v0.y; vv.z = v1.x; vv.w = v1.y; VFn[ss] = __builtin_bit_cast(bf16x8, vv); }
    GLA_STAGE(0);
    __syncthreads();
    for (int c = 0; c < SEQ / 64; ++c) {
        const int par = c & 1; const size_t tok0 = tokb + c * 64;
        if (c + 1 < SEQ / 64) { rq = *(const v4u*)(qsrc + (size_t)(c + 1) * 64 * PW); rk = *(const v4u*)(qsrc + (size_t)(c + 1) * 64 * PW + 256);
            rb0 = *(const f32x4*)(bsrc + (size_t)(c + 1) * 64 * 256); rb1 = *(const f32x4*)(bsrc + (size_t)(c + 1) * 64 * 256 + 4); }
        bf16x8 VF[2] = {VFn[0], VFn[1]};
        if (c + 1 < SEQ / 64) {
#pragma unroll
            for (int ss = 0; ss < 2; ++ss) { const bf16* vp = Vrow + (c + 1) * 64 + 32 * ss; const v2u v0 = *(const v2u*)vp, v1 = *(const v2u*)(vp + 16); v4u vv; vv.x = v0.x; vv.y = v0.y; vv.z = v1.x; vv.w = v1.y; VFn[ss] = __builtin_bit_cast(bf16x8, vv); } }
        v4u rg[2];
#pragma unroll
        for (int i = 0; i < 2; ++i) rg[i] = *(const v4u*)(P + (tok0 + ((tid + 512 * i) >> 4)) * PW + 2560 + h * 128 + opc * 8);
        const LAS unsigned char* qi = lds + par * GL_IMG + GL_QI; const LAS unsigned char* ki = lds + par * GL_IMG + GL_KI;
        bf16x8 qf[4][2], kf[4][2];
#pragma unroll
        for (int blk = 0; blk < 4; ++blk)
#pragma unroll
            for (int ks = 0; ks < 2; ++ks) { qf[blk][ks] = *(const LAS bf16x8*)(qi + foffs[ks] + blk * 2048); kf[blk][ks] = *(const LAS bf16x8*)(ki + foffs[ks] + blk * 2048); }
        const bf16x8 SF0 = pack8(S[0], S[1]), SF1 = pack8(S[2], S[3]);
        f32x4 O[4];
#pragma unroll
        for (int tb = 0; tb < 4; ++tb) { f32x4 o = mfma16(qf[tb][0], SF0, zero4); o = mfma16(qf[tb][1], SF1, o);
#pragma unroll
            for (int ss = 0; ss < 2; ++ss) if (2 * ss <= tb) { f32x4 a2[2];
#pragma unroll
                for (int hh = 0; hh < 2; ++hh) { const int sb = 2 * ss + hh; f32x4 a = zero4;
                    if (sb <= tb) { a = mfma16(kf[sb][0], qf[tb][0], zero4); a = mfma16(kf[sb][1], qf[tb][1], a);
                        if (sb == tb) {
#pragma unroll
                            for (int r = 0; r < 4; ++r) if (4 * g + r > l15) a[r] = 0.f; } }
                    a2[hh] = a; }
                o = mfma16(pack8(a2[0], a2[1]), VF[ss], o); }
            O[tb] = o; }
#pragma unroll
        for (int db = 0; db < 4; ++db) { f32x4 u = S[db];
#pragma unroll
            for (int ss = 0; ss < 2; ++ss) { const f32x4 t0 = mfma16(kf[2 * ss][db >> 1], If[db], zero4), t1 = mfma16(kf[2 * ss + 1][db >> 1], If[db], zero4); u = mfma16(pack8(t0, t1), VF[ss], u); }
            const f32x4 el = *(const LAS f32x4*)(lds + GL_EL + par * 256 + (16 * db + 4 * g) * 4);
            S[db] = u * el; }
        LAS unsigned char* ob = lds + GL_OB + par * GL_OBS; LAS float* ps = (LAS float*)(lds + GL_PS + par * 2048);
#pragma unroll
        for (int tb = 0; tb < 4; ++tb)
#pragma unroll
            for (int r = 0; r < 4; ++r) { const int t = 16 * tb + 4 * g + r; const float ov = O[tb][r]; float q = ov * ov; q += __shfl_xor(q, 1); q += __shfl_xor(q, 2); q += __shfl_xor(q, 4); q += __shfl_xor(q, 8);
                if (l15 == 0) ps[t * 8 + eb] = q;
                *(LAS bf16*)(ob + t * 272 + (16 * eb + l15) * 2) = (bf16)f2bf(ov); }
        if (c + 1 < SEQ / 64) GLA_STAGE(par ^ 1);
        __syncthreads();
#pragma unroll
        for (int i = 0; i < 2; ++i) { const int ot = (tid + 512 * i) >> 4; const f32x4 p0 = *(const LAS f32x4*)(ps + ot * 8), p1 = *(const LAS f32x4*)(ps + ot * 8 + 4);
            const float ss = ((p0[0] + p0[1]) + (p0[2] + p0[3])) + ((p1[0] + p1[1]) + (p1[2] + p1[3])); const float rs = rsqrtf(ss * (1.0f / 128.0f) + EPS);
            const v4u ov = *(const LAS v4u*)(ob + ot * 272 + opc * 16); const unsigned oa[4] = {ov.x, ov.y, ov.z, ov.w}, ga[4] = {rg[i].x, rg[i].y, rg[i].z, rg[i].w};
            const float gn[8] = {gg0[0], gg0[1], gg0[2], gg0[3], gg1[0], gg1[1], gg1[2], gg1[3]}; v4u w; unsigned* wp = (unsigned*)&w;
#pragma unroll
            for (int j = 0; j < 4; ++j) { const float o0 = __builtin_bit_cast(float, oa[j] << 16), o1 = __builtin_bit_cast(float, oa[j] & 0xffff0000u), g0 = __builtin_bit_cast(float, ga[j] << 16), g1 = __builtin_bit_cast(float, ga[j] & 0xffff0000u);
                wp[j] = pg8::cvtpk(o0 * rs * gn[2 * j] * g0 * __builtin_amdgcn_rcpf(1.0f + __builtin_amdgcn_exp2f(-1.4426950408889634f * g0)), o1 * rs * gn[2 * j + 1] * g1 * __builtin_amdgcn_rcpf(1.0f + __builtin_amdgcn_exp2f(-1.4426950408889634f * g1))); }
            *(v4u*)(CAT + (tok0 + ot) * DM + 512 + h * 128 + opc * 8) = w; }
    }
#undef GLA_STAGE
    __syncthreads();
}

__device__ __forceinline__ void router_phase(Frame& F, const bf16* X2, const bf16* W3, const float* b_router, float* rsl, float* gate, unsigned* assign, unsigned* list, gu32* cnt) {
    LAS float* part = (LAS float*)(F.lds + RING_OFF);
    LAS float* lg = part;
    LAS float* pss = (LAS float*)(F.lds + XCH_OFF);
    LAS unsigned* hist = (LAS unsigned*)(F.lds + XCH2_OFF);
    const int tid = F.tid, lane = lane_here(), r16 = lane & 15, kq = lane >> 4, wv = F.wave, t = tid & 63;
    bf16x8 wf[3][2][4];
#pragma unroll
    for (int sp = 0; sp < 3; ++sp)
#pragma unroll
        for (int eb = 0; eb < 2; ++eb)
#pragma unroll
            for (int ks = 0; ks < 4; ++ks) wf[sp][eb][ks] = *(const bf16x8*)(W3 + (size_t)sp * DM * NEXP + (size_t)(16 * eb + r16) * DM + 128 * wv + 32 * ks + 8 * kq);
    for (int blk = F.vcu; blk < NTOK / 128; blk += F.G) {
        const size_t tok0 = (size_t)blk * 128;
        const bf16* xp = X2 + (tok0 + r16) * DM + 128 * wv + 8 * kq;
        bf16x8 xq[3][4];
#define RT_LD(rb, sl) do { _Pragma("unroll") for (int ks = 0; ks < 4; ++ks) xq[sl][ks] = *(const bf16x8*)(xp + (size_t)(rb) * 16 * DM + 32 * ks); } while (0)
        RT_LD(0, 0); RT_LD(1, 1);
#pragma unroll
        for (int rb = 0; rb < 8; ++rb) {
            if (rb + 2 < 8) RT_LD(rb + 2, (rb + 2) % 3);
            f32x4 acc0 = {0.f, 0.f, 0.f, 0.f}, acc1 = acc0; float ssq = 0.f;
#pragma unroll
            for (int ks = 0; ks < 4; ++ks) { const bf16x8 xf = xq[rb % 3][ks];
#pragma unroll
                for (int sp = 0; sp < 3; ++sp) { acc0 = mfma16(xf, wf[sp][0][ks], acc0); acc1 = mfma16(xf, wf[sp][1][ks], acc1); }
#pragma unroll
                for (int i = 0; i < 8; ++i) { const float xv = __builtin_bit_cast(float, (unsigned)(unsigned short)xf[i] << 16); ssq += xv * xv; } }
            ssq += __shfl_xor(ssq, 16); ssq += __shfl_xor(ssq, 32);
            if (kq == 0) pss[wv * 128 + 16 * rb + r16] = ssq;
#pragma unroll
            for (int j = 0; j < 4; ++j) { const int tl = 16 * rb + 4 * kq + j; part[(wv * 128 + tl) * 32 + r16] = acc0[j]; part[(wv * 128 + tl) * 32 + 16 + r16] = acc1[j]; }
        }
#undef RT_LD
        __syncthreads();
        { const int tk = tid >> 2, q = tid & 3; f32x4 s0 = {0.f, 0.f, 0.f, 0.f}, s1 = s0; float sq = 0.f;
#pragma unroll
          for (int w = 0; w < 8; ++w) { s0 = s0 + *(const LAS f32x4*)(part + (w * 128 + tk) * 32 + 8 * q); s1 = s1 + *(const LAS f32x4*)(part + (w * 128 + tk) * 32 + 8 * q + 4); sq += pss[w * 128 + tk]; }
          const float rs = rsqrtf(sq * (1.0f / DM) + EPS); const f32x4 b0 = *(const f32x4*)(b_router + 8 * q), b1 = *(const f32x4*)(b_router + 8 * q + 4);
          s0 = s0 * rs + b0; s1 = s1 * rs + b1;
          __syncthreads();
#pragma unroll
          for (int i = 0; i < 4; ++i) { lg[tk * 33 + 8 * q + i] = s0[i]; lg[tk * 33 + 8 * q + 4 + i] = s1[i]; }
          if (q == 0) lg[tk * 33 + 32] = rs; }
        __syncthreads();
        if (tid < 128) {
            const int w2 = tid >> 6;
            float lv[32];
#pragma unroll
            for (int e = 0; e < 32; ++e) lv[e] = lg[tid * 33 + e];
            const float rs = lg[tid * 33 + 32];
            float tv[4]; int te[4];
#pragma unroll
            for (int k = 0; k < 4; ++k) { float best = -INFINITY; int bi = 0;
#pragma unroll
                for (int e = 0; e < 32; ++e) if (lv[e] > best) { best = lv[e]; bi = e; }
                tv[k] = best; te[k] = bi;
#pragma unroll
                for (int e = 0; e < 32; ++e) if (e == bi) lv[e] = -INFINITY; }
            const float e1 = __expf(tv[1] - tv[0]), e2 = __expf(tv[2] - tv[0]), e3 = __expf(tv[3] - tv[0]); const float inv = 1.0f / (1.0f + e1 + e2 + e3);
            const float gv[4] = {inv, e1 * inv, e2 * inv, e3 * inv};
            const size_t tok = tok0 + tid;
            LAS unsigned* hs = hist + w2 * 32; LAS unsigned* gbase = hist + 64 + w2 * 32;
            if (t < 32) hs[t] = 0u;
            __builtin_amdgcn_wave_barrier(); LDS_WAIT();
            unsigned lpos[4];
#pragma unroll
            for (int k = 0; k < 4; ++k) lpos[k] = __hip_atomic_fetch_add(hs + te[k], 1u, __ATOMIC_RELAXED, __HIP_MEMORY_SCOPE_WORKGROUP);
            __builtin_amdgcn_wave_barrier(); LDS_WAIT();
            if (t < 32) { const unsigned n = hs[t]; gbase[t] = n ? __hip_atomic_fetch_add(cnt + 64 * t, n, RLX_AGENT) : 0u; }
            __builtin_amdgcn_wave_barrier(); LDS_WAIT();
#pragma unroll
            for (int k = 0; k < 4; ++k) { const unsigned pos = gbase[te[k]] + lpos[k]; list[(size_t)te[k] * NTOK + pos] = (unsigned)tok; rsl[(size_t)te[k] * NTOK + pos] = rs;
                assign[tok * 4 + k] = ((unsigned)te[k] << 16) | pos; gate[tok * 4 + k] = gv[k]; }
        }
        __syncthreads();
    }
}
__device__ __forceinline__ int moe_tables(Frame& F) {
    LAS unsigned char* tile_e = F.lds + TAB_OFF; LAS int* tstart = (LAS int*)(F.lds + TAB_TSTART); LAS int* lc = (LAS int*)(F.lds + TAB_CNT);
    if (F.tid < 32) lc[F.tid] = (int)__hip_atomic_load(F.ctl + CW_CNT + 64 * F.tid, RLX_AGENT);
    __syncthreads();
    if (F.tid == 0) { int s = 0; for (int e = 0; e < 32; ++e) { tstart[e] = s; s += (lc[e] + 255) >> 8; } tstart[32] = s; }
    __syncthreads();
    const int T = tstart[32];
    for (int i = F.tid; i < T; i += 512) { int e = 0;
#pragma unroll
        for (int k = 1; k < 32; ++k) e += (tstart[k] <= i) ? 1 : 0;
        tile_e[i] = (unsigned char)e; }
    __syncthreads();
    return T;
}
__device__ __forceinline__ void final_phase(Frame& F, const bf16* X2, float* out, const unsigned char* Y, const float* gate, const unsigned* assign, const float* gfin) {
    (void)moe_tables(F);
    const LAS int* tstart = (const LAS int*)(F.lds + TAB_TSTART);
    const int gw = F.vcu * NWAVES + F.wave, NGW = F.G * NWAVES, lane = lane_here();
    unsigned an[2][4]; float gn[2][4];
#define FIN_ROUTE(t0) do { _Pragma("unroll") for (int u = 0; u < 2; ++u) { const int tok_ = ((t0) + u * NGW < NTOK) ? (t0) + u * NGW : ((t0) < NTOK ? (t0) : gw); \
        const v4u a4 = *(const v4u*)(assign + (size_t)tok_ * 4); const f32x4 g4 = *(const f32x4*)(gate + (size_t)tok_ * 4); \
        an[u][0] = a4.x; an[u][1] = a4.y; an[u][2] = a4.z; an[u][3] = a4.w; gn[u][0] = g4.x; gn[u][1] = g4.y; gn[u][2] = g4.z; gn[u][3] = g4.w; } } while (0)
    FIN_ROUTE(gw);
    f32x4 gfv[4];
#pragma unroll
    for (int j = 0; j < 4; ++j) gfv[j] = ((const f32x4*)gfin)[lane + 64 * j];
    for (int tok0 = gw; tok0 < NTOK; tok0 += 2 * NGW) {
        f32x4 v[2][4]; unsigned yw[2][4][4]; float gk[2][4];
#pragma unroll
        for (int u = 0; u < 2; ++u) { const int tok = (tok0 + u * NGW < NTOK) ? tok0 + u * NGW : tok0;
#pragma unroll
            for (int k = 0; k < 4; ++k) { const unsigned a = an[u][k]; gk[u][k] = gn[u][k]; const size_t row = (size_t)tstart[a >> 16] * 256 + (a & 0xffffu);
                const unsigned* yr = (const unsigned*)(Y + row * DM) + lane;
#pragma unroll
                for (int j = 0; j < 4; ++j) yw[u][k][j] = yr[64 * j]; }
            const v2u* xin = (const v2u*)(X2 + (size_t)tok * DM) + lane;
#pragma unroll
            for (int j = 0; j < 4; ++j) { const v2u w = xin[64 * j]; v[u][j] = (f32x4){__builtin_bit_cast(float, w.x << 16), __builtin_bit_cast(float, w.x & 0xffff0000u), __builtin_bit_cast(float, w.y << 16), __builtin_bit_cast(float, w.y & 0xffff0000u)}; } }
        FIN_ROUTE(tok0 + 2 * NGW);
#pragma unroll
        for (int u = 0; u < 2; ++u) { const int tok = (tok0 + u * NGW < NTOK) ? tok0 + u * NGW : tok0;
#pragma unroll
            for (int k = 0; k < 4; ++k)
#pragma unroll
                for (int j = 0; j < 4; ++j) { const unsigned w = yw[u][k][j]; const auto lo = __builtin_amdgcn_cvt_pk_f32_fp8((int)w, false), hi = __builtin_amdgcn_cvt_pk_f32_fp8((int)w, true);
                    v[u][j].x += gk[u][k] * lo[0]; v[u][j].y += gk[u][k] * lo[1]; v[u][j].z += gk[u][k] * hi[0]; v[u][j].w += gk[u][k] * hi[1]; }
            float s = 0.f;
#pragma unroll
            for (int j = 0; j < 4; ++j) s += (v[u][j].x * v[u][j].x + v[u][j].y * v[u][j].y) + (v[u][j].z * v[u][j].z + v[u][j].w * v[u][j].w);
            const float rs = rsqrtf(wave_sum(s) * (1.0f / DM) + EPS); f32x4* xr = (f32x4*)(out + (size_t)tok * DM) + lane;
#pragma unroll
            for (int j = 0; j < 4; ++j) xr[64 * j] = v[u][j] * rs * gfv[j]; }
    }
#undef FIN_ROUTE
}

constexpr int NPHASE = 10;
struct Args { const void* in[28]; float* out; unsigned char* ws; int ph_lo, ph_hi; };
__global__ void __launch_bounds__(NWAVES * 64, 2) mk_fwd(Args args) {
    extern __shared__ __attribute__((aligned(16))) unsigned char lds[];
    Frame F;
    F.lds = (LAS unsigned char*)lds;
    F.MISC = (volatile LAS unsigned*)(F.lds + MISC_OFF);
    F.tid = threadIdx.x; F.lane = F.tid & 63; F.wave = __builtin_amdgcn_readfirstlane(F.tid >> 6);
    F.G = gridDim.x; { const int bx = blockIdx.x; F.vcu = (F.G % 8 == 0) ? (bx % 8) * (F.G / 8) + bx / 8 : bx; }
    F.ws = args.ws; F.out = args.out; F.ctl = (gu32*)(args.ws + WS_CTL);
    unsigned char* ws = args.ws;
    typedef const void* const volatile __attribute__((address_space(4))) kargp_t;
    kargp_t* const kargs = (kargp_t*)__builtin_amdgcn_kernarg_segment_ptr();
#define INP(k) ((const float*)kargs[k])
    for (int u = F.tid; u < (LDS_BYTES - LDSCTL_OFF) / 4; u += NWAVES * 64) ((LAS unsigned*)(F.lds + LDSCTL_OFF))[u] = 0u;
    __syncthreads();
    const int lo = args.ph_lo, hi = args.ph_hi;
    const bool single = (hi - lo) > 1;
    XcdBarrier bar; bar.bar = (unsigned*)(F.ctl + CW_BAR); bar.x = 0; bar.st = nullptr;
    if (single) bar = xcd_barrier_post((unsigned*)(F.ctl + CW_BAR), F.MISC + 8);
#define IN(k) (lo <= (k) && (k) < hi)
#if defined(PROBE_K0)
    LAS unsigned long long* tsl = (LAS unsigned long long*)(F.lds + TS_OFF);
    if (F.tid == 0) tsl[0] = rt();
#define SEAM(k) do { if (IN(k) && IN((k) + 1)) xcd_barrier(bar); if (F.tid == 0) tsl[(k) + 1] = rt(); } while (0)
#define SEAM_LOCAL(k) do { if (F.tid == 0) tsl[(k) + 1] = rt(); } while (0)
#else
#define SEAM(k) do { if (IN(k) && IN((k) + 1)) xcd_barrier(bar); } while (0)
#define SEAM_LOCAL(k) do { } while (0)
#endif
    typedef pg8::bf16_t hb;
    const int bx = (int)blockIdx.x;

    if (IN(0)) { In I;
        I.x = (const float*)INP(0);
        I.mem = (const float*)INP(1);
        I.positions = (const int*)INP(2);
        I.norm_mix_g = (const float*)INP(3);
        I.w_in = (const float*)INP(4);
        I.lq1 = (const float*)INP(5);
        I.lk1 = (const float*)INP(6);
        I.lq2 = (const float*)INP(7);
        I.lk2 = (const float*)INP(8);
        I.diff_norm_g = (const float*)INP(9);
        I.w_alpha2 = (const float*)INP(10);
        I.b_alpha = (const float*)INP(11);
        I.gla_norm_g = (const float*)INP(12);
        I.w_out = (const float*)INP(13);
        I.norm_cross_g = (const float*)INP(14);
        I.norm_mem_g = (const float*)INP(15);
        I.w_cq = (const float*)INP(16);
        I.w_ck = (const float*)INP(17);
        I.w_cv = (const float*)INP(18);
        I.w_co = (const float*)INP(19);
        I.norm_ffn_g = (const float*)INP(20);
        I.w_router = (const float*)INP(21);
        I.b_router = (const float*)INP(22);
        I.w_up = (const float*)INP(23);
        I.b_up = (const float*)INP(24);
        I.w_down = (const float*)INP(25);
        I.b_down = (const float*)INP(26);
        I.norm_final_g = (const float*)INP(27);
        p0_prologue(F, I); }
    SEAM(0);
    if (IN(1)) {
        pg8::Gemm g{(const hb*)(ws + WS_HN), (const hb*)(ws + WS_WINT), NTOK, 3328, DM, DM, DM, 127, 127};
        typedef pg8::OrderP1<(unsigned)WS_HN, (unsigned)WS_WINT, (unsigned)WS_MN, (unsigned)WS_WCK, (unsigned)WS_WCV> OrdP1; OrdP1 S; S.G = F.G; S.c = bx; S.ws = (const char*)ws;
        pg8::EpiP1 E{pg8::EpiProj{(hb*)(ws + WS_P), (float*)(ws + WS_LA), (const float*)(ws + WS_CS), INP(11)}, pg8::EpiPlain{(hb*)(ws + WS_VT) - (size_t)1024 * NTOK, NTOK, 1.0f},
                     pg8::EpiPlain{(hb*)(ws + WS_KX), DM, 1.0f}, pg8::EpiPlain{(hb*)(ws + WS_VXT), DM, 1.0f}};
        pg8::gemm_phase<pg8::EpiP1, OrdP1, true, true, false, false>(F.lds + RING_OFF, g, S, E);
    }
    SEAM(1);
    if (IN(2)) {
        float lam;
        { const int ln = lane_here(); const float a = INP(5)[ln] * INP(6)[ln], c = INP(7)[ln] * INP(8)[ln]; lam = __expf(wave_sum(a)) - __expf(wave_sum(c)) + 0.2f; }
        LAS int* qslot = (LAS int*)(F.lds + TAB_OFF);
        for (;;) {
            if (F.tid == 0) qslot[0] = (int)__hip_atomic_fetch_add(F.ctl + CW_Q2, 1u, RLX_AGENT);
            __syncthreads();
            const int u = qslot[0];
            __syncthreads();
            if (u >= 64 + 1024 + MOE_UNITS) break;
            int au = -1;
            if (u >= 64) { const int v = u - 64, gi = v / 11, r = v - gi * 11;
                if (r >= 8) { moe_convert_unit(gi * 3 + (r - 8), INP(23), INP(25), INP(20), ws, F.wave, lane_here()); continue; }
                au = gi * 8 + r; }
#if defined(PROBE_SPLIT)
            if (u < 64) continue;
#endif
            if (u < 64) { gla_unit(F, (const bf16*)(ws + WS_P), (const float*)(ws + WS_LA), (const bf16*)(ws + WS_GVT), (bf16*)(ws + WS_CAT), INP(12), u >> 2, u & 3);
            }
            else { const int v = au, bh = v & 63, qb = 15 - (v >> 6);
                diffattn_unit(F, (const bf16*)(ws + WS_P), (const bf16*)(ws + WS_VT), (bf16*)(ws + WS_CAT), INP(9), lam, bh >> 2, bh & 3, qb); }
        }
    }
#if defined(PROBE_SPLIT)
    if (IN(2)) { xcd_barrier(bar); if (F.tid == 0) tsl[13] = rt();
        for (int u = F.vcu; u < 64; u += F.G) gla_unit(F, (const bf16*)(ws + WS_P), (const float*)(ws + WS_LA), (const bf16*)(ws + WS_GVT), (bf16*)(ws + WS_CAT), INP(12), u >> 2, u & 3); }
#endif
    SEAM(2);
    if (IN(3)) {
        { pg8::Gemm g{(const hb*)(ws + WS_CAT), (const hb*)(ws + WS_WOUT), NTOK, DM, DM, DM, DM, 127, 127}; pg8::StaticOrder S; S.init(NTOK, DM, F.G, bx);
          pg8::EpiRes1 E{INP(0), (hb*)(ws + WS_X1B), (float*)(ws + WS_SSP1)};
          pg8::gemm_phase<pg8::EpiRes1, pg8::StaticOrder, true, true, false, false>(F.lds + RING_OFF, g, S, E); }
        { pg8::Gemm g{(const hb*)(ws + WS_KX), (const hb*)(ws + WS_WCQ), 64 * 256, DM, 256, DM, DM, 127, 127};
          typedef pg8::OrderGH<(unsigned)WS_KX, (unsigned)WS_WCQ, (unsigned)WS_WCO, (unsigned)WS_VXT> OrdGH; OrdGH S; S.G = F.G; S.c = bx; S.ws = (const char*)ws;
          pg8::EpiGH E{pg8::EpiPlain{(hb*)(ws + WS_GT), DM, 1.0f}, pg8::EpiPlain{(hb*)(ws + WS_HT), DM, 1.0f}};
          pg8::gemm_phase<pg8::EpiGH, OrdGH, true, true>(F.lds + RING_OFF, g, S, E); }
    }
    SEAM(3);
    if (IN(4)) {
        pg8::Gemm g{(const hb*)(ws + WS_X1B), (const hb*)(ws + WS_GT), NTOK, 256, DM, DM, DM, 127, 127}; pg8::OrderXS S; S.init(F.G, bx);
        pg8::EpiSoftmaxN E{(hb*)(ws + WS_PX), (const float*)(ws + WS_SSP1), (PG8_LAS float*)(F.lds + XCH_OFF), (PG8_LAS float*)(F.lds + XCH2_OFF)};
        pg8::gemm_phase<pg8::EpiSoftmaxN, pg8::OrderXS, true, true>(F.lds + RING_OFF, g, S, E);
    }
    SEAM(4);
    if (IN(5)) {
        pg8::Gemm g{(const hb*)(ws + WS_PX), (const hb*)(ws + WS_HT), NTOK, DM, DM, DM, DM, 127, 127}; pg8::OrderXO S; S.init(F.G, bx);
        pg8::EpiRes2 E{(hb*)(ws + WS_X1B), ws + WS_X2B};
        pg8::gemm_phase<pg8::EpiRes2, pg8::OrderXO, true, true, false, false>(F.lds + RING_OFF, g, S, E);
    }
    SEAM(5);
    if (IN(6)) router_phase(F, (const bf16*)(ws + WS_X1B), (const bf16*)(ws + WS_WR), INP(22), (float*)(ws + WS_RSL), (float*)(ws + WS_GATE), (unsigned*)(ws + WS_ASSIGN), (unsigned*)(ws + WS_LIST), F.ctl + CW_CNT);
    SEAM(6);
    if (IN(7)) {
        const int T = moe_tables(F);
        pg8::Gemm g{(const hb*)(ws + WS_X2B), (const hb*)(ws + WS_WUP), T * 256, NEXP * 2048, 512, 512, 512, 127, 122}; pg8::MoeOrderG S;
        S.init(T, 8, F.G, bx, (const PG8_LAS unsigned char*)(F.lds + TAB_OFF), (const PG8_LAS int*)(F.lds + TAB_TSTART), (const PG8_LAS int*)(F.lds + TAB_CNT), (const unsigned*)(ws + WS_LIST), (PG8_LAS unsigned*)(F.lds + XCH_OFF));
        pg8::EpiUp E{ws + WS_ACT, (const float*)(ws + WS_RSL), (const PG8_LAS int*)(F.lds + TAB_TSTART), (const PG8_LAS int*)(F.lds + TAB_CNT), INP(24), (PG8_LAS unsigned char*)(F.lds + EOP_OFF)};
        pg8::gemm_phase<pg8::EpiUp, pg8::MoeOrderG, true, true, true, false>(F.lds + RING_OFF, g, S, E);
    }
    SEAM(7);
    if (IN(8)) {
        const int T = moe_tables(F);
        pg8::Gemm g{(const hb*)(ws + WS_ACT), (const hb*)(ws + WS_WDN), T * 256, NEXP * 1024, 512, 512, 512, 127, 122}; pg8::MoeOrder S; S.init(T, 4, F.G, bx, (const PG8_LAS unsigned char*)(F.lds + TAB_OFF));
        pg8::EpiDown E{ws + WS_Y, INP(26), (PG8_LAS unsigned char*)(F.lds + EOP_OFF)};
        pg8::gemm_phase<pg8::EpiDown, pg8::MoeOrder, true, true, true, false>(F.lds + RING_OFF, g, S, E);
    }
    SEAM(8);
    if (IN(9)) final_phase(F, (const bf16*)(ws + WS_X1B), F.out, (const unsigned char*)(ws + WS_Y), (const float*)(ws + WS_GATE), (const unsigned*)(ws + WS_ASSIGN), INP(27));
#if defined(PROBE_ATT)
    { xcd_barrier(bar); if (F.tid == 0) tsl[13] = rt();
#pragma unroll 1
      for (int i2 = 2 * F.vcu; i2 < 1024; i2 += 2 * F.G)
#pragma unroll 1
          for (int rep = 0; rep < 2; ++rep) { const int i = i2 >> 1, bh = i >> 3, jj = i & 7;
              diffattn_unit<PROBE_ATT>(F, (const bf16*)(ws + WS_P), (const bf16*)(ws + WS_VT), (bf16*)(ws + WS_ACT), INP(9), 0.5f, bh >> 2, bh & 3, rep ? jj : 15 - jj); }
      xcd_barrier(bar); if (F.tid == 0) tsl[14] = rt(); }
#endif
#if defined(PROBE_GEMM)
    { xcd_barrier(bar); if (F.tid == 0) tsl[13] = rt();
      const int T = moe_tables(F);
      pg8::Gemm g{(const hb*)(ws + WS_X2B), (const hb*)(ws + WS_WUP), T * 256, NEXP * 2048, 512, 512, 512, 127, 122}; pg8::MoeOrderG S;
      S.init(T, 8, F.G, bx, (const PG8_LAS unsigned char*)(F.lds + TAB_OFF), (const PG8_LAS int*)(F.lds + TAB_TSTART), (const PG8_LAS int*)(F.lds + TAB_CNT), (const unsigned*)(ws + WS_LIST), (PG8_LAS unsigned*)(F.lds + XCH_OFF));
      pg8::EpiUp E{ws + WS_ACT, (const float*)(ws + WS_RSL), (const PG8_LAS int*)(F.lds + TAB_TSTART), (const PG8_LAS int*)(F.lds + TAB_CNT), INP(24), (PG8_LAS unsigned char*)(F.lds + EOP_OFF)};
      pg8::gemm_phase<pg8::EpiUp, pg8::MoeOrderG, true, true, true, false, PROBE_GEMM>(F.lds + RING_OFF, g, S, E);
      xcd_barrier(bar); if (F.tid == 0) tsl[14] = rt(); }
#endif
#if defined(PROBE_K0)
#ifndef PROBE_UNIT
#define PROBE_UNIT 1600
#endif
    { if (F.tid == 0) { tsl[NPHASE] = rt();
        const int ks[2] = {PROBE_K0, PROBE_K1}; unsigned long long code = 0, mul = 1;
        for (int i = 0; i < 2; ++i) { unsigned long long dt = ks[i] == 94 ? tsl[14] - tsl[13] : ks[i] == 97 ? tsl[13] - tsl[2] : ks[i] == 98 ? tsl[3] - tsl[13] : ks[i] == 95 ? tsl[13] - tsl[0] : ks[i] == 96 ? tsl[14] - tsl[13] : tsl[ks[i] + 1] - tsl[ks[i]]; unsigned long long q = (dt + PROBE_UNIT / 2) / PROBE_UNIT; if (q > 63) q = 63; code += q * mul; mul *= 64; }
        tsl[15] = code * 6400ull; }
      __syncthreads();
      const unsigned long long t0 = rt(), wait = tsl[15]; float x = (float)F.tid, y = 1.0001f;
      while (rt() - t0 < wait) {
#pragma unroll
          for (int i = 0; i < 64; ++i) x = x * y + 0.5f; }
      if (x == 12345.678f) F.out[0] = x; }
#endif
#undef IN
#undef SEAM
#undef SEAM_LOCAL
}

#ifndef MK_N_LAUNCHES
#define MK_N_LAUNCHES 1
#endif
extern "C" void kernel_launch(void* const* d_in, const int* in_sizes, int n_in, void* d_out, int out_size, void* d_ws, size_t ws_size, hipStream_t stream) {
    static int grid = 0;
    if (grid == 0) {
        if (n_in != 28 || out_size != NTOK * DM || ws_size < WS_END) { fprintf(stderr, "kernel_launch: unexpected shapes: n_in %d out %d ws %zu (need %zu)\n", n_in, out_size, ws_size, (size_t)WS_END); grid = -1; return; }
        int dev = 0, cus = 0, per_cu = 0;
        if (hipGetDevice(&dev) != hipSuccess || hipDeviceGetAttribute(&cus, hipDeviceAttributeMultiprocessorCount, dev) != hipSuccess) { fprintf(stderr, "kernel_launch: device query failed\n"); grid = -1; return; }
        if (hipFuncSetAttribute((const void*)mk_fwd, hipFuncAttributeMaxDynamicSharedMemorySize, LDS_BYTES) != hipSuccess) { fprintf(stderr, "kernel_launch: hipFuncSetAttribute failed\n"); grid = -1; return; }
        if (hipOccupancyMaxActiveBlocksPerMultiprocessor(&per_cu, (const void*)mk_fwd, NWAVES * 64, LDS_BYTES) != hipSuccess || per_cu < 1) { fprintf(stderr, "kernel_launch: occupancy query reports %d workgroups per CU\n", per_cu); (void)hipGetLastError(); grid = -1; return; }
        grid = cus;
    }
    if (grid < 0) return;
    (void)hipMemsetAsync((char*)d_ws + WS_CTL, 0, CTL_ZERO_BYTES, stream);
    Args a{};
    for (int i = 0; i < 28; ++i) a.in[i] = d_in[i];
    a.out = (float*)d_out; a.ws = (unsigned char*)d_ws;
    if (MK_N_LAUNCHES == 1) { a.ph_lo = 0; a.ph_hi = NPHASE; hipLaunchKernelGGL(mk_fwd, dim3(grid), dim3(NWAVES * 64), LDS_BYTES, stream, a); }
    else for (int p = 0; p < NPHASE; ++p) { a.ph_lo = p; a.ph_hi = p + 1; hipLaunchKernelGGL(mk_fwd, dim3(grid), dim3(NWAVES * 64), LDS_BYTES, stream, a); }
}
```

```cpp
#include <hip/hip_runtime.h>
#include <cstdio>
#include <cstdint>
namespace pg8 {
#define PG8_LAS __attribute__((address_space(3)))
typedef unsigned short bf16_t;
typedef short bf16x8 __attribute__((ext_vector_type(8)));
typedef float f32x4 __attribute__((ext_vector_type(4)));
typedef unsigned u32x4 __attribute__((ext_vector_type(4)));
constexpr int BM = 256, BK = 64, HALF = 128, HTB = HALF * BK * 2  , STAGE_BYTES = 8 * HTB, NXCD = 8, WGM = 8;

__host__ __device__ __forceinline__ int lds_byte(int r, int c) { const int st = (r >> 4) * 2 + (c >> 5), rr = r & 15, cc = c & 31, ob = rr * 64 + cc * 2; return st * 1024 + (ob ^ (((ob >> 9) & 1) << 5)); }
__host__ __device__ __forceinline__ void stage_rc(int b, int& R, int& C) { const int st = b / 1024, sb = b % 1024, swz = sb ^ (((sb >> 9) & 1) << 5); R = (st >> 1) * 16 + swz / 64; C = (st & 1) * 32 + (swz % 64) / 2; }
__host__ __device__ __forceinline__ int perm32(int rho) { const int n = rho >> 4, i = rho & 15; return 8 * (i >> 2) + 4 * n + (i & 3); }

struct Unit { int pm, pn; };
struct Gemm { const bf16_t* A; const bf16_t* Bt; int M, N, K, lda, ldb, sa, sb; };
template <class T, class = void> struct epi_ldsops { static constexpr bool value = false; };
template <class T> struct epi_ldsops<T, decltype((void)T::LDSOPS)> { static constexpr bool value = T::LDSOPS; };
struct OrderBase {
    static constexpr bool GATHER = false;
    __device__ __forceinline__ const char* a_base(const Gemm& g, const Unit& u) const { return (const char*)g.A + (size_t)u.pm * 256 * g.lda * 2; }
    __device__ __forceinline__ const char* b_base(const Gemm& g, const Unit& u) const { return (const char*)g.Bt + (size_t)u.pn * 256 * g.ldb * 2; }
    __device__ __forceinline__ void a_ready(const Unit&) const {}
    __device__ __forceinline__ void done(const Unit&) const {}
};

struct StaticOrder : OrderBase {
    int nM, nN, nwg, G, c;
    __host__ __device__ void init(int M, int N, int G_, int c_) { nM = M / BM; nN = N / BM; nwg = nM * nN; G = G_; c = c_; }
    __host__ __device__ bool next(int i, Unit& u) const {
        const long L = (long)i * G + c; if (L >= nwg) return false;
        int wgid = (int)L; { const int q = nwg / NXCD, r = nwg % NXCD, xcd = wgid % NXCD, off = wgid / NXCD; wgid = (xcd < r ? xcd * (q + 1) : r * (q + 1) + (xcd - r) * q) + off; }
        const int nig = WGM * nN, gid = wgid / nig, fm = gid * WGM, gsz = (nM - fm) < WGM ? (nM - fm) : WGM;
        u.pm = fm + ((wgid % nig) % gsz); u.pn = (wgid % nig) / gsz; return true;
    }
};

typedef unsigned u32x2 __attribute__((ext_vector_type(2)));
typedef float f32x2_t __attribute__((ext_vector_type(2)));
typedef __bf16 bf16x2_t __attribute__((ext_vector_type(2)));
__device__ __forceinline__ unsigned cvtpk(float lo, float hi) { f32x2_t v = {lo, hi}; bf16x2_t b = __builtin_convertvector(v, bf16x2_t); return __builtin_bit_cast(unsigned, b); }
__device__ __forceinline__ void st_bf4(bf16_t* p, f32x4 v) { u32x2 w; w.x = cvtpk(v[0], v[1]); w.y = cvtpk(v[2], v[3]); *(u32x2*)p = w; }
__device__ __forceinline__ unsigned cvt4_fp8(f32x4 v) { unsigned w = __builtin_amdgcn_cvt_pk_fp8_f32(v[0], v[1], 0, false); return __builtin_amdgcn_cvt_pk_fp8_f32(v[2], v[3], w, true); }
__device__ __forceinline__ void st_bf8(bf16_t* p, f32x4 a, f32x4 c) { u32x4 w; w.x = cvtpk(a[0], a[1]); w.y = cvtpk(a[2], a[3]); w.z = cvtpk(c[0], c[1]); w.w = cvtpk(c[2], c[3]); *(u32x4*)p = w; }
__device__ __forceinline__ float bf2f(bf16_t b) { return __builtin_bit_cast(float, (unsigned)b << 16); }
__device__ __forceinline__ float xpart16(float v, bool oddrow) { auto rr = __builtin_amdgcn_permlane16_swap(__float_as_uint(v), __float_as_uint(v), false, false); return __uint_as_float(oddrow ? rr[0] : rr[1]); }
__device__ __forceinline__ unsigned pkh(float lo, float hi) { return (unsigned)__builtin_bit_cast(unsigned short, (_Float16)lo) | ((unsigned)__builtin_bit_cast(unsigned short, (_Float16)hi) << 16); }
template <int CTRL> __device__ __forceinline__ float dppz(float v) { return __int_as_float(__builtin_amdgcn_update_dpp(0, __float_as_int(v), CTRL, 0xf, 0xf, false)); }
#define EPI_ROWS _Pragma("unroll") for (int ai = 0; ai < 2; ++ai) _Pragma("unroll") for (int m = 0; m < 4; ++m)
#define EPI_COLS _Pragma("unroll") for (int bj = 0; bj < 2; ++bj) _Pragma("unroll") for (int n = 0; n < 2; ++n)
constexpr float LOG2E = 1.4426950408889634f;
constexpr float QSCALE_DA = 0.125f * LOG2E;
constexpr float QSCALE_X = 0.0625f * LOG2E;

struct EpiPlain {
    static constexpr bool PERM = true, AFTER_DRAIN = false;
    bf16_t* O; int ldc; float scale;
    __device__ __forceinline__ void operator()(const f32x4 (&acc)[2][2][4][2], const Unit& u, int wr, int wc, int fr, int fq) const {
        EPI_ROWS { const int row = u.pm * 256 + ai * 128 + wr * 64 + m * 16 + fr; bf16_t* rp = O + (size_t)row * ldc + u.pn * 256 + wc * 32 + fq * 8;
            _Pragma("unroll") for (int bj = 0; bj < 2; ++bj) st_bf8(rp + bj * 128, acc[ai][bj][m][0] * scale, acc[ai][bj][m][1] * scale); }
    }
};
struct EpiProj {
    static constexpr bool PERM = true, AFTER_DRAIN = false;
    bf16_t* P; float* LA; const float* cs; const float* b_alpha;
    template <int ai> __device__ __forceinline__ void decay_rows(const f32x4 (&acc)[2][2][4][2], const f32x4 (&bav)[2][2], const Unit& u, int wr, int wc, int fr, int fq) const {
        const int row0 = u.pm * 256 + ai * 128 + wr * 64 + fr; unsigned short* LAh = (unsigned short*)LA;
        _Pragma("unroll") for (int bj = 0; bj < 2; ++bj) { const int col = bj * 128 + wc * 32 + fq * 8; f32x4 run[2] = {{0.f, 0.f, 0.f, 0.f}, {0.f, 0.f, 0.f, 0.f}};
            _Pragma("unroll") for (int m = 0; m < 4; ++m) { f32x4 o[2];
                _Pragma("unroll") for (int n = 0; n < 2; ++n) { const f32x4 z = acc[ai][bj][m][n] + bav[bj][n];
                    _Pragma("unroll") for (int i = 0; i < 4; ++i) { float v = __builtin_fmaf(__builtin_amdgcn_logf(1.0f + __builtin_amdgcn_exp2f(fabsf(z[i]) * -1.4426950408889634f)), -0.04332169878499658f, fminf(z[i], 0.f) * 0.0625f);
                        v += dppz<0x111>(v); v += dppz<0x112>(v); v += dppz<0x114>(v); v += dppz<0x118>(v);
                        o[n][i] = v + run[n][i]; run[n][i] += dppz<0x15F>(v); } }
                u32x4 w; w.x = pkh(o[0][0], o[0][1]); w.y = pkh(o[0][2], o[0][3]); w.z = pkh(o[1][0], o[1][1]); w.w = pkh(o[1][2], o[1][3]);
                *(u32x4*)(LAh + (size_t)(row0 + m * 16) * 256 + col) = w; } }
    }
    __device__ __forceinline__ void operator()(const f32x4 (&acc)[2][2][4][2], const Unit& u, int wr, int wc, int fr, int fq) const {
        const int pn = u.pn;
        if (pn < 4) {
            const float sc = pn < 2 ? QSCALE_DA : 1.0f; const bool ropew = (wc & 1) == 0; const bool rl = fq < 2, hi = fq == 1;
            if (ropew) {
                u32x4 cq[4][2];
#define ROPE_LD(i, sl) do { const u32x4* cp_ = (const u32x4*)((const unsigned short*)cs + (size_t)(u.pm * 256 + ((i) >> 2) * 128 + wr * 64 + ((i) & 3) * 16 + fr) * 16); cq[sl][0] = cp_[0]; cq[sl][1] = cp_[1]; } while (0)
                ROPE_LD(0, 0); ROPE_LD(1, 1); ROPE_LD(2, 2); ROPE_LD(3, 3);
                _Pragma("unroll") for (int ri = 0; ri < 8; ++ri) { const int ai = ri >> 2, m = ri & 3; const int row = u.pm * 256 + ai * 128 + wr * 64 + m * 16 + fr; bf16_t* rp = P + (size_t)row * 3072 + pn * 256 + wc * 32 + fq * 8;
                    f32x4 cv[2], sv[2];
                    { const unsigned cw[4] = {cq[ri & 3][0].x, cq[ri & 3][0].y, cq[ri & 3][0].z, cq[ri & 3][0].w}, sw[4] = {cq[ri & 3][1].x, cq[ri & 3][1].y, cq[ri & 3][1].z, cq[ri & 3][1].w};
                      _Pragma("unroll") for (int q = 0; q < 4; ++q) { cv[q >> 1][2 * (q & 1)] = (float)__builtin_bit_cast(_Float16, (unsigned short)(cw[q] & 0xffffu)); cv[q >> 1][2 * (q & 1) + 1] = (float)__builtin_bit_cast(_Float16, (unsigned short)(cw[q] >> 16));
                          sv[q >> 1][2 * (q & 1)] = (float)__builtin_bit_cast(_Float16, (unsigned short)(sw[q] & 0xffffu)); sv[q >> 1][2 * (q & 1) + 1] = (float)__builtin_bit_cast(_Float16, (unsigned short)(sw[q] >> 16)); } }
                    if (ri + 4 < 8) ROPE_LD(ri + 4, ri & 3);
                    _Pragma("unroll") for (int bj = 0; bj < 2; ++bj) { f32x4 v[2] = {acc[ai][bj][m][0], acc[ai][bj][m][1]};
                        _Pragma("unroll") for (int n = 0; n < 2; ++n) { f32x4 p; p[0] = xpart16(v[n][0], hi); p[1] = xpart16(v[n][1], hi); p[2] = xpart16(v[n][2], hi); p[3] = xpart16(v[n][3], hi);
                            const f32x4 r = hi ? (v[n] * cv[n] + p * sv[n]) : (v[n] * cv[n] - p * sv[n]); v[n] = rl ? r : v[n]; }
                        st_bf8(rp + bj * 128, v[0] * sc, v[1] * sc); } }
#undef ROPE_LD
            } else {
                EPI_ROWS { const int row = u.pm * 256 + ai * 128 + wr * 64 + m * 16 + fr; bf16_t* rp = P + (size_t)row * 3072 + pn * 256 + wc * 32 + fq * 8;
                    _Pragma("unroll") for (int bj = 0; bj < 2; ++bj) st_bf8(rp + bj * 128, acc[ai][bj][m][0] * sc, acc[ai][bj][m][1] * sc); }
            }
        } else if (pn < 12) {
            const float sc = pn == 6 ? 0.125f : 1.0f;
            EPI_ROWS { const int row = u.pm * 256 + ai * 128 + wr * 64 + m * 16 + fr; bf16_t* rp = P + (size_t)row * 3072 + pn * 256 + wc * 32 + fq * 8;
                _Pragma("unroll") for (int bj = 0; bj < 2; ++bj) st_bf8(rp + bj * 128, acc[ai][bj][m][0] * sc, acc[ai][bj][m][1] * sc); }
        } else {
            f32x4 bav[2][2]; EPI_COLS bav[bj][n] = *(const f32x4*)(b_alpha + bj * 128 + wc * 32 + fq * 8 + n * 4);
            decay_rows<0>(acc, bav, u, wr, wc, fr, fq); decay_rows<1>(acc, bav, u, wr, wc, fr, fq);
        }
    }
};
struct EpiP1 {
    static constexpr bool PERM = true, AFTER_DRAIN = false;
    EpiProj proj; EpiPlain vt, kx, vxt;
    __device__ __forceinline__ void operator()(const f32x4 (&acc)[2][2][4][2], const Unit& u, int wr, int wc, int fr, int fq) const {
        const int job = u.pn >> 16; Unit v; v.pm = u.pm; v.pn = u.pn & 0xffff;
        if (job == 0) proj(acc, v, wr, wc, fr, fq); else if (job == 1) vt(acc, v, wr, wc, fr, fq); else if (job == 2) kx(acc, v, wr, wc, fr, fq); else vxt(acc, v, wr, wc, fr, fq);
    }
};
struct EpiRes1 {
    static constexpr bool PERM = true, AFTER_DRAIN = false, LDSOPS = true;
    const bf16_t* hn; bf16_t* xb; float* ssp; const float* rsx; PG8_LAS unsigned char* eop;
    __device__ __forceinline__ void prefetch(const Unit& u, int slot, int wid, int lane) const {
        if (wid == 4) __builtin_amdgcn_global_load_lds((const unsigned*)(rsx + (size_t)u.pm * 256 + lane * 4), (PG8_LAS unsigned*)(eop + slot * 2048), 16, 0, 0); }
    __device__ __forceinline__ void operator()(const f32x4 (&acc)[2][2][4][2], const Unit& u, int wr, int wc, int fr, int fq, int slot) const {
        constexpr int ND = 4;
        const size_t off0 = (size_t)(u.pm * 256 + wr * 64 + fr) * 1024 + u.pn * 256 + wc * 32 + fq * 8;
        const PG8_LAS float* ls = (const PG8_LAS float*)(eop + slot * 2048) + wr * 64 + fr;
        u32x4 xq[ND][2]; f32x4 ssv = {0.f, 0.f, 0.f, 0.f};
#define RES1_LD(i, sl) do { const bf16_t* bp_ = hn + off0 + (size_t)((((i) >> 2) * 128 + ((i) & 3) * 16)) * 1024; xq[sl][0] = *(const u32x4*)bp_; xq[sl][1] = *(const u32x4*)(bp_ + 128); } while (0)
        _Pragma("unroll") for (int i = 0; i < ND; ++i) RES1_LD(i, i);
        _Pragma("unroll") for (int i = 0; i < 8; ++i) { const int ai = i >> 2, m = i & 3; const size_t off = off0 + (size_t)(ai * 128 + m * 16) * 1024;
            const float inv = __builtin_amdgcn_rcpf(ls[ai * 128 + m * 16]);
            f32x4 v[4];
            _Pragma("unroll") for (int bj = 0; bj < 2; ++bj) { const u32x4 w = xq[i % ND][bj];
                const f32x4 x0 = {__builtin_bit_cast(float, w.x << 16), __builtin_bit_cast(float, w.x & 0xffff0000u), __builtin_bit_cast(float, w.y << 16), __builtin_bit_cast(float, w.y & 0xffff0000u)};
                const f32x4 x1 = {__builtin_bit_cast(float, w.z << 16), __builtin_bit_cast(float, w.z & 0xffff0000u), __builtin_bit_cast(float, w.w << 16), __builtin_bit_cast(float, w.w & 0xffff0000u)};
                v[2 * bj] = x0 * inv + acc[ai][bj][m][0]; v[2 * bj + 1] = x1 * inv + acc[ai][bj][m][1]; }
            if (i + ND < 8) RES1_LD(i + ND, i % ND);
            st_bf8(xb + off, v[0], v[1]); st_bf8(xb + off + 128, v[2], v[3]); float ss = 0.f;
            _Pragma("unroll") for (int q = 0; q < 4; ++q) ss += (v[q][0] * v[q][0] + v[q][1] * v[q][1]) + (v[q][2] * v[q][2] + v[q][3] * v[q][3]);
            ss += __shfl_xor(ss, 16); ss += __shfl_xor(ss, 32); ssv[m] = ss;
            if (m == 3 && fq == 0) *(f32x4*)(ssp + ((((((size_t)u.pm * 4 + u.pn) * 4 + wc) * 2 + ai) * 2 + wr) * 16 + fr) * 4) = ssv; }
#undef RES1_LD
    }
};
struct EpiQX {
    static constexpr bool PERM = true, AFTER_DRAIN = false;
    bf16_t* O; const float* ssp;
    __device__ __forceinline__ void operator()(const f32x4 (&acc)[2][2][4][2], const Unit& u, int wr, int wc, int fr, int fq) const {
        EPI_ROWS { const int row = u.pm * 256 + ai * 128 + wr * 64 + m * 16 + fr; const f32x4* sp = (const f32x4*)(ssp + (size_t)row * 16);
            const f32x4 a = sp[0], b = sp[1], c = sp[2], d = sp[3]; const float ss = ((a[0] + a[1]) + (a[2] + a[3])) + ((b[0] + b[1]) + (b[2] + b[3])) + ((c[0] + c[1]) + (c[2] + c[3])) + ((d[0] + d[1]) + (d[2] + d[3]));
            const float rs = rsqrtf(ss * (1.0f / 1024.0f) + 1e-6f) * QSCALE_X; bf16_t* rp = O + (size_t)row * 1024 + u.pn * 256 + wc * 32 + fq * 8;
            _Pragma("unroll") for (int bj = 0; bj < 2; ++bj) st_bf8(rp + bj * 128, acc[ai][bj][m][0] * rs, acc[ai][bj][m][1] * rs); }
    }
};
struct EpiRes2 {
    static constexpr bool PERM = true, AFTER_DRAIN = false;
    bf16_t* xh; unsigned char* x8;
    __device__ __forceinline__ void operator()(const f32x4 (&acc)[2][2][4][2], const Unit& u, int wr, int wc, int fr, int fq) const {
        constexpr int ND = 4;
        const size_t off0 = (size_t)(u.pm * 256 + wr * 64 + fr) * 1024 + u.pn * 256 + wc * 32 + fq * 8;
        u32x4 xq[ND][2]; u32x2 qe[2];
#define RES2_LD(i, sl) do { const bf16_t* bp_ = xh + off0 + (size_t)((((i) >> 2) * 128 + ((i) & 3) * 16)) * 1024; xq[sl][0] = *(const u32x4*)bp_; xq[sl][1] = *(const u32x4*)(bp_ + 128); } while (0)
        _Pragma("unroll") for (int i = 0; i < ND; ++i) RES2_LD(i, i);
        _Pragma("unroll") for (int i = 0; i < 8; ++i) { const int ai = i >> 2, m = i & 3; const size_t off = off0 + (size_t)(ai * 128 + m * 16) * 1024;
            f32x4 v[2][2];
            _Pragma("unroll") for (int bj = 0; bj < 2; ++bj) { const u32x4 w = xq[i % ND][bj];
                const f32x4 v0 = {__builtin_bit_cast(float, w.x << 16), __builtin_bit_cast(float, w.x & 0xffff0000u), __builtin_bit_cast(float, w.y << 16), __builtin_bit_cast(float, w.y & 0xffff0000u)};
                const f32x4 v1 = {__builtin_bit_cast(float, w.z << 16), __builtin_bit_cast(float, w.z & 0xffff0000u), __builtin_bit_cast(float, w.w << 16), __builtin_bit_cast(float, w.w & 0xffff0000u)};
                v[bj][0] = v0 + acc[ai][bj][m][0]; v[bj][1] = v1 + acc[ai][bj][m][1]; }
            if (i + ND < 8) RES2_LD(i + ND, i % ND);
            _Pragma("unroll") for (int bj = 0; bj < 2; ++bj) { st_bf8(xh + off + bj * 128, v[bj][0], v[bj][1]); u32x2 q; q.x = cvt4_fp8(v[bj][0]); q.y = cvt4_fp8(v[bj][1]);
                if ((i & 1) == 0) qe[bj] = q;
                else { u32x2 a = qe[bj], b = q; { auto r = __builtin_amdgcn_permlane16_swap(a.x, b.x, false, false); a.x = r[0]; b.x = r[1]; } { auto r = __builtin_amdgcn_permlane16_swap(a.y, b.y, false, false); a.y = r[0]; b.y = r[1]; }
                    u32x4 w; w.x = a.x; w.y = a.y; w.z = b.x; w.w = b.y;
                    *(u32x4*)(x8 + off0 + (size_t)((i >> 2) * 128 + ((i & 3) - 1 + (fq & 1)) * 16) * 1024 - (fq & 1) * 8 + bj * 128) = w; } } }
#undef RES2_LD
    }
};
struct EpiUp {
    static constexpr bool PERM = true, AFTER_DRAIN = false, LDSOPS = true;
    unsigned char* ACT; const float* rsl; const PG8_LAS int* tstart; const PG8_LAS int* cnt; const float* b_up; PG8_LAS unsigned char* eop;
    __device__ __forceinline__ void prefetch(const Unit& u, int slot, int wid, int lane) const {
        const int e = u.pn >> 3, pnl = u.pn & 7;
        if (wid == 4) __builtin_amdgcn_global_load_lds((const unsigned*)(rsl + (size_t)e * 32768 + (size_t)(u.pm - tstart[e]) * 256 + lane * 4), (PG8_LAS unsigned*)(eop + slot * 2048), 16, 0, 0);
        else if (wid == 5) __builtin_amdgcn_global_load_lds((const unsigned*)(b_up + (size_t)e * 2048 + pnl * 128 + (lane >> 5) * 1024 + (lane & 31) * 4), (PG8_LAS unsigned*)(eop + slot * 2048 + 1024), 16, 0, 0);
    }
    __device__ __forceinline__ void operator()(const f32x4 (&acc)[2][2][4][2], const Unit& u, int wr, int wc, int fr, int fq, int slot) const {
        const int e = u.pn >> 3, pnl = u.pn & 7;
        const int pos0 = (u.pm - tstart[e]) * 256 + wr * 64 + fr, nv = cnt[e];
        const PG8_LAS float* ls = (const PG8_LAS float*)(eop + slot * 2048) + wr * 64 + fr; const PG8_LAS float* lb = (const PG8_LAS float*)(eop + slot * 2048 + 1024) + wc * 32 + fq * 8;
        const f32x4 bg0 = *(const PG8_LAS f32x4*)lb, bg1 = *(const PG8_LAS f32x4*)(lb + 4), bl0 = *(const PG8_LAS f32x4*)(lb + 128), bl1 = *(const PG8_LAS f32x4*)(lb + 132);
        const f32x4 bl0p = bl0 + 1.0f, bl1p = bl1 + 1.0f;
        float rsv[2][4];
        EPI_ROWS rsv[ai][m] = (pos0 + ai * 128 + m * 16) < nv ? ls[ai * 128 + m * 16] : 0.f;
        const int odd = fq & 1;
        _Pragma("unroll") for (int ai = 0; ai < 2; ++ai) _Pragma("unroll") for (int mp = 0; mp < 2; ++mp) { u32x2 wv[2];
            _Pragma("unroll") for (int mm = 0; mm < 2; ++mm) { const int m = 2 * mp + mm; const float rs = rsv[ai][m];
                _Pragma("unroll") for (int n = 0; n < 2; ++n) {
                    const f32x4 c7 = {7.0f, 7.0f, 7.0f, 7.0f}, one = {1.0f, 1.0f, 1.0f, 1.0f}, c6m = {-6.0f, -6.0f, -6.0f, -6.0f}, c8 = {8.0f, 8.0f, 8.0f, 8.0f};
                    const f32x4 gl = __builtin_elementwise_min(acc[ai][0][m][n] * rs + (n ? bg1 : bg0), c7), li1 = __builtin_elementwise_min(__builtin_elementwise_max(acc[ai][1][m][n] * rs + (n ? bl1p : bl0p), c6m), c8);
                    const f32x4 t = gl * -2.4554669595930156f; f32x4 e; _Pragma("unroll") for (int i = 0; i < 4; ++i) e[i] = __builtin_amdgcn_exp2f(t[i]);
                    const f32x4 a = e + one; f32x4 r; _Pragma("unroll") for (int i = 0; i < 4; ++i) r[i] = __builtin_amdgcn_rcpf(a[i]);
                    const f32x4 o = (gl * r) * li1;
                    if (n) wv[mm].y = cvt4_fp8(o); else wv[mm].x = cvt4_fp8(o); } }
            { auto r = __builtin_amdgcn_permlane16_swap(wv[0].x, wv[1].x, false, false); wv[0].x = r[0]; wv[1].x = r[1]; } { auto r = __builtin_amdgcn_permlane16_swap(wv[0].y, wv[1].y, false, false); wv[0].y = r[0]; wv[1].y = r[1]; }
            const int row = u.pm * 256 + ai * 128 + wr * 64 + (2 * mp + odd) * 16 + fr;
            u32x4 w; w.x = wv[0].x; w.y = wv[0].y; w.z = wv[1].x; w.w = wv[1].y; *(u32x4*)(ACT + (size_t)row * 1024 + pnl * 128 + wc * 32 + (fq & 2) * 8) = w; }
    }
};
struct EpiDown {
    static constexpr bool PERM = true, AFTER_DRAIN = false, LDSOPS = true;
    unsigned char* Y; const float* b_down; PG8_LAS unsigned char* eop;
    __device__ __forceinline__ void prefetch(const Unit& u, int slot, int wid, int lane) const {
        const int e = u.pn >> 2, pnl = u.pn & 3;
        if (wid == 4) __builtin_amdgcn_global_load_lds((const unsigned*)(b_down + (size_t)e * 1024 + pnl * 256 + lane * 4), (PG8_LAS unsigned*)(eop + slot * 2048), 16, 0, 0);
    }
    __device__ __forceinline__ void operator()(const f32x4 (&acc)[2][2][4][2], const Unit& u, int wr, int wc, int fr, int fq, int slot) const {
        const int pnl = u.pn & 3; const PG8_LAS float* lb = (const PG8_LAS float*)(eop + slot * 2048) + wc * 32 + fq * 8;
        f32x4 bv[2][2];
        _Pragma("unroll") for (int bj = 0; bj < 2; ++bj) _Pragma("unroll") for (int n = 0; n < 2; ++n) bv[bj][n] = *(const PG8_LAS f32x4*)(lb + bj * 128 + n * 4);
        const int odd = fq & 1;
        _Pragma("unroll") for (int ai = 0; ai < 2; ++ai) _Pragma("unroll") for (int mp = 0; mp < 2; ++mp) {
            const int row = u.pm * 256 + ai * 128 + wr * 64 + (2 * mp + odd) * 16 + fr; unsigned char* rp = Y + (size_t)row * 1024 + pnl * 256 + wc * 32 + (fq & 2) * 8;
            _Pragma("unroll") for (int bj = 0; bj < 2; ++bj) {
                u32x2 a, b; a.x = cvt4_fp8(acc[ai][bj][2 * mp][0] + bv[bj][0]); a.y = cvt4_fp8(acc[ai][bj][2 * mp][1] + bv[bj][1]); b.x = cvt4_fp8(acc[ai][bj][2 * mp + 1][0] + bv[bj][0]); b.y = cvt4_fp8(acc[ai][bj][2 * mp + 1][1] + bv[bj][1]);
                { auto r = __builtin_amdgcn_permlane16_swap(a.x, b.x, false, false); a.x = r[0]; b.x = r[1]; } { auto r = __builtin_amdgcn_permlane16_swap(a.y, b.y, false, false); a.y = r[0]; b.y = r[1]; }
                u32x4 w; w.x = a.x; w.y = a.y; w.z = b.x; w.w = b.y; *(u32x4*)(rp + bj * 128) = w; } }
    }
};
struct OrderMap : OrderBase {
    StaticOrder so;
    __device__ void init(int nM, int nN, int G, int c) { so.nM = nM; so.nN = nN; so.nwg = nM * nN; so.G = G; so.c = c; }
    __device__ bool next(int i, Unit& u) const { if (!so.next(i, u)) return false; u.pn += (u.pn >= 4 ? 2 : 0) + (u.pn >= 6 ? 2 : 0); return true; }
};
struct OrderVT : OrderBase {
    StaticOrder so;
    __device__ void init(int nN, int G, int c) { so.nM = 4; so.nN = nN; so.nwg = 4 * nN; so.G = G; so.c = c; }
    __device__ bool next(int i, Unit& u) const { if (!so.next(i, u)) return false; u.pm += (u.pm >= 2 ? 6 : 4); return true; }
};
__device__ __forceinline__ void map_unit(int L, int nM, int nN, int& pm, int& pn) {
    const int nwg = nM * nN; int wgid = L; { const int q = nwg / NXCD, r = nwg % NXCD, xcd = wgid % NXCD, off = wgid / NXCD; wgid = (xcd < r ? xcd * (q + 1) : r * (q + 1) + (xcd - r) * q) + off; }
    const int nig = WGM * nN, gid = wgid / nig, fm = gid * WGM, gsz = (nM - fm) < WGM ? (nM - fm) : WGM;
    pm = fm + ((wgid % nig) % gsz); pn = (wgid % nig) / gsz;
}
template <unsigned oHN, unsigned oWINT, unsigned oMN, unsigned oWCK, unsigned oWCV>
struct OrderP1 : OrderBase {
    int G, c; const char* ws;
    __device__ __forceinline__ bool next(int i, Unit& u) const {
        int L = i * G + c; if (L >= 1792) return false;
        if (L < 1152) { map_unit(L, 128, 9, u.pm, u.pn); u.pn += (u.pn >= 4 ? 2 : 0) + (u.pn >= 6 ? 2 : 0); return true; } L -= 1152;
        if (L < 512) { map_unit(L, 4, 128, u.pm, u.pn); u.pm += (u.pm >= 2 ? 6 : 4); u.pn |= 1 << 16; return true; } L -= 512;
        if (L < 64) { map_unit(L, 16, 4, u.pm, u.pn); u.pn |= 2 << 16; return true; } L -= 64;
        map_unit(L, 16, 4, u.pm, u.pn); u.pn |= 3 << 16; return true;
    }
    __device__ __forceinline__ const char* a_base(const Gemm&, const Unit& u) const { const int job = u.pn >> 16; unsigned o = oHN; o = job == 1 ? oWINT : o; o = job >= 2 ? oMN : o; return ws + o + (size_t)u.pm * (256 * 1024 * 2); }
    __device__ __forceinline__ const char* b_base(const Gemm&, const Unit& u) const { const int job = u.pn >> 16; unsigned o = oWINT; o = job == 1 ? oHN : o; o = job == 2 ? oWCK : o; o = job == 3 ? oWCV : o; return ws + o + (size_t)(u.pn & 0xffff) * (256 * 1024 * 2); }
};
struct MoeOrder : OrderBase {
    StaticOrder so; const PG8_LAS unsigned char* tile_e; int nN;
    __device__ void init(int nM, int nN_, int G, int c, const PG8_LAS unsigned char* te) { so.nM = nM; so.nN = nN_; so.nwg = nM * nN_; so.G = G; so.c = c; tile_e = te; nN = nN_; }
    __device__ bool next(int i, Unit& u) const { if (!so.next(i, u)) return false; u.pm = so.nM - 1 - u.pm; u.pn += (int)tile_e[u.pm] * nN; return true; }
};


struct MoeOrderG : OrderBase {
    static constexpr bool GATHER = true;
    StaticOrder so; const PG8_LAS unsigned char* tile_e; const PG8_LAS int* tstart; const PG8_LAS int* cnt; const unsigned* list; PG8_LAS unsigned* gslot; int nN;
    __device__ void init(int nM, int nN_, int G, int c, const PG8_LAS unsigned char* te, const PG8_LAS int* ts, const PG8_LAS int* cn, const unsigned* li, PG8_LAS unsigned* gs) {
        so.nM = nM; so.nN = nN_; so.nwg = nM * nN_; so.G = G; so.c = c; tile_e = te; tstart = ts; cnt = cn; list = li; gslot = gs; nN = nN_; }
    __device__ bool next(int i, Unit& u) const { if (!so.next(i, u)) return false; u.pn += (int)tile_e[u.pm] * nN; return true; }
    __device__ __forceinline__ const char* a_base(const Gemm& g, const Unit&) const { return (const char*)g.A; }
    __device__ __forceinline__ const unsigned* rows(const Unit& u) const { const int e = u.pn / nN; return list + (size_t)e * 32768 + (size_t)(u.pm - tstart[e]) * 256; }
    __device__ __forceinline__ int nvalid(const Unit& u) const { const int e = u.pn / nN; return cnt[e] - (u.pm - tstart[e]) * 256; }
};
struct OrderX1 : OrderBase {
    StaticOrder so;
    __device__ void init(int G, int c) { so.nM = 128; so.nN = 4; so.nwg = 512; so.G = G; so.c = c; }
    __device__ bool next(int i, Unit& u) const { return so.next(i, u); }
    __device__ __forceinline__ const char* a_base(const Gemm& g, const Unit& u) const { return (const char*)(g.A + (size_t)u.pm * 256 * 1024 + u.pn * 256); }
    __device__ __forceinline__ const char* b_base(const Gemm& g, const Unit& u) const { return (const char*)(g.Bt + (size_t)(u.pm >> 3) * 256 * 1024 + u.pn * 256); }
};
struct OrderX2 : OrderBase {
    StaticOrder so;
    __device__ void init(int G, int c) { so.nM = 128; so.nN = 4; so.nwg = 512; so.G = G; so.c = c; }
    __device__ bool next(int i, Unit& u) const { return so.next(i, u); }
    __device__ __forceinline__ const char* a_base(const Gemm& g, const Unit& u) const { return (const char*)(g.A + (size_t)u.pm * 256 * 1024 + u.pn * 256); }
    __device__ __forceinline__ const char* b_base(const Gemm& g, const Unit& u) const { return (const char*)(g.Bt + (size_t)u.pn * 256 * 4096 + (u.pm >> 3) * 256); }
};
struct EpiSoftmax {
    static constexpr bool PERM = true, AFTER_DRAIN = false;
    bf16_t* PX; float* lp; PG8_LAS float* xch;
    __device__ __forceinline__ void operator()(const f32x4 (&acc)[2][2][4][2], const Unit& u, int wr, int wc, int fr, int fq) const {
        PG8_LAS char* rb = (PG8_LAS char*)xch + (wr * 64 + fr) * 16; asm volatile("" : "+v"(rb));
        PG8_LAS char* wb = rb + wc * 4; asm volatile("" : "+v"(wb));
        EPI_ROWS { float a = -INFINITY;
            EPI_COLS { const f32x4 v = acc[ai][bj][m][n]; a = fmaxf(a, fmaxf(fmaxf(v[0], v[1]), fmaxf(v[2], v[3]))); }
            a = fmaxf(a, __shfl_xor(a, 16)); a = fmaxf(a, __shfl_xor(a, 32));
            if (fq == 0) *(PG8_LAS float*)(wb + (ai * 128 + m * 16) * 16) = a; }
        asm volatile("s_waitcnt lgkmcnt(0)" ::: "memory"); __builtin_amdgcn_s_barrier(); asm volatile("" ::: "memory");
        const int row0 = u.pm * 256 + wr * 64 + fr; bf16_t* rp0 = PX + (size_t)row0 * 1024 + u.pn * 256 + wc * 32 + fq * 8; float* lp0 = lp + (size_t)row0 * 16 + u.pn * 4 + wc;
        EPI_ROWS { const f32x4 q = *(const PG8_LAS f32x4*)(rb + (ai * 128 + m * 16) * 16); const float mr = fmaxf(fmaxf(q[0], q[1]), fmaxf(q[2], q[3]));
            bf16_t* rp = rp0 + (size_t)(ai * 128 + m * 16) * 1024; float ps = 0.f;
            _Pragma("unroll") for (int bj = 0; bj < 2; ++bj) { f32x4 p[2];
                _Pragma("unroll") for (int n = 0; n < 2; ++n) _Pragma("unroll") for (int i = 0; i < 4; ++i) { p[n][i] = __builtin_amdgcn_exp2f(acc[ai][bj][m][n][i] - mr); ps += p[n][i]; }
                st_bf8(rp + bj * 128, p[0], p[1]); }
            ps += __shfl_xor(ps, 16); ps += __shfl_xor(ps, 32);
            if (fq == 0) lp0[(ai * 128 + m * 16) * 16] = ps; }
        asm volatile("s_waitcnt lgkmcnt(0)" ::: "memory"); __builtin_amdgcn_s_barrier(); asm volatile("" ::: "memory");
    }
};
struct EpiPV {
    static constexpr bool PERM = true, AFTER_DRAIN = false;
    bf16_t* O; const float* lp;
    __device__ __forceinline__ void operator()(const f32x4 (&acc)[2][2][4][2], const Unit& u, int wr, int wc, int fr, int fq) const {
        EPI_ROWS { const int row = u.pm * 256 + ai * 128 + wr * 64 + m * 16 + fr; const f32x4 q = *(const f32x4*)(lp + (size_t)row * 16 + u.pn * 4);
            const float inv = 1.0f / ((q[0] + q[1]) + (q[2] + q[3])); bf16_t* rp = O + (size_t)row * 1024 + u.pn * 256 + wc * 32 + fq * 8;
            _Pragma("unroll") for (int bj = 0; bj < 2; ++bj) st_bf8(rp + bj * 128, acc[ai][bj][m][0] * inv, acc[ai][bj][m][1] * inv); }
    }
};

template <unsigned oKX, unsigned oWCQR, unsigned oWCOT, unsigned oVX>
struct OrderGH : OrderBase {
    int G, c; const char* ws;
    __device__ __forceinline__ bool next(int i, Unit& u) const { int L = i * G + c; if (L >= 512) return false;
        if (L < 256) { u.pm = L >> 2; u.pn = L & 3; } else { L -= 256; u.pm = L >> 2; u.pn = (L & 3) | (1 << 16); } return true; }
    __device__ __forceinline__ const char* a_base(const Gemm&, const Unit& u) const { const int job = u.pn >> 16, pn = u.pn & 0xffff;
        return job == 0 ? ws + oKX + ((size_t)(u.pm >> 2) * 256 * 1024 + (u.pm & 3) * 256) * 2 : ws + oWCOT + ((size_t)(u.pm & 3) * 256 * 1024 + pn * 256) * 2; }
    __device__ __forceinline__ const char* b_base(const Gemm&, const Unit& u) const { const int job = u.pn >> 16, pn = u.pn & 0xffff;
        return job == 0 ? ws + oWCQR + ((size_t)pn * 256 * 1024 + (u.pm & 3) * 256) * 2 : ws + oVX + ((size_t)(u.pm >> 2) * 256 * 1024 + pn * 256) * 2; }
};
struct EpiGH {
    static constexpr bool PERM = true, AFTER_DRAIN = false;
    EpiPlain gt, ht;
    __device__ __forceinline__ void operator()(const f32x4 (&acc)[2][2][4][2], const Unit& u, int wr, int wc, int fr, int fq) const {
        Unit v; v.pm = u.pm; v.pn = u.pn & 0xffff; if ((u.pn >> 16) == 0) gt(acc, v, wr, wc, fr, fq); else ht(acc, v, wr, wc, fr, fq); }
};
struct OrderXS : OrderBase {
    StaticOrder so;
    __device__ void init(int G, int c) { so.nM = 128; so.nN = 4; so.nwg = 512; so.G = G; so.c = c; }
    __device__ bool next(int i, Unit& u) const { return so.next(i, u); }
    __device__ __forceinline__ const char* b_base(const Gemm& g, const Unit& u) const { return (const char*)(g.Bt + ((size_t)(u.pm >> 3) * 1024 + u.pn * 256) * 1024); }
};
struct EpiSoftmaxN {
    static constexpr bool PERM = true, AFTER_DRAIN = false;
    bf16_t* PX; const float* ssp; PG8_LAS float* xmax; PG8_LAS float* xsum;
    __device__ __forceinline__ void operator()(f32x4 (&acc)[2][2][4][2], const Unit& u, int wr, int wc, int fr, int fq) const {
        PG8_LAS char* rb = (PG8_LAS char*)xmax + (wr * 64 + fr) * 16; asm volatile("" : "+v"(rb));
        PG8_LAS char* wb = rb + wc * 4; asm volatile("" : "+v"(wb));
        PG8_LAS char* rb2 = (PG8_LAS char*)xsum + (wr * 64 + fr) * 16; asm volatile("" : "+v"(rb2));
        PG8_LAS char* wb2 = rb2 + wc * 4; asm volatile("" : "+v"(wb2));
        const int row0 = u.pm * 256 + wr * 64 + fr;
        f32x4 sq[2][4];
        _Pragma("unroll") for (int ai = 0; ai < 2; ++ai) _Pragma("unroll") for (int w4 = 0; w4 < 4; ++w4) sq[ai][w4] = *(const f32x4*)(ssp + ((((((size_t)u.pm * 4 + fq) * 4 + w4) * 2 + ai) * 2 + wr) * 16 + fr) * 4);
        f32x4 st[2];
        _Pragma("unroll") for (int ai = 0; ai < 2; ++ai) { st[ai] = (sq[ai][0] + sq[ai][1]) + (sq[ai][2] + sq[ai][3]);
            _Pragma("unroll") for (int i = 0; i < 4; ++i) { float t = st[ai][i]; t += __shfl_xor(t, 16); t += __shfl_xor(t, 32); st[ai][i] = t; } }
        float mloc[2][4];
        EPI_ROWS { const float ss = st[ai][m];
            const float rs = rsqrtf(ss * (1.0f / 1024.0f) + 1e-6f) * QSCALE_X; float a = -INFINITY;
            EPI_COLS { f32x4 v = acc[ai][bj][m][n] * rs; acc[ai][bj][m][n] = v; a = fmaxf(a, fmaxf(fmaxf(v[0], v[1]), fmaxf(v[2], v[3]))); }
            a = fmaxf(a, __shfl_xor(a, 16)); a = fmaxf(a, __shfl_xor(a, 32)); mloc[ai][m] = a; float ps = 0.f;
            EPI_COLS { f32x4 p; _Pragma("unroll") for (int i = 0; i < 4; ++i) { p[i] = __builtin_amdgcn_exp2f(acc[ai][bj][m][n][i] - a); ps += p[i]; } acc[ai][bj][m][n] = p; }
            ps += __shfl_xor(ps, 16); ps += __shfl_xor(ps, 32);
            if (fq == 0) { *(PG8_LAS float*)(wb + (ai * 128 + m * 16) * 16) = a; *(PG8_LAS float*)(wb2 + (ai * 128 + m * 16) * 16) = ps; } }
        asm volatile("s_waitcnt lgkmcnt(0)" ::: "memory"); __builtin_amdgcn_s_barrier(); asm volatile("" ::: "memory");
        bf16_t* rp0 = PX + (size_t)row0 * 1024 + u.pn * 256 + wc * 32 + fq * 8;
        EPI_ROWS { const f32x4 qm = *(const PG8_LAS f32x4*)(rb + (ai * 128 + m * 16) * 16), qs = *(const PG8_LAS f32x4*)(rb2 + (ai * 128 + m * 16) * 16);
            const float M = fmaxf(fmaxf(qm[0], qm[1]), fmaxf(qm[2], qm[3]));
            const float S = (qs[0] * __builtin_amdgcn_exp2f(qm[0] - M) + qs[1] * __builtin_amdgcn_exp2f(qm[1] - M)) + (qs[2] * __builtin_amdgcn_exp2f(qm[2] - M) + qs[3] * __builtin_amdgcn_exp2f(qm[3] - M));
            const float inv = __builtin_amdgcn_exp2f(mloc[ai][m] - M) * __builtin_amdgcn_rcpf(S);
            bf16_t* rp = rp0 + (size_t)(ai * 128 + m * 16) * 1024;
            _Pragma("unroll") for (int bj = 0; bj < 2; ++bj) st_bf8(rp + bj * 128, acc[ai][bj][m][0] * inv, acc[ai][bj][m][1] * inv); }
    }
};
struct OrderXO : OrderBase {
    StaticOrder so;
    __device__ void init(int G, int c) { so.nM = 128; so.nN = 4; so.nwg = 512; so.G = G; so.c = c; }
    __device__ bool next(int i, Unit& u) const { return so.next(i, u); }
    __device__ __forceinline__ const char* b_base(const Gemm& g, const Unit& u) const { return (const char*)(g.Bt + ((size_t)(u.pm >> 3) * 1024 + u.pn * 256) * 1024); }
};
typedef int v4i_t __attribute__((ext_vector_type(4))); typedef int v8i_t __attribute__((ext_vector_type(8)));
__device__ __forceinline__ v8i_t cat8(bf16x8 lo, bf16x8 hi) { return __builtin_shufflevector(__builtin_bit_cast(v4i_t, lo), __builtin_bit_cast(v4i_t, hi), 0, 1, 2, 3, 4, 5, 6, 7); }
__device__ __forceinline__ void mfma8(f32x4& acc, v8i_t w, v8i_t a, int sw, int sa) {
    asm volatile("s_nop 1\n\tv_mfma_scale_f32_16x16x128_f8f6f4 %0, %1, %2, %0, %3, %4 op_sel_hi:[0,0,0]" : "+v"(acc) : "v"(w), "v"(a), "v"(sw), "v"(sa)); }
constexpr int PF_D = 4, PF_LDS = 137216;
template <class Epi, class Sched, bool ALIGN_EPI = false, bool SP2 = false, bool FP8 = false, bool PF = false, int DBG = 0>
__device__ __forceinline__ void gemm_phase(PG8_LAS unsigned char* lds, const Gemm g, const Sched& S, const Epi& E) {
    const int tid = threadIdx.x, wid = __builtin_amdgcn_readfirstlane(tid >> 6), lane = tid & 63, wr = wid >> 2, wc = wid & 3, fr = lane & 15, fq = lane >> 4;
    const int K = g.K, nt = K / BK;
    unsigned voffA[2], voffB[2];
    unsigned gC[2][2];
#pragma unroll
    for (int i = 0; i < 2; ++i) { int R, C; stage_rc(tid * 16 + i * 8192, R, C); const int Rb = Epi::PERM ? ((R & ~31) + perm32(R & 31)) : R;
        voffA[i] = (unsigned)(R * g.lda + C) * 2u; voffB[i] = (unsigned)(Rb * g.ldb + C) * 2u; }
    const bool pfA = !Sched::GATHER && wid < 4;
    const unsigned pfoff = (unsigned)((((wid >> 1) & 1) * HALF + (wid & 1) * 64 + lane) * (pfA ? g.lda : g.ldb)) * 2u;
    const size_t kstep = (size_t)(BK * 2);
    const size_t hstepA = (size_t)HALF * g.lda * 2, hstepB = (size_t)HALF * g.ldb * 2;
    const unsigned ldsw = (unsigned)wid * 1024u;
    const int aoff = lds_byte(wr * 64 + fr, fq * 8), boff = lds_byte(wc * 32 + fr, fq * 8);
#define PG8_SA(b, h) (((b) * 2 + (h)) * HTB)
#define PG8_SB(b, h) ((4 + (b) * 2 + (h)) * HTB)
#define PG8_STAGE(bufoff, gbase, voff) do { if constexpr ((DBG & 2) == 0) _Pragma("unroll") for (int _i = 0; _i < 2; ++_i) \
        __builtin_amdgcn_global_load_lds((const unsigned*)((const char*)(gbase) + (voff)[_i]), (PG8_LAS unsigned*)(lds + (bufoff) + ldsw + _i * 8192), 16, 0, 0); } while (0)
#define PG8_STAGE_A(bufoff, ptr, h, nx) do { if constexpr (Sched::GATHER) { PG8_STAGE(bufoff, ptr, gC[h]); } else { PG8_STAGE(bufoff, (ptr) + ((h) ? hstepA : 0), voffA); } } while (0)
#define PG8_LDA(dst, b, h) do { if constexpr ((DBG & 8) == 0) _Pragma("unroll") for (int m = 0; m < 4; ++m) _Pragma("unroll") for (int k = 0; k < 2; ++k) dst[m][k] = *(const PG8_LAS bf16x8*)(lds + PG8_SA(b, h) + aoff + m * 2048 + k * 1024); } while (0)
#define PG8_LDB(dst, b, h) do { if constexpr ((DBG & 8) == 0) _Pragma("unroll") for (int n = 0; n < 2; ++n) _Pragma("unroll") for (int k = 0; k < 2; ++k) dst[n][k] = *(const PG8_LAS bf16x8*)(lds + PG8_SB(b, h) + boff + n * 2048 + k * 1024); } while (0)
#define PG8_MMA(ai, bj, At, Bt) do { if constexpr ((DBG & 1) == 0) { __builtin_amdgcn_s_setprio(1); \
        if constexpr (FP8) { _Pragma("unroll") for (int m = 0; m < 4; ++m) _Pragma("unroll") for (int n = 0; n < 2; ++n) \
            mfma8(acc[ai][bj][m][n], cat8(Bt[n][0], Bt[n][1]), cat8(At[m][0], At[m][1]), g.sb, g.sa); } \
        else { _Pragma("unroll") for (int m = 0; m < 4; ++m) _Pragma("unroll") for (int n = 0; n < 2; ++n) _Pragma("unroll") for (int k = 0; k < 2; ++k) \
            acc[ai][bj][m][n] = __builtin_amdgcn_mfma_f32_16x16x32_bf16(Bt[n][k], At[m][k], acc[ai][bj][m][n], 0, 0, 0); } \
        __builtin_amdgcn_s_setprio(0); } } while (0)
#define PG8_WAIT_V(n) asm volatile("s_waitcnt vmcnt(" #n ")" ::: "memory")
#define PG8_WAIT_VP() do { if constexpr (PF) asm volatile("s_waitcnt vmcnt(9)" ::: "memory"); else asm volatile("s_waitcnt vmcnt(8)" ::: "memory"); } while (0)
#define PG8_PREFETCH(tp) do { if constexpr (PF) { const int tp_ = (tp); const char* pb_ = tp_ < nt ? (pfA ? cA : cB) + (size_t)tp_ * kstep : (pfA ? nA : nB) + (size_t)(tp_ - nt) * kstep; \
        __builtin_amdgcn_global_load_lds((const unsigned*)(pb_ + pfoff), (PG8_LAS unsigned*)(lds + PF_LDS + wid * 256), 4, 0, 0); } } while (0)
#define PG8_WAIT_L(n) asm volatile("s_waitcnt lgkmcnt(" #n ")" ::: "memory")
#define PG8_BAR __builtin_amdgcn_s_barrier()
#define PG8_SCHED __builtin_amdgcn_sched_barrier(0)
    Unit cur, nxt; int ui = 0;
    if (!S.next(0, cur)) return;
    f32x4 acc[2][2][4][2];
#pragma unroll
    for (int a = 0; a < 2; ++a)
#pragma unroll
        for (int b = 0; b < 2; ++b)
#pragma unroll
            for (int m = 0; m < 4; ++m)
#pragma unroll
                for (int n = 0; n < 2; ++n) acc[a][b][m][n] = (f32x4){0.f, 0.f, 0.f, 0.f};
    bf16x8 At[4][2], B0[2][2], B1[2][2];
    const char* cA = S.a_base(g, cur); const char* cB = S.b_base(g, cur);
    if constexpr (Sched::GATHER) { const unsigned* rp = S.rows(cur); const int nv = S.nvalid(cur);
#pragma unroll
        for (int h = 0; h < 2; ++h)
#pragma unroll
            for (int i = 0; i < 2; ++i) { int R, C; stage_rc(tid * 16 + i * 8192, R, C); const int r = h * HALF + R; const unsigned tok = r < nv ? rp[r] : 0u; gC[h][i] = tok * (unsigned)(g.lda * 2) + (unsigned)C * 2u; } }
    constexpr bool LO = epi_ldsops<Epi>::value; int us = 0;
    if constexpr (LO) E.prefetch(cur, 0, wid, lane);
    S.a_ready(cur);
    if constexpr (SP2) {
        PG8_STAGE(PG8_SB(0, 0), cB, voffB); PG8_STAGE(PG8_SB(0, 1), cB + hstepB, voffB); PG8_STAGE_A(PG8_SA(0, 0), cA, 0, 0); PG8_STAGE_A(PG8_SA(0, 1), cA, 1, 0);
        if (wr == 1) PG8_BAR;
        PG8_WAIT_V(2); PG8_BAR;
        PG8_STAGE(PG8_SB(1, 0), cB + kstep, voffB); PG8_STAGE_A(PG8_SA(1, 0), cA + kstep, 0, 0); PG8_STAGE(PG8_SB(1, 1), cB + hstepB + kstep, voffB);
        PG8_WAIT_V(6); PG8_BAR;
    } else {
        PG8_STAGE(PG8_SB(0, 0), cB, voffB); PG8_STAGE_A(PG8_SA(0, 0), cA, 0, 0); PG8_STAGE(PG8_SB(0, 1), cB + hstepB, voffB); PG8_STAGE_A(PG8_SA(0, 1), cA, 1, 0);
        if (wr == 1) PG8_BAR;
        PG8_WAIT_V(4); PG8_BAR;
        PG8_STAGE(PG8_SB(1, 0), cB + kstep, voffB); PG8_STAGE_A(PG8_SA(1, 0), cA + kstep, 0, 0); PG8_STAGE(PG8_SB(1, 1), cB + hstepB + kstep, voffB);
        PG8_WAIT_V(6); PG8_BAR;
    }
    for (;;) {
        const bool has_next = S.next(ui + 1, nxt);
        const char* nA = has_next ? S.a_base(g, nxt) : cA; const char* nB = has_next ? S.b_base(g, nxt) : cB;
        if constexpr (LO) { if (has_next) E.prefetch(nxt, us == 2 ? 0 : us + 1, wid, lane); }
        if constexpr (Sched::GATHER) { if (has_next && wid < 4)
            __builtin_amdgcn_global_load_lds((const unsigned*)(S.rows(nxt) + wid * 64 + lane), (PG8_LAS unsigned*)(S.gslot + ((ui + 1) & 1) * 256 + wid * 64), 4, 0, 0); }
#pragma nounroll
        for (int t = 0; t < nt; t += 2) {
            const bool last = (t == nt - 2);
            const char* a1 = cA + (size_t)(t + 1) * kstep;
            const char* a2 = last ? nA : cA + (size_t)(t + 2) * kstep; const char* b2 = last ? nB : cB + (size_t)(t + 2) * kstep;
            const char* a3 = a2 + kstep; const char* b3 = b2 + kstep;
            if (last && has_next) S.a_ready(nxt);
            if constexpr (SP2) {
            PG8_LDB(B0, 0, 0); PG8_LDB(B1, 0, 1); PG8_SCHED; PG8_LDA(At, 0, 0); PG8_STAGE_A(PG8_SA(1, 1), a1, 1, 0);
            if constexpr (Sched::GATHER) { if (last && has_next) {
                const PG8_LAS unsigned* sl = S.gslot + ((ui + 1) & 1) * 256; const int nv = S.nvalid(nxt);
#pragma unroll
                for (int h = 0; h < 2; ++h)
#pragma unroll
                    for (int i = 0; i < 2; ++i) { int R, C; stage_rc(tid * 16 + i * 8192, R, C); const int r = h * HALF + R; const unsigned v = sl[r]; const unsigned tok = r < nv ? v : 0u; gC[h][i] = tok * (unsigned)(g.lda * 2) + (unsigned)C * 2u; } } }
            PG8_WAIT_VP(); PG8_WAIT_L(0); PG8_BAR; PG8_MMA(0, 0, At, B0); PG8_MMA(0, 1, At, B1); PG8_BAR; PG8_SCHED;
            PG8_LDA(At, 0, 1); PG8_STAGE(PG8_SB(0, 0), b2, voffB); PG8_STAGE(PG8_SB(0, 1), b2 + hstepB, voffB); PG8_STAGE_A(PG8_SA(0, 0), a2, 0, 1); PG8_PREFETCH(t + PF_D);
            PG8_WAIT_VP(); PG8_WAIT_L(0); PG8_BAR; PG8_MMA(1, 0, At, B0); PG8_MMA(1, 1, At, B1); PG8_BAR; PG8_SCHED;
            PG8_LDB(B0, 1, 0); PG8_LDB(B1, 1, 1); PG8_SCHED; PG8_LDA(At, 1, 0); PG8_STAGE_A(PG8_SA(0, 1), a2, 1, 1);
            PG8_WAIT_VP(); PG8_WAIT_L(0); PG8_BAR; PG8_MMA(0, 0, At, B0); PG8_MMA(0, 1, At, B1); PG8_BAR; PG8_SCHED;
            PG8_LDA(At, 1, 1); PG8_STAGE(PG8_SB(1, 0), b3, voffB); PG8_STAGE(PG8_SB(1, 1), b3 + hstepB, voffB); PG8_STAGE_A(PG8_SA(1, 0), a3, 0, 1); PG8_PREFETCH(t + 1 + PF_D);
            PG8_WAIT_VP(); PG8_WAIT_L(0); PG8_BAR; PG8_MMA(1, 0, At, B0); PG8_MMA(1, 1, At, B1); PG8_BAR; PG8_SCHED;
            } else {
            PG8_LDB(B0, 0, 0); PG8_SCHED; PG8_LDA(At, 0, 0); PG8_STAGE_A(PG8_SA(1, 1), a1, 1, 0);
            PG8_WAIT_L(8); PG8_BAR; PG8_WAIT_L(0); PG8_MMA(0, 0, At, B0); PG8_BAR; PG8_SCHED;
            PG8_LDB(B1, 0, 1); PG8_STAGE(PG8_SB(0, 0), b2, voffB);
            PG8_BAR; PG8_WAIT_L(0); PG8_MMA(0, 1, At, B1); PG8_BAR;
            PG8_LDA(At, 0, 1); PG8_STAGE_A(PG8_SA(0, 0), a2, 0, 1);
            PG8_BAR; PG8_WAIT_L(0); PG8_MMA(1, 0, At, B0); PG8_BAR; PG8_SCHED;
            PG8_STAGE(PG8_SB(0, 1), b2 + hstepB, voffB);
            PG8_WAIT_V(6); PG8_BAR; PG8_MMA(1, 1, At, B1); PG8_BAR;
            PG8_LDB(B0, 1, 0); PG8_SCHED; PG8_LDA(At, 1, 0); PG8_STAGE_A(PG8_SA(0, 1), a2, 1, 1);
            PG8_WAIT_L(8); PG8_BAR; PG8_WAIT_L(0); PG8_MMA(0, 0, At, B0); PG8_BAR; PG8_SCHED;
            PG8_LDB(B1, 1, 1); PG8_STAGE(PG8_SB(1, 0), b3, voffB);
            PG8_BAR; PG8_WAIT_L(0); PG8_MMA(0, 1, At, B1); PG8_BAR;
            PG8_LDA(At, 1, 1); PG8_STAGE_A(PG8_SA(1, 0), a3, 0, 1);
            PG8_BAR; PG8_WAIT_L(0); PG8_MMA(1, 0, At, B0); PG8_BAR; PG8_SCHED;
            PG8_STAGE(PG8_SB(1, 1), b3 + hstepB, voffB);
            PG8_WAIT_V(6); PG8_BAR; PG8_MMA(1, 1, At, B1); PG8_BAR;
            }
        }
        if constexpr (ALIGN_EPI) { if (wr == 0) PG8_BAR; }
        if constexpr (FP8) asm volatile("s_nop 15\n\ts_nop 15" ::: "memory");
        if constexpr (!Epi::AFTER_DRAIN && (DBG & 4) == 0) { if constexpr (LO) E(acc, cur, wr, wc, fr, fq, us); else E(acc, cur, wr, wc, fr, fq); S.done(cur); }
        if (!has_next) break;
#pragma unroll
        for (int a = 0; a < 2; ++a)
#pragma unroll
            for (int b = 0; b < 2; ++b)
#pragma unroll
                for (int m = 0; m < 4; ++m)
#pragma unroll
                    for (int n = 0; n < 2; ++n) acc[a][b][m][n] = (f32x4){0.f, 0.f, 0.f, 0.f};
        cur = nxt; cA = nA; cB = nB; ++ui; us = us == 2 ? 0 : us + 1;
        if constexpr (ALIGN_EPI) { if (wr == 1) PG8_BAR; }
    }
    PG8_WAIT_V(0);
    if constexpr (!ALIGN_EPI) { if (wr == 0) PG8_BAR; }
    PG8_BAR;
    if constexpr (Epi::AFTER_DRAIN) { E.fused(acc, cur, wr, wc, fr, fq, lds, wid, lane); S.done(cur); }
#undef PG8_SA
#undef PG8_SB
#undef PG8_STAGE
#undef PG8_STAGE_A
#undef PG8_LDA
#undef PG8_LDB
#undef PG8_MMA
#undef PG8_WAIT_V
#undef PG8_WAIT_VP
#undef PG8_PREFETCH
#undef PG8_WAIT_L
#undef PG8_BAR
#undef PG8_SCHED
}
}
constexpr int NTOK = 32768, DM = 1024, SEQ = 2048, NBATCH = 16, MEMLEN = 256, NMEM = NBATCH * MEMLEN, INW = 3088, NEXP = 32, TOPK = 4;
constexpr int PW = 3072;
constexpr int MAXTILES = 544;
constexpr float EPS = 1e-6f;
constexpr int NWAVES = 8;
constexpr size_t MiB = 1u << 20;
constexpr size_t WS_CTL = 0, CTL_ZERO_BYTES = 64 * 1024;
constexpr size_t WS_WINT = 2 * MiB, WS_WOUT = 10 * MiB, WS_WCQ = 12 * MiB, WS_WCK = 14 * MiB, WS_WCV = 16 * MiB, WS_WCO = 18 * MiB;
constexpr size_t WS_WR = 20 * MiB, WS_CS = 21 * MiB, WS_SSP1 = 24 * MiB, WS_GATE = 27 * MiB, WS_ASSIGN = 28 * MiB, WS_LIST = 29 * MiB;
constexpr size_t WS_RSX = 26 * MiB;
constexpr size_t WS_RSL = 842 * MiB;
constexpr size_t WS_X2B = 378 * MiB;
constexpr size_t WS_WUP = 34 * MiB, WS_WDN = 162 * MiB, WS_KX = 226 * MiB, WS_VXT = 234 * MiB;
constexpr size_t WS_HN = 242 * MiB, WS_CAT = 706 * MiB  , WS_MN = 306 * MiB, WS_P = 314 * MiB, WS_LA = 506 * MiB, WS_VT = 538 * MiB;
constexpr size_t WS_X1B = 314 * MiB, WS_GT = 378 * MiB, WS_HT = 410 * MiB, WS_PX = 506 * MiB;
constexpr size_t WS_GVT = 602 * MiB;
constexpr size_t WS_ACT = 570 * MiB, WS_Y = 706 * MiB, WS_END = 846 * MiB;
constexpr int CW_Q2 = 128;
constexpr int CW_CNT = 1024;
constexpr int CW_PROBE = 192;
constexpr int CW_BAR = 4096;
constexpr int RING_OFF = 0, RING_BYTES = 131072;
constexpr int LDSCTL_OFF = RING_BYTES, MISC_OFF = LDSCTL_OFF + 320;
constexpr int TAB_OFF = LDSCTL_OFF + 512;
constexpr int TAB_TSTART = TAB_OFF + 576, TAB_CNT = TAB_TSTART + 144;
constexpr int XCH2_OFF = LDSCTL_OFF + 6144;
constexpr int XCH_OFF = LDSCTL_OFF + 2048;
constexpr int TS_OFF = TAB_CNT + 128;
constexpr int EOP_OFF = LDSCTL_OFF + 10240;
constexpr int LDS_BYTES = 147456;

#define GAS __attribute__((address_space(1)))
#define LAS __attribute__((address_space(3)))
typedef unsigned short bf16;
typedef unsigned v4u __attribute__((ext_vector_type(4)));
typedef float f32x4 __attribute__((ext_vector_type(4)));
typedef short bf16x8 __attribute__((ext_vector_type(8)));
typedef GAS unsigned gu32;
typedef GAS unsigned long long gu64;
#define RLX_AGENT __ATOMIC_RELAXED, __HIP_MEMORY_SCOPE_AGENT
#define LDS_WAIT() asm volatile("s_waitcnt lgkmcnt(0)" ::: "memory")
#define VM_WAIT() asm volatile("s_waitcnt vmcnt(0)" ::: "memory")
__device__ __forceinline__ unsigned long long rt() { return __builtin_amdgcn_s_memrealtime(); }
__device__ __forceinline__ unsigned f2bf(float f) { unsigned u = __builtin_bit_cast(unsigned, f); return (u + 0x7fffu + ((u >> 16) & 1u)) >> 16; }
__device__ __forceinline__ unsigned pk2(float lo, float hi) { return f2bf(lo) | (f2bf(hi) << 16); }

#define XB_TMO      128
#define XB_XCNT(j)  (256  + 64 * (j))
#define XB_XSUB(j)  (1280 + 64 * (j))
#define XB_XGEN(j)  (2304 + 64 * (j))
#define XB_TOP      3328
#define XB_TOPGEN   3392
#define XCD_BAR_WORDS 3456
#define XB_SPIN_CAP (1u << 18)

__device__ __forceinline__ unsigned xb_ld(unsigned* p)              { return __hip_atomic_load(p, __ATOMIC_RELAXED, __HIP_MEMORY_SCOPE_AGENT); }
__device__ __forceinline__ unsigned xb_add(unsigned* p, unsigned v) { return __hip_atomic_fetch_add(p, v, __ATOMIC_RELAXED, __HIP_MEMORY_SCOPE_AGENT); }
__device__ __forceinline__ unsigned xb_xcc_id() { return (unsigned)__builtin_amdgcn_s_getreg((3 << 11) | 20) & 0xFu; }
#define XB_SPIN(cond, bar) do { unsigned _sp = 0; while (cond) { __builtin_amdgcn_s_sleep(1); \
    if ((++_sp & 255u) == 0u) { if (xb_ld(&(bar)[XB_TMO])) break; if (_sp > XB_SPIN_CAP) { atomicAdd(&(bar)[XB_TMO], 1u); break; } } } } while (0)

struct XcdBarrier {
    unsigned* bar; unsigned x;
    volatile LAS unsigned* st;
};

__device__ __forceinline__ XcdBarrier xcd_barrier_post(unsigned* bar, volatile LAS unsigned* st) {
    XcdBarrier b; b.bar = bar; b.x = xb_xcc_id(); b.st = st;
    if (threadIdx.x == 0) (void)xb_add(&bar[XB_XCNT(b.x)], 1u);
    return b;
}
__device__ __forceinline__ void xcd_barrier_complete(unsigned* bar, unsigned x, unsigned& nloc, unsigned& nx) {
    const unsigned G = gridDim.x * gridDim.y * gridDim.z;
    unsigned sum, cnt, mine, sp = 0u;
    for (;;) {
        sum = 0u; cnt = 0u; mine = 0u;
#pragma unroll
        for (unsigned j = 0; j < 16; ++j) { const unsigned c = xb_ld(&bar[XB_XCNT(j)]); sum += c; cnt += (c > 0u) ? 1u : 0u; mine = (j == x) ? c : mine; }
        if (sum == G) break;
        __builtin_amdgcn_s_sleep(1);
        if ((++sp & 255u) == 0u) { if (xb_ld(&bar[XB_TMO])) break; if (sp > XB_SPIN_CAP) { atomicAdd(&bar[XB_TMO], 1u); break; } }
    }
    nloc = mine > 0u ? mine : 1u; nx = cnt > 0u ? cnt : 1u;
}

__device__ __forceinline__ void xcd_barrier(const XcdBarrier& b) {
    asm volatile("s_waitcnt vmcnt(0)" ::: "memory");
    __syncthreads();
    if (threadIdx.x == 0) {
        unsigned* bar = b.bar;
        __builtin_amdgcn_s_waitcnt(0);
        unsigned nloc = b.st[0], nx = b.st[1];
        if (nloc == 0u) { xcd_barrier_complete(bar, b.x, nloc, nx); b.st[0] = nloc; b.st[1] = nx; }
        const unsigned old = xb_add(&bar[XB_XSUB(b.x)], 1u);
        const unsigned gen = old / nloc;
        if (old + 1u == (gen + 1u) * nloc) {
            __builtin_amdgcn_fence(__ATOMIC_RELEASE, "agent");
            asm volatile("s_waitcnt vmcnt(0)" ::: "memory");
            const unsigned og = xb_add(&bar[XB_TOP], 1u);
            const unsigned tg = og / nx;
            if (og + 1u == (tg + 1u) * nx) xb_add(&bar[XB_TOPGEN], 1u);
            else XB_SPIN(xb_ld(&bar[XB_TOPGEN]) == tg, bar);
            __builtin_amdgcn_fence(__ATOMIC_ACQUIRE, "agent");
            xb_add(&bar[XB_XGEN(b.x)], 1u);
            asm volatile("s_waitcnt vmcnt(0)" ::: "memory");
        } else {
            XB_SPIN(xb_ld(&bar[XB_XGEN(b.x)]) == gen, bar);
            __builtin_amdgcn_fence(__ATOMIC_ACQUIRE, "agent");
            asm volatile("s_waitcnt vmcnt(0)" ::: "memory");
        }
    }
    __syncthreads();
}
typedef short bf16x4 __attribute__((ext_vector_type(4)));
typedef unsigned v2u __attribute__((ext_vector_type(2)));
struct Frame {
    LAS unsigned char* lds;
    volatile LAS unsigned* MISC;
    gu32* ctl;
    int tid, lane, wave;
    int vcu, G;
    unsigned char* ws;
    float* out;
};
__device__ __forceinline__ int lane_here() { int t = (int)threadIdx.x; asm volatile("" : "+v"(t)); return t & 63; }
__device__ __forceinline__ float bf2f(bf16 b) { return __builtin_bit_cast(float, (unsigned)b << 16); }
__device__ __forceinline__ float wave_sum(float v) {
#pragma unroll
    for (int o = 1; o < 64; o <<= 1) v += __shfl_xor(v, o);
    return v;
}
__device__ __forceinline__ float xmax16(float m) { auto rr = __builtin_amdgcn_permlane16_swap(__float_as_uint(m), __float_as_uint(m), false, false); return fmaxf(__uint_as_float(rr[0]), __uint_as_float(rr[1])); }
__device__ __forceinline__ float xmax32(float m) { auto rr = __builtin_amdgcn_permlane32_swap(__float_as_uint(m), __float_as_uint(m), false, false); return fmaxf(__uint_as_float(rr[0]), __uint_as_float(rr[1])); }
template <int CTRL> __device__ __forceinline__ float dppz(float v) { return __int_as_float(__builtin_amdgcn_update_dpp(0, __float_as_int(v), CTRL, 0xf, 0xf, false)); }
__device__ __forceinline__ f32x4 mfma16(bf16x8 a, bf16x8 b, f32x4 c) { return __builtin_amdgcn_mfma_f32_16x16x32_bf16(a, b, c, 0, 0, 0); }

__device__ __forceinline__ void p0_transpose_item(const float* W, int ldw, const float* gain, bf16* WT, int K, int k0, int n0, size_t orow0, int lane) {
    const int n4 = lane & 15, kq = lane >> 4;
    const float* src = W + (size_t)(k0 + 16 * kq) * ldw + n0 + 4 * n4;
    f32x4 v[16];
#pragma unroll
    for (int i = 0; i < 16; ++i) v[i] = __builtin_nontemporal_load((const f32x4*)(src + (size_t)i * ldw));
    if (gain) { const f32x4* gp = (const f32x4*)(gain + k0 + 16 * kq);
#pragma unroll
        for (int q = 0; q < 4; ++q) { const f32x4 gq = gp[q];
#pragma unroll
            for (int r = 0; r < 4; ++r) v[4 * q + r] = v[4 * q + r] * gq[r]; } }
    bf16* dst = WT + (orow0 + 4 * n4) * (size_t)K + k0 + 16 * kq;
#pragma unroll
    for (int j = 0; j < 4; ++j) { v4u o0, o1;
        o0.x = pg8::cvtpk(v[0][j], v[1][j]); o0.y = pg8::cvtpk(v[2][j], v[3][j]); o0.z = pg8::cvtpk(v[4][j], v[5][j]); o0.w = pg8::cvtpk(v[6][j], v[7][j]);
        o1.x = pg8::cvtpk(v[8][j], v[9][j]); o1.y = pg8::cvtpk(v[10][j], v[11][j]); o1.z = pg8::cvtpk(v[12][j], v[13][j]); o1.w = pg8::cvtpk(v[14][j], v[15][j]);
        *(v4u*)(dst + (size_t)j * K) = o0; *(v4u*)(dst + (size_t)j * K + 8) = o1; }
}
__device__ __forceinline__ void p0_t8_load(f32x4 (&v)[16], const float* W, int ldw, int k0, int n0, int lane) {
    const int n4 = lane & 15, kq = lane >> 4;
    const float* src = W + (size_t)(k0 + 16 * kq) * ldw + n0 + 4 * n4;
#pragma unroll
    for (int i = 0; i < 16; ++i) v[i] = __builtin_nontemporal_load((const f32x4*)(src + (size_t)i * ldw));
}
__device__ __forceinline__ void p0_t8_store(f32x4 (&v)[16], const float* gain, unsigned char* WT, int K, int k0, size_t orow0, int lane) {
    const int n4 = lane & 15, kq = lane >> 4;
    { const f32x4* gp = (const f32x4*)(gain + k0 + 16 * kq);
#pragma unroll
        for (int q = 0; q < 4; ++q) { f32x4 gq = {32.f, 32.f, 32.f, 32.f}; if (gain) gq = gp[q] * 32.0f;
#pragma unroll
            for (int r = 0; r < 4; ++r) v[4 * q + r] = v[4 * q + r] * gq[r]; } }
    unsigned char* dst = WT + (orow0 + 4 * n4) * (size_t)K + k0 + 16 * kq;
#pragma unroll
    for (int j = 0; j < 4; ++j) { v4u o;
        o.x = pg8::cvt4_fp8((f32x4){v[0][j], v[1][j], v[2][j], v[3][j]}); o.y = pg8::cvt4_fp8((f32x4){v[4][j], v[5][j], v[6][j], v[7][j]});
        o.z = pg8::cvt4_fp8((f32x4){v[8][j], v[9][j], v[10][j], v[11][j]}); o.w = pg8::cvt4_fp8((f32x4){v[12][j], v[13][j], v[14][j], v[15][j]});
        *(v4u*)(dst + (size_t)j * K) = o; }
}
template <int NR> __device__ __forceinline__ void rms_rows_to_bf16(const float* const (&xrow)[NR], const float* g, bf16* const (&orow)[NR], int lane, float* rsout = nullptr) {
    f32x4 v[NR][4]; float s[NR];
#pragma unroll
    for (int r = 0; r < NR; ++r) { const f32x4* xr = (const f32x4*)xrow[r] + lane;
#pragma unroll
        for (int j = 0; j < 4; ++j) v[r][j] = __builtin_nontemporal_load(xr + 64 * j); }
    f32x4 gg[4];
#pragma unroll
    for (int j = 0; j < 4; ++j) gg[j] = g ? ((const f32x4*)g + lane)[64 * j] : (f32x4){1.f, 1.f, 1.f, 1.f};
#pragma unroll
    for (int r = 0; r < NR; ++r) { s[r] = 0.f;
#pragma unroll
        for (int j = 0; j < 4; ++j) s[r] += (v[r][j].x * v[r][j].x + v[r][j].y * v[r][j].y) + (v[r][j].z * v[r][j].z + v[r][j].w * v[r][j].w); }
    static_assert(NR % 2 == 0, "rows go out in pairs");
    float rsv[NR];
#pragma unroll
    for (int r = 0; r < NR; ++r) rsv[r] = rsqrtf(wave_sum(s[r]) * (1.0f / DM) + EPS);
    if (rsout) { float mine = rsv[0];
#pragma unroll
        for (int r = 1; r < NR; ++r) mine = lane == r ? rsv[r] : mine;
        if (lane < NR) rsout[lane] = mine; }
    const bool odd = (lane & 1) != 0;
#pragma unroll
    for (int r = 0; r < NR; r += 2) { v4u* o16 = (v4u*)(odd ? orow[r + 1] : orow[r]) + (lane >> 1);
#pragma unroll
        for (int j = 0; j < 4; ++j) {
            const unsigned a0 = pk2(v[r][j].x * rsv[r] * gg[j].x, v[r][j].y * rsv[r] * gg[j].y), a1 = pk2(v[r][j].z * rsv[r] * gg[j].z, v[r][j].w * rsv[r] * gg[j].w);
            const unsigned b0 = pk2(v[r + 1][j].x * rsv[r + 1] * gg[j].x, v[r + 1][j].y * rsv[r + 1] * gg[j].y), b1 = pk2(v[r + 1][j].z * rsv[r + 1] * gg[j].z, v[r + 1][j].w * rsv[r + 1] * gg[j].w);
            const unsigned q0 = (unsigned)__builtin_amdgcn_update_dpp(0, (int)(odd ? a0 : b0), 0xB1, 0xf, 0xf, true), q1 = (unsigned)__builtin_amdgcn_update_dpp(0, (int)(odd ? a1 : b1), 0xB1, 0xf, 0xf, true);
            v4u w; w.x = odd ? q0 : a0; w.y = odd ? q1 : a1; w.z = odd ? b0 : q0; w.w = odd ? b1 : q1;
            o16[32 * j] = w; } }
}
constexpr int MOE_I_UP = 32 * 16 * 32, MOE_I_DN = 32 * 16 * 16, MOE_UNITS = (MOE_I_UP + MOE_I_DN) / 64;
__device__ __forceinline__ void moe_convert_unit(int unit, const float* w_up, const float* w_down, const float* g_ffn, unsigned char* ws, int wave, int lane) {
    const bool up = unit * 64 < MOE_I_UP;
#pragma unroll 1
    for (int j = 0; j < 8; j += 2) { f32x4 va[16], vb[16]; int k0[2], n0[2]; size_t orow[2]; const float* W[2];
#pragma unroll
        for (int q = 0; q < 2; ++q) { int r = unit * 64 + (j + q) * 8 + wave;
            if (up) { const int e = r / (16 * 32); r -= e * (16 * 32); n0[q] = 64 * (r % 32); k0[q] = 64 * (r / 32);
                orow[q] = (size_t)e * 2048 + ((n0[q] & 1023) >> 7) * 256 + (n0[q] >> 10) * 128 + (n0[q] & 127); W[q] = w_up + (size_t)e * DM * 2048; }
            else { r -= MOE_I_UP; const int e = r / (16 * 16); r -= e * (16 * 16); n0[q] = 64 * (r % 16); k0[q] = 64 * (r / 16); orow[q] = (size_t)e * 1024 + n0[q]; W[q] = w_down + (size_t)e * DM * DM; } }
        p0_t8_load(va, W[0], up ? 2048 : DM, k0[0], n0[0], lane); p0_t8_load(vb, W[1], up ? 2048 : DM, k0[1], n0[1], lane);
        p0_t8_store(va, up ? g_ffn : nullptr, ws + (up ? WS_WUP : WS_WDN), DM, k0[0], orow[0], lane); p0_t8_store(vb, up ? g_ffn : nullptr, ws + (up ? WS_WUP : WS_WDN), DM, k0[1], orow[1], lane); }
}
struct In {
    const float *x, *mem; const int* positions; const float *norm_mix_g, *w_in, *lq1, *lk1, *lq2, *lk2, *diff_norm_g, *w_alpha2, *b_alpha, *gla_norm_g, *w_out, *norm_cross_g, *norm_mem_g,
        *w_cq, *w_ck, *w_cv, *w_co, *norm_ffn_g, *w_router, *b_router, *w_up, *b_up, *w_down, *b_down, *norm_final_g;
};
__device__ __forceinline__ void p0_prologue(Frame& F, const In& I) {
    const int lane = lane_here();
    unsigned char* ws = F.ws;
    if (F.wave < 4) {
        const int gwr = F.vcu * 4 + F.wave, NGWR = F.G * 4;
        for (int m = gwr * 8; m < NTOK; m += NGWR * 8) { const float* xr[8]; bf16* orw[8];
#pragma unroll
            for (int r = 0; r < 8; ++r) { xr[r] = I.x + (size_t)(m + r) * DM; orw[r] = (bf16*)(ws + WS_HN) + (size_t)(m + r) * DM; }
            rms_rows_to_bf16<8>(xr, nullptr, orw, lane, (float*)(ws + WS_RSX) + m); }
        for (int m = gwr * 8; m < NMEM; m += NGWR * 8) { const float* xr[8]; bf16* orw[8];
#pragma unroll
            for (int r = 0; r < 8; ++r) { xr[r] = I.mem + (size_t)(m + r) * DM; orw[r] = (bf16*)(ws + WS_MN) + (size_t)(m + r) * DM; }
            rms_rows_to_bf16<8>(xr, I.norm_mem_g, orw, lane); }
        return;
    }
    const int gw = F.vcu * 4 + (F.wave - 4), NGW = F.G * 4;
    const int gt = F.vcu * 256 + (F.tid - 256), NGT = F.G * 256;
    constexpr int I_IN = 16 * 48, I_SQ = 16 * 16;
    constexpr int NITEMS = I_IN + 4 * I_SQ;
    for (int it = gw; it < NITEMS; it += NGW) {
        int r = it;
        if (r < I_IN) { p0_transpose_item(I.w_in, INW, I.norm_mix_g, (bf16*)(ws + WS_WINT), DM, 64 * (r / 48), 64 * (r % 48), (size_t)64 * (r % 48), lane); continue; } r -= I_IN;
        { const int w = r / I_SQ; r -= w * I_SQ;
            const float* W = w == 0 ? I.w_out : w == 1 ? I.w_ck : w == 2 ? I.w_cv : I.w_co;
            bf16* WT = (bf16*)(ws + (w == 0 ? WS_WOUT : w == 1 ? WS_WCK : w == 2 ? WS_WCV : WS_WCO));
            p0_transpose_item(W, DM, nullptr, WT, DM, 64 * (r / 16), 64 * (r % 16), (size_t)64 * (r % 16), lane); }
    }
    for (int idx = gt; idx < DM * DM / 4; idx += NGT) { const f32x4 v = ((const f32x4*)I.w_cq)[idx] * I.norm_cross_g[idx >> 8];
        v2u o; o.x = pk2(v.x, v.y); o.y = pk2(v.z, v.w); ((v2u*)(ws + WS_WCQ))[idx] = o; }
    for (int idx = gt; idx < 256 * DM; idx += NGT) { const int j = idx >> 10, k = idx & 1023; const float* wr = I.w_in + (size_t)k * INW + 3072; float s = 0.f;
#pragma unroll
        for (int r = 0; r < 16; ++r) s += wr[r] * I.w_alpha2[r * 256 + j];
        ((bf16*)(ws + WS_WINT))[(size_t)(3072 + j) * DM + k] = (bf16)f2bf(s * I.norm_mix_g[k]); }
    for (int idx = gt; idx < DM * NEXP; idx += NGT) { const int e = idx >> 10, k = idx & 1023; const float w = I.w_router[k * NEXP + e] * I.norm_ffn_g[k];
        const unsigned h1 = f2bf(w); const float r1 = w - __builtin_bit_cast(float, h1 << 16); const unsigned h2 = f2bf(r1); const float r2 = r1 - __builtin_bit_cast(float, h2 << 16); const unsigned h3 = f2bf(r2);
        bf16* W3 = (bf16*)(ws + WS_WR); W3[idx] = (bf16)h1; W3[DM * NEXP + idx] = (bf16)h2; W3[2 * DM * NEXP + idx] = (bf16)h3; }
    for (int idx = gt; idx < NTOK * 8; idx += NGT) { const int tok = idx >> 3, i = idx & 7;
        const double inv = exp(-(double)i * 0.125 * 13.122363377404328); const double ang = (double)I.positions[tok] * inv;
        const double red = ang - rint(ang * 0.15915494309189535) * 6.283185307179586; const float rf = (float)red;
        unsigned short* cs = (unsigned short*)(ws + WS_CS) + (size_t)tok * 16; cs[i] = __builtin_bit_cast(unsigned short, (_Float16)cosf(rf)); cs[8 + i] = __builtin_bit_cast(unsigned short, (_Float16)sinf(rf)); }
}

constexpr int DA_KBUF = 16384, DA_VBUF = 16384, DA_VOFF = 2 * DA_KBUF;
template <int DBG = 0> __device__ __forceinline__ void diffattn_unit(Frame& F, const bf16* P, const bf16* VT, bf16* CAT, const float* gdiff, float lam, int b, int h, int qblk) {
    const int lane = lane_here(), wave = F.wave, tid = F.tid, l15 = lane & 15, g = lane >> 4;
    LAS unsigned char* lds = F.lds + RING_OFF;
    const int q0 = qblk * 128 + wave * 16;
    const size_t tokq = (size_t)b * SEQ + q0 + l15;
    bf16x8 qf[2][2];
#pragma unroll
    for (int c = 0; c < 2; ++c)
#pragma unroll
        for (int ks = 0; ks < 2; ++ks) qf[c][ks] = *(const bf16x8*)(P + tokq * PW + h * 128 + c * 64 + ks * 32 + g * 8);
    f32x4 o[2][8];
#pragma unroll
    for (int c = 0; c < 2; ++c)
#pragma unroll
        for (int k = 0; k < 8; ++k) o[c][k] = (f32x4){0.f, 0.f, 0.f, 0.f};
    float mrun[2] = {0.f, 0.f}, lsum[2] = {0.f, 0.f};
    const int nk = q0 + 16;
    const int nt = 2 * qblk + 2;
    const int skey = tid >> 4, sch = tid & 15, vrow = tid >> 3, vpc = tid & 7;
    const bf16* ksrc = P + ((size_t)b * SEQ + skey) * PW + 512 + h * 128 + sch * 8;
    const bf16* vsrc = VT + (size_t)(h * 128 + vrow) * NTOK + (size_t)b * SEQ + vpc * 8;
    const int kdst = skey * 256 + ((sch ^ ((((skey >> 3) & 3) << 2) | (skey & 3))) * 16);
    const int vdst = DA_VOFF + vrow * 128 + ((vpc ^ ((vrow >> 1) & 7)) * 16);
    int koff[2][2];
#pragma unroll
    for (int c = 0; c < 2; ++c)
#pragma unroll
        for (int ks = 0; ks < 2; ++ks) koff[c][ks] = (8 * (l15 >> 2) + (l15 & 3)) * 256 + (((c * 8 + ks * 4 + g) ^ l15) * 16);
    const int voffs[2] = {DA_VOFF + l15 * 128 + ((g ^ (l15 >> 1)) * 16), DA_VOFF + l15 * 128 + (((4 + g) ^ (l15 >> 1)) * 16)};
    v4u sk0, sk1, sv0, sv1;
#define DA_LOAD(tt) do { const bf16* kp_ = ksrc + (size_t)(tt) * 64 * PW; const bf16* vp_ = vsrc + (tt) * 64; \
        sk0 = *(const v4u*)kp_; sk1 = *(const v4u*)(kp_ + (size_t)32 * PW); sv0 = *(const v4u*)vp_; sv1 = *(const v4u*)(vp_ + (size_t)64 * NTOK); } while (0)
#define DA_STORE(bb) do { LAS unsigned char* kd_ = lds + (bb) * DA_KBUF + kdst; LAS unsigned char* vd_ = lds + (bb) * DA_VBUF; \
        *(LAS v4u*)kd_ = sk0; *(LAS v4u*)(kd_ + 8192) = sk1; \
        *(LAS v4u*)(vd_ + vdst) = sv0; *(LAS v4u*)(vd_ + vdst + 8192) = sv1; } while (0)
    DA_LOAD(0); DA_STORE(0);
    __syncthreads();
    auto step = [&](const int t, const int buf) __attribute__((always_inline)) {
        if (t * 64 < nk) {
            const LAS unsigned char* kb = lds + buf * DA_KBUF; const LAS unsigned char* vb = lds + buf * DA_VBUF;
            f32x4 s[2][2][2];
#pragma unroll
            for (int sub = 0; sub < 2; ++sub)
#pragma unroll
                for (int c = 0; c < 2; ++c)
#pragma unroll
                    for (int s2 = 0; s2 < 2; ++s2) { f32x4 a = (f32x4){-mrun[c], -mrun[c], -mrun[c], -mrun[c]};
#pragma unroll
                        for (int ks = 0; ks < 2; ++ks) { const bf16x8 kf = (DBG & 2) ? qf[c][ks ^ 1] : *(const LAS bf16x8*)(kb + sub * 8192 + s2 * 1024 + koff[c][ks]); if constexpr ((DBG & 1) == 0) a = mfma16(kf, qf[c][ks], a); else a[ks] += __builtin_bit_cast(float, (int)kf[0] << 16); }
                        s[sub][c][s2] = a; }
            if (t * 64 + 63 > q0) {
                const int qrow = q0 + l15;
#pragma unroll
                for (int sub = 0; sub < 2; ++sub)
#pragma unroll
                    for (int c = 0; c < 2; ++c)
#pragma unroll
                        for (int s2 = 0; s2 < 2; ++s2)
#pragma unroll
                            for (int r = 0; r < 4; ++r) if (t * 64 + sub * 32 + 8 * g + 4 * s2 + r > qrow) s[sub][c][s2][r] = -INFINITY;
            }
#pragma unroll
            for (int sub = 0; sub < 2; ++sub) {
                bf16x8 pb[2]; f32x4 pz[2][2]; float ps[2];
                bf16x8 vfa[8];
#pragma unroll
                for (int k = 0; k < 8; ++k) vfa[k] = *(const LAS bf16x8*)(vb + voffs[sub] + k * 2048);
                __builtin_amdgcn_sched_barrier(0);
#pragma unroll
                for (int c = 0; c < 2; ++c) { ps[c] = 0.f;
#pragma unroll
                    for (int s2 = 0; s2 < 2; ++s2)
#pragma unroll
                        for (int r = 0; r < 4; ++r) { const float p = __builtin_amdgcn_exp2f(s[sub][c][s2][r]); pz[c][s2][r] = p; ps[c] += p; } }
                const bool bad = !(ps[0] <= 256.0f) || !(ps[1] <= 256.0f) || (t == 0 && sub == 0);
                if (__any(bad)) {
#pragma unroll
                    for (int c = 0; c < 2; ++c) { float mx = -INFINITY;
#pragma unroll
                        for (int sb = 0; sb < 2; ++sb) if (sb >= sub)
#pragma unroll
                            for (int s2 = 0; s2 < 2; ++s2) mx = fmaxf(mx, fmaxf(fmaxf(s[sb][c][s2][0], s[sb][c][s2][1]), fmaxf(s[sb][c][s2][2], s[sb][c][s2][3])));
                        mx = xmax16(mx); mx = xmax32(mx);
                        const float dl = (t == 0 && sub == 0) ? mx : fmaxf(mx, 0.f);
                        const float alpha = __builtin_amdgcn_exp2f(-dl); mrun[c] += dl; lsum[c] *= alpha;
#pragma unroll
                        for (int k = 0; k < 8; ++k) o[c][k] = o[c][k] * alpha;
#pragma unroll
                        for (int sb = 0; sb < 2; ++sb) if (sb >= sub)
#pragma unroll
                            for (int s2 = 0; s2 < 2; ++s2)
#pragma unroll
                                for (int r = 0; r < 4; ++r) s[sb][c][s2][r] -= dl;
                        ps[c] = 0.f;
#pragma unroll
                        for (int s2 = 0; s2 < 2; ++s2)
#pragma unroll
                            for (int r = 0; r < 4; ++r) { const float p = __builtin_amdgcn_exp2f(s[sub][c][s2][r]); pz[c][s2][r] = p; ps[c] += p; } }
                }
#pragma unroll
                for (int c = 0; c < 2; ++c) { lsum[c] += ps[c];
                    v4u w; w.x = pg8::cvtpk(pz[c][0][0], pz[c][0][1]); w.y = pg8::cvtpk(pz[c][0][2], pz[c][0][3]); w.z = pg8::cvtpk(pz[c][1][0], pz[c][1][1]); w.w = pg8::cvtpk(pz[c][1][2], pz[c][1][3]);
                    pb[c] = __builtin_bit_cast(bf16x8, w); }
#pragma unroll
                for (int k = 0; k < 8; ++k) { o[0][k] = mfma16(vfa[k], pb[0], o[0][k]); o[1][k] = mfma16(vfa[k], pb[1], o[1][k]); }
            }
        }
    };
    for (int t = 0; t < nt; ++t) {
        if ((DBG & 8) == 0 && t + 1 < nt) DA_LOAD(t + 1);
        step(t, t & 1);
        if ((DBG & 8) == 0 && t + 1 < nt) DA_STORE((t & 1) ^ 1);
        __syncthreads();
    }
#undef DA_LOAD
#undef DA_STORE
    float l0 = lsum[0], l1 = lsum[1];
    l0 += __shfl_xor(l0, 16); l0 += __shfl_xor(l0, 32); l1 += __shfl_xor(l1, 16); l1 += __shfl_xor(l1, 32);
    const float i0 = 1.0f / l0, i1 = lam / l1; float ss = 0.f;
#pragma unroll
    for (int k = 0; k < 8; ++k)
#pragma unroll
        for (int r = 0; r < 4; ++r) { const float v = o[0][k][r] * i0 - o[1][k][r] * i1; o[0][k][r] = v; ss += v * v; }
    ss += __shfl_xor(ss, 16); ss += __shfl_xor(ss, 32);
    const float rs = rsqrtf(ss * (1.0f / 128.0f) + EPS) * 0.8f;
    bf16* op = CAT + tokq * DM + h * 128 + 4 * g;
    f32x4 gg[8];
#pragma unroll
    for (int k = 0; k < 8; ++k) gg[k] = *(const f32x4*)(gdiff + k * 16 + 4 * g);
#pragma unroll
    for (int k = 0; k < 8; k += 2) { f32x4 v0 = o[0][k] * rs; v0 = v0 * gg[k]; f32x4 v1 = o[0][k + 1] * rs; v1 = v1 * gg[k + 1];
        unsigned a0 = pg8::cvtpk(v0[0], v0[1]), a1 = pg8::cvtpk(v0[2], v0[3]), b0 = pg8::cvtpk(v1[0], v1[1]), b1 = pg8::cvtpk(v1[2], v1[3]);
        { auto r = __builtin_amdgcn_permlane16_swap(a0, b0, false, false); a0 = r[0]; b0 = r[1]; } { auto r = __builtin_amdgcn_permlane16_swap(a1, b1, false, false); a1 = r[0]; b1 = r[1]; }
        v4u w; w.x = a0; w.y = a1; w.z = b0; w.w = b1;
        *(v4u*)(CAT + tokq * DM + h * 128 + (k + (g & 1)) * 16 + 4 * (g & 2)) = w; }
}

__device__ __forceinline__ bf16x8 pack8(const f32x4& a, const f32x4& b) { v4u w; w.x = pg8::cvtpk(a[0], a[1]); w.y = pg8::cvtpk(a[2], a[3]); w.z = pg8::cvtpk(b[0], b[1]); w.w = pg8::cvtpk(b[2], b[3]); return __builtin_bit_cast(bf16x8, w); }
constexpr int GL_QI = 0, GL_KI = 8192, GL_IMG = 16384, GL_EL = 2 * GL_IMG, GL_OB = GL_EL + 512, GL_OBS = 17408, GL_PS = GL_OB + 2 * GL_OBS, GL_END = GL_PS + 4096;

__device__ __forceinline__ void gla_unit(Frame& F, const bf16* P, const float* Bc, const bf16* GVT, bf16* CAT, const float* ggla, int b, int h) {
    const int lane = lane_here(), l15 = lane & 15, g = lane >> 4, eb = F.wave, tid = F.tid;
    LAS unsigned char* lds = F.lds + RING_OFF;
    const f32x4 zero4 = {0.f, 0.f, 0.f, 0.f};
    f32x4 S[4] = {zero4, zero4, zero4, zero4};
    bf16x8 If[4];
#pragma unroll
    for (int db = 0; db < 4; ++db) { const int ks = db >> 1;
#pragma unroll
        for (int j = 0; j < 8; ++j) { const int dp = 32 * ks + (j < 4 ? 4 * g + j : 16 + 4 * g + j - 4); If[db][j] = (dp == 16 * db + l15) ? (short)0x3F80 : (short)0; } }
    const int st = tid >> 3, sp = tid & 7, opc = tid & 15;
    const size_t tokb = (size_t)b * SEQ;
    const bf16* qsrc = P + (tokb + st) * PW + 1536 + h * 64 + sp * 8;
    const unsigned short* bsrc = (const unsigned short*)Bc + (tokb + st) * 256 + h * 64 + sp * 8;
    const bf16* Vrow = GVT + (size_t)(h * 128 + 16 * eb + l15) * NTOK + tokb + 4 * g;
    const f32x4 gg0 = *(const f32x4*)(ggla + opc * 8), gg1 = *(const f32x4*)(ggla + opc * 8 + 4);
    const int foffs[2] = {l15 * 128 + ((g ^ (l15 >> 1)) * 16), l15 * 128 + (((4 + g) ^ (l15 >> 1)) * 16)};
    const int sfr = (st >> 1) & 7, sch0 = (sp >> 2) * 4 + 2 * (sp & 1), shi = ((sp & 3) >> 1) * 8, sd0 = st * 128 + ((sch0 ^ sfr) * 16) + shi, sd1 = st * 128 + (((sch0 + 1) ^ sfr) * 16) + shi;
    v4u rq = *(const v4u*)qsrc, rk = *(const v4u*)(qsrc + 256); v4u rbh = *(const v4u*)bsrc;
#define GLA_STAGE(par) do { \
        float ee[8]; { const unsigned bh_[4] = {rbh.x, rbh.y, rbh.z, rbh.w}; _Pragma("unroll") for (int i = 0; i < 4; ++i) { ee[2 * i] = __expf((float)__builtin_bit_cast(_Float16, (unsigned short)(bh_[i] & 0xffffu))); ee[2 * i + 1] = __expf((float)__builtin_bit_cast(_Float16, (unsigned short)(bh_[i] >> 16))); } } \
        const unsigned qa[4] = {rq.x, rq.y, rq.z, rq.w}, ka[4] = {rk.x, rk.y, rk.z, rk.w}; v4u wq, wk; unsigned* wqp = (unsigned*)&wq; unsigned* wkp = (unsigned*)&wk; \
        _Pragma("unroll") for (int i = 0; i < 4; ++i) { const float q0 = __builtin_bit_cast(float, qa[i] << 16), q1 = __builtin_bit_cast(float, qa[i] & 0xffff0000u), k0 = __builtin_bit_cast(float, ka[i] << 16), k1 = __builtin_bit_cast(float, ka[i] & 0xffff0000u); \
            wqp[i] = pg8::cvtpk(q0 * ee[2 * i], q1 * ee[2 * i + 1]); wkp[i] = pg8::cvtpk(k0 * __builtin_amdgcn_rcpf(ee[2 * i]), k1 * __builtin_amdgcn_rcpf(ee[2 * i + 1])); } \
        { LAS unsigned char* ib_ = lds + (par) * GL_IMG; *(LAS v2u*)(ib_ + GL_QI + sd0) = (v2u){wq.x, wq.y}; *(LAS v2u*)(ib_ + GL_QI + sd1) = (v2u){wq.z, wq.w}; *(LAS v2u*)(ib_ + GL_KI + sd0) = (v2u){wk.x, wk.y}; *(LAS v2u*)(ib_ + GL_KI + sd1) = (v2u){wk.z, wk.w}; } \
        if (st == 63) { *(LAS f32x4*)(lds + GL_EL + (par) * 256 + sp * 32) = (f32x4){ee[0], ee[1], ee[2], ee[3]}; *(LAS f32x4*)(lds + GL_EL + (par) * 256 + sp * 32 + 16) = (f32x4){ee[4], ee[5], ee[6], ee[7]}; } } while (0)
    bf16x8 VFn[2];
#pragma unroll
    for (int ss = 0; ss < 2; ++ss) { const bf16* vp = Vrow + 32 * ss; const v2u v0 = *(const v2u*)vp, v1 = *(const v2u*)(vp + 16); v4u vv; vv.x = v0.x; vv.y = v0.y; vv.z = v1.x; vv.w = v1.y; VFn[ss] = __builtin_bit_cast(bf16x8, vv); }
    GLA_STAGE(0);
    rq = *(const v4u*)(qsrc + (size_t)64 * PW); rk = *(const v4u*)(qsrc + (size_t)64 * PW + 256); rbh = *(const v4u*)(bsrc + (size_t)64 * 256);
    v4u nq = rq, nk = rk, nbh = rbh;
    v4u rgn[2];
#pragma unroll
    for (int i = 0; i < 2; ++i) rgn[i] = *(const v4u*)(P + (tokb + ((tid + 512 * i) >> 4)) * PW + 2560 + h * 128 + opc * 8);
    __syncthreads();
    for (int c = 0; c < SEQ / 64; ++c) {
        const int par = c & 1; const size_t tok0 = tokb + c * 64;
        if (c + 2 < SEQ / 64) { nq = *(const v4u*)(qsrc + (size_t)(c + 2) * 64 * PW); nk = *(const v4u*)(qsrc + (size_t)(c + 2) * 64 * PW + 256);
            nbh = *(const v4u*)(bsrc + (size_t)(c + 2) * 64 * 256); }
        bf16x8 VF[2] = {VFn[0], VFn[1]};
        if (c + 1 < SEQ / 64) {
#pragma unroll
            for (int ss = 0; ss < 2; ++ss) { const bf16* vp = Vrow + (c + 1) * 64 + 32 * ss; const v2u v0 = *(const v2u*)vp, v1 = *(const v2u*)(vp + 16); v4u vv; vv.x = v0.x; vv.y = v0.y; vv.z = v1.x; vv.w = v1.y; VFn[ss] = __builtin_bit_cast(bf16x8, vv); } }
        v4u rg[2] = {rgn[0], rgn[1]};
        if (c + 1 < SEQ / 64) {
#pragma unroll
            for (int i = 0; i < 2; ++i) rgn[i] = *(const v4u*)(P + (tok0 + 64 + ((tid + 512 * i) >> 4)) * PW + 2560 + h * 128 + opc * 8); }
        const LAS unsigned char* qi = lds + par * GL_IMG + GL_QI; const LAS unsigned char* ki = lds + par * GL_IMG + GL_KI;
        bf16x8 qf[4][2], kf[4][2];
#pragma unroll
        for (int blk = 0; blk < 4; ++blk)
#pragma unroll
            for (int ks = 0; ks < 2; ++ks) { qf[blk][ks] = *(const LAS bf16x8*)(qi + foffs[ks] + blk * 2048); kf[blk][ks] = *(const LAS bf16x8*)(ki + foffs[ks] + blk * 2048); }
        const bf16x8 SF0 = pack8(S[0], S[1]), SF1 = pack8(S[2], S[3]);
        f32x4 O[4];
#pragma unroll
        for (int tb = 0; tb < 4; ++tb) { f32x4 o = mfma16(qf[tb][0], SF0, zero4); o = mfma16(qf[tb][1], SF1, o);
#pragma unroll
            for (int ss = 0; ss < 2; ++ss) if (2 * ss <= tb) { f32x4 a2[2];
#pragma unroll
                for (int hh = 0; hh < 2; ++hh) { const int sb = 2 * ss + hh; f32x4 a = zero4;
                    if (sb <= tb) { a = mfma16(kf[sb][0], qf[tb][0], zero4); a = mfma16(kf[sb][1], qf[tb][1], a);
                        if (sb == tb) {
#pragma unroll
                            for (int r = 0; r < 4; ++r) if (4 * g + r > l15) a[r] = 0.f; } }
                    a2[hh] = a; }
                o = mfma16(pack8(a2[0], a2[1]), VF[ss], o); }
            O[tb] = o; }
#pragma unroll
        for (int db = 0; db < 4; ++db) { f32x4 u = S[db];
#pragma unroll
            for (int ss = 0; ss < 2; ++ss) { const f32x4 t0 = mfma16(kf[2 * ss][db >> 1], If[db], zero4), t1 = mfma16(kf[2 * ss + 1][db >> 1], If[db], zero4); u = mfma16(pack8(t0, t1), VF[ss], u); }
            const f32x4 el = *(const LAS f32x4*)(lds + GL_EL + par * 256 + (16 * db + 4 * g) * 4);
            S[db] = u * el; }
        LAS unsigned char* ob = lds + GL_OB + par * GL_OBS; LAS float* ps = (LAS float*)(lds + GL_PS + par * 2048);
        float qs[4][4];
#pragma unroll
        for (int tb = 0; tb < 4; ++tb)
#pragma unroll
            for (int r = 0; r < 4; ++r) { const int t = 16 * tb + 4 * g + r; const float ov = O[tb][r]; float q = ov * ov;
                q += dppz<0x111>(q); q += dppz<0x112>(q); q += dppz<0x114>(q); q += dppz<0x118>(q);
                qs[tb][r] = q;
                *(LAS bf16*)(ob + t * 272 + (16 * eb + l15) * 2) = (bf16)f2bf(ov); }
        if (l15 == 15) {
#pragma unroll
            for (int tb = 0; tb < 4; ++tb)
#pragma unroll
                for (int r = 0; r < 4; ++r) ps[(16 * tb + 4 * g + r) * 8 + eb] = qs[tb][r]; }
        if (c + 1 < SEQ / 64) { GLA_STAGE(par ^ 1); rq = nq; rk = nk; rbh = nbh; }
        __syncthreads();
#pragma unroll
        for (int i = 0; i < 2; ++i) { const int ot = (tid + 512 * i) >> 4; const f32x4 p0 = *(const LAS f32x4*)(ps + ot * 8), p1 = *(const LAS f32x4*)(ps + ot * 8 + 4);
            const float ss = ((p0[0] + p0[1]) + (p0[2] + p0[3])) + ((p1[0] + p1[1]) + (p1[2] + p1[3])); const float rs = rsqrtf(ss * (1.0f / 128.0f) + EPS);
            const v4u ov = *(const LAS v4u*)(ob + ot * 272 + opc * 16); const unsigned oa[4] = {ov.x, ov.y, ov.z, ov.w}, ga[4] = {rg[i].x, rg[i].y, rg[i].z, rg[i].w};
            const float gn[8] = {gg0[0], gg0[1], gg0[2], gg0[3], gg1[0], gg1[1], gg1[2], gg1[3]}; v4u w; unsigned* wp = (unsigned*)&w;
#pragma unroll
            for (int j = 0; j < 4; ++j) { const float o0 = __builtin_bit_cast(float, oa[j] << 16), o1 = __builtin_bit_cast(float, oa[j] & 0xffff0000u), g0 = __builtin_bit_cast(float, ga[j] << 16), g1 = __builtin_bit_cast(float, ga[j] & 0xffff0000u);
                wp[j] = pg8::cvtpk(o0 * rs * gn[2 * j] * g0 * __builtin_amdgcn_rcpf(1.0f + __builtin_amdgcn_exp2f(-1.4426950408889634f * g0)), o1 * rs * gn[2 * j + 1] * g1 * __builtin_amdgcn_rcpf(1.0f + __builtin_amdgcn_exp2f(-1.4426950408889634f * g1))); }
            *(v4u*)(CAT + (tok0 + ot) * DM + 512 + h * 128 + opc * 8) = w; }
    }
#undef GLA_STAGE
    __syncthreads();
}

__device__ __forceinline__ void router_phase(Frame& F, const bf16* X2, const bf16* W3, const float* b_router, float* rsl, float* gate, unsigned* assign, unsigned* list, gu32* cnt) {
    LAS float* part = (LAS float*)(F.lds + RING_OFF);
    LAS float* lg = part;
    LAS float* pss = (LAS float*)(F.lds + XCH_OFF);
    LAS unsigned* hist = (LAS unsigned*)(F.lds + XCH2_OFF);
    const int tid = F.tid, lane = lane_here(), r16 = lane & 15, kq = lane >> 4, wv = F.wave, t = tid & 63;
    bf16x8 wf[3][2][4];
#pragma unroll
    for (int sp = 0; sp < 3; ++sp)
#pragma unroll
        for (int eb = 0; eb < 2; ++eb)
#pragma unroll
            for (int ks = 0; ks < 4; ++ks) wf[sp][eb][ks] = *(const bf16x8*)(W3 + (size_t)sp * DM * NEXP + (size_t)(16 * eb + r16) * DM + 128 * wv + 32 * ks + 8 * kq);
    const f32x4 brq0 = *(const f32x4*)(b_router + 8 * (tid & 3)), brq1 = *(const f32x4*)(b_router + 8 * (tid & 3) + 4);
    for (int blk = F.vcu; blk < NTOK / 128; blk += F.G) {
        const size_t tok0 = (size_t)blk * 128;
        const bf16* xp = X2 + (tok0 + r16) * DM + 128 * wv + 8 * kq;
        bf16x8 xq[6][4];
#define RT_LD(rb, sl) do { _Pragma("unroll") for (int ks = 0; ks < 4; ++ks) xq[sl][ks] = *(const bf16x8*)(xp + (size_t)(rb) * 16 * DM + 32 * ks); } while (0)
        RT_LD(0, 0); RT_LD(1, 1); RT_LD(2, 2); RT_LD(3, 3); RT_LD(4, 4);
#pragma unroll
        for (int rb = 0; rb < 8; ++rb) {
            if (rb + 5 < 8) RT_LD(rb + 5, (rb + 5) % 6);
            f32x4 acc0 = {0.f, 0.f, 0.f, 0.f}, acc1 = acc0; float ssq = 0.f;
#pragma unroll
            for (int ks = 0; ks < 4; ++ks) { const bf16x8 xf = xq[rb % 6][ks];
#pragma unroll
                for (int sp = 0; sp < 3; ++sp) { acc0 = mfma16(xf, wf[sp][0][ks], acc0); acc1 = mfma16(xf, wf[sp][1][ks], acc1); }
#pragma unroll
                for (int i = 0; i < 8; ++i) { const float xv = __builtin_bit_cast(float, (unsigned)(unsigned short)xf[i] << 16); ssq += xv * xv; } }
            ssq += __shfl_xor(ssq, 16); ssq += __shfl_xor(ssq, 32);
            if (kq == 0) pss[wv * 128 + 16 * rb + r16] = ssq;
#pragma unroll
            for (int j = 0; j < 4; ++j) { const int tl = 16 * rb + 4 * kq + j; part[(wv * 128 + tl) * 32 + r16] = acc0[j]; part[(wv * 128 + tl) * 32 + 16 + r16] = acc1[j]; }
        }
#undef RT_LD
        __syncthreads();
        { const int tk = tid >> 2, q = tid & 3; f32x4 s0 = {0.f, 0.f, 0.f, 0.f}, s1 = s0; float sq = 0.f;
#pragma unroll
          for (int w = 0; w < 8; ++w) { s0 = s0 + *(const LAS f32x4*)(part + (w * 128 + tk) * 32 + 8 * q); s1 = s1 + *(const LAS f32x4*)(part + (w * 128 + tk) * 32 + 8 * q + 4); sq += pss[w * 128 + tk]; }
          const float rs = rsqrtf(sq * (1.0f / DM) + EPS); const f32x4 b0 = brq0, b1 = brq1;
          s0 = s0 * rs + b0; s1 = s1 * rs + b1;
          __syncthreads();
#pragma unroll
          for (int i = 0; i < 4; ++i) { lg[tk * 33 + 8 * q + i] = s0[i]; lg[tk * 33 + 8 * q + 4 + i] = s1[i]; }
          if (q == 0) lg[tk * 33 + 32] = rs; }
        if (tid < 32) hist[tid] = 0u;
        __syncthreads();
        float tv[4], gv[4] = {0.f, 0.f, 0.f, 0.f}, rs = 0.f; int te[4] = {0, 0, 0, 0}; unsigned lpos[4] = {0u, 0u, 0u, 0u};
        LAS unsigned* hs = hist; LAS unsigned* gbase = hist + 64;
        if (tid < 128) {
            float lv[32];
#pragma unroll
            for (int e = 0; e < 32; ++e) lv[e] = lg[tid * 33 + e];
            rs = lg[tid * 33 + 32];
#pragma unroll
            for (int k = 0; k < 4; ++k) { float best = -INFINITY; int bi = 0;
#pragma unroll
                for (int e = 0; e < 32; ++e) if (lv[e] > best) { best = lv[e]; bi = e; }
                tv[k] = best; te[k] = bi;
#pragma unroll
                for (int e = 0; e < 32; ++e) if (e == bi) lv[e] = -INFINITY; }
            const float e1 = __expf(tv[1] - tv[0]), e2 = __expf(tv[2] - tv[0]), e3 = __expf(tv[3] - tv[0]); const float inv = 1.0f / (1.0f + e1 + e2 + e3);
            gv[0] = inv; gv[1] = e1 * inv; gv[2] = e2 * inv; gv[3] = e3 * inv;
#pragma unroll
            for (int k = 0; k < 4; ++k) lpos[k] = __hip_atomic_fetch_add(hs + te[k], 1u, __ATOMIC_RELAXED, __HIP_MEMORY_SCOPE_WORKGROUP);
        }
        __syncthreads();
        if (tid < 32) { const unsigned n = hs[tid]; gbase[tid] = n ? __hip_atomic_fetch_add(cnt + 64 * tid, n, RLX_AGENT) : 0u; }
        __syncthreads();
        if (tid < 128) { const size_t tok = tok0 + tid;
            unsigned asg[4];
#pragma unroll
            for (int k = 0; k < 4; ++k) { const unsigned pos = gbase[te[k]] + lpos[k]; list[(size_t)te[k] * NTOK + pos] = (unsigned)tok; rsl[(size_t)te[k] * NTOK + pos] = rs; asg[k] = ((unsigned)te[k] << 16) | pos; }
            *(v4u*)(assign + tok * 4) = (v4u){asg[0], asg[1], asg[2], asg[3]}; *(f32x4*)(gate + tok * 4) = (f32x4){gv[0], gv[1], gv[2], gv[3]};
        }
        __syncthreads();
    }
}
__device__ __forceinline__ int moe_tables(Frame& F) {
    LAS unsigned char* tile_e = F.lds + TAB_OFF; LAS int* tstart = (LAS int*)(F.lds + TAB_TSTART); LAS int* lc = (LAS int*)(F.lds + TAB_CNT);
    if (F.tid < 32) lc[F.tid] = (int)__hip_atomic_load(F.ctl + CW_CNT + 64 * F.tid, RLX_AGENT);
    __syncthreads();
    if (F.tid == 0) { int s = 0; for (int e = 0; e < 32; ++e) { tstart[e] = s; s += (lc[e] + 255) >> 8; } tstart[32] = s; }
    __syncthreads();
    const int T = tstart[32];
    for (int i = F.tid; i < T; i += 512) { int e = 0;
#pragma unroll
        for (int k = 1; k < 32; ++k) e += (tstart[k] <= i) ? 1 : 0;
        tile_e[i] = (unsigned char)e; }
    __syncthreads();
    return T;
}
__device__ __forceinline__ void final_phase(Frame& F, const bf16* X2, float* out, const unsigned char* Y, const float* gate, const unsigned* assign, const float* gfin) {
    (void)moe_tables(F);
    const LAS int* tstart = (const LAS int*)(F.lds + TAB_TSTART);
    const int gw = F.vcu * NWAVES + F.wave, NGW = F.G * NWAVES, lane = lane_here();
    unsigned an[2][4]; float gn[2][4];
#define FIN_ROUTE(t0) do { _Pragma("unroll") for (int u = 0; u < 2; ++u) { const int tok_ = ((t0) + u * NGW < NTOK) ? (t0) + u * NGW : ((t0) < NTOK ? (t0) : gw); \
        const v4u a4 = *(const v4u*)(assign + (size_t)tok_ * 4); const f32x4 g4 = *(const f32x4*)(gate + (size_t)tok_ * 4); \
        an[u][0] = a4.x; an[u][1] = a4.y; an[u][2] = a4.z; an[u][3] = a4.w; gn[u][0] = g4.x; gn[u][1] = g4.y; gn[u][2] = g4.z; gn[u][3] = g4.w; } } while (0)
    FIN_ROUTE(gw);
    f32x4 gfv[4];
#pragma unroll
    for (int j = 0; j < 4; ++j) gfv[j] = ((const f32x4*)gfin)[lane + 64 * j];
    for (int tok0 = gw; tok0 < NTOK; tok0 += 2 * NGW) {
        f32x4 v[2][4]; unsigned yw[2][4][4]; float gk[2][4];
#pragma unroll
        for (int u = 0; u < 2; ++u) { const int tok = (tok0 + u * NGW < NTOK) ? tok0 + u * NGW : tok0;
#pragma unroll
            for (int k = 0; k < 4; ++k) { const unsigned a = an[u][k]; gk[u][k] = gn[u][k]; const size_t row = (size_t)tstart[a >> 16] * 256 + (a & 0xffffu);
                const unsigned* yr = (const unsigned*)(Y + row * DM) + lane;
#pragma unroll
                for (int j = 0; j < 4; ++j) yw[u][k][j] = yr[64 * j]; }
            const v2u* xin = (const v2u*)(X2 + (size_t)tok * DM) + lane;
#pragma unroll
            for (int j = 0; j < 4; ++j) { const v2u w = xin[64 * j]; v[u][j] = (f32x4){__builtin_bit_cast(float, w.x << 16), __builtin_bit_cast(float, w.x & 0xffff0000u), __builtin_bit_cast(float, w.y << 16), __builtin_bit_cast(float, w.y & 0xffff0000u)}; } }
        FIN_ROUTE(tok0 + 2 * NGW);
#pragma unroll
        for (int u = 0; u < 2; ++u) { const int tok = (tok0 + u * NGW < NTOK) ? tok0 + u * NGW : tok0;
#pragma unroll
            for (int k = 0; k < 4; ++k)
#pragma unroll
                for (int j = 0; j < 4; ++j) { const unsigned w = yw[u][k][j]; const auto lo = __builtin_amdgcn_cvt_pk_f32_fp8((int)w, false), hi = __builtin_amdgcn_cvt_pk_f32_fp8((int)w, true);
                    v[u][j].x += gk[u][k] * lo[0]; v[u][j].y += gk[u][k] * lo[1]; v[u][j].z += gk[u][k] * hi[0]; v[u][j].w += gk[u][k] * hi[1]; }
            float s = 0.f;
#pragma unroll
            for (int j = 0; j < 4; ++j) s += (v[u][j].x * v[u][j].x + v[u][j].y * v[u][j].y) + (v[u][j].z * v[u][j].z + v[u][j].w * v[u][j].w);
            const float rs = rsqrtf(wave_sum(s) * (1.0f / DM) + EPS); f32x4* xr = (f32x4*)(out + (size_t)tok * DM) + lane;
#pragma unroll
            for (int j = 0; j < 4; ++j) xr[64 * j] = v[u][j] * rs * gfv[j]; }
    }
#undef FIN_ROUTE
}

constexpr int NPHASE = 10;
struct Args { const void* in[28]; float* out; unsigned char* ws; int ph_lo, ph_hi; };
__global__ void __launch_bounds__(NWAVES * 64, 2) mk_fwd(Args args) {
    extern __shared__ __attribute__((aligned(16))) unsigned char lds[];
    Frame F;
    F.lds = (LAS unsigned char*)lds;
    F.MISC = (volatile LAS unsigned*)(F.lds + MISC_OFF);
    F.tid = threadIdx.x; F.lane = F.tid & 63; F.wave = __builtin_amdgcn_readfirstlane(F.tid >> 6);
    F.G = gridDim.x; { const int bx = blockIdx.x; F.vcu = (F.G % 8 == 0) ? (bx % 8) * (F.G / 8) + bx / 8 : bx; }
    F.ws = args.ws; F.out = args.out; F.ctl = (gu32*)(args.ws + WS_CTL);
    unsigned char* ws = args.ws;
    typedef const void* const volatile __attribute__((address_space(4))) kargp_t;
    kargp_t* const kargs = (kargp_t*)__builtin_amdgcn_kernarg_segment_ptr();
#define INP(k) ((const float*)kargs[k])
    for (int u = F.tid; u < (LDS_BYTES - LDSCTL_OFF) / 4; u += NWAVES * 64) ((LAS unsigned*)(F.lds + LDSCTL_OFF))[u] = 0u;
    __syncthreads();
    const int lo = args.ph_lo, hi = args.ph_hi;
    const bool single = (hi - lo) > 1;
    XcdBarrier bar; bar.bar = (unsigned*)(F.ctl + CW_BAR); bar.x = 0; bar.st = nullptr;
    if (single) bar = xcd_barrier_post((unsigned*)(F.ctl + CW_BAR), F.MISC + 8);
#define IN(k) (lo <= (k) && (k) < hi)
#if defined(PROBE_K0)
    LAS unsigned long long* tsl = (LAS unsigned long long*)(F.lds + TS_OFF);
    if (F.tid == 0) tsl[0] = rt();
#define SEAM(k) do { if (IN(k) && IN((k) + 1)) xcd_barrier(bar); if (F.tid == 0) tsl[(k) + 1] = rt(); } while (0)
#define SEAM_LOCAL(k) do { if (F.tid == 0) tsl[(k) + 1] = rt(); } while (0)
#else
#define SEAM(k) do { if (IN(k) && IN((k) + 1)) xcd_barrier(bar); } while (0)
#define SEAM_LOCAL(k) do { } while (0)
#endif
    typedef pg8::bf16_t hb;
    const int bx = (int)blockIdx.x;

    if (IN(0)) { In I;
        I.x = (const float*)INP(0);
        I.mem = (const float*)INP(1);
        I.positions = (const int*)INP(2);
        I.norm_mix_g = (const float*)INP(3);
        I.w_in = (const float*)INP(4);
        I.lq1 = (const float*)INP(5);
        I.lk1 = (const float*)INP(6);
        I.lq2 = (const float*)INP(7);
        I.lk2 = (const float*)INP(8);
        I.diff_norm_g = (const float*)INP(9);
        I.w_alpha2 = (const float*)INP(10);
        I.b_alpha = (const float*)INP(11);
        I.gla_norm_g = (const float*)INP(12);
        I.w_out = (const float*)INP(13);
        I.norm_cross_g = (const float*)INP(14);
        I.norm_mem_g = (const float*)INP(15);
        I.w_cq = (const float*)INP(16);
        I.w_ck = (const float*)INP(17);
        I.w_cv = (const float*)INP(18);
        I.w_co = (const float*)INP(19);
        I.norm_ffn_g = (const float*)INP(20);
        I.w_router = (const float*)INP(21);
        I.b_router = (const float*)INP(22);
        I.w_up = (const float*)INP(23);
        I.b_up = (const float*)INP(24);
        I.w_down = (const float*)INP(25);
        I.b_down = (const float*)INP(26);
        I.norm_final_g = (const float*)INP(27);
        p0_prologue(F, I); }
    SEAM(0);
    if (IN(1)) {
        pg8::Gemm g{(const hb*)(ws + WS_HN), (const hb*)(ws + WS_WINT), NTOK, 3328, DM, DM, DM, 127, 127};
        typedef pg8::OrderP1<(unsigned)WS_HN, (unsigned)WS_WINT, (unsigned)WS_MN, (unsigned)WS_WCK, (unsigned)WS_WCV> OrdP1; OrdP1 S; S.G = F.G; S.c = bx; S.ws = (const char*)ws;
        pg8::EpiP1 E{pg8::EpiProj{(hb*)(ws + WS_P), (float*)(ws + WS_LA), (const float*)(ws + WS_CS), INP(11)}, pg8::EpiPlain{(hb*)(ws + WS_VT) - (size_t)1024 * NTOK, NTOK, 1.0f},
                     pg8::EpiPlain{(hb*)(ws + WS_KX), DM, 1.0f}, pg8::EpiPlain{(hb*)(ws + WS_VXT), DM, 1.0f}};
        pg8::gemm_phase<pg8::EpiP1, OrdP1, true, true, false, false>(F.lds + RING_OFF, g, S, E);
    }
    SEAM(1);
    if (IN(2)) {
        float lam;
        { const int ln = lane_here(); const float a = INP(5)[ln] * INP(6)[ln], c = INP(7)[ln] * INP(8)[ln]; lam = __expf(wave_sum(a)) - __expf(wave_sum(c)) + 0.2f; }
        LAS int* qslot = (LAS int*)(F.lds + TAB_OFF);
        for (;;) {
            if (F.tid == 0) qslot[0] = (int)__hip_atomic_fetch_add(F.ctl + CW_Q2, 1u, RLX_AGENT);
            __syncthreads();
            const int u = qslot[0];
            __syncthreads();
            if (u >= 64 + 1024 + MOE_UNITS) break;
            int au = -1;
            if (u >= 64) { const int v = u - 64, gi = v / 11, r = v - gi * 11;
                if (r >= 8) { moe_convert_unit(gi * 3 + (r - 8), INP(23), INP(25), INP(20), ws, F.wave, lane_here()); continue; }
                au = gi * 8 + r; }
#if defined(PROBE_SPLIT)
            if (u < 64) continue;
#endif
            if (u < 64) { gla_unit(F, (const bf16*)(ws + WS_P), (const float*)(ws + WS_LA), (const bf16*)(ws + WS_GVT), (bf16*)(ws + WS_CAT), INP(12), u >> 2, u & 3);
            }
            else { const int v = au, bh = v & 63, qb = 15 - (v >> 6);
                diffattn_unit(F, (const bf16*)(ws + WS_P), (const bf16*)(ws + WS_VT), (bf16*)(ws + WS_CAT), INP(9), lam, bh >> 2, bh & 3, qb); }
        }
    }
#if defined(PROBE_SPLIT)
    if (IN(2)) { xcd_barrier(bar); if (F.tid == 0) tsl[13] = rt();
        for (int u = F.vcu; u < 64; u += F.G) gla_unit(F, (const bf16*)(ws + WS_P), (const float*)(ws + WS_LA), (const bf16*)(ws + WS_GVT), (bf16*)(ws + WS_CAT), INP(12), u >> 2, u & 3); }
#endif
    SEAM(2);
    if (IN(3)) {
        { pg8::Gemm g{(const hb*)(ws + WS_CAT), (const hb*)(ws + WS_WOUT), NTOK, DM, DM, DM, DM, 127, 127}; pg8::StaticOrder S; S.init(NTOK, DM, F.G, bx);
          pg8::EpiRes1 E{(const hb*)(ws + WS_HN), (hb*)(ws + WS_X1B), (float*)(ws + WS_SSP1), (const float*)(ws + WS_RSX), (PG8_LAS unsigned char*)(F.lds + EOP_OFF)};
          pg8::gemm_phase<pg8::EpiRes1, pg8::StaticOrder, true, true, false, false>(F.lds + RING_OFF, g, S, E); }
        { pg8::Gemm g{(const hb*)(ws + WS_KX), (const hb*)(ws + WS_WCQ), 64 * 256, DM, 256, DM, DM, 127, 127};
          typedef pg8::OrderGH<(unsigned)WS_KX, (unsigned)WS_WCQ, (unsigned)WS_WCO, (unsigned)WS_VXT> OrdGH; OrdGH S; S.G = F.G; S.c = bx; S.ws = (const char*)ws;
          pg8::EpiGH E{pg8::EpiPlain{(hb*)(ws + WS_GT), DM, 1.0f}, pg8::EpiPlain{(hb*)(ws + WS_HT), DM, 1.0f}};
          pg8::gemm_phase<pg8::EpiGH, OrdGH, true, true>(F.lds + RING_OFF, g, S, E); }
    }
    SEAM(3);
    if (IN(4)) {
        pg8::Gemm g{(const hb*)(ws + WS_X1B), (const hb*)(ws + WS_GT), NTOK, 256, DM, DM, DM, 127, 127}; pg8::OrderXS S; S.init(F.G, bx);
        pg8::EpiSoftmaxN E{(hb*)(ws + WS_PX), (const float*)(ws + WS_SSP1), (PG8_LAS float*)(F.lds + XCH_OFF), (PG8_LAS float*)(F.lds + XCH2_OFF)};
        pg8::gemm_phase<pg8::EpiSoftmaxN, pg8::OrderXS, true, true>(F.lds + RING_OFF, g, S, E);
    }
    SEAM(4);
    if (IN(5)) {
        pg8::Gemm g{(const hb*)(ws + WS_PX), (const hb*)(ws + WS_HT), NTOK, DM, DM, DM, DM, 127, 127}; pg8::OrderXO S; S.init(F.G, bx);
        pg8::EpiRes2 E{(hb*)(ws + WS_X1B), ws + WS_X2B};
        pg8::gemm_phase<pg8::EpiRes2, pg8::OrderXO, true, true, false, false>(F.lds + RING_OFF, g, S, E);
    }
    SEAM(5);
    if (IN(6)) router_phase(F, (const bf16*)(ws + WS_X1B), (const bf16*)(ws + WS_WR), INP(22), (float*)(ws + WS_RSL), (float*)(ws + WS_GATE), (unsigned*)(ws + WS_ASSIGN), (unsigned*)(ws + WS_LIST), F.ctl + CW_CNT);
    SEAM(6);
    if (IN(7)) {
        const int T = moe_tables(F);
        pg8::Gemm g{(const hb*)(ws + WS_X2B), (const hb*)(ws + WS_WUP), T * 256, NEXP * 2048, 512, 512, 512, 127, 122}; pg8::MoeOrderG S;
        S.init(T, 8, F.G, bx, (const PG8_LAS unsigned char*)(F.lds + TAB_OFF), (const PG8_LAS int*)(F.lds + TAB_TSTART), (const PG8_LAS int*)(F.lds + TAB_CNT), (const unsigned*)(ws + WS_LIST), (PG8_LAS unsigned*)(F.lds + XCH_OFF));
        pg8::EpiUp E{ws + WS_ACT, (const float*)(ws + WS_RSL), (const PG8_LAS int*)(F.lds + TAB_TSTART), (const PG8_LAS int*)(F.lds + TAB_CNT), INP(24), (PG8_LAS unsigned char*)(F.lds + EOP_OFF)};
        pg8::gemm_phase<pg8::EpiUp, pg8::MoeOrderG, true, true, true, false>(F.lds + RING_OFF, g, S, E);
    }
    SEAM(7);
    if (IN(8)) {
        const int T = moe_tables(F);
        pg8::Gemm g{(const hb*)(ws + WS_ACT), (const hb*)(ws + WS_WDN), T * 256, NEXP * 1024, 512, 512, 512, 127, 122}; pg8::MoeOrder S; S.init(T, 4, F.G, bx, (const PG8_LAS unsigned char*)(F.lds + TAB_OFF));
        pg8::EpiDown E{ws + WS_Y, INP(26), (PG8_LAS unsigned char*)(F.lds + EOP_OFF)};
        pg8::gemm_phase<pg8::EpiDown, pg8::MoeOrder, true, true, true, false>(F.lds + RING_OFF, g, S, E);
    }
    SEAM(8);
    if (IN(9)) final_phase(F, (const bf16*)(ws + WS_X1B), F.out, (const unsigned char*)(ws + WS_Y), (const float*)(ws + WS_GATE), (const unsigned*)(ws + WS_ASSIGN), INP(27));
#if defined(PROBE_ATT)
    { xcd_barrier(bar); if (F.tid == 0) tsl[13] = rt();
#pragma unroll 1
      for (int i2 = 2 * F.vcu; i2 < 1024; i2 += 2 * F.G)
#pragma unroll 1
          for (int rep = 0; rep < 2; ++rep) { const int i = i2 >> 1, bh = i >> 3, jj = i & 7;
              diffattn_unit<PROBE_ATT>(F, (const bf16*)(ws + WS_P), (const bf16*)(ws + WS_VT), (bf16*)(ws + WS_ACT), INP(9), 0.5f, bh >> 2, bh & 3, rep ? jj : 15 - jj); }
      xcd_barrier(bar); if (F.tid == 0) tsl[14] = rt(); }
#endif
#if defined(PROBE_GEMM)
    { xcd_barrier(bar); if (F.tid == 0) tsl[13] = rt();
      const int T = moe_tables(F);
      pg8::Gemm g{(const hb*)(ws + WS_X2B), (const hb*)(ws + WS_WUP), T * 256, NEXP * 2048, 512, 512, 512, 127, 122}; pg8::MoeOrderG S;
      S.init(T, 8, F.G, bx, (const PG8_LAS unsigned char*)(F.lds + TAB_OFF), (const PG8_LAS int*)(F.lds + TAB_TSTART), (const PG8_LAS int*)(F.lds + TAB_CNT), (const unsigned*)(ws + WS_LIST), (PG8_LAS unsigned*)(F.lds + XCH_OFF));
      pg8::EpiUp E{ws + WS_ACT, (const float*)(ws + WS_RSL), (const PG8_LAS int*)(F.lds + TAB_TSTART), (const PG8_LAS int*)(F.lds + TAB_CNT), INP(24), (PG8_LAS unsigned char*)(F.lds + EOP_OFF)};
      pg8::gemm_phase<pg8::EpiUp, pg8::MoeOrderG, true, true, true, false, PROBE_GEMM>(F.lds + RING_OFF, g, S, E);
      xcd_barrier(bar); if (F.tid == 0) tsl[14] = rt(); }
#endif
#if defined(PROBE_K0)
#ifndef PROBE_UNIT
#define PROBE_UNIT 1600
#endif
    { if (F.tid == 0) { tsl[NPHASE] = rt();
        const int ks[2] = {PROBE_K0, PROBE_K1}; unsigned long long code = 0, mul = 1;
        for (int i = 0; i < 2; ++i) { unsigned long long dt = ks[i] == 94 ? tsl[14] - tsl[13] : ks[i] == 97 ? tsl[13] - tsl[2] : ks[i] == 98 ? tsl[3] - tsl[13] : ks[i] == 95 ? tsl[13] - tsl[0] : ks[i] == 96 ? tsl[14] - tsl[13] : tsl[ks[i] + 1] - tsl[ks[i]]; unsigned long long q = (dt + PROBE_UNIT / 2) / PROBE_UNIT; if (q > 63) q = 63; code += q * mul; mul *= 64; }
        tsl[15] = code * 6400ull; }
      __syncthreads();
      const unsigned long long t0 = rt(), wait = tsl[15]; float x = (float)F.tid, y = 1.0001f;
      while (rt() - t0 < wait) {
#pragma unroll
          for (int i = 0; i < 64; ++i) x = x * y + 0.5f; }
      if (x == 12345.678f) F.out[0] = x; }
#endif
#undef IN
#undef SEAM
#undef SEAM_LOCAL
}

#ifndef MK_N_LAUNCHES
#define MK_N_LAUNCHES 1
#endif
extern "C" void kernel_launch(void* const* d_in, const int* in_sizes, int n_in, void* d_out, int out_size, void* d_ws, size_t ws_size, hipStream_t stream) {
    static int grid = 0;
    if (grid == 0) {
        if (n_in != 28 || out_size != NTOK * DM || ws_size < WS_END) { fprintf(stderr, "kernel_launch: unexpected shapes: n_in %d out %d ws %zu (need %zu)\n", n_in, out_size, ws_size, (size_t)WS_END); grid = -1; return; }
        int dev = 0, cus = 0, per_cu = 0;
        if (hipGetDevice(&dev) != hipSuccess || hipDeviceGetAttribute(&cus, hipDeviceAttributeMultiprocessorCount, dev) != hipSuccess) { fprintf(stderr, "kernel_launch: device query failed\n"); grid = -1; return; }
        if (hipFuncSetAttribute((const void*)mk_fwd, hipFuncAttributeMaxDynamicSharedMemorySize, LDS_BYTES) != hipSuccess) { fprintf(stderr, "kernel_launch: hipFuncSetAttribute failed\n"); grid = -1; return; }
        if (hipOccupancyMaxActiveBlocksPerMultiprocessor(&per_cu, (const void*)mk_fwd, NWAVES * 64, LDS_BYTES) != hipSuccess || per_cu < 1) { fprintf(stderr, "kernel_launch: occupancy query reports %d workgroups per CU\n", per_cu); (void)hipGetLastError(); grid = -1; return; }
        grid = cus;
    }
    if (grid < 0) return;
    (void)hipMemsetAsync((char*)d_ws + WS_CTL, 0, CTL_ZERO_BYTES, stream);
    Args a{};
    for (int i = 0; i < 28; ++i) a.in[i] = d_in[i];
    a.out = (float*)d_out; a.ws = (unsigned char*)d_ws;
    if (MK_N_LAUNCHES == 1) { a.ph_lo = 0; a.ph_hi = NPHASE; hipLaunchKernelGGL(mk_fwd, dim3(grid), dim3(NWAVES * 64), LDS_BYTES, stream, a); }
    else for (int p = 0; p < NPHASE; ++p) { a.ph_lo = p; a.ph_hi = p + 1; hipLaunchKernelGGL(mk_fwd, dim3(grid), dim3(NWAVES * 64), LDS_BYTES, stream, a); }
}
```
